# Optimizing an MI355X kernel written in HIP

```python
import jax
import jax.numpy as jnp
from jax import lax
import numpy as np

D_MODEL = 1024
BATCH = 4
SEQ = 4096
DEPTH = 2

GRID_W = 64
CTX_LEN = 256
N_GROUPS = 4
GROUP_W = D_MODEL // N_GROUPS
EPS = 1e-6

FNET_GROUPS = 4
FNET_CH = GROUP_W // FNET_GROUPS

LRU_HEADS = 4
LRU_HEAD_DIM = GROUP_W // LRU_HEADS
LRU_CONV = 4
LRU_C = 8.0

MLA_HEADS = 4
MLA_NOPE = 64
MLA_ROPE = 32
MLA_V = GROUP_W // MLA_HEADS
MLA_Q_LORA = 256
MLA_KV_LORA = 128
ROPE_BASE = 10000.0
Q_BLOCK = 128
ATTN_SCALE = (MLA_NOPE + MLA_ROPE) ** -0.5

SC_CONV = 3

N_EXPERTS = 32
TOP_K = 4
D_EXPERT = D_MODEL
SWIGLU_ALPHA = 1.702
SWIGLU_LIMIT = 7.0
MOE_BLOCK = 128

PROJ_SIZES = (GROUP_W, GROUP_W, GROUP_W, MLA_Q_LORA, MLA_KV_LORA, MLA_ROPE, GROUP_W, GROUP_W, GROUP_W)
P_TOTAL = 6 * GROUP_W + MLA_Q_LORA + MLA_KV_LORA + MLA_ROPE

kernel_name = 'hybrid_parallel_group_diffusion_block'


def rms_norm(x, g):
    x32 = x.astype(jnp.float32)
    y = x32 * lax.rsqrt(jnp.mean(x32 * x32, axis=-1, keepdims=True) + EPS)
    return (y * g.astype(jnp.float32)).astype(x.dtype)


def modulate(h, shift, scale):
    return h * (1 + scale) + shift


def split_projection(p):
    idx = np.cumsum(PROJ_SIZES)[:-1].tolist()
    return jnp.split(p, idx, axis=-1)


def depthwise_conv(u, w, b, left):
    k_w = w.shape[0]
    n = u.shape[1]
    up = jnp.pad(u, ((0, 0), (left, k_w - 1 - left), (0, 0)))
    return sum(w[k] * up[:, k:k + n] for k in range(k_w)) + b


def fourier_mix(u):
    bsz, n, _ = u.shape
    ug = u.astype(jnp.float32).reshape(bsz, n, FNET_GROUPS, FNET_CH)
    y = jnp.fft.fft2(ug, axes=(1, 3), norm='ortho').real
    return y.reshape(bsz, n, GROUP_W).astype(u.dtype)


def _linear_combine(e1, e2):
    a1, b1 = e1
    a2, b2 = e2
    return a1 * a2, a2 * b1 + b2


def rglru_direction(u, h0, conv_w, conv_b, w_a, b_a, w_i, b_i, lam, reverse):
    left = 1 if reverse else LRU_CONV // 2
    xc = depthwise_conv(u, conv_w, conv_b, left).astype(jnp.float32)
    bsz, n, wdt = xc.shape
    xh = xc.reshape(bsz, n, LRU_HEADS, LRU_HEAD_DIM)
    r = jax.nn.sigmoid(jnp.einsum('bnhd,hde->bnhe', xh, w_a.astype(jnp.float32)).reshape(bsz, n, wdt) + b_a.astype(jnp.float32))
    i = jax.nn.sigmoid(jnp.einsum('bnhd,hde->bnhe', xh, w_i.astype(jnp.float32)).reshape(bsz, n, wdt) + b_i.astype(jnp.float32))
    a = jnp.exp(-LRU_C * r * jax.nn.softplus(-lam.astype(jnp.float32)))
    bterm = jnp.sqrt(jnp.maximum(1.0 - a * a, 0.0)) * (i * xc)
    a_cum, b_cum = lax.associative_scan(_linear_combine, (a, bterm), axis=1, reverse=reverse)
    h = a_cum * h0[:, None, :] + b_cum
    h_final = h[:, 0] if reverse else h[:, -1]
    return h, h_final


def axial_rope(v, row, col):
    half = MLA_ROPE // 2
    inv = ROPE_BASE ** (-jnp.arange(0, half, 2, dtype=jnp.float32) / half)

    def rot(z, pos):
        ang = pos[:, None] * inv[None, :]
        cos = jnp.cos(ang)[None, :, None, :]
        sin = jnp.sin(ang)[None, :, None, :]
        z1, z2 = jnp.split(z, 2, axis=-1)
        return jnp.concatenate([z1 * cos - z2 * sin, z1 * sin + z2 * cos], axis=-1)

    vf = v.astype(jnp.float32)
    out = jnp.concatenate([rot(vf[..., :half], row), rot(vf[..., half:], col)], axis=-1)
    return out.astype(v.dtype)


def mla_queries(cq, q_norm_g, w_uq, row, col):
    bsz, m, _ = cq.shape
    q = (rms_norm(cq, q_norm_g) @ w_uq).reshape(bsz, m, MLA_HEADS, MLA_NOPE + MLA_ROPE)
    if row is None:
        return q
    return jnp.concatenate([q[..., :MLA_NOPE], axial_rope(q[..., MLA_NOPE:], row, col)], axis=-1)


def mla_keys_values(ckv, krope, kv_norm_g, w_ukv, row, col):
    bsz, m, _ = ckv.shape
    kv = (rms_norm(ckv, kv_norm_g) @ w_ukv).reshape(bsz, m, MLA_HEADS, MLA_NOPE + MLA_V)
    k_nope, v = kv[..., :MLA_NOPE], kv[..., MLA_NOPE:]
    kr = krope[:, :, None, :]
    if row is not None:
        kr = axial_rope(kr, row, col)
    k = jnp.concatenate([k_nope, jnp.broadcast_to(kr, (bsz, m, MLA_HEADS, MLA_ROPE))], axis=-1)
    return k, v


def attend(q, k, v):
    s = jnp.einsum('bqhd,bkhd->bhqk', q, k, preferred_element_type=jnp.float32) * ATTN_SCALE
    p = jax.nn.softmax(s, axis=-1)
    return jnp.einsum('bhqk,bkhd->bqhd', p.astype(v.dtype), v)


def attend_query_blocks(q, k, v):
    bsz, n, h, dq = q.shape
    nb = n // Q_BLOCK
    qb = q.reshape(bsz, nb, Q_BLOCK, h, dq).transpose(1, 0, 2, 3, 4)
    o = lax.map(lambda qi: attend(qi, k, v), qb)
    return o.transpose(1, 0, 2, 3, 4).reshape(bsz, n, h * v.shape[-1])


def short_conv_mix(xin, gb, gc, w, b):
    return gb * depthwise_conv(gc * xin, w, b, SC_CONV // 2)


def mix_layer(p_ctx, p_lat, row, col, with_ctx_out, lru_conv_w, lru_conv_b, lru_w_a, lru_b_a, lru_w_i, lru_b_i,
              lru_lambda, mla_q_norm_g, mla_w_uq, mla_kv_norm_g, mla_w_ukv, sc_conv_w, sc_conv_b):
    fc, lxc, lgc, cqc, ckvc, krc, sxc, sbc, scc = split_projection(p_ctx)
    fl, lxl, lgl, cql, ckvl, krl, sxl, sbl, scl = split_projection(p_lat)
    bsz = p_lat.shape[0]

    a_lat = fourier_mix(fl)

    rec_ctx_dirs = []
    rec_lat_dirs = []
    for d, rev in enumerate((False, True)):
        prm = (lru_conv_w[d], lru_conv_b[d], lru_w_a[d], lru_b_a[d], lru_w_i[d], lru_b_i[d], lru_lambda[d])
        h0 = jnp.zeros((bsz, GROUP_W), jnp.float32)
        h_c, s_c = rglru_direction(lxc, h0, *prm, reverse=rev)
        h_l, _ = rglru_direction(lxl, s_c, *prm, reverse=rev)
        rec_ctx_dirs.append(h_c)
        rec_lat_dirs.append(h_l)
    b_lat = jax.nn.gelu(lgl) * (rec_lat_dirs[0] + rec_lat_dirs[1]).astype(lgl.dtype)

    k_ctx, v_ctx = mla_keys_values(ckvc, krc, mla_kv_norm_g, mla_w_ukv, None, None)
    k_lat, v_lat = mla_keys_values(ckvl, krl, mla_kv_norm_g, mla_w_ukv, row, col)
    q_lat = mla_queries(cql, mla_q_norm_g, mla_w_uq, row, col)
    k_all = jnp.concatenate([k_ctx, k_lat], axis=1)
    v_all = jnp.concatenate([v_ctx, v_lat], axis=1)
    c_lat = attend_query_blocks(q_lat, k_all, v_all)

    d_lat = short_conv_mix(sxl, sbl, scl, sc_conv_w, sc_conv_b)

    mix_lat = jnp.concatenate([a_lat, b_lat, c_lat, d_lat], axis=-1)
    if not with_ctx_out:
        return None, mix_lat

    a_ctx = fourier_mix(fc)
    b_ctx = jax.nn.gelu(lgc) * (rec_ctx_dirs[0] + rec_ctx_dirs[1]).astype(lgc.dtype)
    q_ctx = mla_queries(cqc, mla_q_norm_g, mla_w_uq, None, None)
    c_ctx_out = attend(q_ctx, k_ctx, v_ctx).reshape(bsz, q_ctx.shape[1], MLA_HEADS * MLA_V)
    d_ctx = short_conv_mix(sxc, sbc, scc, sc_conv_w, sc_conv_b)
    mix_ctx = jnp.concatenate([a_ctx, b_ctx, c_ctx_out, d_ctx], axis=-1)
    return mix_ctx, mix_lat


def moe_ffn(h, router_w, router_b, w_gu, b_gu, w_down, b_down):
    shp = h.shape
    t = h.reshape(-1, D_MODEL)
    n_tok = t.shape[0]
    n_asg = n_tok * TOP_K
    logits = jnp.dot(t, router_w, preferred_element_type=jnp.float32) + router_b.astype(jnp.float32)
    top_val, top_idx = lax.top_k(logits, TOP_K)
    gates = jax.nn.softmax(top_val, axis=-1).astype(h.dtype)
    flat_e = top_idx.reshape(-1)
    flat_tok = jnp.arange(n_asg, dtype=jnp.int32) // TOP_K
    order = jnp.argsort(flat_e)
    e_sorted = flat_e[order]
    counts = jnp.bincount(flat_e, length=N_EXPERTS)
    padded = (counts + MOE_BLOCK - 1) // MOE_BLOCK * MOE_BLOCK
    pad_end = jnp.cumsum(padded)
    pad_start = pad_end - padded
    grp_start = jnp.cumsum(counts) - counts
    slot = pad_start[e_sorted] + jnp.arange(n_asg, dtype=jnp.int32) - grp_start[e_sorted]
    n_blocks = (n_asg + N_EXPERTS * (MOE_BLOCK - 1) + MOE_BLOCK - 1) // MOE_BLOCK
    n_slots = n_blocks * MOE_BLOCK
    slot_tok = jnp.full((n_slots,), n_tok, jnp.int32).at[slot].set(flat_tok[order])
    slot_gate = jnp.zeros((n_slots,), h.dtype).at[slot].set(gates.reshape(-1)[order])
    block_exp = jnp.minimum(jnp.searchsorted(pad_end, jnp.arange(n_blocks, dtype=jnp.int32) * MOE_BLOCK, side='right'), N_EXPERTS - 1)
    t_pad = jnp.concatenate([t, jnp.zeros((1, D_MODEL), t.dtype)], axis=0)

    def expert_block(args):
        tok, e = args
        xb = t_pad[tok]
        gu = xb @ w_gu[e] + b_gu[e]
        g = jnp.minimum(gu[:, :D_EXPERT], SWIGLU_LIMIT)
        u = jnp.clip(gu[:, D_EXPERT:], -SWIGLU_LIMIT, SWIGLU_LIMIT)
        act = (u + 1) * (g * jax.nn.sigmoid(SWIGLU_ALPHA * g))
        return act @ w_down[e] + b_down[e]

    y = lax.map(expert_block, (slot_tok.reshape(n_blocks, MOE_BLOCK), block_exp))
    y = y.reshape(n_slots, D_MODEL) * slot_gate[:, None]
    out = jnp.zeros((n_tok + 1, D_MODEL), h.dtype).at[slot_tok].add(y)[:n_tok]
    return out.reshape(shp)


def setup_inputs(seed: int = 0) -> dict:
    key = jax.random.key(seed)
    ks = iter(jax.random.split(key, 40))
    f32 = jnp.float32
    L = DEPTH

    def nrm(shape, scale):
        return jax.random.normal(next(ks), shape, f32) * scale

    def gain(shape):
        return 1.0 + nrm(shape, 0.05)

    x = nrm((BATCH, SEQ, D_MODEL), 1.0)
    c = nrm((BATCH, D_MODEL), 1.0)
    ctx = nrm((BATCH, CTX_LEN, D_MODEL), 1.0)
    c_ctx = nrm((D_MODEL,), 1.0)
    mod_w = nrm((L, D_MODEL, 6 * D_MODEL), D_MODEL ** -0.5)
    mod_b = nrm((L, 6 * D_MODEL), 0.02)
    norm1_g = gain((L, D_MODEL))
    norm2_g = gain((L, D_MODEL))
    w_in = nrm((L, D_MODEL, P_TOTAL), D_MODEL ** -0.5)
    lru_conv_w = nrm((L, 2, LRU_CONV, GROUP_W), LRU_CONV ** -0.5)
    lru_conv_b = nrm((L, 2, GROUP_W), 0.02)
    lru_w_a = nrm((L, 2, LRU_HEADS, LRU_HEAD_DIM, LRU_HEAD_DIM), LRU_HEAD_DIM ** -0.5)
    lru_b_a = nrm((L, 2, GROUP_W), 0.1)
    lru_w_i = nrm((L, 2, LRU_HEADS, LRU_HEAD_DIM, LRU_HEAD_DIM), LRU_HEAD_DIM ** -0.5)
    lru_b_i = nrm((L, 2, GROUP_W), 0.1)
    a_c = jax.random.uniform(next(ks), (L, 2, GROUP_W), f32, 0.9, 0.999)
    a0 = a_c ** (1.0 / LRU_C)
    lru_lambda = jnp.log(a0) - jnp.log1p(-a0)
    mla_q_norm_g = gain((L, MLA_Q_LORA))
    mla_w_uq = nrm((L, MLA_Q_LORA, MLA_HEADS * (MLA_NOPE + MLA_ROPE)), MLA_Q_LORA ** -0.5)
    mla_kv_norm_g = gain((L, MLA_KV_LORA))
    mla_w_ukv = nrm((L, MLA_KV_LORA, MLA_HEADS * (MLA_NOPE + MLA_V)), MLA_KV_LORA ** -0.5)
    sc_conv_w = nrm((L, SC_CONV, GROUP_W), SC_CONV ** -0.5)
    sc_conv_b = nrm((L, GROUP_W), 0.02)
    w_out = nrm((L, D_MODEL, D_MODEL), D_MODEL ** -0.5)
    router_w = nrm((L, D_MODEL, N_EXPERTS), D_MODEL ** -0.5)
    router_b = nrm((L, N_EXPERTS), 0.01)
    exp_w_gu = nrm((L, N_EXPERTS, D_MODEL, 2 * D_EXPERT), D_MODEL ** -0.5)
    exp_b_gu = nrm((L, N_EXPERTS, 2 * D_EXPERT), 0.01)
    exp_w_down = nrm((L, N_EXPERTS, D_EXPERT, D_MODEL), D_EXPERT ** -0.5)
    exp_b_down = nrm((L, N_EXPERTS, D_MODEL), 0.01)
    final_g = gain((D_MODEL,))
    return {'x': x, 'c': c, 'ctx': ctx, 'c_ctx': c_ctx, 'mod_w': mod_w, 'mod_b': mod_b,
            'norm1_g': norm1_g, 'norm2_g': norm2_g, 'w_in': w_in,
            'lru_conv_w': lru_conv_w, 'lru_conv_b': lru_conv_b, 'lru_w_a': lru_w_a, 'lru_b_a': lru_b_a,
            'lru_w_i': lru_w_i, 'lru_b_i': lru_b_i, 'lru_lambda': lru_lambda,
            'mla_q_norm_g': mla_q_norm_g, 'mla_w_uq': mla_w_uq, 'mla_kv_norm_g': mla_kv_norm_g,
            'mla_w_ukv': mla_w_ukv, 'sc_conv_w': sc_conv_w, 'sc_conv_b': sc_conv_b, 'w_out': w_out,
            'router_w': router_w, 'router_b': router_b, 'exp_w_gu': exp_w_gu, 'exp_b_gu': exp_b_gu,
            'exp_w_down': exp_w_down, 'exp_b_down': exp_b_down, 'final_g': final_g}


def reference(x, c, ctx, c_ctx, mod_w, mod_b, norm1_g, norm2_g, w_in, lru_conv_w, lru_conv_b, lru_w_a, lru_b_a,
              lru_w_i, lru_b_i, lru_lambda, mla_q_norm_g, mla_w_uq, mla_kv_norm_g, mla_w_ukv, sc_conv_w, sc_conv_b,
              w_out, router_w, router_b, exp_w_gu, exp_b_gu, exp_w_down, exp_b_down, final_g):
    n = x.shape[1]
    grid_rows = n // GRID_W
    row = jnp.broadcast_to(jnp.arange(grid_rows, dtype=jnp.float32)[:, None], (grid_rows, GRID_W)).reshape(-1)
    col = jnp.broadcast_to(jnp.arange(GRID_W, dtype=jnp.float32)[None, :], (grid_rows, GRID_W)).reshape(-1)
    n_ctx = ctx.shape[1]

    h_lat = x
    h_ctx = ctx
    for l in range(DEPTH):
        with_ctx_out = l < DEPTH - 1
        mod_lat = (jax.nn.silu(c) @ mod_w[l] + mod_b[l])[:, None, :]
        mod_ctx = (jax.nn.silu(c_ctx) @ mod_w[l] + mod_b[l])[None, None, :]
        sh1_l, sc1_l, g1_l, sh2_l, sc2_l, g2_l = jnp.split(mod_lat, 6, axis=-1)
        sh1_c, sc1_c, g1_c, sh2_c, sc2_c, g2_c = jnp.split(mod_ctx, 6, axis=-1)

        a_lat = modulate(rms_norm(h_lat, norm1_g[l]), sh1_l, sc1_l)
        a_ctx = modulate(rms_norm(h_ctx, norm1_g[l]), sh1_c, sc1_c)
        p_lat = a_lat @ w_in[l]
        p_ctx = a_ctx @ w_in[l]
        mix_ctx, mix_lat = mix_layer(p_ctx, p_lat, row, col, with_ctx_out,
                                     lru_conv_w[l], lru_conv_b[l], lru_w_a[l], lru_b_a[l], lru_w_i[l], lru_b_i[l],
                                     lru_lambda[l], mla_q_norm_g[l], mla_w_uq[l], mla_kv_norm_g[l], mla_w_ukv[l],
                                     sc_conv_w[l], sc_conv_b[l])
        h_lat = h_lat + g1_l * (mix_lat @ w_out[l])

        f_lat = modulate(rms_norm(h_lat, norm2_g[l]), sh2_l, sc2_l)
        moe_args = (router_w[l], router_b[l], exp_w_gu[l], exp_b_gu[l], exp_w_down[l], exp_b_down[l])
        if with_ctx_out:
            h_ctx = h_ctx + g1_c * (mix_ctx @ w_out[l])
            f_ctx = modulate(rms_norm(h_ctx, norm2_g[l]), sh2_c, sc2_c)
            y_all = moe_ffn(jnp.concatenate([f_ctx, f_lat], axis=1), *moe_args)
            h_ctx = h_ctx + g2_c * y_all[:, :n_ctx]
            h_lat = h_lat + g2_l * y_all[:, n_ctx:]
        else:
            h_lat = h_lat + g2_l * moe_ffn(f_lat, *moe_args)

    return rms_norm(h_lat, final_g)
```

```cpp
#include <hip/hip_runtime.h>
#include <cstdint>
#include <cstdio>

typedef unsigned short bf16_t;
constexpr int NB_ = 4, SEQ = 4096, CTX = 256, D = 1024, NPOS = SEQ + CTX, MROWS = NB_ * NPOS;
constexpr int PT = 1952, PP = 2048;
constexpr int NE = 32, TOPK = 4, LCAP = MROWS;
constexpr int NASG = MROWS * TOPK;
constexpr int ACT_ROWS = NASG + NE * 256;
constexpr int C_FN = 0, C_LX = 256, C_LG = 512, C_CQ = 768, C_CKV = 1024, C_KR = 1152, C_SX = 1184, C_SB = 1440, C_SC = 1696;

__device__ __forceinline__ float bf2f(bf16_t v) { return __uint_as_float((unsigned)v << 16); }
__device__ __forceinline__ bf16_t f2bf(float f) { unsigned u = __float_as_uint(f); return (bf16_t)((u + 0x7fffu + ((u >> 16) & 1u)) >> 16); }
__device__ __forceinline__ float wave_sum(float v) {
#pragma unroll
    for (int o = 1; o < 64; o <<= 1) v += __shfl_xor(v, o);
    return v;
}
__device__ __forceinline__ float sigmoidf_(float x) { return 1.f / (1.f + __expf(-x)); }
__device__ __forceinline__ float gelu_tanh(float x) { const float u = 0.7978845608028654f * (x + 0.044715f * x * x * x); return 0.5f * x * (1.f + tanhf(u)); }

struct WS {
    float* H; float* MOD; float* TABC; float* TABS; bf16_t* XN; bf16_t* P; bf16_t* MIX; bf16_t* CQN; bf16_t* CKVN; float* QRAW; float* KVRAW;
    bf16_t* QL; bf16_t* QC; bf16_t* KB; bf16_t* VB; float* LA; float* LB; float* HS; float* XCS; float* XCSC;
    int* CNT; int* OFFS; int* LIST; float* GATE; bf16_t* ACT; bf16_t* Y;
};

__global__ void k_init(const float* x, const float* ctx, float* H, float* TABC, float* TABS) {
    const size_t n4 = (size_t)MROWS * D / 4;
    for (size_t i = (size_t)blockIdx.x * blockDim.x + threadIdx.x; i < n4; i += (size_t)gridDim.x * blockDim.x) {
        const size_t e = i * 4; const int r = (int)(e / D), c = (int)(e % D); const int b = r / NPOS, pos = r % NPOS;
        const float4 v = pos < CTX ? *(const float4*)(ctx + ((size_t)b * CTX + pos) * D + c) : *(const float4*)(x + ((size_t)b * SEQ + (pos - CTX)) * D + c);
        *(float4*)(H + e) = v;
    }
    const int t = blockIdx.x * blockDim.x + threadIdx.x;
    if (t < 4096) { float s, c; sincospif((float)t / 2048.f, &s, &c); TABC[t] = c; TABS[t] = s; }
}

__global__ __launch_bounds__(256) void k_mod(const float* c, const float* c_ctx, const float* mod_w, const float* mod_b, float* MOD) {
    __shared__ float s[5][1024];
    for (int i = threadIdx.x; i < 5 * 1024; i += 256) { const int v = i >> 10, k = i & 1023; const float x = v < 4 ? c[v * 1024 + k] : c_ctx[k]; s[v][k] = x / (1.f + __expf(-x)); }
    __syncthreads();
    const int idx = blockIdx.x * 256 + threadIdx.x; const int l = idx / 6144, col = idx % 6144;
    const float* W = mod_w + (size_t)l * 1024 * 6144 + col;
    float a0 = 0, a1 = 0, a2 = 0, a3 = 0, a4 = 0;
#pragma unroll 8
    for (int k = 0; k < 1024; ++k) { const float w = W[(size_t)k * 6144]; a0 += s[0][k] * w; a1 += s[1][k] * w; a2 += s[2][k] * w; a3 += s[3][k] * w; a4 += s[4][k] * w; }
    const float bb = mod_b[l * 6144 + col];
    float* M = MOD + (size_t)l * 5 * 6144 + col;
    M[0] = a0 + bb; M[6144] = a1 + bb; M[2 * 6144] = a2 + bb; M[3 * 6144] = a3 + bb; M[4 * 6144] = a4 + bb;
}

__global__ __launch_bounds__(256) void k_norm_mod(const float* H, const float* g, const float* MODl, int sh_off, int sc_off, bf16_t* XN) {
    const int lane = threadIdx.x & 63, r = blockIdx.x * 4 + (threadIdx.x >> 6);
    const int b = r / NPOS, pos = r % NPOS, v = pos < CTX ? 4 : b;
    const float* mv = MODl + (size_t)v * 6144;
    float4 x[4]; float ss = 0.f;
#pragma unroll
    for (int j = 0; j < 4; ++j) { x[j] = *(const float4*)(H + (size_t)r * D + (j * 64 + lane) * 4); ss += x[j].x * x[j].x + x[j].y * x[j].y + x[j].z * x[j].z + x[j].w * x[j].w; }
    const float rs = rsqrtf(wave_sum(ss) * (1.f / D) + 1e-6f);
#pragma unroll
    for (int j = 0; j < 4; ++j) { const int c = (j * 64 + lane) * 4; const float4 gg = *(const float4*)(g + c), sh = *(const float4*)(mv + sh_off + c), sc = *(const float4*)(mv + sc_off + c);
        ushort4 o; o.x = f2bf(x[j].x * rs * gg.x * (1.f + sc.x) + sh.x); o.y = f2bf(x[j].y * rs * gg.y * (1.f + sc.y) + sh.y); o.z = f2bf(x[j].z * rs * gg.z * (1.f + sc.z) + sh.z); o.w = f2bf(x[j].w * rs * gg.w * (1.f + sc.w) + sh.w);
        *(ushort4*)(XN + (size_t)r * D + c) = o; }
}

template <class AL, class EP, int NBK>
__global__ __launch_bounds__(256) void k_gemm(AL alp, const float* W, int ldw, long wz, int N, int K, int colB2, EP epp) {
    __shared__ float As[16][68];
    __shared__ float Bs[NBK][16][68];
    AL al = alp; EP ep = epp;
    const int tx = threadIdx.x & 15, ty = threadIdx.x >> 4, m0 = blockIdx.y * 64, n0 = blockIdx.x * 64, z = blockIdx.z;
    if (!al.init(m0, z)) return;
    ep.init(m0, z);
    const float* Wz = W + al.woff() + (size_t)z * wz;
    float acc[NBK][4][4];
#pragma unroll
    for (int nb = 0; nb < NBK; ++nb)
#pragma unroll
        for (int i = 0; i < 4; ++i)
#pragma unroll
            for (int j = 0; j < 4; ++j) acc[nb][i][j] = 0.f;
    const int am = threadIdx.x >> 2, ak = (threadIdx.x & 3) * 4, bk = threadIdx.x >> 4, bn = (threadIdx.x & 15) * 4;
    for (int k0 = 0; k0 < K; k0 += 16) {
        { float v[4]; al.load4(z, m0 + am, k0 + ak, v); As[ak + 0][am] = v[0]; As[ak + 1][am] = v[1]; As[ak + 2][am] = v[2]; As[ak + 3][am] = v[3]; }
#pragma unroll
        for (int nb = 0; nb < NBK; ++nb) { const int col = n0 + bn; float4 w = make_float4(0.f, 0.f, 0.f, 0.f);
            if (col + 3 < N) w = *(const float4*)(Wz + (size_t)(k0 + bk) * ldw + col + nb * colB2);
            *(float4*)&Bs[nb][bk][bn] = w; }
        __syncthreads();
#pragma unroll
        for (int kk = 0; kk < 16; ++kk) {
            const float4 a = *(const float4*)&As[kk][ty * 4];
#pragma unroll
            for (int nb = 0; nb < NBK; ++nb) { const float4 b = *(const float4*)&Bs[nb][kk][tx * 4];
                acc[nb][0][0] += a.x * b.x; acc[nb][0][1] += a.x * b.y; acc[nb][0][2] += a.x * b.z; acc[nb][0][3] += a.x * b.w;
                acc[nb][1][0] += a.y * b.x; acc[nb][1][1] += a.y * b.y; acc[nb][1][2] += a.y * b.z; acc[nb][1][3] += a.y * b.w;
                acc[nb][2][0] += a.z * b.x; acc[nb][2][1] += a.z * b.y; acc[nb][2][2] += a.z * b.z; acc[nb][2][3] += a.z * b.w;
                acc[nb][3][0] += a.w * b.x; acc[nb][3][1] += a.w * b.y; acc[nb][3][2] += a.w * b.z; acc[nb][3][3] += a.w * b.w; }
        }
        __syncthreads();
    }
#pragma unroll
    for (int i = 0; i < 4; ++i)
#pragma unroll
        for (int j = 0; j < 4; ++j) { const int col = n0 + tx * 4 + j; if (col < N) ep.store(z, m0 + ty * 4 + i, col, acc[0][i][j], acc[NBK - 1][i][j]); }
}

struct ALBf16 { const bf16_t* A; int lda, pad;
    __device__ bool init(int, int) { return true; } __device__ size_t woff() const { return 0; }
    __device__ void load4(int, int row, int k, float* v) const { const ushort4 w = *(const ushort4*)(A + (size_t)row * lda + k); v[0] = bf2f(w.x); v[1] = bf2f(w.y); v[2] = bf2f(w.z); v[3] = bf2f(w.w); } };
struct ALDft { const float* TC; const float* TS; int n, ts;
    __device__ bool init(int, int) { return true; } __device__ size_t woff() const { return 0; }
    __device__ void load4(int, int row, int k, float* v) const {
#pragma unroll
        for (int j = 0; j < 4; ++j) { const int t = k + j; if (t < n) v[j] = TC[((row * t) & (n - 1)) * ts]; else v[j] = -TS[((row * (t - n)) & (n - 1)) * ts]; } } };
struct ALMoe1 { const bf16_t* XN; const int* offs; const int* cnt; const int* list; int e, base, n, pad;
    __device__ bool init(int m0, int) { if (m0 >= offs[NE]) return false; int ee = 0; for (int i = 1; i < NE; ++i) if (m0 >= offs[i]) ee = i; e = ee; base = offs[ee]; n = cnt[ee]; return true; }
    __device__ size_t woff() const { return (size_t)e * 1024 * 2048; }
    __device__ void load4(int, int row, int k, float* v) const { const int i = row - base; const int tok = i < n ? (list[(size_t)e * LCAP + i] >> 2) : 0;
        const ushort4 w = *(const ushort4*)(XN + (size_t)tok * D + k); v[0] = bf2f(w.x); v[1] = bf2f(w.y); v[2] = bf2f(w.z); v[3] = bf2f(w.w); } };
struct ALMoe2 { const bf16_t* ACT; const int* offs; int e, pad;
    __device__ bool init(int m0, int) { if (m0 >= offs[NE]) return false; int ee = 0; for (int i = 1; i < NE; ++i) if (m0 >= offs[i]) ee = i; e = ee; return true; }
    __device__ size_t woff() const { return (size_t)e * 1024 * 1024; }
    __device__ void load4(int, int row, int k, float* v) const { const ushort4 w = *(const ushort4*)(ACT + (size_t)row * D + k); v[0] = bf2f(w.x); v[1] = bf2f(w.y); v[2] = bf2f(w.z); v[3] = bf2f(w.w); } };

struct EPBf16 { bf16_t* C; int ldc, pad; __device__ void init(int, int) {} __device__ void store(int, int r, int c, float a, float) const { C[(size_t)r * ldc + c] = f2bf(a); } };
struct EPF32 { float* C; int ldc, pad; __device__ void init(int, int) {} __device__ void store(int, int r, int c, float a, float) const { C[(size_t)r * ldc + c] = a; } };
struct EPDft { bf16_t* MIX; int rowoff; float scale; __device__ void init(int, int) {} __device__ void store(int z, int r, int c, float a, float) const { MIX[((size_t)z * NPOS + rowoff + r) * D + c] = f2bf(a * scale); } };
struct EPRes { float* H; const float* MODl; int g_off, pad; __device__ void init(int, int) {}
    __device__ void store(int, int r, int c, float a, float) const { const int b = r / NPOS, pos = r % NPOS, v = pos < CTX ? 4 : b; H[(size_t)r * D + c] += MODl[(size_t)v * 6144 + g_off + c] * a; } };
struct EPMoe1 { bf16_t* ACT; const float* bgu; const int* offs; const int* cnt; int e, base, n, pad;
    __device__ void init(int m0, int) { int ee = 0; for (int i = 1; i < NE; ++i) if (m0 >= offs[i]) ee = i; e = ee; base = offs[ee]; n = cnt[ee]; }
    __device__ void store(int, int r, int c, float ag, float au) const {
        float o = 0.f; if (r - base < n) { const float g = fminf(ag + bgu[(size_t)e * 2048 + c], 7.f); const float u = fminf(fmaxf(au + bgu[(size_t)e * 2048 + 1024 + c], -7.f), 7.f); o = (u + 1.f) * g * sigmoidf_(1.702f * g); }
        ACT[(size_t)r * D + c] = f2bf(o); } };
struct EPMoe2 { bf16_t* Y; const float* bd; const float* GATE; const int* offs; const int* cnt; const int* list; int e, base, n, pad;
    __device__ void init(int m0, int) { int ee = 0; for (int i = 1; i < NE; ++i) if (m0 >= offs[i]) ee = i; e = ee; base = offs[ee]; n = cnt[ee]; }
    __device__ void store(int, int r, int c, float a, float) const { const int i = r - base; if (i < n) { const int asg = list[(size_t)e * LCAP + i]; Y[(size_t)asg * D + c] = f2bf(GATE[asg] * (a + bd[(size_t)e * 1024 + c])); } } };

__global__ __launch_bounds__(256) void k_four_ch(const bf16_t* P, const float* TC, const float* TS, float* XCS, float* XCSC, int with_ctx) {
    __shared__ float u[256];
    const int r = blockIdx.x, b = r / NPOS, pos = r % NPOS;
    if (pos < CTX && !with_ctx) return;
    u[threadIdx.x] = bf2f(P[(size_t)r * PP + C_FN + threadIdx.x]);
    __syncthreads();
    const int g = threadIdx.x >> 6, k = threadIdx.x & 63; float ac = 0.f, as = 0.f;
#pragma unroll 8
    for (int c = 0; c < 64; ++c) { const int i = ((k * c) & 63) * 64; const float x = u[g * 64 + c]; ac += x * TC[i]; as += x * TS[i]; }
    if (pos >= CTX) { const int t = pos - CTX; XCS[((size_t)b * 8192 + t) * 256 + threadIdx.x] = ac; XCS[((size_t)b * 8192 + 4096 + t) * 256 + threadIdx.x] = as; }
    else { XCSC[((size_t)b * 512 + pos) * 256 + threadIdx.x] = ac; XCSC[((size_t)b * 512 + 256 + pos) * 256 + threadIdx.x] = as; }
}

__global__ __launch_bounds__(256) void k_lru_gates(const bf16_t* P, const float* conv_w, const float* conv_b, const float* w_a, const float* b_a, const float* w_i, const float* b_i, const float* lam,
                                                    float* LA, float* LB) {
    __shared__ float xs[16][256];
    const int dir = blockIdx.y, r0 = blockIdx.x * 16, c = threadIdx.x;
    const int b = r0 / NPOS, pos0 = r0 % NPOS; const int lo = pos0 < CTX ? 0 : CTX, hi = pos0 < CTX ? CTX : NPOS;
    const int left = dir ? 1 : 2;
    const float* cw = conv_w + (size_t)dir * 4 * 256; const float cb = conv_b[dir * 256 + c];
    float xc[16];
#pragma unroll
    for (int i = 0; i < 16; ++i) { float a = cb;
#pragma unroll
        for (int k = 0; k < 4; ++k) { const int p = pos0 + i - left + k; if (p >= lo && p < hi) a += cw[k * 256 + c] * bf2f(P[((size_t)b * NPOS + p) * PP + C_LX + c]); }
        xc[i] = a; xs[i][c] = a; }
    __syncthreads();
    const int h = c >> 6, e = c & 63;
    const float* wa = w_a + ((size_t)(dir * 4 + h) * 64) * 64 + e; const float* wi = w_i + ((size_t)(dir * 4 + h) * 64) * 64 + e;
    float ra[16], ri[16];
#pragma unroll
    for (int i = 0; i < 16; ++i) { ra[i] = 0.f; ri[i] = 0.f; }
    for (int d = 0; d < 64; ++d) { const float va = wa[d * 64], vi = wi[d * 64];
#pragma unroll
        for (int i = 0; i < 16; ++i) { const float x = xs[i][h * 64 + d]; ra[i] += x * va; ri[i] += x * vi; } }
    const float ba = b_a[dir * 256 + c], bi = b_i[dir * 256 + c]; const float sp = log1pf(__expf(-lam[dir * 256 + c]));
#pragma unroll
    for (int i = 0; i < 16; ++i) { const float rr = sigmoidf_(ra[i] + ba), ii = sigmoidf_(ri[i] + bi); const float a = __expf(-8.f * rr * sp);
        const float bt = sqrtf(fmaxf(1.f - a * a, 0.f)) * (ii * xc[i]);
        LA[((size_t)dir * MROWS + r0 + i) * 256 + c] = a; LB[((size_t)dir * MROWS + r0 + i) * 256 + c] = bt; }
}
__global__ __launch_bounds__(256) void k_lru_scan(const float* LA, const float* LB, float* HS) {
    const int c = threadIdx.x, b = blockIdx.x, dir = blockIdx.y;
    const float* a = LA + ((size_t)dir * MROWS + (size_t)b * NPOS) * 256 + c; const float* bb = LB + ((size_t)dir * MROWS + (size_t)b * NPOS) * 256 + c;
    float* hs = HS + ((size_t)dir * MROWS + (size_t)b * NPOS) * 256 + c;
    float h = 0.f;
    if (dir == 0) {
#pragma unroll 8
        for (int p = 0; p < NPOS; ++p) { h = a[(size_t)p * 256] * h + bb[(size_t)p * 256]; hs[(size_t)p * 256] = h; }
    } else {
#pragma unroll 8
        for (int p = CTX - 1; p >= 0; --p) { h = a[(size_t)p * 256] * h + bb[(size_t)p * 256]; hs[(size_t)p * 256] = h; }
#pragma unroll 8
        for (int p = NPOS - 1; p >= CTX; --p) { h = a[(size_t)p * 256] * h + bb[(size_t)p * 256]; hs[(size_t)p * 256] = h; }
    }
}
__global__ __launch_bounds__(256) void k_lru_sc_out(const bf16_t* P, const float* HS, const float* scw, const float* scb, bf16_t* MIX) {
    const int r = blockIdx.x, c = threadIdx.x, b = r / NPOS, pos = r % NPOS; const int lo = pos < CTX ? 0 : CTX, hi = pos < CTX ? CTX : NPOS;
    const float lg = bf2f(P[(size_t)r * PP + C_LG + c]);
    MIX[(size_t)r * D + 256 + c] = f2bf(gelu_tanh(lg) * (HS[(size_t)r * 256 + c] + HS[((size_t)MROWS + r) * 256 + c]));
    float a = scb[c];
#pragma unroll
    for (int k = 0; k < 3; ++k) { const int p = pos - 1 + k; if (p >= lo && p < hi) { const size_t rr = (size_t)b * NPOS + p; a += scw[k * 256 + c] * (bf2f(P[rr * PP + C_SC + c]) * bf2f(P[rr * PP + C_SX + c])); } }
    MIX[(size_t)r * D + 768 + c] = f2bf(bf2f(P[(size_t)r * PP + C_SB + c]) * a);
}

__global__ __launch_bounds__(256) void k_lat_norm(const bf16_t* P, const float* qg, const float* kvg, bf16_t* CQN, bf16_t* CKVN) {
    const int lane = threadIdx.x & 63, r = blockIdx.x * 4 + (threadIdx.x >> 6);
    float q[4], ss = 0.f;
#pragma unroll
    for (int j = 0; j < 4; ++j) { q[j] = bf2f(P[(size_t)r * PP + C_CQ + j * 64 + lane]); ss += q[j] * q[j]; }
    const float rq = rsqrtf(wave_sum(ss) * (1.f / 256.f) + 1e-6f);
#pragma unroll
    for (int j = 0; j < 4; ++j) CQN[(size_t)r * 256 + j * 64 + lane] = f2bf(q[j] * rq * qg[j * 64 + lane]);
    float k2[2]; ss = 0.f;
#pragma unroll
    for (int j = 0; j < 2; ++j) { k2[j] = bf2f(P[(size_t)r * PP + C_CKV + j * 64 + lane]); ss += k2[j] * k2[j]; }
    const float rk = rsqrtf(wave_sum(ss) * (1.f / 128.f) + 1e-6f);
#pragma unroll
    for (int j = 0; j < 2; ++j) CKVN[(size_t)r * 128 + j * 64 + lane] = f2bf(k2[j] * rk * kvg[j * 64 + lane]);
}
__device__ __forceinline__ float rope_elem(const float* z  , int i, int row, int col) {
    const int hs = i >> 4, w = i & 15, j = w & 7; const float pos = (float)(hs ? col : row);
    const float inv = __expf(-9.210340371976184f * (float)j * 0.125f); float s, c; sincosf(pos * inv, &s, &c);
    const float z1 = z[hs * 16 + j], z2 = z[hs * 16 + 8 + j];
    return w < 8 ? z1 * c - z2 * s : z1 * s + z2 * c;
}
__global__ __launch_bounds__(256) void k_qkv_finish(const float* QRAW, const float* KVRAW, const bf16_t* P, bf16_t* QL, bf16_t* QC, bf16_t* KB, bf16_t* VB, int with_ctx_q) {
    __shared__ float zq[4][32]; __shared__ float zk[32];
    const int r = blockIdx.x, b = r / NPOS, pos = r % NPOS; const bool lat = pos >= CTX; const int t = pos - CTX, row = t >> 6, col = t & 63;
    if (threadIdx.x < 128) zq[threadIdx.x >> 5][threadIdx.x & 31] = QRAW[(size_t)r * 384 + (threadIdx.x >> 5) * 96 + 64 + (threadIdx.x & 31)];
    else if (threadIdx.x < 160) zk[threadIdx.x - 128] = bf2f(P[(size_t)r * PP + C_KR + threadIdx.x - 128]);
    __syncthreads();
    for (int i = threadIdx.x; i < 384; i += 256) { const int h = i / 96, d = i % 96;
        float q; if (d < 64) q = QRAW[(size_t)r * 384 + i]; else q = lat ? rope_elem(zq[h], d - 64, row, col) : zq[h][d - 64];
        if (lat) QL[((size_t)(b * 4 + h) * SEQ + t) * 96 + d] = f2bf(q); else if (with_ctx_q) QC[((size_t)(b * 4 + h) * CTX + pos) * 96 + d] = f2bf(q);
        float k; if (d < 64) k = KVRAW[(size_t)r * 512 + h * 128 + d]; else k = lat ? rope_elem(zk, d - 64, row, col) : zk[d - 64];
        KB[((size_t)(b * 4 + h) * NPOS + pos) * 96 + d] = f2bf(k); }
    { const int h = threadIdx.x >> 6, d = threadIdx.x & 63; VB[((size_t)(b * 4 + h) * NPOS + pos) * 64 + d] = f2bf(KVRAW[(size_t)r * 512 + h * 128 + 64 + d]); }
}
__global__ __launch_bounds__(256) void k_attn(const bf16_t* Q, int nq, const bf16_t* KB, const bf16_t* VB, int nkeys, bf16_t* MIX, int out_pos_off) {
    __shared__ float Ks[64][96]; __shared__ float Vs[64][64];
    const int bh = blockIdx.y, qi = blockIdx.x * 256 + threadIdx.x, b = bh >> 2, h = bh & 3;
    float q[96], o[64];
    { const bf16_t* qp = Q + ((size_t)bh * nq + qi) * 96;
#pragma unroll
      for (int d = 0; d < 96; ++d) q[d] = bf2f(qp[d]) * 0.10206207261596577f; }
#pragma unroll
    for (int d = 0; d < 64; ++d) o[d] = 0.f;
    float m = -1e30f, l = 0.f;
    for (int k0 = 0; k0 < nkeys; k0 += 64) {
        __syncthreads();
        for (int i = threadIdx.x; i < 64 * 96; i += 256) Ks[i / 96][i % 96] = bf2f(KB[((size_t)bh * NPOS + k0) * 96 + i]);
        for (int i = threadIdx.x; i < 64 * 64; i += 256) Vs[i >> 6][i & 63] = bf2f(VB[((size_t)bh * NPOS + k0) * 64 + i]);
        __syncthreads();
        for (int j = 0; j < 64; ++j) {
            float s = 0.f;
#pragma unroll
            for (int d = 0; d < 96; d += 4) { const float4 kk = *(const float4*)&Ks[j][d]; s += q[d] * kk.x + q[d + 1] * kk.y + q[d + 2] * kk.z + q[d + 3] * kk.w; }
            const float mn = fmaxf(m, s), corr = __expf(m - mn), p = __expf(s - mn); m = mn; l = l * corr + p;
#pragma unroll
            for (int d = 0; d < 64; d += 4) { const float4 vv = *(const float4*)&Vs[j][d]; o[d] = o[d] * corr + p * vv.x; o[d + 1] = o[d + 1] * corr + p * vv.y; o[d + 2] = o[d + 2] * corr + p * vv.z; o[d + 3] = o[d + 3] * corr + p * vv.w; }
        }
    }
    const float il = 1.f / l; bf16_t* op = MIX + ((size_t)b * NPOS + out_pos_off + qi) * D + 512 + h * 64;
#pragma unroll
    for (int d = 0; d < 64; ++d) op[d] = f2bf(o[d] * il);
}

__global__ __launch_bounds__(256) void k_norm2_route(const float* H, const float* g, const float* MODl, const float* rw, const float* rb, bf16_t* XN, int* CNT, int* LIST, float* GATE, int skip_ctx) {
    __shared__ float fs[4][1024]; __shared__ float lg[4][32];
    const int w = threadIdx.x >> 6, lane = threadIdx.x & 63, r = blockIdx.x * 4 + w;
    const int b = r / NPOS, pos = r % NPOS, v = pos < CTX ? 4 : b; const bool act = !(skip_ctx && pos < CTX);
    const float* mv = MODl + (size_t)v * 6144;
    float4 x[4]; float ss = 0.f;
#pragma unroll
    for (int j = 0; j < 4; ++j) { x[j] = *(const float4*)(H + (size_t)r * D + (j * 64 + lane) * 4); ss += x[j].x * x[j].x + x[j].y * x[j].y + x[j].z * x[j].z + x[j].w * x[j].w; }
    const float rs = rsqrtf(wave_sum(ss) * (1.f / D) + 1e-6f);
#pragma unroll
    for (int j = 0; j < 4; ++j) { const int c = (j * 64 + lane) * 4; const float4 gg = *(const float4*)(g + c), sh = *(const float4*)(mv + 3072 + c), sc = *(const float4*)(mv + 4096 + c);
        float4 f; f.x = x[j].x * rs * gg.x * (1.f + sc.x) + sh.x; f.y = x[j].y * rs * gg.y * (1.f + sc.y) + sh.y; f.z = x[j].z * rs * gg.z * (1.f + sc.z) + sh.z; f.w = x[j].w * rs * gg.w * (1.f + sc.w) + sh.w;
        *(float4*)&fs[w][c] = f; ushort4 o; o.x = f2bf(f.x); o.y = f2bf(f.y); o.z = f2bf(f.z); o.w = f2bf(f.w); *(ushort4*)(XN + (size_t)r * D + c) = o; }
    __syncthreads();
    { const int e = lane & 31, half = lane >> 5; float a = 0.f;
#pragma unroll 8
      for (int k = half * 512; k < half * 512 + 512; ++k) a += fs[w][k] * rw[k * 32 + e];
      a += __shfl_xor(a, 32); if (lane < 32) lg[w][e] = a + rb[e]; }
    __syncthreads();
    if (lane == 0 && act) {
        float vals[4]; int idx[4]; unsigned used = 0u;
#pragma unroll
        for (int k = 0; k < 4; ++k) { float best = -3e38f; int bi = 0; for (int e = 0; e < 32; ++e) { const float xx = lg[w][e]; if (!((used >> e) & 1u) && xx > best) { best = xx; bi = e; } } used |= 1u << bi; vals[k] = best; idx[k] = bi; }
        float ex[4], sum = 0.f;
#pragma unroll
        for (int k = 0; k < 4; ++k) { ex[k] = __expf(vals[k] - vals[0]); sum += ex[k]; }
#pragma unroll
        for (int k = 0; k < 4; ++k) { const int asg = r * 4 + k; GATE[asg] = ex[k] / sum; const int p = atomicAdd(&CNT[idx[k]], 1); LIST[(size_t)idx[k] * LCAP + p] = asg; }
    }
}
__global__ void k_moe_offsets(const int* CNT, int* OFFS) { if (threadIdx.x == 0 && blockIdx.x == 0) { int o = 0; for (int e = 0; e < NE; ++e) { OFFS[e] = o; o += (CNT[e] + 255) / 256 * 256; } OFFS[NE] = o; } }
__global__ __launch_bounds__(256) void k_moe_combine(float* H, const bf16_t* Y, const float* MODl, int skip_ctx, const float* final_g, float* out) {
    const int lane = threadIdx.x & 63, r = blockIdx.x * 4 + (threadIdx.x >> 6); const int b = r / NPOS, pos = r % NPOS, v = pos < CTX ? 4 : b;
    if (skip_ctx && pos < CTX) return;
    const float* g2 = MODl + (size_t)v * 6144 + 5120;
    float4 x[4]; float ss = 0.f;
#pragma unroll
    for (int j = 0; j < 4; ++j) { const int c = (j * 64 + lane) * 4; x[j] = *(const float4*)(H + (size_t)r * D + c); float4 s = make_float4(0.f, 0.f, 0.f, 0.f);
#pragma unroll
        for (int k = 0; k < 4; ++k) { const ushort4 y = *(const ushort4*)(Y + ((size_t)r * 4 + k) * D + c); s.x += bf2f(y.x); s.y += bf2f(y.y); s.z += bf2f(y.z); s.w += bf2f(y.w); }
        const float4 gg = *(const float4*)(g2 + c); x[j].x += gg.x * s.x; x[j].y += gg.y * s.y; x[j].z += gg.z * s.z; x[j].w += gg.w * s.w;
        *(float4*)(H + (size_t)r * D + c) = x[j]; ss += x[j].x * x[j].x + x[j].y * x[j].y + x[j].z * x[j].z + x[j].w * x[j].w; }
    if (out) { const float rs = rsqrtf(wave_sum(ss) * (1.f / D) + 1e-6f); float* op = out + ((size_t)b * SEQ + (pos - CTX)) * D;
#pragma unroll
        for (int j = 0; j < 4; ++j) { const int c = (j * 64 + lane) * 4; const float4 fg = *(const float4*)(final_g + c); float4 o; o.x = x[j].x * rs * fg.x; o.y = x[j].y * rs * fg.y; o.z = x[j].z * rs * fg.z; o.w = x[j].w * rs * fg.w; *(float4*)(op + c) = o; } }
}

static inline size_t al256(size_t x) { return (x + 255) & ~(size_t)255; }
extern "C" void kernel_launch(void* const* d_in, const int* in_sizes, int n_in, void* d_out, int out_size, void* d_ws, size_t ws_size, hipStream_t stream) {
    const float* x = (const float*)d_in[0]; const float* c = (const float*)d_in[1]; const float* ctx = (const float*)d_in[2]; const float* c_ctx = (const float*)d_in[3];
    const float* mod_w = (const float*)d_in[4]; const float* mod_b = (const float*)d_in[5]; const float* norm1_g = (const float*)d_in[6]; const float* norm2_g = (const float*)d_in[7];
    const float* w_in = (const float*)d_in[8]; const float* lru_conv_w = (const float*)d_in[9]; const float* lru_conv_b = (const float*)d_in[10]; const float* lru_w_a = (const float*)d_in[11];
    const float* lru_b_a = (const float*)d_in[12]; const float* lru_w_i = (const float*)d_in[13]; const float* lru_b_i = (const float*)d_in[14]; const float* lru_lambda = (const float*)d_in[15];
    const float* q_norm_g = (const float*)d_in[16]; const float* w_uq = (const float*)d_in[17]; const float* kv_norm_g = (const float*)d_in[18]; const float* w_ukv = (const float*)d_in[19];
    const float* sc_conv_w = (const float*)d_in[20]; const float* sc_conv_b = (const float*)d_in[21]; const float* w_out = (const float*)d_in[22]; const float* router_w = (const float*)d_in[23];
    const float* router_b = (const float*)d_in[24]; const float* w_gu = (const float*)d_in[25]; const float* b_gu = (const float*)d_in[26]; const float* w_down = (const float*)d_in[27];
    const float* b_down = (const float*)d_in[28]; const float* final_g = (const float*)d_in[29];
    float* out = (float*)d_out;
    unsigned char* p = (unsigned char*)d_ws; size_t off = 0;
    auto carve = [&](size_t bytes) { void* r = p + off; off = al256(off + bytes); return r; };
    WS w;
    w.CNT = (int*)carve(2 * NE * 4); w.OFFS = (int*)carve(2 * (NE + 1) * 4);
    w.H = (float*)carve((size_t)MROWS * D * 4); w.MOD = (float*)carve(2 * 5 * 6144 * 4); w.TABC = (float*)carve(4096 * 4); w.TABS = (float*)carve(4096 * 4);
    w.XN = (bf16_t*)carve((size_t)MROWS * D * 2); w.P = (bf16_t*)carve((size_t)MROWS * PP * 2); w.MIX = (bf16_t*)carve((size_t)MROWS * D * 2);
    w.CQN = (bf16_t*)carve((size_t)MROWS * 256 * 2); w.CKVN = (bf16_t*)carve((size_t)MROWS * 128 * 2); w.QRAW = (float*)carve((size_t)MROWS * 384 * 4); w.KVRAW = (float*)carve((size_t)MROWS * 512 * 4);
    w.QL = (bf16_t*)carve((size_t)16 * SEQ * 96 * 2); w.QC = (bf16_t*)carve((size_t)16 * CTX * 96 * 2); w.KB = (bf16_t*)carve((size_t)16 * NPOS * 96 * 2); w.VB = (bf16_t*)carve((size_t)16 * NPOS * 64 * 2);
    w.LA = (float*)carve((size_t)2 * MROWS * 256 * 4); w.LB = (float*)carve((size_t)2 * MROWS * 256 * 4); w.HS = (float*)carve((size_t)2 * MROWS * 256 * 4);
    w.XCS = (float*)carve((size_t)4 * 8192 * 256 * 4); w.XCSC = (float*)carve((size_t)4 * 512 * 256 * 4);
    w.LIST = (int*)carve((size_t)2 * NE * LCAP * 4); w.GATE = (float*)carve((size_t)NASG * 4); w.ACT = (bf16_t*)carve((size_t)ACT_ROWS * D * 2); w.Y = (bf16_t*)carve((size_t)NASG * D * 2);
    if (off > ws_size) { fprintf(stderr, "kernel_launch: workspace too small: need %zu have %zu\n", off, ws_size); return; }

    (void)hipMemsetAsync(w.CNT, 0, 2 * NE * 4, stream);
    k_init<<<2048, 256, 0, stream>>>(x, ctx, w.H, w.TABC, w.TABS);
    k_mod<<<48, 256, 0, stream>>>(c, c_ctx, mod_w, mod_b, w.MOD);
    for (int l = 0; l < 2; ++l) {
        const bool wctx = (l == 0); const float* MODl = w.MOD + (size_t)l * 5 * 6144;
        k_norm_mod<<<MROWS / 4, 256, 0, stream>>>(w.H, norm1_g + l * D, MODl, 0, 1024, w.XN);
        k_gemm<ALBf16, EPBf16, 1><<<dim3((PT + 63) / 64, MROWS / 64, 1), 256, 0, stream>>>(ALBf16{w.XN, D}, w_in + (size_t)l * D * PT, PT, 0, PT, D, 0, EPBf16{w.P, PP});
        k_four_ch<<<MROWS, 256, 0, stream>>>(w.P, w.TABC, w.TABS, w.XCS, w.XCSC, wctx ? 1 : 0);
        k_gemm<ALDft, EPDft, 1><<<dim3(4, SEQ / 64, 4), 256, 0, stream>>>(ALDft{w.TABC, w.TABS, 4096, 1}, w.XCS, 256, (long)8192 * 256, 256, 8192, 0, EPDft{w.MIX, CTX, 1.f / 512.f});
        if (wctx) k_gemm<ALDft, EPDft, 1><<<dim3(4, CTX / 64, 4), 256, 0, stream>>>(ALDft{w.TABC, w.TABS, 256, 16}, w.XCSC, 256, (long)512 * 256, 256, 512, 0, EPDft{w.MIX, 0, 1.f / 128.f});
        k_lru_gates<<<dim3(MROWS / 16, 2), 256, 0, stream>>>(w.P, lru_conv_w + (size_t)l * 2 * 4 * 256, lru_conv_b + l * 512, lru_w_a + (size_t)l * 2 * 4 * 64 * 64, lru_b_a + l * 512,
                                                          lru_w_i + (size_t)l * 2 * 4 * 64 * 64, lru_b_i + l * 512, lru_lambda + l * 512, w.LA, w.LB);
        k_lru_scan<<<dim3(4, 2), 256, 0, stream>>>(w.LA, w.LB, w.HS);
        k_lru_sc_out<<<MROWS, 256, 0, stream>>>(w.P, w.HS, sc_conv_w + l * 768, sc_conv_b + l * 256, w.MIX);
        k_lat_norm<<<MROWS / 4, 256, 0, stream>>>(w.P, q_norm_g + l * 256, kv_norm_g + l * 128, w.CQN, w.CKVN);
        k_gemm<ALBf16, EPF32, 1><<<dim3(384 / 64, MROWS / 64, 1), 256, 0, stream>>>(ALBf16{w.CQN, 256}, w_uq + (size_t)l * 256 * 384, 384, 0, 384, 256, 0, EPF32{w.QRAW, 384});
        k_gemm<ALBf16, EPF32, 1><<<dim3(512 / 64, MROWS / 64, 1), 256, 0, stream>>>(ALBf16{w.CKVN, 128}, w_ukv + (size_t)l * 128 * 512, 512, 0, 512, 128, 0, EPF32{w.KVRAW, 512});
        k_qkv_finish<<<MROWS, 256, 0, stream>>>(w.QRAW, w.KVRAW, w.P, w.QL, w.QC, w.KB, w.VB, wctx ? 1 : 0);
        k_attn<<<dim3(SEQ / 256, 16), 256, 0, stream>>>(w.QL, SEQ, w.KB, w.VB, NPOS, w.MIX, CTX);
        if (wctx) k_attn<<<dim3(1, 16), 256, 0, stream>>>(w.QC, CTX, w.KB, w.VB, CTX, w.MIX, 0);
        k_gemm<ALBf16, EPRes, 1><<<dim3(D / 64, MROWS / 64, 1), 256, 0, stream>>>(ALBf16{w.MIX, D}, w_out + (size_t)l * D * D, D, 0, D, D, 0, EPRes{w.H, MODl, 2048});
        int* CNT = w.CNT + l * NE; int* OFFS = w.OFFS + l * (NE + 1); int* LIST = w.LIST + (size_t)l * NE * LCAP;
        k_norm2_route<<<MROWS / 4, 256, 0, stream>>>(w.H, norm2_g + l * D, MODl, router_w + (size_t)l * D * NE, router_b + l * NE, w.XN, CNT, LIST, w.GATE, wctx ? 0 : 1);
        k_moe_offsets<<<1, 64, 0, stream>>>(CNT, OFFS);
        k_gemm<ALMoe1, EPMoe1, 2><<<dim3(D / 64, ACT_ROWS / 64, 1), 256, 0, stream>>>(ALMoe1{w.XN, OFFS, CNT, LIST, 0, 0, 0}, w_gu + (size_t)l * NE * D * 2048, 2048, 0, D, D, 1024,
                                                                                   EPMoe1{w.ACT, b_gu + (size_t)l * NE * 2048, OFFS, CNT, 0, 0, 0});
        k_gemm<ALMoe2, EPMoe2, 1><<<dim3(D / 64, ACT_ROWS / 64, 1), 256, 0, stream>>>(ALMoe2{w.ACT, OFFS, 0}, w_down + (size_t)l * NE * D * D, D, 0, D, D, 0,
                                                                                   EPMoe2{w.Y, b_down + (size_t)l * NE * D, w.GATE, OFFS, CNT, LIST, 0, 0, 0});
        k_moe_combine<<<MROWS / 4, 256, 0, stream>>>(w.H, w.Y, MODl, wctx ? 0 : 1, l == 1 ? final_g : nullptr, l == 1 ? out : nullptr);
    }
}
```

```cpp
#include <hip/hip_runtime.h>
#include <cstdint>
#include <cstdio>

typedef unsigned short bf16_t;
constexpr int NB_ = 4, SEQ = 4096, CTX = 256, D = 1024, NPOS = SEQ + CTX, MROWS = NB_ * NPOS;
constexpr int PT = 1952, PP = 2048;
constexpr int NE = 32, TOPK = 4, LCAP = MROWS;
constexpr int NASG = MROWS * TOPK;
constexpr int ACT_ROWS = NASG + NE * 256;
constexpr int C_FN = 0, C_LX = 256, C_LG = 512, C_CQ = 768, C_CKV = 1024, C_KR = 1152, C_SX = 1184, C_SB = 1440, C_SC = 1696;

__device__ __forceinline__ float bf2f(bf16_t v) { return __uint_as_float((unsigned)v << 16); }
__device__ __forceinline__ bf16_t f2bf(float f) { unsigned u = __float_as_uint(f); return (bf16_t)((u + 0x7fffu + ((u >> 16) & 1u)) >> 16); }
__device__ __forceinline__ float wave_sum(float v) {
#pragma unroll
    for (int o = 1; o < 64; o <<= 1) v += __shfl_xor(v, o);
    return v;
}
__device__ __forceinline__ float sigmoidf_(float x) { return 1.f / (1.f + __expf(-x)); }
__device__ __forceinline__ float gelu_tanh(float x) { const float u = 0.7978845608028654f * (x + 0.044715f * x * x * x); return 0.5f * x * (1.f + tanhf(u)); }

struct WS {
    float* H; float* MOD; float* TABC; float* TABS; bf16_t* XN; bf16_t* P; bf16_t* MIX; bf16_t* CQN; bf16_t* CKVN; float* QRAW; float* KVRAW;
    bf16_t* QL; bf16_t* QC; bf16_t* KB; bf16_t* VB; float* LA; float* LB; float* HS; float* XCS; float* XCSC;
    int* CNT; int* OFFS; int* LIST; float* GATE; bf16_t* ACT; bf16_t* Y;
};

__global__ void k_init(const float* x, const float* ctx, float* H, float* TABC, float* TABS) {
    const size_t n4 = (size_t)MROWS * D / 4;
    for (size_t i = (size_t)blockIdx.x * blockDim.x + threadIdx.x; i < n4; i += (size_t)gridDim.x * blockDim.x) {
        const size_t e = i * 4; const int r = (int)(e / D), c = (int)(e % D); const int b = r / NPOS, pos = r % NPOS;
        const float4 v = pos < CTX ? *(const float4*)(ctx + ((size_t)b * CTX + pos) * D + c) : *(const float4*)(x + ((size_t)b * SEQ + (pos - CTX)) * D + c);
        *(float4*)(H + e) = v;
    }
    const int t = blockIdx.x * blockDim.x + threadIdx.x;
    if (t < 4096) { float s, c; sincospif((float)t / 2048.f, &s, &c); TABC[t] = c; TABS[t] = s; }
}

__global__ __launch_bounds__(256) void k_mod(const float* c, const float* c_ctx, const float* mod_w, const float* mod_b, float* MOD) {
    __shared__ float s[5][1024];
    for (int i = threadIdx.x; i < 5 * 1024; i += 256) { const int v = i >> 10, k = i & 1023; const float x = v < 4 ? c[v * 1024 + k] : c_ctx[k]; s[v][k] = x / (1.f + __expf(-x)); }
    __syncthreads();
    const int idx = blockIdx.x * 256 + threadIdx.x; const int l = idx / 6144, col = idx % 6144;
    const float* W = mod_w + (size_t)l * 1024 * 6144 + col;
    float a0 = 0, a1 = 0, a2 = 0, a3 = 0, a4 = 0;
#pragma unroll 8
    for (int k = 0; k < 1024; ++k) { const float w = W[(size_t)k * 6144]; a0 += s[0][k] * w; a1 += s[1][k] * w; a2 += s[2][k] * w; a3 += s[3][k] * w; a4 += s[4][k] * w; }
    const float bb = mod_b[l * 6144 + col];
    float* M = MOD + (size_t)l * 5 * 6144 + col;
    M[0] = a0 + bb; M[6144] = a1 + bb; M[2 * 6144] = a2 + bb; M[3 * 6144] = a3 + bb; M[4 * 6144] = a4 + bb;
}

__global__ __launch_bounds__(256) void k_norm_mod(const float* H, const float* g, const float* MODl, int sh_off, int sc_off, bf16_t* XN) {
    const int lane = threadIdx.x & 63, r = blockIdx.x * 4 + (threadIdx.x >> 6);
    const int b = r / NPOS, pos = r % NPOS, v = pos < CTX ? 4 : b;
    const float* mv = MODl + (size_t)v * 6144;
    float4 x[4]; float ss = 0.f;
#pragma unroll
    for (int j = 0; j < 4; ++j) { x[j] = *(const float4*)(H + (size_t)r * D + (j * 64 + lane) * 4); ss += x[j].x * x[j].x + x[j].y * x[j].y + x[j].z * x[j].z + x[j].w * x[j].w; }
    const float rs = rsqrtf(wave_sum(ss) * (1.f / D) + 1e-6f);
#pragma unroll
    for (int j = 0; j < 4; ++j) { const int c = (j * 64 + lane) * 4; const float4 gg = *(const float4*)(g + c), sh = *(const float4*)(mv + sh_off + c), sc = *(const float4*)(mv + sc_off + c);
        ushort4 o; o.x = f2bf(x[j].x * rs * gg.x * (1.f + sc.x) + sh.x); o.y = f2bf(x[j].y * rs * gg.y * (1.f + sc.y) + sh.y); o.z = f2bf(x[j].z * rs * gg.z * (1.f + sc.z) + sh.z); o.w = f2bf(x[j].w * rs * gg.w * (1.f + sc.w) + sh.w);
        *(ushort4*)(XN + (size_t)r * D + c) = o; }
}

template <class AL, class EP, int NBK>
__global__ __launch_bounds__(256) void k_gemm(AL alp, const float* W, int ldw, long wz, int N, int K, int colB2, EP epp) {
    __shared__ float As[16][68];
    __shared__ float Bs[NBK][16][68];
    AL al = alp; EP ep = epp;
    const int tx = threadIdx.x & 15, ty = threadIdx.x >> 4, m0 = blockIdx.y * 64, n0 = blockIdx.x * 64, z = blockIdx.z;
    if (!al.init(m0, z)) return;
    ep.init(m0, z);
    const float* Wz = W + al.woff() + (size_t)z * wz;
    float acc[NBK][4][4];
#pragma unroll
    for (int nb = 0; nb < NBK; ++nb)
#pragma unroll
        for (int i = 0; i < 4; ++i)
#pragma unroll
            for (int j = 0; j < 4; ++j) acc[nb][i][j] = 0.f;
    const int am = threadIdx.x >> 2, ak = (threadIdx.x & 3) * 4, bk = threadIdx.x >> 4, bn = (threadIdx.x & 15) * 4;
    for (int k0 = 0; k0 < K; k0 += 16) {
        { float v[4]; al.load4(z, m0 + am, k0 + ak, v); As[ak + 0][am] = v[0]; As[ak + 1][am] = v[1]; As[ak + 2][am] = v[2]; As[ak + 3][am] = v[3]; }
#pragma unroll
        for (int nb = 0; nb < NBK; ++nb) { const int col = n0 + bn; float4 w = make_float4(0.f, 0.f, 0.f, 0.f);
            if (col + 3 < N) w = *(const float4*)(Wz + (size_t)(k0 + bk) * ldw + col + nb * colB2);
            *(float4*)&Bs[nb][bk][bn] = w; }
        __syncthreads();
#pragma unroll
        for (int kk = 0; kk < 16; ++kk) {
            const float4 a = *(const float4*)&As[kk][ty * 4];
#pragma unroll
            for (int nb = 0; nb < NBK; ++nb) { const float4 b = *(const float4*)&Bs[nb][kk][tx * 4];
                acc[nb][0][0] += a.x * b.x; acc[nb][0][1] += a.x * b.y; acc[nb][0][2] += a.x * b.z; acc[nb][0][3] += a.x * b.w;
                acc[nb][1][0] += a.y * b.x; acc[nb][1][1] += a.y * b.y; acc[nb][1][2] += a.y * b.z; acc[nb][1][3] += a.y * b.w;
                acc[nb][2][0] += a.z * b.x; acc[nb][2][1] += a.z * b.y; acc[nb][2][2] += a.z * b.z; acc[nb][2][3] += a.z * b.w;
                acc[nb][3][0] += a.w * b.x; acc[nb][3][1] += a.w * b.y; acc[nb][3][2] += a.w * b.z; acc[nb][3][3] += a.w * b.w; }
        }
        __syncthreads();
    }
#pragma unroll
    for (int i = 0; i < 4; ++i)
#pragma unroll
        for (int j = 0; j < 4; ++j) { const int col = n0 + tx * 4 + j; if (col < N) ep.store(z, m0 + ty * 4 + i, col, acc[0][i][j], acc[NBK - 1][i][j]); }
}

struct ALBf16 { const bf16_t* A; int lda, pad;
    __device__ bool init(int, int) { return true; } __device__ size_t woff() const { return 0; }
    __device__ void load4(int, int row, int k, float* v) const { const ushort4 w = *(const ushort4*)(A + (size_t)row * lda + k); v[0] = bf2f(w.x); v[1] = bf2f(w.y); v[2] = bf2f(w.z); v[3] = bf2f(w.w); } };
struct ALDft { const float* TC; const float* TS; int n, ts;
    __device__ bool init(int, int) { return true; } __device__ size_t woff() const { return 0; }
    __device__ void load4(int, int row, int k, float* v) const {
#pragma unroll
        for (int j = 0; j < 4; ++j) { const int t = k + j; if (t < n) v[j] = TC[((row * t) & (n - 1)) * ts]; else v[j] = -TS[((row * (t - n)) & (n - 1)) * ts]; } } };
struct ALMoe1 { const bf16_t* XN; const int* offs; const int* cnt; const int* list; int e, base, n, pad;
    __device__ bool init(int m0, int) { if (m0 >= offs[NE]) return false; int ee = 0; for (int i = 1; i < NE; ++i) if (m0 >= offs[i]) ee = i; e = ee; base = offs[ee]; n = cnt[ee]; return true; }
    __device__ size_t woff() const { return (size_t)e * 1024 * 2048; }
    __device__ void load4(int, int row, int k, float* v) const { const int i = row - base; const int tok = i < n ? (list[(size_t)e * LCAP + i] >> 2) : 0;
        const ushort4 w = *(const ushort4*)(XN + (size_t)tok * D + k); v[0] = bf2f(w.x); v[1] = bf2f(w.y); v[2] = bf2f(w.z); v[3] = bf2f(w.w); } };
struct ALMoe2 { const bf16_t* ACT; const int* offs; int e, pad;
    __device__ bool init(int m0, int) { if (m0 >= offs[NE]) return false; int ee = 0; for (int i = 1; i < NE; ++i) if (m0 >= offs[i]) ee = i; e = ee; return true; }
    __device__ size_t woff() const { return (size_t)e * 1024 * 1024; }
    __device__ void load4(int, int row, int k, float* v) const { const ushort4 w = *(const ushort4*)(ACT + (size_t)row * D + k); v[0] = bf2f(w.x); v[1] = bf2f(w.y); v[2] = bf2f(w.z); v[3] = bf2f(w.w); } };

struct EPBf16 { bf16_t* C; int ldc, pad; __device__ void init(int, int) {} __device__ void store(int, int r, int c, float a, float) const { C[(size_t)r * ldc + c] = f2bf(a); } };
struct EPF32 { float* C; int ldc, pad; __device__ void init(int, int) {} __device__ void store(int, int r, int c, float a, float) const { C[(size_t)r * ldc + c] = a; } };
struct EPDft { bf16_t* MIX; int rowoff; float scale; __device__ void init(int, int) {} __device__ void store(int z, int r, int c, float a, float) const { MIX[((size_t)z * NPOS + rowoff + r) * D + c] = f2bf(a * scale); } };
struct EPRes { float* H; const float* MODl; int g_off, pad; __device__ void init(int, int) {}
    __device__ void store(int, int r, int c, float a, float) const { const int b = r / NPOS, pos = r % NPOS, v = pos < CTX ? 4 : b; H[(size_t)r * D + c] += MODl[(size_t)v * 6144 + g_off + c] * a; } };
struct EPMoe1 { bf16_t* ACT; const float* bgu; const int* offs; const int* cnt; int e, base, n, pad;
    __device__ void init(int m0, int) { int ee = 0; for (int i = 1; i < NE; ++i) if (m0 >= offs[i]) ee = i; e = ee; base = offs[ee]; n = cnt[ee]; }
    __device__ void store(int, int r, int c, float ag, float au) const {
        float o = 0.f; if (r - base < n) { const float g = fminf(ag + bgu[(size_t)e * 2048 + c], 7.f); const float u = fminf(fmaxf(au + bgu[(size_t)e * 2048 + 1024 + c], -7.f), 7.f); o = (u + 1.f) * g * sigmoidf_(1.702f * g); }
        ACT[(size_t)r * D + c] = f2bf(o); } };
struct EPMoe2 { bf16_t* Y; const float* bd; const float* GATE; const int* offs; const int* cnt; const int* list; int e, base, n, pad;
    __device__ void init(int m0, int) { int ee = 0; for (int i = 1; i < NE; ++i) if (m0 >= offs[i]) ee = i; e = ee; base = offs[ee]; n = cnt[ee]; }
    __device__ void store(int, int r, int c, float a, float) const { const int i = r - base; if (i < n) { const int asg = list[(size_t)e * LCAP + i]; Y[(size_t)asg * D + c] = f2bf(GATE[asg] * (a + bd[(size_t)e * 1024 + c])); } } };

__global__ __launch_bounds__(256) void k_four_ch(const bf16_t* P, const float* TC, const float* TS, float* XCS, float* XCSC, int with_ctx) {
    __shared__ float u[256];
    const int r = blockIdx.x, b = r / NPOS, pos = r % NPOS;
    if (pos < CTX && !with_ctx) return;
    u[threadIdx.x] = bf2f(P[(size_t)r * PP + C_FN + threadIdx.x]);
    __syncthreads();
    const int g = threadIdx.x >> 6, k = threadIdx.x & 63; float ac = 0.f, as = 0.f;
#pragma unroll 8
    for (int c = 0; c < 64; ++c) { const int i = ((k * c) & 63) * 64; const float x = u[g * 64 + c]; ac += x * TC[i]; as += x * TS[i]; }
    if (pos >= CTX) { const int t = pos - CTX; XCS[((size_t)b * 8192 + t) * 256 + threadIdx.x] = ac; XCS[((size_t)b * 8192 + 4096 + t) * 256 + threadIdx.x] = as; }
    else { XCSC[((size_t)b * 512 + pos) * 256 + threadIdx.x] = ac; XCSC[((size_t)b * 512 + 256 + pos) * 256 + threadIdx.x] = as; }
}

__global__ __launch_bounds__(256) void k_lru_gates(const bf16_t* P, const float* conv_w, const float* conv_b, const float* w_a, const float* b_a, const float* w_i, const float* b_i, const float* lam,
                                                    float* LA, float* LB) {
    __shared__ float xs[16][256];
    const int dir = blockIdx.y, r0 = blockIdx.x * 16, c = threadIdx.x;
    const int b = r0 / NPOS, pos0 = r0 % NPOS; const int lo = pos0 < CTX ? 0 : CTX, hi = pos0 < CTX ? CTX : NPOS;
    const int left = dir ? 1 : 2;
    const float* cw = conv_w + (size_t)dir * 4 * 256; const float cb = conv_b[dir * 256 + c];
    float xc[16];
#pragma unroll
    for (int i = 0; i < 16; ++i) { float a = cb;
#pragma unroll
        for (int k = 0; k < 4; ++k) { const int p = pos0 + i - left + k; if (p >= lo && p < hi) a += cw[k * 256 + c] * bf2f(P[((size_t)b * NPOS + p) * PP + C_LX + c]); }
        xc[i] = a; xs[i][c] = a; }
    __syncthreads();
    const int h = c >> 6, e = c & 63;
    const float* wa = w_a + ((size_t)(dir * 4 + h) * 64) * 64 + e; const float* wi = w_i + ((size_t)(dir * 4 + h) * 64) * 64 + e;
    float ra[16], ri[16];
#pragma unroll
    for (int i = 0; i < 16; ++i) { ra[i] = 0.f; ri[i] = 0.f; }
    for (int d = 0; d < 64; ++d) { const float va = wa[d * 64], vi = wi[d * 64];
#pragma unroll
        for (int i = 0; i < 16; ++i) { const float x = xs[i][h * 64 + d]; ra[i] += x * va; ri[i] += x * vi; } }
    const float ba = b_a[dir * 256 + c], bi = b_i[dir * 256 + c]; const float sp = log1pf(__expf(-lam[dir * 256 + c]));
#pragma unroll
    for (int i = 0; i < 16; ++i) { const float rr = sigmoidf_(ra[i] + ba), ii = sigmoidf_(ri[i] + bi); const float a = __expf(-8.f * rr * sp);
        const float bt = sqrtf(fmaxf(1.f - a * a, 0.f)) * (ii * xc[i]);
        LA[((size_t)dir * MROWS + r0 + i) * 256 + c] = a; LB[((size_t)dir * MROWS + r0 + i) * 256 + c] = bt; }
}
__global__ __launch_bounds__(256) void k_lru_scan(const float* LA, const float* LB, float* HS) {
    const int c = threadIdx.x, b = blockIdx.x, dir = blockIdx.y;
    const float* a = LA + ((size_t)dir * MROWS + (size_t)b * NPOS) * 256 + c; const float* bb = LB + ((size_t)dir * MROWS + (size_t)b * NPOS) * 256 + c;
    float* hs = HS + ((size_t)dir * MROWS + (size_t)b * NPOS) * 256 + c;
    float h = 0.f;
    if (dir == 0) {
#pragma unroll 8
        for (int p = 0; p < NPOS; ++p) { h = a[(size_t)p * 256] * h + bb[(size_t)p * 256]; hs[(size_t)p * 256] = h; }
    } else {
#pragma unroll 8
        for (int p = CTX - 1; p >= 0; --p) { h = a[(size_t)p * 256] * h + bb[(size_t)p * 256]; hs[(size_t)p * 256] = h; }
#pragma unroll 8
        for (int p = NPOS - 1; p >= CTX; --p) { h = a[(size_t)p * 256] * h + bb[(size_t)p * 256]; hs[(size_t)p * 256] = h; }
    }
}
__global__ __launch_bounds__(256) void k_lru_sc_out(const bf16_t* P, const float* HS, const float* scw, const float* scb, bf16_t* MIX) {
    const int r = blockIdx.x, c = threadIdx.x, b = r / NPOS, pos = r % NPOS; const int lo = pos < CTX ? 0 : CTX, hi = pos < CTX ? CTX : NPOS;
    const float lg = bf2f(P[(size_t)r * PP + C_LG + c]);
    MIX[(size_t)r * D + 256 + c] = f2bf(gelu_tanh(lg) * (HS[(size_t)r * 256 + c] + HS[((size_t)MROWS + r) * 256 + c]));
    float a = scb[c];
#pragma unroll
    for (int k = 0; k < 3; ++k) { const int p = pos - 1 + k; if (p >= lo && p < hi) { const size_t rr = (size_t)b * NPOS + p; a += scw[k * 256 + c] * (bf2f(P[rr * PP + C_SC + c]) * bf2f(P[rr * PP + C_SX + c])); } }
    MIX[(size_t)r * D + 768 + c] = f2bf(bf2f(P[(size_t)r * PP + C_SB + c]) * a);
}

__global__ __launch_bounds__(256) void k_lat_norm(const bf16_t* P, const float* qg, const float* kvg, bf16_t* CQN, bf16_t* CKVN) {
    const int lane = threadIdx.x & 63, r = blockIdx.x * 4 + (threadIdx.x >> 6);
    float q[4], ss = 0.f;
#pragma unroll
    for (int j = 0; j < 4; ++j) { q[j] = bf2f(P[(size_t)r * PP + C_CQ + j * 64 + lane]); ss += q[j] * q[j]; }
    const float rq = rsqrtf(wave_sum(ss) * (1.f / 256.f) + 1e-6f);
#pragma unroll
    for (int j = 0; j < 4; ++j) CQN[(size_t)r * 256 + j * 64 + lane] = f2bf(q[j] * rq * qg[j * 64 + lane]);
    float k2[2]; ss = 0.f;
#pragma unroll
    for (int j = 0; j < 2; ++j) { k2[j] = bf2f(P[(size_t)r * PP + C_CKV + j * 64 + lane]); ss += k2[j] * k2[j]; }
    const float rk = rsqrtf(wave_sum(ss) * (1.f / 128.f) + 1e-6f);
#pragma unroll
    for (int j = 0; j < 2; ++j) CKVN[(size_t)r * 128 + j * 64 + lane] = f2bf(k2[j] * rk * kvg[j * 64 + lane]);
}
__device__ __forceinline__ float rope_elem(const float* z  , int i, int row, int col) {
    const int hs = i >> 4, w = i & 15, j = w & 7; const float pos = (float)(hs ? col : row);
    const float inv = __expf(-9.210340371976184f * (float)j * 0.125f); float s, c; sincosf(pos * inv, &s, &c);
    const float z1 = z[hs * 16 + j], z2 = z[hs * 16 + 8 + j];
    return w < 8 ? z1 * c - z2 * s : z1 * s + z2 * c;
}
__global__ __launch_bounds__(256) void k_qkv_finish(const float* QRAW, const float* KVRAW, const bf16_t* P, bf16_t* QL, bf16_t* QC, bf16_t* KB, bf16_t* VB, int with_ctx_q) {
    __shared__ float zq[4][32]; __shared__ float zk[32];
    const int r = blockIdx.x, b = r / NPOS, pos = r % NPOS; const bool lat = pos >= CTX; const int t = pos - CTX, row = t >> 6, col = t & 63;
    if (threadIdx.x < 128) zq[threadIdx.x >> 5][threadIdx.x & 31] = QRAW[(size_t)r * 384 + (threadIdx.x >> 5) * 96 + 64 + (threadIdx.x & 31)];
    else if (threadIdx.x < 160) zk[threadIdx.x - 128] = bf2f(P[(size_t)r * PP + C_KR + threadIdx.x - 128]);
    __syncthreads();
    for (int i = threadIdx.x; i < 384; i += 256) { const int h = i / 96, d = i % 96;
        float q; if (d < 64) q = QRAW[(size_t)r * 384 + i]; else q = lat ? rope_elem(zq[h], d - 64, row, col) : zq[h][d - 64];
        if (lat) QL[((size_t)(b * 4 + h) * SEQ + t) * 96 + d] = f2bf(q); else if (with_ctx_q) QC[((size_t)(b * 4 + h) * CTX + pos) * 96 + d] = f2bf(q);
        float k; if (d < 64) k = KVRAW[(size_t)r * 512 + h * 128 + d]; else k = lat ? rope_elem(zk, d - 64, row, col) : zk[d - 64];
        KB[((size_t)(b * 4 + h) * NPOS + pos) * 96 + d] = f2bf(k); }
    { const int h = threadIdx.x >> 6, d = threadIdx.x & 63; VB[((size_t)(b * 4 + h) * NPOS + pos) * 64 + d] = f2bf(KVRAW[(size_t)r * 512 + h * 128 + 64 + d]); }
}
__global__ __launch_bounds__(256) void k_attn(const bf16_t* Q, int nq, const bf16_t* KB, const bf16_t* VB, int nkeys, bf16_t* MIX, int out_pos_off) {
    __shared__ float Ks[64][96]; __shared__ float Vs[64][64];
    const int bh = blockIdx.y, qi = blockIdx.x * 256 + threadIdx.x, b = bh >> 2, h = bh & 3;
    float q[96], o[64];
    { const bf16_t* qp = Q + ((size_t)bh * nq + qi) * 96;
#pragma unroll
      for (int d = 0; d < 96; ++d) q[d] = bf2f(qp[d]) * 0.10206207261596577f; }
#pragma unroll
    for (int d = 0; d < 64; ++d) o[d] = 0.f;
    float m = -1e30f, l = 0.f;
    for (int k0 = 0; k0 < nkeys; k0 += 64) {
        __syncthreads();
        for (int i = threadIdx.x; i < 64 * 96; i += 256) Ks[i / 96][i % 96] = bf2f(KB[((size_t)bh * NPOS + k0) * 96 + i]);
        for (int i = threadIdx.x; i < 64 * 64; i += 256) Vs[i >> 6][i & 63] = bf2f(VB[((size_t)bh * NPOS + k0) * 64 + i]);
        __syncthreads();
        for (int j = 0; j < 64; ++j) {
            float s = 0.f;
#pragma unroll
            for (int d = 0; d < 96; d += 4) { const float4 kk = *(const float4*)&Ks[j][d]; s += q[d] * kk.x + q[d + 1] * kk.y + q[d + 2] * kk.z + q[d + 3] * kk.w; }
            const float mn = fmaxf(m, s), corr = __expf(m - mn), p = __expf(s - mn); m = mn; l = l * corr + p;
#pragma unroll
            for (int d = 0; d < 64; d += 4) { const float4 vv = *(const float4*)&Vs[j][d]; o[d] = o[d] * corr + p * vv.x; o[d + 1] = o[d + 1] * corr + p * vv.y; o[d + 2] = o[d + 2] * corr + p * vv.z; o[d + 3] = o[d + 3] * corr + p * vv.w; }
        }
    }
    const float il = 1.f / l; bf16_t* op = MIX + ((size_t)b * NPOS + out_pos_off + qi) * D + 512 + h * 64;
#pragma unroll
    for (int d = 0; d < 64; ++d) op[d] = f2bf(o[d] * il);
}

__global__ __launch_bounds__(256) void k_norm2_route(const float* H, const float* g, const float* MODl, const float* rw, const float* rb, bf16_t* XN, int* CNT, int* LIST, float* GATE, int skip_ctx) {
    __shared__ float fs[4][1024]; __shared__ float lg[4][32];
    const int w = threadIdx.x >> 6, lane = threadIdx.x & 63, r = blockIdx.x * 4 + w;
    const int b = r / NPOS, pos = r % NPOS, v = pos < CTX ? 4 : b; const bool act = !(skip_ctx && pos < CTX);
    const float* mv = MODl + (size_t)v * 6144;
    float4 x[4]; float ss = 0.f;
#pragma unroll
    for (int j = 0; j < 4; ++j) { x[j] = *(const float4*)(H + (size_t)r * D + (j * 64 + lane) * 4); ss += x[j].x * x[j].x + x[j].y * x[j].y + x[j].z * x[j].z + x[j].w * x[j].w; }
    const float rs = rsqrtf(wave_sum(ss) * (1.f / D) + 1e-6f);
#pragma unroll
    for (int j = 0; j < 4; ++j) { const int c = (j * 64 + lane) * 4; const float4 gg = *(const float4*)(g + c), sh = *(const float4*)(mv + 3072 + c), sc = *(const float4*)(mv + 4096 + c);
        float4 f; f.x = x[j].x * rs * gg.x * (1.f + sc.x) + sh.x; f.y = x[j].y * rs * gg.y * (1.f + sc.y) + sh.y; f.z = x[j].z * rs * gg.z * (1.f + sc.z) + sh.z; f.w = x[j].w * rs * gg.w * (1.f + sc.w) + sh.w;
        *(float4*)&fs[w][c] = f; ushort4 o; o.x = f2bf(f.x); o.y = f2bf(f.y); o.z = f2bf(f.z); o.w = f2bf(f.w); *(ushort4*)(XN + (size_t)r * D + c) = o; }
    __syncthreads();
    { const int e = lane & 31, half = lane >> 5; float a = 0.f;
#pragma unroll 8
      for (int k = half * 512; k < half * 512 + 512; ++k) a += fs[w][k] * rw[k * 32 + e];
      a += __shfl_xor(a, 32); if (lane < 32) lg[w][e] = a + rb[e]; }
    __syncthreads();
    if (lane == 0 && act) {
        float vals[4]; int idx[4]; unsigned used = 0u;
#pragma unroll
        for (int k = 0; k < 4; ++k) { float best = -3e38f; int bi = 0; for (int e = 0; e < 32; ++e) { const float xx = lg[w][e]; if (!((used >> e) & 1u) && xx > best) { best = xx; bi = e; } } used |= 1u << bi; vals[k] = best; idx[k] = bi; }
        float ex[4], sum = 0.f;
#pragma unroll
        for (int k = 0; k < 4; ++k) { ex[k] = __expf(vals[k] - vals[0]); sum += ex[k]; }
#pragma unroll
        for (int k = 0; k < 4; ++k) { const int asg = r * 4 + k; GATE[asg] = ex[k] / sum; const int p = atomicAdd(&CNT[idx[k]], 1); LIST[(size_t)idx[k] * LCAP + p] = asg; }
    }
}
__global__ void k_moe_offsets(const int* CNT, int* OFFS) { if (threadIdx.x == 0 && blockIdx.x == 0) { int o = 0; for (int e = 0; e < NE; ++e) { OFFS[e] = o; o += (CNT[e] + 255) / 256 * 256; } OFFS[NE] = o; } }
__global__ __launch_bounds__(256) void k_moe_combine(float* H, const bf16_t* Y, const float* MODl, int skip_ctx, const float* final_g, float* out) {
    const int lane = threadIdx.x & 63, r = blockIdx.x * 4 + (threadIdx.x >> 6); const int b = r / NPOS, pos = r % NPOS, v = pos < CTX ? 4 : b;
    if (skip_ctx && pos < CTX) return;
    const float* g2 = MODl + (size_t)v * 6144 + 5120;
    float4 x[4]; float ss = 0.f;
#pragma unroll
    for (int j = 0; j < 4; ++j) { const int c = (j * 64 + lane) * 4; x[j] = *(const float4*)(H + (size_t)r * D + c); float4 s = make_float4(0.f, 0.f, 0.f, 0.f);
#pragma unroll
        for (int k = 0; k < 4; ++k) { const ushort4 y = *(const ushort4*)(Y + ((size_t)r * 4 + k) * D + c); s.x += bf2f(y.x); s.y += bf2f(y.y); s.z += bf2f(y.z); s.w += bf2f(y.w); }
        const float4 gg = *(const float4*)(g2 + c); x[j].x += gg.x * s.x; x[j].y += gg.y * s.y; x[j].z += gg.z * s.z; x[j].w += gg.w * s.w;
        *(float4*)(H + (size_t)r * D + c) = x[j]; ss += x[j].x * x[j].x + x[j].y * x[j].y + x[j].z * x[j].z + x[j].w * x[j].w; }
    if (out) { const float rs = rsqrtf(wave_sum(ss) * (1.f / D) + 1e-6f); float* op = out + ((size_t)b * SEQ + (pos - CTX)) * D;
#pragma unroll
        for (int j = 0; j < 4; ++j) { const int c = (j * 64 + lane) * 4; const float4 fg = *(const float4*)(final_g + c); float4 o; o.x = x[j].x * rs * fg.x; o.y = x[j].y * rs * fg.y; o.z = x[j].z * rs * fg.z; o.w = x[j].w * rs * fg.w; *(float4*)(op + c) = o; } }
}

#define LAS __attribute__((address_space(3)))
typedef short bf16x8 __attribute__((ext_vector_type(8)));
typedef float f32x4 __attribute__((ext_vector_type(4)));
typedef unsigned u32x4 __attribute__((ext_vector_type(4)));
typedef unsigned u32x2 __attribute__((ext_vector_type(2)));

namespace L {
constexpr size_t A256(size_t x) { return (x + 255) & ~(size_t)255; }
constexpr size_t CTL = 0, CTL_BYTES = 1u << 20;
constexpr size_t H = CTL + CTL_BYTES;
constexpr size_t MOD = A256(H + (size_t)MROWS * D * 4);
constexpr size_t TABC = A256(MOD + 2 * 5 * 6144 * 4);
constexpr size_t TABS = A256(TABC + 4096 * 4);
constexpr size_t XN = A256(TABS + 4096 * 4);
constexpr size_t P = A256(XN + (size_t)MROWS * D * 2);
constexpr size_t MIX = A256(P + (size_t)MROWS * PP * 2);
constexpr size_t CQN = A256(MIX + (size_t)MROWS * D * 2);
constexpr size_t CKVN = A256(CQN + (size_t)MROWS * 256 * 2);
constexpr size_t QRAW = A256(CKVN + (size_t)MROWS * 128 * 2);
constexpr size_t KVRAW = A256(QRAW + (size_t)MROWS * 384 * 4);
constexpr size_t QL = A256(KVRAW + (size_t)MROWS * 512 * 4);
constexpr size_t QC = A256(QL + (size_t)16 * SEQ * 96 * 2);
constexpr size_t KB = A256(QC + (size_t)16 * CTX * 96 * 2);
constexpr size_t VB = A256(KB + (size_t)16 * NPOS * 96 * 2);
constexpr size_t LA = A256(VB + (size_t)16 * NPOS * 64 * 2);
constexpr size_t LB = A256(LA + (size_t)2 * MROWS * 256 * 4);
constexpr size_t HS = A256(LB + (size_t)2 * MROWS * 256 * 4);
constexpr size_t XCS = A256(HS + (size_t)2 * MROWS * 256 * 4);
constexpr size_t XCSC = A256(XCS + (size_t)4 * 8192 * 256 * 4);
constexpr size_t LIST = A256(XCSC + (size_t)4 * 512 * 256 * 4);
constexpr size_t GATE = A256(LIST + (size_t)2 * NE * LCAP * 4);
constexpr size_t ACT = A256(GATE + (size_t)NASG * 4);
constexpr size_t Y = A256(ACT + (size_t)ACT_ROWS * D * 2);
constexpr size_t WINT = A256(Y + (size_t)NASG * D * 2);
constexpr size_t WOUTT = A256(WINT + (size_t)2 * 2048 * 1024 * 2);
constexpr size_t WGUT = A256(WOUTT + (size_t)2 * 1024 * 1024 * 2);
constexpr size_t WDT = A256(WGUT + (size_t)2 * NE * 2048 * 1024 * 2);
constexpr size_t END = A256(WDT + (size_t)2 * NE * 1024 * 1024 * 2);
constexpr int CW_BAR = 4096;
constexpr int CW_CNT = 32768;
}

#define XB_TMO      128
#define XB_XCNT(j)  (256  + 64 * (j))
#define XB_XSUB(j)  (1280 + 64 * (j))
#define XB_XGEN(j)  (2304 + 64 * (j))
#define XB_TOP      3328
#define XB_TOPGEN   3392
#define XCD_BAR_WORDS 3456
#define XB_SPIN_CAP (1u << 18)
__device__ __forceinline__ unsigned xb_ld(unsigned* p)              { return __hip_atomic_load(p, __ATOMIC_RELAXED, __HIP_MEMORY_SCOPE_AGENT); }
__device__ __forceinline__ unsigned xb_add(unsigned* p, unsigned v) { return __hip_atomic_fetch_add(p, v, __ATOMIC_RELAXED, __HIP_MEMORY_SCOPE_AGENT); }
__device__ __forceinline__ unsigned xb_xcc_id() { return (unsigned)__builtin_amdgcn_s_getreg((3 << 11) | 20) & 0xFu; }
#define XB_SPIN(cond, bar) do { unsigned _sp = 0; while (cond) { __builtin_amdgcn_s_sleep(1); \
    if ((++_sp & 255u) == 0u) { if (xb_ld(&(bar)[XB_TMO])) break; if (_sp > XB_SPIN_CAP) { atomicAdd(&(bar)[XB_TMO], 1u); break; } } } } while (0)
struct XcdBarrier { unsigned* bar; unsigned x; volatile LAS unsigned* st; };
__device__ __forceinline__ XcdBarrier xcd_barrier_post(unsigned* bar, volatile LAS unsigned* st) {
    XcdBarrier b; b.bar = bar; b.x = xb_xcc_id(); b.st = st;
    if (threadIdx.x == 0) (void)xb_add(&bar[XB_XCNT(b.x)], 1u);
    return b;
}
__device__ __forceinline__ void xcd_barrier_complete(unsigned* bar, unsigned x, unsigned& nloc, unsigned& nx) {
    const unsigned G = gridDim.x * gridDim.y * gridDim.z;
    unsigned sum, cnt, mine, sp = 0u;
    for (;;) {
        sum = 0u; cnt = 0u; mine = 0u;
#pragma unroll
        for (unsigned j = 0; j < 16; ++j) { const unsigned c = xb_ld(&bar[XB_XCNT(j)]); sum += c; cnt += (c > 0u) ? 1u : 0u; mine = (j == x) ? c : mine; }
        if (sum == G) break;
        __builtin_amdgcn_s_sleep(1);
        if ((++sp & 255u) == 0u) { if (xb_ld(&bar[XB_TMO])) break; if (sp > XB_SPIN_CAP) { atomicAdd(&bar[XB_TMO], 1u); break; } }
    }
    nloc = mine > 0u ? mine : 1u; nx = cnt > 0u ? cnt : 1u;
}
__device__ __forceinline__ void xcd_barrier(const XcdBarrier& b) {
    asm volatile("s_waitcnt vmcnt(0)" ::: "memory");
    __syncthreads();
    if (threadIdx.x == 0) {
        unsigned* bar = b.bar;
        __builtin_amdgcn_s_waitcnt(0);
        unsigned nloc = b.st[0], nx = b.st[1];
        if (nloc == 0u) { xcd_barrier_complete(bar, b.x, nloc, nx); b.st[0] = nloc; b.st[1] = nx; }
        const unsigned old = xb_add(&bar[XB_XSUB(b.x)], 1u);
        const unsigned gen = old / nloc;
        if (old + 1u == (gen + 1u) * nloc) {
            __builtin_amdgcn_fence(__ATOMIC_RELEASE, "agent");
            asm volatile("s_waitcnt vmcnt(0)" ::: "memory");
            const unsigned og = xb_add(&bar[XB_TOP], 1u);
            const unsigned tg = og / nx;
            if (og + 1u == (tg + 1u) * nx) xb_add(&bar[XB_TOPGEN], 1u);
            else XB_SPIN(xb_ld(&bar[XB_TOPGEN]) == tg, bar);
            __builtin_amdgcn_fence(__ATOMIC_ACQUIRE, "agent");
            xb_add(&bar[XB_XGEN(b.x)], 1u);
            asm volatile("s_waitcnt vmcnt(0)" ::: "memory");
        } else {
            XB_SPIN(xb_ld(&bar[XB_XGEN(b.x)]) == gen, bar);
            __builtin_amdgcn_fence(__ATOMIC_ACQUIRE, "agent");
            asm volatile("s_waitcnt vmcnt(0)" ::: "memory");
        }
    }
    __syncthreads();
}

namespace g8 {
constexpr int BM = 256, BK = 64, HALF = 128, HTB = HALF * BK * 2, STAGE_BYTES = 8 * HTB, NXCD = 8, WGM = 8;
__device__ __forceinline__ int lds_byte(int r, int c) { const int st = (r >> 4) * 2 + (c >> 5), rr = r & 15, cc = c & 31, ob = rr * 64 + cc * 2; return st * 1024 + (ob ^ (((ob >> 9) & 1) << 5)); }
__device__ __forceinline__ void stage_rc(int b, int& R, int& C) { const int st = b / 1024, sb = b % 1024, swz = sb ^ (((sb >> 9) & 1) << 5); R = (st >> 1) * 16 + swz / 64; C = (st & 1) * 32 + (swz % 64) / 2; }
__device__ __forceinline__ int perm32(int rho) { const int n = rho >> 4, i = rho & 15; return 8 * (i >> 2) + 4 * n + (i & 3); }
__device__ __forceinline__ unsigned cvt_pk_bf16(float lo, float hi) { unsigned r; asm volatile("v_cvt_pk_bf16_f32 %0, %1, %2" : "=v"(r) : "v"(lo), "v"(hi)); return r; }
__device__ __forceinline__ int xcd_remap(int wgid, int nwg) { const int q = nwg / NXCD, r = nwg % NXCD, xcd = wgid % NXCD, off = wgid / NXCD; return (xcd < r ? xcd * (q + 1) : r * (q + 1) + (xcd - r) * q) + off; }

struct Unit { int row0, col0, ex, bt, nvalid, lrow; };

struct DenseSched {
    int nM, nN, nwg, G, c, lat_only; const char* Bt; int K; const int* list;
    __device__ __forceinline__ void init(int nM_, int nN_, int G_, int c_, int lat_only_, const void* Bt_, int K_) { nM = nM_; nN = nN_; nwg = nM * nN; G = G_; c = c_; lat_only = lat_only_; Bt = (const char*)Bt_; K = K_; list = nullptr; }
    __device__ __forceinline__ bool next(int i, Unit& u) const {
        const long Lx = (long)i * G + c; if (Lx >= nwg) return false;
        const int wgid = xcd_remap((int)Lx, nwg);
        const int nig = WGM * nN, gid = wgid / nig, fm = gid * WGM, gsz = (nM - fm) < WGM ? (nM - fm) : WGM;
        const int pm = fm + ((wgid % nig) % gsz), pn = (wgid % nig) / gsz;
        const int tile = lat_only ? (pm / 16) * 17 + 1 + (pm % 16) : pm;
        u.row0 = tile * 256; u.col0 = pn * 256; u.ex = 0; u.bt = pn; u.nvalid = 256; u.lrow = 0; return true;
    }
    __device__ __forceinline__ const char* bptr(const Unit& u) const { return Bt + (size_t)u.bt * 256 * K * 2; }
};
struct MoeSched {
    const LAS int* tpre; const LAS int* cnt; int NT, COLW, G, c, total; const char* Bt; int K; const int* list;
    __device__ __forceinline__ bool next(int i, Unit& u) const {
        const long Lx = (long)i * G + c; if (Lx >= total) return false;
        const int wgid = xcd_remap((int)Lx, total);
        int e = 0;
        for (int j = 1; j < NE; ++j) if (tpre[j] * NT <= wgid) e = j;
        const int t0 = tpre[e], mte = tpre[e + 1] - t0, loc = wgid - t0 * NT, nt = loc / mte, mt = loc % mte;
        u.ex = __builtin_amdgcn_readfirstlane(e); u.row0 = __builtin_amdgcn_readfirstlane((t0 + mt) * 256); u.col0 = __builtin_amdgcn_readfirstlane(nt * COLW);
        u.bt = __builtin_amdgcn_readfirstlane(e * NT + nt); const int nv = cnt[e] - mt * 256; u.nvalid = __builtin_amdgcn_readfirstlane(nv < 256 ? nv : 256); u.lrow = __builtin_amdgcn_readfirstlane(mt * 256);
        return true;
    }
    __device__ __forceinline__ const char* bptr(const Unit& u) const { return Bt + (size_t)u.bt * 256 * K * 2; }
};

struct EpiP {
    static constexpr bool PERM = true; bf16_t* O;
    __device__ __forceinline__ void operator()(const f32x4 (&acc)[2][2][4][2], const Unit& u, int wr, int wc, int fr, int fq, const LAS int*) const {
#pragma unroll
        for (int ai = 0; ai < 2; ++ai)
#pragma unroll
            for (int m = 0; m < 4; ++m) { bf16_t* rowp = O + (size_t)(u.row0 + ai * HALF + wr * 64 + m * 16 + fr) * PP + u.col0 + wc * 32 + 8 * fq;
#pragma unroll
                for (int bj = 0; bj < 2; ++bj) { const f32x4 v0 = acc[ai][bj][m][0], v1 = acc[ai][bj][m][1]; u32x4 w; w.x = cvt_pk_bf16(v0[0], v0[1]); w.y = cvt_pk_bf16(v0[2], v0[3]); w.z = cvt_pk_bf16(v1[0], v1[1]); w.w = cvt_pk_bf16(v1[2], v1[3]);
                    *(u32x4*)(rowp + bj * HALF) = w; } }
    }
};
struct EpiH {
    static constexpr bool PERM = false; float* Hh; const float* MODl; int g_off;
    __device__ __forceinline__ void operator()(const f32x4 (&acc)[2][2][4][2], const Unit& u, int wr, int wc, int fr, int fq, const LAS int*) const {
        const int tile = u.row0 >> 8, v = (tile % 17 == 0) ? 4 : tile / 17; const float* gp = MODl + (size_t)v * 6144 + g_off + u.col0 + wc * 32 + 4 * fq;
        f32x4 gv[2][2];
#pragma unroll
        for (int bj = 0; bj < 2; ++bj)
#pragma unroll
            for (int n = 0; n < 2; ++n) gv[bj][n] = *(const f32x4*)(gp + bj * HALF + n * 16);
#pragma unroll
        for (int ai = 0; ai < 2; ++ai)
#pragma unroll
            for (int m = 0; m < 4; ++m) { float* rowp = Hh + (size_t)(u.row0 + ai * HALF + wr * 64 + m * 16 + fr) * D + u.col0 + wc * 32 + 4 * fq;
#pragma unroll
                for (int bj = 0; bj < 2; ++bj)
#pragma unroll
                    for (int n = 0; n < 2; ++n) { f32x4* p = (f32x4*)(rowp + bj * HALF + n * 16); *p = *p + gv[bj][n] * acc[ai][bj][m][n]; } }
    }
};
struct EpiMoe1 {
    static constexpr bool PERM = true; bf16_t* ACTp; const float* bgu;
    __device__ __forceinline__ void operator()(const f32x4 (&acc)[2][2][4][2], const Unit& u, int wr, int wc, int fr, int fq, const LAS int*) const {
        const int cc = u.col0 + wc * 32 + 8 * fq; const float* bp = bgu + (size_t)u.ex * 2048 + cc;
        f32x4 bg[2], bu[2];
#pragma unroll
        for (int n = 0; n < 2; ++n) { bg[n] = *(const f32x4*)(bp + 4 * n); bu[n] = *(const f32x4*)(bp + 1024 + 4 * n); }
#pragma unroll
        for (int ai = 0; ai < 2; ++ai)
#pragma unroll
            for (int m = 0; m < 4; ++m) { const int r = ai * HALF + wr * 64 + m * 16 + fr;
                float o[8];
#pragma unroll
                for (int n = 0; n < 2; ++n)
#pragma unroll
                    for (int i = 0; i < 4; ++i) { const float g = fminf(acc[ai][0][m][n][i] + bg[n][i], 7.f); const float uu = fminf(fmaxf(acc[ai][1][m][n][i] + bu[n][i], -7.f), 7.f);
                        o[n * 4 + i] = (uu + 1.f) * g * __builtin_amdgcn_rcpf(1.f + __expf(-1.702f * g)); }
                if (r < u.nvalid) { u32x4 w; w.x = cvt_pk_bf16(o[0], o[1]); w.y = cvt_pk_bf16(o[2], o[3]); w.z = cvt_pk_bf16(o[4], o[5]); w.w = cvt_pk_bf16(o[6], o[7]);
                    *(u32x4*)(ACTp + (size_t)(u.row0 + r) * D + cc) = w; } }
    }
};
struct EpiMoe2 {
    static constexpr bool PERM = true; bf16_t* Yp; const float* bd; const float* GATEp;
    __device__ __forceinline__ void operator()(const f32x4 (&acc)[2][2][4][2], const Unit& u, int wr, int wc, int fr, int fq, const LAS int* rows) const {
        const int cc = u.col0 + wc * 32 + 8 * fq; const float* bp = bd + (size_t)u.ex * 1024 + cc;
        f32x4 bv[2][2];
#pragma unroll
        for (int bj = 0; bj < 2; ++bj)
#pragma unroll
            for (int n = 0; n < 2; ++n) bv[bj][n] = *(const f32x4*)(bp + bj * HALF + 4 * n);
#pragma unroll
        for (int ai = 0; ai < 2; ++ai)
#pragma unroll
            for (int m = 0; m < 4; ++m) { const int r = ai * HALF + wr * 64 + m * 16 + fr;
                if (r < u.nvalid) { const int asg = rows[r]; const float gt = GATEp[asg]; bf16_t* rowp = Yp + (size_t)asg * D + cc;
#pragma unroll
                    for (int bj = 0; bj < 2; ++bj) { const f32x4 v0 = (acc[ai][bj][m][0] + bv[bj][0]) * gt, v1 = (acc[ai][bj][m][1] + bv[bj][1]) * gt;
                        u32x4 w; w.x = cvt_pk_bf16(v0[0], v0[1]); w.y = cvt_pk_bf16(v0[2], v0[3]); w.z = cvt_pk_bf16(v1[0], v1[1]); w.w = cvt_pk_bf16(v1[2], v1[3]); *(u32x4*)(rowp + bj * HALF) = w; } } }
    }
};

template <class Epi, class Sched, bool GATHER, bool ROWLIST>
__device__ __forceinline__ void gemm_phase(LAS unsigned char* lds, const char* Abase, const int K, const Sched& S, const Epi& E) {
    int tid_l = threadIdx.x; asm volatile("" : "+v"(tid_l));
    const int tid = tid_l, wid = __builtin_amdgcn_readfirstlane(tid >> 6), lane = tid & 63, wr = wid >> 2, wc = wid & 3, fr = lane & 15, fq = lane >> 4;
    const int nt = K / BK; const unsigned Kb = (unsigned)K * 2u;
    int sR[2]; unsigned sC[2], voffB[2];
#pragma unroll
    for (int i = 0; i < 2; ++i) { int R, C; stage_rc(tid * 16 + i * 8192, R, C); sR[i] = R; sC[i] = (unsigned)C * 2u; const int Rb = Epi::PERM ? ((R & ~31) + perm32(R & 31)) : R; voffB[i] = (unsigned)(Rb * K + C) * 2u; }
    const size_t kstep = (size_t)(BK * 2), hstep = (size_t)HALF * K * 2;
    const unsigned ldsw = (unsigned)wid * 1024u;
    const int aoff = lds_byte(wr * 64 + fr, fq * 8), boff = lds_byte(wc * 32 + fr, fq * 8);
    LAS int* rowbuf = (LAS int*)(lds + STAGE_BYTES);
#define G8_SA(b, h) (((b) * 2 + (h)) * HTB)
#define G8_SB(b, h) ((4 + (b) * 2 + (h)) * HTB)
#define G8_STAGE_A(bufoff, kb, v) do { _Pragma("unroll") for (int _i = 0; _i < 2; ++_i) \
        __builtin_amdgcn_global_load_lds((const unsigned*)((kb) + (size_t)(v)[_i]), (LAS unsigned*)(lds + (bufoff) + ldsw + _i * 8192), 16, 0, 0); } while (0)
#define G8_STAGE_B(bufoff, gbase) do { _Pragma("unroll") for (int _i = 0; _i < 2; ++_i) \
        __builtin_amdgcn_global_load_lds((const unsigned*)((gbase) + voffB[_i]), (LAS unsigned*)(lds + (bufoff) + ldsw + _i * 8192), 16, 0, 0); } while (0)
#define G8_LDA(dst, b, h) do { _Pragma("unroll") for (int m = 0; m < 4; ++m) _Pragma("unroll") for (int k = 0; k < 2; ++k) dst[m][k] = *(const LAS bf16x8*)(lds + G8_SA(b, h) + aoff + m * 2048 + k * 1024); } while (0)
#define G8_LDB(dst, b, h) do { _Pragma("unroll") for (int n = 0; n < 2; ++n) _Pragma("unroll") for (int k = 0; k < 2; ++k) dst[n][k] = *(const LAS bf16x8*)(lds + G8_SB(b, h) + boff + n * 2048 + k * 1024); } while (0)
#define G8_MMA(ai, bj, At, Bt) do { __builtin_amdgcn_s_setprio(1); _Pragma("unroll") for (int m = 0; m < 4; ++m) _Pragma("unroll") for (int n = 0; n < 2; ++n) _Pragma("unroll") for (int k = 0; k < 2; ++k) \
        acc[ai][bj][m][n] = __builtin_amdgcn_mfma_f32_16x16x32_bf16(Bt[n][k], At[m][k], acc[ai][bj][m][n], 0, 0, 0); __builtin_amdgcn_s_setprio(0); } while (0)
#define G8_WAIT_V(n) asm volatile("s_waitcnt vmcnt(" #n ")" ::: "memory")
#define G8_WAIT_L(n) asm volatile("s_waitcnt lgkmcnt(" #n ")" ::: "memory")
#define G8_BAR __builtin_amdgcn_s_barrier()
#define G8_SCHED __builtin_amdgcn_sched_barrier(0)
#define G8_LISTDMA(u, s) do { if (wid < 4) __builtin_amdgcn_global_load_lds((const unsigned*)(S.list + (size_t)(u).ex * LCAP + (u).lrow + wid * 64 + lane), (LAS unsigned*)(rowbuf + (s) * 256 + wid * 64), 4, 0, 0); } while (0)
#define G8_ROWS_DENSE(v) do { _Pragma("unroll") for (int _h = 0; _h < 2; ++_h) _Pragma("unroll") for (int _i = 0; _i < 2; ++_i) (v)[_h][_i] = (unsigned)(_h * HALF + sR[_i]) * Kb + sC[_i]; } while (0)
#define G8_ROWS_LIST(v, u, s) do { _Pragma("unroll") for (int _h = 0; _h < 2; ++_h) _Pragma("unroll") for (int _i = 0; _i < 2; ++_i) { const int _r = _h * HALF + sR[_i]; const int _a = rowbuf[(s) * 256 + _r]; \
        (v)[_h][_i] = (unsigned)(_r < (u).nvalid ? (_a >> 2) : 0) * Kb + sC[_i]; } } while (0)
    Unit cur, nxt; int ui = 0, slot = 0;
    if (!S.next(0, cur)) return;
    unsigned vA[2][2];
    if constexpr (ROWLIST) { G8_LISTDMA(cur, 0); G8_WAIT_V(0); G8_BAR; }
    if constexpr (GATHER) { G8_ROWS_LIST(vA, cur, 0); } else { G8_ROWS_DENSE(vA); }
    f32x4 acc[2][2][4][2];
#pragma unroll
    for (int a = 0; a < 2; ++a)
#pragma unroll
        for (int b = 0; b < 2; ++b)
#pragma unroll
            for (int m = 0; m < 4; ++m)
#pragma unroll
                for (int n = 0; n < 2; ++n) acc[a][b][m][n] = (f32x4){0.f, 0.f, 0.f, 0.f};
    bf16x8 At[4][2], B0[2][2], B1[2][2];
    const char* cB = S.bptr(cur);
    const char* cA = GATHER ? Abase : Abase + (size_t)cur.row0 * Kb;
    G8_STAGE_B(G8_SB(0, 0), cB); G8_STAGE_B(G8_SB(0, 1), cB + hstep); G8_STAGE_A(G8_SA(0, 0), cA, vA[0]); G8_STAGE_A(G8_SA(0, 1), cA, vA[1]);
    if (wr == 1) G8_BAR;
    G8_WAIT_V(2); G8_BAR;
    G8_STAGE_B(G8_SB(1, 0), cB + kstep); G8_STAGE_A(G8_SA(1, 0), cA + kstep, vA[0]); G8_STAGE_B(G8_SB(1, 1), cB + hstep + kstep);
    G8_WAIT_V(6); G8_BAR;
    for (;;) {
        const bool has_next = S.next(ui + 1, nxt);
        const char* nB = has_next ? S.bptr(nxt) : cB;
        const char* nA = (GATHER || !has_next) ? cA : Abase + (size_t)nxt.row0 * Kb;
        const int nslot = slot == 2 ? 0 : slot + 1;
        if constexpr (ROWLIST) { if (has_next) G8_LISTDMA(nxt, nslot); }
        for (int t = 0; t < nt; t += 2) {
            const bool last = (t == nt - 2);
            const char* a1 = cA + (size_t)(t + 1) * kstep;
            const char* a2 = last ? nA : cA + (size_t)(t + 2) * kstep; const char* b2 = last ? nB : cB + (size_t)(t + 2) * kstep;
            const char* a3 = a2 + kstep; const char* b3 = b2 + kstep;
            G8_LDB(B0, 0, 0); G8_LDB(B1, 0, 1); G8_SCHED; G8_LDA(At, 0, 0); G8_STAGE_A(G8_SA(1, 1), a1, vA[1]);
            if constexpr (GATHER) { if (last && has_next) { G8_ROWS_LIST(vA, nxt, nslot); } }
            G8_WAIT_V(8); G8_WAIT_L(0); G8_BAR; G8_MMA(0, 0, At, B0); G8_MMA(0, 1, At, B1); G8_BAR; G8_SCHED;
            G8_LDA(At, 0, 1); G8_STAGE_B(G8_SB(0, 0), b2); G8_STAGE_B(G8_SB(0, 1), b2 + hstep); G8_STAGE_A(G8_SA(0, 0), a2, vA[0]);
            G8_WAIT_V(8); G8_WAIT_L(0); G8_BAR; G8_MMA(1, 0, At, B0); G8_MMA(1, 1, At, B1); G8_BAR; G8_SCHED;
            G8_LDB(B0, 1, 0); G8_LDB(B1, 1, 1); G8_SCHED; G8_LDA(At, 1, 0); G8_STAGE_A(G8_SA(0, 1), a2, vA[1]);
            G8_WAIT_V(8); G8_WAIT_L(0); G8_BAR; G8_MMA(0, 0, At, B0); G8_MMA(0, 1, At, B1); G8_BAR; G8_SCHED;
            G8_LDA(At, 1, 1); G8_STAGE_B(G8_SB(1, 0), b3); G8_STAGE_B(G8_SB(1, 1), b3 + hstep); G8_STAGE_A(G8_SA(1, 0), a3, vA[0]);
            G8_WAIT_V(8); G8_WAIT_L(0); G8_BAR; G8_MMA(1, 0, At, B0); G8_MMA(1, 1, At, B1); G8_BAR; G8_SCHED;
        }
        if (wr == 0) G8_BAR;
        E(acc, cur, wr, wc, fr, fq, rowbuf + slot * 256);
        if (!has_next) break;
#pragma unroll
        for (int a = 0; a < 2; ++a)
#pragma unroll
            for (int b = 0; b < 2; ++b)
#pragma unroll
                for (int m = 0; m < 4; ++m)
#pragma unroll
                    for (int n = 0; n < 2; ++n) acc[a][b][m][n] = (f32x4){0.f, 0.f, 0.f, 0.f};
        cur = nxt; cB = nB; cA = nA; ++ui; slot = nslot;
        if (wr == 1) G8_BAR;
    }
    G8_WAIT_V(0);
    G8_BAR;
#undef G8_SA
#undef G8_SB
#undef G8_STAGE_A
#undef G8_STAGE_B
#undef G8_LDA
#undef G8_LDB
#undef G8_MMA
#undef G8_WAIT_V
#undef G8_WAIT_L
#undef G8_BAR
#undef G8_SCHED
#undef G8_LISTDMA
#undef G8_ROWS_DENSE
#undef G8_ROWS_LIST
}
}

constexpr int NWAVES = 8, RING_BYTES = 131072 + 3072, LDSCTL_OFF = RING_BYTES, MISC_OFF = LDSCTL_OFF + 64, META_OFF = MISC_OFF + 64, LDS_BYTES = 147456;
enum { PH_PRO0 = 0, PH_PRO1 = 1, PH_L0 = 2, PH_PER_LAYER = 8, PH_N = 18 };
enum { PL_WIN = 0, PL_PREP = 1, PL_MIX = 2, PL_WOUT = 3, PL_ROUTE = 4, PL_MOE1 = 5, PL_MOE2 = 6, PL_COMB = 7 };
struct MArgs { const float* in[30]; float* out; unsigned char* ws; int ph_lo, ph_hi; };

__device__ __forceinline__ unsigned pk2(float lo, float hi) { return (unsigned)f2bf(lo) | ((unsigned)f2bf(hi) << 16); }
__device__ __forceinline__ void transpose_item(const float* W, int K, int N, bf16_t* WT, int drow0, LAS float* scr, int k0, int n0, int lane) {
#pragma unroll 8
    for (int i = 0; i < 32; ++i) { const int kk = 2 * i + (lane >> 5); scr[kk * 33 + (lane & 31)] = W[(size_t)(k0 + kk) * N + n0 + (lane & 31)]; }
    asm volatile("s_waitcnt lgkmcnt(0)" ::: "memory");
    const int c = lane & 7;
#pragma unroll
    for (int j = 0; j < 4; ++j) { const int n = (lane >> 3) + 8 * j; const LAS float* s = scr + (8 * c) * 33 + n;
        u32x4 o; o.x = pk2(s[0 * 33], s[1 * 33]); o.y = pk2(s[2 * 33], s[3 * 33]); o.z = pk2(s[4 * 33], s[5 * 33]); o.w = pk2(s[6 * 33], s[7 * 33]);
        *(u32x4*)(WT + (size_t)(drow0 + n) * K + k0 + 8 * c) = o; }
    asm volatile("s_waitcnt lgkmcnt(0)" ::: "memory");
}

__global__ void __launch_bounds__(NWAVES * 64, 2) mega(MArgs args) {
    extern __shared__ __attribute__((aligned(16))) unsigned char lds_raw[];
    LAS unsigned char* lds = (LAS unsigned char*)lds_raw;
    const int tid = threadIdx.x, lane = tid & 63, wave = __builtin_amdgcn_readfirstlane(tid >> 6);
    const int G = gridDim.x, bx = blockIdx.x;
    const int vcu = (G % 8 == 0) ? (bx % 8) * (G / 8) + bx / 8 : bx;
    unsigned char* ws = args.ws;
    unsigned* ctl = (unsigned*)(ws + L::CTL);
    for (int u = tid; u < (LDS_BYTES - LDSCTL_OFF) / 4; u += NWAVES * 64) ((LAS unsigned*)(lds + LDSCTL_OFF))[u] = 0u;
    __syncthreads();
    volatile LAS unsigned* MISC = (volatile LAS unsigned*)(lds + MISC_OFF);
    LAS int* META = (LAS int*)(lds + META_OFF);
    XcdBarrier bar = xcd_barrier_post(ctl + L::CW_BAR, MISC);
    const int lo = args.ph_lo, hi = args.ph_hi;

    for (int ph = lo; ph < hi; ++ph) {
        if (ph > lo) xcd_barrier(bar);
        if (ph == PH_PRO0) {
            LAS float* scr = (LAS float*)(lds + wave * 16384);
            const int gw = vcu * NWAVES + wave, NGW = G * NWAVES;
            constexpr int I_IN = 16 * 61, I_OUT = 16 * 32, I_GU = NE * 16 * 64, I_DN = NE * 16 * 32, I_L = I_IN + I_OUT + I_GU + I_DN;
            for (int it = gw; it < 2 * I_L; it += NGW) {
                const int l = it / I_L; int r = it % I_L;
                if (r < I_IN) { const int kb = r / 61, nb = r % 61; transpose_item(args.in[8] + (size_t)l * D * PT, D, PT, (bf16_t*)(ws + L::WINT) + (size_t)l * 2048 * D, 32 * nb, scr, 64 * kb, 32 * nb, lane); continue; } r -= I_IN;
                if (r < I_OUT) { const int kb = r / 32, nb = r % 32; transpose_item(args.in[22] + (size_t)l * D * D, D, D, (bf16_t*)(ws + L::WOUTT) + (size_t)l * D * D, 32 * nb, scr, 64 * kb, 32 * nb, lane); continue; } r -= I_OUT;
                if (r < I_GU) { const int e = r / (16 * 64), q = r % (16 * 64), kb = q / 64, nb = q % 64; const int n0 = 32 * nb; const int c2 = n0 & 1023; const int drow = (c2 >> 7) * 256 + (n0 >> 10) * 128 + (c2 & 127);
                    transpose_item(args.in[25] + ((size_t)l * NE + e) * D * 2048, D, 2048, (bf16_t*)(ws + L::WGUT) + ((size_t)l * NE + e) * 2048 * D, drow, scr, 64 * kb, n0, lane); continue; } r -= I_GU;
                { const int e = r / (16 * 32), q = r % (16 * 32), kb = q / 32, nb = q % 32;
                    transpose_item(args.in[27] + ((size_t)l * NE + e) * D * D, D, D, (bf16_t*)(ws + L::WDT) + ((size_t)l * NE + e) * D * D, 32 * nb, scr, 64 * kb, 32 * nb, lane); }
            }
            for (int i = bx * 512 + tid; i < 2 * 96 * D / 8; i += G * 512) { const int l = i / (96 * D / 8), q = i % (96 * D / 8); *(u32x4*)((bf16_t*)(ws + L::WINT) + ((size_t)l * 2048 + PT) * D + (size_t)q * 8) = (u32x4){0u, 0u, 0u, 0u}; }
            continue;
        }
        if (ph < PH_L0) continue;
        const int l = (ph - PH_L0) / PH_PER_LAYER, pl = (ph - PH_L0) % PH_PER_LAYER;
        const float* MODl = (const float*)(ws + L::MOD) + (size_t)l * 5 * 6144;
        if (pl == PL_WIN) {
            g8::DenseSched S; S.init(MROWS / 256, PP / 256, G, bx, 0, (const bf16_t*)(ws + L::WINT) + (size_t)l * 2048 * D, D);
            g8::EpiP E{(bf16_t*)(ws + L::P)};
            g8::gemm_phase<g8::EpiP, g8::DenseSched, false, false>(lds, (const char*)(ws + L::XN), D, S, E);
        } else if (pl == PL_WOUT) {
            g8::DenseSched S; S.init(l == 0 ? MROWS / 256 : 64, D / 256, G, bx, l == 0 ? 0 : 1, (const bf16_t*)(ws + L::WOUTT) + (size_t)l * D * D, D);
            g8::EpiH E{(float*)(ws + L::H), MODl, 2048};
            g8::gemm_phase<g8::EpiH, g8::DenseSched, false, false>(lds, (const char*)(ws + L::MIX), D, S, E);
        } else if (pl == PL_MOE1 || pl == PL_MOE2) {
            const int* CNTg = (const int*)(ctl + L::CW_CNT) + l * NE;
            if (tid == 0) { int o = 0; for (int e = 0; e < NE; ++e) { const int cn = CNTg[e]; META[e] = o; META[64 + e] = cn; o += (cn + 255) >> 8; } META[NE] = o; }
            __syncthreads();
            g8::MoeSched S; S.tpre = META; S.cnt = META + 64; S.G = G; S.c = bx; S.K = D; S.list = (const int*)(ws + L::LIST) + (size_t)l * NE * LCAP;
            if (pl == PL_MOE1) {
                S.NT = 8; S.COLW = 128; S.total = __builtin_amdgcn_readfirstlane(META[NE]) * 8; S.Bt = (const char*)((const bf16_t*)(ws + L::WGUT) + (size_t)l * NE * 2048 * D);
                g8::EpiMoe1 E{(bf16_t*)(ws + L::ACT), args.in[26] + (size_t)l * NE * 2048};
                g8::gemm_phase<g8::EpiMoe1, g8::MoeSched, true, true>(lds, (const char*)(ws + L::XN), D, S, E);
            } else {
                S.NT = 4; S.COLW = 256; S.total = __builtin_amdgcn_readfirstlane(META[NE]) * 4; S.Bt = (const char*)((const bf16_t*)(ws + L::WDT) + (size_t)l * NE * D * D);
                g8::EpiMoe2 E{(bf16_t*)(ws + L::Y), args.in[28] + (size_t)l * NE * D, (const float*)(ws + L::GATE)};
                g8::gemm_phase<g8::EpiMoe2, g8::MoeSched, false, true>(lds, (const char*)(ws + L::ACT), D, S, E);
            }
            __syncthreads();
        }
    }
}
extern "C" void kernel_launch(void* const* d_in, const int* in_sizes, int n_in, void* d_out, int out_size, void* d_ws, size_t ws_size, hipStream_t stream) {
    const float* x = (const float*)d_in[0]; const float* c = (const float*)d_in[1]; const float* ctx = (const float*)d_in[2]; const float* c_ctx = (const float*)d_in[3];
    const float* mod_w = (const float*)d_in[4]; const float* mod_b = (const float*)d_in[5]; const float* norm1_g = (const float*)d_in[6]; const float* norm2_g = (const float*)d_in[7];
    const float* lru_conv_w = (const float*)d_in[9]; const float* lru_conv_b = (const float*)d_in[10]; const float* lru_w_a = (const float*)d_in[11];
    const float* lru_b_a = (const float*)d_in[12]; const float* lru_w_i = (const float*)d_in[13]; const float* lru_b_i = (const float*)d_in[14]; const float* lru_lambda = (const float*)d_in[15];
    const float* q_norm_g = (const float*)d_in[16]; const float* w_uq = (const float*)d_in[17]; const float* kv_norm_g = (const float*)d_in[18]; const float* w_ukv = (const float*)d_in[19];
    const float* sc_conv_w = (const float*)d_in[20]; const float* sc_conv_b = (const float*)d_in[21]; const float* router_w = (const float*)d_in[23];
    const float* router_b = (const float*)d_in[24]; const float* final_g = (const float*)d_in[29];
    float* out = (float*)d_out;
    unsigned char* p = (unsigned char*)d_ws;
    if (L::END > ws_size) { fprintf(stderr, "kernel_launch: workspace too small: need %zu have %zu\n", (size_t)L::END, ws_size); return; }
    static bool attr_done = false;
    if (!attr_done) { (void)hipFuncSetAttribute((const void*)mega, hipFuncAttributeMaxDynamicSharedMemorySize, LDS_BYTES); attr_done = true; }
    WS w;
    w.H = (float*)(p + L::H); w.MOD = (float*)(p + L::MOD); w.TABC = (float*)(p + L::TABC); w.TABS = (float*)(p + L::TABS); w.XN = (bf16_t*)(p + L::XN); w.P = (bf16_t*)(p + L::P); w.MIX = (bf16_t*)(p + L::MIX);
    w.CQN = (bf16_t*)(p + L::CQN); w.CKVN = (bf16_t*)(p + L::CKVN); w.QRAW = (float*)(p + L::QRAW); w.KVRAW = (float*)(p + L::KVRAW); w.QL = (bf16_t*)(p + L::QL); w.QC = (bf16_t*)(p + L::QC);
    w.KB = (bf16_t*)(p + L::KB); w.VB = (bf16_t*)(p + L::VB); w.LA = (float*)(p + L::LA); w.LB = (float*)(p + L::LB); w.HS = (float*)(p + L::HS); w.XCS = (float*)(p + L::XCS); w.XCSC = (float*)(p + L::XCSC);
    w.CNT = (int*)(p + L::CTL) + L::CW_CNT; w.OFFS = nullptr; w.LIST = (int*)(p + L::LIST); w.GATE = (float*)(p + L::GATE); w.ACT = (bf16_t*)(p + L::ACT); w.Y = (bf16_t*)(p + L::Y);
    MArgs a{};
    for (int i = 0; i < 30; ++i) a.in[i] = (const float*)d_in[i];
    a.out = out; a.ws = p;
    auto run_mega = [&](int lo, int hi) { a.ph_lo = lo; a.ph_hi = hi; hipLaunchKernelGGL(mega, dim3(256), dim3(512), LDS_BYTES, stream, a); };

    (void)hipMemsetAsync(p + L::CTL, 0, L::CTL_BYTES, stream);
    k_init<<<2048, 256, 0, stream>>>(x, ctx, w.H, w.TABC, w.TABS);
    k_mod<<<48, 256, 0, stream>>>(c, c_ctx, mod_w, mod_b, w.MOD);
    run_mega(PH_PRO0, PH_PRO0 + 1);
    for (int l = 0; l < 2; ++l) {
        const bool wctx = (l == 0); const float* MODl = w.MOD + (size_t)l * 5 * 6144; const int pb = PH_L0 + l * PH_PER_LAYER;
        k_norm_mod<<<MROWS / 4, 256, 0, stream>>>(w.H, norm1_g + l * D, MODl, 0, 1024, w.XN);
        run_mega(pb + PL_WIN, pb + PL_WIN + 1);
        k_four_ch<<<MROWS, 256, 0, stream>>>(w.P, w.TABC, w.TABS, w.XCS, w.XCSC, wctx ? 1 : 0);
        k_gemm<ALDft, EPDft, 1><<<dim3(4, SEQ / 64, 4), 256, 0, stream>>>(ALDft{w.TABC, w.TABS, 4096, 1}, w.XCS, 256, (long)8192 * 256, 256, 8192, 0, EPDft{w.MIX, CTX, 1.f / 512.f});
        if (wctx) k_gemm<ALDft, EPDft, 1><<<dim3(4, CTX / 64, 4), 256, 0, stream>>>(ALDft{w.TABC, w.TABS, 256, 16}, w.XCSC, 256, (long)512 * 256, 256, 512, 0, EPDft{w.MIX, 0, 1.f / 128.f});
        k_lru_gates<<<dim3(MROWS / 16, 2), 256, 0, stream>>>(w.P, lru_conv_w + (size_t)l * 2 * 4 * 256, lru_conv_b + l * 512, lru_w_a + (size_t)l * 2 * 4 * 64 * 64, lru_b_a + l * 512,
                                                          lru_w_i + (size_t)l * 2 * 4 * 64 * 64, lru_b_i + l * 512, lru_lambda + l * 512, w.LA, w.LB);
        k_lru_scan<<<dim3(4, 2), 256, 0, stream>>>(w.LA, w.LB, w.HS);
        k_lru_sc_out<<<MROWS, 256, 0, stream>>>(w.P, w.HS, sc_conv_w + l * 768, sc_conv_b + l * 256, w.MIX);
        k_lat_norm<<<MROWS / 4, 256, 0, stream>>>(w.P, q_norm_g + l * 256, kv_norm_g + l * 128, w.CQN, w.CKVN);
        k_gemm<ALBf16, EPF32, 1><<<dim3(384 / 64, MROWS / 64, 1), 256, 0, stream>>>(ALBf16{w.CQN, 256}, w_uq + (size_t)l * 256 * 384, 384, 0, 384, 256, 0, EPF32{w.QRAW, 384});
        k_gemm<ALBf16, EPF32, 1><<<dim3(512 / 64, MROWS / 64, 1), 256, 0, stream>>>(ALBf16{w.CKVN, 128}, w_ukv + (size_t)l * 128 * 512, 512, 0, 512, 128, 0, EPF32{w.KVRAW, 512});
        k_qkv_finish<<<MROWS, 256, 0, stream>>>(w.QRAW, w.KVRAW, w.P, w.QL, w.QC, w.KB, w.VB, wctx ? 1 : 0);
        k_attn<<<dim3(SEQ / 256, 16), 256, 0, stream>>>(w.QL, SEQ, w.KB, w.VB, NPOS, w.MIX, CTX);
        if (wctx) k_attn<<<dim3(1, 16), 256, 0, stream>>>(w.QC, CTX, w.KB, w.VB, CTX, w.MIX, 0);
        run_mega(pb + PL_WOUT, pb + PL_WOUT + 1);
        int* CNT = w.CNT + l * NE; int* LIST = w.LIST + (size_t)l * NE * LCAP;
        k_norm2_route<<<MROWS / 4, 256, 0, stream>>>(w.H, norm2_g + l * D, MODl, router_w + (size_t)l * D * NE, router_b + l * NE, w.XN, CNT, LIST, w.GATE, wctx ? 0 : 1);
        run_mega(pb + PL_MOE1, pb + PL_MOE1 + 1);
        run_mega(pb + PL_MOE2, pb + PL_MOE2 + 1);
        k_moe_combine<<<MROWS / 4, 256, 0, stream>>>(w.H, w.Y, MODl, wctx ? 0 : 1, l == 1 ? final_g : nullptr, l == 1 ? out : nullptr);
    }
}
```

```cpp
#include <hip/hip_runtime.h>
#include <cstdint>
#include <cstdio>

typedef unsigned short bf16_t;
constexpr int NB_ = 4, SEQ = 4096, CTX = 256, D = 1024, NPOS = SEQ + CTX, MROWS = NB_ * NPOS;
constexpr int PT = 1952, PP = 2048;
constexpr int NE = 32, TOPK = 4, LCAP = MROWS;
constexpr int NASG = MROWS * TOPK;
constexpr int ACT_ROWS = NASG + NE * 256;
constexpr int C_FN = 0, C_LX = 256, C_LG = 512, C_CQ = 768, C_CKV = 1024, C_KR = 1152, C_SX = 1184, C_SB = 1440, C_SC = 1696;

__device__ __forceinline__ float bf2f(bf16_t v) { return __uint_as_float((unsigned)v << 16); }
__device__ __forceinline__ bf16_t f2bf(float f) { unsigned u = __float_as_uint(f); return (bf16_t)((u + 0x7fffu + ((u >> 16) & 1u)) >> 16); }
__device__ __forceinline__ float wave_sum(float v) {
#pragma unroll
    for (int o = 1; o < 64; o <<= 1) v += __shfl_xor(v, o);
    return v;
}
__device__ __forceinline__ float sigmoidf_(float x) { return 1.f / (1.f + __expf(-x)); }
__device__ __forceinline__ float gelu_tanh(float x) { const float u = 0.7978845608028654f * (x + 0.044715f * x * x * x); return 0.5f * x * (1.f + tanhf(u)); }

struct WS {
    float* H; float* MOD; float* TABC; float* TABS; bf16_t* XN; bf16_t* P; bf16_t* MIX; bf16_t* CQN; bf16_t* CKVN; float* QRAW; float* KVRAW;
    bf16_t* QL; bf16_t* QC; bf16_t* KB; bf16_t* VB; float* LA; float* LB; float* HS; float* XCS; float* XCSC;
    int* CNT; int* OFFS; int* LIST; float* GATE; bf16_t* ACT; bf16_t* Y;
};

__global__ void k_init(const float* x, const float* ctx, float* H, float* TABC, float* TABS) {
    const size_t n4 = (size_t)MROWS * D / 4;
    for (size_t i = (size_t)blockIdx.x * blockDim.x + threadIdx.x; i < n4; i += (size_t)gridDim.x * blockDim.x) {
        const size_t e = i * 4; const int r = (int)(e / D), c = (int)(e % D); const int b = r / NPOS, pos = r % NPOS;
        const float4 v = pos < CTX ? *(const float4*)(ctx + ((size_t)b * CTX + pos) * D + c) : *(const float4*)(x + ((size_t)b * SEQ + (pos - CTX)) * D + c);
        *(float4*)(H + e) = v;
    }
    const int t = blockIdx.x * blockDim.x + threadIdx.x;
    if (t < 4096) { float s, c; sincospif((float)t / 2048.f, &s, &c); TABC[t] = c; TABS[t] = s; }
}

__global__ __launch_bounds__(256) void k_mod(const float* c, const float* c_ctx, const float* mod_w, const float* mod_b, float* MOD) {
    __shared__ float s[5][1024];
    for (int i = threadIdx.x; i < 5 * 1024; i += 256) { const int v = i >> 10, k = i & 1023; const float x = v < 4 ? c[v * 1024 + k] : c_ctx[k]; s[v][k] = x / (1.f + __expf(-x)); }
    __syncthreads();
    const int idx = blockIdx.x * 256 + threadIdx.x; const int l = idx / 6144, col = idx % 6144;
    const float* W = mod_w + (size_t)l * 1024 * 6144 + col;
    float a0 = 0, a1 = 0, a2 = 0, a3 = 0, a4 = 0;
#pragma unroll 8
    for (int k = 0; k < 1024; ++k) { const float w = W[(size_t)k * 6144]; a0 += s[0][k] * w; a1 += s[1][k] * w; a2 += s[2][k] * w; a3 += s[3][k] * w; a4 += s[4][k] * w; }
    const float bb = mod_b[l * 6144 + col];
    float* M = MOD + (size_t)l * 5 * 6144 + col;
    M[0] = a0 + bb; M[6144] = a1 + bb; M[2 * 6144] = a2 + bb; M[3 * 6144] = a3 + bb; M[4 * 6144] = a4 + bb;
}

__global__ __launch_bounds__(256) void k_norm_mod(const float* H, const float* g, const float* MODl, int sh_off, int sc_off, bf16_t* XN) {
    const int lane = threadIdx.x & 63, r = blockIdx.x * 4 + (threadIdx.x >> 6);
    const int b = r / NPOS, pos = r % NPOS, v = pos < CTX ? 4 : b;
    const float* mv = MODl + (size_t)v * 6144;
    float4 x[4]; float ss = 0.f;
#pragma unroll
    for (int j = 0; j < 4; ++j) { x[j] = *(const float4*)(H + (size_t)r * D + (j * 64 + lane) * 4); ss += x[j].x * x[j].x + x[j].y * x[j].y + x[j].z * x[j].z + x[j].w * x[j].w; }
    const float rs = rsqrtf(wave_sum(ss) * (1.f / D) + 1e-6f);
#pragma unroll
    for (int j = 0; j < 4; ++j) { const int c = (j * 64 + lane) * 4; const float4 gg = *(const float4*)(g + c), sh = *(const float4*)(mv + sh_off + c), sc = *(const float4*)(mv + sc_off + c);
        ushort4 o; o.x = f2bf(x[j].x * rs * gg.x * (1.f + sc.x) + sh.x); o.y = f2bf(x[j].y * rs * gg.y * (1.f + sc.y) + sh.y); o.z = f2bf(x[j].z * rs * gg.z * (1.f + sc.z) + sh.z); o.w = f2bf(x[j].w * rs * gg.w * (1.f + sc.w) + sh.w);
        *(ushort4*)(XN + (size_t)r * D + c) = o; }
}

template <class AL, class EP, int NBK>
__global__ __launch_bounds__(256) void k_gemm(AL alp, const float* W, int ldw, long wz, int N, int K, int colB2, EP epp) {
    __shared__ float As[16][68];
    __shared__ float Bs[NBK][16][68];
    AL al = alp; EP ep = epp;
    const int tx = threadIdx.x & 15, ty = threadIdx.x >> 4, m0 = blockIdx.y * 64, n0 = blockIdx.x * 64, z = blockIdx.z;
    if (!al.init(m0, z)) return;
    ep.init(m0, z);
    const float* Wz = W + al.woff() + (size_t)z * wz;
    float acc[NBK][4][4];
#pragma unroll
    for (int nb = 0; nb < NBK; ++nb)
#pragma unroll
        for (int i = 0; i < 4; ++i)
#pragma unroll
            for (int j = 0; j < 4; ++j) acc[nb][i][j] = 0.f;
    const int am = threadIdx.x >> 2, ak = (threadIdx.x & 3) * 4, bk = threadIdx.x >> 4, bn = (threadIdx.x & 15) * 4;
    for (int k0 = 0; k0 < K; k0 += 16) {
        { float v[4]; al.load4(z, m0 + am, k0 + ak, v); As[ak + 0][am] = v[0]; As[ak + 1][am] = v[1]; As[ak + 2][am] = v[2]; As[ak + 3][am] = v[3]; }
#pragma unroll
        for (int nb = 0; nb < NBK; ++nb) { const int col = n0 + bn; float4 w = make_float4(0.f, 0.f, 0.f, 0.f);
            if (col + 3 < N) w = *(const float4*)(Wz + (size_t)(k0 + bk) * ldw + col + nb * colB2);
            *(float4*)&Bs[nb][bk][bn] = w; }
        __syncthreads();
#pragma unroll
        for (int kk = 0; kk < 16; ++kk) {
            const float4 a = *(const float4*)&As[kk][ty * 4];
#pragma unroll
            for (int nb = 0; nb < NBK; ++nb) { const float4 b = *(const float4*)&Bs[nb][kk][tx * 4];
                acc[nb][0][0] += a.x * b.x; acc[nb][0][1] += a.x * b.y; acc[nb][0][2] += a.x * b.z; acc[nb][0][3] += a.x * b.w;
                acc[nb][1][0] += a.y * b.x; acc[nb][1][1] += a.y * b.y; acc[nb][1][2] += a.y * b.z; acc[nb][1][3] += a.y * b.w;
                acc[nb][2][0] += a.z * b.x; acc[nb][2][1] += a.z * b.y; acc[nb][2][2] += a.z * b.z; acc[nb][2][3] += a.z * b.w;
                acc[nb][3][0] += a.w * b.x; acc[nb][3][1] += a.w * b.y; acc[nb][3][2] += a.w * b.z; acc[nb][3][3] += a.w * b.w; }
        }
        __syncthreads();
    }
#pragma unroll
    for (int i = 0; i < 4; ++i)
#pragma unroll
        for (int j = 0; j < 4; ++j) { const int col = n0 + tx * 4 + j; if (col < N) ep.store(z, m0 + ty * 4 + i, col, acc[0][i][j], acc[NBK - 1][i][j]); }
}

struct ALBf16 { const bf16_t* A; int lda, pad;
    __device__ bool init(int, int) { return true; } __device__ size_t woff() const { return 0; }
    __device__ void load4(int, int row, int k, float* v) const { const ushort4 w = *(const ushort4*)(A + (size_t)row * lda + k); v[0] = bf2f(w.x); v[1] = bf2f(w.y); v[2] = bf2f(w.z); v[3] = bf2f(w.w); } };
struct ALDft { const float* TC; const float* TS; int n, ts;
    __device__ bool init(int, int) { return true; } __device__ size_t woff() const { return 0; }
    __device__ void load4(int, int row, int k, float* v) const {
#pragma unroll
        for (int j = 0; j < 4; ++j) { const int t = k + j; if (t < n) v[j] = TC[((row * t) & (n - 1)) * ts]; else v[j] = -TS[((row * (t - n)) & (n - 1)) * ts]; } } };
struct ALMoe1 { const bf16_t* XN; const int* offs; const int* cnt; const int* list; int e, base, n, pad;
    __device__ bool init(int m0, int) { if (m0 >= offs[NE]) return false; int ee = 0; for (int i = 1; i < NE; ++i) if (m0 >= offs[i]) ee = i; e = ee; base = offs[ee]; n = cnt[ee]; return true; }
    __device__ size_t woff() const { return (size_t)e * 1024 * 2048; }
    __device__ void load4(int, int row, int k, float* v) const { const int i = row - base; const int tok = i < n ? (list[(size_t)e * LCAP + i] >> 2) : 0;
        const ushort4 w = *(const ushort4*)(XN + (size_t)tok * D + k); v[0] = bf2f(w.x); v[1] = bf2f(w.y); v[2] = bf2f(w.z); v[3] = bf2f(w.w); } };
struct ALMoe2 { const bf16_t* ACT; const int* offs; int e, pad;
    __device__ bool init(int m0, int) { if (m0 >= offs[NE]) return false; int ee = 0; for (int i = 1; i < NE; ++i) if (m0 >= offs[i]) ee = i; e = ee; return true; }
    __device__ size_t woff() const { return (size_t)e * 1024 * 1024; }
    __device__ void load4(int, int row, int k, float* v) const { const ushort4 w = *(const ushort4*)(ACT + (size_t)row * D + k); v[0] = bf2f(w.x); v[1] = bf2f(w.y); v[2] = bf2f(w.z); v[3] = bf2f(w.w); } };

struct EPBf16 { bf16_t* C; int ldc, pad; __device__ void init(int, int) {} __device__ void store(int, int r, int c, float a, float) const { C[(size_t)r * ldc + c] = f2bf(a); } };
struct EPF32 { float* C; int ldc, pad; __device__ void init(int, int) {} __device__ void store(int, int r, int c, float a, float) const { C[(size_t)r * ldc + c] = a; } };
struct EPDft { bf16_t* MIX; int rowoff; float scale; __device__ void init(int, int) {} __device__ void store(int z, int r, int c, float a, float) const { MIX[((size_t)z * NPOS + rowoff + r) * D + c] = f2bf(a * scale); } };
struct EPRes { float* H; const float* MODl; int g_off, pad; __device__ void init(int, int) {}
    __device__ void store(int, int r, int c, float a, float) const { const int b = r / NPOS, pos = r % NPOS, v = pos < CTX ? 4 : b; H[(size_t)r * D + c] += MODl[(size_t)v * 6144 + g_off + c] * a; } };
struct EPMoe1 { bf16_t* ACT; const float* bgu; const int* offs; const int* cnt; int e, base, n, pad;
    __device__ void init(int m0, int) { int ee = 0; for (int i = 1; i < NE; ++i) if (m0 >= offs[i]) ee = i; e = ee; base = offs[ee]; n = cnt[ee]; }
    __device__ void store(int, int r, int c, float ag, float au) const {
        float o = 0.f; if (r - base < n) { const float g = fminf(ag + bgu[(size_t)e * 2048 + c], 7.f); const float u = fminf(fmaxf(au + bgu[(size_t)e * 2048 + 1024 + c], -7.f), 7.f); o = (u + 1.f) * g * sigmoidf_(1.702f * g); }
        ACT[(size_t)r * D + c] = f2bf(o); } };
struct EPMoe2 { bf16_t* Y; const float* bd; const float* GATE; const int* offs; const int* cnt; const int* list; int e, base, n, pad;
    __device__ void init(int m0, int) { int ee = 0; for (int i = 1; i < NE; ++i) if (m0 >= offs[i]) ee = i; e = ee; base = offs[ee]; n = cnt[ee]; }
    __device__ void store(int, int r, int c, float a, float) const { const int i = r - base; if (i < n) { const int asg = list[(size_t)e * LCAP + i]; Y[(size_t)asg * D + c] = f2bf(GATE[asg] * (a + bd[(size_t)e * 1024 + c])); } } };

__global__ __launch_bounds__(256) void k_four_ch(const bf16_t* P, const float* TC, const float* TS, float* XCS, float* XCSC, int with_ctx) {
    __shared__ float u[256];
    const int r = blockIdx.x, b = r / NPOS, pos = r % NPOS;
    if (pos >= CTX) return;
    u[threadIdx.x] = bf2f(P[(size_t)r * PP + C_FN + threadIdx.x]);
    __syncthreads();
    const int g = threadIdx.x >> 6, k = threadIdx.x & 63; float ac = 0.f, as = 0.f;
#pragma unroll 8
    for (int c = 0; c < 64; ++c) { const int i = ((k * c) & 63) * 64; const float x = u[g * 64 + c]; ac += x * TC[i]; as += x * TS[i]; }
    if (pos >= CTX) { const int t = pos - CTX; XCS[((size_t)b * 8192 + t) * 256 + threadIdx.x] = ac; XCS[((size_t)b * 8192 + 4096 + t) * 256 + threadIdx.x] = as; }
    else { XCSC[((size_t)b * 512 + pos) * 256 + threadIdx.x] = ac; XCSC[((size_t)b * 512 + 256 + pos) * 256 + threadIdx.x] = as; }
}

__global__ __launch_bounds__(256) void k_lru_gates(const bf16_t* P, const float* conv_w, const float* conv_b, const float* w_a, const float* b_a, const float* w_i, const float* b_i, const float* lam,
                                                    float* LA, float* LB) {
    __shared__ float xs[16][256];
    const int dir = blockIdx.y, r0 = blockIdx.x * 16, c = threadIdx.x;
    const int b = r0 / NPOS, pos0 = r0 % NPOS; const int lo = pos0 < CTX ? 0 : CTX, hi = pos0 < CTX ? CTX : NPOS;
    const int left = dir ? 1 : 2;
    const float* cw = conv_w + (size_t)dir * 4 * 256; const float cb = conv_b[dir * 256 + c];
    float xc[16];
#pragma unroll
    for (int i = 0; i < 16; ++i) { float a = cb;
#pragma unroll
        for (int k = 0; k < 4; ++k) { const int p = pos0 + i - left + k; if (p >= lo && p < hi) a += cw[k * 256 + c] * bf2f(P[((size_t)b * NPOS + p) * PP + C_LX + c]); }
        xc[i] = a; xs[i][c] = a; }
    __syncthreads();
    const int h = c >> 6, e = c & 63;
    const float* wa = w_a + ((size_t)(dir * 4 + h) * 64) * 64 + e; const float* wi = w_i + ((size_t)(dir * 4 + h) * 64) * 64 + e;
    float ra[16], ri[16];
#pragma unroll
    for (int i = 0; i < 16; ++i) { ra[i] = 0.f; ri[i] = 0.f; }
    for (int d = 0; d < 64; ++d) { const float va = wa[d * 64], vi = wi[d * 64];
#pragma unroll
        for (int i = 0; i < 16; ++i) { const float x = xs[i][h * 64 + d]; ra[i] += x * va; ri[i] += x * vi; } }
    const float ba = b_a[dir * 256 + c], bi = b_i[dir * 256 + c]; const float sp = log1pf(__expf(-lam[dir * 256 + c]));
#pragma unroll
    for (int i = 0; i < 16; ++i) { const float rr = sigmoidf_(ra[i] + ba), ii = sigmoidf_(ri[i] + bi); const float a = __expf(-8.f * rr * sp);
        const float bt = sqrtf(fmaxf(1.f - a * a, 0.f)) * (ii * xc[i]);
        LA[((size_t)dir * MROWS + r0 + i) * 256 + c] = a; LB[((size_t)dir * MROWS + r0 + i) * 256 + c] = bt; }
}
__global__ __launch_bounds__(256) void k_lru_scan(const float* LA, const float* LB, float* HS) {
    const int c = threadIdx.x, b = blockIdx.x, dir = blockIdx.y;
    const float* a = LA + ((size_t)dir * MROWS + (size_t)b * NPOS) * 256 + c; const float* bb = LB + ((size_t)dir * MROWS + (size_t)b * NPOS) * 256 + c;
    float* hs = HS + ((size_t)dir * MROWS + (size_t)b * NPOS) * 256 + c;
    float h = 0.f;
    if (dir == 0) {
#pragma unroll 8
        for (int p = 0; p < NPOS; ++p) { h = a[(size_t)p * 256] * h + bb[(size_t)p * 256]; hs[(size_t)p * 256] = h; }
    } else {
#pragma unroll 8
        for (int p = CTX - 1; p >= 0; --p) { h = a[(size_t)p * 256] * h + bb[(size_t)p * 256]; hs[(size_t)p * 256] = h; }
#pragma unroll 8
        for (int p = NPOS - 1; p >= CTX; --p) { h = a[(size_t)p * 256] * h + bb[(size_t)p * 256]; hs[(size_t)p * 256] = h; }
    }
}
__global__ __launch_bounds__(256) void k_lru_sc_out(const bf16_t* P, const float* HS, const float* scw, const float* scb, bf16_t* MIX) {
    const int r = blockIdx.x, c = threadIdx.x, b = r / NPOS, pos = r % NPOS; const int lo = pos < CTX ? 0 : CTX, hi = pos < CTX ? CTX : NPOS;
    const float lg = bf2f(P[(size_t)r * PP + C_LG + c]);
    MIX[(size_t)r * D + 256 + c] = f2bf(gelu_tanh(lg) * (HS[(size_t)r * 256 + c] + HS[((size_t)MROWS + r) * 256 + c]));
    float a = scb[c];
#pragma unroll
    for (int k = 0; k < 3; ++k) { const int p = pos - 1 + k; if (p >= lo && p < hi) { const size_t rr = (size_t)b * NPOS + p; a += scw[k * 256 + c] * (bf2f(P[rr * PP + C_SC + c]) * bf2f(P[rr * PP + C_SX + c])); } }
    MIX[(size_t)r * D + 768 + c] = f2bf(bf2f(P[(size_t)r * PP + C_SB + c]) * a);
}

__global__ __launch_bounds__(256) void k_lat_norm(const bf16_t* P, const float* qg, const float* kvg, bf16_t* CQN, bf16_t* CKVN) {
    const int lane = threadIdx.x & 63, r = blockIdx.x * 4 + (threadIdx.x >> 6);
    float q[4], ss = 0.f;
#pragma unroll
    for (int j = 0; j < 4; ++j) { q[j] = bf2f(P[(size_t)r * PP + C_CQ + j * 64 + lane]); ss += q[j] * q[j]; }
    const float rq = rsqrtf(wave_sum(ss) * (1.f / 256.f) + 1e-6f);
#pragma unroll
    for (int j = 0; j < 4; ++j) CQN[(size_t)r * 256 + j * 64 + lane] = f2bf(q[j] * rq * qg[j * 64 + lane]);
    float k2[2]; ss = 0.f;
#pragma unroll
    for (int j = 0; j < 2; ++j) { k2[j] = bf2f(P[(size_t)r * PP + C_CKV + j * 64 + lane]); ss += k2[j] * k2[j]; }
    const float rk = rsqrtf(wave_sum(ss) * (1.f / 128.f) + 1e-6f);
#pragma unroll
    for (int j = 0; j < 2; ++j) CKVN[(size_t)r * 128 + j * 64 + lane] = f2bf(k2[j] * rk * kvg[j * 64 + lane]);
}
__device__ __forceinline__ float rope_elem(const float* z  , int i, int row, int col) {
    const int hs = i >> 4, w = i & 15, j = w & 7; const float pos = (float)(hs ? col : row);
    const float inv = __expf(-9.210340371976184f * (float)j * 0.125f); float s, c; sincosf(pos * inv, &s, &c);
    const float z1 = z[hs * 16 + j], z2 = z[hs * 16 + 8 + j];
    return w < 8 ? z1 * c - z2 * s : z1 * s + z2 * c;
}
__global__ __launch_bounds__(256) void k_qkv_finish(const float* QRAW, const float* KVRAW, const bf16_t* P, bf16_t* QL, bf16_t* QC, bf16_t* KB, bf16_t* VB, int with_ctx_q) {
    __shared__ float zq[4][32]; __shared__ float zk[32];
    const int r = blockIdx.x, b = r / NPOS, pos = r % NPOS; const bool lat = pos >= CTX; const int t = pos - CTX, row = t >> 6, col = t & 63;
    if (threadIdx.x < 128) zq[threadIdx.x >> 5][threadIdx.x & 31] = QRAW[(size_t)r * 384 + (threadIdx.x >> 5) * 96 + 64 + (threadIdx.x & 31)];
    else if (threadIdx.x < 160) zk[threadIdx.x - 128] = bf2f(P[(size_t)r * PP + C_KR + threadIdx.x - 128]);
    __syncthreads();
    for (int i = threadIdx.x; i < 384; i += 256) { const int h = i / 96, d = i % 96;
        float q; if (d < 64) q = QRAW[(size_t)r * 384 + i]; else q = lat ? rope_elem(zq[h], d - 64, row, col) : zq[h][d - 64];
        if (lat) QL[((size_t)(b * 4 + h) * SEQ + t) * 96 + d] = f2bf(q); else if (with_ctx_q) QC[((size_t)(b * 4 + h) * CTX + pos) * 96 + d] = f2bf(q);
        float k; if (d < 64) k = KVRAW[(size_t)r * 512 + h * 128 + d]; else k = lat ? rope_elem(zk, d - 64, row, col) : zk[d - 64];
        KB[((size_t)(b * 4 + h) * NPOS + pos) * 96 + d] = f2bf(k); }
    { const int h = threadIdx.x >> 6, d = threadIdx.x & 63; VB[((size_t)(b * 4 + h) * NPOS + pos) * 64 + d] = f2bf(KVRAW[(size_t)r * 512 + h * 128 + 64 + d]); }
}
__global__ __launch_bounds__(256) void k_attn(const bf16_t* Q, int nq, const bf16_t* KB, const bf16_t* VB, int nkeys, bf16_t* MIX, int out_pos_off) {
    __shared__ float Ks[64][96]; __shared__ float Vs[64][64];
    const int bh = blockIdx.y, qi = blockIdx.x * 256 + threadIdx.x, b = bh >> 2, h = bh & 3;
    float q[96], o[64];
    { const bf16_t* qp = Q + ((size_t)bh * nq + qi) * 96;
#pragma unroll
      for (int d = 0; d < 96; ++d) q[d] = bf2f(qp[d]) * 0.10206207261596577f; }
#pragma unroll
    for (int d = 0; d < 64; ++d) o[d] = 0.f;
    float m = -1e30f, l = 0.f;
    for (int k0 = 0; k0 < nkeys; k0 += 64) {
        __syncthreads();
        for (int i = threadIdx.x; i < 64 * 96; i += 256) Ks[i / 96][i % 96] = bf2f(KB[((size_t)bh * NPOS + k0) * 96 + i]);
        for (int i = threadIdx.x; i < 64 * 64; i += 256) Vs[i >> 6][i & 63] = bf2f(VB[((size_t)bh * NPOS + k0) * 64 + i]);
        __syncthreads();
        for (int j = 0; j < 64; ++j) {
            float s = 0.f;
#pragma unroll
            for (int d = 0; d < 96; d += 4) { const float4 kk = *(const float4*)&Ks[j][d]; s += q[d] * kk.x + q[d + 1] * kk.y + q[d + 2] * kk.z + q[d + 3] * kk.w; }
            const float mn = fmaxf(m, s), corr = __expf(m - mn), p = __expf(s - mn); m = mn; l = l * corr + p;
#pragma unroll
            for (int d = 0; d < 64; d += 4) { const float4 vv = *(const float4*)&Vs[j][d]; o[d] = o[d] * corr + p * vv.x; o[d + 1] = o[d + 1] * corr + p * vv.y; o[d + 2] = o[d + 2] * corr + p * vv.z; o[d + 3] = o[d + 3] * corr + p * vv.w; }
        }
    }
    const float il = 1.f / l; bf16_t* op = MIX + ((size_t)b * NPOS + out_pos_off + qi) * D + 512 + h * 64;
#pragma unroll
    for (int d = 0; d < 64; ++d) op[d] = f2bf(o[d] * il);
}

__global__ __launch_bounds__(256) void k_norm2_route(const float* H, const float* g, const float* MODl, const float* rw, const float* rb, bf16_t* XN, int* CNT, int* LIST, float* GATE, int skip_ctx) {
    __shared__ float fs[4][1024]; __shared__ float lg[4][32];
    const int w = threadIdx.x >> 6, lane = threadIdx.x & 63, r = blockIdx.x * 4 + w;
    const int b = r / NPOS, pos = r % NPOS, v = pos < CTX ? 4 : b; const bool act = !(skip_ctx && pos < CTX);
    const float* mv = MODl + (size_t)v * 6144;
    float4 x[4]; float ss = 0.f;
#pragma unroll
    for (int j = 0; j < 4; ++j) { x[j] = *(const float4*)(H + (size_t)r * D + (j * 64 + lane) * 4); ss += x[j].x * x[j].x + x[j].y * x[j].y + x[j].z * x[j].z + x[j].w * x[j].w; }
    const float rs = rsqrtf(wave_sum(ss) * (1.f / D) + 1e-6f);
#pragma unroll
    for (int j = 0; j < 4; ++j) { const int c = (j * 64 + lane) * 4; const float4 gg = *(const float4*)(g + c), sh = *(const float4*)(mv + 3072 + c), sc = *(const float4*)(mv + 4096 + c);
        float4 f; f.x = x[j].x * rs * gg.x * (1.f + sc.x) + sh.x; f.y = x[j].y * rs * gg.y * (1.f + sc.y) + sh.y; f.z = x[j].z * rs * gg.z * (1.f + sc.z) + sh.z; f.w = x[j].w * rs * gg.w * (1.f + sc.w) + sh.w;
        *(float4*)&fs[w][c] = f; ushort4 o; o.x = f2bf(f.x); o.y = f2bf(f.y); o.z = f2bf(f.z); o.w = f2bf(f.w); *(ushort4*)(XN + (size_t)r * D + c) = o; }
    __syncthreads();
    { const int e = lane & 31, half = lane >> 5; float a = 0.f;
#pragma unroll 8
      for (int k = half * 512; k < half * 512 + 512; ++k) a += fs[w][k] * rw[k * 32 + e];
      a += __shfl_xor(a, 32); if (lane < 32) lg[w][e] = a + rb[e]; }
    __syncthreads();
    if (lane == 0 && act) {
        float vals[4]; int idx[4]; unsigned used = 0u;
#pragma unroll
        for (int k = 0; k < 4; ++k) { float best = -3e38f; int bi = 0; for (int e = 0; e < 32; ++e) { const float xx = lg[w][e]; if (!((used >> e) & 1u) && xx > best) { best = xx; bi = e; } } used |= 1u << bi; vals[k] = best; idx[k] = bi; }
        float ex[4], sum = 0.f;
#pragma unroll
        for (int k = 0; k < 4; ++k) { ex[k] = __expf(vals[k] - vals[0]); sum += ex[k]; }
#pragma unroll
        for (int k = 0; k < 4; ++k) { const int asg = r * 4 + k; GATE[asg] = ex[k] / sum; const int p = atomicAdd(&CNT[idx[k]], 1); LIST[(size_t)idx[k] * LCAP + p] = asg; }
    }
}
__global__ void k_moe_offsets(const int* CNT, int* OFFS) { if (threadIdx.x == 0 && blockIdx.x == 0) { int o = 0; for (int e = 0; e < NE; ++e) { OFFS[e] = o; o += (CNT[e] + 255) / 256 * 256; } OFFS[NE] = o; } }
__global__ __launch_bounds__(256) void k_moe_combine(float* H, const bf16_t* Y, const float* MODl, int skip_ctx, const float* final_g, float* out) {
    const int lane = threadIdx.x & 63, r = blockIdx.x * 4 + (threadIdx.x >> 6); const int b = r / NPOS, pos = r % NPOS, v = pos < CTX ? 4 : b;
    if (skip_ctx && pos < CTX) return;
    const float* g2 = MODl + (size_t)v * 6144 + 5120;
    float4 x[4]; float ss = 0.f;
#pragma unroll
    for (int j = 0; j < 4; ++j) { const int c = (j * 64 + lane) * 4; x[j] = *(const float4*)(H + (size_t)r * D + c); float4 s = make_float4(0.f, 0.f, 0.f, 0.f);
#pragma unroll
        for (int k = 0; k < 4; ++k) { const ushort4 y = *(const ushort4*)(Y + ((size_t)r * 4 + k) * D + c); s.x += bf2f(y.x); s.y += bf2f(y.y); s.z += bf2f(y.z); s.w += bf2f(y.w); }
        const float4 gg = *(const float4*)(g2 + c); x[j].x += gg.x * s.x; x[j].y += gg.y * s.y; x[j].z += gg.z * s.z; x[j].w += gg.w * s.w;
        *(float4*)(H + (size_t)r * D + c) = x[j]; ss += x[j].x * x[j].x + x[j].y * x[j].y + x[j].z * x[j].z + x[j].w * x[j].w; }
    if (out) { const float rs = rsqrtf(wave_sum(ss) * (1.f / D) + 1e-6f); float* op = out + ((size_t)b * SEQ + (pos - CTX)) * D;
#pragma unroll
        for (int j = 0; j < 4; ++j) { const int c = (j * 64 + lane) * 4; const float4 fg = *(const float4*)(final_g + c); float4 o; o.x = x[j].x * rs * fg.x; o.y = x[j].y * rs * fg.y; o.z = x[j].z * rs * fg.z; o.w = x[j].w * rs * fg.w; *(float4*)(op + c) = o; } }
}

#define LAS __attribute__((address_space(3)))
typedef short bf16x8 __attribute__((ext_vector_type(8)));
typedef float f32x4 __attribute__((ext_vector_type(4)));
typedef unsigned u32x4 __attribute__((ext_vector_type(4)));
typedef unsigned u32x2 __attribute__((ext_vector_type(2)));
__device__ __forceinline__ unsigned pk2(float lo, float hi) { return (unsigned)f2bf(lo) | ((unsigned)f2bf(hi) << 16); }

namespace L {
constexpr size_t A256(size_t x) { return (x + 255) & ~(size_t)255; }
constexpr size_t CTL = 0, CTL_BYTES = 1u << 20;
constexpr size_t H = CTL + CTL_BYTES;
constexpr size_t MOD = A256(H + (size_t)MROWS * D * 4);
constexpr size_t TABC = A256(MOD + 2 * 5 * 6144 * 4);
constexpr size_t TABS = A256(TABC + 4096 * 4);
constexpr size_t XN = A256(TABS + 4096 * 4);
constexpr size_t P = A256(XN + (size_t)MROWS * D * 2);
constexpr size_t MIX = A256(P + (size_t)MROWS * PP * 2);
constexpr size_t CQN = A256(MIX + (size_t)MROWS * D * 2);
constexpr size_t CKVN = A256(CQN + (size_t)MROWS * 256 * 2);
constexpr size_t QRAW = A256(CKVN + (size_t)MROWS * 128 * 2);
constexpr size_t KVRAW = A256(QRAW + (size_t)MROWS * 384 * 4);
constexpr size_t QL = A256(KVRAW + (size_t)MROWS * 512 * 4);
constexpr size_t QC = A256(QL + (size_t)16 * SEQ * 96 * 2);
constexpr size_t KB = A256(QC + (size_t)16 * CTX * 96 * 2);
constexpr size_t VB = A256(KB + (size_t)16 * NPOS * 96 * 2);
constexpr size_t LA = A256(VB + (size_t)16 * NPOS * 64 * 2);
constexpr size_t LB = A256(LA + (size_t)2 * MROWS * 256 * 4);
constexpr size_t HS = A256(LB + (size_t)2 * MROWS * 256 * 4);
constexpr size_t XCS = A256(HS + (size_t)2 * MROWS * 256 * 4);
constexpr size_t XCSC = A256(XCS + (size_t)4 * 8192 * 256 * 4);
constexpr size_t LIST = A256(XCSC + (size_t)4 * 512 * 256 * 4);
constexpr size_t GATE = A256(LIST + (size_t)2 * NE * LCAP * 4);
constexpr size_t ACT = A256(GATE + (size_t)NASG * 4);
constexpr size_t Y = A256(ACT + (size_t)ACT_ROWS * D * 2);
constexpr size_t WINT = A256(Y + (size_t)NASG * D * 2);
constexpr size_t WOUTT = A256(WINT + (size_t)2 * 2048 * 1024 * 2);
constexpr size_t WGUT = A256(WOUTT + (size_t)2 * 1024 * 1024 * 2);
constexpr size_t WDT = A256(WGUT + (size_t)2 * NE * 2048 * 1024 * 2);
constexpr size_t ZBUF = A256(WDT + (size_t)2 * NE * 1024 * 1024 * 2);
constexpr size_t END = A256(ZBUF + (size_t)4 * 64 * 64 * 512 * 2);
constexpr int CW_BAR = 4096;
constexpr int CW_CNT = 32768;
}

#define XB_TMO      128
#define XB_XCNT(j)  (256  + 64 * (j))
#define XB_XSUB(j)  (1280 + 64 * (j))
#define XB_XGEN(j)  (2304 + 64 * (j))
#define XB_TOP      3328
#define XB_TOPGEN   3392
#define XCD_BAR_WORDS 3456
#define XB_SPIN_CAP (1u << 18)
__device__ __forceinline__ unsigned xb_ld(unsigned* p)              { return __hip_atomic_load(p, __ATOMIC_RELAXED, __HIP_MEMORY_SCOPE_AGENT); }
__device__ __forceinline__ unsigned xb_add(unsigned* p, unsigned v) { return __hip_atomic_fetch_add(p, v, __ATOMIC_RELAXED, __HIP_MEMORY_SCOPE_AGENT); }
__device__ __forceinline__ unsigned xb_xcc_id() { return (unsigned)__builtin_amdgcn_s_getreg((3 << 11) | 20) & 0xFu; }
#define XB_SPIN(cond, bar) do { unsigned _sp = 0; while (cond) { __builtin_amdgcn_s_sleep(1); \
    if ((++_sp & 255u) == 0u) { if (xb_ld(&(bar)[XB_TMO])) break; if (_sp > XB_SPIN_CAP) { atomicAdd(&(bar)[XB_TMO], 1u); break; } } } } while (0)
struct XcdBarrier { unsigned* bar; unsigned x; volatile LAS unsigned* st; };
__device__ __forceinline__ XcdBarrier xcd_barrier_post(unsigned* bar, volatile LAS unsigned* st) {
    XcdBarrier b; b.bar = bar; b.x = xb_xcc_id(); b.st = st;
    if (threadIdx.x == 0) (void)xb_add(&bar[XB_XCNT(b.x)], 1u);
    return b;
}
__device__ __forceinline__ void xcd_barrier_complete(unsigned* bar, unsigned x, unsigned& nloc, unsigned& nx) {
    const unsigned G = gridDim.x * gridDim.y * gridDim.z;
    unsigned sum, cnt, mine, sp = 0u;
    for (;;) {
        sum = 0u; cnt = 0u; mine = 0u;
#pragma unroll
        for (unsigned j = 0; j < 16; ++j) { const unsigned c = xb_ld(&bar[XB_XCNT(j)]); sum += c; cnt += (c > 0u) ? 1u : 0u; mine = (j == x) ? c : mine; }
        if (sum == G) break;
        __builtin_amdgcn_s_sleep(1);
        if ((++sp & 255u) == 0u) { if (xb_ld(&bar[XB_TMO])) break; if (sp > XB_SPIN_CAP) { atomicAdd(&bar[XB_TMO], 1u); break; } }
    }
    nloc = mine > 0u ? mine : 1u; nx = cnt > 0u ? cnt : 1u;
}
__device__ __forceinline__ void xcd_barrier(const XcdBarrier& b) {
    asm volatile("s_waitcnt vmcnt(0)" ::: "memory");
    __syncthreads();
    if (threadIdx.x == 0) {
        unsigned* bar = b.bar;
        __builtin_amdgcn_s_waitcnt(0);
        unsigned nloc = b.st[0], nx = b.st[1];
        if (nloc == 0u) { xcd_barrier_complete(bar, b.x, nloc, nx); b.st[0] = nloc; b.st[1] = nx; }
        const unsigned old = xb_add(&bar[XB_XSUB(b.x)], 1u);
        const unsigned gen = old / nloc;
        if (old + 1u == (gen + 1u) * nloc) {
            __builtin_amdgcn_fence(__ATOMIC_RELEASE, "agent");
            asm volatile("s_waitcnt vmcnt(0)" ::: "memory");
            const unsigned og = xb_add(&bar[XB_TOP], 1u);
            const unsigned tg = og / nx;
            if (og + 1u == (tg + 1u) * nx) xb_add(&bar[XB_TOPGEN], 1u);
            else XB_SPIN(xb_ld(&bar[XB_TOPGEN]) == tg, bar);
            __builtin_amdgcn_fence(__ATOMIC_ACQUIRE, "agent");
            xb_add(&bar[XB_XGEN(b.x)], 1u);
            asm volatile("s_waitcnt vmcnt(0)" ::: "memory");
        } else {
            XB_SPIN(xb_ld(&bar[XB_XGEN(b.x)]) == gen, bar);
            __builtin_amdgcn_fence(__ATOMIC_ACQUIRE, "agent");
            asm volatile("s_waitcnt vmcnt(0)" ::: "memory");
        }
    }
    __syncthreads();
}

namespace g8 {
constexpr int BM = 256, BK = 64, HALF = 128, HTB = HALF * BK * 2, STAGE_BYTES = 8 * HTB, NXCD = 8, WGM = 8;
__device__ __forceinline__ int lds_byte(int r, int c) { const int st = (r >> 4) * 2 + (c >> 5), rr = r & 15, cc = c & 31, ob = rr * 64 + cc * 2; return st * 1024 + (ob ^ (((ob >> 9) & 1) << 5)); }
__device__ __forceinline__ void stage_rc(int b, int& R, int& C) { const int st = b / 1024, sb = b % 1024, swz = sb ^ (((sb >> 9) & 1) << 5); R = (st >> 1) * 16 + swz / 64; C = (st & 1) * 32 + (swz % 64) / 2; }
__device__ __forceinline__ int perm32(int rho) { const int n = rho >> 4, i = rho & 15; return 8 * (i >> 2) + 4 * n + (i & 3); }
__device__ __forceinline__ unsigned cvt_pk_bf16(float lo, float hi) { unsigned r; asm volatile("v_cvt_pk_bf16_f32 %0, %1, %2" : "=v"(r) : "v"(lo), "v"(hi)); return r; }
__device__ __forceinline__ int xcd_remap(int wgid, int nwg) { const int q = nwg / NXCD, r = nwg % NXCD, xcd = wgid % NXCD, off = wgid / NXCD; return (xcd < r ? xcd * (q + 1) : r * (q + 1) + (xcd - r) * q) + off; }

struct Unit { int row0, col0, ex, bt, nvalid, lrow; };

struct DenseSched {
    int nM, nN, nwg, G, c, lat_only; const char* Bt; int K; const int* list;
    __device__ __forceinline__ void init(int nM_, int nN_, int G_, int c_, int lat_only_, const void* Bt_, int K_) { nM = nM_; nN = nN_; nwg = nM * nN; G = G_; c = c_; lat_only = lat_only_; Bt = (const char*)Bt_; K = K_; list = nullptr; }
    __device__ __forceinline__ bool next(int i, Unit& u) const {
        const long Lx = (long)i * G + c; if (Lx >= nwg) return false;
        const int wgid = xcd_remap((int)Lx, nwg);
        const int nig = WGM * nN, gid = wgid / nig, fm = gid * WGM, gsz = (nM - fm) < WGM ? (nM - fm) : WGM;
        const int pm = fm + ((wgid % nig) % gsz), pn = (wgid % nig) / gsz;
        const int tile = lat_only ? (pm / 16) * 17 + 1 + (pm % 16) : pm;
        u.row0 = tile * 256; u.col0 = pn * 256; u.ex = 0; u.bt = pn; u.nvalid = 256; u.lrow = 0; return true;
    }
    __device__ __forceinline__ const char* bptr(const Unit& u) const { return Bt + (size_t)u.bt * 256 * K * 2; }
};
struct MoeSched {
    const LAS int* tpre; const LAS int* cnt; int NT, COLW, G, c, total; const char* Bt; int K; const int* list;
    __device__ __forceinline__ bool next(int i, Unit& u) const {
        const long Lx = (long)i * G + c; if (Lx >= total) return false;
        const int wgid = xcd_remap((int)Lx, total);
        int e = 0;
        for (int j = 1; j < NE; ++j) if (tpre[j] * NT <= wgid) e = j;
        const int t0 = tpre[e], mte = tpre[e + 1] - t0, loc = wgid - t0 * NT, nt = loc / mte, mt = loc % mte;
        u.ex = __builtin_amdgcn_readfirstlane(e); u.row0 = __builtin_amdgcn_readfirstlane((t0 + mt) * 256); u.col0 = __builtin_amdgcn_readfirstlane(nt * COLW);
        u.bt = __builtin_amdgcn_readfirstlane(e * NT + nt); const int nv = cnt[e] - mt * 256; u.nvalid = __builtin_amdgcn_readfirstlane(nv < 256 ? nv : 256); u.lrow = __builtin_amdgcn_readfirstlane(mt * 256);
        return true;
    }
    __device__ __forceinline__ const char* bptr(const Unit& u) const { return Bt + (size_t)u.bt * 256 * K * 2; }
};

struct EpiP {
    static constexpr bool PERM = true; bf16_t* O;
    __device__ __forceinline__ void operator()(const f32x4 (&acc)[2][2][4][2], const Unit& u, int wr, int wc, int fr, int fq, const LAS int*) const {
#pragma unroll
        for (int ai = 0; ai < 2; ++ai)
#pragma unroll
            for (int m = 0; m < 4; ++m) { bf16_t* rowp = O + (size_t)(u.row0 + ai * HALF + wr * 64 + m * 16 + fr) * PP + u.col0 + wc * 32 + 8 * fq;
#pragma unroll
                for (int bj = 0; bj < 2; ++bj) { const f32x4 v0 = acc[ai][bj][m][0], v1 = acc[ai][bj][m][1]; u32x4 w; w.x = cvt_pk_bf16(v0[0], v0[1]); w.y = cvt_pk_bf16(v0[2], v0[3]); w.z = cvt_pk_bf16(v1[0], v1[1]); w.w = cvt_pk_bf16(v1[2], v1[3]);
                    *(u32x4*)(rowp + bj * HALF) = w; } }
    }
};
struct EpiH {
    static constexpr bool PERM = false; float* Hh; const float* MODl; int g_off;
    __device__ __forceinline__ void operator()(const f32x4 (&acc)[2][2][4][2], const Unit& u, int wr, int wc, int fr, int fq, const LAS int*) const {
        const int tile = u.row0 >> 8, v = (tile % 17 == 0) ? 4 : tile / 17; const float* gp = MODl + (size_t)v * 6144 + g_off + u.col0 + wc * 32 + 4 * fq;
        f32x4 gv[2][2];
#pragma unroll
        for (int bj = 0; bj < 2; ++bj)
#pragma unroll
            for (int n = 0; n < 2; ++n) gv[bj][n] = *(const f32x4*)(gp + bj * HALF + n * 16);
#pragma unroll
        for (int ai = 0; ai < 2; ++ai)
#pragma unroll
            for (int m = 0; m < 4; ++m) { float* rowp = Hh + (size_t)(u.row0 + ai * HALF + wr * 64 + m * 16 + fr) * D + u.col0 + wc * 32 + 4 * fq;
#pragma unroll
                for (int bj = 0; bj < 2; ++bj)
#pragma unroll
                    for (int n = 0; n < 2; ++n) { f32x4* p = (f32x4*)(rowp + bj * HALF + n * 16); *p = *p + gv[bj][n] * acc[ai][bj][m][n]; } }
    }
};
struct EpiMoe1 {
    static constexpr bool PERM = true; bf16_t* ACTp; const float* bgu;
    __device__ __forceinline__ void operator()(const f32x4 (&acc)[2][2][4][2], const Unit& u, int wr, int wc, int fr, int fq, const LAS int*) const {
        const int cc = u.col0 + wc * 32 + 8 * fq; const float* bp = bgu + (size_t)u.ex * 2048 + cc;
        f32x4 bg[2], bu[2];
#pragma unroll
        for (int n = 0; n < 2; ++n) { bg[n] = *(const f32x4*)(bp + 4 * n); bu[n] = *(const f32x4*)(bp + 1024 + 4 * n); }
#pragma unroll
        for (int ai = 0; ai < 2; ++ai)
#pragma unroll
            for (int m = 0; m < 4; ++m) { const int r = ai * HALF + wr * 64 + m * 16 + fr;
                float o[8];
#pragma unroll
                for (int n = 0; n < 2; ++n)
#pragma unroll
                    for (int i = 0; i < 4; ++i) { const float g = fminf(acc[ai][0][m][n][i] + bg[n][i], 7.f); const float uu = fminf(fmaxf(acc[ai][1][m][n][i] + bu[n][i], -7.f), 7.f);
                        o[n * 4 + i] = (uu + 1.f) * g * __builtin_amdgcn_rcpf(1.f + __expf(-1.702f * g)); }
                if (r < u.nvalid) { u32x4 w; w.x = cvt_pk_bf16(o[0], o[1]); w.y = cvt_pk_bf16(o[2], o[3]); w.z = cvt_pk_bf16(o[4], o[5]); w.w = cvt_pk_bf16(o[6], o[7]);
                    *(u32x4*)(ACTp + (size_t)(u.row0 + r) * D + cc) = w; } }
    }
};
struct EpiMoe2 {
    static constexpr bool PERM = true; bf16_t* Yp; const float* bd; const float* GATEp;
    __device__ __forceinline__ void operator()(const f32x4 (&acc)[2][2][4][2], const Unit& u, int wr, int wc, int fr, int fq, const LAS int* rows) const {
        const int cc = u.col0 + wc * 32 + 8 * fq; const float* bp = bd + (size_t)u.ex * 1024 + cc;
        f32x4 bv[2][2];
#pragma unroll
        for (int bj = 0; bj < 2; ++bj)
#pragma unroll
            for (int n = 0; n < 2; ++n) bv[bj][n] = *(const f32x4*)(bp + bj * HALF + 4 * n);
#pragma unroll
        for (int ai = 0; ai < 2; ++ai)
#pragma unroll
            for (int m = 0; m < 4; ++m) { const int r = ai * HALF + wr * 64 + m * 16 + fr;
                if (r < u.nvalid) { const int asg = rows[r]; const float gt = GATEp[asg]; bf16_t* rowp = Yp + (size_t)asg * D + cc;
#pragma unroll
                    for (int bj = 0; bj < 2; ++bj) { const f32x4 v0 = (acc[ai][bj][m][0] + bv[bj][0]) * gt, v1 = (acc[ai][bj][m][1] + bv[bj][1]) * gt;
                        u32x4 w; w.x = cvt_pk_bf16(v0[0], v0[1]); w.y = cvt_pk_bf16(v0[2], v0[3]); w.z = cvt_pk_bf16(v1[0], v1[1]); w.w = cvt_pk_bf16(v1[2], v1[3]); *(u32x4*)(rowp + bj * HALF) = w; } } }
    }
};

template <class Epi, class Sched, bool GATHER, bool ROWLIST>
__device__ __forceinline__ void gemm_phase(LAS unsigned char* lds, const char* Abase, const int K, const Sched& S, const Epi& E) {
    int tid_l = threadIdx.x; asm volatile("" : "+v"(tid_l));
    const int tid = tid_l, wid = __builtin_amdgcn_readfirstlane(tid >> 6), lane = tid & 63, wr = wid >> 2, wc = wid & 3, fr = lane & 15, fq = lane >> 4;
    const int nt = K / BK; const unsigned Kb = (unsigned)K * 2u;
    int sR[2]; unsigned sC[2], voffB[2];
#pragma unroll
    for (int i = 0; i < 2; ++i) { int R, C; stage_rc(tid * 16 + i * 8192, R, C); sR[i] = R; sC[i] = (unsigned)C * 2u; const int Rb = Epi::PERM ? ((R & ~31) + perm32(R & 31)) : R; voffB[i] = (unsigned)(Rb * K + C) * 2u; }
    const size_t kstep = (size_t)(BK * 2), hstep = (size_t)HALF * K * 2;
    const unsigned ldsw = (unsigned)wid * 1024u;
    const int aoff = lds_byte(wr * 64 + fr, fq * 8), boff = lds_byte(wc * 32 + fr, fq * 8);
    LAS int* rowbuf = (LAS int*)(lds + STAGE_BYTES);
#define G8_SA(b, h) (((b) * 2 + (h)) * HTB)
#define G8_SB(b, h) ((4 + (b) * 2 + (h)) * HTB)
#define G8_STAGE_A(bufoff, kb, v) do { _Pragma("unroll") for (int _i = 0; _i < 2; ++_i) \
        __builtin_amdgcn_global_load_lds((const unsigned*)((kb) + (size_t)(v)[_i]), (LAS unsigned*)(lds + (bufoff) + ldsw + _i * 8192), 16, 0, 0); } while (0)
#define G8_STAGE_B(bufoff, gbase) do { _Pragma("unroll") for (int _i = 0; _i < 2; ++_i) \
        __builtin_amdgcn_global_load_lds((const unsigned*)((gbase) + voffB[_i]), (LAS unsigned*)(lds + (bufoff) + ldsw + _i * 8192), 16, 0, 0); } while (0)
#define G8_LDA(dst, b, h) do { _Pragma("unroll") for (int m = 0; m < 4; ++m) _Pragma("unroll") for (int k = 0; k < 2; ++k) dst[m][k] = *(const LAS bf16x8*)(lds + G8_SA(b, h) + aoff + m * 2048 + k * 1024); } while (0)
#define G8_LDB(dst, b, h) do { _Pragma("unroll") for (int n = 0; n < 2; ++n) _Pragma("unroll") for (int k = 0; k < 2; ++k) dst[n][k] = *(const LAS bf16x8*)(lds + G8_SB(b, h) + boff + n * 2048 + k * 1024); } while (0)
#define G8_MMA(ai, bj, At, Bt) do { __builtin_amdgcn_s_setprio(1); _Pragma("unroll") for (int m = 0; m < 4; ++m) _Pragma("unroll") for (int n = 0; n < 2; ++n) _Pragma("unroll") for (int k = 0; k < 2; ++k) \
        acc[ai][bj][m][n] = __builtin_amdgcn_mfma_f32_16x16x32_bf16(Bt[n][k], At[m][k], acc[ai][bj][m][n], 0, 0, 0); __builtin_amdgcn_s_setprio(0); } while (0)
#define G8_WAIT_V(n) asm volatile("s_waitcnt vmcnt(" #n ")" ::: "memory")
#define G8_WAIT_L(n) asm volatile("s_waitcnt lgkmcnt(" #n ")" ::: "memory")
#define G8_BAR __builtin_amdgcn_s_barrier()
#define G8_SCHED __builtin_amdgcn_sched_barrier(0)
#define G8_LISTDMA(u, s) do { if (wid < 4) __builtin_amdgcn_global_load_lds((const unsigned*)(S.list + (size_t)(u).ex * LCAP + (u).lrow + wid * 64 + lane), (LAS unsigned*)(rowbuf + (s) * 256 + wid * 64), 4, 0, 0); } while (0)
#define G8_ROWS_DENSE(v) do { _Pragma("unroll") for (int _h = 0; _h < 2; ++_h) _Pragma("unroll") for (int _i = 0; _i < 2; ++_i) (v)[_h][_i] = (unsigned)(_h * HALF + sR[_i]) * Kb + sC[_i]; } while (0)
#define G8_ROWS_LIST(v, u, s) do { _Pragma("unroll") for (int _h = 0; _h < 2; ++_h) _Pragma("unroll") for (int _i = 0; _i < 2; ++_i) { const int _r = _h * HALF + sR[_i]; const int _a = rowbuf[(s) * 256 + _r]; \
        (v)[_h][_i] = (unsigned)(_r < (u).nvalid ? (_a >> 2) : 0) * Kb + sC[_i]; } } while (0)
    Unit cur, nxt; int ui = 0, slot = 0;
    if (!S.next(0, cur)) return;
    unsigned vA[2][2];
    if constexpr (ROWLIST) { G8_LISTDMA(cur, 0); G8_WAIT_V(0); G8_BAR; }
    if constexpr (GATHER) { G8_ROWS_LIST(vA, cur, 0); } else { G8_ROWS_DENSE(vA); }
    f32x4 acc[2][2][4][2];
#pragma unroll
    for (int a = 0; a < 2; ++a)
#pragma unroll
        for (int b = 0; b < 2; ++b)
#pragma unroll
            for (int m = 0; m < 4; ++m)
#pragma unroll
                for (int n = 0; n < 2; ++n) acc[a][b][m][n] = (f32x4){0.f, 0.f, 0.f, 0.f};
    bf16x8 At[4][2], B0[2][2], B1[2][2];
    const char* cB = S.bptr(cur);
    const char* cA = GATHER ? Abase : Abase + (size_t)cur.row0 * Kb;
    G8_STAGE_B(G8_SB(0, 0), cB); G8_STAGE_B(G8_SB(0, 1), cB + hstep); G8_STAGE_A(G8_SA(0, 0), cA, vA[0]); G8_STAGE_A(G8_SA(0, 1), cA, vA[1]);
    if (wr == 1) G8_BAR;
    G8_WAIT_V(2); G8_BAR;
    G8_STAGE_B(G8_SB(1, 0), cB + kstep); G8_STAGE_A(G8_SA(1, 0), cA + kstep, vA[0]); G8_STAGE_B(G8_SB(1, 1), cB + hstep + kstep);
    G8_WAIT_V(6); G8_BAR;
    for (;;) {
        const bool has_next = S.next(ui + 1, nxt);
        const char* nB = has_next ? S.bptr(nxt) : cB;
        const char* nA = (GATHER || !has_next) ? cA : Abase + (size_t)nxt.row0 * Kb;
        const int nslot = slot == 2 ? 0 : slot + 1;
        if constexpr (ROWLIST) { if (has_next) G8_LISTDMA(nxt, nslot); }
        for (int t = 0; t < nt; t += 2) {
            const bool last = (t == nt - 2);
            const char* a1 = cA + (size_t)(t + 1) * kstep;
            const char* a2 = last ? nA : cA + (size_t)(t + 2) * kstep; const char* b2 = last ? nB : cB + (size_t)(t + 2) * kstep;
            const char* a3 = a2 + kstep; const char* b3 = b2 + kstep;
            G8_LDB(B0, 0, 0); G8_LDB(B1, 0, 1); G8_SCHED; G8_LDA(At, 0, 0); G8_STAGE_A(G8_SA(1, 1), a1, vA[1]);
            if constexpr (GATHER) { if (last && has_next) { G8_ROWS_LIST(vA, nxt, nslot); } }
            G8_WAIT_V(8); G8_WAIT_L(0); G8_BAR; G8_MMA(0, 0, At, B0); G8_MMA(0, 1, At, B1); G8_BAR; G8_SCHED;
            G8_LDA(At, 0, 1); G8_STAGE_B(G8_SB(0, 0), b2); G8_STAGE_B(G8_SB(0, 1), b2 + hstep); G8_STAGE_A(G8_SA(0, 0), a2, vA[0]);
            G8_WAIT_V(8); G8_WAIT_L(0); G8_BAR; G8_MMA(1, 0, At, B0); G8_MMA(1, 1, At, B1); G8_BAR; G8_SCHED;
            G8_LDB(B0, 1, 0); G8_LDB(B1, 1, 1); G8_SCHED; G8_LDA(At, 1, 0); G8_STAGE_A(G8_SA(0, 1), a2, vA[1]);
            G8_WAIT_V(8); G8_WAIT_L(0); G8_BAR; G8_MMA(0, 0, At, B0); G8_MMA(0, 1, At, B1); G8_BAR; G8_SCHED;
            G8_LDA(At, 1, 1); G8_STAGE_B(G8_SB(1, 0), b3); G8_STAGE_B(G8_SB(1, 1), b3 + hstep); G8_STAGE_A(G8_SA(1, 0), a3, vA[0]);
            G8_WAIT_V(8); G8_WAIT_L(0); G8_BAR; G8_MMA(1, 0, At, B0); G8_MMA(1, 1, At, B1); G8_BAR; G8_SCHED;
        }
        if (wr == 0) G8_BAR;
        E(acc, cur, wr, wc, fr, fq, rowbuf + slot * 256);
        if (!has_next) break;
#pragma unroll
        for (int a = 0; a < 2; ++a)
#pragma unroll
            for (int b = 0; b < 2; ++b)
#pragma unroll
                for (int m = 0; m < 4; ++m)
#pragma unroll
                    for (int n = 0; n < 2; ++n) acc[a][b][m][n] = (f32x4){0.f, 0.f, 0.f, 0.f};
        cur = nxt; cB = nB; cA = nA; ++ui; slot = nslot;
        if (wr == 1) G8_BAR;
    }
    G8_WAIT_V(0);
    G8_BAR;
#undef G8_SA
#undef G8_SB
#undef G8_STAGE_A
#undef G8_STAGE_B
#undef G8_LDA
#undef G8_LDB
#undef G8_MMA
#undef G8_WAIT_V
#undef G8_WAIT_L
#undef G8_BAR
#undef G8_SCHED
#undef G8_LISTDMA
#undef G8_ROWS_DENSE
#undef G8_ROWS_LIST
}
}

namespace fft {
constexpr int TP = 72;
constexpr int UP = 264;
constexpr int ZP = 520;
constexpr int O_TC = 0, O_TS = 9216, O_U = 18432, O_X = 52224, O_TW = 125952;
__device__ __forceinline__ bf16x8 neg8(bf16x8 v) { u32x4 w = __builtin_bit_cast(u32x4, v); w = w ^ 0x80008000u; return __builtin_bit_cast(bf16x8, w); }
__device__ __forceinline__ void build_tables(LAS unsigned char* lds, const float* TABC, const float* TABS) {
    for (int i = threadIdx.x; i < 4096; i += 512) { const int a = i >> 6, b = i & 63, ix = ((a * b) & 63) * 64;
        ((LAS bf16_t*)(lds + O_TC))[a * TP + b] = f2bf(TABC[ix]); ((LAS bf16_t*)(lds + O_TS))[a * TP + b] = f2bf(TABS[ix]); }
}
__device__ __forceinline__ void stage_a(LAS unsigned char* lds, const bf16_t* P, const float* TABC, const float* TABS, bf16_t* ZBUF, int G, int bx) {
    int tid_l = threadIdx.x; asm volatile("" : "+v"(tid_l));
    const int tid = tid_l, lane = tid & 63, w = __builtin_amdgcn_readfirstlane(tid >> 6), fr = lane & 15, fq = lane >> 4;
    build_tables(lds, TABC, TABS);
    const LAS bf16_t* Tc = (const LAS bf16_t*)(lds + O_TC); const LAS bf16_t* Ts = (const LAS bf16_t*)(lds + O_TS);
    LAS bf16_t* U = (LAS bf16_t*)(lds + O_U); LAS bf16_t* X = (LAS bf16_t*)(lds + O_X); LAS float* TW = (LAS float*)(lds + O_TW);
    for (int unit = bx; unit < 256; unit += G) {
        const int b = unit >> 6, t2 = unit & 63;
#pragma unroll
        for (int i = 0; i < 4; ++i) { const int q = tid + 512 * i, t1 = q >> 5, ch = q & 31;
            *(LAS u32x4*)((LAS unsigned char*)U + t1 * (UP * 2) + ch * 16) = *(const u32x4*)(P + ((size_t)b * NPOS + CTX + 64 * t1 + t2) * PP + ch * 8); }
        if (tid < 64) { const int ix = tid * t2; TW[2 * tid] = TABC[ix]; TW[2 * tid + 1] = TABS[ix]; }
        __syncthreads();
        { const int g = w >> 1, part = w & 1; const LAS bf16_t* T = part ? Ts : Tc;
          f32x4 acc[4][4];
#pragma unroll
          for (int mt = 0; mt < 4; ++mt)
#pragma unroll
              for (int nt = 0; nt < 4; ++nt) acc[mt][nt] = (f32x4){0.f, 0.f, 0.f, 0.f};
#pragma unroll
          for (int ks = 0; ks < 2; ++ks) { bf16x8 a[4], bb[4];
#pragma unroll
              for (int mt = 0; mt < 4; ++mt) a[mt] = *(const LAS bf16x8*)(U + (16 * mt + fr) * UP + g * 64 + 32 * ks + 8 * fq);
#pragma unroll
              for (int nt = 0; nt < 4; ++nt) bb[nt] = *(const LAS bf16x8*)(T + (16 * nt + fr) * TP + 32 * ks + 8 * fq);
#pragma unroll
              for (int mt = 0; mt < 4; ++mt)
#pragma unroll
                  for (int nt = 0; nt < 4; ++nt) acc[mt][nt] = __builtin_amdgcn_mfma_f32_16x16x32_bf16(a[mt], bb[nt], acc[mt][nt], 0, 0, 0); }
          const float sg = part ? -1.f : 1.f;
#pragma unroll
          for (int mt = 0; mt < 4; ++mt)
#pragma unroll
              for (int nt = 0; nt < 4; ++nt) { const f32x4 v = acc[mt][nt] * sg; u32x2 o; o.x = pk2(v[0], v[1]); o.y = pk2(v[2], v[3]);
                  *(LAS u32x2*)(X + (part * 256 + g * 64 + 16 * nt + fr) * TP + 16 * mt + 4 * fq) = o; } }
        __syncthreads();
        f32x4 zr[4][2], zi[4][2];
#pragma unroll
        for (int mt = 0; mt < 4; ++mt)
#pragma unroll
            for (int n = 0; n < 2; ++n) { zr[mt][n] = (f32x4){0.f, 0.f, 0.f, 0.f}; zi[mt][n] = (f32x4){0.f, 0.f, 0.f, 0.f}; }
#pragma unroll
        for (int ks = 0; ks < 2; ++ks) { bf16x8 xr[2], xi[2];
#pragma unroll
            for (int n = 0; n < 2; ++n) { xr[n] = *(const LAS bf16x8*)(X + (32 * w + 16 * n + fr) * TP + 32 * ks + 8 * fq); xi[n] = *(const LAS bf16x8*)(X + (256 + 32 * w + 16 * n + fr) * TP + 32 * ks + 8 * fq); }
#pragma unroll
            for (int mt = 0; mt < 4; ++mt) { const bf16x8 c = *(const LAS bf16x8*)(Tc + (16 * mt + fr) * TP + 32 * ks + 8 * fq), s = *(const LAS bf16x8*)(Ts + (16 * mt + fr) * TP + 32 * ks + 8 * fq), ns = neg8(s);
#pragma unroll
                for (int n = 0; n < 2; ++n) { zr[mt][n] = __builtin_amdgcn_mfma_f32_16x16x32_bf16(c, xr[n], zr[mt][n], 0, 0, 0); zr[mt][n] = __builtin_amdgcn_mfma_f32_16x16x32_bf16(s, xi[n], zr[mt][n], 0, 0, 0);
                    zi[mt][n] = __builtin_amdgcn_mfma_f32_16x16x32_bf16(c, xi[n], zi[mt][n], 0, 0, 0); zi[mt][n] = __builtin_amdgcn_mfma_f32_16x16x32_bf16(ns, xr[n], zi[mt][n], 0, 0, 0); } } }
        __syncthreads();
        { LAS bf16_t* Zs = X;
#pragma unroll
          for (int mt = 0; mt < 4; ++mt)
#pragma unroll
              for (int i = 0; i < 4; ++i) { const int f1 = 16 * mt + 4 * fq + i; const float ct = TW[2 * f1], st = TW[2 * f1 + 1];
#pragma unroll
                  for (int n = 0; n < 2; ++n) { const float a = zr[mt][n][i], bq = zi[mt][n][i]; const int col = 32 * w + 16 * n + fr;
                      Zs[f1 * ZP + col] = f2bf(a * ct + bq * st); Zs[f1 * ZP + 256 + col] = f2bf(bq * ct - a * st); } } }
        __syncthreads();
#pragma unroll
        for (int i = 0; i < 8; ++i) { const int q = tid + 512 * i, f1 = q >> 6, ch = q & 63;
            *(u32x4*)(ZBUF + (((size_t)b * 64 + f1) * 64 + t2) * 512 + ch * 8) = *(const LAS u32x4*)((const LAS unsigned char*)X + f1 * (ZP * 2) + ch * 16); }
        __syncthreads();
    }
}
__device__ __forceinline__ void stage_b(LAS unsigned char* lds, const bf16_t* ZBUF, const float* TABC, const float* TABS, bf16_t* MIX, int G, int bx) {
    int tid_l = threadIdx.x; asm volatile("" : "+v"(tid_l));
    const int tid = tid_l, lane = tid & 63, w = __builtin_amdgcn_readfirstlane(tid >> 6), fr = lane & 15, fq = lane >> 4;
    build_tables(lds, TABC, TABS);
    const LAS bf16_t* Tc = (const LAS bf16_t*)(lds + O_TC); const LAS bf16_t* Ts = (const LAS bf16_t*)(lds + O_TS);
    LAS bf16_t* Ys = (LAS bf16_t*)(lds + O_U); LAS bf16_t* ZT = (LAS bf16_t*)(lds + O_X);
    for (int unit = bx; unit < 256; unit += G) {
        const int b = unit >> 6, f1 = unit & 63;
        const bf16_t* Zg = ZBUF + ((size_t)b * 64 + f1) * 64 * 512;
#pragma unroll
        for (int i = 0; i < 4; ++i) { const int q = tid + 512 * i, p = q & 31, ch = q >> 5;
            const u32x4 r0 = *(const u32x4*)(Zg + (size_t)(2 * p) * 512 + ch * 8), r1 = *(const u32x4*)(Zg + (size_t)(2 * p + 1) * 512 + ch * 8);
#pragma unroll
            for (int j = 0; j < 4; ++j) { const unsigned a = r0[j], c = r1[j];
                *(LAS unsigned*)(ZT + (ch * 8 + 2 * j) * TP + 2 * p) = (a & 0xffffu) | (c << 16);
                *(LAS unsigned*)(ZT + (ch * 8 + 2 * j + 1) * TP + 2 * p) = (a >> 16) | (c & 0xffff0000u); } }
        __syncthreads();
        f32x4 y[4][2];
#pragma unroll
        for (int mt = 0; mt < 4; ++mt)
#pragma unroll
            for (int n = 0; n < 2; ++n) y[mt][n] = (f32x4){0.f, 0.f, 0.f, 0.f};
#pragma unroll
        for (int ks = 0; ks < 2; ++ks) { bf16x8 xr[2], xi[2];
#pragma unroll
            for (int n = 0; n < 2; ++n) { xr[n] = *(const LAS bf16x8*)(ZT + (32 * w + 16 * n + fr) * TP + 32 * ks + 8 * fq); xi[n] = *(const LAS bf16x8*)(ZT + (256 + 32 * w + 16 * n + fr) * TP + 32 * ks + 8 * fq); }
#pragma unroll
            for (int mt = 0; mt < 4; ++mt) { const bf16x8 c = *(const LAS bf16x8*)(Tc + (16 * mt + fr) * TP + 32 * ks + 8 * fq), s = *(const LAS bf16x8*)(Ts + (16 * mt + fr) * TP + 32 * ks + 8 * fq);
#pragma unroll
                for (int n = 0; n < 2; ++n) { y[mt][n] = __builtin_amdgcn_mfma_f32_16x16x32_bf16(c, xr[n], y[mt][n], 0, 0, 0); y[mt][n] = __builtin_amdgcn_mfma_f32_16x16x32_bf16(s, xi[n], y[mt][n], 0, 0, 0); } } }
#pragma unroll
        for (int mt = 0; mt < 4; ++mt)
#pragma unroll
            for (int i = 0; i < 4; ++i)
#pragma unroll
                for (int n = 0; n < 2; ++n) Ys[(16 * mt + 4 * fq + i) * UP + 32 * w + 16 * n + fr] = f2bf(y[mt][n][i] * (1.f / 512.f));
        __syncthreads();
#pragma unroll
        for (int i = 0; i < 4; ++i) { const int q = tid + 512 * i, f2 = q >> 5, ch = q & 31;
            *(u32x4*)(MIX + ((size_t)b * NPOS + CTX + f1 + 64 * f2) * D + ch * 8) = *(const LAS u32x4*)((const LAS unsigned char*)Ys + f2 * (UP * 2) + ch * 16); }
        __syncthreads();
    }
}
}

constexpr int NWAVES = 8, RING_BYTES = 131072 + 3072, LDSCTL_OFF = RING_BYTES, MISC_OFF = LDSCTL_OFF + 64, META_OFF = MISC_OFF + 64, LDS_BYTES = 147456;
enum { PH_PRO0 = 0, PH_PRO1 = 1, PH_L0 = 2, PH_PER_LAYER = 8, PH_N = 18 };
enum { PL_WIN = 0, PL_PREP = 1, PL_MIX = 2, PL_WOUT = 3, PL_ROUTE = 4, PL_MOE1 = 5, PL_MOE2 = 6, PL_COMB = 7 };
struct MArgs { const float* in[30]; float* out; unsigned char* ws; int ph_lo, ph_hi; };

__device__ __forceinline__ void transpose_item(const float* W, int K, int N, bf16_t* WT, int drow0, LAS float* scr, int k0, int n0, int lane) {
#pragma unroll 8
    for (int i = 0; i < 32; ++i) { const int kk = 2 * i + (lane >> 5); scr[kk * 33 + (lane & 31)] = W[(size_t)(k0 + kk) * N + n0 + (lane & 31)]; }
    asm volatile("s_waitcnt lgkmcnt(0)" ::: "memory");
    const int c = lane & 7;
#pragma unroll
    for (int j = 0; j < 4; ++j) { const int n = (lane >> 3) + 8 * j; const LAS float* s = scr + (8 * c) * 33 + n;
        u32x4 o; o.x = pk2(s[0 * 33], s[1 * 33]); o.y = pk2(s[2 * 33], s[3 * 33]); o.z = pk2(s[4 * 33], s[5 * 33]); o.w = pk2(s[6 * 33], s[7 * 33]);
        *(u32x4*)(WT + (size_t)(drow0 + n) * K + k0 + 8 * c) = o; }
    asm volatile("s_waitcnt lgkmcnt(0)" ::: "memory");
}

__global__ void __launch_bounds__(NWAVES * 64, 2) mega(MArgs args) {
    extern __shared__ __attribute__((aligned(16))) unsigned char lds_raw[];
    LAS unsigned char* lds = (LAS unsigned char*)lds_raw;
    const int tid = threadIdx.x, lane = tid & 63, wave = __builtin_amdgcn_readfirstlane(tid >> 6);
    const int G = gridDim.x, bx = blockIdx.x;
    const int vcu = (G % 8 == 0) ? (bx % 8) * (G / 8) + bx / 8 : bx;
    unsigned char* ws = args.ws;
    unsigned* ctl = (unsigned*)(ws + L::CTL);
    for (int u = tid; u < (LDS_BYTES - LDSCTL_OFF) / 4; u += NWAVES * 64) ((LAS unsigned*)(lds + LDSCTL_OFF))[u] = 0u;
    __syncthreads();
    volatile LAS unsigned* MISC = (volatile LAS unsigned*)(lds + MISC_OFF);
    LAS int* META = (LAS int*)(lds + META_OFF);
    XcdBarrier bar = xcd_barrier_post(ctl + L::CW_BAR, MISC);
    const int lo = args.ph_lo, hi = args.ph_hi;

    for (int ph = lo; ph < hi; ++ph) {
        if (ph > lo) xcd_barrier(bar);
        if (ph == PH_PRO0) {
            LAS float* scr = (LAS float*)(lds + wave * 16384);
            const int gw = vcu * NWAVES + wave, NGW = G * NWAVES;
            constexpr int I_IN = 16 * 61, I_OUT = 16 * 32, I_GU = NE * 16 * 64, I_DN = NE * 16 * 32, I_L = I_IN + I_OUT + I_GU + I_DN;
            for (int it = gw; it < 2 * I_L; it += NGW) {
                const int l = it / I_L; int r = it % I_L;
                if (r < I_IN) { const int kb = r / 61, nb = r % 61; transpose_item(args.in[8] + (size_t)l * D * PT, D, PT, (bf16_t*)(ws + L::WINT) + (size_t)l * 2048 * D, 32 * nb, scr, 64 * kb, 32 * nb, lane); continue; } r -= I_IN;
                if (r < I_OUT) { const int kb = r / 32, nb = r % 32; transpose_item(args.in[22] + (size_t)l * D * D, D, D, (bf16_t*)(ws + L::WOUTT) + (size_t)l * D * D, 32 * nb, scr, 64 * kb, 32 * nb, lane); continue; } r -= I_OUT;
                if (r < I_GU) { const int e = r / (16 * 64), q = r % (16 * 64), kb = q / 64, nb = q % 64; const int n0 = 32 * nb; const int c2 = n0 & 1023; const int drow = (c2 >> 7) * 256 + (n0 >> 10) * 128 + (c2 & 127);
                    transpose_item(args.in[25] + ((size_t)l * NE + e) * D * 2048, D, 2048, (bf16_t*)(ws + L::WGUT) + ((size_t)l * NE + e) * 2048 * D, drow, scr, 64 * kb, n0, lane); continue; } r -= I_GU;
                { const int e = r / (16 * 32), q = r % (16 * 32), kb = q / 32, nb = q % 32;
                    transpose_item(args.in[27] + ((size_t)l * NE + e) * D * D, D, D, (bf16_t*)(ws + L::WDT) + ((size_t)l * NE + e) * D * D, 32 * nb, scr, 64 * kb, 32 * nb, lane); }
            }
            for (int i = bx * 512 + tid; i < 2 * 96 * D / 8; i += G * 512) { const int l = i / (96 * D / 8), q = i % (96 * D / 8); *(u32x4*)((bf16_t*)(ws + L::WINT) + ((size_t)l * 2048 + PT) * D + (size_t)q * 8) = (u32x4){0u, 0u, 0u, 0u}; }
            continue;
        }
        if (ph < PH_L0) continue;
        const int l = (ph - PH_L0) / PH_PER_LAYER, pl = (ph - PH_L0) % PH_PER_LAYER;
        const float* MODl = (const float*)(ws + L::MOD) + (size_t)l * 5 * 6144;
        if (pl == PL_WIN) {
            g8::DenseSched S; S.init(MROWS / 256, PP / 256, G, bx, 0, (const bf16_t*)(ws + L::WINT) + (size_t)l * 2048 * D, D);
            g8::EpiP E{(bf16_t*)(ws + L::P)};
            g8::gemm_phase<g8::EpiP, g8::DenseSched, false, false>(lds, (const char*)(ws + L::XN), D, S, E);
        } else if (pl == PL_PREP) {
            fft::stage_a(lds, (const bf16_t*)(ws + L::P), (const float*)(ws + L::TABC), (const float*)(ws + L::TABS), (bf16_t*)(ws + L::ZBUF), G, bx);
        } else if (pl == PL_MIX) {
            fft::stage_b(lds, (const bf16_t*)(ws + L::ZBUF), (const float*)(ws + L::TABC), (const float*)(ws + L::TABS), (bf16_t*)(ws + L::MIX), G, bx);
        } else if (pl == PL_WOUT) {
            g8::DenseSched S; S.init(l == 0 ? MROWS / 256 : 64, D / 256, G, bx, l == 0 ? 0 : 1, (const bf16_t*)(ws + L::WOUTT) + (size_t)l * D * D, D);
            g8::EpiH E{(float*)(ws + L::H), MODl, 2048};
            g8::gemm_phase<g8::EpiH, g8::DenseSched, false, false>(lds, (const char*)(ws + L::MIX), D, S, E);
        } else if (pl == PL_MOE1 || pl == PL_MOE2) {
            const int* CNTg = (const int*)(ctl + L::CW_CNT) + l * NE;
            if (tid == 0) { int o = 0; for (int e = 0; e < NE; ++e) { const int cn = CNTg[e]; META[e] = o; META[64 + e] = cn; o += (cn + 255) >> 8; } META[NE] = o; }
            __syncthreads();
            g8::MoeSched S; S.tpre = META; S.cnt = META + 64; S.G = G; S.c = bx; S.K = D; S.list = (const int*)(ws + L::LIST) + (size_t)l * NE * LCAP;
            if (pl == PL_MOE1) {
                S.NT = 8; S.COLW = 128; S.total = __builtin_amdgcn_readfirstlane(META[NE]) * 8; S.Bt = (const char*)((const bf16_t*)(ws + L::WGUT) + (size_t)l * NE * 2048 * D);
                g8::EpiMoe1 E{(bf16_t*)(ws + L::ACT), args.in[26] + (size_t)l * NE * 2048};
                g8::gemm_phase<g8::EpiMoe1, g8::MoeSched, true, true>(lds, (const char*)(ws + L::XN), D, S, E);
            } else {
                S.NT = 4; S.COLW = 256; S.total = __builtin_amdgcn_readfirstlane(META[NE]) * 4; S.Bt = (const char*)((const bf16_t*)(ws + L::WDT) + (size_t)l * NE * D * D);
                g8::EpiMoe2 E{(bf16_t*)(ws + L::Y), args.in[28] + (size_t)l * NE * D, (const float*)(ws + L::GATE)};
                g8::gemm_phase<g8::EpiMoe2, g8::MoeSched, false, true>(lds, (const char*)(ws + L::ACT), D, S, E);
            }
            __syncthreads();
        }
    }
}
extern "C" void kernel_launch(void* const* d_in, const int* in_sizes, int n_in, void* d_out, int out_size, void* d_ws, size_t ws_size, hipStream_t stream) {
    const float* x = (const float*)d_in[0]; const float* c = (const float*)d_in[1]; const float* ctx = (const float*)d_in[2]; const float* c_ctx = (const float*)d_in[3];
    const float* mod_w = (const float*)d_in[4]; const float* mod_b = (const float*)d_in[5]; const float* norm1_g = (const float*)d_in[6]; const float* norm2_g = (const float*)d_in[7];
    const float* lru_conv_w = (const float*)d_in[9]; const float* lru_conv_b = (const float*)d_in[10]; const float* lru_w_a = (const float*)d_in[11];
    const float* lru_b_a = (const float*)d_in[12]; const float* lru_w_i = (const float*)d_in[13]; const float* lru_b_i = (const float*)d_in[14]; const float* lru_lambda = (const float*)d_in[15];
    const float* q_norm_g = (const float*)d_in[16]; const float* w_uq = (const float*)d_in[17]; const float* kv_norm_g = (const float*)d_in[18]; const float* w_ukv = (const float*)d_in[19];
    const float* sc_conv_w = (const float*)d_in[20]; const float* sc_conv_b = (const float*)d_in[21]; const float* router_w = (const float*)d_in[23];
    const float* router_b = (const float*)d_in[24]; const float* final_g = (const float*)d_in[29];
    float* out = (float*)d_out;
    unsigned char* p = (unsigned char*)d_ws;
    if (L::END > ws_size) { fprintf(stderr, "kernel_launch: workspace too small: need %zu have %zu\n", (size_t)L::END, ws_size); return; }
    static bool attr_done = false;
    if (!attr_done) { (void)hipFuncSetAttribute((const void*)mega, hipFuncAttributeMaxDynamicSharedMemorySize, LDS_BYTES); attr_done = true; }
    WS w;
    w.H = (float*)(p + L::H); w.MOD = (float*)(p + L::MOD); w.TABC = (float*)(p + L::TABC); w.TABS = (float*)(p + L::TABS); w.XN = (bf16_t*)(p + L::XN); w.P = (bf16_t*)(p + L::P); w.MIX = (bf16_t*)(p + L::MIX);
    w.CQN = (bf16_t*)(p + L::CQN); w.CKVN = (bf16_t*)(p + L::CKVN); w.QRAW = (float*)(p + L::QRAW); w.KVRAW = (float*)(p + L::KVRAW); w.QL = (bf16_t*)(p + L::QL); w.QC = (bf16_t*)(p + L::QC);
    w.KB = (bf16_t*)(p + L::KB); w.VB = (bf16_t*)(p + L::VB); w.LA = (float*)(p + L::LA); w.LB = (float*)(p + L::LB); w.HS = (float*)(p + L::HS); w.XCS = (float*)(p + L::XCS); w.XCSC = (float*)(p + L::XCSC);
    w.CNT = (int*)(p + L::CTL) + L::CW_CNT; w.OFFS = nullptr; w.LIST = (int*)(p + L::LIST); w.GATE = (float*)(p + L::GATE); w.ACT = (bf16_t*)(p + L::ACT); w.Y = (bf16_t*)(p + L::Y);
    MArgs a{};
    for (int i = 0; i < 30; ++i) a.in[i] = (const float*)d_in[i];
    a.out = out; a.ws = p;
    auto run_mega = [&](int lo, int hi) { a.ph_lo = lo; a.ph_hi = hi; hipLaunchKernelGGL(mega, dim3(256), dim3(512), LDS_BYTES, stream, a); };

    (void)hipMemsetAsync(p + L::CTL, 0, L::CTL_BYTES, stream);
    k_init<<<2048, 256, 0, stream>>>(x, ctx, w.H, w.TABC, w.TABS);
    k_mod<<<48, 256, 0, stream>>>(c, c_ctx, mod_w, mod_b, w.MOD);
    run_mega(PH_PRO0, PH_PRO0 + 1);
    for (int l = 0; l < 2; ++l) {
        const bool wctx = (l == 0); const float* MODl = w.MOD + (size_t)l * 5 * 6144; const int pb = PH_L0 + l * PH_PER_LAYER;
        k_norm_mod<<<MROWS / 4, 256, 0, stream>>>(w.H, norm1_g + l * D, MODl, 0, 1024, w.XN);
        run_mega(pb + PL_WIN, pb + PL_WIN + 1);
        run_mega(pb + PL_PREP, pb + PL_PREP + 1);
        run_mega(pb + PL_MIX, pb + PL_MIX + 1);
        if (wctx) k_four_ch<<<MROWS, 256, 0, stream>>>(w.P, w.TABC, w.TABS, w.XCS, w.XCSC, 1);
        if (wctx) k_gemm<ALDft, EPDft, 1><<<dim3(4, CTX / 64, 4), 256, 0, stream>>>(ALDft{w.TABC, w.TABS, 256, 16}, w.XCSC, 256, (long)512 * 256, 256, 512, 0, EPDft{w.MIX, 0, 1.f / 128.f});
        k_lru_gates<<<dim3(MROWS / 16, 2), 256, 0, stream>>>(w.P, lru_conv_w + (size_t)l * 2 * 4 * 256, lru_conv_b + l * 512, lru_w_a + (size_t)l * 2 * 4 * 64 * 64, lru_b_a + l * 512,
                                                          lru_w_i + (size_t)l * 2 * 4 * 64 * 64, lru_b_i + l * 512, lru_lambda + l * 512, w.LA, w.LB);
        k_lru_scan<<<dim3(4, 2), 256, 0, stream>>>(w.LA, w.LB, w.HS);
        k_lru_sc_out<<<MROWS, 256, 0, stream>>>(w.P, w.HS, sc_conv_w + l * 768, sc_conv_b + l * 256, w.MIX);
        k_lat_norm<<<MROWS / 4, 256, 0, stream>>>(w.P, q_norm_g + l * 256, kv_norm_g + l * 128, w.CQN, w.CKVN);
        k_gemm<ALBf16, EPF32, 1><<<dim3(384 / 64, MROWS / 64, 1), 256, 0, stream>>>(ALBf16{w.CQN, 256}, w_uq + (size_t)l * 256 * 384, 384, 0, 384, 256, 0, EPF32{w.QRAW, 384});
        k_gemm<ALBf16, EPF32, 1><<<dim3(512 / 64, MROWS / 64, 1), 256, 0, stream>>>(ALBf16{w.CKVN, 128}, w_ukv + (size_t)l * 128 * 512, 512, 0, 512, 128, 0, EPF32{w.KVRAW, 512});
        k_qkv_finish<<<MROWS, 256, 0, stream>>>(w.QRAW, w.KVRAW, w.P, w.QL, w.QC, w.KB, w.VB, wctx ? 1 : 0);
        k_attn<<<dim3(SEQ / 256, 16), 256, 0, stream>>>(w.QL, SEQ, w.KB, w.VB, NPOS, w.MIX, CTX);
        if (wctx) k_attn<<<dim3(1, 16), 256, 0, stream>>>(w.QC, CTX, w.KB, w.VB, CTX, w.MIX, 0);
        run_mega(pb + PL_WOUT, pb + PL_WOUT + 1);
        int* CNT = w.CNT + l * NE; int* LIST = w.LIST + (size_t)l * NE * LCAP;
        k_norm2_route<<<MROWS / 4, 256, 0, stream>>>(w.H, norm2_g + l * D, MODl, router_w + (size_t)l * D * NE, router_b + l * NE, w.XN, CNT, LIST, w.GATE, wctx ? 0 : 1);
        run_mega(pb + PL_MOE1, pb + PL_MOE1 + 1);
        run_mega(pb + PL_MOE2, pb + PL_MOE2 + 1);
        k_moe_combine<<<MROWS / 4, 256, 0, stream>>>(w.H, w.Y, MODl, wctx ? 0 : 1, l == 1 ? final_g : nullptr, l == 1 ? out : nullptr);
    }
}
```

```cpp
#include <hip/hip_runtime.h>
#include <cstdint>
#include <cstdio>

typedef unsigned short bf16_t;
constexpr int NB_ = 4, SEQ = 4096, CTX = 256, D = 1024, NPOS = SEQ + CTX, MROWS = NB_ * NPOS;
constexpr int PT = 1952, PP = 2048;
constexpr int NE = 32, TOPK = 4, LCAP = MROWS;
constexpr int NASG = MROWS * TOPK;
constexpr int ACT_ROWS = NASG + NE * 256;
constexpr int C_FN = 0, C_LX = 256, C_LG = 512, C_CQ = 768, C_CKV = 1024, C_KR = 1152, C_SX = 1184, C_SB = 1440, C_SC = 1696;

__device__ __forceinline__ float bf2f(bf16_t v) { return __uint_as_float((unsigned)v << 16); }
__device__ __forceinline__ bf16_t f2bf(float f) { unsigned u = __float_as_uint(f); return (bf16_t)((u + 0x7fffu + ((u >> 16) & 1u)) >> 16); }
__device__ __forceinline__ float wave_sum(float v) {
#pragma unroll
    for (int o = 1; o < 64; o <<= 1) v += __shfl_xor(v, o);
    return v;
}
__device__ __forceinline__ float sigmoidf_(float x) { return 1.f / (1.f + __expf(-x)); }
__device__ __forceinline__ float gelu_tanh(float x) { const float u = 0.7978845608028654f * (x + 0.044715f * x * x * x); return 0.5f * x * (1.f + tanhf(u)); }

struct WS {
    float* H; float* MOD; float* TABC; float* TABS; bf16_t* XN; bf16_t* P; bf16_t* MIX; bf16_t* CQN; bf16_t* CKVN; float* QRAW; float* KVRAW;
    bf16_t* QL; bf16_t* QC; bf16_t* KB; bf16_t* VB; float* LA; float* LB; float* HS; float* XCS; float* XCSC;
    int* CNT; int* OFFS; int* LIST; float* GATE; bf16_t* ACT; bf16_t* Y;
};

__global__ void k_init(const float* x, const float* ctx, float* H, float* TABC, float* TABS) {
    const size_t n4 = (size_t)MROWS * D / 4;
    for (size_t i = (size_t)blockIdx.x * blockDim.x + threadIdx.x; i < n4; i += (size_t)gridDim.x * blockDim.x) {
        const size_t e = i * 4; const int r = (int)(e / D), c = (int)(e % D); const int b = r / NPOS, pos = r % NPOS;
        const float4 v = pos < CTX ? *(const float4*)(ctx + ((size_t)b * CTX + pos) * D + c) : *(const float4*)(x + ((size_t)b * SEQ + (pos - CTX)) * D + c);
        *(float4*)(H + e) = v;
    }
    const int t = blockIdx.x * blockDim.x + threadIdx.x;
    if (t < 4096) { float s, c; sincospif((float)t / 2048.f, &s, &c); TABC[t] = c; TABS[t] = s; }
}

__global__ __launch_bounds__(256) void k_mod(const float* c, const float* c_ctx, const float* mod_w, const float* mod_b, float* MOD) {
    __shared__ float s[5][1024];
    for (int i = threadIdx.x; i < 5 * 1024; i += 256) { const int v = i >> 10, k = i & 1023; const float x = v < 4 ? c[v * 1024 + k] : c_ctx[k]; s[v][k] = x / (1.f + __expf(-x)); }
    __syncthreads();
    const int idx = blockIdx.x * 256 + threadIdx.x; const int l = idx / 6144, col = idx % 6144;
    const float* W = mod_w + (size_t)l * 1024 * 6144 + col;
    float a0 = 0, a1 = 0, a2 = 0, a3 = 0, a4 = 0;
#pragma unroll 8
    for (int k = 0; k < 1024; ++k) { const float w = W[(size_t)k * 6144]; a0 += s[0][k] * w; a1 += s[1][k] * w; a2 += s[2][k] * w; a3 += s[3][k] * w; a4 += s[4][k] * w; }
    const float bb = mod_b[l * 6144 + col];
    float* M = MOD + (size_t)l * 5 * 6144 + col;
    M[0] = a0 + bb; M[6144] = a1 + bb; M[2 * 6144] = a2 + bb; M[3 * 6144] = a3 + bb; M[4 * 6144] = a4 + bb;
}

__global__ __launch_bounds__(256) void k_norm_mod(const float* H, const float* g, const float* MODl, int sh_off, int sc_off, bf16_t* XN) {
    const int lane = threadIdx.x & 63, r = blockIdx.x * 4 + (threadIdx.x >> 6);
    const int b = r / NPOS, pos = r % NPOS, v = pos < CTX ? 4 : b;
    const float* mv = MODl + (size_t)v * 6144;
    float4 x[4]; float ss = 0.f;
#pragma unroll
    for (int j = 0; j < 4; ++j) { x[j] = *(const float4*)(H + (size_t)r * D + (j * 64 + lane) * 4); ss += x[j].x * x[j].x + x[j].y * x[j].y + x[j].z * x[j].z + x[j].w * x[j].w; }
    const float rs = rsqrtf(wave_sum(ss) * (1.f / D) + 1e-6f);
#pragma unroll
    for (int j = 0; j < 4; ++j) { const int c = (j * 64 + lane) * 4; const float4 gg = *(const float4*)(g + c), sh = *(const float4*)(mv + sh_off + c), sc = *(const float4*)(mv + sc_off + c);
        ushort4 o; o.x = f2bf(x[j].x * rs * gg.x * (1.f + sc.x) + sh.x); o.y = f2bf(x[j].y * rs * gg.y * (1.f + sc.y) + sh.y); o.z = f2bf(x[j].z * rs * gg.z * (1.f + sc.z) + sh.z); o.w = f2bf(x[j].w * rs * gg.w * (1.f + sc.w) + sh.w);
        *(ushort4*)(XN + (size_t)r * D + c) = o; }
}

template <class AL, class EP, int NBK>
__global__ __launch_bounds__(256) void k_gemm(AL alp, const float* W, int ldw, long wz, int N, int K, int colB2, EP epp) {
    __shared__ float As[16][68];
    __shared__ float Bs[NBK][16][68];
    AL al = alp; EP ep = epp;
    const int tx = threadIdx.x & 15, ty = threadIdx.x >> 4, m0 = blockIdx.y * 64, n0 = blockIdx.x * 64, z = blockIdx.z;
    if (!al.init(m0, z)) return;
    ep.init(m0, z);
    const float* Wz = W + al.woff() + (size_t)z * wz;
    float acc[NBK][4][4];
#pragma unroll
    for (int nb = 0; nb < NBK; ++nb)
#pragma unroll
        for (int i = 0; i < 4; ++i)
#pragma unroll
            for (int j = 0; j < 4; ++j) acc[nb][i][j] = 0.f;
    const int am = threadIdx.x >> 2, ak = (threadIdx.x & 3) * 4, bk = threadIdx.x >> 4, bn = (threadIdx.x & 15) * 4;
    for (int k0 = 0; k0 < K; k0 += 16) {
        { float v[4]; al.load4(z, m0 + am, k0 + ak, v); As[ak + 0][am] = v[0]; As[ak + 1][am] = v[1]; As[ak + 2][am] = v[2]; As[ak + 3][am] = v[3]; }
#pragma unroll
        for (int nb = 0; nb < NBK; ++nb) { const int col = n0 + bn; float4 w = make_float4(0.f, 0.f, 0.f, 0.f);
            if (col + 3 < N) w = *(const float4*)(Wz + (size_t)(k0 + bk) * ldw + col + nb * colB2);
            *(float4*)&Bs[nb][bk][bn] = w; }
        __syncthreads();
#pragma unroll
        for (int kk = 0; kk < 16; ++kk) {
            const float4 a = *(const float4*)&As[kk][ty * 4];
#pragma unroll
            for (int nb = 0; nb < NBK; ++nb) { const float4 b = *(const float4*)&Bs[nb][kk][tx * 4];
                acc[nb][0][0] += a.x * b.x; acc[nb][0][1] += a.x * b.y; acc[nb][0][2] += a.x * b.z; acc[nb][0][3] += a.x * b.w;
                acc[nb][1][0] += a.y * b.x; acc[nb][1][1] += a.y * b.y; acc[nb][1][2] += a.y * b.z; acc[nb][1][3] += a.y * b.w;
                acc[nb][2][0] += a.z * b.x; acc[nb][2][1] += a.z * b.y; acc[nb][2][2] += a.z * b.z; acc[nb][2][3] += a.z * b.w;
                acc[nb][3][0] += a.w * b.x; acc[nb][3][1] += a.w * b.y; acc[nb][3][2] += a.w * b.z; acc[nb][3][3] += a.w * b.w; }
        }
        __syncthreads();
    }
#pragma unroll
    for (int i = 0; i < 4; ++i)
#pragma unroll
        for (int j = 0; j < 4; ++j) { const int col = n0 + tx * 4 + j; if (col < N) ep.store(z, m0 + ty * 4 + i, col, acc[0][i][j], acc[NBK - 1][i][j]); }
}

struct ALBf16 { const bf16_t* A; int lda, pad;
    __device__ bool init(int, int) { return true; } __device__ size_t woff() const { return 0; }
    __device__ void load4(int, int row, int k, float* v) const { const ushort4 w = *(const ushort4*)(A + (size_t)row * lda + k); v[0] = bf2f(w.x); v[1] = bf2f(w.y); v[2] = bf2f(w.z); v[3] = bf2f(w.w); } };
struct ALDft { const float* TC; const float* TS; int n, ts;
    __device__ bool init(int, int) { return true; } __device__ size_t woff() const { return 0; }
    __device__ void load4(int, int row, int k, float* v) const {
#pragma unroll
        for (int j = 0; j < 4; ++j) { const int t = k + j; if (t < n) v[j] = TC[((row * t) & (n - 1)) * ts]; else v[j] = -TS[((row * (t - n)) & (n - 1)) * ts]; } } };
struct ALMoe1 { const bf16_t* XN; const int* offs; const int* cnt; const int* list; int e, base, n, pad;
    __device__ bool init(int m0, int) { if (m0 >= offs[NE]) return false; int ee = 0; for (int i = 1; i < NE; ++i) if (m0 >= offs[i]) ee = i; e = ee; base = offs[ee]; n = cnt[ee]; return true; }
    __device__ size_t woff() const { return (size_t)e * 1024 * 2048; }
    __device__ void load4(int, int row, int k, float* v) const { const int i = row - base; const int tok = i < n ? (list[(size_t)e * LCAP + i] >> 2) : 0;
        const ushort4 w = *(const ushort4*)(XN + (size_t)tok * D + k); v[0] = bf2f(w.x); v[1] = bf2f(w.y); v[2] = bf2f(w.z); v[3] = bf2f(w.w); } };
struct ALMoe2 { const bf16_t* ACT; const int* offs; int e, pad;
    __device__ bool init(int m0, int) { if (m0 >= offs[NE]) return false; int ee = 0; for (int i = 1; i < NE; ++i) if (m0 >= offs[i]) ee = i; e = ee; return true; }
    __device__ size_t woff() const { return (size_t)e * 1024 * 1024; }
    __device__ void load4(int, int row, int k, float* v) const { const ushort4 w = *(const ushort4*)(ACT + (size_t)row * D + k); v[0] = bf2f(w.x); v[1] = bf2f(w.y); v[2] = bf2f(w.z); v[3] = bf2f(w.w); } };

struct EPBf16 { bf16_t* C; int ldc, pad; __device__ void init(int, int) {} __device__ void store(int, int r, int c, float a, float) const { C[(size_t)r * ldc + c] = f2bf(a); } };
struct EPF32 { float* C; int ldc, pad; __device__ void init(int, int) {} __device__ void store(int, int r, int c, float a, float) const { C[(size_t)r * ldc + c] = a; } };
struct EPDft { bf16_t* MIX; int rowoff; float scale; __device__ void init(int, int) {} __device__ void store(int z, int r, int c, float a, float) const { MIX[((size_t)z * NPOS + rowoff + r) * D + c] = f2bf(a * scale); } };
struct EPRes { float* H; const float* MODl; int g_off, pad; __device__ void init(int, int) {}
    __device__ void store(int, int r, int c, float a, float) const { const int b = r / NPOS, pos = r % NPOS, v = pos < CTX ? 4 : b; H[(size_t)r * D + c] += MODl[(size_t)v * 6144 + g_off + c] * a; } };
struct EPMoe1 { bf16_t* ACT; const float* bgu; const int* offs; const int* cnt; int e, base, n, pad;
    __device__ void init(int m0, int) { int ee = 0; for (int i = 1; i < NE; ++i) if (m0 >= offs[i]) ee = i; e = ee; base = offs[ee]; n = cnt[ee]; }
    __device__ void store(int, int r, int c, float ag, float au) const {
        float o = 0.f; if (r - base < n) { const float g = fminf(ag + bgu[(size_t)e * 2048 + c], 7.f); const float u = fminf(fmaxf(au + bgu[(size_t)e * 2048 + 1024 + c], -7.f), 7.f); o = (u + 1.f) * g * sigmoidf_(1.702f * g); }
        ACT[(size_t)r * D + c] = f2bf(o); } };
struct EPMoe2 { bf16_t* Y; const float* bd; const float* GATE; const int* offs; const int* cnt; const int* list; int e, base, n, pad;
    __device__ void init(int m0, int) { int ee = 0; for (int i = 1; i < NE; ++i) if (m0 >= offs[i]) ee = i; e = ee; base = offs[ee]; n = cnt[ee]; }
    __device__ void store(int, int r, int c, float a, float) const { const int i = r - base; if (i < n) { const int asg = list[(size_t)e * LCAP + i]; Y[(size_t)asg * D + c] = f2bf(GATE[asg] * (a + bd[(size_t)e * 1024 + c])); } } };

__global__ __launch_bounds__(256) void k_four_ch(const bf16_t* P, const float* TC, const float* TS, float* XCS, float* XCSC, int with_ctx) {
    __shared__ float u[256];
    const int r = blockIdx.x, b = r / NPOS, pos = r % NPOS;
    if (pos >= CTX) return;
    u[threadIdx.x] = bf2f(P[(size_t)r * PP + C_FN + threadIdx.x]);
    __syncthreads();
    const int g = threadIdx.x >> 6, k = threadIdx.x & 63; float ac = 0.f, as = 0.f;
#pragma unroll 8
    for (int c = 0; c < 64; ++c) { const int i = ((k * c) & 63) * 64; const float x = u[g * 64 + c]; ac += x * TC[i]; as += x * TS[i]; }
    if (pos >= CTX) { const int t = pos - CTX; XCS[((size_t)b * 8192 + t) * 256 + threadIdx.x] = ac; XCS[((size_t)b * 8192 + 4096 + t) * 256 + threadIdx.x] = as; }
    else { XCSC[((size_t)b * 512 + pos) * 256 + threadIdx.x] = ac; XCSC[((size_t)b * 512 + 256 + pos) * 256 + threadIdx.x] = as; }
}

__global__ __launch_bounds__(256) void k_lru_gates(const bf16_t* P, const float* conv_w, const float* conv_b, const float* w_a, const float* b_a, const float* w_i, const float* b_i, const float* lam,
                                                    float* LA, float* LB) {
    __shared__ float xs[16][256];
    const int dir = blockIdx.y, r0 = blockIdx.x * 16, c = threadIdx.x;
    const int b = r0 / NPOS, pos0 = r0 % NPOS; const int lo = pos0 < CTX ? 0 : CTX, hi = pos0 < CTX ? CTX : NPOS;
    const int left = dir ? 1 : 2;
    const float* cw = conv_w + (size_t)dir * 4 * 256; const float cb = conv_b[dir * 256 + c];
    float xc[16];
#pragma unroll
    for (int i = 0; i < 16; ++i) { float a = cb;
#pragma unroll
        for (int k = 0; k < 4; ++k) { const int p = pos0 + i - left + k; if (p >= lo && p < hi) a += cw[k * 256 + c] * bf2f(P[((size_t)b * NPOS + p) * PP + C_LX + c]); }
        xc[i] = a; xs[i][c] = a; }
    __syncthreads();
    const int h = c >> 6, e = c & 63;
    const float* wa = w_a + ((size_t)(dir * 4 + h) * 64) * 64 + e; const float* wi = w_i + ((size_t)(dir * 4 + h) * 64) * 64 + e;
    float ra[16], ri[16];
#pragma unroll
    for (int i = 0; i < 16; ++i) { ra[i] = 0.f; ri[i] = 0.f; }
    for (int d = 0; d < 64; ++d) { const float va = wa[d * 64], vi = wi[d * 64];
#pragma unroll
        for (int i = 0; i < 16; ++i) { const float x = xs[i][h * 64 + d]; ra[i] += x * va; ri[i] += x * vi; } }
    const float ba = b_a[dir * 256 + c], bi = b_i[dir * 256 + c]; const float sp = log1pf(__expf(-lam[dir * 256 + c]));
#pragma unroll
    for (int i = 0; i < 16; ++i) { const float rr = sigmoidf_(ra[i] + ba), ii = sigmoidf_(ri[i] + bi); const float a = __expf(-8.f * rr * sp);
        const float bt = sqrtf(fmaxf(1.f - a * a, 0.f)) * (ii * xc[i]);
        LA[((size_t)dir * MROWS + r0 + i) * 256 + c] = a; LB[((size_t)dir * MROWS + r0 + i) * 256 + c] = bt; }
}
__global__ __launch_bounds__(256) void k_lru_scan(const float* LA, const float* LB, float* HS) {
    const int c = threadIdx.x, b = blockIdx.x, dir = blockIdx.y;
    const float* a = LA + ((size_t)dir * MROWS + (size_t)b * NPOS) * 256 + c; const float* bb = LB + ((size_t)dir * MROWS + (size_t)b * NPOS) * 256 + c;
    float* hs = HS + ((size_t)dir * MROWS + (size_t)b * NPOS) * 256 + c;
    float h = 0.f;
    if (dir == 0) {
#pragma unroll 8
        for (int p = 0; p < NPOS; ++p) { h = a[(size_t)p * 256] * h + bb[(size_t)p * 256]; hs[(size_t)p * 256] = h; }
    } else {
#pragma unroll 8
        for (int p = CTX - 1; p >= 0; --p) { h = a[(size_t)p * 256] * h + bb[(size_t)p * 256]; hs[(size_t)p * 256] = h; }
#pragma unroll 8
        for (int p = NPOS - 1; p >= CTX; --p) { h = a[(size_t)p * 256] * h + bb[(size_t)p * 256]; hs[(size_t)p * 256] = h; }
    }
}
__global__ __launch_bounds__(256) void k_lru_sc_out(const bf16_t* P, const float* HS, const float* scw, const float* scb, bf16_t* MIX) {
    const int r = blockIdx.x, c = threadIdx.x, b = r / NPOS, pos = r % NPOS; const int lo = pos < CTX ? 0 : CTX, hi = pos < CTX ? CTX : NPOS;
    const float lg = bf2f(P[(size_t)r * PP + C_LG + c]);
    MIX[(size_t)r * D + 256 + c] = f2bf(gelu_tanh(lg) * (HS[(size_t)r * 256 + c] + HS[((size_t)MROWS + r) * 256 + c]));
    float a = scb[c];
#pragma unroll
    for (int k = 0; k < 3; ++k) { const int p = pos - 1 + k; if (p >= lo && p < hi) { const size_t rr = (size_t)b * NPOS + p; a += scw[k * 256 + c] * (bf2f(P[rr * PP + C_SC + c]) * bf2f(P[rr * PP + C_SX + c])); } }
    MIX[(size_t)r * D + 768 + c] = f2bf(bf2f(P[(size_t)r * PP + C_SB + c]) * a);
}

__global__ __launch_bounds__(256) void k_lat_norm(const bf16_t* P, const float* qg, const float* kvg, bf16_t* CQN, bf16_t* CKVN) {
    const int lane = threadIdx.x & 63, r = blockIdx.x * 4 + (threadIdx.x >> 6);
    float q[4], ss = 0.f;
#pragma unroll
    for (int j = 0; j < 4; ++j) { q[j] = bf2f(P[(size_t)r * PP + C_CQ + j * 64 + lane]); ss += q[j] * q[j]; }
    const float rq = rsqrtf(wave_sum(ss) * (1.f / 256.f) + 1e-6f);
#pragma unroll
    for (int j = 0; j < 4; ++j) CQN[(size_t)r * 256 + j * 64 + lane] = f2bf(q[j] * rq * qg[j * 64 + lane]);
    float k2[2]; ss = 0.f;
#pragma unroll
    for (int j = 0; j < 2; ++j) { k2[j] = bf2f(P[(size_t)r * PP + C_CKV + j * 64 + lane]); ss += k2[j] * k2[j]; }
    const float rk = rsqrtf(wave_sum(ss) * (1.f / 128.f) + 1e-6f);
#pragma unroll
    for (int j = 0; j < 2; ++j) CKVN[(size_t)r * 128 + j * 64 + lane] = f2bf(k2[j] * rk * kvg[j * 64 + lane]);
}
__device__ __forceinline__ float rope_elem(const float* z  , int i, int row, int col) {
    const int hs = i >> 4, w = i & 15, j = w & 7; const float pos = (float)(hs ? col : row);
    const float inv = __expf(-9.210340371976184f * (float)j * 0.125f); float s, c; sincosf(pos * inv, &s, &c);
    const float z1 = z[hs * 16 + j], z2 = z[hs * 16 + 8 + j];
    return w < 8 ? z1 * c - z2 * s : z1 * s + z2 * c;
}
__global__ __launch_bounds__(256) void k_qkv_finish(const float* QRAW, const float* KVRAW, const bf16_t* P, bf16_t* QL, bf16_t* QC, bf16_t* KB, bf16_t* VB, int with_ctx_q) {
    __shared__ float zq[4][32]; __shared__ float zk[32];
    const int r = blockIdx.x, b = r / NPOS, pos = r % NPOS; const bool lat = pos >= CTX; const int t = pos - CTX, row = t >> 6, col = t & 63;
    if (threadIdx.x < 128) zq[threadIdx.x >> 5][threadIdx.x & 31] = QRAW[(size_t)r * 384 + (threadIdx.x >> 5) * 96 + 64 + (threadIdx.x & 31)];
    else if (threadIdx.x < 160) zk[threadIdx.x - 128] = bf2f(P[(size_t)r * PP + C_KR + threadIdx.x - 128]);
    __syncthreads();
    for (int i = threadIdx.x; i < 384; i += 256) { const int h = i / 96, d = i % 96;
        float q; if (d < 64) q = QRAW[(size_t)r * 384 + i]; else q = lat ? rope_elem(zq[h], d - 64, row, col) : zq[h][d - 64];
        if (lat) QL[((size_t)(b * 4 + h) * SEQ + t) * 96 + d] = f2bf(q); else if (with_ctx_q) QC[((size_t)(b * 4 + h) * CTX + pos) * 96 + d] = f2bf(q);
        float k; if (d < 64) k = KVRAW[(size_t)r * 512 + h * 128 + d]; else k = lat ? rope_elem(zk, d - 64, row, col) : zk[d - 64];
        KB[((size_t)(b * 4 + h) * NPOS + pos) * 96 + d] = f2bf(k); }
    { const int h = threadIdx.x >> 6, d = threadIdx.x & 63; VB[((size_t)(b * 4 + h) * 64 + d) * NPOS + pos] = f2bf(KVRAW[(size_t)r * 512 + h * 128 + 64 + d]); }
}
__global__ __launch_bounds__(256) void k_attn(const bf16_t* Q, int nq, const bf16_t* KB, const bf16_t* VB, int nkeys, bf16_t* MIX, int out_pos_off) {
    __shared__ float Ks[64][96]; __shared__ float Vs[64][64];
    const int bh = blockIdx.y, qi = blockIdx.x * 256 + threadIdx.x, b = bh >> 2, h = bh & 3;
    float q[96], o[64];
    { const bf16_t* qp = Q + ((size_t)bh * nq + qi) * 96;
#pragma unroll
      for (int d = 0; d < 96; ++d) q[d] = bf2f(qp[d]) * 0.10206207261596577f; }
#pragma unroll
    for (int d = 0; d < 64; ++d) o[d] = 0.f;
    float m = -1e30f, l = 0.f;
    for (int k0 = 0; k0 < nkeys; k0 += 64) {
        __syncthreads();
        for (int i = threadIdx.x; i < 64 * 96; i += 256) Ks[i / 96][i % 96] = bf2f(KB[((size_t)bh * NPOS + k0) * 96 + i]);
        for (int i = threadIdx.x; i < 64 * 64; i += 256) Vs[i >> 6][i & 63] = bf2f(VB[((size_t)bh * NPOS + k0) * 64 + i]);
        __syncthreads();
        for (int j = 0; j < 64; ++j) {
            float s = 0.f;
#pragma unroll
            for (int d = 0; d < 96; d += 4) { const float4 kk = *(const float4*)&Ks[j][d]; s += q[d] * kk.x + q[d + 1] * kk.y + q[d + 2] * kk.z + q[d + 3] * kk.w; }
            const float mn = fmaxf(m, s), corr = __expf(m - mn), p = __expf(s - mn); m = mn; l = l * corr + p;
#pragma unroll
            for (int d = 0; d < 64; d += 4) { const float4 vv = *(const float4*)&Vs[j][d]; o[d] = o[d] * corr + p * vv.x; o[d + 1] = o[d + 1] * corr + p * vv.y; o[d + 2] = o[d + 2] * corr + p * vv.z; o[d + 3] = o[d + 3] * corr + p * vv.w; }
        }
    }
    const float il = 1.f / l; bf16_t* op = MIX + ((size_t)b * NPOS + out_pos_off + qi) * D + 512 + h * 64;
#pragma unroll
    for (int d = 0; d < 64; ++d) op[d] = f2bf(o[d] * il);
}

__global__ __launch_bounds__(256) void k_norm2_route(const float* H, const float* g, const float* MODl, const float* rw, const float* rb, bf16_t* XN, int* CNT, int* LIST, float* GATE, int skip_ctx) {
    __shared__ float fs[4][1024]; __shared__ float lg[4][32];
    const int w = threadIdx.x >> 6, lane = threadIdx.x & 63, r = blockIdx.x * 4 + w;
    const int b = r / NPOS, pos = r % NPOS, v = pos < CTX ? 4 : b; const bool act = !(skip_ctx && pos < CTX);
    const float* mv = MODl + (size_t)v * 6144;
    float4 x[4]; float ss = 0.f;
#pragma unroll
    for (int j = 0; j < 4; ++j) { x[j] = *(const float4*)(H + (size_t)r * D + (j * 64 + lane) * 4); ss += x[j].x * x[j].x + x[j].y * x[j].y + x[j].z * x[j].z + x[j].w * x[j].w; }
    const float rs = rsqrtf(wave_sum(ss) * (1.f / D) + 1e-6f);
#pragma unroll
    for (int j = 0; j < 4; ++j) { const int c = (j * 64 + lane) * 4; const float4 gg = *(const float4*)(g + c), sh = *(const float4*)(mv + 3072 + c), sc = *(const float4*)(mv + 4096 + c);
        float4 f; f.x = x[j].x * rs * gg.x * (1.f + sc.x) + sh.x; f.y = x[j].y * rs * gg.y * (1.f + sc.y) + sh.y; f.z = x[j].z * rs * gg.z * (1.f + sc.z) + sh.z; f.w = x[j].w * rs * gg.w * (1.f + sc.w) + sh.w;
        *(float4*)&fs[w][c] = f; ushort4 o; o.x = f2bf(f.x); o.y = f2bf(f.y); o.z = f2bf(f.z); o.w = f2bf(f.w); *(ushort4*)(XN + (size_t)r * D + c) = o; }
    __syncthreads();
    { const int e = lane & 31, half = lane >> 5; float a = 0.f;
#pragma unroll 8
      for (int k = half * 512; k < half * 512 + 512; ++k) a += fs[w][k] * rw[k * 32 + e];
      a += __shfl_xor(a, 32); if (lane < 32) lg[w][e] = a + rb[e]; }
    __syncthreads();
    if (lane == 0 && act) {
        float vals[4]; int idx[4]; unsigned used = 0u;
#pragma unroll
        for (int k = 0; k < 4; ++k) { float best = -3e38f; int bi = 0; for (int e = 0; e < 32; ++e) { const float xx = lg[w][e]; if (!((used >> e) & 1u) && xx > best) { best = xx; bi = e; } } used |= 1u << bi; vals[k] = best; idx[k] = bi; }
        float ex[4], sum = 0.f;
#pragma unroll
        for (int k = 0; k < 4; ++k) { ex[k] = __expf(vals[k] - vals[0]); sum += ex[k]; }
#pragma unroll
        for (int k = 0; k < 4; ++k) { const int asg = r * 4 + k; GATE[asg] = ex[k] / sum; const int p = atomicAdd(&CNT[idx[k]], 1); LIST[(size_t)idx[k] * LCAP + p] = asg; }
    }
}
__global__ void k_moe_offsets(const int* CNT, int* OFFS) { if (threadIdx.x == 0 && blockIdx.x == 0) { int o = 0; for (int e = 0; e < NE; ++e) { OFFS[e] = o; o += (CNT[e] + 255) / 256 * 256; } OFFS[NE] = o; } }
__global__ __launch_bounds__(256) void k_moe_combine(float* H, const bf16_t* Y, const float* MODl, int skip_ctx, const float* final_g, float* out) {
    const int lane = threadIdx.x & 63, r = blockIdx.x * 4 + (threadIdx.x >> 6); const int b = r / NPOS, pos = r % NPOS, v = pos < CTX ? 4 : b;
    if (skip_ctx && pos < CTX) return;
    const float* g2 = MODl + (size_t)v * 6144 + 5120;
    float4 x[4]; float ss = 0.f;
#pragma unroll
    for (int j = 0; j < 4; ++j) { const int c = (j * 64 + lane) * 4; x[j] = *(const float4*)(H + (size_t)r * D + c); float4 s = make_float4(0.f, 0.f, 0.f, 0.f);
#pragma unroll
        for (int k = 0; k < 4; ++k) { const ushort4 y = *(const ushort4*)(Y + ((size_t)r * 4 + k) * D + c); s.x += bf2f(y.x); s.y += bf2f(y.y); s.z += bf2f(y.z); s.w += bf2f(y.w); }
        const float4 gg = *(const float4*)(g2 + c); x[j].x += gg.x * s.x; x[j].y += gg.y * s.y; x[j].z += gg.z * s.z; x[j].w += gg.w * s.w;
        *(float4*)(H + (size_t)r * D + c) = x[j]; ss += x[j].x * x[j].x + x[j].y * x[j].y + x[j].z * x[j].z + x[j].w * x[j].w; }
    if (out) { const float rs = rsqrtf(wave_sum(ss) * (1.f / D) + 1e-6f); float* op = out + ((size_t)b * SEQ + (pos - CTX)) * D;
#pragma unroll
        for (int j = 0; j < 4; ++j) { const int c = (j * 64 + lane) * 4; const float4 fg = *(const float4*)(final_g + c); float4 o; o.x = x[j].x * rs * fg.x; o.y = x[j].y * rs * fg.y; o.z = x[j].z * rs * fg.z; o.w = x[j].w * rs * fg.w; *(float4*)(op + c) = o; } }
}

#define LAS __attribute__((address_space(3)))
typedef short bf16x8 __attribute__((ext_vector_type(8)));
typedef float f32x4 __attribute__((ext_vector_type(4)));
typedef unsigned u32x4 __attribute__((ext_vector_type(4)));
typedef unsigned u32x2 __attribute__((ext_vector_type(2)));
__device__ __forceinline__ unsigned pk2(float lo, float hi) { return (unsigned)f2bf(lo) | ((unsigned)f2bf(hi) << 16); }

namespace L {
constexpr size_t A256(size_t x) { return (x + 255) & ~(size_t)255; }
constexpr size_t CTL = 0, CTL_BYTES = 1u << 20;
constexpr size_t H = CTL + CTL_BYTES;
constexpr size_t MOD = A256(H + (size_t)MROWS * D * 4);
constexpr size_t TABC = A256(MOD + 2 * 5 * 6144 * 4);
constexpr size_t TABS = A256(TABC + 4096 * 4);
constexpr size_t XN = A256(TABS + 4096 * 4);
constexpr size_t P = A256(XN + (size_t)MROWS * D * 2);
constexpr size_t MIX = A256(P + (size_t)MROWS * PP * 2);
constexpr size_t CQN = A256(MIX + (size_t)MROWS * D * 2);
constexpr size_t CKVN = A256(CQN + (size_t)MROWS * 256 * 2);
constexpr size_t QRAW = A256(CKVN + (size_t)MROWS * 128 * 2);
constexpr size_t KVRAW = A256(QRAW + (size_t)MROWS * 384 * 4);
constexpr size_t QL = A256(KVRAW + (size_t)MROWS * 512 * 4);
constexpr size_t QC = A256(QL + (size_t)16 * SEQ * 96 * 2);
constexpr size_t KB = A256(QC + (size_t)16 * CTX * 96 * 2);
constexpr size_t VB = A256(KB + (size_t)16 * NPOS * 96 * 2);
constexpr size_t LA = A256(VB + (size_t)16 * NPOS * 64 * 2);
constexpr size_t LB = A256(LA + (size_t)2 * MROWS * 256 * 4);
constexpr size_t HS = A256(LB + (size_t)2 * MROWS * 256 * 4);
constexpr size_t XCS = A256(HS + (size_t)2 * MROWS * 256 * 4);
constexpr size_t XCSC = A256(XCS + (size_t)4 * 8192 * 256 * 4);
constexpr size_t LIST = A256(XCSC + (size_t)4 * 512 * 256 * 4);
constexpr size_t GATE = A256(LIST + (size_t)2 * NE * LCAP * 4);
constexpr size_t ACT = A256(GATE + (size_t)NASG * 4);
constexpr size_t Y = A256(ACT + (size_t)ACT_ROWS * D * 2);
constexpr size_t WINT = A256(Y + (size_t)NASG * D * 2);
constexpr size_t WOUTT = A256(WINT + (size_t)2 * 2048 * 1024 * 2);
constexpr size_t WGUT = A256(WOUTT + (size_t)2 * 1024 * 1024 * 2);
constexpr size_t WDT = A256(WGUT + (size_t)2 * NE * 2048 * 1024 * 2);
constexpr size_t ZBUF = A256(WDT + (size_t)2 * NE * 1024 * 1024 * 2);
constexpr size_t VTG = A256(ZBUF + (size_t)4 * 64 * 64 * 512 * 2);
constexpr size_t END = A256(VTG + (size_t)16 * 64 * NPOS * 2);
constexpr int CW_BAR = 4096;
constexpr int CW_CNT = 32768;
}

#define XB_TMO      128
#define XB_XCNT(j)  (256  + 64 * (j))
#define XB_XSUB(j)  (1280 + 64 * (j))
#define XB_XGEN(j)  (2304 + 64 * (j))
#define XB_TOP      3328
#define XB_TOPGEN   3392
#define XCD_BAR_WORDS 3456
#define XB_SPIN_CAP (1u << 18)
__device__ __forceinline__ unsigned xb_ld(unsigned* p)              { return __hip_atomic_load(p, __ATOMIC_RELAXED, __HIP_MEMORY_SCOPE_AGENT); }
__device__ __forceinline__ unsigned xb_add(unsigned* p, unsigned v) { return __hip_atomic_fetch_add(p, v, __ATOMIC_RELAXED, __HIP_MEMORY_SCOPE_AGENT); }
__device__ __forceinline__ unsigned xb_xcc_id() { return (unsigned)__builtin_amdgcn_s_getreg((3 << 11) | 20) & 0xFu; }
#define XB_SPIN(cond, bar) do { unsigned _sp = 0; while (cond) { __builtin_amdgcn_s_sleep(1); \
    if ((++_sp & 255u) == 0u) { if (xb_ld(&(bar)[XB_TMO])) break; if (_sp > XB_SPIN_CAP) { atomicAdd(&(bar)[XB_TMO], 1u); break; } } } } while (0)
struct XcdBarrier { unsigned* bar; unsigned x; volatile LAS unsigned* st; };
__device__ __forceinline__ XcdBarrier xcd_barrier_post(unsigned* bar, volatile LAS unsigned* st) {
    XcdBarrier b; b.bar = bar; b.x = xb_xcc_id(); b.st = st;
    if (threadIdx.x == 0) (void)xb_add(&bar[XB_XCNT(b.x)], 1u);
    return b;
}
__device__ __forceinline__ void xcd_barrier_complete(unsigned* bar, unsigned x, unsigned& nloc, unsigned& nx) {
    const unsigned G = gridDim.x * gridDim.y * gridDim.z;
    unsigned sum, cnt, mine, sp = 0u;
    for (;;) {
        sum = 0u; cnt = 0u; mine = 0u;
#pragma unroll
        for (unsigned j = 0; j < 16; ++j) { const unsigned c = xb_ld(&bar[XB_XCNT(j)]); sum += c; cnt += (c > 0u) ? 1u : 0u; mine = (j == x) ? c : mine; }
        if (sum == G) break;
        __builtin_amdgcn_s_sleep(1);
        if ((++sp & 255u) == 0u) { if (xb_ld(&bar[XB_TMO])) break; if (sp > XB_SPIN_CAP) { atomicAdd(&bar[XB_TMO], 1u); break; } }
    }
    nloc = mine > 0u ? mine : 1u; nx = cnt > 0u ? cnt : 1u;
}
__device__ __forceinline__ void xcd_barrier(const XcdBarrier& b) {
    asm volatile("s_waitcnt vmcnt(0)" ::: "memory");
    __syncthreads();
    if (threadIdx.x == 0) {
        unsigned* bar = b.bar;
        __builtin_amdgcn_s_waitcnt(0);
        unsigned nloc = b.st[0], nx = b.st[1];
        if (nloc == 0u) { xcd_barrier_complete(bar, b.x, nloc, nx); b.st[0] = nloc; b.st[1] = nx; }
        const unsigned old = xb_add(&bar[XB_XSUB(b.x)], 1u);
        const unsigned gen = old / nloc;
        if (old + 1u == (gen + 1u) * nloc) {
            __builtin_amdgcn_fence(__ATOMIC_RELEASE, "agent");
            asm volatile("s_waitcnt vmcnt(0)" ::: "memory");
            const unsigned og = xb_add(&bar[XB_TOP], 1u);
            const unsigned tg = og / nx;
            if (og + 1u == (tg + 1u) * nx) xb_add(&bar[XB_TOPGEN], 1u);
            else XB_SPIN(xb_ld(&bar[XB_TOPGEN]) == tg, bar);
            __builtin_amdgcn_fence(__ATOMIC_ACQUIRE, "agent");
            xb_add(&bar[XB_XGEN(b.x)], 1u);
            asm volatile("s_waitcnt vmcnt(0)" ::: "memory");
        } else {
            XB_SPIN(xb_ld(&bar[XB_XGEN(b.x)]) == gen, bar);
            __builtin_amdgcn_fence(__ATOMIC_ACQUIRE, "agent");
            asm volatile("s_waitcnt vmcnt(0)" ::: "memory");
        }
    }
    __syncthreads();
}

namespace g8 {
constexpr int BM = 256, BK = 64, HALF = 128, HTB = HALF * BK * 2, STAGE_BYTES = 8 * HTB, NXCD = 8, WGM = 8;
__device__ __forceinline__ int lds_byte(int r, int c) { const int st = (r >> 4) * 2 + (c >> 5), rr = r & 15, cc = c & 31, ob = rr * 64 + cc * 2; return st * 1024 + (ob ^ (((ob >> 9) & 1) << 5)); }
__device__ __forceinline__ void stage_rc(int b, int& R, int& C) { const int st = b / 1024, sb = b % 1024, swz = sb ^ (((sb >> 9) & 1) << 5); R = (st >> 1) * 16 + swz / 64; C = (st & 1) * 32 + (swz % 64) / 2; }
__device__ __forceinline__ int perm32(int rho) { const int n = rho >> 4, i = rho & 15; return 8 * (i >> 2) + 4 * n + (i & 3); }
__device__ __forceinline__ unsigned cvt_pk_bf16(float lo, float hi) { unsigned r; asm volatile("v_cvt_pk_bf16_f32 %0, %1, %2" : "=v"(r) : "v"(lo), "v"(hi)); return r; }
__device__ __forceinline__ int xcd_remap(int wgid, int nwg) { const int q = nwg / NXCD, r = nwg % NXCD, xcd = wgid % NXCD, off = wgid / NXCD; return (xcd < r ? xcd * (q + 1) : r * (q + 1) + (xcd - r) * q) + off; }

struct Unit { int row0, col0, ex, bt, nvalid, lrow; };

struct DenseSched {
    int nM, nN, nwg, G, c, lat_only; const char* Bt; int K; const int* list;
    __device__ __forceinline__ void init(int nM_, int nN_, int G_, int c_, int lat_only_, const void* Bt_, int K_) { nM = nM_; nN = nN_; nwg = nM * nN; G = G_; c = c_; lat_only = lat_only_; Bt = (const char*)Bt_; K = K_; list = nullptr; }
    __device__ __forceinline__ bool next(int i, Unit& u) const {
        const long Lx = (long)i * G + c; if (Lx >= nwg) return false;
        const int wgid = xcd_remap((int)Lx, nwg);
        const int nig = WGM * nN, gid = wgid / nig, fm = gid * WGM, gsz = (nM - fm) < WGM ? (nM - fm) : WGM;
        const int pm = fm + ((wgid % nig) % gsz), pn = (wgid % nig) / gsz;
        const int tile = lat_only ? (pm / 16) * 17 + 1 + (pm % 16) : pm;
        u.row0 = tile * 256; u.col0 = pn * 256; u.ex = 0; u.bt = pn; u.nvalid = 256; u.lrow = 0; return true;
    }
    __device__ __forceinline__ const char* bptr(const Unit& u) const { return Bt + (size_t)u.bt * 256 * K * 2; }
};
struct MoeSched {
    const LAS int* tpre; const LAS int* cnt; int NT, COLW, G, c, total; const char* Bt; int K; const int* list;
    __device__ __forceinline__ bool next(int i, Unit& u) const {
        const long Lx = (long)i * G + c; if (Lx >= total) return false;
        const int wgid = xcd_remap((int)Lx, total);
        int e = 0;
        for (int j = 1; j < NE; ++j) if (tpre[j] * NT <= wgid) e = j;
        const int t0 = tpre[e], mte = tpre[e + 1] - t0, loc = wgid - t0 * NT, nt = loc / mte, mt = loc % mte;
        u.ex = __builtin_amdgcn_readfirstlane(e); u.row0 = __builtin_amdgcn_readfirstlane((t0 + mt) * 256); u.col0 = __builtin_amdgcn_readfirstlane(nt * COLW);
        u.bt = __builtin_amdgcn_readfirstlane(e * NT + nt); const int nv = cnt[e] - mt * 256; u.nvalid = __builtin_amdgcn_readfirstlane(nv < 256 ? nv : 256); u.lrow = __builtin_amdgcn_readfirstlane(mt * 256);
        return true;
    }
    __device__ __forceinline__ const char* bptr(const Unit& u) const { return Bt + (size_t)u.bt * 256 * K * 2; }
};

struct EpiP {
    static constexpr bool PERM = true; bf16_t* O;
    __device__ __forceinline__ void operator()(const f32x4 (&acc)[2][2][4][2], const Unit& u, int wr, int wc, int fr, int fq, const LAS int*) const {
#pragma unroll
        for (int ai = 0; ai < 2; ++ai)
#pragma unroll
            for (int m = 0; m < 4; ++m) { bf16_t* rowp = O + (size_t)(u.row0 + ai * HALF + wr * 64 + m * 16 + fr) * PP + u.col0 + wc * 32 + 8 * fq;
#pragma unroll
                for (int bj = 0; bj < 2; ++bj) { const f32x4 v0 = acc[ai][bj][m][0], v1 = acc[ai][bj][m][1]; u32x4 w; w.x = cvt_pk_bf16(v0[0], v0[1]); w.y = cvt_pk_bf16(v0[2], v0[3]); w.z = cvt_pk_bf16(v1[0], v1[1]); w.w = cvt_pk_bf16(v1[2], v1[3]);
                    *(u32x4*)(rowp + bj * HALF) = w; } }
    }
};
struct EpiH {
    static constexpr bool PERM = false; float* Hh; const float* MODl; int g_off;
    __device__ __forceinline__ void operator()(const f32x4 (&acc)[2][2][4][2], const Unit& u, int wr, int wc, int fr, int fq, const LAS int*) const {
        const int tile = u.row0 >> 8, v = (tile % 17 == 0) ? 4 : tile / 17; const float* gp = MODl + (size_t)v * 6144 + g_off + u.col0 + wc * 32 + 4 * fq;
        f32x4 gv[2][2];
#pragma unroll
        for (int bj = 0; bj < 2; ++bj)
#pragma unroll
            for (int n = 0; n < 2; ++n) gv[bj][n] = *(const f32x4*)(gp + bj * HALF + n * 16);
#pragma unroll
        for (int ai = 0; ai < 2; ++ai)
#pragma unroll
            for (int m = 0; m < 4; ++m) { float* rowp = Hh + (size_t)(u.row0 + ai * HALF + wr * 64 + m * 16 + fr) * D + u.col0 + wc * 32 + 4 * fq;
#pragma unroll
                for (int bj = 0; bj < 2; ++bj)
#pragma unroll
                    for (int n = 0; n < 2; ++n) { f32x4* p = (f32x4*)(rowp + bj * HALF + n * 16); *p = *p + gv[bj][n] * acc[ai][bj][m][n]; } }
    }
};
struct EpiMoe1 {
    static constexpr bool PERM = true; bf16_t* ACTp; const float* bgu;
    __device__ __forceinline__ void operator()(const f32x4 (&acc)[2][2][4][2], const Unit& u, int wr, int wc, int fr, int fq, const LAS int*) const {
        const int cc = u.col0 + wc * 32 + 8 * fq; const float* bp = bgu + (size_t)u.ex * 2048 + cc;
        f32x4 bg[2], bu[2];
#pragma unroll
        for (int n = 0; n < 2; ++n) { bg[n] = *(const f32x4*)(bp + 4 * n); bu[n] = *(const f32x4*)(bp + 1024 + 4 * n); }
#pragma unroll
        for (int ai = 0; ai < 2; ++ai)
#pragma unroll
            for (int m = 0; m < 4; ++m) { const int r = ai * HALF + wr * 64 + m * 16 + fr;
                float o[8];
#pragma unroll
                for (int n = 0; n < 2; ++n)
#pragma unroll
                    for (int i = 0; i < 4; ++i) { const float g = fminf(acc[ai][0][m][n][i] + bg[n][i], 7.f); const float uu = fminf(fmaxf(acc[ai][1][m][n][i] + bu[n][i], -7.f), 7.f);
                        o[n * 4 + i] = (uu + 1.f) * g * __builtin_amdgcn_rcpf(1.f + __expf(-1.702f * g)); }
                if (r < u.nvalid) { u32x4 w; w.x = cvt_pk_bf16(o[0], o[1]); w.y = cvt_pk_bf16(o[2], o[3]); w.z = cvt_pk_bf16(o[4], o[5]); w.w = cvt_pk_bf16(o[6], o[7]);
                    *(u32x4*)(ACTp + (size_t)(u.row0 + r) * D + cc) = w; } }
    }
};
struct EpiMoe2 {
    static constexpr bool PERM = true; bf16_t* Yp; const float* bd; const float* GATEp;
    __device__ __forceinline__ void operator()(const f32x4 (&acc)[2][2][4][2], const Unit& u, int wr, int wc, int fr, int fq, const LAS int* rows) const {
        const int cc = u.col0 + wc * 32 + 8 * fq; const float* bp = bd + (size_t)u.ex * 1024 + cc;
        f32x4 bv[2][2];
#pragma unroll
        for (int bj = 0; bj < 2; ++bj)
#pragma unroll
            for (int n = 0; n < 2; ++n) bv[bj][n] = *(const f32x4*)(bp + bj * HALF + 4 * n);
#pragma unroll
        for (int ai = 0; ai < 2; ++ai)
#pragma unroll
            for (int m = 0; m < 4; ++m) { const int r = ai * HALF + wr * 64 + m * 16 + fr;
                if (r < u.nvalid) { const int asg = rows[r]; const float gt = GATEp[asg]; bf16_t* rowp = Yp + (size_t)asg * D + cc;
#pragma unroll
                    for (int bj = 0; bj < 2; ++bj) { const f32x4 v0 = (acc[ai][bj][m][0] + bv[bj][0]) * gt, v1 = (acc[ai][bj][m][1] + bv[bj][1]) * gt;
                        u32x4 w; w.x = cvt_pk_bf16(v0[0], v0[1]); w.y = cvt_pk_bf16(v0[2], v0[3]); w.z = cvt_pk_bf16(v1[0], v1[1]); w.w = cvt_pk_bf16(v1[2], v1[3]); *(u32x4*)(rowp + bj * HALF) = w; } } }
    }
};

template <class Epi, class Sched, bool GATHER, bool ROWLIST>
__device__ __forceinline__ void gemm_phase(LAS unsigned char* lds, const char* Abase, const int K, const Sched& S, const Epi& E) {
    int tid_l = threadIdx.x; asm volatile("" : "+v"(tid_l));
    const int tid = tid_l, wid = __builtin_amdgcn_readfirstlane(tid >> 6), lane = tid & 63, wr = wid >> 2, wc = wid & 3, fr = lane & 15, fq = lane >> 4;
    const int nt = K / BK; const unsigned Kb = (unsigned)K * 2u;
    int sR[2]; unsigned sC[2], voffB[2];
#pragma unroll
    for (int i = 0; i < 2; ++i) { int R, C; stage_rc(tid * 16 + i * 8192, R, C); sR[i] = R; sC[i] = (unsigned)C * 2u; const int Rb = Epi::PERM ? ((R & ~31) + perm32(R & 31)) : R; voffB[i] = (unsigned)(Rb * K + C) * 2u; }
    const size_t kstep = (size_t)(BK * 2), hstep = (size_t)HALF * K * 2;
    const unsigned ldsw = (unsigned)wid * 1024u;
    const int aoff = lds_byte(wr * 64 + fr, fq * 8), boff = lds_byte(wc * 32 + fr, fq * 8);
    LAS int* rowbuf = (LAS int*)(lds + STAGE_BYTES);
#define G8_SA(b, h) (((b) * 2 + (h)) * HTB)
#define G8_SB(b, h) ((4 + (b) * 2 + (h)) * HTB)
#define G8_STAGE_A(bufoff, kb, v) do { _Pragma("unroll") for (int _i = 0; _i < 2; ++_i) \
        __builtin_amdgcn_global_load_lds((const unsigned*)((kb) + (size_t)(v)[_i]), (LAS unsigned*)(lds + (bufoff) + ldsw + _i * 8192), 16, 0, 0); } while (0)
#define G8_STAGE_B(bufoff, gbase) do { _Pragma("unroll") for (int _i = 0; _i < 2; ++_i) \
        __builtin_amdgcn_global_load_lds((const unsigned*)((gbase) + voffB[_i]), (LAS unsigned*)(lds + (bufoff) + ldsw + _i * 8192), 16, 0, 0); } while (0)
#define G8_LDA(dst, b, h) do { _Pragma("unroll") for (int m = 0; m < 4; ++m) _Pragma("unroll") for (int k = 0; k < 2; ++k) dst[m][k] = *(const LAS bf16x8*)(lds + G8_SA(b, h) + aoff + m * 2048 + k * 1024); } while (0)
#define G8_LDB(dst, b, h) do { _Pragma("unroll") for (int n = 0; n < 2; ++n) _Pragma("unroll") for (int k = 0; k < 2; ++k) dst[n][k] = *(const LAS bf16x8*)(lds + G8_SB(b, h) + boff + n * 2048 + k * 1024); } while (0)
#define G8_MMA(ai, bj, At, Bt) do { __builtin_amdgcn_s_setprio(1); _Pragma("unroll") for (int m = 0; m < 4; ++m) _Pragma("unroll") for (int n = 0; n < 2; ++n) _Pragma("unroll") for (int k = 0; k < 2; ++k) \
        acc[ai][bj][m][n] = __builtin_amdgcn_mfma_f32_16x16x32_bf16(Bt[n][k], At[m][k], acc[ai][bj][m][n], 0, 0, 0); __builtin_amdgcn_s_setprio(0); } while (0)
#define G8_WAIT_V(n) asm volatile("s_waitcnt vmcnt(" #n ")" ::: "memory")
#define G8_WAIT_L(n) asm volatile("s_waitcnt lgkmcnt(" #n ")" ::: "memory")
#define G8_BAR __builtin_amdgcn_s_barrier()
#define G8_SCHED __builtin_amdgcn_sched_barrier(0)
#define G8_LISTDMA(u, s) do { if (wid < 4) __builtin_amdgcn_global_load_lds((const unsigned*)(S.list + (size_t)(u).ex * LCAP + (u).lrow + wid * 64 + lane), (LAS unsigned*)(rowbuf + (s) * 256 + wid * 64), 4, 0, 0); } while (0)
#define G8_ROWS_DENSE(v) do { _Pragma("unroll") for (int _h = 0; _h < 2; ++_h) _Pragma("unroll") for (int _i = 0; _i < 2; ++_i) (v)[_h][_i] = (unsigned)(_h * HALF + sR[_i]) * Kb + sC[_i]; } while (0)
#define G8_ROWS_LIST(v, u, s) do { _Pragma("unroll") for (int _h = 0; _h < 2; ++_h) _Pragma("unroll") for (int _i = 0; _i < 2; ++_i) { const int _r = _h * HALF + sR[_i]; const int _a = rowbuf[(s) * 256 + _r]; \
        (v)[_h][_i] = (unsigned)(_r < (u).nvalid ? (_a >> 2) : 0) * Kb + sC[_i]; } } while (0)
    Unit cur, nxt; int ui = 0, slot = 0;
    if (!S.next(0, cur)) return;
    unsigned vA[2][2];
    if constexpr (ROWLIST) { G8_LISTDMA(cur, 0); G8_WAIT_V(0); G8_BAR; }
    if constexpr (GATHER) { G8_ROWS_LIST(vA, cur, 0); } else { G8_ROWS_DENSE(vA); }
    f32x4 acc[2][2][4][2];
#pragma unroll
    for (int a = 0; a < 2; ++a)
#pragma unroll
        for (int b = 0; b < 2; ++b)
#pragma unroll
            for (int m = 0; m < 4; ++m)
#pragma unroll
                for (int n = 0; n < 2; ++n) acc[a][b][m][n] = (f32x4){0.f, 0.f, 0.f, 0.f};
    bf16x8 At[4][2], B0[2][2], B1[2][2];
    const char* cB = S.bptr(cur);
    const char* cA = GATHER ? Abase : Abase + (size_t)cur.row0 * Kb;
    G8_STAGE_B(G8_SB(0, 0), cB); G8_STAGE_B(G8_SB(0, 1), cB + hstep); G8_STAGE_A(G8_SA(0, 0), cA, vA[0]); G8_STAGE_A(G8_SA(0, 1), cA, vA[1]);
    if (wr == 1) G8_BAR;
    G8_WAIT_V(2); G8_BAR;
    G8_STAGE_B(G8_SB(1, 0), cB + kstep); G8_STAGE_A(G8_SA(1, 0), cA + kstep, vA[0]); G8_STAGE_B(G8_SB(1, 1), cB + hstep + kstep);
    G8_WAIT_V(6); G8_BAR;
    for (;;) {
        const bool has_next = S.next(ui + 1, nxt);
        const char* nB = has_next ? S.bptr(nxt) : cB;
        const char* nA = (GATHER || !has_next) ? cA : Abase + (size_t)nxt.row0 * Kb;
        const int nslot = slot == 2 ? 0 : slot + 1;
        if constexpr (ROWLIST) { if (has_next) G8_LISTDMA(nxt, nslot); }
        for (int t = 0; t < nt; t += 2) {
            const bool last = (t == nt - 2);
            const char* a1 = cA + (size_t)(t + 1) * kstep;
            const char* a2 = last ? nA : cA + (size_t)(t + 2) * kstep; const char* b2 = last ? nB : cB + (size_t)(t + 2) * kstep;
            const char* a3 = a2 + kstep; const char* b3 = b2 + kstep;
            G8_LDB(B0, 0, 0); G8_LDB(B1, 0, 1); G8_SCHED; G8_LDA(At, 0, 0); G8_STAGE_A(G8_SA(1, 1), a1, vA[1]);
            if constexpr (GATHER) { if (last && has_next) { G8_ROWS_LIST(vA, nxt, nslot); } }
            G8_WAIT_V(8); G8_WAIT_L(0); G8_BAR; G8_MMA(0, 0, At, B0); G8_MMA(0, 1, At, B1); G8_BAR; G8_SCHED;
            G8_LDA(At, 0, 1); G8_STAGE_B(G8_SB(0, 0), b2); G8_STAGE_B(G8_SB(0, 1), b2 + hstep); G8_STAGE_A(G8_SA(0, 0), a2, vA[0]);
            G8_WAIT_V(8); G8_WAIT_L(0); G8_BAR; G8_MMA(1, 0, At, B0); G8_MMA(1, 1, At, B1); G8_BAR; G8_SCHED;
            G8_LDB(B0, 1, 0); G8_LDB(B1, 1, 1); G8_SCHED; G8_LDA(At, 1, 0); G8_STAGE_A(G8_SA(0, 1), a2, vA[1]);
            G8_WAIT_V(8); G8_WAIT_L(0); G8_BAR; G8_MMA(0, 0, At, B0); G8_MMA(0, 1, At, B1); G8_BAR; G8_SCHED;
            G8_LDA(At, 1, 1); G8_STAGE_B(G8_SB(1, 0), b3); G8_STAGE_B(G8_SB(1, 1), b3 + hstep); G8_STAGE_A(G8_SA(1, 0), a3, vA[0]);
            G8_WAIT_V(8); G8_WAIT_L(0); G8_BAR; G8_MMA(1, 0, At, B0); G8_MMA(1, 1, At, B1); G8_BAR; G8_SCHED;
        }
        if (wr == 0) G8_BAR;
        E(acc, cur, wr, wc, fr, fq, rowbuf + slot * 256);
        if (!has_next) break;
#pragma unroll
        for (int a = 0; a < 2; ++a)
#pragma unroll
            for (int b = 0; b < 2; ++b)
#pragma unroll
                for (int m = 0; m < 4; ++m)
#pragma unroll
                    for (int n = 0; n < 2; ++n) acc[a][b][m][n] = (f32x4){0.f, 0.f, 0.f, 0.f};
        cur = nxt; cB = nB; cA = nA; ++ui; slot = nslot;
        if (wr == 1) G8_BAR;
    }
    G8_WAIT_V(0);
    G8_BAR;
#undef G8_SA
#undef G8_SB
#undef G8_STAGE_A
#undef G8_STAGE_B
#undef G8_LDA
#undef G8_LDB
#undef G8_MMA
#undef G8_WAIT_V
#undef G8_WAIT_L
#undef G8_BAR
#undef G8_SCHED
#undef G8_LISTDMA
#undef G8_ROWS_DENSE
#undef G8_ROWS_LIST
}
}

namespace fft {
constexpr int TP = 72;
constexpr int UP = 264;
constexpr int ZP = 520;
constexpr int O_TC = 0, O_TS = 9216, O_U = 18432, O_X = 52224, O_TW = 125952;
__device__ __forceinline__ bf16x8 neg8(bf16x8 v) { u32x4 w = __builtin_bit_cast(u32x4, v); w = w ^ 0x80008000u; return __builtin_bit_cast(bf16x8, w); }
__device__ __forceinline__ void build_tables(LAS unsigned char* lds, const float* TABC, const float* TABS) {
    for (int i = threadIdx.x; i < 4096; i += 512) { const int a = i >> 6, b = i & 63, ix = ((a * b) & 63) * 64;
        ((LAS bf16_t*)(lds + O_TC))[a * TP + b] = f2bf(TABC[ix]); ((LAS bf16_t*)(lds + O_TS))[a * TP + b] = f2bf(TABS[ix]); }
}
__device__ __forceinline__ void stage_a(LAS unsigned char* lds, const bf16_t* P, const float* TABC, const float* TABS, bf16_t* ZBUF, int G, int bx) {
    int tid_l = threadIdx.x; asm volatile("" : "+v"(tid_l));
    const int tid = tid_l, lane = tid & 63, w = __builtin_amdgcn_readfirstlane(tid >> 6), fr = lane & 15, fq = lane >> 4;
    build_tables(lds, TABC, TABS);
    const LAS bf16_t* Tc = (const LAS bf16_t*)(lds + O_TC); const LAS bf16_t* Ts = (const LAS bf16_t*)(lds + O_TS);
    LAS bf16_t* U = (LAS bf16_t*)(lds + O_U); LAS bf16_t* X = (LAS bf16_t*)(lds + O_X); LAS float* TW = (LAS float*)(lds + O_TW);
    for (int unit = bx; unit < 256; unit += G) {
        const int b = unit >> 6, t2 = unit & 63;
#pragma unroll
        for (int i = 0; i < 4; ++i) { const int q = tid + 512 * i, t1 = q >> 5, ch = q & 31;
            *(LAS u32x4*)((LAS unsigned char*)U + t1 * (UP * 2) + ch * 16) = *(const u32x4*)(P + ((size_t)b * NPOS + CTX + 64 * t1 + t2) * PP + ch * 8); }
        if (tid < 64) { const int ix = tid * t2; TW[2 * tid] = TABC[ix]; TW[2 * tid + 1] = TABS[ix]; }
        __syncthreads();
        { const int g = w >> 1, part = w & 1; const LAS bf16_t* T = part ? Ts : Tc;
          f32x4 acc[4][4];
#pragma unroll
          for (int mt = 0; mt < 4; ++mt)
#pragma unroll
              for (int nt = 0; nt < 4; ++nt) acc[mt][nt] = (f32x4){0.f, 0.f, 0.f, 0.f};
#pragma unroll
          for (int ks = 0; ks < 2; ++ks) { bf16x8 a[4], bb[4];
#pragma unroll
              for (int mt = 0; mt < 4; ++mt) a[mt] = *(const LAS bf16x8*)(U + (16 * mt + fr) * UP + g * 64 + 32 * ks + 8 * fq);
#pragma unroll
              for (int nt = 0; nt < 4; ++nt) bb[nt] = *(const LAS bf16x8*)(T + (16 * nt + fr) * TP + 32 * ks + 8 * fq);
#pragma unroll
              for (int mt = 0; mt < 4; ++mt)
#pragma unroll
                  for (int nt = 0; nt < 4; ++nt) acc[mt][nt] = __builtin_amdgcn_mfma_f32_16x16x32_bf16(a[mt], bb[nt], acc[mt][nt], 0, 0, 0); }
          const float sg = part ? -1.f : 1.f;
#pragma unroll
          for (int mt = 0; mt < 4; ++mt)
#pragma unroll
              for (int nt = 0; nt < 4; ++nt) { const f32x4 v = acc[mt][nt] * sg; u32x2 o; o.x = pk2(v[0], v[1]); o.y = pk2(v[2], v[3]);
                  *(LAS u32x2*)(X + (part * 256 + g * 64 + 16 * nt + fr) * TP + 16 * mt + 4 * fq) = o; } }
        __syncthreads();
        f32x4 zr[4][2], zi[4][2];
#pragma unroll
        for (int mt = 0; mt < 4; ++mt)
#pragma unroll
            for (int n = 0; n < 2; ++n) { zr[mt][n] = (f32x4){0.f, 0.f, 0.f, 0.f}; zi[mt][n] = (f32x4){0.f, 0.f, 0.f, 0.f}; }
#pragma unroll
        for (int ks = 0; ks < 2; ++ks) { bf16x8 xr[2], xi[2];
#pragma unroll
            for (int n = 0; n < 2; ++n) { xr[n] = *(const LAS bf16x8*)(X + (32 * w + 16 * n + fr) * TP + 32 * ks + 8 * fq); xi[n] = *(const LAS bf16x8*)(X + (256 + 32 * w + 16 * n + fr) * TP + 32 * ks + 8 * fq); }
#pragma unroll
            for (int mt = 0; mt < 4; ++mt) { const bf16x8 c = *(const LAS bf16x8*)(Tc + (16 * mt + fr) * TP + 32 * ks + 8 * fq), s = *(const LAS bf16x8*)(Ts + (16 * mt + fr) * TP + 32 * ks + 8 * fq), ns = neg8(s);
#pragma unroll
                for (int n = 0; n < 2; ++n) { zr[mt][n] = __builtin_amdgcn_mfma_f32_16x16x32_bf16(c, xr[n], zr[mt][n], 0, 0, 0); zr[mt][n] = __builtin_amdgcn_mfma_f32_16x16x32_bf16(s, xi[n], zr[mt][n], 0, 0, 0);
                    zi[mt][n] = __builtin_amdgcn_mfma_f32_16x16x32_bf16(c, xi[n], zi[mt][n], 0, 0, 0); zi[mt][n] = __builtin_amdgcn_mfma_f32_16x16x32_bf16(ns, xr[n], zi[mt][n], 0, 0, 0); } } }
        __syncthreads();
        { LAS bf16_t* Zs = X;
#pragma unroll
          for (int mt = 0; mt < 4; ++mt)
#pragma unroll
              for (int i = 0; i < 4; ++i) { const int f1 = 16 * mt + 4 * fq + i; const float ct = TW[2 * f1], st = TW[2 * f1 + 1];
#pragma unroll
                  for (int n = 0; n < 2; ++n) { const float a = zr[mt][n][i], bq = zi[mt][n][i]; const int col = 32 * w + 16 * n + fr;
                      Zs[f1 * ZP + col] = f2bf(a * ct + bq * st); Zs[f1 * ZP + 256 + col] = f2bf(bq * ct - a * st); } } }
        __syncthreads();
#pragma unroll
        for (int i = 0; i < 8; ++i) { const int q = tid + 512 * i, f1 = q >> 6, ch = q & 63;
            *(u32x4*)(ZBUF + (((size_t)b * 64 + f1) * 64 + t2) * 512 + ch * 8) = *(const LAS u32x4*)((const LAS unsigned char*)X + f1 * (ZP * 2) + ch * 16); }
        __syncthreads();
    }
}
__device__ __forceinline__ void stage_b(LAS unsigned char* lds, const bf16_t* ZBUF, const float* TABC, const float* TABS, bf16_t* MIX, int G, int bx) {
    int tid_l = threadIdx.x; asm volatile("" : "+v"(tid_l));
    const int tid = tid_l, lane = tid & 63, w = __builtin_amdgcn_readfirstlane(tid >> 6), fr = lane & 15, fq = lane >> 4;
    build_tables(lds, TABC, TABS);
    const LAS bf16_t* Tc = (const LAS bf16_t*)(lds + O_TC); const LAS bf16_t* Ts = (const LAS bf16_t*)(lds + O_TS);
    LAS bf16_t* Ys = (LAS bf16_t*)(lds + O_U); LAS bf16_t* ZT = (LAS bf16_t*)(lds + O_X);
    for (int unit = bx; unit < 256; unit += G) {
        const int b = unit >> 6, f1 = unit & 63;
        const bf16_t* Zg = ZBUF + ((size_t)b * 64 + f1) * 64 * 512;
#pragma unroll
        for (int i = 0; i < 4; ++i) { const int q = tid + 512 * i, p = q & 31, ch = q >> 5;
            const u32x4 r0 = *(const u32x4*)(Zg + (size_t)(2 * p) * 512 + ch * 8), r1 = *(const u32x4*)(Zg + (size_t)(2 * p + 1) * 512 + ch * 8);
#pragma unroll
            for (int j = 0; j < 4; ++j) { const unsigned a = r0[j], c = r1[j];
                *(LAS unsigned*)(ZT + (ch * 8 + 2 * j) * TP + 2 * p) = (a & 0xffffu) | (c << 16);
                *(LAS unsigned*)(ZT + (ch * 8 + 2 * j + 1) * TP + 2 * p) = (a >> 16) | (c & 0xffff0000u); } }
        __syncthreads();
        f32x4 y[4][2];
#pragma unroll
        for (int mt = 0; mt < 4; ++mt)
#pragma unroll
            for (int n = 0; n < 2; ++n) y[mt][n] = (f32x4){0.f, 0.f, 0.f, 0.f};
#pragma unroll
        for (int ks = 0; ks < 2; ++ks) { bf16x8 xr[2], xi[2];
#pragma unroll
            for (int n = 0; n < 2; ++n) { xr[n] = *(const LAS bf16x8*)(ZT + (32 * w + 16 * n + fr) * TP + 32 * ks + 8 * fq); xi[n] = *(const LAS bf16x8*)(ZT + (256 + 32 * w + 16 * n + fr) * TP + 32 * ks + 8 * fq); }
#pragma unroll
            for (int mt = 0; mt < 4; ++mt) { const bf16x8 c = *(const LAS bf16x8*)(Tc + (16 * mt + fr) * TP + 32 * ks + 8 * fq), s = *(const LAS bf16x8*)(Ts + (16 * mt + fr) * TP + 32 * ks + 8 * fq);
#pragma unroll
                for (int n = 0; n < 2; ++n) { y[mt][n] = __builtin_amdgcn_mfma_f32_16x16x32_bf16(c, xr[n], y[mt][n], 0, 0, 0); y[mt][n] = __builtin_amdgcn_mfma_f32_16x16x32_bf16(s, xi[n], y[mt][n], 0, 0, 0); } } }
#pragma unroll
        for (int mt = 0; mt < 4; ++mt)
#pragma unroll
            for (int i = 0; i < 4; ++i)
#pragma unroll
                for (int n = 0; n < 2; ++n) Ys[(16 * mt + 4 * fq + i) * UP + 32 * w + 16 * n + fr] = f2bf(y[mt][n][i] * (1.f / 512.f));
        __syncthreads();
#pragma unroll
        for (int i = 0; i < 4; ++i) { const int q = tid + 512 * i, f2 = q >> 5, ch = q & 31;
            *(u32x4*)(MIX + ((size_t)b * NPOS + CTX + f1 + 64 * f2) * D + ch * 8) = *(const LAS u32x4*)((const LAS unsigned char*)Ys + f2 * (UP * 2) + ch * 16); }
        __syncthreads();
    }
}
}

namespace attn {
typedef float f32x16 __attribute__((ext_vector_type(16)));
typedef float f32x2_t __attribute__((ext_vector_type(2))); typedef __bf16 bf16x2_t __attribute__((ext_vector_type(2)));
__device__ __forceinline__ unsigned cvtpk(float lo, float hi) { f32x2_t v = {lo, hi}; bf16x2_t b = __builtin_convertvector(v, bf16x2_t); return __builtin_bit_cast(unsigned, b); }
constexpr int KP = 104, VP = 68;
constexpr int KT_BYTES = 64 * KP * 2, VT_BYTES = 64 * VP * 2, BUF_BYTES = KT_BYTES + VT_BYTES;
constexpr float C2 = 0.10206207261596577f * 1.4426950408889634f;
__device__ __forceinline__ void attn_phase(LAS unsigned char* lds, const bf16_t* QL, const bf16_t* QC, const bf16_t* KB, const bf16_t* VTG, bf16_t* MIX, int with_ctx, int G, int vcu) {
    int tid_l = threadIdx.x; asm volatile("" : "+v"(tid_l));
    const int tid = tid_l, lane = tid & 63, wid = __builtin_amdgcn_readfirstlane(tid >> 6), r32 = lane & 31, hi = lane >> 5;
    const int nunits = 256 + (with_ctx ? 16 : 0);
    for (int unit = vcu; unit < nunits; unit += G) {
        int bh, nk, orow0; const bf16_t* Qp;
        if (unit < 256) { bh = unit >> 4; const int qb = unit & 15; Qp = QL + ((size_t)bh * SEQ + qb * 256) * 96; nk = NPOS; orow0 = (bh >> 2) * NPOS + CTX + qb * 256; }
        else { bh = unit - 256; Qp = QC + (size_t)bh * CTX * 96; nk = CTX; orow0 = (bh >> 2) * NPOS; }
        const int hh = bh & 3, NT = nk / 64;
        const bf16_t* Kg = KB + (size_t)bh * NPOS * 96; const bf16_t* Vg = VTG + (size_t)bh * 64 * NPOS;
        bf16x8 qf[6];
        { const bf16_t* qp = Qp + (size_t)(wid * 32 + r32) * 96 + 8 * hi;
#pragma unroll
          for (int ds = 0; ds < 6; ++ds) { const u32x4 raw = *(const u32x4*)(qp + 16 * ds); u32x4 o;
#pragma unroll
              for (int j = 0; j < 4; ++j) { const float lo = __uint_as_float(raw[j] << 16) * C2, hv = __uint_as_float(raw[j] & 0xffff0000u) * C2; o[j] = cvtpk(lo, hv); }
              qf[ds] = __builtin_bit_cast(bf16x8, o); } }
        f32x16 o0 = {}, o1 = {}; float m = -1e30f, l = 0.f;
        const int kr0 = tid / 12, kc0 = tid % 12, kr1 = (tid + 512) / 12, kc1 = (tid + 512) % 12; const bool k1ok = tid < 256;
        const int vd = tid >> 3, vc = tid & 7;
        u32x4 sk0, sk1 = {}, sv;
        sk0 = *(const u32x4*)(Kg + (size_t)kr0 * 96 + kc0 * 8); if (k1ok) sk1 = *(const u32x4*)(Kg + (size_t)kr1 * 96 + kc1 * 8); sv = *(const u32x4*)(Vg + (size_t)vd * NPOS + vc * 8);
        int cur = 0;
        { LAS unsigned char* bp = lds; *(LAS u32x4*)(bp + kr0 * (KP * 2) + kc0 * 16) = sk0; if (k1ok) *(LAS u32x4*)(bp + kr1 * (KP * 2) + kc1 * 16) = sk1; *(LAS u32x4*)(bp + KT_BYTES + vd * (VP * 2) + vc * 16) = sv; }
        __syncthreads();
        for (int t = 0; t < NT; ++t) {
            if (t + 1 < NT) { const size_t k0 = (size_t)(t + 1) * 64;
                sk0 = *(const u32x4*)(Kg + (k0 + kr0) * 96 + kc0 * 8); if (k1ok) sk1 = *(const u32x4*)(Kg + (k0 + kr1) * 96 + kc1 * 8); sv = *(const u32x4*)(Vg + (size_t)vd * NPOS + k0 + vc * 8); }
            const LAS bf16_t* Kt = (const LAS bf16_t*)(lds + cur * BUF_BYTES); const LAS bf16_t* Vt = (const LAS bf16_t*)(lds + cur * BUF_BYTES + KT_BYTES);
            f32x16 p0 = {}, p1 = {};
#pragma unroll
            for (int ds = 0; ds < 6; ++ds) { const bf16x8 k0f = *(const LAS bf16x8*)(Kt + r32 * KP + 16 * ds + 8 * hi), k1f = *(const LAS bf16x8*)(Kt + (32 + r32) * KP + 16 * ds + 8 * hi);
                p0 = __builtin_amdgcn_mfma_f32_32x32x16_bf16(k0f, qf[ds], p0, 0, 0, 0); p1 = __builtin_amdgcn_mfma_f32_32x32x16_bf16(k1f, qf[ds], p1, 0, 0, 0); }
            float mx = fmaxf(p0[0], p1[0]);
#pragma unroll
            for (int r = 1; r < 16; ++r) mx = fmaxf(mx, fmaxf(p0[r], p1[r]));
            mx = fmaxf(mx, __shfl_xor(mx, 32));
            const float mn = fmaxf(m, mx), alpha = __builtin_amdgcn_exp2f(m - mn); m = mn;
            float ls = 0.f;
#pragma unroll
            for (int r = 0; r < 16; ++r) { p0[r] = __builtin_amdgcn_exp2f(p0[r] - mn); p1[r] = __builtin_amdgcn_exp2f(p1[r] - mn); ls += p0[r] + p1[r]; }
            l = l * alpha + ls;
#pragma unroll
            for (int r = 0; r < 16; ++r) { o0[r] *= alpha; o1[r] *= alpha; }
#pragma unroll
            for (int s = 0; s < 4; ++s) {
                u32x4 pw;
#pragma unroll
                for (int j = 0; j < 4; ++j) { const int r = 8 * (s & 1) + 2 * j; pw[j] = (s < 2) ? cvtpk(p0[r], p0[r + 1]) : cvtpk(p1[r], p1[r + 1]); }
                const bf16x8 pf = __builtin_bit_cast(bf16x8, pw);
                const int kvb = 32 * (s >> 1) + 16 * (s & 1) + 4 * hi;
#pragma unroll
                for (int db = 0; db < 2; ++db) { const u32x2 va = *(const LAS u32x2*)(Vt + (32 * db + r32) * VP + kvb), vb = *(const LAS u32x2*)(Vt + (32 * db + r32) * VP + kvb + 8);
                    const u32x4 vw = {va.x, va.y, vb.x, vb.y}; const bf16x8 vf = __builtin_bit_cast(bf16x8, vw);
                    if (db == 0) o0 = __builtin_amdgcn_mfma_f32_32x32x16_bf16(vf, pf, o0, 0, 0, 0); else o1 = __builtin_amdgcn_mfma_f32_32x32x16_bf16(vf, pf, o1, 0, 0, 0); }
            }
            if (t + 1 < NT) { LAS unsigned char* bp = lds + (cur ^ 1) * BUF_BYTES;
                *(LAS u32x4*)(bp + kr0 * (KP * 2) + kc0 * 16) = sk0; if (k1ok) *(LAS u32x4*)(bp + kr1 * (KP * 2) + kc1 * 16) = sk1; *(LAS u32x4*)(bp + KT_BYTES + vd * (VP * 2) + vc * 16) = sv; }
            __syncthreads();
            cur ^= 1;
        }
        l += __shfl_xor(l, 32);
        const float il = 1.f / l;
        bf16_t* op = MIX + (size_t)(orow0 + wid * 32 + r32) * D + 512 + hh * 64 + 4 * hi;
#pragma unroll
        for (int g4 = 0; g4 < 4; ++g4) { u32x2 w0, w1; w0.x = cvtpk(o0[4 * g4] * il, o0[4 * g4 + 1] * il); w0.y = cvtpk(o0[4 * g4 + 2] * il, o0[4 * g4 + 3] * il);
            w1.x = cvtpk(o1[4 * g4] * il, o1[4 * g4 + 1] * il); w1.y = cvtpk(o1[4 * g4 + 2] * il, o1[4 * g4 + 3] * il);
            *(u32x2*)(op + 8 * g4) = w0; *(u32x2*)(op + 32 + 8 * g4) = w1; }
    }
}
}

constexpr int NWAVES = 8, RING_BYTES = 131072 + 3072, LDSCTL_OFF = RING_BYTES, MISC_OFF = LDSCTL_OFF + 64, META_OFF = MISC_OFF + 64, LDS_BYTES = 147456;
enum { PH_PRO0 = 0, PH_PRO1 = 1, PH_L0 = 2, PH_PER_LAYER = 8, PH_N = 18 };
enum { PL_WIN = 0, PL_PREP = 1, PL_MIX = 2, PL_WOUT = 3, PL_ROUTE = 4, PL_MOE1 = 5, PL_MOE2 = 6, PL_COMB = 7 };
struct MArgs { const float* in[30]; float* out; unsigned char* ws; int ph_lo, ph_hi; };

__device__ __forceinline__ void transpose_item(const float* W, int K, int N, bf16_t* WT, int drow0, LAS float* scr, int k0, int n0, int lane) {
#pragma unroll 8
    for (int i = 0; i < 32; ++i) { const int kk = 2 * i + (lane >> 5); scr[kk * 33 + (lane & 31)] = W[(size_t)(k0 + kk) * N + n0 + (lane & 31)]; }
    asm volatile("s_waitcnt lgkmcnt(0)" ::: "memory");
    const int c = lane & 7;
#pragma unroll
    for (int j = 0; j < 4; ++j) { const int n = (lane >> 3) + 8 * j; const LAS float* s = scr + (8 * c) * 33 + n;
        u32x4 o; o.x = pk2(s[0 * 33], s[1 * 33]); o.y = pk2(s[2 * 33], s[3 * 33]); o.z = pk2(s[4 * 33], s[5 * 33]); o.w = pk2(s[6 * 33], s[7 * 33]);
        *(u32x4*)(WT + (size_t)(drow0 + n) * K + k0 + 8 * c) = o; }
    asm volatile("s_waitcnt lgkmcnt(0)" ::: "memory");
}

#define ARG_IN(i) ({ const float* _p; asm volatile("s_load_dwordx2 %0, %1, %2\n\ts_waitcnt lgkmcnt(0)" : "=s"(_p) : "s"(__builtin_amdgcn_kernarg_segment_ptr()), "n"((i) * 8)); _p; })
__global__ void __launch_bounds__(NWAVES * 64, 2) mega(MArgs args) {
    extern __shared__ __attribute__((aligned(16))) unsigned char lds_raw[];
    LAS unsigned char* lds = (LAS unsigned char*)lds_raw;
    const int G = gridDim.x, bx = blockIdx.x;
    const int vcu = (G % 8 == 0) ? (bx % 8) * (G / 8) + bx / 8 : bx;
    unsigned char* ws0 = args.ws;
    unsigned* ctl0 = (unsigned*)(ws0 + L::CTL);
    for (int u = threadIdx.x; u < (LDS_BYTES - LDSCTL_OFF) / 4; u += NWAVES * 64) ((LAS unsigned*)(lds + LDSCTL_OFF))[u] = 0u;
    __syncthreads();
    volatile LAS unsigned* MISC = (volatile LAS unsigned*)(lds + MISC_OFF);
    LAS int* META = (LAS int*)(lds + META_OFF);
    XcdBarrier bar = xcd_barrier_post(ctl0 + L::CW_BAR, MISC);
    const int lo = args.ph_lo, hi = args.ph_hi;

    for (int ph = lo; ph < hi; ++ph) {
        if (ph > lo) xcd_barrier(bar);
        unsigned char* ws = args.ws; asm volatile("" : "+s"(ws));
        unsigned* ctl = (unsigned*)(ws + L::CTL);
        int tid_p = threadIdx.x; asm volatile("" : "+v"(tid_p));
        const int tid = tid_p, lane = tid & 63, wave = __builtin_amdgcn_readfirstlane(tid >> 6); (void)lane; (void)wave;
        if (ph == PH_PRO0) {
            LAS float* scr = (LAS float*)(lds + wave * 16384);
            const int gw = vcu * NWAVES + wave, NGW = G * NWAVES;
            constexpr int I_IN = 16 * 61, I_OUT = 16 * 32, I_GU = NE * 16 * 64, I_DN = NE * 16 * 32, I_L = I_IN + I_OUT + I_GU + I_DN;
            for (int it = gw; it < 2 * I_L; it += NGW) {
                const int l = it / I_L; int r = it % I_L;
                if (r < I_IN) { const int kb = r / 61, nb = r % 61; transpose_item(ARG_IN(8) + (size_t)l * D * PT, D, PT, (bf16_t*)(ws + L::WINT) + (size_t)l * 2048 * D, 32 * nb, scr, 64 * kb, 32 * nb, lane); continue; } r -= I_IN;
                if (r < I_OUT) { const int kb = r / 32, nb = r % 32; transpose_item(ARG_IN(22) + (size_t)l * D * D, D, D, (bf16_t*)(ws + L::WOUTT) + (size_t)l * D * D, 32 * nb, scr, 64 * kb, 32 * nb, lane); continue; } r -= I_OUT;
                if (r < I_GU) { const int e = r / (16 * 64), q = r % (16 * 64), kb = q / 64, nb = q % 64; const int n0 = 32 * nb; const int c2 = n0 & 1023; const int drow = (c2 >> 7) * 256 + (n0 >> 10) * 128 + (c2 & 127);
                    transpose_item(ARG_IN(25) + ((size_t)l * NE + e) * D * 2048, D, 2048, (bf16_t*)(ws + L::WGUT) + ((size_t)l * NE + e) * 2048 * D, drow, scr, 64 * kb, n0, lane); continue; } r -= I_GU;
                { const int e = r / (16 * 32), q = r % (16 * 32), kb = q / 32, nb = q % 32;
                    transpose_item(ARG_IN(27) + ((size_t)l * NE + e) * D * D, D, D, (bf16_t*)(ws + L::WDT) + ((size_t)l * NE + e) * D * D, 32 * nb, scr, 64 * kb, 32 * nb, lane); }
            }
            for (int i = bx * 512 + tid; i < 2 * 96 * D / 8; i += G * 512) { const int l = i / (96 * D / 8), q = i % (96 * D / 8); *(u32x4*)((bf16_t*)(ws + L::WINT) + ((size_t)l * 2048 + PT) * D + (size_t)q * 8) = (u32x4){0u, 0u, 0u, 0u}; }
            continue;
        }
        if (ph < PH_L0) continue;
        const int l = (ph - PH_L0) / PH_PER_LAYER, pl = (ph - PH_L0) % PH_PER_LAYER;
        const float* MODl = (const float*)(ws + L::MOD) + (size_t)l * 5 * 6144;
        if (pl == PL_WIN) {
            g8::DenseSched S; S.init(MROWS / 256, PP / 256, G, bx, 0, (const bf16_t*)(ws + L::WINT) + (size_t)l * 2048 * D, D);
            g8::EpiP E{(bf16_t*)(ws + L::P)};
            g8::gemm_phase<g8::EpiP, g8::DenseSched, false, false>(lds, (const char*)(ws + L::XN), D, S, E);
        } else if (pl == PL_PREP) {
            fft::stage_a(lds, (const bf16_t*)(ws + L::P), (const float*)(ws + L::TABC), (const float*)(ws + L::TABS), (bf16_t*)(ws + L::ZBUF), G, bx);
        } else if (pl == PL_MIX) {
            fft::stage_b(lds, (const bf16_t*)(ws + L::ZBUF), (const float*)(ws + L::TABC), (const float*)(ws + L::TABS), (bf16_t*)(ws + L::MIX), G, bx);
            __syncthreads();
            attn::attn_phase(lds, (const bf16_t*)(ws + L::QL), (const bf16_t*)(ws + L::QC), (const bf16_t*)(ws + L::KB), (const bf16_t*)(ws + L::VTG), (bf16_t*)(ws + L::MIX), l == 0 ? 1 : 0, G, vcu);
        } else if (pl == PL_WOUT) {
            g8::DenseSched S; S.init(l == 0 ? MROWS / 256 : 64, D / 256, G, bx, l == 0 ? 0 : 1, (const bf16_t*)(ws + L::WOUTT) + (size_t)l * D * D, D);
            g8::EpiH E{(float*)(ws + L::H), MODl, 2048};
            g8::gemm_phase<g8::EpiH, g8::DenseSched, false, false>(lds, (const char*)(ws + L::MIX), D, S, E);
        } else if (pl == PL_MOE1 || pl == PL_MOE2) {
            const int* CNTg = (const int*)(ctl + L::CW_CNT) + l * NE;
            if (tid == 0) { int o = 0; for (int e = 0; e < NE; ++e) { const int cn = CNTg[e]; META[e] = o; META[64 + e] = cn; o += (cn + 255) >> 8; } META[NE] = o; }
            __syncthreads();
            g8::MoeSched S; S.tpre = META; S.cnt = META + 64; S.G = G; S.c = bx; S.K = D; S.list = (const int*)(ws + L::LIST) + (size_t)l * NE * LCAP;
            if (pl == PL_MOE1) {
                S.NT = 8; S.COLW = 128; S.total = __builtin_amdgcn_readfirstlane(META[NE]) * 8; S.Bt = (const char*)((const bf16_t*)(ws + L::WGUT) + (size_t)l * NE * 2048 * D);
                g8::EpiMoe1 E{(bf16_t*)(ws + L::ACT), ARG_IN(26) + (size_t)l * NE * 2048};
                g8::gemm_phase<g8::EpiMoe1, g8::MoeSched, true, true>(lds, (const char*)(ws + L::XN), D, S, E);
            } else {
                S.NT = 4; S.COLW = 256; S.total = __builtin_amdgcn_readfirstlane(META[NE]) * 4; S.Bt = (const char*)((const bf16_t*)(ws + L::WDT) + (size_t)l * NE * D * D);
                g8::EpiMoe2 E{(bf16_t*)(ws + L::Y), ARG_IN(28) + (size_t)l * NE * D, (const float*)(ws + L::GATE)};
                g8::gemm_phase<g8::EpiMoe2, g8::MoeSched, false, true>(lds, (const char*)(ws + L::ACT), D, S, E);
            }
            __syncthreads();
        }
    }
}
extern "C" void kernel_launch(void* const* d_in, const int* in_sizes, int n_in, void* d_out, int out_size, void* d_ws, size_t ws_size, hipStream_t stream) {
    const float* x = (const float*)d_in[0]; const float* c = (const float*)d_in[1]; const float* ctx = (const float*)d_in[2]; const float* c_ctx = (const float*)d_in[3];
    const float* mod_w = (const float*)d_in[4]; const float* mod_b = (const float*)d_in[5]; const float* norm1_g = (const float*)d_in[6]; const float* norm2_g = (const float*)d_in[7];
    const float* lru_conv_w = (const float*)d_in[9]; const float* lru_conv_b = (const float*)d_in[10]; const float* lru_w_a = (const float*)d_in[11];
    const float* lru_b_a = (const float*)d_in[12]; const float* lru_w_i = (const float*)d_in[13]; const float* lru_b_i = (const float*)d_in[14]; const float* lru_lambda = (const float*)d_in[15];
    const float* q_norm_g = (const float*)d_in[16]; const float* w_uq = (const float*)d_in[17]; const float* kv_norm_g = (const float*)d_in[18]; const float* w_ukv = (const float*)d_in[19];
    const float* sc_conv_w = (const float*)d_in[20]; const float* sc_conv_b = (const float*)d_in[21]; const float* router_w = (const float*)d_in[23];
    const float* router_b = (const float*)d_in[24]; const float* final_g = (const float*)d_in[29];
    float* out = (float*)d_out;
    unsigned char* p = (unsigned char*)d_ws;
    if (L::END > ws_size) { fprintf(stderr, "kernel_launch: workspace too small: need %zu have %zu\n", (size_t)L::END, ws_size); return; }
    static bool attr_done = false;
    if (!attr_done) { (void)hipFuncSetAttribute((const void*)mega, hipFuncAttributeMaxDynamicSharedMemorySize, LDS_BYTES); attr_done = true; }
    WS w;
    w.H = (float*)(p + L::H); w.MOD = (float*)(p + L::MOD); w.TABC = (float*)(p + L::TABC); w.TABS = (float*)(p + L::TABS); w.XN = (bf16_t*)(p + L::XN); w.P = (bf16_t*)(p + L::P); w.MIX = (bf16_t*)(p + L::MIX);
    w.CQN = (bf16_t*)(p + L::CQN); w.CKVN = (bf16_t*)(p + L::CKVN); w.QRAW = (float*)(p + L::QRAW); w.KVRAW = (float*)(p + L::KVRAW); w.QL = (bf16_t*)(p + L::QL); w.QC = (bf16_t*)(p + L::QC);
    w.KB = (bf16_t*)(p + L::KB); w.VB = (bf16_t*)(p + L::VB); w.LA = (float*)(p + L::LA); w.LB = (float*)(p + L::LB); w.HS = (float*)(p + L::HS); w.XCS = (float*)(p + L::XCS); w.XCSC = (float*)(p + L::XCSC);
    w.CNT = (int*)(p + L::CTL) + L::CW_CNT; w.OFFS = nullptr; w.LIST = (int*)(p + L::LIST); w.GATE = (float*)(p + L::GATE); w.ACT = (bf16_t*)(p + L::ACT); w.Y = (bf16_t*)(p + L::Y);
    MArgs a{};
    for (int i = 0; i < 30; ++i) a.in[i] = (const float*)d_in[i];
    a.out = out; a.ws = p;
    auto run_mega = [&](int lo, int hi) { a.ph_lo = lo; a.ph_hi = hi; hipLaunchKernelGGL(mega, dim3(256), dim3(512), LDS_BYTES, stream, a); };

    (void)hipMemsetAsync(p + L::CTL, 0, L::CTL_BYTES, stream);
    k_init<<<2048, 256, 0, stream>>>(x, ctx, w.H, w.TABC, w.TABS);
    k_mod<<<48, 256, 0, stream>>>(c, c_ctx, mod_w, mod_b, w.MOD);
    run_mega(PH_PRO0, PH_PRO0 + 1);
    for (int l = 0; l < 2; ++l) {
        const bool wctx = (l == 0); const float* MODl = w.MOD + (size_t)l * 5 * 6144; const int pb = PH_L0 + l * PH_PER_LAYER;
        k_norm_mod<<<MROWS / 4, 256, 0, stream>>>(w.H, norm1_g + l * D, MODl, 0, 1024, w.XN);
        run_mega(pb + PL_WIN, pb + PL_WIN + 1);
        run_mega(pb + PL_PREP, pb + PL_PREP + 1);
        if (wctx) k_four_ch<<<MROWS, 256, 0, stream>>>(w.P, w.TABC, w.TABS, w.XCS, w.XCSC, 1);
        if (wctx) k_gemm<ALDft, EPDft, 1><<<dim3(4, CTX / 64, 4), 256, 0, stream>>>(ALDft{w.TABC, w.TABS, 256, 16}, w.XCSC, 256, (long)512 * 256, 256, 512, 0, EPDft{w.MIX, 0, 1.f / 128.f});
        k_lru_gates<<<dim3(MROWS / 16, 2), 256, 0, stream>>>(w.P, lru_conv_w + (size_t)l * 2 * 4 * 256, lru_conv_b + l * 512, lru_w_a + (size_t)l * 2 * 4 * 64 * 64, lru_b_a + l * 512,
                                                          lru_w_i + (size_t)l * 2 * 4 * 64 * 64, lru_b_i + l * 512, lru_lambda + l * 512, w.LA, w.LB);
        k_lru_scan<<<dim3(4, 2), 256, 0, stream>>>(w.LA, w.LB, w.HS);
        k_lru_sc_out<<<MROWS, 256, 0, stream>>>(w.P, w.HS, sc_conv_w + l * 768, sc_conv_b + l * 256, w.MIX);
        k_lat_norm<<<MROWS / 4, 256, 0, stream>>>(w.P, q_norm_g + l * 256, kv_norm_g + l * 128, w.CQN, w.CKVN);
        k_gemm<ALBf16, EPF32, 1><<<dim3(384 / 64, MROWS / 64, 1), 256, 0, stream>>>(ALBf16{w.CQN, 256}, w_uq + (size_t)l * 256 * 384, 384, 0, 384, 256, 0, EPF32{w.QRAW, 384});
        k_gemm<ALBf16, EPF32, 1><<<dim3(512 / 64, MROWS / 64, 1), 256, 0, stream>>>(ALBf16{w.CKVN, 128}, w_ukv + (size_t)l * 128 * 512, 512, 0, 512, 128, 0, EPF32{w.KVRAW, 512});
        k_qkv_finish<<<MROWS, 256, 0, stream>>>(w.QRAW, w.KVRAW, w.P, w.QL, w.QC, w.KB, (bf16_t*)(p + L::VTG), wctx ? 1 : 0);
        run_mega(pb + PL_MIX, pb + PL_MIX + 1);
        run_mega(pb + PL_WOUT, pb + PL_WOUT + 1);
        int* CNT = w.CNT + l * NE; int* LIST = w.LIST + (size_t)l * NE * LCAP;
        k_norm2_route<<<MROWS / 4, 256, 0, stream>>>(w.H, norm2_g + l * D, MODl, router_w + (size_t)l * D * NE, router_b + l * NE, w.XN, CNT, LIST, w.GATE, wctx ? 0 : 1);
        run_mega(pb + PL_MOE1, pb + PL_MOE1 + 1);
        run_mega(pb + PL_MOE2, pb + PL_MOE2 + 1);
        k_moe_combine<<<MROWS / 4, 256, 0, stream>>>(w.H, w.Y, MODl, wctx ? 0 : 1, l == 1 ? final_g : nullptr, l == 1 ? out : nullptr);
    }
}
```

```cpp
#include <hip/hip_runtime.h>
#include <cstdint>
#include <cstdio>

typedef unsigned short bf16_t;
constexpr int NB_ = 4, SEQ = 4096, CTX = 256, D = 1024, NPOS = SEQ + CTX, MROWS = NB_ * NPOS;
constexpr int PT = 1952, PP = 2048;
constexpr int NE = 32, TOPK = 4, LCAP = MROWS;
constexpr int NASG = MROWS * TOPK;
constexpr int ACT_ROWS = NASG + NE * 256;
constexpr int C_FN = 0, C_LX = 256, C_LG = 512, C_CQ = 768, C_CKV = 1024, C_KR = 1152, C_SX = 1184, C_SB = 1440, C_SC = 1696;

__device__ __forceinline__ float bf2f(bf16_t v) { return __uint_as_float((unsigned)v << 16); }
__device__ __forceinline__ bf16_t f2bf(float f) { unsigned u = __float_as_uint(f); return (bf16_t)((u + 0x7fffu + ((u >> 16) & 1u)) >> 16); }
__device__ __forceinline__ float wave_sum(float v) {
#pragma unroll
    for (int o = 1; o < 64; o <<= 1) v += __shfl_xor(v, o);
    return v;
}
__device__ __forceinline__ float sigmoidf_(float x) { return 1.f / (1.f + __expf(-x)); }
__device__ __forceinline__ float gelu_tanh(float x) { const float u = 0.7978845608028654f * (x + 0.044715f * x * x * x); return 0.5f * x * (1.f + tanhf(u)); }

#define LAS __attribute__((address_space(3)))
typedef short bf16x8 __attribute__((ext_vector_type(8)));
typedef float f32x4 __attribute__((ext_vector_type(4)));
typedef unsigned u32x4 __attribute__((ext_vector_type(4)));
typedef unsigned u32x2 __attribute__((ext_vector_type(2)));
__device__ __forceinline__ unsigned pk2(float lo, float hi) { return (unsigned)f2bf(lo) | ((unsigned)f2bf(hi) << 16); }

namespace L {
constexpr size_t A256(size_t x) { return (x + 255) & ~(size_t)255; }
constexpr size_t CTL = 0, CTL_BYTES = 1u << 20;
constexpr size_t H = CTL + CTL_BYTES;
constexpr size_t MOD = CTL + 512 * 1024;
constexpr size_t TABC = A256(H + (size_t)MROWS * D * 4);
constexpr size_t TABS = A256(TABC + 4096 * 4);
constexpr size_t XN = A256(TABS + 4096 * 4);
constexpr size_t P = A256(XN + (size_t)MROWS * D * 2);
constexpr size_t MIX = A256(P + (size_t)MROWS * PP * 2);
constexpr size_t CQN = A256(MIX + (size_t)MROWS * D * 2);
constexpr size_t CKVN = A256(CQN + (size_t)MROWS * 256 * 2);
constexpr size_t QRAW = A256(CKVN + (size_t)MROWS * 128 * 2);
constexpr size_t KVRAW = A256(QRAW + (size_t)MROWS * 384 * 4);
constexpr size_t QL = A256(KVRAW + (size_t)MROWS * 512 * 4);
constexpr size_t QC = A256(QL + (size_t)16 * SEQ * 96 * 2);
constexpr size_t KB = A256(QC + (size_t)16 * CTX * 96 * 2);
constexpr size_t VB = A256(KB + (size_t)16 * NPOS * 96 * 2);
constexpr size_t LA = A256(VB + (size_t)16 * NPOS * 64 * 2);
constexpr size_t LB = A256(LA + (size_t)2 * MROWS * 256 * 4);
constexpr size_t HS = A256(LB + (size_t)2 * MROWS * 256 * 4);
constexpr size_t XCS = A256(HS + (size_t)2 * MROWS * 256 * 4);
constexpr size_t XCSC = A256(XCS + (size_t)4 * 8192 * 256 * 4);
constexpr size_t LIST = A256(XCSC + (size_t)4 * 512 * 256 * 4);
constexpr size_t GATE = A256(LIST + (size_t)2 * NE * LCAP * 4);
constexpr size_t ACT = A256(GATE + (size_t)NASG * 4);
constexpr size_t Y = A256(ACT + (size_t)ACT_ROWS * D * 2);
constexpr size_t WINT = A256(Y + (size_t)NASG * D * 2);
constexpr size_t WOUTT = A256(WINT + (size_t)2 * 2048 * 1024 * 2);
constexpr size_t WGUT = A256(WOUTT + (size_t)2 * 1024 * 1024 * 2);
constexpr size_t WDT = A256(WGUT + (size_t)2 * NE * 2048 * 1024 * 2);
constexpr size_t ZBUF = A256(WDT + (size_t)2 * NE * 1024 * 1024 * 2);
constexpr size_t VTG = A256(ZBUF + (size_t)4 * 64 * 64 * 512 * 2);
constexpr size_t WUQT = A256(VTG + (size_t)16 * 64 * NPOS * 2);
constexpr size_t WUKVT = A256(WUQT + (size_t)2 * 384 * 256 * 2);
constexpr size_t WAT = A256(WUKVT + (size_t)2 * 512 * 128 * 2);
constexpr size_t WIT = A256(WAT + (size_t)16 * 4096 * 2);
constexpr size_t HL = A256(WIT + (size_t)16 * 4096 * 2);
constexpr size_t AC = A256(HL + (size_t)2 * MROWS * 256 * 2);
constexpr size_t SUM = A256(AC + (size_t)2 * MROWS * 256 * 2);
constexpr size_t XCT = A256(SUM + (size_t)2 * 4 * 68 * 512 * 4);
constexpr size_t END = A256(XCT + (size_t)16 * 512 * 64 * 2);
constexpr int CW_BAR = 4096;
constexpr int CW_CNT = 32768;
}

#define XB_TMO      128
#define XB_XCNT(j)  (256  + 64 * (j))
#define XB_XSUB(j)  (1280 + 64 * (j))
#define XB_XGEN(j)  (2304 + 64 * (j))
#define XB_TOP      3328
#define XB_TOPGEN   3392
#define XCD_BAR_WORDS 3456
#define XB_SPIN_CAP (1u << 18)
__device__ __forceinline__ unsigned xb_ld(unsigned* p)              { return __hip_atomic_load(p, __ATOMIC_RELAXED, __HIP_MEMORY_SCOPE_AGENT); }
__device__ __forceinline__ unsigned xb_add(unsigned* p, unsigned v) { return __hip_atomic_fetch_add(p, v, __ATOMIC_RELAXED, __HIP_MEMORY_SCOPE_AGENT); }
__device__ __forceinline__ unsigned xb_xcc_id() { return (unsigned)__builtin_amdgcn_s_getreg((3 << 11) | 20) & 0xFu; }
#define XB_SPIN(cond, bar) do { unsigned _sp = 0; while (cond) { __builtin_amdgcn_s_sleep(1); \
    if ((++_sp & 255u) == 0u) { if (xb_ld(&(bar)[XB_TMO])) break; if (_sp > XB_SPIN_CAP) { atomicAdd(&(bar)[XB_TMO], 1u); break; } } } } while (0)
struct XcdBarrier { unsigned* bar; unsigned x; volatile LAS unsigned* st; };
__device__ __forceinline__ XcdBarrier xcd_barrier_post(unsigned* bar, volatile LAS unsigned* st) {
    XcdBarrier b; b.bar = bar; b.x = xb_xcc_id(); b.st = st;
    if (threadIdx.x == 0) (void)xb_add(&bar[XB_XCNT(b.x)], 1u);
    return b;
}
__device__ __forceinline__ void xcd_barrier_complete(unsigned* bar, unsigned x, unsigned& nloc, unsigned& nx) {
    const unsigned G = gridDim.x * gridDim.y * gridDim.z;
    unsigned sum, cnt, mine, sp = 0u;
    for (;;) {
        sum = 0u; cnt = 0u; mine = 0u;
#pragma unroll
        for (unsigned j = 0; j < 16; ++j) { const unsigned c = xb_ld(&bar[XB_XCNT(j)]); sum += c; cnt += (c > 0u) ? 1u : 0u; mine = (j == x) ? c : mine; }
        if (sum == G) break;
        __builtin_amdgcn_s_sleep(1);
        if ((++sp & 255u) == 0u) { if (xb_ld(&bar[XB_TMO])) break; if (sp > XB_SPIN_CAP) { atomicAdd(&bar[XB_TMO], 1u); break; } }
    }
    nloc = mine > 0u ? mine : 1u; nx = cnt > 0u ? cnt : 1u;
}
__device__ __forceinline__ void xcd_barrier(const XcdBarrier& b) {
    asm volatile("s_waitcnt vmcnt(0)" ::: "memory");
    __syncthreads();
    if (threadIdx.x == 0) {
        unsigned* bar = b.bar;
        __builtin_amdgcn_s_waitcnt(0);
        unsigned nloc = b.st[0], nx = b.st[1];
        if (nloc == 0u) { xcd_barrier_complete(bar, b.x, nloc, nx); b.st[0] = nloc; b.st[1] = nx; }
        const unsigned old = xb_add(&bar[XB_XSUB(b.x)], 1u);
        const unsigned gen = old / nloc;
        if (old + 1u == (gen + 1u) * nloc) {
            __builtin_amdgcn_fence(__ATOMIC_RELEASE, "agent");
            asm volatile("s_waitcnt vmcnt(0)" ::: "memory");
            const unsigned og = xb_add(&bar[XB_TOP], 1u);
            const unsigned tg = og / nx;
            if (og + 1u == (tg + 1u) * nx) xb_add(&bar[XB_TOPGEN], 1u);
            else XB_SPIN(xb_ld(&bar[XB_TOPGEN]) == tg, bar);
            __builtin_amdgcn_fence(__ATOMIC_ACQUIRE, "agent");
            xb_add(&bar[XB_XGEN(b.x)], 1u);
            asm volatile("s_waitcnt vmcnt(0)" ::: "memory");
        } else {
            XB_SPIN(xb_ld(&bar[XB_XGEN(b.x)]) == gen, bar);
            __builtin_amdgcn_fence(__ATOMIC_ACQUIRE, "agent");
            asm volatile("s_waitcnt vmcnt(0)" ::: "memory");
        }
    }
    __syncthreads();
}

namespace g8 {
constexpr int BM = 256, BK = 64, HALF = 128, HTB = HALF * BK * 2, STAGE_BYTES = 8 * HTB, NXCD = 8, WGM = 8;
__device__ __forceinline__ int lds_byte(int r, int c) { const int st = (r >> 4) * 2 + (c >> 5), rr = r & 15, cc = c & 31, ob = rr * 64 + cc * 2; return st * 1024 + (ob ^ (((ob >> 9) & 1) << 5)); }
__device__ __forceinline__ void stage_rc(int b, int& R, int& C) { const int st = b / 1024, sb = b % 1024, swz = sb ^ (((sb >> 9) & 1) << 5); R = (st >> 1) * 16 + swz / 64; C = (st & 1) * 32 + (swz % 64) / 2; }
__device__ __forceinline__ int perm32(int rho) { const int n = rho >> 4, i = rho & 15; return 8 * (i >> 2) + 4 * n + (i & 3); }
__device__ __forceinline__ unsigned cvt_pk_bf16(float lo, float hi) { unsigned r; asm volatile("v_cvt_pk_bf16_f32 %0, %1, %2" : "=v"(r) : "v"(lo), "v"(hi)); return r; }
__device__ __forceinline__ int xcd_remap(int wgid, int nwg) { const int q = nwg / NXCD, r = nwg % NXCD, xcd = wgid % NXCD, off = wgid / NXCD; return (xcd < r ? xcd * (q + 1) : r * (q + 1) + (xcd - r) * q) + off; }

struct Unit { int row0, col0, ex, bt, nvalid, lrow; };

struct DenseSched {
    int nM, nN, nwg, G, c, lat_only; const char* Bt; int K; const int* list;
    __device__ __forceinline__ void init(int nM_, int nN_, int G_, int c_, int lat_only_, const void* Bt_, int K_) { nM = nM_; nN = nN_; nwg = nM * nN; G = G_; c = c_; lat_only = lat_only_; Bt = (const char*)Bt_; K = K_; list = nullptr; }
    __device__ __forceinline__ bool next(int i, Unit& u) const {
        const long Lx = (long)i * G + c; if (Lx >= nwg) return false;
        const int wgid = xcd_remap((int)Lx, nwg);
        const int nig = WGM * nN, gid = wgid / nig, fm = gid * WGM, gsz = (nM - fm) < WGM ? (nM - fm) : WGM;
        const int pm = fm + ((wgid % nig) % gsz), pn = (wgid % nig) / gsz;
        const int tile = lat_only ? (pm / 16) * 17 + 1 + (pm % 16) : pm;
        u.row0 = tile * 256; u.col0 = pn * 256; u.ex = 0; u.bt = pn; u.nvalid = 256; u.lrow = 0; return true;
    }
    __device__ __forceinline__ const char* bptr(const Unit& u) const { return Bt + (size_t)u.bt * 256 * K * 2; }
};
struct MoeSched {
    const LAS int* tpre; const LAS int* cnt; int NT, COLW, G, c, total; const char* Bt; int K; const int* list;
    __device__ __forceinline__ bool next(int i, Unit& u) const {
        const long Lx = (long)i * G + c; if (Lx >= total) return false;
        const int wgid = xcd_remap((int)Lx, total);
        int e = 0;
        for (int j = 1; j < NE; ++j) if (tpre[j] * NT <= wgid) e = j;
        const int t0 = tpre[e], mte = tpre[e + 1] - t0, loc = wgid - t0 * NT, nt = loc / mte, mt = loc % mte;
        u.ex = __builtin_amdgcn_readfirstlane(e); u.row0 = __builtin_amdgcn_readfirstlane((t0 + mt) * 256); u.col0 = __builtin_amdgcn_readfirstlane(nt * COLW);
        u.bt = __builtin_amdgcn_readfirstlane(e * NT + nt); const int nv = cnt[e] - mt * 256; u.nvalid = __builtin_amdgcn_readfirstlane(nv < 256 ? nv : 256); u.lrow = __builtin_amdgcn_readfirstlane(mt * 256);
        return true;
    }
    __device__ __forceinline__ const char* bptr(const Unit& u) const { return Bt + (size_t)u.bt * 256 * K * 2; }
};

struct EpiP {
    static constexpr bool PERM = true; bf16_t* O;
    __device__ __forceinline__ void operator()(const f32x4 (&acc)[2][2][4][2], const Unit& u, int wr, int wc, int fr, int fq, const LAS int*) const {
#pragma unroll
        for (int ai = 0; ai < 2; ++ai)
#pragma unroll
            for (int m = 0; m < 4; ++m) { bf16_t* rowp = O + (size_t)(u.row0 + ai * HALF + wr * 64 + m * 16 + fr) * PP + u.col0 + wc * 32 + 8 * fq;
#pragma unroll
                for (int bj = 0; bj < 2; ++bj) { const f32x4 v0 = acc[ai][bj][m][0], v1 = acc[ai][bj][m][1]; u32x4 w; w.x = cvt_pk_bf16(v0[0], v0[1]); w.y = cvt_pk_bf16(v0[2], v0[3]); w.z = cvt_pk_bf16(v1[0], v1[1]); w.w = cvt_pk_bf16(v1[2], v1[3]);
                    *(u32x4*)(rowp + bj * HALF) = w; } }
    }
};
struct EpiH {
    static constexpr bool PERM = false; float* Hh; const float* MODl; int g_off;
    __device__ __forceinline__ void operator()(const f32x4 (&acc)[2][2][4][2], const Unit& u, int wr, int wc, int fr, int fq, const LAS int*) const {
        const int tile = u.row0 >> 8, v = (tile % 17 == 0) ? 4 : tile / 17; const float* gp = MODl + (size_t)v * 6144 + g_off + u.col0 + wc * 32 + 4 * fq;
        f32x4 gv[2][2];
#pragma unroll
        for (int bj = 0; bj < 2; ++bj)
#pragma unroll
            for (int n = 0; n < 2; ++n) gv[bj][n] = *(const f32x4*)(gp + bj * HALF + n * 16);
#pragma unroll
        for (int ai = 0; ai < 2; ++ai)
#pragma unroll
            for (int m = 0; m < 4; ++m) { float* rowp = Hh + (size_t)(u.row0 + ai * HALF + wr * 64 + m * 16 + fr) * D + u.col0 + wc * 32 + 4 * fq;
#pragma unroll
                for (int bj = 0; bj < 2; ++bj)
#pragma unroll
                    for (int n = 0; n < 2; ++n) { f32x4* p = (f32x4*)(rowp + bj * HALF + n * 16); *p = *p + gv[bj][n] * acc[ai][bj][m][n]; } }
    }
};
struct EpiMoe1 {
    static constexpr bool PERM = true; bf16_t* ACTp; const float* bgu;
    __device__ __forceinline__ void operator()(const f32x4 (&acc)[2][2][4][2], const Unit& u, int wr, int wc, int fr, int fq, const LAS int*) const {
        const int cc = u.col0 + wc * 32 + 8 * fq; const float* bp = bgu + (size_t)u.ex * 2048 + cc;
        f32x4 bg[2], bu[2];
#pragma unroll
        for (int n = 0; n < 2; ++n) { bg[n] = *(const f32x4*)(bp + 4 * n); bu[n] = *(const f32x4*)(bp + 1024 + 4 * n); }
#pragma unroll
        for (int ai = 0; ai < 2; ++ai)
#pragma unroll
            for (int m = 0; m < 4; ++m) { const int r = ai * HALF + wr * 64 + m * 16 + fr;
                float o[8];
#pragma unroll
                for (int n = 0; n < 2; ++n)
#pragma unroll
                    for (int i = 0; i < 4; ++i) { const float g = fminf(acc[ai][0][m][n][i] + bg[n][i], 7.f); const float uu = fminf(fmaxf(acc[ai][1][m][n][i] + bu[n][i], -7.f), 7.f);
                        o[n * 4 + i] = (uu + 1.f) * g * __builtin_amdgcn_rcpf(1.f + __expf(-1.702f * g)); }
                if (r < u.nvalid) { u32x4 w; w.x = cvt_pk_bf16(o[0], o[1]); w.y = cvt_pk_bf16(o[2], o[3]); w.z = cvt_pk_bf16(o[4], o[5]); w.w = cvt_pk_bf16(o[6], o[7]);
                    *(u32x4*)(ACTp + (size_t)(u.row0 + r) * D + cc) = w; } }
    }
};
struct EpiMoe2 {
    static constexpr bool PERM = true; bf16_t* Yp; const float* bd; const float* GATEp;
    __device__ __forceinline__ void operator()(const f32x4 (&acc)[2][2][4][2], const Unit& u, int wr, int wc, int fr, int fq, const LAS int* rows) const {
        const int cc = u.col0 + wc * 32 + 8 * fq; const float* bp = bd + (size_t)u.ex * 1024 + cc;
        f32x4 bv[2][2];
#pragma unroll
        for (int bj = 0; bj < 2; ++bj)
#pragma unroll
            for (int n = 0; n < 2; ++n) bv[bj][n] = *(const f32x4*)(bp + bj * HALF + 4 * n);
#pragma unroll
        for (int ai = 0; ai < 2; ++ai)
#pragma unroll
            for (int m = 0; m < 4; ++m) { const int r = ai * HALF + wr * 64 + m * 16 + fr;
                if (r < u.nvalid) { const int asg = rows[r]; const float gt = GATEp[asg]; bf16_t* rowp = Yp + (size_t)asg * D + cc;
#pragma unroll
                    for (int bj = 0; bj < 2; ++bj) { const f32x4 v0 = (acc[ai][bj][m][0] + bv[bj][0]) * gt, v1 = (acc[ai][bj][m][1] + bv[bj][1]) * gt;
                        u32x4 w; w.x = cvt_pk_bf16(v0[0], v0[1]); w.y = cvt_pk_bf16(v0[2], v0[3]); w.z = cvt_pk_bf16(v1[0], v1[1]); w.w = cvt_pk_bf16(v1[2], v1[3]); *(u32x4*)(rowp + bj * HALF) = w; } } }
    }
};

template <class Epi, class Sched, bool GATHER, bool ROWLIST>
__device__ __forceinline__ void gemm_phase(LAS unsigned char* lds, const char* Abase, const int K, const Sched& S, const Epi& E) {
    int tid_l = threadIdx.x; asm volatile("" : "+v"(tid_l));
    const int tid = tid_l, wid = __builtin_amdgcn_readfirstlane(tid >> 6), lane = tid & 63, wr = wid >> 2, wc = wid & 3, fr = lane & 15, fq = lane >> 4;
    const int nt = K / BK; const unsigned Kb = (unsigned)K * 2u;
    unsigned voffB[2];
#pragma unroll
    for (int i = 0; i < 2; ++i) { int R, C; stage_rc(tid * 16 + i * 8192, R, C); const int Rb = Epi::PERM ? ((R & ~31) + perm32(R & 31)) : R; voffB[i] = (unsigned)(Rb * K + C) * 2u; }
    const size_t kstep = (size_t)(BK * 2), hstep = (size_t)HALF * K * 2;
    const unsigned ldsw = (unsigned)wid * 1024u;
    const int aoff = lds_byte(wr * 64 + fr, fq * 8), boff = lds_byte(wc * 32 + fr, fq * 8);
    LAS int* rowbuf = (LAS int*)(lds + STAGE_BYTES);
#define G8_SA(b, h) (((b) * 2 + (h)) * HTB)
#define G8_SB(b, h) ((4 + (b) * 2 + (h)) * HTB)
#define G8_STAGE_A(bufoff, kb, v) do { _Pragma("unroll") for (int _i = 0; _i < 2; ++_i) \
        __builtin_amdgcn_global_load_lds((const unsigned*)((kb) + (size_t)(v)[_i]), (LAS unsigned*)(lds + (bufoff) + ldsw + _i * 8192), 16, 0, 0); } while (0)
#define G8_STAGE_B(bufoff, gbase) do { _Pragma("unroll") for (int _i = 0; _i < 2; ++_i) \
        __builtin_amdgcn_global_load_lds((const unsigned*)((gbase) + voffB[_i]), (LAS unsigned*)(lds + (bufoff) + ldsw + _i * 8192), 16, 0, 0); } while (0)
#define G8_LDA(dst, b, h) do { _Pragma("unroll") for (int m = 0; m < 4; ++m) _Pragma("unroll") for (int k = 0; k < 2; ++k) dst[m][k] = *(const LAS bf16x8*)(lds + G8_SA(b, h) + aoff + m * 2048 + k * 1024); } while (0)
#define G8_LDB(dst, b, h) do { _Pragma("unroll") for (int n = 0; n < 2; ++n) _Pragma("unroll") for (int k = 0; k < 2; ++k) dst[n][k] = *(const LAS bf16x8*)(lds + G8_SB(b, h) + boff + n * 2048 + k * 1024); } while (0)
#define G8_MMA(ai, bj, At, Bt) do { __builtin_amdgcn_s_setprio(1); _Pragma("unroll") for (int m = 0; m < 4; ++m) _Pragma("unroll") for (int n = 0; n < 2; ++n) _Pragma("unroll") for (int k = 0; k < 2; ++k) \
        acc[ai][bj][m][n] = __builtin_amdgcn_mfma_f32_16x16x32_bf16(Bt[n][k], At[m][k], acc[ai][bj][m][n], 0, 0, 0); __builtin_amdgcn_s_setprio(0); } while (0)
#define G8_WAIT_V(n) asm volatile("s_waitcnt vmcnt(" #n ")" ::: "memory")
#define G8_WAIT_L(n) asm volatile("s_waitcnt lgkmcnt(" #n ")" ::: "memory")
#define G8_BAR __builtin_amdgcn_s_barrier()
#define G8_SCHED __builtin_amdgcn_sched_barrier(0)
#define G8_LISTDMA(u, s) do { if (wid < 4) __builtin_amdgcn_global_load_lds((const unsigned*)(S.list + (size_t)(u).ex * LCAP + (u).lrow + wid * 64 + lane), (LAS unsigned*)(rowbuf + (s) * 256 + wid * 64), 4, 0, 0); } while (0)
#define G8_ROWS_DENSE(v) do { _Pragma("unroll") for (int _i = 0; _i < 2; ++_i) { int _R, _C; stage_rc(tid * 16 + _i * 8192, _R, _C); _Pragma("unroll") for (int _h = 0; _h < 2; ++_h) (v)[_h][_i] = (unsigned)(_h * HALF + _R) * Kb + (unsigned)_C * 2u; } } while (0)
#define G8_ROWS_LIST(v, u, s) do { _Pragma("unroll") for (int _i = 0; _i < 2; ++_i) { int _R, _C; stage_rc(tid * 16 + _i * 8192, _R, _C); _Pragma("unroll") for (int _h = 0; _h < 2; ++_h) { const int _r = _h * HALF + _R; const int _a = rowbuf[(s) * 256 + _r]; \
        (v)[_h][_i] = (unsigned)(_r < (u).nvalid ? (_a >> 2) : 0) * Kb + (unsigned)_C * 2u; } } } while (0)
    Unit cur, nxt; int ui = 0, slot = 0;
    if (!S.next(0, cur)) return;
    unsigned vA[2][2];
    if constexpr (ROWLIST) { G8_LISTDMA(cur, 0); G8_WAIT_V(0); G8_BAR; }
    if constexpr (GATHER) { G8_ROWS_LIST(vA, cur, 0); } else { G8_ROWS_DENSE(vA); }
    f32x4 acc[2][2][4][2];
#pragma unroll
    for (int a = 0; a < 2; ++a)
#pragma unroll
        for (int b = 0; b < 2; ++b)
#pragma unroll
            for (int m = 0; m < 4; ++m)
#pragma unroll
                for (int n = 0; n < 2; ++n) acc[a][b][m][n] = (f32x4){0.f, 0.f, 0.f, 0.f};
    bf16x8 At[4][2], B0[2][2], B1[2][2];
    const char* cB = S.bptr(cur);
    const char* cA = GATHER ? Abase : Abase + (size_t)cur.row0 * Kb;
    G8_STAGE_B(G8_SB(0, 0), cB); G8_STAGE_B(G8_SB(0, 1), cB + hstep); G8_STAGE_A(G8_SA(0, 0), cA, vA[0]); G8_STAGE_A(G8_SA(0, 1), cA, vA[1]);
    if (wr == 1) G8_BAR;
    G8_WAIT_V(2); G8_BAR;
    G8_STAGE_B(G8_SB(1, 0), cB + kstep); G8_STAGE_A(G8_SA(1, 0), cA + kstep, vA[0]); G8_STAGE_B(G8_SB(1, 1), cB + hstep + kstep);
    G8_WAIT_V(6); G8_BAR;
    for (;;) {
        const bool has_next = S.next(ui + 1, nxt);
        const char* nB = has_next ? S.bptr(nxt) : cB;
        const char* nA = (GATHER || !has_next) ? cA : Abase + (size_t)nxt.row0 * Kb;
        const int nslot = slot == 2 ? 0 : slot + 1;
        if constexpr (ROWLIST) { if (has_next) G8_LISTDMA(nxt, nslot); }
        for (int t = 0; t < nt; t += 2) {
            const bool last = (t == nt - 2);
            const char* a1 = cA + (size_t)(t + 1) * kstep;
            const char* a2 = last ? nA : cA + (size_t)(t + 2) * kstep; const char* b2 = last ? nB : cB + (size_t)(t + 2) * kstep;
            const char* a3 = a2 + kstep; const char* b3 = b2 + kstep;
            G8_LDB(B0, 0, 0); G8_LDB(B1, 0, 1); G8_SCHED; G8_LDA(At, 0, 0); G8_STAGE_A(G8_SA(1, 1), a1, vA[1]);
            if constexpr (GATHER) { if (last && has_next) { G8_ROWS_LIST(vA, nxt, nslot); } }
            G8_WAIT_V(8); G8_WAIT_L(0); G8_BAR; G8_MMA(0, 0, At, B0); G8_MMA(0, 1, At, B1); G8_BAR; G8_SCHED;
            G8_LDA(At, 0, 1); G8_STAGE_B(G8_SB(0, 0), b2); G8_STAGE_B(G8_SB(0, 1), b2 + hstep); G8_STAGE_A(G8_SA(0, 0), a2, vA[0]);
            G8_WAIT_V(8); G8_WAIT_L(0); G8_BAR; G8_MMA(1, 0, At, B0); G8_MMA(1, 1, At, B1); G8_BAR; G8_SCHED;
            G8_LDB(B0, 1, 0); G8_LDB(B1, 1, 1); G8_SCHED; G8_LDA(At, 1, 0); G8_STAGE_A(G8_SA(0, 1), a2, vA[1]);
            G8_WAIT_V(8); G8_WAIT_L(0); G8_BAR; G8_MMA(0, 0, At, B0); G8_MMA(0, 1, At, B1); G8_BAR; G8_SCHED;
            G8_LDA(At, 1, 1); G8_STAGE_B(G8_SB(1, 0), b3); G8_STAGE_B(G8_SB(1, 1), b3 + hstep); G8_STAGE_A(G8_SA(1, 0), a3, vA[0]);
            G8_WAIT_V(8); G8_WAIT_L(0); G8_BAR; G8_MMA(1, 0, At, B0); G8_MMA(1, 1, At, B1); G8_BAR; G8_SCHED;
        }
        if (wr == 0) G8_BAR;
        { int t2 = threadIdx.x; asm volatile("" : "+v"(t2));
          const int w2 = __builtin_amdgcn_readfirstlane(t2 >> 6); E(acc, cur, w2 >> 2, w2 & 3, t2 & 15, (t2 & 63) >> 4, rowbuf + slot * 256); }
        if (!has_next) break;
#pragma unroll
        for (int a = 0; a < 2; ++a)
#pragma unroll
            for (int b = 0; b < 2; ++b)
#pragma unroll
                for (int m = 0; m < 4; ++m)
#pragma unroll
                    for (int n = 0; n < 2; ++n) acc[a][b][m][n] = (f32x4){0.f, 0.f, 0.f, 0.f};
        cur = nxt; cB = nB; cA = nA; ++ui; slot = nslot;
        if (wr == 1) G8_BAR;
    }
    G8_WAIT_V(0);
    G8_BAR;
#undef G8_SA
#undef G8_SB
#undef G8_STAGE_A
#undef G8_STAGE_B
#undef G8_LDA
#undef G8_LDB
#undef G8_MMA
#undef G8_WAIT_V
#undef G8_WAIT_L
#undef G8_BAR
#undef G8_SCHED
#undef G8_LISTDMA
#undef G8_ROWS_DENSE
#undef G8_ROWS_LIST
}
}

namespace fft {
constexpr int TP = 72;
constexpr int UP = 264;
constexpr int ZP = 520;
constexpr int O_TC = 0, O_TS = 9216, O_U = 18432, O_X = 52224, O_TW = 125952;
__device__ __forceinline__ bf16x8 neg8(bf16x8 v) { u32x4 w = __builtin_bit_cast(u32x4, v); w = w ^ 0x80008000u; return __builtin_bit_cast(bf16x8, w); }
__device__ __forceinline__ void build_tables(LAS unsigned char* lds, const float* TABC, const float* TABS, int tid) {
    for (int i = tid; i < 4096; i += 512) { const int a = i >> 6, b = i & 63, ix = ((a * b) & 63) * 64;
        ((LAS bf16_t*)(lds + O_TC))[a * TP + b] = f2bf(TABC[ix]); ((LAS bf16_t*)(lds + O_TS))[a * TP + b] = f2bf(TABS[ix]); }
}
__device__ __forceinline__ void stage_a(LAS unsigned char* lds, const bf16_t* P, const float* TABC, const float* TABS, bf16_t* ZBUF, int G, int bx) {
    int tid_l = threadIdx.x; asm volatile("" : "+v"(tid_l));
    const int tid = tid_l, lane = tid & 63, w = __builtin_amdgcn_readfirstlane(tid >> 6), fr = lane & 15, fq = lane >> 4;
    build_tables(lds, TABC, TABS, tid);
    const LAS bf16_t* Tc = (const LAS bf16_t*)(lds + O_TC); const LAS bf16_t* Ts = (const LAS bf16_t*)(lds + O_TS);
    LAS bf16_t* U = (LAS bf16_t*)(lds + O_U); LAS bf16_t* X = (LAS bf16_t*)(lds + O_X); LAS float* TW = (LAS float*)(lds + O_TW);
    for (int unit = bx; unit < 256; unit += G) {
        const int b = unit >> 6, t2 = unit & 63;
#pragma unroll
        for (int i = 0; i < 4; ++i) { const int q = tid + 512 * i, t1 = q >> 5, ch = q & 31;
            *(LAS u32x4*)((LAS unsigned char*)U + t1 * (UP * 2) + ch * 16) = *(const u32x4*)(P + ((size_t)b * NPOS + CTX + 64 * t1 + t2) * PP + ch * 8); }
        if (tid < 64) { const int ix = tid * t2; TW[2 * tid] = TABC[ix]; TW[2 * tid + 1] = TABS[ix]; }
        __syncthreads();
        { const int g = w >> 1, part = w & 1; const LAS bf16_t* T = part ? Ts : Tc;
          f32x4 acc[4][4];
#pragma unroll
          for (int mt = 0; mt < 4; ++mt)
#pragma unroll
              for (int nt = 0; nt < 4; ++nt) acc[mt][nt] = (f32x4){0.f, 0.f, 0.f, 0.f};
#pragma unroll
          for (int ks = 0; ks < 2; ++ks) { bf16x8 a[4], bb[4];
#pragma unroll
              for (int mt = 0; mt < 4; ++mt) a[mt] = *(const LAS bf16x8*)(U + (16 * mt + fr) * UP + g * 64 + 32 * ks + 8 * fq);
#pragma unroll
              for (int nt = 0; nt < 4; ++nt) bb[nt] = *(const LAS bf16x8*)(T + (16 * nt + fr) * TP + 32 * ks + 8 * fq);
#pragma unroll
              for (int mt = 0; mt < 4; ++mt)
#pragma unroll
                  for (int nt = 0; nt < 4; ++nt) acc[mt][nt] = __builtin_amdgcn_mfma_f32_16x16x32_bf16(a[mt], bb[nt], acc[mt][nt], 0, 0, 0); }
          const float sg = part ? -1.f : 1.f;
#pragma unroll
          for (int mt = 0; mt < 4; ++mt)
#pragma unroll
              for (int nt = 0; nt < 4; ++nt) { const f32x4 v = acc[mt][nt] * sg; u32x2 o; o.x = pk2(v[0], v[1]); o.y = pk2(v[2], v[3]);
                  *(LAS u32x2*)(X + (part * 256 + g * 64 + 16 * nt + fr) * TP + 16 * mt + 4 * fq) = o; } }
        __syncthreads();
        f32x4 zr[4][2], zi[4][2];
#pragma unroll
        for (int mt = 0; mt < 4; ++mt)
#pragma unroll
            for (int n = 0; n < 2; ++n) { zr[mt][n] = (f32x4){0.f, 0.f, 0.f, 0.f}; zi[mt][n] = (f32x4){0.f, 0.f, 0.f, 0.f}; }
#pragma unroll
        for (int ks = 0; ks < 2; ++ks) { bf16x8 xr[2], xi[2];
#pragma unroll
            for (int n = 0; n < 2; ++n) { xr[n] = *(const LAS bf16x8*)(X + (32 * w + 16 * n + fr) * TP + 32 * ks + 8 * fq); xi[n] = *(const LAS bf16x8*)(X + (256 + 32 * w + 16 * n + fr) * TP + 32 * ks + 8 * fq); }
#pragma unroll
            for (int mt = 0; mt < 4; ++mt) { const bf16x8 c = *(const LAS bf16x8*)(Tc + (16 * mt + fr) * TP + 32 * ks + 8 * fq), s = *(const LAS bf16x8*)(Ts + (16 * mt + fr) * TP + 32 * ks + 8 * fq), ns = neg8(s);
#pragma unroll
                for (int n = 0; n < 2; ++n) { zr[mt][n] = __builtin_amdgcn_mfma_f32_16x16x32_bf16(c, xr[n], zr[mt][n], 0, 0, 0); zr[mt][n] = __builtin_amdgcn_mfma_f32_16x16x32_bf16(s, xi[n], zr[mt][n], 0, 0, 0);
                    zi[mt][n] = __builtin_amdgcn_mfma_f32_16x16x32_bf16(c, xi[n], zi[mt][n], 0, 0, 0); zi[mt][n] = __builtin_amdgcn_mfma_f32_16x16x32_bf16(ns, xr[n], zi[mt][n], 0, 0, 0); } } }
        __syncthreads();
        { LAS bf16_t* Zs = X;
#pragma unroll
          for (int mt = 0; mt < 4; ++mt)
#pragma unroll
              for (int i = 0; i < 4; ++i) { const int f1 = 16 * mt + 4 * fq + i; const float ct = TW[2 * f1], st = TW[2 * f1 + 1];
#pragma unroll
                  for (int n = 0; n < 2; ++n) { const float a = zr[mt][n][i], bq = zi[mt][n][i]; const int col = 32 * w + 16 * n + fr;
                      Zs[f1 * ZP + col] = f2bf(a * ct + bq * st); Zs[f1 * ZP + 256 + col] = f2bf(bq * ct - a * st); } } }
        __syncthreads();
#pragma unroll
        for (int i = 0; i < 8; ++i) { const int q = tid + 512 * i, f1 = q >> 6, ch = q & 63;
            *(u32x4*)(ZBUF + (((size_t)b * 64 + f1) * 64 + t2) * 512 + ch * 8) = *(const LAS u32x4*)((const LAS unsigned char*)X + f1 * (ZP * 2) + ch * 16); }
        __syncthreads();
    }
}
__device__ __forceinline__ void stage_b(LAS unsigned char* lds, const bf16_t* ZBUF, const float* TABC, const float* TABS, bf16_t* MIX, int G, int bx) {
    int tid_l = threadIdx.x; asm volatile("" : "+v"(tid_l));
    const int tid = tid_l, lane = tid & 63, w = __builtin_amdgcn_readfirstlane(tid >> 6), fr = lane & 15, fq = lane >> 4;
    build_tables(lds, TABC, TABS, tid);
    const LAS bf16_t* Tc = (const LAS bf16_t*)(lds + O_TC); const LAS bf16_t* Ts = (const LAS bf16_t*)(lds + O_TS);
    LAS bf16_t* Ys = (LAS bf16_t*)(lds + O_U); LAS bf16_t* ZT = (LAS bf16_t*)(lds + O_X);
    for (int unit = bx; unit < 256; unit += G) {
        const int b = unit >> 6, f1 = unit & 63;
        const bf16_t* Zg = ZBUF + ((size_t)b * 64 + f1) * 64 * 512;
#pragma unroll
        for (int i = 0; i < 4; ++i) { const int q = tid + 512 * i, p = q & 31, ch = q >> 5;
            const u32x4 r0 = *(const u32x4*)(Zg + (size_t)(2 * p) * 512 + ch * 8), r1 = *(const u32x4*)(Zg + (size_t)(2 * p + 1) * 512 + ch * 8);
#pragma unroll
            for (int j = 0; j < 4; ++j) { const unsigned a = r0[j], c = r1[j];
                *(LAS unsigned*)(ZT + (ch * 8 + 2 * j) * TP + 2 * p) = (a & 0xffffu) | (c << 16);
                *(LAS unsigned*)(ZT + (ch * 8 + 2 * j + 1) * TP + 2 * p) = (a >> 16) | (c & 0xffff0000u); } }
        __syncthreads();
        f32x4 y[4][2];
#pragma unroll
        for (int mt = 0; mt < 4; ++mt)
#pragma unroll
            for (int n = 0; n < 2; ++n) y[mt][n] = (f32x4){0.f, 0.f, 0.f, 0.f};
#pragma unroll
        for (int ks = 0; ks < 2; ++ks) { bf16x8 xr[2], xi[2];
#pragma unroll
            for (int n = 0; n < 2; ++n) { xr[n] = *(const LAS bf16x8*)(ZT + (32 * w + 16 * n + fr) * TP + 32 * ks + 8 * fq); xi[n] = *(const LAS bf16x8*)(ZT + (256 + 32 * w + 16 * n + fr) * TP + 32 * ks + 8 * fq); }
#pragma unroll
            for (int mt = 0; mt < 4; ++mt) { const bf16x8 c = *(const LAS bf16x8*)(Tc + (16 * mt + fr) * TP + 32 * ks + 8 * fq), s = *(const LAS bf16x8*)(Ts + (16 * mt + fr) * TP + 32 * ks + 8 * fq);
#pragma unroll
                for (int n = 0; n < 2; ++n) { y[mt][n] = __builtin_amdgcn_mfma_f32_16x16x32_bf16(c, xr[n], y[mt][n], 0, 0, 0); y[mt][n] = __builtin_amdgcn_mfma_f32_16x16x32_bf16(s, xi[n], y[mt][n], 0, 0, 0); } } }
#pragma unroll
        for (int mt = 0; mt < 4; ++mt)
#pragma unroll
            for (int i = 0; i < 4; ++i)
#pragma unroll
                for (int n = 0; n < 2; ++n) Ys[(16 * mt + 4 * fq + i) * UP + 32 * w + 16 * n + fr] = f2bf(y[mt][n][i] * (1.f / 512.f));
        __syncthreads();
#pragma unroll
        for (int i = 0; i < 4; ++i) { const int q = tid + 512 * i, f2 = q >> 5, ch = q & 31;
            *(u32x4*)(MIX + ((size_t)b * NPOS + CTX + f1 + 64 * f2) * D + ch * 8) = *(const LAS u32x4*)((const LAS unsigned char*)Ys + f2 * (UP * 2) + ch * 16); }
        __syncthreads();
    }
}
}

namespace attn {
typedef float f32x16 __attribute__((ext_vector_type(16)));
typedef float f32x2_t __attribute__((ext_vector_type(2))); typedef __bf16 bf16x2_t __attribute__((ext_vector_type(2)));
__device__ __forceinline__ unsigned cvtpk(float lo, float hi) { f32x2_t v = {lo, hi}; bf16x2_t b = __builtin_convertvector(v, bf16x2_t); return __builtin_bit_cast(unsigned, b); }
constexpr int KP = 104, VP = 68;
constexpr int KT_BYTES = 64 * KP * 2, VT_BYTES = 64 * VP * 2, BUF_BYTES = KT_BYTES + VT_BYTES;
constexpr float C2 = 0.10206207261596577f * 1.4426950408889634f;
__device__ __forceinline__ void attn_phase(LAS unsigned char* lds, const bf16_t* QL, const bf16_t* QC, const bf16_t* KB, const bf16_t* VTG, bf16_t* MIX, int with_ctx, int G, int vcu) {
    int tid_l = threadIdx.x; asm volatile("" : "+v"(tid_l));
    const int tid = tid_l, lane = tid & 63, wid = __builtin_amdgcn_readfirstlane(tid >> 6), r32 = lane & 31, hi = lane >> 5;
    const int nunits = 256 + (with_ctx ? 16 : 0);
    for (int unit = vcu; unit < nunits; unit += G) {
        int bh, nk, orow0; const bf16_t* Qp;
        if (unit < 256) { bh = unit >> 4; const int qb = unit & 15; Qp = QL + ((size_t)bh * SEQ + qb * 256) * 96; nk = NPOS; orow0 = (bh >> 2) * NPOS + CTX + qb * 256; }
        else { bh = unit - 256; Qp = QC + (size_t)bh * CTX * 96; nk = CTX; orow0 = (bh >> 2) * NPOS; }
        const int hh = bh & 3, NT = nk / 64;
        const bf16_t* Kg = KB + (size_t)bh * NPOS * 96; const bf16_t* Vg = VTG + (size_t)bh * 64 * NPOS;
        bf16x8 qf[6];
        { const bf16_t* qp = Qp + (size_t)(wid * 32 + r32) * 96 + 8 * hi;
#pragma unroll
          for (int ds = 0; ds < 6; ++ds) qf[ds] = *(const bf16x8*)(qp + 16 * ds); }
        f32x16 o0 = {}, o1 = {}; float m = -1e30f, l = 0.f;
        const int kr0 = tid / 12, kc0 = tid % 12, kr1 = (tid + 512) / 12, kc1 = (tid + 512) % 12; const bool k1ok = tid < 256;
        const int vd = tid >> 3, vc = tid & 7;
        u32x4 sk0, sk1 = {}, sv;
        sk0 = *(const u32x4*)(Kg + (size_t)kr0 * 96 + kc0 * 8); if (k1ok) sk1 = *(const u32x4*)(Kg + (size_t)kr1 * 96 + kc1 * 8); sv = *(const u32x4*)(Vg + (size_t)vd * NPOS + vc * 8);
        int cur = 0;
        { LAS unsigned char* bp = lds; *(LAS u32x4*)(bp + kr0 * (KP * 2) + kc0 * 16) = sk0; if (k1ok) *(LAS u32x4*)(bp + kr1 * (KP * 2) + kc1 * 16) = sk1; *(LAS u32x4*)(bp + KT_BYTES + vd * (VP * 2) + vc * 16) = sv; }
        __syncthreads();
        for (int t = 0; t < NT; ++t) {
            if (t + 1 < NT) { const size_t k0 = (size_t)(t + 1) * 64;
                sk0 = *(const u32x4*)(Kg + (k0 + kr0) * 96 + kc0 * 8); if (k1ok) sk1 = *(const u32x4*)(Kg + (k0 + kr1) * 96 + kc1 * 8); sv = *(const u32x4*)(Vg + (size_t)vd * NPOS + k0 + vc * 8); }
            const LAS bf16_t* Kt = (const LAS bf16_t*)(lds + cur * BUF_BYTES); const LAS bf16_t* Vt = (const LAS bf16_t*)(lds + cur * BUF_BYTES + KT_BYTES);
            f32x16 p0 = {}, p1 = {};
#pragma unroll
            for (int ds = 0; ds < 6; ++ds) { const bf16x8 k0f = *(const LAS bf16x8*)(Kt + r32 * KP + 16 * ds + 8 * hi), k1f = *(const LAS bf16x8*)(Kt + (32 + r32) * KP + 16 * ds + 8 * hi);
                p0 = __builtin_amdgcn_mfma_f32_32x32x16_bf16(k0f, qf[ds], p0, 0, 0, 0); p1 = __builtin_amdgcn_mfma_f32_32x32x16_bf16(k1f, qf[ds], p1, 0, 0, 0); }
            float mx = fmaxf(p0[0], p1[0]);
#pragma unroll
            for (int r = 1; r < 16; ++r) mx = fmaxf(mx, fmaxf(p0[r], p1[r]));
            mx = fmaxf(mx, __shfl_xor(mx, 32));
            const float mn = fmaxf(m, mx), alpha = __builtin_amdgcn_exp2f(m - mn); m = mn;
            float ls = 0.f;
#pragma unroll
            for (int r = 0; r < 16; ++r) { p0[r] = __builtin_amdgcn_exp2f(p0[r] - mn); p1[r] = __builtin_amdgcn_exp2f(p1[r] - mn); ls += p0[r] + p1[r]; }
            l = l * alpha + ls;
#pragma unroll
            for (int r = 0; r < 16; ++r) { o0[r] *= alpha; o1[r] *= alpha; }
#pragma unroll
            for (int s = 0; s < 4; ++s) {
                u32x4 pw;
#pragma unroll
                for (int j = 0; j < 4; ++j) { const int r = 8 * (s & 1) + 2 * j; pw[j] = (s < 2) ? cvtpk(p0[r], p0[r + 1]) : cvtpk(p1[r], p1[r + 1]); }
                const bf16x8 pf = __builtin_bit_cast(bf16x8, pw);
                const int kvb = 32 * (s >> 1) + 16 * (s & 1) + 4 * hi;
#pragma unroll
                for (int db = 0; db < 2; ++db) { const u32x2 va = *(const LAS u32x2*)(Vt + (32 * db + r32) * VP + kvb), vb = *(const LAS u32x2*)(Vt + (32 * db + r32) * VP + kvb + 8);
                    const u32x4 vw = {va.x, va.y, vb.x, vb.y}; const bf16x8 vf = __builtin_bit_cast(bf16x8, vw);
                    if (db == 0) o0 = __builtin_amdgcn_mfma_f32_32x32x16_bf16(vf, pf, o0, 0, 0, 0); else o1 = __builtin_amdgcn_mfma_f32_32x32x16_bf16(vf, pf, o1, 0, 0, 0); }
            }
            if (t + 1 < NT) { LAS unsigned char* bp = lds + (cur ^ 1) * BUF_BYTES;
                *(LAS u32x4*)(bp + kr0 * (KP * 2) + kc0 * 16) = sk0; if (k1ok) *(LAS u32x4*)(bp + kr1 * (KP * 2) + kc1 * 16) = sk1; *(LAS u32x4*)(bp + KT_BYTES + vd * (VP * 2) + vc * 16) = sv; }
            __syncthreads();
            cur ^= 1;
        }
        l += __shfl_xor(l, 32);
        const float il = 1.f / l;
        bf16_t* op = MIX + (size_t)(orow0 + wid * 32 + r32) * D + 512 + hh * 64 + 4 * hi;
#pragma unroll
        for (int g4 = 0; g4 < 4; ++g4) { u32x2 w0, w1; w0.x = cvtpk(o0[4 * g4] * il, o0[4 * g4 + 1] * il); w0.y = cvtpk(o0[4 * g4 + 2] * il, o0[4 * g4 + 3] * il);
            w1.x = cvtpk(o1[4 * g4] * il, o1[4 * g4 + 1] * il); w1.y = cvtpk(o1[4 * g4 + 2] * il, o1[4 * g4 + 3] * il);
            *(u32x2*)(op + 8 * g4) = w0; *(u32x2*)(op + 32 + 8 * g4) = w1; }
    }
}
}

namespace sm {
__device__ __forceinline__ float silu(float x) { return x / (1.f + __expf(-x)); }
__device__ __forceinline__ void mod_phase(LAS unsigned char* lds, const float* c, const float* c_ctx, const float* mod_w, const float* mod_b, float* MOD, int G, int bx, int tid) {
    LAS float* s = (LAS float*)lds;
    for (int i = tid; i < 5120; i += 512) { const int v = i >> 10, k = i & 1023; s[i] = silu(v < 4 ? c[v * 1024 + k] : c_ctx[k]); }
    __syncthreads();
    LAS float* red = s + 5120;
    for (int unit = bx; unit < 96; unit += G) {
        const int l = unit / 48, cb = unit % 48, cl = tid & 127, col = cb * 128 + cl, kq = tid >> 7, k0 = kq * 256;
        const float* W = mod_w + ((size_t)l * 1024 + k0) * 6144 + col;
        float a0 = 0.f, a1 = 0.f, a2 = 0.f, a3 = 0.f, a4 = 0.f;
#pragma unroll 16
        for (int k = 0; k < 256; ++k) { const float w = W[(size_t)k * 6144]; a0 += s[k0 + k] * w; a1 += s[1024 + k0 + k] * w; a2 += s[2048 + k0 + k] * w; a3 += s[3072 + k0 + k] * w; a4 += s[4096 + k0 + k] * w; }
        LAS float* rq = red + kq * 640 + cl; rq[0] = a0; rq[128] = a1; rq[256] = a2; rq[384] = a3; rq[512] = a4;
        __syncthreads();
        for (int i = tid; i < 640; i += 512) { const int v = i >> 7, cc = i & 127; const float r = ((red[i] + red[640 + i]) + (red[1280 + i] + red[1920 + i])) + mod_b[l * 6144 + cb * 128 + cc];
            MOD[((size_t)l * 5 + v) * 6144 + cb * 128 + cc] = r; }
        __syncthreads();
    }
}
__device__ __forceinline__ void norm_store(const float4 (&x)[4], float ss, const float* g, const float* mv, int sh_off, int sc_off, bf16_t* xn_row, int lane) {
    const float rs = rsqrtf(wave_sum(ss) * (1.f / D) + 1e-6f);
#pragma unroll
    for (int j = 0; j < 4; ++j) { const int c = (j * 64 + lane) * 4; const float4 gg = *(const float4*)(g + c), sh = *(const float4*)(mv + sh_off + c), sc = *(const float4*)(mv + sc_off + c);
        u32x2 o; o.x = pk2(x[j].x * rs * gg.x * (1.f + sc.x) + sh.x, x[j].y * rs * gg.y * (1.f + sc.y) + sh.y); o.y = pk2(x[j].z * rs * gg.z * (1.f + sc.z) + sh.z, x[j].w * rs * gg.w * (1.f + sc.w) + sh.w);
        *(u32x2*)(xn_row + c) = o; }
}
__device__ __forceinline__ void pro1_phase(const float* x, const float* ctx, const float* g, const float* MODl, float* H, bf16_t* XN, int gw, int NGW, int lane) {
    for (int r = gw; r < MROWS; r += NGW) { const int b = r / NPOS, pos = r % NPOS, v = pos < CTX ? 4 : b;
        const float* src = pos < CTX ? ctx + ((size_t)b * CTX + pos) * D : x + ((size_t)b * SEQ + (pos - CTX)) * D;
        float4 xv[4]; float ss = 0.f;
#pragma unroll
        for (int j = 0; j < 4; ++j) { const int c = (j * 64 + lane) * 4; xv[j] = *(const float4*)(src + c); *(float4*)(H + (size_t)r * D + c) = xv[j]; ss += xv[j].x * xv[j].x + xv[j].y * xv[j].y + xv[j].z * xv[j].z + xv[j].w * xv[j].w; }
        norm_store(xv, ss, g, MODl + (size_t)v * 6144, 0, 1024, XN + (size_t)r * D, lane); }
}
__device__ __forceinline__ void comb_phase(int l, float* H, const bf16_t* Y, const float* MODl, const float* g_next, const float* MODn, bf16_t* XN, const float* final_g, float* out, int gw, int NGW, int lane) {
    for (int r = gw; r < MROWS; r += NGW) { const int b = r / NPOS, pos = r % NPOS, v = pos < CTX ? 4 : b;
        if (l == 1 && pos < CTX) continue;
        const float* g2 = MODl + (size_t)v * 6144 + 5120;
        float4 xv[4]; float ss = 0.f;
#pragma unroll
        for (int j = 0; j < 4; ++j) { const int c = (j * 64 + lane) * 4; xv[j] = *(const float4*)(H + (size_t)r * D + c); float4 s = make_float4(0.f, 0.f, 0.f, 0.f);
#pragma unroll
            for (int k = 0; k < 4; ++k) { const u32x2 y = *(const u32x2*)(Y + ((size_t)r * 4 + k) * D + c); s.x += __uint_as_float(y.x << 16); s.y += __uint_as_float(y.x & 0xffff0000u); s.z += __uint_as_float(y.y << 16); s.w += __uint_as_float(y.y & 0xffff0000u); }
            const float4 gg = *(const float4*)(g2 + c); xv[j].x += gg.x * s.x; xv[j].y += gg.y * s.y; xv[j].z += gg.z * s.z; xv[j].w += gg.w * s.w;
            ss += xv[j].x * xv[j].x + xv[j].y * xv[j].y + xv[j].z * xv[j].z + xv[j].w * xv[j].w; }
        if (l == 0) {
#pragma unroll
            for (int j = 0; j < 4; ++j) *(float4*)(H + (size_t)r * D + (j * 64 + lane) * 4) = xv[j];
            norm_store(xv, ss, g_next, MODn + (size_t)v * 6144, 0, 1024, XN + (size_t)r * D, lane);
        } else { const float rs = rsqrtf(wave_sum(ss) * (1.f / D) + 1e-6f); float* op = out + ((size_t)b * SEQ + (pos - CTX)) * D;
#pragma unroll
            for (int j = 0; j < 4; ++j) { const int c = (j * 64 + lane) * 4; const float4 fg = *(const float4*)(final_g + c); float4 o; o.x = xv[j].x * rs * fg.x; o.y = xv[j].y * rs * fg.y; o.z = xv[j].z * rs * fg.z; o.w = xv[j].w * rs * fg.w; *(float4*)(op + c) = o; } }
    }
}
__device__ __forceinline__ void route_phase(LAS unsigned char* lds, int l, const float* H, const float* g, const float* MODl, const float* rw, const float* rb, bf16_t* XN, int* CNT, int* LIST, float* GATE,
                                            int gw, int NGW, int wave, int lane) {
    LAS float* fs4 = (LAS float*)(lds + wave * 16384);
    for (int grp = gw; grp < MROWS / 4; grp += NGW) {
        const int r0 = grp * 4, b = r0 / NPOS, pos0 = r0 % NPOS, v = pos0 < CTX ? 4 : b; const bool act = !(l == 1 && pos0 < CTX);
        if (!act) continue;
        const float* mv = MODl + (size_t)v * 6144;
#pragma unroll 1
        for (int s = 0; s < 4; ++s) { const int r = r0 + s; float4 xv[4]; float ss = 0.f;
#pragma unroll
            for (int j = 0; j < 4; ++j) { xv[j] = *(const float4*)(H + (size_t)r * D + (j * 64 + lane) * 4); ss += xv[j].x * xv[j].x + xv[j].y * xv[j].y + xv[j].z * xv[j].z + xv[j].w * xv[j].w; }
            const float rs = rsqrtf(wave_sum(ss) * (1.f / D) + 1e-6f);
#pragma unroll
            for (int j = 0; j < 4; ++j) { const int c = (j * 64 + lane) * 4; const float4 gg = *(const float4*)(g + c), sh = *(const float4*)(mv + 3072 + c), sc = *(const float4*)(mv + 4096 + c);
                const float f0 = xv[j].x * rs * gg.x * (1.f + sc.x) + sh.x, f1 = xv[j].y * rs * gg.y * (1.f + sc.y) + sh.y, f2 = xv[j].z * rs * gg.z * (1.f + sc.z) + sh.z, f3 = xv[j].w * rs * gg.w * (1.f + sc.w) + sh.w;
                fs4[(c + 0) * 4 + s] = f0; fs4[(c + 1) * 4 + s] = f1; fs4[(c + 2) * 4 + s] = f2; fs4[(c + 3) * 4 + s] = f3;
                u32x2 o; o.x = pk2(f0, f1); o.y = pk2(f2, f3); *(u32x2*)(XN + (size_t)r * D + c) = o; } }
        const int e = lane & 31, half = lane >> 5; float a0 = 0.f, a1 = 0.f, a2 = 0.f, a3 = 0.f;
        const float* rwp = rw + (size_t)half * 512 * 32 + e; const LAS float* fp = fs4 + half * 512 * 4;
#pragma unroll 8
        for (int k = 0; k < 512; ++k) { const float w = rwp[k * 32]; const f32x4 f = *(const LAS f32x4*)(fp + k * 4); a0 += f[0] * w; a1 += f[1] * w; a2 += f[2] * w; a3 += f[3] * w; }
        a0 += __shfl_xor(a0, 32); a1 += __shfl_xor(a1, 32); a2 += __shfl_xor(a2, 32); a3 += __shfl_xor(a3, 32);
        if (lane < 32) { const float bb = rb[e]; fs4[e] = a0 + bb; fs4[32 + e] = a1 + bb; fs4[64 + e] = a2 + bb; fs4[96 + e] = a3 + bb; }
        if (lane < 4) { const int r = r0 + lane; float vals[4]; int idx[4]; unsigned used = 0u;
#pragma unroll
            for (int k = 0; k < 4; ++k) { float best = -3e38f; int bi = 0; for (int ee = 0; ee < 32; ++ee) { const float xx = fs4[lane * 32 + ee]; if (!((used >> ee) & 1u) && xx > best) { best = xx; bi = ee; } } used |= 1u << bi; vals[k] = best; idx[k] = bi; }
            float ex[4], sum = 0.f;
#pragma unroll
            for (int k = 0; k < 4; ++k) { ex[k] = __expf(vals[k] - vals[0]); sum += ex[k]; }
            const float isum = 1.f / sum;
#pragma unroll
            for (int k = 0; k < 4; ++k) { const int asg = r * 4 + k; GATE[asg] = ex[k] * isum; const int p = atomicAdd(&CNT[idx[k]], 1); LIST[(size_t)idx[k] * LCAP + p] = asg; } }
    }
}
__device__ __forceinline__ void smallw_phase(const float* w_uq, const float* qg, const float* w_ukv, const float* kvg, const float* w_a, const float* w_i, bf16_t* WUQT, bf16_t* WUKVT, bf16_t* WAT, bf16_t* WIT,
                                             float* TABC, float* TABS, int gt, int NGT) {
    for (int i = gt; i < 2 * 384 * 256; i += NGT) { const int l = i / (384 * 256), q = i % (384 * 256), n = q >> 8, k = q & 255; WUQT[i] = f2bf(qg[l * 256 + k] * w_uq[((size_t)l * 256 + k) * 384 + n]); }
    for (int i = gt; i < 2 * 512 * 128; i += NGT) { const int l = i / (512 * 128), q = i % (512 * 128), n = q >> 7, k = q & 127; WUKVT[i] = f2bf(kvg[l * 128 + k] * w_ukv[((size_t)l * 128 + k) * 512 + n]); }
    for (int i = gt; i < 16 * 4096; i += NGT) { const int m = i >> 12, q = i & 4095, e = q >> 6, d = q & 63; WAT[i] = f2bf(w_a[(size_t)m * 4096 + d * 64 + e]); WIT[i] = f2bf(w_i[(size_t)m * 4096 + d * 64 + e]); }
    for (int i = gt; i < 4096; i += NGT) { float s, c; sincospif((float)i / 2048.f, &s, &c); TABC[i] = c; TABS[i] = s; }
}
}

namespace prep {
constexpr int O_KR = 0, O_CS = 8192, O_RS = 16384, O_CQ = 16896  , O_KS = 67072, O_CKV = 100864;
constexpr int CQP = 264, CKP = 136, QSP = 392, KSP = 264;
constexpr float C2 = 0.10206207261596577f * 1.4426950408889634f;
__device__ __forceinline__ void qkv_units(LAS unsigned char* lds, int l, const bf16_t* P, const bf16_t* WUQT, const bf16_t* WUKVT, const float* scw, const float* scb,
                                          bf16_t* QL, bf16_t* QC, bf16_t* KB, bf16_t* VTG, bf16_t* MIX, int G, int bx) {
    LAS float* KRo = (LAS float*)(lds + O_KR); LAS float* CS = (LAS float*)(lds + O_CS); LAS float* RS = (LAS float*)(lds + O_RS);
    LAS bf16_t* CQ = (LAS bf16_t*)(lds + O_CQ); LAS bf16_t* CK = (LAS bf16_t*)(lds + O_CKV); LAS bf16_t* KS = (LAS bf16_t*)(lds + O_KS); LAS bf16_t* QS = (LAS bf16_t*)(lds + O_CQ);
    for (int unit = bx; unit < 272; unit += G) {
        int tid_l = threadIdx.x; asm volatile("" : "+v"(tid_l));
        const int tid = tid_l, lane = tid & 63, w = __builtin_amdgcn_readfirstlane(tid >> 6), fr = lane & 15, fq = lane >> 4;
        const int b = unit / 68, chunk = unit % 68, pos0 = 64 * chunk; const bool ctxt = chunk < 4; const size_t r0 = (size_t)b * NPOS + pos0;
#pragma unroll
        for (int i = 0; i < 4; ++i) { const int q = tid + 512 * i, row = q >> 5, ch = q & 31; *(LAS u32x4*)((LAS unsigned char*)CQ + row * (CQP * 2) + ch * 16) = *(const u32x4*)(P + (r0 + row) * PP + C_CQ + ch * 8); }
#pragma unroll
        for (int i = 0; i < 2; ++i) { const int q = tid + 512 * i, row = q >> 4, ch = q & 15; *(LAS u32x4*)((LAS unsigned char*)CK + row * (CKP * 2) + ch * 16) = *(const u32x4*)(P + (r0 + row) * PP + C_CKV + ch * 8); }
        __syncthreads();
        { const int row = tid >> 3, j = tid & 7; float sq = 0.f, sk = 0.f;
#pragma unroll
          for (int i = 0; i < 4; ++i) { const u32x4 v = *(const LAS u32x4*)((const LAS unsigned char*)CQ + row * (CQP * 2) + j * 64 + i * 16);
#pragma unroll
              for (int e = 0; e < 4; ++e) { const float a = __uint_as_float(v[e] << 16), c = __uint_as_float(v[e] & 0xffff0000u); sq += a * a + c * c; } }
#pragma unroll
          for (int i = 0; i < 2; ++i) { const u32x4 v = *(const LAS u32x4*)((const LAS unsigned char*)CK + row * (CKP * 2) + j * 32 + i * 16);
#pragma unroll
              for (int e = 0; e < 4; ++e) { const float a = __uint_as_float(v[e] << 16), c = __uint_as_float(v[e] & 0xffff0000u); sk += a * a + c * c; } }
          sq += __shfl_xor(sq, 1); sq += __shfl_xor(sq, 2); sq += __shfl_xor(sq, 4); sk += __shfl_xor(sk, 1); sk += __shfl_xor(sk, 2); sk += __shfl_xor(sk, 4);
          if (j == 0) { RS[row * 2] = rsqrtf(sq * (1.f / 256.f) + 1e-6f); RS[row * 2 + 1] = rsqrtf(sk * (1.f / 128.f) + 1e-6f); }
          float cr = 1.f, sr = 0.f, cc = 1.f, sc = 0.f;
          if (!ctxt) { const int t = pos0 - CTX + row; const float inv = __expf(-9.210340371976184f * (float)j * 0.125f); float xa = (float)(t >> 6) * inv * 0.15915494309189535f; xa -= rintf(xa); sr = __sinf(xa * 6.283185307179586f); cr = __cosf(xa * 6.283185307179586f); float xb = (float)(t & 63) * inv * 0.15915494309189535f; xb -= rintf(xb); sc = __sinf(xb * 6.283185307179586f); cc = __cosf(xb * 6.283185307179586f); }
          CS[(row * 16 + j) * 2] = cr; CS[(row * 16 + j) * 2 + 1] = sr; CS[(row * 16 + 8 + j) * 2] = cc; CS[(row * 16 + 8 + j) * 2 + 1] = sc;
          const bf16_t* kp = P + (r0 + row) * PP + C_KR; const float z0 = bf2f(kp[j]), z1 = bf2f(kp[8 + j]), z2 = bf2f(kp[16 + j]), z3 = bf2f(kp[24 + j]);
          KRo[row * 32 + j] = z0 * cr - z1 * sr; KRo[row * 32 + 8 + j] = z0 * sr + z1 * cr; KRo[row * 32 + 16 + j] = z2 * cc - z3 * sc; KRo[row * 32 + 24 + j] = z2 * sc + z3 * cc; }
        __builtin_amdgcn_sched_barrier(0);
        { f32x4 qa[4][3];
#pragma unroll
          for (int mt = 0; mt < 4; ++mt)
#pragma unroll
              for (int n = 0; n < 3; ++n) qa[mt][n] = (f32x4){0.f, 0.f, 0.f, 0.f};
          const bf16_t* wq = WUQT + ((size_t)l * 384 + 48 * w + fr) * 256 + 8 * fq;
#pragma unroll 2
          for (int ks = 0; ks < 8; ++ks) { bf16x8 a[4], bb[3];
#pragma unroll
              for (int mt = 0; mt < 4; ++mt) a[mt] = *(const LAS bf16x8*)(CQ + (16 * mt + fr) * CQP + 32 * ks + 8 * fq);
#pragma unroll
              for (int n = 0; n < 3; ++n) bb[n] = *(const bf16x8*)(wq + (size_t)(16 * n) * 256 + 32 * ks);
#pragma unroll
              for (int mt = 0; mt < 4; ++mt)
#pragma unroll
                  for (int n = 0; n < 3; ++n) qa[mt][n] = __builtin_amdgcn_mfma_f32_16x16x32_bf16(a[mt], bb[n], qa[mt][n], 0, 0, 0); }
          __syncthreads();
#pragma unroll
          for (int n = 0; n < 3; ++n) { const int nt = 3 * w + n, m6 = nt % 6, col = 16 * nt + fr;
#pragma unroll
              for (int mt = 0; mt < 4; ++mt)
#pragma unroll
                  for (int i = 0; i < 4; ++i) { const int row = 16 * mt + 4 * fq + i; float v = qa[mt][n][i] * RS[row * 2];
                      if (m6 >= 4) { const float pv = __shfl_xor(v, 8); const int ci = (row * 16 + (m6 == 5 ? 8 : 0) + (fr & 7)) * 2; const float c = CS[ci], s = CS[ci + 1]; v = (fr < 8) ? v * c - pv * s : pv * s + v * c; }
                      QS[row * QSP + col] = f2bf(v * C2); } } }
        __builtin_amdgcn_sched_barrier(0);
        { f32x4 ka[4][4];
#pragma unroll
          for (int mt = 0; mt < 4; ++mt)
#pragma unroll
              for (int n = 0; n < 4; ++n) ka[mt][n] = (f32x4){0.f, 0.f, 0.f, 0.f};
          const bf16_t* wk = WUKVT + ((size_t)l * 512 + 64 * w + fr) * 128 + 8 * fq;
#pragma unroll 2
          for (int ks = 0; ks < 4; ++ks) { bf16x8 a[4], bb[4];
#pragma unroll
              for (int mt = 0; mt < 4; ++mt) a[mt] = *(const LAS bf16x8*)(CK + (16 * mt + fr) * CKP + 32 * ks + 8 * fq);
#pragma unroll
              for (int n = 0; n < 4; ++n) bb[n] = *(const bf16x8*)(wk + (size_t)(16 * n) * 128 + 32 * ks);
#pragma unroll
              for (int mt = 0; mt < 4; ++mt)
#pragma unroll
                  for (int n = 0; n < 4; ++n) ka[mt][n] = __builtin_amdgcn_mfma_f32_16x16x32_bf16(a[mt], bb[n], ka[mt][n], 0, 0, 0); }
          const int head = w >> 1;
          if ((w & 1) == 0) {
#pragma unroll
              for (int n = 0; n < 4; ++n)
#pragma unroll
                  for (int mt = 0; mt < 4; ++mt)
#pragma unroll
                      for (int i = 0; i < 4; ++i) { const int row = 16 * mt + 4 * fq + i; KS[row * KSP + head * 64 + 16 * n + fr] = f2bf(ka[mt][n][i] * RS[row * 2 + 1]); }
          } else {
#pragma unroll
              for (int n = 0; n < 4; ++n)
#pragma unroll
                  for (int mt = 0; mt < 4; ++mt) { const int rb = 16 * mt + 4 * fq; u32x2 o; o.x = pk2(ka[mt][n][0] * RS[rb * 2 + 1], ka[mt][n][1] * RS[rb * 2 + 3]); o.y = pk2(ka[mt][n][2] * RS[rb * 2 + 5], ka[mt][n][3] * RS[rb * 2 + 7]);
                      *(u32x2*)(VTG + ((size_t)(b * 4 + head) * 64 + 16 * n + fr) * NPOS + pos0 + rb) = o; } } }
        __syncthreads();
#pragma unroll
        for (int i = 0; i < 6; ++i) { const int q = tid + 512 * i, row = q / 48, rem = q % 48, head = rem / 12, ch = rem % 12, pos = pos0 + row;
            const u32x4 qv = *(const LAS u32x4*)((const LAS unsigned char*)QS + row * (QSP * 2) + (head * 96 + ch * 8) * 2);
            if (!ctxt) *(u32x4*)(QL + ((size_t)(b * 4 + head) * SEQ + (pos - CTX)) * 96 + ch * 8) = qv; else if (l == 0) *(u32x4*)(QC + ((size_t)(b * 4 + head) * CTX + pos) * 96 + ch * 8) = qv;
            u32x4 kv;
            if (ch < 8) kv = *(const LAS u32x4*)((const LAS unsigned char*)KS + row * (KSP * 2) + (head * 64 + ch * 8) * 2);
            else { const LAS float* kr = KRo + row * 32 + (ch - 8) * 8; kv.x = pk2(kr[0], kr[1]); kv.y = pk2(kr[2], kr[3]); kv.z = pk2(kr[4], kr[5]); kv.w = pk2(kr[6], kr[7]); }
            *(u32x4*)(KB + ((size_t)(b * 4 + head) * NPOS + pos) * 96 + ch * 8) = kv; }
        if (!(ctxt && l == 1)) { const int lo = ctxt ? 0 : CTX, hi = ctxt ? CTX : NPOS;
#pragma unroll
            for (int i = 0; i < 4; ++i) { const int q = tid + 512 * i, row = q >> 5, ch = q & 31, pos = pos0 + row; float acc[8];
#pragma unroll
                for (int e = 0; e < 8; ++e) acc[e] = scb[ch * 8 + e];
#pragma unroll
                for (int k = 0; k < 3; ++k) { const int p = pos - 1 + k; if (p >= lo && p < hi) { const bf16_t* pr = P + ((size_t)b * NPOS + p) * PP; const u32x4 sx = *(const u32x4*)(pr + C_SX + ch * 8), sc = *(const u32x4*)(pr + C_SC + ch * 8);
#pragma unroll
                        for (int e = 0; e < 4; ++e) { const float w0 = scw[k * 256 + ch * 8 + 2 * e], w1 = scw[k * 256 + ch * 8 + 2 * e + 1];
                            acc[2 * e] += w0 * (__uint_as_float(sx[e] << 16) * __uint_as_float(sc[e] << 16)); acc[2 * e + 1] += w1 * (__uint_as_float(sx[e] & 0xffff0000u) * __uint_as_float(sc[e] & 0xffff0000u)); } } }
                const u32x4 sb = *(const u32x4*)(P + (r0 + row) * PP + C_SB + ch * 8); u32x4 o;
#pragma unroll
                for (int e = 0; e < 4; ++e) o[e] = pk2(__uint_as_float(sb[e] << 16) * acc[2 * e], __uint_as_float(sb[e] & 0xffff0000u) * acc[2 * e + 1]);
                *(u32x4*)(MIX + (r0 + row) * D + 768 + ch * 8) = o; } }
        __syncthreads();
    }
}
}

namespace lru {
constexpr int XP = 264, O_X = 0, O_NA = 33792, O_BB = 66560;
__device__ __forceinline__ float sigm(float x) { return __builtin_amdgcn_rcpf(1.f + __expf(-x)); }
__device__ __forceinline__ void chunk_units(LAS unsigned char* lds, int l, const bf16_t* P, const float* conv_w, const float* conv_b, const bf16_t* WAT, const bf16_t* WIT, const float* b_a, const float* b_i, const float* lam,
                                            bf16_t* HL, bf16_t* AC, float* SUM, int G, int bx) {
    LAS bf16_t* X = (LAS bf16_t*)(lds + O_X); LAS bf16_t* NA = (LAS bf16_t*)(lds + O_NA); LAS bf16_t* BB = (LAS bf16_t*)(lds + O_BB);
    for (int unit = bx; unit < 544; unit += G) {
        int tid_l = threadIdx.x; asm volatile("" : "+v"(tid_l));
        const int tid = tid_l, lane = tid & 63, w = __builtin_amdgcn_readfirstlane(tid >> 6), fr = lane & 15, fq = lane >> 4;
        const int dir = unit & 1, bc = unit >> 1, b = bc / 68, chunk = bc % 68, pos0 = 64 * chunk; const int lo = chunk < 4 ? 0 : CTX, hi = chunk < 4 ? CTX : NPOS, left = dir ? 1 : 2;
        const size_t r0 = (size_t)b * NPOS + pos0; const int pd = (l * 2 + dir) * 256;
        { const int c = tid & 255, th = tid >> 8; const float cb = conv_b[pd + c]; const float w0 = conv_w[(size_t)pd * 4 + c], w1 = conv_w[(size_t)pd * 4 + 256 + c], w2 = conv_w[(size_t)pd * 4 + 512 + c], w3 = conv_w[(size_t)pd * 4 + 768 + c];
          const bf16_t* pc = P + (size_t)b * NPOS * PP + C_LX + c; const int pb = pos0 + 32 * th - left;
          float u0 = (pb >= lo && pb < hi) ? bf2f(pc[(size_t)pb * PP]) : 0.f, u1 = (pb + 1 >= lo && pb + 1 < hi) ? bf2f(pc[(size_t)(pb + 1) * PP]) : 0.f, u2 = (pb + 2 >= lo && pb + 2 < hi) ? bf2f(pc[(size_t)(pb + 2) * PP]) : 0.f;
#pragma unroll 8
          for (int i = 0; i < 32; ++i) { const int p3 = pb + 3 + i; const float u3 = (p3 >= lo && p3 < hi) ? bf2f(pc[(size_t)p3 * PP]) : 0.f;
              X[(32 * th + i) * XP + c] = f2bf(cb + w0 * u0 + w1 * u1 + w2 * u2 + w3 * u3); u0 = u1; u1 = u2; u2 = u3; } }
        __syncthreads();
        { const int h = w >> 1, mh = w & 1;
          f32x4 ra[2][4], ri[2][4];
#pragma unroll
          for (int m = 0; m < 2; ++m)
#pragma unroll
              for (int n = 0; n < 4; ++n) { ra[m][n] = (f32x4){0.f, 0.f, 0.f, 0.f}; ri[m][n] = (f32x4){0.f, 0.f, 0.f, 0.f}; }
          const bf16_t* wa = WAT + ((size_t)((l * 2 + dir) * 4 + h) * 64 + fr) * 64 + 8 * fq; const bf16_t* wi = WIT + ((size_t)((l * 2 + dir) * 4 + h) * 64 + fr) * 64 + 8 * fq;
#pragma unroll
          for (int ks = 0; ks < 2; ++ks) { bf16x8 a[2], ba[4], bi[4];
#pragma unroll
              for (int m = 0; m < 2; ++m) a[m] = *(const LAS bf16x8*)(X + (16 * (2 * mh + m) + fr) * XP + 64 * h + 32 * ks + 8 * fq);
#pragma unroll
              for (int n = 0; n < 4; ++n) { ba[n] = *(const bf16x8*)(wa + (size_t)(16 * n) * 64 + 32 * ks); bi[n] = *(const bf16x8*)(wi + (size_t)(16 * n) * 64 + 32 * ks); }
#pragma unroll
              for (int m = 0; m < 2; ++m)
#pragma unroll
                  for (int n = 0; n < 4; ++n) { ra[m][n] = __builtin_amdgcn_mfma_f32_16x16x32_bf16(a[m], ba[n], ra[m][n], 0, 0, 0); ri[m][n] = __builtin_amdgcn_mfma_f32_16x16x32_bf16(a[m], bi[n], ri[m][n], 0, 0, 0); } }
#pragma unroll
          for (int n = 0; n < 4; ++n) { const int c = 64 * h + 16 * n + fr; const float bav = b_a[pd + c], biv = b_i[pd + c], sp = log1pf(__expf(-lam[pd + c]));
#pragma unroll
              for (int m = 0; m < 2; ++m)
#pragma unroll
                  for (int i = 0; i < 4; ++i) { const int t = 16 * (2 * mh + m) + 4 * fq + i; const float r = sigm(ra[m][n][i] + bav), ig = sigm(ri[m][n][i] + biv);
                      const float na = -expm1f(-8.f * r * sp); const float xv = bf2f(X[t * XP + c]);
                      NA[t * 256 + c] = f2bf(na); BB[t * 256 + c] = f2bf(sqrtf(fmaxf(na * (2.f - na), 0.f)) * (ig * xv)); } } }
        __syncthreads();
        if (tid < 256) { const int c = tid; float hst = 0.f, A = 1.f;
            bf16_t* hl = HL + ((size_t)dir * MROWS + r0) * 256 + c; bf16_t* ac = AC + ((size_t)dir * MROWS + r0) * 256 + c;
            if (dir == 0) {
#pragma unroll 8
                for (int t = 0; t < 64; ++t) { const float a = 1.f - bf2f(NA[t * 256 + c]); hst = a * hst + bf2f(BB[t * 256 + c]); A *= a; hl[(size_t)t * 256] = f2bf(hst); ac[(size_t)t * 256] = f2bf(A); }
            } else {
#pragma unroll 8
                for (int t = 63; t >= 0; --t) { const float a = 1.f - bf2f(NA[t * 256 + c]); hst = a * hst + bf2f(BB[t * 256 + c]); A *= a; hl[(size_t)t * 256] = f2bf(hst); ac[(size_t)t * 256] = f2bf(A); }
            }
            float* sm = SUM + ((size_t)(dir * 4 + b) * 68 + chunk) * 512; sm[c] = A; sm[256 + c] = hst; }
        __syncthreads();
    }
}
__device__ __forceinline__ void fixup_units(int l, const bf16_t* P, const bf16_t* HL, const bf16_t* AC, const float* SUM, bf16_t* MIX, int G, int bx) {
    for (int unit = bx; unit < 272; unit += G) {
        int tid_l = threadIdx.x; asm volatile("" : "+v"(tid_l));
        const int tid = tid_l, c = tid & 255, th = tid >> 8;
        const int b = unit / 68, chunk = unit % 68; if (l == 1 && chunk < 4) continue;
        const float* sf = SUM + ((size_t)(0 * 4 + b) * 68) * 512 + c; const float* sb = SUM + ((size_t)(1 * 4 + b) * 68) * 512 + c;
        float cf = 0.f, cb = 0.f;
        for (int j = 0; j < chunk; ++j) cf = sf[(size_t)j * 512 + 256] + sf[(size_t)j * 512] * cf;
        if (chunk < 4) { for (int j = 3; j > chunk; --j) cb = sb[(size_t)j * 512 + 256] + sb[(size_t)j * 512] * cb; }
        else { for (int j = 3; j >= 0; --j) cb = sb[(size_t)j * 512 + 256] + sb[(size_t)j * 512] * cb; for (int j = 67; j > chunk; --j) cb = sb[(size_t)j * 512 + 256] + sb[(size_t)j * 512] * cb; }
        const size_t r0 = (size_t)b * NPOS + 64 * chunk + 32 * th;
#pragma unroll 4
        for (int i = 0; i < 32; ++i) { const size_t r = r0 + i; const float hf = bf2f(HL[r * 256 + c]) + bf2f(AC[r * 256 + c]) * cf, hb = bf2f(HL[((size_t)MROWS + r) * 256 + c]) + bf2f(AC[((size_t)MROWS + r) * 256 + c]) * cb;
            const float x = bf2f(P[r * PP + C_LG + c]); const float u = 0.7978845608028654f * (x + 0.044715f * x * x * x); const float th_ = 1.f - 2.f * __builtin_amdgcn_rcpf(1.f + __expf(2.f * u));
            MIX[r * D + 256 + c] = f2bf(0.5f * x * (1.f + th_) * (hf + hb)); }
    }
}
}

namespace fft {
__device__ __forceinline__ void ctx_a(LAS unsigned char* lds, const bf16_t* P, const float* TABC, const float* TABS, bf16_t* XCT, int G, int bx) {
    LAS bf16_t* U = (LAS bf16_t*)(lds + O_U); LAS bf16_t* X = (LAS bf16_t*)(lds + O_X);
    for (int unit = bx; unit < 16; unit += G) {
        int tid_l = threadIdx.x; asm volatile("" : "+v"(tid_l));
        const int tid = tid_l, lane = tid & 63, w = __builtin_amdgcn_readfirstlane(tid >> 6), fr = lane & 15, fq = lane >> 4;
        build_tables(lds, TABC, TABS, tid);
        const LAS bf16_t* Tc = (const LAS bf16_t*)(lds + O_TC); const LAS bf16_t* Ts = (const LAS bf16_t*)(lds + O_TS);
        const int b = unit >> 2, q = unit & 3;
#pragma unroll
        for (int i = 0; i < 4; ++i) { const int qq = tid + 512 * i, t1 = qq >> 5, ch = qq & 31;
            *(LAS u32x4*)((LAS unsigned char*)U + t1 * (UP * 2) + ch * 16) = *(const u32x4*)(P + ((size_t)b * NPOS + 64 * q + t1) * PP + ch * 8); }
        __syncthreads();
        { const int g = w >> 1, part = w & 1; const LAS bf16_t* T = part ? Ts : Tc;
          f32x4 acc[4][4];
#pragma unroll
          for (int mt = 0; mt < 4; ++mt)
#pragma unroll
              for (int nt = 0; nt < 4; ++nt) acc[mt][nt] = (f32x4){0.f, 0.f, 0.f, 0.f};
#pragma unroll
          for (int ks = 0; ks < 2; ++ks) { bf16x8 a[4], bb[4];
#pragma unroll
              for (int mt = 0; mt < 4; ++mt) a[mt] = *(const LAS bf16x8*)(U + (16 * mt + fr) * UP + g * 64 + 32 * ks + 8 * fq);
#pragma unroll
              for (int nt = 0; nt < 4; ++nt) bb[nt] = *(const LAS bf16x8*)(T + (16 * nt + fr) * TP + 32 * ks + 8 * fq);
#pragma unroll
              for (int mt = 0; mt < 4; ++mt)
#pragma unroll
                  for (int nt = 0; nt < 4; ++nt) acc[mt][nt] = __builtin_amdgcn_mfma_f32_16x16x32_bf16(a[mt], bb[nt], acc[mt][nt], 0, 0, 0); }
          const float sg = part ? -1.f : 1.f;
#pragma unroll
          for (int mt = 0; mt < 4; ++mt)
#pragma unroll
              for (int nt = 0; nt < 4; ++nt) { const f32x4 v = acc[mt][nt] * sg; u32x2 o; o.x = pk2(v[0], v[1]); o.y = pk2(v[2], v[3]);
                  *(LAS u32x2*)(X + (part * 256 + g * 64 + 16 * nt + fr) * TP + 16 * mt + 4 * fq) = o; } }
        __syncthreads();
#pragma unroll
        for (int i = 0; i < 8; ++i) { const int qq = tid + 512 * i, row = qq >> 3, c8 = qq & 7;
            *(u32x4*)(XCT + (((size_t)b * 4 + q) * 512 + row) * 64 + c8 * 8) = *(const LAS u32x4*)((const LAS unsigned char*)X + row * (TP * 2) + c8 * 16); }
        __syncthreads();
    }
}
__device__ __forceinline__ void ctx_b(LAS unsigned char* lds, const bf16_t* XCT, const float* TABC, const float* TABS, bf16_t* MIX, int G, int bx) {
    LAS bf16_t* Tc = (LAS bf16_t*)(lds + O_TC); LAS bf16_t* Ts = (LAS bf16_t*)(lds + O_TS);
    LAS bf16_t* Ys = (LAS bf16_t*)(lds + O_U); LAS bf16_t* ZT = (LAS bf16_t*)(lds + O_X);
    for (int unit = bx; unit < 16; unit += G) {
        int tid_l = threadIdx.x; asm volatile("" : "+v"(tid_l));
        const int tid = tid_l, lane = tid & 63, w = __builtin_amdgcn_readfirstlane(tid >> 6), fr = lane & 15, fq = lane >> 4;
        const int b = unit >> 2, ft = unit & 3;
        f32x4 y[4][2];
#pragma unroll
        for (int mt = 0; mt < 4; ++mt)
#pragma unroll
            for (int n = 0; n < 2; ++n) y[mt][n] = (f32x4){0.f, 0.f, 0.f, 0.f};
        for (int q = 0; q < 4; ++q) {
            for (int i = tid; i < 4096; i += 512) { const int fl = i >> 6, tl = i & 63, ix = (((64 * ft + fl) * (64 * q + tl)) & 255) * 16; Tc[fl * TP + tl] = f2bf(TABC[ix]); Ts[fl * TP + tl] = f2bf(TABS[ix]); }
#pragma unroll
            for (int i = 0; i < 8; ++i) { const int qq = tid + 512 * i, row = qq >> 3, c8 = qq & 7;
                *(LAS u32x4*)((LAS unsigned char*)ZT + row * (TP * 2) + c8 * 16) = *(const u32x4*)(XCT + (((size_t)b * 4 + q) * 512 + row) * 64 + c8 * 8); }
            __syncthreads();
#pragma unroll
            for (int ks = 0; ks < 2; ++ks) { bf16x8 xr[2], xi[2];
#pragma unroll
                for (int n = 0; n < 2; ++n) { xr[n] = *(const LAS bf16x8*)(ZT + (32 * w + 16 * n + fr) * TP + 32 * ks + 8 * fq); xi[n] = *(const LAS bf16x8*)(ZT + (256 + 32 * w + 16 * n + fr) * TP + 32 * ks + 8 * fq); }
#pragma unroll
                for (int mt = 0; mt < 4; ++mt) { const bf16x8 c = *(const LAS bf16x8*)(Tc + (16 * mt + fr) * TP + 32 * ks + 8 * fq), s = *(const LAS bf16x8*)(Ts + (16 * mt + fr) * TP + 32 * ks + 8 * fq);
#pragma unroll
                    for (int n = 0; n < 2; ++n) { y[mt][n] = __builtin_amdgcn_mfma_f32_16x16x32_bf16(c, xr[n], y[mt][n], 0, 0, 0); y[mt][n] = __builtin_amdgcn_mfma_f32_16x16x32_bf16(s, xi[n], y[mt][n], 0, 0, 0); } } }
            __syncthreads();
        }
#pragma unroll
        for (int mt = 0; mt < 4; ++mt)
#pragma unroll
            for (int i = 0; i < 4; ++i)
#pragma unroll
                for (int n = 0; n < 2; ++n) Ys[(16 * mt + 4 * fq + i) * UP + 32 * w + 16 * n + fr] = f2bf(y[mt][n][i] * (1.f / 128.f));
        __syncthreads();
#pragma unroll
        for (int i = 0; i < 4; ++i) { const int qq = tid + 512 * i, fl = qq >> 5, ch = qq & 31;
            *(u32x4*)(MIX + ((size_t)b * NPOS + 64 * ft + fl) * D + ch * 8) = *(const LAS u32x4*)((const LAS unsigned char*)Ys + fl * (UP * 2) + ch * 16); }
        __syncthreads();
    }
}
}

constexpr int NWAVES = 8, RING_BYTES = 131072 + 3072, LDSCTL_OFF = RING_BYTES, MISC_OFF = LDSCTL_OFF + 64, META_OFF = MISC_OFF + 64, LDS_BYTES = 147456;
enum { PH_PRO0 = 0, PH_PRO1 = 1, PH_L0 = 2, PH_PER_LAYER = 8, PH_N = 18 };
enum { PL_WIN = 0, PL_PREP = 1, PL_MIX = 2, PL_WOUT = 3, PL_ROUTE = 4, PL_MOE1 = 5, PL_MOE2 = 6, PL_COMB = 7 };
struct MArgs { const float* in[30]; float* out; unsigned char* ws; int ph_lo, ph_hi, dup_ph, dup_n; };

__device__ __forceinline__ void transpose_item(const float* W, int K, int N, bf16_t* WT, int drow0, LAS float* scr, int k0, int n0, int lane) {
#pragma unroll 8
    for (int i = 0; i < 32; ++i) { const int kk = 2 * i + (lane >> 5); scr[kk * 33 + (lane & 31)] = W[(size_t)(k0 + kk) * N + n0 + (lane & 31)]; }
    asm volatile("s_waitcnt lgkmcnt(0)" ::: "memory");
    const int c = lane & 7;
#pragma unroll
    for (int j = 0; j < 4; ++j) { const int n = (lane >> 3) + 8 * j; const LAS float* s = scr + (8 * c) * 33 + n;
        u32x4 o; o.x = pk2(s[0 * 33], s[1 * 33]); o.y = pk2(s[2 * 33], s[3 * 33]); o.z = pk2(s[4 * 33], s[5 * 33]); o.w = pk2(s[6 * 33], s[7 * 33]);
        *(u32x4*)(WT + (size_t)(drow0 + n) * K + k0 + 8 * c) = o; }
    asm volatile("s_waitcnt lgkmcnt(0)" ::: "memory");
}

#define ARG_IN(i) ({ const float* _p; asm volatile("s_load_dwordx2 %0, %1, %2\n\ts_waitcnt lgkmcnt(0)" : "=s"(_p) : "s"(__builtin_amdgcn_kernarg_segment_ptr()), "n"((i) * 8)); _p; })
__global__ void __launch_bounds__(NWAVES * 64, 2) mega(MArgs args) {
    extern __shared__ __attribute__((aligned(16))) unsigned char lds_raw[];
    LAS unsigned char* lds = (LAS unsigned char*)lds_raw;
    const int G = gridDim.x, bx = blockIdx.x;
    const int vcu = (G % 8 == 0) ? (bx % 8) * (G / 8) + bx / 8 : bx;
    unsigned char* ws0 = args.ws;
    unsigned* ctl0 = (unsigned*)(ws0 + L::CTL);
    for (int u = threadIdx.x; u < (LDS_BYTES - LDSCTL_OFF) / 4; u += NWAVES * 64) ((LAS unsigned*)(lds + LDSCTL_OFF))[u] = 0u;
    __syncthreads();
    volatile LAS unsigned* MISC = (volatile LAS unsigned*)(lds + MISC_OFF);
    LAS int* META = (LAS int*)(lds + META_OFF);
    XcdBarrier bar = xcd_barrier_post(ctl0 + L::CW_BAR, MISC);
    const int lo = args.ph_lo, hi = args.ph_hi;

    bool first = true;
    for (int ph = lo; ph < hi; ++ph) {
      const int reps = (ph == args.dup_ph) ? 1 + args.dup_n : 1;
      for (int rep = 0; rep < reps; ++rep) {
        if (!first) xcd_barrier(bar);
        first = false;
        unsigned char* ws = args.ws; asm volatile("" : "+s"(ws));
        unsigned* ctl = (unsigned*)(ws + L::CTL);
        int tid_p = threadIdx.x; asm volatile("" : "+v"(tid_p));
        const int tid = tid_p, lane = tid & 63, wave = __builtin_amdgcn_readfirstlane(tid >> 6); (void)lane; (void)wave;
        if (ph == PH_PRO0) {
            LAS float* scr = (LAS float*)(lds + wave * 16384);
            const int gw = vcu * NWAVES + wave, NGW = G * NWAVES;
            constexpr int I_IN = 16 * 61, I_OUT = 16 * 32, I_GU = NE * 16 * 64, I_DN = NE * 16 * 32, I_L = I_IN + I_OUT + I_GU + I_DN;
            for (int it = gw; it < 2 * I_L; it += NGW) {
                const int l = it / I_L; int r = it % I_L;
                if (r < I_IN) { const int kb = r / 61, nb = r % 61; transpose_item(ARG_IN(8) + (size_t)l * D * PT, D, PT, (bf16_t*)(ws + L::WINT) + (size_t)l * 2048 * D, 32 * nb, scr, 64 * kb, 32 * nb, lane); continue; } r -= I_IN;
                if (r < I_OUT) { const int kb = r / 32, nb = r % 32; transpose_item(ARG_IN(22) + (size_t)l * D * D, D, D, (bf16_t*)(ws + L::WOUTT) + (size_t)l * D * D, 32 * nb, scr, 64 * kb, 32 * nb, lane); continue; } r -= I_OUT;
                if (r < I_GU) { const int e = r / (16 * 64), q = r % (16 * 64), kb = q / 64, nb = q % 64; const int n0 = 32 * nb; const int c2 = n0 & 1023; const int drow = (c2 >> 7) * 256 + (n0 >> 10) * 128 + (c2 & 127);
                    transpose_item(ARG_IN(25) + ((size_t)l * NE + e) * D * 2048, D, 2048, (bf16_t*)(ws + L::WGUT) + ((size_t)l * NE + e) * 2048 * D, drow, scr, 64 * kb, n0, lane); continue; } r -= I_GU;
                { const int e = r / (16 * 32), q = r % (16 * 32), kb = q / 32, nb = q % 32;
                    transpose_item(ARG_IN(27) + ((size_t)l * NE + e) * D * D, D, D, (bf16_t*)(ws + L::WDT) + ((size_t)l * NE + e) * D * D, 32 * nb, scr, 64 * kb, 32 * nb, lane); }
            }
            sm::smallw_phase(ARG_IN(17), ARG_IN(16), ARG_IN(19), ARG_IN(18), ARG_IN(11), ARG_IN(13), (bf16_t*)(ws + L::WUQT), (bf16_t*)(ws + L::WUKVT), (bf16_t*)(ws + L::WAT), (bf16_t*)(ws + L::WIT),
                             (float*)(ws + L::TABC), (float*)(ws + L::TABS), bx * 512 + tid, G * 512);
            __syncthreads();
            sm::mod_phase(lds, ARG_IN(1), ARG_IN(3), ARG_IN(4), ARG_IN(5), (float*)(ws + L::MOD), G, bx, tid);
            for (int i = bx * 512 + tid; i < 2 * 96 * D / 8; i += G * 512) { const int l = i / (96 * D / 8), q = i % (96 * D / 8); *(u32x4*)((bf16_t*)(ws + L::WINT) + ((size_t)l * 2048 + PT) * D + (size_t)q * 8) = (u32x4){0u, 0u, 0u, 0u}; }
            continue;
        }
        if (ph == PH_PRO1) { sm::pro1_phase(ARG_IN(0), ARG_IN(2), ARG_IN(6), (const float*)(ws + L::MOD), (float*)(ws + L::H), (bf16_t*)(ws + L::XN), bx * NWAVES + wave, G * NWAVES, lane); continue; }
        if (ph < PH_L0) continue;
        const int l = (ph - PH_L0) / PH_PER_LAYER, pl = (ph - PH_L0) % PH_PER_LAYER;
        const float* MODl = (const float*)(ws + L::MOD) + (size_t)l * 5 * 6144;
        if (pl == PL_WIN) {
            g8::DenseSched S; S.init(MROWS / 256, PP / 256, G, bx, 0, (const bf16_t*)(ws + L::WINT) + (size_t)l * 2048 * D, D);
            g8::EpiP E{(bf16_t*)(ws + L::P)};
            g8::gemm_phase<g8::EpiP, g8::DenseSched, false, false>(lds, (const char*)(ws + L::XN), D, S, E);
        } else if (pl == PL_PREP) {
            fft::stage_a(lds, (const bf16_t*)(ws + L::P), (const float*)(ws + L::TABC), (const float*)(ws + L::TABS), (bf16_t*)(ws + L::ZBUF), G, bx);
            __syncthreads();
            if (l == 0) { fft::ctx_a(lds, (const bf16_t*)(ws + L::P), (const float*)(ws + L::TABC), (const float*)(ws + L::TABS), (bf16_t*)(ws + L::XCT), G, G - 1 - bx); __syncthreads(); }
            prep::qkv_units(lds, l, (const bf16_t*)(ws + L::P), (const bf16_t*)(ws + L::WUQT), (const bf16_t*)(ws + L::WUKVT), ARG_IN(20) + l * 768, ARG_IN(21) + l * 256,
                            (bf16_t*)(ws + L::QL), (bf16_t*)(ws + L::QC), (bf16_t*)(ws + L::KB), (bf16_t*)(ws + L::VTG), (bf16_t*)(ws + L::MIX), G, bx);
            __syncthreads();
            lru::chunk_units(lds, l, (const bf16_t*)(ws + L::P), ARG_IN(9), ARG_IN(10), (const bf16_t*)(ws + L::WAT), (const bf16_t*)(ws + L::WIT), ARG_IN(12), ARG_IN(14), ARG_IN(15),
                             (bf16_t*)(ws + L::HL), (bf16_t*)(ws + L::AC), (float*)(ws + L::SUM), G, bx);
        } else if (pl == PL_MIX) {
            lru::fixup_units(l, (const bf16_t*)(ws + L::P), (const bf16_t*)(ws + L::HL), (const bf16_t*)(ws + L::AC), (const float*)(ws + L::SUM), (bf16_t*)(ws + L::MIX), G, bx);
            fft::stage_b(lds, (const bf16_t*)(ws + L::ZBUF), (const float*)(ws + L::TABC), (const float*)(ws + L::TABS), (bf16_t*)(ws + L::MIX), G, bx);
            __syncthreads();
            if (l == 0) { fft::ctx_b(lds, (const bf16_t*)(ws + L::XCT), (const float*)(ws + L::TABC), (const float*)(ws + L::TABS), (bf16_t*)(ws + L::MIX), G, G - 1 - bx); __syncthreads(); }
            attn::attn_phase(lds, (const bf16_t*)(ws + L::QL), (const bf16_t*)(ws + L::QC), (const bf16_t*)(ws + L::KB), (const bf16_t*)(ws + L::VTG), (bf16_t*)(ws + L::MIX), l == 0 ? 1 : 0, G, vcu);
        } else if (pl == PL_WOUT) {
            g8::DenseSched S; S.init(l == 0 ? MROWS / 256 : 64, D / 256, G, bx, l == 0 ? 0 : 1, (const bf16_t*)(ws + L::WOUTT) + (size_t)l * D * D, D);
            g8::EpiH E{(float*)(ws + L::H), MODl, 2048};
            g8::gemm_phase<g8::EpiH, g8::DenseSched, false, false>(lds, (const char*)(ws + L::MIX), D, S, E);
        } else if (pl == PL_ROUTE) {
            sm::route_phase(lds, l, (const float*)(ws + L::H), ARG_IN(7) + l * D, MODl, ARG_IN(23) + (size_t)l * D * NE, ARG_IN(24) + l * NE, (bf16_t*)(ws + L::XN), (int*)(ctl + L::CW_CNT) + l * NE,
                            (int*)(ws + L::LIST) + (size_t)l * NE * LCAP, (float*)(ws + L::GATE), bx * NWAVES + wave, G * NWAVES, wave, lane);
        } else if (pl == PL_COMB) {
            sm::comb_phase(l, (float*)(ws + L::H), (const bf16_t*)(ws + L::Y), MODl, ARG_IN(6) + D, (const float*)(ws + L::MOD) + (size_t)5 * 6144, (bf16_t*)(ws + L::XN), ARG_IN(29), args.out, bx * NWAVES + wave, G * NWAVES, lane);
        } else if (pl == PL_MOE1 || pl == PL_MOE2) {
            const int* CNTg = (const int*)(ctl + L::CW_CNT) + l * NE;
            if (tid == 0) { int o = 0; for (int e = 0; e < NE; ++e) { const int cn = CNTg[e]; META[e] = o; META[64 + e] = cn; o += (cn + 255) >> 8; } META[NE] = o; }
            __syncthreads();
            g8::MoeSched S; S.tpre = META; S.cnt = META + 64; S.G = G; S.c = bx; S.K = D; S.list = (const int*)(ws + L::LIST) + (size_t)l * NE * LCAP;
            if (pl == PL_MOE1) {
                S.NT = 8; S.COLW = 128; S.total = __builtin_amdgcn_readfirstlane(META[NE]) * 8; S.Bt = (const char*)((const bf16_t*)(ws + L::WGUT) + (size_t)l * NE * 2048 * D);
                g8::EpiMoe1 E{(bf16_t*)(ws + L::ACT), ARG_IN(26) + (size_t)l * NE * 2048};
                g8::gemm_phase<g8::EpiMoe1, g8::MoeSched, true, true>(lds, (const char*)(ws + L::XN), D, S, E);
            } else {
                S.NT = 4; S.COLW = 256; S.total = __builtin_amdgcn_readfirstlane(META[NE]) * 4; S.Bt = (const char*)((const bf16_t*)(ws + L::WDT) + (size_t)l * NE * D * D);
                g8::EpiMoe2 E{(bf16_t*)(ws + L::Y), ARG_IN(28) + (size_t)l * NE * D, (const float*)(ws + L::GATE)};
                g8::gemm_phase<g8::EpiMoe2, g8::MoeSched, false, true>(lds, (const char*)(ws + L::ACT), D, S, E);
            }
            __syncthreads();
        }
      }
    }
}
constexpr int PROBE_DUP_PH = -1, PROBE_DUP_N = 0;
extern "C" void kernel_launch(void* const* d_in, const int* in_sizes, int n_in, void* d_out, int out_size, void* d_ws, size_t ws_size, hipStream_t stream) {
    static int grid = 0;
    if (grid == 0) {
        if (n_in != 30 || out_size != NB_ * SEQ * D || (size_t)L::END > ws_size) { fprintf(stderr, "kernel_launch: unexpected problem shape (n_in %d, out %d) or workspace too small (need %zu, have %zu); nothing launched\n", n_in, out_size, (size_t)L::END, ws_size); grid = -1; return; }
        int dev = 0, cus = 0;
        if (hipGetDevice(&dev) != hipSuccess || hipDeviceGetAttribute(&cus, hipDeviceAttributeMultiprocessorCount, dev) != hipSuccess) { fprintf(stderr, "kernel_launch: device query failed\n"); grid = -1; return; }
        if (hipFuncSetAttribute((const void*)mega, hipFuncAttributeMaxDynamicSharedMemorySize, LDS_BYTES) != hipSuccess) { fprintf(stderr, "kernel_launch: hipFuncSetAttribute failed\n"); grid = -1; return; }
        grid = cus < 256 ? cus : 256;
    }
    if (grid < 0) return;
    unsigned char* p = (unsigned char*)d_ws;
    (void)hipMemsetAsync(p + L::CTL, 0, L::CTL_BYTES, stream);
    MArgs a{};
    for (int i = 0; i < 30; ++i) a.in[i] = (const float*)d_in[i];
    a.out = (float*)d_out; a.ws = p; a.ph_lo = 0; a.ph_hi = PH_N; a.dup_ph = PROBE_DUP_PH; a.dup_n = PROBE_DUP_N;
    hipLaunchKernelGGL(mega, dim3(grid), dim3(NWAVES * 64), LDS_BYTES, stream, a);
}
```

```cpp
#include <hip/hip_runtime.h>
#include <cstdint>
#include <cstdio>

typedef unsigned short bf16_t;
constexpr int NB_ = 4, SEQ = 4096, CTX = 256, D = 1024, NPOS = SEQ + CTX, MROWS = NB_ * NPOS;
constexpr int PT = 1952, PP = 2048;
constexpr int NE = 32, TOPK = 4, LCAP = MROWS;
constexpr int NASG = MROWS * TOPK;
constexpr int ACT_ROWS = NASG + NE * 256;
constexpr int C_FN = 0, C_LX = 256, C_LG = 512, C_CQ = 768, C_CKV = 1024, C_KR = 1152, C_SX = 1184, C_SB = 1440, C_SC = 1696;

__device__ __forceinline__ float bf2f(bf16_t v) { return __uint_as_float((unsigned)v << 16); }
__device__ __forceinline__ bf16_t f2bf(float f) { unsigned u = __float_as_uint(f); return (bf16_t)((u + 0x7fffu + ((u >> 16) & 1u)) >> 16); }
__device__ __forceinline__ float wave_sum(float v) {
#pragma unroll
    for (int o = 1; o < 64; o <<= 1) v += __shfl_xor(v, o);
    return v;
}
__device__ __forceinline__ float sigmoidf_(float x) { return 1.f / (1.f + __expf(-x)); }
__device__ __forceinline__ float gelu_tanh(float x) { const float u = 0.7978845608028654f * (x + 0.044715f * x * x * x); return 0.5f * x * (1.f + tanhf(u)); }

#define LAS __attribute__((address_space(3)))
typedef short bf16x8 __attribute__((ext_vector_type(8)));
typedef float f32x4 __attribute__((ext_vector_type(4)));
typedef unsigned u32x4 __attribute__((ext_vector_type(4)));
typedef unsigned u32x2 __attribute__((ext_vector_type(2)));
__device__ __forceinline__ unsigned pk2(float lo, float hi) { return (unsigned)f2bf(lo) | ((unsigned)f2bf(hi) << 16); }

namespace L {
constexpr size_t A256(size_t x) { return (x + 255) & ~(size_t)255; }
constexpr size_t CTL = 0, CTL_BYTES = 1u << 20;
constexpr size_t H = CTL + CTL_BYTES;
constexpr size_t MOD = CTL + 512 * 1024;
constexpr size_t TABC = A256(H + (size_t)MROWS * D * 4);
constexpr size_t TABS = A256(TABC + 4096 * 4);
constexpr size_t XN = A256(TABS + 4096 * 4);
constexpr size_t P = A256(XN + (size_t)MROWS * D * 2);
constexpr size_t MIX = A256(P + (size_t)MROWS * PP * 2);
constexpr size_t CQN = A256(MIX + (size_t)MROWS * D * 2);
constexpr size_t CKVN = A256(CQN + (size_t)MROWS * 256 * 2);
constexpr size_t QRAW = A256(CKVN + (size_t)MROWS * 128 * 2);
constexpr size_t KVRAW = A256(QRAW + (size_t)MROWS * 384 * 4);
constexpr size_t QL = A256(KVRAW + (size_t)MROWS * 512 * 4);
constexpr size_t QC = A256(QL + (size_t)16 * SEQ * 96 * 2);
constexpr size_t KB = A256(QC + (size_t)16 * CTX * 96 * 2);
constexpr size_t VB = A256(KB + (size_t)16 * NPOS * 96 * 2);
constexpr size_t LA = A256(VB + (size_t)16 * NPOS * 64 * 2);
constexpr size_t LB = A256(LA + (size_t)2 * MROWS * 256 * 4);
constexpr size_t HS = A256(LB + (size_t)2 * MROWS * 256 * 4);
constexpr size_t XCS = A256(HS + (size_t)2 * MROWS * 256 * 4);
constexpr size_t XCSC = A256(XCS + (size_t)4 * 8192 * 256 * 4);
constexpr size_t LIST = A256(XCSC + (size_t)4 * 512 * 256 * 4);
constexpr size_t GATE = A256(LIST + (size_t)2 * NE * LCAP * 4);
constexpr size_t ACT = A256(GATE + (size_t)NASG * 4);
constexpr size_t Y = A256(ACT + (size_t)ACT_ROWS * D * 2);
constexpr size_t WINT = A256(Y + (size_t)NASG * D * 2);
constexpr size_t WOUTT = A256(WINT + (size_t)2 * 2048 * 1024 * 2);
constexpr size_t WGUT = A256(WOUTT + (size_t)2 * 1024 * 1024 * 2);
constexpr size_t WDT = A256(WGUT + (size_t)2 * NE * 2048 * 1024 * 2);
constexpr size_t ZBUF = A256(WDT + (size_t)2 * NE * 1024 * 1024 * 2);
constexpr size_t VTG = A256(ZBUF + (size_t)4 * 64 * 64 * 512 * 2);
constexpr size_t WUQT = A256(VTG + (size_t)16 * 64 * NPOS * 2);
constexpr size_t WUKVT = A256(WUQT + (size_t)2 * 384 * 256 * 2);
constexpr size_t WAT = A256(WUKVT + (size_t)2 * 512 * 128 * 2);
constexpr size_t WIT = A256(WAT + (size_t)16 * 4096 * 2);
constexpr size_t HL = A256(WIT + (size_t)16 * 4096 * 2);
constexpr size_t AC = A256(HL + (size_t)2 * MROWS * 256 * 2);
constexpr size_t SUM = A256(AC + (size_t)2 * MROWS * 256 * 2);
constexpr size_t XCT = A256(SUM + (size_t)2 * 4 * 68 * 512 * 4);
constexpr size_t END = A256(XCT + (size_t)16 * 512 * 64 * 2);
constexpr int CW_BAR = 4096;
constexpr int CW_CNT = 32768, CNT_STRIDE = 64;
}

#define XB_TMO      128
#define XB_XCNT(j)  (256  + 64 * (j))
#define XB_XSUB(j)  (1280 + 64 * (j))
#define XB_XGEN(j)  (2304 + 64 * (j))
#define XB_TOP      3328
#define XB_TOPGEN   3392
#define XCD_BAR_WORDS 3456
#define XB_SPIN_CAP (1u << 18)
__device__ __forceinline__ unsigned xb_ld(unsigned* p)              { return __hip_atomic_load(p, __ATOMIC_RELAXED, __HIP_MEMORY_SCOPE_AGENT); }
__device__ __forceinline__ unsigned xb_add(unsigned* p, unsigned v) { return __hip_atomic_fetch_add(p, v, __ATOMIC_RELAXED, __HIP_MEMORY_SCOPE_AGENT); }
__device__ __forceinline__ unsigned xb_xcc_id() { return (unsigned)__builtin_amdgcn_s_getreg((3 << 11) | 20) & 0xFu; }
#define XB_SPIN(cond, bar) do { unsigned _sp = 0; while (cond) { __builtin_amdgcn_s_sleep(1); \
    if ((++_sp & 255u) == 0u) { if (xb_ld(&(bar)[XB_TMO])) break; if (_sp > XB_SPIN_CAP) { atomicAdd(&(bar)[XB_TMO], 1u); break; } } } } while (0)
struct XcdBarrier { unsigned* bar; unsigned x; volatile LAS unsigned* st; };
__device__ __forceinline__ XcdBarrier xcd_barrier_post(unsigned* bar, volatile LAS unsigned* st) {
    XcdBarrier b; b.bar = bar; b.x = xb_xcc_id(); b.st = st;
    if (threadIdx.x == 0) (void)xb_add(&bar[XB_XCNT(b.x)], 1u);
    return b;
}
__device__ __forceinline__ void xcd_barrier_complete(unsigned* bar, unsigned x, unsigned& nloc, unsigned& nx) {
    const unsigned G = gridDim.x * gridDim.y * gridDim.z;
    unsigned sum, cnt, mine, sp = 0u;
    for (;;) {
        sum = 0u; cnt = 0u; mine = 0u;
#pragma unroll
        for (unsigned j = 0; j < 16; ++j) { const unsigned c = xb_ld(&bar[XB_XCNT(j)]); sum += c; cnt += (c > 0u) ? 1u : 0u; mine = (j == x) ? c : mine; }
        if (sum == G) break;
        __builtin_amdgcn_s_sleep(1);
        if ((++sp & 255u) == 0u) { if (xb_ld(&bar[XB_TMO])) break; if (sp > XB_SPIN_CAP) { atomicAdd(&bar[XB_TMO], 1u); break; } }
    }
    nloc = mine > 0u ? mine : 1u; nx = cnt > 0u ? cnt : 1u;
}
__device__ __forceinline__ void xcd_barrier(const XcdBarrier& b) {
    asm volatile("s_waitcnt vmcnt(0)" ::: "memory");
    __syncthreads();
    if (threadIdx.x == 0) {
        unsigned* bar = b.bar;
        __builtin_amdgcn_s_waitcnt(0);
        unsigned nloc = b.st[0], nx = b.st[1];
        if (nloc == 0u) { xcd_barrier_complete(bar, b.x, nloc, nx); b.st[0] = nloc; b.st[1] = nx; }
        const unsigned old = xb_add(&bar[XB_XSUB(b.x)], 1u);
        const unsigned gen = old / nloc;
        if (old + 1u == (gen + 1u) * nloc) {
            __builtin_amdgcn_fence(__ATOMIC_RELEASE, "agent");
            asm volatile("s_waitcnt vmcnt(0)" ::: "memory");
            const unsigned og = xb_add(&bar[XB_TOP], 1u);
            const unsigned tg = og / nx;
            if (og + 1u == (tg + 1u) * nx) xb_add(&bar[XB_TOPGEN], 1u);
            else XB_SPIN(xb_ld(&bar[XB_TOPGEN]) == tg, bar);
            __builtin_amdgcn_fence(__ATOMIC_ACQUIRE, "agent");
            xb_add(&bar[XB_XGEN(b.x)], 1u);
            asm volatile("s_waitcnt vmcnt(0)" ::: "memory");
        } else {
            XB_SPIN(xb_ld(&bar[XB_XGEN(b.x)]) == gen, bar);
            __builtin_amdgcn_fence(__ATOMIC_ACQUIRE, "agent");
            asm volatile("s_waitcnt vmcnt(0)" ::: "memory");
        }
    }
    __syncthreads();
}

namespace g8 {
constexpr int BM = 256, BK = 64, HALF = 128, HTB = HALF * BK * 2, STAGE_BYTES = 8 * HTB, NXCD = 8, WGM = 8;
__device__ __forceinline__ int lds_byte(int r, int c) { const int st = (r >> 4) * 2 + (c >> 5), rr = r & 15, cc = c & 31, ob = rr * 64 + cc * 2; return st * 1024 + (ob ^ (((ob >> 9) & 1) << 5)); }
__device__ __forceinline__ void stage_rc(int b, int& R, int& C) { const int st = b / 1024, sb = b % 1024, swz = sb ^ (((sb >> 9) & 1) << 5); R = (st >> 1) * 16 + swz / 64; C = (st & 1) * 32 + (swz % 64) / 2; }
__device__ __forceinline__ int perm32(int rho) { const int n = rho >> 4, i = rho & 15; return 8 * (i >> 2) + 4 * n + (i & 3); }
__device__ __forceinline__ unsigned cvt_pk_bf16(float lo, float hi) { unsigned r; asm volatile("v_cvt_pk_bf16_f32 %0, %1, %2" : "=v"(r) : "v"(lo), "v"(hi)); return r; }
__device__ __forceinline__ int xcd_remap(int wgid, int nwg) { const int q = nwg / NXCD, r = nwg % NXCD, xcd = wgid % NXCD, off = wgid / NXCD; return (xcd < r ? xcd * (q + 1) : r * (q + 1) + (xcd - r) * q) + off; }

struct Unit { int row0, col0, ex, bt, nvalid, lrow; };

struct DenseSched {
    int nM, nN, nwg, G, c, lat_only; const char* Bt; int K; const int* list;
    __device__ __forceinline__ void init(int nM_, int nN_, int G_, int c_, int lat_only_, const void* Bt_, int K_) { nM = nM_; nN = nN_; nwg = nM * nN; G = G_; c = c_; lat_only = lat_only_; Bt = (const char*)Bt_; K = K_; list = nullptr; }
    __device__ __forceinline__ bool next(int i, Unit& u) const {
        const long Lx = (long)i * G + c; if (Lx >= nwg) return false;
        const int wgid = xcd_remap((int)Lx, nwg);
        const int nig = WGM * nN, gid = wgid / nig, fm = gid * WGM, gsz = (nM - fm) < WGM ? (nM - fm) : WGM;
        const int pm = fm + ((wgid % nig) % gsz), pn = (wgid % nig) / gsz;
        const int tile = lat_only ? (pm / 16) * 17 + 1 + (pm % 16) : pm;
        u.row0 = tile * 256; u.col0 = pn * 256; u.ex = 0; u.bt = pn; u.nvalid = 256; u.lrow = 0; return true;
    }
    __device__ __forceinline__ const char* bptr(const Unit& u) const { return Bt + (size_t)u.bt * (256 * 1024 * 2); }
};
struct MoeSched {
    const LAS int* tpre; const LAS int* cnt; int NT, COLW, G, c, total; const char* Bt; int K; const int* list;
    __device__ __forceinline__ bool next(int i, Unit& u) const {
        const long Lx = (long)i * G + c; if (Lx >= total) return false;
        const int wgid = xcd_remap((int)Lx, total);
        int e = 0;
        for (int j = 1; j < NE; ++j) if (tpre[j] * NT <= wgid) e = j;
        const int t0 = tpre[e], mte = tpre[e + 1] - t0, loc = wgid - t0 * NT, nt = loc / mte, mt = loc % mte;
        u.ex = __builtin_amdgcn_readfirstlane(e); u.row0 = __builtin_amdgcn_readfirstlane((t0 + mt) * 256); u.col0 = __builtin_amdgcn_readfirstlane(nt * COLW);
        u.bt = __builtin_amdgcn_readfirstlane(e * NT + nt); const int nv = cnt[e] - mt * 256; u.nvalid = __builtin_amdgcn_readfirstlane(nv < 256 ? nv : 256); u.lrow = __builtin_amdgcn_readfirstlane(mt * 256);
        return true;
    }
    __device__ __forceinline__ const char* bptr(const Unit& u) const { return Bt + (size_t)u.bt * (256 * 1024 * 2); }
};

struct EpiP {
    static constexpr bool PERM = true; bf16_t* O;
    __device__ __forceinline__ void operator()(const f32x4 (&acc)[2][2][4][2], const Unit& u, int wr, int wc, int fr, int fq, const LAS int*) const {
#pragma unroll
        for (int ai = 0; ai < 2; ++ai)
#pragma unroll
            for (int m = 0; m < 4; ++m) { bf16_t* rowp = O + (size_t)(u.row0 + ai * HALF + wr * 64 + m * 16 + fr) * PP + u.col0 + wc * 32 + 8 * fq;
#pragma unroll
                for (int bj = 0; bj < 2; ++bj) { const f32x4 v0 = acc[ai][bj][m][0], v1 = acc[ai][bj][m][1]; u32x4 w; w.x = cvt_pk_bf16(v0[0], v0[1]); w.y = cvt_pk_bf16(v0[2], v0[3]); w.z = cvt_pk_bf16(v1[0], v1[1]); w.w = cvt_pk_bf16(v1[2], v1[3]);
                    *(u32x4*)(rowp + bj * HALF) = w; } }
    }
};
struct EpiH {
    static constexpr bool PERM = false; float* Hh; const float* MODl; int g_off;
    __device__ __forceinline__ void operator()(const f32x4 (&acc)[2][2][4][2], const Unit& u, int wr, int wc, int fr, int fq, const LAS int*) const {
        const int tile = u.row0 >> 8, v = (tile % 17 == 0) ? 4 : tile / 17; const float* gp = MODl + (size_t)v * 6144 + g_off + u.col0 + wc * 32 + 4 * fq;
        f32x4 gv[2][2];
#pragma unroll
        for (int bj = 0; bj < 2; ++bj)
#pragma unroll
            for (int n = 0; n < 2; ++n) gv[bj][n] = *(const f32x4*)(gp + bj * HALF + n * 16);
#pragma unroll
        for (int ai = 0; ai < 2; ++ai)
#pragma unroll
            for (int m = 0; m < 4; ++m) { float* rowp = Hh + (size_t)(u.row0 + ai * HALF + wr * 64 + m * 16 + fr) * D + u.col0 + wc * 32 + 4 * fq;
#pragma unroll
                for (int bj = 0; bj < 2; ++bj)
#pragma unroll
                    for (int n = 0; n < 2; ++n) { f32x4* p = (f32x4*)(rowp + bj * HALF + n * 16); *p = *p + gv[bj][n] * acc[ai][bj][m][n]; } }
    }
};
struct EpiMoe1 {
    static constexpr bool PERM = true; bf16_t* ACTp; const float* bgu;
    __device__ __forceinline__ void operator()(const f32x4 (&acc)[2][2][4][2], const Unit& u, int wr, int wc, int fr, int fq, const LAS int*) const {
        const int cc = u.col0 + wc * 32 + 8 * fq; const float* bp = bgu + (size_t)u.ex * 2048 + cc;
        f32x4 bg[2], bu[2];
#pragma unroll
        for (int n = 0; n < 2; ++n) { bg[n] = *(const f32x4*)(bp + 4 * n); bu[n] = *(const f32x4*)(bp + 1024 + 4 * n); }
#pragma unroll
        for (int ai = 0; ai < 2; ++ai)
#pragma unroll
            for (int m = 0; m < 4; ++m) { const int r = ai * HALF + wr * 64 + m * 16 + fr;
                float o[8];
#pragma unroll
                for (int n = 0; n < 2; ++n)
#pragma unroll
                    for (int i = 0; i < 4; ++i) { const float g = fminf(acc[ai][0][m][n][i] + bg[n][i], 7.f); const float uu = fminf(fmaxf(acc[ai][1][m][n][i] + bu[n][i], -7.f), 7.f);
                        o[n * 4 + i] = (uu + 1.f) * g * __builtin_amdgcn_rcpf(1.f + __expf(-1.702f * g)); }
                if (r < u.nvalid) { u32x4 w; w.x = cvt_pk_bf16(o[0], o[1]); w.y = cvt_pk_bf16(o[2], o[3]); w.z = cvt_pk_bf16(o[4], o[5]); w.w = cvt_pk_bf16(o[6], o[7]);
                    *(u32x4*)(ACTp + (size_t)(u.row0 + r) * D + cc) = w; } }
    }
};
struct EpiMoe2 {
    static constexpr bool PERM = true; bf16_t* Yp; const float* bd; const float* GATEp;
    __device__ __forceinline__ void operator()(const f32x4 (&acc)[2][2][4][2], const Unit& u, int wr, int wc, int fr, int fq, const LAS int* rows) const {
        const int cc = u.col0 + wc * 32 + 8 * fq; const float* bp = bd + (size_t)u.ex * 1024 + cc;
        f32x4 bv[2][2];
#pragma unroll
        for (int bj = 0; bj < 2; ++bj)
#pragma unroll
            for (int n = 0; n < 2; ++n) bv[bj][n] = *(const f32x4*)(bp + bj * HALF + 4 * n);
#pragma unroll
        for (int ai = 0; ai < 2; ++ai)
#pragma unroll
            for (int m = 0; m < 4; ++m) { const int r = ai * HALF + wr * 64 + m * 16 + fr;
                if (r < u.nvalid) { const int asg = rows[r]; const float gt = GATEp[asg]; bf16_t* rowp = Yp + (size_t)asg * D + cc;
#pragma unroll
                    for (int bj = 0; bj < 2; ++bj) { const f32x4 v0 = (acc[ai][bj][m][0] + bv[bj][0]) * gt, v1 = (acc[ai][bj][m][1] + bv[bj][1]) * gt;
                        u32x4 w; w.x = cvt_pk_bf16(v0[0], v0[1]); w.y = cvt_pk_bf16(v0[2], v0[3]); w.z = cvt_pk_bf16(v1[0], v1[1]); w.w = cvt_pk_bf16(v1[2], v1[3]); *(u32x4*)(rowp + bj * HALF) = w; } } }
    }
};

template <class Epi, class Sched, bool GATHER, bool ROWLIST>
__device__ __forceinline__ void gemm_phase(LAS unsigned char* lds, const char* Abase, const Sched& S, const Epi& E) {
    constexpr int K = 1024;
    int tid_l = threadIdx.x; asm volatile("" : "+v"(tid_l));
    const int tid = tid_l, wid = __builtin_amdgcn_readfirstlane(tid >> 6), lane = tid & 63, wr = wid >> 2, wc = wid & 3, fr = lane & 15, fq = lane >> 4;
    constexpr int nt = K / BK; constexpr unsigned Kb = (unsigned)K * 2u;
    unsigned voffB[2];
#pragma unroll
    for (int i = 0; i < 2; ++i) { int R, C; stage_rc(tid * 16 + i * 8192, R, C); const int Rb = Epi::PERM ? ((R & ~31) + perm32(R & 31)) : R; voffB[i] = (unsigned)(Rb * K + C) * 2u; }
    constexpr size_t kstep = (size_t)(BK * 2), hstep = (size_t)HALF * K * 2;
    const unsigned ldsw = (unsigned)wid * 1024u;
    const int aoff = lds_byte(wr * 64 + fr, fq * 8), boff = lds_byte(wc * 32 + fr, fq * 8);
    LAS int* rowbuf = (LAS int*)(lds + STAGE_BYTES);
#define G8_SA(b, h) (((b) * 2 + (h)) * HTB)
#define G8_SB(b, h) ((4 + (b) * 2 + (h)) * HTB)
#define G8_STAGE_A(bufoff, kb, v) do { _Pragma("unroll") for (int _i = 0; _i < 2; ++_i) \
        __builtin_amdgcn_global_load_lds((const unsigned*)((kb) + (size_t)(v)[_i]), (LAS unsigned*)(lds + (bufoff) + ldsw + _i * 8192), 16, 0, 0); } while (0)
#define G8_STAGE_B(bufoff, gbase) do { _Pragma("unroll") for (int _i = 0; _i < 2; ++_i) \
        __builtin_amdgcn_global_load_lds((const unsigned*)((gbase) + voffB[_i]), (LAS unsigned*)(lds + (bufoff) + ldsw + _i * 8192), 16, 0, 0); } while (0)
#define G8_LDA(dst, b, h) do { _Pragma("unroll") for (int m = 0; m < 4; ++m) _Pragma("unroll") for (int k = 0; k < 2; ++k) dst[m][k] = *(const LAS bf16x8*)(lds + G8_SA(b, h) + aoff + m * 2048 + k * 1024); } while (0)
#define G8_LDB(dst, b, h) do { _Pragma("unroll") for (int n = 0; n < 2; ++n) _Pragma("unroll") for (int k = 0; k < 2; ++k) dst[n][k] = *(const LAS bf16x8*)(lds + G8_SB(b, h) + boff + n * 2048 + k * 1024); } while (0)
#define G8_MMA(ai, bj, At, Bt) do { __builtin_amdgcn_s_setprio(1); _Pragma("unroll") for (int m = 0; m < 4; ++m) _Pragma("unroll") for (int n = 0; n < 2; ++n) _Pragma("unroll") for (int k = 0; k < 2; ++k) \
        acc[ai][bj][m][n] = __builtin_amdgcn_mfma_f32_16x16x32_bf16(Bt[n][k], At[m][k], acc[ai][bj][m][n], 0, 0, 0); __builtin_amdgcn_s_setprio(0); } while (0)
#define G8_WAIT_V(n) asm volatile("s_waitcnt vmcnt(" #n ")" ::: "memory")
#define G8_WAIT_L(n) asm volatile("s_waitcnt lgkmcnt(" #n ")" ::: "memory")
#define G8_BAR __builtin_amdgcn_s_barrier()
#define G8_SCHED __builtin_amdgcn_sched_barrier(0)
#define G8_LISTDMA(u, s) do { if (wid < 4) __builtin_amdgcn_global_load_lds((const unsigned*)(S.list + (size_t)(u).ex * LCAP + (u).lrow + wid * 64 + lane), (LAS unsigned*)(rowbuf + (s) * 256 + wid * 64), 4, 0, 0); } while (0)
#define G8_ROWS_DENSE(v) do { _Pragma("unroll") for (int _i = 0; _i < 2; ++_i) { int _R, _C; stage_rc(tid * 16 + _i * 8192, _R, _C); _Pragma("unroll") for (int _h = 0; _h < 2; ++_h) (v)[_h][_i] = (unsigned)(_h * HALF + _R) * Kb + (unsigned)_C * 2u; } } while (0)
#define G8_ROWS_LIST(v, u, s) do { _Pragma("unroll") for (int _i = 0; _i < 2; ++_i) { int _R, _C; stage_rc(tid * 16 + _i * 8192, _R, _C); _Pragma("unroll") for (int _h = 0; _h < 2; ++_h) { const int _r = _h * HALF + _R; const int _a = rowbuf[(s) * 256 + _r]; \
        (v)[_h][_i] = (unsigned)(_r < (u).nvalid ? (_a >> 2) : 0) * Kb + (unsigned)_C * 2u; } } } while (0)
    Unit cur, nxt; int ui = 0, slot = 0;
    if (!S.next(0, cur)) return;
    unsigned vA[2][2];
    if constexpr (ROWLIST) { G8_LISTDMA(cur, 0); G8_WAIT_V(0); G8_BAR; }
    if constexpr (GATHER) { G8_ROWS_LIST(vA, cur, 0); } else { G8_ROWS_DENSE(vA); }
    f32x4 acc[2][2][4][2];
#pragma unroll
    for (int a = 0; a < 2; ++a)
#pragma unroll
        for (int b = 0; b < 2; ++b)
#pragma unroll
            for (int m = 0; m < 4; ++m)
#pragma unroll
                for (int n = 0; n < 2; ++n) acc[a][b][m][n] = (f32x4){0.f, 0.f, 0.f, 0.f};
    bf16x8 At[4][2], B0[2][2], B1[2][2];
    const char* cB = S.bptr(cur);
    const char* cA = GATHER ? Abase : Abase + (size_t)cur.row0 * Kb;
    G8_STAGE_B(G8_SB(0, 0), cB); G8_STAGE_B(G8_SB(0, 1), cB + hstep); G8_STAGE_A(G8_SA(0, 0), cA, vA[0]); G8_STAGE_A(G8_SA(0, 1), cA, vA[1]);
    if (wr == 1) G8_BAR;
    G8_WAIT_V(2); G8_BAR;
    G8_STAGE_B(G8_SB(1, 0), cB + kstep); G8_STAGE_A(G8_SA(1, 0), cA + kstep, vA[0]); G8_STAGE_B(G8_SB(1, 1), cB + hstep + kstep);
    G8_WAIT_V(6); G8_BAR;
    for (;;) {
        const bool has_next = S.next(ui + 1, nxt);
        const char* nB = has_next ? S.bptr(nxt) : cB;
        const char* nA = (GATHER || !has_next) ? cA : Abase + (size_t)nxt.row0 * Kb;
        const int nslot = slot == 2 ? 0 : slot + 1;
        if constexpr (ROWLIST) { if (has_next) G8_LISTDMA(nxt, nslot); }
        for (int t = 0; t < nt; t += 2) {
            const bool last = (t == nt - 2);
            const char* a1 = cA + (size_t)(t + 1) * kstep;
            const char* a2 = last ? nA : cA + (size_t)(t + 2) * kstep; const char* b2 = last ? nB : cB + (size_t)(t + 2) * kstep;
            const char* a3 = a2 + kstep; const char* b3 = b2 + kstep;
            G8_LDB(B0, 0, 0); G8_LDB(B1, 0, 1); G8_SCHED; G8_LDA(At, 0, 0); G8_STAGE_A(G8_SA(1, 1), a1, vA[1]);
            if constexpr (GATHER) { if (last && has_next) { G8_ROWS_LIST(vA, nxt, nslot); } }
            G8_WAIT_V(8); G8_WAIT_L(0); G8_BAR; G8_MMA(0, 0, At, B0); G8_MMA(0, 1, At, B1); G8_BAR; G8_SCHED;
            G8_LDA(At, 0, 1); G8_STAGE_B(G8_SB(0, 0), b2); G8_STAGE_B(G8_SB(0, 1), b2 + hstep); G8_STAGE_A(G8_SA(0, 0), a2, vA[0]);
            G8_WAIT_V(8); G8_WAIT_L(0); G8_BAR; G8_MMA(1, 0, At, B0); G8_MMA(1, 1, At, B1); G8_BAR; G8_SCHED;
            G8_LDB(B0, 1, 0); G8_LDB(B1, 1, 1); G8_SCHED; G8_LDA(At, 1, 0); G8_STAGE_A(G8_SA(0, 1), a2, vA[1]);
            G8_WAIT_V(8); G8_WAIT_L(0); G8_BAR; G8_MMA(0, 0, At, B0); G8_MMA(0, 1, At, B1); G8_BAR; G8_SCHED;
            G8_LDA(At, 1, 1); G8_STAGE_B(G8_SB(1, 0), b3); G8_STAGE_B(G8_SB(1, 1), b3 + hstep); G8_STAGE_A(G8_SA(1, 0), a3, vA[0]);
            G8_WAIT_V(8); G8_WAIT_L(0); G8_BAR; G8_MMA(1, 0, At, B0); G8_MMA(1, 1, At, B1); G8_BAR; G8_SCHED;
        }
        if (wr == 0) G8_BAR;
        { int t2 = threadIdx.x; asm volatile("" : "+v"(t2));
          const int w2 = __builtin_amdgcn_readfirstlane(t2 >> 6); E(acc, cur, w2 >> 2, w2 & 3, t2 & 15, (t2 & 63) >> 4, rowbuf + slot * 256); }
        if (!has_next) break;
#pragma unroll
        for (int a = 0; a < 2; ++a)
#pragma unroll
            for (int b = 0; b < 2; ++b)
#pragma unroll
                for (int m = 0; m < 4; ++m)
#pragma unroll
                    for (int n = 0; n < 2; ++n) acc[a][b][m][n] = (f32x4){0.f, 0.f, 0.f, 0.f};
        cur = nxt; cB = nB; cA = nA; ++ui; slot = nslot;
        if (wr == 1) G8_BAR;
    }
    G8_WAIT_V(0);
    G8_BAR;
#undef G8_SA
#undef G8_SB
#undef G8_STAGE_A
#undef G8_STAGE_B
#undef G8_LDA
#undef G8_LDB
#undef G8_MMA
#undef G8_WAIT_V
#undef G8_WAIT_L
#undef G8_BAR
#undef G8_SCHED
#undef G8_LISTDMA
#undef G8_ROWS_DENSE
#undef G8_ROWS_LIST
}
}

namespace fft {
constexpr int TP = 72;
constexpr int UP = 264;
constexpr int ZP = 520;
constexpr int O_TC = 0, O_TS = 9216, O_U = 18432, O_X = 52224, O_TW = 125952;
__device__ __forceinline__ bf16x8 neg8(bf16x8 v) { u32x4 w = __builtin_bit_cast(u32x4, v); w = w ^ 0x80008000u; return __builtin_bit_cast(bf16x8, w); }
__device__ __forceinline__ void build_tables(LAS unsigned char* lds, const float* TABC, const float* TABS, int tid) {
    for (int i = tid; i < 4096; i += 512) { const int a = i >> 6, b = i & 63, ix = ((a * b) & 63) * 64;
        ((LAS bf16_t*)(lds + O_TC))[a * TP + b] = f2bf(TABC[ix]); ((LAS bf16_t*)(lds + O_TS))[a * TP + b] = f2bf(TABS[ix]); }
}
__device__ __forceinline__ void stage_a(LAS unsigned char* lds, const bf16_t* P, const float* TABC, const float* TABS, bf16_t* ZBUF, int G, int bx) {
    int tid_l = threadIdx.x; asm volatile("" : "+v"(tid_l));
    const int tid = tid_l, lane = tid & 63, w = __builtin_amdgcn_readfirstlane(tid >> 6), fr = lane & 15, fq = lane >> 4;
    build_tables(lds, TABC, TABS, tid);
    const LAS bf16_t* Tc = (const LAS bf16_t*)(lds + O_TC); const LAS bf16_t* Ts = (const LAS bf16_t*)(lds + O_TS);
    LAS bf16_t* U = (LAS bf16_t*)(lds + O_U); LAS bf16_t* X = (LAS bf16_t*)(lds + O_X); LAS float* TW = (LAS float*)(lds + O_TW);
    for (int unit = bx; unit < 256; unit += G) {
        const int b = unit >> 6, t2 = unit & 63;
#pragma unroll
        for (int i = 0; i < 4; ++i) { const int q = tid + 512 * i, t1 = q >> 5, ch = q & 31;
            *(LAS u32x4*)((LAS unsigned char*)U + t1 * (UP * 2) + ch * 16) = *(const u32x4*)(P + ((size_t)b * NPOS + CTX + 64 * t1 + t2) * PP + ch * 8); }
        if (tid < 64) { const int ix = tid * t2; TW[2 * tid] = TABC[ix]; TW[2 * tid + 1] = TABS[ix]; }
        __syncthreads();
        { const int g = w >> 1, part = w & 1; const LAS bf16_t* T = part ? Ts : Tc;
          f32x4 acc[4][4];
#pragma unroll
          for (int mt = 0; mt < 4; ++mt)
#pragma unroll
              for (int nt = 0; nt < 4; ++nt) acc[mt][nt] = (f32x4){0.f, 0.f, 0.f, 0.f};
#pragma unroll
          for (int ks = 0; ks < 2; ++ks) { bf16x8 a[4], bb[4];
#pragma unroll
              for (int mt = 0; mt < 4; ++mt) a[mt] = *(const LAS bf16x8*)(U + (16 * mt + fr) * UP + g * 64 + 32 * ks + 8 * fq);
#pragma unroll
              for (int nt = 0; nt < 4; ++nt) bb[nt] = *(const LAS bf16x8*)(T + (16 * nt + fr) * TP + 32 * ks + 8 * fq);
#pragma unroll
              for (int mt = 0; mt < 4; ++mt)
#pragma unroll
                  for (int nt = 0; nt < 4; ++nt) acc[mt][nt] = __builtin_amdgcn_mfma_f32_16x16x32_bf16(a[mt], bb[nt], acc[mt][nt], 0, 0, 0); }
          const float sg = part ? -1.f : 1.f;
#pragma unroll
          for (int mt = 0; mt < 4; ++mt)
#pragma unroll
              for (int nt = 0; nt < 4; ++nt) { const f32x4 v = acc[mt][nt] * sg; u32x2 o; o.x = pk2(v[0], v[1]); o.y = pk2(v[2], v[3]);
                  *(LAS u32x2*)(X + (part * 256 + g * 64 + 16 * nt + fr) * TP + 16 * mt + 4 * fq) = o; } }
        __syncthreads();
        f32x4 zr[4][2], zi[4][2];
#pragma unroll
        for (int mt = 0; mt < 4; ++mt)
#pragma unroll
            for (int n = 0; n < 2; ++n) { zr[mt][n] = (f32x4){0.f, 0.f, 0.f, 0.f}; zi[mt][n] = (f32x4){0.f, 0.f, 0.f, 0.f}; }
#pragma unroll
        for (int ks = 0; ks < 2; ++ks) { bf16x8 xr[2], xi[2];
#pragma unroll
            for (int n = 0; n < 2; ++n) { xr[n] = *(const LAS bf16x8*)(X + (32 * w + 16 * n + fr) * TP + 32 * ks + 8 * fq); xi[n] = *(const LAS bf16x8*)(X + (256 + 32 * w + 16 * n + fr) * TP + 32 * ks + 8 * fq); }
#pragma unroll
            for (int mt = 0; mt < 4; ++mt) { const bf16x8 c = *(const LAS bf16x8*)(Tc + (16 * mt + fr) * TP + 32 * ks + 8 * fq), s = *(const LAS bf16x8*)(Ts + (16 * mt + fr) * TP + 32 * ks + 8 * fq), ns = neg8(s);
#pragma unroll
                for (int n = 0; n < 2; ++n) { zr[mt][n] = __builtin_amdgcn_mfma_f32_16x16x32_bf16(c, xr[n], zr[mt][n], 0, 0, 0); zr[mt][n] = __builtin_amdgcn_mfma_f32_16x16x32_bf16(s, xi[n], zr[mt][n], 0, 0, 0);
                    zi[mt][n] = __builtin_amdgcn_mfma_f32_16x16x32_bf16(c, xi[n], zi[mt][n], 0, 0, 0); zi[mt][n] = __builtin_amdgcn_mfma_f32_16x16x32_bf16(ns, xr[n], zi[mt][n], 0, 0, 0); } } }
        __syncthreads();
        { LAS bf16_t* Zs = X;
#pragma unroll
          for (int mt = 0; mt < 4; ++mt)
#pragma unroll
              for (int i = 0; i < 4; ++i) { const int f1 = 16 * mt + 4 * fq + i; const float ct = TW[2 * f1], st = TW[2 * f1 + 1];
#pragma unroll
                  for (int n = 0; n < 2; ++n) { const float a = zr[mt][n][i], bq = zi[mt][n][i]; const int col = 32 * w + 16 * n + fr;
                      Zs[f1 * ZP + col] = f2bf(a * ct + bq * st); Zs[f1 * ZP + 256 + col] = f2bf(bq * ct - a * st); } } }
        __syncthreads();
#pragma unroll
        for (int i = 0; i < 8; ++i) { const int q = tid + 512 * i, f1 = q >> 6, ch = q & 63;
            *(u32x4*)(ZBUF + (((size_t)b * 64 + f1) * 64 + t2) * 512 + ch * 8) = *(const LAS u32x4*)((const LAS unsigned char*)X + f1 * (ZP * 2) + ch * 16); }
        __syncthreads();
    }
}
__device__ __forceinline__ void stage_b(LAS unsigned char* lds, const bf16_t* ZBUF, const float* TABC, const float* TABS, bf16_t* MIX, int G, int bx) {
    int tid_l = threadIdx.x; asm volatile("" : "+v"(tid_l));
    const int tid = tid_l, lane = tid & 63, w = __builtin_amdgcn_readfirstlane(tid >> 6), fr = lane & 15, fq = lane >> 4;
    build_tables(lds, TABC, TABS, tid);
    const LAS bf16_t* Tc = (const LAS bf16_t*)(lds + O_TC); const LAS bf16_t* Ts = (const LAS bf16_t*)(lds + O_TS);
    LAS bf16_t* Ys = (LAS bf16_t*)(lds + O_U); LAS bf16_t* ZT = (LAS bf16_t*)(lds + O_X);
    for (int unit = bx; unit < 256; unit += G) {
        const int b = unit >> 6, f1 = unit & 63;
        const bf16_t* Zg = ZBUF + ((size_t)b * 64 + f1) * 64 * 512;
#pragma unroll
        for (int i = 0; i < 4; ++i) { const int q = tid + 512 * i, p = q & 31, ch = q >> 5;
            const u32x4 r0 = *(const u32x4*)(Zg + (size_t)(2 * p) * 512 + ch * 8), r1 = *(const u32x4*)(Zg + (size_t)(2 * p + 1) * 512 + ch * 8);
#pragma unroll
            for (int j = 0; j < 4; ++j) { const unsigned a = r0[j], c = r1[j];
                *(LAS unsigned*)(ZT + (ch * 8 + 2 * j) * TP + 2 * p) = (a & 0xffffu) | (c << 16);
                *(LAS unsigned*)(ZT + (ch * 8 + 2 * j + 1) * TP + 2 * p) = (a >> 16) | (c & 0xffff0000u); } }
        __syncthreads();
        f32x4 y[4][2];
#pragma unroll
        for (int mt = 0; mt < 4; ++mt)
#pragma unroll
            for (int n = 0; n < 2; ++n) y[mt][n] = (f32x4){0.f, 0.f, 0.f, 0.f};
#pragma unroll
        for (int ks = 0; ks < 2; ++ks) { bf16x8 xr[2], xi[2];
#pragma unroll
            for (int n = 0; n < 2; ++n) { xr[n] = *(const LAS bf16x8*)(ZT + (32 * w + 16 * n + fr) * TP + 32 * ks + 8 * fq); xi[n] = *(const LAS bf16x8*)(ZT + (256 + 32 * w + 16 * n + fr) * TP + 32 * ks + 8 * fq); }
#pragma unroll
            for (int mt = 0; mt < 4; ++mt) { const bf16x8 c = *(const LAS bf16x8*)(Tc + (16 * mt + fr) * TP + 32 * ks + 8 * fq), s = *(const LAS bf16x8*)(Ts + (16 * mt + fr) * TP + 32 * ks + 8 * fq);
#pragma unroll
                for (int n = 0; n < 2; ++n) { y[mt][n] = __builtin_amdgcn_mfma_f32_16x16x32_bf16(c, xr[n], y[mt][n], 0, 0, 0); y[mt][n] = __builtin_amdgcn_mfma_f32_16x16x32_bf16(s, xi[n], y[mt][n], 0, 0, 0); } } }
#pragma unroll
        for (int mt = 0; mt < 4; ++mt)
#pragma unroll
            for (int i = 0; i < 4; ++i)
#pragma unroll
                for (int n = 0; n < 2; ++n) Ys[(16 * mt + 4 * fq + i) * UP + 32 * w + 16 * n + fr] = f2bf(y[mt][n][i] * (1.f / 512.f));
        __syncthreads();
#pragma unroll
        for (int i = 0; i < 4; ++i) { const int q = tid + 512 * i, f2 = q >> 5, ch = q & 31;
            *(u32x4*)(MIX + ((size_t)b * NPOS + CTX + f1 + 64 * f2) * D + ch * 8) = *(const LAS u32x4*)((const LAS unsigned char*)Ys + f2 * (UP * 2) + ch * 16); }
        __syncthreads();
    }
}
}

namespace attn {
typedef float f32x16 __attribute__((ext_vector_type(16)));
typedef float f32x2_t __attribute__((ext_vector_type(2))); typedef __bf16 bf16x2_t __attribute__((ext_vector_type(2)));
__device__ __forceinline__ unsigned cvtpk(float lo, float hi) { f32x2_t v = {lo, hi}; bf16x2_t b = __builtin_convertvector(v, bf16x2_t); return __builtin_bit_cast(unsigned, b); }
constexpr int KP = 104, VP = 68;
constexpr int KT_BYTES = 64 * KP * 2, VT_BYTES = 64 * VP * 2, BUF_BYTES = KT_BYTES + VT_BYTES;
constexpr float C2 = 0.10206207261596577f * 1.4426950408889634f;
__device__ __forceinline__ void attn_phase(LAS unsigned char* lds, const bf16_t* QL, const bf16_t* QC, const bf16_t* KB, const bf16_t* VTG, bf16_t* MIX, int with_ctx, int G, int vcu) {
    int tid_l = threadIdx.x; asm volatile("" : "+v"(tid_l));
    const int tid = tid_l, lane = tid & 63, wid = __builtin_amdgcn_readfirstlane(tid >> 6), r32 = lane & 31, hi = lane >> 5;
    const int nunits = 256 + (with_ctx ? 16 : 0);
    for (int unit = vcu; unit < nunits; unit += G) {
        int bh, nk, orow0; const bf16_t* Qp;
        if (unit < 256) { bh = unit >> 4; const int qb = unit & 15; Qp = QL + ((size_t)bh * SEQ + qb * 256) * 96; nk = NPOS; orow0 = (bh >> 2) * NPOS + CTX + qb * 256; }
        else { bh = unit - 256; Qp = QC + (size_t)bh * CTX * 96; nk = CTX; orow0 = (bh >> 2) * NPOS; }
        const int hh = bh & 3, NT = nk / 64;
        const bf16_t* Kg = KB + (size_t)bh * NPOS * 96; const bf16_t* Vg = VTG + (size_t)bh * 64 * NPOS;
        bf16x8 qf[6];
        { const bf16_t* qp = Qp + (size_t)(wid * 32 + r32) * 96 + 8 * hi;
#pragma unroll
          for (int ds = 0; ds < 6; ++ds) qf[ds] = *(const bf16x8*)(qp + 16 * ds); }
        f32x16 o0 = {}, o1 = {}; float m = -1e30f, l = 0.f;
        const int kr0 = tid / 12, kc0 = tid % 12, kr1 = (tid + 512) / 12, kc1 = (tid + 512) % 12; const bool k1ok = tid < 256;
        const int vd = tid >> 3, vc = tid & 7;
        u32x4 sk0, sk1 = {}, sv;
        sk0 = *(const u32x4*)(Kg + (size_t)kr0 * 96 + kc0 * 8); if (k1ok) sk1 = *(const u32x4*)(Kg + (size_t)kr1 * 96 + kc1 * 8); sv = *(const u32x4*)(Vg + (size_t)vd * NPOS + vc * 8);
        int cur = 0;
        { LAS unsigned char* bp = lds; *(LAS u32x4*)(bp + kr0 * (KP * 2) + kc0 * 16) = sk0; if (k1ok) *(LAS u32x4*)(bp + kr1 * (KP * 2) + kc1 * 16) = sk1; *(LAS u32x4*)(bp + KT_BYTES + vd * (VP * 2) + vc * 16) = sv; }
        __syncthreads();
        for (int t = 0; t < NT; ++t) {
            if (t + 1 < NT) { const size_t k0 = (size_t)(t + 1) * 64;
                sk0 = *(const u32x4*)(Kg + (k0 + kr0) * 96 + kc0 * 8); if (k1ok) sk1 = *(const u32x4*)(Kg + (k0 + kr1) * 96 + kc1 * 8); sv = *(const u32x4*)(Vg + (size_t)vd * NPOS + k0 + vc * 8); }
            const LAS bf16_t* Kt = (const LAS bf16_t*)(lds + cur * BUF_BYTES); const LAS bf16_t* Vt = (const LAS bf16_t*)(lds + cur * BUF_BYTES + KT_BYTES);
            f32x16 p0 = {}, p1 = {};
#pragma unroll
            for (int ds = 0; ds < 6; ++ds) { const bf16x8 k0f = *(const LAS bf16x8*)(Kt + r32 * KP + 16 * ds + 8 * hi), k1f = *(const LAS bf16x8*)(Kt + (32 + r32) * KP + 16 * ds + 8 * hi);
                p0 = __builtin_amdgcn_mfma_f32_32x32x16_bf16(k0f, qf[ds], p0, 0, 0, 0); p1 = __builtin_amdgcn_mfma_f32_32x32x16_bf16(k1f, qf[ds], p1, 0, 0, 0); }
            float mx = fmaxf(p0[0], p1[0]);
#pragma unroll
            for (int r = 1; r < 16; ++r) mx = fmaxf(mx, fmaxf(p0[r], p1[r]));
            mx = fmaxf(mx, __shfl_xor(mx, 32));
            const float mn = fmaxf(m, mx), alpha = __builtin_amdgcn_exp2f(m - mn); m = mn;
            float ls = 0.f;
#pragma unroll
            for (int r = 0; r < 16; ++r) { p0[r] = __builtin_amdgcn_exp2f(p0[r] - mn); p1[r] = __builtin_amdgcn_exp2f(p1[r] - mn); ls += p0[r] + p1[r]; }
            l = l * alpha + ls;
#pragma unroll
            for (int r = 0; r < 16; ++r) { o0[r] *= alpha; o1[r] *= alpha; }
#pragma unroll
            for (int s = 0; s < 4; ++s) {
                u32x4 pw;
#pragma unroll
                for (int j = 0; j < 4; ++j) { const int r = 8 * (s & 1) + 2 * j; pw[j] = (s < 2) ? cvtpk(p0[r], p0[r + 1]) : cvtpk(p1[r], p1[r + 1]); }
                const bf16x8 pf = __builtin_bit_cast(bf16x8, pw);
                const int kvb = 32 * (s >> 1) + 16 * (s & 1) + 4 * hi;
#pragma unroll
                for (int db = 0; db < 2; ++db) { const u32x2 va = *(const LAS u32x2*)(Vt + (32 * db + r32) * VP + kvb), vb = *(const LAS u32x2*)(Vt + (32 * db + r32) * VP + kvb + 8);
                    const u32x4 vw = {va.x, va.y, vb.x, vb.y}; const bf16x8 vf = __builtin_bit_cast(bf16x8, vw);
                    if (db == 0) o0 = __builtin_amdgcn_mfma_f32_32x32x16_bf16(vf, pf, o0, 0, 0, 0); else o1 = __builtin_amdgcn_mfma_f32_32x32x16_bf16(vf, pf, o1, 0, 0, 0); }
            }
            if (t + 1 < NT) { LAS unsigned char* bp = lds + (cur ^ 1) * BUF_BYTES;
                *(LAS u32x4*)(bp + kr0 * (KP * 2) + kc0 * 16) = sk0; if (k1ok) *(LAS u32x4*)(bp + kr1 * (KP * 2) + kc1 * 16) = sk1; *(LAS u32x4*)(bp + KT_BYTES + vd * (VP * 2) + vc * 16) = sv; }
            __syncthreads();
            cur ^= 1;
        }
        l += __shfl_xor(l, 32);
        const float il = 1.f / l;
        bf16_t* op = MIX + (size_t)(orow0 + wid * 32 + r32) * D + 512 + hh * 64 + 4 * hi;
#pragma unroll
        for (int g4 = 0; g4 < 4; ++g4) { u32x2 w0, w1; w0.x = cvtpk(o0[4 * g4] * il, o0[4 * g4 + 1] * il); w0.y = cvtpk(o0[4 * g4 + 2] * il, o0[4 * g4 + 3] * il);
            w1.x = cvtpk(o1[4 * g4] * il, o1[4 * g4 + 1] * il); w1.y = cvtpk(o1[4 * g4 + 2] * il, o1[4 * g4 + 3] * il);
            *(u32x2*)(op + 8 * g4) = w0; *(u32x2*)(op + 32 + 8 * g4) = w1; }
    }
}
}

namespace sm {
__device__ __forceinline__ float silu(float x) { return x / (1.f + __expf(-x)); }
__device__ __forceinline__ void mod_phase(LAS unsigned char* lds, const float* c, const float* c_ctx, const float* mod_w, const float* mod_b, float* MOD, int G, int bx, int tid) {
    LAS float* s = (LAS float*)lds;
    for (int i = tid; i < 5120; i += 512) { const int v = i >> 10, k = i & 1023; s[i] = silu(v < 4 ? c[v * 1024 + k] : c_ctx[k]); }
    __syncthreads();
    LAS float* red = s + 5120;
    for (int unit = bx; unit < 96; unit += G) {
        const int l = unit / 48, cb = unit % 48, cl = tid & 127, col = cb * 128 + cl, kq = tid >> 7, k0 = kq * 256;
        const float* W = mod_w + ((size_t)l * 1024 + k0) * 6144 + col;
        float a0 = 0.f, a1 = 0.f, a2 = 0.f, a3 = 0.f, a4 = 0.f;
#pragma unroll 16
        for (int k = 0; k < 256; ++k) { const float w = W[(size_t)k * 6144]; a0 += s[k0 + k] * w; a1 += s[1024 + k0 + k] * w; a2 += s[2048 + k0 + k] * w; a3 += s[3072 + k0 + k] * w; a4 += s[4096 + k0 + k] * w; }
        LAS float* rq = red + kq * 640 + cl; rq[0] = a0; rq[128] = a1; rq[256] = a2; rq[384] = a3; rq[512] = a4;
        __syncthreads();
        for (int i = tid; i < 640; i += 512) { const int v = i >> 7, cc = i & 127; const float r = ((red[i] + red[640 + i]) + (red[1280 + i] + red[1920 + i])) + mod_b[l * 6144 + cb * 128 + cc];
            MOD[((size_t)l * 5 + v) * 6144 + cb * 128 + cc] = r; }
        __syncthreads();
    }
}
__device__ __forceinline__ void norm_store(const float4 (&x)[4], float ss, const float* g, const float* mv, int sh_off, int sc_off, bf16_t* xn_row, int lane) {
    const float rs = rsqrtf(wave_sum(ss) * (1.f / D) + 1e-6f);
#pragma unroll
    for (int j = 0; j < 4; ++j) { const int c = (j * 64 + lane) * 4; const float4 gg = *(const float4*)(g + c), sh = *(const float4*)(mv + sh_off + c), sc = *(const float4*)(mv + sc_off + c);
        u32x2 o; o.x = pk2(x[j].x * rs * gg.x * (1.f + sc.x) + sh.x, x[j].y * rs * gg.y * (1.f + sc.y) + sh.y); o.y = pk2(x[j].z * rs * gg.z * (1.f + sc.z) + sh.z, x[j].w * rs * gg.w * (1.f + sc.w) + sh.w);
        *(u32x2*)(xn_row + c) = o; }
}
__device__ __forceinline__ void pro1_phase(const float* x, const float* ctx, const float* g, const float* MODl, float* H, bf16_t* XN, int gw, int NGW, int lane) {
    for (int r = gw; r < MROWS; r += NGW) { const int b = r / NPOS, pos = r % NPOS, v = pos < CTX ? 4 : b;
        const float* src = pos < CTX ? ctx + ((size_t)b * CTX + pos) * D : x + ((size_t)b * SEQ + (pos - CTX)) * D;
        float4 xv[4]; float ss = 0.f;
#pragma unroll
        for (int j = 0; j < 4; ++j) { const int c = (j * 64 + lane) * 4; xv[j] = *(const float4*)(src + c); *(float4*)(H + (size_t)r * D + c) = xv[j]; ss += xv[j].x * xv[j].x + xv[j].y * xv[j].y + xv[j].z * xv[j].z + xv[j].w * xv[j].w; }
        norm_store(xv, ss, g, MODl + (size_t)v * 6144, 0, 1024, XN + (size_t)r * D, lane); }
}
__device__ __forceinline__ void comb_phase(int l, float* H, const bf16_t* Y, const float* MODl, const float* g_next, const float* MODn, bf16_t* XN, const float* final_g, float* out, int gw, int NGW, int lane) {
    for (int r = gw; r < MROWS; r += NGW) { const int b = r / NPOS, pos = r % NPOS, v = pos < CTX ? 4 : b;
        if (l == 1 && pos < CTX) continue;
        const float* g2 = MODl + (size_t)v * 6144 + 5120;
        float4 xv[4]; float ss = 0.f;
#pragma unroll
        for (int j = 0; j < 4; ++j) { const int c = (j * 64 + lane) * 4; xv[j] = *(const float4*)(H + (size_t)r * D + c); float4 s = make_float4(0.f, 0.f, 0.f, 0.f);
#pragma unroll
            for (int k = 0; k < 4; ++k) { const u32x2 y = *(const u32x2*)(Y + ((size_t)r * 4 + k) * D + c); s.x += __uint_as_float(y.x << 16); s.y += __uint_as_float(y.x & 0xffff0000u); s.z += __uint_as_float(y.y << 16); s.w += __uint_as_float(y.y & 0xffff0000u); }
            const float4 gg = *(const float4*)(g2 + c); xv[j].x += gg.x * s.x; xv[j].y += gg.y * s.y; xv[j].z += gg.z * s.z; xv[j].w += gg.w * s.w;
            ss += xv[j].x * xv[j].x + xv[j].y * xv[j].y + xv[j].z * xv[j].z + xv[j].w * xv[j].w; }
        if (l == 0) {
#pragma unroll
            for (int j = 0; j < 4; ++j) *(float4*)(H + (size_t)r * D + (j * 64 + lane) * 4) = xv[j];
            norm_store(xv, ss, g_next, MODn + (size_t)v * 6144, 0, 1024, XN + (size_t)r * D, lane);
        } else { const float rs = rsqrtf(wave_sum(ss) * (1.f / D) + 1e-6f); float* op = out + ((size_t)b * SEQ + (pos - CTX)) * D;
#pragma unroll
            for (int j = 0; j < 4; ++j) { const int c = (j * 64 + lane) * 4; const float4 fg = *(const float4*)(final_g + c); float4 o; o.x = xv[j].x * rs * fg.x; o.y = xv[j].y * rs * fg.y; o.z = xv[j].z * rs * fg.z; o.w = xv[j].w * rs * fg.w; *(float4*)(op + c) = o; } }
    }
}
__device__ __forceinline__ void route_phase(LAS unsigned char* lds, int l, const float* H, const float* g, const float* MODl, const float* rw, const float* rb, bf16_t* XN, int* CNT, int* LIST, float* GATE,
                                            int G, int bx, int tid) {
    const int lane = tid & 63, wave = __builtin_amdgcn_readfirstlane(tid >> 6), e = lane & 31, kpart = wave * 2 + (lane >> 5);
    LAS float* F = (LAS float*)lds;
    LAS float* PART = (LAS float*)(lds + 32768);
    LAS int* LCNT = (LAS int*)(lds + 49152);
    LAS int* LBASE = LCNT + 64; LAS int* LENT = LCNT + 128;
    if (tid < 64) LCNT[tid] = 0;
    __syncthreads();
    float w[64];
#pragma unroll
    for (int k = 0; k < 64; ++k) w[k] = rw[(size_t)(kpart * 64 + k) * 32 + e];
    const float bias = rb[e];
    const int nb = l == 1 ? (MROWS - NB_ * CTX) / 8 : MROWS / 8;
    for (int bi = bx; bi < nb; bi += G) {
        int r;
        if (l == 1) { const int q = bi * 8 + wave; r = (q / SEQ) * NPOS + CTX + (q % SEQ); } else r = bi * 8 + wave;
        const int b = r / NPOS, pos = r % NPOS, v = pos < CTX ? 4 : b; const float* mv = MODl + (size_t)v * 6144;
        { float4 xv[4]; float ss = 0.f;
#pragma unroll
          for (int j = 0; j < 4; ++j) { xv[j] = *(const float4*)(H + (size_t)r * D + (j * 64 + lane) * 4); ss += xv[j].x * xv[j].x + xv[j].y * xv[j].y + xv[j].z * xv[j].z + xv[j].w * xv[j].w; }
          const float rs = rsqrtf(wave_sum(ss) * (1.f / D) + 1e-6f);
#pragma unroll
          for (int j = 0; j < 4; ++j) { const int c = (j * 64 + lane) * 4; const float4 gg = *(const float4*)(g + c), sh = *(const float4*)(mv + 3072 + c), sc = *(const float4*)(mv + 4096 + c);
              f32x4 f; f[0] = xv[j].x * rs * gg.x * (1.f + sc.x) + sh.x; f[1] = xv[j].y * rs * gg.y * (1.f + sc.y) + sh.y; f[2] = xv[j].z * rs * gg.z * (1.f + sc.z) + sh.z; f[3] = xv[j].w * rs * gg.w * (1.f + sc.w) + sh.w;
              *(LAS f32x4*)(F + wave * 1024 + c) = f; u32x2 o; o.x = pk2(f[0], f[1]); o.y = pk2(f[2], f[3]); *(u32x2*)(XN + (size_t)r * D + c) = o; } }
        __syncthreads();
        { float acc[8];
#pragma unroll
          for (int rr = 0; rr < 8; ++rr) acc[rr] = 0.f;
#pragma unroll
          for (int k4 = 0; k4 < 16; ++k4) {
#pragma unroll
              for (int rr = 0; rr < 8; ++rr) { const f32x4 f = *(const LAS f32x4*)(F + rr * 1024 + kpart * 64 + k4 * 4); acc[rr] += f[0] * w[k4 * 4] + f[1] * w[k4 * 4 + 1] + f[2] * w[k4 * 4 + 2] + f[3] * w[k4 * 4 + 3]; } }
#pragma unroll
          for (int rr = 0; rr < 8; ++rr) PART[(rr * 16 + kpart) * 32 + e] = acc[rr]; }
        __syncthreads();
        { float lg = bias;
#pragma unroll
          for (int kp = 0; kp < 16; ++kp) lg += PART[(wave * 16 + kp) * 32 + e];
          float val = lane < 32 ? lg : -3e38f; int idx = e; float tv[4]; int ti[4];
#pragma unroll
          for (int k = 0; k < 4; ++k) { float bv = val; int bi2 = idx;
#pragma unroll
              for (int o = 1; o < 32; o <<= 1) { const float ov = __shfl_xor(bv, o); const int oi = __shfl_xor(bi2, o); if (ov > bv || (ov == bv && oi < bi2)) { bv = ov; bi2 = oi; } }
              tv[k] = bv; ti[k] = bi2; if (idx == bi2) val = -3e38f; }
          if (lane == 0) { float ex[4], sum = 0.f;
#pragma unroll
              for (int k = 0; k < 4; ++k) { ex[k] = __expf(tv[k] - tv[0]); sum += ex[k]; }
              const float isum = 1.f / sum;
#pragma unroll
              for (int k = 0; k < 4; ++k) { const int asg = r * 4 + k; GATE[asg] = ex[k] * isum; const int rank = __hip_atomic_fetch_add(&LCNT[ti[k]], 1, __ATOMIC_RELAXED, __HIP_MEMORY_SCOPE_WORKGROUP); const int slot = __hip_atomic_fetch_add(&LCNT[32], 1, __ATOMIC_RELAXED, __HIP_MEMORY_SCOPE_WORKGROUP);
                  LENT[slot * 2] = asg; LENT[slot * 2 + 1] = (ti[k] << 16) | rank; } } }
        __syncthreads();
    }
    if (tid < 32) LBASE[tid] = LCNT[tid] > 0 ? atomicAdd(&CNT[tid * L::CNT_STRIDE], LCNT[tid]) : 0;
    __syncthreads();
    for (int i = tid; i < LCNT[32]; i += 512) { const int asg = LENT[i * 2], er = LENT[i * 2 + 1], ee = er >> 16, rank = er & 0xffff; LIST[(size_t)ee * LCAP + LBASE[ee] + rank] = asg; }
    __syncthreads();
}
__device__ __forceinline__ void smallw_phase(const float* w_uq, const float* qg, const float* w_ukv, const float* kvg, const float* w_a, const float* w_i, bf16_t* WUQT, bf16_t* WUKVT, bf16_t* WAT, bf16_t* WIT,
                                             float* TABC, float* TABS, int gt, int NGT) {
    for (int i = gt; i < 2 * 384 * 256; i += NGT) { const int l = i / (384 * 256), q = i % (384 * 256), n = q >> 8, k = q & 255; WUQT[i] = f2bf(qg[l * 256 + k] * w_uq[((size_t)l * 256 + k) * 384 + n]); }
    for (int i = gt; i < 2 * 512 * 128; i += NGT) { const int l = i / (512 * 128), q = i % (512 * 128), n = q >> 7, k = q & 127; WUKVT[i] = f2bf(kvg[l * 128 + k] * w_ukv[((size_t)l * 128 + k) * 512 + n]); }
    for (int i = gt; i < 16 * 4096; i += NGT) { const int m = i >> 12, q = i & 4095, e = q >> 6, d = q & 63; WAT[i] = f2bf(w_a[(size_t)m * 4096 + d * 64 + e]); WIT[i] = f2bf(w_i[(size_t)m * 4096 + d * 64 + e]); }
    for (int i = gt; i < 4096; i += NGT) { float s, c; sincospif((float)i / 2048.f, &s, &c); TABC[i] = c; TABS[i] = s; }
}
}

namespace prep {
constexpr int O_KR = 0, O_CS = 8192, O_RS = 16384, O_CQ = 16896  , O_KS = 67072, O_CKV = 100864;
constexpr int CQP = 264, CKP = 136, QSP = 392, KSP = 264;
constexpr float C2 = 0.10206207261596577f * 1.4426950408889634f;
__device__ __forceinline__ void qkv_units(LAS unsigned char* lds, int l, const bf16_t* P, const bf16_t* WUQT, const bf16_t* WUKVT, const float* scw, const float* scb,
                                          bf16_t* QL, bf16_t* QC, bf16_t* KB, bf16_t* VTG, bf16_t* MIX, int G, int bx) {
    LAS float* KRo = (LAS float*)(lds + O_KR); LAS float* CS = (LAS float*)(lds + O_CS); LAS float* RS = (LAS float*)(lds + O_RS);
    LAS bf16_t* CQ = (LAS bf16_t*)(lds + O_CQ); LAS bf16_t* CK = (LAS bf16_t*)(lds + O_CKV); LAS bf16_t* KS = (LAS bf16_t*)(lds + O_KS); LAS bf16_t* QS = (LAS bf16_t*)(lds + O_CQ);
    for (int unit = bx; unit < 272; unit += G) {
        int tid_l = threadIdx.x; asm volatile("" : "+v"(tid_l));
        const int tid = tid_l, lane = tid & 63, w = __builtin_amdgcn_readfirstlane(tid >> 6), fr = lane & 15, fq = lane >> 4;
        const int b = unit / 68, chunk = unit % 68, pos0 = 64 * chunk; const bool ctxt = chunk < 4; const size_t r0 = (size_t)b * NPOS + pos0;
#pragma unroll
        for (int i = 0; i < 4; ++i) { const int q = tid + 512 * i, row = q >> 5, ch = q & 31; *(LAS u32x4*)((LAS unsigned char*)CQ + row * (CQP * 2) + ch * 16) = *(const u32x4*)(P + (r0 + row) * PP + C_CQ + ch * 8); }
#pragma unroll
        for (int i = 0; i < 2; ++i) { const int q = tid + 512 * i, row = q >> 4, ch = q & 15; *(LAS u32x4*)((LAS unsigned char*)CK + row * (CKP * 2) + ch * 16) = *(const u32x4*)(P + (r0 + row) * PP + C_CKV + ch * 8); }
        __syncthreads();
        { const int row = tid >> 3, j = tid & 7; float sq = 0.f, sk = 0.f;
#pragma unroll
          for (int i = 0; i < 4; ++i) { const u32x4 v = *(const LAS u32x4*)((const LAS unsigned char*)CQ + row * (CQP * 2) + j * 64 + i * 16);
#pragma unroll
              for (int e = 0; e < 4; ++e) { const float a = __uint_as_float(v[e] << 16), c = __uint_as_float(v[e] & 0xffff0000u); sq += a * a + c * c; } }
#pragma unroll
          for (int i = 0; i < 2; ++i) { const u32x4 v = *(const LAS u32x4*)((const LAS unsigned char*)CK + row * (CKP * 2) + j * 32 + i * 16);
#pragma unroll
              for (int e = 0; e < 4; ++e) { const float a = __uint_as_float(v[e] << 16), c = __uint_as_float(v[e] & 0xffff0000u); sk += a * a + c * c; } }
          sq += __shfl_xor(sq, 1); sq += __shfl_xor(sq, 2); sq += __shfl_xor(sq, 4); sk += __shfl_xor(sk, 1); sk += __shfl_xor(sk, 2); sk += __shfl_xor(sk, 4);
          if (j == 0) { RS[row * 2] = rsqrtf(sq * (1.f / 256.f) + 1e-6f); RS[row * 2 + 1] = rsqrtf(sk * (1.f / 128.f) + 1e-6f); }
          float cr = 1.f, sr = 0.f, cc = 1.f, sc = 0.f;
          if (!ctxt) { const int t = pos0 - CTX + row; const float inv = __expf(-9.210340371976184f * (float)j * 0.125f); float xa = (float)(t >> 6) * inv * 0.15915494309189535f; xa -= rintf(xa); sr = __sinf(xa * 6.283185307179586f); cr = __cosf(xa * 6.283185307179586f); float xb = (float)(t & 63) * inv * 0.15915494309189535f; xb -= rintf(xb); sc = __sinf(xb * 6.283185307179586f); cc = __cosf(xb * 6.283185307179586f); }
          CS[(row * 16 + j) * 2] = cr; CS[(row * 16 + j) * 2 + 1] = sr; CS[(row * 16 + 8 + j) * 2] = cc; CS[(row * 16 + 8 + j) * 2 + 1] = sc;
          const bf16_t* kp = P + (r0 + row) * PP + C_KR; const float z0 = bf2f(kp[j]), z1 = bf2f(kp[8 + j]), z2 = bf2f(kp[16 + j]), z3 = bf2f(kp[24 + j]);
          KRo[row * 32 + j] = z0 * cr - z1 * sr; KRo[row * 32 + 8 + j] = z0 * sr + z1 * cr; KRo[row * 32 + 16 + j] = z2 * cc - z3 * sc; KRo[row * 32 + 24 + j] = z2 * sc + z3 * cc; }
        __builtin_amdgcn_sched_barrier(0);
        { f32x4 qa[4][3];
#pragma unroll
          for (int mt = 0; mt < 4; ++mt)
#pragma unroll
              for (int n = 0; n < 3; ++n) qa[mt][n] = (f32x4){0.f, 0.f, 0.f, 0.f};
          const bf16_t* wq = WUQT + ((size_t)l * 384 + 48 * w + fr) * 256 + 8 * fq;
#pragma unroll 2
          for (int ks = 0; ks < 8; ++ks) { bf16x8 a[4], bb[3];
#pragma unroll
              for (int mt = 0; mt < 4; ++mt) a[mt] = *(const LAS bf16x8*)(CQ + (16 * mt + fr) * CQP + 32 * ks + 8 * fq);
#pragma unroll
              for (int n = 0; n < 3; ++n) bb[n] = *(const bf16x8*)(wq + (size_t)(16 * n) * 256 + 32 * ks);
#pragma unroll
              for (int mt = 0; mt < 4; ++mt)
#pragma unroll
                  for (int n = 0; n < 3; ++n) qa[mt][n] = __builtin_amdgcn_mfma_f32_16x16x32_bf16(a[mt], bb[n], qa[mt][n], 0, 0, 0); }
          __syncthreads();
#pragma unroll
          for (int n = 0; n < 3; ++n) { const int nt = 3 * w + n, m6 = nt % 6, col = 16 * nt + fr;
#pragma unroll
              for (int mt = 0; mt < 4; ++mt)
#pragma unroll
                  for (int i = 0; i < 4; ++i) { const int row = 16 * mt + 4 * fq + i; float v = qa[mt][n][i] * RS[row * 2];
                      if (m6 >= 4) { const float pv = __shfl_xor(v, 8); const int ci = (row * 16 + (m6 == 5 ? 8 : 0) + (fr & 7)) * 2; const float c = CS[ci], s = CS[ci + 1]; v = (fr < 8) ? v * c - pv * s : pv * s + v * c; }
                      QS[row * QSP + col] = f2bf(v * C2); } } }
        __builtin_amdgcn_sched_barrier(0);
        { f32x4 ka[4][4];
#pragma unroll
          for (int mt = 0; mt < 4; ++mt)
#pragma unroll
              for (int n = 0; n < 4; ++n) ka[mt][n] = (f32x4){0.f, 0.f, 0.f, 0.f};
          const bf16_t* wk = WUKVT + ((size_t)l * 512 + 64 * w + fr) * 128 + 8 * fq;
#pragma unroll 2
          for (int ks = 0; ks < 4; ++ks) { bf16x8 a[4], bb[4];
#pragma unroll
              for (int mt = 0; mt < 4; ++mt) a[mt] = *(const LAS bf16x8*)(CK + (16 * mt + fr) * CKP + 32 * ks + 8 * fq);
#pragma unroll
              for (int n = 0; n < 4; ++n) bb[n] = *(const bf16x8*)(wk + (size_t)(16 * n) * 128 + 32 * ks);
#pragma unroll
              for (int mt = 0; mt < 4; ++mt)
#pragma unroll
                  for (int n = 0; n < 4; ++n) ka[mt][n] = __builtin_amdgcn_mfma_f32_16x16x32_bf16(a[mt], bb[n], ka[mt][n], 0, 0, 0); }
          const int head = w >> 1;
          if ((w & 1) == 0) {
#pragma unroll
              for (int n = 0; n < 4; ++n)
#pragma unroll
                  for (int mt = 0; mt < 4; ++mt)
#pragma unroll
                      for (int i = 0; i < 4; ++i) { const int row = 16 * mt + 4 * fq + i; KS[row * KSP + head * 64 + 16 * n + fr] = f2bf(ka[mt][n][i] * RS[row * 2 + 1]); }
          } else {
#pragma unroll
              for (int n = 0; n < 4; ++n)
#pragma unroll
                  for (int mt = 0; mt < 4; ++mt) { const int rb = 16 * mt + 4 * fq; u32x2 o; o.x = pk2(ka[mt][n][0] * RS[rb * 2 + 1], ka[mt][n][1] * RS[rb * 2 + 3]); o.y = pk2(ka[mt][n][2] * RS[rb * 2 + 5], ka[mt][n][3] * RS[rb * 2 + 7]);
                      *(u32x2*)(VTG + ((size_t)(b * 4 + head) * 64 + 16 * n + fr) * NPOS + pos0 + rb) = o; } } }
        __syncthreads();
#pragma unroll
        for (int i = 0; i < 6; ++i) { const int q = tid + 512 * i, row = q / 48, rem = q % 48, head = rem / 12, ch = rem % 12, pos = pos0 + row;
            const u32x4 qv = *(const LAS u32x4*)((const LAS unsigned char*)QS + row * (QSP * 2) + (head * 96 + ch * 8) * 2);
            if (!ctxt) *(u32x4*)(QL + ((size_t)(b * 4 + head) * SEQ + (pos - CTX)) * 96 + ch * 8) = qv; else if (l == 0) *(u32x4*)(QC + ((size_t)(b * 4 + head) * CTX + pos) * 96 + ch * 8) = qv;
            u32x4 kv;
            if (ch < 8) kv = *(const LAS u32x4*)((const LAS unsigned char*)KS + row * (KSP * 2) + (head * 64 + ch * 8) * 2);
            else { const LAS float* kr = KRo + row * 32 + (ch - 8) * 8; kv.x = pk2(kr[0], kr[1]); kv.y = pk2(kr[2], kr[3]); kv.z = pk2(kr[4], kr[5]); kv.w = pk2(kr[6], kr[7]); }
            *(u32x4*)(KB + ((size_t)(b * 4 + head) * NPOS + pos) * 96 + ch * 8) = kv; }
        if (!(ctxt && l == 1)) { const int lo = ctxt ? 0 : CTX, hi = ctxt ? CTX : NPOS;
#pragma unroll
            for (int i = 0; i < 4; ++i) { const int q = tid + 512 * i, row = q >> 5, ch = q & 31, pos = pos0 + row; float acc[8];
#pragma unroll
                for (int e = 0; e < 8; ++e) acc[e] = scb[ch * 8 + e];
#pragma unroll
                for (int k = 0; k < 3; ++k) { const int p = pos - 1 + k; if (p >= lo && p < hi) { const bf16_t* pr = P + ((size_t)b * NPOS + p) * PP; const u32x4 sx = *(const u32x4*)(pr + C_SX + ch * 8), sc = *(const u32x4*)(pr + C_SC + ch * 8);
#pragma unroll
                        for (int e = 0; e < 4; ++e) { const float w0 = scw[k * 256 + ch * 8 + 2 * e], w1 = scw[k * 256 + ch * 8 + 2 * e + 1];
                            acc[2 * e] += w0 * (__uint_as_float(sx[e] << 16) * __uint_as_float(sc[e] << 16)); acc[2 * e + 1] += w1 * (__uint_as_float(sx[e] & 0xffff0000u) * __uint_as_float(sc[e] & 0xffff0000u)); } } }
                const u32x4 sb = *(const u32x4*)(P + (r0 + row) * PP + C_SB + ch * 8); u32x4 o;
#pragma unroll
                for (int e = 0; e < 4; ++e) o[e] = pk2(__uint_as_float(sb[e] << 16) * acc[2 * e], __uint_as_float(sb[e] & 0xffff0000u) * acc[2 * e + 1]);
                *(u32x4*)(MIX + (r0 + row) * D + 768 + ch * 8) = o; } }
        __syncthreads();
    }
}
}

namespace lru {
constexpr int XP = 264, O_X = 0, O_NA = 33792, O_BB = 66560;
__device__ __forceinline__ float sigm(float x) { return __builtin_amdgcn_rcpf(1.f + __expf(-x)); }
__device__ __forceinline__ void chunk_units(LAS unsigned char* lds, int l, const bf16_t* P, const float* conv_w, const float* conv_b, const bf16_t* WAT, const bf16_t* WIT, const float* b_a, const float* b_i, const float* lam,
                                            bf16_t* HL, bf16_t* AC, float* SUM, int G, int bx) {
    LAS bf16_t* X = (LAS bf16_t*)(lds + O_X); LAS bf16_t* NA = (LAS bf16_t*)(lds + O_NA); LAS bf16_t* BB = (LAS bf16_t*)(lds + O_BB);
    for (int unit = bx; unit < 544; unit += G) {
        int tid_l = threadIdx.x; asm volatile("" : "+v"(tid_l));
        const int tid = tid_l, lane = tid & 63, w = __builtin_amdgcn_readfirstlane(tid >> 6), fr = lane & 15, fq = lane >> 4;
        const int dir = unit & 1, bc = unit >> 1, b = bc / 68, chunk = bc % 68, pos0 = 64 * chunk; const int lo = chunk < 4 ? 0 : CTX, hi = chunk < 4 ? CTX : NPOS, left = dir ? 1 : 2;
        const size_t r0 = (size_t)b * NPOS + pos0; const int pd = (l * 2 + dir) * 256;
        { const int c = tid & 255, th = tid >> 8; const float cb = conv_b[pd + c]; const float w0 = conv_w[(size_t)pd * 4 + c], w1 = conv_w[(size_t)pd * 4 + 256 + c], w2 = conv_w[(size_t)pd * 4 + 512 + c], w3 = conv_w[(size_t)pd * 4 + 768 + c];
          const bf16_t* pc = P + (size_t)b * NPOS * PP + C_LX + c; const int pb = pos0 + 32 * th - left;
          float u0 = (pb >= lo && pb < hi) ? bf2f(pc[(size_t)pb * PP]) : 0.f, u1 = (pb + 1 >= lo && pb + 1 < hi) ? bf2f(pc[(size_t)(pb + 1) * PP]) : 0.f, u2 = (pb + 2 >= lo && pb + 2 < hi) ? bf2f(pc[(size_t)(pb + 2) * PP]) : 0.f;
#pragma unroll 8
          for (int i = 0; i < 32; ++i) { const int p3 = pb + 3 + i; const float u3 = (p3 >= lo && p3 < hi) ? bf2f(pc[(size_t)p3 * PP]) : 0.f;
              X[(32 * th + i) * XP + c] = f2bf(cb + w0 * u0 + w1 * u1 + w2 * u2 + w3 * u3); u0 = u1; u1 = u2; u2 = u3; } }
        __syncthreads();
        { const int h = w >> 1, mh = w & 1;
          f32x4 ra[2][4], ri[2][4];
#pragma unroll
          for (int m = 0; m < 2; ++m)
#pragma unroll
              for (int n = 0; n < 4; ++n) { ra[m][n] = (f32x4){0.f, 0.f, 0.f, 0.f}; ri[m][n] = (f32x4){0.f, 0.f, 0.f, 0.f}; }
          const bf16_t* wa = WAT + ((size_t)((l * 2 + dir) * 4 + h) * 64 + fr) * 64 + 8 * fq; const bf16_t* wi = WIT + ((size_t)((l * 2 + dir) * 4 + h) * 64 + fr) * 64 + 8 * fq;
#pragma unroll
          for (int ks = 0; ks < 2; ++ks) { bf16x8 a[2], ba[4], bi[4];
#pragma unroll
              for (int m = 0; m < 2; ++m) a[m] = *(const LAS bf16x8*)(X + (16 * (2 * mh + m) + fr) * XP + 64 * h + 32 * ks + 8 * fq);
#pragma unroll
              for (int n = 0; n < 4; ++n) { ba[n] = *(const bf16x8*)(wa + (size_t)(16 * n) * 64 + 32 * ks); bi[n] = *(const bf16x8*)(wi + (size_t)(16 * n) * 64 + 32 * ks); }
#pragma unroll
              for (int m = 0; m < 2; ++m)
#pragma unroll
                  for (int n = 0; n < 4; ++n) { ra[m][n] = __builtin_amdgcn_mfma_f32_16x16x32_bf16(a[m], ba[n], ra[m][n], 0, 0, 0); ri[m][n] = __builtin_amdgcn_mfma_f32_16x16x32_bf16(a[m], bi[n], ri[m][n], 0, 0, 0); } }
#pragma unroll
          for (int n = 0; n < 4; ++n) { const int c = 64 * h + 16 * n + fr; const float bav = b_a[pd + c], biv = b_i[pd + c], sp = log1pf(__expf(-lam[pd + c]));
#pragma unroll
              for (int m = 0; m < 2; ++m)
#pragma unroll
                  for (int i = 0; i < 4; ++i) { const int t = 16 * (2 * mh + m) + 4 * fq + i; const float r = sigm(ra[m][n][i] + bav), ig = sigm(ri[m][n][i] + biv);
                      const float na = -expm1f(-8.f * r * sp); const float xv = bf2f(X[t * XP + c]);
                      NA[t * 256 + c] = f2bf(na); BB[t * 256 + c] = f2bf(sqrtf(fmaxf(na * (2.f - na), 0.f)) * (ig * xv)); } } }
        __syncthreads();
        if (tid < 256) { const int c = tid; float hst = 0.f, A = 1.f;
            bf16_t* hl = HL + ((size_t)dir * MROWS + r0) * 256 + c; bf16_t* ac = AC + ((size_t)dir * MROWS + r0) * 256 + c;
            if (dir == 0) {
#pragma unroll 8
                for (int t = 0; t < 64; ++t) { const float a = 1.f - bf2f(NA[t * 256 + c]); hst = a * hst + bf2f(BB[t * 256 + c]); A *= a; hl[(size_t)t * 256] = f2bf(hst); ac[(size_t)t * 256] = f2bf(A); }
            } else {
#pragma unroll 8
                for (int t = 63; t >= 0; --t) { const float a = 1.f - bf2f(NA[t * 256 + c]); hst = a * hst + bf2f(BB[t * 256 + c]); A *= a; hl[(size_t)t * 256] = f2bf(hst); ac[(size_t)t * 256] = f2bf(A); }
            }
            float* sm = SUM + ((size_t)(dir * 4 + b) * 68 + chunk) * 512; sm[c] = A; sm[256 + c] = hst; }
        __syncthreads();
    }
}
__device__ __forceinline__ void fixup_units(int l, const bf16_t* P, const bf16_t* HL, const bf16_t* AC, const float* SUM, bf16_t* MIX, int G, int bx) {
    for (int unit = bx; unit < 272; unit += G) {
        int tid_l = threadIdx.x; asm volatile("" : "+v"(tid_l));
        const int tid = tid_l, c = tid & 255, th = tid >> 8;
        const int b = unit / 68, chunk = unit % 68; if (l == 1 && chunk < 4) continue;
        const float* sf = SUM + ((size_t)(0 * 4 + b) * 68) * 512 + c; const float* sb = SUM + ((size_t)(1 * 4 + b) * 68) * 512 + c;
        float cf = 0.f, cb = 0.f;
        for (int j = 0; j < chunk; ++j) cf = sf[(size_t)j * 512 + 256] + sf[(size_t)j * 512] * cf;
        if (chunk < 4) { for (int j = 3; j > chunk; --j) cb = sb[(size_t)j * 512 + 256] + sb[(size_t)j * 512] * cb; }
        else { for (int j = 3; j >= 0; --j) cb = sb[(size_t)j * 512 + 256] + sb[(size_t)j * 512] * cb; for (int j = 67; j > chunk; --j) cb = sb[(size_t)j * 512 + 256] + sb[(size_t)j * 512] * cb; }
        const size_t r0 = (size_t)b * NPOS + 64 * chunk + 32 * th;
#pragma unroll 4
        for (int i = 0; i < 32; ++i) { const size_t r = r0 + i; const float hf = bf2f(HL[r * 256 + c]) + bf2f(AC[r * 256 + c]) * cf, hb = bf2f(HL[((size_t)MROWS + r) * 256 + c]) + bf2f(AC[((size_t)MROWS + r) * 256 + c]) * cb;
            const float x = bf2f(P[r * PP + C_LG + c]); const float u = 0.7978845608028654f * (x + 0.044715f * x * x * x); const float th_ = 1.f - 2.f * __builtin_amdgcn_rcpf(1.f + __expf(2.f * u));
            MIX[r * D + 256 + c] = f2bf(0.5f * x * (1.f + th_) * (hf + hb)); }
    }
}
}

namespace fft {
__device__ __forceinline__ void ctx_a(LAS unsigned char* lds, const bf16_t* P, const float* TABC, const float* TABS, bf16_t* XCT, int G, int bx) {
    LAS bf16_t* U = (LAS bf16_t*)(lds + O_U); LAS bf16_t* X = (LAS bf16_t*)(lds + O_X);
    for (int unit = bx; unit < 16; unit += G) {
        int tid_l = threadIdx.x; asm volatile("" : "+v"(tid_l));
        const int tid = tid_l, lane = tid & 63, w = __builtin_amdgcn_readfirstlane(tid >> 6), fr = lane & 15, fq = lane >> 4;
        build_tables(lds, TABC, TABS, tid);
        const LAS bf16_t* Tc = (const LAS bf16_t*)(lds + O_TC); const LAS bf16_t* Ts = (const LAS bf16_t*)(lds + O_TS);
        const int b = unit >> 2, q = unit & 3;
#pragma unroll
        for (int i = 0; i < 4; ++i) { const int qq = tid + 512 * i, t1 = qq >> 5, ch = qq & 31;
            *(LAS u32x4*)((LAS unsigned char*)U + t1 * (UP * 2) + ch * 16) = *(const u32x4*)(P + ((size_t)b * NPOS + 64 * q + t1) * PP + ch * 8); }
        __syncthreads();
        { const int g = w >> 1, part = w & 1; const LAS bf16_t* T = part ? Ts : Tc;
          f32x4 acc[4][4];
#pragma unroll
          for (int mt = 0; mt < 4; ++mt)
#pragma unroll
              for (int nt = 0; nt < 4; ++nt) acc[mt][nt] = (f32x4){0.f, 0.f, 0.f, 0.f};
#pragma unroll
          for (int ks = 0; ks < 2; ++ks) { bf16x8 a[4], bb[4];
#pragma unroll
              for (int mt = 0; mt < 4; ++mt) a[mt] = *(const LAS bf16x8*)(U + (16 * mt + fr) * UP + g * 64 + 32 * ks + 8 * fq);
#pragma unroll
              for (int nt = 0; nt < 4; ++nt) bb[nt] = *(const LAS bf16x8*)(T + (16 * nt + fr) * TP + 32 * ks + 8 * fq);
#pragma unroll
              for (int mt = 0; mt < 4; ++mt)
#pragma unroll
                  for (int nt = 0; nt < 4; ++nt) acc[mt][nt] = __builtin_amdgcn_mfma_f32_16x16x32_bf16(a[mt], bb[nt], acc[mt][nt], 0, 0, 0); }
          const float sg = part ? -1.f : 1.f;
#pragma unroll
          for (int mt = 0; mt < 4; ++mt)
#pragma unroll
              for (int nt = 0; nt < 4; ++nt) { const f32x4 v = acc[mt][nt] * sg; u32x2 o; o.x = pk2(v[0], v[1]); o.y = pk2(v[2], v[3]);
                  *(LAS u32x2*)(X + (part * 256 + g * 64 + 16 * nt + fr) * TP + 16 * mt + 4 * fq) = o; } }
        __syncthreads();
#pragma unroll
        for (int i = 0; i < 8; ++i) { const int qq = tid + 512 * i, row = qq >> 3, c8 = qq & 7;
            *(u32x4*)(XCT + (((size_t)b * 4 + q) * 512 + row) * 64 + c8 * 8) = *(const LAS u32x4*)((const LAS unsigned char*)X + row * (TP * 2) + c8 * 16); }
        __syncthreads();
    }
}
__device__ __forceinline__ void ctx_b(LAS unsigned char* lds, const bf16_t* XCT, const float* TABC, const float* TABS, bf16_t* MIX, int G, int bx) {
    LAS bf16_t* Tc = (LAS bf16_t*)(lds + O_TC); LAS bf16_t* Ts = (LAS bf16_t*)(lds + O_TS);
    LAS bf16_t* Ys = (LAS bf16_t*)(lds + O_U); LAS bf16_t* ZT = (LAS bf16_t*)(lds + O_X);
    for (int unit = bx; unit < 16; unit += G) {
        int tid_l = threadIdx.x; asm volatile("" : "+v"(tid_l));
        const int tid = tid_l, lane = tid & 63, w = __builtin_amdgcn_readfirstlane(tid >> 6), fr = lane & 15, fq = lane >> 4;
        const int b = unit >> 2, ft = unit & 3;
        f32x4 y[4][2];
#pragma unroll
        for (int mt = 0; mt < 4; ++mt)
#pragma unroll
            for (int n = 0; n < 2; ++n) y[mt][n] = (f32x4){0.f, 0.f, 0.f, 0.f};
        for (int q = 0; q < 4; ++q) {
            for (int i = tid; i < 4096; i += 512) { const int fl = i >> 6, tl = i & 63, ix = (((64 * ft + fl) * (64 * q + tl)) & 255) * 16; Tc[fl * TP + tl] = f2bf(TABC[ix]); Ts[fl * TP + tl] = f2bf(TABS[ix]); }
#pragma unroll
            for (int i = 0; i < 8; ++i) { const int qq = tid + 512 * i, row = qq >> 3, c8 = qq & 7;
                *(LAS u32x4*)((LAS unsigned char*)ZT + row * (TP * 2) + c8 * 16) = *(const u32x4*)(XCT + (((size_t)b * 4 + q) * 512 + row) * 64 + c8 * 8); }
            __syncthreads();
#pragma unroll
            for (int ks = 0; ks < 2; ++ks) { bf16x8 xr[2], xi[2];
#pragma unroll
                for (int n = 0; n < 2; ++n) { xr[n] = *(const LAS bf16x8*)(ZT + (32 * w + 16 * n + fr) * TP + 32 * ks + 8 * fq); xi[n] = *(const LAS bf16x8*)(ZT + (256 + 32 * w + 16 * n + fr) * TP + 32 * ks + 8 * fq); }
#pragma unroll
                for (int mt = 0; mt < 4; ++mt) { const bf16x8 c = *(const LAS bf16x8*)(Tc + (16 * mt + fr) * TP + 32 * ks + 8 * fq), s = *(const LAS bf16x8*)(Ts + (16 * mt + fr) * TP + 32 * ks + 8 * fq);
#pragma unroll
                    for (int n = 0; n < 2; ++n) { y[mt][n] = __builtin_amdgcn_mfma_f32_16x16x32_bf16(c, xr[n], y[mt][n], 0, 0, 0); y[mt][n] = __builtin_amdgcn_mfma_f32_16x16x32_bf16(s, xi[n], y[mt][n], 0, 0, 0); } } }
            __syncthreads();
        }
#pragma unroll
        for (int mt = 0; mt < 4; ++mt)
#pragma unroll
            for (int i = 0; i < 4; ++i)
#pragma unroll
                for (int n = 0; n < 2; ++n) Ys[(16 * mt + 4 * fq + i) * UP + 32 * w + 16 * n + fr] = f2bf(y[mt][n][i] * (1.f / 128.f));
        __syncthreads();
#pragma unroll
        for (int i = 0; i < 4; ++i) { const int qq = tid + 512 * i, fl = qq >> 5, ch = qq & 31;
            *(u32x4*)(MIX + ((size_t)b * NPOS + 64 * ft + fl) * D + ch * 8) = *(const LAS u32x4*)((const LAS unsigned char*)Ys + fl * (UP * 2) + ch * 16); }
        __syncthreads();
    }
}
}

constexpr int NWAVES = 8, RING_BYTES = 131072 + 3072, LDSCTL_OFF = RING_BYTES, MISC_OFF = LDSCTL_OFF + 64, META_OFF = MISC_OFF + 64, LDS_BYTES = 147456;
enum { PH_PRO0 = 0, PH_PRO1 = 1, PH_L0 = 2, PH_PER_LAYER = 8, PH_N = 18 };
enum { PL_WIN = 0, PL_PREP = 1, PL_MIX = 2, PL_WOUT = 3, PL_ROUTE = 4, PL_MOE1 = 5, PL_MOE2 = 6, PL_COMB = 7 };
struct MArgs { const float* in[30]; float* out; unsigned char* ws; int npass, skip_mask, dup_ph, dup_n; };

__device__ __forceinline__ void transpose_item(const float* W, int K, int N, bf16_t* WT, int drow0, LAS float* scr, int k0, int n0, int lane) {
#pragma unroll 8
    for (int i = 0; i < 32; ++i) { const int kk = 2 * i + (lane >> 5); scr[kk * 33 + (lane & 31)] = W[(size_t)(k0 + kk) * N + n0 + (lane & 31)]; }
    asm volatile("s_waitcnt lgkmcnt(0)" ::: "memory");
    const int c = lane & 7;
#pragma unroll
    for (int j = 0; j < 4; ++j) { const int n = (lane >> 3) + 8 * j; const LAS float* s = scr + (8 * c) * 33 + n;
        u32x4 o; o.x = pk2(s[0 * 33], s[1 * 33]); o.y = pk2(s[2 * 33], s[3 * 33]); o.z = pk2(s[4 * 33], s[5 * 33]); o.w = pk2(s[6 * 33], s[7 * 33]);
        *(u32x4*)(WT + (size_t)(drow0 + n) * K + k0 + 8 * c) = o; }
    asm volatile("s_waitcnt lgkmcnt(0)" ::: "memory");
}

#define ARG_IN(i) ({ const float* _p; asm volatile("s_load_dwordx2 %0, %1, %2\n\ts_waitcnt lgkmcnt(0)" : "=s"(_p) : "s"(__builtin_amdgcn_kernarg_segment_ptr()), "n"((i) * 8)); _p; })
__global__ void __launch_bounds__(NWAVES * 64, 2) mega(MArgs args) {
    extern __shared__ __attribute__((aligned(16))) unsigned char lds_raw[];
    const int G0 = gridDim.x, bx0 = blockIdx.x;
    unsigned char* ws0 = args.ws;
    unsigned* ctl0 = (unsigned*)(ws0 + L::CTL);
    for (int u = threadIdx.x; u < (LDS_BYTES - LDSCTL_OFF) / 4; u += NWAVES * 64) ((LAS unsigned*)(lds_raw + LDSCTL_OFF))[u] = 0u;
    __syncthreads();
    volatile LAS unsigned* MISC = (volatile LAS unsigned*)((LAS unsigned char*)lds_raw + MISC_OFF);
    XcdBarrier bar = xcd_barrier_post(ctl0 + L::CW_BAR, MISC);
    const int lo = 0, hi = PH_N;

    bool first = true;
    for (int pass = 0; pass < args.npass; ++pass)
    for (int ph = lo; ph < hi; ++ph) {
      const int reps = (ph == args.dup_ph) ? 1 + args.dup_n : 1;
      for (int rep = 0; rep < reps; ++rep) {
        if (!first) xcd_barrier(bar);
        first = false;
        if (pass + 1 < args.npass && ((args.skip_mask >> ph) & 1)) continue;
        unsigned char* ws = args.ws; asm volatile("" : "+s"(ws));
        unsigned* ctl = (unsigned*)(ws + L::CTL);
        int tid_p = threadIdx.x; asm volatile("" : "+v"(tid_p));
        int G = G0, bx = bx0; asm volatile("" : "+s"(G), "+s"(bx));
        const int vcu = (G % 8 == 0) ? (bx % 8) * (G / 8) + bx / 8 : bx; (void)vcu;
        unsigned ldsb = 0; asm volatile("" : "+s"(ldsb)); LAS unsigned char* lds = (LAS unsigned char*)lds_raw + ldsb;
        LAS int* META = (LAS int*)(lds + META_OFF);
        const int tid = tid_p, lane = tid & 63, wave = __builtin_amdgcn_readfirstlane(tid >> 6); (void)lane; (void)wave;
        if (ph == PH_PRO0) {
            if (bx == 0 && tid < 2 * NE) ((int*)(ctl + L::CW_CNT))[tid * L::CNT_STRIDE] = 0;
            LAS float* scr = (LAS float*)(lds + wave * 16384);
            const int gw = vcu * NWAVES + wave, NGW = G * NWAVES;
            constexpr int I_IN = 16 * 61, I_OUT = 16 * 32, I_GU = NE * 16 * 64, I_DN = NE * 16 * 32, I_L = I_IN + I_OUT + I_GU + I_DN;
            for (int it = gw; it < 2 * I_L; it += NGW) {
                const int l = it / I_L; int r = it % I_L;
                if (r < I_IN) { const int kb = r / 61, nb = r % 61; transpose_item(ARG_IN(8) + (size_t)l * D * PT, D, PT, (bf16_t*)(ws + L::WINT) + (size_t)l * 2048 * D, 32 * nb, scr, 64 * kb, 32 * nb, lane); continue; } r -= I_IN;
                if (r < I_OUT) { const int kb = r / 32, nb = r % 32; transpose_item(ARG_IN(22) + (size_t)l * D * D, D, D, (bf16_t*)(ws + L::WOUTT) + (size_t)l * D * D, 32 * nb, scr, 64 * kb, 32 * nb, lane); continue; } r -= I_OUT;
                if (r < I_GU) { const int e = r / (16 * 64), q = r % (16 * 64), kb = q / 64, nb = q % 64; const int n0 = 32 * nb; const int c2 = n0 & 1023; const int drow = (c2 >> 7) * 256 + (n0 >> 10) * 128 + (c2 & 127);
                    transpose_item(ARG_IN(25) + ((size_t)l * NE + e) * D * 2048, D, 2048, (bf16_t*)(ws + L::WGUT) + ((size_t)l * NE + e) * 2048 * D, drow, scr, 64 * kb, n0, lane); continue; } r -= I_GU;
                { const int e = r / (16 * 32), q = r % (16 * 32), kb = q / 32, nb = q % 32;
                    transpose_item(ARG_IN(27) + ((size_t)l * NE + e) * D * D, D, D, (bf16_t*)(ws + L::WDT) + ((size_t)l * NE + e) * D * D, 32 * nb, scr, 64 * kb, 32 * nb, lane); }
            }
            sm::smallw_phase(ARG_IN(17), ARG_IN(16), ARG_IN(19), ARG_IN(18), ARG_IN(11), ARG_IN(13), (bf16_t*)(ws + L::WUQT), (bf16_t*)(ws + L::WUKVT), (bf16_t*)(ws + L::WAT), (bf16_t*)(ws + L::WIT),
                             (float*)(ws + L::TABC), (float*)(ws + L::TABS), bx * 512 + tid, G * 512);
            __syncthreads();
            sm::mod_phase(lds, ARG_IN(1), ARG_IN(3), ARG_IN(4), ARG_IN(5), (float*)(ws + L::MOD), G, bx, tid);
            for (int i = bx * 512 + tid; i < 2 * 96 * D / 8; i += G * 512) { const int l = i / (96 * D / 8), q = i % (96 * D / 8); *(u32x4*)((bf16_t*)(ws + L::WINT) + ((size_t)l * 2048 + PT) * D + (size_t)q * 8) = (u32x4){0u, 0u, 0u, 0u}; }
            continue;
        }
        if (ph == PH_PRO1) { sm::pro1_phase(ARG_IN(0), ARG_IN(2), ARG_IN(6), (const float*)(ws + L::MOD), (float*)(ws + L::H), (bf16_t*)(ws + L::XN), bx * NWAVES + wave, G * NWAVES, lane); continue; }
        if (ph < PH_L0) continue;
        const int l = (ph - PH_L0) / PH_PER_LAYER, pl = (ph - PH_L0) % PH_PER_LAYER;
        const float* MODl = (const float*)(ws + L::MOD) + (size_t)l * 5 * 6144;
        if (pl == PL_WIN) {
            g8::DenseSched S; S.init(MROWS / 256, PP / 256, G, bx, 0, (const bf16_t*)(ws + L::WINT) + (size_t)l * 2048 * D, D);
            g8::EpiP E{(bf16_t*)(ws + L::P)};
            g8::gemm_phase<g8::EpiP, g8::DenseSched, false, false>(lds, (const char*)(ws + L::XN), S, E);
        } else if (pl == PL_PREP) {
            fft::stage_a(lds, (const bf16_t*)(ws + L::P), (const float*)(ws + L::TABC), (const float*)(ws + L::TABS), (bf16_t*)(ws + L::ZBUF), G, bx);
            __syncthreads();
            if (l == 0) { fft::ctx_a(lds, (const bf16_t*)(ws + L::P), (const float*)(ws + L::TABC), (const float*)(ws + L::TABS), (bf16_t*)(ws + L::XCT), G, G - 1 - bx); __syncthreads(); }
            prep::qkv_units(lds, l, (const bf16_t*)(ws + L::P), (const bf16_t*)(ws + L::WUQT), (const bf16_t*)(ws + L::WUKVT), ARG_IN(20) + l * 768, ARG_IN(21) + l * 256,
                            (bf16_t*)(ws + L::QL), (bf16_t*)(ws + L::QC), (bf16_t*)(ws + L::KB), (bf16_t*)(ws + L::VTG), (bf16_t*)(ws + L::MIX), G, bx);
            __syncthreads();
            lru::chunk_units(lds, l, (const bf16_t*)(ws + L::P), ARG_IN(9), ARG_IN(10), (const bf16_t*)(ws + L::WAT), (const bf16_t*)(ws + L::WIT), ARG_IN(12), ARG_IN(14), ARG_IN(15),
                             (bf16_t*)(ws + L::HL), (bf16_t*)(ws + L::AC), (float*)(ws + L::SUM), G, bx);
        } else if (pl == PL_MIX) {
            lru::fixup_units(l, (const bf16_t*)(ws + L::P), (const bf16_t*)(ws + L::HL), (const bf16_t*)(ws + L::AC), (const float*)(ws + L::SUM), (bf16_t*)(ws + L::MIX), G, bx);
            fft::stage_b(lds, (const bf16_t*)(ws + L::ZBUF), (const float*)(ws + L::TABC), (const float*)(ws + L::TABS), (bf16_t*)(ws + L::MIX), G, bx);
            __syncthreads();
            if (l == 0) { fft::ctx_b(lds, (const bf16_t*)(ws + L::XCT), (const float*)(ws + L::TABC), (const float*)(ws + L::TABS), (bf16_t*)(ws + L::MIX), G, G - 1 - bx); __syncthreads(); }
            attn::attn_phase(lds, (const bf16_t*)(ws + L::QL), (const bf16_t*)(ws + L::QC), (const bf16_t*)(ws + L::KB), (const bf16_t*)(ws + L::VTG), (bf16_t*)(ws + L::MIX), l == 0 ? 1 : 0, G, vcu);
        } else if (pl == PL_WOUT) {
            g8::DenseSched S; S.init(l == 0 ? MROWS / 256 : 64, D / 256, G, bx, l == 0 ? 0 : 1, (const bf16_t*)(ws + L::WOUTT) + (size_t)l * D * D, D);
            g8::EpiH E{(float*)(ws + L::H), MODl, 2048};
            g8::gemm_phase<g8::EpiH, g8::DenseSched, false, false>(lds, (const char*)(ws + L::MIX), S, E);
        } else if (pl == PL_ROUTE) {
            sm::route_phase(lds, l, (const float*)(ws + L::H), ARG_IN(7) + l * D, MODl, ARG_IN(23) + (size_t)l * D * NE, ARG_IN(24) + l * NE, (bf16_t*)(ws + L::XN), (int*)(ctl + L::CW_CNT) + l * NE * L::CNT_STRIDE,
                            (int*)(ws + L::LIST) + (size_t)l * NE * LCAP, (float*)(ws + L::GATE), G, bx, tid);
        } else if (pl == PL_COMB) {
            sm::comb_phase(l, (float*)(ws + L::H), (const bf16_t*)(ws + L::Y), MODl, ARG_IN(6) + D, (const float*)(ws + L::MOD) + (size_t)5 * 6144, (bf16_t*)(ws + L::XN), ARG_IN(29), args.out, bx * NWAVES + wave, G * NWAVES, lane);
        } else if (pl == PL_MOE1 || pl == PL_MOE2) {
            const int* CNTg = (const int*)(ctl + L::CW_CNT) + l * NE * L::CNT_STRIDE;
            if (tid == 0) { int o = 0; for (int e = 0; e < NE; ++e) { const int cn = CNTg[e * L::CNT_STRIDE]; META[e] = o; META[64 + e] = cn; o += (cn + 255) >> 8; } META[NE] = o; }
            __syncthreads();
            g8::MoeSched S; S.tpre = META; S.cnt = META + 64; S.G = G; S.c = bx; S.K = D; S.list = (const int*)(ws + L::LIST) + (size_t)l * NE * LCAP;
            if (pl == PL_MOE1) {
                S.NT = 8; S.COLW = 128; S.total = __builtin_amdgcn_readfirstlane(META[NE]) * 8; S.Bt = (const char*)((const bf16_t*)(ws + L::WGUT) + (size_t)l * NE * 2048 * D);
                g8::EpiMoe1 E{(bf16_t*)(ws + L::ACT), ARG_IN(26) + (size_t)l * NE * 2048};
                g8::gemm_phase<g8::EpiMoe1, g8::MoeSched, true, true>(lds, (const char*)(ws + L::XN), S, E);
            } else {
                S.NT = 4; S.COLW = 256; S.total = __builtin_amdgcn_readfirstlane(META[NE]) * 4; S.Bt = (const char*)((const bf16_t*)(ws + L::WDT) + (size_t)l * NE * D * D);
                g8::EpiMoe2 E{(bf16_t*)(ws + L::Y), ARG_IN(28) + (size_t)l * NE * D, (const float*)(ws + L::GATE)};
                g8::gemm_phase<g8::EpiMoe2, g8::MoeSched, false, true>(lds, (const char*)(ws + L::ACT), S, E);
            }
            __syncthreads();
        }
      }
    }
}
constexpr int PROBE_DUP_PH = -1, PROBE_DUP_N = 0;
constexpr int PROBE_NPASS = 1, PROBE_SKIP = 0;
extern "C" void kernel_launch(void* const* d_in, const int* in_sizes, int n_in, void* d_out, int out_size, void* d_ws, size_t ws_size, hipStream_t stream) {
    static int grid = 0;
    if (grid == 0) {
        if (n_in != 30 || out_size != NB_ * SEQ * D || (size_t)L::END > ws_size) { fprintf(stderr, "kernel_launch: unexpected problem shape (n_in %d, out %d) or workspace too small (need %zu, have %zu); nothing launched\n", n_in, out_size, (size_t)L::END, ws_size); grid = -1; return; }
        int dev = 0, cus = 0;
        if (hipGetDevice(&dev) != hipSuccess || hipDeviceGetAttribute(&cus, hipDeviceAttributeMultiprocessorCount, dev) != hipSuccess) { fprintf(stderr, "kernel_launch: device query failed\n"); grid = -1; return; }
        if (hipFuncSetAttribute((const void*)mega, hipFuncAttributeMaxDynamicSharedMemorySize, LDS_BYTES) != hipSuccess) { fprintf(stderr, "kernel_launch: hipFuncSetAttribute failed\n"); grid = -1; return; }
        grid = cus < 256 ? cus : 256;
    }
    if (grid < 0) return;
    unsigned char* p = (unsigned char*)d_ws;
    (void)hipMemsetAsync(p + L::CTL, 0, L::CTL_BYTES, stream);
    MArgs a{};
    for (int i = 0; i < 30; ++i) a.in[i] = (const float*)d_in[i];
    a.out = (float*)d_out; a.ws = p; a.npass = PROBE_NPASS; a.skip_mask = PROBE_SKIP; a.dup_ph = PROBE_DUP_PH; a.dup_n = PROBE_DUP_N;
    hipLaunchKernelGGL(mega, dim3(grid), dim3(NWAVES * 64), LDS_BYTES, stream, a);
}
```

```cpp
#include <hip/hip_runtime.h>
#include <cstdint>
#include <cstdio>

typedef unsigned short bf16_t;
constexpr int NB_ = 4, SEQ = 4096, CTX = 256, D = 1024, NPOS = SEQ + CTX, MROWS = NB_ * NPOS;
constexpr int PT = 1952, PP = 2048;
constexpr int NE = 32, TOPK = 4, LCAP = MROWS;
constexpr int NASG = MROWS * TOPK;
constexpr int ACT_ROWS = NASG + NE * 256;
constexpr int C_FN = 0, C_LX = 256, C_LG = 512, C_CQ = 768, C_CKV = 1024, C_KR = 1152, C_SX = 1184, C_SB = 1440, C_SC = 1696;

__device__ __forceinline__ float bf2f(bf16_t v) { return __uint_as_float((unsigned)v << 16); }
__device__ __forceinline__ bf16_t f2bf(float f) { unsigned u = __float_as_uint(f); return (bf16_t)((u + 0x7fffu + ((u >> 16) & 1u)) >> 16); }
__device__ __forceinline__ float wave_sum(float v) {
#pragma unroll
    for (int o = 1; o < 64; o <<= 1) v += __shfl_xor(v, o);
    return v;
}
__device__ __forceinline__ float sigmoidf_(float x) { return 1.f / (1.f + __expf(-x)); }
__device__ __forceinline__ float gelu_tanh(float x) { const float u = 0.7978845608028654f * (x + 0.044715f * x * x * x); return 0.5f * x * (1.f + tanhf(u)); }

#define LAS __attribute__((address_space(3)))
typedef short bf16x8 __attribute__((ext_vector_type(8)));
typedef float f32x4 __attribute__((ext_vector_type(4)));
typedef unsigned u32x4 __attribute__((ext_vector_type(4)));
typedef unsigned u32x2 __attribute__((ext_vector_type(2)));
__device__ __forceinline__ unsigned pk2(float lo, float hi) { return (unsigned)f2bf(lo) | ((unsigned)f2bf(hi) << 16); }

namespace L {
constexpr size_t A256(size_t x) { return (x + 255) & ~(size_t)255; }
constexpr size_t CTL = 0, CTL_BYTES = 1u << 20;
constexpr size_t H = CTL + CTL_BYTES;
constexpr size_t MOD = CTL + 512 * 1024;
constexpr size_t TABC = A256(H + (size_t)MROWS * D * 4);
constexpr size_t TABS = A256(TABC + 4096 * 4);
constexpr size_t XN = A256(TABS + 4096 * 4);
constexpr size_t P = A256(XN + (size_t)MROWS * D * 2);
constexpr size_t MIX = A256(P + (size_t)MROWS * PP * 2);
constexpr size_t CQN = A256(MIX + (size_t)MROWS * D * 2);
constexpr size_t CKVN = A256(CQN + (size_t)MROWS * 256 * 2);
constexpr size_t QRAW = A256(CKVN + (size_t)MROWS * 128 * 2);
constexpr size_t KVRAW = A256(QRAW + (size_t)MROWS * 384 * 4);
constexpr size_t QL = A256(KVRAW + (size_t)MROWS * 512 * 4);
constexpr size_t QC = A256(QL + (size_t)16 * SEQ * 96 * 2);
constexpr size_t KB = A256(QC + (size_t)16 * CTX * 96 * 2);
constexpr size_t VB = A256(KB + (size_t)16 * NPOS * 96 * 2);
constexpr size_t LA = A256(VB + (size_t)16 * NPOS * 64 * 2);
constexpr size_t LB = A256(LA + (size_t)2 * MROWS * 256 * 4);
constexpr size_t HS = A256(LB + (size_t)2 * MROWS * 256 * 4);
constexpr size_t XCS = A256(HS + (size_t)2 * MROWS * 256 * 4);
constexpr size_t XCSC = A256(XCS + (size_t)4 * 8192 * 256 * 4);
constexpr size_t LIST = A256(XCSC + (size_t)4 * 512 * 256 * 4);
constexpr size_t GATE = A256(LIST + (size_t)2 * NE * LCAP * 4);
constexpr size_t ACT = A256(GATE + (size_t)NASG * 4);
constexpr size_t Y = A256(ACT + (size_t)ACT_ROWS * D * 2);
constexpr size_t WINT = A256(Y + (size_t)NASG * D * 2);
constexpr size_t WOUTT = A256(WINT + (size_t)2 * 2048 * 1024 * 2);
constexpr size_t WGUT = A256(WOUTT + (size_t)2 * 1024 * 1024 * 2);
constexpr size_t WDT = A256(WGUT + (size_t)2 * NE * 2048 * 1024 * 2);
constexpr size_t ZBUF = A256(WDT + (size_t)2 * NE * 1024 * 1024 * 2);
constexpr size_t VTG = A256(ZBUF + (size_t)4 * 64 * 64 * 512 * 2);
constexpr size_t WUQT = A256(VTG + (size_t)16 * 64 * NPOS * 2);
constexpr size_t WUKVT = A256(WUQT + (size_t)2 * 384 * 256 * 2);
constexpr size_t WAT = A256(WUKVT + (size_t)2 * 512 * 128 * 2);
constexpr size_t WIT = A256(WAT + (size_t)16 * 4096 * 2);
constexpr size_t HL = A256(WIT + (size_t)16 * 4096 * 2);
constexpr size_t AC = A256(HL + (size_t)2 * MROWS * 256 * 2);
constexpr size_t SUM = A256(AC + (size_t)2 * MROWS * 256 * 2);
constexpr size_t XCT = A256(SUM + (size_t)2 * 4 * 68 * 512 * 4);
constexpr size_t END = A256(XCT + (size_t)16 * 512 * 64 * 2);
constexpr int CW_BAR = 4096;
constexpr int CW_CNT = 32768, CNT_STRIDE = 64;
}

#define XB_TMO      128
#define XB_XCNT(j)  (256  + 64 * (j))
#define XB_XSUB(j)  (1280 + 64 * (j))
#define XB_XGEN(j)  (2304 + 64 * (j))
#define XB_TOP      3328
#define XB_TOPGEN   3392
#define XCD_BAR_WORDS 3456
#define XB_SPIN_CAP (1u << 18)
__device__ __forceinline__ unsigned xb_ld(unsigned* p)              { return __hip_atomic_load(p, __ATOMIC_RELAXED, __HIP_MEMORY_SCOPE_AGENT); }
__device__ __forceinline__ unsigned xb_add(unsigned* p, unsigned v) { return __hip_atomic_fetch_add(p, v, __ATOMIC_RELAXED, __HIP_MEMORY_SCOPE_AGENT); }
__device__ __forceinline__ unsigned xb_xcc_id() { return (unsigned)__builtin_amdgcn_s_getreg((3 << 11) | 20) & 0xFu; }
#define XB_SPIN(cond, bar) do { unsigned _sp = 0; while (cond) { __builtin_amdgcn_s_sleep(1); \
    if ((++_sp & 255u) == 0u) { if (xb_ld(&(bar)[XB_TMO])) break; if (_sp > XB_SPIN_CAP) { atomicAdd(&(bar)[XB_TMO], 1u); break; } } } } while (0)
struct XcdBarrier { unsigned* bar; unsigned x; volatile LAS unsigned* st; };
__device__ __forceinline__ XcdBarrier xcd_barrier_post(unsigned* bar, volatile LAS unsigned* st) {
    XcdBarrier b; b.bar = bar; b.x = xb_xcc_id(); b.st = st;
    if (threadIdx.x == 0) (void)xb_add(&bar[XB_XCNT(b.x)], 1u);
    return b;
}
__device__ __forceinline__ void xcd_barrier_complete(unsigned* bar, unsigned x, unsigned& nloc, unsigned& nx) {
    const unsigned G = gridDim.x * gridDim.y * gridDim.z;
    unsigned sum, cnt, mine, sp = 0u;
    for (;;) {
        sum = 0u; cnt = 0u; mine = 0u;
#pragma unroll
        for (unsigned j = 0; j < 16; ++j) { const unsigned c = xb_ld(&bar[XB_XCNT(j)]); sum += c; cnt += (c > 0u) ? 1u : 0u; mine = (j == x) ? c : mine; }
        if (sum == G) break;
        __builtin_amdgcn_s_sleep(1);
        if ((++sp & 255u) == 0u) { if (xb_ld(&bar[XB_TMO])) break; if (sp > XB_SPIN_CAP) { atomicAdd(&bar[XB_TMO], 1u); break; } }
    }
    nloc = mine > 0u ? mine : 1u; nx = cnt > 0u ? cnt : 1u;
}
__device__ __forceinline__ void xcd_barrier(const XcdBarrier& b) {
    asm volatile("s_waitcnt vmcnt(0)" ::: "memory");
    __syncthreads();
    if (threadIdx.x == 0) {
        unsigned* bar = b.bar;
        __builtin_amdgcn_s_waitcnt(0);
        unsigned nloc = b.st[0], nx = b.st[1];
        if (nloc == 0u) { xcd_barrier_complete(bar, b.x, nloc, nx); b.st[0] = nloc; b.st[1] = nx; }
        const unsigned old = xb_add(&bar[XB_XSUB(b.x)], 1u);
        const unsigned gen = old / nloc;
        if (old + 1u == (gen + 1u) * nloc) {
            __builtin_amdgcn_fence(__ATOMIC_RELEASE, "agent");
            asm volatile("s_waitcnt vmcnt(0)" ::: "memory");
            const unsigned og = xb_add(&bar[XB_TOP], 1u);
            const unsigned tg = og / nx;
            if (og + 1u == (tg + 1u) * nx) xb_add(&bar[XB_TOPGEN], 1u);
            else XB_SPIN(xb_ld(&bar[XB_TOPGEN]) == tg, bar);
            __builtin_amdgcn_fence(__ATOMIC_ACQUIRE, "agent");
            xb_add(&bar[XB_XGEN(b.x)], 1u);
            asm volatile("s_waitcnt vmcnt(0)" ::: "memory");
        } else {
            XB_SPIN(xb_ld(&bar[XB_XGEN(b.x)]) == gen, bar);
            __builtin_amdgcn_fence(__ATOMIC_ACQUIRE, "agent");
            asm volatile("s_waitcnt vmcnt(0)" ::: "memory");
        }
    }
    __syncthreads();
}

namespace g8 {
constexpr int BM = 256, BK = 64, HALF = 128, HTB = HALF * BK * 2, STAGE_BYTES = 8 * HTB, NXCD = 8, WGM = 8;
__device__ __forceinline__ int lds_byte(int r, int c) { const int st = (r >> 4) * 2 + (c >> 5), rr = r & 15, cc = c & 31, ob = rr * 64 + cc * 2; return st * 1024 + (ob ^ (((ob >> 9) & 1) << 5)); }
__device__ __forceinline__ void stage_rc(int b, int& R, int& C) { const int st = b / 1024, sb = b % 1024, swz = sb ^ (((sb >> 9) & 1) << 5); R = (st >> 1) * 16 + swz / 64; C = (st & 1) * 32 + (swz % 64) / 2; }
__device__ __forceinline__ int perm32(int rho) { const int n = rho >> 4, i = rho & 15; return 8 * (i >> 2) + 4 * n + (i & 3); }
__device__ __forceinline__ unsigned cvt_pk_bf16(float lo, float hi) { unsigned r; asm volatile("v_cvt_pk_bf16_f32 %0, %1, %2" : "=v"(r) : "v"(lo), "v"(hi)); return r; }
__device__ __forceinline__ int xcd_remap(int wgid, int nwg) { const int q = nwg / NXCD, r = nwg % NXCD, xcd = wgid % NXCD, off = wgid / NXCD; return (xcd < r ? xcd * (q + 1) : r * (q + 1) + (xcd - r) * q) + off; }

struct Unit { int row0, col0, ex, bt, nvalid, lrow; };

struct DenseSched {
    int nM, nN, nwg, G, c, lat_only; const char* Bt; int K; const int* list;
    __device__ __forceinline__ void init(int nM_, int nN_, int G_, int c_, int lat_only_, const void* Bt_, int K_) { nM = nM_; nN = nN_; nwg = nM * nN; G = G_; c = c_; lat_only = lat_only_; Bt = (const char*)Bt_; K = K_; list = nullptr; }
    __device__ __forceinline__ bool next(int i, Unit& u) const {
        const long Lx = (long)i * G + c; if (Lx >= nwg) return false;
        const int wgid = xcd_remap((int)Lx, nwg);
        const int nig = WGM * nN, gid = wgid / nig, fm = gid * WGM, gsz = (nM - fm) < WGM ? (nM - fm) : WGM;
        const int pm = fm + ((wgid % nig) % gsz), pn = (wgid % nig) / gsz;
        const int tile = lat_only ? (pm / 16) * 17 + 1 + (pm % 16) : pm;
        u.row0 = tile * 256; u.col0 = pn * 256; u.ex = 0; u.bt = pn; u.nvalid = 256; u.lrow = 0; return true;
    }
    __device__ __forceinline__ const char* bptr(const Unit& u) const { return Bt + (size_t)u.bt * (256 * 1024 * 2); }
};
struct MoeSched {
    const LAS int* tpre; const LAS int* cnt; int NT, COLW, G, c, total; const char* Bt; int K; const int* list;
    __device__ __forceinline__ bool next(int i, Unit& u) const {
        const long Lx = (long)i * G + c; if (Lx >= total) return false;
        const int wgid = xcd_remap((int)Lx, total);
        int e = 0;
        for (int j = 1; j < NE; ++j) if (tpre[j] * NT <= wgid) e = j;
        const int t0 = tpre[e], mte = tpre[e + 1] - t0, loc = wgid - t0 * NT, nt = loc / mte, mt = loc % mte;
        u.ex = __builtin_amdgcn_readfirstlane(e); u.row0 = __builtin_amdgcn_readfirstlane((t0 + mt) * 256); u.col0 = __builtin_amdgcn_readfirstlane(nt * COLW);
        u.bt = __builtin_amdgcn_readfirstlane(e * NT + nt); const int nv = cnt[e] - mt * 256; u.nvalid = __builtin_amdgcn_readfirstlane(nv < 256 ? nv : 256); u.lrow = __builtin_amdgcn_readfirstlane(mt * 256);
        return true;
    }
    __device__ __forceinline__ const char* bptr(const Unit& u) const { return Bt + (size_t)u.bt * (256 * 1024 * 2); }
};

struct EpiP {
    static constexpr bool PERM = true; bf16_t* O;
    __device__ __forceinline__ void operator()(const f32x4 (&acc)[2][2][4][2], const Unit& u, int wr, int wc, int fr, int fq, const LAS int*) const {
#pragma unroll
        for (int ai = 0; ai < 2; ++ai)
#pragma unroll
            for (int m = 0; m < 4; ++m) { bf16_t* rowp = O + (size_t)(u.row0 + ai * HALF + wr * 64 + m * 16 + fr) * PP + u.col0 + wc * 32 + 8 * fq;
#pragma unroll
                for (int bj = 0; bj < 2; ++bj) { const f32x4 v0 = acc[ai][bj][m][0], v1 = acc[ai][bj][m][1]; u32x4 w; w.x = cvt_pk_bf16(v0[0], v0[1]); w.y = cvt_pk_bf16(v0[2], v0[3]); w.z = cvt_pk_bf16(v1[0], v1[1]); w.w = cvt_pk_bf16(v1[2], v1[3]);
                    *(u32x4*)(rowp + bj * HALF) = w; } }
    }
};
struct EpiH {
    static constexpr bool PERM = false; float* Hh; const float* MODl; int g_off;
    __device__ __forceinline__ void operator()(const f32x4 (&acc)[2][2][4][2], const Unit& u, int wr, int wc, int fr, int fq, const LAS int*) const {
        const int tile = u.row0 >> 8, v = (tile % 17 == 0) ? 4 : tile / 17; const float* gp = MODl + (size_t)v * 6144 + g_off + u.col0 + wc * 32 + 4 * fq;
        f32x4 gv[2][2];
#pragma unroll
        for (int bj = 0; bj < 2; ++bj)
#pragma unroll
            for (int n = 0; n < 2; ++n) gv[bj][n] = *(const f32x4*)(gp + bj * HALF + n * 16);
#pragma unroll
        for (int ai = 0; ai < 2; ++ai)
#pragma unroll
            for (int m = 0; m < 4; ++m) { float* rowp = Hh + (size_t)(u.row0 + ai * HALF + wr * 64 + m * 16 + fr) * D + u.col0 + wc * 32 + 4 * fq;
#pragma unroll
                for (int bj = 0; bj < 2; ++bj)
#pragma unroll
                    for (int n = 0; n < 2; ++n) { f32x4* p = (f32x4*)(rowp + bj * HALF + n * 16); *p = *p + gv[bj][n] * acc[ai][bj][m][n]; } }
    }
};
struct EpiMoe1 {
    static constexpr bool PERM = true; bf16_t* ACTp; const float* bgu;
    __device__ __forceinline__ void operator()(const f32x4 (&acc)[2][2][4][2], const Unit& u, int wr, int wc, int fr, int fq, const LAS int*) const {
        const int cc = u.col0 + wc * 32 + 8 * fq; const float* bp = bgu + (size_t)u.ex * 2048 + cc;
        f32x4 bg[2], bu[2];
#pragma unroll
        for (int n = 0; n < 2; ++n) { bg[n] = *(const f32x4*)(bp + 4 * n); bu[n] = *(const f32x4*)(bp + 1024 + 4 * n); }
#pragma unroll
        for (int ai = 0; ai < 2; ++ai)
#pragma unroll
            for (int m = 0; m < 4; ++m) { const int r = ai * HALF + wr * 64 + m * 16 + fr;
                float o[8];
#pragma unroll
                for (int n = 0; n < 2; ++n)
#pragma unroll
                    for (int i = 0; i < 4; ++i) { const float g = fminf(acc[ai][0][m][n][i] + bg[n][i], 7.f); const float uu = fminf(fmaxf(acc[ai][1][m][n][i] + bu[n][i], -7.f), 7.f);
                        o[n * 4 + i] = (uu + 1.f) * g * __builtin_amdgcn_rcpf(1.f + __expf(-1.702f * g)); }
                if (r < u.nvalid) { u32x4 w; w.x = cvt_pk_bf16(o[0], o[1]); w.y = cvt_pk_bf16(o[2], o[3]); w.z = cvt_pk_bf16(o[4], o[5]); w.w = cvt_pk_bf16(o[6], o[7]);
                    *(u32x4*)(ACTp + (size_t)(u.row0 + r) * D + cc) = w; } }
    }
};
struct EpiMoe2 {
    static constexpr bool PERM = true; bf16_t* Yp; const float* bd; const float* GATEp;
    __device__ __forceinline__ void operator()(const f32x4 (&acc)[2][2][4][2], const Unit& u, int wr, int wc, int fr, int fq, const LAS int* rows) const {
        const int cc = u.col0 + wc * 32 + 8 * fq; const float* bp = bd + (size_t)u.ex * 1024 + cc;
        f32x4 bv[2][2];
#pragma unroll
        for (int bj = 0; bj < 2; ++bj)
#pragma unroll
            for (int n = 0; n < 2; ++n) bv[bj][n] = *(const f32x4*)(bp + bj * HALF + 4 * n);
#pragma unroll
        for (int ai = 0; ai < 2; ++ai)
#pragma unroll
            for (int m = 0; m < 4; ++m) { const int r = ai * HALF + wr * 64 + m * 16 + fr;
                if (r < u.nvalid) { const int asg = rows[r]; const float gt = GATEp[asg]; bf16_t* rowp = Yp + (size_t)asg * D + cc;
#pragma unroll
                    for (int bj = 0; bj < 2; ++bj) { const f32x4 v0 = (acc[ai][bj][m][0] + bv[bj][0]) * gt, v1 = (acc[ai][bj][m][1] + bv[bj][1]) * gt;
                        u32x4 w; w.x = cvt_pk_bf16(v0[0], v0[1]); w.y = cvt_pk_bf16(v0[2], v0[3]); w.z = cvt_pk_bf16(v1[0], v1[1]); w.w = cvt_pk_bf16(v1[2], v1[3]); *(u32x4*)(rowp + bj * HALF) = w; } } }
    }
};

template <class Epi, class Sched, bool GATHER, bool ROWLIST>
__device__ __forceinline__ void gemm_phase(LAS unsigned char* lds, const char* Abase, const Sched& S, const Epi& E) {
    constexpr int K = 1024;
    int tid_l = threadIdx.x; asm volatile("" : "+v"(tid_l));
    const int tid = tid_l, wid = __builtin_amdgcn_readfirstlane(tid >> 6), lane = tid & 63, wr = wid >> 2, wc = wid & 3, fr = lane & 15, fq = lane >> 4;
    constexpr int nt = K / BK; constexpr unsigned Kb = (unsigned)K * 2u;
    unsigned voffB[2];
#pragma unroll
    for (int i = 0; i < 2; ++i) { int R, C; stage_rc(tid * 16 + i * 8192, R, C); const int Rb = Epi::PERM ? ((R & ~31) + perm32(R & 31)) : R; voffB[i] = (unsigned)(Rb * K + C) * 2u; }
    constexpr size_t kstep = (size_t)(BK * 2), hstep = (size_t)HALF * K * 2;
    const unsigned ldsw = (unsigned)wid * 1024u;
    const int aoff = lds_byte(wr * 64 + fr, fq * 8), boff = lds_byte(wc * 32 + fr, fq * 8);
    LAS int* rowbuf = (LAS int*)(lds + STAGE_BYTES);
#define G8_SA(b, h) (((b) * 2 + (h)) * HTB)
#define G8_SB(b, h) ((4 + (b) * 2 + (h)) * HTB)
#define G8_STAGE_A(bufoff, kb, v) do { _Pragma("unroll") for (int _i = 0; _i < 2; ++_i) \
        __builtin_amdgcn_global_load_lds((const unsigned*)((kb) + (size_t)(v)[_i]), (LAS unsigned*)(lds + (bufoff) + ldsw + _i * 8192), 16, 0, 0); } while (0)
#define G8_STAGE_B(bufoff, gbase) do { _Pragma("unroll") for (int _i = 0; _i < 2; ++_i) \
        __builtin_amdgcn_global_load_lds((const unsigned*)((gbase) + voffB[_i]), (LAS unsigned*)(lds + (bufoff) + ldsw + _i * 8192), 16, 0, 0); } while (0)
#define G8_LDA(dst, b, h) do { _Pragma("unroll") for (int m = 0; m < 4; ++m) _Pragma("unroll") for (int k = 0; k < 2; ++k) dst[m][k] = *(const LAS bf16x8*)(lds + G8_SA(b, h) + aoff + m * 2048 + k * 1024); } while (0)
#define G8_LDB(dst, b, h) do { _Pragma("unroll") for (int n = 0; n < 2; ++n) _Pragma("unroll") for (int k = 0; k < 2; ++k) dst[n][k] = *(const LAS bf16x8*)(lds + G8_SB(b, h) + boff + n * 2048 + k * 1024); } while (0)
#define G8_MMA(ai, bj, At, Bt) do { __builtin_amdgcn_s_setprio(1); _Pragma("unroll") for (int m = 0; m < 4; ++m) _Pragma("unroll") for (int n = 0; n < 2; ++n) _Pragma("unroll") for (int k = 0; k < 2; ++k) \
        acc[ai][bj][m][n] = __builtin_amdgcn_mfma_f32_16x16x32_bf16(Bt[n][k], At[m][k], acc[ai][bj][m][n], 0, 0, 0); __builtin_amdgcn_s_setprio(0); } while (0)
#define G8_WAIT_V(n) asm volatile("s_waitcnt vmcnt(" #n ")" ::: "memory")
#define G8_WAIT_L(n) asm volatile("s_waitcnt lgkmcnt(" #n ")" ::: "memory")
#define G8_BAR __builtin_amdgcn_s_barrier()
#define G8_SCHED __builtin_amdgcn_sched_barrier(0)
#define G8_LISTDMA(u, s) do { if (wid < 4) __builtin_amdgcn_global_load_lds((const unsigned*)(S.list + (size_t)(u).ex * LCAP + (u).lrow + wid * 64 + lane), (LAS unsigned*)(rowbuf + (s) * 256 + wid * 64), 4, 0, 0); } while (0)
#define G8_ROWS_DENSE(v) do { _Pragma("unroll") for (int _i = 0; _i < 2; ++_i) { int _R, _C; stage_rc(tid * 16 + _i * 8192, _R, _C); _Pragma("unroll") for (int _h = 0; _h < 2; ++_h) (v)[_h][_i] = (unsigned)(_h * HALF + _R) * Kb + (unsigned)_C * 2u; } } while (0)
#define G8_ROWS_LIST(v, u, s) do { _Pragma("unroll") for (int _i = 0; _i < 2; ++_i) { int _R, _C; stage_rc(tid * 16 + _i * 8192, _R, _C); _Pragma("unroll") for (int _h = 0; _h < 2; ++_h) { const int _r = _h * HALF + _R; const int _a = rowbuf[(s) * 256 + _r]; \
        (v)[_h][_i] = (unsigned)(_r < (u).nvalid ? (_a >> 2) : 0) * Kb + (unsigned)_C * 2u; } } } while (0)
    Unit cur, nxt; int ui = 0, slot = 0;
    if (!S.next(0, cur)) return;
    unsigned vA[2][2];
    if constexpr (ROWLIST) { G8_LISTDMA(cur, 0); G8_WAIT_V(0); G8_BAR; }
    if constexpr (GATHER) { G8_ROWS_LIST(vA, cur, 0); } else { G8_ROWS_DENSE(vA); }
    f32x4 acc[2][2][4][2];
#pragma unroll
    for (int a = 0; a < 2; ++a)
#pragma unroll
        for (int b = 0; b < 2; ++b)
#pragma unroll
            for (int m = 0; m < 4; ++m)
#pragma unroll
                for (int n = 0; n < 2; ++n) acc[a][b][m][n] = (f32x4){0.f, 0.f, 0.f, 0.f};
    bf16x8 At[4][2], B0[2][2], B1[2][2];
    const char* cB = S.bptr(cur);
    const char* cA = GATHER ? Abase : Abase + (size_t)cur.row0 * Kb;
    G8_STAGE_B(G8_SB(0, 0), cB); G8_STAGE_B(G8_SB(0, 1), cB + hstep); G8_STAGE_A(G8_SA(0, 0), cA, vA[0]); G8_STAGE_A(G8_SA(0, 1), cA, vA[1]);
    if (wr == 1) G8_BAR;
    G8_WAIT_V(2); G8_BAR;
    G8_STAGE_B(G8_SB(1, 0), cB + kstep); G8_STAGE_A(G8_SA(1, 0), cA + kstep, vA[0]); G8_STAGE_B(G8_SB(1, 1), cB + hstep + kstep);
    G8_WAIT_V(6); G8_BAR;
    for (;;) {
        const bool has_next = S.next(ui + 1, nxt);
        const char* nB = has_next ? S.bptr(nxt) : cB;
        const char* nA = (GATHER || !has_next) ? cA : Abase + (size_t)nxt.row0 * Kb;
        const int nslot = slot == 2 ? 0 : slot + 1;
        if constexpr (ROWLIST) { if (has_next) G8_LISTDMA(nxt, nslot); }
        for (int t = 0; t < nt; t += 2) {
            const bool last = (t == nt - 2);
            const char* a1 = cA + (size_t)(t + 1) * kstep;
            const char* a2 = last ? nA : cA + (size_t)(t + 2) * kstep; const char* b2 = last ? nB : cB + (size_t)(t + 2) * kstep;
            const char* a3 = a2 + kstep; const char* b3 = b2 + kstep;
            G8_LDB(B0, 0, 0); G8_LDB(B1, 0, 1); G8_SCHED; G8_LDA(At, 0, 0); G8_STAGE_A(G8_SA(1, 1), a1, vA[1]);
            if constexpr (GATHER) { if (last && has_next) { G8_ROWS_LIST(vA, nxt, nslot); } }
            G8_WAIT_V(8); G8_WAIT_L(0); G8_BAR; G8_MMA(0, 0, At, B0); G8_MMA(0, 1, At, B1); G8_BAR; G8_SCHED;
            G8_LDA(At, 0, 1); G8_STAGE_B(G8_SB(0, 0), b2); G8_STAGE_B(G8_SB(0, 1), b2 + hstep); G8_STAGE_A(G8_SA(0, 0), a2, vA[0]);
            G8_WAIT_V(8); G8_WAIT_L(0); G8_BAR; G8_MMA(1, 0, At, B0); G8_MMA(1, 1, At, B1); G8_BAR; G8_SCHED;
            G8_LDB(B0, 1, 0); G8_LDB(B1, 1, 1); G8_SCHED; G8_LDA(At, 1, 0); G8_STAGE_A(G8_SA(0, 1), a2, vA[1]);
            G8_WAIT_V(8); G8_WAIT_L(0); G8_BAR; G8_MMA(0, 0, At, B0); G8_MMA(0, 1, At, B1); G8_BAR; G8_SCHED;
            G8_LDA(At, 1, 1); G8_STAGE_B(G8_SB(1, 0), b3); G8_STAGE_B(G8_SB(1, 1), b3 + hstep); G8_STAGE_A(G8_SA(1, 0), a3, vA[0]);
            G8_WAIT_V(8); G8_WAIT_L(0); G8_BAR; G8_MMA(1, 0, At, B0); G8_MMA(1, 1, At, B1); G8_BAR; G8_SCHED;
        }
        if (wr == 0) G8_BAR;
        { int t2 = threadIdx.x; asm volatile("" : "+v"(t2));
          const int w2 = __builtin_amdgcn_readfirstlane(t2 >> 6); E(acc, cur, w2 >> 2, w2 & 3, t2 & 15, (t2 & 63) >> 4, rowbuf + slot * 256); }
        if (!has_next) break;
#pragma unroll
        for (int a = 0; a < 2; ++a)
#pragma unroll
            for (int b = 0; b < 2; ++b)
#pragma unroll
                for (int m = 0; m < 4; ++m)
#pragma unroll
                    for (int n = 0; n < 2; ++n) acc[a][b][m][n] = (f32x4){0.f, 0.f, 0.f, 0.f};
        cur = nxt; cB = nB; cA = nA; ++ui; slot = nslot;
        if (wr == 1) G8_BAR;
    }
    G8_WAIT_V(0);
    G8_BAR;
#undef G8_SA
#undef G8_SB
#undef G8_STAGE_A
#undef G8_STAGE_B
#undef G8_LDA
#undef G8_LDB
#undef G8_MMA
#undef G8_WAIT_V
#undef G8_WAIT_L
#undef G8_BAR
#undef G8_SCHED
#undef G8_LISTDMA
#undef G8_ROWS_DENSE
#undef G8_ROWS_LIST
}
}

namespace fft {
constexpr int TP = 72;
constexpr int UP = 264;
constexpr int ZP = 520;
constexpr int O_TC = 0, O_TS = 9216, O_U = 18432, O_X = 52224, O_TW = 125952;
__device__ __forceinline__ bf16x8 neg8(bf16x8 v) { u32x4 w = __builtin_bit_cast(u32x4, v); w = w ^ 0x80008000u; return __builtin_bit_cast(bf16x8, w); }
__device__ __forceinline__ void build_tables(LAS unsigned char* lds, const float* TABC, const float* TABS, int tid) {
    for (int i = tid; i < 4096; i += 512) { const int a = i >> 6, b = i & 63, ix = ((a * b) & 63) * 64;
        ((LAS bf16_t*)(lds + O_TC))[a * TP + b] = f2bf(TABC[ix]); ((LAS bf16_t*)(lds + O_TS))[a * TP + b] = f2bf(TABS[ix]); }
}
__device__ __forceinline__ void stage_a(LAS unsigned char* lds, const bf16_t* P, const float* TABC, const float* TABS, bf16_t* ZBUF, int G, int bx) {
    int tid_l = threadIdx.x; asm volatile("" : "+v"(tid_l));
    const int tid = tid_l, lane = tid & 63, w = __builtin_amdgcn_readfirstlane(tid >> 6), fr = lane & 15, fq = lane >> 4;
    build_tables(lds, TABC, TABS, tid);
    const LAS bf16_t* Tc = (const LAS bf16_t*)(lds + O_TC); const LAS bf16_t* Ts = (const LAS bf16_t*)(lds + O_TS);
    LAS bf16_t* U = (LAS bf16_t*)(lds + O_U); LAS bf16_t* X = (LAS bf16_t*)(lds + O_X); LAS float* TW = (LAS float*)(lds + O_TW);
    for (int unit = bx; unit < 256; unit += G) {
        const int b = unit >> 6, t2 = unit & 63;
#pragma unroll
        for (int i = 0; i < 4; ++i) { const int q = tid + 512 * i, t1 = q >> 5, ch = q & 31;
            *(LAS u32x4*)((LAS unsigned char*)U + t1 * (UP * 2) + ch * 16) = *(const u32x4*)(P + ((size_t)b * NPOS + CTX + 64 * t1 + t2) * PP + ch * 8); }
        if (tid < 64) { const int ix = tid * t2; TW[2 * tid] = TABC[ix]; TW[2 * tid + 1] = TABS[ix]; }
        __syncthreads();
        { const int g = w >> 1, part = w & 1; const LAS bf16_t* T = part ? Ts : Tc;
          f32x4 acc[4][4];
#pragma unroll
          for (int mt = 0; mt < 4; ++mt)
#pragma unroll
              for (int nt = 0; nt < 4; ++nt) acc[mt][nt] = (f32x4){0.f, 0.f, 0.f, 0.f};
#pragma unroll
          for (int ks = 0; ks < 2; ++ks) { bf16x8 a[4], bb[4];
#pragma unroll
              for (int mt = 0; mt < 4; ++mt) a[mt] = *(const LAS bf16x8*)(U + (16 * mt + fr) * UP + g * 64 + 32 * ks + 8 * fq);
#pragma unroll
              for (int nt = 0; nt < 4; ++nt) bb[nt] = *(const LAS bf16x8*)(T + (16 * nt + fr) * TP + 32 * ks + 8 * fq);
#pragma unroll
              for (int mt = 0; mt < 4; ++mt)
#pragma unroll
                  for (int nt = 0; nt < 4; ++nt) acc[mt][nt] = __builtin_amdgcn_mfma_f32_16x16x32_bf16(a[mt], bb[nt], acc[mt][nt], 0, 0, 0); }
          const float sg = part ? -1.f : 1.f;
#pragma unroll
          for (int mt = 0; mt < 4; ++mt)
#pragma unroll
              for (int nt = 0; nt < 4; ++nt) { const f32x4 v = acc[mt][nt] * sg; u32x2 o; o.x = pk2(v[0], v[1]); o.y = pk2(v[2], v[3]);
                  *(LAS u32x2*)(X + (part * 256 + g * 64 + 16 * nt + fr) * TP + 16 * mt + 4 * fq) = o; } }
        __syncthreads();
        f32x4 zr[4][2], zi[4][2];
#pragma unroll
        for (int mt = 0; mt < 4; ++mt)
#pragma unroll
            for (int n = 0; n < 2; ++n) { zr[mt][n] = (f32x4){0.f, 0.f, 0.f, 0.f}; zi[mt][n] = (f32x4){0.f, 0.f, 0.f, 0.f}; }
#pragma unroll
        for (int ks = 0; ks < 2; ++ks) { bf16x8 xr[2], xi[2];
#pragma unroll
            for (int n = 0; n < 2; ++n) { xr[n] = *(const LAS bf16x8*)(X + (32 * w + 16 * n + fr) * TP + 32 * ks + 8 * fq); xi[n] = *(const LAS bf16x8*)(X + (256 + 32 * w + 16 * n + fr) * TP + 32 * ks + 8 * fq); }
#pragma unroll
            for (int mt = 0; mt < 4; ++mt) { const bf16x8 c = *(const LAS bf16x8*)(Tc + (16 * mt + fr) * TP + 32 * ks + 8 * fq), s = *(const LAS bf16x8*)(Ts + (16 * mt + fr) * TP + 32 * ks + 8 * fq), ns = neg8(s);
#pragma unroll
                for (int n = 0; n < 2; ++n) { zr[mt][n] = __builtin_amdgcn_mfma_f32_16x16x32_bf16(c, xr[n], zr[mt][n], 0, 0, 0); zr[mt][n] = __builtin_amdgcn_mfma_f32_16x16x32_bf16(s, xi[n], zr[mt][n], 0, 0, 0);
                    zi[mt][n] = __builtin_amdgcn_mfma_f32_16x16x32_bf16(c, xi[n], zi[mt][n], 0, 0, 0); zi[mt][n] = __builtin_amdgcn_mfma_f32_16x16x32_bf16(ns, xr[n], zi[mt][n], 0, 0, 0); } } }
        __syncthreads();
        { LAS bf16_t* Zs = X;
#pragma unroll
          for (int mt = 0; mt < 4; ++mt)
#pragma unroll
              for (int i = 0; i < 4; ++i) { const int f1 = 16 * mt + 4 * fq + i; const float ct = TW[2 * f1], st = TW[2 * f1 + 1];
#pragma unroll
                  for (int n = 0; n < 2; ++n) { const float a = zr[mt][n][i], bq = zi[mt][n][i]; const int col = 32 * w + 16 * n + fr;
                      Zs[f1 * ZP + col] = f2bf(a * ct + bq * st); Zs[f1 * ZP + 256 + col] = f2bf(bq * ct - a * st); } } }
        __syncthreads();
#pragma unroll
        for (int i = 0; i < 8; ++i) { const int q = tid + 512 * i, f1 = q >> 6, ch = q & 63;
            *(u32x4*)(ZBUF + (((size_t)b * 64 + f1) * 64 + t2) * 512 + ch * 8) = *(const LAS u32x4*)((const LAS unsigned char*)X + f1 * (ZP * 2) + ch * 16); }
        __syncthreads();
    }
}
__device__ __forceinline__ void stage_b(LAS unsigned char* lds, const bf16_t* ZBUF, const float* TABC, const float* TABS, bf16_t* MIX, int G, int bx) {
    int tid_l = threadIdx.x; asm volatile("" : "+v"(tid_l));
    const int tid = tid_l, lane = tid & 63, w = __builtin_amdgcn_readfirstlane(tid >> 6), fr = lane & 15, fq = lane >> 4;
    build_tables(lds, TABC, TABS, tid);
    const LAS bf16_t* Tc = (const LAS bf16_t*)(lds + O_TC); const LAS bf16_t* Ts = (const LAS bf16_t*)(lds + O_TS);
    LAS bf16_t* Ys = (LAS bf16_t*)(lds + O_U); LAS bf16_t* ZT = (LAS bf16_t*)(lds + O_X);
    for (int unit = bx; unit < 256; unit += G) {
        const int b = unit >> 6, f1 = unit & 63;
        const bf16_t* Zg = ZBUF + ((size_t)b * 64 + f1) * 64 * 512;
#pragma unroll
        for (int i = 0; i < 4; ++i) { const int q = tid + 512 * i, p = q & 31, ch = q >> 5;
            const u32x4 r0 = *(const u32x4*)(Zg + (size_t)(2 * p) * 512 + ch * 8), r1 = *(const u32x4*)(Zg + (size_t)(2 * p + 1) * 512 + ch * 8);
#pragma unroll
            for (int j = 0; j < 4; ++j) { const unsigned a = r0[j], c = r1[j];
                *(LAS unsigned*)(ZT + (ch * 8 + 2 * j) * TP + 2 * p) = (a & 0xffffu) | (c << 16);
                *(LAS unsigned*)(ZT + (ch * 8 + 2 * j + 1) * TP + 2 * p) = (a >> 16) | (c & 0xffff0000u); } }
        __syncthreads();
        f32x4 y[4][2];
#pragma unroll
        for (int mt = 0; mt < 4; ++mt)
#pragma unroll
            for (int n = 0; n < 2; ++n) y[mt][n] = (f32x4){0.f, 0.f, 0.f, 0.f};
#pragma unroll
        for (int ks = 0; ks < 2; ++ks) { bf16x8 xr[2], xi[2];
#pragma unroll
            for (int n = 0; n < 2; ++n) { xr[n] = *(const LAS bf16x8*)(ZT + (32 * w + 16 * n + fr) * TP + 32 * ks + 8 * fq); xi[n] = *(const LAS bf16x8*)(ZT + (256 + 32 * w + 16 * n + fr) * TP + 32 * ks + 8 * fq); }
#pragma unroll
            for (int mt = 0; mt < 4; ++mt) { const bf16x8 c = *(const LAS bf16x8*)(Tc + (16 * mt + fr) * TP + 32 * ks + 8 * fq), s = *(const LAS bf16x8*)(Ts + (16 * mt + fr) * TP + 32 * ks + 8 * fq);
#pragma unroll
                for (int n = 0; n < 2; ++n) { y[mt][n] = __builtin_amdgcn_mfma_f32_16x16x32_bf16(c, xr[n], y[mt][n], 0, 0, 0); y[mt][n] = __builtin_amdgcn_mfma_f32_16x16x32_bf16(s, xi[n], y[mt][n], 0, 0, 0); } } }
#pragma unroll
        for (int mt = 0; mt < 4; ++mt)
#pragma unroll
            for (int i = 0; i < 4; ++i)
#pragma unroll
                for (int n = 0; n < 2; ++n) Ys[(16 * mt + 4 * fq + i) * UP + 32 * w + 16 * n + fr] = f2bf(y[mt][n][i] * (1.f / 512.f));
        __syncthreads();
#pragma unroll
        for (int i = 0; i < 4; ++i) { const int q = tid + 512 * i, f2 = q >> 5, ch = q & 31;
            *(u32x4*)(MIX + ((size_t)b * NPOS + CTX + f1 + 64 * f2) * D + ch * 8) = *(const LAS u32x4*)((const LAS unsigned char*)Ys + f2 * (UP * 2) + ch * 16); }
        __syncthreads();
    }
}
}

namespace attn {
typedef float f32x16 __attribute__((ext_vector_type(16)));
typedef float f32x2_t __attribute__((ext_vector_type(2))); typedef __bf16 bf16x2_t __attribute__((ext_vector_type(2)));
__device__ __forceinline__ unsigned cvtpk(float lo, float hi) { f32x2_t v = {lo, hi}; bf16x2_t b = __builtin_convertvector(v, bf16x2_t); return __builtin_bit_cast(unsigned, b); }
constexpr int KP = 104, VP = 68;
constexpr int KT_BYTES = 64 * KP * 2, VT_BYTES = 64 * VP * 2, BUF_BYTES = KT_BYTES + VT_BYTES;
constexpr float C2 = 0.10206207261596577f * 1.4426950408889634f;
__device__ __forceinline__ void attn_phase(LAS unsigned char* lds, const bf16_t* QL, const bf16_t* QC, const bf16_t* KB, const bf16_t* VTG, bf16_t* MIX, int with_ctx, int G, int vcu) {
    int tid_l = threadIdx.x; asm volatile("" : "+v"(tid_l));
    const int tid = tid_l, lane = tid & 63, wid = __builtin_amdgcn_readfirstlane(tid >> 6), r32 = lane & 31, hi = lane >> 5;
    const int nunits = 256 + (with_ctx ? 16 : 0);
    for (int unit = vcu; unit < nunits; unit += G) {
        int bh, nk, orow0; const bf16_t* Qp;
        if (unit < 256) { bh = unit >> 4; const int qb = unit & 15; Qp = QL + ((size_t)bh * SEQ + qb * 256) * 96; nk = NPOS; orow0 = (bh >> 2) * NPOS + CTX + qb * 256; }
        else { bh = unit - 256; Qp = QC + (size_t)bh * CTX * 96; nk = CTX; orow0 = (bh >> 2) * NPOS; }
        const int hh = bh & 3, NT = nk / 64;
        const bf16_t* Kg = KB + (size_t)bh * NPOS * 96; const bf16_t* Vg = VTG + (size_t)bh * 64 * NPOS;
        bf16x8 qf[6];
        { const bf16_t* qp = Qp + (size_t)(wid * 32 + r32) * 96 + 8 * hi;
#pragma unroll
          for (int ds = 0; ds < 6; ++ds) qf[ds] = *(const bf16x8*)(qp + 16 * ds); }
        f32x16 o0 = {}, o1 = {}; float m = -1e30f, l = 0.f;
        const int kr0 = tid / 12, kc0 = tid % 12, kr1 = (tid + 512) / 12, kc1 = (tid + 512) % 12; const bool k1ok = tid < 256;
        const int vd = tid >> 3, vc = tid & 7;
        u32x4 sk0, sk1 = {}, sv;
        sk0 = *(const u32x4*)(Kg + (size_t)kr0 * 96 + kc0 * 8); if (k1ok) sk1 = *(const u32x4*)(Kg + (size_t)kr1 * 96 + kc1 * 8); sv = *(const u32x4*)(Vg + (size_t)vd * NPOS + vc * 8);
        int cur = 0;
        { LAS unsigned char* bp = lds; *(LAS u32x4*)(bp + kr0 * (KP * 2) + kc0 * 16) = sk0; if (k1ok) *(LAS u32x4*)(bp + kr1 * (KP * 2) + kc1 * 16) = sk1; *(LAS u32x4*)(bp + KT_BYTES + vd * (VP * 2) + vc * 16) = sv; }
        __syncthreads();
        for (int t = 0; t < NT; ++t) {
            if (t + 1 < NT) { const size_t k0 = (size_t)(t + 1) * 64;
                sk0 = *(const u32x4*)(Kg + (k0 + kr0) * 96 + kc0 * 8); if (k1ok) sk1 = *(const u32x4*)(Kg + (k0 + kr1) * 96 + kc1 * 8); sv = *(const u32x4*)(Vg + (size_t)vd * NPOS + k0 + vc * 8); }
            const LAS bf16_t* Kt = (const LAS bf16_t*)(lds + cur * BUF_BYTES); const LAS bf16_t* Vt = (const LAS bf16_t*)(lds + cur * BUF_BYTES + KT_BYTES);
            f32x16 p0 = {}, p1 = {};
#pragma unroll
            for (int ds = 0; ds < 6; ++ds) { const bf16x8 k0f = *(const LAS bf16x8*)(Kt + r32 * KP + 16 * ds + 8 * hi), k1f = *(const LAS bf16x8*)(Kt + (32 + r32) * KP + 16 * ds + 8 * hi);
                p0 = __builtin_amdgcn_mfma_f32_32x32x16_bf16(k0f, qf[ds], p0, 0, 0, 0); p1 = __builtin_amdgcn_mfma_f32_32x32x16_bf16(k1f, qf[ds], p1, 0, 0, 0); }
            float mx = fmaxf(p0[0], p1[0]);
#pragma unroll
            for (int r = 1; r < 16; ++r) mx = fmaxf(mx, fmaxf(p0[r], p1[r]));
            mx = fmaxf(mx, __shfl_xor(mx, 32));
            const float mn = fmaxf(m, mx), alpha = __builtin_amdgcn_exp2f(m - mn); m = mn;
            float ls = 0.f;
#pragma unroll
            for (int r = 0; r < 16; ++r) { p0[r] = __builtin_amdgcn_exp2f(p0[r] - mn); p1[r] = __builtin_amdgcn_exp2f(p1[r] - mn); ls += p0[r] + p1[r]; }
            l = l * alpha + ls;
#pragma unroll
            for (int r = 0; r < 16; ++r) { o0[r] *= alpha; o1[r] *= alpha; }
#pragma unroll
            for (int s = 0; s < 4; ++s) {
                u32x4 pw;
#pragma unroll
                for (int j = 0; j < 4; ++j) { const int r = 8 * (s & 1) + 2 * j; pw[j] = (s < 2) ? cvtpk(p0[r], p0[r + 1]) : cvtpk(p1[r], p1[r + 1]); }
                const bf16x8 pf = __builtin_bit_cast(bf16x8, pw);
                const int kvb = 32 * (s >> 1) + 16 * (s & 1) + 4 * hi;
#pragma unroll
                for (int db = 0; db < 2; ++db) { const u32x2 va = *(const LAS u32x2*)(Vt + (32 * db + r32) * VP + kvb), vb = *(const LAS u32x2*)(Vt + (32 * db + r32) * VP + kvb + 8);
                    const u32x4 vw = {va.x, va.y, vb.x, vb.y}; const bf16x8 vf = __builtin_bit_cast(bf16x8, vw);
                    if (db == 0) o0 = __builtin_amdgcn_mfma_f32_32x32x16_bf16(vf, pf, o0, 0, 0, 0); else o1 = __builtin_amdgcn_mfma_f32_32x32x16_bf16(vf, pf, o1, 0, 0, 0); }
            }
            if (t + 1 < NT) { LAS unsigned char* bp = lds + (cur ^ 1) * BUF_BYTES;
                *(LAS u32x4*)(bp + kr0 * (KP * 2) + kc0 * 16) = sk0; if (k1ok) *(LAS u32x4*)(bp + kr1 * (KP * 2) + kc1 * 16) = sk1; *(LAS u32x4*)(bp + KT_BYTES + vd * (VP * 2) + vc * 16) = sv; }
            __syncthreads();
            cur ^= 1;
        }
        l += __shfl_xor(l, 32);
        const float il = 1.f / l;
        bf16_t* op = MIX + (size_t)(orow0 + wid * 32 + r32) * D + 512 + hh * 64 + 4 * hi;
#pragma unroll
        for (int g4 = 0; g4 < 4; ++g4) { u32x2 w0, w1; w0.x = cvtpk(o0[4 * g4] * il, o0[4 * g4 + 1] * il); w0.y = cvtpk(o0[4 * g4 + 2] * il, o0[4 * g4 + 3] * il);
            w1.x = cvtpk(o1[4 * g4] * il, o1[4 * g4 + 1] * il); w1.y = cvtpk(o1[4 * g4 + 2] * il, o1[4 * g4 + 3] * il);
            *(u32x2*)(op + 8 * g4) = w0; *(u32x2*)(op + 32 + 8 * g4) = w1; }
    }
}
}

namespace sm {
__device__ __forceinline__ float silu(float x) { return x / (1.f + __expf(-x)); }
__device__ __forceinline__ void mod_phase(LAS unsigned char* lds, const float* c, const float* c_ctx, const float* mod_w, const float* mod_b, float* MOD, int G, int bx, int tid) {
    LAS float* s = (LAS float*)lds;
    for (int i = tid; i < 5120; i += 512) { const int v = i >> 10, k = i & 1023; s[i] = silu(v < 4 ? c[v * 1024 + k] : c_ctx[k]); }
    __syncthreads();
    LAS float* red = s + 5120;
    for (int unit = bx; unit < 96; unit += G) {
        const int l = unit / 48, cb = unit % 48, cl = tid & 127, col = cb * 128 + cl, kq = tid >> 7, k0 = kq * 256;
        const float* W = mod_w + ((size_t)l * 1024 + k0) * 6144 + col;
        float a0 = 0.f, a1 = 0.f, a2 = 0.f, a3 = 0.f, a4 = 0.f;
#pragma unroll 16
        for (int k = 0; k < 256; ++k) { const float w = W[(size_t)k * 6144]; a0 += s[k0 + k] * w; a1 += s[1024 + k0 + k] * w; a2 += s[2048 + k0 + k] * w; a3 += s[3072 + k0 + k] * w; a4 += s[4096 + k0 + k] * w; }
        LAS float* rq = red + kq * 640 + cl; rq[0] = a0; rq[128] = a1; rq[256] = a2; rq[384] = a3; rq[512] = a4;
        __syncthreads();
        for (int i = tid; i < 640; i += 512) { const int v = i >> 7, cc = i & 127; const float r = ((red[i] + red[640 + i]) + (red[1280 + i] + red[1920 + i])) + mod_b[l * 6144 + cb * 128 + cc];
            MOD[((size_t)l * 5 + v) * 6144 + cb * 128 + cc] = r; }
        __syncthreads();
    }
}
__device__ __forceinline__ void norm_store(const float4 (&x)[4], float ss, const float* g, const float* mv, int sh_off, int sc_off, bf16_t* xn_row, int lane) {
    const float rs = rsqrtf(wave_sum(ss) * (1.f / D) + 1e-6f);
#pragma unroll
    for (int j = 0; j < 4; ++j) { const int c = (j * 64 + lane) * 4; const float4 gg = *(const float4*)(g + c), sh = *(const float4*)(mv + sh_off + c), sc = *(const float4*)(mv + sc_off + c);
        u32x2 o; o.x = pk2(x[j].x * rs * gg.x * (1.f + sc.x) + sh.x, x[j].y * rs * gg.y * (1.f + sc.y) + sh.y); o.y = pk2(x[j].z * rs * gg.z * (1.f + sc.z) + sh.z, x[j].w * rs * gg.w * (1.f + sc.w) + sh.w);
        *(u32x2*)(xn_row + c) = o; }
}
__device__ __forceinline__ void pro1_phase(const float* x, const float* ctx, const float* g, const float* MODl, float* H, bf16_t* XN, int gw, int NGW, int lane) {
    for (int r = gw; r < MROWS; r += NGW) { const int b = r / NPOS, pos = r % NPOS, v = pos < CTX ? 4 : b;
        const float* src = pos < CTX ? ctx + ((size_t)b * CTX + pos) * D : x + ((size_t)b * SEQ + (pos - CTX)) * D;
        float4 xv[4]; float ss = 0.f;
#pragma unroll
        for (int j = 0; j < 4; ++j) { const int c = (j * 64 + lane) * 4; xv[j] = *(const float4*)(src + c); *(float4*)(H + (size_t)r * D + c) = xv[j]; ss += xv[j].x * xv[j].x + xv[j].y * xv[j].y + xv[j].z * xv[j].z + xv[j].w * xv[j].w; }
        norm_store(xv, ss, g, MODl + (size_t)v * 6144, 0, 1024, XN + (size_t)r * D, lane); }
}
__device__ __forceinline__ void comb_phase(int l, float* H, const bf16_t* Y, const float* MODl, const float* g_next, const float* MODn, bf16_t* XN, const float* final_g, float* out, int gw, int NGW, int lane) {
    for (int r = gw; r < MROWS; r += NGW) { const int b = r / NPOS, pos = r % NPOS, v = pos < CTX ? 4 : b;
        if (l == 1 && pos < CTX) continue;
        const float* g2 = MODl + (size_t)v * 6144 + 5120;
        float4 xv[4]; float ss = 0.f;
#pragma unroll
        for (int j = 0; j < 4; ++j) { const int c = (j * 64 + lane) * 4; xv[j] = *(const float4*)(H + (size_t)r * D + c); float4 s = make_float4(0.f, 0.f, 0.f, 0.f);
#pragma unroll
            for (int k = 0; k < 4; ++k) { const u32x2 y = *(const u32x2*)(Y + ((size_t)r * 4 + k) * D + c); s.x += __uint_as_float(y.x << 16); s.y += __uint_as_float(y.x & 0xffff0000u); s.z += __uint_as_float(y.y << 16); s.w += __uint_as_float(y.y & 0xffff0000u); }
            const float4 gg = *(const float4*)(g2 + c); xv[j].x += gg.x * s.x; xv[j].y += gg.y * s.y; xv[j].z += gg.z * s.z; xv[j].w += gg.w * s.w;
            ss += xv[j].x * xv[j].x + xv[j].y * xv[j].y + xv[j].z * xv[j].z + xv[j].w * xv[j].w; }
        if (l == 0) {
#pragma unroll
            for (int j = 0; j < 4; ++j) *(float4*)(H + (size_t)r * D + (j * 64 + lane) * 4) = xv[j];
            norm_store(xv, ss, g_next, MODn + (size_t)v * 6144, 0, 1024, XN + (size_t)r * D, lane);
        } else { const float rs = rsqrtf(wave_sum(ss) * (1.f / D) + 1e-6f); float* op = out + ((size_t)b * SEQ + (pos - CTX)) * D;
#pragma unroll
            for (int j = 0; j < 4; ++j) { const int c = (j * 64 + lane) * 4; const float4 fg = *(const float4*)(final_g + c); float4 o; o.x = xv[j].x * rs * fg.x; o.y = xv[j].y * rs * fg.y; o.z = xv[j].z * rs * fg.z; o.w = xv[j].w * rs * fg.w; *(float4*)(op + c) = o; } }
    }
}
__device__ __forceinline__ void route_phase(LAS unsigned char* lds, int l, const float* H, const float* g, const float* MODl, const float* rw, const float* rb, bf16_t* XN, int* CNT, int* LIST, float* GATE,
                                            int G, int bx, int tid) {
    const int lane = tid & 63, wave = __builtin_amdgcn_readfirstlane(tid >> 6), e = lane & 31, kpart = wave * 2 + (lane >> 5);
    LAS float* F = (LAS float*)lds;
    LAS float* PART = (LAS float*)(lds + 32768);
    LAS int* LCNT = (LAS int*)(lds + 49152);
    LAS int* LBASE = LCNT + 64; LAS int* LENT = LCNT + 128;
    if (tid < 64) LCNT[tid] = 0;
    __syncthreads();
    float w[64];
#pragma unroll
    for (int k = 0; k < 64; ++k) w[k] = rw[(size_t)(kpart * 64 + k) * 32 + e];
    const float bias = rb[e];
    const int nb = l == 1 ? (MROWS - NB_ * CTX) / 8 : MROWS / 8;
    for (int bi = bx; bi < nb; bi += G) {
        int r;
        if (l == 1) { const int q = bi * 8 + wave; r = (q / SEQ) * NPOS + CTX + (q % SEQ); } else r = bi * 8 + wave;
        const int b = r / NPOS, pos = r % NPOS, v = pos < CTX ? 4 : b; const float* mv = MODl + (size_t)v * 6144;
        { float4 xv[4]; float ss = 0.f;
#pragma unroll
          for (int j = 0; j < 4; ++j) { xv[j] = *(const float4*)(H + (size_t)r * D + (j * 64 + lane) * 4); ss += xv[j].x * xv[j].x + xv[j].y * xv[j].y + xv[j].z * xv[j].z + xv[j].w * xv[j].w; }
          const float rs = rsqrtf(wave_sum(ss) * (1.f / D) + 1e-6f);
#pragma unroll
          for (int j = 0; j < 4; ++j) { const int c = (j * 64 + lane) * 4; const float4 gg = *(const float4*)(g + c), sh = *(const float4*)(mv + 3072 + c), sc = *(const float4*)(mv + 4096 + c);
              f32x4 f; f[0] = xv[j].x * rs * gg.x * (1.f + sc.x) + sh.x; f[1] = xv[j].y * rs * gg.y * (1.f + sc.y) + sh.y; f[2] = xv[j].z * rs * gg.z * (1.f + sc.z) + sh.z; f[3] = xv[j].w * rs * gg.w * (1.f + sc.w) + sh.w;
              *(LAS f32x4*)(F + wave * 1024 + c) = f; u32x2 o; o.x = pk2(f[0], f[1]); o.y = pk2(f[2], f[3]); *(u32x2*)(XN + (size_t)r * D + c) = o; } }
        __syncthreads();
        { float acc[8];
#pragma unroll
          for (int rr = 0; rr < 8; ++rr) acc[rr] = 0.f;
#pragma unroll
          for (int k4 = 0; k4 < 16; ++k4) {
#pragma unroll
              for (int rr = 0; rr < 8; ++rr) { const f32x4 f = *(const LAS f32x4*)(F + rr * 1024 + kpart * 64 + k4 * 4); acc[rr] += f[0] * w[k4 * 4] + f[1] * w[k4 * 4 + 1] + f[2] * w[k4 * 4 + 2] + f[3] * w[k4 * 4 + 3]; } }
#pragma unroll
          for (int rr = 0; rr < 8; ++rr) PART[(rr * 16 + kpart) * 32 + e] = acc[rr]; }
        __syncthreads();
        { float lg = bias;
#pragma unroll
          for (int kp = 0; kp < 16; ++kp) lg += PART[(wave * 16 + kp) * 32 + e];
          float val = lane < 32 ? lg : -3e38f; int idx = e; float tv[4]; int ti[4];
#pragma unroll
          for (int k = 0; k < 4; ++k) { float bv = val; int bi2 = idx;
#pragma unroll
              for (int o = 1; o < 32; o <<= 1) { const float ov = __shfl_xor(bv, o); const int oi = __shfl_xor(bi2, o); if (ov > bv || (ov == bv && oi < bi2)) { bv = ov; bi2 = oi; } }
              tv[k] = bv; ti[k] = bi2; if (idx == bi2) val = -3e38f; }
          if (lane == 0) { float ex[4], sum = 0.f;
#pragma unroll
              for (int k = 0; k < 4; ++k) { ex[k] = __expf(tv[k] - tv[0]); sum += ex[k]; }
              const float isum = 1.f / sum;
#pragma unroll
              for (int k = 0; k < 4; ++k) { const int asg = r * 4 + k; GATE[asg] = ex[k] * isum; const int rank = __hip_atomic_fetch_add(&LCNT[ti[k]], 1, __ATOMIC_RELAXED, __HIP_MEMORY_SCOPE_WORKGROUP); const int slot = __hip_atomic_fetch_add(&LCNT[32], 1, __ATOMIC_RELAXED, __HIP_MEMORY_SCOPE_WORKGROUP);
                  LENT[slot * 2] = asg; LENT[slot * 2 + 1] = (ti[k] << 16) | rank; } } }
        __syncthreads();
    }
    if (tid < 32) LBASE[tid] = LCNT[tid] > 0 ? atomicAdd(&CNT[tid * L::CNT_STRIDE], LCNT[tid]) : 0;
    __syncthreads();
    for (int i = tid; i < LCNT[32]; i += 512) { const int asg = LENT[i * 2], er = LENT[i * 2 + 1], ee = er >> 16, rank = er & 0xffff; LIST[(size_t)ee * LCAP + LBASE[ee] + rank] = asg; }
    __syncthreads();
}
__device__ __forceinline__ void smallw_phase(const float* w_uq, const float* qg, const float* w_ukv, const float* kvg, const float* w_a, const float* w_i, bf16_t* WUQT, bf16_t* WUKVT, bf16_t* WAT, bf16_t* WIT,
                                             float* TABC, float* TABS, int gt, int NGT) {
    for (int i = gt; i < 2 * 384 * 256; i += NGT) { const int l = i / (384 * 256), q = i % (384 * 256), n = q >> 8, k = q & 255; WUQT[i] = f2bf(qg[l * 256 + k] * w_uq[((size_t)l * 256 + k) * 384 + n]); }
    for (int i = gt; i < 2 * 512 * 128; i += NGT) { const int l = i / (512 * 128), q = i % (512 * 128), n = q >> 7, k = q & 127; WUKVT[i] = f2bf(kvg[l * 128 + k] * w_ukv[((size_t)l * 128 + k) * 512 + n]); }
    for (int i = gt; i < 16 * 4096; i += NGT) { const int m = i >> 12, q = i & 4095, e = q >> 6, d = q & 63; WAT[i] = f2bf(w_a[(size_t)m * 4096 + d * 64 + e]); WIT[i] = f2bf(w_i[(size_t)m * 4096 + d * 64 + e]); }
    for (int i = gt; i < 4096; i += NGT) { float s, c; sincospif((float)i / 2048.f, &s, &c); TABC[i] = c; TABS[i] = s; }
}
}

namespace prep {
constexpr int O_KR = 0, O_CS = 8192, O_RS = 16384, O_CQ = 16896  , O_KS = 67072, O_CKV = 100864;
constexpr int CQP = 264, CKP = 136, QSP = 392, KSP = 264;
constexpr float C2 = 0.10206207261596577f * 1.4426950408889634f;
__device__ __forceinline__ void qkv_units(LAS unsigned char* lds, int l, const bf16_t* P, const bf16_t* WUQT, const bf16_t* WUKVT, const float* scw, const float* scb,
                                          bf16_t* QL, bf16_t* QC, bf16_t* KB, bf16_t* VTG, bf16_t* MIX, int G, int bx) {
    LAS float* KRo = (LAS float*)(lds + O_KR); LAS float* CS = (LAS float*)(lds + O_CS); LAS float* RS = (LAS float*)(lds + O_RS);
    LAS bf16_t* CQ = (LAS bf16_t*)(lds + O_CQ); LAS bf16_t* CK = (LAS bf16_t*)(lds + O_CKV); LAS bf16_t* KS = (LAS bf16_t*)(lds + O_KS); LAS bf16_t* QS = (LAS bf16_t*)(lds + O_CQ);
    for (int unit = bx; unit < 272; unit += G) {
        int tid_l = threadIdx.x; asm volatile("" : "+v"(tid_l));
        const int tid = tid_l, lane = tid & 63, w = __builtin_amdgcn_readfirstlane(tid >> 6), fr = lane & 15, fq = lane >> 4;
        const int b = unit / 68, chunk = unit % 68, pos0 = 64 * chunk; const bool ctxt = chunk < 4; const size_t r0 = (size_t)b * NPOS + pos0;
#pragma unroll
        for (int i = 0; i < 4; ++i) { const int q = tid + 512 * i, row = q >> 5, ch = q & 31; *(LAS u32x4*)((LAS unsigned char*)CQ + row * (CQP * 2) + ch * 16) = *(const u32x4*)(P + (r0 + row) * PP + C_CQ + ch * 8); }
#pragma unroll
        for (int i = 0; i < 2; ++i) { const int q = tid + 512 * i, row = q >> 4, ch = q & 15; *(LAS u32x4*)((LAS unsigned char*)CK + row * (CKP * 2) + ch * 16) = *(const u32x4*)(P + (r0 + row) * PP + C_CKV + ch * 8); }
        __syncthreads();
        { const int row = tid >> 3, j = tid & 7; float sq = 0.f, sk = 0.f;
#pragma unroll
          for (int i = 0; i < 4; ++i) { const u32x4 v = *(const LAS u32x4*)((const LAS unsigned char*)CQ + row * (CQP * 2) + j * 64 + i * 16);
#pragma unroll
              for (int e = 0; e < 4; ++e) { const float a = __uint_as_float(v[e] << 16), c = __uint_as_float(v[e] & 0xffff0000u); sq += a * a + c * c; } }
#pragma unroll
          for (int i = 0; i < 2; ++i) { const u32x4 v = *(const LAS u32x4*)((const LAS unsigned char*)CK + row * (CKP * 2) + j * 32 + i * 16);
#pragma unroll
              for (int e = 0; e < 4; ++e) { const float a = __uint_as_float(v[e] << 16), c = __uint_as_float(v[e] & 0xffff0000u); sk += a * a + c * c; } }
          sq += __shfl_xor(sq, 1); sq += __shfl_xor(sq, 2); sq += __shfl_xor(sq, 4); sk += __shfl_xor(sk, 1); sk += __shfl_xor(sk, 2); sk += __shfl_xor(sk, 4);
          if (j == 0) { RS[row * 2] = rsqrtf(sq * (1.f / 256.f) + 1e-6f); RS[row * 2 + 1] = rsqrtf(sk * (1.f / 128.f) + 1e-6f); }
          float cr = 1.f, sr = 0.f, cc = 1.f, sc = 0.f;
          if (!ctxt) { const int t = pos0 - CTX + row; const float inv = __expf(-9.210340371976184f * (float)j * 0.125f); float xa = (float)(t >> 6) * inv * 0.15915494309189535f; xa -= rintf(xa); sr = __sinf(xa * 6.283185307179586f); cr = __cosf(xa * 6.283185307179586f); float xb = (float)(t & 63) * inv * 0.15915494309189535f; xb -= rintf(xb); sc = __sinf(xb * 6.283185307179586f); cc = __cosf(xb * 6.283185307179586f); }
          CS[(row * 16 + j) * 2] = cr; CS[(row * 16 + j) * 2 + 1] = sr; CS[(row * 16 + 8 + j) * 2] = cc; CS[(row * 16 + 8 + j) * 2 + 1] = sc;
          const bf16_t* kp = P + (r0 + row) * PP + C_KR; const float z0 = bf2f(kp[j]), z1 = bf2f(kp[8 + j]), z2 = bf2f(kp[16 + j]), z3 = bf2f(kp[24 + j]);
          KRo[row * 32 + j] = z0 * cr - z1 * sr; KRo[row * 32 + 8 + j] = z0 * sr + z1 * cr; KRo[row * 32 + 16 + j] = z2 * cc - z3 * sc; KRo[row * 32 + 24 + j] = z2 * sc + z3 * cc; }
        __builtin_amdgcn_sched_barrier(0);
        { f32x4 qa[4][3];
#pragma unroll
          for (int mt = 0; mt < 4; ++mt)
#pragma unroll
              for (int n = 0; n < 3; ++n) qa[mt][n] = (f32x4){0.f, 0.f, 0.f, 0.f};
          const bf16_t* wq = WUQT + ((size_t)l * 384 + 48 * w + fr) * 256 + 8 * fq;
#pragma unroll 2
          for (int ks = 0; ks < 8; ++ks) { bf16x8 a[4], bb[3];
#pragma unroll
              for (int mt = 0; mt < 4; ++mt) a[mt] = *(const LAS bf16x8*)(CQ + (16 * mt + fr) * CQP + 32 * ks + 8 * fq);
#pragma unroll
              for (int n = 0; n < 3; ++n) bb[n] = *(const bf16x8*)(wq + (size_t)(16 * n) * 256 + 32 * ks);
#pragma unroll
              for (int mt = 0; mt < 4; ++mt)
#pragma unroll
                  for (int n = 0; n < 3; ++n) qa[mt][n] = __builtin_amdgcn_mfma_f32_16x16x32_bf16(a[mt], bb[n], qa[mt][n], 0, 0, 0); }
          __syncthreads();
#pragma unroll
          for (int n = 0; n < 3; ++n) { const int nt = 3 * w + n, m6 = nt % 6, col = 16 * nt + fr;
#pragma unroll
              for (int mt = 0; mt < 4; ++mt)
#pragma unroll
                  for (int i = 0; i < 4; ++i) { const int row = 16 * mt + 4 * fq + i; float v = qa[mt][n][i] * RS[row * 2];
                      if (m6 >= 4) { const float pv = __shfl_xor(v, 8); const int ci = (row * 16 + (m6 == 5 ? 8 : 0) + (fr & 7)) * 2; const float c = CS[ci], s = CS[ci + 1]; v = (fr < 8) ? v * c - pv * s : pv * s + v * c; }
                      QS[row * QSP + col] = f2bf(v * C2); } } }
        __builtin_amdgcn_sched_barrier(0);
        { f32x4 ka[4][4];
#pragma unroll
          for (int mt = 0; mt < 4; ++mt)
#pragma unroll
              for (int n = 0; n < 4; ++n) ka[mt][n] = (f32x4){0.f, 0.f, 0.f, 0.f};
          const bf16_t* wk = WUKVT + ((size_t)l * 512 + 64 * w + fr) * 128 + 8 * fq;
#pragma unroll 2
          for (int ks = 0; ks < 4; ++ks) { bf16x8 a[4], bb[4];
#pragma unroll
              for (int mt = 0; mt < 4; ++mt) a[mt] = *(const LAS bf16x8*)(CK + (16 * mt + fr) * CKP + 32 * ks + 8 * fq);
#pragma unroll
              for (int n = 0; n < 4; ++n) bb[n] = *(const bf16x8*)(wk + (size_t)(16 * n) * 128 + 32 * ks);
#pragma unroll
              for (int mt = 0; mt < 4; ++mt)
#pragma unroll
                  for (int n = 0; n < 4; ++n) ka[mt][n] = __builtin_amdgcn_mfma_f32_16x16x32_bf16(a[mt], bb[n], ka[mt][n], 0, 0, 0); }
          const int head = w >> 1;
          if ((w & 1) == 0) {
#pragma unroll
              for (int n = 0; n < 4; ++n)
#pragma unroll
                  for (int mt = 0; mt < 4; ++mt)
#pragma unroll
                      for (int i = 0; i < 4; ++i) { const int row = 16 * mt + 4 * fq + i; KS[row * KSP + head * 64 + 16 * n + fr] = f2bf(ka[mt][n][i] * RS[row * 2 + 1]); }
          } else {
#pragma unroll
              for (int n = 0; n < 4; ++n)
#pragma unroll
                  for (int mt = 0; mt < 4; ++mt) { const int rb = 16 * mt + 4 * fq; u32x2 o; o.x = pk2(ka[mt][n][0] * RS[rb * 2 + 1], ka[mt][n][1] * RS[rb * 2 + 3]); o.y = pk2(ka[mt][n][2] * RS[rb * 2 + 5], ka[mt][n][3] * RS[rb * 2 + 7]);
                      *(u32x2*)(VTG + ((size_t)(b * 4 + head) * 64 + 16 * n + fr) * NPOS + pos0 + rb) = o; } } }
        __syncthreads();
#pragma unroll
        for (int i = 0; i < 6; ++i) { const int q = tid + 512 * i, row = q / 48, rem = q % 48, head = rem / 12, ch = rem % 12, pos = pos0 + row;
            const u32x4 qv = *(const LAS u32x4*)((const LAS unsigned char*)QS + row * (QSP * 2) + (head * 96 + ch * 8) * 2);
            if (!ctxt) *(u32x4*)(QL + ((size_t)(b * 4 + head) * SEQ + (pos - CTX)) * 96 + ch * 8) = qv; else if (l == 0) *(u32x4*)(QC + ((size_t)(b * 4 + head) * CTX + pos) * 96 + ch * 8) = qv;
            u32x4 kv;
            if (ch < 8) kv = *(const LAS u32x4*)((const LAS unsigned char*)KS + row * (KSP * 2) + (head * 64 + ch * 8) * 2);
            else { const LAS float* kr = KRo + row * 32 + (ch - 8) * 8; kv.x = pk2(kr[0], kr[1]); kv.y = pk2(kr[2], kr[3]); kv.z = pk2(kr[4], kr[5]); kv.w = pk2(kr[6], kr[7]); }
            *(u32x4*)(KB + ((size_t)(b * 4 + head) * NPOS + pos) * 96 + ch * 8) = kv; }
        if (!(ctxt && l == 1)) { const int lo = ctxt ? 0 : CTX, hi = ctxt ? CTX : NPOS;
#pragma unroll
            for (int i = 0; i < 4; ++i) { const int q = tid + 512 * i, row = q >> 5, ch = q & 31, pos = pos0 + row; float acc[8];
#pragma unroll
                for (int e = 0; e < 8; ++e) acc[e] = scb[ch * 8 + e];
#pragma unroll
                for (int k = 0; k < 3; ++k) { const int p = pos - 1 + k; if (p >= lo && p < hi) { const bf16_t* pr = P + ((size_t)b * NPOS + p) * PP; const u32x4 sx = *(const u32x4*)(pr + C_SX + ch * 8), sc = *(const u32x4*)(pr + C_SC + ch * 8);
#pragma unroll
                        for (int e = 0; e < 4; ++e) { const float w0 = scw[k * 256 + ch * 8 + 2 * e], w1 = scw[k * 256 + ch * 8 + 2 * e + 1];
                            acc[2 * e] += w0 * (__uint_as_float(sx[e] << 16) * __uint_as_float(sc[e] << 16)); acc[2 * e + 1] += w1 * (__uint_as_float(sx[e] & 0xffff0000u) * __uint_as_float(sc[e] & 0xffff0000u)); } } }
                const u32x4 sb = *(const u32x4*)(P + (r0 + row) * PP + C_SB + ch * 8); u32x4 o;
#pragma unroll
                for (int e = 0; e < 4; ++e) o[e] = pk2(__uint_as_float(sb[e] << 16) * acc[2 * e], __uint_as_float(sb[e] & 0xffff0000u) * acc[2 * e + 1]);
                *(u32x4*)(MIX + (r0 + row) * D + 768 + ch * 8) = o; } }
        __syncthreads();
    }
}
}

namespace lru {
constexpr int XP = 264, O_X = 0, O_NA = 33792, O_BB = 66560;
__device__ __forceinline__ float sigm(float x) { return __builtin_amdgcn_rcpf(1.f + __expf(-x)); }
__device__ __forceinline__ void chunk_units(LAS unsigned char* lds, int l, const bf16_t* P, const float* conv_w, const float* conv_b, const bf16_t* WAT, const bf16_t* WIT, const float* b_a, const float* b_i, const float* lam,
                                            bf16_t* HL, bf16_t* AC, float* SUM, int G, int bx) {
    LAS bf16_t* X = (LAS bf16_t*)(lds + O_X); LAS bf16_t* NA = (LAS bf16_t*)(lds + O_NA); LAS bf16_t* BB = (LAS bf16_t*)(lds + O_BB);
    for (int unit = bx; unit < 544; unit += G) {
        int tid_l = threadIdx.x; asm volatile("" : "+v"(tid_l));
        const int tid = tid_l, lane = tid & 63, w = __builtin_amdgcn_readfirstlane(tid >> 6), fr = lane & 15, fq = lane >> 4;
        const int dir = unit & 1, bc = unit >> 1, b = bc / 68, chunk = bc % 68, pos0 = 64 * chunk; const int lo = chunk < 4 ? 0 : CTX, hi = chunk < 4 ? CTX : NPOS, left = dir ? 1 : 2;
        const size_t r0 = (size_t)b * NPOS + pos0; const int pd = (l * 2 + dir) * 256;
        { const int c = tid & 255, th = tid >> 8; const float cb = conv_b[pd + c]; const float w0 = conv_w[(size_t)pd * 4 + c], w1 = conv_w[(size_t)pd * 4 + 256 + c], w2 = conv_w[(size_t)pd * 4 + 512 + c], w3 = conv_w[(size_t)pd * 4 + 768 + c];
          const bf16_t* pc = P + (size_t)b * NPOS * PP + C_LX + c; const int pb = pos0 + 32 * th - left;
          float u0 = (pb >= lo && pb < hi) ? bf2f(pc[(size_t)pb * PP]) : 0.f, u1 = (pb + 1 >= lo && pb + 1 < hi) ? bf2f(pc[(size_t)(pb + 1) * PP]) : 0.f, u2 = (pb + 2 >= lo && pb + 2 < hi) ? bf2f(pc[(size_t)(pb + 2) * PP]) : 0.f;
#pragma unroll 8
          for (int i = 0; i < 32; ++i) { const int p3 = pb + 3 + i; const float u3 = (p3 >= lo && p3 < hi) ? bf2f(pc[(size_t)p3 * PP]) : 0.f;
              X[(32 * th + i) * XP + c] = f2bf(cb + w0 * u0 + w1 * u1 + w2 * u2 + w3 * u3); u0 = u1; u1 = u2; u2 = u3; } }
        __syncthreads();
        { const int h = w >> 1, mh = w & 1;
          f32x4 ra[2][4], ri[2][4];
#pragma unroll
          for (int m = 0; m < 2; ++m)
#pragma unroll
              for (int n = 0; n < 4; ++n) { ra[m][n] = (f32x4){0.f, 0.f, 0.f, 0.f}; ri[m][n] = (f32x4){0.f, 0.f, 0.f, 0.f}; }
          const bf16_t* wa = WAT + ((size_t)((l * 2 + dir) * 4 + h) * 64 + fr) * 64 + 8 * fq; const bf16_t* wi = WIT + ((size_t)((l * 2 + dir) * 4 + h) * 64 + fr) * 64 + 8 * fq;
#pragma unroll
          for (int ks = 0; ks < 2; ++ks) { bf16x8 a[2], ba[4], bi[4];
#pragma unroll
              for (int m = 0; m < 2; ++m) a[m] = *(const LAS bf16x8*)(X + (16 * (2 * mh + m) + fr) * XP + 64 * h + 32 * ks + 8 * fq);
#pragma unroll
              for (int n = 0; n < 4; ++n) { ba[n] = *(const bf16x8*)(wa + (size_t)(16 * n) * 64 + 32 * ks); bi[n] = *(const bf16x8*)(wi + (size_t)(16 * n) * 64 + 32 * ks); }
#pragma unroll
              for (int m = 0; m < 2; ++m)
#pragma unroll
                  for (int n = 0; n < 4; ++n) { ra[m][n] = __builtin_amdgcn_mfma_f32_16x16x32_bf16(a[m], ba[n], ra[m][n], 0, 0, 0); ri[m][n] = __builtin_amdgcn_mfma_f32_16x16x32_bf16(a[m], bi[n], ri[m][n], 0, 0, 0); } }
#pragma unroll
          for (int n = 0; n < 4; ++n) { const int c = 64 * h + 16 * n + fr; const float bav = b_a[pd + c], biv = b_i[pd + c], sp = log1pf(__expf(-lam[pd + c]));
#pragma unroll
              for (int m = 0; m < 2; ++m)
#pragma unroll
                  for (int i = 0; i < 4; ++i) { const int t = 16 * (2 * mh + m) + 4 * fq + i; const float r = sigm(ra[m][n][i] + bav), ig = sigm(ri[m][n][i] + biv);
                      const float na = -expm1f(-8.f * r * sp); const float xv = bf2f(X[t * XP + c]);
                      NA[t * 256 + c] = f2bf(na); BB[t * 256 + c] = f2bf(sqrtf(fmaxf(na * (2.f - na), 0.f)) * (ig * xv)); } } }
        __syncthreads();
        if (tid < 256) { const int c = tid; float hst = 0.f, A = 1.f;
            bf16_t* hl = HL + ((size_t)dir * MROWS + r0) * 256 + c; bf16_t* ac = AC + ((size_t)dir * MROWS + r0) * 256 + c;
            if (dir == 0) {
#pragma unroll 8
                for (int t = 0; t < 64; ++t) { const float a = 1.f - bf2f(NA[t * 256 + c]); hst = a * hst + bf2f(BB[t * 256 + c]); A *= a; hl[(size_t)t * 256] = f2bf(hst); ac[(size_t)t * 256] = f2bf(A); }
            } else {
#pragma unroll 8
                for (int t = 63; t >= 0; --t) { const float a = 1.f - bf2f(NA[t * 256 + c]); hst = a * hst + bf2f(BB[t * 256 + c]); A *= a; hl[(size_t)t * 256] = f2bf(hst); ac[(size_t)t * 256] = f2bf(A); }
            }
            float* sm = SUM + ((size_t)(dir * 4 + b) * 68 + chunk) * 512; sm[c] = A; sm[256 + c] = hst; }
        __syncthreads();
    }
}
__device__ __forceinline__ void fixup_units(int l, const bf16_t* P, const bf16_t* HL, const bf16_t* AC, const float* SUM, bf16_t* MIX, int G, int bx) {
    for (int unit = bx; unit < 272; unit += G) {
        int tid_l = threadIdx.x; asm volatile("" : "+v"(tid_l));
        const int tid = tid_l, c = tid & 255, th = tid >> 8;
        const int b = unit / 68, chunk = unit % 68; if (l == 1 && chunk < 4) continue;
        const float* sf = SUM + ((size_t)(0 * 4 + b) * 68) * 512 + c; const float* sb = SUM + ((size_t)(1 * 4 + b) * 68) * 512 + c;
        float cf = 0.f, cb = 0.f;
        for (int j = 0; j < chunk; ++j) cf = sf[(size_t)j * 512 + 256] + sf[(size_t)j * 512] * cf;
        if (chunk < 4) { for (int j = 3; j > chunk; --j) cb = sb[(size_t)j * 512 + 256] + sb[(size_t)j * 512] * cb; }
        else { for (int j = 3; j >= 0; --j) cb = sb[(size_t)j * 512 + 256] + sb[(size_t)j * 512] * cb; for (int j = 67; j > chunk; --j) cb = sb[(size_t)j * 512 + 256] + sb[(size_t)j * 512] * cb; }
        const size_t r0 = (size_t)b * NPOS + 64 * chunk + 32 * th;
#pragma unroll 4
        for (int i = 0; i < 32; ++i) { const size_t r = r0 + i; const float hf = bf2f(HL[r * 256 + c]) + bf2f(AC[r * 256 + c]) * cf, hb = bf2f(HL[((size_t)MROWS + r) * 256 + c]) + bf2f(AC[((size_t)MROWS + r) * 256 + c]) * cb;
            const float x = bf2f(P[r * PP + C_LG + c]); const float u = 0.7978845608028654f * (x + 0.044715f * x * x * x); const float th_ = 1.f - 2.f * __builtin_amdgcn_rcpf(1.f + __expf(2.f * u));
            MIX[r * D + 256 + c] = f2bf(0.5f * x * (1.f + th_) * (hf + hb)); }
    }
}
}

namespace fft {
__device__ __forceinline__ void ctx_a(LAS unsigned char* lds, const bf16_t* P, const float* TABC, const float* TABS, bf16_t* XCT, int G, int bx) {
    LAS bf16_t* U = (LAS bf16_t*)(lds + O_U); LAS bf16_t* X = (LAS bf16_t*)(lds + O_X);
    for (int unit = bx; unit < 16; unit += G) {
        int tid_l = threadIdx.x; asm volatile("" : "+v"(tid_l));
        const int tid = tid_l, lane = tid & 63, w = __builtin_amdgcn_readfirstlane(tid >> 6), fr = lane & 15, fq = lane >> 4;
        build_tables(lds, TABC, TABS, tid);
        const LAS bf16_t* Tc = (const LAS bf16_t*)(lds + O_TC); const LAS bf16_t* Ts = (const LAS bf16_t*)(lds + O_TS);
        const int b = unit >> 2, q = unit & 3;
#pragma unroll
        for (int i = 0; i < 4; ++i) { const int qq = tid + 512 * i, t1 = qq >> 5, ch = qq & 31;
            *(LAS u32x4*)((LAS unsigned char*)U + t1 * (UP * 2) + ch * 16) = *(const u32x4*)(P + ((size_t)b * NPOS + 64 * q + t1) * PP + ch * 8); }
        __syncthreads();
        { const int g = w >> 1, part = w & 1; const LAS bf16_t* T = part ? Ts : Tc;
          f32x4 acc[4][4];
#pragma unroll
          for (int mt = 0; mt < 4; ++mt)
#pragma unroll
              for (int nt = 0; nt < 4; ++nt) acc[mt][nt] = (f32x4){0.f, 0.f, 0.f, 0.f};
#pragma unroll
          for (int ks = 0; ks < 2; ++ks) { bf16x8 a[4], bb[4];
#pragma unroll
              for (int mt = 0; mt < 4; ++mt) a[mt] = *(const LAS bf16x8*)(U + (16 * mt + fr) * UP + g * 64 + 32 * ks + 8 * fq);
#pragma unroll
              for (int nt = 0; nt < 4; ++nt) bb[nt] = *(const LAS bf16x8*)(T + (16 * nt + fr) * TP + 32 * ks + 8 * fq);
#pragma unroll
              for (int mt = 0; mt < 4; ++mt)
#pragma unroll
                  for (int nt = 0; nt < 4; ++nt) acc[mt][nt] = __builtin_amdgcn_mfma_f32_16x16x32_bf16(a[mt], bb[nt], acc[mt][nt], 0, 0, 0); }
          const float sg = part ? -1.f : 1.f;
#pragma unroll
          for (int mt = 0; mt < 4; ++mt)
#pragma unroll
              for (int nt = 0; nt < 4; ++nt) { const f32x4 v = acc[mt][nt] * sg; u32x2 o; o.x = pk2(v[0], v[1]); o.y = pk2(v[2], v[3]);
                  *(LAS u32x2*)(X + (part * 256 + g * 64 + 16 * nt + fr) * TP + 16 * mt + 4 * fq) = o; } }
        __syncthreads();
#pragma unroll
        for (int i = 0; i < 8; ++i) { const int qq = tid + 512 * i, row = qq >> 3, c8 = qq & 7;
            *(u32x4*)(XCT + (((size_t)b * 4 + q) * 512 + row) * 64 + c8 * 8) = *(const LAS u32x4*)((const LAS unsigned char*)X + row * (TP * 2) + c8 * 16); }
        __syncthreads();
    }
}
__device__ __forceinline__ void ctx_b(LAS unsigned char* lds, const bf16_t* XCT, const float* TABC, const float* TABS, bf16_t* MIX, int G, int bx) {
    LAS bf16_t* Tc = (LAS bf16_t*)(lds + O_TC); LAS bf16_t* Ts = (LAS bf16_t*)(lds + O_TS);
    LAS bf16_t* Ys = (LAS bf16_t*)(lds + O_U); LAS bf16_t* ZT = (LAS bf16_t*)(lds + O_X);
    for (int unit = bx; unit < 16; unit += G) {
        int tid_l = threadIdx.x; asm volatile("" : "+v"(tid_l));
        const int tid = tid_l, lane = tid & 63, w = __builtin_amdgcn_readfirstlane(tid >> 6), fr = lane & 15, fq = lane >> 4;
        const int b = unit >> 2, ft = unit & 3;
        f32x4 y[4][2];
#pragma unroll
        for (int mt = 0; mt < 4; ++mt)
#pragma unroll
            for (int n = 0; n < 2; ++n) y[mt][n] = (f32x4){0.f, 0.f, 0.f, 0.f};
        for (int q = 0; q < 4; ++q) {
            for (int i = tid; i < 4096; i += 512) { const int fl = i >> 6, tl = i & 63, ix = (((64 * ft + fl) * (64 * q + tl)) & 255) * 16; Tc[fl * TP + tl] = f2bf(TABC[ix]); Ts[fl * TP + tl] = f2bf(TABS[ix]); }
#pragma unroll
            for (int i = 0; i < 8; ++i) { const int qq = tid + 512 * i, row = qq >> 3, c8 = qq & 7;
                *(LAS u32x4*)((LAS unsigned char*)ZT + row * (TP * 2) + c8 * 16) = *(const u32x4*)(XCT + (((size_t)b * 4 + q) * 512 + row) * 64 + c8 * 8); }
            __syncthreads();
#pragma unroll
            for (int ks = 0; ks < 2; ++ks) { bf16x8 xr[2], xi[2];
#pragma unroll
                for (int n = 0; n < 2; ++n) { xr[n] = *(const LAS bf16x8*)(ZT + (32 * w + 16 * n + fr) * TP + 32 * ks + 8 * fq); xi[n] = *(const LAS bf16x8*)(ZT + (256 + 32 * w + 16 * n + fr) * TP + 32 * ks + 8 * fq); }
#pragma unroll
                for (int mt = 0; mt < 4; ++mt) { const bf16x8 c = *(const LAS bf16x8*)(Tc + (16 * mt + fr) * TP + 32 * ks + 8 * fq), s = *(const LAS bf16x8*)(Ts + (16 * mt + fr) * TP + 32 * ks + 8 * fq);
#pragma unroll
                    for (int n = 0; n < 2; ++n) { y[mt][n] = __builtin_amdgcn_mfma_f32_16x16x32_bf16(c, xr[n], y[mt][n], 0, 0, 0); y[mt][n] = __builtin_amdgcn_mfma_f32_16x16x32_bf16(s, xi[n], y[mt][n], 0, 0, 0); } } }
            __syncthreads();
        }
#pragma unroll
        for (int mt = 0; mt < 4; ++mt)
#pragma unroll
            for (int i = 0; i < 4; ++i)
#pragma unroll
                for (int n = 0; n < 2; ++n) Ys[(16 * mt + 4 * fq + i) * UP + 32 * w + 16 * n + fr] = f2bf(y[mt][n][i] * (1.f / 128.f));
        __syncthreads();
#pragma unroll
        for (int i = 0; i < 4; ++i) { const int qq = tid + 512 * i, fl = qq >> 5, ch = qq & 31;
            *(u32x4*)(MIX + ((size_t)b * NPOS + 64 * ft + fl) * D + ch * 8) = *(const LAS u32x4*)((const LAS unsigned char*)Ys + fl * (UP * 2) + ch * 16); }
        __syncthreads();
    }
}
}

constexpr int NWAVES = 8, RING_BYTES = 131072 + 3072, LDSCTL_OFF = RING_BYTES, MISC_OFF = LDSCTL_OFF + 64, META_OFF = MISC_OFF + 64, LDS_BYTES = 147456;
enum { PH_PRO0 = 0, PH_PRO1 = 1, PH_L0 = 2, PH_PER_LAYER = 8, PH_N = 18 };
enum { PL_WIN = 0, PL_PREP = 1, PL_MIX = 2, PL_WOUT = 3, PL_ROUTE = 4, PL_MOE1 = 5, PL_MOE2 = 6, PL_COMB = 7 };
struct MArgs { const float* in[30]; float* out; unsigned char* ws; int npass, skip_mask, dup_ph, dup_n; };

__device__ __forceinline__ void transpose_item(const float* W, int K, int N, bf16_t* WT, int drow0, LAS float* scr, int k0, int n0, int lane) {
    const int kr = lane >> 3, nc = (lane & 7) * 4;
    f32x4 v[8];
#pragma unroll
    for (int i = 0; i < 8; ++i) v[i] = __builtin_nontemporal_load((const f32x4*)(W + (size_t)(k0 + kr + 8 * i) * N + n0 + nc));
#pragma unroll
    for (int i = 0; i < 8; ++i) { LAS float* d = scr + (kr + 8 * i) * 33 + nc; d[0] = v[i][0]; d[1] = v[i][1]; d[2] = v[i][2]; d[3] = v[i][3]; }
    asm volatile("s_waitcnt lgkmcnt(0)" ::: "memory");
    const int c = lane & 7;
#pragma unroll
    for (int j = 0; j < 4; ++j) { const int n = (lane >> 3) + 8 * j; const LAS float* s = scr + (8 * c) * 33 + n;
        u32x4 o; o.x = pk2(s[0 * 33], s[1 * 33]); o.y = pk2(s[2 * 33], s[3 * 33]); o.z = pk2(s[4 * 33], s[5 * 33]); o.w = pk2(s[6 * 33], s[7 * 33]);
        *(u32x4*)(WT + (size_t)(drow0 + n) * K + k0 + 8 * c) = o; }
    asm volatile("s_waitcnt lgkmcnt(0)" ::: "memory");
}

#define ARG_IN(i) ({ const float* _p; asm volatile("s_load_dwordx2 %0, %1, %2\n\ts_waitcnt lgkmcnt(0)" : "=s"(_p) : "s"(__builtin_amdgcn_kernarg_segment_ptr()), "n"((i) * 8)); _p; })
__global__ void __launch_bounds__(NWAVES * 64, 2) mega(MArgs args) {
    extern __shared__ __attribute__((aligned(16))) unsigned char lds_raw[];
    const int G0 = gridDim.x, bx0 = blockIdx.x;
    unsigned char* ws0 = args.ws;
    unsigned* ctl0 = (unsigned*)(ws0 + L::CTL);
    for (int u = threadIdx.x; u < (LDS_BYTES - LDSCTL_OFF) / 4; u += NWAVES * 64) ((LAS unsigned*)(lds_raw + LDSCTL_OFF))[u] = 0u;
    __syncthreads();
    volatile LAS unsigned* MISC = (volatile LAS unsigned*)((LAS unsigned char*)lds_raw + MISC_OFF);
    XcdBarrier bar = xcd_barrier_post(ctl0 + L::CW_BAR, MISC);
    const int lo = 0, hi = PH_N;

    bool first = true;
    for (int pass = 0; pass < args.npass; ++pass)
    for (int ph = lo; ph < hi; ++ph) {
      const int reps = (ph == args.dup_ph) ? 1 + args.dup_n : 1;
      for (int rep = 0; rep < reps; ++rep) {
        if (!first) xcd_barrier(bar);
        first = false;
        if (pass + 1 < args.npass && ((args.skip_mask >> ph) & 1)) continue;
        unsigned char* ws = args.ws; asm volatile("" : "+s"(ws));
        unsigned* ctl = (unsigned*)(ws + L::CTL);
        int tid_p = threadIdx.x; asm volatile("" : "+v"(tid_p));
        int G = G0, bx = bx0; asm volatile("" : "+s"(G), "+s"(bx));
        const int vcu = (G % 8 == 0) ? (bx % 8) * (G / 8) + bx / 8 : bx; (void)vcu;
        unsigned ldsb = 0; asm volatile("" : "+s"(ldsb)); LAS unsigned char* lds = (LAS unsigned char*)lds_raw + ldsb;
        LAS int* META = (LAS int*)(lds + META_OFF);
        const int tid = tid_p, lane = tid & 63, wave = __builtin_amdgcn_readfirstlane(tid >> 6); (void)lane; (void)wave;
        if (ph == PH_PRO0) {
            if (bx == 0 && tid < 2 * NE) ((int*)(ctl + L::CW_CNT))[tid * L::CNT_STRIDE] = 0;
            LAS float* scr = (LAS float*)(lds + wave * 16384);
            const int gw = vcu * NWAVES + wave, NGW = G * NWAVES;
            constexpr int I_IN = 16 * 61, I_OUT = 16 * 32, I_GU = NE * 16 * 64, I_DN = NE * 16 * 32, I_L = I_IN + I_OUT + I_GU + I_DN;
            for (int it = gw; it < 2 * I_L; it += NGW) {
                const int l = it / I_L; int r = it % I_L;
                if (r < I_IN) { const int kb = r / 61, nb = r % 61; transpose_item(ARG_IN(8) + (size_t)l * D * PT, D, PT, (bf16_t*)(ws + L::WINT) + (size_t)l * 2048 * D, 32 * nb, scr, 64 * kb, 32 * nb, lane); continue; } r -= I_IN;
                if (r < I_OUT) { const int kb = r / 32, nb = r % 32; transpose_item(ARG_IN(22) + (size_t)l * D * D, D, D, (bf16_t*)(ws + L::WOUTT) + (size_t)l * D * D, 32 * nb, scr, 64 * kb, 32 * nb, lane); continue; } r -= I_OUT;
                if (r < I_GU) { const int e = r / (16 * 64), q = r % (16 * 64), kb = q / 64, nb = q % 64; const int n0 = 32 * nb; const int c2 = n0 & 1023; const int drow = (c2 >> 7) * 256 + (n0 >> 10) * 128 + (c2 & 127);
                    transpose_item(ARG_IN(25) + ((size_t)l * NE + e) * D * 2048, D, 2048, (bf16_t*)(ws + L::WGUT) + ((size_t)l * NE + e) * 2048 * D, drow, scr, 64 * kb, n0, lane); continue; } r -= I_GU;
                { const int e = r / (16 * 32), q = r % (16 * 32), kb = q / 32, nb = q % 32;
                    transpose_item(ARG_IN(27) + ((size_t)l * NE + e) * D * D, D, D, (bf16_t*)(ws + L::WDT) + ((size_t)l * NE + e) * D * D, 32 * nb, scr, 64 * kb, 32 * nb, lane); }
            }
            sm::smallw_phase(ARG_IN(17), ARG_IN(16), ARG_IN(19), ARG_IN(18), ARG_IN(11), ARG_IN(13), (bf16_t*)(ws + L::WUQT), (bf16_t*)(ws + L::WUKVT), (bf16_t*)(ws + L::WAT), (bf16_t*)(ws + L::WIT),
                             (float*)(ws + L::TABC), (float*)(ws + L::TABS), bx * 512 + tid, G * 512);
            __syncthreads();
            sm::mod_phase(lds, ARG_IN(1), ARG_IN(3), ARG_IN(4), ARG_IN(5), (float*)(ws + L::MOD), G, bx, tid);
            for (int i = bx * 512 + tid; i < 2 * 96 * D / 8; i += G * 512) { const int l = i / (96 * D / 8), q = i % (96 * D / 8); *(u32x4*)((bf16_t*)(ws + L::WINT) + ((size_t)l * 2048 + PT) * D + (size_t)q * 8) = (u32x4){0u, 0u, 0u, 0u}; }
            continue;
        }
        if (ph == PH_PRO1) { sm::pro1_phase(ARG_IN(0), ARG_IN(2), ARG_IN(6), (const float*)(ws + L::MOD), (float*)(ws + L::H), (bf16_t*)(ws + L::XN), bx * NWAVES + wave, G * NWAVES, lane); continue; }
        if (ph < PH_L0) continue;
        const int l = (ph - PH_L0) / PH_PER_LAYER, pl = (ph - PH_L0) % PH_PER_LAYER;
        const float* MODl = (const float*)(ws + L::MOD) + (size_t)l * 5 * 6144;
        if (pl == PL_WIN) {
            g8::DenseSched S; S.init(MROWS / 256, PP / 256, G, bx, 0, (const bf16_t*)(ws + L::WINT) + (size_t)l * 2048 * D, D);
            g8::EpiP E{(bf16_t*)(ws + L::P)};
            g8::gemm_phase<g8::EpiP, g8::DenseSched, false, false>(lds, (const char*)(ws + L::XN), S, E);
        } else if (pl == PL_PREP) {
            fft::stage_a(lds, (const bf16_t*)(ws + L::P), (const float*)(ws + L::TABC), (const float*)(ws + L::TABS), (bf16_t*)(ws + L::ZBUF), G, bx);
            __syncthreads();
            if (l == 0) { fft::ctx_a(lds, (const bf16_t*)(ws + L::P), (const float*)(ws + L::TABC), (const float*)(ws + L::TABS), (bf16_t*)(ws + L::XCT), G, G - 1 - bx); __syncthreads(); }
            prep::qkv_units(lds, l, (const bf16_t*)(ws + L::P), (const bf16_t*)(ws + L::WUQT), (const bf16_t*)(ws + L::WUKVT), ARG_IN(20) + l * 768, ARG_IN(21) + l * 256,
                            (bf16_t*)(ws + L::QL), (bf16_t*)(ws + L::QC), (bf16_t*)(ws + L::KB), (bf16_t*)(ws + L::VTG), (bf16_t*)(ws + L::MIX), G, bx);
            __syncthreads();
            lru::chunk_units(lds, l, (const bf16_t*)(ws + L::P), ARG_IN(9), ARG_IN(10), (const bf16_t*)(ws + L::WAT), (const bf16_t*)(ws + L::WIT), ARG_IN(12), ARG_IN(14), ARG_IN(15),
                             (bf16_t*)(ws + L::HL), (bf16_t*)(ws + L::AC), (float*)(ws + L::SUM), G, bx);
        } else if (pl == PL_MIX) {
            lru::fixup_units(l, (const bf16_t*)(ws + L::P), (const bf16_t*)(ws + L::HL), (const bf16_t*)(ws + L::AC), (const float*)(ws + L::SUM), (bf16_t*)(ws + L::MIX), G, bx);
            fft::stage_b(lds, (const bf16_t*)(ws + L::ZBUF), (const float*)(ws + L::TABC), (const float*)(ws + L::TABS), (bf16_t*)(ws + L::MIX), G, bx);
            __syncthreads();
            if (l == 0) { fft::ctx_b(lds, (const bf16_t*)(ws + L::XCT), (const float*)(ws + L::TABC), (const float*)(ws + L::TABS), (bf16_t*)(ws + L::MIX), G, G - 1 - bx); __syncthreads(); }
            attn::attn_phase(lds, (const bf16_t*)(ws + L::QL), (const bf16_t*)(ws + L::QC), (const bf16_t*)(ws + L::KB), (const bf16_t*)(ws + L::VTG), (bf16_t*)(ws + L::MIX), l == 0 ? 1 : 0, G, vcu);
        } else if (pl == PL_WOUT) {
            g8::DenseSched S; S.init(l == 0 ? MROWS / 256 : 64, D / 256, G, bx, l == 0 ? 0 : 1, (const bf16_t*)(ws + L::WOUTT) + (size_t)l * D * D, D);
            g8::EpiH E{(float*)(ws + L::H), MODl, 2048};
            g8::gemm_phase<g8::EpiH, g8::DenseSched, false, false>(lds, (const char*)(ws + L::MIX), S, E);
        } else if (pl == PL_ROUTE) {
            sm::route_phase(lds, l, (const float*)(ws + L::H), ARG_IN(7) + l * D, MODl, ARG_IN(23) + (size_t)l * D * NE, ARG_IN(24) + l * NE, (bf16_t*)(ws + L::XN), (int*)(ctl + L::CW_CNT) + l * NE * L::CNT_STRIDE,
                            (int*)(ws + L::LIST) + (size_t)l * NE * LCAP, (float*)(ws + L::GATE), G, bx, tid);
        } else if (pl == PL_COMB) {
            sm::comb_phase(l, (float*)(ws + L::H), (const bf16_t*)(ws + L::Y), MODl, ARG_IN(6) + D, (const float*)(ws + L::MOD) + (size_t)5 * 6144, (bf16_t*)(ws + L::XN), ARG_IN(29), args.out, bx * NWAVES + wave, G * NWAVES, lane);
        } else if (pl == PL_MOE1 || pl == PL_MOE2) {
            const int* CNTg = (const int*)(ctl + L::CW_CNT) + l * NE * L::CNT_STRIDE;
            if (tid == 0) { int o = 0; for (int e = 0; e < NE; ++e) { const int cn = CNTg[e * L::CNT_STRIDE]; META[e] = o; META[64 + e] = cn; o += (cn + 255) >> 8; } META[NE] = o; }
            __syncthreads();
            g8::MoeSched S; S.tpre = META; S.cnt = META + 64; S.G = G; S.c = bx; S.K = D; S.list = (const int*)(ws + L::LIST) + (size_t)l * NE * LCAP;
            if (pl == PL_MOE1) {
                S.NT = 8; S.COLW = 128; S.total = __builtin_amdgcn_readfirstlane(META[NE]) * 8; S.Bt = (const char*)((const bf16_t*)(ws + L::WGUT) + (size_t)l * NE * 2048 * D);
                g8::EpiMoe1 E{(bf16_t*)(ws + L::ACT), ARG_IN(26) + (size_t)l * NE * 2048};
                g8::gemm_phase<g8::EpiMoe1, g8::MoeSched, true, true>(lds, (const char*)(ws + L::XN), S, E);
            } else {
                S.NT = 4; S.COLW = 256; S.total = __builtin_amdgcn_readfirstlane(META[NE]) * 4; S.Bt = (const char*)((const bf16_t*)(ws + L::WDT) + (size_t)l * NE * D * D);
                g8::EpiMoe2 E{(bf16_t*)(ws + L::Y), ARG_IN(28) + (size_t)l * NE * D, (const float*)(ws + L::GATE)};
                g8::gemm_phase<g8::EpiMoe2, g8::MoeSched, false, true>(lds, (const char*)(ws + L::ACT), S, E);
            }
            __syncthreads();
        }
      }
    }
}
constexpr int PROBE_DUP_PH = -1, PROBE_DUP_N = 0;
constexpr int PROBE_NPASS = 1, PROBE_SKIP = 0;
extern "C" void kernel_launch(void* const* d_in, const int* in_sizes, int n_in, void* d_out, int out_size, void* d_ws, size_t ws_size, hipStream_t stream) {
    static int grid = 0;
    if (grid == 0) {
        if (n_in != 30 || out_size != NB_ * SEQ * D || (size_t)L::END > ws_size) { fprintf(stderr, "kernel_launch: unexpected problem shape (n_in %d, out %d) or workspace too small (need %zu, have %zu); nothing launched\n", n_in, out_size, (size_t)L::END, ws_size); grid = -1; return; }
        int dev = 0, cus = 0;
        if (hipGetDevice(&dev) != hipSuccess || hipDeviceGetAttribute(&cus, hipDeviceAttributeMultiprocessorCount, dev) != hipSuccess) { fprintf(stderr, "kernel_launch: device query failed\n"); grid = -1; return; }
        if (hipFuncSetAttribute((const void*)mega, hipFuncAttributeMaxDynamicSharedMemorySize, LDS_BYTES) != hipSuccess) { fprintf(stderr, "kernel_launch: hipFuncSetAttribute failed\n"); grid = -1; return; }
        grid = cus < 256 ? cus : 256;
    }
    if (grid < 0) return;
    unsigned char* p = (unsigned char*)d_ws;
    (void)hipMemsetAsync(p + L::CTL, 0, L::CTL_BYTES, stream);
    MArgs a{};
    for (int i = 0; i < 30; ++i) a.in[i] = (const float*)d_in[i];
    a.out = (float*)d_out; a.ws = p; a.npass = PROBE_NPASS; a.skip_mask = PROBE_SKIP; a.dup_ph = PROBE_DUP_PH; a.dup_n = PROBE_DUP_N;
    hipLaunchKernelGGL(mega, dim3(grid), dim3(NWAVES * 64), LDS_BYTES, stream, a);
}
```

```cpp
#include <hip/hip_runtime.h>
#include <cstdint>
#include <cstdio>

typedef unsigned short bf16_t;
constexpr int NB_ = 4, SEQ = 4096, CTX = 256, D = 1024, NPOS = SEQ + CTX, MROWS = NB_ * NPOS;
constexpr int PT = 1952, PP = 2048;
constexpr int NE = 32, TOPK = 4, LCAP = MROWS;
constexpr int NASG = MROWS * TOPK;
constexpr int ACT_ROWS = NASG + NE * 256;
constexpr int C_FN = 0, C_LX = 256, C_LG = 512, C_CQ = 768, C_CKV = 1024, C_KR = 1152, C_SX = 1184, C_SB = 1440, C_SC = 1696;

__device__ __forceinline__ float bf2f(bf16_t v) { return __uint_as_float((unsigned)v << 16); }
__device__ __forceinline__ bf16_t f2bf(float f) { unsigned u = __float_as_uint(f); return (bf16_t)((u + 0x7fffu + ((u >> 16) & 1u)) >> 16); }
__device__ __forceinline__ float wave_sum(float v) {
#pragma unroll
    for (int o = 1; o < 64; o <<= 1) v += __shfl_xor(v, o);
    return v;
}
__device__ __forceinline__ float sigmoidf_(float x) { return 1.f / (1.f + __expf(-x)); }
__device__ __forceinline__ float gelu_tanh(float x) { const float u = 0.7978845608028654f * (x + 0.044715f * x * x * x); return 0.5f * x * (1.f + tanhf(u)); }

#define LAS __attribute__((address_space(3)))
typedef short bf16x8 __attribute__((ext_vector_type(8)));
typedef float f32x4 __attribute__((ext_vector_type(4)));
typedef unsigned u32x4 __attribute__((ext_vector_type(4)));
typedef unsigned u32x2 __attribute__((ext_vector_type(2)));
__device__ __forceinline__ unsigned pk2(float lo, float hi) { return (unsigned)f2bf(lo) | ((unsigned)f2bf(hi) << 16); }

namespace L {
constexpr size_t A256(size_t x) { return (x + 255) & ~(size_t)255; }
constexpr size_t CTL = 0, CTL_BYTES = 1u << 20;
constexpr size_t H = CTL + CTL_BYTES;
constexpr size_t MOD = CTL + 512 * 1024;
constexpr size_t TABC = A256(H + (size_t)MROWS * D * 4);
constexpr size_t TABS = A256(TABC + 4096 * 4);
constexpr size_t XN = A256(TABS + 4096 * 4);
constexpr size_t P = A256(XN + (size_t)MROWS * D * 2);
constexpr size_t MIX = A256(P + (size_t)MROWS * PP * 2);
constexpr size_t CQN = A256(MIX + (size_t)MROWS * D * 2);
constexpr size_t CKVN = A256(CQN + (size_t)MROWS * 256 * 2);
constexpr size_t QRAW = A256(CKVN + (size_t)MROWS * 128 * 2);
constexpr size_t KVRAW = A256(QRAW + (size_t)MROWS * 384 * 4);
constexpr size_t QL = A256(KVRAW + (size_t)MROWS * 512 * 4);
constexpr size_t QC = A256(QL + (size_t)16 * SEQ * 96 * 2);
constexpr size_t KB = A256(QC + (size_t)16 * CTX * 96 * 2);
constexpr size_t VB = A256(KB + (size_t)16 * NPOS * 96 * 2);
constexpr size_t LA = A256(VB + (size_t)16 * NPOS * 64 * 2);
constexpr size_t LB = A256(LA + (size_t)2 * MROWS * 256 * 4);
constexpr size_t HS = A256(LB + (size_t)2 * MROWS * 256 * 4);
constexpr size_t XCS = A256(HS + (size_t)2 * MROWS * 256 * 4);
constexpr size_t XCSC = A256(XCS + (size_t)4 * 8192 * 256 * 4);
constexpr size_t LIST = A256(XCSC + (size_t)4 * 512 * 256 * 4);
constexpr size_t GATE = A256(LIST + (size_t)2 * NE * LCAP * 4);
constexpr size_t ACT = A256(GATE + (size_t)NASG * 4);
constexpr size_t Y = A256(ACT + (size_t)ACT_ROWS * D * 2);
constexpr size_t WINT = A256(Y + (size_t)NASG * D * 2);
constexpr size_t WOUTT = A256(WINT + (size_t)2 * 2048 * 1024 * 2);
constexpr size_t WGUT = A256(WOUTT + (size_t)2 * 1024 * 1024 * 2);
constexpr size_t WDT = A256(WGUT + (size_t)2 * NE * 2048 * 1024 * 2);
constexpr size_t ZBUF = A256(WDT + (size_t)2 * NE * 1024 * 1024 * 2);
constexpr size_t VTG = A256(ZBUF + (size_t)4 * 64 * 64 * 512 * 2);
constexpr size_t WUQT = A256(VTG + (size_t)16 * 64 * NPOS * 2);
constexpr size_t WUKVT = A256(WUQT + (size_t)2 * 384 * 256 * 2);
constexpr size_t WAT = A256(WUKVT + (size_t)2 * 512 * 128 * 2);
constexpr size_t WIT = A256(WAT + (size_t)16 * 4096 * 2);
constexpr size_t SPT = A256(WIT + (size_t)16 * 4096 * 2);
constexpr size_t HL = A256(SPT + (size_t)1024 * 4);
constexpr size_t AC = A256(HL + (size_t)2 * MROWS * 256 * 2);
constexpr size_t SUM = A256(AC + (size_t)2 * MROWS * 256 * 2);
constexpr size_t XCT = A256(SUM + (size_t)2 * 4 * 68 * 512 * 4);
constexpr size_t END = A256(XCT + (size_t)16 * 512 * 64 * 2);
constexpr int CW_BAR = 4096;
constexpr int CW_CNT = 32768, CNT_STRIDE = 64;
}

#define XB_TMO      128
#define XB_XCNT(j)  (256  + 64 * (j))
#define XB_XSUB(j)  (1280 + 64 * (j))
#define XB_XGEN(j)  (2304 + 64 * (j))
#define XB_TOP      3328
#define XB_TOPGEN   3392
#define XCD_BAR_WORDS 3456
#define XB_SPIN_CAP (1u << 18)
__device__ __forceinline__ unsigned xb_ld(unsigned* p)              { return __hip_atomic_load(p, __ATOMIC_RELAXED, __HIP_MEMORY_SCOPE_AGENT); }
__device__ __forceinline__ unsigned xb_add(unsigned* p, unsigned v) { return __hip_atomic_fetch_add(p, v, __ATOMIC_RELAXED, __HIP_MEMORY_SCOPE_AGENT); }
__device__ __forceinline__ unsigned xb_xcc_id() { return (unsigned)__builtin_amdgcn_s_getreg((3 << 11) | 20) & 0xFu; }
#define XB_SPIN(cond, bar) do { unsigned _sp = 0; while (cond) { __builtin_amdgcn_s_sleep(1); \
    if ((++_sp & 255u) == 0u) { if (xb_ld(&(bar)[XB_TMO])) break; if (_sp > XB_SPIN_CAP) { atomicAdd(&(bar)[XB_TMO], 1u); break; } } } } while (0)
struct XcdBarrier { unsigned* bar; unsigned x; volatile LAS unsigned* st; };
__device__ __forceinline__ XcdBarrier xcd_barrier_post(unsigned* bar, volatile LAS unsigned* st) {
    XcdBarrier b; b.bar = bar; b.x = xb_xcc_id(); b.st = st;
    if (threadIdx.x == 0) (void)xb_add(&bar[XB_XCNT(b.x)], 1u);
    return b;
}
__device__ __forceinline__ void xcd_barrier_complete(unsigned* bar, unsigned x, unsigned& nloc, unsigned& nx) {
    const unsigned G = gridDim.x * gridDim.y * gridDim.z;
    unsigned sum, cnt, mine, sp = 0u;
    for (;;) {
        sum = 0u; cnt = 0u; mine = 0u;
#pragma unroll
        for (unsigned j = 0; j < 16; ++j) { const unsigned c = xb_ld(&bar[XB_XCNT(j)]); sum += c; cnt += (c > 0u) ? 1u : 0u; mine = (j == x) ? c : mine; }
        if (sum == G) break;
        __builtin_amdgcn_s_sleep(1);
        if ((++sp & 255u) == 0u) { if (xb_ld(&bar[XB_TMO])) break; if (sp > XB_SPIN_CAP) { atomicAdd(&bar[XB_TMO], 1u); break; } }
    }
    nloc = mine > 0u ? mine : 1u; nx = cnt > 0u ? cnt : 1u;
}
__device__ __forceinline__ void xcd_barrier(const XcdBarrier& b) {
    asm volatile("s_waitcnt vmcnt(0)" ::: "memory");
    __syncthreads();
    if (threadIdx.x == 0) {
        unsigned* bar = b.bar;
        __builtin_amdgcn_s_waitcnt(0);
        unsigned nloc = b.st[0], nx = b.st[1];
        if (nloc == 0u) { xcd_barrier_complete(bar, b.x, nloc, nx); b.st[0] = nloc; b.st[1] = nx; }
        const unsigned old = xb_add(&bar[XB_XSUB(b.x)], 1u);
        const unsigned gen = old / nloc;
        if (old + 1u == (gen + 1u) * nloc) {
            __builtin_amdgcn_fence(__ATOMIC_RELEASE, "agent");
            asm volatile("s_waitcnt vmcnt(0)" ::: "memory");
            const unsigned og = xb_add(&bar[XB_TOP], 1u);
            const unsigned tg = og / nx;
            if (og + 1u == (tg + 1u) * nx) xb_add(&bar[XB_TOPGEN], 1u);
            else XB_SPIN(xb_ld(&bar[XB_TOPGEN]) == tg, bar);
            __builtin_amdgcn_fence(__ATOMIC_ACQUIRE, "agent");
            xb_add(&bar[XB_XGEN(b.x)], 1u);
            asm volatile("s_waitcnt vmcnt(0)" ::: "memory");
        } else {
            XB_SPIN(xb_ld(&bar[XB_XGEN(b.x)]) == gen, bar);
            __builtin_amdgcn_fence(__ATOMIC_ACQUIRE, "agent");
            asm volatile("s_waitcnt vmcnt(0)" ::: "memory");
        }
    }
    __syncthreads();
}

namespace g8 {
constexpr int BM = 256, BK = 64, HALF = 128, HTB = HALF * BK * 2, STAGE_BYTES = 8 * HTB, NXCD = 8, WGM = 8;
__device__ __forceinline__ int lds_byte(int r, int c) { const int st = (r >> 4) * 2 + (c >> 5), rr = r & 15, cc = c & 31, ob = rr * 64 + cc * 2; return st * 1024 + (ob ^ (((ob >> 9) & 1) << 5)); }
__device__ __forceinline__ void stage_rc(int b, int& R, int& C) { const int st = b / 1024, sb = b % 1024, swz = sb ^ (((sb >> 9) & 1) << 5); R = (st >> 1) * 16 + swz / 64; C = (st & 1) * 32 + (swz % 64) / 2; }
__device__ __forceinline__ int perm32(int rho) { const int n = rho >> 4, i = rho & 15; return 8 * (i >> 2) + 4 * n + (i & 3); }
__device__ __forceinline__ unsigned cvt_pk_bf16(float lo, float hi) { unsigned r; asm volatile("v_cvt_pk_bf16_f32 %0, %1, %2" : "=v"(r) : "v"(lo), "v"(hi)); return r; }
__device__ __forceinline__ int xcd_remap(int wgid, int nwg) { const int q = nwg / NXCD, r = nwg % NXCD, xcd = wgid % NXCD, off = wgid / NXCD; return (xcd < r ? xcd * (q + 1) : r * (q + 1) + (xcd - r) * q) + off; }

struct Unit { int row0, col0, ex, bt, nvalid, lrow; };

struct DenseSched {
    int nM, nN, nwg, G, c, lat_only; const char* Bt; int K; const int* list;
    __device__ __forceinline__ void init(int nM_, int nN_, int G_, int c_, int lat_only_, const void* Bt_, int K_) { nM = nM_; nN = nN_; nwg = nM * nN; G = G_; c = c_; lat_only = lat_only_; Bt = (const char*)Bt_; K = K_; list = nullptr; }
    __device__ __forceinline__ bool next(int i, Unit& u) const {
        const long Lx = (long)i * G + c; if (Lx >= nwg) return false;
        const int wgid = xcd_remap((int)Lx, nwg);
        const int nig = WGM * nN, gid = wgid / nig, fm = gid * WGM, gsz = (nM - fm) < WGM ? (nM - fm) : WGM;
        const int pm = fm + ((wgid % nig) % gsz), pn = (wgid % nig) / gsz;
        const int tile = lat_only ? (pm / 16) * 17 + 1 + (pm % 16) : pm;
        u.row0 = tile * 256; u.col0 = pn * 256; u.ex = 0; u.bt = pn; u.nvalid = 256; u.lrow = 0; return true;
    }
    __device__ __forceinline__ const char* bptr(const Unit& u) const { return Bt + (size_t)u.bt * (256 * 1024 * 2); }
};
struct MoeSched {
    const LAS int* tpre; const LAS int* cnt; int NT, COLW, G, c, total; const char* Bt; int K; const int* list;
    __device__ __forceinline__ bool next(int i, Unit& u) const {
        const long Lx = (long)i * G + c; if (Lx >= total) return false;
        const int wgid = xcd_remap((int)Lx, total);
        int e = 0;
        for (int j = 1; j < NE; ++j) if (tpre[j] * NT <= wgid) e = j;
        const int t0 = tpre[e], mte = tpre[e + 1] - t0, loc = wgid - t0 * NT, nt = loc / mte, mt = loc % mte;
        u.ex = __builtin_amdgcn_readfirstlane(e); u.row0 = __builtin_amdgcn_readfirstlane((t0 + mt) * 256); u.col0 = __builtin_amdgcn_readfirstlane(nt * COLW);
        u.bt = __builtin_amdgcn_readfirstlane(e * NT + nt); const int nv = cnt[e] - mt * 256; u.nvalid = __builtin_amdgcn_readfirstlane(nv < 256 ? nv : 256); u.lrow = __builtin_amdgcn_readfirstlane(mt * 256);
        return true;
    }
    __device__ __forceinline__ const char* bptr(const Unit& u) const { return Bt + (size_t)u.bt * (256 * 1024 * 2); }
};

struct EpiP {
    static constexpr bool PERM = true; bf16_t* O;
    __device__ __forceinline__ void operator()(const f32x4 (&acc)[2][2][4][2], const Unit& u, int wr, int wc, int fr, int fq, const LAS int*) const {
#pragma unroll
        for (int ai = 0; ai < 2; ++ai)
#pragma unroll
            for (int m = 0; m < 4; ++m) { bf16_t* rowp = O + (size_t)(u.row0 + ai * HALF + wr * 64 + m * 16 + fr) * PP + u.col0 + wc * 32 + 8 * fq;
#pragma unroll
                for (int bj = 0; bj < 2; ++bj) { const f32x4 v0 = acc[ai][bj][m][0], v1 = acc[ai][bj][m][1]; u32x4 w; w.x = cvt_pk_bf16(v0[0], v0[1]); w.y = cvt_pk_bf16(v0[2], v0[3]); w.z = cvt_pk_bf16(v1[0], v1[1]); w.w = cvt_pk_bf16(v1[2], v1[3]);
                    *(u32x4*)(rowp + bj * HALF) = w; } }
    }
};
struct EpiH {
    static constexpr bool PERM = false; float* Hh; const float* MODl; int g_off;
    __device__ __forceinline__ void operator()(const f32x4 (&acc)[2][2][4][2], const Unit& u, int wr, int wc, int fr, int fq, const LAS int*) const {
        const int tile = u.row0 >> 8, v = (tile % 17 == 0) ? 4 : tile / 17; const float* gp = MODl + (size_t)v * 6144 + g_off + u.col0 + wc * 32 + 4 * fq;
        f32x4 gv[2][2];
#pragma unroll
        for (int bj = 0; bj < 2; ++bj)
#pragma unroll
            for (int n = 0; n < 2; ++n) gv[bj][n] = *(const f32x4*)(gp + bj * HALF + n * 16);
#pragma unroll
        for (int ai = 0; ai < 2; ++ai)
#pragma unroll
            for (int m = 0; m < 4; ++m) { float* rowp = Hh + (size_t)(u.row0 + ai * HALF + wr * 64 + m * 16 + fr) * D + u.col0 + wc * 32 + 4 * fq;
#pragma unroll
                for (int bj = 0; bj < 2; ++bj)
#pragma unroll
                    for (int n = 0; n < 2; ++n) { f32x4* p = (f32x4*)(rowp + bj * HALF + n * 16); *p = *p + gv[bj][n] * acc[ai][bj][m][n]; } }
    }
};
struct EpiMoe1 {
    static constexpr bool PERM = true; bf16_t* ACTp; const float* bgu;
    __device__ __forceinline__ void operator()(const f32x4 (&acc)[2][2][4][2], const Unit& u, int wr, int wc, int fr, int fq, const LAS int*) const {
        const int cc = u.col0 + wc * 32 + 8 * fq; const float* bp = bgu + (size_t)u.ex * 2048 + cc;
        f32x4 bg[2], bu[2];
#pragma unroll
        for (int n = 0; n < 2; ++n) { bg[n] = *(const f32x4*)(bp + 4 * n); bu[n] = *(const f32x4*)(bp + 1024 + 4 * n); }
#pragma unroll
        for (int ai = 0; ai < 2; ++ai)
#pragma unroll
            for (int m = 0; m < 4; ++m) { const int r = ai * HALF + wr * 64 + m * 16 + fr;
                float o[8];
#pragma unroll
                for (int n = 0; n < 2; ++n)
#pragma unroll
                    for (int i = 0; i < 4; ++i) { const float g = fminf(acc[ai][0][m][n][i] + bg[n][i], 7.f); const float uu = fminf(fmaxf(acc[ai][1][m][n][i] + bu[n][i], -7.f), 7.f);
                        o[n * 4 + i] = (uu + 1.f) * g * __builtin_amdgcn_rcpf(1.f + __expf(-1.702f * g)); }
                if (r < u.nvalid) { u32x4 w; w.x = cvt_pk_bf16(o[0], o[1]); w.y = cvt_pk_bf16(o[2], o[3]); w.z = cvt_pk_bf16(o[4], o[5]); w.w = cvt_pk_bf16(o[6], o[7]);
                    *(u32x4*)(ACTp + (size_t)(u.row0 + r) * D + cc) = w; } }
    }
};
struct EpiMoe2 {
    static constexpr bool PERM = true; bf16_t* Yp; const float* bd; const float* GATEp;
    __device__ __forceinline__ void operator()(const f32x4 (&acc)[2][2][4][2], const Unit& u, int wr, int wc, int fr, int fq, const LAS int* rows) const {
        const int cc = u.col0 + wc * 32 + 8 * fq; const float* bp = bd + (size_t)u.ex * 1024 + cc;
        f32x4 bv[2][2];
#pragma unroll
        for (int bj = 0; bj < 2; ++bj)
#pragma unroll
            for (int n = 0; n < 2; ++n) bv[bj][n] = *(const f32x4*)(bp + bj * HALF + 4 * n);
#pragma unroll
        for (int ai = 0; ai < 2; ++ai)
#pragma unroll
            for (int m = 0; m < 4; ++m) { const int r = ai * HALF + wr * 64 + m * 16 + fr;
                if (r < u.nvalid) { const int asg = rows[r]; const float gt = GATEp[asg]; bf16_t* rowp = Yp + (size_t)asg * D + cc;
#pragma unroll
                    for (int bj = 0; bj < 2; ++bj) { const f32x4 v0 = (acc[ai][bj][m][0] + bv[bj][0]) * gt, v1 = (acc[ai][bj][m][1] + bv[bj][1]) * gt;
                        u32x4 w; w.x = cvt_pk_bf16(v0[0], v0[1]); w.y = cvt_pk_bf16(v0[2], v0[3]); w.z = cvt_pk_bf16(v1[0], v1[1]); w.w = cvt_pk_bf16(v1[2], v1[3]); *(u32x4*)(rowp + bj * HALF) = w; } } }
    }
};

template <class Epi, class Sched, bool GATHER, bool ROWLIST>
__device__ __forceinline__ void gemm_phase(LAS unsigned char* lds, const char* Abase, const Sched& S, const Epi& E) {
    constexpr int K = 1024;
    int tid_l = threadIdx.x; asm volatile("" : "+v"(tid_l));
    const int tid = tid_l, wid = __builtin_amdgcn_readfirstlane(tid >> 6), lane = tid & 63, wr = wid >> 2, wc = wid & 3, fr = lane & 15, fq = lane >> 4;
    constexpr int nt = K / BK; constexpr unsigned Kb = (unsigned)K * 2u;
    unsigned voffB[2];
#pragma unroll
    for (int i = 0; i < 2; ++i) { int R, C; stage_rc(tid * 16 + i * 8192, R, C); const int Rb = Epi::PERM ? ((R & ~31) + perm32(R & 31)) : R; voffB[i] = (unsigned)(Rb * K + C) * 2u; }
    constexpr size_t kstep = (size_t)(BK * 2), hstep = (size_t)HALF * K * 2;
    const unsigned ldsw = (unsigned)wid * 1024u;
    const int aoff = lds_byte(wr * 64 + fr, fq * 8), boff = lds_byte(wc * 32 + fr, fq * 8);
    LAS int* rowbuf = (LAS int*)(lds + STAGE_BYTES);
#define G8_SA(b, h) (((b) * 2 + (h)) * HTB)
#define G8_SB(b, h) ((4 + (b) * 2 + (h)) * HTB)
#define G8_STAGE_A(bufoff, kb, v) do { _Pragma("unroll") for (int _i = 0; _i < 2; ++_i) \
        __builtin_amdgcn_global_load_lds((const unsigned*)((kb) + (size_t)(v)[_i]), (LAS unsigned*)(lds + (bufoff) + ldsw + _i * 8192), 16, 0, 0); } while (0)
#define G8_STAGE_B(bufoff, gbase) do { _Pragma("unroll") for (int _i = 0; _i < 2; ++_i) \
        __builtin_amdgcn_global_load_lds((const unsigned*)((gbase) + voffB[_i]), (LAS unsigned*)(lds + (bufoff) + ldsw + _i * 8192), 16, 0, 0); } while (0)
#define G8_LDA(dst, b, h) do { _Pragma("unroll") for (int m = 0; m < 4; ++m) _Pragma("unroll") for (int k = 0; k < 2; ++k) dst[m][k] = *(const LAS bf16x8*)(lds + G8_SA(b, h) + aoff + m * 2048 + k * 1024); } while (0)
#define G8_LDB(dst, b, h) do { _Pragma("unroll") for (int n = 0; n < 2; ++n) _Pragma("unroll") for (int k = 0; k < 2; ++k) dst[n][k] = *(const LAS bf16x8*)(lds + G8_SB(b, h) + boff + n * 2048 + k * 1024); } while (0)
#define G8_MMA(ai, bj, At, Bt) do { __builtin_amdgcn_s_setprio(1); _Pragma("unroll") for (int m = 0; m < 4; ++m) _Pragma("unroll") for (int n = 0; n < 2; ++n) _Pragma("unroll") for (int k = 0; k < 2; ++k) \
        acc[ai][bj][m][n] = __builtin_amdgcn_mfma_f32_16x16x32_bf16(Bt[n][k], At[m][k], acc[ai][bj][m][n], 0, 0, 0); __builtin_amdgcn_s_setprio(0); } while (0)
#define G8_WAIT_V(n) asm volatile("s_waitcnt vmcnt(" #n ")" ::: "memory")
#define G8_WAIT_L(n) asm volatile("s_waitcnt lgkmcnt(" #n ")" ::: "memory")
#define G8_BAR __builtin_amdgcn_s_barrier()
#define G8_SCHED __builtin_amdgcn_sched_barrier(0)
#define G8_LISTDMA(u, s) do { if (wid < 4) __builtin_amdgcn_global_load_lds((const unsigned*)(S.list + (size_t)(u).ex * LCAP + (u).lrow + wid * 64 + lane), (LAS unsigned*)(rowbuf + (s) * 256 + wid * 64), 4, 0, 0); } while (0)
#define G8_ROWS_DENSE(v) do { _Pragma("unroll") for (int _i = 0; _i < 2; ++_i) { int _R, _C; stage_rc(tid * 16 + _i * 8192, _R, _C); _Pragma("unroll") for (int _h = 0; _h < 2; ++_h) (v)[_h][_i] = (unsigned)(_h * HALF + _R) * Kb + (unsigned)_C * 2u; } } while (0)
#define G8_ROWS_LIST(v, u, s) do { _Pragma("unroll") for (int _i = 0; _i < 2; ++_i) { int _R, _C; stage_rc(tid * 16 + _i * 8192, _R, _C); _Pragma("unroll") for (int _h = 0; _h < 2; ++_h) { const int _r = _h * HALF + _R; const int _a = rowbuf[(s) * 256 + _r]; \
        (v)[_h][_i] = (unsigned)(_r < (u).nvalid ? (_a >> 2) : 0) * Kb + (unsigned)_C * 2u; } } } while (0)
    Unit cur, nxt; int ui = 0, slot = 0;
    if (!S.next(0, cur)) return;
    unsigned vA[2][2];
    if constexpr (ROWLIST) { G8_LISTDMA(cur, 0); G8_WAIT_V(0); G8_BAR; }
    if constexpr (GATHER) { G8_ROWS_LIST(vA, cur, 0); } else { G8_ROWS_DENSE(vA); }
    f32x4 acc[2][2][4][2];
#pragma unroll
    for (int a = 0; a < 2; ++a)
#pragma unroll
        for (int b = 0; b < 2; ++b)
#pragma unroll
            for (int m = 0; m < 4; ++m)
#pragma unroll
                for (int n = 0; n < 2; ++n) acc[a][b][m][n] = (f32x4){0.f, 0.f, 0.f, 0.f};
    bf16x8 At[4][2], B0[2][2], B1[2][2];
    const char* cB = S.bptr(cur);
    const char* cA = GATHER ? Abase : Abase + (size_t)cur.row0 * Kb;
    G8_STAGE_B(G8_SB(0, 0), cB); G8_STAGE_B(G8_SB(0, 1), cB + hstep); G8_STAGE_A(G8_SA(0, 0), cA, vA[0]); G8_STAGE_A(G8_SA(0, 1), cA, vA[1]);
    if (wr == 1) G8_BAR;
    G8_WAIT_V(2); G8_BAR;
    G8_STAGE_B(G8_SB(1, 0), cB + kstep); G8_STAGE_A(G8_SA(1, 0), cA + kstep, vA[0]); G8_STAGE_B(G8_SB(1, 1), cB + hstep + kstep);
    G8_WAIT_V(6); G8_BAR;
    for (;;) {
        const bool has_next = S.next(ui + 1, nxt);
        const char* nB = has_next ? S.bptr(nxt) : cB;
        const char* nA = (GATHER || !has_next) ? cA : Abase + (size_t)nxt.row0 * Kb;
        const int nslot = slot == 2 ? 0 : slot + 1;
        if constexpr (ROWLIST) { if (has_next) G8_LISTDMA(nxt, nslot); }
        for (int t = 0; t < nt; t += 2) {
            const bool last = (t == nt - 2);
            const char* a1 = cA + (size_t)(t + 1) * kstep;
            const char* a2 = last ? nA : cA + (size_t)(t + 2) * kstep; const char* b2 = last ? nB : cB + (size_t)(t + 2) * kstep;
            const char* a3 = a2 + kstep; const char* b3 = b2 + kstep;
            G8_LDB(B0, 0, 0); G8_LDB(B1, 0, 1); G8_SCHED; G8_LDA(At, 0, 0); G8_STAGE_A(G8_SA(1, 1), a1, vA[1]);
            if constexpr (GATHER) { if (last && has_next) { G8_ROWS_LIST(vA, nxt, nslot); } }
            G8_WAIT_V(8); G8_WAIT_L(0); G8_BAR; G8_MMA(0, 0, At, B0); G8_MMA(0, 1, At, B1); G8_BAR; G8_SCHED;
            G8_LDA(At, 0, 1); G8_STAGE_B(G8_SB(0, 0), b2); G8_STAGE_B(G8_SB(0, 1), b2 + hstep); G8_STAGE_A(G8_SA(0, 0), a2, vA[0]);
            G8_WAIT_V(8); G8_WAIT_L(0); G8_BAR; G8_MMA(1, 0, At, B0); G8_MMA(1, 1, At, B1); G8_BAR; G8_SCHED;
            G8_LDB(B0, 1, 0); G8_LDB(B1, 1, 1); G8_SCHED; G8_LDA(At, 1, 0); G8_STAGE_A(G8_SA(0, 1), a2, vA[1]);
            G8_WAIT_V(8); G8_WAIT_L(0); G8_BAR; G8_MMA(0, 0, At, B0); G8_MMA(0, 1, At, B1); G8_BAR; G8_SCHED;
            G8_LDA(At, 1, 1); G8_STAGE_B(G8_SB(1, 0), b3); G8_STAGE_B(G8_SB(1, 1), b3 + hstep); G8_STAGE_A(G8_SA(1, 0), a3, vA[0]);
            G8_WAIT_V(8); G8_WAIT_L(0); G8_BAR; G8_MMA(1, 0, At, B0); G8_MMA(1, 1, At, B1); G8_BAR; G8_SCHED;
        }
        if (wr == 0) G8_BAR;
        { int t2 = threadIdx.x; asm volatile("" : "+v"(t2));
          const int w2 = __builtin_amdgcn_readfirstlane(t2 >> 6); E(acc, cur, w2 >> 2, w2 & 3, t2 & 15, (t2 & 63) >> 4, rowbuf + slot * 256); }
        if (!has_next) break;
#pragma unroll
        for (int a = 0; a < 2; ++a)
#pragma unroll
            for (int b = 0; b < 2; ++b)
#pragma unroll
                for (int m = 0; m < 4; ++m)
#pragma unroll
                    for (int n = 0; n < 2; ++n) acc[a][b][m][n] = (f32x4){0.f, 0.f, 0.f, 0.f};
        cur = nxt; cB = nB; cA = nA; ++ui; slot = nslot;
        if (wr == 1) G8_BAR;
    }
    G8_WAIT_V(0);
    G8_BAR;
#undef G8_SA
#undef G8_SB
#undef G8_STAGE_A
#undef G8_STAGE_B
#undef G8_LDA
#undef G8_LDB
#undef G8_MMA
#undef G8_WAIT_V
#undef G8_WAIT_L
#undef G8_BAR
#undef G8_SCHED
#undef G8_LISTDMA
#undef G8_ROWS_DENSE
#undef G8_ROWS_LIST
}
}

namespace fft {
constexpr int TP = 72;
constexpr int UP = 264;
constexpr int ZP = 520;
constexpr int O_TC = 0, O_TS = 9216, O_U = 18432, O_X = 52224, O_TW = 125952;
__device__ __forceinline__ bf16x8 neg8(bf16x8 v) { u32x4 w = __builtin_bit_cast(u32x4, v); w = w ^ 0x80008000u; return __builtin_bit_cast(bf16x8, w); }
__device__ __forceinline__ void build_tables(LAS unsigned char* lds, const float* TABC, const float* TABS, int tid) {
    for (int i = tid; i < 4096; i += 512) { const int a = i >> 6, b = i & 63, ix = ((a * b) & 63) * 64;
        ((LAS bf16_t*)(lds + O_TC))[a * TP + b] = f2bf(TABC[ix]); ((LAS bf16_t*)(lds + O_TS))[a * TP + b] = f2bf(TABS[ix]); }
}
__device__ __forceinline__ void stage_a(LAS unsigned char* lds, const bf16_t* P, const float* TABC, const float* TABS, bf16_t* ZBUF, int G, int bx) {
    int tid_l = threadIdx.x; asm volatile("" : "+v"(tid_l));
    const int tid = tid_l, lane = tid & 63, w = __builtin_amdgcn_readfirstlane(tid >> 6), fr = lane & 15, fq = lane >> 4;
    build_tables(lds, TABC, TABS, tid);
    const LAS bf16_t* Tc = (const LAS bf16_t*)(lds + O_TC); const LAS bf16_t* Ts = (const LAS bf16_t*)(lds + O_TS);
    LAS bf16_t* U = (LAS bf16_t*)(lds + O_U); LAS bf16_t* X = (LAS bf16_t*)(lds + O_X); LAS float* TW = (LAS float*)(lds + O_TW);
    for (int unit = bx; unit < 256; unit += G) {
        const int b = unit >> 6, t2 = unit & 63;
#pragma unroll
        for (int i = 0; i < 4; ++i) { const int q = tid + 512 * i, t1 = q >> 5, ch = q & 31;
            *(LAS u32x4*)((LAS unsigned char*)U + t1 * (UP * 2) + ch * 16) = *(const u32x4*)(P + ((size_t)b * NPOS + CTX + 64 * t1 + t2) * PP + ch * 8); }
        if (tid < 64) { const int ix = tid * t2; TW[2 * tid] = TABC[ix]; TW[2 * tid + 1] = TABS[ix]; }
        __syncthreads();
        { const int g = w >> 1, part = w & 1; const LAS bf16_t* T = part ? Ts : Tc;
          f32x4 acc[4][4];
#pragma unroll
          for (int mt = 0; mt < 4; ++mt)
#pragma unroll
              for (int nt = 0; nt < 4; ++nt) acc[mt][nt] = (f32x4){0.f, 0.f, 0.f, 0.f};
#pragma unroll
          for (int ks = 0; ks < 2; ++ks) { bf16x8 a[4], bb[4];
#pragma unroll
              for (int mt = 0; mt < 4; ++mt) a[mt] = *(const LAS bf16x8*)(U + (16 * mt + fr) * UP + g * 64 + 32 * ks + 8 * fq);
#pragma unroll
              for (int nt = 0; nt < 4; ++nt) bb[nt] = *(const LAS bf16x8*)(T + (16 * nt + fr) * TP + 32 * ks + 8 * fq);
#pragma unroll
              for (int mt = 0; mt < 4; ++mt)
#pragma unroll
                  for (int nt = 0; nt < 4; ++nt) acc[mt][nt] = __builtin_amdgcn_mfma_f32_16x16x32_bf16(a[mt], bb[nt], acc[mt][nt], 0, 0, 0); }
          const float sg = part ? -1.f : 1.f;
#pragma unroll
          for (int mt = 0; mt < 4; ++mt)
#pragma unroll
              for (int nt = 0; nt < 4; ++nt) { const f32x4 v = acc[mt][nt] * sg; u32x2 o; o.x = pk2(v[0], v[1]); o.y = pk2(v[2], v[3]);
                  *(LAS u32x2*)(X + (part * 256 + g * 64 + 16 * nt + fr) * TP + 16 * mt + 4 * fq) = o; } }
        __syncthreads();
        f32x4 zr[4][2], zi[4][2];
#pragma unroll
        for (int mt = 0; mt < 4; ++mt)
#pragma unroll
            for (int n = 0; n < 2; ++n) { zr[mt][n] = (f32x4){0.f, 0.f, 0.f, 0.f}; zi[mt][n] = (f32x4){0.f, 0.f, 0.f, 0.f}; }
#pragma unroll
        for (int ks = 0; ks < 2; ++ks) { bf16x8 xr[2], xi[2];
#pragma unroll
            for (int n = 0; n < 2; ++n) { xr[n] = *(const LAS bf16x8*)(X + (32 * w + 16 * n + fr) * TP + 32 * ks + 8 * fq); xi[n] = *(const LAS bf16x8*)(X + (256 + 32 * w + 16 * n + fr) * TP + 32 * ks + 8 * fq); }
#pragma unroll
            for (int mt = 0; mt < 4; ++mt) { const bf16x8 c = *(const LAS bf16x8*)(Tc + (16 * mt + fr) * TP + 32 * ks + 8 * fq), s = *(const LAS bf16x8*)(Ts + (16 * mt + fr) * TP + 32 * ks + 8 * fq), ns = neg8(s);
#pragma unroll
                for (int n = 0; n < 2; ++n) { zr[mt][n] = __builtin_amdgcn_mfma_f32_16x16x32_bf16(c, xr[n], zr[mt][n], 0, 0, 0); zr[mt][n] = __builtin_amdgcn_mfma_f32_16x16x32_bf16(s, xi[n], zr[mt][n], 0, 0, 0);
                    zi[mt][n] = __builtin_amdgcn_mfma_f32_16x16x32_bf16(c, xi[n], zi[mt][n], 0, 0, 0); zi[mt][n] = __builtin_amdgcn_mfma_f32_16x16x32_bf16(ns, xr[n], zi[mt][n], 0, 0, 0); } } }
        __syncthreads();
        { LAS bf16_t* Zs = X;
#pragma unroll
          for (int mt = 0; mt < 4; ++mt)
#pragma unroll
              for (int i = 0; i < 4; ++i) { const int f1 = 16 * mt + 4 * fq + i; const float ct = TW[2 * f1], st = TW[2 * f1 + 1];
#pragma unroll
                  for (int n = 0; n < 2; ++n) { const float a = zr[mt][n][i], bq = zi[mt][n][i]; const int col = 32 * w + 16 * n + fr;
                      Zs[f1 * ZP + col] = f2bf(a * ct + bq * st); Zs[f1 * ZP + 256 + col] = f2bf(bq * ct - a * st); } } }
        __syncthreads();
#pragma unroll
        for (int i = 0; i < 8; ++i) { const int q = tid + 512 * i, f1 = q >> 6, ch = q & 63;
            *(u32x4*)(ZBUF + (((size_t)b * 64 + f1) * 64 + t2) * 512 + ch * 8) = *(const LAS u32x4*)((const LAS unsigned char*)X + f1 * (ZP * 2) + ch * 16); }
        __syncthreads();
    }
}
__device__ __forceinline__ void stage_b(LAS unsigned char* lds, const bf16_t* ZBUF, const float* TABC, const float* TABS, bf16_t* MIX, int G, int bx) {
    int tid_l = threadIdx.x; asm volatile("" : "+v"(tid_l));
    const int tid = tid_l, lane = tid & 63, w = __builtin_amdgcn_readfirstlane(tid >> 6), fr = lane & 15, fq = lane >> 4;
    build_tables(lds, TABC, TABS, tid);
    const LAS bf16_t* Tc = (const LAS bf16_t*)(lds + O_TC); const LAS bf16_t* Ts = (const LAS bf16_t*)(lds + O_TS);
    LAS bf16_t* Ys = (LAS bf16_t*)(lds + O_U); LAS bf16_t* ZT = (LAS bf16_t*)(lds + O_X);
    for (int unit = bx; unit < 256; unit += G) {
        const int b = unit >> 6, f1 = unit & 63;
        const bf16_t* Zg = ZBUF + ((size_t)b * 64 + f1) * 64 * 512;
#pragma unroll
        for (int i = 0; i < 4; ++i) { const int q = tid + 512 * i, p = q & 31, ch = q >> 5;
            const u32x4 r0 = *(const u32x4*)(Zg + (size_t)(2 * p) * 512 + ch * 8), r1 = *(const u32x4*)(Zg + (size_t)(2 * p + 1) * 512 + ch * 8);
#pragma unroll
            for (int j = 0; j < 4; ++j) { const unsigned a = r0[j], c = r1[j];
                *(LAS unsigned*)(ZT + (ch * 8 + 2 * j) * TP + 2 * p) = (a & 0xffffu) | (c << 16);
                *(LAS unsigned*)(ZT + (ch * 8 + 2 * j + 1) * TP + 2 * p) = (a >> 16) | (c & 0xffff0000u); } }
        __syncthreads();
        f32x4 y[4][2];
#pragma unroll
        for (int mt = 0; mt < 4; ++mt)
#pragma unroll
            for (int n = 0; n < 2; ++n) y[mt][n] = (f32x4){0.f, 0.f, 0.f, 0.f};
#pragma unroll
        for (int ks = 0; ks < 2; ++ks) { bf16x8 xr[2], xi[2];
#pragma unroll
            for (int n = 0; n < 2; ++n) { xr[n] = *(const LAS bf16x8*)(ZT + (32 * w + 16 * n + fr) * TP + 32 * ks + 8 * fq); xi[n] = *(const LAS bf16x8*)(ZT + (256 + 32 * w + 16 * n + fr) * TP + 32 * ks + 8 * fq); }
#pragma unroll
            for (int mt = 0; mt < 4; ++mt) { const bf16x8 c = *(const LAS bf16x8*)(Tc + (16 * mt + fr) * TP + 32 * ks + 8 * fq), s = *(const LAS bf16x8*)(Ts + (16 * mt + fr) * TP + 32 * ks + 8 * fq);
#pragma unroll
                for (int n = 0; n < 2; ++n) { y[mt][n] = __builtin_amdgcn_mfma_f32_16x16x32_bf16(c, xr[n], y[mt][n], 0, 0, 0); y[mt][n] = __builtin_amdgcn_mfma_f32_16x16x32_bf16(s, xi[n], y[mt][n], 0, 0, 0); } } }
#pragma unroll
        for (int mt = 0; mt < 4; ++mt)
#pragma unroll
            for (int i = 0; i < 4; ++i)
#pragma unroll
                for (int n = 0; n < 2; ++n) Ys[(16 * mt + 4 * fq + i) * UP + 32 * w + 16 * n + fr] = f2bf(y[mt][n][i] * (1.f / 512.f));
        __syncthreads();
#pragma unroll
        for (int i = 0; i < 4; ++i) { const int q = tid + 512 * i, f2 = q >> 5, ch = q & 31;
            *(u32x4*)(MIX + ((size_t)b * NPOS + CTX + f1 + 64 * f2) * D + ch * 8) = *(const LAS u32x4*)((const LAS unsigned char*)Ys + f2 * (UP * 2) + ch * 16); }
        __syncthreads();
    }
}
}

namespace attn {
typedef float f32x16 __attribute__((ext_vector_type(16)));
typedef float f32x2_t __attribute__((ext_vector_type(2))); typedef __bf16 bf16x2_t __attribute__((ext_vector_type(2)));
__device__ __forceinline__ unsigned cvtpk(float lo, float hi) { f32x2_t v = {lo, hi}; bf16x2_t b = __builtin_convertvector(v, bf16x2_t); return __builtin_bit_cast(unsigned, b); }
constexpr int KP = 104, VP = 68;
constexpr int KT_BYTES = 64 * KP * 2, VT_BYTES = 64 * VP * 2, BUF_BYTES = KT_BYTES + VT_BYTES;
constexpr float C2 = 0.10206207261596577f * 1.4426950408889634f;
__device__ __forceinline__ void attn_phase(LAS unsigned char* lds, const bf16_t* QL, const bf16_t* QC, const bf16_t* KB, const bf16_t* VTG, bf16_t* MIX, int with_ctx, int G, int vcu) {
    int tid_l = threadIdx.x; asm volatile("" : "+v"(tid_l));
    const int tid = tid_l, lane = tid & 63, wid = __builtin_amdgcn_readfirstlane(tid >> 6), r32 = lane & 31, hi = lane >> 5;
    const int nunits = 256 + (with_ctx ? 16 : 0);
    for (int unit = vcu; unit < nunits; unit += G) {
        int bh, nk, orow0; const bf16_t* Qp;
        if (unit < 256) { bh = unit >> 4; const int qb = unit & 15; Qp = QL + ((size_t)bh * SEQ + qb * 256) * 96; nk = NPOS; orow0 = (bh >> 2) * NPOS + CTX + qb * 256; }
        else { bh = unit - 256; Qp = QC + (size_t)bh * CTX * 96; nk = CTX; orow0 = (bh >> 2) * NPOS; }
        const int hh = bh & 3, NT = nk / 64;
        const bf16_t* Kg = KB + (size_t)bh * NPOS * 96; const bf16_t* Vg = VTG + (size_t)bh * 64 * NPOS;
        bf16x8 qf[6];
        { const bf16_t* qp = Qp + (size_t)(wid * 32 + r32) * 96 + 8 * hi;
#pragma unroll
          for (int ds = 0; ds < 6; ++ds) qf[ds] = *(const bf16x8*)(qp + 16 * ds); }
        f32x16 o0 = {}, o1 = {}; float m = -1e30f, l = 0.f;
        const int kr0 = tid / 12, kc0 = tid % 12, kr1 = (tid + 512) / 12, kc1 = (tid + 512) % 12; const bool k1ok = tid < 256;
        const int vd = tid >> 3, vc = tid & 7;
        u32x4 sk0, sk1 = {}, sv;
        sk0 = *(const u32x4*)(Kg + (size_t)kr0 * 96 + kc0 * 8); if (k1ok) sk1 = *(const u32x4*)(Kg + (size_t)kr1 * 96 + kc1 * 8); sv = *(const u32x4*)(Vg + (size_t)vd * NPOS + vc * 8);
        int cur = 0;
        { LAS unsigned char* bp = lds; *(LAS u32x4*)(bp + kr0 * (KP * 2) + kc0 * 16) = sk0; if (k1ok) *(LAS u32x4*)(bp + kr1 * (KP * 2) + kc1 * 16) = sk1; *(LAS u32x4*)(bp + KT_BYTES + vd * (VP * 2) + vc * 16) = sv; }
        __syncthreads();
        for (int t = 0; t < NT; ++t) {
            if (t + 1 < NT) { const size_t k0 = (size_t)(t + 1) * 64;
                sk0 = *(const u32x4*)(Kg + (k0 + kr0) * 96 + kc0 * 8); if (k1ok) sk1 = *(const u32x4*)(Kg + (k0 + kr1) * 96 + kc1 * 8); sv = *(const u32x4*)(Vg + (size_t)vd * NPOS + k0 + vc * 8); }
            const LAS bf16_t* Kt = (const LAS bf16_t*)(lds + cur * BUF_BYTES); const LAS bf16_t* Vt = (const LAS bf16_t*)(lds + cur * BUF_BYTES + KT_BYTES);
            f32x16 p0 = {}, p1 = {};
#pragma unroll
            for (int ds = 0; ds < 6; ++ds) { const bf16x8 k0f = *(const LAS bf16x8*)(Kt + r32 * KP + 16 * ds + 8 * hi), k1f = *(const LAS bf16x8*)(Kt + (32 + r32) * KP + 16 * ds + 8 * hi);
                p0 = __builtin_amdgcn_mfma_f32_32x32x16_bf16(k0f, qf[ds], p0, 0, 0, 0); p1 = __builtin_amdgcn_mfma_f32_32x32x16_bf16(k1f, qf[ds], p1, 0, 0, 0); }
            float mx = fmaxf(p0[0], p1[0]);
#pragma unroll
            for (int r = 1; r < 16; ++r) mx = fmaxf(mx, fmaxf(p0[r], p1[r]));
            mx = fmaxf(mx, __shfl_xor(mx, 32));
            const float mn = fmaxf(m, mx), alpha = __builtin_amdgcn_exp2f(m - mn); m = mn;
            float ls = 0.f;
#pragma unroll
            for (int r = 0; r < 16; ++r) { p0[r] = __builtin_amdgcn_exp2f(p0[r] - mn); p1[r] = __builtin_amdgcn_exp2f(p1[r] - mn); ls += p0[r] + p1[r]; }
            l = l * alpha + ls;
#pragma unroll
            for (int r = 0; r < 16; ++r) { o0[r] *= alpha; o1[r] *= alpha; }
#pragma unroll
            for (int s = 0; s < 4; ++s) {
                u32x4 pw;
#pragma unroll
                for (int j = 0; j < 4; ++j) { const int r = 8 * (s & 1) + 2 * j; pw[j] = (s < 2) ? cvtpk(p0[r], p0[r + 1]) : cvtpk(p1[r], p1[r + 1]); }
                const bf16x8 pf = __builtin_bit_cast(bf16x8, pw);
                const int kvb = 32 * (s >> 1) + 16 * (s & 1) + 4 * hi;
#pragma unroll
                for (int db = 0; db < 2; ++db) { const u32x2 va = *(const LAS u32x2*)(Vt + (32 * db + r32) * VP + kvb), vb = *(const LAS u32x2*)(Vt + (32 * db + r32) * VP + kvb + 8);
                    const u32x4 vw = {va.x, va.y, vb.x, vb.y}; const bf16x8 vf = __builtin_bit_cast(bf16x8, vw);
                    if (db == 0) o0 = __builtin_amdgcn_mfma_f32_32x32x16_bf16(vf, pf, o0, 0, 0, 0); else o1 = __builtin_amdgcn_mfma_f32_32x32x16_bf16(vf, pf, o1, 0, 0, 0); }
            }
            if (t + 1 < NT) { LAS unsigned char* bp = lds + (cur ^ 1) * BUF_BYTES;
                *(LAS u32x4*)(bp + kr0 * (KP * 2) + kc0 * 16) = sk0; if (k1ok) *(LAS u32x4*)(bp + kr1 * (KP * 2) + kc1 * 16) = sk1; *(LAS u32x4*)(bp + KT_BYTES + vd * (VP * 2) + vc * 16) = sv; }
            __syncthreads();
            cur ^= 1;
        }
        l += __shfl_xor(l, 32);
        const float il = 1.f / l;
        bf16_t* op = MIX + (size_t)(orow0 + wid * 32 + r32) * D + 512 + hh * 64 + 4 * hi;
#pragma unroll
        for (int g4 = 0; g4 < 4; ++g4) { u32x2 w0, w1; w0.x = cvtpk(o0[4 * g4] * il, o0[4 * g4 + 1] * il); w0.y = cvtpk(o0[4 * g4 + 2] * il, o0[4 * g4 + 3] * il);
            w1.x = cvtpk(o1[4 * g4] * il, o1[4 * g4 + 1] * il); w1.y = cvtpk(o1[4 * g4 + 2] * il, o1[4 * g4 + 3] * il);
            *(u32x2*)(op + 8 * g4) = w0; *(u32x2*)(op + 32 + 8 * g4) = w1; }
    }
}
}

namespace sm {
__device__ __forceinline__ float silu(float x) { return x / (1.f + __expf(-x)); }
__device__ __forceinline__ void mod_phase(LAS unsigned char* lds, const float* c, const float* c_ctx, const float* mod_w, const float* mod_b, float* MOD, int G, int bx, int tid) {
    LAS float* s = (LAS float*)lds;
    for (int i = tid; i < 5120; i += 512) { const int v = i >> 10, k = i & 1023; s[i] = silu(v < 4 ? c[v * 1024 + k] : c_ctx[k]); }
    __syncthreads();
    LAS float* red = s + 5120;
    for (int unit = bx; unit < 96; unit += G) {
        const int l = unit / 48, cb = unit % 48, cl = tid & 127, col = cb * 128 + cl, kq = tid >> 7, k0 = kq * 256;
        const float* W = mod_w + ((size_t)l * 1024 + k0) * 6144 + col;
        float a0 = 0.f, a1 = 0.f, a2 = 0.f, a3 = 0.f, a4 = 0.f;
#pragma unroll 16
        for (int k = 0; k < 256; ++k) { const float w = W[(size_t)k * 6144]; a0 += s[k0 + k] * w; a1 += s[1024 + k0 + k] * w; a2 += s[2048 + k0 + k] * w; a3 += s[3072 + k0 + k] * w; a4 += s[4096 + k0 + k] * w; }
        LAS float* rq = red + kq * 640 + cl; rq[0] = a0; rq[128] = a1; rq[256] = a2; rq[384] = a3; rq[512] = a4;
        __syncthreads();
        for (int i = tid; i < 640; i += 512) { const int v = i >> 7, cc = i & 127; const float r = ((red[i] + red[640 + i]) + (red[1280 + i] + red[1920 + i])) + mod_b[l * 6144 + cb * 128 + cc];
            MOD[((size_t)l * 5 + v) * 6144 + cb * 128 + cc] = r; }
        __syncthreads();
    }
}
__device__ __forceinline__ void norm_store(const float4 (&x)[4], float ss, const float* g, const float* mv, int sh_off, int sc_off, bf16_t* xn_row, int lane) {
    const float rs = rsqrtf(wave_sum(ss) * (1.f / D) + 1e-6f);
#pragma unroll
    for (int j = 0; j < 4; ++j) { const int c = (j * 64 + lane) * 4; const float4 gg = *(const float4*)(g + c), sh = *(const float4*)(mv + sh_off + c), sc = *(const float4*)(mv + sc_off + c);
        u32x2 o; o.x = pk2(x[j].x * rs * gg.x * (1.f + sc.x) + sh.x, x[j].y * rs * gg.y * (1.f + sc.y) + sh.y); o.y = pk2(x[j].z * rs * gg.z * (1.f + sc.z) + sh.z, x[j].w * rs * gg.w * (1.f + sc.w) + sh.w);
        *(u32x2*)(xn_row + c) = o; }
}
__device__ __forceinline__ void pro1_phase(const float* x, const float* ctx, const float* g, const float* MODl, float* H, bf16_t* XN, int gw, int NGW, int lane) {
    for (int r = gw; r < MROWS; r += NGW) { const int b = r / NPOS, pos = r % NPOS, v = pos < CTX ? 4 : b;
        const float* src = pos < CTX ? ctx + ((size_t)b * CTX + pos) * D : x + ((size_t)b * SEQ + (pos - CTX)) * D;
        float4 xv[4]; float ss = 0.f;
#pragma unroll
        for (int j = 0; j < 4; ++j) { const int c = (j * 64 + lane) * 4; xv[j] = *(const float4*)(src + c); *(float4*)(H + (size_t)r * D + c) = xv[j]; ss += xv[j].x * xv[j].x + xv[j].y * xv[j].y + xv[j].z * xv[j].z + xv[j].w * xv[j].w; }
        norm_store(xv, ss, g, MODl + (size_t)v * 6144, 0, 1024, XN + (size_t)r * D, lane); }
}
__device__ __forceinline__ void comb_phase(int l, float* H, const bf16_t* Y, const float* MODl, const float* g_next, const float* MODn, bf16_t* XN, const float* final_g, float* out, int gw, int NGW, int lane) {
    for (int r = gw; r < MROWS; r += NGW) { const int b = r / NPOS, pos = r % NPOS, v = pos < CTX ? 4 : b;
        if (l == 1 && pos < CTX) continue;
        const float* g2 = MODl + (size_t)v * 6144 + 5120;
        float4 xv[4]; float ss = 0.f;
#pragma unroll
        for (int j = 0; j < 4; ++j) { const int c = (j * 64 + lane) * 4; xv[j] = *(const float4*)(H + (size_t)r * D + c); float4 s = make_float4(0.f, 0.f, 0.f, 0.f);
#pragma unroll
            for (int k = 0; k < 4; ++k) { const u32x2 y = *(const u32x2*)(Y + ((size_t)r * 4 + k) * D + c); s.x += __uint_as_float(y.x << 16); s.y += __uint_as_float(y.x & 0xffff0000u); s.z += __uint_as_float(y.y << 16); s.w += __uint_as_float(y.y & 0xffff0000u); }
            const float4 gg = *(const float4*)(g2 + c); xv[j].x += gg.x * s.x; xv[j].y += gg.y * s.y; xv[j].z += gg.z * s.z; xv[j].w += gg.w * s.w;
            ss += xv[j].x * xv[j].x + xv[j].y * xv[j].y + xv[j].z * xv[j].z + xv[j].w * xv[j].w; }
        if (l == 0) {
#pragma unroll
            for (int j = 0; j < 4; ++j) *(float4*)(H + (size_t)r * D + (j * 64 + lane) * 4) = xv[j];
            norm_store(xv, ss, g_next, MODn + (size_t)v * 6144, 0, 1024, XN + (size_t)r * D, lane);
        } else { const float rs = rsqrtf(wave_sum(ss) * (1.f / D) + 1e-6f); float* op = out + ((size_t)b * SEQ + (pos - CTX)) * D;
#pragma unroll
            for (int j = 0; j < 4; ++j) { const int c = (j * 64 + lane) * 4; const float4 fg = *(const float4*)(final_g + c); float4 o; o.x = xv[j].x * rs * fg.x; o.y = xv[j].y * rs * fg.y; o.z = xv[j].z * rs * fg.z; o.w = xv[j].w * rs * fg.w; *(float4*)(op + c) = o; } }
    }
}
__device__ __forceinline__ void route_phase(LAS unsigned char* lds, int l, const float* H, const float* g, const float* MODl, const float* rw, const float* rb, bf16_t* XN, int* CNT, int* LIST, float* GATE,
                                            int G, int bx, int tid) {
    const int lane = tid & 63, wave = __builtin_amdgcn_readfirstlane(tid >> 6), e = lane & 31, kpart = wave * 2 + (lane >> 5);
    LAS float* F = (LAS float*)lds;
    LAS float* PART = (LAS float*)(lds + 32768);
    LAS int* LCNT = (LAS int*)(lds + 49152);
    LAS int* LBASE = LCNT + 64; LAS int* LENT = LCNT + 128;
    if (tid < 64) LCNT[tid] = 0;
    __syncthreads();
    float w[64];
#pragma unroll
    for (int k = 0; k < 64; ++k) w[k] = rw[(size_t)(kpart * 64 + k) * 32 + e];
    const float bias = rb[e];
    const int nb = l == 1 ? (MROWS - NB_ * CTX) / 8 : MROWS / 8;
    for (int bi = bx; bi < nb; bi += G) {
        int r;
        if (l == 1) { const int q = bi * 8 + wave; r = (q / SEQ) * NPOS + CTX + (q % SEQ); } else r = bi * 8 + wave;
        const int b = r / NPOS, pos = r % NPOS, v = pos < CTX ? 4 : b; const float* mv = MODl + (size_t)v * 6144;
        { float4 xv[4]; float ss = 0.f;
#pragma unroll
          for (int j = 0; j < 4; ++j) { xv[j] = *(const float4*)(H + (size_t)r * D + (j * 64 + lane) * 4); ss += xv[j].x * xv[j].x + xv[j].y * xv[j].y + xv[j].z * xv[j].z + xv[j].w * xv[j].w; }
          const float rs = rsqrtf(wave_sum(ss) * (1.f / D) + 1e-6f);
#pragma unroll
          for (int j = 0; j < 4; ++j) { const int c = (j * 64 + lane) * 4; const float4 gg = *(const float4*)(g + c), sh = *(const float4*)(mv + 3072 + c), sc = *(const float4*)(mv + 4096 + c);
              f32x4 f; f[0] = xv[j].x * rs * gg.x * (1.f + sc.x) + sh.x; f[1] = xv[j].y * rs * gg.y * (1.f + sc.y) + sh.y; f[2] = xv[j].z * rs * gg.z * (1.f + sc.z) + sh.z; f[3] = xv[j].w * rs * gg.w * (1.f + sc.w) + sh.w;
              *(LAS f32x4*)(F + wave * 1024 + c) = f; u32x2 o; o.x = pk2(f[0], f[1]); o.y = pk2(f[2], f[3]); *(u32x2*)(XN + (size_t)r * D + c) = o; } }
        __syncthreads();
        { float acc[8];
#pragma unroll
          for (int rr = 0; rr < 8; ++rr) acc[rr] = 0.f;
#pragma unroll
          for (int k4 = 0; k4 < 16; ++k4) {
#pragma unroll
              for (int rr = 0; rr < 8; ++rr) { const f32x4 f = *(const LAS f32x4*)(F + rr * 1024 + kpart * 64 + k4 * 4); acc[rr] += f[0] * w[k4 * 4] + f[1] * w[k4 * 4 + 1] + f[2] * w[k4 * 4 + 2] + f[3] * w[k4 * 4 + 3]; } }
#pragma unroll
          for (int rr = 0; rr < 8; ++rr) PART[(rr * 16 + kpart) * 32 + e] = acc[rr]; }
        __syncthreads();
        { float lg = bias;
#pragma unroll
          for (int kp = 0; kp < 16; ++kp) lg += PART[(wave * 16 + kp) * 32 + e];
          float val = lane < 32 ? lg : -3e38f; int idx = e; float tv[4]; int ti[4];
#pragma unroll
          for (int k = 0; k < 4; ++k) { float bv = val; int bi2 = idx;
#pragma unroll
              for (int o = 1; o < 32; o <<= 1) { const float ov = __shfl_xor(bv, o); const int oi = __shfl_xor(bi2, o); if (ov > bv || (ov == bv && oi < bi2)) { bv = ov; bi2 = oi; } }
              tv[k] = bv; ti[k] = bi2; if (idx == bi2) val = -3e38f; }
          if (lane == 0) { float ex[4], sum = 0.f;
#pragma unroll
              for (int k = 0; k < 4; ++k) { ex[k] = __expf(tv[k] - tv[0]); sum += ex[k]; }
              const float isum = 1.f / sum;
#pragma unroll
              for (int k = 0; k < 4; ++k) { const int asg = r * 4 + k; GATE[asg] = ex[k] * isum; const int rank = __hip_atomic_fetch_add(&LCNT[ti[k]], 1, __ATOMIC_RELAXED, __HIP_MEMORY_SCOPE_WORKGROUP); const int slot = __hip_atomic_fetch_add(&LCNT[32], 1, __ATOMIC_RELAXED, __HIP_MEMORY_SCOPE_WORKGROUP);
                  LENT[slot * 2] = asg; LENT[slot * 2 + 1] = (ti[k] << 16) | rank; } } }
        __syncthreads();
    }
    if (tid < 32) LBASE[tid] = LCNT[tid] > 0 ? atomicAdd(&CNT[tid * L::CNT_STRIDE], LCNT[tid]) : 0;
    __syncthreads();
    for (int i = tid; i < LCNT[32]; i += 512) { const int asg = LENT[i * 2], er = LENT[i * 2 + 1], ee = er >> 16, rank = er & 0xffff; LIST[(size_t)ee * LCAP + LBASE[ee] + rank] = asg; }
    __syncthreads();
}
__device__ __forceinline__ void smallw_phase(const float* w_uq, const float* qg, const float* w_ukv, const float* kvg, const float* w_a, const float* w_i, bf16_t* WUQT, bf16_t* WUKVT, bf16_t* WAT, bf16_t* WIT,
                                             float* TABC, float* TABS, const float* lam, float* SPT, int gt, int NGT) {
    for (int i = gt; i < 2 * 384 * 256; i += NGT) { const int l = i / (384 * 256), q = i % (384 * 256), n = q >> 8, k = q & 255; WUQT[i] = f2bf(qg[l * 256 + k] * w_uq[((size_t)l * 256 + k) * 384 + n]); }
    for (int i = gt; i < 2 * 512 * 128; i += NGT) { const int l = i / (512 * 128), q = i % (512 * 128), n = q >> 7, k = q & 127; WUKVT[i] = f2bf(kvg[l * 128 + k] * w_ukv[((size_t)l * 128 + k) * 512 + n]); }
    for (int i = gt; i < 16 * 4096; i += NGT) { const int m = i >> 12, q = i & 4095, e = q >> 6, d = q & 63; WAT[i] = f2bf(w_a[(size_t)m * 4096 + d * 64 + e]); WIT[i] = f2bf(w_i[(size_t)m * 4096 + d * 64 + e]); }
    for (int i = gt; i < 4096; i += NGT) { float s, c; sincospif((float)i / 2048.f, &s, &c); TABC[i] = c; TABS[i] = s; }
    for (int i = gt; i < 1024; i += NGT) SPT[i] = log1pf(__expf(-lam[i]));
}
}

namespace prep {
constexpr int O_KR = 0, O_CS = 8192, O_RS = 16384, O_CQ = 16896  , O_KS = 67072, O_CKV = 100864;
constexpr int CQP = 264, CKP = 136, QSP = 392, KSP = 264;
constexpr float C2 = 0.10206207261596577f * 1.4426950408889634f;
__device__ __forceinline__ void qkv_units(LAS unsigned char* lds, int l, const bf16_t* P, const bf16_t* WUQT, const bf16_t* WUKVT, const float* scw, const float* scb,
                                          bf16_t* QL, bf16_t* QC, bf16_t* KB, bf16_t* VTG, bf16_t* MIX, int G, int bx) {
    LAS float* KRo = (LAS float*)(lds + O_KR); LAS float* CS = (LAS float*)(lds + O_CS); LAS float* RS = (LAS float*)(lds + O_RS);
    LAS bf16_t* CQ = (LAS bf16_t*)(lds + O_CQ); LAS bf16_t* CK = (LAS bf16_t*)(lds + O_CKV); LAS bf16_t* KS = (LAS bf16_t*)(lds + O_KS); LAS bf16_t* QS = (LAS bf16_t*)(lds + O_CQ);
    for (int unit = bx; unit < 272; unit += G) {
        int tid_l = threadIdx.x; asm volatile("" : "+v"(tid_l));
        const int tid = tid_l, lane = tid & 63, w = __builtin_amdgcn_readfirstlane(tid >> 6), fr = lane & 15, fq = lane >> 4;
        const int b = unit / 68, chunk = unit % 68, pos0 = 64 * chunk; const bool ctxt = chunk < 4; const size_t r0 = (size_t)b * NPOS + pos0;
#pragma unroll
        for (int i = 0; i < 4; ++i) { const int q = tid + 512 * i, row = q >> 5, ch = q & 31; *(LAS u32x4*)((LAS unsigned char*)CQ + row * (CQP * 2) + ch * 16) = *(const u32x4*)(P + (r0 + row) * PP + C_CQ + ch * 8); }
#pragma unroll
        for (int i = 0; i < 2; ++i) { const int q = tid + 512 * i, row = q >> 4, ch = q & 15; *(LAS u32x4*)((LAS unsigned char*)CK + row * (CKP * 2) + ch * 16) = *(const u32x4*)(P + (r0 + row) * PP + C_CKV + ch * 8); }
        __syncthreads();
        { const int row = tid >> 3, j = tid & 7; float sq = 0.f, sk = 0.f;
#pragma unroll
          for (int i = 0; i < 4; ++i) { const u32x4 v = *(const LAS u32x4*)((const LAS unsigned char*)CQ + row * (CQP * 2) + j * 64 + i * 16);
#pragma unroll
              for (int e = 0; e < 4; ++e) { const float a = __uint_as_float(v[e] << 16), c = __uint_as_float(v[e] & 0xffff0000u); sq += a * a + c * c; } }
#pragma unroll
          for (int i = 0; i < 2; ++i) { const u32x4 v = *(const LAS u32x4*)((const LAS unsigned char*)CK + row * (CKP * 2) + j * 32 + i * 16);
#pragma unroll
              for (int e = 0; e < 4; ++e) { const float a = __uint_as_float(v[e] << 16), c = __uint_as_float(v[e] & 0xffff0000u); sk += a * a + c * c; } }
          sq += __shfl_xor(sq, 1); sq += __shfl_xor(sq, 2); sq += __shfl_xor(sq, 4); sk += __shfl_xor(sk, 1); sk += __shfl_xor(sk, 2); sk += __shfl_xor(sk, 4);
          if (j == 0) { RS[row * 2] = rsqrtf(sq * (1.f / 256.f) + 1e-6f); RS[row * 2 + 1] = rsqrtf(sk * (1.f / 128.f) + 1e-6f); }
          float cr = 1.f, sr = 0.f, cc = 1.f, sc = 0.f;
          if (!ctxt) { const int t = pos0 - CTX + row; const float inv = __expf(-9.210340371976184f * (float)j * 0.125f); float xa = (float)(t >> 6) * inv * 0.15915494309189535f; xa -= rintf(xa); sr = __sinf(xa * 6.283185307179586f); cr = __cosf(xa * 6.283185307179586f); float xb = (float)(t & 63) * inv * 0.15915494309189535f; xb -= rintf(xb); sc = __sinf(xb * 6.283185307179586f); cc = __cosf(xb * 6.283185307179586f); }
          CS[(row * 16 + j) * 2] = cr; CS[(row * 16 + j) * 2 + 1] = sr; CS[(row * 16 + 8 + j) * 2] = cc; CS[(row * 16 + 8 + j) * 2 + 1] = sc;
          const bf16_t* kp = P + (r0 + row) * PP + C_KR; const float z0 = bf2f(kp[j]), z1 = bf2f(kp[8 + j]), z2 = bf2f(kp[16 + j]), z3 = bf2f(kp[24 + j]);
          KRo[row * 32 + j] = z0 * cr - z1 * sr; KRo[row * 32 + 8 + j] = z0 * sr + z1 * cr; KRo[row * 32 + 16 + j] = z2 * cc - z3 * sc; KRo[row * 32 + 24 + j] = z2 * sc + z3 * cc; }
        __builtin_amdgcn_sched_barrier(0);
        { f32x4 qa[4][3];
#pragma unroll
          for (int mt = 0; mt < 4; ++mt)
#pragma unroll
              for (int n = 0; n < 3; ++n) qa[mt][n] = (f32x4){0.f, 0.f, 0.f, 0.f};
          const bf16_t* wq = WUQT + ((size_t)l * 384 + 48 * w + fr) * 256 + 8 * fq;
#pragma unroll
          for (int ks = 0; ks < 8; ++ks) { bf16x8 a[4], bb[3];
#pragma unroll
              for (int mt = 0; mt < 4; ++mt) a[mt] = *(const LAS bf16x8*)(CQ + (16 * mt + fr) * CQP + 32 * ks + 8 * fq);
#pragma unroll
              for (int n = 0; n < 3; ++n) bb[n] = *(const bf16x8*)(wq + (size_t)(16 * n) * 256 + 32 * ks);
#pragma unroll
              for (int mt = 0; mt < 4; ++mt)
#pragma unroll
                  for (int n = 0; n < 3; ++n) qa[mt][n] = __builtin_amdgcn_mfma_f32_16x16x32_bf16(a[mt], bb[n], qa[mt][n], 0, 0, 0); }
          __syncthreads();
#pragma unroll
          for (int n = 0; n < 3; ++n) { const int nt = 3 * w + n, m6 = nt % 6, col = 16 * nt + fr;
#pragma unroll
              for (int mt = 0; mt < 4; ++mt)
#pragma unroll
                  for (int i = 0; i < 4; ++i) { const int row = 16 * mt + 4 * fq + i; float v = qa[mt][n][i] * RS[row * 2];
                      if (m6 >= 4) { const float pv = __shfl_xor(v, 8); const int ci = (row * 16 + (m6 == 5 ? 8 : 0) + (fr & 7)) * 2; const float c = CS[ci], s = CS[ci + 1]; v = (fr < 8) ? v * c - pv * s : pv * s + v * c; }
                      QS[row * QSP + col] = f2bf(v * C2); } } }
        __builtin_amdgcn_sched_barrier(0);
        { f32x4 ka[4][4];
#pragma unroll
          for (int mt = 0; mt < 4; ++mt)
#pragma unroll
              for (int n = 0; n < 4; ++n) ka[mt][n] = (f32x4){0.f, 0.f, 0.f, 0.f};
          const bf16_t* wk = WUKVT + ((size_t)l * 512 + 64 * w + fr) * 128 + 8 * fq;
#pragma unroll
          for (int ks = 0; ks < 4; ++ks) { bf16x8 a[4], bb[4];
#pragma unroll
              for (int mt = 0; mt < 4; ++mt) a[mt] = *(const LAS bf16x8*)(CK + (16 * mt + fr) * CKP + 32 * ks + 8 * fq);
#pragma unroll
              for (int n = 0; n < 4; ++n) bb[n] = *(const bf16x8*)(wk + (size_t)(16 * n) * 128 + 32 * ks);
#pragma unroll
              for (int mt = 0; mt < 4; ++mt)
#pragma unroll
                  for (int n = 0; n < 4; ++n) ka[mt][n] = __builtin_amdgcn_mfma_f32_16x16x32_bf16(a[mt], bb[n], ka[mt][n], 0, 0, 0); }
          const int head = w >> 1;
          if ((w & 1) == 0) {
#pragma unroll
              for (int n = 0; n < 4; ++n)
#pragma unroll
                  for (int mt = 0; mt < 4; ++mt)
#pragma unroll
                      for (int i = 0; i < 4; ++i) { const int row = 16 * mt + 4 * fq + i; KS[row * KSP + head * 64 + 16 * n + fr] = f2bf(ka[mt][n][i] * RS[row * 2 + 1]); }
          } else {
#pragma unroll
              for (int n = 0; n < 4; ++n)
#pragma unroll
                  for (int mt = 0; mt < 4; ++mt) { const int rb = 16 * mt + 4 * fq; u32x2 o; o.x = pk2(ka[mt][n][0] * RS[rb * 2 + 1], ka[mt][n][1] * RS[rb * 2 + 3]); o.y = pk2(ka[mt][n][2] * RS[rb * 2 + 5], ka[mt][n][3] * RS[rb * 2 + 7]);
                      *(u32x2*)(VTG + ((size_t)(b * 4 + head) * 64 + 16 * n + fr) * NPOS + pos0 + rb) = o; } } }
        __syncthreads();
#pragma unroll
        for (int i = 0; i < 6; ++i) { const int q = tid + 512 * i, row = q / 48, rem = q % 48, head = rem / 12, ch = rem % 12, pos = pos0 + row;
            const u32x4 qv = *(const LAS u32x4*)((const LAS unsigned char*)QS + row * (QSP * 2) + (head * 96 + ch * 8) * 2);
            if (!ctxt) *(u32x4*)(QL + ((size_t)(b * 4 + head) * SEQ + (pos - CTX)) * 96 + ch * 8) = qv; else if (l == 0) *(u32x4*)(QC + ((size_t)(b * 4 + head) * CTX + pos) * 96 + ch * 8) = qv;
            u32x4 kv;
            if (ch < 8) kv = *(const LAS u32x4*)((const LAS unsigned char*)KS + row * (KSP * 2) + (head * 64 + ch * 8) * 2);
            else { const LAS float* kr = KRo + row * 32 + (ch - 8) * 8; kv.x = pk2(kr[0], kr[1]); kv.y = pk2(kr[2], kr[3]); kv.z = pk2(kr[4], kr[5]); kv.w = pk2(kr[6], kr[7]); }
            *(u32x4*)(KB + ((size_t)(b * 4 + head) * NPOS + pos) * 96 + ch * 8) = kv; }
        if (!(ctxt && l == 1)) { const int lo = ctxt ? 0 : CTX, hi = ctxt ? CTX : NPOS;
#pragma unroll
            for (int i = 0; i < 4; ++i) { const int q = tid + 512 * i, row = q >> 5, ch = q & 31, pos = pos0 + row; float acc[8];
#pragma unroll
                for (int e = 0; e < 8; ++e) acc[e] = scb[ch * 8 + e];
#pragma unroll
                for (int k = 0; k < 3; ++k) { const int p = pos - 1 + k; if (p >= lo && p < hi) { const bf16_t* pr = P + ((size_t)b * NPOS + p) * PP; const u32x4 sx = *(const u32x4*)(pr + C_SX + ch * 8), sc = *(const u32x4*)(pr + C_SC + ch * 8);
#pragma unroll
                        for (int e = 0; e < 4; ++e) { const float w0 = scw[k * 256 + ch * 8 + 2 * e], w1 = scw[k * 256 + ch * 8 + 2 * e + 1];
                            acc[2 * e] += w0 * (__uint_as_float(sx[e] << 16) * __uint_as_float(sc[e] << 16)); acc[2 * e + 1] += w1 * (__uint_as_float(sx[e] & 0xffff0000u) * __uint_as_float(sc[e] & 0xffff0000u)); } } }
                const u32x4 sb = *(const u32x4*)(P + (r0 + row) * PP + C_SB + ch * 8); u32x4 o;
#pragma unroll
                for (int e = 0; e < 4; ++e) o[e] = pk2(__uint_as_float(sb[e] << 16) * acc[2 * e], __uint_as_float(sb[e] & 0xffff0000u) * acc[2 * e + 1]);
                *(u32x4*)(MIX + (r0 + row) * D + 768 + ch * 8) = o; } }
        __syncthreads();
    }
}
}

namespace lru {
constexpr int XP = 264, O_X = 0, O_NA = 33792, O_BB = 66560;
__device__ __forceinline__ float sigm(float x) { return __builtin_amdgcn_rcpf(1.f + __expf(-x)); }
__device__ __forceinline__ void chunk_units(LAS unsigned char* lds, int l, const bf16_t* P, const float* conv_w, const float* conv_b, const bf16_t* WAT, const bf16_t* WIT, const float* b_a, const float* b_i, const float* SPT,
                                            bf16_t* HL, bf16_t* AC, float* SUM, int G, int bx, int knob) {
    LAS bf16_t* X = (LAS bf16_t*)(lds + O_X); LAS bf16_t* NA = (LAS bf16_t*)(lds + O_NA); LAS bf16_t* BB = (LAS bf16_t*)(lds + O_BB);
    for (int unit = bx; unit < 544; unit += G) {
        int tid_l = threadIdx.x; asm volatile("" : "+v"(tid_l));
        const int tid = tid_l, lane = tid & 63, w = __builtin_amdgcn_readfirstlane(tid >> 6), fr = lane & 15, fq = lane >> 4;
        const int dir = unit & 1, bc = unit >> 1, b = bc / 68, chunk = bc % 68, pos0 = 64 * chunk; const int lo = chunk < 4 ? 0 : CTX, hi = chunk < 4 ? CTX : NPOS, left = dir ? 1 : 2;
        const size_t r0 = (size_t)b * NPOS + pos0; const int pd = (l * 2 + dir) * 256;
        if (!(knob & 1)) { const int cg = tid & 31, ts = tid >> 5, c0 = cg * 8; float wv[4][8], cbv[8];
#pragma unroll
          for (int e = 0; e < 8; ++e) { cbv[e] = conv_b[pd + c0 + e];
#pragma unroll
              for (int k = 0; k < 4; ++k) wv[k][e] = conv_w[(size_t)pd * 4 + k * 256 + c0 + e]; }
          const bf16_t* pc = P + (size_t)b * NPOS * PP + C_LX + c0; const int pb = pos0 + 4 * ts - left;
          u32x4 u[7];
#pragma unroll
          for (int i = 0; i < 7; ++i) { const int p = pb + i; const int pcl = p < lo ? lo : (p >= hi ? hi - 1 : p); u[i] = *(const u32x4*)(pc + (size_t)pcl * PP); if (p < lo || p >= hi) u[i] = (u32x4){0u, 0u, 0u, 0u}; }
#pragma unroll
          for (int i = 0; i < 4; ++i) { u32x4 o;
#pragma unroll
              for (int e2 = 0; e2 < 4; ++e2) { float lo_ = cbv[2 * e2], hi_ = cbv[2 * e2 + 1];
#pragma unroll
                  for (int k = 0; k < 4; ++k) { const unsigned d = u[i + k][e2]; lo_ += wv[k][2 * e2] * __uint_as_float(d << 16); hi_ += wv[k][2 * e2 + 1] * __uint_as_float(d & 0xffff0000u); }
                  o[e2] = pk2(lo_, hi_); }
              *(LAS u32x4*)(X + (4 * ts + i) * XP + c0) = o; } }
        __syncthreads();
        if (!(knob & 2)) { const int h = w >> 1, mh = w & 1;
          f32x4 ra[2][4], ri[2][4];
#pragma unroll
          for (int m = 0; m < 2; ++m)
#pragma unroll
              for (int n = 0; n < 4; ++n) { ra[m][n] = (f32x4){0.f, 0.f, 0.f, 0.f}; ri[m][n] = (f32x4){0.f, 0.f, 0.f, 0.f}; }
          const bf16_t* wa = WAT + ((size_t)((l * 2 + dir) * 4 + h) * 64 + fr) * 64 + 8 * fq; const bf16_t* wi = WIT + ((size_t)((l * 2 + dir) * 4 + h) * 64 + fr) * 64 + 8 * fq;
#pragma unroll
          for (int ks = 0; ks < 2; ++ks) { bf16x8 a[2], ba[4], bi[4];
#pragma unroll
              for (int m = 0; m < 2; ++m) a[m] = *(const LAS bf16x8*)(X + (16 * (2 * mh + m) + fr) * XP + 64 * h + 32 * ks + 8 * fq);
#pragma unroll
              for (int n = 0; n < 4; ++n) { ba[n] = *(const bf16x8*)(wa + (size_t)(16 * n) * 64 + 32 * ks); bi[n] = *(const bf16x8*)(wi + (size_t)(16 * n) * 64 + 32 * ks); }
#pragma unroll
              for (int m = 0; m < 2; ++m)
#pragma unroll
                  for (int n = 0; n < 4; ++n) { ra[m][n] = __builtin_amdgcn_mfma_f32_16x16x32_bf16(a[m], ba[n], ra[m][n], 0, 0, 0); ri[m][n] = __builtin_amdgcn_mfma_f32_16x16x32_bf16(a[m], bi[n], ri[m][n], 0, 0, 0); } }
#pragma unroll
          for (int n = 0; n < 4; ++n) { const int c = 64 * h + 16 * n + fr; const float bav = b_a[pd + c], biv = b_i[pd + c], sp8 = 8.f * SPT[pd + c];
#pragma unroll
              for (int m = 0; m < 2; ++m)
#pragma unroll
                  for (int i = 0; i < 4; ++i) { const int t = 16 * (2 * mh + m) + 4 * fq + i; const float r = sigm(ra[m][n][i] + bav), ig = sigm(ri[m][n][i] + biv);
                      const float x = r * sp8; const float na = x < 0.03125f ? x * (1.f - 0.5f * x * (1.f - 0.33333334f * x * (1.f - 0.25f * x))) : 1.f - __expf(-x); const float xv = bf2f(X[t * XP + c]);
                      NA[t * 256 + c] = f2bf(na); BB[t * 256 + c] = f2bf(__builtin_amdgcn_sqrtf(fmaxf(na * (2.f - na), 0.f)) * (ig * xv)); } } }
        __syncthreads();
        if (tid < 256 && !(knob & 4)) { const int c = tid; float hst = 0.f, A = 1.f;
            if (dir == 0) {
#pragma unroll 8
                for (int t = 0; t < 64; ++t) { const float a = 1.f - bf2f(NA[t * 256 + c]); hst = a * hst + bf2f(BB[t * 256 + c]); A *= a; BB[t * 256 + c] = f2bf(hst); NA[t * 256 + c] = f2bf(A); }
            } else {
#pragma unroll 8
                for (int t = 63; t >= 0; --t) { const float a = 1.f - bf2f(NA[t * 256 + c]); hst = a * hst + bf2f(BB[t * 256 + c]); A *= a; BB[t * 256 + c] = f2bf(hst); NA[t * 256 + c] = f2bf(A); }
            }
            float* sm = SUM + ((size_t)(dir * 4 + b) * 68 + chunk) * 512; sm[c] = A; sm[256 + c] = hst; }
        __syncthreads();
        if (!(knob & 4)) {
#pragma unroll
            for (int i = 0; i < 4; ++i) { const int q = tid + 512 * i, t = q >> 5, ch = q & 31; const size_t go = ((size_t)dir * MROWS + r0 + t) * 256 + ch * 8;
                *(u32x4*)(AC + go) = *(const LAS u32x4*)(NA + t * 256 + ch * 8); *(u32x4*)(HL + go) = *(const LAS u32x4*)(BB + t * 256 + ch * 8); } }
        __syncthreads();
    }
}
__device__ __forceinline__ void fixup_units(LAS unsigned char* lds, int l, const bf16_t* P, const bf16_t* HL, const bf16_t* AC, const float* SUM, bf16_t* MIX, int G, int bx) {
    LAS float* CAR = (LAS float*)lds;
    for (int unit = bx; unit < 272; unit += G) {
        int tid_l = threadIdx.x; asm volatile("" : "+v"(tid_l));
        const int tid = tid_l;
        const int b = unit / 68, chunk = unit % 68; if (l == 1 && chunk < 4) continue;
        { const int dir = tid >> 8, c = tid & 255; const float* sp = SUM + ((size_t)(dir * 4 + b) * 68) * 512 + c;
          const int n_pre = dir == 0 ? chunk : (chunk < 4 ? 3 - chunk : 4 + (67 - chunk));
          float cy = 0.f;
          for (int j0 = 0; j0 < n_pre; j0 += 16) { float av[16], hv[16];
#pragma unroll
              for (int u = 0; u < 16; ++u) { const int n = j0 + u < n_pre ? j0 + u : n_pre - 1; const int j = dir == 0 ? n : (n < 4 ? 3 - n : 71 - n); av[u] = sp[(size_t)j * 512]; hv[u] = sp[(size_t)j * 512 + 256]; }
#pragma unroll
              for (int u = 0; u < 16; ++u) cy = (j0 + u < n_pre) ? hv[u] + av[u] * cy : cy; }
          CAR[tid] = cy; }
        __syncthreads();
        { const int cg = tid & 31, ts = tid >> 5, c0 = cg * 8; float cf[8], cb[8];
#pragma unroll
          for (int e = 0; e < 8; ++e) { cf[e] = CAR[c0 + e]; cb[e] = CAR[256 + c0 + e]; }
          const size_t r0 = (size_t)b * NPOS + 64 * chunk + 4 * ts;
          u32x4 hf[4], af[4], hb[4], ab[4], gt[4];
#pragma unroll
          for (int i = 0; i < 4; ++i) { const size_t r = r0 + i; hf[i] = *(const u32x4*)(HL + r * 256 + c0); af[i] = *(const u32x4*)(AC + r * 256 + c0); hb[i] = *(const u32x4*)(HL + ((size_t)MROWS + r) * 256 + c0); ab[i] = *(const u32x4*)(AC + ((size_t)MROWS + r) * 256 + c0);
              gt[i] = *(const u32x4*)(P + r * PP + C_LG + c0); }
#pragma unroll
          for (int i = 0; i < 4; ++i) { u32x4 o;
#pragma unroll
              for (int e2 = 0; e2 < 4; ++e2) { float res[2];
#pragma unroll
                  for (int hh = 0; hh < 2; ++hh) { const int e = 2 * e2 + hh;
                      const float vhf = hh ? __uint_as_float(hf[i][e2] & 0xffff0000u) : __uint_as_float(hf[i][e2] << 16), vaf = hh ? __uint_as_float(af[i][e2] & 0xffff0000u) : __uint_as_float(af[i][e2] << 16);
                      const float vhb = hh ? __uint_as_float(hb[i][e2] & 0xffff0000u) : __uint_as_float(hb[i][e2] << 16), vab = hh ? __uint_as_float(ab[i][e2] & 0xffff0000u) : __uint_as_float(ab[i][e2] << 16);
                      const float x = hh ? __uint_as_float(gt[i][e2] & 0xffff0000u) : __uint_as_float(gt[i][e2] << 16);
                      const float hsum = (vhf + vaf * cf[e]) + (vhb + vab * cb[e]);
                      const float u = 0.7978845608028654f * (x + 0.044715f * x * x * x); const float th_ = 1.f - 2.f * __builtin_amdgcn_rcpf(1.f + __expf(2.f * u));
                      res[hh] = 0.5f * x * (1.f + th_) * hsum; }
                  o[e2] = pk2(res[0], res[1]); }
              *(u32x4*)(MIX + (r0 + i) * D + 256 + c0) = o; } }
        __syncthreads();
    }
}
}

namespace fft {
__device__ __forceinline__ void ctx_a(LAS unsigned char* lds, const bf16_t* P, const float* TABC, const float* TABS, bf16_t* XCT, int G, int bx) {
    LAS bf16_t* U = (LAS bf16_t*)(lds + O_U); LAS bf16_t* X = (LAS bf16_t*)(lds + O_X);
    for (int unit = bx; unit < 16; unit += G) {
        int tid_l = threadIdx.x; asm volatile("" : "+v"(tid_l));
        const int tid = tid_l, lane = tid & 63, w = __builtin_amdgcn_readfirstlane(tid >> 6), fr = lane & 15, fq = lane >> 4;
        build_tables(lds, TABC, TABS, tid);
        const LAS bf16_t* Tc = (const LAS bf16_t*)(lds + O_TC); const LAS bf16_t* Ts = (const LAS bf16_t*)(lds + O_TS);
        const int b = unit >> 2, q = unit & 3;
#pragma unroll
        for (int i = 0; i < 4; ++i) { const int qq = tid + 512 * i, t1 = qq >> 5, ch = qq & 31;
            *(LAS u32x4*)((LAS unsigned char*)U + t1 * (UP * 2) + ch * 16) = *(const u32x4*)(P + ((size_t)b * NPOS + 64 * q + t1) * PP + ch * 8); }
        __syncthreads();
        { const int g = w >> 1, part = w & 1; const LAS bf16_t* T = part ? Ts : Tc;
          f32x4 acc[4][4];
#pragma unroll
          for (int mt = 0; mt < 4; ++mt)
#pragma unroll
              for (int nt = 0; nt < 4; ++nt) acc[mt][nt] = (f32x4){0.f, 0.f, 0.f, 0.f};
#pragma unroll
          for (int ks = 0; ks < 2; ++ks) { bf16x8 a[4], bb[4];
#pragma unroll
              for (int mt = 0; mt < 4; ++mt) a[mt] = *(const LAS bf16x8*)(U + (16 * mt + fr) * UP + g * 64 + 32 * ks + 8 * fq);
#pragma unroll
              for (int nt = 0; nt < 4; ++nt) bb[nt] = *(const LAS bf16x8*)(T + (16 * nt + fr) * TP + 32 * ks + 8 * fq);
#pragma unroll
              for (int mt = 0; mt < 4; ++mt)
#pragma unroll
                  for (int nt = 0; nt < 4; ++nt) acc[mt][nt] = __builtin_amdgcn_mfma_f32_16x16x32_bf16(a[mt], bb[nt], acc[mt][nt], 0, 0, 0); }
          const float sg = part ? -1.f : 1.f;
#pragma unroll
          for (int mt = 0; mt < 4; ++mt)
#pragma unroll
              for (int nt = 0; nt < 4; ++nt) { const f32x4 v = acc[mt][nt] * sg; u32x2 o; o.x = pk2(v[0], v[1]); o.y = pk2(v[2], v[3]);
                  *(LAS u32x2*)(X + (part * 256 + g * 64 + 16 * nt + fr) * TP + 16 * mt + 4 * fq) = o; } }
        __syncthreads();
#pragma unroll
        for (int i = 0; i < 8; ++i) { const int qq = tid + 512 * i, row = qq >> 3, c8 = qq & 7;
            *(u32x4*)(XCT + (((size_t)b * 4 + q) * 512 + row) * 64 + c8 * 8) = *(const LAS u32x4*)((const LAS unsigned char*)X + row * (TP * 2) + c8 * 16); }
        __syncthreads();
    }
}
__device__ __forceinline__ void ctx_b(LAS unsigned char* lds, const bf16_t* XCT, const float* TABC, const float* TABS, bf16_t* MIX, int G, int bx) {
    LAS bf16_t* Tc = (LAS bf16_t*)(lds + O_TC); LAS bf16_t* Ts = (LAS bf16_t*)(lds + O_TS);
    LAS bf16_t* Ys = (LAS bf16_t*)(lds + O_U); LAS bf16_t* ZT = (LAS bf16_t*)(lds + O_X);
    for (int unit = bx; unit < 16; unit += G) {
        int tid_l = threadIdx.x; asm volatile("" : "+v"(tid_l));
        const int tid = tid_l, lane = tid & 63, w = __builtin_amdgcn_readfirstlane(tid >> 6), fr = lane & 15, fq = lane >> 4;
        const int b = unit >> 2, ft = unit & 3;
        f32x4 y[4][2];
#pragma unroll
        for (int mt = 0; mt < 4; ++mt)
#pragma unroll
            for (int n = 0; n < 2; ++n) y[mt][n] = (f32x4){0.f, 0.f, 0.f, 0.f};
        for (int q = 0; q < 4; ++q) {
            for (int i = tid; i < 4096; i += 512) { const int fl = i >> 6, tl = i & 63, ix = (((64 * ft + fl) * (64 * q + tl)) & 255) * 16; Tc[fl * TP + tl] = f2bf(TABC[ix]); Ts[fl * TP + tl] = f2bf(TABS[ix]); }
#pragma unroll
            for (int i = 0; i < 8; ++i) { const int qq = tid + 512 * i, row = qq >> 3, c8 = qq & 7;
                *(LAS u32x4*)((LAS unsigned char*)ZT + row * (TP * 2) + c8 * 16) = *(const u32x4*)(XCT + (((size_t)b * 4 + q) * 512 + row) * 64 + c8 * 8); }
            __syncthreads();
#pragma unroll
            for (int ks = 0; ks < 2; ++ks) { bf16x8 xr[2], xi[2];
#pragma unroll
                for (int n = 0; n < 2; ++n) { xr[n] = *(const LAS bf16x8*)(ZT + (32 * w + 16 * n + fr) * TP + 32 * ks + 8 * fq); xi[n] = *(const LAS bf16x8*)(ZT + (256 + 32 * w + 16 * n + fr) * TP + 32 * ks + 8 * fq); }
#pragma unroll
                for (int mt = 0; mt < 4; ++mt) { const bf16x8 c = *(const LAS bf16x8*)(Tc + (16 * mt + fr) * TP + 32 * ks + 8 * fq), s = *(const LAS bf16x8*)(Ts + (16 * mt + fr) * TP + 32 * ks + 8 * fq);
#pragma unroll
                    for (int n = 0; n < 2; ++n) { y[mt][n] = __builtin_amdgcn_mfma_f32_16x16x32_bf16(c, xr[n], y[mt][n], 0, 0, 0); y[mt][n] = __builtin_amdgcn_mfma_f32_16x16x32_bf16(s, xi[n], y[mt][n], 0, 0, 0); } } }
            __syncthreads();
        }
#pragma unroll
        for (int mt = 0; mt < 4; ++mt)
#pragma unroll
            for (int i = 0; i < 4; ++i)
#pragma unroll
                for (int n = 0; n < 2; ++n) Ys[(16 * mt + 4 * fq + i) * UP + 32 * w + 16 * n + fr] = f2bf(y[mt][n][i] * (1.f / 128.f));
        __syncthreads();
#pragma unroll
        for (int i = 0; i < 4; ++i) { const int qq = tid + 512 * i, fl = qq >> 5, ch = qq & 31;
            *(u32x4*)(MIX + ((size_t)b * NPOS + 64 * ft + fl) * D + ch * 8) = *(const LAS u32x4*)((const LAS unsigned char*)Ys + fl * (UP * 2) + ch * 16); }
        __syncthreads();
    }
}
}

constexpr int NWAVES = 8, RING_BYTES = 131072 + 3072, LDSCTL_OFF = RING_BYTES, MISC_OFF = LDSCTL_OFF + 64, META_OFF = MISC_OFF + 64, LDS_BYTES = 147456;
enum { PH_PRO0 = 0, PH_PRO1 = 1, PH_L0 = 2, PH_PER_LAYER = 8, PH_N = 18 };
enum { PL_WIN = 0, PL_PREP = 1, PL_MIX = 2, PL_WOUT = 3, PL_ROUTE = 4, PL_MOE1 = 5, PL_MOE2 = 6, PL_COMB = 7 };
struct MArgs { const float* in[30]; float* out; unsigned char* ws; int npass, skip_mask, dup_ph, dup_n, dup_sub, knob; };

__device__ __forceinline__ void transpose_item(const float* W, int K, int N, bf16_t* WT, int drow0, LAS float* scr, int k0, int n0, int lane) {
    const int kr = lane >> 3, nc = (lane & 7) * 4;
    f32x4 v[8];
#pragma unroll
    for (int i = 0; i < 8; ++i) v[i] = __builtin_nontemporal_load((const f32x4*)(W + (size_t)(k0 + kr + 8 * i) * N + n0 + nc));
#pragma unroll
    for (int i = 0; i < 8; ++i) { LAS float* d = scr + (kr + 8 * i) * 33 + nc; d[0] = v[i][0]; d[1] = v[i][1]; d[2] = v[i][2]; d[3] = v[i][3]; }
    asm volatile("s_waitcnt lgkmcnt(0)" ::: "memory");
    const int c = lane & 7;
#pragma unroll
    for (int j = 0; j < 4; ++j) { const int n = (lane >> 3) + 8 * j; const LAS float* s = scr + (8 * c) * 33 + n;
        u32x4 o; o.x = pk2(s[0 * 33], s[1 * 33]); o.y = pk2(s[2 * 33], s[3 * 33]); o.z = pk2(s[4 * 33], s[5 * 33]); o.w = pk2(s[6 * 33], s[7 * 33]);
        *(u32x4*)(WT + (size_t)(drow0 + n) * K + k0 + 8 * c) = o; }
    asm volatile("s_waitcnt lgkmcnt(0)" ::: "memory");
}

#define ARG_IN(i) ({ const float* _p; asm volatile("s_load_dwordx2 %0, %1, %2\n\ts_waitcnt lgkmcnt(0)" : "=s"(_p) : "s"(__builtin_amdgcn_kernarg_segment_ptr()), "n"((i) * 8)); _p; })
__global__ void __launch_bounds__(NWAVES * 64, 2) mega(MArgs args) {
    extern __shared__ __attribute__((aligned(16))) unsigned char lds_raw[];
    const int G0 = gridDim.x, bx0 = blockIdx.x;
    unsigned char* ws0 = args.ws;
    unsigned* ctl0 = (unsigned*)(ws0 + L::CTL);
    for (int u = threadIdx.x; u < (LDS_BYTES - LDSCTL_OFF) / 4; u += NWAVES * 64) ((LAS unsigned*)(lds_raw + LDSCTL_OFF))[u] = 0u;
    __syncthreads();
    volatile LAS unsigned* MISC = (volatile LAS unsigned*)((LAS unsigned char*)lds_raw + MISC_OFF);
    XcdBarrier bar = xcd_barrier_post(ctl0 + L::CW_BAR, MISC);
    const int lo = 0, hi = PH_N;

    bool first = true;
    for (int pass = 0; pass < args.npass; ++pass)
    for (int ph = lo; ph < hi; ++ph) {
      const int reps = (ph == args.dup_ph) ? 1 + args.dup_n : 1;
      for (int rep = 0; rep < reps; ++rep) {
        if (!first) xcd_barrier(bar);
        first = false;
        if (pass + 1 < args.npass && ((args.skip_mask >> ph) & 1)) continue;
        const int sub = rep + 1 < reps ? args.dup_sub : 15; const int knob = rep + 1 < reps ? args.knob : 0; (void)knob;
        unsigned char* ws = args.ws; asm volatile("" : "+s"(ws));
        unsigned* ctl = (unsigned*)(ws + L::CTL);
        int tid_p = threadIdx.x; asm volatile("" : "+v"(tid_p));
        int G = G0, bx = bx0; asm volatile("" : "+s"(G), "+s"(bx));
        const int vcu = (G % 8 == 0) ? (bx % 8) * (G / 8) + bx / 8 : bx; (void)vcu;
        unsigned ldsb = 0; asm volatile("" : "+s"(ldsb)); LAS unsigned char* lds = (LAS unsigned char*)lds_raw + ldsb;
        LAS int* META = (LAS int*)(lds + META_OFF);
        const int tid = tid_p, lane = tid & 63, wave = __builtin_amdgcn_readfirstlane(tid >> 6); (void)lane; (void)wave;
        if (ph == PH_PRO0) {
            if (bx == 0 && tid < 2 * NE) ((int*)(ctl + L::CW_CNT))[tid * L::CNT_STRIDE] = 0;
            LAS float* scr = (LAS float*)(lds + wave * 16384);
            const int gw = vcu * NWAVES + wave, NGW = G * NWAVES;
            constexpr int I_IN = 16 * 61, I_OUT = 16 * 32, I_GU = NE * 16 * 64, I_DN = NE * 16 * 32, I_L = I_IN + I_OUT + I_GU + I_DN;
            for (int it = gw; it < 2 * I_L; it += NGW) {
                const int l = it / I_L; int r = it % I_L;
                if (r < I_IN) { const int kb = r / 61, nb = r % 61; transpose_item(ARG_IN(8) + (size_t)l * D * PT, D, PT, (bf16_t*)(ws + L::WINT) + (size_t)l * 2048 * D, 32 * nb, scr, 64 * kb, 32 * nb, lane); continue; } r -= I_IN;
                if (r < I_OUT) { const int kb = r / 32, nb = r % 32; transpose_item(ARG_IN(22) + (size_t)l * D * D, D, D, (bf16_t*)(ws + L::WOUTT) + (size_t)l * D * D, 32 * nb, scr, 64 * kb, 32 * nb, lane); continue; } r -= I_OUT;
                if (r < I_GU) { const int e = r / (16 * 64), q = r % (16 * 64), kb = q / 64, nb = q % 64; const int n0 = 32 * nb; const int c2 = n0 & 1023; const int drow = (c2 >> 7) * 256 + (n0 >> 10) * 128 + (c2 & 127);
                    transpose_item(ARG_IN(25) + ((size_t)l * NE + e) * D * 2048, D, 2048, (bf16_t*)(ws + L::WGUT) + ((size_t)l * NE + e) * 2048 * D, drow, scr, 64 * kb, n0, lane); continue; } r -= I_GU;
                { const int e = r / (16 * 32), q = r % (16 * 32), kb = q / 32, nb = q % 32;
                    transpose_item(ARG_IN(27) + ((size_t)l * NE + e) * D * D, D, D, (bf16_t*)(ws + L::WDT) + ((size_t)l * NE + e) * D * D, 32 * nb, scr, 64 * kb, 32 * nb, lane); }
            }
            sm::smallw_phase(ARG_IN(17), ARG_IN(16), ARG_IN(19), ARG_IN(18), ARG_IN(11), ARG_IN(13), (bf16_t*)(ws + L::WUQT), (bf16_t*)(ws + L::WUKVT), (bf16_t*)(ws + L::WAT), (bf16_t*)(ws + L::WIT),
                             (float*)(ws + L::TABC), (float*)(ws + L::TABS), ARG_IN(15), (float*)(ws + L::SPT), bx * 512 + tid, G * 512);
            __syncthreads();
            sm::mod_phase(lds, ARG_IN(1), ARG_IN(3), ARG_IN(4), ARG_IN(5), (float*)(ws + L::MOD), G, bx, tid);
            for (int i = bx * 512 + tid; i < 2 * 96 * D / 8; i += G * 512) { const int l = i / (96 * D / 8), q = i % (96 * D / 8); *(u32x4*)((bf16_t*)(ws + L::WINT) + ((size_t)l * 2048 + PT) * D + (size_t)q * 8) = (u32x4){0u, 0u, 0u, 0u}; }
            continue;
        }
        if (ph == PH_PRO1) { sm::pro1_phase(ARG_IN(0), ARG_IN(2), ARG_IN(6), (const float*)(ws + L::MOD), (float*)(ws + L::H), (bf16_t*)(ws + L::XN), bx * NWAVES + wave, G * NWAVES, lane); continue; }
        if (ph < PH_L0) continue;
        const int l = (ph - PH_L0) / PH_PER_LAYER, pl = (ph - PH_L0) % PH_PER_LAYER;
        const float* MODl = (const float*)(ws + L::MOD) + (size_t)l * 5 * 6144;
        if (pl == PL_WIN) {
            g8::DenseSched S; S.init(MROWS / 256, PP / 256, G, bx, 0, (const bf16_t*)(ws + L::WINT) + (size_t)l * 2048 * D, D);
            g8::EpiP E{(bf16_t*)(ws + L::P)};
            g8::gemm_phase<g8::EpiP, g8::DenseSched, false, false>(lds, (const char*)(ws + L::XN), S, E);
        } else if (pl == PL_PREP) {
            if (sub & 1) fft::stage_a(lds, (const bf16_t*)(ws + L::P), (const float*)(ws + L::TABC), (const float*)(ws + L::TABS), (bf16_t*)(ws + L::ZBUF), G, bx);
            __syncthreads();
            if (l == 0 && (sub & 2)) { fft::ctx_a(lds, (const bf16_t*)(ws + L::P), (const float*)(ws + L::TABC), (const float*)(ws + L::TABS), (bf16_t*)(ws + L::XCT), G, G - 1 - bx); __syncthreads(); }
            if (sub & 4) prep::qkv_units(lds, l, (const bf16_t*)(ws + L::P), (const bf16_t*)(ws + L::WUQT), (const bf16_t*)(ws + L::WUKVT), ARG_IN(20) + l * 768, ARG_IN(21) + l * 256,
                            (bf16_t*)(ws + L::QL), (bf16_t*)(ws + L::QC), (bf16_t*)(ws + L::KB), (bf16_t*)(ws + L::VTG), (bf16_t*)(ws + L::MIX), G, bx);
            __syncthreads();
            if (sub & 8) lru::chunk_units(lds, l, (const bf16_t*)(ws + L::P), ARG_IN(9), ARG_IN(10), (const bf16_t*)(ws + L::WAT), (const bf16_t*)(ws + L::WIT), ARG_IN(12), ARG_IN(14), (const float*)(ws + L::SPT),
                             (bf16_t*)(ws + L::HL), (bf16_t*)(ws + L::AC), (float*)(ws + L::SUM), G, bx, knob);
        } else if (pl == PL_MIX) {
            if (sub & 1) lru::fixup_units(lds, l, (const bf16_t*)(ws + L::P), (const bf16_t*)(ws + L::HL), (const bf16_t*)(ws + L::AC), (const float*)(ws + L::SUM), (bf16_t*)(ws + L::MIX), G, bx);
            if (sub & 2) fft::stage_b(lds, (const bf16_t*)(ws + L::ZBUF), (const float*)(ws + L::TABC), (const float*)(ws + L::TABS), (bf16_t*)(ws + L::MIX), G, bx);
            __syncthreads();
            if (l == 0 && (sub & 4)) { fft::ctx_b(lds, (const bf16_t*)(ws + L::XCT), (const float*)(ws + L::TABC), (const float*)(ws + L::TABS), (bf16_t*)(ws + L::MIX), G, G - 1 - bx); __syncthreads(); }
            if (sub & 8) attn::attn_phase(lds, (const bf16_t*)(ws + L::QL), (const bf16_t*)(ws + L::QC), (const bf16_t*)(ws + L::KB), (const bf16_t*)(ws + L::VTG), (bf16_t*)(ws + L::MIX), l == 0 ? 1 : 0, G, vcu);
        } else if (pl == PL_WOUT) {
            g8::DenseSched S; S.init(l == 0 ? MROWS / 256 : 64, D / 256, G, bx, l == 0 ? 0 : 1, (const bf16_t*)(ws + L::WOUTT) + (size_t)l * D * D, D);
            g8::EpiH E{(float*)(ws + L::H), MODl, 2048};
            g8::gemm_phase<g8::EpiH, g8::DenseSched, false, false>(lds, (const char*)(ws + L::MIX), S, E);
        } else if (pl == PL_ROUTE) {
            sm::route_phase(lds, l, (const float*)(ws + L::H), ARG_IN(7) + l * D, MODl, ARG_IN(23) + (size_t)l * D * NE, ARG_IN(24) + l * NE, (bf16_t*)(ws + L::XN), (int*)(ctl + L::CW_CNT) + l * NE * L::CNT_STRIDE,
                            (int*)(ws + L::LIST) + (size_t)l * NE * LCAP, (float*)(ws + L::GATE), G, bx, tid);
        } else if (pl == PL_COMB) {
            sm::comb_phase(l, (float*)(ws + L::H), (const bf16_t*)(ws + L::Y), MODl, ARG_IN(6) + D, (const float*)(ws + L::MOD) + (size_t)5 * 6144, (bf16_t*)(ws + L::XN), ARG_IN(29), args.out, bx * NWAVES + wave, G * NWAVES, lane);
        } else if (pl == PL_MOE1 || pl == PL_MOE2) {
            const int* CNTg = (const int*)(ctl + L::CW_CNT) + l * NE * L::CNT_STRIDE;
            if (tid == 0) { int o = 0; for (int e = 0; e < NE; ++e) { const int cn = CNTg[e * L::CNT_STRIDE]; META[e] = o; META[64 + e] = cn; o += (cn + 255) >> 8; } META[NE] = o; }
            __syncthreads();
            g8::MoeSched S; S.tpre = META; S.cnt = META + 64; S.G = G; S.c = bx; S.K = D; S.list = (const int*)(ws + L::LIST) + (size_t)l * NE * LCAP;
            if (pl == PL_MOE1) {
                S.NT = 8; S.COLW = 128; S.total = __builtin_amdgcn_readfirstlane(META[NE]) * 8; S.Bt = (const char*)((const bf16_t*)(ws + L::WGUT) + (size_t)l * NE * 2048 * D);
                g8::EpiMoe1 E{(bf16_t*)(ws + L::ACT), ARG_IN(26) + (size_t)l * NE * 2048};
                g8::gemm_phase<g8::EpiMoe1, g8::MoeSched, true, true>(lds, (const char*)(ws + L::XN), S, E);
            } else {
                S.NT = 4; S.COLW = 256; S.total = __builtin_amdgcn_readfirstlane(META[NE]) * 4; S.Bt = (const char*)((const bf16_t*)(ws + L::WDT) + (size_t)l * NE * D * D);
                g8::EpiMoe2 E{(bf16_t*)(ws + L::Y), ARG_IN(28) + (size_t)l * NE * D, (const float*)(ws + L::GATE)};
                g8::gemm_phase<g8::EpiMoe2, g8::MoeSched, false, true>(lds, (const char*)(ws + L::ACT), S, E);
            }
            __syncthreads();
        }
      }
    }
}
constexpr int PROBE_DUP_PH = -1, PROBE_DUP_N = 0, PROBE_DUP_SUB = 15, PROBE_KNOB = 0;
constexpr int PROBE_NPASS = 1, PROBE_SKIP = 0;
extern "C" void kernel_launch(void* const* d_in, const int* in_sizes, int n_in, void* d_out, int out_size, void* d_ws, size_t ws_size, hipStream_t stream) {
    static int grid = 0;
    if (grid == 0) {
        if (n_in != 30 || out_size != NB_ * SEQ * D || (size_t)L::END > ws_size) { fprintf(stderr, "kernel_launch: unexpected problem shape (n_in %d, out %d) or workspace too small (need %zu, have %zu); nothing launched\n", n_in, out_size, (size_t)L::END, ws_size); grid = -1; return; }
        int dev = 0, cus = 0;
        if (hipGetDevice(&dev) != hipSuccess || hipDeviceGetAttribute(&cus, hipDeviceAttributeMultiprocessorCount, dev) != hipSuccess) { fprintf(stderr, "kernel_launch: device query failed\n"); grid = -1; return; }
        if (hipFuncSetAttribute((const void*)mega, hipFuncAttributeMaxDynamicSharedMemorySize, LDS_BYTES) != hipSuccess) { fprintf(stderr, "kernel_launch: hipFuncSetAttribute failed\n"); grid = -1; return; }
        grid = cus < 256 ? cus : 256;
    }
    if (grid < 0) return;
    unsigned char* p = (unsigned char*)d_ws;
    (void)hipMemsetAsync(p + L::CTL, 0, L::CTL_BYTES, stream);
    MArgs a{};
    for (int i = 0; i < 30; ++i) a.in[i] = (const float*)d_in[i];
    a.out = (float*)d_out; a.ws = p; a.npass = PROBE_NPASS; a.skip_mask = PROBE_SKIP; a.dup_ph = PROBE_DUP_PH; a.dup_n = PROBE_DUP_N; a.dup_sub = PROBE_DUP_SUB; a.knob = PROBE_KNOB;
    hipLaunchKernelGGL(mega, dim3(grid), dim3(NWAVES * 64), LDS_BYTES, stream, a);
}
```

```cpp
#include <hip/hip_runtime.h>
#include <cstdint>
#include <cstdio>

typedef unsigned short bf16_t;
constexpr int NB_ = 4, SEQ = 4096, CTX = 256, D = 1024, NPOS = SEQ + CTX, MROWS = NB_ * NPOS;
constexpr int PT = 1952, PP = 2048;
constexpr int NE = 32, TOPK = 4, LCAP = MROWS;
constexpr int NASG = MROWS * TOPK;
constexpr int ACT_ROWS = NASG + NE * 256;
constexpr int C_FN = 0, C_LX = 256, C_LG = 512, C_CQ = 768, C_CKV = 1024, C_KR = 1152, C_SX = 1184, C_SB = 1440, C_SC = 1696;

__device__ __forceinline__ float bf2f(bf16_t v) { return __uint_as_float((unsigned)v << 16); }
__device__ __forceinline__ bf16_t f2bf(float f) { unsigned u = __float_as_uint(f); return (bf16_t)((u + 0x7fffu + ((u >> 16) & 1u)) >> 16); }
__device__ __forceinline__ float wave_sum(float v) {
#pragma unroll
    for (int o = 1; o < 64; o <<= 1) v += __shfl_xor(v, o);
    return v;
}
__device__ __forceinline__ float sigmoidf_(float x) { return 1.f / (1.f + __expf(-x)); }
__device__ __forceinline__ float gelu_tanh(float x) { const float u = 0.7978845608028654f * (x + 0.044715f * x * x * x); return 0.5f * x * (1.f + tanhf(u)); }

#define LAS __attribute__((address_space(3)))
typedef short bf16x8 __attribute__((ext_vector_type(8)));
typedef float f32x4 __attribute__((ext_vector_type(4)));
typedef unsigned u32x4 __attribute__((ext_vector_type(4)));
typedef unsigned u32x2 __attribute__((ext_vector_type(2)));
__device__ __forceinline__ unsigned pk2(float lo, float hi) { return (unsigned)f2bf(lo) | ((unsigned)f2bf(hi) << 16); }

namespace L {
constexpr size_t A256(size_t x) { return (x + 255) & ~(size_t)255; }
constexpr size_t CTL = 0, CTL_BYTES = 1u << 20;
constexpr size_t H = CTL + CTL_BYTES;
constexpr size_t MOD = CTL + 512 * 1024;
constexpr size_t TABC = A256(H + (size_t)MROWS * D * 4);
constexpr size_t TABS = A256(TABC + 4096 * 4);
constexpr size_t XN = A256(TABS + 4096 * 4);
constexpr size_t P = A256(XN + (size_t)MROWS * D * 2);
constexpr size_t MIX = A256(P + (size_t)MROWS * PP * 2);
constexpr size_t CQN = A256(MIX + (size_t)MROWS * D * 2);
constexpr size_t CKVN = A256(CQN + (size_t)MROWS * 256 * 2);
constexpr size_t QRAW = A256(CKVN + (size_t)MROWS * 128 * 2);
constexpr size_t KVRAW = A256(QRAW + (size_t)MROWS * 384 * 4);
constexpr size_t QL = A256(KVRAW + (size_t)MROWS * 512 * 4);
constexpr size_t QC = A256(QL + (size_t)16 * SEQ * 96 * 2);
constexpr size_t KB = A256(QC + (size_t)16 * CTX * 96 * 2);
constexpr size_t VB = A256(KB + (size_t)16 * NPOS * 96 * 2);
constexpr size_t LA = A256(VB + (size_t)16 * NPOS * 64 * 2);
constexpr size_t LB = A256(LA + (size_t)2 * MROWS * 256 * 4);
constexpr size_t HS = A256(LB + (size_t)2 * MROWS * 256 * 4);
constexpr size_t XCS = A256(HS + (size_t)2 * MROWS * 256 * 4);
constexpr size_t XCSC = A256(XCS + (size_t)4 * 8192 * 256 * 4);
constexpr size_t LIST = A256(XCSC + (size_t)4 * 512 * 256 * 4);
constexpr size_t GATE = A256(LIST + (size_t)2 * NE * LCAP * 4);
constexpr size_t ACT = A256(GATE + (size_t)NASG * 4);
constexpr size_t Y = A256(ACT + (size_t)ACT_ROWS * D * 2);
constexpr size_t WINT = A256(Y + (size_t)NASG * D * 2);
constexpr size_t WOUTT = A256(WINT + (size_t)2 * 2048 * 1024 * 2);
constexpr size_t WGUT = A256(WOUTT + (size_t)2 * 1024 * 1024 * 2);
constexpr size_t WDT = A256(WGUT + (size_t)2 * NE * 2048 * 1024 * 2);
constexpr size_t ZBUF = A256(WDT + (size_t)2 * NE * 1024 * 1024 * 2);
constexpr size_t VTG = A256(ZBUF + (size_t)4 * 64 * 64 * 512 * 2);
constexpr size_t WUQT = A256(VTG + (size_t)16 * 64 * NPOS * 2);
constexpr size_t WUKVT = A256(WUQT + (size_t)2 * 384 * 256 * 2);
constexpr size_t WAT = A256(WUKVT + (size_t)2 * 512 * 128 * 2);
constexpr size_t WIT = A256(WAT + (size_t)16 * 4096 * 2);
constexpr size_t SPT = A256(WIT + (size_t)16 * 4096 * 2);
constexpr size_t HL = A256(SPT + (size_t)1024 * 4);
constexpr size_t AC = A256(HL + (size_t)2 * MROWS * 256 * 2);
constexpr size_t SUM = A256(AC + (size_t)2 * MROWS * 256 * 2);
constexpr size_t XCT = A256(SUM + (size_t)2 * 4 * 68 * 512 * 4);
constexpr size_t END = A256(XCT + (size_t)16 * 512 * 64 * 2);
constexpr int CW_BAR = 4096;
constexpr int CW_CNT = 32768, CNT_STRIDE = 64;
}

#define XB_TMO      128
#define XB_XCNT(j)  (256  + 64 * (j))
#define XB_XSUB(j)  (1280 + 64 * (j))
#define XB_XGEN(j)  (2304 + 64 * (j))
#define XB_TOP      3328
#define XB_TOPGEN   3392
#define XCD_BAR_WORDS 3456
#define XB_SPIN_CAP (1u << 18)
__device__ __forceinline__ unsigned xb_ld(unsigned* p)              { return __hip_atomic_load(p, __ATOMIC_RELAXED, __HIP_MEMORY_SCOPE_AGENT); }
__device__ __forceinline__ unsigned xb_add(unsigned* p, unsigned v) { return __hip_atomic_fetch_add(p, v, __ATOMIC_RELAXED, __HIP_MEMORY_SCOPE_AGENT); }
__device__ __forceinline__ unsigned xb_xcc_id() { return (unsigned)__builtin_amdgcn_s_getreg((3 << 11) | 20) & 0xFu; }
#define XB_SPIN(cond, bar) do { unsigned _sp = 0; while (cond) { __builtin_amdgcn_s_sleep(1); \
    if ((++_sp & 255u) == 0u) { if (xb_ld(&(bar)[XB_TMO])) break; if (_sp > XB_SPIN_CAP) { atomicAdd(&(bar)[XB_TMO], 1u); break; } } } } while (0)
struct XcdBarrier { unsigned* bar; unsigned x; volatile LAS unsigned* st; };
__device__ __forceinline__ XcdBarrier xcd_barrier_post(unsigned* bar, volatile LAS unsigned* st) {
    XcdBarrier b; b.bar = bar; b.x = xb_xcc_id(); b.st = st;
    if (threadIdx.x == 0) (void)xb_add(&bar[XB_XCNT(b.x)], 1u);
    return b;
}
__device__ __forceinline__ void xcd_barrier_complete(unsigned* bar, unsigned x, unsigned& nloc, unsigned& nx) {
    const unsigned G = gridDim.x * gridDim.y * gridDim.z;
    unsigned sum, cnt, mine, sp = 0u;
    for (;;) {
        sum = 0u; cnt = 0u; mine = 0u;
#pragma unroll
        for (unsigned j = 0; j < 16; ++j) { const unsigned c = xb_ld(&bar[XB_XCNT(j)]); sum += c; cnt += (c > 0u) ? 1u : 0u; mine = (j == x) ? c : mine; }
        if (sum == G) break;
        __builtin_amdgcn_s_sleep(1);
        if ((++sp & 255u) == 0u) { if (xb_ld(&bar[XB_TMO])) break; if (sp > XB_SPIN_CAP) { atomicAdd(&bar[XB_TMO], 1u); break; } }
    }
    nloc = mine > 0u ? mine : 1u; nx = cnt > 0u ? cnt : 1u;
}
__device__ __forceinline__ void xcd_barrier(const XcdBarrier& b) {
    asm volatile("s_waitcnt vmcnt(0)" ::: "memory");
    __syncthreads();
    if (threadIdx.x == 0) {
        unsigned* bar = b.bar;
        __builtin_amdgcn_s_waitcnt(0);
        unsigned nloc = b.st[0], nx = b.st[1];
        if (nloc == 0u) { xcd_barrier_complete(bar, b.x, nloc, nx); b.st[0] = nloc; b.st[1] = nx; }
        const unsigned old = xb_add(&bar[XB_XSUB(b.x)], 1u);
        const unsigned gen = old / nloc;
        if (old + 1u == (gen + 1u) * nloc) {
            __builtin_amdgcn_fence(__ATOMIC_RELEASE, "agent");
            asm volatile("s_waitcnt vmcnt(0)" ::: "memory");
            const unsigned og = xb_add(&bar[XB_TOP], 1u);
            const unsigned tg = og / nx;
            if (og + 1u == (tg + 1u) * nx) xb_add(&bar[XB_TOPGEN], 1u);
            else XB_SPIN(xb_ld(&bar[XB_TOPGEN]) == tg, bar);
            __builtin_amdgcn_fence(__ATOMIC_ACQUIRE, "agent");
            xb_add(&bar[XB_XGEN(b.x)], 1u);
            asm volatile("s_waitcnt vmcnt(0)" ::: "memory");
        } else {
            XB_SPIN(xb_ld(&bar[XB_XGEN(b.x)]) == gen, bar);
            __builtin_amdgcn_fence(__ATOMIC_ACQUIRE, "agent");
            asm volatile("s_waitcnt vmcnt(0)" ::: "memory");
        }
    }
    __syncthreads();
}

namespace g8 {
constexpr int BM = 256, BK = 64, HALF = 128, HTB = HALF * BK * 2, STAGE_BYTES = 8 * HTB, NXCD = 8, WGM = 8;
__device__ __forceinline__ int lds_byte(int r, int c) { const int st = (r >> 4) * 2 + (c >> 5), rr = r & 15, cc = c & 31, ob = rr * 64 + cc * 2; return st * 1024 + (ob ^ (((ob >> 9) & 1) << 5)); }
__device__ __forceinline__ void stage_rc(int b, int& R, int& C) { const int st = b / 1024, sb = b % 1024, swz = sb ^ (((sb >> 9) & 1) << 5); R = (st >> 1) * 16 + swz / 64; C = (st & 1) * 32 + (swz % 64) / 2; }
__device__ __forceinline__ int perm32(int rho) { const int n = rho >> 4, i = rho & 15; return 8 * (i >> 2) + 4 * n + (i & 3); }
__device__ __forceinline__ unsigned cvt_pk_bf16(float lo, float hi) { unsigned r; asm volatile("v_cvt_pk_bf16_f32 %0, %1, %2" : "=v"(r) : "v"(lo), "v"(hi)); return r; }
__device__ __forceinline__ int xcd_remap(int wgid, int nwg) { const int q = nwg / NXCD, r = nwg % NXCD, xcd = wgid % NXCD, off = wgid / NXCD; return (xcd < r ? xcd * (q + 1) : r * (q + 1) + (xcd - r) * q) + off; }

struct Unit { int row0, col0, ex, bt, nvalid, lrow; };

struct DenseSched {
    int nM, nN, nwg, G, c, lat_only; const char* Bt; int K; const int* list;
    __device__ __forceinline__ void init(int nM_, int nN_, int G_, int c_, int lat_only_, const void* Bt_, int K_) { nM = nM_; nN = nN_; nwg = nM * nN; G = G_; c = c_; lat_only = lat_only_; Bt = (const char*)Bt_; K = K_; list = nullptr; }
    __device__ __forceinline__ bool next(int i, Unit& u) const {
        const long Lx = (long)i * G + c; if (Lx >= nwg) return false;
        const int wgid = xcd_remap((int)Lx, nwg);
        const int nig = WGM * nN, gid = wgid / nig, fm = gid * WGM, gsz = (nM - fm) < WGM ? (nM - fm) : WGM;
        const int pm = fm + ((wgid % nig) % gsz), pn = (wgid % nig) / gsz;
        const int tile = lat_only ? (pm / 16) * 17 + 1 + (pm % 16) : pm;
        u.row0 = tile * 256; u.col0 = pn * 256; u.ex = 0; u.bt = pn; u.nvalid = 256; u.lrow = 0; return true;
    }
    __device__ __forceinline__ const char* bptr(const Unit& u) const { return Bt + (size_t)u.bt * (256 * 1024 * 2); }
};
struct MoeSched {
    const LAS int* tpre; const LAS int* cnt; int NT, COLW, G, c, total; const char* Bt; int K; const int* list;
    __device__ __forceinline__ bool next(int i, Unit& u) const {
        const long Lx = (long)i * G + c; if (Lx >= total) return false;
        const int wgid = xcd_remap((int)Lx, total);
        int e = 0;
        for (int j = 1; j < NE; ++j) if (tpre[j] * NT <= wgid) e = j;
        const int t0 = tpre[e], mte = tpre[e + 1] - t0, loc = wgid - t0 * NT, nt = loc / mte, mt = loc % mte;
        u.ex = __builtin_amdgcn_readfirstlane(e); u.row0 = __builtin_amdgcn_readfirstlane((t0 + mt) * 256); u.col0 = __builtin_amdgcn_readfirstlane(nt * COLW);
        u.bt = __builtin_amdgcn_readfirstlane(e * NT + nt); const int nv = cnt[e] - mt * 256; u.nvalid = __builtin_amdgcn_readfirstlane(nv < 256 ? nv : 256); u.lrow = __builtin_amdgcn_readfirstlane(mt * 256);
        return true;
    }
    __device__ __forceinline__ const char* bptr(const Unit& u) const { return Bt + (size_t)u.bt * (256 * 1024 * 2); }
};

struct EpiP {
    static constexpr bool PERM = true; bf16_t* O;
    __device__ __forceinline__ void operator()(const f32x4 (&acc)[2][2][4][2], const Unit& u, int wr, int wc, int fr, int fq, const LAS int*) const {
#pragma unroll
        for (int ai = 0; ai < 2; ++ai)
#pragma unroll
            for (int m = 0; m < 4; ++m) { bf16_t* rowp = O + (size_t)(u.row0 + ai * HALF + wr * 64 + m * 16 + fr) * PP + u.col0 + wc * 32 + 8 * fq;
#pragma unroll
                for (int bj = 0; bj < 2; ++bj) { const f32x4 v0 = acc[ai][bj][m][0], v1 = acc[ai][bj][m][1]; u32x4 w; w.x = cvt_pk_bf16(v0[0], v0[1]); w.y = cvt_pk_bf16(v0[2], v0[3]); w.z = cvt_pk_bf16(v1[0], v1[1]); w.w = cvt_pk_bf16(v1[2], v1[3]);
                    *(u32x4*)(rowp + bj * HALF) = w; } }
    }
};
struct EpiH {
    static constexpr bool PERM = false; float* Hh; const float* MODl; int g_off;
    __device__ __forceinline__ void operator()(const f32x4 (&acc)[2][2][4][2], const Unit& u, int wr, int wc, int fr, int fq, const LAS int*) const {
        const int tile = u.row0 >> 8, v = (tile % 17 == 0) ? 4 : tile / 17; const float* gp = MODl + (size_t)v * 6144 + g_off + u.col0 + wc * 32 + 4 * fq;
        f32x4 gv[2][2];
#pragma unroll
        for (int bj = 0; bj < 2; ++bj)
#pragma unroll
            for (int n = 0; n < 2; ++n) gv[bj][n] = *(const f32x4*)(gp + bj * HALF + n * 16);
#pragma unroll
        for (int ai = 0; ai < 2; ++ai)
#pragma unroll
            for (int m = 0; m < 4; ++m) { float* rowp = Hh + (size_t)(u.row0 + ai * HALF + wr * 64 + m * 16 + fr) * D + u.col0 + wc * 32 + 4 * fq;
#pragma unroll
                for (int bj = 0; bj < 2; ++bj)
#pragma unroll
                    for (int n = 0; n < 2; ++n) { f32x4* p = (f32x4*)(rowp + bj * HALF + n * 16); *p = *p + gv[bj][n] * acc[ai][bj][m][n]; } }
    }
};
struct EpiMoe1 {
    static constexpr bool PERM = true; bf16_t* ACTp; const float* bgu;
    __device__ __forceinline__ void operator()(const f32x4 (&acc)[2][2][4][2], const Unit& u, int wr, int wc, int fr, int fq, const LAS int*) const {
        const int cc = u.col0 + wc * 32 + 8 * fq; const float* bp = bgu + (size_t)u.ex * 2048 + cc;
        f32x4 bg[2], bu[2];
#pragma unroll
        for (int n = 0; n < 2; ++n) { bg[n] = *(const f32x4*)(bp + 4 * n); bu[n] = *(const f32x4*)(bp + 1024 + 4 * n); }
#pragma unroll
        for (int ai = 0; ai < 2; ++ai)
#pragma unroll
            for (int m = 0; m < 4; ++m) { const int r = ai * HALF + wr * 64 + m * 16 + fr;
                float o[8];
#pragma unroll
                for (int n = 0; n < 2; ++n)
#pragma unroll
                    for (int i = 0; i < 4; ++i) { const float g = fminf(acc[ai][0][m][n][i] + bg[n][i], 7.f); const float uu = fminf(fmaxf(acc[ai][1][m][n][i] + bu[n][i], -7.f), 7.f);
                        o[n * 4 + i] = (uu + 1.f) * g * __builtin_amdgcn_rcpf(1.f + __expf(-1.702f * g)); }
                if (r < u.nvalid) { u32x4 w; w.x = cvt_pk_bf16(o[0], o[1]); w.y = cvt_pk_bf16(o[2], o[3]); w.z = cvt_pk_bf16(o[4], o[5]); w.w = cvt_pk_bf16(o[6], o[7]);
                    *(u32x4*)(ACTp + (size_t)(u.row0 + r) * D + cc) = w; } }
    }
};
struct EpiMoe2 {
    static constexpr bool PERM = true; bf16_t* Yp; const float* bd; const float* GATEp;
    __device__ __forceinline__ void operator()(const f32x4 (&acc)[2][2][4][2], const Unit& u, int wr, int wc, int fr, int fq, const LAS int* rows) const {
        const int cc = u.col0 + wc * 32 + 8 * fq; const float* bp = bd + (size_t)u.ex * 1024 + cc;
        f32x4 bv[2][2];
#pragma unroll
        for (int bj = 0; bj < 2; ++bj)
#pragma unroll
            for (int n = 0; n < 2; ++n) bv[bj][n] = *(const f32x4*)(bp + bj * HALF + 4 * n);
#pragma unroll
        for (int ai = 0; ai < 2; ++ai)
#pragma unroll
            for (int m = 0; m < 4; ++m) { const int r = ai * HALF + wr * 64 + m * 16 + fr;
                if (r < u.nvalid) { const int asg = rows[r]; const float gt = GATEp[asg]; bf16_t* rowp = Yp + (size_t)asg * D + cc;
#pragma unroll
                    for (int bj = 0; bj < 2; ++bj) { const f32x4 v0 = (acc[ai][bj][m][0] + bv[bj][0]) * gt, v1 = (acc[ai][bj][m][1] + bv[bj][1]) * gt;
                        u32x4 w; w.x = cvt_pk_bf16(v0[0], v0[1]); w.y = cvt_pk_bf16(v0[2], v0[3]); w.z = cvt_pk_bf16(v1[0], v1[1]); w.w = cvt_pk_bf16(v1[2], v1[3]); *(u32x4*)(rowp + bj * HALF) = w; } } }
    }
};

template <class Epi, class Sched, bool GATHER, bool ROWLIST>
__device__ __forceinline__ void gemm_phase(LAS unsigned char* lds, const char* Abase, const Sched& S, const Epi& E) {
    constexpr int K = 1024;
    int tid_l = threadIdx.x; asm volatile("" : "+v"(tid_l));
    const int tid = tid_l, wid = __builtin_amdgcn_readfirstlane(tid >> 6), lane = tid & 63, wr = wid >> 2, wc = wid & 3, fr = lane & 15, fq = lane >> 4;
    constexpr int nt = K / BK; constexpr unsigned Kb = (unsigned)K * 2u;
    unsigned voffB[2];
#pragma unroll
    for (int i = 0; i < 2; ++i) { int R, C; stage_rc(tid * 16 + i * 8192, R, C); const int Rb = Epi::PERM ? ((R & ~31) + perm32(R & 31)) : R; voffB[i] = (unsigned)(Rb * K + C) * 2u; }
    constexpr size_t kstep = (size_t)(BK * 2), hstep = (size_t)HALF * K * 2;
    const unsigned ldsw = (unsigned)wid * 1024u;
    const int aoff = lds_byte(wr * 64 + fr, fq * 8), boff = lds_byte(wc * 32 + fr, fq * 8);
    LAS int* rowbuf = (LAS int*)(lds + STAGE_BYTES);
#define G8_SA(b, h) (((b) * 2 + (h)) * HTB)
#define G8_SB(b, h) ((4 + (b) * 2 + (h)) * HTB)
#define G8_STAGE_A(bufoff, kb, v) do { _Pragma("unroll") for (int _i = 0; _i < 2; ++_i) \
        __builtin_amdgcn_global_load_lds((const unsigned*)((kb) + (size_t)(v)[_i]), (LAS unsigned*)(lds + (bufoff) + ldsw + _i * 8192), 16, 0, 0); } while (0)
#define G8_STAGE_B(bufoff, gbase) do { _Pragma("unroll") for (int _i = 0; _i < 2; ++_i) \
        __builtin_amdgcn_global_load_lds((const unsigned*)((gbase) + voffB[_i]), (LAS unsigned*)(lds + (bufoff) + ldsw + _i * 8192), 16, 0, 0); } while (0)
#define G8_LDA(dst, b, h) do { _Pragma("unroll") for (int m = 0; m < 4; ++m) _Pragma("unroll") for (int k = 0; k < 2; ++k) dst[m][k] = *(const LAS bf16x8*)(lds + G8_SA(b, h) + aoff + m * 2048 + k * 1024); } while (0)
#define G8_LDB(dst, b, h) do { _Pragma("unroll") for (int n = 0; n < 2; ++n) _Pragma("unroll") for (int k = 0; k < 2; ++k) dst[n][k] = *(const LAS bf16x8*)(lds + G8_SB(b, h) + boff + n * 2048 + k * 1024); } while (0)
#define G8_MMA(ai, bj, At, Bt) do { __builtin_amdgcn_s_setprio(1); _Pragma("unroll") for (int m = 0; m < 4; ++m) _Pragma("unroll") for (int n = 0; n < 2; ++n) _Pragma("unroll") for (int k = 0; k < 2; ++k) \
        acc[ai][bj][m][n] = __builtin_amdgcn_mfma_f32_16x16x32_bf16(Bt[n][k], At[m][k], acc[ai][bj][m][n], 0, 0, 0); __builtin_amdgcn_s_setprio(0); } while (0)
#define G8_WAIT_V(n) asm volatile("s_waitcnt vmcnt(" #n ")" ::: "memory")
#define G8_WAIT_L(n) asm volatile("s_waitcnt lgkmcnt(" #n ")" ::: "memory")
#define G8_BAR __builtin_amdgcn_s_barrier()
#define G8_SCHED __builtin_amdgcn_sched_barrier(0)
#define G8_LISTDMA(u, s) do { if (wid < 4) __builtin_amdgcn_global_load_lds((const unsigned*)(S.list + (size_t)(u).ex * LCAP + (u).lrow + wid * 64 + lane), (LAS unsigned*)(rowbuf + (s) * 256 + wid * 64), 4, 0, 0); } while (0)
#define G8_ROWS_DENSE(v) do { _Pragma("unroll") for (int _i = 0; _i < 2; ++_i) { int _R, _C; stage_rc(tid * 16 + _i * 8192, _R, _C); _Pragma("unroll") for (int _h = 0; _h < 2; ++_h) (v)[_h][_i] = (unsigned)(_h * HALF + _R) * Kb + (unsigned)_C * 2u; } } while (0)
#define G8_ROWS_LIST(v, u, s) do { _Pragma("unroll") for (int _i = 0; _i < 2; ++_i) { int _R, _C; stage_rc(tid * 16 + _i * 8192, _R, _C); _Pragma("unroll") for (int _h = 0; _h < 2; ++_h) { const int _r = _h * HALF + _R; const int _a = rowbuf[(s) * 256 + _r]; \
        (v)[_h][_i] = (unsigned)(_r < (u).nvalid ? (_a >> 2) : 0) * Kb + (unsigned)_C * 2u; } } } while (0)
    Unit cur, nxt; int ui = 0, slot = 0;
    if (!S.next(0, cur)) return;
    unsigned vA[2][2];
    if constexpr (ROWLIST) { G8_LISTDMA(cur, 0); G8_WAIT_V(0); G8_BAR; }
    if constexpr (GATHER) { G8_ROWS_LIST(vA, cur, 0); } else { G8_ROWS_DENSE(vA); }
    f32x4 acc[2][2][4][2];
#pragma unroll
    for (int a = 0; a < 2; ++a)
#pragma unroll
        for (int b = 0; b < 2; ++b)
#pragma unroll
            for (int m = 0; m < 4; ++m)
#pragma unroll
                for (int n = 0; n < 2; ++n) acc[a][b][m][n] = (f32x4){0.f, 0.f, 0.f, 0.f};
    bf16x8 At[4][2], B0[2][2], B1[2][2];
    const char* cB = S.bptr(cur);
    const char* cA = GATHER ? Abase : Abase + (size_t)cur.row0 * Kb;
    G8_STAGE_B(G8_SB(0, 0), cB); G8_STAGE_B(G8_SB(0, 1), cB + hstep); G8_STAGE_A(G8_SA(0, 0), cA, vA[0]); G8_STAGE_A(G8_SA(0, 1), cA, vA[1]);
    if (wr == 1) G8_BAR;
    G8_WAIT_V(2); G8_BAR;
    G8_STAGE_B(G8_SB(1, 0), cB + kstep); G8_STAGE_A(G8_SA(1, 0), cA + kstep, vA[0]); G8_STAGE_B(G8_SB(1, 1), cB + hstep + kstep);
    G8_WAIT_V(6); G8_BAR;
    for (;;) {
        const bool has_next = S.next(ui + 1, nxt);
        const char* nB = has_next ? S.bptr(nxt) : cB;
        const char* nA = (GATHER || !has_next) ? cA : Abase + (size_t)nxt.row0 * Kb;
        const int nslot = slot == 2 ? 0 : slot + 1;
        if constexpr (ROWLIST) { if (has_next) G8_LISTDMA(nxt, nslot); }
        for (int t = 0; t < nt; t += 2) {
            const bool last = (t == nt - 2);
            const char* a1 = cA + (size_t)(t + 1) * kstep;
            const char* a2 = last ? nA : cA + (size_t)(t + 2) * kstep; const char* b2 = last ? nB : cB + (size_t)(t + 2) * kstep;
            const char* a3 = a2 + kstep; const char* b3 = b2 + kstep;
            G8_LDB(B0, 0, 0); G8_LDB(B1, 0, 1); G8_SCHED; G8_LDA(At, 0, 0); G8_STAGE_A(G8_SA(1, 1), a1, vA[1]);
            if constexpr (GATHER) { if (last && has_next) { G8_ROWS_LIST(vA, nxt, nslot); } }
            G8_WAIT_V(8); G8_WAIT_L(0); G8_BAR; G8_MMA(0, 0, At, B0); G8_MMA(0, 1, At, B1); G8_BAR; G8_SCHED;
            G8_LDA(At, 0, 1); G8_STAGE_B(G8_SB(0, 0), b2); G8_STAGE_B(G8_SB(0, 1), b2 + hstep); G8_STAGE_A(G8_SA(0, 0), a2, vA[0]);
            G8_WAIT_V(8); G8_WAIT_L(0); G8_BAR; G8_MMA(1, 0, At, B0); G8_MMA(1, 1, At, B1); G8_BAR; G8_SCHED;
            G8_LDB(B0, 1, 0); G8_LDB(B1, 1, 1); G8_SCHED; G8_LDA(At, 1, 0); G8_STAGE_A(G8_SA(0, 1), a2, vA[1]);
            G8_WAIT_V(8); G8_WAIT_L(0); G8_BAR; G8_MMA(0, 0, At, B0); G8_MMA(0, 1, At, B1); G8_BAR; G8_SCHED;
            G8_LDA(At, 1, 1); G8_STAGE_B(G8_SB(1, 0), b3); G8_STAGE_B(G8_SB(1, 1), b3 + hstep); G8_STAGE_A(G8_SA(1, 0), a3, vA[0]);
            G8_WAIT_V(8); G8_WAIT_L(0); G8_BAR; G8_MMA(1, 0, At, B0); G8_MMA(1, 1, At, B1); G8_BAR; G8_SCHED;
        }
        if (wr == 0) G8_BAR;
        { int t2 = threadIdx.x; asm volatile("" : "+v"(t2));
          const int w2 = __builtin_amdgcn_readfirstlane(t2 >> 6); E(acc, cur, w2 >> 2, w2 & 3, t2 & 15, (t2 & 63) >> 4, rowbuf + slot * 256); }
        if (!has_next) break;
#pragma unroll
        for (int a = 0; a < 2; ++a)
#pragma unroll
            for (int b = 0; b < 2; ++b)
#pragma unroll
                for (int m = 0; m < 4; ++m)
#pragma unroll
                    for (int n = 0; n < 2; ++n) acc[a][b][m][n] = (f32x4){0.f, 0.f, 0.f, 0.f};
        cur = nxt; cB = nB; cA = nA; ++ui; slot = nslot;
        if (wr == 1) G8_BAR;
    }
    G8_WAIT_V(0);
    G8_BAR;
#undef G8_SA
#undef G8_SB
#undef G8_STAGE_A
#undef G8_STAGE_B
#undef G8_LDA
#undef G8_LDB
#undef G8_MMA
#undef G8_WAIT_V
#undef G8_WAIT_L
#undef G8_BAR
#undef G8_SCHED
#undef G8_LISTDMA
#undef G8_ROWS_DENSE
#undef G8_ROWS_LIST
}
}

namespace fft {
constexpr int TP = 72;
constexpr int UP = 264;
constexpr int ZP = 520;
constexpr int O_TC = 0, O_TS = 9216, O_U = 18432, O_X = 52224, O_TW = 125952;
__device__ __forceinline__ bf16x8 neg8(bf16x8 v) { u32x4 w = __builtin_bit_cast(u32x4, v); w = w ^ 0x80008000u; return __builtin_bit_cast(bf16x8, w); }
__device__ __forceinline__ void build_tables(LAS unsigned char* lds, const float* TABC, const float* TABS, int tid) {
    for (int i = tid; i < 4096; i += 512) { const int a = i >> 6, b = i & 63, ix = ((a * b) & 63) * 64;
        ((LAS bf16_t*)(lds + O_TC))[a * TP + b] = f2bf(TABC[ix]); ((LAS bf16_t*)(lds + O_TS))[a * TP + b] = f2bf(TABS[ix]); }
}
__device__ __forceinline__ void stage_a(LAS unsigned char* lds, const bf16_t* P, const float* TABC, const float* TABS, bf16_t* ZBUF, int G, int bx) {
    int tid_l = threadIdx.x; asm volatile("" : "+v"(tid_l));
    const int tid = tid_l, lane = tid & 63, w = __builtin_amdgcn_readfirstlane(tid >> 6), fr = lane & 15, fq = lane >> 4;
    build_tables(lds, TABC, TABS, tid);
    const LAS bf16_t* Tc = (const LAS bf16_t*)(lds + O_TC); const LAS bf16_t* Ts = (const LAS bf16_t*)(lds + O_TS);
    LAS bf16_t* U = (LAS bf16_t*)(lds + O_U); LAS bf16_t* X = (LAS bf16_t*)(lds + O_X); LAS float* TW = (LAS float*)(lds + O_TW);
    for (int unit = bx; unit < 256; unit += G) {
        const int b = unit >> 6, t2 = unit & 63;
#pragma unroll
        for (int i = 0; i < 4; ++i) { const int q = tid + 512 * i, t1 = q >> 5, ch = q & 31;
            *(LAS u32x4*)((LAS unsigned char*)U + t1 * (UP * 2) + ch * 16) = *(const u32x4*)(P + ((size_t)b * NPOS + CTX + 64 * t1 + t2) * PP + ch * 8); }
        if (tid < 64) { const int ix = tid * t2; TW[2 * tid] = TABC[ix]; TW[2 * tid + 1] = TABS[ix]; }
        __syncthreads();
        { const int g = w >> 1, part = w & 1; const LAS bf16_t* T = part ? Ts : Tc;
          f32x4 acc[4][4];
#pragma unroll
          for (int mt = 0; mt < 4; ++mt)
#pragma unroll
              for (int nt = 0; nt < 4; ++nt) acc[mt][nt] = (f32x4){0.f, 0.f, 0.f, 0.f};
#pragma unroll
          for (int ks = 0; ks < 2; ++ks) { bf16x8 a[4], bb[4];
#pragma unroll
              for (int mt = 0; mt < 4; ++mt) a[mt] = *(const LAS bf16x8*)(U + (16 * mt + fr) * UP + g * 64 + 32 * ks + 8 * fq);
#pragma unroll
              for (int nt = 0; nt < 4; ++nt) bb[nt] = *(const LAS bf16x8*)(T + (16 * nt + fr) * TP + 32 * ks + 8 * fq);
#pragma unroll
              for (int mt = 0; mt < 4; ++mt)
#pragma unroll
                  for (int nt = 0; nt < 4; ++nt) acc[mt][nt] = __builtin_amdgcn_mfma_f32_16x16x32_bf16(a[mt], bb[nt], acc[mt][nt], 0, 0, 0); }
          const float sg = part ? -1.f : 1.f;
#pragma unroll
          for (int mt = 0; mt < 4; ++mt)
#pragma unroll
              for (int nt = 0; nt < 4; ++nt) { const f32x4 v = acc[mt][nt] * sg; u32x2 o; o.x = pk2(v[0], v[1]); o.y = pk2(v[2], v[3]);
                  *(LAS u32x2*)(X + (part * 256 + g * 64 + 16 * nt + fr) * TP + 16 * mt + 4 * fq) = o; } }
        __syncthreads();
        f32x4 zr[4][2], zi[4][2];
#pragma unroll
        for (int mt = 0; mt < 4; ++mt)
#pragma unroll
            for (int n = 0; n < 2; ++n) { zr[mt][n] = (f32x4){0.f, 0.f, 0.f, 0.f}; zi[mt][n] = (f32x4){0.f, 0.f, 0.f, 0.f}; }
#pragma unroll
        for (int ks = 0; ks < 2; ++ks) { bf16x8 xr[2], xi[2];
#pragma unroll
            for (int n = 0; n < 2; ++n) { xr[n] = *(const LAS bf16x8*)(X + (32 * w + 16 * n + fr) * TP + 32 * ks + 8 * fq); xi[n] = *(const LAS bf16x8*)(X + (256 + 32 * w + 16 * n + fr) * TP + 32 * ks + 8 * fq); }
#pragma unroll
            for (int mt = 0; mt < 4; ++mt) { const bf16x8 c = *(const LAS bf16x8*)(Tc + (16 * mt + fr) * TP + 32 * ks + 8 * fq), s = *(const LAS bf16x8*)(Ts + (16 * mt + fr) * TP + 32 * ks + 8 * fq), ns = neg8(s);
#pragma unroll
                for (int n = 0; n < 2; ++n) { zr[mt][n] = __builtin_amdgcn_mfma_f32_16x16x32_bf16(c, xr[n], zr[mt][n], 0, 0, 0); zr[mt][n] = __builtin_amdgcn_mfma_f32_16x16x32_bf16(s, xi[n], zr[mt][n], 0, 0, 0);
                    zi[mt][n] = __builtin_amdgcn_mfma_f32_16x16x32_bf16(c, xi[n], zi[mt][n], 0, 0, 0); zi[mt][n] = __builtin_amdgcn_mfma_f32_16x16x32_bf16(ns, xr[n], zi[mt][n], 0, 0, 0); } } }
        __syncthreads();
        { LAS bf16_t* Zs = X;
#pragma unroll
          for (int mt = 0; mt < 4; ++mt)
#pragma unroll
              for (int i = 0; i < 4; ++i) { const int f1 = 16 * mt + 4 * fq + i; const float ct = TW[2 * f1], st = TW[2 * f1 + 1];
#pragma unroll
                  for (int n = 0; n < 2; ++n) { const float a = zr[mt][n][i], bq = zi[mt][n][i]; const int col = 32 * w + 16 * n + fr;
                      Zs[f1 * ZP + col] = f2bf(a * ct + bq * st); Zs[f1 * ZP + 256 + col] = f2bf(bq * ct - a * st); } } }
        __syncthreads();
#pragma unroll
        for (int i = 0; i < 8; ++i) { const int q = tid + 512 * i, f1 = q >> 6, ch = q & 63;
            *(u32x4*)(ZBUF + (((size_t)b * 64 + f1) * 64 + t2) * 512 + ch * 8) = *(const LAS u32x4*)((const LAS unsigned char*)X + f1 * (ZP * 2) + ch * 16); }
        __syncthreads();
    }
}
__device__ __forceinline__ void stage_b(LAS unsigned char* lds, const bf16_t* ZBUF, const float* TABC, const float* TABS, bf16_t* MIX, int G, int bx) {
    int tid_l = threadIdx.x; asm volatile("" : "+v"(tid_l));
    const int tid = tid_l, lane = tid & 63, w = __builtin_amdgcn_readfirstlane(tid >> 6), fr = lane & 15, fq = lane >> 4;
    build_tables(lds, TABC, TABS, tid);
    const LAS bf16_t* Tc = (const LAS bf16_t*)(lds + O_TC); const LAS bf16_t* Ts = (const LAS bf16_t*)(lds + O_TS);
    LAS bf16_t* Ys = (LAS bf16_t*)(lds + O_U); LAS bf16_t* ZT = (LAS bf16_t*)(lds + O_X);
    for (int unit = bx; unit < 256; unit += G) {
        const int b = unit >> 6, f1 = unit & 63;
        const bf16_t* Zg = ZBUF + ((size_t)b * 64 + f1) * 64 * 512;
#pragma unroll
        for (int i = 0; i < 4; ++i) { const int q = tid + 512 * i, p = q & 31, ch = q >> 5;
            const u32x4 r0 = *(const u32x4*)(Zg + (size_t)(2 * p) * 512 + ch * 8), r1 = *(const u32x4*)(Zg + (size_t)(2 * p + 1) * 512 + ch * 8);
#pragma unroll
            for (int j = 0; j < 4; ++j) { const unsigned a = r0[j], c = r1[j];
                *(LAS unsigned*)(ZT + (ch * 8 + 2 * j) * TP + 2 * p) = (a & 0xffffu) | (c << 16);
                *(LAS unsigned*)(ZT + (ch * 8 + 2 * j + 1) * TP + 2 * p) = (a >> 16) | (c & 0xffff0000u); } }
        __syncthreads();
        f32x4 y[4][2];
#pragma unroll
        for (int mt = 0; mt < 4; ++mt)
#pragma unroll
            for (int n = 0; n < 2; ++n) y[mt][n] = (f32x4){0.f, 0.f, 0.f, 0.f};
#pragma unroll
        for (int ks = 0; ks < 2; ++ks) { bf16x8 xr[2], xi[2];
#pragma unroll
            for (int n = 0; n < 2; ++n) { xr[n] = *(const LAS bf16x8*)(ZT + (32 * w + 16 * n + fr) * TP + 32 * ks + 8 * fq); xi[n] = *(const LAS bf16x8*)(ZT + (256 + 32 * w + 16 * n + fr) * TP + 32 * ks + 8 * fq); }
#pragma unroll
            for (int mt = 0; mt < 4; ++mt) { const bf16x8 c = *(const LAS bf16x8*)(Tc + (16 * mt + fr) * TP + 32 * ks + 8 * fq), s = *(const LAS bf16x8*)(Ts + (16 * mt + fr) * TP + 32 * ks + 8 * fq);
#pragma unroll
                for (int n = 0; n < 2; ++n) { y[mt][n] = __builtin_amdgcn_mfma_f32_16x16x32_bf16(c, xr[n], y[mt][n], 0, 0, 0); y[mt][n] = __builtin_amdgcn_mfma_f32_16x16x32_bf16(s, xi[n], y[mt][n], 0, 0, 0); } } }
#pragma unroll
        for (int mt = 0; mt < 4; ++mt)
#pragma unroll
            for (int i = 0; i < 4; ++i)
#pragma unroll
                for (int n = 0; n < 2; ++n) Ys[(16 * mt + 4 * fq + i) * UP + 32 * w + 16 * n + fr] = f2bf(y[mt][n][i] * (1.f / 512.f));
        __syncthreads();
#pragma unroll
        for (int i = 0; i < 4; ++i) { const int q = tid + 512 * i, f2 = q >> 5, ch = q & 31;
            *(u32x4*)(MIX + ((size_t)b * NPOS + CTX + f1 + 64 * f2) * D + ch * 8) = *(const LAS u32x4*)((const LAS unsigned char*)Ys + f2 * (UP * 2) + ch * 16); }
        __syncthreads();
    }
}
}

namespace attn {
typedef float f32x16 __attribute__((ext_vector_type(16)));
typedef float f32x2_t __attribute__((ext_vector_type(2))); typedef __bf16 bf16x2_t __attribute__((ext_vector_type(2)));
__device__ __forceinline__ unsigned cvtpk(float lo, float hi) { f32x2_t v = {lo, hi}; bf16x2_t b = __builtin_convertvector(v, bf16x2_t); return __builtin_bit_cast(unsigned, b); }
constexpr int KP = 104, VP = 68;
constexpr int KT_BYTES = 64 * KP * 2, VT_BYTES = 64 * VP * 2, BUF_BYTES = KT_BYTES + VT_BYTES;
constexpr float THR = 8.f;
__device__ __forceinline__ void attn_phase(LAS unsigned char* lds, const bf16_t* QL, const bf16_t* QC, const bf16_t* KB, const bf16_t* VTG, bf16_t* MIX, int with_ctx, int G, int vcu) {
    const int nunits = 256 + (with_ctx ? 16 : 0);
    for (int unit = vcu; unit < nunits; unit += G) {
        int tid_l = threadIdx.x; asm volatile("" : "+v"(tid_l));
        const int tid = tid_l, lane = tid & 63, wid = __builtin_amdgcn_readfirstlane(tid >> 6), r32 = lane & 31, hi = lane >> 5;
        int bh, nk, orow0; const bf16_t* Qp;
        if (unit < 256) { bh = unit >> 4; const int qb = unit & 15; Qp = QL + ((size_t)bh * SEQ + qb * 256) * 96; nk = NPOS; orow0 = (bh >> 2) * NPOS + CTX + qb * 256; }
        else { bh = unit - 256; Qp = QC + (size_t)bh * CTX * 96; nk = CTX; orow0 = (bh >> 2) * NPOS; }
        const int hh = bh & 3, NT = nk / 64;
        const bf16_t* Kg = KB + (size_t)bh * NPOS * 96; const bf16_t* Vg = VTG + (size_t)bh * 64 * NPOS;
        bf16x8 qf[6];
        { const bf16_t* qp = Qp + (size_t)(wid * 32 + r32) * 96 + 8 * hi;
#pragma unroll
          for (int ds = 0; ds < 6; ++ds) qf[ds] = *(const bf16x8*)(qp + 16 * ds); }
        f32x16 o0 = {}, o1 = {}; float mhat = 0.f, l = 0.f;
        const int kr0 = tid / 12, kc0 = tid % 12, kr1 = (tid + 512) / 12, kc1 = (tid + 512) % 12; const bool k1ok = tid < 256;
        const int vd = tid >> 3, vc = tid & 7;
        u32x4 sk0, sk1 = {}, sv;
#define AT_LOAD(t_) do { const size_t k0_ = (size_t)(t_) * 64; sk0 = *(const u32x4*)(Kg + (k0_ + kr0) * 96 + kc0 * 8); if (k1ok) sk1 = *(const u32x4*)(Kg + (k0_ + kr1) * 96 + kc1 * 8); sv = *(const u32x4*)(Vg + (size_t)vd * NPOS + k0_ + vc * 8); } while (0)
#define AT_STORE(slot_) do { LAS unsigned char* bp_ = lds + (slot_) * BUF_BYTES; *(LAS u32x4*)(bp_ + kr0 * (KP * 2) + kc0 * 16) = sk0; if (k1ok) *(LAS u32x4*)(bp_ + kr1 * (KP * 2) + kc1 * 16) = sk1; *(LAS u32x4*)(bp_ + KT_BYTES + vd * (VP * 2) + vc * 16) = sv; } while (0)
#define AT_QK(P0, P1, slot_) do { const LAS bf16_t* Kt_ = (const LAS bf16_t*)(lds + (slot_) * BUF_BYTES); f32x16 c_; _Pragma("unroll") for (int r_ = 0; r_ < 16; ++r_) c_[r_] = -mhat; P0 = c_; P1 = c_; \
        _Pragma("unroll") for (int ds = 0; ds < 6; ++ds) { const bf16x8 k0f = *(const LAS bf16x8*)(Kt_ + r32 * KP + 16 * ds + 8 * hi), k1f = *(const LAS bf16x8*)(Kt_ + (32 + r32) * KP + 16 * ds + 8 * hi); \
            P0 = __builtin_amdgcn_mfma_f32_32x32x16_bf16(k0f, qf[ds], P0, 0, 0, 0); P1 = __builtin_amdgcn_mfma_f32_32x32x16_bf16(k1f, qf[ds], P1, 0, 0, 0); } } while (0)
        AT_LOAD(0); AT_STORE(0);
        if (NT > 1) { AT_LOAD(1); AT_STORE(1); }
        __syncthreads();
        f32x16 p0, p1, n0, n1;
        AT_QK(p0, p1, 0);
        int s_cur = 0, s_nxt = 1, s_ld = 2;
        for (int t = 0; t < NT; ++t) {
            if (t + 2 < NT) AT_LOAD(t + 2);
            if (t + 1 < NT) AT_QK(n0, n1, s_nxt);
            float mx = fmaxf(p0[0], p1[0]);
#pragma unroll
            for (int r = 1; r < 16; ++r) mx = fmaxf(mx, fmaxf(p0[r], p1[r]));
            mx = fmaxf(mx, __shfl_xor(mx, 32));
            if (__builtin_expect(t == 0 || __any(mx > THR), 0)) { const float dl = t == 0 ? mx : fmaxf(mx, 0.f), f = __builtin_amdgcn_exp2f(-dl); mhat += dl; l *= f;
#pragma unroll
                for (int r = 0; r < 16; ++r) { p0[r] -= dl; p1[r] -= dl; o0[r] *= f; o1[r] *= f; }
                if (t + 1 < NT) {
#pragma unroll
                    for (int r = 0; r < 16; ++r) { n0[r] -= dl; n1[r] -= dl; } } }
            float ls = 0.f;
#pragma unroll
            for (int r = 0; r < 16; ++r) { p0[r] = __builtin_amdgcn_exp2f(p0[r]); p1[r] = __builtin_amdgcn_exp2f(p1[r]); ls += p0[r] + p1[r]; }
            l += ls;
            const LAS bf16_t* Vt = (const LAS bf16_t*)(lds + s_cur * BUF_BYTES + KT_BYTES);
#pragma unroll
            for (int s = 0; s < 4; ++s) {
                u32x4 pw;
#pragma unroll
                for (int j = 0; j < 4; ++j) { const int r = 8 * (s & 1) + 2 * j; pw[j] = (s < 2) ? cvtpk(p0[r], p0[r + 1]) : cvtpk(p1[r], p1[r + 1]); }
                const bf16x8 pf = __builtin_bit_cast(bf16x8, pw);
                const int kvb = 32 * (s >> 1) + 16 * (s & 1) + 4 * hi;
#pragma unroll
                for (int db = 0; db < 2; ++db) { const u32x2 va = *(const LAS u32x2*)(Vt + (32 * db + r32) * VP + kvb), vb = *(const LAS u32x2*)(Vt + (32 * db + r32) * VP + kvb + 8);
                    const u32x4 vw = {va.x, va.y, vb.x, vb.y}; const bf16x8 vf = __builtin_bit_cast(bf16x8, vw);
                    if (db == 0) o0 = __builtin_amdgcn_mfma_f32_32x32x16_bf16(vf, pf, o0, 0, 0, 0); else o1 = __builtin_amdgcn_mfma_f32_32x32x16_bf16(vf, pf, o1, 0, 0, 0); }
            }
            if (t + 2 < NT) AT_STORE(s_ld);
            __syncthreads();
            p0 = n0; p1 = n1;
            { const int tmp = s_cur; s_cur = s_nxt; s_nxt = s_ld; s_ld = tmp; }
        }
#undef AT_LOAD
#undef AT_STORE
#undef AT_QK
        l += __shfl_xor(l, 32);
        const float il = 1.f / l;
        bf16_t* op = MIX + (size_t)(orow0 + wid * 32 + r32) * D + 512 + hh * 64 + 4 * hi;
#pragma unroll
        for (int g4 = 0; g4 < 4; ++g4) { u32x2 w0, w1; w0.x = cvtpk(o0[4 * g4] * il, o0[4 * g4 + 1] * il); w0.y = cvtpk(o0[4 * g4 + 2] * il, o0[4 * g4 + 3] * il);
            w1.x = cvtpk(o1[4 * g4] * il, o1[4 * g4 + 1] * il); w1.y = cvtpk(o1[4 * g4 + 2] * il, o1[4 * g4 + 3] * il);
            *(u32x2*)(op + 8 * g4) = w0; *(u32x2*)(op + 32 + 8 * g4) = w1; }
    }
}
}

namespace sm {
__device__ __forceinline__ float silu(float x) { return x / (1.f + __expf(-x)); }
__device__ __forceinline__ void mod_phase(LAS unsigned char* lds, const float* c, const float* c_ctx, const float* mod_w, const float* mod_b, float* MOD, int G, int bx, int tid) {
    LAS float* s = (LAS float*)lds;
    for (int i = tid; i < 5120; i += 512) { const int v = i >> 10, k = i & 1023; s[i] = silu(v < 4 ? c[v * 1024 + k] : c_ctx[k]); }
    __syncthreads();
    LAS float* red = s + 5120;
    for (int unit = bx; unit < 96; unit += G) {
        const int l = unit / 48, cb = unit % 48, cl = tid & 127, col = cb * 128 + cl, kq = tid >> 7, k0 = kq * 256;
        const float* W = mod_w + ((size_t)l * 1024 + k0) * 6144 + col;
        float a0 = 0.f, a1 = 0.f, a2 = 0.f, a3 = 0.f, a4 = 0.f;
#pragma unroll 16
        for (int k = 0; k < 256; ++k) { const float w = W[(size_t)k * 6144]; a0 += s[k0 + k] * w; a1 += s[1024 + k0 + k] * w; a2 += s[2048 + k0 + k] * w; a3 += s[3072 + k0 + k] * w; a4 += s[4096 + k0 + k] * w; }
        LAS float* rq = red + kq * 640 + cl; rq[0] = a0; rq[128] = a1; rq[256] = a2; rq[384] = a3; rq[512] = a4;
        __syncthreads();
        for (int i = tid; i < 640; i += 512) { const int v = i >> 7, cc = i & 127; const float r = ((red[i] + red[640 + i]) + (red[1280 + i] + red[1920 + i])) + mod_b[l * 6144 + cb * 128 + cc];
            MOD[((size_t)l * 5 + v) * 6144 + cb * 128 + cc] = r; }
        __syncthreads();
    }
}
__device__ __forceinline__ void norm_store(const float4 (&x)[4], float ss, const float* g, const float* mv, int sh_off, int sc_off, bf16_t* xn_row, int lane) {
    const float rs = rsqrtf(wave_sum(ss) * (1.f / D) + 1e-6f);
#pragma unroll
    for (int j = 0; j < 4; ++j) { const int c = (j * 64 + lane) * 4; const float4 gg = *(const float4*)(g + c), sh = *(const float4*)(mv + sh_off + c), sc = *(const float4*)(mv + sc_off + c);
        u32x2 o; o.x = pk2(x[j].x * rs * gg.x * (1.f + sc.x) + sh.x, x[j].y * rs * gg.y * (1.f + sc.y) + sh.y); o.y = pk2(x[j].z * rs * gg.z * (1.f + sc.z) + sh.z, x[j].w * rs * gg.w * (1.f + sc.w) + sh.w);
        *(u32x2*)(xn_row + c) = o; }
}
__device__ __forceinline__ void pro1_phase(const float* x, const float* ctx, const float* g, const float* MODl, float* H, bf16_t* XN, int gw, int NGW, int lane) {
    for (int r = gw; r < MROWS; r += NGW) { const int b = r / NPOS, pos = r % NPOS, v = pos < CTX ? 4 : b;
        const float* src = pos < CTX ? ctx + ((size_t)b * CTX + pos) * D : x + ((size_t)b * SEQ + (pos - CTX)) * D;
        float4 xv[4]; float ss = 0.f;
#pragma unroll
        for (int j = 0; j < 4; ++j) { const int c = (j * 64 + lane) * 4; xv[j] = *(const float4*)(src + c); *(float4*)(H + (size_t)r * D + c) = xv[j]; ss += xv[j].x * xv[j].x + xv[j].y * xv[j].y + xv[j].z * xv[j].z + xv[j].w * xv[j].w; }
        norm_store(xv, ss, g, MODl + (size_t)v * 6144, 0, 1024, XN + (size_t)r * D, lane); }
}
__device__ __forceinline__ void comb_phase(int l, float* H, const bf16_t* Y, const float* MODl, const float* g_next, const float* MODn, bf16_t* XN, const float* final_g, float* out, int gw, int NGW, int lane) {
    for (int r = gw; r < MROWS; r += NGW) { const int b = r / NPOS, pos = r % NPOS, v = pos < CTX ? 4 : b;
        if (l == 1 && pos < CTX) continue;
        const float* g2 = MODl + (size_t)v * 6144 + 5120;
        float4 xv[4]; float ss = 0.f;
#pragma unroll
        for (int j = 0; j < 4; ++j) { const int c = (j * 64 + lane) * 4; xv[j] = *(const float4*)(H + (size_t)r * D + c); float4 s = make_float4(0.f, 0.f, 0.f, 0.f);
#pragma unroll
            for (int k = 0; k < 4; ++k) { const u32x2 y = *(const u32x2*)(Y + ((size_t)r * 4 + k) * D + c); s.x += __uint_as_float(y.x << 16); s.y += __uint_as_float(y.x & 0xffff0000u); s.z += __uint_as_float(y.y << 16); s.w += __uint_as_float(y.y & 0xffff0000u); }
            const float4 gg = *(const float4*)(g2 + c); xv[j].x += gg.x * s.x; xv[j].y += gg.y * s.y; xv[j].z += gg.z * s.z; xv[j].w += gg.w * s.w;
            ss += xv[j].x * xv[j].x + xv[j].y * xv[j].y + xv[j].z * xv[j].z + xv[j].w * xv[j].w; }
        if (l == 0) {
#pragma unroll
            for (int j = 0; j < 4; ++j) *(float4*)(H + (size_t)r * D + (j * 64 + lane) * 4) = xv[j];
            norm_store(xv, ss, g_next, MODn + (size_t)v * 6144, 0, 1024, XN + (size_t)r * D, lane);
        } else { const float rs = rsqrtf(wave_sum(ss) * (1.f / D) + 1e-6f); float* op = out + ((size_t)b * SEQ + (pos - CTX)) * D;
#pragma unroll
            for (int j = 0; j < 4; ++j) { const int c = (j * 64 + lane) * 4; const float4 fg = *(const float4*)(final_g + c); float4 o; o.x = xv[j].x * rs * fg.x; o.y = xv[j].y * rs * fg.y; o.z = xv[j].z * rs * fg.z; o.w = xv[j].w * rs * fg.w; *(float4*)(op + c) = o; } }
    }
}
__device__ __forceinline__ void route_phase(LAS unsigned char* lds, int l, const float* H, const float* g, const float* MODl, const float* rw, const float* rb, bf16_t* XN, int* CNT, int* LIST, float* GATE,
                                            int G, int bx, int tid) {
    const int lane = tid & 63, wave = __builtin_amdgcn_readfirstlane(tid >> 6), e = lane & 31, kpart = wave * 2 + (lane >> 5);
    LAS float* F = (LAS float*)lds;
    LAS float* PART = (LAS float*)(lds + 32768);
    LAS int* LCNT = (LAS int*)(lds + 49152);
    LAS int* LBASE = LCNT + 64; LAS int* LENT = LCNT + 128;
    if (tid < 64) LCNT[tid] = 0;
    __syncthreads();
    float w[64];
#pragma unroll
    for (int k = 0; k < 64; ++k) w[k] = rw[(size_t)(kpart * 64 + k) * 32 + e];
    const float bias = rb[e];
    const int nb = l == 1 ? (MROWS - NB_ * CTX) / 8 : MROWS / 8;
    for (int bi = bx; bi < nb; bi += G) {
        int r;
        if (l == 1) { const int q = bi * 8 + wave; r = (q / SEQ) * NPOS + CTX + (q % SEQ); } else r = bi * 8 + wave;
        const int b = r / NPOS, pos = r % NPOS, v = pos < CTX ? 4 : b; const float* mv = MODl + (size_t)v * 6144;
        { float4 xv[4]; float ss = 0.f;
#pragma unroll
          for (int j = 0; j < 4; ++j) { xv[j] = *(const float4*)(H + (size_t)r * D + (j * 64 + lane) * 4); ss += xv[j].x * xv[j].x + xv[j].y * xv[j].y + xv[j].z * xv[j].z + xv[j].w * xv[j].w; }
          const float rs = rsqrtf(wave_sum(ss) * (1.f / D) + 1e-6f);
#pragma unroll
          for (int j = 0; j < 4; ++j) { const int c = (j * 64 + lane) * 4; const float4 gg = *(const float4*)(g + c), sh = *(const float4*)(mv + 3072 + c), sc = *(const float4*)(mv + 4096 + c);
              f32x4 f; f[0] = xv[j].x * rs * gg.x * (1.f + sc.x) + sh.x; f[1] = xv[j].y * rs * gg.y * (1.f + sc.y) + sh.y; f[2] = xv[j].z * rs * gg.z * (1.f + sc.z) + sh.z; f[3] = xv[j].w * rs * gg.w * (1.f + sc.w) + sh.w;
              *(LAS f32x4*)(F + wave * 1024 + c) = f; u32x2 o; o.x = pk2(f[0], f[1]); o.y = pk2(f[2], f[3]); *(u32x2*)(XN + (size_t)r * D + c) = o; } }
        __syncthreads();
        { float acc[8];
#pragma unroll
          for (int rr = 0; rr < 8; ++rr) acc[rr] = 0.f;
#pragma unroll
          for (int k4 = 0; k4 < 16; ++k4) {
#pragma unroll
              for (int rr = 0; rr < 8; ++rr) { const f32x4 f = *(const LAS f32x4*)(F + rr * 1024 + kpart * 64 + k4 * 4); acc[rr] += f[0] * w[k4 * 4] + f[1] * w[k4 * 4 + 1] + f[2] * w[k4 * 4 + 2] + f[3] * w[k4 * 4 + 3]; } }
#pragma unroll
          for (int rr = 0; rr < 8; ++rr) PART[(rr * 16 + kpart) * 32 + e] = acc[rr]; }
        __syncthreads();
        { float lg = bias;
#pragma unroll
          for (int kp = 0; kp < 16; ++kp) lg += PART[(wave * 16 + kp) * 32 + e];
          float val = lane < 32 ? lg : -3e38f; int idx = e; float tv[4]; int ti[4];
#pragma unroll
          for (int k = 0; k < 4; ++k) { float bv = val; int bi2 = idx;
#pragma unroll
              for (int o = 1; o < 32; o <<= 1) { const float ov = __shfl_xor(bv, o); const int oi = __shfl_xor(bi2, o); if (ov > bv || (ov == bv && oi < bi2)) { bv = ov; bi2 = oi; } }
              tv[k] = bv; ti[k] = bi2; if (idx == bi2) val = -3e38f; }
          if (lane == 0) { float ex[4], sum = 0.f;
#pragma unroll
              for (int k = 0; k < 4; ++k) { ex[k] = __expf(tv[k] - tv[0]); sum += ex[k]; }
              const float isum = 1.f / sum;
#pragma unroll
              for (int k = 0; k < 4; ++k) { const int asg = r * 4 + k; GATE[asg] = ex[k] * isum; const int rank = __hip_atomic_fetch_add(&LCNT[ti[k]], 1, __ATOMIC_RELAXED, __HIP_MEMORY_SCOPE_WORKGROUP); const int slot = __hip_atomic_fetch_add(&LCNT[32], 1, __ATOMIC_RELAXED, __HIP_MEMORY_SCOPE_WORKGROUP);
                  LENT[slot * 2] = asg; LENT[slot * 2 + 1] = (ti[k] << 16) | rank; } } }
        __syncthreads();
    }
    if (tid < 32) LBASE[tid] = LCNT[tid] > 0 ? atomicAdd(&CNT[tid * L::CNT_STRIDE], LCNT[tid]) : 0;
    __syncthreads();
    for (int i = tid; i < LCNT[32]; i += 512) { const int asg = LENT[i * 2], er = LENT[i * 2 + 1], ee = er >> 16, rank = er & 0xffff; LIST[(size_t)ee * LCAP + LBASE[ee] + rank] = asg; }
    __syncthreads();
}
__device__ __forceinline__ void smallw_phase(const float* w_uq, const float* qg, const float* w_ukv, const float* kvg, const float* w_a, const float* w_i, bf16_t* WUQT, bf16_t* WUKVT, bf16_t* WAT, bf16_t* WIT,
                                             float* TABC, float* TABS, const float* lam, float* SPT, int gt, int NGT) {
    for (int i = gt; i < 2 * 384 * 256; i += NGT) { const int l = i / (384 * 256), q = i % (384 * 256), n = q >> 8, k = q & 255; WUQT[i] = f2bf(qg[l * 256 + k] * w_uq[((size_t)l * 256 + k) * 384 + n]); }
    for (int i = gt; i < 2 * 512 * 128; i += NGT) { const int l = i / (512 * 128), q = i % (512 * 128), n = q >> 7, k = q & 127; WUKVT[i] = f2bf(kvg[l * 128 + k] * w_ukv[((size_t)l * 128 + k) * 512 + n]); }
    for (int i = gt; i < 16 * 4096; i += NGT) { const int m = i >> 12, q = i & 4095, e = q >> 6, d = q & 63; WAT[i] = f2bf(w_a[(size_t)m * 4096 + d * 64 + e]); WIT[i] = f2bf(w_i[(size_t)m * 4096 + d * 64 + e]); }
    for (int i = gt; i < 4096; i += NGT) { float s, c; sincospif((float)i / 2048.f, &s, &c); TABC[i] = c; TABS[i] = s; }
    for (int i = gt; i < 1024; i += NGT) SPT[i] = log1pf(__expf(-lam[i]));
}
}

namespace prep {
constexpr int O_KR = 0, O_CS = 8192, O_RS = 16384, O_CQ = 16896  , O_KS = 67072, O_CKV = 100864;
constexpr int CQP = 264, CKP = 136, QSP = 392, KSP = 264;
constexpr float C2 = 0.10206207261596577f * 1.4426950408889634f;
__device__ __forceinline__ void qkv_units(LAS unsigned char* lds, int l, const bf16_t* P, const bf16_t* WUQT, const bf16_t* WUKVT, const float* scw, const float* scb,
                                          bf16_t* QL, bf16_t* QC, bf16_t* KB, bf16_t* VTG, bf16_t* MIX, int G, int bx) {
    LAS float* KRo = (LAS float*)(lds + O_KR); LAS float* CS = (LAS float*)(lds + O_CS); LAS float* RS = (LAS float*)(lds + O_RS);
    LAS bf16_t* CQ = (LAS bf16_t*)(lds + O_CQ); LAS bf16_t* CK = (LAS bf16_t*)(lds + O_CKV); LAS bf16_t* KS = (LAS bf16_t*)(lds + O_KS); LAS bf16_t* QS = (LAS bf16_t*)(lds + O_CQ);
    for (int unit = bx; unit < 272; unit += G) {
        int tid_l = threadIdx.x; asm volatile("" : "+v"(tid_l));
        const int tid = tid_l, lane = tid & 63, w = __builtin_amdgcn_readfirstlane(tid >> 6), fr = lane & 15, fq = lane >> 4;
        const int b = unit / 68, chunk = unit % 68, pos0 = 64 * chunk; const bool ctxt = chunk < 4; const size_t r0 = (size_t)b * NPOS + pos0;
#pragma unroll
        for (int i = 0; i < 4; ++i) { const int q = tid + 512 * i, row = q >> 5, ch = q & 31; *(LAS u32x4*)((LAS unsigned char*)CQ + row * (CQP * 2) + ch * 16) = *(const u32x4*)(P + (r0 + row) * PP + C_CQ + ch * 8); }
#pragma unroll
        for (int i = 0; i < 2; ++i) { const int q = tid + 512 * i, row = q >> 4, ch = q & 15; *(LAS u32x4*)((LAS unsigned char*)CK + row * (CKP * 2) + ch * 16) = *(const u32x4*)(P + (r0 + row) * PP + C_CKV + ch * 8); }
        __syncthreads();
        { const int row = tid >> 3, j = tid & 7; float sq = 0.f, sk = 0.f;
#pragma unroll
          for (int i = 0; i < 4; ++i) { const u32x4 v = *(const LAS u32x4*)((const LAS unsigned char*)CQ + row * (CQP * 2) + j * 64 + i * 16);
#pragma unroll
              for (int e = 0; e < 4; ++e) { const float a = __uint_as_float(v[e] << 16), c = __uint_as_float(v[e] & 0xffff0000u); sq += a * a + c * c; } }
#pragma unroll
          for (int i = 0; i < 2; ++i) { const u32x4 v = *(const LAS u32x4*)((const LAS unsigned char*)CK + row * (CKP * 2) + j * 32 + i * 16);
#pragma unroll
              for (int e = 0; e < 4; ++e) { const float a = __uint_as_float(v[e] << 16), c = __uint_as_float(v[e] & 0xffff0000u); sk += a * a + c * c; } }
          sq += __shfl_xor(sq, 1); sq += __shfl_xor(sq, 2); sq += __shfl_xor(sq, 4); sk += __shfl_xor(sk, 1); sk += __shfl_xor(sk, 2); sk += __shfl_xor(sk, 4);
          if (j == 0) { RS[row * 2] = rsqrtf(sq * (1.f / 256.f) + 1e-6f); RS[row * 2 + 1] = rsqrtf(sk * (1.f / 128.f) + 1e-6f); }
          float cr = 1.f, sr = 0.f, cc = 1.f, sc = 0.f;
          if (!ctxt) { const int t = pos0 - CTX + row; const float inv = __expf(-9.210340371976184f * (float)j * 0.125f); float xa = (float)(t >> 6) * inv * 0.15915494309189535f; xa -= rintf(xa); sr = __sinf(xa * 6.283185307179586f); cr = __cosf(xa * 6.283185307179586f); float xb = (float)(t & 63) * inv * 0.15915494309189535f; xb -= rintf(xb); sc = __sinf(xb * 6.283185307179586f); cc = __cosf(xb * 6.283185307179586f); }
          CS[(row * 16 + j) * 2] = cr; CS[(row * 16 + j) * 2 + 1] = sr; CS[(row * 16 + 8 + j) * 2] = cc; CS[(row * 16 + 8 + j) * 2 + 1] = sc;
          const bf16_t* kp = P + (r0 + row) * PP + C_KR; const float z0 = bf2f(kp[j]), z1 = bf2f(kp[8 + j]), z2 = bf2f(kp[16 + j]), z3 = bf2f(kp[24 + j]);
          KRo[row * 32 + j] = z0 * cr - z1 * sr; KRo[row * 32 + 8 + j] = z0 * sr + z1 * cr; KRo[row * 32 + 16 + j] = z2 * cc - z3 * sc; KRo[row * 32 + 24 + j] = z2 * sc + z3 * cc; }
        __builtin_amdgcn_sched_barrier(0);
        { f32x4 qa[4][3];
#pragma unroll
          for (int mt = 0; mt < 4; ++mt)
#pragma unroll
              for (int n = 0; n < 3; ++n) qa[mt][n] = (f32x4){0.f, 0.f, 0.f, 0.f};
          const bf16_t* wq = WUQT + ((size_t)l * 384 + 48 * w + fr) * 256 + 8 * fq;
#pragma unroll
          for (int ks = 0; ks < 8; ++ks) { bf16x8 a[4], bb[3];
#pragma unroll
              for (int mt = 0; mt < 4; ++mt) a[mt] = *(const LAS bf16x8*)(CQ + (16 * mt + fr) * CQP + 32 * ks + 8 * fq);
#pragma unroll
              for (int n = 0; n < 3; ++n) bb[n] = *(const bf16x8*)(wq + (size_t)(16 * n) * 256 + 32 * ks);
#pragma unroll
              for (int mt = 0; mt < 4; ++mt)
#pragma unroll
                  for (int n = 0; n < 3; ++n) qa[mt][n] = __builtin_amdgcn_mfma_f32_16x16x32_bf16(a[mt], bb[n], qa[mt][n], 0, 0, 0); }
          __syncthreads();
#pragma unroll
          for (int n = 0; n < 3; ++n) { const int nt = 3 * w + n, m6 = nt % 6, col = 16 * nt + fr;
#pragma unroll
              for (int mt = 0; mt < 4; ++mt)
#pragma unroll
                  for (int i = 0; i < 4; ++i) { const int row = 16 * mt + 4 * fq + i; float v = qa[mt][n][i] * RS[row * 2];
                      if (m6 >= 4) { const float pv = __shfl_xor(v, 8); const int ci = (row * 16 + (m6 == 5 ? 8 : 0) + (fr & 7)) * 2; const float c = CS[ci], s = CS[ci + 1]; v = (fr < 8) ? v * c - pv * s : pv * s + v * c; }
                      QS[row * QSP + col] = f2bf(v * C2); } } }
        __builtin_amdgcn_sched_barrier(0);
        { f32x4 ka[4][4];
#pragma unroll
          for (int mt = 0; mt < 4; ++mt)
#pragma unroll
              for (int n = 0; n < 4; ++n) ka[mt][n] = (f32x4){0.f, 0.f, 0.f, 0.f};
          const bf16_t* wk = WUKVT + ((size_t)l * 512 + 64 * w + fr) * 128 + 8 * fq;
#pragma unroll
          for (int ks = 0; ks < 4; ++ks) { bf16x8 a[4], bb[4];
#pragma unroll
              for (int mt = 0; mt < 4; ++mt) a[mt] = *(const LAS bf16x8*)(CK + (16 * mt + fr) * CKP + 32 * ks + 8 * fq);
#pragma unroll
              for (int n = 0; n < 4; ++n) bb[n] = *(const bf16x8*)(wk + (size_t)(16 * n) * 128 + 32 * ks);
#pragma unroll
              for (int mt = 0; mt < 4; ++mt)
#pragma unroll
                  for (int n = 0; n < 4; ++n) ka[mt][n] = __builtin_amdgcn_mfma_f32_16x16x32_bf16(a[mt], bb[n], ka[mt][n], 0, 0, 0); }
          const int head = w >> 1;
          if ((w & 1) == 0) {
#pragma unroll
              for (int n = 0; n < 4; ++n)
#pragma unroll
                  for (int mt = 0; mt < 4; ++mt)
#pragma unroll
                      for (int i = 0; i < 4; ++i) { const int row = 16 * mt + 4 * fq + i; KS[row * KSP + head * 64 + 16 * n + fr] = f2bf(ka[mt][n][i] * RS[row * 2 + 1]); }
          } else {
#pragma unroll
              for (int n = 0; n < 4; ++n)
#pragma unroll
                  for (int mt = 0; mt < 4; ++mt) { const int rb = 16 * mt + 4 * fq; u32x2 o; o.x = pk2(ka[mt][n][0] * RS[rb * 2 + 1], ka[mt][n][1] * RS[rb * 2 + 3]); o.y = pk2(ka[mt][n][2] * RS[rb * 2 + 5], ka[mt][n][3] * RS[rb * 2 + 7]);
                      *(u32x2*)(VTG + ((size_t)(b * 4 + head) * 64 + 16 * n + fr) * NPOS + pos0 + rb) = o; } } }
        __syncthreads();
#pragma unroll
        for (int i = 0; i < 6; ++i) { const int q = tid + 512 * i, row = q / 48, rem = q % 48, head = rem / 12, ch = rem % 12, pos = pos0 + row;
            const u32x4 qv = *(const LAS u32x4*)((const LAS unsigned char*)QS + row * (QSP * 2) + (head * 96 + ch * 8) * 2);
            if (!ctxt) *(u32x4*)(QL + ((size_t)(b * 4 + head) * SEQ + (pos - CTX)) * 96 + ch * 8) = qv; else if (l == 0) *(u32x4*)(QC + ((size_t)(b * 4 + head) * CTX + pos) * 96 + ch * 8) = qv;
            u32x4 kv;
            if (ch < 8) kv = *(const LAS u32x4*)((const LAS unsigned char*)KS + row * (KSP * 2) + (head * 64 + ch * 8) * 2);
            else { const LAS float* kr = KRo + row * 32 + (ch - 8) * 8; kv.x = pk2(kr[0], kr[1]); kv.y = pk2(kr[2], kr[3]); kv.z = pk2(kr[4], kr[5]); kv.w = pk2(kr[6], kr[7]); }
            *(u32x4*)(KB + ((size_t)(b * 4 + head) * NPOS + pos) * 96 + ch * 8) = kv; }
        if (!(ctxt && l == 1)) { const int lo = ctxt ? 0 : CTX, hi = ctxt ? CTX : NPOS;
#pragma unroll
            for (int i = 0; i < 4; ++i) { const int q = tid + 512 * i, row = q >> 5, ch = q & 31, pos = pos0 + row; float acc[8];
#pragma unroll
                for (int e = 0; e < 8; ++e) acc[e] = scb[ch * 8 + e];
#pragma unroll
                for (int k = 0; k < 3; ++k) { const int p = pos - 1 + k; if (p >= lo && p < hi) { const bf16_t* pr = P + ((size_t)b * NPOS + p) * PP; const u32x4 sx = *(const u32x4*)(pr + C_SX + ch * 8), sc = *(const u32x4*)(pr + C_SC + ch * 8);
#pragma unroll
                        for (int e = 0; e < 4; ++e) { const float w0 = scw[k * 256 + ch * 8 + 2 * e], w1 = scw[k * 256 + ch * 8 + 2 * e + 1];
                            acc[2 * e] += w0 * (__uint_as_float(sx[e] << 16) * __uint_as_float(sc[e] << 16)); acc[2 * e + 1] += w1 * (__uint_as_float(sx[e] & 0xffff0000u) * __uint_as_float(sc[e] & 0xffff0000u)); } } }
                const u32x4 sb = *(const u32x4*)(P + (r0 + row) * PP + C_SB + ch * 8); u32x4 o;
#pragma unroll
                for (int e = 0; e < 4; ++e) o[e] = pk2(__uint_as_float(sb[e] << 16) * acc[2 * e], __uint_as_float(sb[e] & 0xffff0000u) * acc[2 * e + 1]);
                *(u32x4*)(MIX + (r0 + row) * D + 768 + ch * 8) = o; } }
        __syncthreads();
    }
}
}

namespace lru {
constexpr int XP = 264, O_X = 0, O_NA = 33792, O_BB = 66560;
__device__ __forceinline__ float sigm(float x) { return __builtin_amdgcn_rcpf(1.f + __expf(-x)); }
__device__ __forceinline__ void chunk_units(LAS unsigned char* lds, int l, const bf16_t* P, const float* conv_w, const float* conv_b, const bf16_t* WAT, const bf16_t* WIT, const float* b_a, const float* b_i, const float* SPT,
                                            bf16_t* HL, bf16_t* AC, float* SUM, int G, int bx, int knob) {
    LAS bf16_t* X = (LAS bf16_t*)(lds + O_X); LAS bf16_t* NA = (LAS bf16_t*)(lds + O_NA); LAS bf16_t* BB = (LAS bf16_t*)(lds + O_BB);
    for (int unit = bx; unit < 544; unit += G) {
        int tid_l = threadIdx.x; asm volatile("" : "+v"(tid_l));
        const int tid = tid_l, lane = tid & 63, w = __builtin_amdgcn_readfirstlane(tid >> 6), fr = lane & 15, fq = lane >> 4;
        const int dir = unit & 1, bc = unit >> 1, b = bc / 68, chunk = bc % 68, pos0 = 64 * chunk; const int lo = chunk < 4 ? 0 : CTX, hi = chunk < 4 ? CTX : NPOS, left = dir ? 1 : 2;
        const size_t r0 = (size_t)b * NPOS + pos0; const int pd = (l * 2 + dir) * 256;
        if (!(knob & 1)) { const int cg = tid & 31, ts = tid >> 5, c0 = cg * 8; float wv[4][8], cbv[8];
#pragma unroll
          for (int e = 0; e < 8; ++e) { cbv[e] = conv_b[pd + c0 + e];
#pragma unroll
              for (int k = 0; k < 4; ++k) wv[k][e] = conv_w[(size_t)pd * 4 + k * 256 + c0 + e]; }
          const bf16_t* pc = P + (size_t)b * NPOS * PP + C_LX + c0; const int pb = pos0 + 4 * ts - left;
          u32x4 u[7];
#pragma unroll
          for (int i = 0; i < 7; ++i) { const int p = pb + i; const int pcl = p < lo ? lo : (p >= hi ? hi - 1 : p); u[i] = *(const u32x4*)(pc + (size_t)pcl * PP); if (p < lo || p >= hi) u[i] = (u32x4){0u, 0u, 0u, 0u}; }
#pragma unroll
          for (int i = 0; i < 4; ++i) { u32x4 o;
#pragma unroll
              for (int e2 = 0; e2 < 4; ++e2) { float lo_ = cbv[2 * e2], hi_ = cbv[2 * e2 + 1];
#pragma unroll
                  for (int k = 0; k < 4; ++k) { const unsigned d = u[i + k][e2]; lo_ += wv[k][2 * e2] * __uint_as_float(d << 16); hi_ += wv[k][2 * e2 + 1] * __uint_as_float(d & 0xffff0000u); }
                  o[e2] = pk2(lo_, hi_); }
              *(LAS u32x4*)(X + (4 * ts + i) * XP + c0) = o; } }
        __syncthreads();
        if (!(knob & 2)) { const int h = w >> 1, mh = w & 1;
          f32x4 ra[2][4], ri[2][4];
#pragma unroll
          for (int m = 0; m < 2; ++m)
#pragma unroll
              for (int n = 0; n < 4; ++n) { ra[m][n] = (f32x4){0.f, 0.f, 0.f, 0.f}; ri[m][n] = (f32x4){0.f, 0.f, 0.f, 0.f}; }
          const bf16_t* wa = WAT + ((size_t)((l * 2 + dir) * 4 + h) * 64 + fr) * 64 + 8 * fq; const bf16_t* wi = WIT + ((size_t)((l * 2 + dir) * 4 + h) * 64 + fr) * 64 + 8 * fq;
#pragma unroll
          for (int ks = 0; ks < 2; ++ks) { bf16x8 a[2], ba[4], bi[4];
#pragma unroll
              for (int m = 0; m < 2; ++m) a[m] = *(const LAS bf16x8*)(X + (16 * (2 * mh + m) + fr) * XP + 64 * h + 32 * ks + 8 * fq);
#pragma unroll
              for (int n = 0; n < 4; ++n) { ba[n] = *(const bf16x8*)(wa + (size_t)(16 * n) * 64 + 32 * ks); bi[n] = *(const bf16x8*)(wi + (size_t)(16 * n) * 64 + 32 * ks); }
#pragma unroll
              for (int m = 0; m < 2; ++m)
#pragma unroll
                  for (int n = 0; n < 4; ++n) { ra[m][n] = __builtin_amdgcn_mfma_f32_16x16x32_bf16(a[m], ba[n], ra[m][n], 0, 0, 0); ri[m][n] = __builtin_amdgcn_mfma_f32_16x16x32_bf16(a[m], bi[n], ri[m][n], 0, 0, 0); } }
#pragma unroll
          for (int n = 0; n < 4; ++n) { const int c = 64 * h + 16 * n + fr; const float bav = b_a[pd + c], biv = b_i[pd + c], sp8 = 8.f * SPT[pd + c];
#pragma unroll
              for (int m = 0; m < 2; ++m)
#pragma unroll
                  for (int i = 0; i < 4; ++i) { const int t = 16 * (2 * mh + m) + 4 * fq + i; const float r = sigm(ra[m][n][i] + bav), ig = sigm(ri[m][n][i] + biv);
                      const float x = r * sp8; const float na = x < 0.03125f ? x * (1.f - 0.5f * x * (1.f - 0.33333334f * x * (1.f - 0.25f * x))) : 1.f - __expf(-x); const float xv = bf2f(X[t * XP + c]);
                      NA[t * 256 + c] = f2bf(na); BB[t * 256 + c] = f2bf(__builtin_amdgcn_sqrtf(fmaxf(na * (2.f - na), 0.f)) * (ig * xv)); } } }
        __syncthreads();
        if (tid < 256 && !(knob & 4)) { const int c = tid; float hst = 0.f, A = 1.f;
            if (dir == 0) {
#pragma unroll 8
                for (int t = 0; t < 64; ++t) { const float a = 1.f - bf2f(NA[t * 256 + c]); hst = a * hst + bf2f(BB[t * 256 + c]); A *= a; BB[t * 256 + c] = f2bf(hst); NA[t * 256 + c] = f2bf(A); }
            } else {
#pragma unroll 8
                for (int t = 63; t >= 0; --t) { const float a = 1.f - bf2f(NA[t * 256 + c]); hst = a * hst + bf2f(BB[t * 256 + c]); A *= a; BB[t * 256 + c] = f2bf(hst); NA[t * 256 + c] = f2bf(A); }
            }
            float* sm = SUM + ((size_t)(dir * 4 + b) * 68 + chunk) * 512; sm[c] = A; sm[256 + c] = hst; }
        __syncthreads();
        if (!(knob & 4)) {
#pragma unroll
            for (int i = 0; i < 4; ++i) { const int q = tid + 512 * i, t = q >> 5, ch = q & 31; const size_t go = ((size_t)dir * MROWS + r0 + t) * 256 + ch * 8;
                *(u32x4*)(AC + go) = *(const LAS u32x4*)(NA + t * 256 + ch * 8); *(u32x4*)(HL + go) = *(const LAS u32x4*)(BB + t * 256 + ch * 8); } }
        __syncthreads();
    }
}
__device__ __forceinline__ void fixup_units(LAS unsigned char* lds, int l, const bf16_t* P, const bf16_t* HL, const bf16_t* AC, const float* SUM, bf16_t* MIX, int G, int bx) {
    LAS float* CAR = (LAS float*)lds;
    for (int unit = bx; unit < 272; unit += G) {
        int tid_l = threadIdx.x; asm volatile("" : "+v"(tid_l));
        const int tid = tid_l;
        const int b = unit / 68, chunk = unit % 68; if (l == 1 && chunk < 4) continue;
        { const int dir = tid >> 8, c = tid & 255; const float* sp = SUM + ((size_t)(dir * 4 + b) * 68) * 512 + c;
          const int n_pre = dir == 0 ? chunk : (chunk < 4 ? 3 - chunk : 4 + (67 - chunk));
          float cy = 0.f;
          for (int j0 = 0; j0 < n_pre; j0 += 16) { float av[16], hv[16];
#pragma unroll
              for (int u = 0; u < 16; ++u) { const int n = j0 + u < n_pre ? j0 + u : n_pre - 1; const int j = dir == 0 ? n : (n < 4 ? 3 - n : 71 - n); av[u] = sp[(size_t)j * 512]; hv[u] = sp[(size_t)j * 512 + 256]; }
#pragma unroll
              for (int u = 0; u < 16; ++u) cy = (j0 + u < n_pre) ? hv[u] + av[u] * cy : cy; }
          CAR[tid] = cy; }
        __syncthreads();
        { const int cg = tid & 31, ts = tid >> 5, c0 = cg * 8; float cf[8], cb[8];
#pragma unroll
          for (int e = 0; e < 8; ++e) { cf[e] = CAR[c0 + e]; cb[e] = CAR[256 + c0 + e]; }
          const size_t r0 = (size_t)b * NPOS + 64 * chunk + 4 * ts;
          u32x4 hf[4], af[4], hb[4], ab[4], gt[4];
#pragma unroll
          for (int i = 0; i < 4; ++i) { const size_t r = r0 + i; hf[i] = *(const u32x4*)(HL + r * 256 + c0); af[i] = *(const u32x4*)(AC + r * 256 + c0); hb[i] = *(const u32x4*)(HL + ((size_t)MROWS + r) * 256 + c0); ab[i] = *(const u32x4*)(AC + ((size_t)MROWS + r) * 256 + c0);
              gt[i] = *(const u32x4*)(P + r * PP + C_LG + c0); }
#pragma unroll
          for (int i = 0; i < 4; ++i) { u32x4 o;
#pragma unroll
              for (int e2 = 0; e2 < 4; ++e2) { float res[2];
#pragma unroll
                  for (int hh = 0; hh < 2; ++hh) { const int e = 2 * e2 + hh;
                      const float vhf = hh ? __uint_as_float(hf[i][e2] & 0xffff0000u) : __uint_as_float(hf[i][e2] << 16), vaf = hh ? __uint_as_float(af[i][e2] & 0xffff0000u) : __uint_as_float(af[i][e2] << 16);
                      const float vhb = hh ? __uint_as_float(hb[i][e2] & 0xffff0000u) : __uint_as_float(hb[i][e2] << 16), vab = hh ? __uint_as_float(ab[i][e2] & 0xffff0000u) : __uint_as_float(ab[i][e2] << 16);
                      const float x = hh ? __uint_as_float(gt[i][e2] & 0xffff0000u) : __uint_as_float(gt[i][e2] << 16);
                      const float hsum = (vhf + vaf * cf[e]) + (vhb + vab * cb[e]);
                      const float u = 0.7978845608028654f * (x + 0.044715f * x * x * x); const float th_ = 1.f - 2.f * __builtin_amdgcn_rcpf(1.f + __expf(2.f * u));
                      res[hh] = 0.5f * x * (1.f + th_) * hsum; }
                  o[e2] = pk2(res[0], res[1]); }
              *(u32x4*)(MIX + (r0 + i) * D + 256 + c0) = o; } }
        __syncthreads();
    }
}
}

namespace fft {
__device__ __forceinline__ void ctx_a(LAS unsigned char* lds, const bf16_t* P, const float* TABC, const float* TABS, bf16_t* XCT, int G, int bx) {
    LAS bf16_t* U = (LAS bf16_t*)(lds + O_U); LAS bf16_t* X = (LAS bf16_t*)(lds + O_X);
    for (int unit = bx; unit < 16; unit += G) {
        int tid_l = threadIdx.x; asm volatile("" : "+v"(tid_l));
        const int tid = tid_l, lane = tid & 63, w = __builtin_amdgcn_readfirstlane(tid >> 6), fr = lane & 15, fq = lane >> 4;
        build_tables(lds, TABC, TABS, tid);
        const LAS bf16_t* Tc = (const LAS bf16_t*)(lds + O_TC); const LAS bf16_t* Ts = (const LAS bf16_t*)(lds + O_TS);
        const int b = unit >> 2, q = unit & 3;
#pragma unroll
        for (int i = 0; i < 4; ++i) { const int qq = tid + 512 * i, t1 = qq >> 5, ch = qq & 31;
            *(LAS u32x4*)((LAS unsigned char*)U + t1 * (UP * 2) + ch * 16) = *(const u32x4*)(P + ((size_t)b * NPOS + 64 * q + t1) * PP + ch * 8); }
        __syncthreads();
        { const int g = w >> 1, part = w & 1; const LAS bf16_t* T = part ? Ts : Tc;
          f32x4 acc[4][4];
#pragma unroll
          for (int mt = 0; mt < 4; ++mt)
#pragma unroll
              for (int nt = 0; nt < 4; ++nt) acc[mt][nt] = (f32x4){0.f, 0.f, 0.f, 0.f};
#pragma unroll
          for (int ks = 0; ks < 2; ++ks) { bf16x8 a[4], bb[4];
#pragma unroll
              for (int mt = 0; mt < 4; ++mt) a[mt] = *(const LAS bf16x8*)(U + (16 * mt + fr) * UP + g * 64 + 32 * ks + 8 * fq);
#pragma unroll
              for (int nt = 0; nt < 4; ++nt) bb[nt] = *(const LAS bf16x8*)(T + (16 * nt + fr) * TP + 32 * ks + 8 * fq);
#pragma unroll
              for (int mt = 0; mt < 4; ++mt)
#pragma unroll
                  for (int nt = 0; nt < 4; ++nt) acc[mt][nt] = __builtin_amdgcn_mfma_f32_16x16x32_bf16(a[mt], bb[nt], acc[mt][nt], 0, 0, 0); }
          const float sg = part ? -1.f : 1.f;
#pragma unroll
          for (int mt = 0; mt < 4; ++mt)
#pragma unroll
              for (int nt = 0; nt < 4; ++nt) { const f32x4 v = acc[mt][nt] * sg; u32x2 o; o.x = pk2(v[0], v[1]); o.y = pk2(v[2], v[3]);
                  *(LAS u32x2*)(X + (part * 256 + g * 64 + 16 * nt + fr) * TP + 16 * mt + 4 * fq) = o; } }
        __syncthreads();
#pragma unroll
        for (int i = 0; i < 8; ++i) { const int qq = tid + 512 * i, row = qq >> 3, c8 = qq & 7;
            *(u32x4*)(XCT + (((size_t)b * 4 + q) * 512 + row) * 64 + c8 * 8) = *(const LAS u32x4*)((const LAS unsigned char*)X + row * (TP * 2) + c8 * 16); }
        __syncthreads();
    }
}
__device__ __forceinline__ void ctx_b(LAS unsigned char* lds, const bf16_t* XCT, const float* TABC, const float* TABS, bf16_t* MIX, int G, int bx) {
    LAS bf16_t* Tc = (LAS bf16_t*)(lds + O_TC); LAS bf16_t* Ts = (LAS bf16_t*)(lds + O_TS);
    LAS bf16_t* Ys = (LAS bf16_t*)(lds + O_U); LAS bf16_t* ZT = (LAS bf16_t*)(lds + O_X);
    for (int unit = bx; unit < 16; unit += G) {
        int tid_l = threadIdx.x; asm volatile("" : "+v"(tid_l));
        const int tid = tid_l, lane = tid & 63, w = __builtin_amdgcn_readfirstlane(tid >> 6), fr = lane & 15, fq = lane >> 4;
        const int b = unit >> 2, ft = unit & 3;
        f32x4 y[4][2];
#pragma unroll
        for (int mt = 0; mt < 4; ++mt)
#pragma unroll
            for (int n = 0; n < 2; ++n) y[mt][n] = (f32x4){0.f, 0.f, 0.f, 0.f};
        for (int q = 0; q < 4; ++q) {
            for (int i = tid; i < 4096; i += 512) { const int fl = i >> 6, tl = i & 63, ix = (((64 * ft + fl) * (64 * q + tl)) & 255) * 16; Tc[fl * TP + tl] = f2bf(TABC[ix]); Ts[fl * TP + tl] = f2bf(TABS[ix]); }
#pragma unroll
            for (int i = 0; i < 8; ++i) { const int qq = tid + 512 * i, row = qq >> 3, c8 = qq & 7;
                *(LAS u32x4*)((LAS unsigned char*)ZT + row * (TP * 2) + c8 * 16) = *(const u32x4*)(XCT + (((size_t)b * 4 + q) * 512 + row) * 64 + c8 * 8); }
            __syncthreads();
#pragma unroll
            for (int ks = 0; ks < 2; ++ks) { bf16x8 xr[2], xi[2];
#pragma unroll
                for (int n = 0; n < 2; ++n) { xr[n] = *(const LAS bf16x8*)(ZT + (32 * w + 16 * n + fr) * TP + 32 * ks + 8 * fq); xi[n] = *(const LAS bf16x8*)(ZT + (256 + 32 * w + 16 * n + fr) * TP + 32 * ks + 8 * fq); }
#pragma unroll
                for (int mt = 0; mt < 4; ++mt) { const bf16x8 c = *(const LAS bf16x8*)(Tc + (16 * mt + fr) * TP + 32 * ks + 8 * fq), s = *(const LAS bf16x8*)(Ts + (16 * mt + fr) * TP + 32 * ks + 8 * fq);
#pragma unroll
                    for (int n = 0; n < 2; ++n) { y[mt][n] = __builtin_amdgcn_mfma_f32_16x16x32_bf16(c, xr[n], y[mt][n], 0, 0, 0); y[mt][n] = __builtin_amdgcn_mfma_f32_16x16x32_bf16(s, xi[n], y[mt][n], 0, 0, 0); } } }
            __syncthreads();
        }
#pragma unroll
        for (int mt = 0; mt < 4; ++mt)
#pragma unroll
            for (int i = 0; i < 4; ++i)
#pragma unroll
                for (int n = 0; n < 2; ++n) Ys[(16 * mt + 4 * fq + i) * UP + 32 * w + 16 * n + fr] = f2bf(y[mt][n][i] * (1.f / 128.f));
        __syncthreads();
#pragma unroll
        for (int i = 0; i < 4; ++i) { const int qq = tid + 512 * i, fl = qq >> 5, ch = qq & 31;
            *(u32x4*)(MIX + ((size_t)b * NPOS + 64 * ft + fl) * D + ch * 8) = *(const LAS u32x4*)((const LAS unsigned char*)Ys + fl * (UP * 2) + ch * 16); }
        __syncthreads();
    }
}
}

constexpr int NWAVES = 8, RING_BYTES = 131072 + 3072, LDSCTL_OFF = RING_BYTES, MISC_OFF = LDSCTL_OFF + 64, META_OFF = MISC_OFF + 64, LDS_BYTES = 147456;
enum { PH_PRO0 = 0, PH_PRO1 = 1, PH_L0 = 2, PH_PER_LAYER = 8, PH_N = 18 };
enum { PL_WIN = 0, PL_PREP = 1, PL_MIX = 2, PL_WOUT = 3, PL_ROUTE = 4, PL_MOE1 = 5, PL_MOE2 = 6, PL_COMB = 7 };
struct MArgs { const float* in[30]; float* out; unsigned char* ws; int npass, skip_mask, dup_ph, dup_n, dup_sub, knob; };

__device__ __forceinline__ void transpose_item(const float* W, int K, int N, bf16_t* WT, int drow0, LAS float* scr, int k0, int n0, int lane) {
    const int kr = lane >> 3, nc = (lane & 7) * 4;
    f32x4 v[8];
#pragma unroll
    for (int i = 0; i < 8; ++i) v[i] = __builtin_nontemporal_load((const f32x4*)(W + (size_t)(k0 + kr + 8 * i) * N + n0 + nc));
#pragma unroll
    for (int i = 0; i < 8; ++i) { LAS float* d = scr + (kr + 8 * i) * 33 + nc; d[0] = v[i][0]; d[1] = v[i][1]; d[2] = v[i][2]; d[3] = v[i][3]; }
    asm volatile("s_waitcnt lgkmcnt(0)" ::: "memory");
    const int c = lane & 7;
#pragma unroll
    for (int j = 0; j < 4; ++j) { const int n = (lane >> 3) + 8 * j; const LAS float* s = scr + (8 * c) * 33 + n;
        u32x4 o; o.x = pk2(s[0 * 33], s[1 * 33]); o.y = pk2(s[2 * 33], s[3 * 33]); o.z = pk2(s[4 * 33], s[5 * 33]); o.w = pk2(s[6 * 33], s[7 * 33]);
        *(u32x4*)(WT + (size_t)(drow0 + n) * K + k0 + 8 * c) = o; }
    asm volatile("s_waitcnt lgkmcnt(0)" ::: "memory");
}

#define GASP __attribute__((address_space(1)))
#define ARG_IN(i) ({ const GASP float* _p; asm volatile("s_load_dwordx2 %0, %1, %2\n\ts_waitcnt lgkmcnt(0)" : "=s"(_p) : "s"(__builtin_amdgcn_kernarg_segment_ptr()), "n"((i) * 8)); (const float*)_p; })
__global__ void __launch_bounds__(NWAVES * 64, 2) mega(MArgs args) {
    extern __shared__ __attribute__((aligned(16))) unsigned char lds_raw[];
    const int G0 = gridDim.x, bx0 = blockIdx.x;
    unsigned char* ws0 = args.ws;
    unsigned* ctl0 = (unsigned*)(ws0 + L::CTL);
    for (int u = threadIdx.x; u < (LDS_BYTES - LDSCTL_OFF) / 4; u += NWAVES * 64) ((LAS unsigned*)(lds_raw + LDSCTL_OFF))[u] = 0u;
    __syncthreads();
    volatile LAS unsigned* MISC = (volatile LAS unsigned*)((LAS unsigned char*)lds_raw + MISC_OFF);
    XcdBarrier bar = xcd_barrier_post(ctl0 + L::CW_BAR, MISC);
    const int lo = 0, hi = PH_N;

    bool first = true;
    for (int pass = 0; pass < args.npass; ++pass)
    for (int ph = lo; ph < hi; ++ph) {
      const int reps = (ph == args.dup_ph) ? 1 + args.dup_n : 1;
      for (int rep = 0; rep < reps; ++rep) {
        if (!first) xcd_barrier(bar);
        first = false;
        if (pass + 1 < args.npass && ((args.skip_mask >> ph) & 1)) continue;
        const int sub = rep + 1 < reps ? args.dup_sub : 15; const int knob = rep + 1 < reps ? args.knob : 0; (void)knob;
        GASP unsigned char* wsg = (GASP unsigned char*)args.ws; asm volatile("" : "+s"(wsg)); unsigned char* ws = (unsigned char*)wsg;
        unsigned* ctl = (unsigned*)(ws + L::CTL);
        int tid_p = threadIdx.x; asm volatile("" : "+v"(tid_p));
        int G = G0, bx = bx0; asm volatile("" : "+s"(G), "+s"(bx));
        const int vcu = (G % 8 == 0) ? (bx % 8) * (G / 8) + bx / 8 : bx; (void)vcu;
        unsigned ldsb = 0; asm volatile("" : "+s"(ldsb)); LAS unsigned char* lds = (LAS unsigned char*)lds_raw + ldsb;
        LAS int* META = (LAS int*)(lds + META_OFF);
        const int tid = tid_p, lane = tid & 63, wave = __builtin_amdgcn_readfirstlane(tid >> 6); (void)lane; (void)wave;
        if (ph == PH_PRO0) {
            if (bx == 0 && tid < 2 * NE) ((int*)(ctl + L::CW_CNT))[tid * L::CNT_STRIDE] = 0;
            LAS float* scr = (LAS float*)(lds + wave * 16384);
            const int gw = vcu * NWAVES + wave, NGW = G * NWAVES;
            constexpr int I_IN = 16 * 61, I_OUT = 16 * 32, I_GU = NE * 16 * 64, I_DN = NE * 16 * 32, I_L = I_IN + I_OUT + I_GU + I_DN;
            for (int it = gw; it < 2 * I_L; it += NGW) {
                const int l = it / I_L; int r = it % I_L;
                if (r < I_IN) { const int kb = r / 61, nb = r % 61; transpose_item(ARG_IN(8) + (size_t)l * D * PT, D, PT, (bf16_t*)(ws + L::WINT) + (size_t)l * 2048 * D, 32 * nb, scr, 64 * kb, 32 * nb, lane); continue; } r -= I_IN;
                if (r < I_OUT) { const int kb = r / 32, nb = r % 32; transpose_item(ARG_IN(22) + (size_t)l * D * D, D, D, (bf16_t*)(ws + L::WOUTT) + (size_t)l * D * D, 32 * nb, scr, 64 * kb, 32 * nb, lane); continue; } r -= I_OUT;
                if (r < I_GU) { const int e = r / (16 * 64), q = r % (16 * 64), kb = q / 64, nb = q % 64; const int n0 = 32 * nb; const int c2 = n0 & 1023; const int drow = (c2 >> 7) * 256 + (n0 >> 10) * 128 + (c2 & 127);
                    transpose_item(ARG_IN(25) + ((size_t)l * NE + e) * D * 2048, D, 2048, (bf16_t*)(ws + L::WGUT) + ((size_t)l * NE + e) * 2048 * D, drow, scr, 64 * kb, n0, lane); continue; } r -= I_GU;
                { const int e = r / (16 * 32), q = r % (16 * 32), kb = q / 32, nb = q % 32;
                    transpose_item(ARG_IN(27) + ((size_t)l * NE + e) * D * D, D, D, (bf16_t*)(ws + L::WDT) + ((size_t)l * NE + e) * D * D, 32 * nb, scr, 64 * kb, 32 * nb, lane); }
            }
            sm::smallw_phase(ARG_IN(17), ARG_IN(16), ARG_IN(19), ARG_IN(18), ARG_IN(11), ARG_IN(13), (bf16_t*)(ws + L::WUQT), (bf16_t*)(ws + L::WUKVT), (bf16_t*)(ws + L::WAT), (bf16_t*)(ws + L::WIT),
                             (float*)(ws + L::TABC), (float*)(ws + L::TABS), ARG_IN(15), (float*)(ws + L::SPT), bx * 512 + tid, G * 512);
            __syncthreads();
            sm::mod_phase(lds, ARG_IN(1), ARG_IN(3), ARG_IN(4), ARG_IN(5), (float*)(ws + L::MOD), G, bx, tid);
            for (int i = bx * 512 + tid; i < 2 * 96 * D / 8; i += G * 512) { const int l = i / (96 * D / 8), q = i % (96 * D / 8); *(u32x4*)((bf16_t*)(ws + L::WINT) + ((size_t)l * 2048 + PT) * D + (size_t)q * 8) = (u32x4){0u, 0u, 0u, 0u}; }
            continue;
        }
        if (ph == PH_PRO1) { sm::pro1_phase(ARG_IN(0), ARG_IN(2), ARG_IN(6), (const float*)(ws + L::MOD), (float*)(ws + L::H), (bf16_t*)(ws + L::XN), bx * NWAVES + wave, G * NWAVES, lane); continue; }
        if (ph < PH_L0) continue;
        const int l = (ph - PH_L0) / PH_PER_LAYER, pl = (ph - PH_L0) % PH_PER_LAYER;
        const float* MODl = (const float*)(ws + L::MOD) + (size_t)l * 5 * 6144;
        if (pl == PL_WIN) {
            g8::DenseSched S; S.init(MROWS / 256, PP / 256, G, bx, 0, (const bf16_t*)(ws + L::WINT) + (size_t)l * 2048 * D, D);
            g8::EpiP E{(bf16_t*)(ws + L::P)};
            g8::gemm_phase<g8::EpiP, g8::DenseSched, false, false>(lds, (const char*)(ws + L::XN), S, E);
        } else if (pl == PL_PREP) {
            if (sub & 1) fft::stage_a(lds, (const bf16_t*)(ws + L::P), (const float*)(ws + L::TABC), (const float*)(ws + L::TABS), (bf16_t*)(ws + L::ZBUF), G, bx);
            __syncthreads();
            if (l == 0 && (sub & 2)) { fft::ctx_a(lds, (const bf16_t*)(ws + L::P), (const float*)(ws + L::TABC), (const float*)(ws + L::TABS), (bf16_t*)(ws + L::XCT), G, G - 1 - bx); __syncthreads(); }
            if (sub & 4) prep::qkv_units(lds, l, (const bf16_t*)(ws + L::P), (const bf16_t*)(ws + L::WUQT), (const bf16_t*)(ws + L::WUKVT), ARG_IN(20) + l * 768, ARG_IN(21) + l * 256,
                            (bf16_t*)(ws + L::QL), (bf16_t*)(ws + L::QC), (bf16_t*)(ws + L::KB), (bf16_t*)(ws + L::VTG), (bf16_t*)(ws + L::MIX), G, bx);
            __syncthreads();
            if (sub & 8) lru::chunk_units(lds, l, (const bf16_t*)(ws + L::P), ARG_IN(9), ARG_IN(10), (const bf16_t*)(ws + L::WAT), (const bf16_t*)(ws + L::WIT), ARG_IN(12), ARG_IN(14), (const float*)(ws + L::SPT),
                             (bf16_t*)(ws + L::HL), (bf16_t*)(ws + L::AC), (float*)(ws + L::SUM), G, bx, knob);
        } else if (pl == PL_MIX) {
            if (sub & 1) lru::fixup_units(lds, l, (const bf16_t*)(ws + L::P), (const bf16_t*)(ws + L::HL), (const bf16_t*)(ws + L::AC), (const float*)(ws + L::SUM), (bf16_t*)(ws + L::MIX), G, bx);
            if (sub & 2) fft::stage_b(lds, (const bf16_t*)(ws + L::ZBUF), (const float*)(ws + L::TABC), (const float*)(ws + L::TABS), (bf16_t*)(ws + L::MIX), G, bx);
            __syncthreads();
            if (l == 0 && (sub & 4)) { fft::ctx_b(lds, (const bf16_t*)(ws + L::XCT), (const float*)(ws + L::TABC), (const float*)(ws + L::TABS), (bf16_t*)(ws + L::MIX), G, G - 1 - bx); __syncthreads(); }
            if (sub & 8) attn::attn_phase(lds, (const bf16_t*)(ws + L::QL), (const bf16_t*)(ws + L::QC), (const bf16_t*)(ws + L::KB), (const bf16_t*)(ws + L::VTG), (bf16_t*)(ws + L::MIX), l == 0 ? 1 : 0, G, vcu);
        } else if (pl == PL_WOUT) {
            g8::DenseSched S; S.init(l == 0 ? MROWS / 256 : 64, D / 256, G, bx, l == 0 ? 0 : 1, (const bf16_t*)(ws + L::WOUTT) + (size_t)l * D * D, D);
            g8::EpiH E{(float*)(ws + L::H), MODl, 2048};
            g8::gemm_phase<g8::EpiH, g8::DenseSched, false, false>(lds, (const char*)(ws + L::MIX), S, E);
        } else if (pl == PL_ROUTE) {
            sm::route_phase(lds, l, (const float*)(ws + L::H), ARG_IN(7) + l * D, MODl, ARG_IN(23) + (size_t)l * D * NE, ARG_IN(24) + l * NE, (bf16_t*)(ws + L::XN), (int*)(ctl + L::CW_CNT) + l * NE * L::CNT_STRIDE,
                            (int*)(ws + L::LIST) + (size_t)l * NE * LCAP, (float*)(ws + L::GATE), G, bx, tid);
        } else if (pl == PL_COMB) {
            sm::comb_phase(l, (float*)(ws + L::H), (const bf16_t*)(ws + L::Y), MODl, ARG_IN(6) + D, (const float*)(ws + L::MOD) + (size_t)5 * 6144, (bf16_t*)(ws + L::XN), ARG_IN(29), args.out, bx * NWAVES + wave, G * NWAVES, lane);
        } else if (pl == PL_MOE1 || pl == PL_MOE2) {
            const int* CNTg = (const int*)(ctl + L::CW_CNT) + l * NE * L::CNT_STRIDE;
            if (tid == 0) { int o = 0; for (int e = 0; e < NE; ++e) { const int cn = CNTg[e * L::CNT_STRIDE]; META[e] = o; META[64 + e] = cn; o += (cn + 255) >> 8; } META[NE] = o; }
            __syncthreads();
            g8::MoeSched S; S.tpre = META; S.cnt = META + 64; S.G = G; S.c = bx; S.K = D; S.list = (const int*)(ws + L::LIST) + (size_t)l * NE * LCAP;
            if (pl == PL_MOE1) {
                S.NT = 8; S.COLW = 128; S.total = __builtin_amdgcn_readfirstlane(META[NE]) * 8; S.Bt = (const char*)((const bf16_t*)(ws + L::WGUT) + (size_t)l * NE * 2048 * D);
                g8::EpiMoe1 E{(bf16_t*)(ws + L::ACT), ARG_IN(26) + (size_t)l * NE * 2048};
                g8::gemm_phase<g8::EpiMoe1, g8::MoeSched, true, true>(lds, (const char*)(ws + L::XN), S, E);
            } else {
                S.NT = 4; S.COLW = 256; S.total = __builtin_amdgcn_readfirstlane(META[NE]) * 4; S.Bt = (const char*)((const bf16_t*)(ws + L::WDT) + (size_t)l * NE * D * D);
                g8::EpiMoe2 E{(bf16_t*)(ws + L::Y), ARG_IN(28) + (size_t)l * NE * D, (const float*)(ws + L::GATE)};
                g8::gemm_phase<g8::EpiMoe2, g8::MoeSched, false, true>(lds, (const char*)(ws + L::ACT), S, E);
            }
            __syncthreads();
        }
      }
    }
}
constexpr int PROBE_DUP_PH = -1, PROBE_DUP_N = 0, PROBE_DUP_SUB = 15, PROBE_KNOB = 0;
constexpr int PROBE_NPASS = 1, PROBE_SKIP = 0;
extern "C" void kernel_launch(void* const* d_in, const int* in_sizes, int n_in, void* d_out, int out_size, void* d_ws, size_t ws_size, hipStream_t stream) {
    static int grid = 0;
    if (grid == 0) {
        if (n_in != 30 || out_size != NB_ * SEQ * D || (size_t)L::END > ws_size) { fprintf(stderr, "kernel_launch: unexpected problem shape (n_in %d, out %d) or workspace too small (need %zu, have %zu); nothing launched\n", n_in, out_size, (size_t)L::END, ws_size); grid = -1; return; }
        int dev = 0, cus = 0;
        if (hipGetDevice(&dev) != hipSuccess || hipDeviceGetAttribute(&cus, hipDeviceAttributeMultiprocessorCount, dev) != hipSuccess) { fprintf(stderr, "kernel_launch: device query failed\n"); grid = -1; return; }
        if (hipFuncSetAttribute((const void*)mega, hipFuncAttributeMaxDynamicSharedMemorySize, LDS_BYTES) != hipSuccess) { fprintf(stderr, "kernel_launch: hipFuncSetAttribute failed\n"); grid = -1; return; }
        grid = cus < 256 ? cus : 256;
    }
    if (grid < 0) return;
    unsigned char* p = (unsigned char*)d_ws;
    (void)hipMemsetAsync(p + L::CTL, 0, L::CTL_BYTES, stream);
    MArgs a{};
    for (int i = 0; i < 30; ++i) a.in[i] = (const float*)d_in[i];
    a.out = (float*)d_out; a.ws = p; a.npass = PROBE_NPASS; a.skip_mask = PROBE_SKIP; a.dup_ph = PROBE_DUP_PH; a.dup_n = PROBE_DUP_N; a.dup_sub = PROBE_DUP_SUB; a.knob = PROBE_KNOB;
    hipLaunchKernelGGL(mega, dim3(grid), dim3(NWAVES * 64), LDS_BYTES, stream, a);
}
```

```cpp
#include <hip/hip_runtime.h>
#include <cstdint>
#include <cstdio>

typedef unsigned short bf16_t;
constexpr int NB_ = 4, SEQ = 4096, CTX = 256, D = 1024, NPOS = SEQ + CTX, MROWS = NB_ * NPOS;
constexpr int PT = 1952, PP = 2048;
constexpr int NE = 32, TOPK = 4, LCAP = MROWS;
constexpr int NASG = MROWS * TOPK;
constexpr int ACT_ROWS = NASG + NE * 256;
constexpr int C_FN = 0, C_LX = 256, C_LG = 512, C_CQ = 768, C_CKV = 1024, C_KR = 1152, C_SX = 1184, C_SB = 1440, C_SC = 1696;

__device__ __forceinline__ float bf2f(bf16_t v) { return __uint_as_float((unsigned)v << 16); }
__device__ __forceinline__ bf16_t f2bf(float f) { unsigned u = __float_as_uint(f); return (bf16_t)((u + 0x7fffu + ((u >> 16) & 1u)) >> 16); }
__device__ __forceinline__ float wave_sum(float v) {
#pragma unroll
    for (int o = 1; o < 64; o <<= 1) v += __shfl_xor(v, o);
    return v;
}
__device__ __forceinline__ float sigmoidf_(float x) { return 1.f / (1.f + __expf(-x)); }
__device__ __forceinline__ float gelu_tanh(float x) { const float u = 0.7978845608028654f * (x + 0.044715f * x * x * x); return 0.5f * x * (1.f + tanhf(u)); }

#define LAS __attribute__((address_space(3)))
typedef short bf16x8 __attribute__((ext_vector_type(8)));
typedef float f32x4 __attribute__((ext_vector_type(4)));
typedef unsigned u32x4 __attribute__((ext_vector_type(4)));
typedef unsigned u32x2 __attribute__((ext_vector_type(2)));
__device__ __forceinline__ unsigned pk2(float lo, float hi) { return (unsigned)f2bf(lo) | ((unsigned)f2bf(hi) << 16); }

namespace L {
constexpr size_t A256(size_t x) { return (x + 255) & ~(size_t)255; }
constexpr size_t CTL = 0, CTL_BYTES = 1u << 20;
constexpr size_t H = CTL + CTL_BYTES;
constexpr size_t MOD = CTL + 512 * 1024;
constexpr size_t TABC = A256(H + (size_t)MROWS * D * 4);
constexpr size_t TABS = A256(TABC + 4096 * 4);
constexpr size_t XN = A256(TABS + 4096 * 4);
constexpr size_t P = A256(XN + (size_t)MROWS * D * 2);
constexpr size_t MIX = A256(P + (size_t)MROWS * PP * 2);
constexpr size_t CQN = A256(MIX + (size_t)MROWS * D * 2);
constexpr size_t CKVN = A256(CQN + (size_t)MROWS * 256 * 2);
constexpr size_t QRAW = A256(CKVN + (size_t)MROWS * 128 * 2);
constexpr size_t KVRAW = A256(QRAW + (size_t)MROWS * 384 * 4);
constexpr size_t QL = A256(KVRAW + (size_t)MROWS * 512 * 4);
constexpr size_t QC = A256(QL + (size_t)16 * SEQ * 96 * 2);
constexpr size_t KB = A256(QC + (size_t)16 * CTX * 96 * 2);
constexpr size_t VB = A256(KB + (size_t)16 * NPOS * 96 * 2);
constexpr size_t LA = A256(VB + (size_t)16 * NPOS * 64 * 2);
constexpr size_t LB = A256(LA + (size_t)2 * MROWS * 256 * 4);
constexpr size_t HS = A256(LB + (size_t)2 * MROWS * 256 * 4);
constexpr size_t XCS = A256(HS + (size_t)2 * MROWS * 256 * 4);
constexpr size_t XCSC = A256(XCS + (size_t)4 * 8192 * 256 * 4);
constexpr size_t LIST = A256(XCSC + (size_t)4 * 512 * 256 * 4);
constexpr size_t GATE = A256(LIST + (size_t)2 * NE * LCAP * 4);
constexpr size_t ACT = A256(GATE + (size_t)NASG * 4);
constexpr size_t Y = A256(ACT + (size_t)ACT_ROWS * D * 2);
constexpr size_t WINT = A256(Y + (size_t)NASG * D * 2);
constexpr size_t WOUTT = A256(WINT + (size_t)2 * 2048 * 1024 * 2);
constexpr size_t WGUT = A256(WOUTT + (size_t)2 * 1024 * 1024 * 2);
constexpr size_t WDT = A256(WGUT + (size_t)2 * NE * 2048 * 1024 * 2);
constexpr size_t ZBUF = A256(WDT + (size_t)2 * NE * 1024 * 1024 * 2);
constexpr size_t VTG = A256(ZBUF + (size_t)4 * 64 * 64 * 512 * 2);
constexpr size_t WUQT = A256(VTG + (size_t)16 * 64 * NPOS * 2);
constexpr size_t WUKVT = A256(WUQT + (size_t)2 * 384 * 256 * 2);
constexpr size_t WAT = A256(WUKVT + (size_t)2 * 512 * 128 * 2);
constexpr size_t WIT = A256(WAT + (size_t)16 * 4096 * 2);
constexpr size_t SPT = A256(WIT + (size_t)16 * 4096 * 2);
constexpr size_t HL = A256(SPT + (size_t)1024 * 4);
constexpr size_t AC = A256(HL + (size_t)2 * MROWS * 256 * 2);
constexpr size_t SUM = A256(AC + (size_t)2 * MROWS * 256 * 2);
constexpr size_t XCT = A256(SUM + (size_t)2 * 4 * 68 * 512 * 4);
constexpr size_t END = A256(XCT + (size_t)16 * 512 * 64 * 2);
constexpr int CW_BAR = 4096;
constexpr int CW_CNT = 32768, CNT_STRIDE = 64;
}

#define XB_TMO      128
#define XB_XCNT(j)  (256  + 64 * (j))
#define XB_XSUB(j)  (1280 + 64 * (j))
#define XB_XGEN(j)  (2304 + 64 * (j))
#define XB_TOP      3328
#define XB_TOPGEN   3392
#define XCD_BAR_WORDS 3456
#define XB_SPIN_CAP (1u << 18)
__device__ __forceinline__ unsigned xb_ld(unsigned* p)              { return __hip_atomic_load(p, __ATOMIC_RELAXED, __HIP_MEMORY_SCOPE_AGENT); }
__device__ __forceinline__ unsigned xb_add(unsigned* p, unsigned v) { return __hip_atomic_fetch_add(p, v, __ATOMIC_RELAXED, __HIP_MEMORY_SCOPE_AGENT); }
__device__ __forceinline__ unsigned xb_xcc_id() { return (unsigned)__builtin_amdgcn_s_getreg((3 << 11) | 20) & 0xFu; }
#define XB_SPIN(cond, bar) do { unsigned _sp = 0; while (cond) { __builtin_amdgcn_s_sleep(1); \
    if ((++_sp & 255u) == 0u) { if (xb_ld(&(bar)[XB_TMO])) break; if (_sp > XB_SPIN_CAP) { atomicAdd(&(bar)[XB_TMO], 1u); break; } } } } while (0)
struct XcdBarrier { unsigned* bar; unsigned x; volatile LAS unsigned* st; };
__device__ __forceinline__ XcdBarrier xcd_barrier_post(unsigned* bar, volatile LAS unsigned* st) {
    XcdBarrier b; b.bar = bar; b.x = xb_xcc_id(); b.st = st;
    if (threadIdx.x == 0) (void)xb_add(&bar[XB_XCNT(b.x)], 1u);
    return b;
}
__device__ __forceinline__ void xcd_barrier_complete(unsigned* bar, unsigned x, unsigned& nloc, unsigned& nx) {
    const unsigned G = gridDim.x * gridDim.y * gridDim.z;
    unsigned sum, cnt, mine, sp = 0u;
    for (;;) {
        sum = 0u; cnt = 0u; mine = 0u;
#pragma unroll
        for (unsigned j = 0; j < 16; ++j) { const unsigned c = xb_ld(&bar[XB_XCNT(j)]); sum += c; cnt += (c > 0u) ? 1u : 0u; mine = (j == x) ? c : mine; }
        if (sum == G) break;
        __builtin_amdgcn_s_sleep(1);
        if ((++sp & 255u) == 0u) { if (xb_ld(&bar[XB_TMO])) break; if (sp > XB_SPIN_CAP) { atomicAdd(&bar[XB_TMO], 1u); break; } }
    }
    nloc = mine > 0u ? mine : 1u; nx = cnt > 0u ? cnt : 1u;
}
__device__ __forceinline__ void xcd_barrier(const XcdBarrier& b) {
    asm volatile("s_waitcnt vmcnt(0)" ::: "memory");
    __syncthreads();
    if (threadIdx.x == 0) {
        unsigned* bar = b.bar;
        __builtin_amdgcn_s_waitcnt(0);
        unsigned nloc = b.st[0], nx = b.st[1];
        if (nloc == 0u) { xcd_barrier_complete(bar, b.x, nloc, nx); b.st[0] = nloc; b.st[1] = nx; }
        const unsigned old = xb_add(&bar[XB_XSUB(b.x)], 1u);
        const unsigned gen = old / nloc;
        if (old + 1u == (gen + 1u) * nloc) {
            __builtin_amdgcn_fence(__ATOMIC_RELEASE, "agent");
            asm volatile("s_waitcnt vmcnt(0)" ::: "memory");
            const unsigned og = xb_add(&bar[XB_TOP], 1u);
            const unsigned tg = og / nx;
            if (og + 1u == (tg + 1u) * nx) xb_add(&bar[XB_TOPGEN], 1u);
            else XB_SPIN(xb_ld(&bar[XB_TOPGEN]) == tg, bar);
            __builtin_amdgcn_fence(__ATOMIC_ACQUIRE, "agent");
            xb_add(&bar[XB_XGEN(b.x)], 1u);
            asm volatile("s_waitcnt vmcnt(0)" ::: "memory");
        } else {
            XB_SPIN(xb_ld(&bar[XB_XGEN(b.x)]) == gen, bar);
            __builtin_amdgcn_fence(__ATOMIC_ACQUIRE, "agent");
            asm volatile("s_waitcnt vmcnt(0)" ::: "memory");
        }
    }
    __syncthreads();
}

namespace g8 {
constexpr int BM = 256, BK = 64, HALF = 128, HTB = HALF * BK * 2, STAGE_BYTES = 8 * HTB, NXCD = 8, WGM = 8;
__device__ __forceinline__ int lds_byte(int r, int c) { const int st = (r >> 4) * 2 + (c >> 5), rr = r & 15, cc = c & 31, ob = rr * 64 + cc * 2; return st * 1024 + (ob ^ (((ob >> 9) & 1) << 5)); }
__device__ __forceinline__ void stage_rc(int b, int& R, int& C) { const int st = b / 1024, sb = b % 1024, swz = sb ^ (((sb >> 9) & 1) << 5); R = (st >> 1) * 16 + swz / 64; C = (st & 1) * 32 + (swz % 64) / 2; }
__device__ __forceinline__ int perm32(int rho) { const int n = rho >> 4, i = rho & 15; return 8 * (i >> 2) + 4 * n + (i & 3); }
__device__ __forceinline__ unsigned cvt_pk_bf16(float lo, float hi) { unsigned r; asm volatile("v_cvt_pk_bf16_f32 %0, %1, %2" : "=v"(r) : "v"(lo), "v"(hi)); return r; }
__device__ __forceinline__ int xcd_remap(int wgid, int nwg) { const int q = nwg / NXCD, r = nwg % NXCD, xcd = wgid % NXCD, off = wgid / NXCD; return (xcd < r ? xcd * (q + 1) : r * (q + 1) + (xcd - r) * q) + off; }

struct Unit { int row0, col0, ex, bt, nvalid, lrow; };

struct DenseSched {
    int nM, nN, nwg, G, c, lat_only; const char* Bt; int K; const int* list;
    __device__ __forceinline__ void init(int nM_, int nN_, int G_, int c_, int lat_only_, const void* Bt_, int K_) { nM = nM_; nN = nN_; nwg = nM * nN; G = G_; c = c_; lat_only = lat_only_; Bt = (const char*)Bt_; K = K_; list = nullptr; }
    __device__ __forceinline__ bool next(int i, Unit& u) const {
        const long Lx = (long)i * G + c; if (Lx >= nwg) return false;
        const int wgid = xcd_remap((int)Lx, nwg);
        const int nig = WGM * nN, gid = wgid / nig, fm = gid * WGM, gsz = (nM - fm) < WGM ? (nM - fm) : WGM;
        const int pm = fm + ((wgid % nig) % gsz), pn = (wgid % nig) / gsz;
        const int tile = lat_only ? (pm / 16) * 17 + 1 + (pm % 16) : pm;
        u.row0 = tile * 256; u.col0 = pn * 256; u.ex = 0; u.bt = pn; u.nvalid = 256; u.lrow = 0; return true;
    }
    __device__ __forceinline__ const char* bptr(const Unit& u) const { return Bt + (size_t)u.bt * (256 * 1024 * 2); }
};
struct MoeSched {
    const LAS int* tpre; const LAS int* cnt; int NT, COLW, G, c, total; const char* Bt; int K; const int* list;
    __device__ __forceinline__ bool next(int i, Unit& u) const {
        const long Lx = (long)i * G + c; if (Lx >= total) return false;
        const int wgid = xcd_remap((int)Lx, total);
        int e = 0;
        for (int j = 1; j < NE; ++j) if (tpre[j] * NT <= wgid) e = j;
        const int t0 = tpre[e], mte = tpre[e + 1] - t0, loc = wgid - t0 * NT, nt = loc / mte, mt = loc % mte;
        u.ex = __builtin_amdgcn_readfirstlane(e); u.row0 = __builtin_amdgcn_readfirstlane((t0 + mt) * 256); u.col0 = __builtin_amdgcn_readfirstlane(nt * COLW);
        u.bt = __builtin_amdgcn_readfirstlane(e * NT + nt); const int nv = cnt[e] - mt * 256; u.nvalid = __builtin_amdgcn_readfirstlane(nv < 256 ? nv : 256); u.lrow = __builtin_amdgcn_readfirstlane(mt * 256);
        return true;
    }
    __device__ __forceinline__ const char* bptr(const Unit& u) const { return Bt + (size_t)u.bt * (256 * 1024 * 2); }
};

struct EpiP {
    static constexpr bool PERM = true; bf16_t* O;
    __device__ __forceinline__ void operator()(const f32x4 (&acc)[2][2][4][2], const Unit& u, int wr, int wc, int fr, int fq, const LAS int*) const {
#pragma unroll
        for (int ai = 0; ai < 2; ++ai)
#pragma unroll
            for (int m = 0; m < 4; ++m) { bf16_t* rowp = O + (size_t)(u.row0 + ai * HALF + wr * 64 + m * 16 + fr) * PP + u.col0 + wc * 32 + 8 * fq;
#pragma unroll
                for (int bj = 0; bj < 2; ++bj) { const f32x4 v0 = acc[ai][bj][m][0], v1 = acc[ai][bj][m][1]; u32x4 w; w.x = cvt_pk_bf16(v0[0], v0[1]); w.y = cvt_pk_bf16(v0[2], v0[3]); w.z = cvt_pk_bf16(v1[0], v1[1]); w.w = cvt_pk_bf16(v1[2], v1[3]);
                    *(u32x4*)(rowp + bj * HALF) = w; } }
    }
};
struct EpiH {
    static constexpr bool PERM = false; float* Hh; const float* MODl; int g_off;
    __device__ __forceinline__ void operator()(const f32x4 (&acc)[2][2][4][2], const Unit& u, int wr, int wc, int fr, int fq, const LAS int*) const {
        const int tile = u.row0 >> 8, v = (tile % 17 == 0) ? 4 : tile / 17; const float* gp = MODl + (size_t)v * 6144 + g_off + u.col0 + wc * 32 + 4 * fq;
        f32x4 gv[2][2];
#pragma unroll
        for (int bj = 0; bj < 2; ++bj)
#pragma unroll
            for (int n = 0; n < 2; ++n) gv[bj][n] = *(const f32x4*)(gp + bj * HALF + n * 16);
#pragma unroll
        for (int ai = 0; ai < 2; ++ai)
#pragma unroll
            for (int m = 0; m < 4; ++m) { float* rowp = Hh + (size_t)(u.row0 + ai * HALF + wr * 64 + m * 16 + fr) * D + u.col0 + wc * 32 + 4 * fq;
#pragma unroll
                for (int bj = 0; bj < 2; ++bj)
#pragma unroll
                    for (int n = 0; n < 2; ++n) { f32x4* p = (f32x4*)(rowp + bj * HALF + n * 16); *p = *p + gv[bj][n] * acc[ai][bj][m][n]; } }
    }
};
struct EpiMoe1 {
    static constexpr bool PERM = true; bf16_t* ACTp; const float* bgu;
    __device__ __forceinline__ void operator()(const f32x4 (&acc)[2][2][4][2], const Unit& u, int wr, int wc, int fr, int fq, const LAS int*) const {
        const int cc = u.col0 + wc * 32 + 8 * fq; const float* bp = bgu + (size_t)u.ex * 2048 + cc;
        f32x4 bg[2], bu[2];
#pragma unroll
        for (int n = 0; n < 2; ++n) { bg[n] = *(const f32x4*)(bp + 4 * n); bu[n] = *(const f32x4*)(bp + 1024 + 4 * n); }
#pragma unroll
        for (int ai = 0; ai < 2; ++ai)
#pragma unroll
            for (int m = 0; m < 4; ++m) { const int r = ai * HALF + wr * 64 + m * 16 + fr;
                float o[8];
#pragma unroll
                for (int n = 0; n < 2; ++n)
#pragma unroll
                    for (int i = 0; i < 4; ++i) { const float g = fminf(acc[ai][0][m][n][i] + bg[n][i], 7.f); const float uu = fminf(fmaxf(acc[ai][1][m][n][i] + bu[n][i], -7.f), 7.f);
                        o[n * 4 + i] = (uu + 1.f) * g * __builtin_amdgcn_rcpf(1.f + __expf(-1.702f * g)); }
                if (r < u.nvalid) { u32x4 w; w.x = cvt_pk_bf16(o[0], o[1]); w.y = cvt_pk_bf16(o[2], o[3]); w.z = cvt_pk_bf16(o[4], o[5]); w.w = cvt_pk_bf16(o[6], o[7]);
                    *(u32x4*)(ACTp + (size_t)(u.row0 + r) * D + cc) = w; } }
    }
};
struct EpiMoe2 {
    static constexpr bool PERM = true; bf16_t* Yp; const float* bd; const float* GATEp;
    __device__ __forceinline__ void operator()(const f32x4 (&acc)[2][2][4][2], const Unit& u, int wr, int wc, int fr, int fq, const LAS int* rows) const {
        const int cc = u.col0 + wc * 32 + 8 * fq; const float* bp = bd + (size_t)u.ex * 1024 + cc;
        f32x4 bv[2][2];
#pragma unroll
        for (int bj = 0; bj < 2; ++bj)
#pragma unroll
            for (int n = 0; n < 2; ++n) bv[bj][n] = *(const f32x4*)(bp + bj * HALF + 4 * n);
#pragma unroll
        for (int ai = 0; ai < 2; ++ai)
#pragma unroll
            for (int m = 0; m < 4; ++m) { const int r = ai * HALF + wr * 64 + m * 16 + fr;
                if (r < u.nvalid) { const int asg = rows[r]; const float gt = GATEp[asg]; bf16_t* rowp = Yp + (size_t)asg * D + cc;
#pragma unroll
                    for (int bj = 0; bj < 2; ++bj) { const f32x4 v0 = (acc[ai][bj][m][0] + bv[bj][0]) * gt, v1 = (acc[ai][bj][m][1] + bv[bj][1]) * gt;
                        u32x4 w; w.x = cvt_pk_bf16(v0[0], v0[1]); w.y = cvt_pk_bf16(v0[2], v0[3]); w.z = cvt_pk_bf16(v1[0], v1[1]); w.w = cvt_pk_bf16(v1[2], v1[3]); *(u32x4*)(rowp + bj * HALF) = w; } } }
    }
};

template <class Epi, class Sched, bool GATHER, bool ROWLIST>
__device__ __forceinline__ void gemm_phase(LAS unsigned char* lds, const char* Abase, const Sched& S, const Epi& E) {
    constexpr int K = 1024;
    int tid_l = threadIdx.x; asm volatile("" : "+v"(tid_l));
    const int tid = tid_l, wid = __builtin_amdgcn_readfirstlane(tid >> 6), lane = tid & 63, wr = wid >> 2, wc = wid & 3, fr = lane & 15, fq = lane >> 4;
    constexpr int nt = K / BK; constexpr unsigned Kb = (unsigned)K * 2u;
    unsigned voffB[2];
#pragma unroll
    for (int i = 0; i < 2; ++i) { int R, C; stage_rc(tid * 16 + i * 8192, R, C); const int Rb = Epi::PERM ? ((R & ~31) + perm32(R & 31)) : R; voffB[i] = (unsigned)(Rb * K + C) * 2u; }
    constexpr size_t kstep = (size_t)(BK * 2), hstep = (size_t)HALF * K * 2;
    const unsigned ldsw = (unsigned)wid * 1024u;
    const int aoff = lds_byte(wr * 64 + fr, fq * 8), boff = lds_byte(wc * 32 + fr, fq * 8);
    LAS int* rowbuf = (LAS int*)(lds + STAGE_BYTES);
#define G8_SA(b, h) (((b) * 2 + (h)) * HTB)
#define G8_SB(b, h) ((4 + (b) * 2 + (h)) * HTB)
#define G8_STAGE_A(bufoff, kb, v) do { _Pragma("unroll") for (int _i = 0; _i < 2; ++_i) \
        __builtin_amdgcn_global_load_lds((const unsigned*)((kb) + (size_t)(v)[_i]), (LAS unsigned*)(lds + (bufoff) + ldsw + _i * 8192), 16, 0, 0); } while (0)
#define G8_STAGE_B(bufoff, gbase) do { _Pragma("unroll") for (int _i = 0; _i < 2; ++_i) \
        __builtin_amdgcn_global_load_lds((const unsigned*)((gbase) + voffB[_i]), (LAS unsigned*)(lds + (bufoff) + ldsw + _i * 8192), 16, 0, 0); } while (0)
#define G8_LDA(dst, b, h) do { _Pragma("unroll") for (int m = 0; m < 4; ++m) _Pragma("unroll") for (int k = 0; k < 2; ++k) dst[m][k] = *(const LAS bf16x8*)(lds + G8_SA(b, h) + aoff + m * 2048 + k * 1024); } while (0)
#define G8_LDB(dst, b, h) do { _Pragma("unroll") for (int n = 0; n < 2; ++n) _Pragma("unroll") for (int k = 0; k < 2; ++k) dst[n][k] = *(const LAS bf16x8*)(lds + G8_SB(b, h) + boff + n * 2048 + k * 1024); } while (0)
#define G8_MMA(ai, bj, At, Bt) do { __builtin_amdgcn_s_setprio(1); _Pragma("unroll") for (int m = 0; m < 4; ++m) _Pragma("unroll") for (int n = 0; n < 2; ++n) _Pragma("unroll") for (int k = 0; k < 2; ++k) \
        acc[ai][bj][m][n] = __builtin_amdgcn_mfma_f32_16x16x32_bf16(Bt[n][k], At[m][k], acc[ai][bj][m][n], 0, 0, 0); __builtin_amdgcn_s_setprio(0); } while (0)
#define G8_WAIT_V(n) asm volatile("s_waitcnt vmcnt(" #n ")" ::: "memory")
#define G8_WAIT_L(n) asm volatile("s_waitcnt lgkmcnt(" #n ")" ::: "memory")
#define G8_BAR __builtin_amdgcn_s_barrier()
#define G8_SCHED __builtin_amdgcn_sched_barrier(0)
#define G8_LISTDMA(u, s) do { if (wid < 4) __builtin_amdgcn_global_load_lds((const unsigned*)(S.list + (size_t)(u).ex * LCAP + (u).lrow + wid * 64 + lane), (LAS unsigned*)(rowbuf + (s) * 256 + wid * 64), 4, 0, 0); } while (0)
#define G8_ROWS_DENSE(v) do { _Pragma("unroll") for (int _i = 0; _i < 2; ++_i) { int _R, _C; stage_rc(tid * 16 + _i * 8192, _R, _C); _Pragma("unroll") for (int _h = 0; _h < 2; ++_h) (v)[_h][_i] = (unsigned)(_h * HALF + _R) * Kb + (unsigned)_C * 2u; } } while (0)
#define G8_ROWS_LIST(v, u, s) do { _Pragma("unroll") for (int _i = 0; _i < 2; ++_i) { int _R, _C; stage_rc(tid * 16 + _i * 8192, _R, _C); _Pragma("unroll") for (int _h = 0; _h < 2; ++_h) { const int _r = _h * HALF + _R; const int _a = rowbuf[(s) * 256 + _r]; \
        (v)[_h][_i] = (unsigned)(_r < (u).nvalid ? (_a >> 2) : 0) * Kb + (unsigned)_C * 2u; } } } while (0)
    Unit cur, nxt; int ui = 0, slot = 0;
    if (!S.next(0, cur)) return;
    unsigned vA[2][2];
    if constexpr (ROWLIST) { G8_LISTDMA(cur, 0); G8_WAIT_V(0); G8_BAR; }
    if constexpr (GATHER) { G8_ROWS_LIST(vA, cur, 0); } else { G8_ROWS_DENSE(vA); }
    f32x4 acc[2][2][4][2];
#pragma unroll
    for (int a = 0; a < 2; ++a)
#pragma unroll
        for (int b = 0; b < 2; ++b)
#pragma unroll
            for (int m = 0; m < 4; ++m)
#pragma unroll
                for (int n = 0; n < 2; ++n) acc[a][b][m][n] = (f32x4){0.f, 0.f, 0.f, 0.f};
    bf16x8 At[4][2], B0[2][2], B1[2][2];
    const char* cB = S.bptr(cur);
    const char* cA = GATHER ? Abase : Abase + (size_t)cur.row0 * Kb;
    G8_STAGE_B(G8_SB(0, 0), cB); G8_STAGE_B(G8_SB(0, 1), cB + hstep); G8_STAGE_A(G8_SA(0, 0), cA, vA[0]); G8_STAGE_A(G8_SA(0, 1), cA, vA[1]);
    if (wr == 1) G8_BAR;
    G8_WAIT_V(2); G8_BAR;
    G8_STAGE_B(G8_SB(1, 0), cB + kstep); G8_STAGE_A(G8_SA(1, 0), cA + kstep, vA[0]); G8_STAGE_B(G8_SB(1, 1), cB + hstep + kstep);
    G8_WAIT_V(6); G8_BAR;
    for (;;) {
        const bool has_next = S.next(ui + 1, nxt);
        const char* nB = has_next ? S.bptr(nxt) : cB;
        const char* nA = (GATHER || !has_next) ? cA : Abase + (size_t)nxt.row0 * Kb;
        const int nslot = slot == 2 ? 0 : slot + 1;
        if constexpr (ROWLIST) { if (has_next) G8_LISTDMA(nxt, nslot); }
        for (int t = 0; t < nt; t += 2) {
            const bool last = (t == nt - 2);
            const char* a1 = cA + (size_t)(t + 1) * kstep;
            const char* a2 = last ? nA : cA + (size_t)(t + 2) * kstep; const char* b2 = last ? nB : cB + (size_t)(t + 2) * kstep;
            const char* a3 = a2 + kstep; const char* b3 = b2 + kstep;
            G8_LDB(B0, 0, 0); G8_LDB(B1, 0, 1); G8_SCHED; G8_LDA(At, 0, 0); G8_STAGE_A(G8_SA(1, 1), a1, vA[1]);
            if constexpr (GATHER) { if (last && has_next) { G8_ROWS_LIST(vA, nxt, nslot); } }
            G8_WAIT_V(8); G8_WAIT_L(0); G8_BAR; G8_MMA(0, 0, At, B0); G8_MMA(0, 1, At, B1); G8_BAR; G8_SCHED;
            G8_LDA(At, 0, 1); G8_STAGE_B(G8_SB(0, 0), b2); G8_STAGE_B(G8_SB(0, 1), b2 + hstep); G8_STAGE_A(G8_SA(0, 0), a2, vA[0]);
            G8_WAIT_V(8); G8_WAIT_L(0); G8_BAR; G8_MMA(1, 0, At, B0); G8_MMA(1, 1, At, B1); G8_BAR; G8_SCHED;
            G8_LDB(B0, 1, 0); G8_LDB(B1, 1, 1); G8_SCHED; G8_LDA(At, 1, 0); G8_STAGE_A(G8_SA(0, 1), a2, vA[1]);
            G8_WAIT_V(8); G8_WAIT_L(0); G8_BAR; G8_MMA(0, 0, At, B0); G8_MMA(0, 1, At, B1); G8_BAR; G8_SCHED;
            G8_LDA(At, 1, 1); G8_STAGE_B(G8_SB(1, 0), b3); G8_STAGE_B(G8_SB(1, 1), b3 + hstep); G8_STAGE_A(G8_SA(1, 0), a3, vA[0]);
            G8_WAIT_V(8); G8_WAIT_L(0); G8_BAR; G8_MMA(1, 0, At, B0); G8_MMA(1, 1, At, B1); G8_BAR; G8_SCHED;
        }
        if (wr == 0) G8_BAR;
        { int t2 = threadIdx.x; asm volatile("" : "+v"(t2));
          const int w2 = __builtin_amdgcn_readfirstlane(t2 >> 6); E(acc, cur, w2 >> 2, w2 & 3, t2 & 15, (t2 & 63) >> 4, rowbuf + slot * 256); }
        if (!has_next) break;
#pragma unroll
        for (int a = 0; a < 2; ++a)
#pragma unroll
            for (int b = 0; b < 2; ++b)
#pragma unroll
                for (int m = 0; m < 4; ++m)
#pragma unroll
                    for (int n = 0; n < 2; ++n) acc[a][b][m][n] = (f32x4){0.f, 0.f, 0.f, 0.f};
        cur = nxt; cB = nB; cA = nA; ++ui; slot = nslot;
        if (wr == 1) G8_BAR;
    }
    G8_WAIT_V(0);
    G8_BAR;
#undef G8_SA
#undef G8_SB
#undef G8_STAGE_A
#undef G8_STAGE_B
#undef G8_LDA
#undef G8_LDB
#undef G8_MMA
#undef G8_WAIT_V
#undef G8_WAIT_L
#undef G8_BAR
#undef G8_SCHED
#undef G8_LISTDMA
#undef G8_ROWS_DENSE
#undef G8_ROWS_LIST
}
}

namespace fft {
constexpr int TP = 72;
constexpr int UP = 264;
constexpr int ZP = 520;
constexpr int O_TC = 0, O_TS = 9216, O_U = 18432, O_X = 52224, O_TW = 125952;
__device__ __forceinline__ bf16x8 neg8(bf16x8 v) { u32x4 w = __builtin_bit_cast(u32x4, v); w = w ^ 0x80008000u; return __builtin_bit_cast(bf16x8, w); }
__device__ __forceinline__ void build_tables(LAS unsigned char* lds, const float* TABC, const float* TABS, int tid) {
    for (int i = tid; i < 4096; i += 512) { const int a = i >> 6, b = i & 63, ix = ((a * b) & 63) * 64;
        ((LAS bf16_t*)(lds + O_TC))[a * TP + b] = f2bf(TABC[ix]); ((LAS bf16_t*)(lds + O_TS))[a * TP + b] = f2bf(TABS[ix]); }
}
__device__ __forceinline__ void stage_a(LAS unsigned char* lds, const bf16_t* P, const float* TABC, const float* TABS, bf16_t* ZBUF, int u0, int u1, int ustep) {
    int tid_l = threadIdx.x; asm volatile("" : "+v"(tid_l));
    const int tid = tid_l, lane = tid & 63, w = __builtin_amdgcn_readfirstlane(tid >> 6), fr = lane & 15, fq = lane >> 4;
    build_tables(lds, TABC, TABS, tid);
    const LAS bf16_t* Tc = (const LAS bf16_t*)(lds + O_TC); const LAS bf16_t* Ts = (const LAS bf16_t*)(lds + O_TS);
    LAS bf16_t* U = (LAS bf16_t*)(lds + O_U); LAS bf16_t* X = (LAS bf16_t*)(lds + O_X); LAS float* TW = (LAS float*)(lds + O_TW);
    for (int unit = u0; unit < u1; unit += ustep) {
        const int b = unit >> 6, t2 = unit & 63;
#pragma unroll
        for (int i = 0; i < 4; ++i) { const int q = tid + 512 * i, t1 = q >> 5, ch = q & 31;
            *(LAS u32x4*)((LAS unsigned char*)U + t1 * (UP * 2) + ch * 16) = *(const u32x4*)(P + ((size_t)b * NPOS + CTX + 64 * t1 + t2) * PP + ch * 8); }
        if (tid < 64) { const int ix = tid * t2; TW[2 * tid] = TABC[ix]; TW[2 * tid + 1] = TABS[ix]; }
        __syncthreads();
        { const int g = w >> 1, part = w & 1; const LAS bf16_t* T = part ? Ts : Tc;
          f32x4 acc[4][4];
#pragma unroll
          for (int mt = 0; mt < 4; ++mt)
#pragma unroll
              for (int nt = 0; nt < 4; ++nt) acc[mt][nt] = (f32x4){0.f, 0.f, 0.f, 0.f};
#pragma unroll
          for (int ks = 0; ks < 2; ++ks) { bf16x8 a[4], bb[4];
#pragma unroll
              for (int mt = 0; mt < 4; ++mt) a[mt] = *(const LAS bf16x8*)(U + (16 * mt + fr) * UP + g * 64 + 32 * ks + 8 * fq);
#pragma unroll
              for (int nt = 0; nt < 4; ++nt) bb[nt] = *(const LAS bf16x8*)(T + (16 * nt + fr) * TP + 32 * ks + 8 * fq);
#pragma unroll
              for (int mt = 0; mt < 4; ++mt)
#pragma unroll
                  for (int nt = 0; nt < 4; ++nt) acc[mt][nt] = __builtin_amdgcn_mfma_f32_16x16x32_bf16(a[mt], bb[nt], acc[mt][nt], 0, 0, 0); }
          const float sg = part ? -1.f : 1.f;
#pragma unroll
          for (int mt = 0; mt < 4; ++mt)
#pragma unroll
              for (int nt = 0; nt < 4; ++nt) { const f32x4 v = acc[mt][nt] * sg; u32x2 o; o.x = pk2(v[0], v[1]); o.y = pk2(v[2], v[3]);
                  *(LAS u32x2*)(X + (part * 256 + g * 64 + 16 * nt + fr) * TP + 16 * mt + 4 * fq) = o; } }
        __syncthreads();
        f32x4 zr[4][2], zi[4][2];
#pragma unroll
        for (int mt = 0; mt < 4; ++mt)
#pragma unroll
            for (int n = 0; n < 2; ++n) { zr[mt][n] = (f32x4){0.f, 0.f, 0.f, 0.f}; zi[mt][n] = (f32x4){0.f, 0.f, 0.f, 0.f}; }
#pragma unroll
        for (int ks = 0; ks < 2; ++ks) { bf16x8 xr[2], xi[2];
#pragma unroll
            for (int n = 0; n < 2; ++n) { xr[n] = *(const LAS bf16x8*)(X + (32 * w + 16 * n + fr) * TP + 32 * ks + 8 * fq); xi[n] = *(const LAS bf16x8*)(X + (256 + 32 * w + 16 * n + fr) * TP + 32 * ks + 8 * fq); }
#pragma unroll
            for (int mt = 0; mt < 4; ++mt) { const bf16x8 c = *(const LAS bf16x8*)(Tc + (16 * mt + fr) * TP + 32 * ks + 8 * fq), s = *(const LAS bf16x8*)(Ts + (16 * mt + fr) * TP + 32 * ks + 8 * fq), ns = neg8(s);
#pragma unroll
                for (int n = 0; n < 2; ++n) { zr[mt][n] = __builtin_amdgcn_mfma_f32_16x16x32_bf16(c, xr[n], zr[mt][n], 0, 0, 0); zr[mt][n] = __builtin_amdgcn_mfma_f32_16x16x32_bf16(s, xi[n], zr[mt][n], 0, 0, 0);
                    zi[mt][n] = __builtin_amdgcn_mfma_f32_16x16x32_bf16(c, xi[n], zi[mt][n], 0, 0, 0); zi[mt][n] = __builtin_amdgcn_mfma_f32_16x16x32_bf16(ns, xr[n], zi[mt][n], 0, 0, 0); } } }
        __syncthreads();
        { LAS bf16_t* Zs = X;
#pragma unroll
          for (int mt = 0; mt < 4; ++mt)
#pragma unroll
              for (int i = 0; i < 4; ++i) { const int f1 = 16 * mt + 4 * fq + i; const float ct = TW[2 * f1], st = TW[2 * f1 + 1];
#pragma unroll
                  for (int n = 0; n < 2; ++n) { const float a = zr[mt][n][i], bq = zi[mt][n][i]; const int col = 32 * w + 16 * n + fr;
                      Zs[f1 * ZP + col] = f2bf(a * ct + bq * st); Zs[f1 * ZP + 256 + col] = f2bf(bq * ct - a * st); } } }
        __syncthreads();
#pragma unroll
        for (int i = 0; i < 8; ++i) { const int q = tid + 512 * i, f1 = q >> 6, ch = q & 63;
            *(u32x4*)(ZBUF + (((size_t)b * 64 + f1) * 64 + t2) * 512 + ch * 8) = *(const LAS u32x4*)((const LAS unsigned char*)X + f1 * (ZP * 2) + ch * 16); }
        __syncthreads();
    }
}
__device__ __forceinline__ void stage_b(LAS unsigned char* lds, const bf16_t* ZBUF, const float* TABC, const float* TABS, bf16_t* MIX, int G, int bx) {
    int tid_l = threadIdx.x; asm volatile("" : "+v"(tid_l));
    const int tid = tid_l, lane = tid & 63, w = __builtin_amdgcn_readfirstlane(tid >> 6), fr = lane & 15, fq = lane >> 4;
    build_tables(lds, TABC, TABS, tid);
    const LAS bf16_t* Tc = (const LAS bf16_t*)(lds + O_TC); const LAS bf16_t* Ts = (const LAS bf16_t*)(lds + O_TS);
    LAS bf16_t* Ys = (LAS bf16_t*)(lds + O_U); LAS bf16_t* ZT = (LAS bf16_t*)(lds + O_X);
    for (int unit = bx; unit < 256; unit += G) {
        const int b = unit >> 6, f1 = unit & 63;
        const bf16_t* Zg = ZBUF + ((size_t)b * 64 + f1) * 64 * 512;
#pragma unroll
        for (int i = 0; i < 4; ++i) { const int q = tid + 512 * i, p = q & 31, ch = q >> 5;
            const u32x4 r0 = *(const u32x4*)(Zg + (size_t)(2 * p) * 512 + ch * 8), r1 = *(const u32x4*)(Zg + (size_t)(2 * p + 1) * 512 + ch * 8);
#pragma unroll
            for (int j = 0; j < 4; ++j) { const unsigned a = r0[j], c = r1[j];
                *(LAS unsigned*)(ZT + (ch * 8 + 2 * j) * TP + 2 * p) = (a & 0xffffu) | (c << 16);
                *(LAS unsigned*)(ZT + (ch * 8 + 2 * j + 1) * TP + 2 * p) = (a >> 16) | (c & 0xffff0000u); } }
        __syncthreads();
        f32x4 y[4][2];
#pragma unroll
        for (int mt = 0; mt < 4; ++mt)
#pragma unroll
            for (int n = 0; n < 2; ++n) y[mt][n] = (f32x4){0.f, 0.f, 0.f, 0.f};
#pragma unroll
        for (int ks = 0; ks < 2; ++ks) { bf16x8 xr[2], xi[2];
#pragma unroll
            for (int n = 0; n < 2; ++n) { xr[n] = *(const LAS bf16x8*)(ZT + (32 * w + 16 * n + fr) * TP + 32 * ks + 8 * fq); xi[n] = *(const LAS bf16x8*)(ZT + (256 + 32 * w + 16 * n + fr) * TP + 32 * ks + 8 * fq); }
#pragma unroll
            for (int mt = 0; mt < 4; ++mt) { const bf16x8 c = *(const LAS bf16x8*)(Tc + (16 * mt + fr) * TP + 32 * ks + 8 * fq), s = *(const LAS bf16x8*)(Ts + (16 * mt + fr) * TP + 32 * ks + 8 * fq);
#pragma unroll
                for (int n = 0; n < 2; ++n) { y[mt][n] = __builtin_amdgcn_mfma_f32_16x16x32_bf16(c, xr[n], y[mt][n], 0, 0, 0); y[mt][n] = __builtin_amdgcn_mfma_f32_16x16x32_bf16(s, xi[n], y[mt][n], 0, 0, 0); } } }
#pragma unroll
        for (int mt = 0; mt < 4; ++mt)
#pragma unroll
            for (int i = 0; i < 4; ++i)
#pragma unroll
                for (int n = 0; n < 2; ++n) Ys[(16 * mt + 4 * fq + i) * UP + 32 * w + 16 * n + fr] = f2bf(y[mt][n][i] * (1.f / 512.f));
        __syncthreads();
#pragma unroll
        for (int i = 0; i < 4; ++i) { const int q = tid + 512 * i, f2 = q >> 5, ch = q & 31;
            *(u32x4*)(MIX + ((size_t)b * NPOS + CTX + f1 + 64 * f2) * D + ch * 8) = *(const LAS u32x4*)((const LAS unsigned char*)Ys + f2 * (UP * 2) + ch * 16); }
        __syncthreads();
    }
}
}

namespace attn {
typedef float f32x16 __attribute__((ext_vector_type(16)));
typedef float f32x2_t __attribute__((ext_vector_type(2))); typedef __bf16 bf16x2_t __attribute__((ext_vector_type(2)));
__device__ __forceinline__ unsigned cvtpk(float lo, float hi) { f32x2_t v = {lo, hi}; bf16x2_t b = __builtin_convertvector(v, bf16x2_t); return __builtin_bit_cast(unsigned, b); }
constexpr int KP = 104, VP = 68;
constexpr int KT_BYTES = 64 * KP * 2, VT_BYTES = 64 * VP * 2, BUF_BYTES = KT_BYTES + VT_BYTES;
constexpr float THR = 8.f;
__device__ __forceinline__ void attn_phase(LAS unsigned char* lds, const bf16_t* QL, const bf16_t* QC, const bf16_t* KB, const bf16_t* VTG, bf16_t* MIX, int with_ctx, int G, int vcu) {
    const int nunits = 256 + (with_ctx ? 16 : 0);
    for (int unit = vcu; unit < nunits; unit += G) {
        int tid_l = threadIdx.x; asm volatile("" : "+v"(tid_l));
        const int tid = tid_l, lane = tid & 63, wid = __builtin_amdgcn_readfirstlane(tid >> 6), r32 = lane & 31, hi = lane >> 5;
        int bh, nk, orow0; const bf16_t* Qp;
        if (unit < 256) { bh = unit >> 4; const int qb = unit & 15; Qp = QL + ((size_t)bh * SEQ + qb * 256) * 96; nk = NPOS; orow0 = (bh >> 2) * NPOS + CTX + qb * 256; }
        else { bh = unit - 256; Qp = QC + (size_t)bh * CTX * 96; nk = CTX; orow0 = (bh >> 2) * NPOS; }
        const int hh = bh & 3, NT = nk / 64;
        const bf16_t* Kg = KB + (size_t)bh * NPOS * 96; const bf16_t* Vg = VTG + (size_t)bh * 64 * NPOS;
        bf16x8 qf[6];
        { const bf16_t* qp = Qp + (size_t)(wid * 32 + r32) * 96 + 8 * hi;
#pragma unroll
          for (int ds = 0; ds < 6; ++ds) qf[ds] = *(const bf16x8*)(qp + 16 * ds); }
        f32x16 o0 = {}, o1 = {}; float mhat = 0.f, l = 0.f;
        const int kr0 = tid / 12, kc0 = tid % 12, kr1 = (tid + 512) / 12, kc1 = (tid + 512) % 12; const bool k1ok = tid < 256;
        const int vd = tid >> 3, vc = tid & 7;
        u32x4 sk0, sk1 = {}, sv;
#define AT_LOAD(t_) do { const size_t k0_ = (size_t)(t_) * 64; sk0 = *(const u32x4*)(Kg + (k0_ + kr0) * 96 + kc0 * 8); if (k1ok) sk1 = *(const u32x4*)(Kg + (k0_ + kr1) * 96 + kc1 * 8); sv = *(const u32x4*)(Vg + (size_t)vd * NPOS + k0_ + vc * 8); } while (0)
#define AT_STORE(slot_) do { LAS unsigned char* bp_ = lds + (slot_) * BUF_BYTES; *(LAS u32x4*)(bp_ + kr0 * (KP * 2) + kc0 * 16) = sk0; if (k1ok) *(LAS u32x4*)(bp_ + kr1 * (KP * 2) + kc1 * 16) = sk1; *(LAS u32x4*)(bp_ + KT_BYTES + vd * (VP * 2) + vc * 16) = sv; } while (0)
#define AT_QK(P0, P1, slot_) do { const LAS bf16_t* Kt_ = (const LAS bf16_t*)(lds + (slot_) * BUF_BYTES); f32x16 c_; _Pragma("unroll") for (int r_ = 0; r_ < 16; ++r_) c_[r_] = -mhat; P0 = c_; P1 = c_; \
        _Pragma("unroll") for (int ds = 0; ds < 6; ++ds) { const bf16x8 k0f = *(const LAS bf16x8*)(Kt_ + r32 * KP + 16 * ds + 8 * hi), k1f = *(const LAS bf16x8*)(Kt_ + (32 + r32) * KP + 16 * ds + 8 * hi); \
            P0 = __builtin_amdgcn_mfma_f32_32x32x16_bf16(k0f, qf[ds], P0, 0, 0, 0); P1 = __builtin_amdgcn_mfma_f32_32x32x16_bf16(k1f, qf[ds], P1, 0, 0, 0); } } while (0)
        AT_LOAD(0); AT_STORE(0);
        if (NT > 1) { AT_LOAD(1); AT_STORE(1); }
        __syncthreads();
        f32x16 p0, p1, n0, n1;
        AT_QK(p0, p1, 0);
        int s_cur = 0, s_nxt = 1, s_ld = 2;
        for (int t = 0; t < NT; ++t) {
            if (t + 2 < NT) AT_LOAD(t + 2);
            if (t + 1 < NT) AT_QK(n0, n1, s_nxt);
            float mx = fmaxf(p0[0], p1[0]);
#pragma unroll
            for (int r = 1; r < 16; ++r) mx = fmaxf(mx, fmaxf(p0[r], p1[r]));
            mx = fmaxf(mx, __shfl_xor(mx, 32));
            if (__builtin_expect(t == 0 || __any(mx > THR), 0)) { const float dl = t == 0 ? mx : fmaxf(mx, 0.f), f = __builtin_amdgcn_exp2f(-dl); mhat += dl; l *= f;
#pragma unroll
                for (int r = 0; r < 16; ++r) { p0[r] -= dl; p1[r] -= dl; o0[r] *= f; o1[r] *= f; }
                if (t + 1 < NT) {
#pragma unroll
                    for (int r = 0; r < 16; ++r) { n0[r] -= dl; n1[r] -= dl; } } }
            float ls = 0.f;
#pragma unroll
            for (int r = 0; r < 16; ++r) { p0[r] = __builtin_amdgcn_exp2f(p0[r]); p1[r] = __builtin_amdgcn_exp2f(p1[r]); ls += p0[r] + p1[r]; }
            l += ls;
            const LAS bf16_t* Vt = (const LAS bf16_t*)(lds + s_cur * BUF_BYTES + KT_BYTES);
#pragma unroll
            for (int s = 0; s < 4; ++s) {
                u32x4 pw;
#pragma unroll
                for (int j = 0; j < 4; ++j) { const int r = 8 * (s & 1) + 2 * j; pw[j] = (s < 2) ? cvtpk(p0[r], p0[r + 1]) : cvtpk(p1[r], p1[r + 1]); }
                const bf16x8 pf = __builtin_bit_cast(bf16x8, pw);
                const int kvb = 32 * (s >> 1) + 16 * (s & 1) + 4 * hi;
#pragma unroll
                for (int db = 0; db < 2; ++db) { const u32x2 va = *(const LAS u32x2*)(Vt + (32 * db + r32) * VP + kvb), vb = *(const LAS u32x2*)(Vt + (32 * db + r32) * VP + kvb + 8);
                    const u32x4 vw = {va.x, va.y, vb.x, vb.y}; const bf16x8 vf = __builtin_bit_cast(bf16x8, vw);
                    if (db == 0) o0 = __builtin_amdgcn_mfma_f32_32x32x16_bf16(vf, pf, o0, 0, 0, 0); else o1 = __builtin_amdgcn_mfma_f32_32x32x16_bf16(vf, pf, o1, 0, 0, 0); }
            }
            if (t + 2 < NT) AT_STORE(s_ld);
            __syncthreads();
            p0 = n0; p1 = n1;
            { const int tmp = s_cur; s_cur = s_nxt; s_nxt = s_ld; s_ld = tmp; }
        }
#undef AT_LOAD
#undef AT_STORE
#undef AT_QK
        l += __shfl_xor(l, 32);
        const float il = 1.f / l;
        bf16_t* op = MIX + (size_t)(orow0 + wid * 32 + r32) * D + 512 + hh * 64 + 4 * hi;
#pragma unroll
        for (int g4 = 0; g4 < 4; ++g4) { u32x2 w0, w1; w0.x = cvtpk(o0[4 * g4] * il, o0[4 * g4 + 1] * il); w0.y = cvtpk(o0[4 * g4 + 2] * il, o0[4 * g4 + 3] * il);
            w1.x = cvtpk(o1[4 * g4] * il, o1[4 * g4 + 1] * il); w1.y = cvtpk(o1[4 * g4 + 2] * il, o1[4 * g4 + 3] * il);
            *(u32x2*)(op + 8 * g4) = w0; *(u32x2*)(op + 32 + 8 * g4) = w1; }
    }
}
}

namespace sm {
__device__ __forceinline__ float silu(float x) { return x / (1.f + __expf(-x)); }
__device__ __forceinline__ void mod_phase(LAS unsigned char* lds, const float* c, const float* c_ctx, const float* mod_w, const float* mod_b, float* MOD, int G, int bx, int tid) {
    LAS float* s = (LAS float*)lds;
    for (int i = tid; i < 5120; i += 512) { const int v = i >> 10, k = i & 1023; s[i] = silu(v < 4 ? c[v * 1024 + k] : c_ctx[k]); }
    __syncthreads();
    LAS float* red = s + 5120;
    for (int unit = bx; unit < 96; unit += G) {
        const int l = unit / 48, cb = unit % 48, cl = tid & 127, col = cb * 128 + cl, kq = tid >> 7, k0 = kq * 256;
        const float* W = mod_w + ((size_t)l * 1024 + k0) * 6144 + col;
        float a0 = 0.f, a1 = 0.f, a2 = 0.f, a3 = 0.f, a4 = 0.f;
#pragma unroll 16
        for (int k = 0; k < 256; ++k) { const float w = W[(size_t)k * 6144]; a0 += s[k0 + k] * w; a1 += s[1024 + k0 + k] * w; a2 += s[2048 + k0 + k] * w; a3 += s[3072 + k0 + k] * w; a4 += s[4096 + k0 + k] * w; }
        LAS float* rq = red + kq * 640 + cl; rq[0] = a0; rq[128] = a1; rq[256] = a2; rq[384] = a3; rq[512] = a4;
        __syncthreads();
        for (int i = tid; i < 640; i += 512) { const int v = i >> 7, cc = i & 127; const float r = ((red[i] + red[640 + i]) + (red[1280 + i] + red[1920 + i])) + mod_b[l * 6144 + cb * 128 + cc];
            MOD[((size_t)l * 5 + v) * 6144 + cb * 128 + cc] = r; }
        __syncthreads();
    }
}
__device__ __forceinline__ void norm_store(const float4 (&x)[4], float ss, const float* g, const float* mv, int sh_off, int sc_off, bf16_t* xn_row, int lane) {
    const float rs = rsqrtf(wave_sum(ss) * (1.f / D) + 1e-6f);
#pragma unroll
    for (int j = 0; j < 4; ++j) { const int c = (j * 64 + lane) * 4; const float4 gg = *(const float4*)(g + c), sh = *(const float4*)(mv + sh_off + c), sc = *(const float4*)(mv + sc_off + c);
        u32x2 o; o.x = pk2(x[j].x * rs * gg.x * (1.f + sc.x) + sh.x, x[j].y * rs * gg.y * (1.f + sc.y) + sh.y); o.y = pk2(x[j].z * rs * gg.z * (1.f + sc.z) + sh.z, x[j].w * rs * gg.w * (1.f + sc.w) + sh.w);
        *(u32x2*)(xn_row + c) = o; }
}
__device__ __forceinline__ void pro1_phase(const float* x, const float* ctx, const float* g, const float* MODl, float* H, bf16_t* XN, int gw, int NGW, int lane) {
    for (int r = gw; r < MROWS; r += NGW) { const int b = r / NPOS, pos = r % NPOS, v = pos < CTX ? 4 : b;
        const float* src = pos < CTX ? ctx + ((size_t)b * CTX + pos) * D : x + ((size_t)b * SEQ + (pos - CTX)) * D;
        float4 xv[4]; float ss = 0.f;
#pragma unroll
        for (int j = 0; j < 4; ++j) { const int c = (j * 64 + lane) * 4; xv[j] = *(const float4*)(src + c); *(float4*)(H + (size_t)r * D + c) = xv[j]; ss += xv[j].x * xv[j].x + xv[j].y * xv[j].y + xv[j].z * xv[j].z + xv[j].w * xv[j].w; }
        norm_store(xv, ss, g, MODl + (size_t)v * 6144, 0, 1024, XN + (size_t)r * D, lane); }
}
__device__ __forceinline__ void comb_phase(int l, float* H, const bf16_t* Y, const float* MODl, const float* g_next, const float* MODn, bf16_t* XN, const float* final_g, float* out, int gw, int NGW, int lane) {
    for (int r = gw; r < MROWS; r += NGW) { const int b = r / NPOS, pos = r % NPOS, v = pos < CTX ? 4 : b;
        if (l == 1 && pos < CTX) continue;
        const float* g2 = MODl + (size_t)v * 6144 + 5120;
        float4 xv[4]; float ss = 0.f;
#pragma unroll
        for (int j = 0; j < 4; ++j) { const int c = (j * 64 + lane) * 4; xv[j] = *(const float4*)(H + (size_t)r * D + c); float4 s = make_float4(0.f, 0.f, 0.f, 0.f);
#pragma unroll
            for (int k = 0; k < 4; ++k) { const u32x2 y = *(const u32x2*)(Y + ((size_t)r * 4 + k) * D + c); s.x += __uint_as_float(y.x << 16); s.y += __uint_as_float(y.x & 0xffff0000u); s.z += __uint_as_float(y.y << 16); s.w += __uint_as_float(y.y & 0xffff0000u); }
            const float4 gg = *(const float4*)(g2 + c); xv[j].x += gg.x * s.x; xv[j].y += gg.y * s.y; xv[j].z += gg.z * s.z; xv[j].w += gg.w * s.w;
            ss += xv[j].x * xv[j].x + xv[j].y * xv[j].y + xv[j].z * xv[j].z + xv[j].w * xv[j].w; }
        if (l == 0) {
#pragma unroll
            for (int j = 0; j < 4; ++j) *(float4*)(H + (size_t)r * D + (j * 64 + lane) * 4) = xv[j];
            norm_store(xv, ss, g_next, MODn + (size_t)v * 6144, 0, 1024, XN + (size_t)r * D, lane);
        } else { const float rs = rsqrtf(wave_sum(ss) * (1.f / D) + 1e-6f); float* op = out + ((size_t)b * SEQ + (pos - CTX)) * D;
#pragma unroll
            for (int j = 0; j < 4; ++j) { const int c = (j * 64 + lane) * 4; const float4 fg = *(const float4*)(final_g + c); float4 o; o.x = xv[j].x * rs * fg.x; o.y = xv[j].y * rs * fg.y; o.z = xv[j].z * rs * fg.z; o.w = xv[j].w * rs * fg.w; *(float4*)(op + c) = o; } }
    }
}
__device__ __forceinline__ void route_phase(LAS unsigned char* lds, int l, const float* H, const float* g, const float* MODl, const float* rw, const float* rb, bf16_t* XN, int* CNT, int* LIST, float* GATE,
                                            int G, int bx, int tid) {
    const int lane = tid & 63, wave = __builtin_amdgcn_readfirstlane(tid >> 6), e = lane & 31, kpart = wave * 2 + (lane >> 5);
    LAS float* F = (LAS float*)lds;
    LAS float* PART = (LAS float*)(lds + 32768);
    LAS int* LCNT = (LAS int*)(lds + 49152);
    LAS int* LBASE = LCNT + 64; LAS int* LENT = LCNT + 128;
    if (tid < 64) LCNT[tid] = 0;
    __syncthreads();
    float w[64];
#pragma unroll
    for (int k = 0; k < 64; ++k) w[k] = rw[(size_t)(kpart * 64 + k) * 32 + e];
    const float bias = rb[e];
    const int nb = l == 1 ? (MROWS - NB_ * CTX) / 8 : MROWS / 8;
    for (int bi = bx; bi < nb; bi += G) {
        int r;
        if (l == 1) { const int q = bi * 8 + wave; r = (q / SEQ) * NPOS + CTX + (q % SEQ); } else r = bi * 8 + wave;
        const int b = r / NPOS, pos = r % NPOS, v = pos < CTX ? 4 : b; const float* mv = MODl + (size_t)v * 6144;
        { float4 xv[4]; float ss = 0.f;
#pragma unroll
          for (int j = 0; j < 4; ++j) { xv[j] = *(const float4*)(H + (size_t)r * D + (j * 64 + lane) * 4); ss += xv[j].x * xv[j].x + xv[j].y * xv[j].y + xv[j].z * xv[j].z + xv[j].w * xv[j].w; }
          const float rs = rsqrtf(wave_sum(ss) * (1.f / D) + 1e-6f);
#pragma unroll
          for (int j = 0; j < 4; ++j) { const int c = (j * 64 + lane) * 4; const float4 gg = *(const float4*)(g + c), sh = *(const float4*)(mv + 3072 + c), sc = *(const float4*)(mv + 4096 + c);
              f32x4 f; f[0] = xv[j].x * rs * gg.x * (1.f + sc.x) + sh.x; f[1] = xv[j].y * rs * gg.y * (1.f + sc.y) + sh.y; f[2] = xv[j].z * rs * gg.z * (1.f + sc.z) + sh.z; f[3] = xv[j].w * rs * gg.w * (1.f + sc.w) + sh.w;
              *(LAS f32x4*)(F + wave * 1024 + c) = f; u32x2 o; o.x = pk2(f[0], f[1]); o.y = pk2(f[2], f[3]); *(u32x2*)(XN + (size_t)r * D + c) = o; } }
        __syncthreads();
        { float acc[8];
#pragma unroll
          for (int rr = 0; rr < 8; ++rr) acc[rr] = 0.f;
#pragma unroll
          for (int k4 = 0; k4 < 16; ++k4) {
#pragma unroll
              for (int rr = 0; rr < 8; ++rr) { const f32x4 f = *(const LAS f32x4*)(F + rr * 1024 + kpart * 64 + k4 * 4); acc[rr] += f[0] * w[k4 * 4] + f[1] * w[k4 * 4 + 1] + f[2] * w[k4 * 4 + 2] + f[3] * w[k4 * 4 + 3]; } }
#pragma unroll
          for (int rr = 0; rr < 8; ++rr) PART[(rr * 16 + kpart) * 32 + e] = acc[rr]; }
        __syncthreads();
        { float lg = bias;
#pragma unroll
          for (int kp = 0; kp < 16; ++kp) lg += PART[(wave * 16 + kp) * 32 + e];
          float val = lane < 32 ? lg : -3e38f; int idx = e; float tv[4]; int ti[4];
#pragma unroll
          for (int k = 0; k < 4; ++k) { float bv = val; int bi2 = idx;
#pragma unroll
              for (int o = 1; o < 32; o <<= 1) { const float ov = __shfl_xor(bv, o); const int oi = __shfl_xor(bi2, o); if (ov > bv || (ov == bv && oi < bi2)) { bv = ov; bi2 = oi; } }
              tv[k] = bv; ti[k] = bi2; if (idx == bi2) val = -3e38f; }
          if (lane == 0) { float ex[4], sum = 0.f;
#pragma unroll
              for (int k = 0; k < 4; ++k) { ex[k] = __expf(tv[k] - tv[0]); sum += ex[k]; }
              const float isum = 1.f / sum;
#pragma unroll
              for (int k = 0; k < 4; ++k) { const int asg = r * 4 + k; GATE[asg] = ex[k] * isum; const int rank = __hip_atomic_fetch_add(&LCNT[ti[k]], 1, __ATOMIC_RELAXED, __HIP_MEMORY_SCOPE_WORKGROUP); const int slot = __hip_atomic_fetch_add(&LCNT[32], 1, __ATOMIC_RELAXED, __HIP_MEMORY_SCOPE_WORKGROUP);
                  LENT[slot * 2] = asg; LENT[slot * 2 + 1] = (ti[k] << 16) | rank; } } }
        __syncthreads();
    }
    if (tid < 32) LBASE[tid] = LCNT[tid] > 0 ? atomicAdd(&CNT[tid * L::CNT_STRIDE], LCNT[tid]) : 0;
    __syncthreads();
    for (int i = tid; i < LCNT[32]; i += 512) { const int asg = LENT[i * 2], er = LENT[i * 2 + 1], ee = er >> 16, rank = er & 0xffff; LIST[(size_t)ee * LCAP + LBASE[ee] + rank] = asg; }
    __syncthreads();
}
__device__ __forceinline__ void smallw_phase(const float* w_uq, const float* qg, const float* w_ukv, const float* kvg, const float* w_a, const float* w_i, bf16_t* WUQT, bf16_t* WUKVT, bf16_t* WAT, bf16_t* WIT,
                                             float* TABC, float* TABS, const float* lam, float* SPT, int gt, int NGT) {
    for (int i = gt; i < 2 * 384 * 256; i += NGT) { const int l = i / (384 * 256), q = i % (384 * 256), n = q >> 8, k = q & 255; WUQT[i] = f2bf(qg[l * 256 + k] * w_uq[((size_t)l * 256 + k) * 384 + n]); }
    for (int i = gt; i < 2 * 512 * 128; i += NGT) { const int l = i / (512 * 128), q = i % (512 * 128), n = q >> 7, k = q & 127; WUKVT[i] = f2bf(kvg[l * 128 + k] * w_ukv[((size_t)l * 128 + k) * 512 + n]); }
    for (int i = gt; i < 16 * 4096; i += NGT) { const int m = i >> 12, q = i & 4095, e = q >> 6, d = q & 63; WAT[i] = f2bf(w_a[(size_t)m * 4096 + d * 64 + e]); WIT[i] = f2bf(w_i[(size_t)m * 4096 + d * 64 + e]); }
    for (int i = gt; i < 4096; i += NGT) { float s, c; sincospif((float)i / 2048.f, &s, &c); TABC[i] = c; TABS[i] = s; }
    for (int i = gt; i < 1024; i += NGT) SPT[i] = log1pf(__expf(-lam[i]));
}
}

namespace prep {
constexpr int O_KR = 0, O_CS = 8192, O_RS = 16384, O_CQ = 16896  , O_KS = 67072, O_CKV = 100864;
constexpr int CQP = 264, CKP = 136, QSP = 392, KSP = 264;
constexpr float C2 = 0.10206207261596577f * 1.4426950408889634f;
__device__ __forceinline__ void qkv_units(LAS unsigned char* lds, int l, const bf16_t* P, const bf16_t* WUQT, const bf16_t* WUKVT, const float* scw, const float* scb,
                                          bf16_t* QL, bf16_t* QC, bf16_t* KB, bf16_t* VTG, bf16_t* MIX, int u0, int u1, int ustep) {
    LAS float* KRo = (LAS float*)(lds + O_KR); LAS float* CS = (LAS float*)(lds + O_CS); LAS float* RS = (LAS float*)(lds + O_RS);
    LAS bf16_t* CQ = (LAS bf16_t*)(lds + O_CQ); LAS bf16_t* CK = (LAS bf16_t*)(lds + O_CKV); LAS bf16_t* KS = (LAS bf16_t*)(lds + O_KS); LAS bf16_t* QS = (LAS bf16_t*)(lds + O_CQ);
    for (int unit = u0; unit < u1; unit += ustep) {
        int tid_l = threadIdx.x; asm volatile("" : "+v"(tid_l));
        const int tid = tid_l, lane = tid & 63, w = __builtin_amdgcn_readfirstlane(tid >> 6), fr = lane & 15, fq = lane >> 4;
        const int b = unit / 68, chunk = unit % 68, pos0 = 64 * chunk; const bool ctxt = chunk < 4; const size_t r0 = (size_t)b * NPOS + pos0;
#pragma unroll
        for (int i = 0; i < 4; ++i) { const int q = tid + 512 * i, row = q >> 5, ch = q & 31; *(LAS u32x4*)((LAS unsigned char*)CQ + row * (CQP * 2) + ch * 16) = *(const u32x4*)(P + (r0 + row) * PP + C_CQ + ch * 8); }
#pragma unroll
        for (int i = 0; i < 2; ++i) { const int q = tid + 512 * i, row = q >> 4, ch = q & 15; *(LAS u32x4*)((LAS unsigned char*)CK + row * (CKP * 2) + ch * 16) = *(const u32x4*)(P + (r0 + row) * PP + C_CKV + ch * 8); }
        __syncthreads();
        { const int row = tid >> 3, j = tid & 7; float sq = 0.f, sk = 0.f;
#pragma unroll
          for (int i = 0; i < 4; ++i) { const u32x4 v = *(const LAS u32x4*)((const LAS unsigned char*)CQ + row * (CQP * 2) + j * 64 + i * 16);
#pragma unroll
              for (int e = 0; e < 4; ++e) { const float a = __uint_as_float(v[e] << 16), c = __uint_as_float(v[e] & 0xffff0000u); sq += a * a + c * c; } }
#pragma unroll
          for (int i = 0; i < 2; ++i) { const u32x4 v = *(const LAS u32x4*)((const LAS unsigned char*)CK + row * (CKP * 2) + j * 32 + i * 16);
#pragma unroll
              for (int e = 0; e < 4; ++e) { const float a = __uint_as_float(v[e] << 16), c = __uint_as_float(v[e] & 0xffff0000u); sk += a * a + c * c; } }
          sq += __shfl_xor(sq, 1); sq += __shfl_xor(sq, 2); sq += __shfl_xor(sq, 4); sk += __shfl_xor(sk, 1); sk += __shfl_xor(sk, 2); sk += __shfl_xor(sk, 4);
          if (j == 0) { RS[row * 2] = rsqrtf(sq * (1.f / 256.f) + 1e-6f); RS[row * 2 + 1] = rsqrtf(sk * (1.f / 128.f) + 1e-6f); }
          float cr = 1.f, sr = 0.f, cc = 1.f, sc = 0.f;
          if (!ctxt) { const int t = pos0 - CTX + row; const float inv = __expf(-9.210340371976184f * (float)j * 0.125f); float xa = (float)(t >> 6) * inv * 0.15915494309189535f; xa -= rintf(xa); sr = __sinf(xa * 6.283185307179586f); cr = __cosf(xa * 6.283185307179586f); float xb = (float)(t & 63) * inv * 0.15915494309189535f; xb -= rintf(xb); sc = __sinf(xb * 6.283185307179586f); cc = __cosf(xb * 6.283185307179586f); }
          CS[(row * 16 + j) * 2] = cr; CS[(row * 16 + j) * 2 + 1] = sr; CS[(row * 16 + 8 + j) * 2] = cc; CS[(row * 16 + 8 + j) * 2 + 1] = sc;
          const bf16_t* kp = P + (r0 + row) * PP + C_KR; const float z0 = bf2f(kp[j]), z1 = bf2f(kp[8 + j]), z2 = bf2f(kp[16 + j]), z3 = bf2f(kp[24 + j]);
          KRo[row * 32 + j] = z0 * cr - z1 * sr; KRo[row * 32 + 8 + j] = z0 * sr + z1 * cr; KRo[row * 32 + 16 + j] = z2 * cc - z3 * sc; KRo[row * 32 + 24 + j] = z2 * sc + z3 * cc; }
        __builtin_amdgcn_sched_barrier(0);
        { f32x4 qa[4][3];
#pragma unroll
          for (int mt = 0; mt < 4; ++mt)
#pragma unroll
              for (int n = 0; n < 3; ++n) qa[mt][n] = (f32x4){0.f, 0.f, 0.f, 0.f};
          const bf16_t* wq = WUQT + ((size_t)l * 384 + 48 * w + fr) * 256 + 8 * fq;
#pragma unroll
          for (int ks = 0; ks < 8; ++ks) { bf16x8 a[4], bb[3];
#pragma unroll
              for (int mt = 0; mt < 4; ++mt) a[mt] = *(const LAS bf16x8*)(CQ + (16 * mt + fr) * CQP + 32 * ks + 8 * fq);
#pragma unroll
              for (int n = 0; n < 3; ++n) bb[n] = *(const bf16x8*)(wq + (size_t)(16 * n) * 256 + 32 * ks);
#pragma unroll
              for (int mt = 0; mt < 4; ++mt)
#pragma unroll
                  for (int n = 0; n < 3; ++n) qa[mt][n] = __builtin_amdgcn_mfma_f32_16x16x32_bf16(a[mt], bb[n], qa[mt][n], 0, 0, 0); }
          __syncthreads();
#pragma unroll
          for (int n = 0; n < 3; ++n) { const int nt = 3 * w + n, m6 = nt % 6, col = 16 * nt + fr;
#pragma unroll
              for (int mt = 0; mt < 4; ++mt)
#pragma unroll
                  for (int i = 0; i < 4; ++i) { const int row = 16 * mt + 4 * fq + i; float v = qa[mt][n][i] * RS[row * 2];
                      if (m6 >= 4) { const float pv = __shfl_xor(v, 8); const int ci = (row * 16 + (m6 == 5 ? 8 : 0) + (fr & 7)) * 2; const float c = CS[ci], s = CS[ci + 1]; v = (fr < 8) ? v * c - pv * s : pv * s + v * c; }
                      QS[row * QSP + col] = f2bf(v * C2); } } }
        __builtin_amdgcn_sched_barrier(0);
        { f32x4 ka[4][4];
#pragma unroll
          for (int mt = 0; mt < 4; ++mt)
#pragma unroll
              for (int n = 0; n < 4; ++n) ka[mt][n] = (f32x4){0.f, 0.f, 0.f, 0.f};
          const bf16_t* wk = WUKVT + ((size_t)l * 512 + 64 * w + fr) * 128 + 8 * fq;
#pragma unroll
          for (int ks = 0; ks < 4; ++ks) { bf16x8 a[4], bb[4];
#pragma unroll
              for (int mt = 0; mt < 4; ++mt) a[mt] = *(const LAS bf16x8*)(CK + (16 * mt + fr) * CKP + 32 * ks + 8 * fq);
#pragma unroll
              for (int n = 0; n < 4; ++n) bb[n] = *(const bf16x8*)(wk + (size_t)(16 * n) * 128 + 32 * ks);
#pragma unroll
              for (int mt = 0; mt < 4; ++mt)
#pragma unroll
                  for (int n = 0; n < 4; ++n) ka[mt][n] = __builtin_amdgcn_mfma_f32_16x16x32_bf16(a[mt], bb[n], ka[mt][n], 0, 0, 0); }
          const int head = w >> 1;
          if ((w & 1) == 0) {
#pragma unroll
              for (int n = 0; n < 4; ++n)
#pragma unroll
                  for (int mt = 0; mt < 4; ++mt)
#pragma unroll
                      for (int i = 0; i < 4; ++i) { const int row = 16 * mt + 4 * fq + i; KS[row * KSP + head * 64 + 16 * n + fr] = f2bf(ka[mt][n][i] * RS[row * 2 + 1]); }
          } else {
#pragma unroll
              for (int n = 0; n < 4; ++n)
#pragma unroll
                  for (int mt = 0; mt < 4; ++mt) { const int rb = 16 * mt + 4 * fq; u32x2 o; o.x = pk2(ka[mt][n][0] * RS[rb * 2 + 1], ka[mt][n][1] * RS[rb * 2 + 3]); o.y = pk2(ka[mt][n][2] * RS[rb * 2 + 5], ka[mt][n][3] * RS[rb * 2 + 7]);
                      *(u32x2*)(VTG + ((size_t)(b * 4 + head) * 64 + 16 * n + fr) * NPOS + pos0 + rb) = o; } } }
        __syncthreads();
#pragma unroll
        for (int i = 0; i < 6; ++i) { const int q = tid + 512 * i, row = q / 48, rem = q % 48, head = rem / 12, ch = rem % 12, pos = pos0 + row;
            const u32x4 qv = *(const LAS u32x4*)((const LAS unsigned char*)QS + row * (QSP * 2) + (head * 96 + ch * 8) * 2);
            if (!ctxt) *(u32x4*)(QL + ((size_t)(b * 4 + head) * SEQ + (pos - CTX)) * 96 + ch * 8) = qv; else if (l == 0) *(u32x4*)(QC + ((size_t)(b * 4 + head) * CTX + pos) * 96 + ch * 8) = qv;
            u32x4 kv;
            if (ch < 8) kv = *(const LAS u32x4*)((const LAS unsigned char*)KS + row * (KSP * 2) + (head * 64 + ch * 8) * 2);
            else { const LAS float* kr = KRo + row * 32 + (ch - 8) * 8; kv.x = pk2(kr[0], kr[1]); kv.y = pk2(kr[2], kr[3]); kv.z = pk2(kr[4], kr[5]); kv.w = pk2(kr[6], kr[7]); }
            *(u32x4*)(KB + ((size_t)(b * 4 + head) * NPOS + pos) * 96 + ch * 8) = kv; }
        if (!(ctxt && l == 1)) { const int lo = ctxt ? 0 : CTX, hi = ctxt ? CTX : NPOS;
#pragma unroll
            for (int i = 0; i < 4; ++i) { const int q = tid + 512 * i, row = q >> 5, ch = q & 31, pos = pos0 + row; float acc[8];
#pragma unroll
                for (int e = 0; e < 8; ++e) acc[e] = scb[ch * 8 + e];
#pragma unroll
                for (int k = 0; k < 3; ++k) { const int p = pos - 1 + k; if (p >= lo && p < hi) { const bf16_t* pr = P + ((size_t)b * NPOS + p) * PP; const u32x4 sx = *(const u32x4*)(pr + C_SX + ch * 8), sc = *(const u32x4*)(pr + C_SC + ch * 8);
#pragma unroll
                        for (int e = 0; e < 4; ++e) { const float w0 = scw[k * 256 + ch * 8 + 2 * e], w1 = scw[k * 256 + ch * 8 + 2 * e + 1];
                            acc[2 * e] += w0 * (__uint_as_float(sx[e] << 16) * __uint_as_float(sc[e] << 16)); acc[2 * e + 1] += w1 * (__uint_as_float(sx[e] & 0xffff0000u) * __uint_as_float(sc[e] & 0xffff0000u)); } } }
                const u32x4 sb = *(const u32x4*)(P + (r0 + row) * PP + C_SB + ch * 8); u32x4 o;
#pragma unroll
                for (int e = 0; e < 4; ++e) o[e] = pk2(__uint_as_float(sb[e] << 16) * acc[2 * e], __uint_as_float(sb[e] & 0xffff0000u) * acc[2 * e + 1]);
                *(u32x4*)(MIX + (r0 + row) * D + 768 + ch * 8) = o; } }
        __syncthreads();
    }
}
}

namespace lru {
constexpr int XP = 264, O_X = 0, O_NA = 33792, O_BB = 66560;
__device__ __forceinline__ float sigm(float x) { return __builtin_amdgcn_rcpf(1.f + __expf(-x)); }
__device__ __forceinline__ void chunk_units(LAS unsigned char* lds, int l, const bf16_t* P, const float* conv_w, const float* conv_b, const bf16_t* WAT, const bf16_t* WIT, const float* b_a, const float* b_i, const float* SPT,
                                            bf16_t* HL, bf16_t* AC, float* SUM, int u0, int u1, int ustep, int knob) {
    LAS bf16_t* X = (LAS bf16_t*)(lds + O_X); LAS bf16_t* NA = (LAS bf16_t*)(lds + O_NA); LAS bf16_t* BB = (LAS bf16_t*)(lds + O_BB);
    for (int unit = u0; unit < u1; unit += ustep) {
        int tid_l = threadIdx.x; asm volatile("" : "+v"(tid_l));
        const int tid = tid_l, lane = tid & 63, w = __builtin_amdgcn_readfirstlane(tid >> 6), fr = lane & 15, fq = lane >> 4;
        const int dir = unit & 1, bc = unit >> 1, b = bc / 68, chunk = bc % 68, pos0 = 64 * chunk; const int lo = chunk < 4 ? 0 : CTX, hi = chunk < 4 ? CTX : NPOS, left = dir ? 1 : 2;
        const size_t r0 = (size_t)b * NPOS + pos0; const int pd = (l * 2 + dir) * 256;
        if (!(knob & 1)) { const int cg = tid & 31, ts = tid >> 5, c0 = cg * 8; float wv[4][8], cbv[8];
#pragma unroll
          for (int e = 0; e < 8; ++e) { cbv[e] = conv_b[pd + c0 + e];
#pragma unroll
              for (int k = 0; k < 4; ++k) wv[k][e] = conv_w[(size_t)pd * 4 + k * 256 + c0 + e]; }
          const bf16_t* pc = P + (size_t)b * NPOS * PP + C_LX + c0; const int pb = pos0 + 4 * ts - left;
          u32x4 u[7];
#pragma unroll
          for (int i = 0; i < 7; ++i) { const int p = pb + i; const int pcl = p < lo ? lo : (p >= hi ? hi - 1 : p); u[i] = *(const u32x4*)(pc + (size_t)pcl * PP); if (p < lo || p >= hi) u[i] = (u32x4){0u, 0u, 0u, 0u}; }
#pragma unroll
          for (int i = 0; i < 4; ++i) { u32x4 o;
#pragma unroll
              for (int e2 = 0; e2 < 4; ++e2) { float lo_ = cbv[2 * e2], hi_ = cbv[2 * e2 + 1];
#pragma unroll
                  for (int k = 0; k < 4; ++k) { const unsigned d = u[i + k][e2]; lo_ += wv[k][2 * e2] * __uint_as_float(d << 16); hi_ += wv[k][2 * e2 + 1] * __uint_as_float(d & 0xffff0000u); }
                  o[e2] = pk2(lo_, hi_); }
              *(LAS u32x4*)(X + (4 * ts + i) * XP + c0) = o; } }
        __syncthreads();
        if (!(knob & 2)) { const int h = w >> 1, mh = w & 1;
          f32x4 ra[2][4], ri[2][4];
#pragma unroll
          for (int m = 0; m < 2; ++m)
#pragma unroll
              for (int n = 0; n < 4; ++n) { ra[m][n] = (f32x4){0.f, 0.f, 0.f, 0.f}; ri[m][n] = (f32x4){0.f, 0.f, 0.f, 0.f}; }
          const bf16_t* wa = WAT + ((size_t)((l * 2 + dir) * 4 + h) * 64 + fr) * 64 + 8 * fq; const bf16_t* wi = WIT + ((size_t)((l * 2 + dir) * 4 + h) * 64 + fr) * 64 + 8 * fq;
#pragma unroll
          for (int ks = 0; ks < 2; ++ks) { bf16x8 a[2], ba[4], bi[4];
#pragma unroll
              for (int m = 0; m < 2; ++m) a[m] = *(const LAS bf16x8*)(X + (16 * (2 * mh + m) + fr) * XP + 64 * h + 32 * ks + 8 * fq);
#pragma unroll
              for (int n = 0; n < 4; ++n) { ba[n] = *(const bf16x8*)(wa + (size_t)(16 * n) * 64 + 32 * ks); bi[n] = *(const bf16x8*)(wi + (size_t)(16 * n) * 64 + 32 * ks); }
#pragma unroll
              for (int m = 0; m < 2; ++m)
#pragma unroll
                  for (int n = 0; n < 4; ++n) { ra[m][n] = __builtin_amdgcn_mfma_f32_16x16x32_bf16(a[m], ba[n], ra[m][n], 0, 0, 0); ri[m][n] = __builtin_amdgcn_mfma_f32_16x16x32_bf16(a[m], bi[n], ri[m][n], 0, 0, 0); } }
#pragma unroll
          for (int n = 0; n < 4; ++n) { const int c = 64 * h + 16 * n + fr; const float bav = b_a[pd + c], biv = b_i[pd + c], sp8 = 8.f * SPT[pd + c];
#pragma unroll
              for (int m = 0; m < 2; ++m)
#pragma unroll
                  for (int i = 0; i < 4; ++i) { const int t = 16 * (2 * mh + m) + 4 * fq + i; const float r = sigm(ra[m][n][i] + bav), ig = sigm(ri[m][n][i] + biv);
                      const float x = r * sp8; const float na = x < 0.03125f ? x * (1.f - 0.5f * x * (1.f - 0.33333334f * x * (1.f - 0.25f * x))) : 1.f - __expf(-x); const float xv = bf2f(X[t * XP + c]);
                      NA[t * 256 + c] = f2bf(na); BB[t * 256 + c] = f2bf(__builtin_amdgcn_sqrtf(fmaxf(na * (2.f - na), 0.f)) * (ig * xv)); } } }
        __syncthreads();
        if (tid < 256 && !(knob & 4)) { const int c = tid; float hst = 0.f, A = 1.f;
            if (dir == 0) {
#pragma unroll 8
                for (int t = 0; t < 64; ++t) { const float a = 1.f - bf2f(NA[t * 256 + c]); hst = a * hst + bf2f(BB[t * 256 + c]); A *= a; BB[t * 256 + c] = f2bf(hst); NA[t * 256 + c] = f2bf(A); }
            } else {
#pragma unroll 8
                for (int t = 63; t >= 0; --t) { const float a = 1.f - bf2f(NA[t * 256 + c]); hst = a * hst + bf2f(BB[t * 256 + c]); A *= a; BB[t * 256 + c] = f2bf(hst); NA[t * 256 + c] = f2bf(A); }
            }
            float* sm = SUM + ((size_t)(dir * 4 + b) * 68 + chunk) * 512; sm[c] = A; sm[256 + c] = hst; }
        __syncthreads();
        if (!(knob & 4)) {
#pragma unroll
            for (int i = 0; i < 4; ++i) { const int q = tid + 512 * i, t = q >> 5, ch = q & 31; const size_t go = ((size_t)dir * MROWS + r0 + t) * 256 + ch * 8;
                *(u32x4*)(AC + go) = *(const LAS u32x4*)(NA + t * 256 + ch * 8); *(u32x4*)(HL + go) = *(const LAS u32x4*)(BB + t * 256 + ch * 8); } }
        __syncthreads();
    }
}
__device__ __forceinline__ void fixup_units(LAS unsigned char* lds, int l, const bf16_t* P, const bf16_t* HL, const bf16_t* AC, const float* SUM, bf16_t* MIX, int G, int bx) {
    LAS float* CAR = (LAS float*)lds;
    for (int unit = bx; unit < 272; unit += G) {
        int tid_l = threadIdx.x; asm volatile("" : "+v"(tid_l));
        const int tid = tid_l;
        const int b = unit / 68, chunk = unit % 68; if (l == 1 && chunk < 4) continue;
        { const int dir = tid >> 8, c = tid & 255; const float* sp = SUM + ((size_t)(dir * 4 + b) * 68) * 512 + c;
          const int n_pre = dir == 0 ? chunk : (chunk < 4 ? 3 - chunk : 4 + (67 - chunk));
          float cy = 0.f;
          for (int j0 = 0; j0 < n_pre; j0 += 16) { float av[16], hv[16];
#pragma unroll
              for (int u = 0; u < 16; ++u) { const int n = j0 + u < n_pre ? j0 + u : n_pre - 1; const int j = dir == 0 ? n : (n < 4 ? 3 - n : 71 - n); av[u] = sp[(size_t)j * 512]; hv[u] = sp[(size_t)j * 512 + 256]; }
#pragma unroll
              for (int u = 0; u < 16; ++u) cy = (j0 + u < n_pre) ? hv[u] + av[u] * cy : cy; }
          CAR[tid] = cy; }
        __syncthreads();
        { const int cg = tid & 31, ts = tid >> 5, c0 = cg * 8; float cf[8], cb[8];
#pragma unroll
          for (int e = 0; e < 8; ++e) { cf[e] = CAR[c0 + e]; cb[e] = CAR[256 + c0 + e]; }
          const size_t r0 = (size_t)b * NPOS + 64 * chunk + 4 * ts;
          u32x4 hf[4], af[4], hb[4], ab[4], gt[4];
#pragma unroll
          for (int i = 0; i < 4; ++i) { const size_t r = r0 + i; hf[i] = *(const u32x4*)(HL + r * 256 + c0); af[i] = *(const u32x4*)(AC + r * 256 + c0); hb[i] = *(const u32x4*)(HL + ((size_t)MROWS + r) * 256 + c0); ab[i] = *(const u32x4*)(AC + ((size_t)MROWS + r) * 256 + c0);
              gt[i] = *(const u32x4*)(P + r * PP + C_LG + c0); }
#pragma unroll
          for (int i = 0; i < 4; ++i) { u32x4 o;
#pragma unroll
              for (int e2 = 0; e2 < 4; ++e2) { float res[2];
#pragma unroll
                  for (int hh = 0; hh < 2; ++hh) { const int e = 2 * e2 + hh;
                      const float vhf = hh ? __uint_as_float(hf[i][e2] & 0xffff0000u) : __uint_as_float(hf[i][e2] << 16), vaf = hh ? __uint_as_float(af[i][e2] & 0xffff0000u) : __uint_as_float(af[i][e2] << 16);
                      const float vhb = hh ? __uint_as_float(hb[i][e2] & 0xffff0000u) : __uint_as_float(hb[i][e2] << 16), vab = hh ? __uint_as_float(ab[i][e2] & 0xffff0000u) : __uint_as_float(ab[i][e2] << 16);
                      const float x = hh ? __uint_as_float(gt[i][e2] & 0xffff0000u) : __uint_as_float(gt[i][e2] << 16);
                      const float hsum = (vhf + vaf * cf[e]) + (vhb + vab * cb[e]);
                      const float u = 0.7978845608028654f * (x + 0.044715f * x * x * x); const float th_ = 1.f - 2.f * __builtin_amdgcn_rcpf(1.f + __expf(2.f * u));
                      res[hh] = 0.5f * x * (1.f + th_) * hsum; }
                  o[e2] = pk2(res[0], res[1]); }
              *(u32x4*)(MIX + (r0 + i) * D + 256 + c0) = o; } }
        __syncthreads();
    }
}
}

namespace fft {
__device__ __forceinline__ void ctx_a(LAS unsigned char* lds, const bf16_t* P, const float* TABC, const float* TABS, bf16_t* XCT, int G, int bx) {
    LAS bf16_t* U = (LAS bf16_t*)(lds + O_U); LAS bf16_t* X = (LAS bf16_t*)(lds + O_X);
    for (int unit = bx; unit < 16; unit += G) {
        int tid_l = threadIdx.x; asm volatile("" : "+v"(tid_l));
        const int tid = tid_l, lane = tid & 63, w = __builtin_amdgcn_readfirstlane(tid >> 6), fr = lane & 15, fq = lane >> 4;
        build_tables(lds, TABC, TABS, tid);
        const LAS bf16_t* Tc = (const LAS bf16_t*)(lds + O_TC); const LAS bf16_t* Ts = (const LAS bf16_t*)(lds + O_TS);
        const int b = unit >> 2, q = unit & 3;
#pragma unroll
        for (int i = 0; i < 4; ++i) { const int qq = tid + 512 * i, t1 = qq >> 5, ch = qq & 31;
            *(LAS u32x4*)((LAS unsigned char*)U + t1 * (UP * 2) + ch * 16) = *(const u32x4*)(P + ((size_t)b * NPOS + 64 * q + t1) * PP + ch * 8); }
        __syncthreads();
        { const int g = w >> 1, part = w & 1; const LAS bf16_t* T = part ? Ts : Tc;
          f32x4 acc[4][4];
#pragma unroll
          for (int mt = 0; mt < 4; ++mt)
#pragma unroll
              for (int nt = 0; nt < 4; ++nt) acc[mt][nt] = (f32x4){0.f, 0.f, 0.f, 0.f};
#pragma unroll
          for (int ks = 0; ks < 2; ++ks) { bf16x8 a[4], bb[4];
#pragma unroll
              for (int mt = 0; mt < 4; ++mt) a[mt] = *(const LAS bf16x8*)(U + (16 * mt + fr) * UP + g * 64 + 32 * ks + 8 * fq);
#pragma unroll
              for (int nt = 0; nt < 4; ++nt) bb[nt] = *(const LAS bf16x8*)(T + (16 * nt + fr) * TP + 32 * ks + 8 * fq);
#pragma unroll
              for (int mt = 0; mt < 4; ++mt)
#pragma unroll
                  for (int nt = 0; nt < 4; ++nt) acc[mt][nt] = __builtin_amdgcn_mfma_f32_16x16x32_bf16(a[mt], bb[nt], acc[mt][nt], 0, 0, 0); }
          const float sg = part ? -1.f : 1.f;
#pragma unroll
          for (int mt = 0; mt < 4; ++mt)
#pragma unroll
              for (int nt = 0; nt < 4; ++nt) { const f32x4 v = acc[mt][nt] * sg; u32x2 o; o.x = pk2(v[0], v[1]); o.y = pk2(v[2], v[3]);
                  *(LAS u32x2*)(X + (part * 256 + g * 64 + 16 * nt + fr) * TP + 16 * mt + 4 * fq) = o; } }
        __syncthreads();
#pragma unroll
        for (int i = 0; i < 8; ++i) { const int qq = tid + 512 * i, row = qq >> 3, c8 = qq & 7;
            *(u32x4*)(XCT + (((size_t)b * 4 + q) * 512 + row) * 64 + c8 * 8) = *(const LAS u32x4*)((const LAS unsigned char*)X + row * (TP * 2) + c8 * 16); }
        __syncthreads();
    }
}
__device__ __forceinline__ void ctx_b(LAS unsigned char* lds, const bf16_t* XCT, const float* TABC, const float* TABS, bf16_t* MIX, int G, int bx) {
    LAS bf16_t* Tc = (LAS bf16_t*)(lds + O_TC); LAS bf16_t* Ts = (LAS bf16_t*)(lds + O_TS);
    LAS bf16_t* Ys = (LAS bf16_t*)(lds + O_U); LAS bf16_t* ZT = (LAS bf16_t*)(lds + O_X);
    for (int unit = bx; unit < 16; unit += G) {
        int tid_l = threadIdx.x; asm volatile("" : "+v"(tid_l));
        const int tid = tid_l, lane = tid & 63, w = __builtin_amdgcn_readfirstlane(tid >> 6), fr = lane & 15, fq = lane >> 4;
        const int b = unit >> 2, ft = unit & 3;
        f32x4 y[4][2];
#pragma unroll
        for (int mt = 0; mt < 4; ++mt)
#pragma unroll
            for (int n = 0; n < 2; ++n) y[mt][n] = (f32x4){0.f, 0.f, 0.f, 0.f};
        for (int q = 0; q < 4; ++q) {
            for (int i = tid; i < 4096; i += 512) { const int fl = i >> 6, tl = i & 63, ix = (((64 * ft + fl) * (64 * q + tl)) & 255) * 16; Tc[fl * TP + tl] = f2bf(TABC[ix]); Ts[fl * TP + tl] = f2bf(TABS[ix]); }
#pragma unroll
            for (int i = 0; i < 8; ++i) { const int qq = tid + 512 * i, row = qq >> 3, c8 = qq & 7;
                *(LAS u32x4*)((LAS unsigned char*)ZT + row * (TP * 2) + c8 * 16) = *(const u32x4*)(XCT + (((size_t)b * 4 + q) * 512 + row) * 64 + c8 * 8); }
            __syncthreads();
#pragma unroll
            for (int ks = 0; ks < 2; ++ks) { bf16x8 xr[2], xi[2];
#pragma unroll
                for (int n = 0; n < 2; ++n) { xr[n] = *(const LAS bf16x8*)(ZT + (32 * w + 16 * n + fr) * TP + 32 * ks + 8 * fq); xi[n] = *(const LAS bf16x8*)(ZT + (256 + 32 * w + 16 * n + fr) * TP + 32 * ks + 8 * fq); }
#pragma unroll
                for (int mt = 0; mt < 4; ++mt) { const bf16x8 c = *(const LAS bf16x8*)(Tc + (16 * mt + fr) * TP + 32 * ks + 8 * fq), s = *(const LAS bf16x8*)(Ts + (16 * mt + fr) * TP + 32 * ks + 8 * fq);
#pragma unroll
                    for (int n = 0; n < 2; ++n) { y[mt][n] = __builtin_amdgcn_mfma_f32_16x16x32_bf16(c, xr[n], y[mt][n], 0, 0, 0); y[mt][n] = __builtin_amdgcn_mfma_f32_16x16x32_bf16(s, xi[n], y[mt][n], 0, 0, 0); } } }
            __syncthreads();
        }
#pragma unroll
        for (int mt = 0; mt < 4; ++mt)
#pragma unroll
            for (int i = 0; i < 4; ++i)
#pragma unroll
                for (int n = 0; n < 2; ++n) Ys[(16 * mt + 4 * fq + i) * UP + 32 * w + 16 * n + fr] = f2bf(y[mt][n][i] * (1.f / 128.f));
        __syncthreads();
#pragma unroll
        for (int i = 0; i < 4; ++i) { const int qq = tid + 512 * i, fl = qq >> 5, ch = qq & 31;
            *(u32x4*)(MIX + ((size_t)b * NPOS + 64 * ft + fl) * D + ch * 8) = *(const LAS u32x4*)((const LAS unsigned char*)Ys + fl * (UP * 2) + ch * 16); }
        __syncthreads();
    }
}
}

constexpr int NWAVES = 8, RING_BYTES = 131072 + 3072, LDSCTL_OFF = RING_BYTES, MISC_OFF = LDSCTL_OFF + 64, META_OFF = MISC_OFF + 64, LDS_BYTES = 147456;
enum { PH_PRO0 = 0, PH_PRO1 = 1, PH_L0 = 2, PH_PER_LAYER = 8, PH_N = 18 };
enum { PL_WIN = 0, PL_PREP = 1, PL_MIX = 2, PL_WOUT = 3, PL_ROUTE = 4, PL_MOE1 = 5, PL_MOE2 = 6, PL_COMB = 7 };
struct MArgs { const float* in[30]; float* out; unsigned char* ws; int npass, skip_mask, dup_ph, dup_n, dup_sub, knob; };

__device__ __forceinline__ void transpose_item(const float* W, int K, int N, bf16_t* WT, int drow0, LAS float* scr, int k0, int n0, int lane) {
    const int kr = lane >> 3, nc = (lane & 7) * 4;
    f32x4 v[8];
#pragma unroll
    for (int i = 0; i < 8; ++i) v[i] = __builtin_nontemporal_load((const f32x4*)(W + (size_t)(k0 + kr + 8 * i) * N + n0 + nc));
#pragma unroll
    for (int i = 0; i < 8; ++i) { LAS float* d = scr + (kr + 8 * i) * 33 + nc; d[0] = v[i][0]; d[1] = v[i][1]; d[2] = v[i][2]; d[3] = v[i][3]; }
    asm volatile("s_waitcnt lgkmcnt(0)" ::: "memory");
    const int c = lane & 7;
#pragma unroll
    for (int j = 0; j < 4; ++j) { const int n = (lane >> 3) + 8 * j; const LAS float* s = scr + (8 * c) * 33 + n;
        u32x4 o; o.x = pk2(s[0 * 33], s[1 * 33]); o.y = pk2(s[2 * 33], s[3 * 33]); o.z = pk2(s[4 * 33], s[5 * 33]); o.w = pk2(s[6 * 33], s[7 * 33]);
        *(u32x4*)(WT + (size_t)(drow0 + n) * K + k0 + 8 * c) = o; }
    asm volatile("s_waitcnt lgkmcnt(0)" ::: "memory");
}

constexpr int I_GU = NE * 16 * 64, I_DN = NE * 16 * 32, I_EXP = I_GU + I_DN;
__device__ __forceinline__ void expert_item(int l, int j, const float* wgu, const float* wdn, unsigned char* ws, LAS float* scr, int lane) {
    if (j < I_GU) { const int e = j / (16 * 64), q = j % (16 * 64), kb = q / 64, nb = q % 64; const int n0 = 32 * nb; const int c2 = n0 & 1023; const int drow = (c2 >> 7) * 256 + (n0 >> 10) * 128 + (c2 & 127);
        transpose_item(wgu + ((size_t)l * NE + e) * D * 2048, D, 2048, (bf16_t*)(ws + L::WGUT) + ((size_t)l * NE + e) * 2048 * D, drow, scr, 64 * kb, n0, lane); }
    else { const int r = j - I_GU; const int e = r / (16 * 32), q = r % (16 * 32), kb = q / 32, nb = q % 32;
        transpose_item(wdn + ((size_t)l * NE + e) * D * D, D, D, (bf16_t*)(ws + L::WDT) + ((size_t)l * NE + e) * D * D, 32 * nb, scr, 64 * kb, 32 * nb, lane); }
}
constexpr int Q_WIN = 48, Q_WOUT = 96, Q_MOE2 = 0;
constexpr int DEF_WIN = 224 * Q_WIN, DEF0 = DEF_WIN + 240 * Q_WOUT, DEF_MOE2 = 128 * Q_MOE2, DEF1 = DEF_MOE2 + 224 * Q_WIN;
__device__ __forceinline__ void deferred_items(int l, int first, int count, const float* wgu, const float* wdn, unsigned char* ws, LAS unsigned char* lds, int wave, int lane) {
    LAS float* scr = (LAS float*)(lds + wave * 16384);
    for (int j = first + wave; j < first + count; j += NWAVES) expert_item(l, j, wgu, wdn, ws, scr, lane);
}

#define GASP __attribute__((address_space(1)))
#define ARG_IN(i) ({ const GASP float* _p; asm volatile("s_load_dwordx2 %0, %1, %2\n\ts_waitcnt lgkmcnt(0)" : "=s"(_p) : "s"(__builtin_amdgcn_kernarg_segment_ptr()), "n"((i) * 8)); (const float*)_p; })
__global__ void __launch_bounds__(NWAVES * 64, 2) mega(MArgs args) {
    extern __shared__ __attribute__((aligned(16))) unsigned char lds_raw[];
    const int G0 = gridDim.x, bx0 = blockIdx.x;
    unsigned char* ws0 = args.ws;
    unsigned* ctl0 = (unsigned*)(ws0 + L::CTL);
    for (int u = threadIdx.x; u < (LDS_BYTES - LDSCTL_OFF) / 4; u += NWAVES * 64) ((LAS unsigned*)(lds_raw + LDSCTL_OFF))[u] = 0u;
    __syncthreads();
    volatile LAS unsigned* MISC = (volatile LAS unsigned*)((LAS unsigned char*)lds_raw + MISC_OFF);
    XcdBarrier bar = xcd_barrier_post(ctl0 + L::CW_BAR, MISC);
    const int lo = 0, hi = PH_N;

    bool first = true;
    for (int pass = 0; pass < args.npass; ++pass)
    for (int ph = lo; ph < hi; ++ph) {
      const int reps = (ph == args.dup_ph) ? 1 + args.dup_n : 1;
      for (int rep = 0; rep < reps; ++rep) {
        if (!first) xcd_barrier(bar);
        first = false;
        if (pass + 1 < args.npass && ((args.skip_mask >> ph) & 1)) continue;
        const int sub = rep + 1 < reps ? args.dup_sub : 15; const int knob = rep + 1 < reps ? args.knob : 0; (void)knob;
        GASP unsigned char* wsg = (GASP unsigned char*)args.ws; asm volatile("" : "+s"(wsg)); unsigned char* ws = (unsigned char*)wsg;
        unsigned* ctl = (unsigned*)(ws + L::CTL);
        int tid_p = threadIdx.x; asm volatile("" : "+v"(tid_p));
        int G = G0, bx = bx0; asm volatile("" : "+s"(G), "+s"(bx));
        const int vcu = (G % 8 == 0) ? (bx % 8) * (G / 8) + bx / 8 : bx; (void)vcu;
        unsigned ldsb = 0; asm volatile("" : "+s"(ldsb)); LAS unsigned char* lds = (LAS unsigned char*)lds_raw + ldsb;
        LAS int* META = (LAS int*)(lds + META_OFF);
        const int tid = tid_p, lane = tid & 63, wave = __builtin_amdgcn_readfirstlane(tid >> 6); (void)lane; (void)wave;
        if (ph == PH_PRO0) {
            if (bx == 0 && tid < 2 * NE) ((int*)(ctl + L::CW_CNT))[tid * L::CNT_STRIDE] = 0;
            LAS float* scr = (LAS float*)(lds + wave * 16384);
            const int gw = vcu * NWAVES + wave, NGW = G * NWAVES;
            constexpr int I_IN = 16 * 61, I_OUT = 16 * 32, I_D = I_IN + I_OUT; const int d0 = G == 256 ? DEF0 : 0, d1 = G == 256 ? DEF1 : 0, R0 = I_EXP - d0, R1 = I_EXP - d1;
            for (int it = gw; it < 2 * I_D + R0 + R1; it += NGW) {
                if (it < 2 * I_D) { const int l = it / I_D; int r = it % I_D;
                    if (r < I_IN) { const int kb = r / 61, nb = r % 61; transpose_item(ARG_IN(8) + (size_t)l * D * PT, D, PT, (bf16_t*)(ws + L::WINT) + (size_t)l * 2048 * D, 32 * nb, scr, 64 * kb, 32 * nb, lane); }
                    else { r -= I_IN; const int kb = r / 32, nb = r % 32; transpose_item(ARG_IN(22) + (size_t)l * D * D, D, D, (bf16_t*)(ws + L::WOUTT) + (size_t)l * D * D, 32 * nb, scr, 64 * kb, 32 * nb, lane); }
                } else { const int r = it - 2 * I_D; if (r < R0) expert_item(0, d0 + r, ARG_IN(25), ARG_IN(27), ws, scr, lane); else expert_item(1, d1 + (r - R0), ARG_IN(25), ARG_IN(27), ws, scr, lane); }
            }
            sm::smallw_phase(ARG_IN(17), ARG_IN(16), ARG_IN(19), ARG_IN(18), ARG_IN(11), ARG_IN(13), (bf16_t*)(ws + L::WUQT), (bf16_t*)(ws + L::WUKVT), (bf16_t*)(ws + L::WAT), (bf16_t*)(ws + L::WIT),
                             (float*)(ws + L::TABC), (float*)(ws + L::TABS), ARG_IN(15), (float*)(ws + L::SPT), bx * 512 + tid, G * 512);
            __syncthreads();
            sm::mod_phase(lds, ARG_IN(1), ARG_IN(3), ARG_IN(4), ARG_IN(5), (float*)(ws + L::MOD), G, bx, tid);
            for (int i = bx * 512 + tid; i < 2 * 96 * D / 8; i += G * 512) { const int l = i / (96 * D / 8), q = i % (96 * D / 8); *(u32x4*)((bf16_t*)(ws + L::WINT) + ((size_t)l * 2048 + PT) * D + (size_t)q * 8) = (u32x4){0u, 0u, 0u, 0u}; }
            continue;
        }
        if (ph == PH_PRO1) { sm::pro1_phase(ARG_IN(0), ARG_IN(2), ARG_IN(6), (const float*)(ws + L::MOD), (float*)(ws + L::H), (bf16_t*)(ws + L::XN), bx * NWAVES + wave, G * NWAVES, lane); continue; }
        if (ph < PH_L0) continue;
        const int l = (ph - PH_L0) / PH_PER_LAYER, pl = (ph - PH_L0) % PH_PER_LAYER;
        const float* MODl = (const float*)(ws + L::MOD) + (size_t)l * 5 * 6144;
        if (pl == PL_WIN) {
            g8::DenseSched S; S.init(MROWS / 256, PP / 256, G, bx, 0, (const bf16_t*)(ws + L::WINT) + (size_t)l * 2048 * D, D);
            g8::EpiP E{(bf16_t*)(ws + L::P)};
            g8::gemm_phase<g8::EpiP, g8::DenseSched, false, false>(lds, (const char*)(ws + L::XN), S, E);
            if (G == 256 && bx >= 32) deferred_items(l, (l == 0 ? 0 : DEF_MOE2) + (bx - 32) * Q_WIN, Q_WIN, ARG_IN(25), ARG_IN(27), ws, lds, wave, lane);
        } else if (pl == PL_PREP) {
            if (l == 0 && (sub & 2)) { fft::ctx_a(lds, (const bf16_t*)(ws + L::P), (const float*)(ws + L::TABC), (const float*)(ws + L::TABS), (bf16_t*)(ws + L::XCT), G, G - 1 - bx); __syncthreads(); }
            for (int p = 0; p * G < 1072; ++p) {
                const int k = p * G + ((p & 1) ? G - 1 - bx : bx);
                if (k >= 1072) continue;
                if (k < 272) { if (sub & 4) prep::qkv_units(lds, l, (const bf16_t*)(ws + L::P), (const bf16_t*)(ws + L::WUQT), (const bf16_t*)(ws + L::WUKVT), ARG_IN(20) + l * 768, ARG_IN(21) + l * 256,
                            (bf16_t*)(ws + L::QL), (bf16_t*)(ws + L::QC), (bf16_t*)(ws + L::KB), (bf16_t*)(ws + L::VTG), (bf16_t*)(ws + L::MIX), k, k + 1, 1); }
                else if (k < 816) { if (sub & 8) lru::chunk_units(lds, l, (const bf16_t*)(ws + L::P), ARG_IN(9), ARG_IN(10), (const bf16_t*)(ws + L::WAT), (const bf16_t*)(ws + L::WIT), ARG_IN(12), ARG_IN(14), (const float*)(ws + L::SPT),
                             (bf16_t*)(ws + L::HL), (bf16_t*)(ws + L::AC), (float*)(ws + L::SUM), k - 272, k - 271, 1, knob); }
                else { if (sub & 1) fft::stage_a(lds, (const bf16_t*)(ws + L::P), (const float*)(ws + L::TABC), (const float*)(ws + L::TABS), (bf16_t*)(ws + L::ZBUF), k - 816, k - 815, 1); }
                __syncthreads();
            }
        } else if (pl == PL_MIX) {
            if (sub & 1) lru::fixup_units(lds, l, (const bf16_t*)(ws + L::P), (const bf16_t*)(ws + L::HL), (const bf16_t*)(ws + L::AC), (const float*)(ws + L::SUM), (bf16_t*)(ws + L::MIX), G, bx);
            if (sub & 2) fft::stage_b(lds, (const bf16_t*)(ws + L::ZBUF), (const float*)(ws + L::TABC), (const float*)(ws + L::TABS), (bf16_t*)(ws + L::MIX), G, bx);
            __syncthreads();
            if (l == 0 && (sub & 4)) { fft::ctx_b(lds, (const bf16_t*)(ws + L::XCT), (const float*)(ws + L::TABC), (const float*)(ws + L::TABS), (bf16_t*)(ws + L::MIX), G, G - 1 - bx); __syncthreads(); }
            if (sub & 8) attn::attn_phase(lds, (const bf16_t*)(ws + L::QL), (const bf16_t*)(ws + L::QC), (const bf16_t*)(ws + L::KB), (const bf16_t*)(ws + L::VTG), (bf16_t*)(ws + L::MIX), l == 0 ? 1 : 0, G, vcu);
        } else if (pl == PL_WOUT) {
            g8::DenseSched S; S.init(l == 0 ? MROWS / 256 : 64, D / 256, G, bx, l == 0 ? 0 : 1, (const bf16_t*)(ws + L::WOUTT) + (size_t)l * D * D, D);
            g8::EpiH E{(float*)(ws + L::H), MODl, 2048};
            g8::gemm_phase<g8::EpiH, g8::DenseSched, false, false>(lds, (const char*)(ws + L::MIX), S, E);
            if (G == 256 && l == 0 && bx >= 16) deferred_items(0, DEF_WIN + (bx - 16) * Q_WOUT, Q_WOUT, ARG_IN(25), ARG_IN(27), ws, lds, wave, lane);
        } else if (pl == PL_ROUTE) {
            sm::route_phase(lds, l, (const float*)(ws + L::H), ARG_IN(7) + l * D, MODl, ARG_IN(23) + (size_t)l * D * NE, ARG_IN(24) + l * NE, (bf16_t*)(ws + L::XN), (int*)(ctl + L::CW_CNT) + l * NE * L::CNT_STRIDE,
                            (int*)(ws + L::LIST) + (size_t)l * NE * LCAP, (float*)(ws + L::GATE), G, bx, tid);
        } else if (pl == PL_COMB) {
            sm::comb_phase(l, (float*)(ws + L::H), (const bf16_t*)(ws + L::Y), MODl, ARG_IN(6) + D, (const float*)(ws + L::MOD) + (size_t)5 * 6144, (bf16_t*)(ws + L::XN), ARG_IN(29), args.out, bx * NWAVES + wave, G * NWAVES, lane);
        } else if (pl == PL_MOE1 || pl == PL_MOE2) {
            const int* CNTg = (const int*)(ctl + L::CW_CNT) + l * NE * L::CNT_STRIDE;
            if (tid == 0) { int o = 0; for (int e = 0; e < NE; ++e) { const int cn = CNTg[e * L::CNT_STRIDE]; META[e] = o; META[64 + e] = cn; o += (cn + 255) >> 8; } META[NE] = o; }
            __syncthreads();
            g8::MoeSched S; S.tpre = META; S.cnt = META + 64; S.G = G; S.c = bx; S.K = D; S.list = (const int*)(ws + L::LIST) + (size_t)l * NE * LCAP;
            if (pl == PL_MOE1) {
                S.NT = 8; S.COLW = 128; S.total = __builtin_amdgcn_readfirstlane(META[NE]) * 8; S.Bt = (const char*)((const bf16_t*)(ws + L::WGUT) + (size_t)l * NE * 2048 * D);
                g8::EpiMoe1 E{(bf16_t*)(ws + L::ACT), ARG_IN(26) + (size_t)l * NE * 2048};
                g8::gemm_phase<g8::EpiMoe1, g8::MoeSched, true, true>(lds, (const char*)(ws + L::XN), S, E);
            } else {
                S.NT = 4; S.COLW = 256; S.total = __builtin_amdgcn_readfirstlane(META[NE]) * 4; S.Bt = (const char*)((const bf16_t*)(ws + L::WDT) + (size_t)l * NE * D * D);
                g8::EpiMoe2 E{(bf16_t*)(ws + L::Y), ARG_IN(28) + (size_t)l * NE * D, (const float*)(ws + L::GATE)};
                g8::gemm_phase<g8::EpiMoe2, g8::MoeSched, false, true>(lds, (const char*)(ws + L::ACT), S, E);
                if (G == 256 && l == 0 && bx >= 128) deferred_items(1, (bx - 128) * Q_MOE2, Q_MOE2, ARG_IN(25), ARG_IN(27), ws, lds, wave, lane);
            }
            __syncthreads();
        }
      }
    }
}
constexpr int PROBE_DUP_PH = -1, PROBE_DUP_N = 0, PROBE_DUP_SUB = 15, PROBE_KNOB = 0;
constexpr int PROBE_NPASS = 1, PROBE_SKIP = 0;
extern "C" void kernel_launch(void* const* d_in, const int* in_sizes, int n_in, void* d_out, int out_size, void* d_ws, size_t ws_size, hipStream_t stream) {
    static int grid = 0;
    if (grid == 0) {
        if (n_in != 30 || out_size != NB_ * SEQ * D || (size_t)L::END > ws_size) { fprintf(stderr, "kernel_launch: unexpected problem shape (n_in %d, out %d) or workspace too small (need %zu, have %zu); nothing launched\n", n_in, out_size, (size_t)L::END, ws_size); grid = -1; return; }
        int dev = 0, cus = 0;
        if (hipGetDevice(&dev) != hipSuccess || hipDeviceGetAttribute(&cus, hipDeviceAttributeMultiprocessorCount, dev) != hipSuccess) { fprintf(stderr, "kernel_launch: device query failed\n"); grid = -1; return; }
        if (hipFuncSetAttribute((const void*)mega, hipFuncAttributeMaxDynamicSharedMemorySize, LDS_BYTES) != hipSuccess) { fprintf(stderr, "kernel_launch: hipFuncSetAttribute failed\n"); grid = -1; return; }
        grid = cus < 256 ? cus : 256;
    }
    if (grid < 0) return;
    unsigned char* p = (unsigned char*)d_ws;
    (void)hipMemsetAsync(p + L::CTL, 0, L::CTL_BYTES, stream);
    MArgs a{};
    for (int i = 0; i < 30; ++i) a.in[i] = (const float*)d_in[i];
    a.out = (float*)d_out; a.ws = p; a.npass = PROBE_NPASS; a.skip_mask = PROBE_SKIP; a.dup_ph = PROBE_DUP_PH; a.dup_n = PROBE_DUP_N; a.dup_sub = PROBE_DUP_SUB; a.knob = PROBE_KNOB;
    hipLaunchKernelGGL(mega, dim3(grid), dim3(NWAVES * 64), LDS_BYTES, stream, a);
}
```

```cpp
#include <hip/hip_runtime.h>
#include <cstdint>
#include <cstdio>

typedef unsigned short bf16_t;
constexpr int NB_ = 4, SEQ = 4096, CTX = 256, D = 1024, NPOS = SEQ + CTX, MROWS = NB_ * NPOS;
constexpr int PT = 1952, PP = 2048;
constexpr int NE = 32, TOPK = 4, LCAP = MROWS;
constexpr int NASG = MROWS * TOPK;
constexpr int ACT_ROWS = NASG + NE * 256;
constexpr int C_FN = 0, C_LX = 256, C_LG = 512, C_CQ = 768, C_CKV = 1024, C_KR = 1152, C_SX = 1184, C_SB = 1440, C_SC = 1696;

__device__ __forceinline__ float bf2f(bf16_t v) { return __uint_as_float((unsigned)v << 16); }
__device__ __forceinline__ bf16_t f2bf(float f) { unsigned u = __float_as_uint(f); return (bf16_t)((u + 0x7fffu + ((u >> 16) & 1u)) >> 16); }
__device__ __forceinline__ float wave_sum(float v) {
#pragma unroll
    for (int o = 1; o < 64; o <<= 1) v += __shfl_xor(v, o);
    return v;
}
__device__ __forceinline__ float sigmoidf_(float x) { return 1.f / (1.f + __expf(-x)); }
__device__ __forceinline__ float gelu_tanh(float x) { const float u = 0.7978845608028654f * (x + 0.044715f * x * x * x); return 0.5f * x * (1.f + tanhf(u)); }

#define LAS __attribute__((address_space(3)))
typedef short bf16x8 __attribute__((ext_vector_type(8)));
typedef float f32x4 __attribute__((ext_vector_type(4)));
typedef unsigned u32x4 __attribute__((ext_vector_type(4)));
typedef unsigned u32x2 __attribute__((ext_vector_type(2)));
__device__ __forceinline__ unsigned pk2(float lo, float hi) { return (unsigned)f2bf(lo) | ((unsigned)f2bf(hi) << 16); }

namespace L {
constexpr size_t A256(size_t x) { return (x + 255) & ~(size_t)255; }
constexpr size_t CTL = 0, CTL_BYTES = 1u << 20;
constexpr size_t H = CTL + CTL_BYTES;
constexpr size_t MOD = CTL + 512 * 1024;
constexpr size_t TABC = A256(H + (size_t)MROWS * D * 4);
constexpr size_t TABS = A256(TABC + 4096 * 4);
constexpr size_t XN = A256(TABS + 4096 * 4);
constexpr size_t P = A256(XN + (size_t)MROWS * D * 2);
constexpr size_t MIX = A256(P + (size_t)MROWS * PP * 2);
constexpr size_t CQN = A256(MIX + (size_t)MROWS * D * 2);
constexpr size_t CKVN = A256(CQN + (size_t)MROWS * 256 * 2);
constexpr size_t QRAW = A256(CKVN + (size_t)MROWS * 128 * 2);
constexpr size_t KVRAW = A256(QRAW + (size_t)MROWS * 384 * 4);
constexpr size_t QL = A256(KVRAW + (size_t)MROWS * 512 * 4);
constexpr size_t QC = A256(QL + (size_t)16 * SEQ * 96 * 2);
constexpr size_t KB = A256(QC + (size_t)16 * CTX * 96 * 2);
constexpr size_t VB = A256(KB + (size_t)16 * NPOS * 96 * 2);
constexpr size_t LA = A256(VB + (size_t)16 * NPOS * 64 * 2);
constexpr size_t LB = A256(LA + (size_t)2 * MROWS * 256 * 4);
constexpr size_t HS = A256(LB + (size_t)2 * MROWS * 256 * 4);
constexpr size_t XCS = A256(HS + (size_t)2 * MROWS * 256 * 4);
constexpr size_t XCSC = A256(XCS + (size_t)4 * 8192 * 256 * 4);
constexpr size_t LIST = A256(XCSC + (size_t)4 * 512 * 256 * 4);
constexpr size_t GATE = A256(LIST + (size_t)2 * NE * LCAP * 4);
constexpr size_t ACT = A256(GATE + (size_t)NASG * 4);
constexpr size_t Y = A256(ACT + (size_t)ACT_ROWS * D * 2);
constexpr size_t WINT = A256(Y + (size_t)NASG * D * 2);
constexpr size_t WOUTT = A256(WINT + (size_t)2 * 2048 * 1024 * 2);
constexpr size_t WGUT = A256(WOUTT + (size_t)2 * 1024 * 1024 * 2);
constexpr size_t WDT = A256(WGUT + (size_t)2 * NE * 2048 * 1024 * 2);
constexpr size_t ZBUF = A256(WDT + (size_t)2 * NE * 1024 * 1024 * 2);
constexpr size_t VTG = A256(ZBUF + (size_t)4 * 64 * 64 * 512 * 2);
constexpr size_t WUQT = A256(VTG + (size_t)16 * 64 * NPOS * 2);
constexpr size_t WUKVT = A256(WUQT + (size_t)2 * 384 * 256 * 2);
constexpr size_t WAT = A256(WUKVT + (size_t)2 * 512 * 128 * 2);
constexpr size_t WIT = A256(WAT + (size_t)16 * 4096 * 2);
constexpr size_t SPT = A256(WIT + (size_t)16 * 4096 * 2);
constexpr size_t RWH = A256(SPT + (size_t)1024 * 4);
constexpr size_t RWL = A256(RWH + (size_t)2 * NE * D * 2);
constexpr size_t HL = A256(RWL + (size_t)2 * NE * D * 2);
constexpr size_t AC = A256(HL + (size_t)2 * MROWS * 256 * 2);
constexpr size_t SUM = A256(AC + (size_t)2 * MROWS * 256 * 2);
constexpr size_t XCT = A256(SUM + (size_t)2 * 4 * 68 * 512 * 4);
constexpr size_t END = A256(XCT + (size_t)16 * 512 * 64 * 2);
constexpr int CW_BAR = 4096;
constexpr int CW_CNT = 32768, CNT_STRIDE = 64;
}

#define XB_TMO      128
#define XB_XCNT(j)  (256  + 64 * (j))
#define XB_XSUB(j)  (1280 + 64 * (j))
#define XB_XGEN(j)  (2304 + 64 * (j))
#define XB_TOP      3328
#define XB_TOPGEN   3392
#define XCD_BAR_WORDS 3456
#define XB_SPIN_CAP (1u << 18)
__device__ __forceinline__ unsigned xb_ld(unsigned* p)              { return __hip_atomic_load(p, __ATOMIC_RELAXED, __HIP_MEMORY_SCOPE_AGENT); }
__device__ __forceinline__ unsigned xb_add(unsigned* p, unsigned v) { return __hip_atomic_fetch_add(p, v, __ATOMIC_RELAXED, __HIP_MEMORY_SCOPE_AGENT); }
__device__ __forceinline__ unsigned xb_xcc_id() { return (unsigned)__builtin_amdgcn_s_getreg((3 << 11) | 20) & 0xFu; }
#define XB_SPIN(cond, bar) do { unsigned _sp = 0; while (cond) { __builtin_amdgcn_s_sleep(1); \
    if ((++_sp & 255u) == 0u) { if (xb_ld(&(bar)[XB_TMO])) break; if (_sp > XB_SPIN_CAP) { atomicAdd(&(bar)[XB_TMO], 1u); break; } } } } while (0)
struct XcdBarrier { unsigned* bar; unsigned x; volatile LAS unsigned* st; };
__device__ __forceinline__ XcdBarrier xcd_barrier_post(unsigned* bar, volatile LAS unsigned* st) {
    XcdBarrier b; b.bar = bar; b.x = xb_xcc_id(); b.st = st;
    if (threadIdx.x == 0) (void)xb_add(&bar[XB_XCNT(b.x)], 1u);
    return b;
}
__device__ __forceinline__ void xcd_barrier_complete(unsigned* bar, unsigned x, unsigned& nloc, unsigned& nx) {
    const unsigned G = gridDim.x * gridDim.y * gridDim.z;
    unsigned sum, cnt, mine, sp = 0u;
    for (;;) {
        sum = 0u; cnt = 0u; mine = 0u;
#pragma unroll
        for (unsigned j = 0; j < 16; ++j) { const unsigned c = xb_ld(&bar[XB_XCNT(j)]); sum += c; cnt += (c > 0u) ? 1u : 0u; mine = (j == x) ? c : mine; }
        if (sum == G) break;
        __builtin_amdgcn_s_sleep(1);
        if ((++sp & 255u) == 0u) { if (xb_ld(&bar[XB_TMO])) break; if (sp > XB_SPIN_CAP) { atomicAdd(&bar[XB_TMO], 1u); break; } }
    }
    nloc = mine > 0u ? mine : 1u; nx = cnt > 0u ? cnt : 1u;
}
__device__ __forceinline__ void xcd_barrier(const XcdBarrier& b) {
    asm volatile("s_waitcnt vmcnt(0)" ::: "memory");
    __syncthreads();
    if (threadIdx.x == 0) {
        unsigned* bar = b.bar;
        __builtin_amdgcn_s_waitcnt(0);
        unsigned nloc = b.st[0], nx = b.st[1];
        if (nloc == 0u) { xcd_barrier_complete(bar, b.x, nloc, nx); b.st[0] = nloc; b.st[1] = nx; }
        const unsigned old = xb_add(&bar[XB_XSUB(b.x)], 1u);
        const unsigned gen = old / nloc;
        if (old + 1u == (gen + 1u) * nloc) {
            __builtin_amdgcn_fence(__ATOMIC_RELEASE, "agent");
            asm volatile("s_waitcnt vmcnt(0)" ::: "memory");
            const unsigned og = xb_add(&bar[XB_TOP], 1u);
            const unsigned tg = og / nx;
            if (og + 1u == (tg + 1u) * nx) xb_add(&bar[XB_TOPGEN], 1u);
            else XB_SPIN(xb_ld(&bar[XB_TOPGEN]) == tg, bar);
            __builtin_amdgcn_fence(__ATOMIC_ACQUIRE, "agent");
            xb_add(&bar[XB_XGEN(b.x)], 1u);
            asm volatile("s_waitcnt vmcnt(0)" ::: "memory");
        } else {
            XB_SPIN(xb_ld(&bar[XB_XGEN(b.x)]) == gen, bar);
            __builtin_amdgcn_fence(__ATOMIC_ACQUIRE, "agent");
            asm volatile("s_waitcnt vmcnt(0)" ::: "memory");
        }
    }
    __syncthreads();
}

namespace g8 {
constexpr int BM = 256, BK = 64, HALF = 128, HTB = HALF * BK * 2, STAGE_BYTES = 8 * HTB, NXCD = 8, WGM = 8;
__device__ __forceinline__ int lds_byte(int r, int c) { const int st = (r >> 4) * 2 + (c >> 5), rr = r & 15, cc = c & 31, ob = rr * 64 + cc * 2; return st * 1024 + (ob ^ (((ob >> 9) & 1) << 5)); }
__device__ __forceinline__ void stage_rc(int b, int& R, int& C) { const int st = b / 1024, sb = b % 1024, swz = sb ^ (((sb >> 9) & 1) << 5); R = (st >> 1) * 16 + swz / 64; C = (st & 1) * 32 + (swz % 64) / 2; }
__device__ __forceinline__ int perm32(int rho) { const int n = rho >> 4, i = rho & 15; return 8 * (i >> 2) + 4 * n + (i & 3); }
__device__ __forceinline__ unsigned cvt_pk_bf16(float lo, float hi) { unsigned r; asm volatile("v_cvt_pk_bf16_f32 %0, %1, %2" : "=v"(r) : "v"(lo), "v"(hi)); return r; }
__device__ __forceinline__ int xcd_remap(int wgid, int nwg) { const int q = nwg / NXCD, r = nwg % NXCD, xcd = wgid % NXCD, off = wgid / NXCD; return (xcd < r ? xcd * (q + 1) : r * (q + 1) + (xcd - r) * q) + off; }

struct Unit { int row0, col0, ex, bt, nvalid, lrow; };

struct DenseSched {
    int nM, nN, nwg, G, c, lat_only; const char* Bt; int K; const int* list;
    __device__ __forceinline__ void init(int nM_, int nN_, int G_, int c_, int lat_only_, const void* Bt_, int K_) { nM = nM_; nN = nN_; nwg = nM * nN; G = G_; c = c_; lat_only = lat_only_; Bt = (const char*)Bt_; K = K_; list = nullptr; }
    __device__ __forceinline__ bool next(int i, Unit& u) const {
        const long Lx = (long)i * G + c; if (Lx >= nwg) return false;
        const int wgid = xcd_remap((int)Lx, nwg);
        const int nig = WGM * nN, gid = wgid / nig, fm = gid * WGM, gsz = (nM - fm) < WGM ? (nM - fm) : WGM;
        const int pm = fm + ((wgid % nig) % gsz), pn = (wgid % nig) / gsz;
        const int tile = lat_only ? (pm / 16) * 17 + 1 + (pm % 16) : pm;
        u.row0 = tile * 256; u.col0 = pn * 256; u.ex = 0; u.bt = pn; u.nvalid = 256; u.lrow = 0; return true;
    }
    __device__ __forceinline__ const char* bptr(const Unit& u) const { return Bt + (size_t)u.bt * (256 * 1024 * 2); }
};
struct MoeSched {
    const LAS int* tpre; const LAS int* cnt; int NT, COLW, G, c, total; const char* Bt; int K; const int* list;
    __device__ __forceinline__ bool next(int i, Unit& u) const {
        const long Lx = (long)i * G + c; if (Lx >= total) return false;
        const int wgid = xcd_remap((int)Lx, total);
        int e = 0;
        for (int j = 1; j < NE; ++j) if (tpre[j] * NT <= wgid) e = j;
        const int t0 = tpre[e], mte = tpre[e + 1] - t0, loc = wgid - t0 * NT, nt = loc / mte, mt = loc % mte;
        u.ex = __builtin_amdgcn_readfirstlane(e); u.row0 = __builtin_amdgcn_readfirstlane((t0 + mt) * 256); u.col0 = __builtin_amdgcn_readfirstlane(nt * COLW);
        u.bt = __builtin_amdgcn_readfirstlane(e * NT + nt); const int nv = cnt[e] - mt * 256; u.nvalid = __builtin_amdgcn_readfirstlane(nv < 256 ? nv : 256); u.lrow = __builtin_amdgcn_readfirstlane(mt * 256);
        return true;
    }
    __device__ __forceinline__ const char* bptr(const Unit& u) const { return Bt + (size_t)u.bt * (256 * 1024 * 2); }
};

struct EpiP {
    static constexpr bool PERM = true; bf16_t* O;
    __device__ __forceinline__ void operator()(const f32x4 (&acc)[2][2][4][2], const Unit& u, int wr, int wc, int fr, int fq, const LAS int*) const {
#pragma unroll
        for (int ai = 0; ai < 2; ++ai)
#pragma unroll
            for (int m = 0; m < 4; ++m) { bf16_t* rowp = O + (size_t)(u.row0 + ai * HALF + wr * 64 + m * 16 + fr) * PP + u.col0 + wc * 32 + 8 * fq;
#pragma unroll
                for (int bj = 0; bj < 2; ++bj) { const f32x4 v0 = acc[ai][bj][m][0], v1 = acc[ai][bj][m][1]; u32x4 w; w.x = cvt_pk_bf16(v0[0], v0[1]); w.y = cvt_pk_bf16(v0[2], v0[3]); w.z = cvt_pk_bf16(v1[0], v1[1]); w.w = cvt_pk_bf16(v1[2], v1[3]);
                    *(u32x4*)(rowp + bj * HALF) = w; } }
    }
};
struct EpiH {
    static constexpr bool PERM = false; float* Hh; const float* MODl; int g_off;
    __device__ __forceinline__ void operator()(const f32x4 (&acc)[2][2][4][2], const Unit& u, int wr, int wc, int fr, int fq, const LAS int*) const {
        const int tile = u.row0 >> 8, v = (tile % 17 == 0) ? 4 : tile / 17; const float* gp = MODl + (size_t)v * 6144 + g_off + u.col0 + wc * 32 + 4 * fq;
        f32x4 gv[2][2];
#pragma unroll
        for (int bj = 0; bj < 2; ++bj)
#pragma unroll
            for (int n = 0; n < 2; ++n) gv[bj][n] = *(const f32x4*)(gp + bj * HALF + n * 16);
#pragma unroll
        for (int ai = 0; ai < 2; ++ai)
#pragma unroll
            for (int m = 0; m < 4; ++m) { float* rowp = Hh + (size_t)(u.row0 + ai * HALF + wr * 64 + m * 16 + fr) * D + u.col0 + wc * 32 + 4 * fq;
#pragma unroll
                for (int bj = 0; bj < 2; ++bj)
#pragma unroll
                    for (int n = 0; n < 2; ++n) { f32x4* p = (f32x4*)(rowp + bj * HALF + n * 16); *p = *p + gv[bj][n] * acc[ai][bj][m][n]; } }
    }
};
struct EpiMoe1 {
    static constexpr bool PERM = true; bf16_t* ACTp; const float* bgu;
    __device__ __forceinline__ void operator()(const f32x4 (&acc)[2][2][4][2], const Unit& u, int wr, int wc, int fr, int fq, const LAS int*) const {
        const int cc = u.col0 + wc * 32 + 8 * fq; const float* bp = bgu + (size_t)u.ex * 2048 + cc;
        f32x4 bg[2], bu[2];
#pragma unroll
        for (int n = 0; n < 2; ++n) { bg[n] = *(const f32x4*)(bp + 4 * n); bu[n] = *(const f32x4*)(bp + 1024 + 4 * n); }
#pragma unroll
        for (int ai = 0; ai < 2; ++ai)
#pragma unroll
            for (int m = 0; m < 4; ++m) { const int r = ai * HALF + wr * 64 + m * 16 + fr;
                float o[8];
#pragma unroll
                for (int n = 0; n < 2; ++n)
#pragma unroll
                    for (int i = 0; i < 4; ++i) { const float g = fminf(acc[ai][0][m][n][i] + bg[n][i], 7.f); const float uu = fminf(fmaxf(acc[ai][1][m][n][i] + bu[n][i], -7.f), 7.f);
                        o[n * 4 + i] = (uu + 1.f) * g * __builtin_amdgcn_rcpf(1.f + __expf(-1.702f * g)); }
                if (r < u.nvalid) { u32x4 w; w.x = cvt_pk_bf16(o[0], o[1]); w.y = cvt_pk_bf16(o[2], o[3]); w.z = cvt_pk_bf16(o[4], o[5]); w.w = cvt_pk_bf16(o[6], o[7]);
                    *(u32x4*)(ACTp + (size_t)(u.row0 + r) * D + cc) = w; } }
    }
};
struct EpiMoe2 {
    static constexpr bool PERM = true; bf16_t* Yp; const float* bd; const float* GATEp;
    __device__ __forceinline__ void operator()(const f32x4 (&acc)[2][2][4][2], const Unit& u, int wr, int wc, int fr, int fq, const LAS int* rows) const {
        const int cc = u.col0 + wc * 32 + 8 * fq; const float* bp = bd + (size_t)u.ex * 1024 + cc;
        f32x4 bv[2][2];
#pragma unroll
        for (int bj = 0; bj < 2; ++bj)
#pragma unroll
            for (int n = 0; n < 2; ++n) bv[bj][n] = *(const f32x4*)(bp + bj * HALF + 4 * n);
#pragma unroll
        for (int ai = 0; ai < 2; ++ai)
#pragma unroll
            for (int m = 0; m < 4; ++m) { const int r = ai * HALF + wr * 64 + m * 16 + fr;
                if (r < u.nvalid) { const int asg = rows[r]; const float gt = GATEp[asg]; bf16_t* rowp = Yp + (size_t)asg * D + cc;
#pragma unroll
                    for (int bj = 0; bj < 2; ++bj) { const f32x4 v0 = (acc[ai][bj][m][0] + bv[bj][0]) * gt, v1 = (acc[ai][bj][m][1] + bv[bj][1]) * gt;
                        u32x4 w; w.x = cvt_pk_bf16(v0[0], v0[1]); w.y = cvt_pk_bf16(v0[2], v0[3]); w.z = cvt_pk_bf16(v1[0], v1[1]); w.w = cvt_pk_bf16(v1[2], v1[3]); *(u32x4*)(rowp + bj * HALF) = w; } } }
    }
};

template <class Epi, class Sched, bool GATHER, bool ROWLIST>
__device__ __forceinline__ void gemm_phase(LAS unsigned char* lds, const char* Abase, const Sched& S, const Epi& E) {
    constexpr int K = 1024;
    int tid_l = threadIdx.x; asm volatile("" : "+v"(tid_l));
    const int tid = tid_l, wid = __builtin_amdgcn_readfirstlane(tid >> 6), lane = tid & 63, wr = wid >> 2, wc = wid & 3, fr = lane & 15, fq = lane >> 4;
    constexpr int nt = K / BK; constexpr unsigned Kb = (unsigned)K * 2u;
    unsigned voffB[2];
#pragma unroll
    for (int i = 0; i < 2; ++i) { int R, C; stage_rc(tid * 16 + i * 8192, R, C); const int Rb = Epi::PERM ? ((R & ~31) + perm32(R & 31)) : R; voffB[i] = (unsigned)(Rb * K + C) * 2u; }
    constexpr size_t kstep = (size_t)(BK * 2), hstep = (size_t)HALF * K * 2;
    const unsigned ldsw = (unsigned)wid * 1024u;
    const int aoff = lds_byte(wr * 64 + fr, fq * 8), boff = lds_byte(wc * 32 + fr, fq * 8);
    LAS int* rowbuf = (LAS int*)(lds + STAGE_BYTES);
#define G8_SA(b, h) (((b) * 2 + (h)) * HTB)
#define G8_SB(b, h) ((4 + (b) * 2 + (h)) * HTB)
#define G8_STAGE_A(bufoff, kb, v) do { _Pragma("unroll") for (int _i = 0; _i < 2; ++_i) \
        __builtin_amdgcn_global_load_lds((const unsigned*)((kb) + (size_t)(v)[_i]), (LAS unsigned*)(lds + (bufoff) + ldsw + _i * 8192), 16, 0, 0); } while (0)
#define G8_STAGE_B(bufoff, gbase) do { _Pragma("unroll") for (int _i = 0; _i < 2; ++_i) \
        __builtin_amdgcn_global_load_lds((const unsigned*)((gbase) + voffB[_i]), (LAS unsigned*)(lds + (bufoff) + ldsw + _i * 8192), 16, 0, 0); } while (0)
#define G8_LDA(dst, b, h) do { _Pragma("unroll") for (int m = 0; m < 4; ++m) _Pragma("unroll") for (int k = 0; k < 2; ++k) dst[m][k] = *(const LAS bf16x8*)(lds + G8_SA(b, h) + aoff + m * 2048 + k * 1024); } while (0)
#define G8_LDB(dst, b, h) do { _Pragma("unroll") for (int n = 0; n < 2; ++n) _Pragma("unroll") for (int k = 0; k < 2; ++k) dst[n][k] = *(const LAS bf16x8*)(lds + G8_SB(b, h) + boff + n * 2048 + k * 1024); } while (0)
#define G8_MMA(ai, bj, At, Bt) do { __builtin_amdgcn_s_setprio(1); _Pragma("unroll") for (int m = 0; m < 4; ++m) _Pragma("unroll") for (int n = 0; n < 2; ++n) _Pragma("unroll") for (int k = 0; k < 2; ++k) \
        acc[ai][bj][m][n] = __builtin_amdgcn_mfma_f32_16x16x32_bf16(Bt[n][k], At[m][k], acc[ai][bj][m][n], 0, 0, 0); __builtin_amdgcn_s_setprio(0); } while (0)
#define G8_WAIT_V(n) asm volatile("s_waitcnt vmcnt(" #n ")" ::: "memory")
#define G8_WAIT_L(n) asm volatile("s_waitcnt lgkmcnt(" #n ")" ::: "memory")
#define G8_BAR __builtin_amdgcn_s_barrier()
#define G8_SCHED __builtin_amdgcn_sched_barrier(0)
#define G8_LISTDMA(u, s) do { if (wid < 4) __builtin_amdgcn_global_load_lds((const unsigned*)(S.list + (size_t)(u).ex * LCAP + (u).lrow + wid * 64 + lane), (LAS unsigned*)(rowbuf + (s) * 256 + wid * 64), 4, 0, 0); } while (0)
#define G8_ROWS_DENSE(v) do { _Pragma("unroll") for (int _i = 0; _i < 2; ++_i) { int _R, _C; stage_rc(tid * 16 + _i * 8192, _R, _C); _Pragma("unroll") for (int _h = 0; _h < 2; ++_h) (v)[_h][_i] = (unsigned)(_h * HALF + _R) * Kb + (unsigned)_C * 2u; } } while (0)
#define G8_ROWS_LIST(v, u, s) do { _Pragma("unroll") for (int _i = 0; _i < 2; ++_i) { int _R, _C; stage_rc(tid * 16 + _i * 8192, _R, _C); _Pragma("unroll") for (int _h = 0; _h < 2; ++_h) { const int _r = _h * HALF + _R; const int _a = rowbuf[(s) * 256 + _r]; \
        (v)[_h][_i] = (unsigned)(_r < (u).nvalid ? (_a >> 2) : 0) * Kb + (unsigned)_C * 2u; } } } while (0)
    Unit cur, nxt; int ui = 0, slot = 0;
    if (!S.next(0, cur)) return;
    unsigned vA[2][2];
    if constexpr (ROWLIST) { G8_LISTDMA(cur, 0); G8_WAIT_V(0); G8_BAR; }
    if constexpr (GATHER) { G8_ROWS_LIST(vA, cur, 0); } else { G8_ROWS_DENSE(vA); }
    f32x4 acc[2][2][4][2];
#pragma unroll
    for (int a = 0; a < 2; ++a)
#pragma unroll
        for (int b = 0; b < 2; ++b)
#pragma unroll
            for (int m = 0; m < 4; ++m)
#pragma unroll
                for (int n = 0; n < 2; ++n) acc[a][b][m][n] = (f32x4){0.f, 0.f, 0.f, 0.f};
    bf16x8 At[4][2], B0[2][2], B1[2][2];
    const char* cB = S.bptr(cur);
    const char* cA = GATHER ? Abase : Abase + (size_t)cur.row0 * Kb;
    G8_STAGE_B(G8_SB(0, 0), cB); G8_STAGE_B(G8_SB(0, 1), cB + hstep); G8_STAGE_A(G8_SA(0, 0), cA, vA[0]); G8_STAGE_A(G8_SA(0, 1), cA, vA[1]);
    if (wr == 1) G8_BAR;
    G8_WAIT_V(2); G8_BAR;
    G8_STAGE_B(G8_SB(1, 0), cB + kstep); G8_STAGE_A(G8_SA(1, 0), cA + kstep, vA[0]); G8_STAGE_B(G8_SB(1, 1), cB + hstep + kstep);
    G8_WAIT_V(6); G8_BAR;
    for (;;) {
        const bool has_next = S.next(ui + 1, nxt);
        const char* nB = has_next ? S.bptr(nxt) : cB;
        const char* nA = (GATHER || !has_next) ? cA : Abase + (size_t)nxt.row0 * Kb;
        const int nslot = slot == 2 ? 0 : slot + 1;
        if constexpr (ROWLIST) { if (has_next) G8_LISTDMA(nxt, nslot); }
        for (int t = 0; t < nt; t += 2) {
            const bool last = (t == nt - 2);
            const char* a1 = cA + (size_t)(t + 1) * kstep;
            const char* a2 = last ? nA : cA + (size_t)(t + 2) * kstep; const char* b2 = last ? nB : cB + (size_t)(t + 2) * kstep;
            const char* a3 = a2 + kstep; const char* b3 = b2 + kstep;
            G8_LDB(B0, 0, 0); G8_LDB(B1, 0, 1); G8_SCHED; G8_LDA(At, 0, 0); G8_STAGE_A(G8_SA(1, 1), a1, vA[1]);
            if constexpr (GATHER) { if (last && has_next) { G8_ROWS_LIST(vA, nxt, nslot); } }
            G8_WAIT_V(8); G8_WAIT_L(0); G8_BAR; G8_MMA(0, 0, At, B0); G8_MMA(0, 1, At, B1); G8_BAR; G8_SCHED;
            G8_LDA(At, 0, 1); G8_STAGE_B(G8_SB(0, 0), b2); G8_STAGE_B(G8_SB(0, 1), b2 + hstep); G8_STAGE_A(G8_SA(0, 0), a2, vA[0]);
            G8_WAIT_V(8); G8_WAIT_L(0); G8_BAR; G8_MMA(1, 0, At, B0); G8_MMA(1, 1, At, B1); G8_BAR; G8_SCHED;
            G8_LDB(B0, 1, 0); G8_LDB(B1, 1, 1); G8_SCHED; G8_LDA(At, 1, 0); G8_STAGE_A(G8_SA(0, 1), a2, vA[1]);
            G8_WAIT_V(8); G8_WAIT_L(0); G8_BAR; G8_MMA(0, 0, At, B0); G8_MMA(0, 1, At, B1); G8_BAR; G8_SCHED;
            G8_LDA(At, 1, 1); G8_STAGE_B(G8_SB(1, 0), b3); G8_STAGE_B(G8_SB(1, 1), b3 + hstep); G8_STAGE_A(G8_SA(1, 0), a3, vA[0]);
            G8_WAIT_V(8); G8_WAIT_L(0); G8_BAR; G8_MMA(1, 0, At, B0); G8_MMA(1, 1, At, B1); G8_BAR; G8_SCHED;
        }
        if (wr == 0) G8_BAR;
        { int t2 = threadIdx.x; asm volatile("" : "+v"(t2));
          const int w2 = __builtin_amdgcn_readfirstlane(t2 >> 6); E(acc, cur, w2 >> 2, w2 & 3, t2 & 15, (t2 & 63) >> 4, rowbuf + slot * 256); }
        if (!has_next) break;
#pragma unroll
        for (int a = 0; a < 2; ++a)
#pragma unroll
            for (int b = 0; b < 2; ++b)
#pragma unroll
                for (int m = 0; m < 4; ++m)
#pragma unroll
                    for (int n = 0; n < 2; ++n) acc[a][b][m][n] = (f32x4){0.f, 0.f, 0.f, 0.f};
        cur = nxt; cB = nB; cA = nA; ++ui; slot = nslot;
        if (wr == 1) G8_BAR;
    }
    G8_WAIT_V(0);
    G8_BAR;
#undef G8_SA
#undef G8_SB
#undef G8_STAGE_A
#undef G8_STAGE_B
#undef G8_LDA
#undef G8_LDB
#undef G8_MMA
#undef G8_WAIT_V
#undef G8_WAIT_L
#undef G8_BAR
#undef G8_SCHED
#undef G8_LISTDMA
#undef G8_ROWS_DENSE
#undef G8_ROWS_LIST
}
}

namespace fft {
constexpr int TP = 72;
constexpr int UP = 264;
constexpr int ZP = 520;
constexpr int O_TC = 0, O_TS = 9216, O_U = 18432, O_X = 52224, O_TW = 125952;
__device__ __forceinline__ bf16x8 neg8(bf16x8 v) { u32x4 w = __builtin_bit_cast(u32x4, v); w = w ^ 0x80008000u; return __builtin_bit_cast(bf16x8, w); }
__device__ __forceinline__ void build_tables(LAS unsigned char* lds, const float* TABC, const float* TABS, int tid) {
    for (int i = tid; i < 4096; i += 512) { const int a = i >> 6, b = i & 63, ix = ((a * b) & 63) * 64;
        ((LAS bf16_t*)(lds + O_TC))[a * TP + b] = f2bf(TABC[ix]); ((LAS bf16_t*)(lds + O_TS))[a * TP + b] = f2bf(TABS[ix]); }
}
__device__ __forceinline__ void stage_a(LAS unsigned char* lds, const bf16_t* P, const float* TABC, const float* TABS, bf16_t* ZBUF, int u0, int u1, int ustep) {
    int tid_l = threadIdx.x; asm volatile("" : "+v"(tid_l));
    const int tid = tid_l, lane = tid & 63, w = __builtin_amdgcn_readfirstlane(tid >> 6), fr = lane & 15, fq = lane >> 4;
    build_tables(lds, TABC, TABS, tid);
    const LAS bf16_t* Tc = (const LAS bf16_t*)(lds + O_TC); const LAS bf16_t* Ts = (const LAS bf16_t*)(lds + O_TS);
    LAS bf16_t* U = (LAS bf16_t*)(lds + O_U); LAS bf16_t* X = (LAS bf16_t*)(lds + O_X); LAS float* TW = (LAS float*)(lds + O_TW);
    for (int unit = u0; unit < u1; unit += ustep) {
        const int b = unit >> 6, t2 = unit & 63;
#pragma unroll
        for (int i = 0; i < 4; ++i) { const int q = tid + 512 * i, t1 = q >> 5, ch = q & 31;
            *(LAS u32x4*)((LAS unsigned char*)U + t1 * (UP * 2) + ch * 16) = *(const u32x4*)(P + ((size_t)b * NPOS + CTX + 64 * t1 + t2) * PP + ch * 8); }
        if (tid < 64) { const int ix = tid * t2; TW[2 * tid] = TABC[ix]; TW[2 * tid + 1] = TABS[ix]; }
        __syncthreads();
        { const int g = w >> 1, part = w & 1; const LAS bf16_t* T = part ? Ts : Tc;
          f32x4 acc[4][4];
#pragma unroll
          for (int mt = 0; mt < 4; ++mt)
#pragma unroll
              for (int nt = 0; nt < 4; ++nt) acc[mt][nt] = (f32x4){0.f, 0.f, 0.f, 0.f};
#pragma unroll
          for (int ks = 0; ks < 2; ++ks) { bf16x8 a[4], bb[4];
#pragma unroll
              for (int mt = 0; mt < 4; ++mt) a[mt] = *(const LAS bf16x8*)(U + (16 * mt + fr) * UP + g * 64 + 32 * ks + 8 * fq);
#pragma unroll
              for (int nt = 0; nt < 4; ++nt) bb[nt] = *(const LAS bf16x8*)(T + (16 * nt + fr) * TP + 32 * ks + 8 * fq);
#pragma unroll
              for (int mt = 0; mt < 4; ++mt)
#pragma unroll
                  for (int nt = 0; nt < 4; ++nt) acc[mt][nt] = __builtin_amdgcn_mfma_f32_16x16x32_bf16(a[mt], bb[nt], acc[mt][nt], 0, 0, 0); }
          const float sg = part ? -1.f : 1.f;
#pragma unroll
          for (int mt = 0; mt < 4; ++mt)
#pragma unroll
              for (int nt = 0; nt < 4; ++nt) { const f32x4 v = acc[mt][nt] * sg; u32x2 o; o.x = pk2(v[0], v[1]); o.y = pk2(v[2], v[3]);
                  *(LAS u32x2*)(X + (part * 256 + g * 64 + 16 * nt + fr) * TP + 16 * mt + 4 * fq) = o; } }
        __syncthreads();
        f32x4 zr[4][2], zi[4][2];
#pragma unroll
        for (int mt = 0; mt < 4; ++mt)
#pragma unroll
            for (int n = 0; n < 2; ++n) { zr[mt][n] = (f32x4){0.f, 0.f, 0.f, 0.f}; zi[mt][n] = (f32x4){0.f, 0.f, 0.f, 0.f}; }
#pragma unroll
        for (int ks = 0; ks < 2; ++ks) { bf16x8 xr[2], xi[2];
#pragma unroll
            for (int n = 0; n < 2; ++n) { xr[n] = *(const LAS bf16x8*)(X + (32 * w + 16 * n + fr) * TP + 32 * ks + 8 * fq); xi[n] = *(const LAS bf16x8*)(X + (256 + 32 * w + 16 * n + fr) * TP + 32 * ks + 8 * fq); }
#pragma unroll
            for (int mt = 0; mt < 4; ++mt) { const bf16x8 c = *(const LAS bf16x8*)(Tc + (16 * mt + fr) * TP + 32 * ks + 8 * fq), s = *(const LAS bf16x8*)(Ts + (16 * mt + fr) * TP + 32 * ks + 8 * fq), ns = neg8(s);
#pragma unroll
                for (int n = 0; n < 2; ++n) { zr[mt][n] = __builtin_amdgcn_mfma_f32_16x16x32_bf16(c, xr[n], zr[mt][n], 0, 0, 0); zr[mt][n] = __builtin_amdgcn_mfma_f32_16x16x32_bf16(s, xi[n], zr[mt][n], 0, 0, 0);
                    zi[mt][n] = __builtin_amdgcn_mfma_f32_16x16x32_bf16(c, xi[n], zi[mt][n], 0, 0, 0); zi[mt][n] = __builtin_amdgcn_mfma_f32_16x16x32_bf16(ns, xr[n], zi[mt][n], 0, 0, 0); } } }
        __syncthreads();
        { LAS bf16_t* Zs = X;
#pragma unroll
          for (int mt = 0; mt < 4; ++mt)
#pragma unroll
              for (int i = 0; i < 4; ++i) { const int f1 = 16 * mt + 4 * fq + i; const float ct = TW[2 * f1], st = TW[2 * f1 + 1];
#pragma unroll
                  for (int n = 0; n < 2; ++n) { const float a = zr[mt][n][i], bq = zi[mt][n][i]; const int col = 32 * w + 16 * n + fr;
                      Zs[f1 * ZP + col] = f2bf(a * ct + bq * st); Zs[f1 * ZP + 256 + col] = f2bf(bq * ct - a * st); } } }
        __syncthreads();
#pragma unroll
        for (int i = 0; i < 8; ++i) { const int q = tid + 512 * i, f1 = q >> 6, ch = q & 63;
            *(u32x4*)(ZBUF + (((size_t)b * 64 + f1) * 64 + t2) * 512 + ch * 8) = *(const LAS u32x4*)((const LAS unsigned char*)X + f1 * (ZP * 2) + ch * 16); }
        __syncthreads();
    }
}
__device__ __forceinline__ void stage_b(LAS unsigned char* lds, const bf16_t* ZBUF, const float* TABC, const float* TABS, bf16_t* MIX, int G, int bx) {
    int tid_l = threadIdx.x; asm volatile("" : "+v"(tid_l));
    const int tid = tid_l, lane = tid & 63, w = __builtin_amdgcn_readfirstlane(tid >> 6), fr = lane & 15, fq = lane >> 4;
    build_tables(lds, TABC, TABS, tid);
    const LAS bf16_t* Tc = (const LAS bf16_t*)(lds + O_TC); const LAS bf16_t* Ts = (const LAS bf16_t*)(lds + O_TS);
    LAS bf16_t* Ys = (LAS bf16_t*)(lds + O_U); LAS bf16_t* ZT = (LAS bf16_t*)(lds + O_X);
    for (int unit = bx; unit < 256; unit += G) {
        const int b = unit >> 6, f1 = unit & 63;
        const bf16_t* Zg = ZBUF + ((size_t)b * 64 + f1) * 64 * 512;
#pragma unroll
        for (int i = 0; i < 4; ++i) { const int q = tid + 512 * i, p = q & 31, ch = q >> 5;
            const u32x4 r0 = *(const u32x4*)(Zg + (size_t)(2 * p) * 512 + ch * 8), r1 = *(const u32x4*)(Zg + (size_t)(2 * p + 1) * 512 + ch * 8);
#pragma unroll
            for (int j = 0; j < 4; ++j) { const unsigned a = r0[j], c = r1[j];
                *(LAS unsigned*)(ZT + (ch * 8 + 2 * j) * TP + 2 * p) = (a & 0xffffu) | (c << 16);
                *(LAS unsigned*)(ZT + (ch * 8 + 2 * j + 1) * TP + 2 * p) = (a >> 16) | (c & 0xffff0000u); } }
        __syncthreads();
        f32x4 y[4][2];
#pragma unroll
        for (int mt = 0; mt < 4; ++mt)
#pragma unroll
            for (int n = 0; n < 2; ++n) y[mt][n] = (f32x4){0.f, 0.f, 0.f, 0.f};
#pragma unroll
        for (int ks = 0; ks < 2; ++ks) { bf16x8 xr[2], xi[2];
#pragma unroll
            for (int n = 0; n < 2; ++n) { xr[n] = *(const LAS bf16x8*)(ZT + (32 * w + 16 * n + fr) * TP + 32 * ks + 8 * fq); xi[n] = *(const LAS bf16x8*)(ZT + (256 + 32 * w + 16 * n + fr) * TP + 32 * ks + 8 * fq); }
#pragma unroll
            for (int mt = 0; mt < 4; ++mt) { const bf16x8 c = *(const LAS bf16x8*)(Tc + (16 * mt + fr) * TP + 32 * ks + 8 * fq), s = *(const LAS bf16x8*)(Ts + (16 * mt + fr) * TP + 32 * ks + 8 * fq);
#pragma unroll
                for (int n = 0; n < 2; ++n) { y[mt][n] = __builtin_amdgcn_mfma_f32_16x16x32_bf16(c, xr[n], y[mt][n], 0, 0, 0); y[mt][n] = __builtin_amdgcn_mfma_f32_16x16x32_bf16(s, xi[n], y[mt][n], 0, 0, 0); } } }
#pragma unroll
        for (int mt = 0; mt < 4; ++mt)
#pragma unroll
            for (int i = 0; i < 4; ++i)
#pragma unroll
                for (int n = 0; n < 2; ++n) Ys[(16 * mt + 4 * fq + i) * UP + 32 * w + 16 * n + fr] = f2bf(y[mt][n][i] * (1.f / 512.f));
        __syncthreads();
#pragma unroll
        for (int i = 0; i < 4; ++i) { const int q = tid + 512 * i, f2 = q >> 5, ch = q & 31;
            *(u32x4*)(MIX + ((size_t)b * NPOS + CTX + f1 + 64 * f2) * D + ch * 8) = *(const LAS u32x4*)((const LAS unsigned char*)Ys + f2 * (UP * 2) + ch * 16); }
        __syncthreads();
    }
}
}

namespace attn {
typedef float f32x16 __attribute__((ext_vector_type(16)));
typedef float f32x2_t __attribute__((ext_vector_type(2))); typedef __bf16 bf16x2_t __attribute__((ext_vector_type(2)));
__device__ __forceinline__ unsigned cvtpk(float lo, float hi) { f32x2_t v = {lo, hi}; bf16x2_t b = __builtin_convertvector(v, bf16x2_t); return __builtin_bit_cast(unsigned, b); }
constexpr int KP = 104, VP = 68;
constexpr int KT_BYTES = 64 * KP * 2, VT_BYTES = 64 * VP * 2, BUF_BYTES = KT_BYTES + VT_BYTES;
constexpr float THR = 8.f;
__device__ __forceinline__ void attn_phase(LAS unsigned char* lds, const bf16_t* QL, const bf16_t* QC, const bf16_t* KB, const bf16_t* VTG, bf16_t* MIX, int with_ctx, int G, int vcu) {
    const int nunits = 256 + (with_ctx ? 16 : 0);
    for (int unit = vcu; unit < nunits; unit += G) {
        int tid_l = threadIdx.x; asm volatile("" : "+v"(tid_l));
        const int tid = tid_l, lane = tid & 63, wid = __builtin_amdgcn_readfirstlane(tid >> 6), r32 = lane & 31, hi = lane >> 5;
        int bh, nk, orow0; const bf16_t* Qp;
        if (unit < 256) { bh = unit >> 4; const int qb = unit & 15; Qp = QL + ((size_t)bh * SEQ + qb * 256) * 96; nk = NPOS; orow0 = (bh >> 2) * NPOS + CTX + qb * 256; }
        else { bh = unit - 256; Qp = QC + (size_t)bh * CTX * 96; nk = CTX; orow0 = (bh >> 2) * NPOS; }
        const int hh = bh & 3, NT = nk / 64;
        const bf16_t* Kg = KB + (size_t)bh * NPOS * 96; const bf16_t* Vg = VTG + (size_t)bh * 64 * NPOS;
        bf16x8 qf[6];
        { const bf16_t* qp = Qp + (size_t)(wid * 32 + r32) * 96 + 8 * hi;
#pragma unroll
          for (int ds = 0; ds < 6; ++ds) qf[ds] = *(const bf16x8*)(qp + 16 * ds); }
        f32x16 o0 = {}, o1 = {}, negm = {}; float mhat = 0.f, l = 0.f;
        const int kr0 = tid / 12, kc0 = tid % 12, kr1 = (tid + 512) / 12, kc1 = (tid + 512) % 12; const bool k1ok = tid < 256;
        const int vd = tid >> 3, vc = tid & 7;
        u32x4 sk0, sk1 = {}, sv;
#define AT_LOAD(t_) do { const size_t k0_ = (size_t)(t_) * 64; sk0 = *(const u32x4*)(Kg + (k0_ + kr0) * 96 + kc0 * 8); if (k1ok) sk1 = *(const u32x4*)(Kg + (k0_ + kr1) * 96 + kc1 * 8); sv = *(const u32x4*)(Vg + (size_t)vd * NPOS + k0_ + vc * 8); } while (0)
#define AT_STORE(slot_) do { LAS unsigned char* bp_ = lds + (slot_) * BUF_BYTES; *(LAS u32x4*)(bp_ + kr0 * (KP * 2) + kc0 * 16) = sk0; if (k1ok) *(LAS u32x4*)(bp_ + kr1 * (KP * 2) + kc1 * 16) = sk1; *(LAS u32x4*)(bp_ + KT_BYTES + vd * (VP * 2) + vc * 16) = sv; } while (0)
#define AT_QK(P0, P1, slot_) do { const LAS bf16_t* Kt_ = (const LAS bf16_t*)(lds + (slot_) * BUF_BYTES); \
        _Pragma("unroll") for (int ds = 0; ds < 6; ++ds) { const bf16x8 k0f = *(const LAS bf16x8*)(Kt_ + r32 * KP + 16 * ds + 8 * hi), k1f = *(const LAS bf16x8*)(Kt_ + (32 + r32) * KP + 16 * ds + 8 * hi); \
            if (ds == 0) { P0 = __builtin_amdgcn_mfma_f32_32x32x16_bf16(k0f, qf[0], negm, 0, 0, 0); P1 = __builtin_amdgcn_mfma_f32_32x32x16_bf16(k1f, qf[0], negm, 0, 0, 0); } \
            else { P0 = __builtin_amdgcn_mfma_f32_32x32x16_bf16(k0f, qf[ds], P0, 0, 0, 0); P1 = __builtin_amdgcn_mfma_f32_32x32x16_bf16(k1f, qf[ds], P1, 0, 0, 0); } } } while (0)
#define MX3(a_, b_, c_) __builtin_fmaxf(__builtin_fmaxf((a_), (b_)), (c_))
#define AT_STEP(C0, C1, N0, N1, t_) do { \
            if ((t_) + 2 < NT) AT_LOAD((t_) + 2); \
            if ((t_) + 1 < NT) AT_QK(N0, N1, s_nxt); \
            float mx_ = MX3(C0[0], C0[1], C1[0]), my_ = MX3(C0[2], C0[3], C1[1]); mx_ = MX3(mx_, C1[2], C1[3]); \
            _Pragma("unroll") for (int r = 4; r < 16; r += 4) { mx_ = MX3(mx_, C0[r], C0[r + 1]); my_ = MX3(my_, C0[r + 2], C0[r + 3]); mx_ = MX3(mx_, C1[r], C1[r + 1]); my_ = MX3(my_, C1[r + 2], C1[r + 3]); } \
            mx_ = fmaxf(mx_, my_); mx_ = fmaxf(mx_, __shfl_xor(mx_, 32)); \
            if (__builtin_expect((t_) == 0 || __any(mx_ > THR), 0)) { const float dl = (t_) == 0 ? mx_ : fmaxf(mx_, 0.f), f = __builtin_amdgcn_exp2f(-dl); mhat += dl; l *= f; \
                _Pragma("unroll") for (int r = 0; r < 16; ++r) { C0[r] -= dl; C1[r] -= dl; o0[r] *= f; o1[r] *= f; negm[r] = -mhat; } \
                if ((t_) + 1 < NT) { _Pragma("unroll") for (int r = 0; r < 16; ++r) { N0[r] -= dl; N1[r] -= dl; } } } \
            float ls_ = 0.f; \
            _Pragma("unroll") for (int r = 0; r < 16; ++r) { C0[r] = __builtin_amdgcn_exp2f(C0[r]); C1[r] = __builtin_amdgcn_exp2f(C1[r]); ls_ += C0[r] + C1[r]; } \
            l += ls_; \
            const LAS bf16_t* Vt_ = (const LAS bf16_t*)(lds + s_cur * BUF_BYTES + KT_BYTES); \
            _Pragma("unroll") for (int q = 0; q < 4; ++q) { u32x4 pw_; \
                _Pragma("unroll") for (int j = 0; j < 4; ++j) { const int r = 8 * (q & 1) + 2 * j; pw_[j] = (q < 2) ? cvtpk(C0[r], C0[r + 1]) : cvtpk(C1[r], C1[r + 1]); } \
                const bf16x8 pf_ = __builtin_bit_cast(bf16x8, pw_); const int kvb = 32 * (q >> 1) + 16 * (q & 1) + 4 * hi; \
                _Pragma("unroll") for (int db = 0; db < 2; ++db) { const u32x2 va = *(const LAS u32x2*)(Vt_ + (32 * db + r32) * VP + kvb), vb = *(const LAS u32x2*)(Vt_ + (32 * db + r32) * VP + kvb + 8); \
                    const u32x4 vw = {va.x, va.y, vb.x, vb.y}; const bf16x8 vf = __builtin_bit_cast(bf16x8, vw); \
                    if (db == 0) o0 = __builtin_amdgcn_mfma_f32_32x32x16_bf16(vf, pf_, o0, 0, 0, 0); else o1 = __builtin_amdgcn_mfma_f32_32x32x16_bf16(vf, pf_, o1, 0, 0, 0); } } \
            if ((t_) + 2 < NT) AT_STORE(s_ld); \
            __syncthreads(); \
            { const int tmp_ = s_cur; s_cur = s_nxt; s_nxt = s_ld; s_ld = tmp_; } } while (0)
        AT_LOAD(0); AT_STORE(0);
        if (NT > 1) { AT_LOAD(1); AT_STORE(1); }
        __syncthreads();
        f32x16 pA0, pA1, pB0, pB1;
        AT_QK(pA0, pA1, 0);
        int s_cur = 0, s_nxt = 1, s_ld = 2;
        for (int t = 0; t < NT; t += 2) {
            AT_STEP(pA0, pA1, pB0, pB1, t);
            AT_STEP(pB0, pB1, pA0, pA1, t + 1);
        }
#undef AT_LOAD
#undef AT_STORE
#undef AT_QK
#undef AT_STEP
#undef MX3
        l += __shfl_xor(l, 32);
        const float il = 1.f / l;
        bf16_t* op = MIX + (size_t)(orow0 + wid * 32 + r32) * D + 512 + hh * 64 + 4 * hi;
#pragma unroll
        for (int g4 = 0; g4 < 4; ++g4) { u32x2 w0, w1; w0.x = cvtpk(o0[4 * g4] * il, o0[4 * g4 + 1] * il); w0.y = cvtpk(o0[4 * g4 + 2] * il, o0[4 * g4 + 3] * il);
            w1.x = cvtpk(o1[4 * g4] * il, o1[4 * g4 + 1] * il); w1.y = cvtpk(o1[4 * g4 + 2] * il, o1[4 * g4 + 3] * il);
            *(u32x2*)(op + 8 * g4) = w0; *(u32x2*)(op + 32 + 8 * g4) = w1; }
    }
}
}

namespace sm {
__device__ __forceinline__ float silu(float x) { return x / (1.f + __expf(-x)); }
__device__ __forceinline__ void mod_phase(LAS unsigned char* lds, const float* c, const float* c_ctx, const float* mod_w, const float* mod_b, float* MOD, int G, int bx, int tid) {
    LAS float* s = (LAS float*)lds;
    for (int i = tid; i < 5120; i += 512) { const int v = i >> 10, k = i & 1023; s[i] = silu(v < 4 ? c[v * 1024 + k] : c_ctx[k]); }
    __syncthreads();
    LAS float* red = s + 5120;
    for (int unit = bx; unit < 96; unit += G) {
        const int l = unit / 48, cb = unit % 48, cl = tid & 127, col = cb * 128 + cl, kq = tid >> 7, k0 = kq * 256;
        const float* W = mod_w + ((size_t)l * 1024 + k0) * 6144 + col;
        float a0 = 0.f, a1 = 0.f, a2 = 0.f, a3 = 0.f, a4 = 0.f;
#pragma unroll 16
        for (int k = 0; k < 256; ++k) { const float w = W[(size_t)k * 6144]; a0 += s[k0 + k] * w; a1 += s[1024 + k0 + k] * w; a2 += s[2048 + k0 + k] * w; a3 += s[3072 + k0 + k] * w; a4 += s[4096 + k0 + k] * w; }
        LAS float* rq = red + kq * 640 + cl; rq[0] = a0; rq[128] = a1; rq[256] = a2; rq[384] = a3; rq[512] = a4;
        __syncthreads();
        for (int i = tid; i < 640; i += 512) { const int v = i >> 7, cc = i & 127; const float r = ((red[i] + red[640 + i]) + (red[1280 + i] + red[1920 + i])) + mod_b[l * 6144 + cb * 128 + cc];
            MOD[((size_t)l * 5 + v) * 6144 + cb * 128 + cc] = r; }
        __syncthreads();
    }
}
__device__ __forceinline__ void norm_store(const float4 (&x)[4], float ss, const float* g, const float* mv, int sh_off, int sc_off, bf16_t* xn_row, int lane) {
    const float rs = rsqrtf(wave_sum(ss) * (1.f / D) + 1e-6f);
#pragma unroll
    for (int j = 0; j < 4; ++j) { const int c = (j * 64 + lane) * 4; const float4 gg = *(const float4*)(g + c), sh = *(const float4*)(mv + sh_off + c), sc = *(const float4*)(mv + sc_off + c);
        u32x2 o; o.x = pk2(x[j].x * rs * gg.x * (1.f + sc.x) + sh.x, x[j].y * rs * gg.y * (1.f + sc.y) + sh.y); o.y = pk2(x[j].z * rs * gg.z * (1.f + sc.z) + sh.z, x[j].w * rs * gg.w * (1.f + sc.w) + sh.w);
        *(u32x2*)(xn_row + c) = o; }
}
__device__ __forceinline__ void pro1_phase(const float* x, const float* ctx, const float* g, const float* MODl, float* H, bf16_t* XN, int gw, int NGW, int lane) {
    for (int r = gw; r < MROWS; r += NGW) { const int b = r / NPOS, pos = r % NPOS, v = pos < CTX ? 4 : b;
        const float* src = pos < CTX ? ctx + ((size_t)b * CTX + pos) * D : x + ((size_t)b * SEQ + (pos - CTX)) * D;
        float4 xv[4]; float ss = 0.f;
#pragma unroll
        for (int j = 0; j < 4; ++j) { const int c = (j * 64 + lane) * 4; xv[j] = *(const float4*)(src + c); *(float4*)(H + (size_t)r * D + c) = xv[j]; ss += xv[j].x * xv[j].x + xv[j].y * xv[j].y + xv[j].z * xv[j].z + xv[j].w * xv[j].w; }
        norm_store(xv, ss, g, MODl + (size_t)v * 6144, 0, 1024, XN + (size_t)r * D, lane); }
}
__device__ __forceinline__ void comb_phase(int l, float* H, const bf16_t* Y, const float* MODl, const float* g_next, const float* MODn, bf16_t* XN, const float* final_g, float* out, int gw, int NGW, int lane) {
    for (int r = gw; r < MROWS; r += NGW) { const int b = r / NPOS, pos = r % NPOS, v = pos < CTX ? 4 : b;
        if (l == 1 && pos < CTX) continue;
        const float* g2 = MODl + (size_t)v * 6144 + 5120;
        float4 xv[4]; float ss = 0.f;
#pragma unroll
        for (int j = 0; j < 4; ++j) { const int c = (j * 64 + lane) * 4; xv[j] = *(const float4*)(H + (size_t)r * D + c); float4 s = make_float4(0.f, 0.f, 0.f, 0.f);
#pragma unroll
            for (int k = 0; k < 4; ++k) { const u32x2 y = *(const u32x2*)(Y + ((size_t)r * 4 + k) * D + c); s.x += __uint_as_float(y.x << 16); s.y += __uint_as_float(y.x & 0xffff0000u); s.z += __uint_as_float(y.y << 16); s.w += __uint_as_float(y.y & 0xffff0000u); }
            const float4 gg = *(const float4*)(g2 + c); xv[j].x += gg.x * s.x; xv[j].y += gg.y * s.y; xv[j].z += gg.z * s.z; xv[j].w += gg.w * s.w;
            ss += xv[j].x * xv[j].x + xv[j].y * xv[j].y + xv[j].z * xv[j].z + xv[j].w * xv[j].w; }
        if (l == 0) {
#pragma unroll
            for (int j = 0; j < 4; ++j) *(float4*)(H + (size_t)r * D + (j * 64 + lane) * 4) = xv[j];
            norm_store(xv, ss, g_next, MODn + (size_t)v * 6144, 0, 1024, XN + (size_t)r * D, lane);
        } else { const float rs = rsqrtf(wave_sum(ss) * (1.f / D) + 1e-6f); float* op = out + ((size_t)b * SEQ + (pos - CTX)) * D;
#pragma unroll
            for (int j = 0; j < 4; ++j) { const int c = (j * 64 + lane) * 4; const float4 fg = *(const float4*)(final_g + c); float4 o; o.x = xv[j].x * rs * fg.x; o.y = xv[j].y * rs * fg.y; o.z = xv[j].z * rs * fg.z; o.w = xv[j].w * rs * fg.w; *(float4*)(op + c) = o; } }
    }
}
__device__ __forceinline__ void route_phase(LAS unsigned char* lds, int l, const float* H, const float* g, const float* MODl, const bf16_t* RWH, const bf16_t* RWL, const float* rb, bf16_t* XN, int* CNT, int* LIST, float* GATE,
                                            int G, int bx, int tid) {
    const int lane = tid & 63, wave = __builtin_amdgcn_readfirstlane(tid >> 6), fr = lane & 15, fq = lane >> 4;
    constexpr int FP = 1032;
    LAS bf16_t* FH = (LAS bf16_t*)lds; LAS bf16_t* FL = FH + 16 * FP;
    LAS float* PART = (LAS float*)(lds + 66048);
    LAS int* LCNT = (LAS int*)(lds + 66048 + 16384);
    LAS int* LBASE = LCNT + 64; LAS int* LENT = LCNT + 128;
    if (tid < 64) LCNT[tid] = 0;
    bf16x8 wh[2][4], wl[2][4];
#pragma unroll
    for (int nt = 0; nt < 2; ++nt)
#pragma unroll
        for (int ks = 0; ks < 4; ++ks) { const size_t o = ((size_t)l * NE + 16 * nt + fr) * D + 128 * wave + 32 * ks + 8 * fq; wh[nt][ks] = *(const bf16x8*)(RWH + o); wl[nt][ks] = *(const bf16x8*)(RWL + o); }
    const float bias = rb[lane & 31];
    __syncthreads();
    const int nb = l == 1 ? (MROWS - NB_ * CTX) / 16 : MROWS / 16;
    for (int bi = bx; bi < nb; bi += G) {
#pragma unroll
        for (int rr = 0; rr < 2; ++rr) { const int q = bi * 16 + 2 * wave + rr; const int r = l == 1 ? (q / SEQ) * NPOS + CTX + (q % SEQ) : q;
            const int b = r / NPOS, pos = r % NPOS, v = pos < CTX ? 4 : b; const float* mv = MODl + (size_t)v * 6144;
            float4 xv[4]; float ss = 0.f;
#pragma unroll
            for (int j = 0; j < 4; ++j) { xv[j] = *(const float4*)(H + (size_t)r * D + (j * 64 + lane) * 4); ss += xv[j].x * xv[j].x + xv[j].y * xv[j].y + xv[j].z * xv[j].z + xv[j].w * xv[j].w; }
            const float rs = rsqrtf(wave_sum(ss) * (1.f / D) + 1e-6f);
#pragma unroll
            for (int j = 0; j < 4; ++j) { const int c = (j * 64 + lane) * 4; const float4 gg = *(const float4*)(g + c), sh = *(const float4*)(mv + 3072 + c), sc = *(const float4*)(mv + 4096 + c);
                float f[4]; f[0] = xv[j].x * rs * gg.x * (1.f + sc.x) + sh.x; f[1] = xv[j].y * rs * gg.y * (1.f + sc.y) + sh.y; f[2] = xv[j].z * rs * gg.z * (1.f + sc.z) + sh.z; f[3] = xv[j].w * rs * gg.w * (1.f + sc.w) + sh.w;
                bf16_t hb[4], lb[4];
#pragma unroll
                for (int i = 0; i < 4; ++i) { hb[i] = f2bf(f[i]); lb[i] = f2bf(f[i] - bf2f(hb[i])); }
                u32x2 oh, ol; oh.x = (unsigned)hb[0] | ((unsigned)hb[1] << 16); oh.y = (unsigned)hb[2] | ((unsigned)hb[3] << 16); ol.x = (unsigned)lb[0] | ((unsigned)lb[1] << 16); ol.y = (unsigned)lb[2] | ((unsigned)lb[3] << 16);
                *(u32x2*)(XN + (size_t)r * D + c) = oh; *(LAS u32x2*)(FH + (2 * wave + rr) * FP + c) = oh; *(LAS u32x2*)(FL + (2 * wave + rr) * FP + c) = ol; } }
        __syncthreads();
        { f32x4 acc[2] = {(f32x4){0.f, 0.f, 0.f, 0.f}, (f32x4){0.f, 0.f, 0.f, 0.f}};
#pragma unroll
          for (int ks = 0; ks < 4; ++ks) { const bf16x8 ah = *(const LAS bf16x8*)(FH + fr * FP + 128 * wave + 32 * ks + 8 * fq), al = *(const LAS bf16x8*)(FL + fr * FP + 128 * wave + 32 * ks + 8 * fq);
#pragma unroll
              for (int nt = 0; nt < 2; ++nt) { acc[nt] = __builtin_amdgcn_mfma_f32_16x16x32_bf16(ah, wh[nt][ks], acc[nt], 0, 0, 0); acc[nt] = __builtin_amdgcn_mfma_f32_16x16x32_bf16(ah, wl[nt][ks], acc[nt], 0, 0, 0);
                  acc[nt] = __builtin_amdgcn_mfma_f32_16x16x32_bf16(al, wh[nt][ks], acc[nt], 0, 0, 0); } }
#pragma unroll
          for (int nt = 0; nt < 2; ++nt)
#pragma unroll
              for (int i = 0; i < 4; ++i) PART[(wave * 16 + 4 * fq + i) * 32 + 16 * nt + fr] = acc[nt][i]; }
        __syncthreads();
        { const int row = 2 * wave + (lane >> 5), e = lane & 31; const int q = bi * 16 + row; const int r = l == 1 ? (q / SEQ) * NPOS + CTX + (q % SEQ) : q;
          float lg = bias;
#pragma unroll
          for (int kw = 0; kw < 8; ++kw) lg += PART[(kw * 16 + row) * 32 + e];
          float val = lg; int idx = e; float tv[4]; int ti[4];
#pragma unroll
          for (int k = 0; k < 4; ++k) { float bv = val; int bi2 = idx;
#pragma unroll
              for (int o = 1; o < 32; o <<= 1) { const float ov = __shfl_xor(bv, o); const int oi = __shfl_xor(bi2, o); if (ov > bv || (ov == bv && oi < bi2)) { bv = ov; bi2 = oi; } }
              tv[k] = bv; ti[k] = bi2; if (idx == bi2) val = -3e38f; }
          if (e == 0) { float ex[4], sum = 0.f;
#pragma unroll
              for (int k = 0; k < 4; ++k) { ex[k] = __expf(tv[k] - tv[0]); sum += ex[k]; }
              const float isum = 1.f / sum;
#pragma unroll
              for (int k = 0; k < 4; ++k) { const int asg = r * 4 + k; GATE[asg] = ex[k] * isum; const int rank = __hip_atomic_fetch_add(&LCNT[ti[k]], 1, __ATOMIC_RELAXED, __HIP_MEMORY_SCOPE_WORKGROUP); const int slot = __hip_atomic_fetch_add(&LCNT[32], 1, __ATOMIC_RELAXED, __HIP_MEMORY_SCOPE_WORKGROUP);
                  LENT[slot * 2] = asg; LENT[slot * 2 + 1] = (ti[k] << 16) | rank; } } }
        __syncthreads();
    }
    if (tid < 32) LBASE[tid] = LCNT[tid] > 0 ? atomicAdd(&CNT[tid * L::CNT_STRIDE], LCNT[tid]) : 0;
    __syncthreads();
    for (int i = tid; i < LCNT[32]; i += 512) { const int asg = LENT[i * 2], er = LENT[i * 2 + 1], ee = er >> 16, rank = er & 0xffff; LIST[(size_t)ee * LCAP + LBASE[ee] + rank] = asg; }
    __syncthreads();
}
__device__ __forceinline__ void smallw_phase(const float* w_uq, const float* qg, const float* w_ukv, const float* kvg, const float* w_a, const float* w_i, bf16_t* WUQT, bf16_t* WUKVT, bf16_t* WAT, bf16_t* WIT,
                                             float* TABC, float* TABS, const float* lam, float* SPT, const float* rw, bf16_t* RWHp, bf16_t* RWLp, int gt, int NGT) {
    for (int i = gt; i < 2 * 384 * 256; i += NGT) { const int l = i / (384 * 256), q = i % (384 * 256), n = q >> 8, k = q & 255; WUQT[i] = f2bf(qg[l * 256 + k] * w_uq[((size_t)l * 256 + k) * 384 + n]); }
    for (int i = gt; i < 2 * 512 * 128; i += NGT) { const int l = i / (512 * 128), q = i % (512 * 128), n = q >> 7, k = q & 127; WUKVT[i] = f2bf(kvg[l * 128 + k] * w_ukv[((size_t)l * 128 + k) * 512 + n]); }
    for (int i = gt; i < 16 * 4096; i += NGT) { const int m = i >> 12, q = i & 4095, e = q >> 6, d = q & 63; WAT[i] = f2bf(w_a[(size_t)m * 4096 + d * 64 + e]); WIT[i] = f2bf(w_i[(size_t)m * 4096 + d * 64 + e]); }
    for (int i = gt; i < 4096; i += NGT) { float s, c; sincospif((float)i / 2048.f, &s, &c); TABC[i] = c; TABS[i] = s; }
    for (int i = gt; i < 1024; i += NGT) SPT[i] = log1pf(__expf(-lam[i]));
    for (int i = gt; i < 2 * NE * D; i += NGT) { const int l = i / (NE * D), q = i % (NE * D), e = q >> 10, k = q & 1023; const float w = rw[((size_t)l * D + k) * NE + e]; const bf16_t h = f2bf(w); RWHp[i] = h; RWLp[i] = f2bf(w - bf2f(h)); }
}
}

namespace prep {
constexpr int O_KR = 0, O_CS = 8192, O_RS = 16384, O_CQ = 16896  , O_KS = 67072, O_CKV = 100864;
constexpr int CQP = 264, CKP = 136, QSP = 392, KSP = 264;
constexpr float C2 = 0.10206207261596577f * 1.4426950408889634f;
__device__ __forceinline__ void qkv_units(LAS unsigned char* lds, int l, const bf16_t* P, const bf16_t* WUQT, const bf16_t* WUKVT, const float* scw, const float* scb,
                                          bf16_t* QL, bf16_t* QC, bf16_t* KB, bf16_t* VTG, bf16_t* MIX, int u0, int u1, int ustep) {
    LAS float* KRo = (LAS float*)(lds + O_KR); LAS float* CS = (LAS float*)(lds + O_CS); LAS float* RS = (LAS float*)(lds + O_RS);
    LAS bf16_t* CQ = (LAS bf16_t*)(lds + O_CQ); LAS bf16_t* CK = (LAS bf16_t*)(lds + O_CKV); LAS bf16_t* KS = (LAS bf16_t*)(lds + O_KS); LAS bf16_t* QS = (LAS bf16_t*)(lds + O_CQ);
    for (int unit = u0; unit < u1; unit += ustep) {
        int tid_l = threadIdx.x; asm volatile("" : "+v"(tid_l));
        const int tid = tid_l, lane = tid & 63, w = __builtin_amdgcn_readfirstlane(tid >> 6), fr = lane & 15, fq = lane >> 4;
        const int b = unit / 68, chunk = unit % 68, pos0 = 64 * chunk; const bool ctxt = chunk < 4; const size_t r0 = (size_t)b * NPOS + pos0;
#pragma unroll
        for (int i = 0; i < 4; ++i) { const int q = tid + 512 * i, row = q >> 5, ch = q & 31; *(LAS u32x4*)((LAS unsigned char*)CQ + row * (CQP * 2) + ch * 16) = *(const u32x4*)(P + (r0 + row) * PP + C_CQ + ch * 8); }
#pragma unroll
        for (int i = 0; i < 2; ++i) { const int q = tid + 512 * i, row = q >> 4, ch = q & 15; *(LAS u32x4*)((LAS unsigned char*)CK + row * (CKP * 2) + ch * 16) = *(const u32x4*)(P + (r0 + row) * PP + C_CKV + ch * 8); }
        __syncthreads();
        { const int row = tid >> 3, j = tid & 7; float sq = 0.f, sk = 0.f;
#pragma unroll
          for (int i = 0; i < 4; ++i) { const u32x4 v = *(const LAS u32x4*)((const LAS unsigned char*)CQ + row * (CQP * 2) + j * 64 + i * 16);
#pragma unroll
              for (int e = 0; e < 4; ++e) { const float a = __uint_as_float(v[e] << 16), c = __uint_as_float(v[e] & 0xffff0000u); sq += a * a + c * c; } }
#pragma unroll
          for (int i = 0; i < 2; ++i) { const u32x4 v = *(const LAS u32x4*)((const LAS unsigned char*)CK + row * (CKP * 2) + j * 32 + i * 16);
#pragma unroll
              for (int e = 0; e < 4; ++e) { const float a = __uint_as_float(v[e] << 16), c = __uint_as_float(v[e] & 0xffff0000u); sk += a * a + c * c; } }
          sq += __shfl_xor(sq, 1); sq += __shfl_xor(sq, 2); sq += __shfl_xor(sq, 4); sk += __shfl_xor(sk, 1); sk += __shfl_xor(sk, 2); sk += __shfl_xor(sk, 4);
          if (j == 0) { RS[row * 2] = rsqrtf(sq * (1.f / 256.f) + 1e-6f); RS[row * 2 + 1] = rsqrtf(sk * (1.f / 128.f) + 1e-6f); }
          float cr = 1.f, sr = 0.f, cc = 1.f, sc = 0.f;
          if (!ctxt) { const int t = pos0 - CTX + row; const float inv = __expf(-9.210340371976184f * (float)j * 0.125f); float xa = (float)(t >> 6) * inv * 0.15915494309189535f; xa -= rintf(xa); sr = __sinf(xa * 6.283185307179586f); cr = __cosf(xa * 6.283185307179586f); float xb = (float)(t & 63) * inv * 0.15915494309189535f; xb -= rintf(xb); sc = __sinf(xb * 6.283185307179586f); cc = __cosf(xb * 6.283185307179586f); }
          CS[(row * 16 + j) * 2] = cr; CS[(row * 16 + j) * 2 + 1] = sr; CS[(row * 16 + 8 + j) * 2] = cc; CS[(row * 16 + 8 + j) * 2 + 1] = sc;
          const bf16_t* kp = P + (r0 + row) * PP + C_KR; const float z0 = bf2f(kp[j]), z1 = bf2f(kp[8 + j]), z2 = bf2f(kp[16 + j]), z3 = bf2f(kp[24 + j]);
          KRo[row * 32 + j] = z0 * cr - z1 * sr; KRo[row * 32 + 8 + j] = z0 * sr + z1 * cr; KRo[row * 32 + 16 + j] = z2 * cc - z3 * sc; KRo[row * 32 + 24 + j] = z2 * sc + z3 * cc; }
        __builtin_amdgcn_sched_barrier(0);
        { f32x4 qa[4][3];
#pragma unroll
          for (int mt = 0; mt < 4; ++mt)
#pragma unroll
              for (int n = 0; n < 3; ++n) qa[mt][n] = (f32x4){0.f, 0.f, 0.f, 0.f};
          const bf16_t* wq = WUQT + ((size_t)l * 384 + 48 * w + fr) * 256 + 8 * fq;
#pragma unroll
          for (int ks = 0; ks < 8; ++ks) { bf16x8 a[4], bb[3];
#pragma unroll
              for (int mt = 0; mt < 4; ++mt) a[mt] = *(const LAS bf16x8*)(CQ + (16 * mt + fr) * CQP + 32 * ks + 8 * fq);
#pragma unroll
              for (int n = 0; n < 3; ++n) bb[n] = *(const bf16x8*)(wq + (size_t)(16 * n) * 256 + 32 * ks);
#pragma unroll
              for (int mt = 0; mt < 4; ++mt)
#pragma unroll
                  for (int n = 0; n < 3; ++n) qa[mt][n] = __builtin_amdgcn_mfma_f32_16x16x32_bf16(a[mt], bb[n], qa[mt][n], 0, 0, 0); }
          __syncthreads();
#pragma unroll
          for (int n = 0; n < 3; ++n) { const int nt = 3 * w + n, m6 = nt % 6, col = 16 * nt + fr;
#pragma unroll
              for (int mt = 0; mt < 4; ++mt)
#pragma unroll
                  for (int i = 0; i < 4; ++i) { const int row = 16 * mt + 4 * fq + i; float v = qa[mt][n][i] * RS[row * 2];
                      if (m6 >= 4) { const float pv = __shfl_xor(v, 8); const int ci = (row * 16 + (m6 == 5 ? 8 : 0) + (fr & 7)) * 2; const float c = CS[ci], s = CS[ci + 1]; v = (fr < 8) ? v * c - pv * s : pv * s + v * c; }
                      QS[row * QSP + col] = f2bf(v * C2); } } }
        __builtin_amdgcn_sched_barrier(0);
        { f32x4 ka[4][4];
#pragma unroll
          for (int mt = 0; mt < 4; ++mt)
#pragma unroll
              for (int n = 0; n < 4; ++n) ka[mt][n] = (f32x4){0.f, 0.f, 0.f, 0.f};
          const bf16_t* wk = WUKVT + ((size_t)l * 512 + 64 * w + fr) * 128 + 8 * fq;
#pragma unroll
          for (int ks = 0; ks < 4; ++ks) { bf16x8 a[4], bb[4];
#pragma unroll
              for (int mt = 0; mt < 4; ++mt) a[mt] = *(const LAS bf16x8*)(CK + (16 * mt + fr) * CKP + 32 * ks + 8 * fq);
#pragma unroll
              for (int n = 0; n < 4; ++n) bb[n] = *(const bf16x8*)(wk + (size_t)(16 * n) * 128 + 32 * ks);
#pragma unroll
              for (int mt = 0; mt < 4; ++mt)
#pragma unroll
                  for (int n = 0; n < 4; ++n) ka[mt][n] = __builtin_amdgcn_mfma_f32_16x16x32_bf16(a[mt], bb[n], ka[mt][n], 0, 0, 0); }
          const int head = w >> 1;
          if ((w & 1) == 0) {
#pragma unroll
              for (int n = 0; n < 4; ++n)
#pragma unroll
                  for (int mt = 0; mt < 4; ++mt)
#pragma unroll
                      for (int i = 0; i < 4; ++i) { const int row = 16 * mt + 4 * fq + i; KS[row * KSP + head * 64 + 16 * n + fr] = f2bf(ka[mt][n][i] * RS[row * 2 + 1]); }
          } else {
#pragma unroll
              for (int n = 0; n < 4; ++n)
#pragma unroll
                  for (int mt = 0; mt < 4; ++mt) { const int rb = 16 * mt + 4 * fq; u32x2 o; o.x = pk2(ka[mt][n][0] * RS[rb * 2 + 1], ka[mt][n][1] * RS[rb * 2 + 3]); o.y = pk2(ka[mt][n][2] * RS[rb * 2 + 5], ka[mt][n][3] * RS[rb * 2 + 7]);
                      *(u32x2*)(VTG + ((size_t)(b * 4 + head) * 64 + 16 * n + fr) * NPOS + pos0 + rb) = o; } } }
        __syncthreads();
#pragma unroll
        for (int i = 0; i < 6; ++i) { const int q = tid + 512 * i, row = q / 48, rem = q % 48, head = rem / 12, ch = rem % 12, pos = pos0 + row;
            const u32x4 qv = *(const LAS u32x4*)((const LAS unsigned char*)QS + row * (QSP * 2) + (head * 96 + ch * 8) * 2);
            if (!ctxt) *(u32x4*)(QL + ((size_t)(b * 4 + head) * SEQ + (pos - CTX)) * 96 + ch * 8) = qv; else if (l == 0) *(u32x4*)(QC + ((size_t)(b * 4 + head) * CTX + pos) * 96 + ch * 8) = qv;
            u32x4 kv;
            if (ch < 8) kv = *(const LAS u32x4*)((const LAS unsigned char*)KS + row * (KSP * 2) + (head * 64 + ch * 8) * 2);
            else { const LAS float* kr = KRo + row * 32 + (ch - 8) * 8; kv.x = pk2(kr[0], kr[1]); kv.y = pk2(kr[2], kr[3]); kv.z = pk2(kr[4], kr[5]); kv.w = pk2(kr[6], kr[7]); }
            *(u32x4*)(KB + ((size_t)(b * 4 + head) * NPOS + pos) * 96 + ch * 8) = kv; }
        if (!(ctxt && l == 1)) { const int lo = ctxt ? 0 : CTX, hi = ctxt ? CTX : NPOS;
#pragma unroll
            for (int i = 0; i < 4; ++i) { const int q = tid + 512 * i, row = q >> 5, ch = q & 31, pos = pos0 + row; float acc[8];
#pragma unroll
                for (int e = 0; e < 8; ++e) acc[e] = scb[ch * 8 + e];
#pragma unroll
                for (int k = 0; k < 3; ++k) { const int p = pos - 1 + k; if (p >= lo && p < hi) { const bf16_t* pr = P + ((size_t)b * NPOS + p) * PP; const u32x4 sx = *(const u32x4*)(pr + C_SX + ch * 8), sc = *(const u32x4*)(pr + C_SC + ch * 8);
#pragma unroll
                        for (int e = 0; e < 4; ++e) { const float w0 = scw[k * 256 + ch * 8 + 2 * e], w1 = scw[k * 256 + ch * 8 + 2 * e + 1];
                            acc[2 * e] += w0 * (__uint_as_float(sx[e] << 16) * __uint_as_float(sc[e] << 16)); acc[2 * e + 1] += w1 * (__uint_as_float(sx[e] & 0xffff0000u) * __uint_as_float(sc[e] & 0xffff0000u)); } } }
                const u32x4 sb = *(const u32x4*)(P + (r0 + row) * PP + C_SB + ch * 8); u32x4 o;
#pragma unroll
                for (int e = 0; e < 4; ++e) o[e] = pk2(__uint_as_float(sb[e] << 16) * acc[2 * e], __uint_as_float(sb[e] & 0xffff0000u) * acc[2 * e + 1]);
                *(u32x4*)(MIX + (r0 + row) * D + 768 + ch * 8) = o; } }
        __syncthreads();
    }
}
}

namespace lru {
constexpr int XP = 264, O_X = 0, O_NA = 33792, O_BB = 66560;
__device__ __forceinline__ float sigm(float x) { return __builtin_amdgcn_rcpf(1.f + __expf(-x)); }
__device__ __forceinline__ void chunk_units(LAS unsigned char* lds, int l, const bf16_t* P, const float* conv_w, const float* conv_b, const bf16_t* WAT, const bf16_t* WIT, const float* b_a, const float* b_i, const float* SPT,
                                            bf16_t* HL, bf16_t* AC, float* SUM, int u0, int u1, int ustep, int knob) {
    LAS bf16_t* X = (LAS bf16_t*)(lds + O_X); LAS bf16_t* NA = (LAS bf16_t*)(lds + O_NA); LAS bf16_t* BB = (LAS bf16_t*)(lds + O_BB);
    for (int unit = u0; unit < u1; unit += ustep) {
        int tid_l = threadIdx.x; asm volatile("" : "+v"(tid_l));
        const int tid = tid_l, lane = tid & 63, w = __builtin_amdgcn_readfirstlane(tid >> 6), fr = lane & 15, fq = lane >> 4;
        const int dir = unit & 1, bc = unit >> 1, b = bc / 68, chunk = bc % 68, pos0 = 64 * chunk; const int lo = chunk < 4 ? 0 : CTX, hi = chunk < 4 ? CTX : NPOS, left = dir ? 1 : 2;
        const size_t r0 = (size_t)b * NPOS + pos0; const int pd = (l * 2 + dir) * 256;
        if (!(knob & 1)) { const int cg = tid & 31, ts = tid >> 5, c0 = cg * 8; float wv[4][8], cbv[8];
#pragma unroll
          for (int e = 0; e < 8; ++e) { cbv[e] = conv_b[pd + c0 + e];
#pragma unroll
              for (int k = 0; k < 4; ++k) wv[k][e] = conv_w[(size_t)pd * 4 + k * 256 + c0 + e]; }
          const bf16_t* pc = P + (size_t)b * NPOS * PP + C_LX + c0; const int pb = pos0 + 4 * ts - left;
          u32x4 u[7];
#pragma unroll
          for (int i = 0; i < 7; ++i) { const int p = pb + i; const int pcl = p < lo ? lo : (p >= hi ? hi - 1 : p); u[i] = *(const u32x4*)(pc + (size_t)pcl * PP); if (p < lo || p >= hi) u[i] = (u32x4){0u, 0u, 0u, 0u}; }
#pragma unroll
          for (int i = 0; i < 4; ++i) { u32x4 o;
#pragma unroll
              for (int e2 = 0; e2 < 4; ++e2) { float lo_ = cbv[2 * e2], hi_ = cbv[2 * e2 + 1];
#pragma unroll
                  for (int k = 0; k < 4; ++k) { const unsigned d = u[i + k][e2]; lo_ += wv[k][2 * e2] * __uint_as_float(d << 16); hi_ += wv[k][2 * e2 + 1] * __uint_as_float(d & 0xffff0000u); }
                  o[e2] = pk2(lo_, hi_); }
              *(LAS u32x4*)(X + (4 * ts + i) * XP + c0) = o; } }
        __syncthreads();
        if (!(knob & 2)) { const int h = w >> 1, mh = w & 1;
          f32x4 ra[2][4], ri[2][4];
#pragma unroll
          for (int m = 0; m < 2; ++m)
#pragma unroll
              for (int n = 0; n < 4; ++n) { ra[m][n] = (f32x4){0.f, 0.f, 0.f, 0.f}; ri[m][n] = (f32x4){0.f, 0.f, 0.f, 0.f}; }
          const bf16_t* wa = WAT + ((size_t)((l * 2 + dir) * 4 + h) * 64 + fr) * 64 + 8 * fq; const bf16_t* wi = WIT + ((size_t)((l * 2 + dir) * 4 + h) * 64 + fr) * 64 + 8 * fq;
#pragma unroll
          for (int ks = 0; ks < 2; ++ks) { bf16x8 a[2], ba[4], bi[4];
#pragma unroll
              for (int m = 0; m < 2; ++m) a[m] = *(const LAS bf16x8*)(X + (16 * (2 * mh + m) + fr) * XP + 64 * h + 32 * ks + 8 * fq);
#pragma unroll
              for (int n = 0; n < 4; ++n) { ba[n] = *(const bf16x8*)(wa + (size_t)(16 * n) * 64 + 32 * ks); bi[n] = *(const bf16x8*)(wi + (size_t)(16 * n) * 64 + 32 * ks); }
#pragma unroll
              for (int m = 0; m < 2; ++m)
#pragma unroll
                  for (int n = 0; n < 4; ++n) { ra[m][n] = __builtin_amdgcn_mfma_f32_16x16x32_bf16(a[m], ba[n], ra[m][n], 0, 0, 0); ri[m][n] = __builtin_amdgcn_mfma_f32_16x16x32_bf16(a[m], bi[n], ri[m][n], 0, 0, 0); } }
#pragma unroll
          for (int n = 0; n < 4; ++n) { const int c = 64 * h + 16 * n + fr; const float bav = b_a[pd + c], biv = b_i[pd + c], sp8 = 8.f * SPT[pd + c];
#pragma unroll
              for (int m = 0; m < 2; ++m)
#pragma unroll
                  for (int i = 0; i < 4; ++i) { const int t = 16 * (2 * mh + m) + 4 * fq + i; const float r = sigm(ra[m][n][i] + bav), ig = sigm(ri[m][n][i] + biv);
                      const float x = r * sp8; const float na = x < 0.03125f ? x * (1.f - 0.5f * x * (1.f - 0.33333334f * x * (1.f - 0.25f * x))) : 1.f - __expf(-x); const float xv = bf2f(X[t * XP + c]);
                      NA[t * 256 + c] = f2bf(na); BB[t * 256 + c] = f2bf(__builtin_amdgcn_sqrtf(fmaxf(na * (2.f - na), 0.f)) * (ig * xv)); } } }
        __syncthreads();
        if (tid < 256 && !(knob & 4)) { const int c = tid; float hst = 0.f, A = 1.f;
            if (dir == 0) {
#pragma unroll 8
                for (int t = 0; t < 64; ++t) { const float a = 1.f - bf2f(NA[t * 256 + c]); hst = a * hst + bf2f(BB[t * 256 + c]); A *= a; BB[t * 256 + c] = f2bf(hst); NA[t * 256 + c] = f2bf(A); }
            } else {
#pragma unroll 8
                for (int t = 63; t >= 0; --t) { const float a = 1.f - bf2f(NA[t * 256 + c]); hst = a * hst + bf2f(BB[t * 256 + c]); A *= a; BB[t * 256 + c] = f2bf(hst); NA[t * 256 + c] = f2bf(A); }
            }
            float* sm = SUM + ((size_t)(dir * 4 + b) * 68 + chunk) * 512; sm[c] = A; sm[256 + c] = hst; }
        __syncthreads();
        if (!(knob & 4)) {
#pragma unroll
            for (int i = 0; i < 4; ++i) { const int q = tid + 512 * i, t = q >> 5, ch = q & 31; const size_t go = ((size_t)dir * MROWS + r0 + t) * 256 + ch * 8;
                *(u32x4*)(AC + go) = *(const LAS u32x4*)(NA + t * 256 + ch * 8); *(u32x4*)(HL + go) = *(const LAS u32x4*)(BB + t * 256 + ch * 8); } }
        __syncthreads();
    }
}
__device__ __forceinline__ void fixup_units(LAS unsigned char* lds, int l, const bf16_t* P, const bf16_t* HL, const bf16_t* AC, const float* SUM, bf16_t* MIX, int G, int bx) {
    LAS float* CAR = (LAS float*)lds;
    for (int unit = bx; unit < 272; unit += G) {
        int tid_l = threadIdx.x; asm volatile("" : "+v"(tid_l));
        const int tid = tid_l;
        const int b = unit / 68, chunk = unit % 68; if (l == 1 && chunk < 4) continue;
        { const int dir = tid >> 8, c = tid & 255; const float* sp = SUM + ((size_t)(dir * 4 + b) * 68) * 512 + c;
          const int n_pre = dir == 0 ? chunk : (chunk < 4 ? 3 - chunk : 4 + (67 - chunk));
          float cy = 0.f;
          for (int j0 = 0; j0 < n_pre; j0 += 16) { float av[16], hv[16];
#pragma unroll
              for (int u = 0; u < 16; ++u) { const int n = j0 + u < n_pre ? j0 + u : n_pre - 1; const int j = dir == 0 ? n : (n < 4 ? 3 - n : 71 - n); av[u] = sp[(size_t)j * 512]; hv[u] = sp[(size_t)j * 512 + 256]; }
#pragma unroll
              for (int u = 0; u < 16; ++u) cy = (j0 + u < n_pre) ? hv[u] + av[u] * cy : cy; }
          CAR[tid] = cy; }
        __syncthreads();
        { const int cg = tid & 31, ts = tid >> 5, c0 = cg * 8; float cf[8], cb[8];
#pragma unroll
          for (int e = 0; e < 8; ++e) { cf[e] = CAR[c0 + e]; cb[e] = CAR[256 + c0 + e]; }
          const size_t r0 = (size_t)b * NPOS + 64 * chunk + 4 * ts;
          u32x4 hf[4], af[4], hb[4], ab[4], gt[4];
#pragma unroll
          for (int i = 0; i < 4; ++i) { const size_t r = r0 + i; hf[i] = *(const u32x4*)(HL + r * 256 + c0); af[i] = *(const u32x4*)(AC + r * 256 + c0); hb[i] = *(const u32x4*)(HL + ((size_t)MROWS + r) * 256 + c0); ab[i] = *(const u32x4*)(AC + ((size_t)MROWS + r) * 256 + c0);
              gt[i] = *(const u32x4*)(P + r * PP + C_LG + c0); }
#pragma unroll
          for (int i = 0; i < 4; ++i) { u32x4 o;
#pragma unroll
              for (int e2 = 0; e2 < 4; ++e2) { float res[2];
#pragma unroll
                  for (int hh = 0; hh < 2; ++hh) { const int e = 2 * e2 + hh;
                      const float vhf = hh ? __uint_as_float(hf[i][e2] & 0xffff0000u) : __uint_as_float(hf[i][e2] << 16), vaf = hh ? __uint_as_float(af[i][e2] & 0xffff0000u) : __uint_as_float(af[i][e2] << 16);
                      const float vhb = hh ? __uint_as_float(hb[i][e2] & 0xffff0000u) : __uint_as_float(hb[i][e2] << 16), vab = hh ? __uint_as_float(ab[i][e2] & 0xffff0000u) : __uint_as_float(ab[i][e2] << 16);
                      const float x = hh ? __uint_as_float(gt[i][e2] & 0xffff0000u) : __uint_as_float(gt[i][e2] << 16);
                      const float hsum = (vhf + vaf * cf[e]) + (vhb + vab * cb[e]);
                      const float u = 0.7978845608028654f * (x + 0.044715f * x * x * x); const float th_ = 1.f - 2.f * __builtin_amdgcn_rcpf(1.f + __expf(2.f * u));
                      res[hh] = 0.5f * x * (1.f + th_) * hsum; }
                  o[e2] = pk2(res[0], res[1]); }
              *(u32x4*)(MIX + (r0 + i) * D + 256 + c0) = o; } }
        __syncthreads();
    }
}
}

namespace fft {
__device__ __forceinline__ void ctx_a(LAS unsigned char* lds, const bf16_t* P, const float* TABC, const float* TABS, bf16_t* XCT, int G, int bx) {
    LAS bf16_t* U = (LAS bf16_t*)(lds + O_U); LAS bf16_t* X = (LAS bf16_t*)(lds + O_X);
    for (int unit = bx; unit < 16; unit += G) {
        int tid_l = threadIdx.x; asm volatile("" : "+v"(tid_l));
        const int tid = tid_l, lane = tid & 63, w = __builtin_amdgcn_readfirstlane(tid >> 6), fr = lane & 15, fq = lane >> 4;
        build_tables(lds, TABC, TABS, tid);
        const LAS bf16_t* Tc = (const LAS bf16_t*)(lds + O_TC); const LAS bf16_t* Ts = (const LAS bf16_t*)(lds + O_TS);
        const int b = unit >> 2, q = unit & 3;
#pragma unroll
        for (int i = 0; i < 4; ++i) { const int qq = tid + 512 * i, t1 = qq >> 5, ch = qq & 31;
            *(LAS u32x4*)((LAS unsigned char*)U + t1 * (UP * 2) + ch * 16) = *(const u32x4*)(P + ((size_t)b * NPOS + 64 * q + t1) * PP + ch * 8); }
        __syncthreads();
        { const int g = w >> 1, part = w & 1; const LAS bf16_t* T = part ? Ts : Tc;
          f32x4 acc[4][4];
#pragma unroll
          for (int mt = 0; mt < 4; ++mt)
#pragma unroll
              for (int nt = 0; nt < 4; ++nt) acc[mt][nt] = (f32x4){0.f, 0.f, 0.f, 0.f};
#pragma unroll
          for (int ks = 0; ks < 2; ++ks) { bf16x8 a[4], bb[4];
#pragma unroll
              for (int mt = 0; mt < 4; ++mt) a[mt] = *(const LAS bf16x8*)(U + (16 * mt + fr) * UP + g * 64 + 32 * ks + 8 * fq);
#pragma unroll
              for (int nt = 0; nt < 4; ++nt) bb[nt] = *(const LAS bf16x8*)(T + (16 * nt + fr) * TP + 32 * ks + 8 * fq);
#pragma unroll
              for (int mt = 0; mt < 4; ++mt)
#pragma unroll
                  for (int nt = 0; nt < 4; ++nt) acc[mt][nt] = __builtin_amdgcn_mfma_f32_16x16x32_bf16(a[mt], bb[nt], acc[mt][nt], 0, 0, 0); }
          const float sg = part ? -1.f : 1.f;
#pragma unroll
          for (int mt = 0; mt < 4; ++mt)
#pragma unroll
              for (int nt = 0; nt < 4; ++nt) { const f32x4 v = acc[mt][nt] * sg; u32x2 o; o.x = pk2(v[0], v[1]); o.y = pk2(v[2], v[3]);
                  *(LAS u32x2*)(X + (part * 256 + g * 64 + 16 * nt + fr) * TP + 16 * mt + 4 * fq) = o; } }
        __syncthreads();
#pragma unroll
        for (int i = 0; i < 8; ++i) { const int qq = tid + 512 * i, row = qq >> 3, c8 = qq & 7;
            *(u32x4*)(XCT + (((size_t)b * 4 + q) * 512 + row) * 64 + c8 * 8) = *(const LAS u32x4*)((const LAS unsigned char*)X + row * (TP * 2) + c8 * 16); }
        __syncthreads();
    }
}
__device__ __forceinline__ void ctx_b(LAS unsigned char* lds, const bf16_t* XCT, const float* TABC, const float* TABS, bf16_t* MIX, int G, int bx) {
    LAS bf16_t* Tc = (LAS bf16_t*)(lds + O_TC); LAS bf16_t* Ts = (LAS bf16_t*)(lds + O_TS);
    LAS bf16_t* Ys = (LAS bf16_t*)(lds + O_U); LAS bf16_t* ZT = (LAS bf16_t*)(lds + O_X);
    for (int unit = bx; unit < 16; unit += G) {
        int tid_l = threadIdx.x; asm volatile("" : "+v"(tid_l));
        const int tid = tid_l, lane = tid & 63, w = __builtin_amdgcn_readfirstlane(tid >> 6), fr = lane & 15, fq = lane >> 4;
        const int b = unit >> 2, ft = unit & 3;
        f32x4 y[4][2];
#pragma unroll
        for (int mt = 0; mt < 4; ++mt)
#pragma unroll
            for (int n = 0; n < 2; ++n) y[mt][n] = (f32x4){0.f, 0.f, 0.f, 0.f};
        for (int q = 0; q < 4; ++q) {
            for (int i = tid; i < 4096; i += 512) { const int fl = i >> 6, tl = i & 63, ix = (((64 * ft + fl) * (64 * q + tl)) & 255) * 16; Tc[fl * TP + tl] = f2bf(TABC[ix]); Ts[fl * TP + tl] = f2bf(TABS[ix]); }
#pragma unroll
            for (int i = 0; i < 8; ++i) { const int qq = tid + 512 * i, row = qq >> 3, c8 = qq & 7;
                *(LAS u32x4*)((LAS unsigned char*)ZT + row * (TP * 2) + c8 * 16) = *(const u32x4*)(XCT + (((size_t)b * 4 + q) * 512 + row) * 64 + c8 * 8); }
            __syncthreads();
#pragma unroll
            for (int ks = 0; ks < 2; ++ks) { bf16x8 xr[2], xi[2];
#pragma unroll
                for (int n = 0; n < 2; ++n) { xr[n] = *(const LAS bf16x8*)(ZT + (32 * w + 16 * n + fr) * TP + 32 * ks + 8 * fq); xi[n] = *(const LAS bf16x8*)(ZT + (256 + 32 * w + 16 * n + fr) * TP + 32 * ks + 8 * fq); }
#pragma unroll
                for (int mt = 0; mt < 4; ++mt) { const bf16x8 c = *(const LAS bf16x8*)(Tc + (16 * mt + fr) * TP + 32 * ks + 8 * fq), s = *(const LAS bf16x8*)(Ts + (16 * mt + fr) * TP + 32 * ks + 8 * fq);
#pragma unroll
                    for (int n = 0; n < 2; ++n) { y[mt][n] = __builtin_amdgcn_mfma_f32_16x16x32_bf16(c, xr[n], y[mt][n], 0, 0, 0); y[mt][n] = __builtin_amdgcn_mfma_f32_16x16x32_bf16(s, xi[n], y[mt][n], 0, 0, 0); } } }
            __syncthreads();
        }
#pragma unroll
        for (int mt = 0; mt < 4; ++mt)
#pragma unroll
            for (int i = 0; i < 4; ++i)
#pragma unroll
                for (int n = 0; n < 2; ++n) Ys[(16 * mt + 4 * fq + i) * UP + 32 * w + 16 * n + fr] = f2bf(y[mt][n][i] * (1.f / 128.f));
        __syncthreads();
#pragma unroll
        for (int i = 0; i < 4; ++i) { const int qq = tid + 512 * i, fl = qq >> 5, ch = qq & 31;
            *(u32x4*)(MIX + ((size_t)b * NPOS + 64 * ft + fl) * D + ch * 8) = *(const LAS u32x4*)((const LAS unsigned char*)Ys + fl * (UP * 2) + ch * 16); }
        __syncthreads();
    }
}
}

constexpr int NWAVES = 8, RING_BYTES = 131072 + 3072, LDSCTL_OFF = RING_BYTES, MISC_OFF = LDSCTL_OFF + 64, META_OFF = MISC_OFF + 64, LDS_BYTES = 147456;
enum { PH_PRO0 = 0, PH_PRO1 = 1, PH_L0 = 2, PH_PER_LAYER = 8, PH_N = 18 };
enum { PL_WIN = 0, PL_PREP = 1, PL_MIX = 2, PL_WOUT = 3, PL_ROUTE = 4, PL_MOE1 = 5, PL_MOE2 = 6, PL_COMB = 7 };
struct MArgs { const float* in[30]; float* out; unsigned char* ws; int npass, skip_mask, dup_ph, dup_n, dup_sub, knob; };

__device__ __forceinline__ void transpose_item(const float* W, int K, int N, bf16_t* WT, int drow0, LAS float* scr, int k0, int n0, int lane) {
    const int kr = lane >> 3, nc = (lane & 7) * 4;
    f32x4 v[8];
#pragma unroll
    for (int i = 0; i < 8; ++i) v[i] = __builtin_nontemporal_load((const f32x4*)(W + (size_t)(k0 + kr + 8 * i) * N + n0 + nc));
#pragma unroll
    for (int i = 0; i < 8; ++i) { LAS float* d = scr + (kr + 8 * i) * 33 + nc; d[0] = v[i][0]; d[1] = v[i][1]; d[2] = v[i][2]; d[3] = v[i][3]; }
    asm volatile("s_waitcnt lgkmcnt(0)" ::: "memory");
    const int c = lane & 7;
#pragma unroll
    for (int j = 0; j < 4; ++j) { const int n = (lane >> 3) + 8 * j; const LAS float* s = scr + (8 * c) * 33 + n;
        u32x4 o; o.x = pk2(s[0 * 33], s[1 * 33]); o.y = pk2(s[2 * 33], s[3 * 33]); o.z = pk2(s[4 * 33], s[5 * 33]); o.w = pk2(s[6 * 33], s[7 * 33]);
        *(u32x4*)(WT + (size_t)(drow0 + n) * K + k0 + 8 * c) = o; }
    asm volatile("s_waitcnt lgkmcnt(0)" ::: "memory");
}

constexpr int I_GU = NE * 16 * 64, I_DN = NE * 16 * 32, I_EXP = I_GU + I_DN;
__device__ __forceinline__ void expert_item(int l, int j, const float* wgu, const float* wdn, unsigned char* ws, LAS float* scr, int lane) {
    if (j < I_GU) { const int e = j / (16 * 64), q = j % (16 * 64), kb = q / 64, nb = q % 64; const int n0 = 32 * nb; const int c2 = n0 & 1023; const int drow = (c2 >> 7) * 256 + (n0 >> 10) * 128 + (c2 & 127);
        transpose_item(wgu + ((size_t)l * NE + e) * D * 2048, D, 2048, (bf16_t*)(ws + L::WGUT) + ((size_t)l * NE + e) * 2048 * D, drow, scr, 64 * kb, n0, lane); }
    else { const int r = j - I_GU; const int e = r / (16 * 32), q = r % (16 * 32), kb = q / 32, nb = q % 32;
        transpose_item(wdn + ((size_t)l * NE + e) * D * D, D, D, (bf16_t*)(ws + L::WDT) + ((size_t)l * NE + e) * D * D, 32 * nb, scr, 64 * kb, 32 * nb, lane); }
}
constexpr int Q_WIN = 48, Q_WOUT = 96, Q_MOE2 = 0;
constexpr int DEF_WIN = 224 * Q_WIN, DEF0 = DEF_WIN + 240 * Q_WOUT, DEF_MOE2 = 128 * Q_MOE2, DEF1 = DEF_MOE2 + 224 * Q_WIN;
__device__ __forceinline__ void deferred_items(int l, int first, int count, const float* wgu, const float* wdn, unsigned char* ws, LAS unsigned char* lds, int wave, int lane) {
    LAS float* scr = (LAS float*)(lds + wave * 16384);
    for (int j = first + wave; j < first + count; j += NWAVES) expert_item(l, j, wgu, wdn, ws, scr, lane);
}

#define GASP __attribute__((address_space(1)))
#define ARG_IN(i) ({ const GASP float* _p; asm volatile("s_load_dwordx2 %0, %1, %2\n\ts_waitcnt lgkmcnt(0)" : "=s"(_p) : "s"(__builtin_amdgcn_kernarg_segment_ptr()), "n"((i) * 8)); (const float*)_p; })
__global__ void __launch_bounds__(NWAVES * 64, 2) mega(MArgs args) {
    extern __shared__ __attribute__((aligned(16))) unsigned char lds_raw[];
    const int G0 = gridDim.x, bx0 = blockIdx.x;
    unsigned char* ws0 = args.ws;
    unsigned* ctl0 = (unsigned*)(ws0 + L::CTL);
    for (int u = threadIdx.x; u < (LDS_BYTES - LDSCTL_OFF) / 4; u += NWAVES * 64) ((LAS unsigned*)(lds_raw + LDSCTL_OFF))[u] = 0u;
    __syncthreads();
    volatile LAS unsigned* MISC = (volatile LAS unsigned*)((LAS unsigned char*)lds_raw + MISC_OFF);
    XcdBarrier bar = xcd_barrier_post(ctl0 + L::CW_BAR, MISC);
    const int lo = 0, hi = PH_N;

    bool first = true;
    for (int pass = 0; pass < args.npass; ++pass)
    for (int ph = lo; ph < hi; ++ph) {
      const int reps = (ph == args.dup_ph) ? 1 + args.dup_n : 1;
      for (int rep = 0; rep < reps; ++rep) {
        if (!first) xcd_barrier(bar);
        first = false;
        if (pass + 1 < args.npass && ((args.skip_mask >> ph) & 1)) continue;
        const int sub = rep + 1 < reps ? args.dup_sub : 15; const int knob = rep + 1 < reps ? args.knob : 0; (void)knob;
        GASP unsigned char* wsg = (GASP unsigned char*)args.ws; asm volatile("" : "+s"(wsg)); unsigned char* ws = (unsigned char*)wsg;
        unsigned* ctl = (unsigned*)(ws + L::CTL);
        int tid_p = threadIdx.x; asm volatile("" : "+v"(tid_p));
        int G = G0, bx = bx0; asm volatile("" : "+s"(G), "+s"(bx));
        const int vcu = (G % 8 == 0) ? (bx % 8) * (G / 8) + bx / 8 : bx; (void)vcu;
        unsigned ldsb = 0; asm volatile("" : "+s"(ldsb)); LAS unsigned char* lds = (LAS unsigned char*)lds_raw + ldsb;
        LAS int* META = (LAS int*)(lds + META_OFF);
        const int tid = tid_p, lane = tid & 63, wave = __builtin_amdgcn_readfirstlane(tid >> 6); (void)lane; (void)wave;
        if (ph == PH_PRO0) {
            if (bx == 0 && tid < 2 * NE) ((int*)(ctl + L::CW_CNT))[tid * L::CNT_STRIDE] = 0;
            LAS float* scr = (LAS float*)(lds + wave * 16384);
            const int gw = vcu * NWAVES + wave, NGW = G * NWAVES;
            constexpr int I_IN = 16 * 61, I_OUT = 16 * 32, I_D = I_IN + I_OUT; const int d0 = G == 256 ? DEF0 : 0, d1 = G == 256 ? DEF1 : 0, R0 = I_EXP - d0, R1 = I_EXP - d1;
            for (int it = gw; it < 2 * I_D + R0 + R1; it += NGW) {
                if (it < 2 * I_D) { const int l = it / I_D; int r = it % I_D;
                    if (r < I_IN) { const int kb = r / 61, nb = r % 61; transpose_item(ARG_IN(8) + (size_t)l * D * PT, D, PT, (bf16_t*)(ws + L::WINT) + (size_t)l * 2048 * D, 32 * nb, scr, 64 * kb, 32 * nb, lane); }
                    else { r -= I_IN; const int kb = r / 32, nb = r % 32; transpose_item(ARG_IN(22) + (size_t)l * D * D, D, D, (bf16_t*)(ws + L::WOUTT) + (size_t)l * D * D, 32 * nb, scr, 64 * kb, 32 * nb, lane); }
                } else { const int r = it - 2 * I_D; if (r < R0) expert_item(0, d0 + r, ARG_IN(25), ARG_IN(27), ws, scr, lane); else expert_item(1, d1 + (r - R0), ARG_IN(25), ARG_IN(27), ws, scr, lane); }
            }
            sm::smallw_phase(ARG_IN(17), ARG_IN(16), ARG_IN(19), ARG_IN(18), ARG_IN(11), ARG_IN(13), (bf16_t*)(ws + L::WUQT), (bf16_t*)(ws + L::WUKVT), (bf16_t*)(ws + L::WAT), (bf16_t*)(ws + L::WIT),
                             (float*)(ws + L::TABC), (float*)(ws + L::TABS), ARG_IN(15), (float*)(ws + L::SPT), ARG_IN(23), (bf16_t*)(ws + L::RWH), (bf16_t*)(ws + L::RWL), bx * 512 + tid, G * 512);
            __syncthreads();
            sm::mod_phase(lds, ARG_IN(1), ARG_IN(3), ARG_IN(4), ARG_IN(5), (float*)(ws + L::MOD), G, bx, tid);
            for (int i = bx * 512 + tid; i < 2 * 96 * D / 8; i += G * 512) { const int l = i / (96 * D / 8), q = i % (96 * D / 8); *(u32x4*)((bf16_t*)(ws + L::WINT) + ((size_t)l * 2048 + PT) * D + (size_t)q * 8) = (u32x4){0u, 0u, 0u, 0u}; }
            continue;
        }
        if (ph == PH_PRO1) { sm::pro1_phase(ARG_IN(0), ARG_IN(2), ARG_IN(6), (const float*)(ws + L::MOD), (float*)(ws + L::H), (bf16_t*)(ws + L::XN), bx * NWAVES + wave, G * NWAVES, lane); continue; }
        if (ph < PH_L0) continue;
        const int l = (ph - PH_L0) / PH_PER_LAYER, pl = (ph - PH_L0) % PH_PER_LAYER;
        const float* MODl = (const float*)(ws + L::MOD) + (size_t)l * 5 * 6144;
        if (pl == PL_WIN) {
            g8::DenseSched S; S.init(MROWS / 256, PP / 256, G, bx, 0, (const bf16_t*)(ws + L::WINT) + (size_t)l * 2048 * D, D);
            g8::EpiP E{(bf16_t*)(ws + L::P)};
            g8::gemm_phase<g8::EpiP, g8::DenseSched, false, false>(lds, (const char*)(ws + L::XN), S, E);
            if (G == 256 && bx >= 32) deferred_items(l, (l == 0 ? 0 : DEF_MOE2) + (bx - 32) * Q_WIN, Q_WIN, ARG_IN(25), ARG_IN(27), ws, lds, wave, lane);
        } else if (pl == PL_PREP) {
            if (l == 0 && (sub & 2)) { fft::ctx_a(lds, (const bf16_t*)(ws + L::P), (const float*)(ws + L::TABC), (const float*)(ws + L::TABS), (bf16_t*)(ws + L::XCT), G, G - 1 - bx); __syncthreads(); }
            for (int p = 0; p * G < 1072; ++p) {
                const int k = p * G + ((p & 1) ? G - 1 - bx : bx);
                if (k >= 1072) continue;
                if (k < 272) { if (sub & 4) prep::qkv_units(lds, l, (const bf16_t*)(ws + L::P), (const bf16_t*)(ws + L::WUQT), (const bf16_t*)(ws + L::WUKVT), ARG_IN(20) + l * 768, ARG_IN(21) + l * 256,
                            (bf16_t*)(ws + L::QL), (bf16_t*)(ws + L::QC), (bf16_t*)(ws + L::KB), (bf16_t*)(ws + L::VTG), (bf16_t*)(ws + L::MIX), k, k + 1, 1); }
                else if (k < 816) { if (sub & 8) lru::chunk_units(lds, l, (const bf16_t*)(ws + L::P), ARG_IN(9), ARG_IN(10), (const bf16_t*)(ws + L::WAT), (const bf16_t*)(ws + L::WIT), ARG_IN(12), ARG_IN(14), (const float*)(ws + L::SPT),
                             (bf16_t*)(ws + L::HL), (bf16_t*)(ws + L::AC), (float*)(ws + L::SUM), k - 272, k - 271, 1, knob); }
                else { if (sub & 1) fft::stage_a(lds, (const bf16_t*)(ws + L::P), (const float*)(ws + L::TABC), (const float*)(ws + L::TABS), (bf16_t*)(ws + L::ZBUF), k - 816, k - 815, 1); }
                __syncthreads();
            }
        } else if (pl == PL_MIX) {
            if (sub & 1) lru::fixup_units(lds, l, (const bf16_t*)(ws + L::P), (const bf16_t*)(ws + L::HL), (const bf16_t*)(ws + L::AC), (const float*)(ws + L::SUM), (bf16_t*)(ws + L::MIX), G, bx);
            if (sub & 2) fft::stage_b(lds, (const bf16_t*)(ws + L::ZBUF), (const float*)(ws + L::TABC), (const float*)(ws + L::TABS), (bf16_t*)(ws + L::MIX), G, bx);
            __syncthreads();
            if (l == 0 && (sub & 4)) { fft::ctx_b(lds, (const bf16_t*)(ws + L::XCT), (const float*)(ws + L::TABC), (const float*)(ws + L::TABS), (bf16_t*)(ws + L::MIX), G, G - 1 - bx); __syncthreads(); }
            if (sub & 8) attn::attn_phase(lds, (const bf16_t*)(ws + L::QL), (const bf16_t*)(ws + L::QC), (const bf16_t*)(ws + L::KB), (const bf16_t*)(ws + L::VTG), (bf16_t*)(ws + L::MIX), l == 0 ? 1 : 0, G, vcu);
        } else if (pl == PL_WOUT) {
            g8::DenseSched S; S.init(l == 0 ? MROWS / 256 : 64, D / 256, G, bx, l == 0 ? 0 : 1, (const bf16_t*)(ws + L::WOUTT) + (size_t)l * D * D, D);
            g8::EpiH E{(float*)(ws + L::H), MODl, 2048};
            g8::gemm_phase<g8::EpiH, g8::DenseSched, false, false>(lds, (const char*)(ws + L::MIX), S, E);
            if (G == 256 && l == 0 && bx >= 16) deferred_items(0, DEF_WIN + (bx - 16) * Q_WOUT, Q_WOUT, ARG_IN(25), ARG_IN(27), ws, lds, wave, lane);
        } else if (pl == PL_ROUTE) {
            sm::route_phase(lds, l, (const float*)(ws + L::H), ARG_IN(7) + l * D, MODl, (const bf16_t*)(ws + L::RWH), (const bf16_t*)(ws + L::RWL), ARG_IN(24) + l * NE, (bf16_t*)(ws + L::XN), (int*)(ctl + L::CW_CNT) + l * NE * L::CNT_STRIDE,
                            (int*)(ws + L::LIST) + (size_t)l * NE * LCAP, (float*)(ws + L::GATE), G, bx, tid);
        } else if (pl == PL_COMB) {
            sm::comb_phase(l, (float*)(ws + L::H), (const bf16_t*)(ws + L::Y), MODl, ARG_IN(6) + D, (const float*)(ws + L::MOD) + (size_t)5 * 6144, (bf16_t*)(ws + L::XN), ARG_IN(29), args.out, bx * NWAVES + wave, G * NWAVES, lane);
        } else if (pl == PL_MOE1 || pl == PL_MOE2) {
            const int* CNTg = (const int*)(ctl + L::CW_CNT) + l * NE * L::CNT_STRIDE;
            if (tid == 0) { int o = 0; for (int e = 0; e < NE; ++e) { const int cn = CNTg[e * L::CNT_STRIDE]; META[e] = o; META[64 + e] = cn; o += (cn + 255) >> 8; } META[NE] = o; }
            __syncthreads();
            g8::MoeSched S; S.tpre = META; S.cnt = META + 64; S.G = G; S.c = bx; S.K = D; S.list = (const int*)(ws + L::LIST) + (size_t)l * NE * LCAP;
            if (pl == PL_MOE1) {
                S.NT = 8; S.COLW = 128; S.total = __builtin_amdgcn_readfirstlane(META[NE]) * 8; S.Bt = (const char*)((const bf16_t*)(ws + L::WGUT) + (size_t)l * NE * 2048 * D);
                g8::EpiMoe1 E{(bf16_t*)(ws + L::ACT), ARG_IN(26) + (size_t)l * NE * 2048};
                g8::gemm_phase<g8::EpiMoe1, g8::MoeSched, true, true>(lds, (const char*)(ws + L::XN), S, E);
            } else {
                S.NT = 4; S.COLW = 256; S.total = __builtin_amdgcn_readfirstlane(META[NE]) * 4; S.Bt = (const char*)((const bf16_t*)(ws + L::WDT) + (size_t)l * NE * D * D);
                g8::EpiMoe2 E{(bf16_t*)(ws + L::Y), ARG_IN(28) + (size_t)l * NE * D, (const float*)(ws + L::GATE)};
                g8::gemm_phase<g8::EpiMoe2, g8::MoeSched, false, true>(lds, (const char*)(ws + L::ACT), S, E);
                if (G == 256 && l == 0 && bx >= 128) deferred_items(1, (bx - 128) * Q_MOE2, Q_MOE2, ARG_IN(25), ARG_IN(27), ws, lds, wave, lane);
            }
            __syncthreads();
        }
      }
    }
}
constexpr int PROBE_DUP_PH = -1, PROBE_DUP_N = 0, PROBE_DUP_SUB = 15, PROBE_KNOB = 0;
constexpr int PROBE_NPASS = 1, PROBE_SKIP = 0;
extern "C" void kernel_launch(void* const* d_in, const int* in_sizes, int n_in, void* d_out, int out_size, void* d_ws, size_t ws_size, hipStream_t stream) {
    static int grid = 0;
    if (grid == 0) {
        if (n_in != 30 || out_size != NB_ * SEQ * D || (size_t)L::END > ws_size) { fprintf(stderr, "kernel_launch: unexpected problem shape (n_in %d, out %d) or workspace too small (need %zu, have %zu); nothing launched\n", n_in, out_size, (size_t)L::END, ws_size); grid = -1; return; }
        int dev = 0, cus = 0;
        if (hipGetDevice(&dev) != hipSuccess || hipDeviceGetAttribute(&cus, hipDeviceAttributeMultiprocessorCount, dev) != hipSuccess) { fprintf(stderr, "kernel_launch: device query failed\n"); grid = -1; return; }
        if (hipFuncSetAttribute((const void*)mega, hipFuncAttributeMaxDynamicSharedMemorySize, LDS_BYTES) != hipSuccess) { fprintf(stderr, "kernel_launch: hipFuncSetAttribute failed\n"); grid = -1; return; }
        grid = cus < 256 ? cus : 256;
    }
    if (grid < 0) return;
    unsigned char* p = (unsigned char*)d_ws;
    (void)hipMemsetAsync(p + L::CTL, 0, L::CTL_BYTES, stream);
    MArgs a{};
    for (int i = 0; i < 30; ++i) a.in[i] = (const float*)d_in[i];
    a.out = (float*)d_out; a.ws = p; a.npass = PROBE_NPASS; a.skip_mask = PROBE_SKIP; a.dup_ph = PROBE_DUP_PH; a.dup_n = PROBE_DUP_N; a.dup_sub = PROBE_DUP_SUB; a.knob = PROBE_KNOB;
    hipLaunchKernelGGL(mega, dim3(grid), dim3(NWAVES * 64), LDS_BYTES, stream, a);
}
```

```cpp
#include <hip/hip_runtime.h>
#include <cstdint>
#include <cstdio>

typedef unsigned short bf16_t;
constexpr int NB_ = 4, SEQ = 4096, CTX = 256, D = 1024, NPOS = SEQ + CTX, MROWS = NB_ * NPOS;
constexpr int PT = 1952, PP = 2048;
constexpr int NE = 32, TOPK = 4, LCAP = MROWS;
constexpr int NASG = MROWS * TOPK;
constexpr int ACT_ROWS = NASG + NE * 256;
constexpr int C_FN = 0, C_LX = 256, C_LG = 512, C_CQ = 768, C_CKV = 1024, C_KR = 1152, C_SX = 1184, C_SB = 1440, C_SC = 1696;

__device__ __forceinline__ float bf2f(bf16_t v) { return __uint_as_float((unsigned)v << 16); }
__device__ __forceinline__ bf16_t f2bf(float f) { unsigned u = __float_as_uint(f); return (bf16_t)((u + 0x7fffu + ((u >> 16) & 1u)) >> 16); }
__device__ __forceinline__ float wave_sum(float v) {
#pragma unroll
    for (int o = 1; o < 64; o <<= 1) v += __shfl_xor(v, o);
    return v;
}
__device__ __forceinline__ float sigmoidf_(float x) { return 1.f / (1.f + __expf(-x)); }
__device__ __forceinline__ float gelu_tanh(float x) { const float u = 0.7978845608028654f * (x + 0.044715f * x * x * x); return 0.5f * x * (1.f + tanhf(u)); }

#define LAS __attribute__((address_space(3)))
typedef short bf16x8 __attribute__((ext_vector_type(8)));
typedef float f32x4 __attribute__((ext_vector_type(4)));
typedef unsigned u32x4 __attribute__((ext_vector_type(4)));
typedef unsigned u32x2 __attribute__((ext_vector_type(2)));
__device__ __forceinline__ unsigned pk2(float lo, float hi) { return (unsigned)f2bf(lo) | ((unsigned)f2bf(hi) << 16); }

namespace L {
constexpr size_t A256(size_t x) { return (x + 255) & ~(size_t)255; }
constexpr size_t CTL = 0, CTL_BYTES = 1u << 20;
constexpr size_t H = CTL + CTL_BYTES;
constexpr size_t MOD = CTL + 512 * 1024;
constexpr size_t TABC = A256(H + (size_t)MROWS * D * 4);
constexpr size_t TABS = A256(TABC + 4096 * 4);
constexpr size_t XN = A256(TABS + 4096 * 4);
constexpr size_t P = A256(XN + (size_t)MROWS * D * 2);
constexpr size_t MIX = A256(P + (size_t)MROWS * PP * 2);
constexpr size_t CQN = A256(MIX + (size_t)MROWS * D * 2);
constexpr size_t CKVN = A256(CQN + (size_t)MROWS * 256 * 2);
constexpr size_t QRAW = A256(CKVN + (size_t)MROWS * 128 * 2);
constexpr size_t KVRAW = A256(QRAW + (size_t)MROWS * 384 * 4);
constexpr size_t QL = A256(KVRAW + (size_t)MROWS * 512 * 4);
constexpr size_t QC = A256(QL + (size_t)16 * SEQ * 96 * 2);
constexpr size_t KB = A256(QC + (size_t)16 * CTX * 96 * 2);
constexpr size_t VB = A256(KB + (size_t)16 * NPOS * 96 * 2);
constexpr size_t LA = A256(VB + (size_t)16 * NPOS * 64 * 2);
constexpr size_t LB = A256(LA + (size_t)2 * MROWS * 256 * 4);
constexpr size_t HS = A256(LB + (size_t)2 * MROWS * 256 * 4);
constexpr size_t XCS = A256(HS + (size_t)2 * MROWS * 256 * 4);
constexpr size_t XCSC = A256(XCS + (size_t)4 * 8192 * 256 * 4);
constexpr size_t LIST = A256(XCSC + (size_t)4 * 512 * 256 * 4);
constexpr size_t GATE = A256(LIST + (size_t)2 * NE * LCAP * 4);
constexpr size_t ACT = A256(GATE + (size_t)NASG * 4);
constexpr size_t Y = A256(ACT + (size_t)ACT_ROWS * D * 2);
constexpr size_t WINT = A256(Y + (size_t)(NASG + 1) * D * 2);
constexpr size_t WOUTT = A256(WINT + (size_t)2 * 2048 * 1024 * 2);
constexpr size_t WGUT = A256(WOUTT + (size_t)2 * 1024 * 1024 * 2);
constexpr size_t WDT = A256(WGUT + (size_t)2 * NE * 2048 * 1024 * 2);
constexpr size_t ZBUF = A256(WDT + (size_t)2 * NE * 1024 * 1024 * 2);
constexpr size_t VTG = A256(ZBUF + (size_t)4 * 64 * 64 * 512 * 2);
constexpr size_t WUQT = A256(VTG + (size_t)16 * 64 * NPOS * 2);
constexpr size_t WUKVT = A256(WUQT + (size_t)2 * 384 * 256 * 2);
constexpr size_t WAT = A256(WUKVT + (size_t)2 * 512 * 128 * 2);
constexpr size_t WIT = A256(WAT + (size_t)16 * 4096 * 2);
constexpr size_t SPT = A256(WIT + (size_t)16 * 4096 * 2);
constexpr size_t RWH = A256(SPT + (size_t)1024 * 4);
constexpr size_t RWL = A256(RWH + (size_t)2 * NE * D * 2);
constexpr size_t HL = A256(RWL + (size_t)2 * NE * D * 2);
constexpr size_t AC = A256(HL + (size_t)2 * MROWS * 256 * 2);
constexpr size_t SUM = A256(AC + (size_t)2 * MROWS * 256 * 2);
constexpr size_t XCT = A256(SUM + (size_t)2 * 4 * 68 * 512 * 4);
constexpr size_t END = A256(XCT + (size_t)16 * 512 * 64 * 2);
constexpr int CW_BAR = 4096;
constexpr int CW_MODCNT = 2048;
constexpr int CW_CNT = 32768, CNT_STRIDE = 64;
}

#define XB_TMO      128
#define XB_XCNT(j)  (256  + 64 * (j))
#define XB_XSUB(j)  (1280 + 64 * (j))
#define XB_XGEN(j)  (2304 + 64 * (j))
#define XB_TOP      3328
#define XB_TOPGEN   3392
#define XCD_BAR_WORDS 3456
#define XB_SPIN_CAP (1u << 18)
__device__ __forceinline__ unsigned xb_ld(unsigned* p)              { return __hip_atomic_load(p, __ATOMIC_RELAXED, __HIP_MEMORY_SCOPE_AGENT); }
__device__ __forceinline__ unsigned xb_add(unsigned* p, unsigned v) { return __hip_atomic_fetch_add(p, v, __ATOMIC_RELAXED, __HIP_MEMORY_SCOPE_AGENT); }
__device__ __forceinline__ unsigned xb_xcc_id() { return (unsigned)__builtin_amdgcn_s_getreg((3 << 11) | 20) & 0xFu; }
#define XB_SPIN(cond, bar) do { unsigned _sp = 0; while (cond) { __builtin_amdgcn_s_sleep(1); \
    if ((++_sp & 255u) == 0u) { if (xb_ld(&(bar)[XB_TMO])) break; if (_sp > XB_SPIN_CAP) { atomicAdd(&(bar)[XB_TMO], 1u); break; } } } } while (0)
struct XcdBarrier { unsigned* bar; unsigned x; volatile LAS unsigned* st; };
__device__ __forceinline__ XcdBarrier xcd_barrier_post(unsigned* bar, volatile LAS unsigned* st) {
    XcdBarrier b; b.bar = bar; b.x = xb_xcc_id(); b.st = st;
    if (threadIdx.x == 0) (void)xb_add(&bar[XB_XCNT(b.x)], 1u);
    return b;
}
__device__ __forceinline__ void xcd_barrier_complete(unsigned* bar, unsigned x, unsigned& nloc, unsigned& nx) {
    const unsigned G = gridDim.x * gridDim.y * gridDim.z;
    unsigned sum, cnt, mine, sp = 0u;
    for (;;) {
        sum = 0u; cnt = 0u; mine = 0u;
#pragma unroll
        for (unsigned j = 0; j < 16; ++j) { const unsigned c = xb_ld(&bar[XB_XCNT(j)]); sum += c; cnt += (c > 0u) ? 1u : 0u; mine = (j == x) ? c : mine; }
        if (sum == G) break;
        __builtin_amdgcn_s_sleep(1);
        if ((++sp & 255u) == 0u) { if (xb_ld(&bar[XB_TMO])) break; if (sp > XB_SPIN_CAP) { atomicAdd(&bar[XB_TMO], 1u); break; } }
    }
    nloc = mine > 0u ? mine : 1u; nx = cnt > 0u ? cnt : 1u;
}
__device__ __forceinline__ void xcd_barrier(const XcdBarrier& b) {
    asm volatile("s_waitcnt vmcnt(0)" ::: "memory");
    __syncthreads();
    if (threadIdx.x == 0) {
        unsigned* bar = b.bar;
        __builtin_amdgcn_s_waitcnt(0);
        unsigned nloc = b.st[0], nx = b.st[1];
        if (nloc == 0u) { xcd_barrier_complete(bar, b.x, nloc, nx); b.st[0] = nloc; b.st[1] = nx; }
        const unsigned old = xb_add(&bar[XB_XSUB(b.x)], 1u);
        const unsigned gen = old / nloc;
        if (old + 1u == (gen + 1u) * nloc) {
            __builtin_amdgcn_fence(__ATOMIC_RELEASE, "agent");
            asm volatile("s_waitcnt vmcnt(0)" ::: "memory");
            const unsigned og = xb_add(&bar[XB_TOP], 1u);
            const unsigned tg = og / nx;
            if (og + 1u == (tg + 1u) * nx) xb_add(&bar[XB_TOPGEN], 1u);
            else XB_SPIN(xb_ld(&bar[XB_TOPGEN]) == tg, bar);
            __builtin_amdgcn_fence(__ATOMIC_ACQUIRE, "agent");
            xb_add(&bar[XB_XGEN(b.x)], 1u);
            asm volatile("s_waitcnt vmcnt(0)" ::: "memory");
        } else {
            XB_SPIN(xb_ld(&bar[XB_XGEN(b.x)]) == gen, bar);
            __builtin_amdgcn_fence(__ATOMIC_ACQUIRE, "agent");
            asm volatile("s_waitcnt vmcnt(0)" ::: "memory");
        }
    }
    __syncthreads();
}

namespace g8 {
constexpr int BM = 256, BK = 64, HALF = 128, HTB = HALF * BK * 2, STAGE_BYTES = 8 * HTB, NXCD = 8, WGM = 8;
__device__ __forceinline__ int lds_byte(int r, int c) { const int st = (r >> 4) * 2 + (c >> 5), rr = r & 15, cc = c & 31, ob = rr * 64 + cc * 2; return st * 1024 + (ob ^ (((ob >> 9) & 1) << 5)); }
__device__ __forceinline__ void stage_rc(int b, int& R, int& C) { const int st = b / 1024, sb = b % 1024, swz = sb ^ (((sb >> 9) & 1) << 5); R = (st >> 1) * 16 + swz / 64; C = (st & 1) * 32 + (swz % 64) / 2; }
__device__ __forceinline__ int perm32(int rho) { const int n = rho >> 4, i = rho & 15; return 8 * (i >> 2) + 4 * n + (i & 3); }
__device__ __forceinline__ unsigned cvt_pk_bf16(float lo, float hi) { unsigned r; asm volatile("v_cvt_pk_bf16_f32 %0, %1, %2" : "=v"(r) : "v"(lo), "v"(hi)); return r; }
__device__ __forceinline__ int xcd_remap(int wgid, int nwg) { const int q = nwg / NXCD, r = nwg % NXCD, xcd = wgid % NXCD, off = wgid / NXCD; return (xcd < r ? xcd * (q + 1) : r * (q + 1) + (xcd - r) * q) + off; }

struct Unit { int row0, col0, ex, bt, nvalid, lrow; };

struct DenseSched {
    int nM, nN, nwg, G, c, lat_only; const char* Bt; int K; const int* list;
    __device__ __forceinline__ void init(int nM_, int nN_, int G_, int c_, int lat_only_, const void* Bt_, int K_) { nM = nM_; nN = nN_; nwg = nM * nN; G = G_; c = c_; lat_only = lat_only_; Bt = (const char*)Bt_; K = K_; list = nullptr; }
    __device__ __forceinline__ bool next(int i, Unit& u) const {
        const long Lx = (long)i * G + c; if (Lx >= nwg) return false;
        const int wgid = xcd_remap((int)Lx, nwg);
        const int nig = WGM * nN, gid = wgid / nig, fm = gid * WGM, gsz = (nM - fm) < WGM ? (nM - fm) : WGM;
        const int pm = fm + ((wgid % nig) % gsz), pn = (wgid % nig) / gsz;
        const int tile = lat_only ? (pm / 16) * 17 + 1 + (pm % 16) : pm;
        u.row0 = tile * 256; u.col0 = pn * 256; u.ex = 0; u.bt = pn; u.nvalid = 256; u.lrow = 0; return true;
    }
    __device__ __forceinline__ const char* bptr(const Unit& u) const { return Bt + (size_t)u.bt * (256 * 1024 * 2); }
};
struct MoeSched {
    const LAS int* tpre; const LAS int* cnt; int NT, COLW, G, c, total; const char* Bt; int K; const int* list;
    __device__ __forceinline__ bool next(int i, Unit& u) const {
        const long Lx = (long)i * G + c; if (Lx >= total) return false;
        const int wgid = xcd_remap((int)Lx, total);
        int e = 0;
        for (int j = 1; j < NE; ++j) if (tpre[j] * NT <= wgid) e = j;
        const int t0 = tpre[e], mte = tpre[e + 1] - t0, loc = wgid - t0 * NT, nt = loc / mte, mt = loc % mte;
        u.ex = __builtin_amdgcn_readfirstlane(e); u.row0 = __builtin_amdgcn_readfirstlane((t0 + mt) * 256); u.col0 = __builtin_amdgcn_readfirstlane(nt * COLW);
        u.bt = __builtin_amdgcn_readfirstlane(e * NT + nt); const int nv = cnt[e] - mt * 256; u.nvalid = __builtin_amdgcn_readfirstlane(nv < 256 ? nv : 256); u.lrow = __builtin_amdgcn_readfirstlane(mt * 256);
        return true;
    }
    __device__ __forceinline__ const char* bptr(const Unit& u) const { return Bt + (size_t)u.bt * (256 * 1024 * 2); }
};

struct EpiP {
    static constexpr bool PERM = true; bf16_t* O;
    __device__ __forceinline__ void operator()(const f32x4 (&acc)[2][2][4][2], const Unit& u, int wr, int wc, int fr, int fq, const LAS int*) const {
#pragma unroll
        for (int ai = 0; ai < 2; ++ai)
#pragma unroll
            for (int m = 0; m < 4; ++m) { bf16_t* rowp = O + (size_t)(u.row0 + ai * HALF + wr * 64 + m * 16 + fr) * PP + u.col0 + wc * 32 + 8 * fq;
#pragma unroll
                for (int bj = 0; bj < 2; ++bj) { const f32x4 v0 = acc[ai][bj][m][0], v1 = acc[ai][bj][m][1]; u32x4 w; w.x = cvt_pk_bf16(v0[0], v0[1]); w.y = cvt_pk_bf16(v0[2], v0[3]); w.z = cvt_pk_bf16(v1[0], v1[1]); w.w = cvt_pk_bf16(v1[2], v1[3]);
                    *(u32x4*)(rowp + bj * HALF) = w; } }
    }
};
struct EpiH {
    static constexpr bool PERM = false; float* Hh; const float* MODl; int g_off;
    __device__ __forceinline__ void operator()(const f32x4 (&acc)[2][2][4][2], const Unit& u, int wr, int wc, int fr, int fq, const LAS int*) const {
        const int tile = u.row0 >> 8, v = (tile % 17 == 0) ? 4 : tile / 17; const float* gp = MODl + (size_t)v * 6144 + g_off + u.col0 + wc * 32 + 4 * fq;
        f32x4 gv[2][2];
#pragma unroll
        for (int bj = 0; bj < 2; ++bj)
#pragma unroll
            for (int n = 0; n < 2; ++n) gv[bj][n] = *(const f32x4*)(gp + bj * HALF + n * 16);
#pragma unroll
        for (int ai = 0; ai < 2; ++ai)
#pragma unroll
          for (int mp = 0; mp < 2; ++mp) {
            f32x4 hv[2][2][2];
#pragma unroll
            for (int m2 = 0; m2 < 2; ++m2) { const float* rowp = Hh + (size_t)(u.row0 + ai * HALF + wr * 64 + (2 * mp + m2) * 16 + fr) * D + u.col0 + wc * 32 + 4 * fq;
#pragma unroll
                for (int bj = 0; bj < 2; ++bj)
#pragma unroll
                    for (int n = 0; n < 2; ++n) hv[m2][bj][n] = *(const f32x4*)(rowp + bj * HALF + n * 16); }
#pragma unroll
            for (int m2 = 0; m2 < 2; ++m2) { float* rowp = Hh + (size_t)(u.row0 + ai * HALF + wr * 64 + (2 * mp + m2) * 16 + fr) * D + u.col0 + wc * 32 + 4 * fq;
#pragma unroll
                for (int bj = 0; bj < 2; ++bj)
#pragma unroll
                    for (int n = 0; n < 2; ++n) *(f32x4*)(rowp + bj * HALF + n * 16) = hv[m2][bj][n] + gv[bj][n] * acc[ai][bj][2 * mp + m2][n]; }
          }
    }
};
struct EpiMoe1 {
    static constexpr bool PERM = true; bf16_t* ACTp; const float* bgu;
    __device__ __forceinline__ void operator()(const f32x4 (&acc)[2][2][4][2], const Unit& u, int wr, int wc, int fr, int fq, const LAS int*) const {
        const int cc = u.col0 + wc * 32 + 8 * fq; const float* bp = bgu + (size_t)u.ex * 2048 + cc;
        f32x4 bg[2], bu[2];
#pragma unroll
        for (int n = 0; n < 2; ++n) { bg[n] = *(const f32x4*)(bp + 4 * n); bu[n] = *(const f32x4*)(bp + 1024 + 4 * n); }
#pragma unroll
        for (int ai = 0; ai < 2; ++ai)
#pragma unroll
            for (int m = 0; m < 4; ++m) { const int r = ai * HALF + wr * 64 + m * 16 + fr;
                float o[8];
#pragma unroll
                for (int n = 0; n < 2; ++n)
#pragma unroll
                    for (int i = 0; i < 4; ++i) { const float g = fminf(acc[ai][0][m][n][i] + bg[n][i], 7.f); const float uu = fminf(fmaxf(acc[ai][1][m][n][i] + bu[n][i], -7.f), 7.f);
                        o[n * 4 + i] = (uu + 1.f) * g * __builtin_amdgcn_rcpf(1.f + __expf(-1.702f * g)); }
                { u32x4 w; w.x = cvt_pk_bf16(o[0], o[1]); w.y = cvt_pk_bf16(o[2], o[3]); w.z = cvt_pk_bf16(o[4], o[5]); w.w = cvt_pk_bf16(o[6], o[7]);
                    *(u32x4*)(ACTp + (size_t)(u.row0 + r) * D + cc) = w; } }
    }
};
struct EpiMoe2 {
    static constexpr bool PERM = true; bf16_t* Yp; const float* bd; const float* GATEp;
    __device__ __forceinline__ void operator()(const f32x4 (&acc)[2][2][4][2], const Unit& u, int wr, int wc, int fr, int fq, const LAS int* rows) const {
        const int cc = u.col0 + wc * 32 + 8 * fq; const float* bp = bd + (size_t)u.ex * 1024 + cc;
        f32x4 bv[2][2];
#pragma unroll
        for (int bj = 0; bj < 2; ++bj)
#pragma unroll
            for (int n = 0; n < 2; ++n) bv[bj][n] = *(const f32x4*)(bp + bj * HALF + 4 * n);
        int asgv[2][4]; float gtv[2][4];
#pragma unroll
        for (int ai = 0; ai < 2; ++ai)
#pragma unroll
            for (int m = 0; m < 4; ++m) { const int r = ai * HALF + wr * 64 + m * 16 + fr; const bool ok = r < u.nvalid; const int a = rows[ok ? r : 0]; asgv[ai][m] = ok ? a : NASG; gtv[ai][m] = GATEp[a]; }
#pragma unroll
        for (int ai = 0; ai < 2; ++ai)
#pragma unroll
            for (int m = 0; m < 4; ++m) { const float gt = gtv[ai][m]; bf16_t* rowp = Yp + (size_t)asgv[ai][m] * D + cc;
#pragma unroll
                for (int bj = 0; bj < 2; ++bj) { const f32x4 v0 = (acc[ai][bj][m][0] + bv[bj][0]) * gt, v1 = (acc[ai][bj][m][1] + bv[bj][1]) * gt;
                    u32x4 w; w.x = cvt_pk_bf16(v0[0], v0[1]); w.y = cvt_pk_bf16(v0[2], v0[3]); w.z = cvt_pk_bf16(v1[0], v1[1]); w.w = cvt_pk_bf16(v1[2], v1[3]); *(u32x4*)(rowp + bj * HALF) = w; } }
    }
};

template <class Epi, class Sched, bool GATHER, bool ROWLIST>
__device__ __forceinline__ void gemm_phase(LAS unsigned char* lds, const char* Abase, const Sched& S, const Epi& E) {
    constexpr int K = 1024;
    int tid_l = threadIdx.x; asm volatile("" : "+v"(tid_l));
    const int tid = tid_l, wid = __builtin_amdgcn_readfirstlane(tid >> 6), lane = tid & 63, wr = wid >> 2, wc = wid & 3, fr = lane & 15, fq = lane >> 4;
    constexpr int nt = K / BK; constexpr unsigned Kb = (unsigned)K * 2u;
    unsigned voffB[2];
#pragma unroll
    for (int i = 0; i < 2; ++i) { int R, C; stage_rc(tid * 16 + i * 8192, R, C); const int Rb = Epi::PERM ? ((R & ~31) + perm32(R & 31)) : R; voffB[i] = (unsigned)(Rb * K + C) * 2u; }
    constexpr size_t kstep = (size_t)(BK * 2), hstep = (size_t)HALF * K * 2;
    const unsigned ldsw = (unsigned)wid * 1024u;
    const int aoff = lds_byte(wr * 64 + fr, fq * 8), boff = lds_byte(wc * 32 + fr, fq * 8);
    LAS int* rowbuf = (LAS int*)(lds + STAGE_BYTES);
#define G8_SA(b, h) (((b) * 2 + (h)) * HTB)
#define G8_SB(b, h) ((4 + (b) * 2 + (h)) * HTB)
#define G8_STAGE_A(bufoff, kb, v) do { _Pragma("unroll") for (int _i = 0; _i < 2; ++_i) \
        __builtin_amdgcn_global_load_lds((const unsigned*)((kb) + (size_t)(v)[_i]), (LAS unsigned*)(lds + (bufoff) + ldsw + _i * 8192), 16, 0, 0); } while (0)
#define G8_STAGE_B(bufoff, gbase) do { _Pragma("unroll") for (int _i = 0; _i < 2; ++_i) \
        __builtin_amdgcn_global_load_lds((const unsigned*)((gbase) + voffB[_i]), (LAS unsigned*)(lds + (bufoff) + ldsw + _i * 8192), 16, 0, 0); } while (0)
#define G8_LDA(dst, b, h) do { _Pragma("unroll") for (int m = 0; m < 4; ++m) _Pragma("unroll") for (int k = 0; k < 2; ++k) dst[m][k] = *(const LAS bf16x8*)(lds + G8_SA(b, h) + aoff + m * 2048 + k * 1024); } while (0)
#define G8_LDB(dst, b, h) do { _Pragma("unroll") for (int n = 0; n < 2; ++n) _Pragma("unroll") for (int k = 0; k < 2; ++k) dst[n][k] = *(const LAS bf16x8*)(lds + G8_SB(b, h) + boff + n * 2048 + k * 1024); } while (0)
#define G8_MMA(ai, bj, At, Bt) do { __builtin_amdgcn_s_setprio(1); _Pragma("unroll") for (int m = 0; m < 4; ++m) _Pragma("unroll") for (int n = 0; n < 2; ++n) _Pragma("unroll") for (int k = 0; k < 2; ++k) \
        acc[ai][bj][m][n] = __builtin_amdgcn_mfma_f32_16x16x32_bf16(Bt[n][k], At[m][k], acc[ai][bj][m][n], 0, 0, 0); __builtin_amdgcn_s_setprio(0); } while (0)
#define G8_WAIT_V(n) asm volatile("s_waitcnt vmcnt(" #n ")" ::: "memory")
#define G8_WAIT_L(n) asm volatile("s_waitcnt lgkmcnt(" #n ")" ::: "memory")
#define G8_BAR __builtin_amdgcn_s_barrier()
#define G8_SCHED __builtin_amdgcn_sched_barrier(0)
#define G8_LISTDMA(u, s) do { if (wid < 4) __builtin_amdgcn_global_load_lds((const unsigned*)(S.list + (size_t)(u).ex * LCAP + (u).lrow + wid * 64 + lane), (LAS unsigned*)(rowbuf + (s) * 256 + wid * 64), 4, 0, 0); } while (0)
#define G8_ROWS_DENSE(v) do { _Pragma("unroll") for (int _i = 0; _i < 2; ++_i) { int _R, _C; stage_rc(tid * 16 + _i * 8192, _R, _C); _Pragma("unroll") for (int _h = 0; _h < 2; ++_h) (v)[_h][_i] = (unsigned)(_h * HALF + _R) * Kb + (unsigned)_C * 2u; } } while (0)
#define G8_ROWS_LIST(v, u, s) do { _Pragma("unroll") for (int _i = 0; _i < 2; ++_i) { int _R, _C; stage_rc(tid * 16 + _i * 8192, _R, _C); _Pragma("unroll") for (int _h = 0; _h < 2; ++_h) { const int _r = _h * HALF + _R; const int _a = rowbuf[(s) * 256 + _r]; \
        (v)[_h][_i] = (unsigned)(_r < (u).nvalid ? (_a >> 2) : 0) * Kb + (unsigned)_C * 2u; } } } while (0)
    Unit cur, nxt; int ui = 0, slot = 0;
    if (!S.next(0, cur)) return;
    unsigned vA[2][2];
    if constexpr (ROWLIST) { G8_LISTDMA(cur, 0); G8_WAIT_V(0); G8_BAR; }
    if constexpr (GATHER) { G8_ROWS_LIST(vA, cur, 0); } else { G8_ROWS_DENSE(vA); }
    f32x4 acc[2][2][4][2];
#pragma unroll
    for (int a = 0; a < 2; ++a)
#pragma unroll
        for (int b = 0; b < 2; ++b)
#pragma unroll
            for (int m = 0; m < 4; ++m)
#pragma unroll
                for (int n = 0; n < 2; ++n) acc[a][b][m][n] = (f32x4){0.f, 0.f, 0.f, 0.f};
    bf16x8 At[4][2], B0[2][2], B1[2][2];
    const char* cB = S.bptr(cur);
    const char* cA = GATHER ? Abase : Abase + (size_t)cur.row0 * Kb;
    G8_STAGE_B(G8_SB(0, 0), cB); G8_STAGE_B(G8_SB(0, 1), cB + hstep); G8_STAGE_A(G8_SA(0, 0), cA, vA[0]); G8_STAGE_A(G8_SA(0, 1), cA, vA[1]);
    if (wr == 1) G8_BAR;
    G8_WAIT_V(2); G8_BAR;
    G8_STAGE_B(G8_SB(1, 0), cB + kstep); G8_STAGE_A(G8_SA(1, 0), cA + kstep, vA[0]); G8_STAGE_B(G8_SB(1, 1), cB + hstep + kstep);
    G8_WAIT_V(6); G8_BAR;
    for (;;) {
        const bool has_next = S.next(ui + 1, nxt);
        const char* nB = has_next ? S.bptr(nxt) : cB;
        const char* nA = (GATHER || !has_next) ? cA : Abase + (size_t)nxt.row0 * Kb;
        const int nslot = slot == 2 ? 0 : slot + 1;
        if constexpr (ROWLIST) { if (has_next) G8_LISTDMA(nxt, nslot); }
        for (int t = 0; t < nt; t += 2) {
            const bool last = (t == nt - 2);
            const char* a1 = cA + (size_t)(t + 1) * kstep;
            const char* a2 = last ? nA : cA + (size_t)(t + 2) * kstep; const char* b2 = last ? nB : cB + (size_t)(t + 2) * kstep;
            const char* a3 = a2 + kstep; const char* b3 = b2 + kstep;
            G8_LDB(B0, 0, 0); G8_LDB(B1, 0, 1); G8_SCHED; G8_LDA(At, 0, 0); G8_STAGE_A(G8_SA(1, 1), a1, vA[1]);
            if constexpr (GATHER) { if (last && has_next) { G8_ROWS_LIST(vA, nxt, nslot); } }
            G8_WAIT_V(8); G8_WAIT_L(0); G8_BAR; G8_MMA(0, 0, At, B0); G8_MMA(0, 1, At, B1); G8_BAR; G8_SCHED;
            G8_LDA(At, 0, 1); G8_STAGE_B(G8_SB(0, 0), b2); G8_STAGE_B(G8_SB(0, 1), b2 + hstep); G8_STAGE_A(G8_SA(0, 0), a2, vA[0]);
            G8_WAIT_V(8); G8_WAIT_L(0); G8_BAR; G8_MMA(1, 0, At, B0); G8_MMA(1, 1, At, B1); G8_BAR; G8_SCHED;
            G8_LDB(B0, 1, 0); G8_LDB(B1, 1, 1); G8_SCHED; G8_LDA(At, 1, 0); G8_STAGE_A(G8_SA(0, 1), a2, vA[1]);
            G8_WAIT_V(8); G8_WAIT_L(0); G8_BAR; G8_MMA(0, 0, At, B0); G8_MMA(0, 1, At, B1); G8_BAR; G8_SCHED;
            G8_LDA(At, 1, 1); G8_STAGE_B(G8_SB(1, 0), b3); G8_STAGE_B(G8_SB(1, 1), b3 + hstep); G8_STAGE_A(G8_SA(1, 0), a3, vA[0]);
            G8_WAIT_V(8); G8_WAIT_L(0); G8_BAR; G8_MMA(1, 0, At, B0); G8_MMA(1, 1, At, B1); G8_BAR; G8_SCHED;
        }
        if (wr == 0) G8_BAR;
        { int t2 = threadIdx.x; asm volatile("" : "+v"(t2));
          const int w2 = __builtin_amdgcn_readfirstlane(t2 >> 6); E(acc, cur, w2 >> 2, w2 & 3, t2 & 15, (t2 & 63) >> 4, rowbuf + slot * 256); }
        if (!has_next) break;
#pragma unroll
        for (int a = 0; a < 2; ++a)
#pragma unroll
            for (int b = 0; b < 2; ++b)
#pragma unroll
                for (int m = 0; m < 4; ++m)
#pragma unroll
                    for (int n = 0; n < 2; ++n) acc[a][b][m][n] = (f32x4){0.f, 0.f, 0.f, 0.f};
        cur = nxt; cB = nB; cA = nA; ++ui; slot = nslot;
        if (wr == 1) G8_BAR;
    }
    G8_WAIT_V(0);
    G8_BAR;
#undef G8_SA
#undef G8_SB
#undef G8_STAGE_A
#undef G8_STAGE_B
#undef G8_LDA
#undef G8_LDB
#undef G8_MMA
#undef G8_WAIT_V
#undef G8_WAIT_L
#undef G8_BAR
#undef G8_SCHED
#undef G8_LISTDMA
#undef G8_ROWS_DENSE
#undef G8_ROWS_LIST
}
}

namespace fft {
constexpr int TP = 72;
constexpr int UP = 264;
constexpr int ZP = 520;
constexpr int O_TC = 0, O_TS = 9216, O_U = 18432, O_X = 52224, O_TW = 125952;
__device__ __forceinline__ bf16x8 neg8(bf16x8 v) { u32x4 w = __builtin_bit_cast(u32x4, v); w = w ^ 0x80008000u; return __builtin_bit_cast(bf16x8, w); }
__device__ __forceinline__ void build_tables(LAS unsigned char* lds, const float* TABC, const float* TABS, int tid) {
    for (int i = tid; i < 4096; i += 512) { const int a = i >> 6, b = i & 63, ix = ((a * b) & 63) * 64;
        ((LAS bf16_t*)(lds + O_TC))[a * TP + b] = f2bf(TABC[ix]); ((LAS bf16_t*)(lds + O_TS))[a * TP + b] = f2bf(TABS[ix]); }
}
__device__ __forceinline__ void stage_a(LAS unsigned char* lds, const bf16_t* P, const float* TABC, const float* TABS, bf16_t* ZBUF, int u0, int u1, int ustep) {
    int tid_l = threadIdx.x; asm volatile("" : "+v"(tid_l));
    const int tid = tid_l, lane = tid & 63, w = __builtin_amdgcn_readfirstlane(tid >> 6), fr = lane & 15, fq = lane >> 4;
    build_tables(lds, TABC, TABS, tid);
    const LAS bf16_t* Tc = (const LAS bf16_t*)(lds + O_TC); const LAS bf16_t* Ts = (const LAS bf16_t*)(lds + O_TS);
    LAS bf16_t* U = (LAS bf16_t*)(lds + O_U); LAS bf16_t* X = (LAS bf16_t*)(lds + O_X); LAS float* TW = (LAS float*)(lds + O_TW);
    for (int unit = u0; unit < u1; unit += ustep) {
        const int b = unit >> 6, t2 = unit & 63;
#pragma unroll
        for (int i = 0; i < 4; ++i) { const int q = tid + 512 * i, t1 = q >> 5, ch = q & 31;
            *(LAS u32x4*)((LAS unsigned char*)U + t1 * (UP * 2) + ch * 16) = *(const u32x4*)(P + ((size_t)b * NPOS + CTX + 64 * t1 + t2) * PP + ch * 8); }
        if (tid < 64) { const int ix = tid * t2; TW[2 * tid] = TABC[ix]; TW[2 * tid + 1] = TABS[ix]; }
        __syncthreads();
        { const int g = w >> 1, part = w & 1; const LAS bf16_t* T = part ? Ts : Tc;
          f32x4 acc[4][4];
#pragma unroll
          for (int mt = 0; mt < 4; ++mt)
#pragma unroll
              for (int nt = 0; nt < 4; ++nt) acc[mt][nt] = (f32x4){0.f, 0.f, 0.f, 0.f};
#pragma unroll
          for (int ks = 0; ks < 2; ++ks) { bf16x8 a[4], bb[4];
#pragma unroll
              for (int mt = 0; mt < 4; ++mt) a[mt] = *(const LAS bf16x8*)(U + (16 * mt + fr) * UP + g * 64 + 32 * ks + 8 * fq);
#pragma unroll
              for (int nt = 0; nt < 4; ++nt) bb[nt] = *(const LAS bf16x8*)(T + (16 * nt + fr) * TP + 32 * ks + 8 * fq);
#pragma unroll
              for (int mt = 0; mt < 4; ++mt)
#pragma unroll
                  for (int nt = 0; nt < 4; ++nt) acc[mt][nt] = __builtin_amdgcn_mfma_f32_16x16x32_bf16(a[mt], bb[nt], acc[mt][nt], 0, 0, 0); }
          const float sg = part ? -1.f : 1.f;
#pragma unroll
          for (int mt = 0; mt < 4; ++mt)
#pragma unroll
              for (int nt = 0; nt < 4; ++nt) { const f32x4 v = acc[mt][nt] * sg; u32x2 o; o.x = pk2(v[0], v[1]); o.y = pk2(v[2], v[3]);
                  *(LAS u32x2*)(X + (part * 256 + g * 64 + 16 * nt + fr) * TP + 16 * mt + 4 * fq) = o; } }
        __syncthreads();
        f32x4 zr[4][2], zi[4][2];
#pragma unroll
        for (int mt = 0; mt < 4; ++mt)
#pragma unroll
            for (int n = 0; n < 2; ++n) { zr[mt][n] = (f32x4){0.f, 0.f, 0.f, 0.f}; zi[mt][n] = (f32x4){0.f, 0.f, 0.f, 0.f}; }
#pragma unroll
        for (int ks = 0; ks < 2; ++ks) { bf16x8 xr[2], xi[2];
#pragma unroll
            for (int n = 0; n < 2; ++n) { xr[n] = *(const LAS bf16x8*)(X + (32 * w + 16 * n + fr) * TP + 32 * ks + 8 * fq); xi[n] = *(const LAS bf16x8*)(X + (256 + 32 * w + 16 * n + fr) * TP + 32 * ks + 8 * fq); }
#pragma unroll
            for (int mt = 0; mt < 4; ++mt) { const bf16x8 c = *(const LAS bf16x8*)(Tc + (16 * mt + fr) * TP + 32 * ks + 8 * fq), s = *(const LAS bf16x8*)(Ts + (16 * mt + fr) * TP + 32 * ks + 8 * fq), ns = neg8(s);
#pragma unroll
                for (int n = 0; n < 2; ++n) { zr[mt][n] = __builtin_amdgcn_mfma_f32_16x16x32_bf16(c, xr[n], zr[mt][n], 0, 0, 0); zr[mt][n] = __builtin_amdgcn_mfma_f32_16x16x32_bf16(s, xi[n], zr[mt][n], 0, 0, 0);
                    zi[mt][n] = __builtin_amdgcn_mfma_f32_16x16x32_bf16(c, xi[n], zi[mt][n], 0, 0, 0); zi[mt][n] = __builtin_amdgcn_mfma_f32_16x16x32_bf16(ns, xr[n], zi[mt][n], 0, 0, 0); } } }
        __syncthreads();
        { LAS bf16_t* Zs = X;
#pragma unroll
          for (int mt = 0; mt < 4; ++mt)
#pragma unroll
              for (int i = 0; i < 4; ++i) { const int f1 = 16 * mt + 4 * fq + i; const float ct = TW[2 * f1], st = TW[2 * f1 + 1];
#pragma unroll
                  for (int n = 0; n < 2; ++n) { const float a = zr[mt][n][i], bq = zi[mt][n][i]; const int col = 32 * w + 16 * n + fr;
                      Zs[f1 * ZP + col] = f2bf(a * ct + bq * st); Zs[f1 * ZP + 256 + col] = f2bf(bq * ct - a * st); } } }
        __syncthreads();
#pragma unroll
        for (int i = 0; i < 8; ++i) { const int q = tid + 512 * i, f1 = q >> 6, ch = q & 63;
            *(u32x4*)(ZBUF + (((size_t)b * 64 + f1) * 64 + t2) * 512 + ch * 8) = *(const LAS u32x4*)((const LAS unsigned char*)X + f1 * (ZP * 2) + ch * 16); }
        __syncthreads();
    }
}
__device__ __forceinline__ void stage_b(LAS unsigned char* lds, const bf16_t* ZBUF, const float* TABC, const float* TABS, bf16_t* MIX, int G, int bx) {
    int tid_l = threadIdx.x; asm volatile("" : "+v"(tid_l));
    const int tid = tid_l, lane = tid & 63, w = __builtin_amdgcn_readfirstlane(tid >> 6), fr = lane & 15, fq = lane >> 4;
    build_tables(lds, TABC, TABS, tid);
    const LAS bf16_t* Tc = (const LAS bf16_t*)(lds + O_TC); const LAS bf16_t* Ts = (const LAS bf16_t*)(lds + O_TS);
    LAS bf16_t* Ys = (LAS bf16_t*)(lds + O_U); LAS bf16_t* ZT = (LAS bf16_t*)(lds + O_X);
    for (int unit = bx; unit < 256; unit += G) {
        const int b = unit >> 6, f1 = unit & 63;
        const bf16_t* Zg = ZBUF + ((size_t)b * 64 + f1) * 64 * 512;
#pragma unroll
        for (int i = 0; i < 4; ++i) { const int q = tid + 512 * i, p = q & 31, ch = q >> 5;
            const u32x4 r0 = *(const u32x4*)(Zg + (size_t)(2 * p) * 512 + ch * 8), r1 = *(const u32x4*)(Zg + (size_t)(2 * p + 1) * 512 + ch * 8);
#pragma unroll
            for (int j = 0; j < 4; ++j) { const unsigned a = r0[j], c = r1[j];
                *(LAS unsigned*)(ZT + (ch * 8 + 2 * j) * TP + 2 * p) = (a & 0xffffu) | (c << 16);
                *(LAS unsigned*)(ZT + (ch * 8 + 2 * j + 1) * TP + 2 * p) = (a >> 16) | (c & 0xffff0000u); } }
        __syncthreads();
        f32x4 y[4][2];
#pragma unroll
        for (int mt = 0; mt < 4; ++mt)
#pragma unroll
            for (int n = 0; n < 2; ++n) y[mt][n] = (f32x4){0.f, 0.f, 0.f, 0.f};
#pragma unroll
        for (int ks = 0; ks < 2; ++ks) { bf16x8 xr[2], xi[2];
#pragma unroll
            for (int n = 0; n < 2; ++n) { xr[n] = *(const LAS bf16x8*)(ZT + (32 * w + 16 * n + fr) * TP + 32 * ks + 8 * fq); xi[n] = *(const LAS bf16x8*)(ZT + (256 + 32 * w + 16 * n + fr) * TP + 32 * ks + 8 * fq); }
#pragma unroll
            for (int mt = 0; mt < 4; ++mt) { const bf16x8 c = *(const LAS bf16x8*)(Tc + (16 * mt + fr) * TP + 32 * ks + 8 * fq), s = *(const LAS bf16x8*)(Ts + (16 * mt + fr) * TP + 32 * ks + 8 * fq);
#pragma unroll
                for (int n = 0; n < 2; ++n) { y[mt][n] = __builtin_amdgcn_mfma_f32_16x16x32_bf16(c, xr[n], y[mt][n], 0, 0, 0); y[mt][n] = __builtin_amdgcn_mfma_f32_16x16x32_bf16(s, xi[n], y[mt][n], 0, 0, 0); } } }
#pragma unroll
        for (int mt = 0; mt < 4; ++mt)
#pragma unroll
            for (int i = 0; i < 4; ++i)
#pragma unroll
                for (int n = 0; n < 2; ++n) Ys[(16 * mt + 4 * fq + i) * UP + 32 * w + 16 * n + fr] = f2bf(y[mt][n][i] * (1.f / 512.f));
        __syncthreads();
#pragma unroll
        for (int i = 0; i < 4; ++i) { const int q = tid + 512 * i, f2 = q >> 5, ch = q & 31;
            *(u32x4*)(MIX + ((size_t)b * NPOS + CTX + f1 + 64 * f2) * D + ch * 8) = *(const LAS u32x4*)((const LAS unsigned char*)Ys + f2 * (UP * 2) + ch * 16); }
        __syncthreads();
    }
}
}

namespace attn {
typedef float f32x16 __attribute__((ext_vector_type(16)));
typedef float f32x2_t __attribute__((ext_vector_type(2))); typedef __bf16 bf16x2_t __attribute__((ext_vector_type(2)));
__device__ __forceinline__ unsigned cvtpk(float lo, float hi) { f32x2_t v = {lo, hi}; bf16x2_t b = __builtin_convertvector(v, bf16x2_t); return __builtin_bit_cast(unsigned, b); }
constexpr int KP = 104, VP = 68;
constexpr int KT_BYTES = 64 * KP * 2, VT_BYTES = 64 * VP * 2, BUF_BYTES = KT_BYTES + VT_BYTES;
constexpr float THR = 8.f;
__device__ __forceinline__ void attn_phase(LAS unsigned char* lds, const bf16_t* QL, const bf16_t* QC, const bf16_t* KB, const bf16_t* VTG, bf16_t* MIX, int with_ctx, int G, int vcu) {
    const int nunits = 256 + (with_ctx ? 16 : 0);
    for (int unit = vcu; unit < nunits; unit += G) {
        int tid_l = threadIdx.x; asm volatile("" : "+v"(tid_l));
        const int tid = tid_l, lane = tid & 63, wid = __builtin_amdgcn_readfirstlane(tid >> 6), r32 = lane & 31, hi = lane >> 5;
        int bh, nk, orow0; const bf16_t* Qp;
        if (unit < 256) { bh = unit >> 4; const int qb = unit & 15; Qp = QL + ((size_t)bh * SEQ + qb * 256) * 96; nk = NPOS; orow0 = (bh >> 2) * NPOS + CTX + qb * 256; }
        else { bh = unit - 256; Qp = QC + (size_t)bh * CTX * 96; nk = CTX; orow0 = (bh >> 2) * NPOS; }
        const int hh = bh & 3, NT = nk / 64;
        const bf16_t* Kg = KB + (size_t)bh * NPOS * 96; const bf16_t* Vg = VTG + (size_t)bh * 64 * NPOS;
        bf16x8 qf[6];
        { const bf16_t* qp = Qp + (size_t)(wid * 32 + r32) * 96 + 8 * hi;
#pragma unroll
          for (int ds = 0; ds < 6; ++ds) qf[ds] = *(const bf16x8*)(qp + 16 * ds); }
        f32x16 o0 = {}, o1 = {}, negm = {}; float mhat = 0.f, l = 0.f;
        const int kr0 = tid / 12, kc0 = tid % 12, kr1 = (tid + 512) / 12, kc1 = (tid + 512) % 12; const bool k1ok = tid < 256;
        const int vd = tid >> 3, vc = tid & 7;
        u32x4 sk0, sk1 = {}, sv;
#define AT_LOAD(t_) do { const size_t k0_ = (size_t)(t_) * 64; sk0 = *(const u32x4*)(Kg + (k0_ + kr0) * 96 + kc0 * 8); if (k1ok) sk1 = *(const u32x4*)(Kg + (k0_ + kr1) * 96 + kc1 * 8); sv = *(const u32x4*)(Vg + (size_t)vd * NPOS + k0_ + vc * 8); } while (0)
#define AT_STORE(slot_) do { LAS unsigned char* bp_ = lds + (slot_) * BUF_BYTES; *(LAS u32x4*)(bp_ + kr0 * (KP * 2) + kc0 * 16) = sk0; if (k1ok) *(LAS u32x4*)(bp_ + kr1 * (KP * 2) + kc1 * 16) = sk1; *(LAS u32x4*)(bp_ + KT_BYTES + vd * (VP * 2) + vc * 16) = sv; } while (0)
#define AT_QK(P0, P1, slot_) do { const LAS bf16_t* Kt_ = (const LAS bf16_t*)(lds + (slot_) * BUF_BYTES); \
        _Pragma("unroll") for (int ds = 0; ds < 6; ++ds) { const bf16x8 k0f = *(const LAS bf16x8*)(Kt_ + r32 * KP + 16 * ds + 8 * hi), k1f = *(const LAS bf16x8*)(Kt_ + (32 + r32) * KP + 16 * ds + 8 * hi); \
            if (ds == 0) { P0 = __builtin_amdgcn_mfma_f32_32x32x16_bf16(k0f, qf[0], negm, 0, 0, 0); P1 = __builtin_amdgcn_mfma_f32_32x32x16_bf16(k1f, qf[0], negm, 0, 0, 0); } \
            else { P0 = __builtin_amdgcn_mfma_f32_32x32x16_bf16(k0f, qf[ds], P0, 0, 0, 0); P1 = __builtin_amdgcn_mfma_f32_32x32x16_bf16(k1f, qf[ds], P1, 0, 0, 0); } } } while (0)
#define MX3(a_, b_, c_) __builtin_fmaxf(__builtin_fmaxf((a_), (b_)), (c_))
#define AT_STEP(C0, C1, N0, N1, t_) do { \
            if ((t_) + 2 < NT) AT_LOAD((t_) + 2); \
            if ((t_) + 1 < NT) AT_QK(N0, N1, s_nxt); \
            float mx_ = MX3(C0[0], C0[1], C1[0]), my_ = MX3(C0[2], C0[3], C1[1]); mx_ = MX3(mx_, C1[2], C1[3]); \
            _Pragma("unroll") for (int r = 4; r < 16; r += 4) { mx_ = MX3(mx_, C0[r], C0[r + 1]); my_ = MX3(my_, C0[r + 2], C0[r + 3]); mx_ = MX3(mx_, C1[r], C1[r + 1]); my_ = MX3(my_, C1[r + 2], C1[r + 3]); } \
            mx_ = fmaxf(mx_, my_); mx_ = fmaxf(mx_, __shfl_xor(mx_, 32)); \
            if (__builtin_expect((t_) == 0 || __any(mx_ > THR), 0)) { const float dl = (t_) == 0 ? mx_ : fmaxf(mx_, 0.f), f = __builtin_amdgcn_exp2f(-dl); mhat += dl; l *= f; \
                _Pragma("unroll") for (int r = 0; r < 16; ++r) { C0[r] -= dl; C1[r] -= dl; o0[r] *= f; o1[r] *= f; negm[r] = -mhat; } \
                if ((t_) + 1 < NT) { _Pragma("unroll") for (int r = 0; r < 16; ++r) { N0[r] -= dl; N1[r] -= dl; } } } \
            float ls_ = 0.f; \
            _Pragma("unroll") for (int r = 0; r < 16; ++r) { C0[r] = __builtin_amdgcn_exp2f(C0[r]); C1[r] = __builtin_amdgcn_exp2f(C1[r]); ls_ += C0[r] + C1[r]; } \
            l += ls_; \
            const LAS bf16_t* Vt_ = (const LAS bf16_t*)(lds + s_cur * BUF_BYTES + KT_BYTES); \
            _Pragma("unroll") for (int q = 0; q < 4; ++q) { u32x4 pw_; \
                _Pragma("unroll") for (int j = 0; j < 4; ++j) { const int r = 8 * (q & 1) + 2 * j; pw_[j] = (q < 2) ? cvtpk(C0[r], C0[r + 1]) : cvtpk(C1[r], C1[r + 1]); } \
                const bf16x8 pf_ = __builtin_bit_cast(bf16x8, pw_); const int kvb = 32 * (q >> 1) + 16 * (q & 1) + 4 * hi; \
                _Pragma("unroll") for (int db = 0; db < 2; ++db) { const u32x2 va = *(const LAS u32x2*)(Vt_ + (32 * db + r32) * VP + kvb), vb = *(const LAS u32x2*)(Vt_ + (32 * db + r32) * VP + kvb + 8); \
                    const u32x4 vw = {va.x, va.y, vb.x, vb.y}; const bf16x8 vf = __builtin_bit_cast(bf16x8, vw); \
                    if (db == 0) o0 = __builtin_amdgcn_mfma_f32_32x32x16_bf16(vf, pf_, o0, 0, 0, 0); else o1 = __builtin_amdgcn_mfma_f32_32x32x16_bf16(vf, pf_, o1, 0, 0, 0); } } \
            if ((t_) + 2 < NT) AT_STORE(s_ld); \
            __syncthreads(); \
            { const int tmp_ = s_cur; s_cur = s_nxt; s_nxt = s_ld; s_ld = tmp_; } } while (0)
        AT_LOAD(0); AT_STORE(0);
        if (NT > 1) { AT_LOAD(1); AT_STORE(1); }
        __syncthreads();
        f32x16 pA0, pA1, pB0, pB1;
        AT_QK(pA0, pA1, 0);
        int s_cur = 0, s_nxt = 1, s_ld = 2;
        for (int t = 0; t < NT; t += 2) {
            AT_STEP(pA0, pA1, pB0, pB1, t);
            AT_STEP(pB0, pB1, pA0, pA1, t + 1);
        }
#undef AT_LOAD
#undef AT_STORE
#undef AT_QK
#undef AT_STEP
#undef MX3
        l += __shfl_xor(l, 32);
        const float il = 1.f / l;
        bf16_t* op = MIX + (size_t)(orow0 + wid * 32 + r32) * D + 512 + hh * 64 + 4 * hi;
#pragma unroll
        for (int g4 = 0; g4 < 4; ++g4) { u32x2 w0, w1; w0.x = cvtpk(o0[4 * g4] * il, o0[4 * g4 + 1] * il); w0.y = cvtpk(o0[4 * g4 + 2] * il, o0[4 * g4 + 3] * il);
            w1.x = cvtpk(o1[4 * g4] * il, o1[4 * g4 + 1] * il); w1.y = cvtpk(o1[4 * g4 + 2] * il, o1[4 * g4 + 3] * il);
            *(u32x2*)(op + 8 * g4) = w0; *(u32x2*)(op + 32 + 8 * g4) = w1; }
    }
}
}

namespace sm {
__device__ __forceinline__ float silu(float x) { return x / (1.f + __expf(-x)); }
__device__ __forceinline__ void mod_phase(LAS unsigned char* lds, const float* c, const float* c_ctx, const float* mod_w, const float* mod_b, float* MOD, int G, int bx, int tid) {
    LAS float* s = (LAS float*)lds;
    for (int i = tid; i < 5120; i += 512) { const int v = i >> 10, k = i & 1023; s[i] = silu(v < 4 ? c[v * 1024 + k] : c_ctx[k]); }
    __syncthreads();
    LAS float* red = s + 5120;
    for (int unit = bx; unit < 96; unit += G) {
        const int l = unit / 48, cb = unit % 48, cl = tid & 127, col = cb * 128 + cl, kq = tid >> 7, k0 = kq * 256;
        const float* W = mod_w + ((size_t)l * 1024 + k0) * 6144 + col;
        float a0 = 0.f, a1 = 0.f, a2 = 0.f, a3 = 0.f, a4 = 0.f;
#pragma unroll 16
        for (int k = 0; k < 256; ++k) { const float w = W[(size_t)k * 6144]; a0 += s[k0 + k] * w; a1 += s[1024 + k0 + k] * w; a2 += s[2048 + k0 + k] * w; a3 += s[3072 + k0 + k] * w; a4 += s[4096 + k0 + k] * w; }
        LAS float* rq = red + kq * 640 + cl; rq[0] = a0; rq[128] = a1; rq[256] = a2; rq[384] = a3; rq[512] = a4;
        __syncthreads();
        for (int i = tid; i < 640; i += 512) { const int v = i >> 7, cc = i & 127; const float r = ((red[i] + red[640 + i]) + (red[1280 + i] + red[1920 + i])) + mod_b[l * 6144 + cb * 128 + cc];
            MOD[((size_t)l * 5 + v) * 6144 + cb * 128 + cc] = r; }
        __syncthreads();
    }
}
__device__ __forceinline__ void norm_store(const float4 (&x)[4], float ss, const float* g, const float* mv, int sh_off, int sc_off, bf16_t* xn_row, int lane) {
    const float rs = rsqrtf(wave_sum(ss) * (1.f / D) + 1e-6f);
#pragma unroll
    for (int j = 0; j < 4; ++j) { const int c = (j * 64 + lane) * 4; const float4 gg = *(const float4*)(g + c), sh = *(const float4*)(mv + sh_off + c), sc = *(const float4*)(mv + sc_off + c);
        u32x2 o; o.x = pk2(x[j].x * rs * gg.x * (1.f + sc.x) + sh.x, x[j].y * rs * gg.y * (1.f + sc.y) + sh.y); o.y = pk2(x[j].z * rs * gg.z * (1.f + sc.z) + sh.z, x[j].w * rs * gg.w * (1.f + sc.w) + sh.w);
        *(u32x2*)(xn_row + c) = o; }
}
__device__ __forceinline__ void pro1_phase(const float* x, const float* ctx, const float* g, const float* MODl, float* H, bf16_t* XN, int r_first, int r_end, int r_step, int lane) {
    for (int r = r_first; r < r_end; r += r_step) { const int b = r / NPOS, pos = r % NPOS, v = pos < CTX ? 4 : b;
        const float* src = pos < CTX ? ctx + ((size_t)b * CTX + pos) * D : x + ((size_t)b * SEQ + (pos - CTX)) * D;
        float4 xv[4]; float ss = 0.f;
#pragma unroll
        for (int j = 0; j < 4; ++j) { const int c = (j * 64 + lane) * 4; xv[j] = *(const float4*)(src + c); ss += xv[j].x * xv[j].x + xv[j].y * xv[j].y + xv[j].z * xv[j].z + xv[j].w * xv[j].w; }
#pragma unroll
        for (int j = 0; j < 4; ++j) *(float4*)(H + (size_t)r * D + (j * 64 + lane) * 4) = xv[j];
        norm_store(xv, ss, g, MODl + (size_t)v * 6144, 0, 1024, XN + (size_t)r * D, lane); }
}
__device__ __forceinline__ void comb_phase(int l, float* H, const bf16_t* Y, const float* MODl, const float* g_next, const float* MODn, bf16_t* XN, const float* final_g, float* out, int gw, int NGW, int lane) {
    for (int r = gw; r < MROWS; r += NGW) { const int b = r / NPOS, pos = r % NPOS, v = pos < CTX ? 4 : b;
        if (l == 1 && pos < CTX) continue;
        const float* g2 = MODl + (size_t)v * 6144 + 5120;
        float4 xv[4]; float ss = 0.f;
#pragma unroll
        for (int j = 0; j < 4; ++j) { const int c = (j * 64 + lane) * 4; xv[j] = *(const float4*)(H + (size_t)r * D + c); float4 s = make_float4(0.f, 0.f, 0.f, 0.f);
#pragma unroll
            for (int k = 0; k < 4; ++k) { const u32x2 y = *(const u32x2*)(Y + ((size_t)r * 4 + k) * D + c); s.x += __uint_as_float(y.x << 16); s.y += __uint_as_float(y.x & 0xffff0000u); s.z += __uint_as_float(y.y << 16); s.w += __uint_as_float(y.y & 0xffff0000u); }
            const float4 gg = *(const float4*)(g2 + c); xv[j].x += gg.x * s.x; xv[j].y += gg.y * s.y; xv[j].z += gg.z * s.z; xv[j].w += gg.w * s.w;
            ss += xv[j].x * xv[j].x + xv[j].y * xv[j].y + xv[j].z * xv[j].z + xv[j].w * xv[j].w; }
        if (l == 0) {
#pragma unroll
            for (int j = 0; j < 4; ++j) *(float4*)(H + (size_t)r * D + (j * 64 + lane) * 4) = xv[j];
            norm_store(xv, ss, g_next, MODn + (size_t)v * 6144, 0, 1024, XN + (size_t)r * D, lane);
        } else { const float rs = rsqrtf(wave_sum(ss) * (1.f / D) + 1e-6f); float* op = out + ((size_t)b * SEQ + (pos - CTX)) * D;
#pragma unroll
            for (int j = 0; j < 4; ++j) { const int c = (j * 64 + lane) * 4; const float4 fg = *(const float4*)(final_g + c); float4 o; o.x = xv[j].x * rs * fg.x; o.y = xv[j].y * rs * fg.y; o.z = xv[j].z * rs * fg.z; o.w = xv[j].w * rs * fg.w; *(float4*)(op + c) = o; } }
    }
}
__device__ __forceinline__ void route_phase(LAS unsigned char* lds, int l, const float* H, const float* g, const float* MODl, const bf16_t* RWH, const bf16_t* RWL, const float* rb, bf16_t* XN, int* CNT, int* LIST, float* GATE,
                                            int G, int bx, int tid) {
    const int lane = tid & 63, wave = __builtin_amdgcn_readfirstlane(tid >> 6), fr = lane & 15, fq = lane >> 4;
    constexpr int FP = 1032;
    LAS bf16_t* FH = (LAS bf16_t*)lds; LAS bf16_t* FL = FH + 16 * FP;
    LAS float* PART = (LAS float*)(lds + 66048);
    LAS int* LCNT = (LAS int*)(lds + 66048 + 16384);
    LAS int* LBASE = LCNT + 64; LAS int* LENT = LCNT + 128;
    if (tid < 64) LCNT[tid] = 0;
    bf16x8 wh[2][4], wl[2][4];
#pragma unroll
    for (int nt = 0; nt < 2; ++nt)
#pragma unroll
        for (int ks = 0; ks < 4; ++ks) { const size_t o = ((size_t)l * NE + 16 * nt + fr) * D + 128 * wave + 32 * ks + 8 * fq; wh[nt][ks] = *(const bf16x8*)(RWH + o); wl[nt][ks] = *(const bf16x8*)(RWL + o); }
    const float bias = rb[lane & 31];
    __syncthreads();
    const int nb = l == 1 ? (MROWS - NB_ * CTX) / 16 : MROWS / 16;
    for (int bi = bx; bi < nb; bi += G) {
#pragma unroll
        for (int rr = 0; rr < 2; ++rr) { const int q = bi * 16 + 2 * wave + rr; const int r = l == 1 ? (q / SEQ) * NPOS + CTX + (q % SEQ) : q;
            const int b = r / NPOS, pos = r % NPOS, v = pos < CTX ? 4 : b; const float* mv = MODl + (size_t)v * 6144;
            float4 xv[4]; float ss = 0.f;
#pragma unroll
            for (int j = 0; j < 4; ++j) { xv[j] = *(const float4*)(H + (size_t)r * D + (j * 64 + lane) * 4); ss += xv[j].x * xv[j].x + xv[j].y * xv[j].y + xv[j].z * xv[j].z + xv[j].w * xv[j].w; }
            const float rs = rsqrtf(wave_sum(ss) * (1.f / D) + 1e-6f);
#pragma unroll
            for (int j = 0; j < 4; ++j) { const int c = (j * 64 + lane) * 4; const float4 gg = *(const float4*)(g + c), sh = *(const float4*)(mv + 3072 + c), sc = *(const float4*)(mv + 4096 + c);
                float f[4]; f[0] = xv[j].x * rs * gg.x * (1.f + sc.x) + sh.x; f[1] = xv[j].y * rs * gg.y * (1.f + sc.y) + sh.y; f[2] = xv[j].z * rs * gg.z * (1.f + sc.z) + sh.z; f[3] = xv[j].w * rs * gg.w * (1.f + sc.w) + sh.w;
                bf16_t hb[4], lb[4];
#pragma unroll
                for (int i = 0; i < 4; ++i) { hb[i] = f2bf(f[i]); lb[i] = f2bf(f[i] - bf2f(hb[i])); }
                u32x2 oh, ol; oh.x = (unsigned)hb[0] | ((unsigned)hb[1] << 16); oh.y = (unsigned)hb[2] | ((unsigned)hb[3] << 16); ol.x = (unsigned)lb[0] | ((unsigned)lb[1] << 16); ol.y = (unsigned)lb[2] | ((unsigned)lb[3] << 16);
                *(u32x2*)(XN + (size_t)r * D + c) = oh; *(LAS u32x2*)(FH + (2 * wave + rr) * FP + c) = oh; *(LAS u32x2*)(FL + (2 * wave + rr) * FP + c) = ol; } }
        __syncthreads();
        { f32x4 acc[2] = {(f32x4){0.f, 0.f, 0.f, 0.f}, (f32x4){0.f, 0.f, 0.f, 0.f}};
#pragma unroll
          for (int ks = 0; ks < 4; ++ks) { const bf16x8 ah = *(const LAS bf16x8*)(FH + fr * FP + 128 * wave + 32 * ks + 8 * fq), al = *(const LAS bf16x8*)(FL + fr * FP + 128 * wave + 32 * ks + 8 * fq);
#pragma unroll
              for (int nt = 0; nt < 2; ++nt) { acc[nt] = __builtin_amdgcn_mfma_f32_16x16x32_bf16(ah, wh[nt][ks], acc[nt], 0, 0, 0); acc[nt] = __builtin_amdgcn_mfma_f32_16x16x32_bf16(ah, wl[nt][ks], acc[nt], 0, 0, 0);
                  acc[nt] = __builtin_amdgcn_mfma_f32_16x16x32_bf16(al, wh[nt][ks], acc[nt], 0, 0, 0); } }
#pragma unroll
          for (int nt = 0; nt < 2; ++nt)
#pragma unroll
              for (int i = 0; i < 4; ++i) PART[(wave * 16 + 4 * fq + i) * 32 + 16 * nt + fr] = acc[nt][i]; }
        __syncthreads();
        { const int row = 2 * wave + (lane >> 5), e = lane & 31; const int q = bi * 16 + row; const int r = l == 1 ? (q / SEQ) * NPOS + CTX + (q % SEQ) : q;
          float lg = bias;
#pragma unroll
          for (int kw = 0; kw < 8; ++kw) lg += PART[(kw * 16 + row) * 32 + e];
          float val = lg; int idx = e; float tv[4]; int ti[4];
#pragma unroll
          for (int k = 0; k < 4; ++k) { float bv = val; int bi2 = idx;
#pragma unroll
              for (int o = 1; o < 32; o <<= 1) { const float ov = __shfl_xor(bv, o); const int oi = __shfl_xor(bi2, o); if (ov > bv || (ov == bv && oi < bi2)) { bv = ov; bi2 = oi; } }
              tv[k] = bv; ti[k] = bi2; if (idx == bi2) val = -3e38f; }
          if (e == 0) { float ex[4], sum = 0.f;
#pragma unroll
              for (int k = 0; k < 4; ++k) { ex[k] = __expf(tv[k] - tv[0]); sum += ex[k]; }
              const float isum = 1.f / sum;
#pragma unroll
              for (int k = 0; k < 4; ++k) { const int asg = r * 4 + k; GATE[asg] = ex[k] * isum; const int rank = __hip_atomic_fetch_add(&LCNT[ti[k]], 1, __ATOMIC_RELAXED, __HIP_MEMORY_SCOPE_WORKGROUP); const int slot = __hip_atomic_fetch_add(&LCNT[32], 1, __ATOMIC_RELAXED, __HIP_MEMORY_SCOPE_WORKGROUP);
                  LENT[slot * 2] = asg; LENT[slot * 2 + 1] = (ti[k] << 16) | rank; } } }
        __syncthreads();
    }
    if (tid < 32) LBASE[tid] = LCNT[tid] > 0 ? atomicAdd(&CNT[tid * L::CNT_STRIDE], LCNT[tid]) : 0;
    __syncthreads();
    for (int i = tid; i < LCNT[32]; i += 512) { const int asg = LENT[i * 2], er = LENT[i * 2 + 1], ee = er >> 16, rank = er & 0xffff; LIST[(size_t)ee * LCAP + LBASE[ee] + rank] = asg; }
    __syncthreads();
}
__device__ __forceinline__ void smallw_phase(const float* w_uq, const float* qg, const float* w_ukv, const float* kvg, const float* w_a, const float* w_i, bf16_t* WUQT, bf16_t* WUKVT, bf16_t* WAT, bf16_t* WIT,
                                             float* TABC, float* TABS, const float* lam, float* SPT, const float* rw, bf16_t* RWHp, bf16_t* RWLp, int gt, int NGT) {
    for (int i = gt; i < 2 * 384 * 256; i += NGT) { const int l = i / (384 * 256), q = i % (384 * 256), n = q >> 8, k = q & 255; WUQT[i] = f2bf(qg[l * 256 + k] * w_uq[((size_t)l * 256 + k) * 384 + n]); }
    for (int i = gt; i < 2 * 512 * 128; i += NGT) { const int l = i / (512 * 128), q = i % (512 * 128), n = q >> 7, k = q & 127; WUKVT[i] = f2bf(kvg[l * 128 + k] * w_ukv[((size_t)l * 128 + k) * 512 + n]); }
    for (int i = gt; i < 16 * 4096; i += NGT) { const int m = i >> 12, q = i & 4095, e = q >> 6, d = q & 63; WAT[i] = f2bf(w_a[(size_t)m * 4096 + d * 64 + e]); WIT[i] = f2bf(w_i[(size_t)m * 4096 + d * 64 + e]); }
    for (int i = gt; i < 4096; i += NGT) { float s, c; sincospif((float)i / 2048.f, &s, &c); TABC[i] = c; TABS[i] = s; }
    for (int i = gt; i < 1024; i += NGT) SPT[i] = log1pf(__expf(-lam[i]));
    for (int i = gt; i < 2 * NE * D; i += NGT) { const int l = i / (NE * D), q = i % (NE * D), e = q >> 10, k = q & 1023; const float w = rw[((size_t)l * D + k) * NE + e]; const bf16_t h = f2bf(w); RWHp[i] = h; RWLp[i] = f2bf(w - bf2f(h)); }
}
}

namespace prep {
constexpr int O_KR = 0, O_CS = 8192, O_RS = 16384, O_CQ = 16896  , O_KS = 67072, O_CKV = 100864;
constexpr int CQP = 264, CKP = 136, QSP = 392, KSP = 264;
constexpr float C2 = 0.10206207261596577f * 1.4426950408889634f;
__device__ __forceinline__ void qkv_units(LAS unsigned char* lds, int l, const bf16_t* P, const bf16_t* WUQT, const bf16_t* WUKVT, const float* scw, const float* scb,
                                          bf16_t* QL, bf16_t* QC, bf16_t* KB, bf16_t* VTG, bf16_t* MIX, int u0, int u1, int ustep) {
    LAS float* KRo = (LAS float*)(lds + O_KR); LAS float* CS = (LAS float*)(lds + O_CS); LAS float* RS = (LAS float*)(lds + O_RS);
    LAS bf16_t* CQ = (LAS bf16_t*)(lds + O_CQ); LAS bf16_t* CK = (LAS bf16_t*)(lds + O_CKV); LAS bf16_t* KS = (LAS bf16_t*)(lds + O_KS); LAS bf16_t* QS = (LAS bf16_t*)(lds + O_CQ);
    for (int unit = u0; unit < u1; unit += ustep) {
        int tid_l = threadIdx.x; asm volatile("" : "+v"(tid_l));
        const int tid = tid_l, lane = tid & 63, w = __builtin_amdgcn_readfirstlane(tid >> 6), fr = lane & 15, fq = lane >> 4;
        const int b = unit / 68, chunk = unit % 68, pos0 = 64 * chunk; const bool ctxt = chunk < 4; const size_t r0 = (size_t)b * NPOS + pos0;
#pragma unroll
        for (int i = 0; i < 4; ++i) { const int q = tid + 512 * i, row = q >> 5, ch = q & 31; *(LAS u32x4*)((LAS unsigned char*)CQ + row * (CQP * 2) + ch * 16) = *(const u32x4*)(P + (r0 + row) * PP + C_CQ + ch * 8); }
#pragma unroll
        for (int i = 0; i < 2; ++i) { const int q = tid + 512 * i, row = q >> 4, ch = q & 15; *(LAS u32x4*)((LAS unsigned char*)CK + row * (CKP * 2) + ch * 16) = *(const u32x4*)(P + (r0 + row) * PP + C_CKV + ch * 8); }
        __syncthreads();
        { const int row = tid >> 3, j = tid & 7; float sq = 0.f, sk = 0.f;
#pragma unroll
          for (int i = 0; i < 4; ++i) { const u32x4 v = *(const LAS u32x4*)((const LAS unsigned char*)CQ + row * (CQP * 2) + j * 64 + i * 16);
#pragma unroll
              for (int e = 0; e < 4; ++e) { const float a = __uint_as_float(v[e] << 16), c = __uint_as_float(v[e] & 0xffff0000u); sq += a * a + c * c; } }
#pragma unroll
          for (int i = 0; i < 2; ++i) { const u32x4 v = *(const LAS u32x4*)((const LAS unsigned char*)CK + row * (CKP * 2) + j * 32 + i * 16);
#pragma unroll
              for (int e = 0; e < 4; ++e) { const float a = __uint_as_float(v[e] << 16), c = __uint_as_float(v[e] & 0xffff0000u); sk += a * a + c * c; } }
          sq += __shfl_xor(sq, 1); sq += __shfl_xor(sq, 2); sq += __shfl_xor(sq, 4); sk += __shfl_xor(sk, 1); sk += __shfl_xor(sk, 2); sk += __shfl_xor(sk, 4);
          if (j == 0) { RS[row * 2] = rsqrtf(sq * (1.f / 256.f) + 1e-6f); RS[row * 2 + 1] = rsqrtf(sk * (1.f / 128.f) + 1e-6f); }
          float cr = 1.f, sr = 0.f, cc = 1.f, sc = 0.f;
          if (!ctxt) { const int t = pos0 - CTX + row; const float inv = __expf(-9.210340371976184f * (float)j * 0.125f); float xa = (float)(t >> 6) * inv * 0.15915494309189535f; xa -= rintf(xa); sr = __sinf(xa * 6.283185307179586f); cr = __cosf(xa * 6.283185307179586f); float xb = (float)(t & 63) * inv * 0.15915494309189535f; xb -= rintf(xb); sc = __sinf(xb * 6.283185307179586f); cc = __cosf(xb * 6.283185307179586f); }
          CS[(row * 16 + j) * 2] = cr; CS[(row * 16 + j) * 2 + 1] = sr; CS[(row * 16 + 8 + j) * 2] = cc; CS[(row * 16 + 8 + j) * 2 + 1] = sc;
          const bf16_t* kp = P + (r0 + row) * PP + C_KR; const float z0 = bf2f(kp[j]), z1 = bf2f(kp[8 + j]), z2 = bf2f(kp[16 + j]), z3 = bf2f(kp[24 + j]);
          KRo[row * 32 + j] = z0 * cr - z1 * sr; KRo[row * 32 + 8 + j] = z0 * sr + z1 * cr; KRo[row * 32 + 16 + j] = z2 * cc - z3 * sc; KRo[row * 32 + 24 + j] = z2 * sc + z3 * cc; }
        __builtin_amdgcn_sched_barrier(0);
        { f32x4 qa[4][3];
#pragma unroll
          for (int mt = 0; mt < 4; ++mt)
#pragma unroll
              for (int n = 0; n < 3; ++n) qa[mt][n] = (f32x4){0.f, 0.f, 0.f, 0.f};
          const bf16_t* wq = WUQT + ((size_t)l * 384 + 48 * w + fr) * 256 + 8 * fq;
#pragma unroll
          for (int ks = 0; ks < 8; ++ks) { bf16x8 a[4], bb[3];
#pragma unroll
              for (int mt = 0; mt < 4; ++mt) a[mt] = *(const LAS bf16x8*)(CQ + (16 * mt + fr) * CQP + 32 * ks + 8 * fq);
#pragma unroll
              for (int n = 0; n < 3; ++n) bb[n] = *(const bf16x8*)(wq + (size_t)(16 * n) * 256 + 32 * ks);
#pragma unroll
              for (int mt = 0; mt < 4; ++mt)
#pragma unroll
                  for (int n = 0; n < 3; ++n) qa[mt][n] = __builtin_amdgcn_mfma_f32_16x16x32_bf16(a[mt], bb[n], qa[mt][n], 0, 0, 0); }
          __syncthreads();
#pragma unroll
          for (int n = 0; n < 3; ++n) { const int nt = 3 * w + n, m6 = nt % 6, col = 16 * nt + fr;
#pragma unroll
              for (int mt = 0; mt < 4; ++mt)
#pragma unroll
                  for (int i = 0; i < 4; ++i) { const int row = 16 * mt + 4 * fq + i; float v = qa[mt][n][i] * RS[row * 2];
                      if (m6 >= 4) { const float pv = __shfl_xor(v, 8); const int ci = (row * 16 + (m6 == 5 ? 8 : 0) + (fr & 7)) * 2; const float c = CS[ci], s = CS[ci + 1]; v = (fr < 8) ? v * c - pv * s : pv * s + v * c; }
                      QS[row * QSP + col] = f2bf(v * C2); } } }
        __builtin_amdgcn_sched_barrier(0);
        { f32x4 ka[4][4];
#pragma unroll
          for (int mt = 0; mt < 4; ++mt)
#pragma unroll
              for (int n = 0; n < 4; ++n) ka[mt][n] = (f32x4){0.f, 0.f, 0.f, 0.f};
          const bf16_t* wk = WUKVT + ((size_t)l * 512 + 64 * w + fr) * 128 + 8 * fq;
#pragma unroll
          for (int ks = 0; ks < 4; ++ks) { bf16x8 a[4], bb[4];
#pragma unroll
              for (int mt = 0; mt < 4; ++mt) a[mt] = *(const LAS bf16x8*)(CK + (16 * mt + fr) * CKP + 32 * ks + 8 * fq);
#pragma unroll
              for (int n = 0; n < 4; ++n) bb[n] = *(const bf16x8*)(wk + (size_t)(16 * n) * 128 + 32 * ks);
#pragma unroll
              for (int mt = 0; mt < 4; ++mt)
#pragma unroll
                  for (int n = 0; n < 4; ++n) ka[mt][n] = __builtin_amdgcn_mfma_f32_16x16x32_bf16(a[mt], bb[n], ka[mt][n], 0, 0, 0); }
          const int head = w >> 1;
          if ((w & 1) == 0) {
#pragma unroll
              for (int n = 0; n < 4; ++n)
#pragma unroll
                  for (int mt = 0; mt < 4; ++mt)
#pragma unroll
                      for (int i = 0; i < 4; ++i) { const int row = 16 * mt + 4 * fq + i; KS[row * KSP + head * 64 + 16 * n + fr] = f2bf(ka[mt][n][i] * RS[row * 2 + 1]); }
          } else {
#pragma unroll
              for (int n = 0; n < 4; ++n)
#pragma unroll
                  for (int mt = 0; mt < 4; ++mt) { const int rb = 16 * mt + 4 * fq; u32x2 o; o.x = pk2(ka[mt][n][0] * RS[rb * 2 + 1], ka[mt][n][1] * RS[rb * 2 + 3]); o.y = pk2(ka[mt][n][2] * RS[rb * 2 + 5], ka[mt][n][3] * RS[rb * 2 + 7]);
                      *(u32x2*)(VTG + ((size_t)(b * 4 + head) * 64 + 16 * n + fr) * NPOS + pos0 + rb) = o; } } }
        __syncthreads();
#pragma unroll
        for (int i = 0; i < 6; ++i) { const int q = tid + 512 * i, row = q / 48, rem = q % 48, head = rem / 12, ch = rem % 12, pos = pos0 + row;
            const u32x4 qv = *(const LAS u32x4*)((const LAS unsigned char*)QS + row * (QSP * 2) + (head * 96 + ch * 8) * 2);
            if (!ctxt) *(u32x4*)(QL + ((size_t)(b * 4 + head) * SEQ + (pos - CTX)) * 96 + ch * 8) = qv; else if (l == 0) *(u32x4*)(QC + ((size_t)(b * 4 + head) * CTX + pos) * 96 + ch * 8) = qv;
            u32x4 kv;
            if (ch < 8) kv = *(const LAS u32x4*)((const LAS unsigned char*)KS + row * (KSP * 2) + (head * 64 + ch * 8) * 2);
            else { const LAS float* kr = KRo + row * 32 + (ch - 8) * 8; kv.x = pk2(kr[0], kr[1]); kv.y = pk2(kr[2], kr[3]); kv.z = pk2(kr[4], kr[5]); kv.w = pk2(kr[6], kr[7]); }
            *(u32x4*)(KB + ((size_t)(b * 4 + head) * NPOS + pos) * 96 + ch * 8) = kv; }
        if (!(ctxt && l == 1)) { const int lo = ctxt ? 0 : CTX, hi = ctxt ? CTX : NPOS;
#pragma unroll
            for (int i = 0; i < 4; ++i) { const int q = tid + 512 * i, row = q >> 5, ch = q & 31, pos = pos0 + row; float acc[8];
#pragma unroll
                for (int e = 0; e < 8; ++e) acc[e] = scb[ch * 8 + e];
#pragma unroll
                for (int k = 0; k < 3; ++k) { const int p = pos - 1 + k; if (p >= lo && p < hi) { const bf16_t* pr = P + ((size_t)b * NPOS + p) * PP; const u32x4 sx = *(const u32x4*)(pr + C_SX + ch * 8), sc = *(const u32x4*)(pr + C_SC + ch * 8);
#pragma unroll
                        for (int e = 0; e < 4; ++e) { const float w0 = scw[k * 256 + ch * 8 + 2 * e], w1 = scw[k * 256 + ch * 8 + 2 * e + 1];
                            acc[2 * e] += w0 * (__uint_as_float(sx[e] << 16) * __uint_as_float(sc[e] << 16)); acc[2 * e + 1] += w1 * (__uint_as_float(sx[e] & 0xffff0000u) * __uint_as_float(sc[e] & 0xffff0000u)); } } }
                const u32x4 sb = *(const u32x4*)(P + (r0 + row) * PP + C_SB + ch * 8); u32x4 o;
#pragma unroll
                for (int e = 0; e < 4; ++e) o[e] = pk2(__uint_as_float(sb[e] << 16) * acc[2 * e], __uint_as_float(sb[e] & 0xffff0000u) * acc[2 * e + 1]);
                *(u32x4*)(MIX + (r0 + row) * D + 768 + ch * 8) = o; } }
        __syncthreads();
    }
}
}

namespace lru {
constexpr int XP = 264, O_X = 0, O_NA = 33792, O_BB = 66560;
__device__ __forceinline__ float sigm(float x) { return __builtin_amdgcn_rcpf(1.f + __expf(-x)); }
__device__ __forceinline__ void chunk_units(LAS unsigned char* lds, int l, const bf16_t* P, const float* conv_w, const float* conv_b, const bf16_t* WAT, const bf16_t* WIT, const float* b_a, const float* b_i, const float* SPT,
                                            bf16_t* HL, bf16_t* AC, float* SUM, int u0, int u1, int ustep, int knob) {
    LAS bf16_t* X = (LAS bf16_t*)(lds + O_X); LAS bf16_t* NA = (LAS bf16_t*)(lds + O_NA); LAS bf16_t* BB = (LAS bf16_t*)(lds + O_BB);
    for (int unit = u0; unit < u1; unit += ustep) {
        int tid_l = threadIdx.x; asm volatile("" : "+v"(tid_l));
        const int tid = tid_l, lane = tid & 63, w = __builtin_amdgcn_readfirstlane(tid >> 6), fr = lane & 15, fq = lane >> 4;
        const int dir = unit & 1, bc = unit >> 1, b = bc / 68, chunk = bc % 68, pos0 = 64 * chunk; const int lo = chunk < 4 ? 0 : CTX, hi = chunk < 4 ? CTX : NPOS, left = dir ? 1 : 2;
        const size_t r0 = (size_t)b * NPOS + pos0; const int pd = (l * 2 + dir) * 256;
        if (!(knob & 1)) { const int cg = tid & 31, ts = tid >> 5, c0 = cg * 8; float wv[4][8], cbv[8];
#pragma unroll
          for (int e = 0; e < 8; ++e) { cbv[e] = conv_b[pd + c0 + e];
#pragma unroll
              for (int k = 0; k < 4; ++k) wv[k][e] = conv_w[(size_t)pd * 4 + k * 256 + c0 + e]; }
          const bf16_t* pc = P + (size_t)b * NPOS * PP + C_LX + c0; const int pb = pos0 + 4 * ts - left;
          u32x4 u[7];
#pragma unroll
          for (int i = 0; i < 7; ++i) { const int p = pb + i; const int pcl = p < lo ? lo : (p >= hi ? hi - 1 : p); u[i] = *(const u32x4*)(pc + (size_t)pcl * PP); if (p < lo || p >= hi) u[i] = (u32x4){0u, 0u, 0u, 0u}; }
#pragma unroll
          for (int i = 0; i < 4; ++i) { u32x4 o;
#pragma unroll
              for (int e2 = 0; e2 < 4; ++e2) { float lo_ = cbv[2 * e2], hi_ = cbv[2 * e2 + 1];
#pragma unroll
                  for (int k = 0; k < 4; ++k) { const unsigned d = u[i + k][e2]; lo_ += wv[k][2 * e2] * __uint_as_float(d << 16); hi_ += wv[k][2 * e2 + 1] * __uint_as_float(d & 0xffff0000u); }
                  o[e2] = pk2(lo_, hi_); }
              *(LAS u32x4*)(X + (4 * ts + i) * XP + c0) = o; } }
        __syncthreads();
        if (!(knob & 2)) { const int h = w >> 1, mh = w & 1;
          f32x4 ra[2][4], ri[2][4];
#pragma unroll
          for (int m = 0; m < 2; ++m)
#pragma unroll
              for (int n = 0; n < 4; ++n) { ra[m][n] = (f32x4){0.f, 0.f, 0.f, 0.f}; ri[m][n] = (f32x4){0.f, 0.f, 0.f, 0.f}; }
          const bf16_t* wa = WAT + ((size_t)((l * 2 + dir) * 4 + h) * 64 + fr) * 64 + 8 * fq; const bf16_t* wi = WIT + ((size_t)((l * 2 + dir) * 4 + h) * 64 + fr) * 64 + 8 * fq;
#pragma unroll
          for (int ks = 0; ks < 2; ++ks) { bf16x8 a[2], ba[4], bi[4];
#pragma unroll
              for (int m = 0; m < 2; ++m) a[m] = *(const LAS bf16x8*)(X + (16 * (2 * mh + m) + fr) * XP + 64 * h + 32 * ks + 8 * fq);
#pragma unroll
              for (int n = 0; n < 4; ++n) { ba[n] = *(const bf16x8*)(wa + (size_t)(16 * n) * 64 + 32 * ks); bi[n] = *(const bf16x8*)(wi + (size_t)(16 * n) * 64 + 32 * ks); }
#pragma unroll
              for (int m = 0; m < 2; ++m)
#pragma unroll
                  for (int n = 0; n < 4; ++n) { ra[m][n] = __builtin_amdgcn_mfma_f32_16x16x32_bf16(a[m], ba[n], ra[m][n], 0, 0, 0); ri[m][n] = __builtin_amdgcn_mfma_f32_16x16x32_bf16(a[m], bi[n], ri[m][n], 0, 0, 0); } }
#pragma unroll
          for (int n = 0; n < 4; ++n) { const int c = 64 * h + 16 * n + fr; const float bav = b_a[pd + c], biv = b_i[pd + c], sp8 = 8.f * SPT[pd + c];
#pragma unroll
              for (int m = 0; m < 2; ++m)
#pragma unroll
                  for (int i = 0; i < 4; ++i) { const int t = 16 * (2 * mh + m) + 4 * fq + i; const float r = sigm(ra[m][n][i] + bav), ig = sigm(ri[m][n][i] + biv);
                      const float x = r * sp8; const float na = x < 0.03125f ? x * (1.f - 0.5f * x * (1.f - 0.33333334f * x * (1.f - 0.25f * x))) : 1.f - __expf(-x); const float xv = bf2f(X[t * XP + c]);
                      NA[t * 256 + c] = f2bf(na); BB[t * 256 + c] = f2bf(__builtin_amdgcn_sqrtf(fmaxf(na * (2.f - na), 0.f)) * (ig * xv)); } } }
        __syncthreads();
        if (tid < 256 && !(knob & 4)) { const int c = tid; float hst = 0.f, A = 1.f;
            if (dir == 0) {
#pragma unroll 8
                for (int t = 0; t < 64; ++t) { const float a = 1.f - bf2f(NA[t * 256 + c]); hst = a * hst + bf2f(BB[t * 256 + c]); A *= a; BB[t * 256 + c] = f2bf(hst); NA[t * 256 + c] = f2bf(A); }
            } else {
#pragma unroll 8
                for (int t = 63; t >= 0; --t) { const float a = 1.f - bf2f(NA[t * 256 + c]); hst = a * hst + bf2f(BB[t * 256 + c]); A *= a; BB[t * 256 + c] = f2bf(hst); NA[t * 256 + c] = f2bf(A); }
            }
            float* sm = SUM + ((size_t)(dir * 4 + b) * 68 + chunk) * 512; sm[c] = A; sm[256 + c] = hst; }
        __syncthreads();
        if (!(knob & 4)) {
#pragma unroll
            for (int i = 0; i < 4; ++i) { const int q = tid + 512 * i, t = q >> 5, ch = q & 31; const size_t go = ((size_t)dir * MROWS + r0 + t) * 256 + ch * 8;
                *(u32x4*)(AC + go) = *(const LAS u32x4*)(NA + t * 256 + ch * 8); *(u32x4*)(HL + go) = *(const LAS u32x4*)(BB + t * 256 + ch * 8); } }
        __syncthreads();
    }
}
__device__ __forceinline__ void fixup_units(LAS unsigned char* lds, int l, const bf16_t* P, const bf16_t* HL, const bf16_t* AC, const float* SUM, bf16_t* MIX, int G, int bx) {
    LAS float* CAR = (LAS float*)lds;
    for (int unit = bx; unit < 272; unit += G) {
        int tid_l = threadIdx.x; asm volatile("" : "+v"(tid_l));
        const int tid = tid_l;
        const int b = unit / 68, chunk = unit % 68; if (l == 1 && chunk < 4) continue;
        { const int dir = tid >> 8, c = tid & 255; const float* sp = SUM + ((size_t)(dir * 4 + b) * 68) * 512 + c;
          const int n_pre = dir == 0 ? chunk : (chunk < 4 ? 3 - chunk : 4 + (67 - chunk));
          float cy = 0.f;
          for (int j0 = 0; j0 < n_pre; j0 += 16) { float av[16], hv[16];
#pragma unroll
              for (int u = 0; u < 16; ++u) { const int n = j0 + u < n_pre ? j0 + u : n_pre - 1; const int j = dir == 0 ? n : (n < 4 ? 3 - n : 71 - n); av[u] = sp[(size_t)j * 512]; hv[u] = sp[(size_t)j * 512 + 256]; }
#pragma unroll
              for (int u = 0; u < 16; ++u) cy = (j0 + u < n_pre) ? hv[u] + av[u] * cy : cy; }
          CAR[tid] = cy; }
        __syncthreads();
        { const int cg = tid & 31, ts = tid >> 5, c0 = cg * 8; float cf[8], cb[8];
#pragma unroll
          for (int e = 0; e < 8; ++e) { cf[e] = CAR[c0 + e]; cb[e] = CAR[256 + c0 + e]; }
          const size_t r0 = (size_t)b * NPOS + 64 * chunk + 4 * ts;
          u32x4 hf[4], af[4], hb[4], ab[4], gt[4];
#pragma unroll
          for (int i = 0; i < 4; ++i) { const size_t r = r0 + i; hf[i] = *(const u32x4*)(HL + r * 256 + c0); af[i] = *(const u32x4*)(AC + r * 256 + c0); hb[i] = *(const u32x4*)(HL + ((size_t)MROWS + r) * 256 + c0); ab[i] = *(const u32x4*)(AC + ((size_t)MROWS + r) * 256 + c0);
              gt[i] = *(const u32x4*)(P + r * PP + C_LG + c0); }
#pragma unroll
          for (int i = 0; i < 4; ++i) { u32x4 o;
#pragma unroll
              for (int e2 = 0; e2 < 4; ++e2) { float res[2];
#pragma unroll
                  for (int hh = 0; hh < 2; ++hh) { const int e = 2 * e2 + hh;
                      const float vhf = hh ? __uint_as_float(hf[i][e2] & 0xffff0000u) : __uint_as_float(hf[i][e2] << 16), vaf = hh ? __uint_as_float(af[i][e2] & 0xffff0000u) : __uint_as_float(af[i][e2] << 16);
                      const float vhb = hh ? __uint_as_float(hb[i][e2] & 0xffff0000u) : __uint_as_float(hb[i][e2] << 16), vab = hh ? __uint_as_float(ab[i][e2] & 0xffff0000u) : __uint_as_float(ab[i][e2] << 16);
                      const float x = hh ? __uint_as_float(gt[i][e2] & 0xffff0000u) : __uint_as_float(gt[i][e2] << 16);
                      const float hsum = (vhf + vaf * cf[e]) + (vhb + vab * cb[e]);
                      const float u = 0.7978845608028654f * (x + 0.044715f * x * x * x); const float th_ = 1.f - 2.f * __builtin_amdgcn_rcpf(1.f + __expf(2.f * u));
                      res[hh] = 0.5f * x * (1.f + th_) * hsum; }
                  o[e2] = pk2(res[0], res[1]); }
              *(u32x4*)(MIX + (r0 + i) * D + 256 + c0) = o; } }
        __syncthreads();
    }
}
}

namespace fft {
__device__ __forceinline__ void ctx_a(LAS unsigned char* lds, const bf16_t* P, const float* TABC, const float* TABS, bf16_t* XCT, int G, int bx) {
    LAS bf16_t* U = (LAS bf16_t*)(lds + O_U); LAS bf16_t* X = (LAS bf16_t*)(lds + O_X);
    for (int unit = bx; unit < 16; unit += G) {
        int tid_l = threadIdx.x; asm volatile("" : "+v"(tid_l));
        const int tid = tid_l, lane = tid & 63, w = __builtin_amdgcn_readfirstlane(tid >> 6), fr = lane & 15, fq = lane >> 4;
        build_tables(lds, TABC, TABS, tid);
        const LAS bf16_t* Tc = (const LAS bf16_t*)(lds + O_TC); const LAS bf16_t* Ts = (const LAS bf16_t*)(lds + O_TS);
        const int b = unit >> 2, q = unit & 3;
#pragma unroll
        for (int i = 0; i < 4; ++i) { const int qq = tid + 512 * i, t1 = qq >> 5, ch = qq & 31;
            *(LAS u32x4*)((LAS unsigned char*)U + t1 * (UP * 2) + ch * 16) = *(const u32x4*)(P + ((size_t)b * NPOS + 64 * q + t1) * PP + ch * 8); }
        __syncthreads();
        { const int g = w >> 1, part = w & 1; const LAS bf16_t* T = part ? Ts : Tc;
          f32x4 acc[4][4];
#pragma unroll
          for (int mt = 0; mt < 4; ++mt)
#pragma unroll
              for (int nt = 0; nt < 4; ++nt) acc[mt][nt] = (f32x4){0.f, 0.f, 0.f, 0.f};
#pragma unroll
          for (int ks = 0; ks < 2; ++ks) { bf16x8 a[4], bb[4];
#pragma unroll
              for (int mt = 0; mt < 4; ++mt) a[mt] = *(const LAS bf16x8*)(U + (16 * mt + fr) * UP + g * 64 + 32 * ks + 8 * fq);
#pragma unroll
              for (int nt = 0; nt < 4; ++nt) bb[nt] = *(const LAS bf16x8*)(T + (16 * nt + fr) * TP + 32 * ks + 8 * fq);
#pragma unroll
              for (int mt = 0; mt < 4; ++mt)
#pragma unroll
                  for (int nt = 0; nt < 4; ++nt) acc[mt][nt] = __builtin_amdgcn_mfma_f32_16x16x32_bf16(a[mt], bb[nt], acc[mt][nt], 0, 0, 0); }
          const float sg = part ? -1.f : 1.f;
#pragma unroll
          for (int mt = 0; mt < 4; ++mt)
#pragma unroll
              for (int nt = 0; nt < 4; ++nt) { const f32x4 v = acc[mt][nt] * sg; u32x2 o; o.x = pk2(v[0], v[1]); o.y = pk2(v[2], v[3]);
                  *(LAS u32x2*)(X + (part * 256 + g * 64 + 16 * nt + fr) * TP + 16 * mt + 4 * fq) = o; } }
        __syncthreads();
#pragma unroll
        for (int i = 0; i < 8; ++i) { const int qq = tid + 512 * i, row = qq >> 3, c8 = qq & 7;
            *(u32x4*)(XCT + (((size_t)b * 4 + q) * 512 + row) * 64 + c8 * 8) = *(const LAS u32x4*)((const LAS unsigned char*)X + row * (TP * 2) + c8 * 16); }
        __syncthreads();
    }
}
__device__ __forceinline__ void ctx_b(LAS unsigned char* lds, const bf16_t* XCT, const float* TABC, const float* TABS, bf16_t* MIX, int G, int bx) {
    LAS bf16_t* Tc = (LAS bf16_t*)(lds + O_TC); LAS bf16_t* Ts = (LAS bf16_t*)(lds + O_TS);
    LAS bf16_t* Ys = (LAS bf16_t*)(lds + O_U); LAS bf16_t* ZT = (LAS bf16_t*)(lds + O_X);
    for (int unit = bx; unit < 16; unit += G) {
        int tid_l = threadIdx.x; asm volatile("" : "+v"(tid_l));
        const int tid = tid_l, lane = tid & 63, w = __builtin_amdgcn_readfirstlane(tid >> 6), fr = lane & 15, fq = lane >> 4;
        const int b = unit >> 2, ft = unit & 3;
        f32x4 y[4][2];
#pragma unroll
        for (int mt = 0; mt < 4; ++mt)
#pragma unroll
            for (int n = 0; n < 2; ++n) y[mt][n] = (f32x4){0.f, 0.f, 0.f, 0.f};
        for (int q = 0; q < 4; ++q) {
            for (int i = tid; i < 4096; i += 512) { const int fl = i >> 6, tl = i & 63, ix = (((64 * ft + fl) * (64 * q + tl)) & 255) * 16; Tc[fl * TP + tl] = f2bf(TABC[ix]); Ts[fl * TP + tl] = f2bf(TABS[ix]); }
#pragma unroll
            for (int i = 0; i < 8; ++i) { const int qq = tid + 512 * i, row = qq >> 3, c8 = qq & 7;
                *(LAS u32x4*)((LAS unsigned char*)ZT + row * (TP * 2) + c8 * 16) = *(const u32x4*)(XCT + (((size_t)b * 4 + q) * 512 + row) * 64 + c8 * 8); }
            __syncthreads();
#pragma unroll
            for (int ks = 0; ks < 2; ++ks) { bf16x8 xr[2], xi[2];
#pragma unroll
                for (int n = 0; n < 2; ++n) { xr[n] = *(const LAS bf16x8*)(ZT + (32 * w + 16 * n + fr) * TP + 32 * ks + 8 * fq); xi[n] = *(const LAS bf16x8*)(ZT + (256 + 32 * w + 16 * n + fr) * TP + 32 * ks + 8 * fq); }
#pragma unroll
                for (int mt = 0; mt < 4; ++mt) { const bf16x8 c = *(const LAS bf16x8*)(Tc + (16 * mt + fr) * TP + 32 * ks + 8 * fq), s = *(const LAS bf16x8*)(Ts + (16 * mt + fr) * TP + 32 * ks + 8 * fq);
#pragma unroll
                    for (int n = 0; n < 2; ++n) { y[mt][n] = __builtin_amdgcn_mfma_f32_16x16x32_bf16(c, xr[n], y[mt][n], 0, 0, 0); y[mt][n] = __builtin_amdgcn_mfma_f32_16x16x32_bf16(s, xi[n], y[mt][n], 0, 0, 0); } } }
            __syncthreads();
        }
#pragma unroll
        for (int mt = 0; mt < 4; ++mt)
#pragma unroll
            for (int i = 0; i < 4; ++i)
#pragma unroll
                for (int n = 0; n < 2; ++n) Ys[(16 * mt + 4 * fq + i) * UP + 32 * w + 16 * n + fr] = f2bf(y[mt][n][i] * (1.f / 128.f));
        __syncthreads();
#pragma unroll
        for (int i = 0; i < 4; ++i) { const int qq = tid + 512 * i, fl = qq >> 5, ch = qq & 31;
            *(u32x4*)(MIX + ((size_t)b * NPOS + 64 * ft + fl) * D + ch * 8) = *(const LAS u32x4*)((const LAS unsigned char*)Ys + fl * (UP * 2) + ch * 16); }
        __syncthreads();
    }
}
}

constexpr int NWAVES = 8, RING_BYTES = 131072 + 3072, LDSCTL_OFF = RING_BYTES, MISC_OFF = LDSCTL_OFF + 64, META_OFF = MISC_OFF + 64, LDS_BYTES = 147456;
enum { PH_PRO0 = 0, PH_PRO1 = 1, PH_L0 = 2, PH_PER_LAYER = 8, PH_N = 18 };
enum { PL_WIN = 0, PL_PREP = 1, PL_MIX = 2, PL_WOUT = 3, PL_ROUTE = 4, PL_MOE1 = 5, PL_MOE2 = 6, PL_COMB = 7 };
struct MArgs { const float* in[30]; float* out; unsigned char* ws; int npass, skip_mask, dup_ph, dup_n, dup_sub, knob; };

__device__ __forceinline__ void transpose_item(const float* W, int K, int N, bf16_t* WT, int drow0, LAS float* scr, int k0, int n0, int lane) {
    const int kr = lane >> 3, nc = (lane & 7) * 4;
    f32x4 v[8];
#pragma unroll
    for (int i = 0; i < 8; ++i) v[i] = __builtin_nontemporal_load((const f32x4*)(W + (size_t)(k0 + kr + 8 * i) * N + n0 + nc));
#pragma unroll
    for (int i = 0; i < 8; ++i) { LAS float* d = scr + (kr + 8 * i) * 33 + nc; d[0] = v[i][0]; d[1] = v[i][1]; d[2] = v[i][2]; d[3] = v[i][3]; }
    asm volatile("s_waitcnt lgkmcnt(0)" ::: "memory");
    const int c = lane & 7;
#pragma unroll
    for (int j = 0; j < 4; ++j) { const int n = (lane >> 3) + 8 * j; const LAS float* s = scr + (8 * c) * 33 + n;
        u32x4 o; o.x = pk2(s[0 * 33], s[1 * 33]); o.y = pk2(s[2 * 33], s[3 * 33]); o.z = pk2(s[4 * 33], s[5 * 33]); o.w = pk2(s[6 * 33], s[7 * 33]);
        *(u32x4*)(WT + (size_t)(drow0 + n) * K + k0 + 8 * c) = o; }
    asm volatile("s_waitcnt lgkmcnt(0)" ::: "memory");
}

constexpr int I_GU = NE * 16 * 64, I_DN = NE * 16 * 32, I_EXP = I_GU + I_DN;
__device__ __forceinline__ void expert_item(int l, int j, const float* wgu, const float* wdn, unsigned char* ws, LAS float* scr, int lane) {
    if (j < I_GU) { const int e = j / (16 * 64), q = j % (16 * 64), kb = q / 64, nb = q % 64; const int n0 = 32 * nb; const int c2 = n0 & 1023; const int drow = (c2 >> 7) * 256 + (n0 >> 10) * 128 + (c2 & 127);
        transpose_item(wgu + ((size_t)l * NE + e) * D * 2048, D, 2048, (bf16_t*)(ws + L::WGUT) + ((size_t)l * NE + e) * 2048 * D, drow, scr, 64 * kb, n0, lane); }
    else { const int r = j - I_GU; const int e = r / (16 * 32), q = r % (16 * 32), kb = q / 32, nb = q % 32;
        transpose_item(wdn + ((size_t)l * NE + e) * D * D, D, D, (bf16_t*)(ws + L::WDT) + ((size_t)l * NE + e) * D * D, 32 * nb, scr, 64 * kb, 32 * nb, lane); }
}
constexpr int Q_WIN = 48, Q_WOUT = 96, Q_MOE2 = 0;
constexpr int DEF_WIN = 224 * Q_WIN, DEF0 = DEF_WIN + 240 * Q_WOUT, DEF_MOE2 = 128 * Q_MOE2, DEF1 = DEF_MOE2 + 224 * Q_WIN;
__device__ __forceinline__ void deferred_items(int l, int first, int count, const float* wgu, const float* wdn, unsigned char* ws, LAS unsigned char* lds, int wave, int lane) {
    LAS float* scr = (LAS float*)(lds + wave * 16384);
    for (int j = first + wave; j < first + count; j += NWAVES) expert_item(l, j, wgu, wdn, ws, scr, lane);
}

#define GASP __attribute__((address_space(1)))
#define ARG_IN(i) ({ const GASP float* _p; asm volatile("s_load_dwordx2 %0, %1, %2\n\ts_waitcnt lgkmcnt(0)" : "=s"(_p) : "s"(__builtin_amdgcn_kernarg_segment_ptr()), "n"((i) * 8)); (const float*)_p; })
__global__ void __launch_bounds__(NWAVES * 64, 2) mega(MArgs args) {
    extern __shared__ __attribute__((aligned(16))) unsigned char lds_raw[];
    const int G0 = gridDim.x, bx0 = blockIdx.x;
    unsigned char* ws0 = args.ws;
    unsigned* ctl0 = (unsigned*)(ws0 + L::CTL);
    for (int u = threadIdx.x; u < (LDS_BYTES - LDSCTL_OFF) / 4; u += NWAVES * 64) ((LAS unsigned*)(lds_raw + LDSCTL_OFF))[u] = 0u;
    __syncthreads();
    volatile LAS unsigned* MISC = (volatile LAS unsigned*)((LAS unsigned char*)lds_raw + MISC_OFF);
    XcdBarrier bar = xcd_barrier_post(ctl0 + L::CW_BAR, MISC);
    const int lo = 0, hi = PH_N;

    bool first = true;
    for (int pass = 0; pass < args.npass; ++pass)
    for (int ph = lo; ph < hi; ++ph) {
      const int reps = (ph == args.dup_ph) ? 1 + args.dup_n : 1;
      if (ph == PH_PRO1) continue;
      for (int rep = 0; rep < reps; ++rep) {
        if (!first) xcd_barrier(bar);
        first = false;
        if (pass + 1 < args.npass && ((args.skip_mask >> ph) & 1)) continue;
        const int sub = rep + 1 < reps ? args.dup_sub : 15; const int knob = rep + 1 < reps ? args.knob : 0; (void)knob;
        GASP unsigned char* wsg = (GASP unsigned char*)args.ws; asm volatile("" : "+s"(wsg)); unsigned char* ws = (unsigned char*)wsg;
        unsigned* ctl = (unsigned*)(ws + L::CTL);
        int tid_p = threadIdx.x; asm volatile("" : "+v"(tid_p));
        int G = G0, bx = bx0; asm volatile("" : "+s"(G), "+s"(bx));
        const int vcu = (G % 8 == 0) ? (bx % 8) * (G / 8) + bx / 8 : bx; (void)vcu;
        unsigned ldsb = 0; asm volatile("" : "+s"(ldsb)); LAS unsigned char* lds = (LAS unsigned char*)lds_raw + ldsb;
        LAS int* META = (LAS int*)(lds + META_OFF);
        const int tid = tid_p, lane = tid & 63, wave = __builtin_amdgcn_readfirstlane(tid >> 6); (void)lane; (void)wave;
        if (ph == PH_PRO0) {
            if (bx == 0 && tid < 2 * NE) ((int*)(ctl + L::CW_CNT))[tid * L::CNT_STRIDE] = 0;
            sm::smallw_phase(ARG_IN(17), ARG_IN(16), ARG_IN(19), ARG_IN(18), ARG_IN(11), ARG_IN(13), (bf16_t*)(ws + L::WUQT), (bf16_t*)(ws + L::WUKVT), (bf16_t*)(ws + L::WAT), (bf16_t*)(ws + L::WIT),
                             (float*)(ws + L::TABC), (float*)(ws + L::TABS), ARG_IN(15), (float*)(ws + L::SPT), ARG_IN(23), (bf16_t*)(ws + L::RWH), (bf16_t*)(ws + L::RWL), bx * 512 + tid, G * 512);
            __syncthreads();
            sm::mod_phase(lds, ARG_IN(1), ARG_IN(3), ARG_IN(4), ARG_IN(5), (float*)(ws + L::MOD), G, bx, tid);
            { int nmine = 0; for (int u = bx; u < 96; u += G) ++nmine;
              if (nmine) { asm volatile("s_waitcnt vmcnt(0)" ::: "memory"); __syncthreads();
                  if (tid == 0) { __builtin_amdgcn_fence(__ATOMIC_RELEASE, "agent"); asm volatile("s_waitcnt vmcnt(0)" ::: "memory"); __hip_atomic_fetch_add(ctl + L::CW_MODCNT, (unsigned)nmine, __ATOMIC_RELAXED, __HIP_MEMORY_SCOPE_AGENT); } } }
            __syncthreads();
            LAS float* scr = (LAS float*)(lds + wave * 16384);
            const int gw = vcu * NWAVES + wave, NGW = G * NWAVES;
            constexpr int I_IN = 16 * 61, I_OUT = 16 * 32, I_D = I_IN + I_OUT; const int d0 = G == 256 ? DEF0 : 0, d1 = G == 256 ? DEF1 : 0, R0 = I_EXP - d0, R1 = I_EXP - d1;
            for (int it = gw; it < 2 * I_D + R0 + R1; it += NGW) {
                if (it < 2 * I_D) { const int l = it / I_D; int r = it % I_D;
                    if (r < I_IN) { const int kb = r / 61, nb = r % 61; transpose_item(ARG_IN(8) + (size_t)l * D * PT, D, PT, (bf16_t*)(ws + L::WINT) + (size_t)l * 2048 * D, 32 * nb, scr, 64 * kb, 32 * nb, lane); }
                    else { r -= I_IN; const int kb = r / 32, nb = r % 32; transpose_item(ARG_IN(22) + (size_t)l * D * D, D, D, (bf16_t*)(ws + L::WOUTT) + (size_t)l * D * D, 32 * nb, scr, 64 * kb, 32 * nb, lane); }
                } else { const int r = it - 2 * I_D; if (r < R0) expert_item(0, d0 + r, ARG_IN(25), ARG_IN(27), ws, scr, lane); else expert_item(1, d1 + (r - R0), ARG_IN(25), ARG_IN(27), ws, scr, lane); }
            }
            for (int i = bx * 512 + tid; i < 2 * 96 * D / 8; i += G * 512) { const int l = i / (96 * D / 8), q = i % (96 * D / 8); *(u32x4*)((bf16_t*)(ws + L::WINT) + ((size_t)l * 2048 + PT) * D + (size_t)q * 8) = (u32x4){0u, 0u, 0u, 0u}; }
            if (tid == 0) { unsigned sp = 0; while (__hip_atomic_load(ctl + L::CW_MODCNT, __ATOMIC_RELAXED, __HIP_MEMORY_SCOPE_AGENT) < 96u && ++sp < (1u << 22)) __builtin_amdgcn_s_sleep(2);
                __builtin_amdgcn_fence(__ATOMIC_ACQUIRE, "agent"); asm volatile("s_waitcnt vmcnt(0)" ::: "memory"); }
            __syncthreads();
            { const int nmod = G < 96 ? G : 96; const int small = 45, rs0 = bx < nmod ? bx * small : nmod * small + (int)(((long)(bx - nmod) * (MROWS - nmod * small)) / (G - nmod)),
                  rs1 = bx + 1 < nmod ? (bx + 1) * small : (bx + 1 >= G ? MROWS : nmod * small + (int)(((long)(bx + 1 - nmod) * (MROWS - nmod * small)) / (G - nmod)));
              sm::pro1_phase(ARG_IN(0), ARG_IN(2), ARG_IN(6), (const float*)(ws + L::MOD), (float*)(ws + L::H), (bf16_t*)(ws + L::XN), rs0 + wave, rs1, NWAVES, lane); }
            continue;
        }
        if (ph < PH_L0) continue;
        const int l = (ph - PH_L0) / PH_PER_LAYER, pl = (ph - PH_L0) % PH_PER_LAYER;
        const float* MODl = (const float*)(ws + L::MOD) + (size_t)l * 5 * 6144;
        if (pl == PL_WIN) {
            g8::DenseSched S; S.init(MROWS / 256, PP / 256, G, bx, 0, (const bf16_t*)(ws + L::WINT) + (size_t)l * 2048 * D, D);
            g8::EpiP E{(bf16_t*)(ws + L::P)};
            g8::gemm_phase<g8::EpiP, g8::DenseSched, false, false>(lds, (const char*)(ws + L::XN), S, E);
            if (G == 256 && bx >= 32) deferred_items(l, (l == 0 ? 0 : DEF_MOE2) + (bx - 32) * Q_WIN, Q_WIN, ARG_IN(25), ARG_IN(27), ws, lds, wave, lane);
        } else if (pl == PL_PREP) {
            if (l == 0 && (sub & 2)) { fft::ctx_a(lds, (const bf16_t*)(ws + L::P), (const float*)(ws + L::TABC), (const float*)(ws + L::TABS), (bf16_t*)(ws + L::XCT), G, G - 1 - bx); __syncthreads(); }
            for (int p = 0; p * G < 1072; ++p) {
                const int k = p * G + ((p & 1) ? G - 1 - bx : bx);
                if (k >= 1072) continue;
                if (k < 272) { if (sub & 4) prep::qkv_units(lds, l, (const bf16_t*)(ws + L::P), (const bf16_t*)(ws + L::WUQT), (const bf16_t*)(ws + L::WUKVT), ARG_IN(20) + l * 768, ARG_IN(21) + l * 256,
                            (bf16_t*)(ws + L::QL), (bf16_t*)(ws + L::QC), (bf16_t*)(ws + L::KB), (bf16_t*)(ws + L::VTG), (bf16_t*)(ws + L::MIX), k, k + 1, 1); }
                else if (k < 816) { if (sub & 8) lru::chunk_units(lds, l, (const bf16_t*)(ws + L::P), ARG_IN(9), ARG_IN(10), (const bf16_t*)(ws + L::WAT), (const bf16_t*)(ws + L::WIT), ARG_IN(12), ARG_IN(14), (const float*)(ws + L::SPT),
                             (bf16_t*)(ws + L::HL), (bf16_t*)(ws + L::AC), (float*)(ws + L::SUM), k - 272, k - 271, 1, knob); }
                else { if (sub & 1) fft::stage_a(lds, (const bf16_t*)(ws + L::P), (const float*)(ws + L::TABC), (const float*)(ws + L::TABS), (bf16_t*)(ws + L::ZBUF), k - 816, k - 815, 1); }
                __syncthreads();
            }
        } else if (pl == PL_MIX) {
            if (sub & 1) lru::fixup_units(lds, l, (const bf16_t*)(ws + L::P), (const bf16_t*)(ws + L::HL), (const bf16_t*)(ws + L::AC), (const float*)(ws + L::SUM), (bf16_t*)(ws + L::MIX), G, bx);
            if (sub & 2) fft::stage_b(lds, (const bf16_t*)(ws + L::ZBUF), (const float*)(ws + L::TABC), (const float*)(ws + L::TABS), (bf16_t*)(ws + L::MIX), G, bx);
            __syncthreads();
            if (l == 0 && (sub & 4)) { fft::ctx_b(lds, (const bf16_t*)(ws + L::XCT), (const float*)(ws + L::TABC), (const float*)(ws + L::TABS), (bf16_t*)(ws + L::MIX), G, G - 1 - bx); __syncthreads(); }
            if (sub & 8) attn::attn_phase(lds, (const bf16_t*)(ws + L::QL), (const bf16_t*)(ws + L::QC), (const bf16_t*)(ws + L::KB), (const bf16_t*)(ws + L::VTG), (bf16_t*)(ws + L::MIX), l == 0 ? 1 : 0, G, vcu);
        } else if (pl == PL_WOUT) {
            g8::DenseSched S; S.init(l == 0 ? MROWS / 256 : 64, D / 256, G, bx, l == 0 ? 0 : 1, (const bf16_t*)(ws + L::WOUTT) + (size_t)l * D * D, D);
            g8::EpiH E{(float*)(ws + L::H), MODl, 2048};
            g8::gemm_phase<g8::EpiH, g8::DenseSched, false, false>(lds, (const char*)(ws + L::MIX), S, E);
            if (G == 256 && l == 0 && bx >= 16) deferred_items(0, DEF_WIN + (bx - 16) * Q_WOUT, Q_WOUT, ARG_IN(25), ARG_IN(27), ws, lds, wave, lane);
        } else if (pl == PL_ROUTE) {
            sm::route_phase(lds, l, (const float*)(ws + L::H), ARG_IN(7) + l * D, MODl, (const bf16_t*)(ws + L::RWH), (const bf16_t*)(ws + L::RWL), ARG_IN(24) + l * NE, (bf16_t*)(ws + L::XN), (int*)(ctl + L::CW_CNT) + l * NE * L::CNT_STRIDE,
                            (int*)(ws + L::LIST) + (size_t)l * NE * LCAP, (float*)(ws + L::GATE), G, bx, tid);
        } else if (pl == PL_COMB) {
            sm::comb_phase(l, (float*)(ws + L::H), (const bf16_t*)(ws + L::Y), MODl, ARG_IN(6) + D, (const float*)(ws + L::MOD) + (size_t)5 * 6144, (bf16_t*)(ws + L::XN), ARG_IN(29), args.out, bx * NWAVES + wave, G * NWAVES, lane);
        } else if (pl == PL_MOE1 || pl == PL_MOE2) {
            const int* CNTg = (const int*)(ctl + L::CW_CNT) + l * NE * L::CNT_STRIDE;
            if (tid == 0) { int o = 0; for (int e = 0; e < NE; ++e) { const int cn = CNTg[e * L::CNT_STRIDE]; META[e] = o; META[64 + e] = cn; o += (cn + 255) >> 8; } META[NE] = o; }
            __syncthreads();
            g8::MoeSched S; S.tpre = META; S.cnt = META + 64; S.G = G; S.c = bx; S.K = D; S.list = (const int*)(ws + L::LIST) + (size_t)l * NE * LCAP;
            if (pl == PL_MOE1) {
                S.NT = 8; S.COLW = 128; S.total = __builtin_amdgcn_readfirstlane(META[NE]) * 8; S.Bt = (const char*)((const bf16_t*)(ws + L::WGUT) + (size_t)l * NE * 2048 * D);
                g8::EpiMoe1 E{(bf16_t*)(ws + L::ACT), ARG_IN(26) + (size_t)l * NE * 2048};
                g8::gemm_phase<g8::EpiMoe1, g8::MoeSched, true, true>(lds, (const char*)(ws + L::XN), S, E);
            } else {
                S.NT = 4; S.COLW = 256; S.total = __builtin_amdgcn_readfirstlane(META[NE]) * 4; S.Bt = (const char*)((const bf16_t*)(ws + L::WDT) + (size_t)l * NE * D * D);
                g8::EpiMoe2 E{(bf16_t*)(ws + L::Y), ARG_IN(28) + (size_t)l * NE * D, (const float*)(ws + L::GATE)};
                g8::gemm_phase<g8::EpiMoe2, g8::MoeSched, false, true>(lds, (const char*)(ws + L::ACT), S, E);
                if (G == 256 && l == 0 && bx >= 128) deferred_items(1, (bx - 128) * Q_MOE2, Q_MOE2, ARG_IN(25), ARG_IN(27), ws, lds, wave, lane);
            }
            __syncthreads();
        }
      }
    }
}
constexpr int PROBE_DUP_PH = -1, PROBE_DUP_N = 0, PROBE_DUP_SUB = 15, PROBE_KNOB = 0;
constexpr int PROBE_NPASS = 1, PROBE_SKIP = 0;
extern "C" void kernel_launch(void* const* d_in, const int* in_sizes, int n_in, void* d_out, int out_size, void* d_ws, size_t ws_size, hipStream_t stream) {
    static int grid = 0;
    if (grid == 0) {
        if (n_in != 30 || out_size != NB_ * SEQ * D || (size_t)L::END > ws_size) { fprintf(stderr, "kernel_launch: unexpected problem shape (n_in %d, out %d) or workspace too small (need %zu, have %zu); nothing launched\n", n_in, out_size, (size_t)L::END, ws_size); grid = -1; return; }
        int dev = 0, cus = 0;
        if (hipGetDevice(&dev) != hipSuccess || hipDeviceGetAttribute(&cus, hipDeviceAttributeMultiprocessorCount, dev) != hipSuccess) { fprintf(stderr, "kernel_launch: device query failed\n"); grid = -1; return; }
        if (hipFuncSetAttribute((const void*)mega, hipFuncAttributeMaxDynamicSharedMemorySize, LDS_BYTES) != hipSuccess) { fprintf(stderr, "kernel_launch: hipFuncSetAttribute failed\n"); grid = -1; return; }
        grid = cus < 256 ? cus : 256;
    }
    if (grid < 0) return;
    unsigned char* p = (unsigned char*)d_ws;
    (void)hipMemsetAsync(p + L::CTL, 0, L::CTL_BYTES, stream);
    MArgs a{};
    for (int i = 0; i < 30; ++i) a.in[i] = (const float*)d_in[i];
    a.out = (float*)d_out; a.ws = p; a.npass = PROBE_NPASS; a.skip_mask = PROBE_SKIP; a.dup_ph = PROBE_DUP_PH; a.dup_n = PROBE_DUP_N; a.dup_sub = PROBE_DUP_SUB; a.knob = PROBE_KNOB;
    hipLaunchKernelGGL(mega, dim3(grid), dim3(NWAVES * 64), LDS_BYTES, stream, a);
}
```

```cpp
#include <hip/hip_runtime.h>
#include <cstdint>
#include <cstdio>

typedef unsigned short bf16_t;
constexpr int NB_ = 4, SEQ = 4096, CTX = 256, D = 1024, NPOS = SEQ + CTX, MROWS = NB_ * NPOS;
constexpr int PT = 1952, PP = 2048;
constexpr int NE = 32, TOPK = 4, LCAP = MROWS;
constexpr int NASG = MROWS * TOPK;
constexpr int ACT_ROWS = NASG + NE * 256;
constexpr int C_FN = 0, C_LX = 256, C_LG = 512, C_CQ = 768, C_CKV = 1024, C_KR = 1152, C_SX = 1184, C_SB = 1440, C_SC = 1696;

__device__ __forceinline__ float bf2f(bf16_t v) { return __uint_as_float((unsigned)v << 16); }
__device__ __forceinline__ bf16_t f2bf(float f) { unsigned u = __float_as_uint(f); return (bf16_t)((u + 0x7fffu + ((u >> 16) & 1u)) >> 16); }
__device__ __forceinline__ float wave_sum(float v) {
#pragma unroll
    for (int o = 1; o < 64; o <<= 1) v += __shfl_xor(v, o);
    return v;
}
__device__ __forceinline__ float sigmoidf_(float x) { return 1.f / (1.f + __expf(-x)); }
__device__ __forceinline__ float gelu_tanh(float x) { const float u = 0.7978845608028654f * (x + 0.044715f * x * x * x); return 0.5f * x * (1.f + tanhf(u)); }

#define LAS __attribute__((address_space(3)))
typedef short bf16x8 __attribute__((ext_vector_type(8)));
typedef float f32x4 __attribute__((ext_vector_type(4)));
typedef unsigned u32x4 __attribute__((ext_vector_type(4)));
typedef unsigned u32x2 __attribute__((ext_vector_type(2)));
__device__ __forceinline__ unsigned pk2(float lo, float hi) { return (unsigned)f2bf(lo) | ((unsigned)f2bf(hi) << 16); }

namespace L {
constexpr size_t A256(size_t x) { return (x + 255) & ~(size_t)255; }
constexpr size_t CTL = 0, CTL_BYTES = 1u << 20;
constexpr size_t H = CTL + CTL_BYTES;
constexpr size_t MOD = CTL + 512 * 1024;
constexpr size_t TABC = A256(H + (size_t)MROWS * D * 4);
constexpr size_t TABS = A256(TABC + 4096 * 4);
constexpr size_t XN = A256(TABS + 4096 * 4);
constexpr size_t P = A256(XN + (size_t)MROWS * D * 2);
constexpr size_t MIX = A256(P + (size_t)MROWS * PP * 2);
constexpr size_t CQN = A256(MIX + (size_t)MROWS * D * 2);
constexpr size_t CKVN = A256(CQN + (size_t)MROWS * 256 * 2);
constexpr size_t QRAW = A256(CKVN + (size_t)MROWS * 128 * 2);
constexpr size_t KVRAW = A256(QRAW + (size_t)MROWS * 384 * 4);
constexpr size_t QL = A256(KVRAW + (size_t)MROWS * 512 * 4);
constexpr size_t QC = A256(QL + (size_t)16 * SEQ * 96 * 2);
constexpr size_t KB = A256(QC + (size_t)16 * CTX * 96 * 2);
constexpr size_t VB = A256(KB + (size_t)16 * NPOS * 96 * 2);
constexpr size_t LA = A256(VB + (size_t)16 * NPOS * 64 * 2);
constexpr size_t LB = A256(LA + (size_t)2 * MROWS * 256 * 4);
constexpr size_t HS = A256(LB + (size_t)2 * MROWS * 256 * 4);
constexpr size_t XCS = A256(HS + (size_t)2 * MROWS * 256 * 4);
constexpr size_t XCSC = A256(XCS + (size_t)4 * 8192 * 256 * 4);
constexpr size_t LIST = A256(XCSC + (size_t)4 * 512 * 256 * 4);
constexpr size_t GATE = A256(LIST + (size_t)2 * NE * LCAP * 4);
constexpr size_t ACT = A256(GATE + (size_t)NASG * 4);
constexpr size_t Y = A256(ACT + (size_t)ACT_ROWS * D * 2);
constexpr size_t WINT = A256(Y + (size_t)(NASG + 1) * D * 2);
constexpr size_t WOUTT = A256(WINT + (size_t)2 * 2048 * 1024 * 2);
constexpr size_t WGUT = A256(WOUTT + (size_t)2 * 1024 * 1024 * 2);
constexpr size_t WDT = A256(WGUT + (size_t)2 * NE * 2048 * 1024 * 2);
constexpr size_t ZBUF = A256(WDT + (size_t)2 * NE * 1024 * 1024 * 2);
constexpr size_t VTG = A256(ZBUF + (size_t)4 * 64 * 64 * 512 * 2);
constexpr size_t WUQT = A256(VTG + (size_t)16 * 64 * NPOS * 2);
constexpr size_t WUKVT = A256(WUQT + (size_t)2 * 384 * 256 * 2);
constexpr size_t WAT = A256(WUKVT + (size_t)2 * 512 * 128 * 2);
constexpr size_t WIT = A256(WAT + (size_t)16 * 4096 * 2);
constexpr size_t SPT = A256(WIT + (size_t)16 * 4096 * 2);
constexpr size_t RWH = A256(SPT + (size_t)1024 * 4);
constexpr size_t RWL = A256(RWH + (size_t)2 * NE * D * 2);
constexpr size_t HL = A256(RWL + (size_t)2 * NE * D * 2);
constexpr size_t AC = A256(HL + (size_t)2 * MROWS * 256 * 2);
constexpr size_t SUM = A256(AC + (size_t)2 * MROWS * 256 * 2);
constexpr size_t XCT = A256(SUM + (size_t)2 * 4 * 68 * 512 * 4);
constexpr size_t END = A256(XCT + (size_t)16 * 512 * 64 * 2);
constexpr int CW_BAR = 4096;
constexpr int CW_MODCNT = 2048;
constexpr int CW_CNT = 32768, CNT_STRIDE = 64;
}

#define XB_TMO      128
#define XB_XCNT(j)  (256  + 64 * (j))
#define XB_XSUB(j)  (1280 + 64 * (j))
#define XB_XGEN(j)  (2304 + 64 * (j))
#define XB_TOP      3328
#define XB_TOPGEN   3392
#define XCD_BAR_WORDS 3456
#define XB_SPIN_CAP (1u << 18)
__device__ __forceinline__ unsigned xb_ld(unsigned* p)              { return __hip_atomic_load(p, __ATOMIC_RELAXED, __HIP_MEMORY_SCOPE_AGENT); }
__device__ __forceinline__ unsigned xb_add(unsigned* p, unsigned v) { return __hip_atomic_fetch_add(p, v, __ATOMIC_RELAXED, __HIP_MEMORY_SCOPE_AGENT); }
__device__ __forceinline__ unsigned xb_xcc_id() { return (unsigned)__builtin_amdgcn_s_getreg((3 << 11) | 20) & 0xFu; }
#define XB_SPIN(cond, bar) do { unsigned _sp = 0; while (cond) { __builtin_amdgcn_s_sleep(1); \
    if ((++_sp & 255u) == 0u) { if (xb_ld(&(bar)[XB_TMO])) break; if (_sp > XB_SPIN_CAP) { atomicAdd(&(bar)[XB_TMO], 1u); break; } } } } while (0)
struct XcdBarrier { unsigned* bar; unsigned x; volatile LAS unsigned* st; };
__device__ __forceinline__ XcdBarrier xcd_barrier_post(unsigned* bar, volatile LAS unsigned* st) {
    XcdBarrier b; b.bar = bar; b.x = xb_xcc_id(); b.st = st;
    if (threadIdx.x == 0) (void)xb_add(&bar[XB_XCNT(b.x)], 1u);
    return b;
}
__device__ __forceinline__ void xcd_barrier_complete(unsigned* bar, unsigned x, unsigned& nloc, unsigned& nx) {
    const unsigned G = gridDim.x * gridDim.y * gridDim.z;
    unsigned sum, cnt, mine, sp = 0u;
    for (;;) {
        sum = 0u; cnt = 0u; mine = 0u;
#pragma unroll
        for (unsigned j = 0; j < 16; ++j) { const unsigned c = xb_ld(&bar[XB_XCNT(j)]); sum += c; cnt += (c > 0u) ? 1u : 0u; mine = (j == x) ? c : mine; }
        if (sum == G) break;
        __builtin_amdgcn_s_sleep(1);
        if ((++sp & 255u) == 0u) { if (xb_ld(&bar[XB_TMO])) break; if (sp > XB_SPIN_CAP) { atomicAdd(&bar[XB_TMO], 1u); break; } }
    }
    nloc = mine > 0u ? mine : 1u; nx = cnt > 0u ? cnt : 1u;
}
__device__ __forceinline__ void xcd_barrier(const XcdBarrier& b) {
    asm volatile("s_waitcnt vmcnt(0)" ::: "memory");
    __syncthreads();
    if (threadIdx.x == 0) {
        unsigned* bar = b.bar;
        __builtin_amdgcn_s_waitcnt(0);
        unsigned nloc = b.st[0], nx = b.st[1];
        if (nloc == 0u) { xcd_barrier_complete(bar, b.x, nloc, nx); b.st[0] = nloc; b.st[1] = nx; }
        const unsigned old = xb_add(&bar[XB_XSUB(b.x)], 1u);
        const unsigned gen = old / nloc;
        if (old + 1u == (gen + 1u) * nloc) {
            __builtin_amdgcn_fence(__ATOMIC_RELEASE, "agent");
            asm volatile("s_waitcnt vmcnt(0)" ::: "memory");
            const unsigned og = xb_add(&bar[XB_TOP], 1u);
            const unsigned tg = og / nx;
            if (og + 1u == (tg + 1u) * nx) xb_add(&bar[XB_TOPGEN], 1u);
            else XB_SPIN(xb_ld(&bar[XB_TOPGEN]) == tg, bar);
            __builtin_amdgcn_fence(__ATOMIC_ACQUIRE, "agent");
            xb_add(&bar[XB_XGEN(b.x)], 1u);
            asm volatile("s_waitcnt vmcnt(0)" ::: "memory");
        } else {
            XB_SPIN(xb_ld(&bar[XB_XGEN(b.x)]) == gen, bar);
            __builtin_amdgcn_fence(__ATOMIC_ACQUIRE, "agent");
            asm volatile("s_waitcnt vmcnt(0)" ::: "memory");
        }
    }
    __syncthreads();
}

namespace g8 {
constexpr int BM = 256, BK = 64, HALF = 128, HTB = HALF * BK * 2, STAGE_BYTES = 8 * HTB, NXCD = 8, WGM = 8;
__device__ __forceinline__ int lds_byte(int r, int c) { const int st = (r >> 4) * 2 + (c >> 5), rr = r & 15, cc = c & 31, ob = rr * 64 + cc * 2; return st * 1024 + (ob ^ (((ob >> 9) & 1) << 5)); }
__device__ __forceinline__ void stage_rc(int b, int& R, int& C) { const int st = b / 1024, sb = b % 1024, swz = sb ^ (((sb >> 9) & 1) << 5); R = (st >> 1) * 16 + swz / 64; C = (st & 1) * 32 + (swz % 64) / 2; }
__device__ __forceinline__ int perm32(int rho) { const int n = rho >> 4, i = rho & 15; return 8 * (i >> 2) + 4 * n + (i & 3); }
__device__ __forceinline__ unsigned cvt_pk_bf16(float lo, float hi) { unsigned r; asm volatile("v_cvt_pk_bf16_f32 %0, %1, %2" : "=v"(r) : "v"(lo), "v"(hi)); return r; }
__device__ __forceinline__ int xcd_remap(int wgid, int nwg) { const int q = nwg / NXCD, r = nwg % NXCD, xcd = wgid % NXCD, off = wgid / NXCD; return (xcd < r ? xcd * (q + 1) : r * (q + 1) + (xcd - r) * q) + off; }

struct Unit { int row0, col0, ex, bt, nvalid, lrow; };

struct DenseSched {
    int nM, nN, nwg, G, c, lat_only; const char* Bt; int K; const int* list;
    __device__ __forceinline__ void init(int nM_, int nN_, int G_, int c_, int lat_only_, const void* Bt_, int K_) { nM = nM_; nN = nN_; nwg = nM * nN; G = G_; c = c_; lat_only = lat_only_; Bt = (const char*)Bt_; K = K_; list = nullptr; }
    __device__ __forceinline__ bool next(int i, Unit& u) const {
        const long Lx = (long)i * G + c; if (Lx >= nwg) return false;
        const int wgid = xcd_remap((int)Lx, nwg);
        const int nig = WGM * nN, gid = wgid / nig, fm = gid * WGM, gsz = (nM - fm) < WGM ? (nM - fm) : WGM;
        const int pm = fm + ((wgid % nig) % gsz), pn = (wgid % nig) / gsz;
        const int tile = lat_only ? (pm / 16) * 17 + 1 + (pm % 16) : pm;
        u.row0 = tile * 256; u.col0 = pn * 256; u.ex = 0; u.bt = pn; u.nvalid = 256; u.lrow = 0; return true;
    }
    __device__ __forceinline__ const char* bptr(const Unit& u) const { return Bt + (size_t)u.bt * (256 * 1024 * 2); }
};
struct MoeSched {
    const LAS int* tpre; const LAS int* cnt; int NT, COLW, G, c, total; const char* Bt; int K; const int* list;
    __device__ __forceinline__ bool next(int i, Unit& u) const {
        const long Lx = (long)i * G + c; if (Lx >= total) return false;
        const int wgid = xcd_remap((int)Lx, total);
        int e = 0;
        for (int j = 1; j < NE; ++j) if (tpre[j] * NT <= wgid) e = j;
        const int t0 = tpre[e], mte = tpre[e + 1] - t0, loc = wgid - t0 * NT, nt = loc / mte, mt = loc % mte;
        u.ex = __builtin_amdgcn_readfirstlane(e); u.row0 = __builtin_amdgcn_readfirstlane((t0 + mt) * 256); u.col0 = __builtin_amdgcn_readfirstlane(nt * COLW);
        u.bt = __builtin_amdgcn_readfirstlane(e * NT + nt); const int nv = cnt[e] - mt * 256; u.nvalid = __builtin_amdgcn_readfirstlane(nv < 256 ? nv : 256); u.lrow = __builtin_amdgcn_readfirstlane(mt * 256);
        return true;
    }
    __device__ __forceinline__ const char* bptr(const Unit& u) const { return Bt + (size_t)u.bt * (256 * 1024 * 2); }
};

struct EpiP {
    static constexpr bool PERM = true; bf16_t* O;
    __device__ __forceinline__ void operator()(const f32x4 (&acc)[2][2][4][2], const Unit& u, int wr, int wc, int fr, int fq, const LAS int*) const {
#pragma unroll
        for (int ai = 0; ai < 2; ++ai)
#pragma unroll
            for (int m = 0; m < 4; ++m) { bf16_t* rowp = O + (size_t)(u.row0 + ai * HALF + wr * 64 + m * 16 + fr) * PP + u.col0 + wc * 32 + 8 * fq;
#pragma unroll
                for (int bj = 0; bj < 2; ++bj) { const f32x4 v0 = acc[ai][bj][m][0], v1 = acc[ai][bj][m][1]; u32x4 w; w.x = cvt_pk_bf16(v0[0], v0[1]); w.y = cvt_pk_bf16(v0[2], v0[3]); w.z = cvt_pk_bf16(v1[0], v1[1]); w.w = cvt_pk_bf16(v1[2], v1[3]);
                    *(u32x4*)(rowp + bj * HALF) = w; } }
    }
};
struct EpiH {
    static constexpr bool PERM = false; float* Hh; const float* MODl; int g_off;
    __device__ __forceinline__ void operator()(const f32x4 (&acc)[2][2][4][2], const Unit& u, int wr, int wc, int fr, int fq, const LAS int*) const {
        const int tile = u.row0 >> 8, v = (tile % 17 == 0) ? 4 : tile / 17; const float* gp = MODl + (size_t)v * 6144 + g_off + u.col0 + wc * 32 + 4 * fq;
        f32x4 gv[2][2];
#pragma unroll
        for (int bj = 0; bj < 2; ++bj)
#pragma unroll
            for (int n = 0; n < 2; ++n) gv[bj][n] = *(const f32x4*)(gp + bj * HALF + n * 16);
#pragma unroll
        for (int ai = 0; ai < 2; ++ai)
#pragma unroll
          for (int mp = 0; mp < 2; ++mp) {
            f32x4 hv[2][2][2];
#pragma unroll
            for (int m2 = 0; m2 < 2; ++m2) { const float* rowp = Hh + (size_t)(u.row0 + ai * HALF + wr * 64 + (2 * mp + m2) * 16 + fr) * D + u.col0 + wc * 32 + 4 * fq;
#pragma unroll
                for (int bj = 0; bj < 2; ++bj)
#pragma unroll
                    for (int n = 0; n < 2; ++n) hv[m2][bj][n] = *(const f32x4*)(rowp + bj * HALF + n * 16); }
#pragma unroll
            for (int m2 = 0; m2 < 2; ++m2) { float* rowp = Hh + (size_t)(u.row0 + ai * HALF + wr * 64 + (2 * mp + m2) * 16 + fr) * D + u.col0 + wc * 32 + 4 * fq;
#pragma unroll
                for (int bj = 0; bj < 2; ++bj)
#pragma unroll
                    for (int n = 0; n < 2; ++n) *(f32x4*)(rowp + bj * HALF + n * 16) = hv[m2][bj][n] + gv[bj][n] * acc[ai][bj][2 * mp + m2][n]; }
          }
    }
};
struct EpiMoe1 {
    static constexpr bool PERM = true; bf16_t* ACTp; const float* bgu;
    __device__ __forceinline__ void operator()(const f32x4 (&acc)[2][2][4][2], const Unit& u, int wr, int wc, int fr, int fq, const LAS int*) const {
        const int cc = u.col0 + wc * 32 + 8 * fq; const float* bp = bgu + (size_t)u.ex * 2048 + cc;
        f32x4 bg[2], bu[2];
#pragma unroll
        for (int n = 0; n < 2; ++n) { bg[n] = *(const f32x4*)(bp + 4 * n); bu[n] = *(const f32x4*)(bp + 1024 + 4 * n); }
#pragma unroll
        for (int ai = 0; ai < 2; ++ai)
#pragma unroll
            for (int m = 0; m < 4; ++m) { const int r = ai * HALF + wr * 64 + m * 16 + fr;
                float o[8];
#pragma unroll
                for (int n = 0; n < 2; ++n)
#pragma unroll
                    for (int i = 0; i < 4; ++i) { const float g = fminf(acc[ai][0][m][n][i] + bg[n][i], 7.f); const float uu = fminf(fmaxf(acc[ai][1][m][n][i] + bu[n][i], -7.f), 7.f);
                        o[n * 4 + i] = (uu + 1.f) * g * __builtin_amdgcn_rcpf(1.f + __expf(-1.702f * g)); }
                { u32x4 w; w.x = cvt_pk_bf16(o[0], o[1]); w.y = cvt_pk_bf16(o[2], o[3]); w.z = cvt_pk_bf16(o[4], o[5]); w.w = cvt_pk_bf16(o[6], o[7]);
                    *(u32x4*)(ACTp + (size_t)(u.row0 + r) * D + cc) = w; } }
    }
};
struct EpiMoe2 {
    static constexpr bool PERM = true; bf16_t* Yp; const float* bd; const float* GATEp;
    __device__ __forceinline__ void operator()(const f32x4 (&acc)[2][2][4][2], const Unit& u, int wr, int wc, int fr, int fq, const LAS int* rows) const {
        const int cc = u.col0 + wc * 32 + 8 * fq; const float* bp = bd + (size_t)u.ex * 1024 + cc;
        f32x4 bv[2][2];
#pragma unroll
        for (int bj = 0; bj < 2; ++bj)
#pragma unroll
            for (int n = 0; n < 2; ++n) bv[bj][n] = *(const f32x4*)(bp + bj * HALF + 4 * n);
        int asgv[2][4]; float gtv[2][4];
#pragma unroll
        for (int ai = 0; ai < 2; ++ai)
#pragma unroll
            for (int m = 0; m < 4; ++m) { const int r = ai * HALF + wr * 64 + m * 16 + fr; const bool ok = r < u.nvalid; const int a = rows[ok ? r : 0]; asgv[ai][m] = ok ? a : NASG; gtv[ai][m] = GATEp[a]; }
#pragma unroll
        for (int ai = 0; ai < 2; ++ai)
#pragma unroll
            for (int m = 0; m < 4; ++m) { const float gt = gtv[ai][m]; bf16_t* rowp = Yp + (size_t)asgv[ai][m] * D + cc;
#pragma unroll
                for (int bj = 0; bj < 2; ++bj) { const f32x4 v0 = (acc[ai][bj][m][0] + bv[bj][0]) * gt, v1 = (acc[ai][bj][m][1] + bv[bj][1]) * gt;
                    u32x4 w; w.x = cvt_pk_bf16(v0[0], v0[1]); w.y = cvt_pk_bf16(v0[2], v0[3]); w.z = cvt_pk_bf16(v1[0], v1[1]); w.w = cvt_pk_bf16(v1[2], v1[3]); *(u32x4*)(rowp + bj * HALF) = w; } }
    }
};

template <class Epi, class Sched, bool GATHER, bool ROWLIST>
__device__ __forceinline__ void gemm_phase(LAS unsigned char* lds, const char* Abase, const Sched& S, const Epi& E) {
    constexpr int K = 1024;
    int tid_l = threadIdx.x; asm volatile("" : "+v"(tid_l));
    const int tid = tid_l, wid = __builtin_amdgcn_readfirstlane(tid >> 6), lane = tid & 63, wr = wid >> 2, wc = wid & 3, fr = lane & 15, fq = lane >> 4;
    constexpr int nt = K / BK; constexpr unsigned Kb = (unsigned)K * 2u;
    unsigned voffB[2];
#pragma unroll
    for (int i = 0; i < 2; ++i) { int R, C; stage_rc(tid * 16 + i * 8192, R, C); const int Rb = Epi::PERM ? ((R & ~31) + perm32(R & 31)) : R; voffB[i] = (unsigned)(Rb * K + C) * 2u; }
    constexpr size_t kstep = (size_t)(BK * 2), hstep = (size_t)HALF * K * 2;
    const unsigned ldsw = (unsigned)wid * 1024u;
    const int aoff = lds_byte(wr * 64 + fr, fq * 8), boff = lds_byte(wc * 32 + fr, fq * 8);
    LAS int* rowbuf = (LAS int*)(lds + STAGE_BYTES);
#define G8_SA(b, h) (((b) * 2 + (h)) * HTB)
#define G8_SB(b, h) ((4 + (b) * 2 + (h)) * HTB)
#define G8_STAGE_A(bufoff, kb, v) do { _Pragma("unroll") for (int _i = 0; _i < 2; ++_i) \
        __builtin_amdgcn_global_load_lds((const unsigned*)((kb) + (size_t)(v)[_i]), (LAS unsigned*)(lds + (bufoff) + ldsw + _i * 8192), 16, 0, 0); } while (0)
#define G8_STAGE_B(bufoff, gbase) do { _Pragma("unroll") for (int _i = 0; _i < 2; ++_i) \
        __builtin_amdgcn_global_load_lds((const unsigned*)((gbase) + voffB[_i]), (LAS unsigned*)(lds + (bufoff) + ldsw + _i * 8192), 16, 0, 0); } while (0)
#define G8_LDA(dst, b, h) do { _Pragma("unroll") for (int m = 0; m < 4; ++m) _Pragma("unroll") for (int k = 0; k < 2; ++k) dst[m][k] = *(const LAS bf16x8*)(lds + G8_SA(b, h) + aoff + m * 2048 + k * 1024); } while (0)
#define G8_LDB(dst, b, h) do { _Pragma("unroll") for (int n = 0; n < 2; ++n) _Pragma("unroll") for (int k = 0; k < 2; ++k) dst[n][k] = *(const LAS bf16x8*)(lds + G8_SB(b, h) + boff + n * 2048 + k * 1024); } while (0)
#define G8_MMA(ai, bj, At, Bt) do { __builtin_amdgcn_s_setprio(1); _Pragma("unroll") for (int m = 0; m < 4; ++m) _Pragma("unroll") for (int n = 0; n < 2; ++n) _Pragma("unroll") for (int k = 0; k < 2; ++k) \
        acc[ai][bj][m][n] = __builtin_amdgcn_mfma_f32_16x16x32_bf16(Bt[n][k], At[m][k], acc[ai][bj][m][n], 0, 0, 0); __builtin_amdgcn_s_setprio(0); } while (0)
#define G8_WAIT_V(n) asm volatile("s_waitcnt vmcnt(" #n ")" ::: "memory")
#define G8_WAIT_L(n) asm volatile("s_waitcnt lgkmcnt(" #n ")" ::: "memory")
#define G8_BAR __builtin_amdgcn_s_barrier()
#define G8_SCHED __builtin_amdgcn_sched_barrier(0)
#define G8_LISTDMA(u, s) do { if (wid < 4) __builtin_amdgcn_global_load_lds((const unsigned*)(S.list + (size_t)(u).ex * LCAP + (u).lrow + wid * 64 + lane), (LAS unsigned*)(rowbuf + (s) * 256 + wid * 64), 4, 0, 0); } while (0)
#define G8_ROWS_DENSE(v) do { _Pragma("unroll") for (int _i = 0; _i < 2; ++_i) { int _R, _C; stage_rc(tid * 16 + _i * 8192, _R, _C); _Pragma("unroll") for (int _h = 0; _h < 2; ++_h) (v)[_h][_i] = (unsigned)(_h * HALF + _R) * Kb + (unsigned)_C * 2u; } } while (0)
#define G8_ROWS_LIST(v, u, s) do { _Pragma("unroll") for (int _i = 0; _i < 2; ++_i) { int _R, _C; stage_rc(tid * 16 + _i * 8192, _R, _C); _Pragma("unroll") for (int _h = 0; _h < 2; ++_h) { const int _r = _h * HALF + _R; const int _a = rowbuf[(s) * 256 + _r]; \
        (v)[_h][_i] = (unsigned)(_r < (u).nvalid ? (_a >> 2) : 0) * Kb + (unsigned)_C * 2u; } } } while (0)
    Unit cur, nxt; int ui = 0, slot = 0;
    if (!S.next(0, cur)) return;
    unsigned vA[2][2];
    if constexpr (ROWLIST) { G8_LISTDMA(cur, 0); G8_WAIT_V(0); G8_BAR; }
    if constexpr (GATHER) { G8_ROWS_LIST(vA, cur, 0); } else { G8_ROWS_DENSE(vA); }
    f32x4 acc[2][2][4][2];
#pragma unroll
    for (int a = 0; a < 2; ++a)
#pragma unroll
        for (int b = 0; b < 2; ++b)
#pragma unroll
            for (int m = 0; m < 4; ++m)
#pragma unroll
                for (int n = 0; n < 2; ++n) acc[a][b][m][n] = (f32x4){0.f, 0.f, 0.f, 0.f};
    bf16x8 At[4][2], B0[2][2], B1[2][2];
    const char* cB = S.bptr(cur);
    const char* cA = GATHER ? Abase : Abase + (size_t)cur.row0 * Kb;
    G8_STAGE_B(G8_SB(0, 0), cB); G8_STAGE_B(G8_SB(0, 1), cB + hstep); G8_STAGE_A(G8_SA(0, 0), cA, vA[0]); G8_STAGE_A(G8_SA(0, 1), cA, vA[1]);
    if (wr == 1) G8_BAR;
    G8_WAIT_V(2); G8_BAR;
    G8_STAGE_B(G8_SB(1, 0), cB + kstep); G8_STAGE_A(G8_SA(1, 0), cA + kstep, vA[0]); G8_STAGE_B(G8_SB(1, 1), cB + hstep + kstep);
    G8_WAIT_V(6); G8_BAR;
    for (;;) {
        const bool has_next = S.next(ui + 1, nxt);
        const char* nB = has_next ? S.bptr(nxt) : cB;
        const char* nA = (GATHER || !has_next) ? cA : Abase + (size_t)nxt.row0 * Kb;
        const int nslot = slot == 2 ? 0 : slot + 1;
        if constexpr (ROWLIST) { if (has_next) G8_LISTDMA(nxt, nslot); }
        for (int t = 0; t < nt; t += 2) {
            const bool last = (t == nt - 2);
            const char* a1 = cA + (size_t)(t + 1) * kstep;
            const char* a2 = last ? nA : cA + (size_t)(t + 2) * kstep; const char* b2 = last ? nB : cB + (size_t)(t + 2) * kstep;
            const char* a3 = a2 + kstep; const char* b3 = b2 + kstep;
            G8_LDB(B0, 0, 0); G8_LDB(B1, 0, 1); G8_SCHED; G8_LDA(At, 0, 0); G8_STAGE_A(G8_SA(1, 1), a1, vA[1]);
            if constexpr (GATHER) { if (last && has_next) { G8_ROWS_LIST(vA, nxt, nslot); } }
            G8_WAIT_V(8); G8_WAIT_L(0); G8_BAR; G8_MMA(0, 0, At, B0); G8_MMA(0, 1, At, B1); G8_BAR; G8_SCHED;
            G8_LDA(At, 0, 1); G8_STAGE_B(G8_SB(0, 0), b2); G8_STAGE_B(G8_SB(0, 1), b2 + hstep); G8_STAGE_A(G8_SA(0, 0), a2, vA[0]);
            G8_WAIT_V(8); G8_WAIT_L(0); G8_BAR; G8_MMA(1, 0, At, B0); G8_MMA(1, 1, At, B1); G8_BAR; G8_SCHED;
            G8_LDB(B0, 1, 0); G8_LDB(B1, 1, 1); G8_SCHED; G8_LDA(At, 1, 0); G8_STAGE_A(G8_SA(0, 1), a2, vA[1]);
            G8_WAIT_V(8); G8_WAIT_L(0); G8_BAR; G8_MMA(0, 0, At, B0); G8_MMA(0, 1, At, B1); G8_BAR; G8_SCHED;
            G8_LDA(At, 1, 1); G8_STAGE_B(G8_SB(1, 0), b3); G8_STAGE_B(G8_SB(1, 1), b3 + hstep); G8_STAGE_A(G8_SA(1, 0), a3, vA[0]);
            G8_WAIT_V(8); G8_WAIT_L(0); G8_BAR; G8_MMA(1, 0, At, B0); G8_MMA(1, 1, At, B1); G8_BAR; G8_SCHED;
        }
        if (wr == 0) G8_BAR;
        { int t2 = threadIdx.x; asm volatile("" : "+v"(t2));
          const int w2 = __builtin_amdgcn_readfirstlane(t2 >> 6); E(acc, cur, w2 >> 2, w2 & 3, t2 & 15, (t2 & 63) >> 4, rowbuf + slot * 256); }
        if (!has_next) break;
#pragma unroll
        for (int a = 0; a < 2; ++a)
#pragma unroll
            for (int b = 0; b < 2; ++b)
#pragma unroll
                for (int m = 0; m < 4; ++m)
#pragma unroll
                    for (int n = 0; n < 2; ++n) acc[a][b][m][n] = (f32x4){0.f, 0.f, 0.f, 0.f};
        cur = nxt; cB = nB; cA = nA; ++ui; slot = nslot;
        if (wr == 1) G8_BAR;
    }
    G8_WAIT_V(0);
    G8_BAR;
#undef G8_SA
#undef G8_SB
#undef G8_STAGE_A
#undef G8_STAGE_B
#undef G8_LDA
#undef G8_LDB
#undef G8_MMA
#undef G8_WAIT_V
#undef G8_WAIT_L
#undef G8_BAR
#undef G8_SCHED
#undef G8_LISTDMA
#undef G8_ROWS_DENSE
#undef G8_ROWS_LIST
}
}

namespace fft {
constexpr int TP = 72;
constexpr int UP = 264;
constexpr int ZP = 520;
constexpr int O_TC = 0, O_TS = 9216, O_U = 18432, O_X = 52224, O_TW = 125952;
__device__ __forceinline__ bf16x8 neg8(bf16x8 v) { u32x4 w = __builtin_bit_cast(u32x4, v); w = w ^ 0x80008000u; return __builtin_bit_cast(bf16x8, w); }
__device__ __forceinline__ void build_tables(LAS unsigned char* lds, const float* TABC, const float* TABS, int tid) {
    for (int i = tid; i < 4096; i += 512) { const int a = i >> 6, b = i & 63, ix = ((a * b) & 63) * 64;
        ((LAS bf16_t*)(lds + O_TC))[a * TP + b] = f2bf(TABC[ix]); ((LAS bf16_t*)(lds + O_TS))[a * TP + b] = f2bf(TABS[ix]); }
}
__device__ __forceinline__ void stage_a(LAS unsigned char* lds, const bf16_t* P, const float* TABC, const float* TABS, bf16_t* ZBUF, int u0, int u1, int ustep) {
    int tid_l = threadIdx.x; asm volatile("" : "+v"(tid_l));
    const int tid = tid_l, lane = tid & 63, w = __builtin_amdgcn_readfirstlane(tid >> 6), fr = lane & 15, fq = lane >> 4;
    build_tables(lds, TABC, TABS, tid);
    const LAS bf16_t* Tc = (const LAS bf16_t*)(lds + O_TC); const LAS bf16_t* Ts = (const LAS bf16_t*)(lds + O_TS);
    LAS bf16_t* U = (LAS bf16_t*)(lds + O_U); LAS bf16_t* X = (LAS bf16_t*)(lds + O_X); LAS float* TW = (LAS float*)(lds + O_TW);
    for (int unit = u0; unit < u1; unit += ustep) {
        const int b = unit >> 6, t2 = unit & 63;
#pragma unroll
        for (int i = 0; i < 4; ++i) { const int q = tid + 512 * i, t1 = q >> 5, ch = q & 31;
            *(LAS u32x4*)((LAS unsigned char*)U + t1 * (UP * 2) + ch * 16) = *(const u32x4*)(P + ((size_t)b * NPOS + CTX + 64 * t1 + t2) * PP + ch * 8); }
        if (tid < 64) { const int ix = tid * t2; TW[2 * tid] = TABC[ix]; TW[2 * tid + 1] = TABS[ix]; }
        __syncthreads();
        { const int g = w >> 1, part = w & 1; const LAS bf16_t* T = part ? Ts : Tc;
          f32x4 acc[4][4];
#pragma unroll
          for (int mt = 0; mt < 4; ++mt)
#pragma unroll
              for (int nt = 0; nt < 4; ++nt) acc[mt][nt] = (f32x4){0.f, 0.f, 0.f, 0.f};
#pragma unroll
          for (int ks = 0; ks < 2; ++ks) { bf16x8 a[4], bb[4];
#pragma unroll
              for (int mt = 0; mt < 4; ++mt) a[mt] = *(const LAS bf16x8*)(U + (16 * mt + fr) * UP + g * 64 + 32 * ks + 8 * fq);
#pragma unroll
              for (int nt = 0; nt < 4; ++nt) bb[nt] = *(const LAS bf16x8*)(T + (16 * nt + fr) * TP + 32 * ks + 8 * fq);
#pragma unroll
              for (int mt = 0; mt < 4; ++mt)
#pragma unroll
                  for (int nt = 0; nt < 4; ++nt) acc[mt][nt] = __builtin_amdgcn_mfma_f32_16x16x32_bf16(a[mt], bb[nt], acc[mt][nt], 0, 0, 0); }
          const float sg = part ? -1.f : 1.f;
#pragma unroll
          for (int mt = 0; mt < 4; ++mt)
#pragma unroll
              for (int nt = 0; nt < 4; ++nt) { const f32x4 v = acc[mt][nt] * sg; u32x2 o; o.x = pk2(v[0], v[1]); o.y = pk2(v[2], v[3]);
                  *(LAS u32x2*)(X + (part * 256 + g * 64 + 16 * nt + fr) * TP + 16 * mt + 4 * fq) = o; } }
        __syncthreads();
        f32x4 zr[4][2], zi[4][2];
#pragma unroll
        for (int mt = 0; mt < 4; ++mt)
#pragma unroll
            for (int n = 0; n < 2; ++n) { zr[mt][n] = (f32x4){0.f, 0.f, 0.f, 0.f}; zi[mt][n] = (f32x4){0.f, 0.f, 0.f, 0.f}; }
#pragma unroll
        for (int ks = 0; ks < 2; ++ks) { bf16x8 xr[2], xi[2];
#pragma unroll
            for (int n = 0; n < 2; ++n) { xr[n] = *(const LAS bf16x8*)(X + (32 * w + 16 * n + fr) * TP + 32 * ks + 8 * fq); xi[n] = *(const LAS bf16x8*)(X + (256 + 32 * w + 16 * n + fr) * TP + 32 * ks + 8 * fq); }
#pragma unroll
            for (int mt = 0; mt < 4; ++mt) { const bf16x8 c = *(const LAS bf16x8*)(Tc + (16 * mt + fr) * TP + 32 * ks + 8 * fq), s = *(const LAS bf16x8*)(Ts + (16 * mt + fr) * TP + 32 * ks + 8 * fq), ns = neg8(s);
#pragma unroll
                for (int n = 0; n < 2; ++n) { zr[mt][n] = __builtin_amdgcn_mfma_f32_16x16x32_bf16(c, xr[n], zr[mt][n], 0, 0, 0); zr[mt][n] = __builtin_amdgcn_mfma_f32_16x16x32_bf16(s, xi[n], zr[mt][n], 0, 0, 0);
                    zi[mt][n] = __builtin_amdgcn_mfma_f32_16x16x32_bf16(c, xi[n], zi[mt][n], 0, 0, 0); zi[mt][n] = __builtin_amdgcn_mfma_f32_16x16x32_bf16(ns, xr[n], zi[mt][n], 0, 0, 0); } } }
        __syncthreads();
        { LAS bf16_t* Zs = X;
#pragma unroll
          for (int mt = 0; mt < 4; ++mt)
#pragma unroll
              for (int i = 0; i < 4; ++i) { const int f1 = 16 * mt + 4 * fq + i; const float ct = TW[2 * f1], st = TW[2 * f1 + 1];
#pragma unroll
                  for (int n = 0; n < 2; ++n) { const float a = zr[mt][n][i], bq = zi[mt][n][i]; const int col = 32 * w + 16 * n + fr;
                      Zs[f1 * ZP + col] = f2bf(a * ct + bq * st); Zs[f1 * ZP + 256 + col] = f2bf(bq * ct - a * st); } } }
        __syncthreads();
#pragma unroll
        for (int i = 0; i < 8; ++i) { const int q = tid + 512 * i, f1 = q >> 6, ch = q & 63;
            *(u32x4*)(ZBUF + (((size_t)b * 64 + f1) * 64 + t2) * 512 + ch * 8) = *(const LAS u32x4*)((const LAS unsigned char*)X + f1 * (ZP * 2) + ch * 16); }
        __syncthreads();
    }
}
__device__ __forceinline__ void stage_b(LAS unsigned char* lds, const bf16_t* ZBUF, const float* TABC, const float* TABS, bf16_t* MIX, int G, int bx) {
    int tid_l = threadIdx.x; asm volatile("" : "+v"(tid_l));
    const int tid = tid_l, lane = tid & 63, w = __builtin_amdgcn_readfirstlane(tid >> 6), fr = lane & 15, fq = lane >> 4;
    build_tables(lds, TABC, TABS, tid);
    const LAS bf16_t* Tc = (const LAS bf16_t*)(lds + O_TC); const LAS bf16_t* Ts = (const LAS bf16_t*)(lds + O_TS);
    LAS bf16_t* Ys = (LAS bf16_t*)(lds + O_U); LAS bf16_t* ZT = (LAS bf16_t*)(lds + O_X);
    for (int unit = bx; unit < 256; unit += G) {
        const int b = unit >> 6, f1 = unit & 63;
        const bf16_t* Zg = ZBUF + ((size_t)b * 64 + f1) * 64 * 512;
#pragma unroll
        for (int i = 0; i < 4; ++i) { const int q = tid + 512 * i, p = q & 31, ch = q >> 5;
            const u32x4 r0 = *(const u32x4*)(Zg + (size_t)(2 * p) * 512 + ch * 8), r1 = *(const u32x4*)(Zg + (size_t)(2 * p + 1) * 512 + ch * 8);
#pragma unroll
            for (int j = 0; j < 4; ++j) { const unsigned a = r0[j], c = r1[j];
                *(LAS unsigned*)(ZT + (ch * 8 + 2 * j) * TP + 2 * p) = (a & 0xffffu) | (c << 16);
                *(LAS unsigned*)(ZT + (ch * 8 + 2 * j + 1) * TP + 2 * p) = (a >> 16) | (c & 0xffff0000u); } }
        __syncthreads();
        f32x4 y[4][2];
#pragma unroll
        for (int mt = 0; mt < 4; ++mt)
#pragma unroll
            for (int n = 0; n < 2; ++n) y[mt][n] = (f32x4){0.f, 0.f, 0.f, 0.f};
#pragma unroll
        for (int ks = 0; ks < 2; ++ks) { bf16x8 xr[2], xi[2];
#pragma unroll
            for (int n = 0; n < 2; ++n) { xr[n] = *(const LAS bf16x8*)(ZT + (32 * w + 16 * n + fr) * TP + 32 * ks + 8 * fq); xi[n] = *(const LAS bf16x8*)(ZT + (256 + 32 * w + 16 * n + fr) * TP + 32 * ks + 8 * fq); }
#pragma unroll
            for (int mt = 0; mt < 4; ++mt) { const bf16x8 c = *(const LAS bf16x8*)(Tc + (16 * mt + fr) * TP + 32 * ks + 8 * fq), s = *(const LAS bf16x8*)(Ts + (16 * mt + fr) * TP + 32 * ks + 8 * fq);
#pragma unroll
                for (int n = 0; n < 2; ++n) { y[mt][n] = __builtin_amdgcn_mfma_f32_16x16x32_bf16(c, xr[n], y[mt][n], 0, 0, 0); y[mt][n] = __builtin_amdgcn_mfma_f32_16x16x32_bf16(s, xi[n], y[mt][n], 0, 0, 0); } } }
#pragma unroll
        for (int mt = 0; mt < 4; ++mt)
#pragma unroll
            for (int i = 0; i < 4; ++i)
#pragma unroll
                for (int n = 0; n < 2; ++n) Ys[(16 * mt + 4 * fq + i) * UP + 32 * w + 16 * n + fr] = f2bf(y[mt][n][i] * (1.f / 512.f));
        __syncthreads();
#pragma unroll
        for (int i = 0; i < 4; ++i) { const int q = tid + 512 * i, f2 = q >> 5, ch = q & 31;
            *(u32x4*)(MIX + ((size_t)b * NPOS + CTX + f1 + 64 * f2) * D + ch * 8) = *(const LAS u32x4*)((const LAS unsigned char*)Ys + f2 * (UP * 2) + ch * 16); }
        __syncthreads();
    }
}
}

namespace attn {
typedef float f32x16 __attribute__((ext_vector_type(16)));
typedef float f32x2_t __attribute__((ext_vector_type(2))); typedef __bf16 bf16x2_t __attribute__((ext_vector_type(2)));
__device__ __forceinline__ unsigned cvtpk(float lo, float hi) { f32x2_t v = {lo, hi}; bf16x2_t b = __builtin_convertvector(v, bf16x2_t); return __builtin_bit_cast(unsigned, b); }
constexpr int KP = 104, VP = 68;
constexpr int KT_BYTES = 64 * KP * 2, VT_BYTES = 64 * VP * 2, BUF_BYTES = KT_BYTES + VT_BYTES;
constexpr float THR = 8.f;
__device__ __forceinline__ void attn_phase(LAS unsigned char* lds, const bf16_t* QL, const bf16_t* QC, const bf16_t* KB, const bf16_t* VTG, bf16_t* MIX, int with_ctx, int G, int vcu) {
    const int nunits = 256 + (with_ctx ? 16 : 0);
    for (int unit = vcu; unit < nunits; unit += G) {
        int tid_l = threadIdx.x; asm volatile("" : "+v"(tid_l));
        const int tid = tid_l, lane = tid & 63, wid = __builtin_amdgcn_readfirstlane(tid >> 6), r32 = lane & 31, hi = lane >> 5;
        int bh, nk, orow0; const bf16_t* Qp;
        if (unit < 256) { bh = unit >> 4; const int qb = unit & 15; Qp = QL + ((size_t)bh * SEQ + qb * 256) * 96; nk = NPOS; orow0 = (bh >> 2) * NPOS + CTX + qb * 256; }
        else { bh = unit - 256; Qp = QC + (size_t)bh * CTX * 96; nk = CTX; orow0 = (bh >> 2) * NPOS; }
        const int hh = bh & 3, NT = nk / 64;
        const bf16_t* Kg = KB + (size_t)bh * NPOS * 96; const bf16_t* Vg = VTG + (size_t)bh * 64 * NPOS;
        bf16x8 qf[6];
        { const bf16_t* qp = Qp + (size_t)(wid * 32 + r32) * 96 + 8 * hi;
#pragma unroll
          for (int ds = 0; ds < 6; ++ds) qf[ds] = *(const bf16x8*)(qp + 16 * ds); }
        f32x16 o0 = {}, o1 = {}, negm = {}; float mhat = 0.f, l = 0.f;
        const int kr0 = tid / 12, kc0 = tid % 12, kr1 = (tid + 512) / 12, kc1 = (tid + 512) % 12; const bool k1ok = tid < 256;
        const int vd = tid >> 3, vc = tid & 7;
        u32x4 sk0, sk1 = {}, sv;
#define AT_LOAD(t_) do { const size_t k0_ = (size_t)(t_) * 64; sk0 = *(const u32x4*)(Kg + (k0_ + kr0) * 96 + kc0 * 8); if (k1ok) sk1 = *(const u32x4*)(Kg + (k0_ + kr1) * 96 + kc1 * 8); sv = *(const u32x4*)(Vg + (size_t)vd * NPOS + k0_ + vc * 8); } while (0)
#define AT_STORE(slot_) do { LAS unsigned char* bp_ = lds + (slot_) * BUF_BYTES; *(LAS u32x4*)(bp_ + kr0 * (KP * 2) + kc0 * 16) = sk0; if (k1ok) *(LAS u32x4*)(bp_ + kr1 * (KP * 2) + kc1 * 16) = sk1; *(LAS u32x4*)(bp_ + KT_BYTES + vd * (VP * 2) + vc * 16) = sv; } while (0)
#define AT_QK(P0, P1, slot_) do { const LAS bf16_t* Kt_ = (const LAS bf16_t*)(lds + (slot_) * BUF_BYTES); \
        _Pragma("unroll") for (int ds = 0; ds < 6; ++ds) { const bf16x8 k0f = *(const LAS bf16x8*)(Kt_ + r32 * KP + 16 * ds + 8 * hi), k1f = *(const LAS bf16x8*)(Kt_ + (32 + r32) * KP + 16 * ds + 8 * hi); \
            if (ds == 0) { P0 = __builtin_amdgcn_mfma_f32_32x32x16_bf16(k0f, qf[0], negm, 0, 0, 0); P1 = __builtin_amdgcn_mfma_f32_32x32x16_bf16(k1f, qf[0], negm, 0, 0, 0); } \
            else { P0 = __builtin_amdgcn_mfma_f32_32x32x16_bf16(k0f, qf[ds], P0, 0, 0, 0); P1 = __builtin_amdgcn_mfma_f32_32x32x16_bf16(k1f, qf[ds], P1, 0, 0, 0); } } } while (0)
#define MX3(a_, b_, c_) __builtin_fmaxf(__builtin_fmaxf((a_), (b_)), (c_))
#define AT_STEP(C0, C1, N0, N1, t_) do { \
            if ((t_) + 2 < NT) AT_LOAD((t_) + 2); \
            if ((t_) + 1 < NT) AT_QK(N0, N1, s_nxt); \
            float mx_ = MX3(C0[0], C0[1], C1[0]), my_ = MX3(C0[2], C0[3], C1[1]); mx_ = MX3(mx_, C1[2], C1[3]); \
            _Pragma("unroll") for (int r = 4; r < 16; r += 4) { mx_ = MX3(mx_, C0[r], C0[r + 1]); my_ = MX3(my_, C0[r + 2], C0[r + 3]); mx_ = MX3(mx_, C1[r], C1[r + 1]); my_ = MX3(my_, C1[r + 2], C1[r + 3]); } \
            mx_ = fmaxf(mx_, my_); mx_ = fmaxf(mx_, __shfl_xor(mx_, 32)); \
            if (__builtin_expect((t_) == 0 || __any(mx_ > THR), 0)) { const float dl = (t_) == 0 ? mx_ : fmaxf(mx_, 0.f), f = __builtin_amdgcn_exp2f(-dl); mhat += dl; l *= f; \
                _Pragma("unroll") for (int r = 0; r < 16; ++r) { C0[r] -= dl; C1[r] -= dl; o0[r] *= f; o1[r] *= f; negm[r] = -mhat; } \
                if ((t_) + 1 < NT) { _Pragma("unroll") for (int r = 0; r < 16; ++r) { N0[r] -= dl; N1[r] -= dl; } } } \
            float ls_ = 0.f; \
            _Pragma("unroll") for (int r = 0; r < 16; ++r) { C0[r] = __builtin_amdgcn_exp2f(C0[r]); C1[r] = __builtin_amdgcn_exp2f(C1[r]); ls_ += C0[r] + C1[r]; } \
            l += ls_; \
            const LAS bf16_t* Vt_ = (const LAS bf16_t*)(lds + s_cur * BUF_BYTES + KT_BYTES); \
            _Pragma("unroll") for (int q = 0; q < 4; ++q) { u32x4 pw_; \
                _Pragma("unroll") for (int j = 0; j < 4; ++j) { const int r = 8 * (q & 1) + 2 * j; pw_[j] = (q < 2) ? cvtpk(C0[r], C0[r + 1]) : cvtpk(C1[r], C1[r + 1]); } \
                const bf16x8 pf_ = __builtin_bit_cast(bf16x8, pw_); const int kvb = 32 * (q >> 1) + 16 * (q & 1) + 4 * hi; \
                _Pragma("unroll") for (int db = 0; db < 2; ++db) { const u32x2 va = *(const LAS u32x2*)(Vt_ + (32 * db + r32) * VP + kvb), vb = *(const LAS u32x2*)(Vt_ + (32 * db + r32) * VP + kvb + 8); \
                    const u32x4 vw = {va.x, va.y, vb.x, vb.y}; const bf16x8 vf = __builtin_bit_cast(bf16x8, vw); \
                    if (db == 0) o0 = __builtin_amdgcn_mfma_f32_32x32x16_bf16(vf, pf_, o0, 0, 0, 0); else o1 = __builtin_amdgcn_mfma_f32_32x32x16_bf16(vf, pf_, o1, 0, 0, 0); } } \
            if ((t_) + 2 < NT) AT_STORE(s_ld); \
            __syncthreads(); \
            { const int tmp_ = s_cur; s_cur = s_nxt; s_nxt = s_ld; s_ld = tmp_; } } while (0)
        AT_LOAD(0); AT_STORE(0);
        if (NT > 1) { AT_LOAD(1); AT_STORE(1); }
        __syncthreads();
        f32x16 pA0, pA1, pB0, pB1;
        AT_QK(pA0, pA1, 0);
        int s_cur = 0, s_nxt = 1, s_ld = 2;
        for (int t = 0; t < NT; t += 2) {
            AT_STEP(pA0, pA1, pB0, pB1, t);
            AT_STEP(pB0, pB1, pA0, pA1, t + 1);
        }
#undef AT_LOAD
#undef AT_STORE
#undef AT_QK
#undef AT_STEP
#undef MX3
        l += __shfl_xor(l, 32);
        const float il = 1.f / l;
        bf16_t* op = MIX + (size_t)(orow0 + wid * 32 + r32) * D + 512 + hh * 64 + 4 * hi;
#pragma unroll
        for (int g4 = 0; g4 < 4; ++g4) { u32x2 w0, w1; w0.x = cvtpk(o0[4 * g4] * il, o0[4 * g4 + 1] * il); w0.y = cvtpk(o0[4 * g4 + 2] * il, o0[4 * g4 + 3] * il);
            w1.x = cvtpk(o1[4 * g4] * il, o1[4 * g4 + 1] * il); w1.y = cvtpk(o1[4 * g4 + 2] * il, o1[4 * g4 + 3] * il);
            *(u32x2*)(op + 8 * g4) = w0; *(u32x2*)(op + 32 + 8 * g4) = w1; }
    }
}
}

namespace sm {
__device__ __forceinline__ float silu(float x) { return x / (1.f + __expf(-x)); }
__device__ __forceinline__ void mod_phase(LAS unsigned char* lds, const float* c, const float* c_ctx, const float* mod_w, const float* mod_b, float* MOD, int G, int bx, int tid) {
    LAS float* s = (LAS float*)lds;
    for (int i = tid; i < 5120; i += 512) { const int v = i >> 10, k = i & 1023; s[i] = silu(v < 4 ? c[v * 1024 + k] : c_ctx[k]); }
    __syncthreads();
    LAS float* red = s + 5120;
    for (int unit = bx; unit < 96; unit += G) {
        const int l = unit / 48, cb = unit % 48, cl = tid & 127, col = cb * 128 + cl, kq = tid >> 7, k0 = kq * 256;
        const float* W = mod_w + ((size_t)l * 1024 + k0) * 6144 + col;
        float a0 = 0.f, a1 = 0.f, a2 = 0.f, a3 = 0.f, a4 = 0.f;
#pragma unroll 16
        for (int k = 0; k < 256; ++k) { const float w = W[(size_t)k * 6144]; a0 += s[k0 + k] * w; a1 += s[1024 + k0 + k] * w; a2 += s[2048 + k0 + k] * w; a3 += s[3072 + k0 + k] * w; a4 += s[4096 + k0 + k] * w; }
        LAS float* rq = red + kq * 640 + cl; rq[0] = a0; rq[128] = a1; rq[256] = a2; rq[384] = a3; rq[512] = a4;
        __syncthreads();
        for (int i = tid; i < 640; i += 512) { const int v = i >> 7, cc = i & 127; const float r = ((red[i] + red[640 + i]) + (red[1280 + i] + red[1920 + i])) + mod_b[l * 6144 + cb * 128 + cc];
            MOD[((size_t)l * 5 + v) * 6144 + cb * 128 + cc] = r; }
        __syncthreads();
    }
}
__device__ __forceinline__ void norm_store(const float4 (&x)[4], float ss, const float* g, const float* mv, int sh_off, int sc_off, bf16_t* xn_row, int lane) {
    const float rs = rsqrtf(wave_sum(ss) * (1.f / D) + 1e-6f);
#pragma unroll
    for (int j = 0; j < 4; ++j) { const int c = (j * 64 + lane) * 4; const float4 gg = *(const float4*)(g + c), sh = *(const float4*)(mv + sh_off + c), sc = *(const float4*)(mv + sc_off + c);
        u32x2 o; o.x = pk2(x[j].x * rs * gg.x * (1.f + sc.x) + sh.x, x[j].y * rs * gg.y * (1.f + sc.y) + sh.y); o.y = pk2(x[j].z * rs * gg.z * (1.f + sc.z) + sh.z, x[j].w * rs * gg.w * (1.f + sc.w) + sh.w);
        *(u32x2*)(xn_row + c) = o; }
}
__device__ __forceinline__ void pro1_phase(const float* x, const float* ctx, const float* g, const float* MODl, float* H, bf16_t* XN, int r_first, int r_end, int r_step, int lane) {
    for (int r = r_first; r < r_end; r += r_step) { const int b = r / NPOS, pos = r % NPOS, v = pos < CTX ? 4 : b;
        const float* src = pos < CTX ? ctx + ((size_t)b * CTX + pos) * D : x + ((size_t)b * SEQ + (pos - CTX)) * D;
        float4 xv[4]; float ss = 0.f;
#pragma unroll
        for (int j = 0; j < 4; ++j) { const int c = (j * 64 + lane) * 4; xv[j] = *(const float4*)(src + c); ss += xv[j].x * xv[j].x + xv[j].y * xv[j].y + xv[j].z * xv[j].z + xv[j].w * xv[j].w; }
#pragma unroll
        for (int j = 0; j < 4; ++j) *(float4*)(H + (size_t)r * D + (j * 64 + lane) * 4) = xv[j];
        norm_store(xv, ss, g, MODl + (size_t)v * 6144, 0, 1024, XN + (size_t)r * D, lane); }
}
__device__ __forceinline__ void comb_phase(int l, float* H, const bf16_t* Y, const float* MODl, const float* g_next, const float* MODn, bf16_t* XN, const float* final_g, float* out, int gw, int NGW, int lane) {
    for (int r = gw; r < MROWS; r += NGW) { const int b = r / NPOS, pos = r % NPOS, v = pos < CTX ? 4 : b;
        if (l == 1 && pos < CTX) continue;
        const float* g2 = MODl + (size_t)v * 6144 + 5120;
        float4 xv[4]; float ss = 0.f;
#pragma unroll
        for (int j = 0; j < 4; ++j) { const int c = (j * 64 + lane) * 4; xv[j] = *(const float4*)(H + (size_t)r * D + c); float4 s = make_float4(0.f, 0.f, 0.f, 0.f);
#pragma unroll
            for (int k = 0; k < 4; ++k) { const u32x2 y = *(const u32x2*)(Y + ((size_t)r * 4 + k) * D + c); s.x += __uint_as_float(y.x << 16); s.y += __uint_as_float(y.x & 0xffff0000u); s.z += __uint_as_float(y.y << 16); s.w += __uint_as_float(y.y & 0xffff0000u); }
            const float4 gg = *(const float4*)(g2 + c); xv[j].x += gg.x * s.x; xv[j].y += gg.y * s.y; xv[j].z += gg.z * s.z; xv[j].w += gg.w * s.w;
            ss += xv[j].x * xv[j].x + xv[j].y * xv[j].y + xv[j].z * xv[j].z + xv[j].w * xv[j].w; }
        if (l == 0) {
#pragma unroll
            for (int j = 0; j < 4; ++j) *(float4*)(H + (size_t)r * D + (j * 64 + lane) * 4) = xv[j];
            norm_store(xv, ss, g_next, MODn + (size_t)v * 6144, 0, 1024, XN + (size_t)r * D, lane);
        } else { const float rs = rsqrtf(wave_sum(ss) * (1.f / D) + 1e-6f); float* op = out + ((size_t)b * SEQ + (pos - CTX)) * D;
#pragma unroll
            for (int j = 0; j < 4; ++j) { const int c = (j * 64 + lane) * 4; const float4 fg = *(const float4*)(final_g + c); float4 o; o.x = xv[j].x * rs * fg.x; o.y = xv[j].y * rs * fg.y; o.z = xv[j].z * rs * fg.z; o.w = xv[j].w * rs * fg.w; *(float4*)(op + c) = o; } }
    }
}
__device__ __forceinline__ void route_phase(LAS unsigned char* lds, int l, const float* H, const float* g, const float* MODl, const bf16_t* RWH, const bf16_t* RWL, const float* rb, bf16_t* XN, int* CNT, int* LIST, float* GATE,
                                            int G, int bx, int tid) {
    const int lane = tid & 63, wave = __builtin_amdgcn_readfirstlane(tid >> 6), fr = lane & 15, fq = lane >> 4;
    constexpr int FP = 1032;
    LAS bf16_t* FH = (LAS bf16_t*)lds; LAS bf16_t* FL = FH + 16 * FP;
    LAS float* PART = (LAS float*)(lds + 66048);
    LAS int* LCNT = (LAS int*)(lds + 66048 + 16384);
    LAS int* LBASE = LCNT + 64; LAS int* LENT = LCNT + 128;
    if (tid < 64) LCNT[tid] = 0;
    bf16x8 wh[2][4], wl[2][4];
#pragma unroll
    for (int nt = 0; nt < 2; ++nt)
#pragma unroll
        for (int ks = 0; ks < 4; ++ks) { const size_t o = ((size_t)l * NE + 16 * nt + fr) * D + 128 * wave + 32 * ks + 8 * fq; wh[nt][ks] = *(const bf16x8*)(RWH + o); wl[nt][ks] = *(const bf16x8*)(RWL + o); }
    const float bias = rb[lane & 31];
    __syncthreads();
    const int nb = l == 1 ? (MROWS - NB_ * CTX) / 16 : MROWS / 16;
    for (int bi = bx; bi < nb; bi += G) {
#pragma unroll
        for (int rr = 0; rr < 2; ++rr) { const int q = bi * 16 + 2 * wave + rr; const int r = l == 1 ? (q / SEQ) * NPOS + CTX + (q % SEQ) : q;
            const int b = r / NPOS, pos = r % NPOS, v = pos < CTX ? 4 : b; const float* mv = MODl + (size_t)v * 6144;
            float4 xv[4]; float ss = 0.f;
#pragma unroll
            for (int j = 0; j < 4; ++j) { xv[j] = *(const float4*)(H + (size_t)r * D + (j * 64 + lane) * 4); ss += xv[j].x * xv[j].x + xv[j].y * xv[j].y + xv[j].z * xv[j].z + xv[j].w * xv[j].w; }
            const float rs = rsqrtf(wave_sum(ss) * (1.f / D) + 1e-6f);
#pragma unroll
            for (int j = 0; j < 4; ++j) { const int c = (j * 64 + lane) * 4; const float4 gg = *(const float4*)(g + c), sh = *(const float4*)(mv + 3072 + c), sc = *(const float4*)(mv + 4096 + c);
                float f[4]; f[0] = xv[j].x * rs * gg.x * (1.f + sc.x) + sh.x; f[1] = xv[j].y * rs * gg.y * (1.f + sc.y) + sh.y; f[2] = xv[j].z * rs * gg.z * (1.f + sc.z) + sh.z; f[3] = xv[j].w * rs * gg.w * (1.f + sc.w) + sh.w;
                bf16_t hb[4], lb[4];
#pragma unroll
                for (int i = 0; i < 4; ++i) { hb[i] = f2bf(f[i]); lb[i] = f2bf(f[i] - bf2f(hb[i])); }
                u32x2 oh, ol; oh.x = (unsigned)hb[0] | ((unsigned)hb[1] << 16); oh.y = (unsigned)hb[2] | ((unsigned)hb[3] << 16); ol.x = (unsigned)lb[0] | ((unsigned)lb[1] << 16); ol.y = (unsigned)lb[2] | ((unsigned)lb[3] << 16);
                *(u32x2*)(XN + (size_t)r * D + c) = oh; *(LAS u32x2*)(FH + (2 * wave + rr) * FP + c) = oh; *(LAS u32x2*)(FL + (2 * wave + rr) * FP + c) = ol; } }
        __syncthreads();
        { f32x4 acc[2] = {(f32x4){0.f, 0.f, 0.f, 0.f}, (f32x4){0.f, 0.f, 0.f, 0.f}};
#pragma unroll
          for (int ks = 0; ks < 4; ++ks) { const bf16x8 ah = *(const LAS bf16x8*)(FH + fr * FP + 128 * wave + 32 * ks + 8 * fq), al = *(const LAS bf16x8*)(FL + fr * FP + 128 * wave + 32 * ks + 8 * fq);
#pragma unroll
              for (int nt = 0; nt < 2; ++nt) { acc[nt] = __builtin_amdgcn_mfma_f32_16x16x32_bf16(ah, wh[nt][ks], acc[nt], 0, 0, 0); acc[nt] = __builtin_amdgcn_mfma_f32_16x16x32_bf16(ah, wl[nt][ks], acc[nt], 0, 0, 0);
                  acc[nt] = __builtin_amdgcn_mfma_f32_16x16x32_bf16(al, wh[nt][ks], acc[nt], 0, 0, 0); } }
#pragma unroll
          for (int nt = 0; nt < 2; ++nt)
#pragma unroll
              for (int i = 0; i < 4; ++i) PART[(wave * 16 + 4 * fq + i) * 32 + 16 * nt + fr] = acc[nt][i]; }
        __syncthreads();
        { const int row = 2 * wave + (lane >> 5), e = lane & 31; const int q = bi * 16 + row; const int r = l == 1 ? (q / SEQ) * NPOS + CTX + (q % SEQ) : q;
          float lg = bias;
#pragma unroll
          for (int kw = 0; kw < 8; ++kw) lg += PART[(kw * 16 + row) * 32 + e];
          float val = lg; int idx = e; float tv[4]; int ti[4];
#pragma unroll
          for (int k = 0; k < 4; ++k) { float bv = val; int bi2 = idx;
#pragma unroll
              for (int o = 1; o < 32; o <<= 1) { const float ov = __shfl_xor(bv, o); const int oi = __shfl_xor(bi2, o); if (ov > bv || (ov == bv && oi < bi2)) { bv = ov; bi2 = oi; } }
              tv[k] = bv; ti[k] = bi2; if (idx == bi2) val = -3e38f; }
          if (e == 0) { float ex[4], sum = 0.f;
#pragma unroll
              for (int k = 0; k < 4; ++k) { ex[k] = __expf(tv[k] - tv[0]); sum += ex[k]; }
              const float isum = 1.f / sum;
#pragma unroll
              for (int k = 0; k < 4; ++k) { const int asg = r * 4 + k; GATE[asg] = ex[k] * isum; const int rank = __hip_atomic_fetch_add(&LCNT[ti[k]], 1, __ATOMIC_RELAXED, __HIP_MEMORY_SCOPE_WORKGROUP); const int slot = __hip_atomic_fetch_add(&LCNT[32], 1, __ATOMIC_RELAXED, __HIP_MEMORY_SCOPE_WORKGROUP);
                  LENT[slot * 2] = asg; LENT[slot * 2 + 1] = (ti[k] << 16) | rank; } } }
        __syncthreads();
    }
    if (tid < 32) LBASE[tid] = LCNT[tid] > 0 ? atomicAdd(&CNT[tid * L::CNT_STRIDE], LCNT[tid]) : 0;
    __syncthreads();
    for (int i = tid; i < LCNT[32]; i += 512) { const int asg = LENT[i * 2], er = LENT[i * 2 + 1], ee = er >> 16, rank = er & 0xffff; LIST[(size_t)ee * LCAP + LBASE[ee] + rank] = asg; }
    __syncthreads();
}
__device__ __forceinline__ void smallw_phase(const float* w_uq, const float* qg, const float* w_ukv, const float* kvg, const float* w_a, const float* w_i, bf16_t* WUQT, bf16_t* WUKVT, bf16_t* WAT, bf16_t* WIT,
                                             float* TABC, float* TABS, const float* lam, float* SPT, const float* rw, bf16_t* RWHp, bf16_t* RWLp, int gt, int NGT) {
    for (int i = gt; i < 2 * 384 * 256; i += NGT) { const int l = i / (384 * 256), q = i % (384 * 256), n = q >> 8, k = q & 255; WUQT[i] = f2bf(qg[l * 256 + k] * w_uq[((size_t)l * 256 + k) * 384 + n]); }
    for (int i = gt; i < 2 * 512 * 128; i += NGT) { const int l = i / (512 * 128), q = i % (512 * 128), n = q >> 7, k = q & 127; WUKVT[i] = f2bf(kvg[l * 128 + k] * w_ukv[((size_t)l * 128 + k) * 512 + n]); }
    for (int i = gt; i < 16 * 4096; i += NGT) { const int m = i >> 12, q = i & 4095, e = q >> 6, d = q & 63; WAT[i] = f2bf(w_a[(size_t)m * 4096 + d * 64 + e]); WIT[i] = f2bf(w_i[(size_t)m * 4096 + d * 64 + e]); }
    for (int i = gt; i < 4096; i += NGT) { float s, c; sincospif((float)i / 2048.f, &s, &c); TABC[i] = c; TABS[i] = s; }
    for (int i = gt; i < 1024; i += NGT) SPT[i] = log1pf(__expf(-lam[i]));
    for (int i = gt; i < 2 * NE * D; i += NGT) { const int l = i / (NE * D), q = i % (NE * D), e = q >> 10, k = q & 1023; const float w = rw[((size_t)l * D + k) * NE + e]; const bf16_t h = f2bf(w); RWHp[i] = h; RWLp[i] = f2bf(w - bf2f(h)); }
}
}

namespace prep {
constexpr int O_KR = 0, O_CS = 8192, O_RS = 16384, O_CQ = 16896  , O_KS = 67072, O_CKV = 100864;
constexpr int CQP = 264, CKP = 136, QSP = 392, KSP = 264;
constexpr float C2 = 0.10206207261596577f * 1.4426950408889634f;
__device__ __forceinline__ void qkv_units(LAS unsigned char* lds, int l, const bf16_t* P, const bf16_t* WUQT, const bf16_t* WUKVT, const float* scw, const float* scb,
                                          bf16_t* QL, bf16_t* QC, bf16_t* KB, bf16_t* VTG, bf16_t* MIX, int u0, int u1, int ustep) {
    LAS float* KRo = (LAS float*)(lds + O_KR); LAS float* CS = (LAS float*)(lds + O_CS); LAS float* RS = (LAS float*)(lds + O_RS);
    LAS bf16_t* CQ = (LAS bf16_t*)(lds + O_CQ); LAS bf16_t* CK = (LAS bf16_t*)(lds + O_CKV); LAS bf16_t* KS = (LAS bf16_t*)(lds + O_KS); LAS bf16_t* QS = (LAS bf16_t*)(lds + O_CQ);
    for (int unit = u0; unit < u1; unit += ustep) {
        int tid_l = threadIdx.x; asm volatile("" : "+v"(tid_l));
        const int tid = tid_l, lane = tid & 63, w = __builtin_amdgcn_readfirstlane(tid >> 6), fr = lane & 15, fq = lane >> 4;
        const int b = unit / 68, chunk = unit % 68, pos0 = 64 * chunk; const bool ctxt = chunk < 4; const size_t r0 = (size_t)b * NPOS + pos0;
#pragma unroll
        for (int i = 0; i < 4; ++i) { const int q = tid + 512 * i, row = q >> 5, ch = q & 31; *(LAS u32x4*)((LAS unsigned char*)CQ + row * (CQP * 2) + ch * 16) = *(const u32x4*)(P + (r0 + row) * PP + C_CQ + ch * 8); }
#pragma unroll
        for (int i = 0; i < 2; ++i) { const int q = tid + 512 * i, row = q >> 4, ch = q & 15; *(LAS u32x4*)((LAS unsigned char*)CK + row * (CKP * 2) + ch * 16) = *(const u32x4*)(P + (r0 + row) * PP + C_CKV + ch * 8); }
        __syncthreads();
        { const int row = tid >> 3, j = tid & 7; float sq = 0.f, sk = 0.f;
#pragma unroll
          for (int i = 0; i < 4; ++i) { const u32x4 v = *(const LAS u32x4*)((const LAS unsigned char*)CQ + row * (CQP * 2) + j * 64 + i * 16);
#pragma unroll
              for (int e = 0; e < 4; ++e) { const float a = __uint_as_float(v[e] << 16), c = __uint_as_float(v[e] & 0xffff0000u); sq += a * a + c * c; } }
#pragma unroll
          for (int i = 0; i < 2; ++i) { const u32x4 v = *(const LAS u32x4*)((const LAS unsigned char*)CK + row * (CKP * 2) + j * 32 + i * 16);
#pragma unroll
              for (int e = 0; e < 4; ++e) { const float a = __uint_as_float(v[e] << 16), c = __uint_as_float(v[e] & 0xffff0000u); sk += a * a + c * c; } }
          sq += __shfl_xor(sq, 1); sq += __shfl_xor(sq, 2); sq += __shfl_xor(sq, 4); sk += __shfl_xor(sk, 1); sk += __shfl_xor(sk, 2); sk += __shfl_xor(sk, 4);
          if (j == 0) { RS[row * 2] = rsqrtf(sq * (1.f / 256.f) + 1e-6f); RS[row * 2 + 1] = rsqrtf(sk * (1.f / 128.f) + 1e-6f); }
          float cr = 1.f, sr = 0.f, cc = 1.f, sc = 0.f;
          if (!ctxt) { const int t = pos0 - CTX + row; const float inv = __expf(-9.210340371976184f * (float)j * 0.125f); float xa = (float)(t >> 6) * inv * 0.15915494309189535f; xa -= rintf(xa); sr = __sinf(xa * 6.283185307179586f); cr = __cosf(xa * 6.283185307179586f); float xb = (float)(t & 63) * inv * 0.15915494309189535f; xb -= rintf(xb); sc = __sinf(xb * 6.283185307179586f); cc = __cosf(xb * 6.283185307179586f); }
          CS[(row * 16 + j) * 2] = cr; CS[(row * 16 + j) * 2 + 1] = sr; CS[(row * 16 + 8 + j) * 2] = cc; CS[(row * 16 + 8 + j) * 2 + 1] = sc;
          const bf16_t* kp = P + (r0 + row) * PP + C_KR; const float z0 = bf2f(kp[j]), z1 = bf2f(kp[8 + j]), z2 = bf2f(kp[16 + j]), z3 = bf2f(kp[24 + j]);
          KRo[row * 32 + j] = z0 * cr - z1 * sr; KRo[row * 32 + 8 + j] = z0 * sr + z1 * cr; KRo[row * 32 + 16 + j] = z2 * cc - z3 * sc; KRo[row * 32 + 24 + j] = z2 * sc + z3 * cc; }
        __builtin_amdgcn_sched_barrier(0);
        { f32x4 qa[4][3];
#pragma unroll
          for (int mt = 0; mt < 4; ++mt)
#pragma unroll
              for (int n = 0; n < 3; ++n) qa[mt][n] = (f32x4){0.f, 0.f, 0.f, 0.f};
          const bf16_t* wq = WUQT + ((size_t)l * 384 + 48 * w + fr) * 256 + 8 * fq;
#pragma unroll
          for (int ks = 0; ks < 8; ++ks) { bf16x8 a[4], bb[3];
#pragma unroll
              for (int mt = 0; mt < 4; ++mt) a[mt] = *(const LAS bf16x8*)(CQ + (16 * mt + fr) * CQP + 32 * ks + 8 * fq);
#pragma unroll
              for (int n = 0; n < 3; ++n) bb[n] = *(const bf16x8*)(wq + (size_t)(16 * n) * 256 + 32 * ks);
#pragma unroll
              for (int mt = 0; mt < 4; ++mt)
#pragma unroll
                  for (int n = 0; n < 3; ++n) qa[mt][n] = __builtin_amdgcn_mfma_f32_16x16x32_bf16(a[mt], bb[n], qa[mt][n], 0, 0, 0); }
          __syncthreads();
#pragma unroll
          for (int n = 0; n < 3; ++n) { const int nt = 3 * w + n, m6 = nt % 6, col = 16 * nt + fr;
#pragma unroll
              for (int mt = 0; mt < 4; ++mt)
#pragma unroll
                  for (int i = 0; i < 4; ++i) { const int row = 16 * mt + 4 * fq + i; float v = qa[mt][n][i] * RS[row * 2];
                      if (m6 >= 4) { const float pv = __shfl_xor(v, 8); const int ci = (row * 16 + (m6 == 5 ? 8 : 0) + (fr & 7)) * 2; const float c = CS[ci], s = CS[ci + 1]; v = (fr < 8) ? v * c - pv * s : pv * s + v * c; }
                      QS[row * QSP + col] = f2bf(v * C2); } } }
        __builtin_amdgcn_sched_barrier(0);
        { f32x4 ka[4][4];
#pragma unroll
          for (int mt = 0; mt < 4; ++mt)
#pragma unroll
              for (int n = 0; n < 4; ++n) ka[mt][n] = (f32x4){0.f, 0.f, 0.f, 0.f};
          const bf16_t* wk = WUKVT + ((size_t)l * 512 + 64 * w + fr) * 128 + 8 * fq;
#pragma unroll
          for (int ks = 0; ks < 4; ++ks) { bf16x8 a[4], bb[4];
#pragma unroll
              for (int mt = 0; mt < 4; ++mt) a[mt] = *(const LAS bf16x8*)(CK + (16 * mt + fr) * CKP + 32 * ks + 8 * fq);
#pragma unroll
              for (int n = 0; n < 4; ++n) bb[n] = *(const bf16x8*)(wk + (size_t)(16 * n) * 128 + 32 * ks);
#pragma unroll
              for (int mt = 0; mt < 4; ++mt)
#pragma unroll
                  for (int n = 0; n < 4; ++n) ka[mt][n] = __builtin_amdgcn_mfma_f32_16x16x32_bf16(a[mt], bb[n], ka[mt][n], 0, 0, 0); }
          const int head = w >> 1;
          if ((w & 1) == 0) {
#pragma unroll
              for (int n = 0; n < 4; ++n)
#pragma unroll
                  for (int mt = 0; mt < 4; ++mt)
#pragma unroll
                      for (int i = 0; i < 4; ++i) { const int row = 16 * mt + 4 * fq + i; KS[row * KSP + head * 64 + 16 * n + fr] = f2bf(ka[mt][n][i] * RS[row * 2 + 1]); }
          } else {
#pragma unroll
              for (int n = 0; n < 4; ++n)
#pragma unroll
                  for (int mt = 0; mt < 4; ++mt) { const int rb = 16 * mt + 4 * fq; u32x2 o; o.x = pk2(ka[mt][n][0] * RS[rb * 2 + 1], ka[mt][n][1] * RS[rb * 2 + 3]); o.y = pk2(ka[mt][n][2] * RS[rb * 2 + 5], ka[mt][n][3] * RS[rb * 2 + 7]);
                      *(u32x2*)(VTG + ((size_t)(b * 4 + head) * 64 + 16 * n + fr) * NPOS + pos0 + rb) = o; } } }
        __syncthreads();
#pragma unroll
        for (int i = 0; i < 6; ++i) { const int q = tid + 512 * i, row = q / 48, rem = q % 48, head = rem / 12, ch = rem % 12, pos = pos0 + row;
            const u32x4 qv = *(const LAS u32x4*)((const LAS unsigned char*)QS + row * (QSP * 2) + (head * 96 + ch * 8) * 2);
            if (!ctxt) *(u32x4*)(QL + ((size_t)(b * 4 + head) * SEQ + (pos - CTX)) * 96 + ch * 8) = qv; else if (l == 0) *(u32x4*)(QC + ((size_t)(b * 4 + head) * CTX + pos) * 96 + ch * 8) = qv;
            u32x4 kv;
            if (ch < 8) kv = *(const LAS u32x4*)((const LAS unsigned char*)KS + row * (KSP * 2) + (head * 64 + ch * 8) * 2);
            else { const LAS float* kr = KRo + row * 32 + (ch - 8) * 8; kv.x = pk2(kr[0], kr[1]); kv.y = pk2(kr[2], kr[3]); kv.z = pk2(kr[4], kr[5]); kv.w = pk2(kr[6], kr[7]); }
            *(u32x4*)(KB + ((size_t)(b * 4 + head) * NPOS + pos) * 96 + ch * 8) = kv; }
        if (!(ctxt && l == 1)) { const int lo = ctxt ? 0 : CTX, hi = ctxt ? CTX : NPOS;
#pragma unroll
            for (int i = 0; i < 4; ++i) { const int q = tid + 512 * i, row = q >> 5, ch = q & 31, pos = pos0 + row; float acc[8];
#pragma unroll
                for (int e = 0; e < 8; ++e) acc[e] = scb[ch * 8 + e];
#pragma unroll
                for (int k = 0; k < 3; ++k) { const int p = pos - 1 + k; if (p >= lo && p < hi) { const bf16_t* pr = P + ((size_t)b * NPOS + p) * PP; const u32x4 sx = *(const u32x4*)(pr + C_SX + ch * 8), sc = *(const u32x4*)(pr + C_SC + ch * 8);
#pragma unroll
                        for (int e = 0; e < 4; ++e) { const float w0 = scw[k * 256 + ch * 8 + 2 * e], w1 = scw[k * 256 + ch * 8 + 2 * e + 1];
                            acc[2 * e] += w0 * (__uint_as_float(sx[e] << 16) * __uint_as_float(sc[e] << 16)); acc[2 * e + 1] += w1 * (__uint_as_float(sx[e] & 0xffff0000u) * __uint_as_float(sc[e] & 0xffff0000u)); } } }
                const u32x4 sb = *(const u32x4*)(P + (r0 + row) * PP + C_SB + ch * 8); u32x4 o;
#pragma unroll
                for (int e = 0; e < 4; ++e) o[e] = pk2(__uint_as_float(sb[e] << 16) * acc[2 * e], __uint_as_float(sb[e] & 0xffff0000u) * acc[2 * e + 1]);
                *(u32x4*)(MIX + (r0 + row) * D + 768 + ch * 8) = o; } }
        __syncthreads();
    }
}
}

namespace lru {
constexpr int XP = 264, O_X = 0, O_NA = 33792, O_BB = 66560;
__device__ __forceinline__ float sigm(float x) { return __builtin_amdgcn_rcpf(1.f + __expf(-x)); }
__device__ __forceinline__ void chunk_units(LAS unsigned char* lds, int l, const bf16_t* P, const float* conv_w, const float* conv_b, const bf16_t* WAT, const bf16_t* WIT, const float* b_a, const float* b_i, const float* SPT,
                                            bf16_t* HL, bf16_t* AC, float* SUM, int u0, int u1, int ustep, int knob) {
    LAS bf16_t* X = (LAS bf16_t*)(lds + O_X); LAS bf16_t* NA = (LAS bf16_t*)(lds + O_NA); LAS bf16_t* BB = (LAS bf16_t*)(lds + O_BB);
    for (int unit = u0; unit < u1; unit += ustep) {
        int tid_l = threadIdx.x; asm volatile("" : "+v"(tid_l));
        const int tid = tid_l, lane = tid & 63, w = __builtin_amdgcn_readfirstlane(tid >> 6), fr = lane & 15, fq = lane >> 4;
        const int dir = unit & 1, bc = unit >> 1, b = bc / 68, chunk = bc % 68, pos0 = 64 * chunk; const int lo = chunk < 4 ? 0 : CTX, hi = chunk < 4 ? CTX : NPOS, left = dir ? 1 : 2;
        const size_t r0 = (size_t)b * NPOS + pos0; const int pd = (l * 2 + dir) * 256;
        if (!(knob & 1)) { const int cg = tid & 31, ts = tid >> 5, c0 = cg * 8; float wv[4][8], cbv[8];
#pragma unroll
          for (int e = 0; e < 8; ++e) { cbv[e] = conv_b[pd + c0 + e];
#pragma unroll
              for (int k = 0; k < 4; ++k) wv[k][e] = conv_w[(size_t)pd * 4 + k * 256 + c0 + e]; }
          const bf16_t* pc = P + (size_t)b * NPOS * PP + C_LX + c0; const int pb = pos0 + 4 * ts - left;
          u32x4 u[7];
#pragma unroll
          for (int i = 0; i < 7; ++i) { const int p = pb + i; const int pcl = p < lo ? lo : (p >= hi ? hi - 1 : p); u[i] = *(const u32x4*)(pc + (size_t)pcl * PP); if (p < lo || p >= hi) u[i] = (u32x4){0u, 0u, 0u, 0u}; }
#pragma unroll
          for (int i = 0; i < 4; ++i) { u32x4 o;
#pragma unroll
              for (int e2 = 0; e2 < 4; ++e2) { float lo_ = cbv[2 * e2], hi_ = cbv[2 * e2 + 1];
#pragma unroll
                  for (int k = 0; k < 4; ++k) { const unsigned d = u[i + k][e2]; lo_ += wv[k][2 * e2] * __uint_as_float(d << 16); hi_ += wv[k][2 * e2 + 1] * __uint_as_float(d & 0xffff0000u); }
                  o[e2] = pk2(lo_, hi_); }
              *(LAS u32x4*)(X + (4 * ts + i) * XP + c0) = o; } }
        __syncthreads();
        if (!(knob & 2)) { const int h = w >> 1, mh = w & 1;
          f32x4 ra[2][4], ri[2][4];
#pragma unroll
          for (int m = 0; m < 2; ++m)
#pragma unroll
              for (int n = 0; n < 4; ++n) { ra[m][n] = (f32x4){0.f, 0.f, 0.f, 0.f}; ri[m][n] = (f32x4){0.f, 0.f, 0.f, 0.f}; }
          const bf16_t* wa = WAT + ((size_t)((l * 2 + dir) * 4 + h) * 64 + fr) * 64 + 8 * fq; const bf16_t* wi = WIT + ((size_t)((l * 2 + dir) * 4 + h) * 64 + fr) * 64 + 8 * fq;
#pragma unroll
          for (int ks = 0; ks < 2; ++ks) { bf16x8 a[2], ba[4], bi[4];
#pragma unroll
              for (int m = 0; m < 2; ++m) a[m] = *(const LAS bf16x8*)(X + (16 * (2 * mh + m) + fr) * XP + 64 * h + 32 * ks + 8 * fq);
#pragma unroll
              for (int n = 0; n < 4; ++n) { ba[n] = *(const bf16x8*)(wa + (size_t)(16 * n) * 64 + 32 * ks); bi[n] = *(const bf16x8*)(wi + (size_t)(16 * n) * 64 + 32 * ks); }
#pragma unroll
              for (int m = 0; m < 2; ++m)
#pragma unroll
                  for (int n = 0; n < 4; ++n) { ra[m][n] = __builtin_amdgcn_mfma_f32_16x16x32_bf16(a[m], ba[n], ra[m][n], 0, 0, 0); ri[m][n] = __builtin_amdgcn_mfma_f32_16x16x32_bf16(a[m], bi[n], ri[m][n], 0, 0, 0); } }
#pragma unroll
          for (int n = 0; n < 4; ++n) { const int c = 64 * h + 16 * n + fr; const float bav = b_a[pd + c], biv = b_i[pd + c], sp8 = 8.f * SPT[pd + c];
#pragma unroll
              for (int m = 0; m < 2; ++m)
#pragma unroll
                  for (int i = 0; i < 4; ++i) { const int t = 16 * (2 * mh + m) + 4 * fq + i; const float r = sigm(ra[m][n][i] + bav), ig = sigm(ri[m][n][i] + biv);
                      const float x = r * sp8; const float na = x < 0.03125f ? x * (1.f - 0.5f * x * (1.f - 0.33333334f * x * (1.f - 0.25f * x))) : 1.f - __expf(-x); const float xv = bf2f(X[t * XP + c]);
                      NA[t * 256 + c] = f2bf(na); BB[t * 256 + c] = f2bf(__builtin_amdgcn_sqrtf(fmaxf(na * (2.f - na), 0.f)) * (ig * xv)); } } }
        __syncthreads();
        if (tid < 256 && !(knob & 4)) { const int c = tid; float hst = 0.f, A = 1.f;
            if (dir == 0) {
#pragma unroll 8
                for (int t = 0; t < 64; ++t) { const float a = 1.f - bf2f(NA[t * 256 + c]); hst = a * hst + bf2f(BB[t * 256 + c]); A *= a; BB[t * 256 + c] = f2bf(hst); NA[t * 256 + c] = f2bf(A); }
            } else {
#pragma unroll 8
                for (int t = 63; t >= 0; --t) { const float a = 1.f - bf2f(NA[t * 256 + c]); hst = a * hst + bf2f(BB[t * 256 + c]); A *= a; BB[t * 256 + c] = f2bf(hst); NA[t * 256 + c] = f2bf(A); }
            }
            float* sm = SUM + ((size_t)(dir * 4 + b) * 68 + chunk) * 512; sm[c] = A; sm[256 + c] = hst; }
        __syncthreads();
        if (!(knob & 4)) {
#pragma unroll
            for (int i = 0; i < 4; ++i) { const int q = tid + 512 * i, t = q >> 5, ch = q & 31; const size_t go = ((size_t)dir * MROWS + r0 + t) * 256 + ch * 8;
                *(u32x4*)(AC + go) = *(const LAS u32x4*)(NA + t * 256 + ch * 8); *(u32x4*)(HL + go) = *(const LAS u32x4*)(BB + t * 256 + ch * 8); } }
        __syncthreads();
    }
}
__device__ __forceinline__ void fixup_units(LAS unsigned char* lds, int l, const bf16_t* P, const bf16_t* HL, const bf16_t* AC, const float* SUM, bf16_t* MIX, int G, int bx) {
    LAS float* CAR = (LAS float*)lds;
    for (int unit = bx; unit < 272; unit += G) {
        int tid_l = threadIdx.x; asm volatile("" : "+v"(tid_l));
        const int tid = tid_l;
        const int b = unit / 68, chunk = unit % 68; if (l == 1 && chunk < 4) continue;
        { const int dir = tid >> 8, c = tid & 255; const float* sp = SUM + ((size_t)(dir * 4 + b) * 68) * 512 + c;
          const int n_pre = dir == 0 ? chunk : (chunk < 4 ? 3 - chunk : 4 + (67 - chunk));
          float cy = 0.f;
          for (int j0 = 0; j0 < n_pre; j0 += 16) { float av[16], hv[16];
#pragma unroll
              for (int u = 0; u < 16; ++u) { const int n = j0 + u < n_pre ? j0 + u : n_pre - 1; const int j = dir == 0 ? n : (n < 4 ? 3 - n : 71 - n); av[u] = sp[(size_t)j * 512]; hv[u] = sp[(size_t)j * 512 + 256]; }
#pragma unroll
              for (int u = 0; u < 16; ++u) cy = (j0 + u < n_pre) ? hv[u] + av[u] * cy : cy; }
          CAR[tid] = cy; }
        __syncthreads();
        { const int cg = tid & 31, ts = tid >> 5, c0 = cg * 8; float cf[8], cb[8];
#pragma unroll
          for (int e = 0; e < 8; ++e) { cf[e] = CAR[c0 + e]; cb[e] = CAR[256 + c0 + e]; }
          const size_t r0 = (size_t)b * NPOS + 64 * chunk + 4 * ts;
          u32x4 hf[4], af[4], hb[4], ab[4], gt[4];
#pragma unroll
          for (int i = 0; i < 4; ++i) { const size_t r = r0 + i; hf[i] = *(const u32x4*)(HL + r * 256 + c0); af[i] = *(const u32x4*)(AC + r * 256 + c0); hb[i] = *(const u32x4*)(HL + ((size_t)MROWS + r) * 256 + c0); ab[i] = *(const u32x4*)(AC + ((size_t)MROWS + r) * 256 + c0);
              gt[i] = *(const u32x4*)(P + r * PP + C_LG + c0); }
#pragma unroll
          for (int i = 0; i < 4; ++i) { u32x4 o;
#pragma unroll
              for (int e2 = 0; e2 < 4; ++e2) { float res[2];
#pragma unroll
                  for (int hh = 0; hh < 2; ++hh) { const int e = 2 * e2 + hh;
                      const float vhf = hh ? __uint_as_float(hf[i][e2] & 0xffff0000u) : __uint_as_float(hf[i][e2] << 16), vaf = hh ? __uint_as_float(af[i][e2] & 0xffff0000u) : __uint_as_float(af[i][e2] << 16);
                      const float vhb = hh ? __uint_as_float(hb[i][e2] & 0xffff0000u) : __uint_as_float(hb[i][e2] << 16), vab = hh ? __uint_as_float(ab[i][e2] & 0xffff0000u) : __uint_as_float(ab[i][e2] << 16);
                      const float x = hh ? __uint_as_float(gt[i][e2] & 0xffff0000u) : __uint_as_float(gt[i][e2] << 16);
                      const float hsum = (vhf + vaf * cf[e]) + (vhb + vab * cb[e]);
                      const float u = 0.7978845608028654f * (x + 0.044715f * x * x * x); const float th_ = 1.f - 2.f * __builtin_amdgcn_rcpf(1.f + __expf(2.f * u));
                      res[hh] = 0.5f * x * (1.f + th_) * hsum; }
                  o[e2] = pk2(res[0], res[1]); }
              *(u32x4*)(MIX + (r0 + i) * D + 256 + c0) = o; } }
        __syncthreads();
    }
}
}

namespace fft {
__device__ __forceinline__ void ctx_a(LAS unsigned char* lds, const bf16_t* P, const float* TABC, const float* TABS, bf16_t* XCT, int G, int bx) {
    LAS bf16_t* U = (LAS bf16_t*)(lds + O_U); LAS bf16_t* X = (LAS bf16_t*)(lds + O_X);
    for (int unit = bx; unit < 16; unit += G) {
        int tid_l = threadIdx.x; asm volatile("" : "+v"(tid_l));
        const int tid = tid_l, lane = tid & 63, w = __builtin_amdgcn_readfirstlane(tid >> 6), fr = lane & 15, fq = lane >> 4;
        build_tables(lds, TABC, TABS, tid);
        const LAS bf16_t* Tc = (const LAS bf16_t*)(lds + O_TC); const LAS bf16_t* Ts = (const LAS bf16_t*)(lds + O_TS);
        const int b = unit >> 2, q = unit & 3;
#pragma unroll
        for (int i = 0; i < 4; ++i) { const int qq = tid + 512 * i, t1 = qq >> 5, ch = qq & 31;
            *(LAS u32x4*)((LAS unsigned char*)U + t1 * (UP * 2) + ch * 16) = *(const u32x4*)(P + ((size_t)b * NPOS + 64 * q + t1) * PP + ch * 8); }
        __syncthreads();
        { const int g = w >> 1, part = w & 1; const LAS bf16_t* T = part ? Ts : Tc;
          f32x4 acc[4][4];
#pragma unroll
          for (int mt = 0; mt < 4; ++mt)
#pragma unroll
              for (int nt = 0; nt < 4; ++nt) acc[mt][nt] = (f32x4){0.f, 0.f, 0.f, 0.f};
#pragma unroll
          for (int ks = 0; ks < 2; ++ks) { bf16x8 a[4], bb[4];
#pragma unroll
              for (int mt = 0; mt < 4; ++mt) a[mt] = *(const LAS bf16x8*)(U + (16 * mt + fr) * UP + g * 64 + 32 * ks + 8 * fq);
#pragma unroll
              for (int nt = 0; nt < 4; ++nt) bb[nt] = *(const LAS bf16x8*)(T + (16 * nt + fr) * TP + 32 * ks + 8 * fq);
#pragma unroll
              for (int mt = 0; mt < 4; ++mt)
#pragma unroll
                  for (int nt = 0; nt < 4; ++nt) acc[mt][nt] = __builtin_amdgcn_mfma_f32_16x16x32_bf16(a[mt], bb[nt], acc[mt][nt], 0, 0, 0); }
          const float sg = part ? -1.f : 1.f;
#pragma unroll
          for (int mt = 0; mt < 4; ++mt)
#pragma unroll
              for (int nt = 0; nt < 4; ++nt) { const f32x4 v = acc[mt][nt] * sg; u32x2 o; o.x = pk2(v[0], v[1]); o.y = pk2(v[2], v[3]);
                  *(LAS u32x2*)(X + (part * 256 + g * 64 + 16 * nt + fr) * TP + 16 * mt + 4 * fq) = o; } }
        __syncthreads();
#pragma unroll
        for (int i = 0; i < 8; ++i) { const int qq = tid + 512 * i, row = qq >> 3, c8 = qq & 7;
            *(u32x4*)(XCT + (((size_t)b * 4 + q) * 512 + row) * 64 + c8 * 8) = *(const LAS u32x4*)((const LAS unsigned char*)X + row * (TP * 2) + c8 * 16); }
        __syncthreads();
    }
}
__device__ __forceinline__ void ctx_b(LAS unsigned char* lds, const bf16_t* XCT, const float* TABC, const float* TABS, bf16_t* MIX, int G, int bx) {
    LAS bf16_t* Tc = (LAS bf16_t*)(lds + O_TC); LAS bf16_t* Ts = (LAS bf16_t*)(lds + O_TS);
    LAS bf16_t* Ys = (LAS bf16_t*)(lds + O_U); LAS bf16_t* ZT = (LAS bf16_t*)(lds + O_X);
    for (int unit = bx; unit < 16; unit += G) {
        int tid_l = threadIdx.x; asm volatile("" : "+v"(tid_l));
        const int tid = tid_l, lane = tid & 63, w = __builtin_amdgcn_readfirstlane(tid >> 6), fr = lane & 15, fq = lane >> 4;
        const int b = unit >> 2, ft = unit & 3;
        f32x4 y[4][2];
#pragma unroll
        for (int mt = 0; mt < 4; ++mt)
#pragma unroll
            for (int n = 0; n < 2; ++n) y[mt][n] = (f32x4){0.f, 0.f, 0.f, 0.f};
        for (int q = 0; q < 4; ++q) {
            for (int i = tid; i < 4096; i += 512) { const int fl = i >> 6, tl = i & 63, ix = (((64 * ft + fl) * (64 * q + tl)) & 255) * 16; Tc[fl * TP + tl] = f2bf(TABC[ix]); Ts[fl * TP + tl] = f2bf(TABS[ix]); }
#pragma unroll
            for (int i = 0; i < 8; ++i) { const int qq = tid + 512 * i, row = qq >> 3, c8 = qq & 7;
                *(LAS u32x4*)((LAS unsigned char*)ZT + row * (TP * 2) + c8 * 16) = *(const u32x4*)(XCT + (((size_t)b * 4 + q) * 512 + row) * 64 + c8 * 8); }
            __syncthreads();
#pragma unroll
            for (int ks = 0; ks < 2; ++ks) { bf16x8 xr[2], xi[2];
#pragma unroll
                for (int n = 0; n < 2; ++n) { xr[n] = *(const LAS bf16x8*)(ZT + (32 * w + 16 * n + fr) * TP + 32 * ks + 8 * fq); xi[n] = *(const LAS bf16x8*)(ZT + (256 + 32 * w + 16 * n + fr) * TP + 32 * ks + 8 * fq); }
#pragma unroll
                for (int mt = 0; mt < 4; ++mt) { const bf16x8 c = *(const LAS bf16x8*)(Tc + (16 * mt + fr) * TP + 32 * ks + 8 * fq), s = *(const LAS bf16x8*)(Ts + (16 * mt + fr) * TP + 32 * ks + 8 * fq);
#pragma unroll
                    for (int n = 0; n < 2; ++n) { y[mt][n] = __builtin_amdgcn_mfma_f32_16x16x32_bf16(c, xr[n], y[mt][n], 0, 0, 0); y[mt][n] = __builtin_amdgcn_mfma_f32_16x16x32_bf16(s, xi[n], y[mt][n], 0, 0, 0); } } }
            __syncthreads();
        }
#pragma unroll
        for (int mt = 0; mt < 4; ++mt)
#pragma unroll
            for (int i = 0; i < 4; ++i)
#pragma unroll
                for (int n = 0; n < 2; ++n) Ys[(16 * mt + 4 * fq + i) * UP + 32 * w + 16 * n + fr] = f2bf(y[mt][n][i] * (1.f / 128.f));
        __syncthreads();
#pragma unroll
        for (int i = 0; i < 4; ++i) { const int qq = tid + 512 * i, fl = qq >> 5, ch = qq & 31;
            *(u32x4*)(MIX + ((size_t)b * NPOS + 64 * ft + fl) * D + ch * 8) = *(const LAS u32x4*)((const LAS unsigned char*)Ys + fl * (UP * 2) + ch * 16); }
        __syncthreads();
    }
}
}

constexpr int NWAVES = 8, RING_BYTES = 131072 + 3072, LDSCTL_OFF = RING_BYTES, MISC_OFF = LDSCTL_OFF + 64, META_OFF = MISC_OFF + 64, LDS_BYTES = 147456;
enum { PH_PRO0 = 0, PH_PRO1 = 1, PH_L0 = 2, PH_PER_LAYER = 8, PH_N = 18 };
enum { PL_WIN = 0, PL_PREP = 1, PL_MIX = 2, PL_WOUT = 3, PL_ROUTE = 4, PL_MOE1 = 5, PL_MOE2 = 6, PL_COMB = 7 };
struct MArgs { const float* in[30]; float* out; unsigned char* ws; int npass, skip_mask, dup_ph, dup_n, dup_sub, knob; };

__device__ __forceinline__ void transpose_item(const float* W, int K, int N, bf16_t* WT, int drow0, LAS float* scr, int k0, int n0, int lane) {
    const int kr = lane >> 3, nc = (lane & 7) * 4;
    f32x4 v[8];
#pragma unroll
    for (int i = 0; i < 8; ++i) v[i] = __builtin_nontemporal_load((const f32x4*)(W + (size_t)(k0 + kr + 8 * i) * N + n0 + nc));
#pragma unroll
    for (int i = 0; i < 8; ++i) { LAS float* d = scr + (kr + 8 * i) * 33 + nc; d[0] = v[i][0]; d[1] = v[i][1]; d[2] = v[i][2]; d[3] = v[i][3]; }
    asm volatile("s_waitcnt lgkmcnt(0)" ::: "memory");
    const int c = lane & 7;
#pragma unroll
    for (int j = 0; j < 4; ++j) { const int n = (lane >> 3) + 8 * j; const LAS float* s = scr + (8 * c) * 33 + n;
        u32x4 o; o.x = pk2(s[0 * 33], s[1 * 33]); o.y = pk2(s[2 * 33], s[3 * 33]); o.z = pk2(s[4 * 33], s[5 * 33]); o.w = pk2(s[6 * 33], s[7 * 33]);
        *(u32x4*)(WT + (size_t)(drow0 + n) * K + k0 + 8 * c) = o; }
    asm volatile("s_waitcnt lgkmcnt(0)" ::: "memory");
}

constexpr int I_GU = NE * 16 * 64, I_DN = NE * 16 * 32, I_EXP = I_GU + I_DN;
__device__ __forceinline__ void expert_item(int l, int j, const float* wgu, const float* wdn, unsigned char* ws, LAS float* scr, int lane) {
    if (j < I_GU) { const int e = j / (16 * 64), q = j % (16 * 64), kb = q / 64, nb = q % 64; const int n0 = 32 * nb; const int c2 = n0 & 1023; const int drow = (c2 >> 7) * 256 + (n0 >> 10) * 128 + (c2 & 127);
        transpose_item(wgu + ((size_t)l * NE + e) * D * 2048, D, 2048, (bf16_t*)(ws + L::WGUT) + ((size_t)l * NE + e) * 2048 * D, drow, scr, 64 * kb, n0, lane); }
    else { const int r = j - I_GU; const int e = r / (16 * 32), q = r % (16 * 32), kb = q / 32, nb = q % 32;
        transpose_item(wdn + ((size_t)l * NE + e) * D * D, D, D, (bf16_t*)(ws + L::WDT) + ((size_t)l * NE + e) * D * D, 32 * nb, scr, 64 * kb, 32 * nb, lane); }
}
constexpr int Q_WIN = 48, Q_WOUT = 96, Q_MOE2 = 0;
constexpr int DEF_WIN = 224 * Q_WIN, DEF0 = DEF_WIN + 240 * Q_WOUT, DEF_MOE2 = 128 * Q_MOE2, DEF1 = DEF_MOE2 + 224 * Q_WIN;
__device__ __forceinline__ void deferred_items(int l, int first, int count, const float* wgu, const float* wdn, unsigned char* ws, LAS unsigned char* lds, int wave, int lane) {
    LAS float* scr = (LAS float*)(lds + wave * 16384);
    for (int j = first + wave; j < first + count; j += NWAVES) expert_item(l, j, wgu, wdn, ws, scr, lane);
}

#define GASP __attribute__((address_space(1)))
#define ARG_IN(i) ({ const GASP float* _p; asm volatile("s_load_dwordx2 %0, %1, %2\n\ts_waitcnt lgkmcnt(0)" : "=s"(_p) : "s"(__builtin_amdgcn_kernarg_segment_ptr()), "n"((i) * 8)); (const float*)_p; })
__global__ void __launch_bounds__(NWAVES * 64, 2) mega(MArgs args) {
    extern __shared__ __attribute__((aligned(16))) unsigned char lds_raw[];
    const int G0 = gridDim.x, bx0 = blockIdx.x;
    unsigned char* ws0 = args.ws;
    unsigned* ctl0 = (unsigned*)(ws0 + L::CTL);
    for (int u = threadIdx.x; u < (LDS_BYTES - LDSCTL_OFF) / 4; u += NWAVES * 64) ((LAS unsigned*)(lds_raw + LDSCTL_OFF))[u] = 0u;
    __syncthreads();
    volatile LAS unsigned* MISC = (volatile LAS unsigned*)((LAS unsigned char*)lds_raw + MISC_OFF);
    XcdBarrier bar = xcd_barrier_post(ctl0 + L::CW_BAR, MISC);
    const int lo = 0, hi = PH_N;

    bool first = true;
    for (int pass = 0; pass < args.npass; ++pass)
    for (int ph = lo; ph < hi; ++ph) {
      const int reps = (ph == args.dup_ph) ? 1 + args.dup_n : 1;
      if (ph == PH_PRO1) continue;
      for (int rep = 0; rep < reps; ++rep) {
        if (!first) xcd_barrier(bar);
        first = false;
        if (pass + 1 < args.npass && ((args.skip_mask >> ph) & 1)) continue;
        const int sub = rep + 1 < reps ? args.dup_sub : 15; const int knob = rep + 1 < reps ? args.knob : 0; (void)knob;
        GASP unsigned char* wsg = (GASP unsigned char*)args.ws; asm volatile("" : "+s"(wsg)); unsigned char* ws = (unsigned char*)wsg;
        unsigned* ctl = (unsigned*)(ws + L::CTL);
        int tid_p = threadIdx.x; asm volatile("" : "+v"(tid_p));
        int G = G0, bx = bx0; asm volatile("" : "+s"(G), "+s"(bx));
        const int vcu = (G % 8 == 0) ? (bx % 8) * (G / 8) + bx / 8 : bx; (void)vcu;
        unsigned ldsb = 0; asm volatile("" : "+s"(ldsb)); LAS unsigned char* lds = (LAS unsigned char*)lds_raw + ldsb;
        LAS int* META = (LAS int*)(lds + META_OFF);
        const int tid = tid_p, lane = tid & 63, wave = __builtin_amdgcn_readfirstlane(tid >> 6); (void)lane; (void)wave;
        if (ph == PH_PRO0) {
            if (bx == 0 && tid < 2 * NE) ((int*)(ctl + L::CW_CNT))[tid * L::CNT_STRIDE] = 0;
            sm::smallw_phase(ARG_IN(17), ARG_IN(16), ARG_IN(19), ARG_IN(18), ARG_IN(11), ARG_IN(13), (bf16_t*)(ws + L::WUQT), (bf16_t*)(ws + L::WUKVT), (bf16_t*)(ws + L::WAT), (bf16_t*)(ws + L::WIT),
                             (float*)(ws + L::TABC), (float*)(ws + L::TABS), ARG_IN(15), (float*)(ws + L::SPT), ARG_IN(23), (bf16_t*)(ws + L::RWH), (bf16_t*)(ws + L::RWL), bx * 512 + tid, G * 512);
            __syncthreads();
            sm::mod_phase(lds, ARG_IN(1), ARG_IN(3), ARG_IN(4), ARG_IN(5), (float*)(ws + L::MOD), G, bx, tid);
            { int nmine = 0; for (int u = bx; u < 96; u += G) ++nmine;
              if (nmine) { asm volatile("s_waitcnt vmcnt(0)" ::: "memory"); __syncthreads();
                  if (tid == 0) { __builtin_amdgcn_fence(__ATOMIC_RELEASE, "agent"); asm volatile("s_waitcnt vmcnt(0)" ::: "memory"); __hip_atomic_fetch_add(ctl + L::CW_MODCNT, (unsigned)nmine, __ATOMIC_RELAXED, __HIP_MEMORY_SCOPE_AGENT); } } }
            __syncthreads();
            LAS float* scr = (LAS float*)(lds + wave * 16384);
            const int gw = vcu * NWAVES + wave, NGW = G * NWAVES;
            constexpr int I_IN = 16 * 61, I_OUT = 16 * 32, I_D = I_IN + I_OUT; const int d0 = G == 256 ? DEF0 : 0, d1 = G == 256 ? DEF1 : 0, R0 = I_EXP - d0, R1 = I_EXP - d1;
            for (int it = gw; it < 2 * I_D + R0 + R1; it += NGW) {
                if (it < 2 * I_D) { const int l = it / I_D; int r = it % I_D;
                    if (r < I_IN) { const int kb = r / 61, nb = r % 61; transpose_item(ARG_IN(8) + (size_t)l * D * PT, D, PT, (bf16_t*)(ws + L::WINT) + (size_t)l * 2048 * D, 32 * nb, scr, 64 * kb, 32 * nb, lane); }
                    else { r -= I_IN; const int kb = r / 32, nb = r % 32; transpose_item(ARG_IN(22) + (size_t)l * D * D, D, D, (bf16_t*)(ws + L::WOUTT) + (size_t)l * D * D, 32 * nb, scr, 64 * kb, 32 * nb, lane); }
                } else { const int r = it - 2 * I_D; if (r < R0) expert_item(0, d0 + r, ARG_IN(25), ARG_IN(27), ws, scr, lane); else expert_item(1, d1 + (r - R0), ARG_IN(25), ARG_IN(27), ws, scr, lane); }
            }
            for (int i = bx * 512 + tid; i < 2 * 96 * D / 8; i += G * 512) { const int l = i / (96 * D / 8), q = i % (96 * D / 8); *(u32x4*)((bf16_t*)(ws + L::WINT) + ((size_t)l * 2048 + PT) * D + (size_t)q * 8) = (u32x4){0u, 0u, 0u, 0u}; }
            if (tid == 0) { unsigned sp = 0; while (__hip_atomic_load(ctl + L::CW_MODCNT, __ATOMIC_RELAXED, __HIP_MEMORY_SCOPE_AGENT) < 96u && ++sp < (1u << 22)) __builtin_amdgcn_s_sleep(2);
                __builtin_amdgcn_fence(__ATOMIC_ACQUIRE, "agent"); asm volatile("s_waitcnt vmcnt(0)" ::: "memory"); }
            __syncthreads();
            { const int nmod = G < 96 ? G : 96; const int small = 45, rs0 = bx < nmod ? bx * small : nmod * small + (int)(((long)(bx - nmod) * (MROWS - nmod * small)) / (G - nmod)),
                  rs1 = bx + 1 < nmod ? (bx + 1) * small : (bx + 1 >= G ? MROWS : nmod * small + (int)(((long)(bx + 1 - nmod) * (MROWS - nmod * small)) / (G - nmod)));
              sm::pro1_phase(ARG_IN(0), ARG_IN(2), ARG_IN(6), (const float*)(ws + L::MOD), (float*)(ws + L::H), (bf16_t*)(ws + L::XN), rs0 + wave, rs1, NWAVES, lane); }
            continue;
        }
        if (ph < PH_L0) continue;
        const int l = (ph - PH_L0) / PH_PER_LAYER, pl = (ph - PH_L0) % PH_PER_LAYER;
        const float* MODl = (const float*)(ws + L::MOD) + (size_t)l * 5 * 6144;
        if (pl == PL_WIN) {
            g8::DenseSched S; S.init(MROWS / 256, PP / 256, G, bx, 0, (const bf16_t*)(ws + L::WINT) + (size_t)l * 2048 * D, D);
            g8::EpiP E{(bf16_t*)(ws + L::P)};
            g8::gemm_phase<g8::EpiP, g8::DenseSched, false, false>(lds, (const char*)(ws + L::XN), S, E);
            if (G == 256 && bx >= 32) deferred_items(l, (l == 0 ? 0 : DEF_MOE2) + (bx - 32) * Q_WIN, Q_WIN, ARG_IN(25), ARG_IN(27), ws, lds, wave, lane);
        } else if (pl == PL_PREP) {
            if (l == 0 && (sub & 2)) { fft::ctx_a(lds, (const bf16_t*)(ws + L::P), (const float*)(ws + L::TABC), (const float*)(ws + L::TABS), (bf16_t*)(ws + L::XCT), G, G - 1 - bx); __syncthreads(); }
            for (int p = 0; p * G < 1072; ++p) {
                const int k = p * G + ((p & 1) ? G - 1 - bx : bx);
                if (k >= 1072) continue;
                if (k < 272) { if (sub & 4) prep::qkv_units(lds, l, (const bf16_t*)(ws + L::P), (const bf16_t*)(ws + L::WUQT), (const bf16_t*)(ws + L::WUKVT), ARG_IN(20) + l * 768, ARG_IN(21) + l * 256,
                            (bf16_t*)(ws + L::QL), (bf16_t*)(ws + L::QC), (bf16_t*)(ws + L::KB), (bf16_t*)(ws + L::VTG), (bf16_t*)(ws + L::MIX), k, k + 1, 1); }
                else if (k < 816) { if (sub & 8) lru::chunk_units(lds, l, (const bf16_t*)(ws + L::P), ARG_IN(9), ARG_IN(10), (const bf16_t*)(ws + L::WAT), (const bf16_t*)(ws + L::WIT), ARG_IN(12), ARG_IN(14), (const float*)(ws + L::SPT),
                             (bf16_t*)(ws + L::HL), (bf16_t*)(ws + L::AC), (float*)(ws + L::SUM), k - 272, k - 271, 1, knob); }
                else { if (sub & 1) fft::stage_a(lds, (const bf16_t*)(ws + L::P), (const float*)(ws + L::TABC), (const float*)(ws + L::TABS), (bf16_t*)(ws + L::ZBUF), k - 816, k - 815, 1); }
                __syncthreads();
            }
        } else if (pl == PL_MIX) {
            if (sub & 1) lru::fixup_units(lds, l, (const bf16_t*)(ws + L::P), (const bf16_t*)(ws + L::HL), (const bf16_t*)(ws + L::AC), (const float*)(ws + L::SUM), (bf16_t*)(ws + L::MIX), G, bx);
            if (sub & 2) fft::stage_b(lds, (const bf16_t*)(ws + L::ZBUF), (const float*)(ws + L::TABC), (const float*)(ws + L::TABS), (bf16_t*)(ws + L::MIX), G, bx);
            __syncthreads();
            if (l == 0 && (sub & 4)) { fft::ctx_b(lds, (const bf16_t*)(ws + L::XCT), (const float*)(ws + L::TABC), (const float*)(ws + L::TABS), (bf16_t*)(ws + L::MIX), G, G - 1 - bx); __syncthreads(); }
            if (sub & 8) attn::attn_phase(lds, (const bf16_t*)(ws + L::QL), (const bf16_t*)(ws + L::QC), (const bf16_t*)(ws + L::KB), (const bf16_t*)(ws + L::VTG), (bf16_t*)(ws + L::MIX), l == 0 ? 1 : 0, G, vcu);
        } else if (pl == PL_WOUT) {
            g8::DenseSched S; S.init(l == 0 ? MROWS / 256 : 64, D / 256, G, bx, l == 0 ? 0 : 1, (const bf16_t*)(ws + L::WOUTT) + (size_t)l * D * D, D);
            g8::EpiH E{(float*)(ws + L::H), MODl, 2048};
            g8::gemm_phase<g8::EpiH, g8::DenseSched, false, false>(lds, (const char*)(ws + L::MIX), S, E);
            if (G == 256 && l == 0 && bx >= 16) deferred_items(0, DEF_WIN + (bx - 16) * Q_WOUT, Q_WOUT, ARG_IN(25), ARG_IN(27), ws, lds, wave, lane);
        } else if (pl == PL_ROUTE) {
            sm::route_phase(lds, l, (const float*)(ws + L::H), ARG_IN(7) + l * D, MODl, (const bf16_t*)(ws + L::RWH), (const bf16_t*)(ws + L::RWL), ARG_IN(24) + l * NE, (bf16_t*)(ws + L::XN), (int*)(ctl + L::CW_CNT) + l * NE * L::CNT_STRIDE,
                            (int*)(ws + L::LIST) + (size_t)l * NE * LCAP, (float*)(ws + L::GATE), G, bx, tid);
        } else if (pl == PL_COMB) {
            sm::comb_phase(l, (float*)(ws + L::H), (const bf16_t*)(ws + L::Y), MODl, ARG_IN(6) + D, (const float*)(ws + L::MOD) + (size_t)5 * 6144, (bf16_t*)(ws + L::XN), ARG_IN(29), args.out, bx * NWAVES + wave, G * NWAVES, lane);
        } else if (pl == PL_MOE1 || pl == PL_MOE2) {
            const int* CNTg = (const int*)(ctl + L::CW_CNT) + l * NE * L::CNT_STRIDE;
            if (tid == 0) { int o = 0; for (int e = 0; e < NE; ++e) { const int cn = CNTg[e * L::CNT_STRIDE]; META[e] = o; META[64 + e] = cn; o += (cn + 255) >> 8; } META[NE] = o; }
            __syncthreads();
            g8::MoeSched S; S.tpre = META; S.cnt = META + 64; S.G = G; S.c = bx; S.K = D; S.list = (const int*)(ws + L::LIST) + (size_t)l * NE * LCAP;
            if (pl == PL_MOE1) {
                S.NT = 8; S.COLW = 128; S.total = __builtin_amdgcn_readfirstlane(META[NE]) * 8; S.Bt = (const char*)((const bf16_t*)(ws + L::WGUT) + (size_t)l * NE * 2048 * D);
                g8::EpiMoe1 E{(bf16_t*)(ws + L::ACT), ARG_IN(26) + (size_t)l * NE * 2048};
                g8::gemm_phase<g8::EpiMoe1, g8::MoeSched, true, true>(lds, (const char*)(ws + L::XN), S, E);
            } else {
                S.NT = 4; S.COLW = 256; S.total = __builtin_amdgcn_readfirstlane(META[NE]) * 4; S.Bt = (const char*)((const bf16_t*)(ws + L::WDT) + (size_t)l * NE * D * D);
                g8::EpiMoe2 E{(bf16_t*)(ws + L::Y), ARG_IN(28) + (size_t)l * NE * D, (const float*)(ws + L::GATE)};
                g8::gemm_phase<g8::EpiMoe2, g8::MoeSched, false, true>(lds, (const char*)(ws + L::ACT), S, E);
                if (G == 256 && l == 0 && bx >= 128) deferred_items(1, (bx - 128) * Q_MOE2, Q_MOE2, ARG_IN(25), ARG_IN(27), ws, lds, wave, lane);
            }
            __syncthreads();
        }
      }
    }
}
constexpr int PROBE_DUP_PH = -1, PROBE_DUP_N = 0, PROBE_DUP_SUB = 15, PROBE_KNOB = 0;
constexpr int PROBE_NPASS = 1, PROBE_SKIP = 0;
extern "C" void kernel_launch(void* const* d_in, const int* in_sizes, int n_in, void* d_out, int out_size, void* d_ws, size_t ws_size, hipStream_t stream) {
    static int grid = 0;
    if (grid == 0) {
        if (n_in != 30 || out_size != NB_ * SEQ * D || (size_t)L::END > ws_size) { fprintf(stderr, "kernel_launch: unexpected problem shape (n_in %d, out %d) or workspace too small (need %zu, have %zu); nothing launched\n", n_in, out_size, (size_t)L::END, ws_size); grid = -1; return; }
        int dev = 0, cus = 0;
        if (hipGetDevice(&dev) != hipSuccess || hipDeviceGetAttribute(&cus, hipDeviceAttributeMultiprocessorCount, dev) != hipSuccess) { fprintf(stderr, "kernel_launch: device query failed\n"); grid = -1; return; }
        if (hipFuncSetAttribute((const void*)mega, hipFuncAttributeMaxDynamicSharedMemorySize, LDS_BYTES) != hipSuccess) { fprintf(stderr, "kernel_launch: hipFuncSetAttribute failed\n"); grid = -1; return; }
        int per_cu = 0;
        if (hipOccupancyMaxActiveBlocksPerMultiprocessor(&per_cu, (const void*)mega, NWAVES * 64, LDS_BYTES) != hipSuccess || per_cu < 1) fprintf(stderr, "kernel_launch: note: the occupancy query reports %d workgroups per CU; launching one per CU anyway\n", per_cu);
        (void)hipGetLastError();
        grid = cus < 256 ? cus : 256;
    }
    if (grid < 0) return;
    unsigned char* p = (unsigned char*)d_ws;
    (void)hipMemsetAsync(p + L::CTL, 0, L::CTL_BYTES, stream);
    MArgs a{};
    for (int i = 0; i < 30; ++i) a.in[i] = (const float*)d_in[i];
    a.out = (float*)d_out; a.ws = p; a.npass = PROBE_NPASS; a.skip_mask = PROBE_SKIP; a.dup_ph = PROBE_DUP_PH; a.dup_n = PROBE_DUP_N; a.dup_sub = PROBE_DUP_SUB; a.knob = PROBE_KNOB;
    hipLaunchKernelGGL(mega, dim3(grid), dim3(NWAVES * 64), LDS_BYTES, stream, a);
}
```

```cpp
#include <hip/hip_runtime.h>
#include <cstdint>
#include <cstdio>

typedef unsigned short bf16_t;
constexpr int NB_ = 4, SEQ = 4096, CTX = 256, D = 1024, NPOS = SEQ + CTX, MROWS = NB_ * NPOS;
constexpr int PT = 1952, PP = 2048;
constexpr int NE = 32, TOPK = 4, LCAP = MROWS;
constexpr int NASG = MROWS * TOPK;
constexpr int ACT_ROWS = NASG + NE * 256;
constexpr int C_FN = 0, C_LX = 256, C_LG = 512, C_CQ = 768, C_CKV = 1024, C_KR = 1152, C_SX = 1184, C_SB = 1440, C_SC = 1696;

__device__ __forceinline__ float bf2f(bf16_t v) { return __uint_as_float((unsigned)v << 16); }
typedef float cv_f2 __attribute__((ext_vector_type(2))); typedef __bf16 cv_b2 __attribute__((ext_vector_type(2)));
__device__ __forceinline__ unsigned pk2(float lo, float hi) { cv_f2 v = {lo, hi}; return __builtin_bit_cast(unsigned, __builtin_convertvector(v, cv_b2)); }
__device__ __forceinline__ bf16_t f2bf(float f) { return (bf16_t)pk2(f, 0.f); }
__device__ __forceinline__ float wave_sum(float v) {
#pragma unroll
    for (int o = 1; o < 64; o <<= 1) v += __shfl_xor(v, o);
    return v;
}
__device__ __forceinline__ float sigmoidf_(float x) { return 1.f / (1.f + __expf(-x)); }
__device__ __forceinline__ float gelu_tanh(float x) { const float u = 0.7978845608028654f * (x + 0.044715f * x * x * x); return 0.5f * x * (1.f + tanhf(u)); }

#define LAS __attribute__((address_space(3)))
typedef short bf16x8 __attribute__((ext_vector_type(8)));
typedef float f32x4 __attribute__((ext_vector_type(4)));
typedef unsigned u32x4 __attribute__((ext_vector_type(4)));
typedef unsigned u32x2 __attribute__((ext_vector_type(2)));

namespace L {
constexpr size_t A256(size_t x) { return (x + 255) & ~(size_t)255; }
constexpr size_t CTL = 0, CTL_BYTES = 1u << 20;
constexpr size_t H = CTL + CTL_BYTES;
constexpr size_t MOD = CTL + 512 * 1024;
constexpr size_t TABC = A256(H + (size_t)MROWS * D * 4);
constexpr size_t TABS = A256(TABC + 4096 * 4);
constexpr size_t XN = A256(TABS + 4096 * 4);
constexpr size_t P = A256(XN + (size_t)MROWS * D * 2);
constexpr size_t MIX = A256(P + (size_t)MROWS * PP * 2);
constexpr size_t CQN = A256(MIX + (size_t)MROWS * D * 2);
constexpr size_t CKVN = A256(CQN + (size_t)MROWS * 256 * 2);
constexpr size_t QRAW = A256(CKVN + (size_t)MROWS * 128 * 2);
constexpr size_t KVRAW = A256(QRAW + (size_t)MROWS * 384 * 4);
constexpr size_t QL = A256(KVRAW + (size_t)MROWS * 512 * 4);
constexpr size_t QC = A256(QL + (size_t)16 * SEQ * 96 * 2);
constexpr size_t KB = A256(QC + (size_t)16 * CTX * 96 * 2);
constexpr size_t VB = A256(KB + (size_t)16 * NPOS * 96 * 2);
constexpr size_t LA = A256(VB + (size_t)16 * NPOS * 64 * 2);
constexpr size_t LB = A256(LA + (size_t)2 * MROWS * 256 * 4);
constexpr size_t HS = A256(LB + (size_t)2 * MROWS * 256 * 4);
constexpr size_t XCS = A256(HS + (size_t)2 * MROWS * 256 * 4);
constexpr size_t XCSC = A256(XCS + (size_t)4 * 8192 * 256 * 4);
constexpr size_t LIST = A256(XCSC + (size_t)4 * 512 * 256 * 4);
constexpr size_t GATE = A256(LIST + (size_t)2 * NE * LCAP * 4);
constexpr size_t ACT = A256(GATE + (size_t)NASG * 4);
constexpr size_t Y = A256(ACT + (size_t)ACT_ROWS * D * 2);
constexpr size_t WINT = A256(Y + (size_t)(NASG + 1) * D * 2);
constexpr size_t WOUTT = A256(WINT + (size_t)2 * 2048 * 1024 * 2);
constexpr size_t WGUT = A256(WOUTT + (size_t)2 * 1024 * 1024 * 2);
constexpr size_t WDT = A256(WGUT + (size_t)2 * NE * 2048 * 1024 * 2);
constexpr size_t ZBUF = A256(WDT + (size_t)2 * NE * 1024 * 1024 * 2);
constexpr size_t VTG = A256(ZBUF + (size_t)4 * 64 * 64 * 512 * 2);
constexpr size_t WUQT = A256(VTG + (size_t)16 * 64 * NPOS * 2);
constexpr size_t WUKVT = A256(WUQT + (size_t)2 * 384 * 256 * 2);
constexpr size_t WAT = A256(WUKVT + (size_t)2 * 512 * 128 * 2);
constexpr size_t WIT = A256(WAT + (size_t)16 * 4096 * 2);
constexpr size_t SPT = A256(WIT + (size_t)16 * 4096 * 2);
constexpr size_t RWH = A256(SPT + (size_t)1024 * 4);
constexpr size_t RWL = A256(RWH + (size_t)2 * NE * D * 2);
constexpr size_t HL = A256(RWL + (size_t)2 * NE * D * 2);
constexpr size_t AC = A256(HL + (size_t)2 * MROWS * 256 * 2);
constexpr size_t SUM = A256(AC + (size_t)2 * MROWS * 256 * 2);
constexpr size_t XCT = A256(SUM + (size_t)2 * 4 * 68 * 512 * 4);
constexpr size_t END = A256(XCT + (size_t)16 * 512 * 64 * 2);
constexpr int CW_BAR = 4096;
constexpr int CW_MODCNT = 2048;
constexpr int CW_CNT = 32768, CNT_STRIDE = 64;
}

#define XB_TMO      128
#define XB_XCNT(j)  (256  + 64 * (j))
#define XB_XSUB(j)  (1280 + 64 * (j))
#define XB_XGEN(j)  (2304 + 64 * (j))
#define XB_TOP      3328
#define XB_TOPGEN   3392
#define XCD_BAR_WORDS 3456
#define XB_SPIN_CAP (1u << 18)
__device__ __forceinline__ unsigned xb_ld(unsigned* p)              { return __hip_atomic_load(p, __ATOMIC_RELAXED, __HIP_MEMORY_SCOPE_AGENT); }
__device__ __forceinline__ unsigned xb_add(unsigned* p, unsigned v) { return __hip_atomic_fetch_add(p, v, __ATOMIC_RELAXED, __HIP_MEMORY_SCOPE_AGENT); }
__device__ __forceinline__ unsigned xb_xcc_id() { return (unsigned)__builtin_amdgcn_s_getreg((3 << 11) | 20) & 0xFu; }
#define XB_SPIN(cond, bar) do { unsigned _sp = 0; while (cond) { __builtin_amdgcn_s_sleep(1); \
    if ((++_sp & 255u) == 0u) { if (xb_ld(&(bar)[XB_TMO])) break; if (_sp > XB_SPIN_CAP) { atomicAdd(&(bar)[XB_TMO], 1u); break; } } } } while (0)
struct XcdBarrier { unsigned* bar; unsigned x; volatile LAS unsigned* st; };
__device__ __forceinline__ XcdBarrier xcd_barrier_post(unsigned* bar, volatile LAS unsigned* st) {
    XcdBarrier b; b.bar = bar; b.x = xb_xcc_id(); b.st = st;
    if (threadIdx.x == 0) (void)xb_add(&bar[XB_XCNT(b.x)], 1u);
    return b;
}
__device__ __forceinline__ void xcd_barrier_complete(unsigned* bar, unsigned x, unsigned& nloc, unsigned& nx) {
    const unsigned G = gridDim.x * gridDim.y * gridDim.z;
    unsigned sum, cnt, mine, sp = 0u;
    for (;;) {
        sum = 0u; cnt = 0u; mine = 0u;
#pragma unroll
        for (unsigned j = 0; j < 16; ++j) { const unsigned c = xb_ld(&bar[XB_XCNT(j)]); sum += c; cnt += (c > 0u) ? 1u : 0u; mine = (j == x) ? c : mine; }
        if (sum == G) break;
        __builtin_amdgcn_s_sleep(1);
        if ((++sp & 255u) == 0u) { if (xb_ld(&bar[XB_TMO])) break; if (sp > XB_SPIN_CAP) { atomicAdd(&bar[XB_TMO], 1u); break; } }
    }
    nloc = mine > 0u ? mine : 1u; nx = cnt > 0u ? cnt : 1u;
}
__device__ __forceinline__ void xcd_barrier(const XcdBarrier& b) {
    asm volatile("s_waitcnt vmcnt(0)" ::: "memory");
    __syncthreads();
    if (threadIdx.x == 0) {
        unsigned* bar = b.bar;
        __builtin_amdgcn_s_waitcnt(0);
        unsigned nloc = b.st[0], nx = b.st[1];
        if (nloc == 0u) { xcd_barrier_complete(bar, b.x, nloc, nx); b.st[0] = nloc; b.st[1] = nx; }
        const unsigned old = xb_add(&bar[XB_XSUB(b.x)], 1u);
        const unsigned gen = old / nloc;
        if (old + 1u == (gen + 1u) * nloc) {
            __builtin_amdgcn_fence(__ATOMIC_RELEASE, "agent");
            asm volatile("s_waitcnt vmcnt(0)" ::: "memory");
            const unsigned og = xb_add(&bar[XB_TOP], 1u);
            const unsigned tg = og / nx;
            if (og + 1u == (tg + 1u) * nx) xb_add(&bar[XB_TOPGEN], 1u);
            else XB_SPIN(xb_ld(&bar[XB_TOPGEN]) == tg, bar);
            __builtin_amdgcn_fence(__ATOMIC_ACQUIRE, "agent");
            xb_add(&bar[XB_XGEN(b.x)], 1u);
            asm volatile("s_waitcnt vmcnt(0)" ::: "memory");
        } else {
            XB_SPIN(xb_ld(&bar[XB_XGEN(b.x)]) == gen, bar);
            __builtin_amdgcn_fence(__ATOMIC_ACQUIRE, "agent");
            asm volatile("s_waitcnt vmcnt(0)" ::: "memory");
        }
    }
    __syncthreads();
}

namespace g8 {
constexpr int BM = 256, BK = 64, HALF = 128, HTB = HALF * BK * 2, STAGE_BYTES = 8 * HTB, NXCD = 8, WGM = 8;
__device__ __forceinline__ int lds_byte(int r, int c) { const int st = (r >> 4) * 2 + (c >> 5), rr = r & 15, cc = c & 31, ob = rr * 64 + cc * 2; return st * 1024 + (ob ^ (((ob >> 9) & 1) << 5)); }
__device__ __forceinline__ void stage_rc(int b, int& R, int& C) { const int st = b / 1024, sb = b % 1024, swz = sb ^ (((sb >> 9) & 1) << 5); R = (st >> 1) * 16 + swz / 64; C = (st & 1) * 32 + (swz % 64) / 2; }
__device__ __forceinline__ int perm32(int rho) { const int n = rho >> 4, i = rho & 15; return 8 * (i >> 2) + 4 * n + (i & 3); }
__device__ __forceinline__ unsigned cvt_pk_bf16(float lo, float hi) { return pk2(lo, hi); }
__device__ __forceinline__ int xcd_remap(int wgid, int nwg) { const int q = nwg / NXCD, r = nwg % NXCD, xcd = wgid % NXCD, off = wgid / NXCD; return (xcd < r ? xcd * (q + 1) : r * (q + 1) + (xcd - r) * q) + off; }

struct Unit { int row0, col0, ex, bt, nvalid, lrow; };

struct DenseSched {
    int nM, nN, nwg, G, c, lat_only; const char* Bt; int K; const int* list;
    __device__ __forceinline__ void init(int nM_, int nN_, int G_, int c_, int lat_only_, const void* Bt_, int K_) { nM = nM_; nN = nN_; nwg = nM * nN; G = G_; c = c_; lat_only = lat_only_; Bt = (const char*)Bt_; K = K_; list = nullptr; }
    __device__ __forceinline__ bool next(int i, Unit& u) const {
        const long Lx = (long)i * G + c; if (Lx >= nwg) return false;
        const int wgid = xcd_remap((int)Lx, nwg);
        const int nig = WGM * nN, gid = wgid / nig, fm = gid * WGM, gsz = (nM - fm) < WGM ? (nM - fm) : WGM;
        const int pm = fm + ((wgid % nig) % gsz), pn = (wgid % nig) / gsz;
        const int tile = lat_only ? (pm / 16) * 17 + 1 + (pm % 16) : pm;
        u.row0 = tile * 256; u.col0 = pn * 256; u.ex = 0; u.bt = pn; u.nvalid = 256; u.lrow = 0; return true;
    }
    __device__ __forceinline__ const char* bptr(const Unit& u) const { return Bt + (size_t)u.bt * (256 * 1024 * 2); }
};
struct MoeSched {
    const LAS int* tpre; const LAS int* cnt; int NT, COLW, G, c, total; const char* Bt; int K; const int* list;
    __device__ __forceinline__ bool next(int i, Unit& u) const {
        const long Lx = (long)i * G + c; if (Lx >= total) return false;
        const int wgid = xcd_remap((int)Lx, total);
        int e = 0;
        for (int j = 1; j < NE; ++j) if (tpre[j] * NT <= wgid) e = j;
        const int t0 = tpre[e], mte = tpre[e + 1] - t0, loc = wgid - t0 * NT, nt = loc / mte, mt = loc % mte;
        u.ex = __builtin_amdgcn_readfirstlane(e); u.row0 = __builtin_amdgcn_readfirstlane((t0 + mt) * 256); u.col0 = __builtin_amdgcn_readfirstlane(nt * COLW);
        u.bt = __builtin_amdgcn_readfirstlane(e * NT + nt); const int nv = cnt[e] - mt * 256; u.nvalid = __builtin_amdgcn_readfirstlane(nv < 256 ? nv : 256); u.lrow = __builtin_amdgcn_readfirstlane(mt * 256);
        return true;
    }
    __device__ __forceinline__ const char* bptr(const Unit& u) const { return Bt + (size_t)u.bt * (256 * 1024 * 2); }
};

struct EpiP {
    static constexpr bool PERM = true; bf16_t* O;
    __device__ __forceinline__ void operator()(const f32x4 (&acc)[2][2][4][2], const Unit& u, int wr, int wc, int fr, int fq, const LAS int*) const {
#pragma unroll
        for (int ai = 0; ai < 2; ++ai)
#pragma unroll
            for (int m = 0; m < 4; ++m) { bf16_t* rowp = O + (size_t)(u.row0 + ai * HALF + wr * 64 + m * 16 + fr) * PP + u.col0 + wc * 32 + 8 * fq;
#pragma unroll
                for (int bj = 0; bj < 2; ++bj) { const f32x4 v0 = acc[ai][bj][m][0], v1 = acc[ai][bj][m][1]; u32x4 w; w.x = cvt_pk_bf16(v0[0], v0[1]); w.y = cvt_pk_bf16(v0[2], v0[3]); w.z = cvt_pk_bf16(v1[0], v1[1]); w.w = cvt_pk_bf16(v1[2], v1[3]);
                    *(u32x4*)(rowp + bj * HALF) = w; } }
    }
};
struct EpiH {
    static constexpr bool PERM = false; float* Hh; const float* MODl; int g_off;
    __device__ __forceinline__ void operator()(const f32x4 (&acc)[2][2][4][2], const Unit& u, int wr, int wc, int fr, int fq, const LAS int*) const {
        const int tile = u.row0 >> 8, v = (tile % 17 == 0) ? 4 : tile / 17; const float* gp = MODl + (size_t)v * 6144 + g_off + u.col0 + wc * 32 + 4 * fq;
        f32x4 gv[2][2];
#pragma unroll
        for (int bj = 0; bj < 2; ++bj)
#pragma unroll
            for (int n = 0; n < 2; ++n) gv[bj][n] = *(const f32x4*)(gp + bj * HALF + n * 16);
#pragma unroll
        for (int ai = 0; ai < 2; ++ai)
#pragma unroll
          for (int mp = 0; mp < 2; ++mp) {
            f32x4 hv[2][2][2];
#pragma unroll
            for (int m2 = 0; m2 < 2; ++m2) { const float* rowp = Hh + (size_t)(u.row0 + ai * HALF + wr * 64 + (2 * mp + m2) * 16 + fr) * D + u.col0 + wc * 32 + 4 * fq;
#pragma unroll
                for (int bj = 0; bj < 2; ++bj)
#pragma unroll
                    for (int n = 0; n < 2; ++n) hv[m2][bj][n] = *(const f32x4*)(rowp + bj * HALF + n * 16); }
#pragma unroll
            for (int m2 = 0; m2 < 2; ++m2) { float* rowp = Hh + (size_t)(u.row0 + ai * HALF + wr * 64 + (2 * mp + m2) * 16 + fr) * D + u.col0 + wc * 32 + 4 * fq;
#pragma unroll
                for (int bj = 0; bj < 2; ++bj)
#pragma unroll
                    for (int n = 0; n < 2; ++n) *(f32x4*)(rowp + bj * HALF + n * 16) = hv[m2][bj][n] + gv[bj][n] * acc[ai][bj][2 * mp + m2][n]; }
          }
    }
};
struct EpiMoe1 {
    static constexpr bool PERM = true; bf16_t* ACTp; const float* bgu;
    __device__ __forceinline__ void operator()(const f32x4 (&acc)[2][2][4][2], const Unit& u, int wr, int wc, int fr, int fq, const LAS int*) const {
        const int cc = u.col0 + wc * 32 + 8 * fq; const float* bp = bgu + (size_t)u.ex * 2048 + cc;
        f32x4 bg[2], bu[2];
#pragma unroll
        for (int n = 0; n < 2; ++n) { bg[n] = *(const f32x4*)(bp + 4 * n); bu[n] = *(const f32x4*)(bp + 1024 + 4 * n); }
#pragma unroll
        for (int ai = 0; ai < 2; ++ai)
#pragma unroll
            for (int m = 0; m < 4; ++m) { const int r = ai * HALF + wr * 64 + m * 16 + fr;
                float o[8];
#pragma unroll
                for (int n = 0; n < 2; ++n)
#pragma unroll
                    for (int i = 0; i < 4; ++i) { const float g = fminf(acc[ai][0][m][n][i] + bg[n][i], 7.f); const float uu = fminf(fmaxf(acc[ai][1][m][n][i] + bu[n][i], -7.f), 7.f);
                        o[n * 4 + i] = (uu + 1.f) * g * __builtin_amdgcn_rcpf(1.f + __expf(-1.702f * g)); }
                { u32x4 w; w.x = cvt_pk_bf16(o[0], o[1]); w.y = cvt_pk_bf16(o[2], o[3]); w.z = cvt_pk_bf16(o[4], o[5]); w.w = cvt_pk_bf16(o[6], o[7]);
                    *(u32x4*)(ACTp + (size_t)(u.row0 + r) * D + cc) = w; } }
    }
};
struct EpiMoe2 {
    static constexpr bool PERM = true; bf16_t* Yp; const float* bd; const float* GATEp;
    __device__ __forceinline__ void operator()(const f32x4 (&acc)[2][2][4][2], const Unit& u, int wr, int wc, int fr, int fq, const LAS int* rows) const {
        const int cc = u.col0 + wc * 32 + 8 * fq; const float* bp = bd + (size_t)u.ex * 1024 + cc;
        f32x4 bv[2][2];
#pragma unroll
        for (int bj = 0; bj < 2; ++bj)
#pragma unroll
            for (int n = 0; n < 2; ++n) bv[bj][n] = *(const f32x4*)(bp + bj * HALF + 4 * n);
        int asgv[2][4]; float gtv[2][4];
#pragma unroll
        for (int ai = 0; ai < 2; ++ai)
#pragma unroll
            for (int m = 0; m < 4; ++m) { const int r = ai * HALF + wr * 64 + m * 16 + fr; const bool ok = r < u.nvalid; const int a = rows[ok ? r : 0]; asgv[ai][m] = ok ? a : NASG; gtv[ai][m] = GATEp[a]; }
#pragma unroll
        for (int ai = 0; ai < 2; ++ai)
#pragma unroll
            for (int m = 0; m < 4; ++m) { const float gt = gtv[ai][m]; bf16_t* rowp = Yp + (size_t)asgv[ai][m] * D + cc;
#pragma unroll
                for (int bj = 0; bj < 2; ++bj) { const f32x4 v0 = (acc[ai][bj][m][0] + bv[bj][0]) * gt, v1 = (acc[ai][bj][m][1] + bv[bj][1]) * gt;
                    u32x4 w; w.x = cvt_pk_bf16(v0[0], v0[1]); w.y = cvt_pk_bf16(v0[2], v0[3]); w.z = cvt_pk_bf16(v1[0], v1[1]); w.w = cvt_pk_bf16(v1[2], v1[3]); *(u32x4*)(rowp + bj * HALF) = w; } }
    }
};

template <class Epi, class Sched, bool GATHER, bool ROWLIST>
__device__ __forceinline__ void gemm_phase(LAS unsigned char* lds, const char* Abase, const Sched& S, const Epi& E) {
    constexpr int K = 1024;
    int tid_l = threadIdx.x; asm volatile("" : "+v"(tid_l));
    const int tid = tid_l, wid = __builtin_amdgcn_readfirstlane(tid >> 6), lane = tid & 63, wr = wid >> 2, wc = wid & 3, fr = lane & 15, fq = lane >> 4;
    constexpr int nt = K / BK; constexpr unsigned Kb = (unsigned)K * 2u;
    unsigned voffB[2];
#pragma unroll
    for (int i = 0; i < 2; ++i) { int R, C; stage_rc(tid * 16 + i * 8192, R, C); const int Rb = Epi::PERM ? ((R & ~31) + perm32(R & 31)) : R; voffB[i] = (unsigned)(Rb * K + C) * 2u; }
    constexpr size_t kstep = (size_t)(BK * 2), hstep = (size_t)HALF * K * 2;
    const unsigned ldsw = (unsigned)wid * 1024u;
    const int aoff = lds_byte(wr * 64 + fr, fq * 8), boff = lds_byte(wc * 32 + fr, fq * 8);
    LAS int* rowbuf = (LAS int*)(lds + STAGE_BYTES);
#define G8_SA(b, h) (((b) * 2 + (h)) * HTB)
#define G8_SB(b, h) ((4 + (b) * 2 + (h)) * HTB)
#define G8_STAGE_A(bufoff, kb, v) do { _Pragma("unroll") for (int _i = 0; _i < 2; ++_i) \
        __builtin_amdgcn_global_load_lds((const unsigned*)((kb) + (size_t)(v)[_i]), (LAS unsigned*)(lds + (bufoff) + ldsw + _i * 8192), 16, 0, 0); } while (0)
#define G8_STAGE_B(bufoff, gbase) do { _Pragma("unroll") for (int _i = 0; _i < 2; ++_i) \
        __builtin_amdgcn_global_load_lds((const unsigned*)((gbase) + voffB[_i]), (LAS unsigned*)(lds + (bufoff) + ldsw + _i * 8192), 16, 0, 0); } while (0)
#define G8_LDA(dst, b, h) do { _Pragma("unroll") for (int m = 0; m < 4; ++m) _Pragma("unroll") for (int k = 0; k < 2; ++k) dst[m][k] = *(const LAS bf16x8*)(lds + G8_SA(b, h) + aoff + m * 2048 + k * 1024); } while (0)
#define G8_LDB(dst, b, h) do { _Pragma("unroll") for (int n = 0; n < 2; ++n) _Pragma("unroll") for (int k = 0; k < 2; ++k) dst[n][k] = *(const LAS bf16x8*)(lds + G8_SB(b, h) + boff + n * 2048 + k * 1024); } while (0)
#define G8_MMA(ai, bj, At, Bt) do { __builtin_amdgcn_s_setprio(1); _Pragma("unroll") for (int m = 0; m < 4; ++m) _Pragma("unroll") for (int n = 0; n < 2; ++n) _Pragma("unroll") for (int k = 0; k < 2; ++k) \
        acc[ai][bj][m][n] = __builtin_amdgcn_mfma_f32_16x16x32_bf16(Bt[n][k], At[m][k], acc[ai][bj][m][n], 0, 0, 0); __builtin_amdgcn_s_setprio(0); } while (0)
#define G8_WAIT_V(n) asm volatile("s_waitcnt vmcnt(" #n ")" ::: "memory")
#define G8_WAIT_L(n) asm volatile("s_waitcnt lgkmcnt(" #n ")" ::: "memory")
#define G8_BAR __builtin_amdgcn_s_barrier()
#define G8_SCHED __builtin_amdgcn_sched_barrier(0)
#define G8_LISTDMA(u, s) do { if (wid < 4) __builtin_amdgcn_global_load_lds((const unsigned*)(S.list + (size_t)(u).ex * LCAP + (u).lrow + wid * 64 + lane), (LAS unsigned*)(rowbuf + (s) * 256 + wid * 64), 4, 0, 0); } while (0)
#define G8_ROWS_DENSE(v) do { _Pragma("unroll") for (int _i = 0; _i < 2; ++_i) { int _R, _C; stage_rc(tid * 16 + _i * 8192, _R, _C); _Pragma("unroll") for (int _h = 0; _h < 2; ++_h) (v)[_h][_i] = (unsigned)(_h * HALF + _R) * Kb + (unsigned)_C * 2u; } } while (0)
#define G8_ROWS_LIST(v, u, s) do { _Pragma("unroll") for (int _i = 0; _i < 2; ++_i) { int _R, _C; stage_rc(tid * 16 + _i * 8192, _R, _C); _Pragma("unroll") for (int _h = 0; _h < 2; ++_h) { const int _r = _h * HALF + _R; const int _a = rowbuf[(s) * 256 + _r]; \
        (v)[_h][_i] = (unsigned)(_r < (u).nvalid ? (_a >> 2) : 0) * Kb + (unsigned)_C * 2u; } } } while (0)
    Unit cur, nxt; int ui = 0, slot = 0;
    if (!S.next(0, cur)) return;
    unsigned vA[2][2];
    if constexpr (ROWLIST) { G8_LISTDMA(cur, 0); G8_WAIT_V(0); G8_BAR; }
    if constexpr (GATHER) { G8_ROWS_LIST(vA, cur, 0); } else { G8_ROWS_DENSE(vA); }
    f32x4 acc[2][2][4][2];
#pragma unroll
    for (int a = 0; a < 2; ++a)
#pragma unroll
        for (int b = 0; b < 2; ++b)
#pragma unroll
            for (int m = 0; m < 4; ++m)
#pragma unroll
                for (int n = 0; n < 2; ++n) acc[a][b][m][n] = (f32x4){0.f, 0.f, 0.f, 0.f};
    bf16x8 At[4][2], B0[2][2], B1[2][2];
    const char* cB = S.bptr(cur);
    const char* cA = GATHER ? Abase : Abase + (size_t)cur.row0 * Kb;
    G8_STAGE_B(G8_SB(0, 0), cB); G8_STAGE_B(G8_SB(0, 1), cB + hstep); G8_STAGE_A(G8_SA(0, 0), cA, vA[0]); G8_STAGE_A(G8_SA(0, 1), cA, vA[1]);
    if (wr == 1) G8_BAR;
    G8_WAIT_V(2); G8_BAR;
    G8_STAGE_B(G8_SB(1, 0), cB + kstep); G8_STAGE_A(G8_SA(1, 0), cA + kstep, vA[0]); G8_STAGE_B(G8_SB(1, 1), cB + hstep + kstep);
    G8_WAIT_V(6); G8_BAR;
    for (;;) {
        const bool has_next = S.next(ui + 1, nxt);
        const char* nB = has_next ? S.bptr(nxt) : cB;
        const char* nA = (GATHER || !has_next) ? cA : Abase + (size_t)nxt.row0 * Kb;
        const int nslot = slot == 2 ? 0 : slot + 1;
        if constexpr (ROWLIST) { if (has_next) G8_LISTDMA(nxt, nslot); }
        for (int t = 0; t < nt; t += 2) {
            const bool last = (t == nt - 2);
            const char* a1 = cA + (size_t)(t + 1) * kstep;
            const char* a2 = last ? nA : cA + (size_t)(t + 2) * kstep; const char* b2 = last ? nB : cB + (size_t)(t + 2) * kstep;
            const char* a3 = a2 + kstep; const char* b3 = b2 + kstep;
            G8_LDB(B0, 0, 0); G8_LDB(B1, 0, 1); G8_SCHED; G8_LDA(At, 0, 0); G8_STAGE_A(G8_SA(1, 1), a1, vA[1]);
            if constexpr (GATHER) { if (last && has_next) { G8_ROWS_LIST(vA, nxt, nslot); } }
            G8_WAIT_V(8); G8_WAIT_L(0); G8_BAR; G8_MMA(0, 0, At, B0); G8_MMA(0, 1, At, B1); G8_BAR; G8_SCHED;
            G8_LDA(At, 0, 1); G8_STAGE_B(G8_SB(0, 0), b2); G8_STAGE_B(G8_SB(0, 1), b2 + hstep); G8_STAGE_A(G8_SA(0, 0), a2, vA[0]);
            G8_WAIT_V(8); G8_WAIT_L(0); G8_BAR; G8_MMA(1, 0, At, B0); G8_MMA(1, 1, At, B1); G8_BAR; G8_SCHED;
            G8_LDB(B0, 1, 0); G8_LDB(B1, 1, 1); G8_SCHED; G8_LDA(At, 1, 0); G8_STAGE_A(G8_SA(0, 1), a2, vA[1]);
            G8_WAIT_V(8); G8_WAIT_L(0); G8_BAR; G8_MMA(0, 0, At, B0); G8_MMA(0, 1, At, B1); G8_BAR; G8_SCHED;
            G8_LDA(At, 1, 1); G8_STAGE_B(G8_SB(1, 0), b3); G8_STAGE_B(G8_SB(1, 1), b3 + hstep); G8_STAGE_A(G8_SA(1, 0), a3, vA[0]);
            G8_WAIT_V(8); G8_WAIT_L(0); G8_BAR; G8_MMA(1, 0, At, B0); G8_MMA(1, 1, At, B1); G8_BAR; G8_SCHED;
        }
        if (wr == 0) G8_BAR;
        { int t2 = threadIdx.x; asm volatile("" : "+v"(t2));
          const int w2 = __builtin_amdgcn_readfirstlane(t2 >> 6); E(acc, cur, w2 >> 2, w2 & 3, t2 & 15, (t2 & 63) >> 4, rowbuf + slot * 256); }
        if (!has_next) break;
#pragma unroll
        for (int a = 0; a < 2; ++a)
#pragma unroll
            for (int b = 0; b < 2; ++b)
#pragma unroll
                for (int m = 0; m < 4; ++m)
#pragma unroll
                    for (int n = 0; n < 2; ++n) acc[a][b][m][n] = (f32x4){0.f, 0.f, 0.f, 0.f};
        cur = nxt; cB = nB; cA = nA; ++ui; slot = nslot;
        if (wr == 1) G8_BAR;
    }
    G8_WAIT_V(0);
    G8_BAR;
#undef G8_SA
#undef G8_SB
#undef G8_STAGE_A
#undef G8_STAGE_B
#undef G8_LDA
#undef G8_LDB
#undef G8_MMA
#undef G8_WAIT_V
#undef G8_WAIT_L
#undef G8_BAR
#undef G8_SCHED
#undef G8_LISTDMA
#undef G8_ROWS_DENSE
#undef G8_ROWS_LIST
}
}

namespace fft {
constexpr int TP = 72;
constexpr int UP = 264;
constexpr int ZP = 520;
constexpr int O_TC = 0, O_TS = 9216, O_U = 18432, O_X = 52224, O_TW = 125952;
__device__ __forceinline__ bf16x8 neg8(bf16x8 v) { u32x4 w = __builtin_bit_cast(u32x4, v); w = w ^ 0x80008000u; return __builtin_bit_cast(bf16x8, w); }
__device__ __forceinline__ void build_tables(LAS unsigned char* lds, const float* TABC, const float* TABS, int tid) {
    for (int i = tid; i < 4096; i += 512) { const int a = i >> 6, b = i & 63, ix = ((a * b) & 63) * 64;
        ((LAS bf16_t*)(lds + O_TC))[a * TP + b] = f2bf(TABC[ix]); ((LAS bf16_t*)(lds + O_TS))[a * TP + b] = f2bf(TABS[ix]); }
}
__device__ __forceinline__ void stage_a(LAS unsigned char* lds, const bf16_t* P, const float* TABC, const float* TABS, bf16_t* ZBUF, int u0, int u1, int ustep) {
    int tid_l = threadIdx.x; asm volatile("" : "+v"(tid_l));
    const int tid = tid_l, lane = tid & 63, w = __builtin_amdgcn_readfirstlane(tid >> 6), fr = lane & 15, fq = lane >> 4;
    build_tables(lds, TABC, TABS, tid);
    const LAS bf16_t* Tc = (const LAS bf16_t*)(lds + O_TC); const LAS bf16_t* Ts = (const LAS bf16_t*)(lds + O_TS);
    LAS bf16_t* U = (LAS bf16_t*)(lds + O_U); LAS bf16_t* X = (LAS bf16_t*)(lds + O_X); LAS float* TW = (LAS float*)(lds + O_TW);
    for (int unit = u0; unit < u1; unit += ustep) {
        const int b = unit >> 6, t2 = unit & 63;
#pragma unroll
        for (int i = 0; i < 4; ++i) { const int q = tid + 512 * i, t1 = q >> 5, ch = q & 31;
            *(LAS u32x4*)((LAS unsigned char*)U + t1 * (UP * 2) + ch * 16) = *(const u32x4*)(P + ((size_t)b * NPOS + CTX + 64 * t1 + t2) * PP + ch * 8); }
        if (tid < 64) { const int ix = tid * t2; TW[2 * tid] = TABC[ix]; TW[2 * tid + 1] = TABS[ix]; }
        __syncthreads();
        { const int g = w >> 1, part = w & 1; const LAS bf16_t* T = part ? Ts : Tc;
          f32x4 acc[4][4];
#pragma unroll
          for (int mt = 0; mt < 4; ++mt)
#pragma unroll
              for (int nt = 0; nt < 4; ++nt) acc[mt][nt] = (f32x4){0.f, 0.f, 0.f, 0.f};
#pragma unroll
          for (int ks = 0; ks < 2; ++ks) { bf16x8 a[4], bb[4];
#pragma unroll
              for (int mt = 0; mt < 4; ++mt) a[mt] = *(const LAS bf16x8*)(U + (16 * mt + fr) * UP + g * 64 + 32 * ks + 8 * fq);
#pragma unroll
              for (int nt = 0; nt < 4; ++nt) bb[nt] = *(const LAS bf16x8*)(T + (16 * nt + fr) * TP + 32 * ks + 8 * fq);
#pragma unroll
              for (int mt = 0; mt < 4; ++mt)
#pragma unroll
                  for (int nt = 0; nt < 4; ++nt) acc[mt][nt] = __builtin_amdgcn_mfma_f32_16x16x32_bf16(a[mt], bb[nt], acc[mt][nt], 0, 0, 0); }
          const float sg = part ? -1.f : 1.f;
#pragma unroll
          for (int mt = 0; mt < 4; ++mt)
#pragma unroll
              for (int nt = 0; nt < 4; ++nt) { const f32x4 v = acc[mt][nt] * sg; u32x2 o; o.x = pk2(v[0], v[1]); o.y = pk2(v[2], v[3]);
                  *(LAS u32x2*)(X + (part * 256 + g * 64 + 16 * nt + fr) * TP + 16 * mt + 4 * fq) = o; } }
        __syncthreads();
        f32x4 zr[4][2], zi[4][2];
#pragma unroll
        for (int mt = 0; mt < 4; ++mt)
#pragma unroll
            for (int n = 0; n < 2; ++n) { zr[mt][n] = (f32x4){0.f, 0.f, 0.f, 0.f}; zi[mt][n] = (f32x4){0.f, 0.f, 0.f, 0.f}; }
#pragma unroll
        for (int ks = 0; ks < 2; ++ks) { bf16x8 xr[2], xi[2];
#pragma unroll
            for (int n = 0; n < 2; ++n) { xr[n] = *(const LAS bf16x8*)(X + (32 * w + 16 * n + fr) * TP + 32 * ks + 8 * fq); xi[n] = *(const LAS bf16x8*)(X + (256 + 32 * w + 16 * n + fr) * TP + 32 * ks + 8 * fq); }
#pragma unroll
            for (int mt = 0; mt < 4; ++mt) { const bf16x8 c = *(const LAS bf16x8*)(Tc + (16 * mt + fr) * TP + 32 * ks + 8 * fq), s = *(const LAS bf16x8*)(Ts + (16 * mt + fr) * TP + 32 * ks + 8 * fq), ns = neg8(s);
#pragma unroll
                for (int n = 0; n < 2; ++n) { zr[mt][n] = __builtin_amdgcn_mfma_f32_16x16x32_bf16(c, xr[n], zr[mt][n], 0, 0, 0); zr[mt][n] = __builtin_amdgcn_mfma_f32_16x16x32_bf16(s, xi[n], zr[mt][n], 0, 0, 0);
                    zi[mt][n] = __builtin_amdgcn_mfma_f32_16x16x32_bf16(c, xi[n], zi[mt][n], 0, 0, 0); zi[mt][n] = __builtin_amdgcn_mfma_f32_16x16x32_bf16(ns, xr[n], zi[mt][n], 0, 0, 0); } } }
        __syncthreads();
        { LAS bf16_t* Zs = X;
#pragma unroll
          for (int mt = 0; mt < 4; ++mt)
#pragma unroll
              for (int i = 0; i < 4; ++i) { const int f1 = 16 * mt + 4 * fq + i; const float ct = TW[2 * f1], st = TW[2 * f1 + 1];
#pragma unroll
                  for (int n = 0; n < 2; ++n) { const float a = zr[mt][n][i], bq = zi[mt][n][i]; const int col = 32 * w + 16 * n + fr;
                      Zs[f1 * ZP + col] = f2bf(a * ct + bq * st); Zs[f1 * ZP + 256 + col] = f2bf(bq * ct - a * st); } } }
        __syncthreads();
#pragma unroll
        for (int i = 0; i < 8; ++i) { const int q = tid + 512 * i, f1 = q >> 6, ch = q & 63;
            *(u32x4*)(ZBUF + (((size_t)b * 64 + f1) * 64 + t2) * 512 + ch * 8) = *(const LAS u32x4*)((const LAS unsigned char*)X + f1 * (ZP * 2) + ch * 16); }
        __syncthreads();
    }
}
__device__ __forceinline__ void stage_b(LAS unsigned char* lds, const bf16_t* ZBUF, const float* TABC, const float* TABS, bf16_t* MIX, int G, int bx) {
    int tid_l = threadIdx.x; asm volatile("" : "+v"(tid_l));
    const int tid = tid_l, lane = tid & 63, w = __builtin_amdgcn_readfirstlane(tid >> 6), fr = lane & 15, fq = lane >> 4;
    build_tables(lds, TABC, TABS, tid);
    const LAS bf16_t* Tc = (const LAS bf16_t*)(lds + O_TC); const LAS bf16_t* Ts = (const LAS bf16_t*)(lds + O_TS);
    LAS bf16_t* Ys = (LAS bf16_t*)(lds + O_U); LAS bf16_t* ZT = (LAS bf16_t*)(lds + O_X);
    for (int unit = bx; unit < 256; unit += G) {
        const int b = unit >> 6, f1 = unit & 63;
        const bf16_t* Zg = ZBUF + ((size_t)b * 64 + f1) * 64 * 512;
#pragma unroll
        for (int i = 0; i < 4; ++i) { const int q = tid + 512 * i, p = q & 31, ch = q >> 5;
            const u32x4 r0 = *(const u32x4*)(Zg + (size_t)(2 * p) * 512 + ch * 8), r1 = *(const u32x4*)(Zg + (size_t)(2 * p + 1) * 512 + ch * 8);
#pragma unroll
            for (int j = 0; j < 4; ++j) { const unsigned a = r0[j], c = r1[j];
                *(LAS unsigned*)(ZT + (ch * 8 + 2 * j) * TP + 2 * p) = (a & 0xffffu) | (c << 16);
                *(LAS unsigned*)(ZT + (ch * 8 + 2 * j + 1) * TP + 2 * p) = (a >> 16) | (c & 0xffff0000u); } }
        __syncthreads();
        f32x4 y[4][2];
#pragma unroll
        for (int mt = 0; mt < 4; ++mt)
#pragma unroll
            for (int n = 0; n < 2; ++n) y[mt][n] = (f32x4){0.f, 0.f, 0.f, 0.f};
#pragma unroll
        for (int ks = 0; ks < 2; ++ks) { bf16x8 xr[2], xi[2];
#pragma unroll
            for (int n = 0; n < 2; ++n) { xr[n] = *(const LAS bf16x8*)(ZT + (32 * w + 16 * n + fr) * TP + 32 * ks + 8 * fq); xi[n] = *(const LAS bf16x8*)(ZT + (256 + 32 * w + 16 * n + fr) * TP + 32 * ks + 8 * fq); }
#pragma unroll
            for (int mt = 0; mt < 4; ++mt) { const bf16x8 c = *(const LAS bf16x8*)(Tc + (16 * mt + fr) * TP + 32 * ks + 8 * fq), s = *(const LAS bf16x8*)(Ts + (16 * mt + fr) * TP + 32 * ks + 8 * fq);
#pragma unroll
                for (int n = 0; n < 2; ++n) { y[mt][n] = __builtin_amdgcn_mfma_f32_16x16x32_bf16(c, xr[n], y[mt][n], 0, 0, 0); y[mt][n] = __builtin_amdgcn_mfma_f32_16x16x32_bf16(s, xi[n], y[mt][n], 0, 0, 0); } } }
#pragma unroll
        for (int mt = 0; mt < 4; ++mt)
#pragma unroll
            for (int i = 0; i < 4; ++i)
#pragma unroll
                for (int n = 0; n < 2; ++n) Ys[(16 * mt + 4 * fq + i) * UP + 32 * w + 16 * n + fr] = f2bf(y[mt][n][i] * (1.f / 512.f));
        __syncthreads();
#pragma unroll
        for (int i = 0; i < 4; ++i) { const int q = tid + 512 * i, f2 = q >> 5, ch = q & 31;
            *(u32x4*)(MIX + ((size_t)b * NPOS + CTX + f1 + 64 * f2) * D + ch * 8) = *(const LAS u32x4*)((const LAS unsigned char*)Ys + f2 * (UP * 2) + ch * 16); }
        __syncthreads();
    }
}
}

namespace attn {
typedef float f32x16 __attribute__((ext_vector_type(16)));
typedef float f32x2_t __attribute__((ext_vector_type(2))); typedef __bf16 bf16x2_t __attribute__((ext_vector_type(2)));
__device__ __forceinline__ unsigned cvtpk(float lo, float hi) { f32x2_t v = {lo, hi}; bf16x2_t b = __builtin_convertvector(v, bf16x2_t); return __builtin_bit_cast(unsigned, b); }
constexpr int KP = 104, VP = 68;
constexpr int KT_BYTES = 64 * KP * 2, VT_BYTES = 64 * VP * 2, BUF_BYTES = KT_BYTES + VT_BYTES;
constexpr float THR = 8.f;
__device__ __forceinline__ void attn_phase(LAS unsigned char* lds, const bf16_t* QL, const bf16_t* QC, const bf16_t* KB, const bf16_t* VTG, bf16_t* MIX, int with_ctx, int G, int vcu) {
    const int nunits = 256 + (with_ctx ? 16 : 0);
    for (int unit = vcu; unit < nunits; unit += G) {
        int tid_l = threadIdx.x; asm volatile("" : "+v"(tid_l));
        const int tid = tid_l, lane = tid & 63, wid = __builtin_amdgcn_readfirstlane(tid >> 6), r32 = lane & 31, hi = lane >> 5;
        int bh, nk, orow0; const bf16_t* Qp;
        if (unit < 256) { bh = unit >> 4; const int qb = unit & 15; Qp = QL + ((size_t)bh * SEQ + qb * 256) * 96; nk = NPOS; orow0 = (bh >> 2) * NPOS + CTX + qb * 256; }
        else { bh = unit - 256; Qp = QC + (size_t)bh * CTX * 96; nk = CTX; orow0 = (bh >> 2) * NPOS; }
        const int hh = bh & 3, NT = nk / 64;
        const bf16_t* Kg = KB + (size_t)bh * NPOS * 96; const bf16_t* Vg = VTG + (size_t)bh * 64 * NPOS;
        bf16x8 qf[6];
        { const bf16_t* qp = Qp + (size_t)(wid * 32 + r32) * 96 + 8 * hi;
#pragma unroll
          for (int ds = 0; ds < 6; ++ds) qf[ds] = *(const bf16x8*)(qp + 16 * ds); }
        f32x16 o0 = {}, o1 = {}, negm = {}; float mhat = 0.f, l = 0.f;
        const int kr0 = tid / 12, kc0 = tid % 12, kr1 = (tid + 512) / 12, kc1 = (tid + 512) % 12; const bool k1ok = tid < 256;
        const int vd = tid >> 3, vc = tid & 7;
        u32x4 sk0, sk1 = {}, sv;
#define AT_LOAD(t_) do { const size_t k0_ = (size_t)(t_) * 64; sk0 = *(const u32x4*)(Kg + (k0_ + kr0) * 96 + kc0 * 8); if (k1ok) sk1 = *(const u32x4*)(Kg + (k0_ + kr1) * 96 + kc1 * 8); sv = *(const u32x4*)(Vg + (size_t)vd * NPOS + k0_ + vc * 8); } while (0)
#define AT_STORE(slot_) do { LAS unsigned char* bp_ = lds + (slot_) * BUF_BYTES; *(LAS u32x4*)(bp_ + kr0 * (KP * 2) + kc0 * 16) = sk0; if (k1ok) *(LAS u32x4*)(bp_ + kr1 * (KP * 2) + kc1 * 16) = sk1; *(LAS u32x4*)(bp_ + KT_BYTES + vd * (VP * 2) + vc * 16) = sv; } while (0)
#define AT_QK(P0, P1, slot_) do { const LAS bf16_t* Kt_ = (const LAS bf16_t*)(lds + (slot_) * BUF_BYTES); \
        _Pragma("unroll") for (int ds = 0; ds < 6; ++ds) { const bf16x8 k0f = *(const LAS bf16x8*)(Kt_ + r32 * KP + 16 * ds + 8 * hi), k1f = *(const LAS bf16x8*)(Kt_ + (32 + r32) * KP + 16 * ds + 8 * hi); \
            if (ds == 0) { P0 = __builtin_amdgcn_mfma_f32_32x32x16_bf16(k0f, qf[0], negm, 0, 0, 0); P1 = __builtin_amdgcn_mfma_f32_32x32x16_bf16(k1f, qf[0], negm, 0, 0, 0); } \
            else { P0 = __builtin_amdgcn_mfma_f32_32x32x16_bf16(k0f, qf[ds], P0, 0, 0, 0); P1 = __builtin_amdgcn_mfma_f32_32x32x16_bf16(k1f, qf[ds], P1, 0, 0, 0); } } } while (0)
#define MX3(a_, b_, c_) __builtin_fmaxf(__builtin_fmaxf((a_), (b_)), (c_))
#define AT_STEP(C0, C1, N0, N1, t_) do { \
            if ((t_) + 2 < NT) AT_LOAD((t_) + 2); \
            if ((t_) + 1 < NT) AT_QK(N0, N1, s_nxt); \
            float mx_ = MX3(C0[0], C0[1], C1[0]), my_ = MX3(C0[2], C0[3], C1[1]); mx_ = MX3(mx_, C1[2], C1[3]); \
            _Pragma("unroll") for (int r = 4; r < 16; r += 4) { mx_ = MX3(mx_, C0[r], C0[r + 1]); my_ = MX3(my_, C0[r + 2], C0[r + 3]); mx_ = MX3(mx_, C1[r], C1[r + 1]); my_ = MX3(my_, C1[r + 2], C1[r + 3]); } \
            mx_ = fmaxf(mx_, my_); mx_ = fmaxf(mx_, __shfl_xor(mx_, 32)); \
            if (__builtin_expect((t_) == 0 || __any(mx_ > THR), 0)) { const float dl = (t_) == 0 ? mx_ : fmaxf(mx_, 0.f), f = __builtin_amdgcn_exp2f(-dl); mhat += dl; l *= f; \
                _Pragma("unroll") for (int r = 0; r < 16; ++r) { C0[r] -= dl; C1[r] -= dl; o0[r] *= f; o1[r] *= f; negm[r] = -mhat; } \
                if ((t_) + 1 < NT) { _Pragma("unroll") for (int r = 0; r < 16; ++r) { N0[r] -= dl; N1[r] -= dl; } } } \
            float ls_ = 0.f; \
            _Pragma("unroll") for (int r = 0; r < 16; ++r) { C0[r] = __builtin_amdgcn_exp2f(C0[r]); C1[r] = __builtin_amdgcn_exp2f(C1[r]); ls_ += C0[r] + C1[r]; } \
            l += ls_; \
            const LAS bf16_t* Vt_ = (const LAS bf16_t*)(lds + s_cur * BUF_BYTES + KT_BYTES); \
            _Pragma("unroll") for (int q = 0; q < 4; ++q) { u32x4 pw_; \
                _Pragma("unroll") for (int j = 0; j < 4; ++j) { const int r = 8 * (q & 1) + 2 * j; pw_[j] = (q < 2) ? cvtpk(C0[r], C0[r + 1]) : cvtpk(C1[r], C1[r + 1]); } \
                const bf16x8 pf_ = __builtin_bit_cast(bf16x8, pw_); const int kvb = 32 * (q >> 1) + 16 * (q & 1) + 4 * hi; \
                _Pragma("unroll") for (int db = 0; db < 2; ++db) { const u32x2 va = *(const LAS u32x2*)(Vt_ + (32 * db + r32) * VP + kvb), vb = *(const LAS u32x2*)(Vt_ + (32 * db + r32) * VP + kvb + 8); \
                    const u32x4 vw = {va.x, va.y, vb.x, vb.y}; const bf16x8 vf = __builtin_bit_cast(bf16x8, vw); \
                    if (db == 0) o0 = __builtin_amdgcn_mfma_f32_32x32x16_bf16(vf, pf_, o0, 0, 0, 0); else o1 = __builtin_amdgcn_mfma_f32_32x32x16_bf16(vf, pf_, o1, 0, 0, 0); } } \
            if ((t_) + 2 < NT) AT_STORE(s_ld); \
            __syncthreads(); \
            { const int tmp_ = s_cur; s_cur = s_nxt; s_nxt = s_ld; s_ld = tmp_; } } while (0)
        AT_LOAD(0); AT_STORE(0);
        if (NT > 1) { AT_LOAD(1); AT_STORE(1); }
        __syncthreads();
        f32x16 pA0, pA1, pB0, pB1;
        AT_QK(pA0, pA1, 0);
        int s_cur = 0, s_nxt = 1, s_ld = 2;
        for (int t = 0; t < NT; t += 2) {
            AT_STEP(pA0, pA1, pB0, pB1, t);
            AT_STEP(pB0, pB1, pA0, pA1, t + 1);
        }
#undef AT_LOAD
#undef AT_STORE
#undef AT_QK
#undef AT_STEP
#undef MX3
        l += __shfl_xor(l, 32);
        const float il = 1.f / l;
        bf16_t* op = MIX + (size_t)(orow0 + wid * 32 + r32) * D + 512 + hh * 64 + 4 * hi;
#pragma unroll
        for (int g4 = 0; g4 < 4; ++g4) { u32x2 w0, w1; w0.x = cvtpk(o0[4 * g4] * il, o0[4 * g4 + 1] * il); w0.y = cvtpk(o0[4 * g4 + 2] * il, o0[4 * g4 + 3] * il);
            w1.x = cvtpk(o1[4 * g4] * il, o1[4 * g4 + 1] * il); w1.y = cvtpk(o1[4 * g4 + 2] * il, o1[4 * g4 + 3] * il);
            *(u32x2*)(op + 8 * g4) = w0; *(u32x2*)(op + 32 + 8 * g4) = w1; }
    }
}
}

namespace sm {
__device__ __forceinline__ float silu(float x) { return x / (1.f + __expf(-x)); }
__device__ __forceinline__ void mod_phase(LAS unsigned char* lds, const float* c, const float* c_ctx, const float* mod_w, const float* mod_b, float* MOD, int G, int bx, int tid) {
    LAS float* s = (LAS float*)lds;
    for (int i = tid; i < 5120; i += 512) { const int v = i >> 10, k = i & 1023; s[i] = silu(v < 4 ? c[v * 1024 + k] : c_ctx[k]); }
    __syncthreads();
    LAS float* red = s + 5120;
    for (int unit = bx; unit < 96; unit += G) {
        const int l = unit / 48, cb = unit % 48, cl = tid & 127, col = cb * 128 + cl, kq = tid >> 7, k0 = kq * 256;
        const float* W = mod_w + ((size_t)l * 1024 + k0) * 6144 + col;
        float a0 = 0.f, a1 = 0.f, a2 = 0.f, a3 = 0.f, a4 = 0.f;
#pragma unroll 16
        for (int k = 0; k < 256; ++k) { const float w = W[(size_t)k * 6144]; a0 += s[k0 + k] * w; a1 += s[1024 + k0 + k] * w; a2 += s[2048 + k0 + k] * w; a3 += s[3072 + k0 + k] * w; a4 += s[4096 + k0 + k] * w; }
        LAS float* rq = red + kq * 640 + cl; rq[0] = a0; rq[128] = a1; rq[256] = a2; rq[384] = a3; rq[512] = a4;
        __syncthreads();
        for (int i = tid; i < 640; i += 512) { const int v = i >> 7, cc = i & 127; const float r = ((red[i] + red[640 + i]) + (red[1280 + i] + red[1920 + i])) + mod_b[l * 6144 + cb * 128 + cc];
            MOD[((size_t)l * 5 + v) * 6144 + cb * 128 + cc] = r; }
        __syncthreads();
    }
}
__device__ __forceinline__ void norm_store(const float4 (&x)[4], float ss, const float* g, const float* mv, int sh_off, int sc_off, bf16_t* xn_row, int lane) {
    const float rs = rsqrtf(wave_sum(ss) * (1.f / D) + 1e-6f);
#pragma unroll
    for (int j = 0; j < 4; ++j) { const int c = (j * 64 + lane) * 4; const float4 gg = *(const float4*)(g + c), sh = *(const float4*)(mv + sh_off + c), sc = *(const float4*)(mv + sc_off + c);
        u32x2 o; o.x = pk2(x[j].x * rs * gg.x * (1.f + sc.x) + sh.x, x[j].y * rs * gg.y * (1.f + sc.y) + sh.y); o.y = pk2(x[j].z * rs * gg.z * (1.f + sc.z) + sh.z, x[j].w * rs * gg.w * (1.f + sc.w) + sh.w);
        *(u32x2*)(xn_row + c) = o; }
}
__device__ __forceinline__ void pro1_phase(const float* x, const float* ctx, const float* g, const float* MODl, float* H, bf16_t* XN, int r_first, int r_end, int r_step, int lane) {
    for (int r = r_first; r < r_end; r += r_step) { const int b = r / NPOS, pos = r % NPOS, v = pos < CTX ? 4 : b;
        const float* src = pos < CTX ? ctx + ((size_t)b * CTX + pos) * D : x + ((size_t)b * SEQ + (pos - CTX)) * D;
        float4 xv[4]; float ss = 0.f;
#pragma unroll
        for (int j = 0; j < 4; ++j) { const int c = (j * 64 + lane) * 4; xv[j] = *(const float4*)(src + c); ss += xv[j].x * xv[j].x + xv[j].y * xv[j].y + xv[j].z * xv[j].z + xv[j].w * xv[j].w; }
#pragma unroll
        for (int j = 0; j < 4; ++j) *(float4*)(H + (size_t)r * D + (j * 64 + lane) * 4) = xv[j];
        norm_store(xv, ss, g, MODl + (size_t)v * 6144, 0, 1024, XN + (size_t)r * D, lane); }
}
__device__ __forceinline__ void comb_phase(int l, float* H, const bf16_t* Y, const float* MODl, const float* g_next, const float* MODn, bf16_t* XN, const float* final_g, float* out, int gw, int NGW, int lane) {
    for (int r = gw; r < MROWS; r += NGW) { const int b = r / NPOS, pos = r % NPOS, v = pos < CTX ? 4 : b;
        if (l == 1 && pos < CTX) continue;
        const float* g2 = MODl + (size_t)v * 6144 + 5120;
        float4 xv[4]; float ss = 0.f;
#pragma unroll
        for (int j = 0; j < 4; ++j) { const int c = (j * 64 + lane) * 4; xv[j] = *(const float4*)(H + (size_t)r * D + c); float4 s = make_float4(0.f, 0.f, 0.f, 0.f);
#pragma unroll
            for (int k = 0; k < 4; ++k) { const u32x2 y = *(const u32x2*)(Y + ((size_t)r * 4 + k) * D + c); s.x += __uint_as_float(y.x << 16); s.y += __uint_as_float(y.x & 0xffff0000u); s.z += __uint_as_float(y.y << 16); s.w += __uint_as_float(y.y & 0xffff0000u); }
            const float4 gg = *(const float4*)(g2 + c); xv[j].x += gg.x * s.x; xv[j].y += gg.y * s.y; xv[j].z += gg.z * s.z; xv[j].w += gg.w * s.w;
            ss += xv[j].x * xv[j].x + xv[j].y * xv[j].y + xv[j].z * xv[j].z + xv[j].w * xv[j].w; }
        if (l == 0) {
#pragma unroll
            for (int j = 0; j < 4; ++j) *(float4*)(H + (size_t)r * D + (j * 64 + lane) * 4) = xv[j];
            norm_store(xv, ss, g_next, MODn + (size_t)v * 6144, 0, 1024, XN + (size_t)r * D, lane);
        } else { const float rs = rsqrtf(wave_sum(ss) * (1.f / D) + 1e-6f); float* op = out + ((size_t)b * SEQ + (pos - CTX)) * D;
#pragma unroll
            for (int j = 0; j < 4; ++j) { const int c = (j * 64 + lane) * 4; const float4 fg = *(const float4*)(final_g + c); float4 o; o.x = xv[j].x * rs * fg.x; o.y = xv[j].y * rs * fg.y; o.z = xv[j].z * rs * fg.z; o.w = xv[j].w * rs * fg.w; *(float4*)(op + c) = o; } }
    }
}
__device__ __forceinline__ void route_phase(LAS unsigned char* lds, int l, const float* H, const float* g, const float* MODl, const bf16_t* RWH, const bf16_t* RWL, const float* rb, bf16_t* XN, int* CNT, int* LIST, float* GATE,
                                            int G, int bx, int tid) {
    const int lane = tid & 63, wave = __builtin_amdgcn_readfirstlane(tid >> 6), fr = lane & 15, fq = lane >> 4;
    constexpr int FP = 1032;
    LAS bf16_t* FH = (LAS bf16_t*)lds; LAS bf16_t* FL = FH + 16 * FP;
    LAS float* PART = (LAS float*)(lds + 66048);
    LAS int* LCNT = (LAS int*)(lds + 66048 + 16384);
    LAS int* LBASE = LCNT + 64; LAS int* LENT = LCNT + 128;
    if (tid < 64) LCNT[tid] = 0;
    bf16x8 wh[2][4], wl[2][4];
#pragma unroll
    for (int nt = 0; nt < 2; ++nt)
#pragma unroll
        for (int ks = 0; ks < 4; ++ks) { const size_t o = ((size_t)l * NE + 16 * nt + fr) * D + 128 * wave + 32 * ks + 8 * fq; wh[nt][ks] = *(const bf16x8*)(RWH + o); wl[nt][ks] = *(const bf16x8*)(RWL + o); }
    const float bias = rb[lane & 31];
    __syncthreads();
    const int nb = l == 1 ? (MROWS - NB_ * CTX) / 16 : MROWS / 16;
    for (int bi = bx; bi < nb; bi += G) {
#pragma unroll
        for (int rr = 0; rr < 2; ++rr) { const int q = bi * 16 + 2 * wave + rr; const int r = l == 1 ? (q / SEQ) * NPOS + CTX + (q % SEQ) : q;
            const int b = r / NPOS, pos = r % NPOS, v = pos < CTX ? 4 : b; const float* mv = MODl + (size_t)v * 6144;
            float4 xv[4]; float ss = 0.f;
#pragma unroll
            for (int j = 0; j < 4; ++j) { xv[j] = *(const float4*)(H + (size_t)r * D + (j * 64 + lane) * 4); ss += xv[j].x * xv[j].x + xv[j].y * xv[j].y + xv[j].z * xv[j].z + xv[j].w * xv[j].w; }
            const float rs = rsqrtf(wave_sum(ss) * (1.f / D) + 1e-6f);
#pragma unroll
            for (int j = 0; j < 4; ++j) { const int c = (j * 64 + lane) * 4; const float4 gg = *(const float4*)(g + c), sh = *(const float4*)(mv + 3072 + c), sc = *(const float4*)(mv + 4096 + c);
                float f[4]; f[0] = xv[j].x * rs * gg.x * (1.f + sc.x) + sh.x; f[1] = xv[j].y * rs * gg.y * (1.f + sc.y) + sh.y; f[2] = xv[j].z * rs * gg.z * (1.f + sc.z) + sh.z; f[3] = xv[j].w * rs * gg.w * (1.f + sc.w) + sh.w;
                bf16_t hb[4], lb[4];
#pragma unroll
                for (int i = 0; i < 4; ++i) { hb[i] = f2bf(f[i]); lb[i] = f2bf(f[i] - bf2f(hb[i])); }
                u32x2 oh, ol; oh.x = (unsigned)hb[0] | ((unsigned)hb[1] << 16); oh.y = (unsigned)hb[2] | ((unsigned)hb[3] << 16); ol.x = (unsigned)lb[0] | ((unsigned)lb[1] << 16); ol.y = (unsigned)lb[2] | ((unsigned)lb[3] << 16);
                *(u32x2*)(XN + (size_t)r * D + c) = oh; *(LAS u32x2*)(FH + (2 * wave + rr) * FP + c) = oh; *(LAS u32x2*)(FL + (2 * wave + rr) * FP + c) = ol; } }
        __syncthreads();
        { f32x4 acc[2] = {(f32x4){0.f, 0.f, 0.f, 0.f}, (f32x4){0.f, 0.f, 0.f, 0.f}};
#pragma unroll
          for (int ks = 0; ks < 4; ++ks) { const bf16x8 ah = *(const LAS bf16x8*)(FH + fr * FP + 128 * wave + 32 * ks + 8 * fq), al = *(const LAS bf16x8*)(FL + fr * FP + 128 * wave + 32 * ks + 8 * fq);
#pragma unroll
              for (int nt = 0; nt < 2; ++nt) { acc[nt] = __builtin_amdgcn_mfma_f32_16x16x32_bf16(ah, wh[nt][ks], acc[nt], 0, 0, 0); acc[nt] = __builtin_amdgcn_mfma_f32_16x16x32_bf16(ah, wl[nt][ks], acc[nt], 0, 0, 0);
                  acc[nt] = __builtin_amdgcn_mfma_f32_16x16x32_bf16(al, wh[nt][ks], acc[nt], 0, 0, 0); } }
#pragma unroll
          for (int nt = 0; nt < 2; ++nt)
#pragma unroll
              for (int i = 0; i < 4; ++i) PART[(wave * 16 + 4 * fq + i) * 32 + 16 * nt + fr] = acc[nt][i]; }
        __syncthreads();
        { const int row = 2 * wave + (lane >> 5), e = lane & 31; const int q = bi * 16 + row; const int r = l == 1 ? (q / SEQ) * NPOS + CTX + (q % SEQ) : q;
          float lg = bias;
#pragma unroll
          for (int kw = 0; kw < 8; ++kw) lg += PART[(kw * 16 + row) * 32 + e];
          float val = lg; int idx = e; float tv[4]; int ti[4];
#pragma unroll
          for (int k = 0; k < 4; ++k) { float bv = val; int bi2 = idx;
#pragma unroll
              for (int o = 1; o < 32; o <<= 1) { const float ov = __shfl_xor(bv, o); const int oi = __shfl_xor(bi2, o); if (ov > bv || (ov == bv && oi < bi2)) { bv = ov; bi2 = oi; } }
              tv[k] = bv; ti[k] = bi2; if (idx == bi2) val = -3e38f; }
          if (e == 0) { float ex[4], sum = 0.f;
#pragma unroll
              for (int k = 0; k < 4; ++k) { ex[k] = __expf(tv[k] - tv[0]); sum += ex[k]; }
              const float isum = 1.f / sum;
#pragma unroll
              for (int k = 0; k < 4; ++k) { const int asg = r * 4 + k; GATE[asg] = ex[k] * isum; const int rank = __hip_atomic_fetch_add(&LCNT[ti[k]], 1, __ATOMIC_RELAXED, __HIP_MEMORY_SCOPE_WORKGROUP); const int slot = __hip_atomic_fetch_add(&LCNT[32], 1, __ATOMIC_RELAXED, __HIP_MEMORY_SCOPE_WORKGROUP);
                  LENT[slot * 2] = asg; LENT[slot * 2 + 1] = (ti[k] << 16) | rank; } } }
        __syncthreads();
    }
    if (tid < 32) LBASE[tid] = LCNT[tid] > 0 ? atomicAdd(&CNT[tid * L::CNT_STRIDE], LCNT[tid]) : 0;
    __syncthreads();
    for (int i = tid; i < LCNT[32]; i += 512) { const int asg = LENT[i * 2], er = LENT[i * 2 + 1], ee = er >> 16, rank = er & 0xffff; LIST[(size_t)ee * LCAP + LBASE[ee] + rank] = asg; }
    __syncthreads();
}
__device__ __forceinline__ void smallw_phase(const float* w_uq, const float* qg, const float* w_ukv, const float* kvg, const float* w_a, const float* w_i, bf16_t* WUQT, bf16_t* WUKVT, bf16_t* WAT, bf16_t* WIT,
                                             float* TABC, float* TABS, const float* lam, float* SPT, const float* rw, bf16_t* RWHp, bf16_t* RWLp, int gt, int NGT) {
    for (int i = gt; i < 2 * 384 * 256; i += NGT) { const int l = i / (384 * 256), q = i % (384 * 256), n = q >> 8, k = q & 255; WUQT[i] = f2bf(qg[l * 256 + k] * w_uq[((size_t)l * 256 + k) * 384 + n]); }
    for (int i = gt; i < 2 * 512 * 128; i += NGT) { const int l = i / (512 * 128), q = i % (512 * 128), n = q >> 7, k = q & 127; WUKVT[i] = f2bf(kvg[l * 128 + k] * w_ukv[((size_t)l * 128 + k) * 512 + n]); }
    for (int i = gt; i < 16 * 4096; i += NGT) { const int m = i >> 12, q = i & 4095, e = q >> 6, d = q & 63; WAT[i] = f2bf(w_a[(size_t)m * 4096 + d * 64 + e]); WIT[i] = f2bf(w_i[(size_t)m * 4096 + d * 64 + e]); }
    for (int i = gt; i < 4096; i += NGT) { float s, c; sincospif((float)i / 2048.f, &s, &c); TABC[i] = c; TABS[i] = s; }
    for (int i = gt; i < 1024; i += NGT) SPT[i] = log1pf(__expf(-lam[i]));
    for (int i = gt; i < 2 * NE * D; i += NGT) { const int l = i / (NE * D), q = i % (NE * D), e = q >> 10, k = q & 1023; const float w = rw[((size_t)l * D + k) * NE + e]; const bf16_t h = f2bf(w); RWHp[i] = h; RWLp[i] = f2bf(w - bf2f(h)); }
}
}

namespace prep {
constexpr int O_KR = 0, O_CS = 8192, O_RS = 16384, O_CQ = 16896  , O_KS = 67072, O_CKV = 100864;
constexpr int CQP = 264, CKP = 136, QSP = 392, KSP = 264;
constexpr float C2 = 0.10206207261596577f * 1.4426950408889634f;
__device__ __forceinline__ void qkv_units(LAS unsigned char* lds, int l, const bf16_t* P, const bf16_t* WUQT, const bf16_t* WUKVT, const float* scw, const float* scb,
                                          bf16_t* QL, bf16_t* QC, bf16_t* KB, bf16_t* VTG, bf16_t* MIX, int u0, int u1, int ustep) {
    LAS float* KRo = (LAS float*)(lds + O_KR); LAS float* CS = (LAS float*)(lds + O_CS); LAS float* RS = (LAS float*)(lds + O_RS);
    LAS bf16_t* CQ = (LAS bf16_t*)(lds + O_CQ); LAS bf16_t* CK = (LAS bf16_t*)(lds + O_CKV); LAS bf16_t* KS = (LAS bf16_t*)(lds + O_KS); LAS bf16_t* QS = (LAS bf16_t*)(lds + O_CQ);
    for (int unit = u0; unit < u1; unit += ustep) {
        int tid_l = threadIdx.x; asm volatile("" : "+v"(tid_l));
        const int tid = tid_l, lane = tid & 63, w = __builtin_amdgcn_readfirstlane(tid >> 6), fr = lane & 15, fq = lane >> 4;
        const int b = unit / 68, chunk = unit % 68, pos0 = 64 * chunk; const bool ctxt = chunk < 4; const size_t r0 = (size_t)b * NPOS + pos0;
#pragma unroll
        for (int i = 0; i < 4; ++i) { const int q = tid + 512 * i, row = q >> 5, ch = q & 31; *(LAS u32x4*)((LAS unsigned char*)CQ + row * (CQP * 2) + ch * 16) = *(const u32x4*)(P + (r0 + row) * PP + C_CQ + ch * 8); }
#pragma unroll
        for (int i = 0; i < 2; ++i) { const int q = tid + 512 * i, row = q >> 4, ch = q & 15; *(LAS u32x4*)((LAS unsigned char*)CK + row * (CKP * 2) + ch * 16) = *(const u32x4*)(P + (r0 + row) * PP + C_CKV + ch * 8); }
        __syncthreads();
        { const int row = tid >> 3, j = tid & 7; float sq = 0.f, sk = 0.f;
#pragma unroll
          for (int i = 0; i < 4; ++i) { const u32x4 v = *(const LAS u32x4*)((const LAS unsigned char*)CQ + row * (CQP * 2) + j * 64 + i * 16);
#pragma unroll
              for (int e = 0; e < 4; ++e) { const float a = __uint_as_float(v[e] << 16), c = __uint_as_float(v[e] & 0xffff0000u); sq += a * a + c * c; } }
#pragma unroll
          for (int i = 0; i < 2; ++i) { const u32x4 v = *(const LAS u32x4*)((const LAS unsigned char*)CK + row * (CKP * 2) + j * 32 + i * 16);
#pragma unroll
              for (int e = 0; e < 4; ++e) { const float a = __uint_as_float(v[e] << 16), c = __uint_as_float(v[e] & 0xffff0000u); sk += a * a + c * c; } }
          sq += __shfl_xor(sq, 1); sq += __shfl_xor(sq, 2); sq += __shfl_xor(sq, 4); sk += __shfl_xor(sk, 1); sk += __shfl_xor(sk, 2); sk += __shfl_xor(sk, 4);
          if (j == 0) { RS[row * 2] = rsqrtf(sq * (1.f / 256.f) + 1e-6f); RS[row * 2 + 1] = rsqrtf(sk * (1.f / 128.f) + 1e-6f); }
          float cr = 1.f, sr = 0.f, cc = 1.f, sc = 0.f;
          if (!ctxt) { const int t = pos0 - CTX + row; const float inv = __expf(-9.210340371976184f * (float)j * 0.125f); float xa = (float)(t >> 6) * inv * 0.15915494309189535f; xa -= rintf(xa); sr = __sinf(xa * 6.283185307179586f); cr = __cosf(xa * 6.283185307179586f); float xb = (float)(t & 63) * inv * 0.15915494309189535f; xb -= rintf(xb); sc = __sinf(xb * 6.283185307179586f); cc = __cosf(xb * 6.283185307179586f); }
          CS[(row * 16 + j) * 2] = cr; CS[(row * 16 + j) * 2 + 1] = sr; CS[(row * 16 + 8 + j) * 2] = cc; CS[(row * 16 + 8 + j) * 2 + 1] = sc;
          const bf16_t* kp = P + (r0 + row) * PP + C_KR; const float z0 = bf2f(kp[j]), z1 = bf2f(kp[8 + j]), z2 = bf2f(kp[16 + j]), z3 = bf2f(kp[24 + j]);
          KRo[row * 32 + j] = z0 * cr - z1 * sr; KRo[row * 32 + 8 + j] = z0 * sr + z1 * cr; KRo[row * 32 + 16 + j] = z2 * cc - z3 * sc; KRo[row * 32 + 24 + j] = z2 * sc + z3 * cc; }
        __builtin_amdgcn_sched_barrier(0);
        { f32x4 qa[4][3];
#pragma unroll
          for (int mt = 0; mt < 4; ++mt)
#pragma unroll
              for (int n = 0; n < 3; ++n) qa[mt][n] = (f32x4){0.f, 0.f, 0.f, 0.f};
          const bf16_t* wq = WUQT + ((size_t)l * 384 + 48 * w + fr) * 256 + 8 * fq;
#pragma unroll
          for (int ks = 0; ks < 8; ++ks) { bf16x8 a[4], bb[3];
#pragma unroll
              for (int mt = 0; mt < 4; ++mt) a[mt] = *(const LAS bf16x8*)(CQ + (16 * mt + fr) * CQP + 32 * ks + 8 * fq);
#pragma unroll
              for (int n = 0; n < 3; ++n) bb[n] = *(const bf16x8*)(wq + (size_t)(16 * n) * 256 + 32 * ks);
#pragma unroll
              for (int mt = 0; mt < 4; ++mt)
#pragma unroll
                  for (int n = 0; n < 3; ++n) qa[mt][n] = __builtin_amdgcn_mfma_f32_16x16x32_bf16(a[mt], bb[n], qa[mt][n], 0, 0, 0); }
          __syncthreads();
#pragma unroll
          for (int n = 0; n < 3; ++n) { const int nt = 3 * w + n, m6 = nt % 6, col = 16 * nt + fr;
#pragma unroll
              for (int mt = 0; mt < 4; ++mt)
#pragma unroll
                  for (int i = 0; i < 4; ++i) { const int row = 16 * mt + 4 * fq + i; float v = qa[mt][n][i] * RS[row * 2];
                      if (m6 >= 4) { const float pv = __shfl_xor(v, 8); const int ci = (row * 16 + (m6 == 5 ? 8 : 0) + (fr & 7)) * 2; const float c = CS[ci], s = CS[ci + 1]; v = (fr < 8) ? v * c - pv * s : pv * s + v * c; }
                      QS[row * QSP + col] = f2bf(v * C2); } } }
        __builtin_amdgcn_sched_barrier(0);
        { f32x4 ka[4][4];
#pragma unroll
          for (int mt = 0; mt < 4; ++mt)
#pragma unroll
              for (int n = 0; n < 4; ++n) ka[mt][n] = (f32x4){0.f, 0.f, 0.f, 0.f};
          const bf16_t* wk = WUKVT + ((size_t)l * 512 + 64 * w + fr) * 128 + 8 * fq;
#pragma unroll
          for (int ks = 0; ks < 4; ++ks) { bf16x8 a[4], bb[4];
#pragma unroll
              for (int mt = 0; mt < 4; ++mt) a[mt] = *(const LAS bf16x8*)(CK + (16 * mt + fr) * CKP + 32 * ks + 8 * fq);
#pragma unroll
              for (int n = 0; n < 4; ++n) bb[n] = *(const bf16x8*)(wk + (size_t)(16 * n) * 128 + 32 * ks);
#pragma unroll
              for (int mt = 0; mt < 4; ++mt)
#pragma unroll
                  for (int n = 0; n < 4; ++n) ka[mt][n] = __builtin_amdgcn_mfma_f32_16x16x32_bf16(a[mt], bb[n], ka[mt][n], 0, 0, 0); }
          const int head = w >> 1;
          if ((w & 1) == 0) {
#pragma unroll
              for (int n = 0; n < 4; ++n)
#pragma unroll
                  for (int mt = 0; mt < 4; ++mt)
#pragma unroll
                      for (int i = 0; i < 4; ++i) { const int row = 16 * mt + 4 * fq + i; KS[row * KSP + head * 64 + 16 * n + fr] = f2bf(ka[mt][n][i] * RS[row * 2 + 1]); }
          } else {
#pragma unroll
              for (int n = 0; n < 4; ++n)
#pragma unroll
                  for (int mt = 0; mt < 4; ++mt) { const int rb = 16 * mt + 4 * fq; u32x2 o; o.x = pk2(ka[mt][n][0] * RS[rb * 2 + 1], ka[mt][n][1] * RS[rb * 2 + 3]); o.y = pk2(ka[mt][n][2] * RS[rb * 2 + 5], ka[mt][n][3] * RS[rb * 2 + 7]);
                      *(u32x2*)(VTG + ((size_t)(b * 4 + head) * 64 + 16 * n + fr) * NPOS + pos0 + rb) = o; } } }
        __syncthreads();
#pragma unroll
        for (int i = 0; i < 6; ++i) { const int q = tid + 512 * i, row = q / 48, rem = q % 48, head = rem / 12, ch = rem % 12, pos = pos0 + row;
            const u32x4 qv = *(const LAS u32x4*)((const LAS unsigned char*)QS + row * (QSP * 2) + (head * 96 + ch * 8) * 2);
            if (!ctxt) *(u32x4*)(QL + ((size_t)(b * 4 + head) * SEQ + (pos - CTX)) * 96 + ch * 8) = qv; else if (l == 0) *(u32x4*)(QC + ((size_t)(b * 4 + head) * CTX + pos) * 96 + ch * 8) = qv;
            u32x4 kv;
            if (ch < 8) kv = *(const LAS u32x4*)((const LAS unsigned char*)KS + row * (KSP * 2) + (head * 64 + ch * 8) * 2);
            else { const LAS float* kr = KRo + row * 32 + (ch - 8) * 8; kv.x = pk2(kr[0], kr[1]); kv.y = pk2(kr[2], kr[3]); kv.z = pk2(kr[4], kr[5]); kv.w = pk2(kr[6], kr[7]); }
            *(u32x4*)(KB + ((size_t)(b * 4 + head) * NPOS + pos) * 96 + ch * 8) = kv; }
        if (!(ctxt && l == 1)) { const int lo = ctxt ? 0 : CTX, hi = ctxt ? CTX : NPOS;
#pragma unroll
            for (int i = 0; i < 4; ++i) { const int q = tid + 512 * i, row = q >> 5, ch = q & 31, pos = pos0 + row; float acc[8];
#pragma unroll
                for (int e = 0; e < 8; ++e) acc[e] = scb[ch * 8 + e];
#pragma unroll
                for (int k = 0; k < 3; ++k) { const int p = pos - 1 + k; if (p >= lo && p < hi) { const bf16_t* pr = P + ((size_t)b * NPOS + p) * PP; const u32x4 sx = *(const u32x4*)(pr + C_SX + ch * 8), sc = *(const u32x4*)(pr + C_SC + ch * 8);
#pragma unroll
                        for (int e = 0; e < 4; ++e) { const float w0 = scw[k * 256 + ch * 8 + 2 * e], w1 = scw[k * 256 + ch * 8 + 2 * e + 1];
                            acc[2 * e] += w0 * (__uint_as_float(sx[e] << 16) * __uint_as_float(sc[e] << 16)); acc[2 * e + 1] += w1 * (__uint_as_float(sx[e] & 0xffff0000u) * __uint_as_float(sc[e] & 0xffff0000u)); } } }
                const u32x4 sb = *(const u32x4*)(P + (r0 + row) * PP + C_SB + ch * 8); u32x4 o;
#pragma unroll
                for (int e = 0; e < 4; ++e) o[e] = pk2(__uint_as_float(sb[e] << 16) * acc[2 * e], __uint_as_float(sb[e] & 0xffff0000u) * acc[2 * e + 1]);
                *(u32x4*)(MIX + (r0 + row) * D + 768 + ch * 8) = o; } }
        __syncthreads();
    }
}
}

namespace lru {
constexpr int XP = 264, O_X = 0, O_NA = 33792, O_BB = 66560;
__device__ __forceinline__ float sigm(float x) { return __builtin_amdgcn_rcpf(1.f + __expf(-x)); }
__device__ __forceinline__ void chunk_units(LAS unsigned char* lds, int l, const bf16_t* P, const float* conv_w, const float* conv_b, const bf16_t* WAT, const bf16_t* WIT, const float* b_a, const float* b_i, const float* SPT,
                                            bf16_t* HL, bf16_t* AC, float* SUM, int u0, int u1, int ustep, int knob) {
    LAS bf16_t* X = (LAS bf16_t*)(lds + O_X); LAS bf16_t* NA = (LAS bf16_t*)(lds + O_NA); LAS bf16_t* BB = (LAS bf16_t*)(lds + O_BB);
    for (int unit = u0; unit < u1; unit += ustep) {
        int tid_l = threadIdx.x; asm volatile("" : "+v"(tid_l));
        const int tid = tid_l, lane = tid & 63, w = __builtin_amdgcn_readfirstlane(tid >> 6), fr = lane & 15, fq = lane >> 4;
        const int dir = unit & 1, bc = unit >> 1, b = bc / 68, chunk = bc % 68, pos0 = 64 * chunk; const int lo = chunk < 4 ? 0 : CTX, hi = chunk < 4 ? CTX : NPOS, left = dir ? 1 : 2;
        const size_t r0 = (size_t)b * NPOS + pos0; const int pd = (l * 2 + dir) * 256;
        if (!(knob & 1)) { const int cg = tid & 31, ts = tid >> 5, c0 = cg * 8; float wv[4][8], cbv[8];
#pragma unroll
          for (int e = 0; e < 8; ++e) { cbv[e] = conv_b[pd + c0 + e];
#pragma unroll
              for (int k = 0; k < 4; ++k) wv[k][e] = conv_w[(size_t)pd * 4 + k * 256 + c0 + e]; }
          const bf16_t* pc = P + (size_t)b * NPOS * PP + C_LX + c0; const int pb = pos0 + 4 * ts - left;
          u32x4 u[7];
#pragma unroll
          for (int i = 0; i < 7; ++i) { const int p = pb + i; const int pcl = p < lo ? lo : (p >= hi ? hi - 1 : p); u[i] = *(const u32x4*)(pc + (size_t)pcl * PP); if (p < lo || p >= hi) u[i] = (u32x4){0u, 0u, 0u, 0u}; }
#pragma unroll
          for (int i = 0; i < 4; ++i) { u32x4 o;
#pragma unroll
              for (int e2 = 0; e2 < 4; ++e2) { float lo_ = cbv[2 * e2], hi_ = cbv[2 * e2 + 1];
#pragma unroll
                  for (int k = 0; k < 4; ++k) { const unsigned d = u[i + k][e2]; lo_ += wv[k][2 * e2] * __uint_as_float(d << 16); hi_ += wv[k][2 * e2 + 1] * __uint_as_float(d & 0xffff0000u); }
                  o[e2] = pk2(lo_, hi_); }
              *(LAS u32x4*)(X + (4 * ts + i) * XP + c0) = o; } }
        __syncthreads();
        if (!(knob & 2)) { const int h = w >> 1, mh = w & 1;
          f32x4 ra[2][4], ri[2][4];
#pragma unroll
          for (int m = 0; m < 2; ++m)
#pragma unroll
              for (int n = 0; n < 4; ++n) { ra[m][n] = (f32x4){0.f, 0.f, 0.f, 0.f}; ri[m][n] = (f32x4){0.f, 0.f, 0.f, 0.f}; }
          const bf16_t* wa = WAT + ((size_t)((l * 2 + dir) * 4 + h) * 64 + fr) * 64 + 8 * fq; const bf16_t* wi = WIT + ((size_t)((l * 2 + dir) * 4 + h) * 64 + fr) * 64 + 8 * fq;
#pragma unroll
          for (int ks = 0; ks < 2; ++ks) { bf16x8 a[2], ba[4], bi[4];
#pragma unroll
              for (int m = 0; m < 2; ++m) a[m] = *(const LAS bf16x8*)(X + (16 * (2 * mh + m) + fr) * XP + 64 * h + 32 * ks + 8 * fq);
#pragma unroll
              for (int n = 0; n < 4; ++n) { ba[n] = *(const bf16x8*)(wa + (size_t)(16 * n) * 64 + 32 * ks); bi[n] = *(const bf16x8*)(wi + (size_t)(16 * n) * 64 + 32 * ks); }
#pragma unroll
              for (int m = 0; m < 2; ++m)
#pragma unroll
                  for (int n = 0; n < 4; ++n) { ra[m][n] = __builtin_amdgcn_mfma_f32_16x16x32_bf16(a[m], ba[n], ra[m][n], 0, 0, 0); ri[m][n] = __builtin_amdgcn_mfma_f32_16x16x32_bf16(a[m], bi[n], ri[m][n], 0, 0, 0); } }
#pragma unroll
          for (int n = 0; n < 4; ++n) { const int c = 64 * h + 16 * n + fr; const float bav = b_a[pd + c], biv = b_i[pd + c], sp8 = 8.f * SPT[pd + c];
#pragma unroll
              for (int m = 0; m < 2; ++m)
#pragma unroll
                  for (int i = 0; i < 4; ++i) { const int t = 16 * (2 * mh + m) + 4 * fq + i; const float r = sigm(ra[m][n][i] + bav), ig = sigm(ri[m][n][i] + biv);
                      const float x = r * sp8; const float na = x < 0.03125f ? x * (1.f - 0.5f * x * (1.f - 0.33333334f * x * (1.f - 0.25f * x))) : 1.f - __expf(-x); const float xv = bf2f(X[t * XP + c]);
                      NA[t * 256 + c] = f2bf(na); BB[t * 256 + c] = f2bf(__builtin_amdgcn_sqrtf(fmaxf(na * (2.f - na), 0.f)) * (ig * xv)); } } }
        __syncthreads();
        if (tid < 256 && !(knob & 4)) { const int c = tid; float hst = 0.f, A = 1.f;
            if (dir == 0) {
#pragma unroll 8
                for (int t = 0; t < 64; ++t) { const float a = 1.f - bf2f(NA[t * 256 + c]); hst = a * hst + bf2f(BB[t * 256 + c]); A *= a; BB[t * 256 + c] = f2bf(hst); NA[t * 256 + c] = f2bf(A); }
            } else {
#pragma unroll 8
                for (int t = 63; t >= 0; --t) { const float a = 1.f - bf2f(NA[t * 256 + c]); hst = a * hst + bf2f(BB[t * 256 + c]); A *= a; BB[t * 256 + c] = f2bf(hst); NA[t * 256 + c] = f2bf(A); }
            }
            float* sm = SUM + ((size_t)(dir * 4 + b) * 68 + chunk) * 512; sm[c] = A; sm[256 + c] = hst; }
        __syncthreads();
        if (!(knob & 4)) {
#pragma unroll
            for (int i = 0; i < 4; ++i) { const int q = tid + 512 * i, t = q >> 5, ch = q & 31; const size_t go = ((size_t)dir * MROWS + r0 + t) * 256 + ch * 8;
                *(u32x4*)(AC + go) = *(const LAS u32x4*)(NA + t * 256 + ch * 8); *(u32x4*)(HL + go) = *(const LAS u32x4*)(BB + t * 256 + ch * 8); } }
        __syncthreads();
    }
}
__device__ __forceinline__ void fixup_units(LAS unsigned char* lds, int l, const bf16_t* P, const bf16_t* HL, const bf16_t* AC, const float* SUM, bf16_t* MIX, int G, int bx) {
    LAS float* CAR = (LAS float*)lds;
    for (int unit = bx; unit < 272; unit += G) {
        int tid_l = threadIdx.x; asm volatile("" : "+v"(tid_l));
        const int tid = tid_l;
        const int b = unit / 68, chunk = unit % 68; if (l == 1 && chunk < 4) continue;
        { const int dir = tid >> 8, c = tid & 255; const float* sp = SUM + ((size_t)(dir * 4 + b) * 68) * 512 + c;
          const int n_pre = dir == 0 ? chunk : (chunk < 4 ? 3 - chunk : 4 + (67 - chunk));
          float cy = 0.f;
          for (int j0 = 0; j0 < n_pre; j0 += 16) { float av[16], hv[16];
#pragma unroll
              for (int u = 0; u < 16; ++u) { const int n = j0 + u < n_pre ? j0 + u : n_pre - 1; const int j = dir == 0 ? n : (n < 4 ? 3 - n : 71 - n); av[u] = sp[(size_t)j * 512]; hv[u] = sp[(size_t)j * 512 + 256]; }
#pragma unroll
              for (int u = 0; u < 16; ++u) cy = (j0 + u < n_pre) ? hv[u] + av[u] * cy : cy; }
          CAR[tid] = cy; }
        __syncthreads();
        { const int cg = tid & 31, ts = tid >> 5, c0 = cg * 8; float cf[8], cb[8];
#pragma unroll
          for (int e = 0; e < 8; ++e) { cf[e] = CAR[c0 + e]; cb[e] = CAR[256 + c0 + e]; }
          const size_t r0 = (size_t)b * NPOS + 64 * chunk + 4 * ts;
          u32x4 hf[4], af[4], hb[4], ab[4], gt[4];
#pragma unroll
          for (int i = 0; i < 4; ++i) { const size_t r = r0 + i; hf[i] = *(const u32x4*)(HL + r * 256 + c0); af[i] = *(const u32x4*)(AC + r * 256 + c0); hb[i] = *(const u32x4*)(HL + ((size_t)MROWS + r) * 256 + c0); ab[i] = *(const u32x4*)(AC + ((size_t)MROWS + r) * 256 + c0);
              gt[i] = *(const u32x4*)(P + r * PP + C_LG + c0); }
#pragma unroll
          for (int i = 0; i < 4; ++i) { u32x4 o;
#pragma unroll
              for (int e2 = 0; e2 < 4; ++e2) { float res[2];
#pragma unroll
                  for (int hh = 0; hh < 2; ++hh) { const int e = 2 * e2 + hh;
                      const float vhf = hh ? __uint_as_float(hf[i][e2] & 0xffff0000u) : __uint_as_float(hf[i][e2] << 16), vaf = hh ? __uint_as_float(af[i][e2] & 0xffff0000u) : __uint_as_float(af[i][e2] << 16);
                      const float vhb = hh ? __uint_as_float(hb[i][e2] & 0xffff0000u) : __uint_as_float(hb[i][e2] << 16), vab = hh ? __uint_as_float(ab[i][e2] & 0xffff0000u) : __uint_as_float(ab[i][e2] << 16);
                      const float x = hh ? __uint_as_float(gt[i][e2] & 0xffff0000u) : __uint_as_float(gt[i][e2] << 16);
                      const float hsum = (vhf + vaf * cf[e]) + (vhb + vab * cb[e]);
                      const float u = 0.7978845608028654f * (x + 0.044715f * x * x * x); const float th_ = 1.f - 2.f * __builtin_amdgcn_rcpf(1.f + __expf(2.f * u));
                      res[hh] = 0.5f * x * (1.f + th_) * hsum; }
                  o[e2] = pk2(res[0], res[1]); }
              *(u32x4*)(MIX + (r0 + i) * D + 256 + c0) = o; } }
        __syncthreads();
    }
}
}

namespace fft {
__device__ __forceinline__ void ctx_a(LAS unsigned char* lds, const bf16_t* P, const float* TABC, const float* TABS, bf16_t* XCT, int G, int bx) {
    LAS bf16_t* U = (LAS bf16_t*)(lds + O_U); LAS bf16_t* X = (LAS bf16_t*)(lds + O_X);
    for (int unit = bx; unit < 16; unit += G) {
        int tid_l = threadIdx.x; asm volatile("" : "+v"(tid_l));
        const int tid = tid_l, lane = tid & 63, w = __builtin_amdgcn_readfirstlane(tid >> 6), fr = lane & 15, fq = lane >> 4;
        build_tables(lds, TABC, TABS, tid);
        const LAS bf16_t* Tc = (const LAS bf16_t*)(lds + O_TC); const LAS bf16_t* Ts = (const LAS bf16_t*)(lds + O_TS);
        const int b = unit >> 2, q = unit & 3;
#pragma unroll
        for (int i = 0; i < 4; ++i) { const int qq = tid + 512 * i, t1 = qq >> 5, ch = qq & 31;
            *(LAS u32x4*)((LAS unsigned char*)U + t1 * (UP * 2) + ch * 16) = *(const u32x4*)(P + ((size_t)b * NPOS + 64 * q + t1) * PP + ch * 8); }
        __syncthreads();
        { const int g = w >> 1, part = w & 1; const LAS bf16_t* T = part ? Ts : Tc;
          f32x4 acc[4][4];
#pragma unroll
          for (int mt = 0; mt < 4; ++mt)
#pragma unroll
              for (int nt = 0; nt < 4; ++nt) acc[mt][nt] = (f32x4){0.f, 0.f, 0.f, 0.f};
#pragma unroll
          for (int ks = 0; ks < 2; ++ks) { bf16x8 a[4], bb[4];
#pragma unroll
              for (int mt = 0; mt < 4; ++mt) a[mt] = *(const LAS bf16x8*)(U + (16 * mt + fr) * UP + g * 64 + 32 * ks + 8 * fq);
#pragma unroll
              for (int nt = 0; nt < 4; ++nt) bb[nt] = *(const LAS bf16x8*)(T + (16 * nt + fr) * TP + 32 * ks + 8 * fq);
#pragma unroll
              for (int mt = 0; mt < 4; ++mt)
#pragma unroll
                  for (int nt = 0; nt < 4; ++nt) acc[mt][nt] = __builtin_amdgcn_mfma_f32_16x16x32_bf16(a[mt], bb[nt], acc[mt][nt], 0, 0, 0); }
          const float sg = part ? -1.f : 1.f;
#pragma unroll
          for (int mt = 0; mt < 4; ++mt)
#pragma unroll
              for (int nt = 0; nt < 4; ++nt) { const f32x4 v = acc[mt][nt] * sg; u32x2 o; o.x = pk2(v[0], v[1]); o.y = pk2(v[2], v[3]);
                  *(LAS u32x2*)(X + (part * 256 + g * 64 + 16 * nt + fr) * TP + 16 * mt + 4 * fq) = o; } }
        __syncthreads();
#pragma unroll
        for (int i = 0; i < 8; ++i) { const int qq = tid + 512 * i, row = qq >> 3, c8 = qq & 7;
            *(u32x4*)(XCT + (((size_t)b * 4 + q) * 512 + row) * 64 + c8 * 8) = *(const LAS u32x4*)((const LAS unsigned char*)X + row * (TP * 2) + c8 * 16); }
        __syncthreads();
    }
}
__device__ __forceinline__ void ctx_b(LAS unsigned char* lds, const bf16_t* XCT, const float* TABC, const float* TABS, bf16_t* MIX, int G, int bx) {
    LAS bf16_t* Tc = (LAS bf16_t*)(lds + O_TC); LAS bf16_t* Ts = (LAS bf16_t*)(lds + O_TS);
    LAS bf16_t* Ys = (LAS bf16_t*)(lds + O_U); LAS bf16_t* ZT = (LAS bf16_t*)(lds + O_X);
    for (int unit = bx; unit < 16; unit += G) {
        int tid_l = threadIdx.x; asm volatile("" : "+v"(tid_l));
        const int tid = tid_l, lane = tid & 63, w = __builtin_amdgcn_readfirstlane(tid >> 6), fr = lane & 15, fq = lane >> 4;
        const int b = unit >> 2, ft = unit & 3;
        f32x4 y[4][2];
#pragma unroll
        for (int mt = 0; mt < 4; ++mt)
#pragma unroll
            for (int n = 0; n < 2; ++n) y[mt][n] = (f32x4){0.f, 0.f, 0.f, 0.f};
        for (int q = 0; q < 4; ++q) {
            for (int i = tid; i < 4096; i += 512) { const int fl = i >> 6, tl = i & 63, ix = (((64 * ft + fl) * (64 * q + tl)) & 255) * 16; Tc[fl * TP + tl] = f2bf(TABC[ix]); Ts[fl * TP + tl] = f2bf(TABS[ix]); }
#pragma unroll
            for (int i = 0; i < 8; ++i) { const int qq = tid + 512 * i, row = qq >> 3, c8 = qq & 7;
                *(LAS u32x4*)((LAS unsigned char*)ZT + row * (TP * 2) + c8 * 16) = *(const u32x4*)(XCT + (((size_t)b * 4 + q) * 512 + row) * 64 + c8 * 8); }
            __syncthreads();
#pragma unroll
            for (int ks = 0; ks < 2; ++ks) { bf16x8 xr[2], xi[2];
#pragma unroll
                for (int n = 0; n < 2; ++n) { xr[n] = *(const LAS bf16x8*)(ZT + (32 * w + 16 * n + fr) * TP + 32 * ks + 8 * fq); xi[n] = *(const LAS bf16x8*)(ZT + (256 + 32 * w + 16 * n + fr) * TP + 32 * ks + 8 * fq); }
#pragma unroll
                for (int mt = 0; mt < 4; ++mt) { const bf16x8 c = *(const LAS bf16x8*)(Tc + (16 * mt + fr) * TP + 32 * ks + 8 * fq), s = *(const LAS bf16x8*)(Ts + (16 * mt + fr) * TP + 32 * ks + 8 * fq);
#pragma unroll
                    for (int n = 0; n < 2; ++n) { y[mt][n] = __builtin_amdgcn_mfma_f32_16x16x32_bf16(c, xr[n], y[mt][n], 0, 0, 0); y[mt][n] = __builtin_amdgcn_mfma_f32_16x16x32_bf16(s, xi[n], y[mt][n], 0, 0, 0); } } }
            __syncthreads();
        }
#pragma unroll
        for (int mt = 0; mt < 4; ++mt)
#pragma unroll
            for (int i = 0; i < 4; ++i)
#pragma unroll
                for (int n = 0; n < 2; ++n) Ys[(16 * mt + 4 * fq + i) * UP + 32 * w + 16 * n + fr] = f2bf(y[mt][n][i] * (1.f / 128.f));
        __syncthreads();
#pragma unroll
        for (int i = 0; i < 4; ++i) { const int qq = tid + 512 * i, fl = qq >> 5, ch = qq & 31;
            *(u32x4*)(MIX + ((size_t)b * NPOS + 64 * ft + fl) * D + ch * 8) = *(const LAS u32x4*)((const LAS unsigned char*)Ys + fl * (UP * 2) + ch * 16); }
        __syncthreads();
    }
}
}

constexpr int NWAVES = 8, RING_BYTES = 131072 + 3072, LDSCTL_OFF = RING_BYTES, MISC_OFF = LDSCTL_OFF + 64, META_OFF = MISC_OFF + 64, LDS_BYTES = 147456;
enum { PH_PRO0 = 0, PH_PRO1 = 1, PH_L0 = 2, PH_PER_LAYER = 8, PH_N = 18 };
enum { PL_WIN = 0, PL_PREP = 1, PL_MIX = 2, PL_WOUT = 3, PL_ROUTE = 4, PL_MOE1 = 5, PL_MOE2 = 6, PL_COMB = 7 };
struct MArgs { const float* in[30]; float* out; unsigned char* ws; int npass, skip_mask, dup_ph, dup_n, dup_sub, knob; };

__device__ __forceinline__ void transpose_item(const float* W, int K, int N, bf16_t* WT, int drow0, LAS float* scr, int k0, int n0, int lane) {
    const int kr = lane >> 3, nc = (lane & 7) * 4;
    f32x4 v[8];
#pragma unroll
    for (int i = 0; i < 8; ++i) v[i] = __builtin_nontemporal_load((const f32x4*)(W + (size_t)(k0 + kr + 8 * i) * N + n0 + nc));
#pragma unroll
    for (int i = 0; i < 8; ++i) { LAS float* d = scr + (kr + 8 * i) * 33 + nc; d[0] = v[i][0]; d[1] = v[i][1]; d[2] = v[i][2]; d[3] = v[i][3]; }
    asm volatile("s_waitcnt lgkmcnt(0)" ::: "memory");
    const int c = lane & 7;
#pragma unroll
    for (int j = 0; j < 4; ++j) { const int n = (lane >> 3) + 8 * j; const LAS float* s = scr + (8 * c) * 33 + n;
        u32x4 o; o.x = pk2(s[0 * 33], s[1 * 33]); o.y = pk2(s[2 * 33], s[3 * 33]); o.z = pk2(s[4 * 33], s[5 * 33]); o.w = pk2(s[6 * 33], s[7 * 33]);
        *(u32x4*)(WT + (size_t)(drow0 + n) * K + k0 + 8 * c) = o; }
    asm volatile("s_waitcnt lgkmcnt(0)" ::: "memory");
}

constexpr int I_GU = NE * 16 * 64, I_DN = NE * 16 * 32, I_EXP = I_GU + I_DN;
__device__ __forceinline__ void expert_item(int l, int j, const float* wgu, const float* wdn, unsigned char* ws, LAS float* scr, int lane) {
    if (j < I_GU) { const int e = j / (16 * 64), q = j % (16 * 64), kb = q / 64, nb = q % 64; const int n0 = 32 * nb; const int c2 = n0 & 1023; const int drow = (c2 >> 7) * 256 + (n0 >> 10) * 128 + (c2 & 127);
        transpose_item(wgu + ((size_t)l * NE + e) * D * 2048, D, 2048, (bf16_t*)(ws + L::WGUT) + ((size_t)l * NE + e) * 2048 * D, drow, scr, 64 * kb, n0, lane); }
    else { const int r = j - I_GU; const int e = r / (16 * 32), q = r % (16 * 32), kb = q / 32, nb = q % 32;
        transpose_item(wdn + ((size_t)l * NE + e) * D * D, D, D, (bf16_t*)(ws + L::WDT) + ((size_t)l * NE + e) * D * D, 32 * nb, scr, 64 * kb, 32 * nb, lane); }
}
constexpr int Q_WIN = 48, Q_WOUT = 96, Q_MOE2 = 0;
constexpr int DEF_WIN = 224 * Q_WIN, DEF0 = DEF_WIN + 240 * Q_WOUT, DEF_MOE2 = 128 * Q_MOE2, DEF1 = DEF_MOE2 + 224 * Q_WIN;
__device__ __forceinline__ void deferred_items(int l, int first, int count, const float* wgu, const float* wdn, unsigned char* ws, LAS unsigned char* lds, int wave, int lane) {
    LAS float* scr = (LAS float*)(lds + wave * 16384);
    for (int j = first + wave; j < first + count; j += NWAVES) expert_item(l, j, wgu, wdn, ws, scr, lane);
}

#define GASP __attribute__((address_space(1)))
#define ARG_IN(i) ({ const GASP float* _p; asm volatile("s_load_dwordx2 %0, %1, %2\n\ts_waitcnt lgkmcnt(0)" : "=s"(_p) : "s"(__builtin_amdgcn_kernarg_segment_ptr()), "n"((i) * 8)); (const float*)_p; })
__global__ void __launch_bounds__(NWAVES * 64, 2) mega(MArgs args) {
    extern __shared__ __attribute__((aligned(16))) unsigned char lds_raw[];
    const int G0 = gridDim.x, bx0 = blockIdx.x;
    unsigned char* ws0 = args.ws;
    unsigned* ctl0 = (unsigned*)(ws0 + L::CTL);
    for (int u = threadIdx.x; u < (LDS_BYTES - LDSCTL_OFF) / 4; u += NWAVES * 64) ((LAS unsigned*)(lds_raw + LDSCTL_OFF))[u] = 0u;
    __syncthreads();
    volatile LAS unsigned* MISC = (volatile LAS unsigned*)((LAS unsigned char*)lds_raw + MISC_OFF);
    XcdBarrier bar = xcd_barrier_post(ctl0 + L::CW_BAR, MISC);
    const int lo = 0, hi = PH_N;

    bool first = true;
    for (int pass = 0; pass < args.npass; ++pass)
    for (int ph = lo; ph < hi; ++ph) {
      const int reps = (ph == args.dup_ph) ? 1 + args.dup_n : 1;
      if (ph == PH_PRO1) continue;
      for (int rep = 0; rep < reps; ++rep) {
        if (!first) xcd_barrier(bar);
        first = false;
        if (pass + 1 < args.npass && ((args.skip_mask >> ph) & 1)) continue;
        const int sub = rep + 1 < reps ? args.dup_sub : 15; const int knob = rep + 1 < reps ? args.knob : 0; (void)knob;
        GASP unsigned char* wsg = (GASP unsigned char*)args.ws; asm volatile("" : "+s"(wsg)); unsigned char* ws = (unsigned char*)wsg;
        unsigned* ctl = (unsigned*)(ws + L::CTL);
        int tid_p = threadIdx.x; asm volatile("" : "+v"(tid_p));
        int G = G0, bx = bx0; asm volatile("" : "+s"(G), "+s"(bx));
        const int vcu = (G % 8 == 0) ? (bx % 8) * (G / 8) + bx / 8 : bx; (void)vcu;
        unsigned ldsb = 0; asm volatile("" : "+s"(ldsb)); LAS unsigned char* lds = (LAS unsigned char*)lds_raw + ldsb;
        LAS int* META = (LAS int*)(lds + META_OFF);
        const int tid = tid_p, lane = tid & 63, wave = __builtin_amdgcn_readfirstlane(tid >> 6); (void)lane; (void)wave;
        if (ph == PH_PRO0) {
            if (bx == 0 && tid < 2 * NE) ((int*)(ctl + L::CW_CNT))[tid * L::CNT_STRIDE] = 0;
            sm::smallw_phase(ARG_IN(17), ARG_IN(16), ARG_IN(19), ARG_IN(18), ARG_IN(11), ARG_IN(13), (bf16_t*)(ws + L::WUQT), (bf16_t*)(ws + L::WUKVT), (bf16_t*)(ws + L::WAT), (bf16_t*)(ws + L::WIT),
                             (float*)(ws + L::TABC), (float*)(ws + L::TABS), ARG_IN(15), (float*)(ws + L::SPT), ARG_IN(23), (bf16_t*)(ws + L::RWH), (bf16_t*)(ws + L::RWL), bx * 512 + tid, G * 512);
            __syncthreads();
            sm::mod_phase(lds, ARG_IN(1), ARG_IN(3), ARG_IN(4), ARG_IN(5), (float*)(ws + L::MOD), G, bx, tid);
            { int nmine = 0; for (int u = bx; u < 96; u += G) ++nmine;
              if (nmine) { asm volatile("s_waitcnt vmcnt(0)" ::: "memory"); __syncthreads();
                  if (tid == 0) { __builtin_amdgcn_fence(__ATOMIC_RELEASE, "agent"); asm volatile("s_waitcnt vmcnt(0)" ::: "memory"); __hip_atomic_fetch_add(ctl + L::CW_MODCNT, (unsigned)nmine, __ATOMIC_RELAXED, __HIP_MEMORY_SCOPE_AGENT); } } }
            __syncthreads();
            LAS float* scr = (LAS float*)(lds + wave * 16384);
            const int gw = vcu * NWAVES + wave, NGW = G * NWAVES;
            constexpr int I_IN = 16 * 61, I_OUT = 16 * 32, I_D = I_IN + I_OUT; const int d0 = G == 256 ? DEF0 : 0, d1 = G == 256 ? DEF1 : 0, R0 = I_EXP - d0, R1 = I_EXP - d1;
            for (int it = gw; it < 2 * I_D + R0 + R1; it += NGW) {
                if (it < 2 * I_D) { const int l = it / I_D; int r = it % I_D;
                    if (r < I_IN) { const int kb = r / 61, nb = r % 61; transpose_item(ARG_IN(8) + (size_t)l * D * PT, D, PT, (bf16_t*)(ws + L::WINT) + (size_t)l * 2048 * D, 32 * nb, scr, 64 * kb, 32 * nb, lane); }
                    else { r -= I_IN; const int kb = r / 32, nb = r % 32; transpose_item(ARG_IN(22) + (size_t)l * D * D, D, D, (bf16_t*)(ws + L::WOUTT) + (size_t)l * D * D, 32 * nb, scr, 64 * kb, 32 * nb, lane); }
                } else { const int r = it - 2 * I_D; if (r < R0) expert_item(0, d0 + r, ARG_IN(25), ARG_IN(27), ws, scr, lane); else expert_item(1, d1 + (r - R0), ARG_IN(25), ARG_IN(27), ws, scr, lane); }
            }
            for (int i = bx * 512 + tid; i < 2 * 96 * D / 8; i += G * 512) { const int l = i / (96 * D / 8), q = i % (96 * D / 8); *(u32x4*)((bf16_t*)(ws + L::WINT) + ((size_t)l * 2048 + PT) * D + (size_t)q * 8) = (u32x4){0u, 0u, 0u, 0u}; }
            if (tid == 0) { unsigned sp = 0; while (__hip_atomic_load(ctl + L::CW_MODCNT, __ATOMIC_RELAXED, __HIP_MEMORY_SCOPE_AGENT) < 96u && ++sp < (1u << 22)) __builtin_amdgcn_s_sleep(2);
                __builtin_amdgcn_fence(__ATOMIC_ACQUIRE, "agent"); asm volatile("s_waitcnt vmcnt(0)" ::: "memory"); }
            __syncthreads();
            { const int nmod = G < 96 ? G : 96; const int small = 45, rs0 = bx < nmod ? bx * small : nmod * small + (int)(((long)(bx - nmod) * (MROWS - nmod * small)) / (G - nmod)),
                  rs1 = bx + 1 < nmod ? (bx + 1) * small : (bx + 1 >= G ? MROWS : nmod * small + (int)(((long)(bx + 1 - nmod) * (MROWS - nmod * small)) / (G - nmod)));
              sm::pro1_phase(ARG_IN(0), ARG_IN(2), ARG_IN(6), (const float*)(ws + L::MOD), (float*)(ws + L::H), (bf16_t*)(ws + L::XN), rs0 + wave, rs1, NWAVES, lane); }
            continue;
        }
        if (ph < PH_L0) continue;
        const int l = (ph - PH_L0) / PH_PER_LAYER, pl = (ph - PH_L0) % PH_PER_LAYER;
        const float* MODl = (const float*)(ws + L::MOD) + (size_t)l * 5 * 6144;
        if (pl == PL_WIN) {
            g8::DenseSched S; S.init(MROWS / 256, PP / 256, G, bx, 0, (const bf16_t*)(ws + L::WINT) + (size_t)l * 2048 * D, D);
            g8::EpiP E{(bf16_t*)(ws + L::P)};
            g8::gemm_phase<g8::EpiP, g8::DenseSched, false, false>(lds, (const char*)(ws + L::XN), S, E);
            if (G == 256 && bx >= 32) deferred_items(l, (l == 0 ? 0 : DEF_MOE2) + (bx - 32) * Q_WIN, Q_WIN, ARG_IN(25), ARG_IN(27), ws, lds, wave, lane);
        } else if (pl == PL_PREP) {
            if (l == 0 && (sub & 2)) { fft::ctx_a(lds, (const bf16_t*)(ws + L::P), (const float*)(ws + L::TABC), (const float*)(ws + L::TABS), (bf16_t*)(ws + L::XCT), G, G - 1 - bx); __syncthreads(); }
            for (int p = 0; p * G < 1072; ++p) {
                const int k = p * G + ((p & 1) ? G - 1 - bx : bx);
                if (k >= 1072) continue;
                if (k < 272) { if (sub & 4) prep::qkv_units(lds, l, (const bf16_t*)(ws + L::P), (const bf16_t*)(ws + L::WUQT), (const bf16_t*)(ws + L::WUKVT), ARG_IN(20) + l * 768, ARG_IN(21) + l * 256,
                            (bf16_t*)(ws + L::QL), (bf16_t*)(ws + L::QC), (bf16_t*)(ws + L::KB), (bf16_t*)(ws + L::VTG), (bf16_t*)(ws + L::MIX), k, k + 1, 1); }
                else if (k < 816) { if (sub & 8) lru::chunk_units(lds, l, (const bf16_t*)(ws + L::P), ARG_IN(9), ARG_IN(10), (const bf16_t*)(ws + L::WAT), (const bf16_t*)(ws + L::WIT), ARG_IN(12), ARG_IN(14), (const float*)(ws + L::SPT),
                             (bf16_t*)(ws + L::HL), (bf16_t*)(ws + L::AC), (float*)(ws + L::SUM), k - 272, k - 271, 1, knob); }
                else { if (sub & 1) fft::stage_a(lds, (const bf16_t*)(ws + L::P), (const float*)(ws + L::TABC), (const float*)(ws + L::TABS), (bf16_t*)(ws + L::ZBUF), k - 816, k - 815, 1); }
                __syncthreads();
            }
        } else if (pl == PL_MIX) {
            if (sub & 1) lru::fixup_units(lds, l, (const bf16_t*)(ws + L::P), (const bf16_t*)(ws + L::HL), (const bf16_t*)(ws + L::AC), (const float*)(ws + L::SUM), (bf16_t*)(ws + L::MIX), G, bx);
            if (sub & 2) fft::stage_b(lds, (const bf16_t*)(ws + L::ZBUF), (const float*)(ws + L::TABC), (const float*)(ws + L::TABS), (bf16_t*)(ws + L::MIX), G, bx);
            __syncthreads();
            if (l == 0 && (sub & 4)) { fft::ctx_b(lds, (const bf16_t*)(ws + L::XCT), (const float*)(ws + L::TABC), (const float*)(ws + L::TABS), (bf16_t*)(ws + L::MIX), G, G - 1 - bx); __syncthreads(); }
            if (sub & 8) attn::attn_phase(lds, (const bf16_t*)(ws + L::QL), (const bf16_t*)(ws + L::QC), (const bf16_t*)(ws + L::KB), (const bf16_t*)(ws + L::VTG), (bf16_t*)(ws + L::MIX), l == 0 ? 1 : 0, G, vcu);
        } else if (pl == PL_WOUT) {
            g8::DenseSched S; S.init(l == 0 ? MROWS / 256 : 64, D / 256, G, bx, l == 0 ? 0 : 1, (const bf16_t*)(ws + L::WOUTT) + (size_t)l * D * D, D);
            g8::EpiH E{(float*)(ws + L::H), MODl, 2048};
            g8::gemm_phase<g8::EpiH, g8::DenseSched, false, false>(lds, (const char*)(ws + L::MIX), S, E);
            if (G == 256 && l == 0 && bx >= 16) deferred_items(0, DEF_WIN + (bx - 16) * Q_WOUT, Q_WOUT, ARG_IN(25), ARG_IN(27), ws, lds, wave, lane);
        } else if (pl == PL_ROUTE) {
            sm::route_phase(lds, l, (const float*)(ws + L::H), ARG_IN(7) + l * D, MODl, (const bf16_t*)(ws + L::RWH), (const bf16_t*)(ws + L::RWL), ARG_IN(24) + l * NE, (bf16_t*)(ws + L::XN), (int*)(ctl + L::CW_CNT) + l * NE * L::CNT_STRIDE,
                            (int*)(ws + L::LIST) + (size_t)l * NE * LCAP, (float*)(ws + L::GATE), G, bx, tid);
        } else if (pl == PL_COMB) {
            sm::comb_phase(l, (float*)(ws + L::H), (const bf16_t*)(ws + L::Y), MODl, ARG_IN(6) + D, (const float*)(ws + L::MOD) + (size_t)5 * 6144, (bf16_t*)(ws + L::XN), ARG_IN(29), args.out, bx * NWAVES + wave, G * NWAVES, lane);
        } else if (pl == PL_MOE1 || pl == PL_MOE2) {
            const int* CNTg = (const int*)(ctl + L::CW_CNT) + l * NE * L::CNT_STRIDE;
            if (tid == 0) { int o = 0; for (int e = 0; e < NE; ++e) { const int cn = CNTg[e * L::CNT_STRIDE]; META[e] = o; META[64 + e] = cn; o += (cn + 255) >> 8; } META[NE] = o; }
            __syncthreads();
            g8::MoeSched S; S.tpre = META; S.cnt = META + 64; S.G = G; S.c = bx; S.K = D; S.list = (const int*)(ws + L::LIST) + (size_t)l * NE * LCAP;
            if (pl == PL_MOE1) {
                S.NT = 8; S.COLW = 128; S.total = __builtin_amdgcn_readfirstlane(META[NE]) * 8; S.Bt = (const char*)((const bf16_t*)(ws + L::WGUT) + (size_t)l * NE * 2048 * D);
                g8::EpiMoe1 E{(bf16_t*)(ws + L::ACT), ARG_IN(26) + (size_t)l * NE * 2048};
                g8::gemm_phase<g8::EpiMoe1, g8::MoeSched, true, true>(lds, (const char*)(ws + L::XN), S, E);
            } else {
                S.NT = 4; S.COLW = 256; S.total = __builtin_amdgcn_readfirstlane(META[NE]) * 4; S.Bt = (const char*)((const bf16_t*)(ws + L::WDT) + (size_t)l * NE * D * D);
                g8::EpiMoe2 E{(bf16_t*)(ws + L::Y), ARG_IN(28) + (size_t)l * NE * D, (const float*)(ws + L::GATE)};
                g8::gemm_phase<g8::EpiMoe2, g8::MoeSched, false, true>(lds, (const char*)(ws + L::ACT), S, E);
                if (G == 256 && l == 0 && bx >= 128) deferred_items(1, (bx - 128) * Q_MOE2, Q_MOE2, ARG_IN(25), ARG_IN(27), ws, lds, wave, lane);
            }
            __syncthreads();
        }
      }
    }
}
constexpr int PROBE_DUP_PH = -1, PROBE_DUP_N = 0, PROBE_DUP_SUB = 15, PROBE_KNOB = 0;
constexpr int PROBE_NPASS = 1, PROBE_SKIP = 0;
extern "C" void kernel_launch(void* const* d_in, const int* in_sizes, int n_in, void* d_out, int out_size, void* d_ws, size_t ws_size, hipStream_t stream) {
    static int grid = 0;
    if (grid == 0) {
        if (n_in != 30 || out_size != NB_ * SEQ * D || (size_t)L::END > ws_size) { fprintf(stderr, "kernel_launch: unexpected problem shape (n_in %d, out %d) or workspace too small (need %zu, have %zu); nothing launched\n", n_in, out_size, (size_t)L::END, ws_size); grid = -1; return; }
        int dev = 0, cus = 0;
        if (hipGetDevice(&dev) != hipSuccess || hipDeviceGetAttribute(&cus, hipDeviceAttributeMultiprocessorCount, dev) != hipSuccess) { fprintf(stderr, "kernel_launch: device query failed\n"); grid = -1; return; }
        if (hipFuncSetAttribute((const void*)mega, hipFuncAttributeMaxDynamicSharedMemorySize, LDS_BYTES) != hipSuccess) { fprintf(stderr, "kernel_launch: hipFuncSetAttribute failed\n"); grid = -1; return; }
        int per_cu = 0;
        if (hipOccupancyMaxActiveBlocksPerMultiprocessor(&per_cu, (const void*)mega, NWAVES * 64, LDS_BYTES) != hipSuccess || per_cu < 1) fprintf(stderr, "kernel_launch: note: the occupancy query reports %d workgroups per CU; launching one per CU anyway\n", per_cu);
        (void)hipGetLastError();
        grid = cus < 256 ? cus : 256;
    }
    if (grid < 0) return;
    unsigned char* p = (unsigned char*)d_ws;
    (void)hipMemsetAsync(p + L::CTL, 0, L::CTL_BYTES, stream);
    MArgs a{};
    for (int i = 0; i < 30; ++i) a.in[i] = (const float*)d_in[i];
    a.out = (float*)d_out; a.ws = p; a.npass = PROBE_NPASS; a.skip_mask = PROBE_SKIP; a.dup_ph = PROBE_DUP_PH; a.dup_n = PROBE_DUP_N; a.dup_sub = PROBE_DUP_SUB; a.knob = PROBE_KNOB;
    hipLaunchKernelGGL(mega, dim3(grid), dim3(NWAVES * 64), LDS_BYTES, stream, a);
}
```

```cpp
#include <hip/hip_runtime.h>
#include <cstdint>
#include <cstdio>

typedef unsigned short bf16_t;
constexpr int NB_ = 4, SEQ = 4096, CTX = 256, D = 1024, NPOS = SEQ + CTX, MROWS = NB_ * NPOS;
constexpr int PT = 1952, PP = 2048;
constexpr int NE = 32, TOPK = 4, LCAP = MROWS;
constexpr int NASG = MROWS * TOPK;
constexpr int ACT_ROWS = NASG + NE * 256;
constexpr int C_FN = 0, C_LX = 256, C_LG = 512, C_CQ = 768, C_CKV = 1024, C_KR = 1152, C_SX = 1184, C_SB = 1440, C_SC = 1696;

__device__ __forceinline__ float bf2f(bf16_t v) { return __uint_as_float((unsigned)v << 16); }
typedef float cv_f2 __attribute__((ext_vector_type(2))); typedef __bf16 cv_b2 __attribute__((ext_vector_type(2)));
__device__ __forceinline__ unsigned pk2(float lo, float hi) { cv_f2 v = {lo, hi}; return __builtin_bit_cast(unsigned, __builtin_convertvector(v, cv_b2)); }
__device__ __forceinline__ bf16_t f2bf(float f) { return (bf16_t)pk2(f, 0.f); }
__device__ __forceinline__ float wave_sum(float v) {
#pragma unroll
    for (int o = 1; o < 64; o <<= 1) v += __shfl_xor(v, o);
    return v;
}
__device__ __forceinline__ float sigmoidf_(float x) { return 1.f / (1.f + __expf(-x)); }
__device__ __forceinline__ float gelu_tanh(float x) { const float u = 0.7978845608028654f * (x + 0.044715f * x * x * x); return 0.5f * x * (1.f + tanhf(u)); }

#define LAS __attribute__((address_space(3)))
typedef short bf16x8 __attribute__((ext_vector_type(8)));
typedef float f32x4 __attribute__((ext_vector_type(4)));
typedef unsigned u32x4 __attribute__((ext_vector_type(4)));
typedef unsigned u32x2 __attribute__((ext_vector_type(2)));

namespace L {
constexpr size_t A256(size_t x) { return (x + 255) & ~(size_t)255; }
constexpr size_t CTL = 0, CTL_BYTES = 1u << 20;
constexpr size_t H = CTL + CTL_BYTES;
constexpr size_t MOD = CTL + 512 * 1024;
constexpr size_t TABC = A256(H + (size_t)MROWS * D * 4);
constexpr size_t TABS = A256(TABC + 4096 * 4);
constexpr size_t XN = A256(TABS + 4096 * 4);
constexpr size_t P = A256(XN + (size_t)MROWS * D * 2);
constexpr size_t MIX = A256(P + (size_t)MROWS * PP * 2);
constexpr size_t CQN = A256(MIX + (size_t)MROWS * D * 2);
constexpr size_t CKVN = A256(CQN + (size_t)MROWS * 256 * 2);
constexpr size_t QRAW = A256(CKVN + (size_t)MROWS * 128 * 2);
constexpr size_t KVRAW = A256(QRAW + (size_t)MROWS * 384 * 4);
constexpr size_t QL = A256(KVRAW + (size_t)MROWS * 512 * 4);
constexpr size_t QC = A256(QL + (size_t)16 * SEQ * 96 * 2);
constexpr size_t KB = A256(QC + (size_t)16 * CTX * 96 * 2);
constexpr size_t VB = A256(KB + (size_t)16 * NPOS * 96 * 2);
constexpr size_t LA = A256(VB + (size_t)16 * NPOS * 64 * 2);
constexpr size_t LB = A256(LA + (size_t)2 * MROWS * 256 * 4);
constexpr size_t HS = A256(LB + (size_t)2 * MROWS * 256 * 4);
constexpr size_t XCS = A256(HS + (size_t)2 * MROWS * 256 * 4);
constexpr size_t XCSC = A256(XCS + (size_t)4 * 8192 * 256 * 4);
constexpr size_t LIST = A256(XCSC + (size_t)4 * 512 * 256 * 4);
constexpr size_t GATE = A256(LIST + (size_t)2 * NE * LCAP * 4);
constexpr size_t ACT = A256(GATE + (size_t)NASG * 4);
constexpr size_t Y = A256(ACT + (size_t)ACT_ROWS * D * 2);
constexpr size_t WINT = A256(Y + (size_t)(NASG + 1) * D * 2);
constexpr size_t WOUTT = A256(WINT + (size_t)2 * 2048 * 1024 * 2);
constexpr size_t WGUT = A256(WOUTT + (size_t)2 * 1024 * 1024 * 2);
constexpr size_t WDT = A256(WGUT + (size_t)2 * NE * 2048 * 1024 * 2);
constexpr size_t ZBUF = A256(WDT + (size_t)2 * NE * 1024 * 1024 * 2);
constexpr size_t VTG = A256(ZBUF + (size_t)4 * 64 * 64 * 512 * 2);
constexpr size_t WUQT = A256(VTG + (size_t)16 * 64 * NPOS * 2);
constexpr size_t WUKVT = A256(WUQT + (size_t)2 * 384 * 256 * 2);
constexpr size_t WAT = A256(WUKVT + (size_t)2 * 512 * 128 * 2);
constexpr size_t WIT = A256(WAT + (size_t)16 * 4096 * 2);
constexpr size_t SPT = A256(WIT + (size_t)16 * 4096 * 2);
constexpr size_t RWH = A256(SPT + (size_t)1024 * 4);
constexpr size_t RWL = A256(RWH + (size_t)2 * NE * D * 2);
constexpr size_t HL = A256(RWL + (size_t)2 * NE * D * 2);
constexpr size_t AC = A256(HL + (size_t)2 * MROWS * 256 * 2);
constexpr size_t SUM = A256(AC + (size_t)2 * MROWS * 256 * 2);
constexpr size_t XCT = A256(SUM + (size_t)2 * 4 * 68 * 512 * 4);
constexpr size_t END = A256(XCT + (size_t)16 * 512 * 64 * 2);
constexpr int CW_BAR = 4096;
constexpr int CW_MODCNT = 2048;
constexpr int CW_CNT = 32768, CNT_STRIDE = 64;
}

#define XB_TMO      128
#define XB_XCNT(j)  (256  + 64 * (j))
#define XB_XSUB(j)  (1280 + 64 * (j))
#define XB_XGEN(j)  (2304 + 64 * (j))
#define XB_TOP      3328
#define XB_TOPGEN   3392
#define XCD_BAR_WORDS 3456
#define XB_SPIN_CAP (1u << 18)
__device__ __forceinline__ unsigned xb_ld(unsigned* p)              { return __hip_atomic_load(p, __ATOMIC_RELAXED, __HIP_MEMORY_SCOPE_AGENT); }
__device__ __forceinline__ unsigned xb_add(unsigned* p, unsigned v) { return __hip_atomic_fetch_add(p, v, __ATOMIC_RELAXED, __HIP_MEMORY_SCOPE_AGENT); }
__device__ __forceinline__ unsigned xb_xcc_id() { return (unsigned)__builtin_amdgcn_s_getreg((3 << 11) | 20) & 0xFu; }
#define XB_SPIN(cond, bar) do { unsigned _sp = 0; while (cond) { __builtin_amdgcn_s_sleep(1); \
    if ((++_sp & 255u) == 0u) { if (xb_ld(&(bar)[XB_TMO])) break; if (_sp > XB_SPIN_CAP) { atomicAdd(&(bar)[XB_TMO], 1u); break; } } } } while (0)
struct XcdBarrier { unsigned* bar; unsigned x; volatile LAS unsigned* st; };
__device__ __forceinline__ XcdBarrier xcd_barrier_post(unsigned* bar, volatile LAS unsigned* st) {
    XcdBarrier b; b.bar = bar; b.x = xb_xcc_id(); b.st = st;
    if (threadIdx.x == 0) (void)xb_add(&bar[XB_XCNT(b.x)], 1u);
    return b;
}
__device__ __forceinline__ void xcd_barrier_complete(unsigned* bar, unsigned x, unsigned& nloc, unsigned& nx) {
    const unsigned G = gridDim.x * gridDim.y * gridDim.z;
    unsigned sum, cnt, mine, sp = 0u;
    for (;;) {
        sum = 0u; cnt = 0u; mine = 0u;
#pragma unroll
        for (unsigned j = 0; j < 16; ++j) { const unsigned c = xb_ld(&bar[XB_XCNT(j)]); sum += c; cnt += (c > 0u) ? 1u : 0u; mine = (j == x) ? c : mine; }
        if (sum == G) break;
        __builtin_amdgcn_s_sleep(1);
        if ((++sp & 255u) == 0u) { if (xb_ld(&bar[XB_TMO])) break; if (sp > XB_SPIN_CAP) { atomicAdd(&bar[XB_TMO], 1u); break; } }
    }
    nloc = mine > 0u ? mine : 1u; nx = cnt > 0u ? cnt : 1u;
}
__device__ __forceinline__ void xcd_barrier(const XcdBarrier& b) {
    asm volatile("s_waitcnt vmcnt(0)" ::: "memory");
    __syncthreads();
    if (threadIdx.x == 0) {
        unsigned* bar = b.bar;
        __builtin_amdgcn_s_waitcnt(0);
        unsigned nloc = b.st[0], nx = b.st[1];
        if (nloc == 0u) { xcd_barrier_complete(bar, b.x, nloc, nx); b.st[0] = nloc; b.st[1] = nx; }
        const unsigned old = xb_add(&bar[XB_XSUB(b.x)], 1u);
        const unsigned gen = old / nloc;
        if (old + 1u == (gen + 1u) * nloc) {
            __builtin_amdgcn_fence(__ATOMIC_RELEASE, "agent");
            asm volatile("s_waitcnt vmcnt(0)" ::: "memory");
            const unsigned og = xb_add(&bar[XB_TOP], 1u);
            const unsigned tg = og / nx;
            if (og + 1u == (tg + 1u) * nx) xb_add(&bar[XB_TOPGEN], 1u);
            else XB_SPIN(xb_ld(&bar[XB_TOPGEN]) == tg, bar);
            __builtin_amdgcn_fence(__ATOMIC_ACQUIRE, "agent");
            xb_add(&bar[XB_XGEN(b.x)], 1u);
            asm volatile("s_waitcnt vmcnt(0)" ::: "memory");
        } else {
            XB_SPIN(xb_ld(&bar[XB_XGEN(b.x)]) == gen, bar);
            __builtin_amdgcn_fence(__ATOMIC_ACQUIRE, "agent");
            asm volatile("s_waitcnt vmcnt(0)" ::: "memory");
        }
    }
    __syncthreads();
}

namespace g8 {
constexpr int BM = 256, BK = 64, HALF = 128, HTB = HALF * BK * 2, STAGE_BYTES = 8 * HTB, NXCD = 8, WGM = 8;
__device__ __forceinline__ int lds_byte(int r, int c) { const int st = (r >> 4) * 2 + (c >> 5), rr = r & 15, cc = c & 31, ob = rr * 64 + cc * 2; return st * 1024 + (ob ^ (((ob >> 9) & 1) << 5)); }
__device__ __forceinline__ void stage_rc(int b, int& R, int& C) { const int st = b / 1024, sb = b % 1024, swz = sb ^ (((sb >> 9) & 1) << 5); R = (st >> 1) * 16 + swz / 64; C = (st & 1) * 32 + (swz % 64) / 2; }
__device__ __forceinline__ int perm32(int rho) { const int n = rho >> 4, i = rho & 15; return 8 * (i >> 2) + 4 * n + (i & 3); }
__device__ __forceinline__ unsigned cvt_pk_bf16(float lo, float hi) { return pk2(lo, hi); }
__device__ __forceinline__ int xcd_remap(int wgid, int nwg) { const int q = nwg / NXCD, r = nwg % NXCD, xcd = wgid % NXCD, off = wgid / NXCD; return (xcd < r ? xcd * (q + 1) : r * (q + 1) + (xcd - r) * q) + off; }

struct Unit { int row0, col0, ex, bt, nvalid, lrow; };

struct DenseSched {
    int nM, nN, nwg, G, c, lat_only; const char* Bt; int K; const int* list;
    __device__ __forceinline__ void init(int nM_, int nN_, int G_, int c_, int lat_only_, const void* Bt_, int K_) { nM = nM_; nN = nN_; nwg = nM * nN; G = G_; c = c_; lat_only = lat_only_; Bt = (const char*)Bt_; K = K_; list = nullptr; }
    __device__ __forceinline__ bool next(int i, Unit& u) const {
        const long Lx = (long)i * G + c; if (Lx >= nwg) return false;
        const int wgid = xcd_remap((int)Lx, nwg);
        const int nig = WGM * nN, gid = wgid / nig, fm = gid * WGM, gsz = (nM - fm) < WGM ? (nM - fm) : WGM;
        const int pm = fm + ((wgid % nig) % gsz), pn = (wgid % nig) / gsz;
        const int tile = lat_only ? (pm / 16) * 17 + 1 + (pm % 16) : pm;
        u.row0 = tile * 256; u.col0 = pn * 256; u.ex = 0; u.bt = pn; u.nvalid = 256; u.lrow = 0; return true;
    }
    __device__ __forceinline__ const char* bptr(const Unit& u) const { return Bt + (size_t)u.bt * (256 * 1024 * 2); }
};
struct MoeSched {
    const LAS int* tpre; const LAS int* cnt; int NT, COLW, G, c, total; const char* Bt; int K; const int* list;
    __device__ __forceinline__ bool next(int i, Unit& u) const {
        const long Lx = (long)i * G + c; if (Lx >= total) return false;
        const int wgid = xcd_remap((int)Lx, total);
        int e = 0;
        for (int j = 1; j < NE; ++j) if (tpre[j] * NT <= wgid) e = j;
        const int t0 = tpre[e], mte = tpre[e + 1] - t0, loc = wgid - t0 * NT, nt = loc / mte, mt = loc % mte;
        u.ex = __builtin_amdgcn_readfirstlane(e); u.row0 = __builtin_amdgcn_readfirstlane((t0 + mt) * 256); u.col0 = __builtin_amdgcn_readfirstlane(nt * COLW);
        u.bt = __builtin_amdgcn_readfirstlane(e * NT + nt); const int nv = cnt[e] - mt * 256; u.nvalid = __builtin_amdgcn_readfirstlane(nv < 256 ? nv : 256); u.lrow = __builtin_amdgcn_readfirstlane(mt * 256);
        return true;
    }
    __device__ __forceinline__ const char* bptr(const Unit& u) const { return Bt + (size_t)u.bt * (256 * 1024 * 2); }
};

struct EpiP {
    static constexpr bool PERM = true; bf16_t* O;
    __device__ __forceinline__ void operator()(const f32x4 (&acc)[2][2][4][2], const Unit& u, int wr, int wc, int fr, int fq, const LAS int*) const {
#pragma unroll
        for (int ai = 0; ai < 2; ++ai)
#pragma unroll
            for (int m = 0; m < 4; ++m) { bf16_t* rowp = O + (size_t)(u.row0 + ai * HALF + wr * 64 + m * 16 + fr) * PP + u.col0 + wc * 32 + 8 * fq;
#pragma unroll
                for (int bj = 0; bj < 2; ++bj) { const f32x4 v0 = acc[ai][bj][m][0], v1 = acc[ai][bj][m][1]; u32x4 w; w.x = cvt_pk_bf16(v0[0], v0[1]); w.y = cvt_pk_bf16(v0[2], v0[3]); w.z = cvt_pk_bf16(v1[0], v1[1]); w.w = cvt_pk_bf16(v1[2], v1[3]);
                    *(u32x4*)(rowp + bj * HALF) = w; } }
    }
};
struct EpiH {
    static constexpr bool PERM = false; float* Hh; const float* MODl; int g_off;
    __device__ __forceinline__ void operator()(const f32x4 (&acc)[2][2][4][2], const Unit& u, int wr, int wc, int fr, int fq, const LAS int*) const {
        const int tile = u.row0 >> 8, v = (tile % 17 == 0) ? 4 : tile / 17; const float* gp = MODl + (size_t)v * 6144 + g_off + u.col0 + wc * 32 + 4 * fq;
        f32x4 gv[2][2];
#pragma unroll
        for (int bj = 0; bj < 2; ++bj)
#pragma unroll
            for (int n = 0; n < 2; ++n) gv[bj][n] = *(const f32x4*)(gp + bj * HALF + n * 16);
#pragma unroll
        for (int ai = 0; ai < 2; ++ai)
#pragma unroll
          for (int mp = 0; mp < 2; ++mp) {
            f32x4 hv[2][2][2];
#pragma unroll
            for (int m2 = 0; m2 < 2; ++m2) { const float* rowp = Hh + (size_t)(u.row0 + ai * HALF + wr * 64 + (2 * mp + m2) * 16 + fr) * D + u.col0 + wc * 32 + 4 * fq;
#pragma unroll
                for (int bj = 0; bj < 2; ++bj)
#pragma unroll
                    for (int n = 0; n < 2; ++n) hv[m2][bj][n] = *(const f32x4*)(rowp + bj * HALF + n * 16); }
#pragma unroll
            for (int m2 = 0; m2 < 2; ++m2) { float* rowp = Hh + (size_t)(u.row0 + ai * HALF + wr * 64 + (2 * mp + m2) * 16 + fr) * D + u.col0 + wc * 32 + 4 * fq;
#pragma unroll
                for (int bj = 0; bj < 2; ++bj)
#pragma unroll
                    for (int n = 0; n < 2; ++n) *(f32x4*)(rowp + bj * HALF + n * 16) = hv[m2][bj][n] + gv[bj][n] * acc[ai][bj][2 * mp + m2][n]; }
          }
    }
};
struct EpiMoe1 {
    static constexpr bool PERM = true; bf16_t* ACTp; const float* bgu;
    __device__ __forceinline__ void operator()(const f32x4 (&acc)[2][2][4][2], const Unit& u, int wr, int wc, int fr, int fq, const LAS int*) const {
        const int cc = u.col0 + wc * 32 + 8 * fq; const float* bp = bgu + (size_t)u.ex * 2048 + cc;
        f32x4 bg[2], bu[2];
#pragma unroll
        for (int n = 0; n < 2; ++n) { bg[n] = *(const f32x4*)(bp + 4 * n); bu[n] = *(const f32x4*)(bp + 1024 + 4 * n); }
#pragma unroll
        for (int ai = 0; ai < 2; ++ai)
#pragma unroll
            for (int m = 0; m < 4; ++m) { const int r = ai * HALF + wr * 64 + m * 16 + fr;
                float o[8];
#pragma unroll
                for (int n = 0; n < 2; ++n)
#pragma unroll
                    for (int i = 0; i < 4; ++i) { const float g = fminf(acc[ai][0][m][n][i] + bg[n][i], 7.f); const float uu = fminf(fmaxf(acc[ai][1][m][n][i] + bu[n][i], -7.f), 7.f);
                        o[n * 4 + i] = (uu + 1.f) * g * __builtin_amdgcn_rcpf(1.f + __expf(-1.702f * g)); }
                { u32x4 w; w.x = cvt_pk_bf16(o[0], o[1]); w.y = cvt_pk_bf16(o[2], o[3]); w.z = cvt_pk_bf16(o[4], o[5]); w.w = cvt_pk_bf16(o[6], o[7]);
                    *(u32x4*)(ACTp + (size_t)(u.row0 + r) * D + cc) = w; } }
    }
};
struct EpiMoe2 {
    static constexpr bool PERM = true; bf16_t* Yp; const float* bd; const float* GATEp;
    __device__ __forceinline__ void operator()(const f32x4 (&acc)[2][2][4][2], const Unit& u, int wr, int wc, int fr, int fq, const LAS int* rows) const {
        const int cc = u.col0 + wc * 32 + 8 * fq; const float* bp = bd + (size_t)u.ex * 1024 + cc;
        f32x4 bv[2][2];
#pragma unroll
        for (int bj = 0; bj < 2; ++bj)
#pragma unroll
            for (int n = 0; n < 2; ++n) bv[bj][n] = *(const f32x4*)(bp + bj * HALF + 4 * n);
        int asgv[2][4]; float gtv[2][4];
#pragma unroll
        for (int ai = 0; ai < 2; ++ai)
#pragma unroll
            for (int m = 0; m < 4; ++m) { const int r = ai * HALF + wr * 64 + m * 16 + fr; const bool ok = r < u.nvalid; const int a = rows[ok ? r : 0]; asgv[ai][m] = ok ? a : NASG; gtv[ai][m] = GATEp[a]; }
#pragma unroll
        for (int ai = 0; ai < 2; ++ai)
#pragma unroll
            for (int m = 0; m < 4; ++m) { const float gt = gtv[ai][m]; bf16_t* rowp = Yp + (size_t)asgv[ai][m] * D + cc;
#pragma unroll
                for (int bj = 0; bj < 2; ++bj) { const f32x4 v0 = (acc[ai][bj][m][0] + bv[bj][0]) * gt, v1 = (acc[ai][bj][m][1] + bv[bj][1]) * gt;
                    u32x4 w; w.x = cvt_pk_bf16(v0[0], v0[1]); w.y = cvt_pk_bf16(v0[2], v0[3]); w.z = cvt_pk_bf16(v1[0], v1[1]); w.w = cvt_pk_bf16(v1[2], v1[3]); *(u32x4*)(rowp + bj * HALF) = w; } }
    }
};

template <class Epi, class Sched, bool GATHER, bool ROWLIST>
__device__ __forceinline__ void gemm_phase(LAS unsigned char* lds, const char* Abase, const Sched& S, const Epi& E) {
    constexpr int K = 1024;
    int tid_l = threadIdx.x; asm volatile("" : "+v"(tid_l));
    const int tid = tid_l, wid = __builtin_amdgcn_readfirstlane(tid >> 6), lane = tid & 63, wr = wid >> 2, wc = wid & 3, fr = lane & 15, fq = lane >> 4;
    constexpr int nt = K / BK; constexpr unsigned Kb = (unsigned)K * 2u;
    unsigned voffB[2];
#pragma unroll
    for (int i = 0; i < 2; ++i) { int R, C; stage_rc(tid * 16 + i * 8192, R, C); const int Rb = Epi::PERM ? ((R & ~31) + perm32(R & 31)) : R; voffB[i] = (unsigned)(Rb * K + C) * 2u; }
    constexpr size_t kstep = (size_t)(BK * 2), hstep = (size_t)HALF * K * 2;
    const unsigned ldsw = (unsigned)wid * 1024u;
    const int aoff = lds_byte(wr * 64 + fr, fq * 8), boff = lds_byte(wc * 32 + fr, fq * 8);
    LAS int* rowbuf = (LAS int*)(lds + STAGE_BYTES);
#define G8_SA(b, h) (((b) * 2 + (h)) * HTB)
#define G8_SB(b, h) ((4 + (b) * 2 + (h)) * HTB)
#define G8_STAGE_A(bufoff, kb, v) do { _Pragma("unroll") for (int _i = 0; _i < 2; ++_i) \
        __builtin_amdgcn_global_load_lds((const unsigned*)((kb) + (size_t)(v)[_i]), (LAS unsigned*)(lds + (bufoff) + ldsw + _i * 8192), 16, 0, 0); } while (0)
#define G8_STAGE_B(bufoff, gbase) do { _Pragma("unroll") for (int _i = 0; _i < 2; ++_i) \
        __builtin_amdgcn_global_load_lds((const unsigned*)((gbase) + voffB[_i]), (LAS unsigned*)(lds + (bufoff) + ldsw + _i * 8192), 16, 0, 0); } while (0)
#define G8_LDA(dst, b, h) do { _Pragma("unroll") for (int m = 0; m < 4; ++m) _Pragma("unroll") for (int k = 0; k < 2; ++k) dst[m][k] = *(const LAS bf16x8*)(lds + G8_SA(b, h) + aoff + m * 2048 + k * 1024); } while (0)
#define G8_LDB(dst, b, h) do { _Pragma("unroll") for (int n = 0; n < 2; ++n) _Pragma("unroll") for (int k = 0; k < 2; ++k) dst[n][k] = *(const LAS bf16x8*)(lds + G8_SB(b, h) + boff + n * 2048 + k * 1024); } while (0)
#define G8_MMA(ai, bj, At, Bt) do { __builtin_amdgcn_s_setprio(1); _Pragma("unroll") for (int m = 0; m < 4; ++m) _Pragma("unroll") for (int n = 0; n < 2; ++n) _Pragma("unroll") for (int k = 0; k < 2; ++k) \
        acc[ai][bj][m][n] = __builtin_amdgcn_mfma_f32_16x16x32_bf16(Bt[n][k], At[m][k], acc[ai][bj][m][n], 0, 0, 0); __builtin_amdgcn_s_setprio(0); } while (0)
#define G8_WAIT_V(n) asm volatile("s_waitcnt vmcnt(" #n ")" ::: "memory")
#define G8_WAIT_L(n) asm volatile("s_waitcnt lgkmcnt(" #n ")" ::: "memory")
#define G8_BAR __builtin_amdgcn_s_barrier()
#define G8_SCHED __builtin_amdgcn_sched_barrier(0)
#define G8_LISTDMA(u, s) do { if (wid < 4) __builtin_amdgcn_global_load_lds((const unsigned*)(S.list + (size_t)(u).ex * LCAP + (u).lrow + wid * 64 + lane), (LAS unsigned*)(rowbuf + (s) * 256 + wid * 64), 4, 0, 0); } while (0)
#define G8_ROWS_DENSE(v) do { _Pragma("unroll") for (int _i = 0; _i < 2; ++_i) { int _R, _C; stage_rc(tid * 16 + _i * 8192, _R, _C); _Pragma("unroll") for (int _h = 0; _h < 2; ++_h) (v)[_h][_i] = (unsigned)(_h * HALF + _R) * Kb + (unsigned)_C * 2u; } } while (0)
#define G8_ROWS_LIST(v, u, s) do { _Pragma("unroll") for (int _i = 0; _i < 2; ++_i) { int _R, _C; stage_rc(tid * 16 + _i * 8192, _R, _C); _Pragma("unroll") for (int _h = 0; _h < 2; ++_h) { const int _r = _h * HALF + _R; const int _a = rowbuf[(s) * 256 + _r]; \
        (v)[_h][_i] = (unsigned)(_r < (u).nvalid ? (_a >> 2) : 0) * Kb + (unsigned)_C * 2u; } } } while (0)
    Unit cur, nxt; int ui = 0, slot = 0;
    if (!S.next(0, cur)) return;
    unsigned vA[2][2];
    if constexpr (ROWLIST) { G8_LISTDMA(cur, 0); G8_WAIT_V(0); G8_BAR; }
    if constexpr (GATHER) { G8_ROWS_LIST(vA, cur, 0); } else { G8_ROWS_DENSE(vA); }
    f32x4 acc[2][2][4][2];
#pragma unroll
    for (int a = 0; a < 2; ++a)
#pragma unroll
        for (int b = 0; b < 2; ++b)
#pragma unroll
            for (int m = 0; m < 4; ++m)
#pragma unroll
                for (int n = 0; n < 2; ++n) acc[a][b][m][n] = (f32x4){0.f, 0.f, 0.f, 0.f};
    bf16x8 At[4][2], B0[2][2], B1[2][2];
    const char* cB = S.bptr(cur);
    const char* cA = GATHER ? Abase : Abase + (size_t)cur.row0 * Kb;
    G8_STAGE_B(G8_SB(0, 0), cB); G8_STAGE_B(G8_SB(0, 1), cB + hstep); G8_STAGE_A(G8_SA(0, 0), cA, vA[0]); G8_STAGE_A(G8_SA(0, 1), cA, vA[1]);
    if (wr == 1) G8_BAR;
    G8_WAIT_V(2); G8_BAR;
    G8_STAGE_B(G8_SB(1, 0), cB + kstep); G8_STAGE_A(G8_SA(1, 0), cA + kstep, vA[0]); G8_STAGE_B(G8_SB(1, 1), cB + hstep + kstep);
    G8_WAIT_V(6); G8_BAR;
    for (;;) {
        const bool has_next = S.next(ui + 1, nxt);
        const char* nB = has_next ? S.bptr(nxt) : cB;
        const char* nA = (GATHER || !has_next) ? cA : Abase + (size_t)nxt.row0 * Kb;
        const int nslot = slot == 2 ? 0 : slot + 1;
        if constexpr (ROWLIST) { if (has_next) G8_LISTDMA(nxt, nslot); }
        for (int t = 0; t < nt; t += 2) {
            const bool last = (t == nt - 2);
            const char* a1 = cA + (size_t)(t + 1) * kstep;
            const char* a2 = last ? nA : cA + (size_t)(t + 2) * kstep; const char* b2 = last ? nB : cB + (size_t)(t + 2) * kstep;
            const char* a3 = a2 + kstep; const char* b3 = b2 + kstep;
            G8_LDB(B0, 0, 0); G8_LDB(B1, 0, 1); G8_SCHED; G8_LDA(At, 0, 0); G8_STAGE_A(G8_SA(1, 1), a1, vA[1]);
            if constexpr (GATHER) { if (last && has_next) { G8_ROWS_LIST(vA, nxt, nslot); } }
            G8_WAIT_V(8); G8_WAIT_L(0); G8_BAR; G8_MMA(0, 0, At, B0); G8_MMA(0, 1, At, B1); G8_BAR; G8_SCHED;
            G8_LDA(At, 0, 1); G8_STAGE_B(G8_SB(0, 0), b2); G8_STAGE_B(G8_SB(0, 1), b2 + hstep); G8_STAGE_A(G8_SA(0, 0), a2, vA[0]);
            G8_WAIT_V(8); G8_WAIT_L(0); G8_BAR; G8_MMA(1, 0, At, B0); G8_MMA(1, 1, At, B1); G8_BAR; G8_SCHED;
            G8_LDB(B0, 1, 0); G8_LDB(B1, 1, 1); G8_SCHED; G8_LDA(At, 1, 0); G8_STAGE_A(G8_SA(0, 1), a2, vA[1]);
            G8_WAIT_V(8); G8_WAIT_L(0); G8_BAR; G8_MMA(0, 0, At, B0); G8_MMA(0, 1, At, B1); G8_BAR; G8_SCHED;
            G8_LDA(At, 1, 1); G8_STAGE_B(G8_SB(1, 0), b3); G8_STAGE_B(G8_SB(1, 1), b3 + hstep); G8_STAGE_A(G8_SA(1, 0), a3, vA[0]);
            G8_WAIT_V(8); G8_WAIT_L(0); G8_BAR; G8_MMA(1, 0, At, B0); G8_MMA(1, 1, At, B1); G8_BAR; G8_SCHED;
        }
        if (wr == 0) G8_BAR;
        { int t2 = threadIdx.x; asm volatile("" : "+v"(t2));
          const int w2 = __builtin_amdgcn_readfirstlane(t2 >> 6); E(acc, cur, w2 >> 2, w2 & 3, t2 & 15, (t2 & 63) >> 4, rowbuf + slot * 256); }
        if (!has_next) break;
#pragma unroll
        for (int a = 0; a < 2; ++a)
#pragma unroll
            for (int b = 0; b < 2; ++b)
#pragma unroll
                for (int m = 0; m < 4; ++m)
#pragma unroll
                    for (int n = 0; n < 2; ++n) acc[a][b][m][n] = (f32x4){0.f, 0.f, 0.f, 0.f};
        cur = nxt; cB = nB; cA = nA; ++ui; slot = nslot;
        if (wr == 1) G8_BAR;
    }
    G8_WAIT_V(0);
    G8_BAR;
#undef G8_SA
#undef G8_SB
#undef G8_STAGE_A
#undef G8_STAGE_B
#undef G8_LDA
#undef G8_LDB
#undef G8_MMA
#undef G8_WAIT_V
#undef G8_WAIT_L
#undef G8_BAR
#undef G8_SCHED
#undef G8_LISTDMA
#undef G8_ROWS_DENSE
#undef G8_ROWS_LIST
}
}

namespace fft {
constexpr int TP = 72;
constexpr int UP = 264;
constexpr int ZP = 520;
constexpr int O_TC = 0, O_TS = 9216, O_U = 18432, O_X = 52224, O_TW = 125952;
__device__ __forceinline__ bf16x8 neg8(bf16x8 v) { u32x4 w = __builtin_bit_cast(u32x4, v); w = w ^ 0x80008000u; return __builtin_bit_cast(bf16x8, w); }
__device__ __forceinline__ void build_tables(LAS unsigned char* lds, const float* TABC, const float* TABS, int tid) {
    for (int i = tid; i < 4096; i += 512) { const int a = i >> 6, b = i & 63, ix = ((a * b) & 63) * 64;
        ((LAS bf16_t*)(lds + O_TC))[a * TP + b] = f2bf(TABC[ix]); ((LAS bf16_t*)(lds + O_TS))[a * TP + b] = f2bf(TABS[ix]); }
}
__device__ __forceinline__ void stage_a(LAS unsigned char* lds, const bf16_t* P, const float* TABC, const float* TABS, bf16_t* ZBUF, int u0, int u1, int ustep) {
    int tid_l = threadIdx.x; asm volatile("" : "+v"(tid_l));
    const int tid = tid_l, lane = tid & 63, w = __builtin_amdgcn_readfirstlane(tid >> 6), fr = lane & 15, fq = lane >> 4;
    build_tables(lds, TABC, TABS, tid);
    const LAS bf16_t* Tc = (const LAS bf16_t*)(lds + O_TC); const LAS bf16_t* Ts = (const LAS bf16_t*)(lds + O_TS);
    LAS bf16_t* U = (LAS bf16_t*)(lds + O_U); LAS bf16_t* X = (LAS bf16_t*)(lds + O_X); LAS float* TW = (LAS float*)(lds + O_TW);
    for (int unit = u0; unit < u1; unit += ustep) {
        const int b = unit >> 6, t2 = unit & 63;
#pragma unroll
        for (int i = 0; i < 4; ++i) { const int q = tid + 512 * i, t1 = q >> 5, ch = q & 31;
            *(LAS u32x4*)((LAS unsigned char*)U + t1 * (UP * 2) + ch * 16) = *(const u32x4*)(P + ((size_t)b * NPOS + CTX + 64 * t1 + t2) * PP + ch * 8); }
        if (tid < 64) { const int ix = tid * t2; TW[2 * tid] = TABC[ix]; TW[2 * tid + 1] = TABS[ix]; }
        __syncthreads();
        { const int g = w >> 1, part = w & 1; const LAS bf16_t* T = part ? Ts : Tc;
          f32x4 acc[4][4];
#pragma unroll
          for (int mt = 0; mt < 4; ++mt)
#pragma unroll
              for (int nt = 0; nt < 4; ++nt) acc[mt][nt] = (f32x4){0.f, 0.f, 0.f, 0.f};
#pragma unroll
          for (int ks = 0; ks < 2; ++ks) { bf16x8 a[4], bb[4];
#pragma unroll
              for (int mt = 0; mt < 4; ++mt) a[mt] = *(const LAS bf16x8*)(U + (16 * mt + fr) * UP + g * 64 + 32 * ks + 8 * fq);
#pragma unroll
              for (int nt = 0; nt < 4; ++nt) bb[nt] = *(const LAS bf16x8*)(T + (16 * nt + fr) * TP + 32 * ks + 8 * fq);
#pragma unroll
              for (int mt = 0; mt < 4; ++mt)
#pragma unroll
                  for (int nt = 0; nt < 4; ++nt) acc[mt][nt] = __builtin_amdgcn_mfma_f32_16x16x32_bf16(a[mt], bb[nt], acc[mt][nt], 0, 0, 0); }
          const float sg = part ? -1.f : 1.f;
#pragma unroll
          for (int mt = 0; mt < 4; ++mt)
#pragma unroll
              for (int nt = 0; nt < 4; ++nt) { const f32x4 v = acc[mt][nt] * sg; u32x2 o; o.x = pk2(v[0], v[1]); o.y = pk2(v[2], v[3]);
                  *(LAS u32x2*)(X + (part * 256 + g * 64 + 16 * nt + fr) * TP + 16 * mt + 4 * fq) = o; } }
        __syncthreads();
        f32x4 zr[4][2], zi[4][2];
#pragma unroll
        for (int mt = 0; mt < 4; ++mt)
#pragma unroll
            for (int n = 0; n < 2; ++n) { zr[mt][n] = (f32x4){0.f, 0.f, 0.f, 0.f}; zi[mt][n] = (f32x4){0.f, 0.f, 0.f, 0.f}; }
#pragma unroll
        for (int ks = 0; ks < 2; ++ks) { bf16x8 xr[2], xi[2];
#pragma unroll
            for (int n = 0; n < 2; ++n) { xr[n] = *(const LAS bf16x8*)(X + (32 * w + 16 * n + fr) * TP + 32 * ks + 8 * fq); xi[n] = *(const LAS bf16x8*)(X + (256 + 32 * w + 16 * n + fr) * TP + 32 * ks + 8 * fq); }
#pragma unroll
            for (int mt = 0; mt < 4; ++mt) { const bf16x8 c = *(const LAS bf16x8*)(Tc + (16 * mt + fr) * TP + 32 * ks + 8 * fq), s = *(const LAS bf16x8*)(Ts + (16 * mt + fr) * TP + 32 * ks + 8 * fq), ns = neg8(s);
#pragma unroll
                for (int n = 0; n < 2; ++n) { zr[mt][n] = __builtin_amdgcn_mfma_f32_16x16x32_bf16(c, xr[n], zr[mt][n], 0, 0, 0); zr[mt][n] = __builtin_amdgcn_mfma_f32_16x16x32_bf16(s, xi[n], zr[mt][n], 0, 0, 0);
                    zi[mt][n] = __builtin_amdgcn_mfma_f32_16x16x32_bf16(c, xi[n], zi[mt][n], 0, 0, 0); zi[mt][n] = __builtin_amdgcn_mfma_f32_16x16x32_bf16(ns, xr[n], zi[mt][n], 0, 0, 0); } } }
        __syncthreads();
        { LAS bf16_t* Zs = X;
#pragma unroll
          for (int mt = 0; mt < 4; ++mt)
#pragma unroll
              for (int i = 0; i < 4; ++i) { const int f1 = 16 * mt + 4 * fq + i; const float ct = TW[2 * f1], st = TW[2 * f1 + 1];
#pragma unroll
                  for (int n = 0; n < 2; ++n) { const float a = zr[mt][n][i], bq = zi[mt][n][i]; const int col = 32 * w + 16 * n + fr;
                      Zs[f1 * ZP + col] = f2bf(a * ct + bq * st); Zs[f1 * ZP + 256 + col] = f2bf(bq * ct - a * st); } } }
        __syncthreads();
#pragma unroll
        for (int i = 0; i < 8; ++i) { const int q = tid + 512 * i, f1 = q >> 6, ch = q & 63;
            *(u32x4*)(ZBUF + (((size_t)b * 64 + f1) * 64 + t2) * 512 + ch * 8) = *(const LAS u32x4*)((const LAS unsigned char*)X + f1 * (ZP * 2) + ch * 16); }
        __syncthreads();
    }
}
__device__ __forceinline__ void stage_b(LAS unsigned char* lds, const bf16_t* ZBUF, const float* TABC, const float* TABS, bf16_t* MIX, int G, int bx) {
    int tid_l = threadIdx.x; asm volatile("" : "+v"(tid_l));
    const int tid = tid_l, lane = tid & 63, w = __builtin_amdgcn_readfirstlane(tid >> 6), fr = lane & 15, fq = lane >> 4;
    build_tables(lds, TABC, TABS, tid);
    const LAS bf16_t* Tc = (const LAS bf16_t*)(lds + O_TC); const LAS bf16_t* Ts = (const LAS bf16_t*)(lds + O_TS);
    LAS bf16_t* Ys = (LAS bf16_t*)(lds + O_U); LAS bf16_t* ZT = (LAS bf16_t*)(lds + O_X);
    for (int unit = bx; unit < 256; unit += G) {
        const int b = unit >> 6, f1 = unit & 63;
        const bf16_t* Zg = ZBUF + ((size_t)b * 64 + f1) * 64 * 512;
#pragma unroll
        for (int i = 0; i < 4; ++i) { const int q = tid + 512 * i, p = q & 31, ch = q >> 5;
            const u32x4 r0 = *(const u32x4*)(Zg + (size_t)(2 * p) * 512 + ch * 8), r1 = *(const u32x4*)(Zg + (size_t)(2 * p + 1) * 512 + ch * 8);
#pragma unroll
            for (int j = 0; j < 4; ++j) { const unsigned a = r0[j], c = r1[j];
                *(LAS unsigned*)(ZT + (ch * 8 + 2 * j) * TP + 2 * p) = (a & 0xffffu) | (c << 16);
                *(LAS unsigned*)(ZT + (ch * 8 + 2 * j + 1) * TP + 2 * p) = (a >> 16) | (c & 0xffff0000u); } }
        __syncthreads();
        f32x4 y[4][2];
#pragma unroll
        for (int mt = 0; mt < 4; ++mt)
#pragma unroll
            for (int n = 0; n < 2; ++n) y[mt][n] = (f32x4){0.f, 0.f, 0.f, 0.f};
#pragma unroll
        for (int ks = 0; ks < 2; ++ks) { bf16x8 xr[2], xi[2];
#pragma unroll
            for (int n = 0; n < 2; ++n) { xr[n] = *(const LAS bf16x8*)(ZT + (32 * w + 16 * n + fr) * TP + 32 * ks + 8 * fq); xi[n] = *(const LAS bf16x8*)(ZT + (256 + 32 * w + 16 * n + fr) * TP + 32 * ks + 8 * fq); }
#pragma unroll
            for (int mt = 0; mt < 4; ++mt) { const bf16x8 c = *(const LAS bf16x8*)(Tc + (16 * mt + fr) * TP + 32 * ks + 8 * fq), s = *(const LAS bf16x8*)(Ts + (16 * mt + fr) * TP + 32 * ks + 8 * fq);
#pragma unroll
                for (int n = 0; n < 2; ++n) { y[mt][n] = __builtin_amdgcn_mfma_f32_16x16x32_bf16(c, xr[n], y[mt][n], 0, 0, 0); y[mt][n] = __builtin_amdgcn_mfma_f32_16x16x32_bf16(s, xi[n], y[mt][n], 0, 0, 0); } } }
#pragma unroll
        for (int mt = 0; mt < 4; ++mt)
#pragma unroll
            for (int i = 0; i < 4; ++i)
#pragma unroll
                for (int n = 0; n < 2; ++n) Ys[(16 * mt + 4 * fq + i) * UP + 32 * w + 16 * n + fr] = f2bf(y[mt][n][i] * (1.f / 512.f));
        __syncthreads();
#pragma unroll
        for (int i = 0; i < 4; ++i) { const int q = tid + 512 * i, f2 = q >> 5, ch = q & 31;
            *(u32x4*)(MIX + ((size_t)b * NPOS + CTX + f1 + 64 * f2) * D + ch * 8) = *(const LAS u32x4*)((const LAS unsigned char*)Ys + f2 * (UP * 2) + ch * 16); }
        __syncthreads();
    }
}
}

namespace attn {
typedef float f32x16 __attribute__((ext_vector_type(16)));
typedef float f32x2_t __attribute__((ext_vector_type(2))); typedef __bf16 bf16x2_t __attribute__((ext_vector_type(2)));
__device__ __forceinline__ unsigned cvtpk(float lo, float hi) { f32x2_t v = {lo, hi}; bf16x2_t b = __builtin_convertvector(v, bf16x2_t); return __builtin_bit_cast(unsigned, b); }
constexpr int KP = 104, VP = 68;
constexpr int KT_BYTES = 64 * KP * 2, VT_BYTES = 64 * VP * 2, BUF_BYTES = KT_BYTES + VT_BYTES;
constexpr float THR = 8.f;
__device__ __forceinline__ void attn_phase(LAS unsigned char* lds, const bf16_t* QL, const bf16_t* QC, const bf16_t* KB, const bf16_t* VTG, bf16_t* MIX, int with_ctx, int G, int vcu) {
    const int nunits = 256 + (with_ctx ? 16 : 0);
    for (int unit = vcu; unit < nunits; unit += G) {
        int tid_l = threadIdx.x; asm volatile("" : "+v"(tid_l));
        const int tid = tid_l, lane = tid & 63, wid = __builtin_amdgcn_readfirstlane(tid >> 6), r32 = lane & 31, hi = lane >> 5;
        int bh, nk, orow0; const bf16_t* Qp;
        if (unit < 256) { bh = unit >> 4; const int qb = unit & 15; Qp = QL + ((size_t)bh * SEQ + qb * 256) * 96; nk = NPOS; orow0 = (bh >> 2) * NPOS + CTX + qb * 256; }
        else { bh = unit - 256; Qp = QC + (size_t)bh * CTX * 96; nk = CTX; orow0 = (bh >> 2) * NPOS; }
        const int hh = bh & 3, NT = nk / 64;
        const bf16_t* Kg = KB + (size_t)bh * NPOS * 96; const bf16_t* Vg = VTG + (size_t)bh * 64 * NPOS;
        bf16x8 qf[6];
        { const bf16_t* qp = Qp + (size_t)(wid * 32 + r32) * 96 + 8 * hi;
#pragma unroll
          for (int ds = 0; ds < 6; ++ds) qf[ds] = *(const bf16x8*)(qp + 16 * ds); }
        f32x16 o0 = {}, o1 = {}, negm = {}; float mhat = 0.f, l = 0.f;
        const int kr0 = tid / 12, kc0 = tid % 12, kr1 = (tid + 512) / 12, kc1 = (tid + 512) % 12; const bool k1ok = tid < 256;
        const int vd = tid >> 3, vc = tid & 7;
        u32x4 sk0, sk1 = {}, sv;
#define AT_LOAD(t_) do { const size_t k0_ = (size_t)(t_) * 64; sk0 = *(const u32x4*)(Kg + (k0_ + kr0) * 96 + kc0 * 8); if (k1ok) sk1 = *(const u32x4*)(Kg + (k0_ + kr1) * 96 + kc1 * 8); sv = *(const u32x4*)(Vg + (size_t)vd * NPOS + k0_ + vc * 8); } while (0)
#define AT_STORE(slot_) do { LAS unsigned char* bp_ = lds + (slot_) * BUF_BYTES; *(LAS u32x4*)(bp_ + kr0 * (KP * 2) + kc0 * 16) = sk0; if (k1ok) *(LAS u32x4*)(bp_ + kr1 * (KP * 2) + kc1 * 16) = sk1; *(LAS u32x4*)(bp_ + KT_BYTES + vd * (VP * 2) + vc * 16) = sv; } while (0)
#define AT_QK(P0, P1, slot_) do { const LAS bf16_t* Kt_ = (const LAS bf16_t*)(lds + (slot_) * BUF_BYTES); \
        _Pragma("unroll") for (int ds = 0; ds < 6; ++ds) { const bf16x8 k0f = *(const LAS bf16x8*)(Kt_ + r32 * KP + 16 * ds + 8 * hi), k1f = *(const LAS bf16x8*)(Kt_ + (32 + r32) * KP + 16 * ds + 8 * hi); \
            if (ds == 0) { P0 = __builtin_amdgcn_mfma_f32_32x32x16_bf16(k0f, qf[0], negm, 0, 0, 0); P1 = __builtin_amdgcn_mfma_f32_32x32x16_bf16(k1f, qf[0], negm, 0, 0, 0); } \
            else { P0 = __builtin_amdgcn_mfma_f32_32x32x16_bf16(k0f, qf[ds], P0, 0, 0, 0); P1 = __builtin_amdgcn_mfma_f32_32x32x16_bf16(k1f, qf[ds], P1, 0, 0, 0); } } } while (0)
#define MX3(a_, b_, c_) __builtin_fmaxf(__builtin_fmaxf((a_), (b_)), (c_))
#define AT_STEP(C0, C1, N0, N1, t_) do { \
            if ((t_) + 2 < NT) AT_LOAD((t_) + 2); \
            if ((t_) + 1 < NT) AT_QK(N0, N1, s_nxt); \
            float mx_ = MX3(C0[0], C0[1], C1[0]), my_ = MX3(C0[2], C0[3], C1[1]); mx_ = MX3(mx_, C1[2], C1[3]); \
            _Pragma("unroll") for (int r = 4; r < 16; r += 4) { mx_ = MX3(mx_, C0[r], C0[r + 1]); my_ = MX3(my_, C0[r + 2], C0[r + 3]); mx_ = MX3(mx_, C1[r], C1[r + 1]); my_ = MX3(my_, C1[r + 2], C1[r + 3]); } \
            mx_ = fmaxf(mx_, my_); mx_ = fmaxf(mx_, __shfl_xor(mx_, 32)); \
            if (__builtin_expect((t_) == 0 || __any(mx_ > THR), 0)) { const float dl = (t_) == 0 ? mx_ : fmaxf(mx_, 0.f), f = __builtin_amdgcn_exp2f(-dl); mhat += dl; l *= f; \
                _Pragma("unroll") for (int r = 0; r < 16; ++r) { C0[r] -= dl; C1[r] -= dl; o0[r] *= f; o1[r] *= f; negm[r] = -mhat; } \
                if ((t_) + 1 < NT) { _Pragma("unroll") for (int r = 0; r < 16; ++r) { N0[r] -= dl; N1[r] -= dl; } } } \
            float ls_ = 0.f; \
            _Pragma("unroll") for (int r = 0; r < 16; ++r) { C0[r] = __builtin_amdgcn_exp2f(C0[r]); C1[r] = __builtin_amdgcn_exp2f(C1[r]); ls_ += C0[r] + C1[r]; } \
            l += ls_; \
            const LAS bf16_t* Vt_ = (const LAS bf16_t*)(lds + s_cur * BUF_BYTES + KT_BYTES); \
            _Pragma("unroll") for (int q = 0; q < 4; ++q) { u32x4 pw_; \
                _Pragma("unroll") for (int j = 0; j < 4; ++j) { const int r = 8 * (q & 1) + 2 * j; pw_[j] = (q < 2) ? cvtpk(C0[r], C0[r + 1]) : cvtpk(C1[r], C1[r + 1]); } \
                const bf16x8 pf_ = __builtin_bit_cast(bf16x8, pw_); const int kvb = 32 * (q >> 1) + 16 * (q & 1) + 4 * hi; \
                _Pragma("unroll") for (int db = 0; db < 2; ++db) { const u32x2 va = *(const LAS u32x2*)(Vt_ + (32 * db + r32) * VP + kvb), vb = *(const LAS u32x2*)(Vt_ + (32 * db + r32) * VP + kvb + 8); \
                    const u32x4 vw = {va.x, va.y, vb.x, vb.y}; const bf16x8 vf = __builtin_bit_cast(bf16x8, vw); \
                    if (db == 0) o0 = __builtin_amdgcn_mfma_f32_32x32x16_bf16(vf, pf_, o0, 0, 0, 0); else o1 = __builtin_amdgcn_mfma_f32_32x32x16_bf16(vf, pf_, o1, 0, 0, 0); } } \
            if ((t_) + 2 < NT) AT_STORE(s_ld); \
            __syncthreads(); \
            { const int tmp_ = s_cur; s_cur = s_nxt; s_nxt = s_ld; s_ld = tmp_; } } while (0)
        AT_LOAD(0); AT_STORE(0);
        if (NT > 1) { AT_LOAD(1); AT_STORE(1); }
        __syncthreads();
        f32x16 pA0, pA1, pB0, pB1;
        AT_QK(pA0, pA1, 0);
        int s_cur = 0, s_nxt = 1, s_ld = 2;
        for (int t = 0; t < NT; t += 2) {
            AT_STEP(pA0, pA1, pB0, pB1, t);
            AT_STEP(pB0, pB1, pA0, pA1, t + 1);
        }
#undef AT_LOAD
#undef AT_STORE
#undef AT_QK
#undef AT_STEP
#undef MX3
        l += __shfl_xor(l, 32);
        const float il = 1.f / l;
        bf16_t* op = MIX + (size_t)(orow0 + wid * 32 + r32) * D + 512 + hh * 64 + 4 * hi;
#pragma unroll
        for (int g4 = 0; g4 < 4; ++g4) { u32x2 w0, w1; w0.x = cvtpk(o0[4 * g4] * il, o0[4 * g4 + 1] * il); w0.y = cvtpk(o0[4 * g4 + 2] * il, o0[4 * g4 + 3] * il);
            w1.x = cvtpk(o1[4 * g4] * il, o1[4 * g4 + 1] * il); w1.y = cvtpk(o1[4 * g4 + 2] * il, o1[4 * g4 + 3] * il);
            *(u32x2*)(op + 8 * g4) = w0; *(u32x2*)(op + 32 + 8 * g4) = w1; }
    }
}
}

namespace sm {
__device__ __forceinline__ float silu(float x) { return x / (1.f + __expf(-x)); }
__device__ __forceinline__ void mod_phase(LAS unsigned char* lds, const float* c, const float* c_ctx, const float* mod_w, const float* mod_b, float* MOD, int G, int bx, int tid) {
    LAS float* s = (LAS float*)lds;
    for (int i = tid; i < 5120; i += 512) { const int v = i >> 10, k = i & 1023; s[i] = silu(v < 4 ? c[v * 1024 + k] : c_ctx[k]); }
    __syncthreads();
    LAS float* red = s + 5120;
    for (int unit = bx; unit < 96; unit += G) {
        const int l = unit / 48, cb = unit % 48, cl = tid & 127, col = cb * 128 + cl, kq = tid >> 7, k0 = kq * 256;
        const float* W = mod_w + ((size_t)l * 1024 + k0) * 6144 + col;
        float a0 = 0.f, a1 = 0.f, a2 = 0.f, a3 = 0.f, a4 = 0.f;
#pragma unroll 16
        for (int k = 0; k < 256; ++k) { const float w = W[(size_t)k * 6144]; a0 += s[k0 + k] * w; a1 += s[1024 + k0 + k] * w; a2 += s[2048 + k0 + k] * w; a3 += s[3072 + k0 + k] * w; a4 += s[4096 + k0 + k] * w; }
        LAS float* rq = red + kq * 640 + cl; rq[0] = a0; rq[128] = a1; rq[256] = a2; rq[384] = a3; rq[512] = a4;
        __syncthreads();
        for (int i = tid; i < 640; i += 512) { const int v = i >> 7, cc = i & 127; const float r = ((red[i] + red[640 + i]) + (red[1280 + i] + red[1920 + i])) + mod_b[l * 6144 + cb * 128 + cc];
            MOD[((size_t)l * 5 + v) * 6144 + cb * 128 + cc] = r; }
        __syncthreads();
    }
}
__device__ __forceinline__ void norm_store(const float4 (&x)[4], float ss, const float* g, const float* mv, int sh_off, int sc_off, bf16_t* xn_row, int lane) {
    const float rs = rsqrtf(wave_sum(ss) * (1.f / D) + 1e-6f);
#pragma unroll
    for (int j = 0; j < 4; ++j) { const int c = (j * 64 + lane) * 4; const float4 gg = *(const float4*)(g + c), sh = *(const float4*)(mv + sh_off + c), sc = *(const float4*)(mv + sc_off + c);
        u32x2 o; o.x = pk2(x[j].x * rs * gg.x * (1.f + sc.x) + sh.x, x[j].y * rs * gg.y * (1.f + sc.y) + sh.y); o.y = pk2(x[j].z * rs * gg.z * (1.f + sc.z) + sh.z, x[j].w * rs * gg.w * (1.f + sc.w) + sh.w);
        *(u32x2*)(xn_row + c) = o; }
}
__device__ __forceinline__ void pro1_phase(const float* x, const float* ctx, const float* g, const float* MODl, float* H, bf16_t* XN, int r_first, int r_end, int r_step, int lane) {
    for (int r = r_first; r < r_end; r += r_step) { const int b = r / NPOS, pos = r % NPOS, v = pos < CTX ? 4 : b;
        const float* src = pos < CTX ? ctx + ((size_t)b * CTX + pos) * D : x + ((size_t)b * SEQ + (pos - CTX)) * D;
        float4 xv[4]; float ss = 0.f;
#pragma unroll
        for (int j = 0; j < 4; ++j) { const int c = (j * 64 + lane) * 4; xv[j] = *(const float4*)(src + c); ss += xv[j].x * xv[j].x + xv[j].y * xv[j].y + xv[j].z * xv[j].z + xv[j].w * xv[j].w; }
#pragma unroll
        for (int j = 0; j < 4; ++j) *(float4*)(H + (size_t)r * D + (j * 64 + lane) * 4) = xv[j];
        norm_store(xv, ss, g, MODl + (size_t)v * 6144, 0, 1024, XN + (size_t)r * D, lane); }
}
__device__ __forceinline__ void comb_phase(int l, float* H, const bf16_t* Y, const float* MODl, const float* g_next, const float* MODn, bf16_t* XN, const float* final_g, float* out, int gw, int NGW, int lane) {
    for (int r = gw; r < MROWS; r += NGW) { const int b = r / NPOS, pos = r % NPOS, v = pos < CTX ? 4 : b;
        if (l == 1 && pos < CTX) continue;
        const float* g2 = MODl + (size_t)v * 6144 + 5120;
        float4 xv[4]; float ss = 0.f;
#pragma unroll
        for (int j = 0; j < 4; ++j) { const int c = (j * 64 + lane) * 4; xv[j] = *(const float4*)(H + (size_t)r * D + c); float4 s = make_float4(0.f, 0.f, 0.f, 0.f);
#pragma unroll
            for (int k = 0; k < 4; ++k) { const u32x2 y = *(const u32x2*)(Y + ((size_t)r * 4 + k) * D + c); s.x += __uint_as_float(y.x << 16); s.y += __uint_as_float(y.x & 0xffff0000u); s.z += __uint_as_float(y.y << 16); s.w += __uint_as_float(y.y & 0xffff0000u); }
            const float4 gg = *(const float4*)(g2 + c); xv[j].x += gg.x * s.x; xv[j].y += gg.y * s.y; xv[j].z += gg.z * s.z; xv[j].w += gg.w * s.w;
            ss += xv[j].x * xv[j].x + xv[j].y * xv[j].y + xv[j].z * xv[j].z + xv[j].w * xv[j].w; }
        if (l == 0) {
#pragma unroll
            for (int j = 0; j < 4; ++j) *(float4*)(H + (size_t)r * D + (j * 64 + lane) * 4) = xv[j];
            norm_store(xv, ss, g_next, MODn + (size_t)v * 6144, 0, 1024, XN + (size_t)r * D, lane);
        } else { const float rs = rsqrtf(wave_sum(ss) * (1.f / D) + 1e-6f); float* op = out + ((size_t)b * SEQ + (pos - CTX)) * D;
#pragma unroll
            for (int j = 0; j < 4; ++j) { const int c = (j * 64 + lane) * 4; const float4 fg = *(const float4*)(final_g + c); float4 o; o.x = xv[j].x * rs * fg.x; o.y = xv[j].y * rs * fg.y; o.z = xv[j].z * rs * fg.z; o.w = xv[j].w * rs * fg.w; *(float4*)(op + c) = o; } }
    }
}
__device__ __forceinline__ void route_phase(LAS unsigned char* lds, int l, const float* H, const float* g, const float* MODl, const bf16_t* RWH, const bf16_t* RWL, const float* rb, bf16_t* XN, int* CNT, int* LIST, float* GATE,
                                            int G, int bx, int tid) {
    const int lane = tid & 63, wave = __builtin_amdgcn_readfirstlane(tid >> 6), fr = lane & 15, fq = lane >> 4;
    constexpr int FP = 1032;
    LAS bf16_t* FH = (LAS bf16_t*)lds; LAS bf16_t* FL = FH + 16 * FP;
    LAS float* PART = (LAS float*)(lds + 66048);
    LAS int* LCNT = (LAS int*)(lds + 66048 + 16384);
    LAS int* LBASE = LCNT + 64; LAS int* LENT = LCNT + 128;
    if (tid < 64) LCNT[tid] = 0;
    bf16x8 wh[2][4], wl[2][4];
#pragma unroll
    for (int nt = 0; nt < 2; ++nt)
#pragma unroll
        for (int ks = 0; ks < 4; ++ks) { const size_t o = ((size_t)l * NE + 16 * nt + fr) * D + 128 * wave + 32 * ks + 8 * fq; wh[nt][ks] = *(const bf16x8*)(RWH + o); wl[nt][ks] = *(const bf16x8*)(RWL + o); }
    const float bias = rb[lane & 31];
    __syncthreads();
    const int nb = l == 1 ? (MROWS - NB_ * CTX) / 16 : MROWS / 16;
    LAS float* LG = (LAS float*)(lds + 90112);
    LAS float* TOP = (LAS float*)(lds + 92160);
    float4 xv[2][4];
#define RT_ROW(q_) ((l == 1) ? ((q_) / SEQ) * NPOS + CTX + ((q_) % SEQ) : (q_))
#define RT_LOAD(bi_) do { _Pragma("unroll") for (int rr = 0; rr < 2; ++rr) { const int r_ = RT_ROW((bi_) * 16 + 2 * wave + rr); _Pragma("unroll") for (int j = 0; j < 4; ++j) xv[rr][j] = *(const float4*)(H + (size_t)r_ * D + (j * 64 + lane) * 4); } } while (0)
    if (bx < nb) RT_LOAD(bx);
    for (int bi = bx; bi < nb; bi += G) {
#pragma unroll
        for (int rr = 0; rr < 2; ++rr) { const int r = RT_ROW(bi * 16 + 2 * wave + rr);
            const int b = r / NPOS, pos = r % NPOS, v = pos < CTX ? 4 : b; const float* mv = MODl + (size_t)v * 6144;
            float ss = 0.f;
#pragma unroll
            for (int j = 0; j < 4; ++j) ss += xv[rr][j].x * xv[rr][j].x + xv[rr][j].y * xv[rr][j].y + xv[rr][j].z * xv[rr][j].z + xv[rr][j].w * xv[rr][j].w;
            const float rs = rsqrtf(wave_sum(ss) * (1.f / D) + 1e-6f);
#pragma unroll
            for (int j = 0; j < 4; ++j) { const int c = (j * 64 + lane) * 4; const float4 gg = *(const float4*)(g + c), sh = *(const float4*)(mv + 3072 + c), sc = *(const float4*)(mv + 4096 + c);
                float f[4]; f[0] = xv[rr][j].x * rs * gg.x * (1.f + sc.x) + sh.x; f[1] = xv[rr][j].y * rs * gg.y * (1.f + sc.y) + sh.y; f[2] = xv[rr][j].z * rs * gg.z * (1.f + sc.z) + sh.z; f[3] = xv[rr][j].w * rs * gg.w * (1.f + sc.w) + sh.w;
                u32x2 oh, ol; oh.x = pk2(f[0], f[1]); oh.y = pk2(f[2], f[3]);
                ol.x = pk2(f[0] - __uint_as_float(oh.x << 16), f[1] - __uint_as_float(oh.x & 0xffff0000u)); ol.y = pk2(f[2] - __uint_as_float(oh.y << 16), f[3] - __uint_as_float(oh.y & 0xffff0000u));
                *(u32x2*)(XN + (size_t)r * D + c) = oh; *(LAS u32x2*)(FH + (2 * wave + rr) * FP + c) = oh; *(LAS u32x2*)(FL + (2 * wave + rr) * FP + c) = ol; } }
        if (bi + G < nb) RT_LOAD(bi + G);
        __syncthreads();
        { f32x4 acc[2] = {(f32x4){0.f, 0.f, 0.f, 0.f}, (f32x4){0.f, 0.f, 0.f, 0.f}};
#pragma unroll
          for (int ks = 0; ks < 4; ++ks) { const bf16x8 ah = *(const LAS bf16x8*)(FH + fr * FP + 128 * wave + 32 * ks + 8 * fq), al = *(const LAS bf16x8*)(FL + fr * FP + 128 * wave + 32 * ks + 8 * fq);
#pragma unroll
              for (int nt = 0; nt < 2; ++nt) { acc[nt] = __builtin_amdgcn_mfma_f32_16x16x32_bf16(ah, wh[nt][ks], acc[nt], 0, 0, 0); acc[nt] = __builtin_amdgcn_mfma_f32_16x16x32_bf16(ah, wl[nt][ks], acc[nt], 0, 0, 0);
                  acc[nt] = __builtin_amdgcn_mfma_f32_16x16x32_bf16(al, wh[nt][ks], acc[nt], 0, 0, 0); } }
#pragma unroll
          for (int nt = 0; nt < 2; ++nt)
#pragma unroll
              for (int i = 0; i < 4; ++i) PART[(wave * 16 + 4 * fq + i) * 32 + 16 * nt + fr] = acc[nt][i]; }
        __syncthreads();
        { const int row = 2 * wave + (lane >> 5), e = lane & 31; const int r = RT_ROW(bi * 16 + row);
          float lg = bias;
#pragma unroll
          for (int kw = 0; kw < 8; ++kw) lg += PART[(kw * 16 + row) * 32 + e];
          LG[row * 32 + e] = lg;
          int rank = 0;
#pragma unroll
          for (int j4 = 0; j4 < 8; ++j4) { const f32x4 o = *(const LAS f32x4*)(LG + row * 32 + 4 * j4);
#pragma unroll
              for (int i = 0; i < 4; ++i) { const int j = 4 * j4 + i; rank += (o[i] > lg || (o[i] == lg && j < e)) ? 1 : 0; } }
          if (rank < 4) { TOP[(row * 4 + rank) * 2] = lg; TOP[(row * 4 + rank) * 2 + 1] = __int_as_float(e); }
          if (e == 0) { float tv[4]; int ti[4];
#pragma unroll
              for (int k = 0; k < 4; ++k) { tv[k] = TOP[(row * 4 + k) * 2]; ti[k] = __float_as_int(TOP[(row * 4 + k) * 2 + 1]); }
              float ex[4], sum = 0.f;
#pragma unroll
              for (int k = 0; k < 4; ++k) { ex[k] = __expf(tv[k] - tv[0]); sum += ex[k]; }
              const float isum = 1.f / sum;
#pragma unroll
              for (int k = 0; k < 4; ++k) { const int asg = r * 4 + k; GATE[asg] = ex[k] * isum; const int rk = __hip_atomic_fetch_add(&LCNT[ti[k]], 1, __ATOMIC_RELAXED, __HIP_MEMORY_SCOPE_WORKGROUP); const int slot = __hip_atomic_fetch_add(&LCNT[32], 1, __ATOMIC_RELAXED, __HIP_MEMORY_SCOPE_WORKGROUP);
                  LENT[slot * 2] = asg; LENT[slot * 2 + 1] = (ti[k] << 16) | rk; } } }
        __syncthreads();
    }
#undef RT_ROW
#undef RT_LOAD
    if (tid < 32) LBASE[tid] = LCNT[tid] > 0 ? atomicAdd(&CNT[tid * L::CNT_STRIDE], LCNT[tid]) : 0;
    __syncthreads();
    for (int i = tid; i < LCNT[32]; i += 512) { const int asg = LENT[i * 2], er = LENT[i * 2 + 1], ee = er >> 16, rank = er & 0xffff; LIST[(size_t)ee * LCAP + LBASE[ee] + rank] = asg; }
    __syncthreads();
}
__device__ __forceinline__ void smallw_phase(const float* w_uq, const float* qg, const float* w_ukv, const float* kvg, const float* w_a, const float* w_i, bf16_t* WUQT, bf16_t* WUKVT, bf16_t* WAT, bf16_t* WIT,
                                             float* TABC, float* TABS, const float* lam, float* SPT, const float* rw, bf16_t* RWHp, bf16_t* RWLp, int gt, int NGT) {
    for (int i = gt; i < 2 * 384 * 256; i += NGT) { const int l = i / (384 * 256), q = i % (384 * 256), n = q >> 8, k = q & 255; WUQT[i] = f2bf(qg[l * 256 + k] * w_uq[((size_t)l * 256 + k) * 384 + n]); }
    for (int i = gt; i < 2 * 512 * 128; i += NGT) { const int l = i / (512 * 128), q = i % (512 * 128), n = q >> 7, k = q & 127; WUKVT[i] = f2bf(kvg[l * 128 + k] * w_ukv[((size_t)l * 128 + k) * 512 + n]); }
    for (int i = gt; i < 16 * 4096; i += NGT) { const int m = i >> 12, q = i & 4095, e = q >> 6, d = q & 63; WAT[i] = f2bf(w_a[(size_t)m * 4096 + d * 64 + e]); WIT[i] = f2bf(w_i[(size_t)m * 4096 + d * 64 + e]); }
    for (int i = gt; i < 4096; i += NGT) { float s, c; sincospif((float)i / 2048.f, &s, &c); TABC[i] = c; TABS[i] = s; }
    for (int i = gt; i < 1024; i += NGT) SPT[i] = log1pf(__expf(-lam[i]));
    for (int i = gt; i < 2 * NE * D; i += NGT) { const int l = i / (NE * D), q = i % (NE * D), e = q >> 10, k = q & 1023; const float w = rw[((size_t)l * D + k) * NE + e]; const bf16_t h = f2bf(w); RWHp[i] = h; RWLp[i] = f2bf(w - bf2f(h)); }
}
}

namespace prep {
constexpr int O_KR = 0, O_CS = 8192, O_RS = 16384, O_CQ = 16896  , O_KS = 67072, O_CKV = 100864;
constexpr int CQP = 264, CKP = 136, QSP = 392, KSP = 264;
constexpr float C2 = 0.10206207261596577f * 1.4426950408889634f;
__device__ __forceinline__ void qkv_units(LAS unsigned char* lds, int l, const bf16_t* P, const bf16_t* WUQT, const bf16_t* WUKVT, const float* scw, const float* scb,
                                          bf16_t* QL, bf16_t* QC, bf16_t* KB, bf16_t* VTG, bf16_t* MIX, int u0, int u1, int ustep) {
    LAS float* KRo = (LAS float*)(lds + O_KR); LAS float* CS = (LAS float*)(lds + O_CS); LAS float* RS = (LAS float*)(lds + O_RS);
    LAS bf16_t* CQ = (LAS bf16_t*)(lds + O_CQ); LAS bf16_t* CK = (LAS bf16_t*)(lds + O_CKV); LAS bf16_t* KS = (LAS bf16_t*)(lds + O_KS); LAS bf16_t* QS = (LAS bf16_t*)(lds + O_CQ);
    for (int unit = u0; unit < u1; unit += ustep) {
        int tid_l = threadIdx.x; asm volatile("" : "+v"(tid_l));
        const int tid = tid_l, lane = tid & 63, w = __builtin_amdgcn_readfirstlane(tid >> 6), fr = lane & 15, fq = lane >> 4;
        const int b = unit / 68, chunk = unit % 68, pos0 = 64 * chunk; const bool ctxt = chunk < 4; const size_t r0 = (size_t)b * NPOS + pos0;
#pragma unroll
        for (int i = 0; i < 4; ++i) { const int q = tid + 512 * i, row = q >> 5, ch = q & 31; *(LAS u32x4*)((LAS unsigned char*)CQ + row * (CQP * 2) + ch * 16) = *(const u32x4*)(P + (r0 + row) * PP + C_CQ + ch * 8); }
#pragma unroll
        for (int i = 0; i < 2; ++i) { const int q = tid + 512 * i, row = q >> 4, ch = q & 15; *(LAS u32x4*)((LAS unsigned char*)CK + row * (CKP * 2) + ch * 16) = *(const u32x4*)(P + (r0 + row) * PP + C_CKV + ch * 8); }
        __syncthreads();
        { const int row = tid >> 3, j = tid & 7; float sq = 0.f, sk = 0.f;
#pragma unroll
          for (int i = 0; i < 4; ++i) { const u32x4 v = *(const LAS u32x4*)((const LAS unsigned char*)CQ + row * (CQP * 2) + j * 64 + i * 16);
#pragma unroll
              for (int e = 0; e < 4; ++e) { const float a = __uint_as_float(v[e] << 16), c = __uint_as_float(v[e] & 0xffff0000u); sq += a * a + c * c; } }
#pragma unroll
          for (int i = 0; i < 2; ++i) { const u32x4 v = *(const LAS u32x4*)((const LAS unsigned char*)CK + row * (CKP * 2) + j * 32 + i * 16);
#pragma unroll
              for (int e = 0; e < 4; ++e) { const float a = __uint_as_float(v[e] << 16), c = __uint_as_float(v[e] & 0xffff0000u); sk += a * a + c * c; } }
          sq += __shfl_xor(sq, 1); sq += __shfl_xor(sq, 2); sq += __shfl_xor(sq, 4); sk += __shfl_xor(sk, 1); sk += __shfl_xor(sk, 2); sk += __shfl_xor(sk, 4);
          if (j == 0) { RS[row * 2] = rsqrtf(sq * (1.f / 256.f) + 1e-6f); RS[row * 2 + 1] = rsqrtf(sk * (1.f / 128.f) + 1e-6f); }
          float cr = 1.f, sr = 0.f, cc = 1.f, sc = 0.f;
          if (!ctxt) { const int t = pos0 - CTX + row; const float inv = __expf(-9.210340371976184f * (float)j * 0.125f); float xa = (float)(t >> 6) * inv * 0.15915494309189535f; xa -= rintf(xa); sr = __sinf(xa * 6.283185307179586f); cr = __cosf(xa * 6.283185307179586f); float xb = (float)(t & 63) * inv * 0.15915494309189535f; xb -= rintf(xb); sc = __sinf(xb * 6.283185307179586f); cc = __cosf(xb * 6.283185307179586f); }
          CS[(row * 16 + j) * 2] = cr; CS[(row * 16 + j) * 2 + 1] = sr; CS[(row * 16 + 8 + j) * 2] = cc; CS[(row * 16 + 8 + j) * 2 + 1] = sc;
          const bf16_t* kp = P + (r0 + row) * PP + C_KR; const float z0 = bf2f(kp[j]), z1 = bf2f(kp[8 + j]), z2 = bf2f(kp[16 + j]), z3 = bf2f(kp[24 + j]);
          KRo[row * 32 + j] = z0 * cr - z1 * sr; KRo[row * 32 + 8 + j] = z0 * sr + z1 * cr; KRo[row * 32 + 16 + j] = z2 * cc - z3 * sc; KRo[row * 32 + 24 + j] = z2 * sc + z3 * cc; }
        __builtin_amdgcn_sched_barrier(0);
        { f32x4 qa[4][3];
#pragma unroll
          for (int mt = 0; mt < 4; ++mt)
#pragma unroll
              for (int n = 0; n < 3; ++n) qa[mt][n] = (f32x4){0.f, 0.f, 0.f, 0.f};
          const bf16_t* wq = WUQT + ((size_t)l * 384 + 48 * w + fr) * 256 + 8 * fq;
#pragma unroll
          for (int ks = 0; ks < 8; ++ks) { bf16x8 a[4], bb[3];
#pragma unroll
              for (int mt = 0; mt < 4; ++mt) a[mt] = *(const LAS bf16x8*)(CQ + (16 * mt + fr) * CQP + 32 * ks + 8 * fq);
#pragma unroll
              for (int n = 0; n < 3; ++n) bb[n] = *(const bf16x8*)(wq + (size_t)(16 * n) * 256 + 32 * ks);
#pragma unroll
              for (int mt = 0; mt < 4; ++mt)
#pragma unroll
                  for (int n = 0; n < 3; ++n) qa[mt][n] = __builtin_amdgcn_mfma_f32_16x16x32_bf16(a[mt], bb[n], qa[mt][n], 0, 0, 0); }
          __syncthreads();
#pragma unroll
          for (int n = 0; n < 3; ++n) { const int nt = 3 * w + n, m6 = nt % 6, col = 16 * nt + fr;
#pragma unroll
              for (int mt = 0; mt < 4; ++mt)
#pragma unroll
                  for (int i = 0; i < 4; ++i) { const int row = 16 * mt + 4 * fq + i; float v = qa[mt][n][i] * RS[row * 2];
                      if (m6 >= 4) { const float pv = __shfl_xor(v, 8); const int ci = (row * 16 + (m6 == 5 ? 8 : 0) + (fr & 7)) * 2; const float c = CS[ci], s = CS[ci + 1]; v = (fr < 8) ? v * c - pv * s : pv * s + v * c; }
                      QS[row * QSP + col] = f2bf(v * C2); } } }
        __builtin_amdgcn_sched_barrier(0);
        { f32x4 ka[4][4];
#pragma unroll
          for (int mt = 0; mt < 4; ++mt)
#pragma unroll
              for (int n = 0; n < 4; ++n) ka[mt][n] = (f32x4){0.f, 0.f, 0.f, 0.f};
          const bf16_t* wk = WUKVT + ((size_t)l * 512 + 64 * w + fr) * 128 + 8 * fq;
#pragma unroll
          for (int ks = 0; ks < 4; ++ks) { bf16x8 a[4], bb[4];
#pragma unroll
              for (int mt = 0; mt < 4; ++mt) a[mt] = *(const LAS bf16x8*)(CK + (16 * mt + fr) * CKP + 32 * ks + 8 * fq);
#pragma unroll
              for (int n = 0; n < 4; ++n) bb[n] = *(const bf16x8*)(wk + (size_t)(16 * n) * 128 + 32 * ks);
#pragma unroll
              for (int mt = 0; mt < 4; ++mt)
#pragma unroll
                  for (int n = 0; n < 4; ++n) ka[mt][n] = __builtin_amdgcn_mfma_f32_16x16x32_bf16(a[mt], bb[n], ka[mt][n], 0, 0, 0); }
          const int head = w >> 1;
          if ((w & 1) == 0) {
#pragma unroll
              for (int n = 0; n < 4; ++n)
#pragma unroll
                  for (int mt = 0; mt < 4; ++mt)
#pragma unroll
                      for (int i = 0; i < 4; ++i) { const int row = 16 * mt + 4 * fq + i; KS[row * KSP + head * 64 + 16 * n + fr] = f2bf(ka[mt][n][i] * RS[row * 2 + 1]); }
          } else {
#pragma unroll
              for (int n = 0; n < 4; ++n)
#pragma unroll
                  for (int mt = 0; mt < 4; ++mt) { const int rb = 16 * mt + 4 * fq; u32x2 o; o.x = pk2(ka[mt][n][0] * RS[rb * 2 + 1], ka[mt][n][1] * RS[rb * 2 + 3]); o.y = pk2(ka[mt][n][2] * RS[rb * 2 + 5], ka[mt][n][3] * RS[rb * 2 + 7]);
                      *(u32x2*)(VTG + ((size_t)(b * 4 + head) * 64 + 16 * n + fr) * NPOS + pos0 + rb) = o; } } }
        __syncthreads();
#pragma unroll
        for (int i = 0; i < 6; ++i) { const int q = tid + 512 * i, row = q / 48, rem = q % 48, head = rem / 12, ch = rem % 12, pos = pos0 + row;
            const u32x4 qv = *(const LAS u32x4*)((const LAS unsigned char*)QS + row * (QSP * 2) + (head * 96 + ch * 8) * 2);
            if (!ctxt) *(u32x4*)(QL + ((size_t)(b * 4 + head) * SEQ + (pos - CTX)) * 96 + ch * 8) = qv; else if (l == 0) *(u32x4*)(QC + ((size_t)(b * 4 + head) * CTX + pos) * 96 + ch * 8) = qv;
            u32x4 kv;
            if (ch < 8) kv = *(const LAS u32x4*)((const LAS unsigned char*)KS + row * (KSP * 2) + (head * 64 + ch * 8) * 2);
            else { const LAS float* kr = KRo + row * 32 + (ch - 8) * 8; kv.x = pk2(kr[0], kr[1]); kv.y = pk2(kr[2], kr[3]); kv.z = pk2(kr[4], kr[5]); kv.w = pk2(kr[6], kr[7]); }
            *(u32x4*)(KB + ((size_t)(b * 4 + head) * NPOS + pos) * 96 + ch * 8) = kv; }
        if (!(ctxt && l == 1)) { const int lo = ctxt ? 0 : CTX, hi = ctxt ? CTX : NPOS;
#pragma unroll
            for (int i = 0; i < 4; ++i) { const int q = tid + 512 * i, row = q >> 5, ch = q & 31, pos = pos0 + row; float acc[8];
#pragma unroll
                for (int e = 0; e < 8; ++e) acc[e] = scb[ch * 8 + e];
#pragma unroll
                for (int k = 0; k < 3; ++k) { const int p = pos - 1 + k; if (p >= lo && p < hi) { const bf16_t* pr = P + ((size_t)b * NPOS + p) * PP; const u32x4 sx = *(const u32x4*)(pr + C_SX + ch * 8), sc = *(const u32x4*)(pr + C_SC + ch * 8);
#pragma unroll
                        for (int e = 0; e < 4; ++e) { const float w0 = scw[k * 256 + ch * 8 + 2 * e], w1 = scw[k * 256 + ch * 8 + 2 * e + 1];
                            acc[2 * e] += w0 * (__uint_as_float(sx[e] << 16) * __uint_as_float(sc[e] << 16)); acc[2 * e + 1] += w1 * (__uint_as_float(sx[e] & 0xffff0000u) * __uint_as_float(sc[e] & 0xffff0000u)); } } }
                const u32x4 sb = *(const u32x4*)(P + (r0 + row) * PP + C_SB + ch * 8); u32x4 o;
#pragma unroll
                for (int e = 0; e < 4; ++e) o[e] = pk2(__uint_as_float(sb[e] << 16) * acc[2 * e], __uint_as_float(sb[e] & 0xffff0000u) * acc[2 * e + 1]);
                *(u32x4*)(MIX + (r0 + row) * D + 768 + ch * 8) = o; } }
        __syncthreads();
    }
}
}

namespace lru {
constexpr int XP = 264, O_X = 0, O_NA = 33792, O_BB = 66560;
__device__ __forceinline__ float sigm(float x) { return __builtin_amdgcn_rcpf(1.f + __expf(-x)); }
__device__ __forceinline__ void chunk_units(LAS unsigned char* lds, int l, const bf16_t* P, const float* conv_w, const float* conv_b, const bf16_t* WAT, const bf16_t* WIT, const float* b_a, const float* b_i, const float* SPT,
                                            bf16_t* HL, bf16_t* AC, float* SUM, int u0, int u1, int ustep, int knob) {
    LAS bf16_t* X = (LAS bf16_t*)(lds + O_X); LAS bf16_t* NA = (LAS bf16_t*)(lds + O_NA); LAS bf16_t* BB = (LAS bf16_t*)(lds + O_BB);
    for (int unit = u0; unit < u1; unit += ustep) {
        int tid_l = threadIdx.x; asm volatile("" : "+v"(tid_l));
        const int tid = tid_l, lane = tid & 63, w = __builtin_amdgcn_readfirstlane(tid >> 6), fr = lane & 15, fq = lane >> 4;
        const int dir = unit & 1, bc = unit >> 1, b = bc / 68, chunk = bc % 68, pos0 = 64 * chunk; const int lo = chunk < 4 ? 0 : CTX, hi = chunk < 4 ? CTX : NPOS, left = dir ? 1 : 2;
        const size_t r0 = (size_t)b * NPOS + pos0; const int pd = (l * 2 + dir) * 256;
        if (!(knob & 1)) { const int cg = tid & 31, ts = tid >> 5, c0 = cg * 8; float wv[4][8], cbv[8];
#pragma unroll
          for (int e = 0; e < 8; ++e) { cbv[e] = conv_b[pd + c0 + e];
#pragma unroll
              for (int k = 0; k < 4; ++k) wv[k][e] = conv_w[(size_t)pd * 4 + k * 256 + c0 + e]; }
          const bf16_t* pc = P + (size_t)b * NPOS * PP + C_LX + c0; const int pb = pos0 + 4 * ts - left;
          u32x4 u[7];
#pragma unroll
          for (int i = 0; i < 7; ++i) { const int p = pb + i; const int pcl = p < lo ? lo : (p >= hi ? hi - 1 : p); u[i] = *(const u32x4*)(pc + (size_t)pcl * PP); if (p < lo || p >= hi) u[i] = (u32x4){0u, 0u, 0u, 0u}; }
#pragma unroll
          for (int i = 0; i < 4; ++i) { u32x4 o;
#pragma unroll
              for (int e2 = 0; e2 < 4; ++e2) { float lo_ = cbv[2 * e2], hi_ = cbv[2 * e2 + 1];
#pragma unroll
                  for (int k = 0; k < 4; ++k) { const unsigned d = u[i + k][e2]; lo_ += wv[k][2 * e2] * __uint_as_float(d << 16); hi_ += wv[k][2 * e2 + 1] * __uint_as_float(d & 0xffff0000u); }
                  o[e2] = pk2(lo_, hi_); }
              *(LAS u32x4*)(X + (4 * ts + i) * XP + c0) = o; } }
        __syncthreads();
        if (!(knob & 2)) { const int h = w >> 1, mh = w & 1;
          f32x4 ra[2][4], ri[2][4];
#pragma unroll
          for (int m = 0; m < 2; ++m)
#pragma unroll
              for (int n = 0; n < 4; ++n) { ra[m][n] = (f32x4){0.f, 0.f, 0.f, 0.f}; ri[m][n] = (f32x4){0.f, 0.f, 0.f, 0.f}; }
          const bf16_t* wa = WAT + ((size_t)((l * 2 + dir) * 4 + h) * 64 + fr) * 64 + 8 * fq; const bf16_t* wi = WIT + ((size_t)((l * 2 + dir) * 4 + h) * 64 + fr) * 64 + 8 * fq;
#pragma unroll
          for (int ks = 0; ks < 2; ++ks) { bf16x8 a[2], ba[4], bi[4];
#pragma unroll
              for (int m = 0; m < 2; ++m) a[m] = *(const LAS bf16x8*)(X + (16 * (2 * mh + m) + fr) * XP + 64 * h + 32 * ks + 8 * fq);
#pragma unroll
              for (int n = 0; n < 4; ++n) { ba[n] = *(const bf16x8*)(wa + (size_t)(16 * n) * 64 + 32 * ks); bi[n] = *(const bf16x8*)(wi + (size_t)(16 * n) * 64 + 32 * ks); }
#pragma unroll
              for (int m = 0; m < 2; ++m)
#pragma unroll
                  for (int n = 0; n < 4; ++n) { ra[m][n] = __builtin_amdgcn_mfma_f32_16x16x32_bf16(a[m], ba[n], ra[m][n], 0, 0, 0); ri[m][n] = __builtin_amdgcn_mfma_f32_16x16x32_bf16(a[m], bi[n], ri[m][n], 0, 0, 0); } }
#pragma unroll
          for (int n = 0; n < 4; ++n) { const int c = 64 * h + 16 * n + fr; const float bav = b_a[pd + c], biv = b_i[pd + c], sp8 = 8.f * SPT[pd + c];
#pragma unroll
              for (int m = 0; m < 2; ++m)
#pragma unroll
                  for (int i = 0; i < 4; ++i) { const int t = 16 * (2 * mh + m) + 4 * fq + i; const float r = sigm(ra[m][n][i] + bav), ig = sigm(ri[m][n][i] + biv);
                      const float x = r * sp8; const float na = x < 0.03125f ? x * (1.f - 0.5f * x * (1.f - 0.33333334f * x * (1.f - 0.25f * x))) : 1.f - __expf(-x); const float xv = bf2f(X[t * XP + c]);
                      NA[t * 256 + c] = f2bf(na); BB[t * 256 + c] = f2bf(__builtin_amdgcn_sqrtf(fmaxf(na * (2.f - na), 0.f)) * (ig * xv)); } } }
        __syncthreads();
        if (tid < 256 && !(knob & 4)) { const int c = tid; float hst = 0.f, A = 1.f;
            if (dir == 0) {
#pragma unroll 8
                for (int t = 0; t < 64; ++t) { const float a = 1.f - bf2f(NA[t * 256 + c]); hst = a * hst + bf2f(BB[t * 256 + c]); A *= a; BB[t * 256 + c] = f2bf(hst); NA[t * 256 + c] = f2bf(A); }
            } else {
#pragma unroll 8
                for (int t = 63; t >= 0; --t) { const float a = 1.f - bf2f(NA[t * 256 + c]); hst = a * hst + bf2f(BB[t * 256 + c]); A *= a; BB[t * 256 + c] = f2bf(hst); NA[t * 256 + c] = f2bf(A); }
            }
            float* sm = SUM + ((size_t)(dir * 4 + b) * 68 + chunk) * 512; sm[c] = A; sm[256 + c] = hst; }
        __syncthreads();
        if (!(knob & 4)) {
#pragma unroll
            for (int i = 0; i < 4; ++i) { const int q = tid + 512 * i, t = q >> 5, ch = q & 31; const size_t go = ((size_t)dir * MROWS + r0 + t) * 256 + ch * 8;
                *(u32x4*)(AC + go) = *(const LAS u32x4*)(NA + t * 256 + ch * 8); *(u32x4*)(HL + go) = *(const LAS u32x4*)(BB + t * 256 + ch * 8); } }
        __syncthreads();
    }
}
__device__ __forceinline__ void fixup_units(LAS unsigned char* lds, int l, const bf16_t* P, const bf16_t* HL, const bf16_t* AC, const float* SUM, bf16_t* MIX, int G, int bx) {
    LAS float* CAR = (LAS float*)lds;
    for (int unit = bx; unit < 272; unit += G) {
        int tid_l = threadIdx.x; asm volatile("" : "+v"(tid_l));
        const int tid = tid_l;
        const int b = unit / 68, chunk = unit % 68; if (l == 1 && chunk < 4) continue;
        { const int dir = tid >> 8, c = tid & 255; const float* sp = SUM + ((size_t)(dir * 4 + b) * 68) * 512 + c;
          const int n_pre = dir == 0 ? chunk : (chunk < 4 ? 3 - chunk : 4 + (67 - chunk));
          float cy = 0.f;
          for (int j0 = 0; j0 < n_pre; j0 += 16) { float av[16], hv[16];
#pragma unroll
              for (int u = 0; u < 16; ++u) { const int n = j0 + u < n_pre ? j0 + u : n_pre - 1; const int j = dir == 0 ? n : (n < 4 ? 3 - n : 71 - n); av[u] = sp[(size_t)j * 512]; hv[u] = sp[(size_t)j * 512 + 256]; }
#pragma unroll
              for (int u = 0; u < 16; ++u) cy = (j0 + u < n_pre) ? hv[u] + av[u] * cy : cy; }
          CAR[tid] = cy; }
        __syncthreads();
        { const int cg = tid & 31, ts = tid >> 5, c0 = cg * 8; float cf[8], cb[8];
#pragma unroll
          for (int e = 0; e < 8; ++e) { cf[e] = CAR[c0 + e]; cb[e] = CAR[256 + c0 + e]; }
          const size_t r0 = (size_t)b * NPOS + 64 * chunk + 4 * ts;
          u32x4 hf[4], af[4], hb[4], ab[4], gt[4];
#pragma unroll
          for (int i = 0; i < 4; ++i) { const size_t r = r0 + i; hf[i] = *(const u32x4*)(HL + r * 256 + c0); af[i] = *(const u32x4*)(AC + r * 256 + c0); hb[i] = *(const u32x4*)(HL + ((size_t)MROWS + r) * 256 + c0); ab[i] = *(const u32x4*)(AC + ((size_t)MROWS + r) * 256 + c0);
              gt[i] = *(const u32x4*)(P + r * PP + C_LG + c0); }
#pragma unroll
          for (int i = 0; i < 4; ++i) { u32x4 o;
#pragma unroll
              for (int e2 = 0; e2 < 4; ++e2) { float res[2];
#pragma unroll
                  for (int hh = 0; hh < 2; ++hh) { const int e = 2 * e2 + hh;
                      const float vhf = hh ? __uint_as_float(hf[i][e2] & 0xffff0000u) : __uint_as_float(hf[i][e2] << 16), vaf = hh ? __uint_as_float(af[i][e2] & 0xffff0000u) : __uint_as_float(af[i][e2] << 16);
                      const float vhb = hh ? __uint_as_float(hb[i][e2] & 0xffff0000u) : __uint_as_float(hb[i][e2] << 16), vab = hh ? __uint_as_float(ab[i][e2] & 0xffff0000u) : __uint_as_float(ab[i][e2] << 16);
                      const float x = hh ? __uint_as_float(gt[i][e2] & 0xffff0000u) : __uint_as_float(gt[i][e2] << 16);
                      const float hsum = (vhf + vaf * cf[e]) + (vhb + vab * cb[e]);
                      const float u = 0.7978845608028654f * (x + 0.044715f * x * x * x); const float th_ = 1.f - 2.f * __builtin_amdgcn_rcpf(1.f + __expf(2.f * u));
                      res[hh] = 0.5f * x * (1.f + th_) * hsum; }
                  o[e2] = pk2(res[0], res[1]); }
              *(u32x4*)(MIX + (r0 + i) * D + 256 + c0) = o; } }
        __syncthreads();
    }
}
}

namespace fft {
__device__ __forceinline__ void ctx_a(LAS unsigned char* lds, const bf16_t* P, const float* TABC, const float* TABS, bf16_t* XCT, int G, int bx) {
    LAS bf16_t* U = (LAS bf16_t*)(lds + O_U); LAS bf16_t* X = (LAS bf16_t*)(lds + O_X);
    for (int unit = bx; unit < 16; unit += G) {
        int tid_l = threadIdx.x; asm volatile("" : "+v"(tid_l));
        const int tid = tid_l, lane = tid & 63, w = __builtin_amdgcn_readfirstlane(tid >> 6), fr = lane & 15, fq = lane >> 4;
        build_tables(lds, TABC, TABS, tid);
        const LAS bf16_t* Tc = (const LAS bf16_t*)(lds + O_TC); const LAS bf16_t* Ts = (const LAS bf16_t*)(lds + O_TS);
        const int b = unit >> 2, q = unit & 3;
#pragma unroll
        for (int i = 0; i < 4; ++i) { const int qq = tid + 512 * i, t1 = qq >> 5, ch = qq & 31;
            *(LAS u32x4*)((LAS unsigned char*)U + t1 * (UP * 2) + ch * 16) = *(const u32x4*)(P + ((size_t)b * NPOS + 64 * q + t1) * PP + ch * 8); }
        __syncthreads();
        { const int g = w >> 1, part = w & 1; const LAS bf16_t* T = part ? Ts : Tc;
          f32x4 acc[4][4];
#pragma unroll
          for (int mt = 0; mt < 4; ++mt)
#pragma unroll
              for (int nt = 0; nt < 4; ++nt) acc[mt][nt] = (f32x4){0.f, 0.f, 0.f, 0.f};
#pragma unroll
          for (int ks = 0; ks < 2; ++ks) { bf16x8 a[4], bb[4];
#pragma unroll
              for (int mt = 0; mt < 4; ++mt) a[mt] = *(const LAS bf16x8*)(U + (16 * mt + fr) * UP + g * 64 + 32 * ks + 8 * fq);
#pragma unroll
              for (int nt = 0; nt < 4; ++nt) bb[nt] = *(const LAS bf16x8*)(T + (16 * nt + fr) * TP + 32 * ks + 8 * fq);
#pragma unroll
              for (int mt = 0; mt < 4; ++mt)
#pragma unroll
                  for (int nt = 0; nt < 4; ++nt) acc[mt][nt] = __builtin_amdgcn_mfma_f32_16x16x32_bf16(a[mt], bb[nt], acc[mt][nt], 0, 0, 0); }
          const float sg = part ? -1.f : 1.f;
#pragma unroll
          for (int mt = 0; mt < 4; ++mt)
#pragma unroll
              for (int nt = 0; nt < 4; ++nt) { const f32x4 v = acc[mt][nt] * sg; u32x2 o; o.x = pk2(v[0], v[1]); o.y = pk2(v[2], v[3]);
                  *(LAS u32x2*)(X + (part * 256 + g * 64 + 16 * nt + fr) * TP + 16 * mt + 4 * fq) = o; } }
        __syncthreads();
#pragma unroll
        for (int i = 0; i < 8; ++i) { const int qq = tid + 512 * i, row = qq >> 3, c8 = qq & 7;
            *(u32x4*)(XCT + (((size_t)b * 4 + q) * 512 + row) * 64 + c8 * 8) = *(const LAS u32x4*)((const LAS unsigned char*)X + row * (TP * 2) + c8 * 16); }
        __syncthreads();
    }
}
__device__ __forceinline__ void ctx_b(LAS unsigned char* lds, const bf16_t* XCT, const float* TABC, const float* TABS, bf16_t* MIX, int G, int bx) {
    LAS bf16_t* Tc = (LAS bf16_t*)(lds + O_TC); LAS bf16_t* Ts = (LAS bf16_t*)(lds + O_TS);
    LAS bf16_t* Ys = (LAS bf16_t*)(lds + O_U); LAS bf16_t* ZT = (LAS bf16_t*)(lds + O_X);
    for (int unit = bx; unit < 16; unit += G) {
        int tid_l = threadIdx.x; asm volatile("" : "+v"(tid_l));
        const int tid = tid_l, lane = tid & 63, w = __builtin_amdgcn_readfirstlane(tid >> 6), fr = lane & 15, fq = lane >> 4;
        const int b = unit >> 2, ft = unit & 3;
        f32x4 y[4][2];
#pragma unroll
        for (int mt = 0; mt < 4; ++mt)
#pragma unroll
            for (int n = 0; n < 2; ++n) y[mt][n] = (f32x4){0.f, 0.f, 0.f, 0.f};
        for (int q = 0; q < 4; ++q) {
            for (int i = tid; i < 4096; i += 512) { const int fl = i >> 6, tl = i & 63, ix = (((64 * ft + fl) * (64 * q + tl)) & 255) * 16; Tc[fl * TP + tl] = f2bf(TABC[ix]); Ts[fl * TP + tl] = f2bf(TABS[ix]); }
#pragma unroll
            for (int i = 0; i < 8; ++i) { const int qq = tid + 512 * i, row = qq >> 3, c8 = qq & 7;
                *(LAS u32x4*)((LAS unsigned char*)ZT + row * (TP * 2) + c8 * 16) = *(const u32x4*)(XCT + (((size_t)b * 4 + q) * 512 + row) * 64 + c8 * 8); }
            __syncthreads();
#pragma unroll
            for (int ks = 0; ks < 2; ++ks) { bf16x8 xr[2], xi[2];
#pragma unroll
                for (int n = 0; n < 2; ++n) { xr[n] = *(const LAS bf16x8*)(ZT + (32 * w + 16 * n + fr) * TP + 32 * ks + 8 * fq); xi[n] = *(const LAS bf16x8*)(ZT + (256 + 32 * w + 16 * n + fr) * TP + 32 * ks + 8 * fq); }
#pragma unroll
                for (int mt = 0; mt < 4; ++mt) { const bf16x8 c = *(const LAS bf16x8*)(Tc + (16 * mt + fr) * TP + 32 * ks + 8 * fq), s = *(const LAS bf16x8*)(Ts + (16 * mt + fr) * TP + 32 * ks + 8 * fq);
#pragma unroll
                    for (int n = 0; n < 2; ++n) { y[mt][n] = __builtin_amdgcn_mfma_f32_16x16x32_bf16(c, xr[n], y[mt][n], 0, 0, 0); y[mt][n] = __builtin_amdgcn_mfma_f32_16x16x32_bf16(s, xi[n], y[mt][n], 0, 0, 0); } } }
            __syncthreads();
        }
#pragma unroll
        for (int mt = 0; mt < 4; ++mt)
#pragma unroll
            for (int i = 0; i < 4; ++i)
#pragma unroll
                for (int n = 0; n < 2; ++n) Ys[(16 * mt + 4 * fq + i) * UP + 32 * w + 16 * n + fr] = f2bf(y[mt][n][i] * (1.f / 128.f));
        __syncthreads();
#pragma unroll
        for (int i = 0; i < 4; ++i) { const int qq = tid + 512 * i, fl = qq >> 5, ch = qq & 31;
            *(u32x4*)(MIX + ((size_t)b * NPOS + 64 * ft + fl) * D + ch * 8) = *(const LAS u32x4*)((const LAS unsigned char*)Ys + fl * (UP * 2) + ch * 16); }
        __syncthreads();
    }
}
}

constexpr int NWAVES = 8, RING_BYTES = 131072 + 3072, LDSCTL_OFF = RING_BYTES, MISC_OFF = LDSCTL_OFF + 64, META_OFF = MISC_OFF + 64, LDS_BYTES = 147456;
enum { PH_PRO0 = 0, PH_PRO1 = 1, PH_L0 = 2, PH_PER_LAYER = 8, PH_N = 18 };
enum { PL_WIN = 0, PL_PREP = 1, PL_MIX = 2, PL_WOUT = 3, PL_ROUTE = 4, PL_MOE1 = 5, PL_MOE2 = 6, PL_COMB = 7 };
struct MArgs { const float* in[30]; float* out; unsigned char* ws; int npass, skip_mask, dup_ph, dup_n, dup_sub, knob; };

__device__ __forceinline__ void transpose_item(const float* W, int K, int N, bf16_t* WT, int drow0, LAS float* scr, int k0, int n0, int lane) {
    const int kr = lane >> 3, nc = (lane & 7) * 4;
    f32x4 v[8];
#pragma unroll
    for (int i = 0; i < 8; ++i) v[i] = __builtin_nontemporal_load((const f32x4*)(W + (size_t)(k0 + kr + 8 * i) * N + n0 + nc));
#pragma unroll
    for (int i = 0; i < 8; ++i) { LAS float* d = scr + (kr + 8 * i) * 33 + nc; d[0] = v[i][0]; d[1] = v[i][1]; d[2] = v[i][2]; d[3] = v[i][3]; }
    asm volatile("s_waitcnt lgkmcnt(0)" ::: "memory");
    const int c = lane & 7;
#pragma unroll
    for (int j = 0; j < 4; ++j) { const int n = (lane >> 3) + 8 * j; const LAS float* s = scr + (8 * c) * 33 + n;
        u32x4 o; o.x = pk2(s[0 * 33], s[1 * 33]); o.y = pk2(s[2 * 33], s[3 * 33]); o.z = pk2(s[4 * 33], s[5 * 33]); o.w = pk2(s[6 * 33], s[7 * 33]);
        *(u32x4*)(WT + (size_t)(drow0 + n) * K + k0 + 8 * c) = o; }
    asm volatile("s_waitcnt lgkmcnt(0)" ::: "memory");
}

constexpr int I_GU = NE * 16 * 64, I_DN = NE * 16 * 32, I_EXP = I_GU + I_DN;
__device__ __forceinline__ void expert_item(int l, int j, const float* wgu, const float* wdn, unsigned char* ws, LAS float* scr, int lane) {
    if (j < I_GU) { const int e = j / (16 * 64), q = j % (16 * 64), kb = q / 64, nb = q % 64; const int n0 = 32 * nb; const int c2 = n0 & 1023; const int drow = (c2 >> 7) * 256 + (n0 >> 10) * 128 + (c2 & 127);
        transpose_item(wgu + ((size_t)l * NE + e) * D * 2048, D, 2048, (bf16_t*)(ws + L::WGUT) + ((size_t)l * NE + e) * 2048 * D, drow, scr, 64 * kb, n0, lane); }
    else { const int r = j - I_GU; const int e = r / (16 * 32), q = r % (16 * 32), kb = q / 32, nb = q % 32;
        transpose_item(wdn + ((size_t)l * NE + e) * D * D, D, D, (bf16_t*)(ws + L::WDT) + ((size_t)l * NE + e) * D * D, 32 * nb, scr, 64 * kb, 32 * nb, lane); }
}
constexpr int Q_WIN = 48, Q_WOUT = 96, Q_MOE2 = 0;
constexpr int DEF_WIN = 224 * Q_WIN, DEF0 = DEF_WIN + 240 * Q_WOUT, DEF_MOE2 = 128 * Q_MOE2, DEF1 = DEF_MOE2 + 224 * Q_WIN;
__device__ __forceinline__ void deferred_items(int l, int first, int count, const float* wgu, const float* wdn, unsigned char* ws, LAS unsigned char* lds, int wave, int lane) {
    LAS float* scr = (LAS float*)(lds + wave * 16384);
    for (int j = first + wave; j < first + count; j += NWAVES) expert_item(l, j, wgu, wdn, ws, scr, lane);
}

#define GASP __attribute__((address_space(1)))
#define ARG_IN(i) ({ const GASP float* _p; asm volatile("s_load_dwordx2 %0, %1, %2\n\ts_waitcnt lgkmcnt(0)" : "=s"(_p) : "s"(__builtin_amdgcn_kernarg_segment_ptr()), "n"((i) * 8)); (const float*)_p; })
__global__ void __launch_bounds__(NWAVES * 64, 2) mega(MArgs args) {
    extern __shared__ __attribute__((aligned(16))) unsigned char lds_raw[];
    const int G0 = gridDim.x, bx0 = blockIdx.x;
    unsigned char* ws0 = args.ws;
    unsigned* ctl0 = (unsigned*)(ws0 + L::CTL);
    for (int u = threadIdx.x; u < (LDS_BYTES - LDSCTL_OFF) / 4; u += NWAVES * 64) ((LAS unsigned*)(lds_raw + LDSCTL_OFF))[u] = 0u;
    __syncthreads();
    volatile LAS unsigned* MISC = (volatile LAS unsigned*)((LAS unsigned char*)lds_raw + MISC_OFF);
    XcdBarrier bar = xcd_barrier_post(ctl0 + L::CW_BAR, MISC);
    const int lo = 0, hi = PH_N;

    bool first = true;
    for (int pass = 0; pass < args.npass; ++pass)
    for (int ph = lo; ph < hi; ++ph) {
      const int reps = (ph == args.dup_ph) ? 1 + args.dup_n : 1;
      if (ph == PH_PRO1) continue;
      for (int rep = 0; rep < reps; ++rep) {
        if (!first) xcd_barrier(bar);
        first = false;
        if (pass + 1 < args.npass && ((args.skip_mask >> ph) & 1)) continue;
        const int sub = rep + 1 < reps ? args.dup_sub : 15; const int knob = rep + 1 < reps ? args.knob : 0; (void)knob;
        GASP unsigned char* wsg = (GASP unsigned char*)args.ws; asm volatile("" : "+s"(wsg)); unsigned char* ws = (unsigned char*)wsg;
        unsigned* ctl = (unsigned*)(ws + L::CTL);
        int tid_p = threadIdx.x; asm volatile("" : "+v"(tid_p));
        int G = G0, bx = bx0; asm volatile("" : "+s"(G), "+s"(bx));
        const int vcu = (G % 8 == 0) ? (bx % 8) * (G / 8) + bx / 8 : bx; (void)vcu;
        unsigned ldsb = 0; asm volatile("" : "+s"(ldsb)); LAS unsigned char* lds = (LAS unsigned char*)lds_raw + ldsb;
        LAS int* META = (LAS int*)(lds + META_OFF);
        const int tid = tid_p, lane = tid & 63, wave = __builtin_amdgcn_readfirstlane(tid >> 6); (void)lane; (void)wave;
        if (ph == PH_PRO0) {
            if (bx == 0 && tid < 2 * NE) ((int*)(ctl + L::CW_CNT))[tid * L::CNT_STRIDE] = 0;
            sm::smallw_phase(ARG_IN(17), ARG_IN(16), ARG_IN(19), ARG_IN(18), ARG_IN(11), ARG_IN(13), (bf16_t*)(ws + L::WUQT), (bf16_t*)(ws + L::WUKVT), (bf16_t*)(ws + L::WAT), (bf16_t*)(ws + L::WIT),
                             (float*)(ws + L::TABC), (float*)(ws + L::TABS), ARG_IN(15), (float*)(ws + L::SPT), ARG_IN(23), (bf16_t*)(ws + L::RWH), (bf16_t*)(ws + L::RWL), bx * 512 + tid, G * 512);
            __syncthreads();
            sm::mod_phase(lds, ARG_IN(1), ARG_IN(3), ARG_IN(4), ARG_IN(5), (float*)(ws + L::MOD), G, bx, tid);
            { int nmine = 0; for (int u = bx; u < 96; u += G) ++nmine;
              if (nmine) { asm volatile("s_waitcnt vmcnt(0)" ::: "memory"); __syncthreads();
                  if (tid == 0) { __builtin_amdgcn_fence(__ATOMIC_RELEASE, "agent"); asm volatile("s_waitcnt vmcnt(0)" ::: "memory"); __hip_atomic_fetch_add(ctl + L::CW_MODCNT, (unsigned)nmine, __ATOMIC_RELAXED, __HIP_MEMORY_SCOPE_AGENT); } } }
            __syncthreads();
            LAS float* scr = (LAS float*)(lds + wave * 16384);
            const int gw = vcu * NWAVES + wave, NGW = G * NWAVES;
            constexpr int I_IN = 16 * 61, I_OUT = 16 * 32, I_D = I_IN + I_OUT; const int d0 = G == 256 ? DEF0 : 0, d1 = G == 256 ? DEF1 : 0, R0 = I_EXP - d0, R1 = I_EXP - d1;
            for (int it = gw; it < 2 * I_D + R0 + R1; it += NGW) {
                if (it < 2 * I_D) { const int l = it / I_D; int r = it % I_D;
                    if (r < I_IN) { const int kb = r / 61, nb = r % 61; transpose_item(ARG_IN(8) + (size_t)l * D * PT, D, PT, (bf16_t*)(ws + L::WINT) + (size_t)l * 2048 * D, 32 * nb, scr, 64 * kb, 32 * nb, lane); }
                    else { r -= I_IN; const int kb = r / 32, nb = r % 32; transpose_item(ARG_IN(22) + (size_t)l * D * D, D, D, (bf16_t*)(ws + L::WOUTT) + (size_t)l * D * D, 32 * nb, scr, 64 * kb, 32 * nb, lane); }
                } else { const int r = it - 2 * I_D; if (r < R0) expert_item(0, d0 + r, ARG_IN(25), ARG_IN(27), ws, scr, lane); else expert_item(1, d1 + (r - R0), ARG_IN(25), ARG_IN(27), ws, scr, lane); }
            }
            for (int i = bx * 512 + tid; i < 2 * 96 * D / 8; i += G * 512) { const int l = i / (96 * D / 8), q = i % (96 * D / 8); *(u32x4*)((bf16_t*)(ws + L::WINT) + ((size_t)l * 2048 + PT) * D + (size_t)q * 8) = (u32x4){0u, 0u, 0u, 0u}; }
            if (tid == 0) { unsigned sp = 0; while (__hip_atomic_load(ctl + L::CW_MODCNT, __ATOMIC_RELAXED, __HIP_MEMORY_SCOPE_AGENT) < 96u && ++sp < (1u << 22)) __builtin_amdgcn_s_sleep(2);
                __builtin_amdgcn_fence(__ATOMIC_ACQUIRE, "agent"); asm volatile("s_waitcnt vmcnt(0)" ::: "memory"); }
            __syncthreads();
            { const int nmod = G < 96 ? G : 96; const int small = 45, rs0 = bx < nmod ? bx * small : nmod * small + (int)(((long)(bx - nmod) * (MROWS - nmod * small)) / (G - nmod)),
                  rs1 = bx + 1 < nmod ? (bx + 1) * small : (bx + 1 >= G ? MROWS : nmod * small + (int)(((long)(bx + 1 - nmod) * (MROWS - nmod * small)) / (G - nmod)));
              sm::pro1_phase(ARG_IN(0), ARG_IN(2), ARG_IN(6), (const float*)(ws + L::MOD), (float*)(ws + L::H), (bf16_t*)(ws + L::XN), rs0 + wave, rs1, NWAVES, lane); }
            continue;
        }
        if (ph < PH_L0) continue;
        const int l = (ph - PH_L0) / PH_PER_LAYER, pl = (ph - PH_L0) % PH_PER_LAYER;
        const float* MODl = (const float*)(ws + L::MOD) + (size_t)l * 5 * 6144;
        if (pl == PL_WIN) {
            g8::DenseSched S; S.init(MROWS / 256, PP / 256, G, bx, 0, (const bf16_t*)(ws + L::WINT) + (size_t)l * 2048 * D, D);
            g8::EpiP E{(bf16_t*)(ws + L::P)};
            g8::gemm_phase<g8::EpiP, g8::DenseSched, false, false>(lds, (const char*)(ws + L::XN), S, E);
            if (G == 256 && bx >= 32) deferred_items(l, (l == 0 ? 0 : DEF_MOE2) + (bx - 32) * Q_WIN, Q_WIN, ARG_IN(25), ARG_IN(27), ws, lds, wave, lane);
        } else if (pl == PL_PREP) {
            if (l == 0 && (sub & 2)) { fft::ctx_a(lds, (const bf16_t*)(ws + L::P), (const float*)(ws + L::TABC), (const float*)(ws + L::TABS), (bf16_t*)(ws + L::XCT), G, G - 1 - bx); __syncthreads(); }
            for (int p = 0; p * G < 1072; ++p) {
                const int k = p * G + ((p & 1) ? G - 1 - bx : bx);
                if (k >= 1072) continue;
                if (k < 272) { if (sub & 4) prep::qkv_units(lds, l, (const bf16_t*)(ws + L::P), (const bf16_t*)(ws + L::WUQT), (const bf16_t*)(ws + L::WUKVT), ARG_IN(20) + l * 768, ARG_IN(21) + l * 256,
                            (bf16_t*)(ws + L::QL), (bf16_t*)(ws + L::QC), (bf16_t*)(ws + L::KB), (bf16_t*)(ws + L::VTG), (bf16_t*)(ws + L::MIX), k, k + 1, 1); }
                else if (k < 816) { if (sub & 8) lru::chunk_units(lds, l, (const bf16_t*)(ws + L::P), ARG_IN(9), ARG_IN(10), (const bf16_t*)(ws + L::WAT), (const bf16_t*)(ws + L::WIT), ARG_IN(12), ARG_IN(14), (const float*)(ws + L::SPT),
                             (bf16_t*)(ws + L::HL), (bf16_t*)(ws + L::AC), (float*)(ws + L::SUM), k - 272, k - 271, 1, knob); }
                else { if (sub & 1) fft::stage_a(lds, (const bf16_t*)(ws + L::P), (const float*)(ws + L::TABC), (const float*)(ws + L::TABS), (bf16_t*)(ws + L::ZBUF), k - 816, k - 815, 1); }
                __syncthreads();
            }
        } else if (pl == PL_MIX) {
            if (sub & 1) lru::fixup_units(lds, l, (const bf16_t*)(ws + L::P), (const bf16_t*)(ws + L::HL), (const bf16_t*)(ws + L::AC), (const float*)(ws + L::SUM), (bf16_t*)(ws + L::MIX), G, bx);
            if (sub & 2) fft::stage_b(lds, (const bf16_t*)(ws + L::ZBUF), (const float*)(ws + L::TABC), (const float*)(ws + L::TABS), (bf16_t*)(ws + L::MIX), G, bx);
            __syncthreads();
            if (l == 0 && (sub & 4)) { fft::ctx_b(lds, (const bf16_t*)(ws + L::XCT), (const float*)(ws + L::TABC), (const float*)(ws + L::TABS), (bf16_t*)(ws + L::MIX), G, G - 1 - bx); __syncthreads(); }
            if (sub & 8) attn::attn_phase(lds, (const bf16_t*)(ws + L::QL), (const bf16_t*)(ws + L::QC), (const bf16_t*)(ws + L::KB), (const bf16_t*)(ws + L::VTG), (bf16_t*)(ws + L::MIX), l == 0 ? 1 : 0, G, vcu);
        } else if (pl == PL_WOUT) {
            g8::DenseSched S; S.init(l == 0 ? MROWS / 256 : 64, D / 256, G, bx, l == 0 ? 0 : 1, (const bf16_t*)(ws + L::WOUTT) + (size_t)l * D * D, D);
            g8::EpiH E{(float*)(ws + L::H), MODl, 2048};
            g8::gemm_phase<g8::EpiH, g8::DenseSched, false, false>(lds, (const char*)(ws + L::MIX), S, E);
            if (G == 256 && l == 0 && bx >= 16) deferred_items(0, DEF_WIN + (bx - 16) * Q_WOUT, Q_WOUT, ARG_IN(25), ARG_IN(27), ws, lds, wave, lane);
        } else if (pl == PL_ROUTE) {
            sm::route_phase(lds, l, (const float*)(ws + L::H), ARG_IN(7) + l * D, MODl, (const bf16_t*)(ws + L::RWH), (const bf16_t*)(ws + L::RWL), ARG_IN(24) + l * NE, (bf16_t*)(ws + L::XN), (int*)(ctl + L::CW_CNT) + l * NE * L::CNT_STRIDE,
                            (int*)(ws + L::LIST) + (size_t)l * NE * LCAP, (float*)(ws + L::GATE), G, bx, tid);
        } else if (pl == PL_COMB) {
            sm::comb_phase(l, (float*)(ws + L::H), (const bf16_t*)(ws + L::Y), MODl, ARG_IN(6) + D, (const float*)(ws + L::MOD) + (size_t)5 * 6144, (bf16_t*)(ws + L::XN), ARG_IN(29), args.out, bx * NWAVES + wave, G * NWAVES, lane);
        } else if (pl == PL_MOE1 || pl == PL_MOE2) {
            const int* CNTg = (const int*)(ctl + L::CW_CNT) + l * NE * L::CNT_STRIDE;
            if (tid == 0) { int o = 0; for (int e = 0; e < NE; ++e) { const int cn = CNTg[e * L::CNT_STRIDE]; META[e] = o; META[64 + e] = cn; o += (cn + 255) >> 8; } META[NE] = o; }
            __syncthreads();
            g8::MoeSched S; S.tpre = META; S.cnt = META + 64; S.G = G; S.c = bx; S.K = D; S.list = (const int*)(ws + L::LIST) + (size_t)l * NE * LCAP;
            if (pl == PL_MOE1) {
                S.NT = 8; S.COLW = 128; S.total = __builtin_amdgcn_readfirstlane(META[NE]) * 8; S.Bt = (const char*)((const bf16_t*)(ws + L::WGUT) + (size_t)l * NE * 2048 * D);
                g8::EpiMoe1 E{(bf16_t*)(ws + L::ACT), ARG_IN(26) + (size_t)l * NE * 2048};
                g8::gemm_phase<g8::EpiMoe1, g8::MoeSched, true, true>(lds, (const char*)(ws + L::XN), S, E);
            } else {
                S.NT = 4; S.COLW = 256; S.total = __builtin_amdgcn_readfirstlane(META[NE]) * 4; S.Bt = (const char*)((const bf16_t*)(ws + L::WDT) + (size_t)l * NE * D * D);
                g8::EpiMoe2 E{(bf16_t*)(ws + L::Y), ARG_IN(28) + (size_t)l * NE * D, (const float*)(ws + L::GATE)};
                g8::gemm_phase<g8::EpiMoe2, g8::MoeSched, false, true>(lds, (const char*)(ws + L::ACT), S, E);
                if (G == 256 && l == 0 && bx >= 128) deferred_items(1, (bx - 128) * Q_MOE2, Q_MOE2, ARG_IN(25), ARG_IN(27), ws, lds, wave, lane);
            }
            __syncthreads();
        }
      }
    }
}
constexpr int PROBE_DUP_PH = -1, PROBE_DUP_N = 0, PROBE_DUP_SUB = 15, PROBE_KNOB = 0;
constexpr int PROBE_NPASS = 1, PROBE_SKIP = 0;
extern "C" void kernel_launch(void* const* d_in, const int* in_sizes, int n_in, void* d_out, int out_size, void* d_ws, size_t ws_size, hipStream_t stream) {
    static int grid = 0;
    if (grid == 0) {
        if (n_in != 30 || out_size != NB_ * SEQ * D || (size_t)L::END > ws_size) { fprintf(stderr, "kernel_launch: unexpected problem shape (n_in %d, out %d) or workspace too small (need %zu, have %zu); nothing launched\n", n_in, out_size, (size_t)L::END, ws_size); grid = -1; return; }
        int dev = 0, cus = 0;
        if (hipGetDevice(&dev) != hipSuccess || hipDeviceGetAttribute(&cus, hipDeviceAttributeMultiprocessorCount, dev) != hipSuccess) { fprintf(stderr, "kernel_launch: device query failed\n"); grid = -1; return; }
        if (hipFuncSetAttribute((const void*)mega, hipFuncAttributeMaxDynamicSharedMemorySize, LDS_BYTES) != hipSuccess) { fprintf(stderr, "kernel_launch: hipFuncSetAttribute failed\n"); grid = -1; return; }
        int per_cu = 0;
        if (hipOccupancyMaxActiveBlocksPerMultiprocessor(&per_cu, (const void*)mega, NWAVES * 64, LDS_BYTES) != hipSuccess || per_cu < 1) fprintf(stderr, "kernel_launch: note: the occupancy query reports %d workgroups per CU; launching one per CU anyway\n", per_cu);
        (void)hipGetLastError();
        grid = cus < 256 ? cus : 256;
    }
    if (grid < 0) return;
    unsigned char* p = (unsigned char*)d_ws;
    (void)hipMemsetAsync(p + L::CTL, 0, L::CTL_BYTES, stream);
    MArgs a{};
    for (int i = 0; i < 30; ++i) a.in[i] = (const float*)d_in[i];
    a.out = (float*)d_out; a.ws = p; a.npass = PROBE_NPASS; a.skip_mask = PROBE_SKIP; a.dup_ph = PROBE_DUP_PH; a.dup_n = PROBE_DUP_N; a.dup_sub = PROBE_DUP_SUB; a.knob = PROBE_KNOB;
    hipLaunchKernelGGL(mega, dim3(grid), dim3(NWAVES * 64), LDS_BYTES, stream, a);
}
```

```cpp
#include <hip/hip_runtime.h>
#include <cstdint>
#include <cstdio>

typedef unsigned short bf16_t;
constexpr int NB_ = 4, SEQ = 4096, CTX = 256, D = 1024, NPOS = SEQ + CTX, MROWS = NB_ * NPOS;
constexpr int PT = 1952, PP = 2048;
constexpr int NE = 32, TOPK = 4, LCAP = MROWS;
constexpr int NASG = MROWS * TOPK;
constexpr int ACT_ROWS = NASG + NE * 256;
constexpr int C_FN = 0, C_LX = 256, C_LG = 512, C_CQ = 768, C_CKV = 1024, C_KR = 1152, C_SX = 1184, C_SB = 1440, C_SC = 1696;

__device__ __forceinline__ float bf2f(bf16_t v) { return __uint_as_float((unsigned)v << 16); }
typedef float cv_f2 __attribute__((ext_vector_type(2))); typedef __bf16 cv_b2 __attribute__((ext_vector_type(2)));
__device__ __forceinline__ unsigned pk2(float lo, float hi) { cv_f2 v = {lo, hi}; return __builtin_bit_cast(unsigned, __builtin_convertvector(v, cv_b2)); }
__device__ __forceinline__ bf16_t f2bf(float f) { return (bf16_t)pk2(f, 0.f); }
__device__ __forceinline__ float wave_sum(float v) {
#pragma unroll
    for (int o = 1; o < 64; o <<= 1) v += __shfl_xor(v, o);
    return v;
}
__device__ __forceinline__ float sigmoidf_(float x) { return 1.f / (1.f + __expf(-x)); }
__device__ __forceinline__ float gelu_tanh(float x) { const float u = 0.7978845608028654f * (x + 0.044715f * x * x * x); return 0.5f * x * (1.f + tanhf(u)); }

#define LAS __attribute__((address_space(3)))
typedef short bf16x8 __attribute__((ext_vector_type(8)));
typedef float f32x4 __attribute__((ext_vector_type(4)));
typedef unsigned u32x4 __attribute__((ext_vector_type(4)));
typedef unsigned u32x2 __attribute__((ext_vector_type(2)));

namespace L {
constexpr size_t A256(size_t x) { return (x + 255) & ~(size_t)255; }
constexpr size_t CTL = 0, CTL_BYTES = 1u << 20;
constexpr size_t H = CTL + CTL_BYTES;
constexpr size_t MOD = CTL + 512 * 1024;
constexpr size_t TABC = A256(H + (size_t)MROWS * D * 4);
constexpr size_t TABS = A256(TABC + 4096 * 4);
constexpr size_t XN = A256(TABS + 4096 * 4);
constexpr size_t P = A256(XN + (size_t)MROWS * D * 2);
constexpr size_t MIX = A256(P + (size_t)MROWS * PP * 2);
constexpr size_t CQN = A256(MIX + (size_t)MROWS * D * 2);
constexpr size_t CKVN = A256(CQN + (size_t)MROWS * 256 * 2);
constexpr size_t QRAW = A256(CKVN + (size_t)MROWS * 128 * 2);
constexpr size_t KVRAW = A256(QRAW + (size_t)MROWS * 384 * 4);
constexpr size_t QL = A256(KVRAW + (size_t)MROWS * 512 * 4);
constexpr size_t QC = A256(QL + (size_t)16 * SEQ * 96 * 2);
constexpr size_t KB = A256(QC + (size_t)16 * CTX * 96 * 2);
constexpr size_t VB = A256(KB + (size_t)16 * NPOS * 96 * 2);
constexpr size_t LA = A256(VB + (size_t)16 * NPOS * 64 * 2);
constexpr size_t LB = A256(LA + (size_t)2 * MROWS * 256 * 4);
constexpr size_t HS = A256(LB + (size_t)2 * MROWS * 256 * 4);
constexpr size_t XCS = A256(HS + (size_t)2 * MROWS * 256 * 4);
constexpr size_t XCSC = A256(XCS + (size_t)4 * 8192 * 256 * 4);
constexpr size_t LIST = A256(XCSC + (size_t)4 * 512 * 256 * 4);
constexpr size_t GATE = A256(LIST + (size_t)2 * NE * LCAP * 4);
constexpr size_t ACT = A256(GATE + (size_t)NASG * 4);
constexpr size_t Y = A256(ACT + (size_t)ACT_ROWS * D * 2);
constexpr size_t WINT = A256(Y + (size_t)(NASG + 1) * D * 2);
constexpr size_t WOUTT = A256(WINT + (size_t)2 * 2048 * 1024 * 2);
constexpr size_t WGUT = A256(WOUTT + (size_t)2 * 1024 * 1024 * 2);
constexpr size_t WDT = A256(WGUT + (size_t)2 * NE * 2048 * 1024 * 2);
constexpr size_t ZBUF = A256(WDT + (size_t)2 * NE * 1024 * 1024 * 2);
constexpr size_t VTG = A256(ZBUF + (size_t)4 * 64 * 64 * 512 * 2);
constexpr size_t WUQT = A256(VTG + (size_t)16 * 64 * NPOS * 2);
constexpr size_t WUKVT = A256(WUQT + (size_t)2 * 384 * 256 * 2);
constexpr size_t WAT = A256(WUKVT + (size_t)2 * 512 * 128 * 2);
constexpr size_t WIT = A256(WAT + (size_t)16 * 4096 * 2);
constexpr size_t SPT = A256(WIT + (size_t)16 * 4096 * 2);
constexpr size_t RWH = A256(SPT + (size_t)1024 * 4);
constexpr size_t RWL = A256(RWH + (size_t)2 * NE * D * 2);
constexpr size_t HL = A256(RWL + (size_t)2 * NE * D * 2);
constexpr size_t AC = A256(HL + (size_t)2 * MROWS * 256 * 2);
constexpr size_t SUM = A256(AC + (size_t)2 * MROWS * 256 * 2);
constexpr size_t XCT = A256(SUM + (size_t)2 * 4 * 68 * 512 * 4);
constexpr size_t END = A256(XCT + (size_t)16 * 512 * 64 * 2);
constexpr int CW_BAR = 4096;
constexpr int CW_MODCNT = 2048;
constexpr int CW_CNT = 32768, CNT_STRIDE = 64;
}

#define XB_TMO      128
#define XB_XCNT(j)  (256  + 64 * (j))
#define XB_XSUB(j)  (1280 + 64 * (j))
#define XB_XGEN(j)  (2304 + 64 * (j))
#define XB_TOP      3328
#define XB_TOPGEN   3392
#define XCD_BAR_WORDS 3456
#define XB_SPIN_CAP (1u << 18)
__device__ __forceinline__ unsigned xb_ld(unsigned* p)              { return __hip_atomic_load(p, __ATOMIC_RELAXED, __HIP_MEMORY_SCOPE_AGENT); }
__device__ __forceinline__ unsigned xb_add(unsigned* p, unsigned v) { return __hip_atomic_fetch_add(p, v, __ATOMIC_RELAXED, __HIP_MEMORY_SCOPE_AGENT); }
__device__ __forceinline__ unsigned xb_xcc_id() { return (unsigned)__builtin_amdgcn_s_getreg((3 << 11) | 20) & 0xFu; }
#define XB_SPIN(cond, bar) do { unsigned _sp = 0; while (cond) { __builtin_amdgcn_s_sleep(1); \
    if ((++_sp & 255u) == 0u) { if (xb_ld(&(bar)[XB_TMO])) break; if (_sp > XB_SPIN_CAP) { atomicAdd(&(bar)[XB_TMO], 1u); break; } } } } while (0)
struct XcdBarrier { unsigned* bar; unsigned x; volatile LAS unsigned* st; };
__device__ __forceinline__ XcdBarrier xcd_barrier_post(unsigned* bar, volatile LAS unsigned* st) {
    XcdBarrier b; b.bar = bar; b.x = xb_xcc_id(); b.st = st;
    if (threadIdx.x == 0) (void)xb_add(&bar[XB_XCNT(b.x)], 1u);
    return b;
}
__device__ __forceinline__ void xcd_barrier_complete(unsigned* bar, unsigned x, unsigned& nloc, unsigned& nx) {
    const unsigned G = gridDim.x * gridDim.y * gridDim.z;
    unsigned sum, cnt, mine, sp = 0u;
    for (;;) {
        sum = 0u; cnt = 0u; mine = 0u;
#pragma unroll
        for (unsigned j = 0; j < 16; ++j) { const unsigned c = xb_ld(&bar[XB_XCNT(j)]); sum += c; cnt += (c > 0u) ? 1u : 0u; mine = (j == x) ? c : mine; }
        if (sum == G) break;
        __builtin_amdgcn_s_sleep(1);
        if ((++sp & 255u) == 0u) { if (xb_ld(&bar[XB_TMO])) break; if (sp > XB_SPIN_CAP) { atomicAdd(&bar[XB_TMO], 1u); break; } }
    }
    nloc = mine > 0u ? mine : 1u; nx = cnt > 0u ? cnt : 1u;
}
__device__ __forceinline__ void xcd_barrier(const XcdBarrier& b) {
    asm volatile("s_waitcnt vmcnt(0)" ::: "memory");
    __syncthreads();
    if (threadIdx.x == 0) {
        unsigned* bar = b.bar;
        __builtin_amdgcn_s_waitcnt(0);
        unsigned nloc = b.st[0], nx = b.st[1];
        if (nloc == 0u) { xcd_barrier_complete(bar, b.x, nloc, nx); b.st[0] = nloc; b.st[1] = nx; }
        const unsigned old = xb_add(&bar[XB_XSUB(b.x)], 1u);
        const unsigned gen = old / nloc;
        if (old + 1u == (gen + 1u) * nloc) {
            __builtin_amdgcn_fence(__ATOMIC_RELEASE, "agent");
            asm volatile("s_waitcnt vmcnt(0)" ::: "memory");
            const unsigned og = xb_add(&bar[XB_TOP], 1u);
            const unsigned tg = og / nx;
            if (og + 1u == (tg + 1u) * nx) xb_add(&bar[XB_TOPGEN], 1u);
            else XB_SPIN(xb_ld(&bar[XB_TOPGEN]) == tg, bar);
            __builtin_amdgcn_fence(__ATOMIC_ACQUIRE, "agent");
            xb_add(&bar[XB_XGEN(b.x)], 1u);
            asm volatile("s_waitcnt vmcnt(0)" ::: "memory");
        } else {
            XB_SPIN(xb_ld(&bar[XB_XGEN(b.x)]) == gen, bar);
            __builtin_amdgcn_fence(__ATOMIC_ACQUIRE, "agent");
            asm volatile("s_waitcnt vmcnt(0)" ::: "memory");
        }
    }
    __syncthreads();
}

namespace g8 {
constexpr int BM = 256, BK = 64, HALF = 128, HTB = HALF * BK * 2, STAGE_BYTES = 8 * HTB, NXCD = 8, WGM = 8;
__device__ __forceinline__ int lds_byte(int r, int c) { const int st = (r >> 4) * 2 + (c >> 5), rr = r & 15, cc = c & 31, ob = rr * 64 + cc * 2; return st * 1024 + (ob ^ (((ob >> 9) & 1) << 5)); }
__device__ __forceinline__ void stage_rc(int b, int& R, int& C) { const int st = b / 1024, sb = b % 1024, swz = sb ^ (((sb >> 9) & 1) << 5); R = (st >> 1) * 16 + swz / 64; C = (st & 1) * 32 + (swz % 64) / 2; }
__device__ __forceinline__ int perm32(int rho) { const int n = rho >> 4, i = rho & 15; return 8 * (i >> 2) + 4 * n + (i & 3); }
__device__ __forceinline__ unsigned cvt_pk_bf16(float lo, float hi) { return pk2(lo, hi); }
__device__ __forceinline__ int xcd_remap(int wgid, int nwg) { const int q = nwg / NXCD, r = nwg % NXCD, xcd = wgid % NXCD, off = wgid / NXCD; return (xcd < r ? xcd * (q + 1) : r * (q + 1) + (xcd - r) * q) + off; }

struct Unit { int row0, col0, ex, bt, nvalid, lrow; };

struct DenseSched {
    int nM, nN, nwg, G, c, lat_only; const char* Bt; int K; const int* list;
    __device__ __forceinline__ void init(int nM_, int nN_, int G_, int c_, int lat_only_, const void* Bt_, int K_) { nM = nM_; nN = nN_; nwg = nM * nN; G = G_; c = c_; lat_only = lat_only_; Bt = (const char*)Bt_; K = K_; list = nullptr; }
    __device__ __forceinline__ bool next(int i, Unit& u) const {
        const long Lx = (long)i * G + c; if (Lx >= nwg) return false;
        const int wgid = xcd_remap((int)Lx, nwg);
        const int nig = WGM * nN, gid = wgid / nig, fm = gid * WGM, gsz = (nM - fm) < WGM ? (nM - fm) : WGM;
        const int pm = fm + ((wgid % nig) % gsz), pn = (wgid % nig) / gsz;
        const int tile = lat_only ? (pm / 16) * 17 + 1 + (pm % 16) : pm;
        u.row0 = tile * 256; u.col0 = pn * 256; u.ex = 0; u.bt = pn; u.nvalid = 256; u.lrow = 0; return true;
    }
    __device__ __forceinline__ const char* bptr(const Unit& u) const { return Bt + (size_t)u.bt * (256 * 1024 * 2); }
};
struct MoeSched {
    const LAS int* tpre; const LAS int* cnt; int NT, COLW, G, c, total; const char* Bt; int K; const int* list;
    __device__ __forceinline__ bool next(int i, Unit& u) const {
        const long Lx = (long)i * G + c; if (Lx >= total) return false;
        const int wgid = xcd_remap((int)Lx, total);
        int e = 0;
        for (int j = 1; j < NE; ++j) if (tpre[j] * NT <= wgid) e = j;
        const int t0 = tpre[e], mte = tpre[e + 1] - t0, loc = wgid - t0 * NT, nt = loc / mte, mt = loc % mte;
        u.ex = __builtin_amdgcn_readfirstlane(e); u.row0 = __builtin_amdgcn_readfirstlane((t0 + mt) * 256); u.col0 = __builtin_amdgcn_readfirstlane(nt * COLW);
        u.bt = __builtin_amdgcn_readfirstlane(e * NT + nt); const int nv = cnt[e] - mt * 256; u.nvalid = __builtin_amdgcn_readfirstlane(nv < 256 ? nv : 256); u.lrow = __builtin_amdgcn_readfirstlane(mt * 256);
        return true;
    }
    __device__ __forceinline__ const char* bptr(const Unit& u) const { return Bt + (size_t)u.bt * (256 * 1024 * 2); }
};

struct EpiP {
    static constexpr bool PERM = true; bf16_t* O;
    __device__ __forceinline__ void operator()(const f32x4 (&acc)[2][2][4][2], const Unit& u, int wr, int wc, int fr, int fq, const LAS int*) const {
#pragma unroll
        for (int ai = 0; ai < 2; ++ai)
#pragma unroll
            for (int m = 0; m < 4; ++m) { bf16_t* rowp = O + (size_t)(u.row0 + ai * HALF + wr * 64 + m * 16 + fr) * PP + u.col0 + wc * 32 + 8 * fq;
#pragma unroll
                for (int bj = 0; bj < 2; ++bj) { const f32x4 v0 = acc[ai][bj][m][0], v1 = acc[ai][bj][m][1]; u32x4 w; w.x = cvt_pk_bf16(v0[0], v0[1]); w.y = cvt_pk_bf16(v0[2], v0[3]); w.z = cvt_pk_bf16(v1[0], v1[1]); w.w = cvt_pk_bf16(v1[2], v1[3]);
                    *(u32x4*)(rowp + bj * HALF) = w; } }
    }
};
struct EpiH {
    static constexpr bool PERM = false; float* Hh; const float* MODl; int g_off;
    __device__ __forceinline__ void operator()(const f32x4 (&acc)[2][2][4][2], const Unit& u, int wr, int wc, int fr, int fq, const LAS int*) const {
        const int tile = u.row0 >> 8, v = (tile % 17 == 0) ? 4 : tile / 17; const float* gp = MODl + (size_t)v * 6144 + g_off + u.col0 + wc * 32 + 4 * fq;
        f32x4 gv[2][2];
#pragma unroll
        for (int bj = 0; bj < 2; ++bj)
#pragma unroll
            for (int n = 0; n < 2; ++n) gv[bj][n] = *(const f32x4*)(gp + bj * HALF + n * 16);
#pragma unroll
        for (int ai = 0; ai < 2; ++ai)
#pragma unroll
          for (int mp = 0; mp < 2; ++mp) {
            f32x4 hv[2][2][2];
#pragma unroll
            for (int m2 = 0; m2 < 2; ++m2) { const float* rowp = Hh + (size_t)(u.row0 + ai * HALF + wr * 64 + (2 * mp + m2) * 16 + fr) * D + u.col0 + wc * 32 + 4 * fq;
#pragma unroll
                for (int bj = 0; bj < 2; ++bj)
#pragma unroll
                    for (int n = 0; n < 2; ++n) hv[m2][bj][n] = *(const f32x4*)(rowp + bj * HALF + n * 16); }
#pragma unroll
            for (int m2 = 0; m2 < 2; ++m2) { float* rowp = Hh + (size_t)(u.row0 + ai * HALF + wr * 64 + (2 * mp + m2) * 16 + fr) * D + u.col0 + wc * 32 + 4 * fq;
#pragma unroll
                for (int bj = 0; bj < 2; ++bj)
#pragma unroll
                    for (int n = 0; n < 2; ++n) *(f32x4*)(rowp + bj * HALF + n * 16) = hv[m2][bj][n] + gv[bj][n] * acc[ai][bj][2 * mp + m2][n]; }
          }
    }
};
struct EpiMoe1 {
    static constexpr bool PERM = true; bf16_t* ACTp; const float* bgu;
    __device__ __forceinline__ void operator()(const f32x4 (&acc)[2][2][4][2], const Unit& u, int wr, int wc, int fr, int fq, const LAS int*) const {
        const int cc = u.col0 + wc * 32 + 8 * fq; const float* bp = bgu + (size_t)u.ex * 2048 + cc;
        f32x4 bg[2], bu[2];
#pragma unroll
        for (int n = 0; n < 2; ++n) { bg[n] = *(const f32x4*)(bp + 4 * n); bu[n] = *(const f32x4*)(bp + 1024 + 4 * n); }
#pragma unroll
        for (int ai = 0; ai < 2; ++ai)
#pragma unroll
            for (int m = 0; m < 4; ++m) { const int r = ai * HALF + wr * 64 + m * 16 + fr;
                float o[8];
#pragma unroll
                for (int n = 0; n < 2; ++n)
#pragma unroll
                    for (int i = 0; i < 4; ++i) { const float g = fminf(acc[ai][0][m][n][i] + bg[n][i], 7.f); const float uu = fminf(fmaxf(acc[ai][1][m][n][i] + bu[n][i], -7.f), 7.f);
                        o[n * 4 + i] = (uu + 1.f) * g * __builtin_amdgcn_rcpf(1.f + __expf(-1.702f * g)); }
                { u32x4 w; w.x = cvt_pk_bf16(o[0], o[1]); w.y = cvt_pk_bf16(o[2], o[3]); w.z = cvt_pk_bf16(o[4], o[5]); w.w = cvt_pk_bf16(o[6], o[7]);
                    *(u32x4*)(ACTp + (size_t)(u.row0 + r) * D + cc) = w; } }
    }
};
struct EpiMoe2 {
    static constexpr bool PERM = true; bf16_t* Yp; const float* bd; const float* GATEp;
    __device__ __forceinline__ void operator()(const f32x4 (&acc)[2][2][4][2], const Unit& u, int wr, int wc, int fr, int fq, const LAS int* rows) const {
        const int cc = u.col0 + wc * 32 + 8 * fq; const float* bp = bd + (size_t)u.ex * 1024 + cc;
        f32x4 bv[2][2];
#pragma unroll
        for (int bj = 0; bj < 2; ++bj)
#pragma unroll
            for (int n = 0; n < 2; ++n) bv[bj][n] = *(const f32x4*)(bp + bj * HALF + 4 * n);
        int asgv[2][4]; float gtv[2][4];
#pragma unroll
        for (int ai = 0; ai < 2; ++ai)
#pragma unroll
            for (int m = 0; m < 4; ++m) { const int r = ai * HALF + wr * 64 + m * 16 + fr; const bool ok = r < u.nvalid; const int a = rows[ok ? r : 0]; asgv[ai][m] = ok ? a : NASG; gtv[ai][m] = GATEp[a]; }
#pragma unroll
        for (int ai = 0; ai < 2; ++ai)
#pragma unroll
            for (int m = 0; m < 4; ++m) { const float gt = gtv[ai][m]; bf16_t* rowp = Yp + (size_t)asgv[ai][m] * D + cc;
#pragma unroll
                for (int bj = 0; bj < 2; ++bj) { const f32x4 v0 = (acc[ai][bj][m][0] + bv[bj][0]) * gt, v1 = (acc[ai][bj][m][1] + bv[bj][1]) * gt;
                    u32x4 w; w.x = cvt_pk_bf16(v0[0], v0[1]); w.y = cvt_pk_bf16(v0[2], v0[3]); w.z = cvt_pk_bf16(v1[0], v1[1]); w.w = cvt_pk_bf16(v1[2], v1[3]); *(u32x4*)(rowp + bj * HALF) = w; } }
    }
};

template <class Epi, class Sched, bool GATHER, bool ROWLIST>
__device__ __forceinline__ void gemm_phase(LAS unsigned char* lds, const char* Abase, const Sched& S, const Epi& E) {
    constexpr int K = 1024;
    int tid_l = threadIdx.x; asm volatile("" : "+v"(tid_l));
    const int tid = tid_l, wid = __builtin_amdgcn_readfirstlane(tid >> 6), lane = tid & 63, wr = wid >> 2, wc = wid & 3, fr = lane & 15, fq = lane >> 4;
    constexpr int nt = K / BK; constexpr unsigned Kb = (unsigned)K * 2u;
    unsigned voffB[2];
#pragma unroll
    for (int i = 0; i < 2; ++i) { int R, C; stage_rc(tid * 16 + i * 8192, R, C); const int Rb = Epi::PERM ? ((R & ~31) + perm32(R & 31)) : R; voffB[i] = (unsigned)(Rb * K + C) * 2u; }
    constexpr size_t kstep = (size_t)(BK * 2), hstep = (size_t)HALF * K * 2;
    const unsigned ldsw = (unsigned)wid * 1024u;
    const int aoff = lds_byte(wr * 64 + fr, fq * 8), boff = lds_byte(wc * 32 + fr, fq * 8);
    LAS int* rowbuf = (LAS int*)(lds + STAGE_BYTES);
#define G8_SA(b, h) (((b) * 2 + (h)) * HTB)
#define G8_SB(b, h) ((4 + (b) * 2 + (h)) * HTB)
#define G8_STAGE_A(bufoff, kb, v) do { _Pragma("unroll") for (int _i = 0; _i < 2; ++_i) \
        __builtin_amdgcn_global_load_lds((const unsigned*)((kb) + (size_t)(v)[_i]), (LAS unsigned*)(lds + (bufoff) + ldsw + _i * 8192), 16, 0, 0); } while (0)
#define G8_STAGE_B(bufoff, gbase) do { _Pragma("unroll") for (int _i = 0; _i < 2; ++_i) \
        __builtin_amdgcn_global_load_lds((const unsigned*)((gbase) + voffB[_i]), (LAS unsigned*)(lds + (bufoff) + ldsw + _i * 8192), 16, 0, 0); } while (0)
#define G8_LDA(dst, b, h) do { _Pragma("unroll") for (int m = 0; m < 4; ++m) _Pragma("unroll") for (int k = 0; k < 2; ++k) dst[m][k] = *(const LAS bf16x8*)(lds + G8_SA(b, h) + aoff + m * 2048 + k * 1024); } while (0)
#define G8_LDB(dst, b, h) do { _Pragma("unroll") for (int n = 0; n < 2; ++n) _Pragma("unroll") for (int k = 0; k < 2; ++k) dst[n][k] = *(const LAS bf16x8*)(lds + G8_SB(b, h) + boff + n * 2048 + k * 1024); } while (0)
#define G8_MMA(ai, bj, At, Bt) do { __builtin_amdgcn_s_setprio(1); _Pragma("unroll") for (int m = 0; m < 4; ++m) _Pragma("unroll") for (int n = 0; n < 2; ++n) _Pragma("unroll") for (int k = 0; k < 2; ++k) \
        acc[ai][bj][m][n] = __builtin_amdgcn_mfma_f32_16x16x32_bf16(Bt[n][k], At[m][k], acc[ai][bj][m][n], 0, 0, 0); __builtin_amdgcn_s_setprio(0); } while (0)
#define G8_WAIT_V(n) asm volatile("s_waitcnt vmcnt(" #n ")" ::: "memory")
#define G8_WAIT_L(n) asm volatile("s_waitcnt lgkmcnt(" #n ")" ::: "memory")
#define G8_BAR __builtin_amdgcn_s_barrier()
#define G8_SCHED __builtin_amdgcn_sched_barrier(0)
#define G8_LISTDMA(u, s) do { if (wid < 4) __builtin_amdgcn_global_load_lds((const unsigned*)(S.list + (size_t)(u).ex * LCAP + (u).lrow + wid * 64 + lane), (LAS unsigned*)(rowbuf + (s) * 256 + wid * 64), 4, 0, 0); } while (0)
#define G8_ROWS_DENSE(v) do { _Pragma("unroll") for (int _i = 0; _i < 2; ++_i) { int _R, _C; stage_rc(tid * 16 + _i * 8192, _R, _C); _Pragma("unroll") for (int _h = 0; _h < 2; ++_h) (v)[_h][_i] = (unsigned)(_h * HALF + _R) * Kb + (unsigned)_C * 2u; } } while (0)
#define G8_ROWS_LIST(v, u, s) do { _Pragma("unroll") for (int _i = 0; _i < 2; ++_i) { int _R, _C; stage_rc(tid * 16 + _i * 8192, _R, _C); _Pragma("unroll") for (int _h = 0; _h < 2; ++_h) { const int _r = _h * HALF + _R; const int _a = rowbuf[(s) * 256 + _r]; \
        (v)[_h][_i] = (unsigned)(_r < (u).nvalid ? (_a >> 2) : 0) * Kb + (unsigned)_C * 2u; } } } while (0)
    Unit cur, nxt; int ui = 0, slot = 0;
    if (!S.next(0, cur)) return;
    unsigned vA[2][2];
    if constexpr (ROWLIST) { G8_LISTDMA(cur, 0); G8_WAIT_V(0); G8_BAR; }
    if constexpr (GATHER) { G8_ROWS_LIST(vA, cur, 0); } else { G8_ROWS_DENSE(vA); }
    f32x4 acc[2][2][4][2];
#pragma unroll
    for (int a = 0; a < 2; ++a)
#pragma unroll
        for (int b = 0; b < 2; ++b)
#pragma unroll
            for (int m = 0; m < 4; ++m)
#pragma unroll
                for (int n = 0; n < 2; ++n) acc[a][b][m][n] = (f32x4){0.f, 0.f, 0.f, 0.f};
    bf16x8 At[4][2], B0[2][2], B1[2][2];
    const char* cB = S.bptr(cur);
    const char* cA = GATHER ? Abase : Abase + (size_t)cur.row0 * Kb;
    G8_STAGE_B(G8_SB(0, 0), cB); G8_STAGE_B(G8_SB(0, 1), cB + hstep); G8_STAGE_A(G8_SA(0, 0), cA, vA[0]); G8_STAGE_A(G8_SA(0, 1), cA, vA[1]);
    if (wr == 1) G8_BAR;
    G8_WAIT_V(2); G8_BAR;
    G8_STAGE_B(G8_SB(1, 0), cB + kstep); G8_STAGE_A(G8_SA(1, 0), cA + kstep, vA[0]); G8_STAGE_B(G8_SB(1, 1), cB + hstep + kstep);
    G8_WAIT_V(6); G8_BAR;
    for (;;) {
        const bool has_next = S.next(ui + 1, nxt);
        const char* nB = has_next ? S.bptr(nxt) : cB;
        const char* nA = (GATHER || !has_next) ? cA : Abase + (size_t)nxt.row0 * Kb;
        const int nslot = slot == 2 ? 0 : slot + 1;
        if constexpr (ROWLIST) { if (has_next) G8_LISTDMA(nxt, nslot); }
        for (int t = 0; t < nt; t += 2) {
            const bool last = (t == nt - 2);
            const char* a1 = cA + (size_t)(t + 1) * kstep;
            const char* a2 = last ? nA : cA + (size_t)(t + 2) * kstep; const char* b2 = last ? nB : cB + (size_t)(t + 2) * kstep;
            const char* a3 = a2 + kstep; const char* b3 = b2 + kstep;
            G8_LDB(B0, 0, 0); G8_LDB(B1, 0, 1); G8_SCHED; G8_LDA(At, 0, 0); G8_STAGE_A(G8_SA(1, 1), a1, vA[1]);
            if constexpr (GATHER) { if (last && has_next) { G8_ROWS_LIST(vA, nxt, nslot); } }
            G8_WAIT_V(8); G8_WAIT_L(0); G8_BAR; G8_MMA(0, 0, At, B0); G8_MMA(0, 1, At, B1); G8_BAR; G8_SCHED;
            G8_LDA(At, 0, 1); G8_STAGE_B(G8_SB(0, 0), b2); G8_STAGE_B(G8_SB(0, 1), b2 + hstep); G8_STAGE_A(G8_SA(0, 0), a2, vA[0]);
            G8_WAIT_V(8); G8_WAIT_L(0); G8_BAR; G8_MMA(1, 0, At, B0); G8_MMA(1, 1, At, B1); G8_BAR; G8_SCHED;
            G8_LDB(B0, 1, 0); G8_LDB(B1, 1, 1); G8_SCHED; G8_LDA(At, 1, 0); G8_STAGE_A(G8_SA(0, 1), a2, vA[1]);
            G8_WAIT_V(8); G8_WAIT_L(0); G8_BAR; G8_MMA(0, 0, At, B0); G8_MMA(0, 1, At, B1); G8_BAR; G8_SCHED;
            G8_LDA(At, 1, 1); G8_STAGE_B(G8_SB(1, 0), b3); G8_STAGE_B(G8_SB(1, 1), b3 + hstep); G8_STAGE_A(G8_SA(1, 0), a3, vA[0]);
            G8_WAIT_V(8); G8_WAIT_L(0); G8_BAR; G8_MMA(1, 0, At, B0); G8_MMA(1, 1, At, B1); G8_BAR; G8_SCHED;
        }
        if (wr == 0) G8_BAR;
        { int t2 = threadIdx.x; asm volatile("" : "+v"(t2));
          const int w2 = __builtin_amdgcn_readfirstlane(t2 >> 6); E(acc, cur, w2 >> 2, w2 & 3, t2 & 15, (t2 & 63) >> 4, rowbuf + slot * 256); }
        if (!has_next) break;
#pragma unroll
        for (int a = 0; a < 2; ++a)
#pragma unroll
            for (int b = 0; b < 2; ++b)
#pragma unroll
                for (int m = 0; m < 4; ++m)
#pragma unroll
                    for (int n = 0; n < 2; ++n) acc[a][b][m][n] = (f32x4){0.f, 0.f, 0.f, 0.f};
        cur = nxt; cB = nB; cA = nA; ++ui; slot = nslot;
        if (wr == 1) G8_BAR;
    }
    G8_WAIT_V(0);
    G8_BAR;
#undef G8_SA
#undef G8_SB
#undef G8_STAGE_A
#undef G8_STAGE_B
#undef G8_LDA
#undef G8_LDB
#undef G8_MMA
#undef G8_WAIT_V
#undef G8_WAIT_L
#undef G8_BAR
#undef G8_SCHED
#undef G8_LISTDMA
#undef G8_ROWS_DENSE
#undef G8_ROWS_LIST
}
}

namespace fft {
constexpr int TP = 72;
constexpr int UP = 264;
constexpr int ZP = 520;
constexpr int O_TC = 0, O_TS = 9216, O_U = 18432, O_X = 52224, O_TW = 125952;
__device__ __forceinline__ bf16x8 neg8(bf16x8 v) { u32x4 w = __builtin_bit_cast(u32x4, v); w = w ^ 0x80008000u; return __builtin_bit_cast(bf16x8, w); }
__device__ __forceinline__ void build_tables(LAS unsigned char* lds, const float* TABC, const float* TABS, int tid) {
    for (int i = tid; i < 4096; i += 512) { const int a = i >> 6, b = i & 63, ix = ((a * b) & 63) * 64;
        ((LAS bf16_t*)(lds + O_TC))[a * TP + b] = f2bf(TABC[ix]); ((LAS bf16_t*)(lds + O_TS))[a * TP + b] = f2bf(TABS[ix]); }
}
__device__ __forceinline__ void stage_a(LAS unsigned char* lds, const bf16_t* P, const float* TABC, const float* TABS, bf16_t* ZBUF, int u0, int u1, int ustep) {
    int tid_l = threadIdx.x; asm volatile("" : "+v"(tid_l));
    const int tid = tid_l, lane = tid & 63, w = __builtin_amdgcn_readfirstlane(tid >> 6), fr = lane & 15, fq = lane >> 4;
    build_tables(lds, TABC, TABS, tid);
    const LAS bf16_t* Tc = (const LAS bf16_t*)(lds + O_TC); const LAS bf16_t* Ts = (const LAS bf16_t*)(lds + O_TS);
    LAS bf16_t* U = (LAS bf16_t*)(lds + O_U); LAS bf16_t* X = (LAS bf16_t*)(lds + O_X); LAS float* TW = (LAS float*)(lds + O_TW);
    for (int unit = u0; unit < u1; unit += ustep) {
        const int b = unit >> 6, t2 = unit & 63;
#pragma unroll
        for (int i = 0; i < 4; ++i) { const int q = tid + 512 * i, t1 = q >> 5, ch = q & 31;
            *(LAS u32x4*)((LAS unsigned char*)U + t1 * (UP * 2) + ch * 16) = *(const u32x4*)(P + ((size_t)b * NPOS + CTX + 64 * t1 + t2) * PP + ch * 8); }
        if (tid < 64) { const int ix = tid * t2; TW[2 * tid] = TABC[ix]; TW[2 * tid + 1] = TABS[ix]; }
        __syncthreads();
        { const int g = w >> 1, part = w & 1; const LAS bf16_t* T = part ? Ts : Tc;
          f32x4 acc[4][4];
#pragma unroll
          for (int mt = 0; mt < 4; ++mt)
#pragma unroll
              for (int nt = 0; nt < 4; ++nt) acc[mt][nt] = (f32x4){0.f, 0.f, 0.f, 0.f};
#pragma unroll
          for (int ks = 0; ks < 2; ++ks) { bf16x8 a[4], bb[4];
#pragma unroll
              for (int mt = 0; mt < 4; ++mt) a[mt] = *(const LAS bf16x8*)(U + (16 * mt + fr) * UP + g * 64 + 32 * ks + 8 * fq);
#pragma unroll
              for (int nt = 0; nt < 4; ++nt) bb[nt] = *(const LAS bf16x8*)(T + (16 * nt + fr) * TP + 32 * ks + 8 * fq);
#pragma unroll
              for (int mt = 0; mt < 4; ++mt)
#pragma unroll
                  for (int nt = 0; nt < 4; ++nt) acc[mt][nt] = __builtin_amdgcn_mfma_f32_16x16x32_bf16(a[mt], bb[nt], acc[mt][nt], 0, 0, 0); }
          const float sg = part ? -1.f : 1.f;
#pragma unroll
          for (int mt = 0; mt < 4; ++mt)
#pragma unroll
              for (int nt = 0; nt < 4; ++nt) { const f32x4 v = acc[mt][nt] * sg; u32x2 o; o.x = pk2(v[0], v[1]); o.y = pk2(v[2], v[3]);
                  *(LAS u32x2*)(X + (part * 256 + g * 64 + 16 * nt + fr) * TP + 16 * mt + 4 * fq) = o; } }
        __syncthreads();
        f32x4 zr[4][2], zi[4][2];
#pragma unroll
        for (int mt = 0; mt < 4; ++mt)
#pragma unroll
            for (int n = 0; n < 2; ++n) { zr[mt][n] = (f32x4){0.f, 0.f, 0.f, 0.f}; zi[mt][n] = (f32x4){0.f, 0.f, 0.f, 0.f}; }
#pragma unroll
        for (int ks = 0; ks < 2; ++ks) { bf16x8 xr[2], xi[2];
#pragma unroll
            for (int n = 0; n < 2; ++n) { xr[n] = *(const LAS bf16x8*)(X + (32 * w + 16 * n + fr) * TP + 32 * ks + 8 * fq); xi[n] = *(const LAS bf16x8*)(X + (256 + 32 * w + 16 * n + fr) * TP + 32 * ks + 8 * fq); }
#pragma unroll
            for (int mt = 0; mt < 4; ++mt) { const bf16x8 c = *(const LAS bf16x8*)(Tc + (16 * mt + fr) * TP + 32 * ks + 8 * fq), s = *(const LAS bf16x8*)(Ts + (16 * mt + fr) * TP + 32 * ks + 8 * fq), ns = neg8(s);
#pragma unroll
                for (int n = 0; n < 2; ++n) { zr[mt][n] = __builtin_amdgcn_mfma_f32_16x16x32_bf16(c, xr[n], zr[mt][n], 0, 0, 0); zr[mt][n] = __builtin_amdgcn_mfma_f32_16x16x32_bf16(s, xi[n], zr[mt][n], 0, 0, 0);
                    zi[mt][n] = __builtin_amdgcn_mfma_f32_16x16x32_bf16(c, xi[n], zi[mt][n], 0, 0, 0); zi[mt][n] = __builtin_amdgcn_mfma_f32_16x16x32_bf16(ns, xr[n], zi[mt][n], 0, 0, 0); } } }
        __syncthreads();
        { LAS bf16_t* Zs = X;
#pragma unroll
          for (int mt = 0; mt < 4; ++mt)
#pragma unroll
              for (int i = 0; i < 4; ++i) { const int f1 = 16 * mt + 4 * fq + i; const float ct = TW[2 * f1], st = TW[2 * f1 + 1];
#pragma unroll
                  for (int n = 0; n < 2; ++n) { const float a = zr[mt][n][i], bq = zi[mt][n][i]; const int col = 32 * w + 16 * n + fr;
                      Zs[f1 * ZP + col] = f2bf(a * ct + bq * st); Zs[f1 * ZP + 256 + col] = f2bf(bq * ct - a * st); } } }
        __syncthreads();
#pragma unroll
        for (int i = 0; i < 8; ++i) { const int q = tid + 512 * i, f1 = q >> 6, ch = q & 63;
            *(u32x4*)(ZBUF + (((size_t)b * 64 + f1) * 64 + t2) * 512 + ch * 8) = *(const LAS u32x4*)((const LAS unsigned char*)X + f1 * (ZP * 2) + ch * 16); }
        __syncthreads();
    }
}
__device__ __forceinline__ void stage_b(LAS unsigned char* lds, const bf16_t* ZBUF, const float* TABC, const float* TABS, bf16_t* MIX, int G, int bx) {
    int tid_l = threadIdx.x; asm volatile("" : "+v"(tid_l));
    const int tid = tid_l, lane = tid & 63, w = __builtin_amdgcn_readfirstlane(tid >> 6), fr = lane & 15, fq = lane >> 4;
    build_tables(lds, TABC, TABS, tid);
    const LAS bf16_t* Tc = (const LAS bf16_t*)(lds + O_TC); const LAS bf16_t* Ts = (const LAS bf16_t*)(lds + O_TS);
    LAS bf16_t* Ys = (LAS bf16_t*)(lds + O_U); LAS bf16_t* ZT = (LAS bf16_t*)(lds + O_X);
    for (int unit = bx; unit < 256; unit += G) {
        const int b = unit >> 6, f1 = unit & 63;
        const bf16_t* Zg = ZBUF + ((size_t)b * 64 + f1) * 64 * 512;
#pragma unroll
        for (int i = 0; i < 4; ++i) { const int q = tid + 512 * i, p = q & 31, ch = q >> 5;
            const u32x4 r0 = *(const u32x4*)(Zg + (size_t)(2 * p) * 512 + ch * 8), r1 = *(const u32x4*)(Zg + (size_t)(2 * p + 1) * 512 + ch * 8);
#pragma unroll
            for (int j = 0; j < 4; ++j) { const unsigned a = r0[j], c = r1[j];
                *(LAS unsigned*)(ZT + (ch * 8 + 2 * j) * TP + 2 * p) = (a & 0xffffu) | (c << 16);
                *(LAS unsigned*)(ZT + (ch * 8 + 2 * j + 1) * TP + 2 * p) = (a >> 16) | (c & 0xffff0000u); } }
        __syncthreads();
        f32x4 y[4][2];
#pragma unroll
        for (int mt = 0; mt < 4; ++mt)
#pragma unroll
            for (int n = 0; n < 2; ++n) y[mt][n] = (f32x4){0.f, 0.f, 0.f, 0.f};
#pragma unroll
        for (int ks = 0; ks < 2; ++ks) { bf16x8 xr[2], xi[2];
#pragma unroll
            for (int n = 0; n < 2; ++n) { xr[n] = *(const LAS bf16x8*)(ZT + (32 * w + 16 * n + fr) * TP + 32 * ks + 8 * fq); xi[n] = *(const LAS bf16x8*)(ZT + (256 + 32 * w + 16 * n + fr) * TP + 32 * ks + 8 * fq); }
#pragma unroll
            for (int mt = 0; mt < 4; ++mt) { const bf16x8 c = *(const LAS bf16x8*)(Tc + (16 * mt + fr) * TP + 32 * ks + 8 * fq), s = *(const LAS bf16x8*)(Ts + (16 * mt + fr) * TP + 32 * ks + 8 * fq);
#pragma unroll
                for (int n = 0; n < 2; ++n) { y[mt][n] = __builtin_amdgcn_mfma_f32_16x16x32_bf16(c, xr[n], y[mt][n], 0, 0, 0); y[mt][n] = __builtin_amdgcn_mfma_f32_16x16x32_bf16(s, xi[n], y[mt][n], 0, 0, 0); } } }
#pragma unroll
        for (int mt = 0; mt < 4; ++mt)
#pragma unroll
            for (int i = 0; i < 4; ++i)
#pragma unroll
                for (int n = 0; n < 2; ++n) Ys[(16 * mt + 4 * fq + i) * UP + 32 * w + 16 * n + fr] = f2bf(y[mt][n][i] * (1.f / 512.f));
        __syncthreads();
#pragma unroll
        for (int i = 0; i < 4; ++i) { const int q = tid + 512 * i, f2 = q >> 5, ch = q & 31;
            *(u32x4*)(MIX + ((size_t)b * NPOS + CTX + f1 + 64 * f2) * D + ch * 8) = *(const LAS u32x4*)((const LAS unsigned char*)Ys + f2 * (UP * 2) + ch * 16); }
        __syncthreads();
    }
}
}

namespace cv {
constexpr int SCR_BYTES = 64 * 33 * 4;
struct Job { const float* wgu; const float* wdn; unsigned char* ws; int n0, first0, first1, nv; };
struct Dec { const float* W; bf16_t* WT; int N, drow0, k0, n0; };
__device__ __forceinline__ Dec decode(const Job& J, int v) {
    const int l = v < J.n0 ? 0 : 1, j = v < J.n0 ? J.first0 + v : J.first1 + (v - J.n0); Dec d;
    if (j < NE * 16 * 64) { const int e = j / (16 * 64), q = j % (16 * 64), kb = q / 64, nb = q % 64; const int n0 = 32 * nb; const int c2 = n0 & 1023;
        d.W = J.wgu + ((size_t)l * NE + e) * D * 2048; d.N = 2048; d.WT = (bf16_t*)(J.ws + L::WGUT) + ((size_t)l * NE + e) * 2048 * D; d.drow0 = (c2 >> 7) * 256 + (n0 >> 10) * 128 + (c2 & 127); d.k0 = 64 * kb; d.n0 = n0; }
    else { const int r = j - NE * 16 * 64; const int e = r / (16 * 32), q = r % (16 * 32), kb = q / 32, nb = q % 32;
        d.W = J.wdn + ((size_t)l * NE + e) * D * D; d.N = D; d.WT = (bf16_t*)(J.ws + L::WDT) + ((size_t)l * NE + e) * D * D; d.drow0 = 32 * nb; d.k0 = 64 * kb; d.n0 = 32 * nb; }
    return d;
}
__device__ __forceinline__ void issue_half(const Dec& d, int h, int lane, f32x4 (&v)[4]) {
    const int kr = lane >> 3, nc = (lane & 7) * 4; const float* gp = d.W + (size_t)(d.k0 + 32 * h + kr) * d.N + d.n0 + nc;
#pragma unroll
    for (int i = 0; i < 4; ++i) v[i] = __builtin_nontemporal_load((const f32x4*)(gp + (size_t)(8 * i) * d.N));
}
__device__ __forceinline__ void park_half(LAS float* scr, int h, int lane, const f32x4 (&v)[4]) {
    const int kr = lane >> 3, nc = (lane & 7) * 4;
#pragma unroll
    for (int i = 0; i < 4; ++i) { LAS float* p = scr + (32 * h + kr + 8 * i) * 33 + nc; p[0] = v[i][0]; p[1] = v[i][1]; p[2] = v[i][2]; p[3] = v[i][3]; }
}
__device__ __forceinline__ void finish(const Dec& d, const LAS float* scr, int lane) {
    asm volatile("s_waitcnt lgkmcnt(0)" ::: "memory");
    const int c = lane & 7;
#pragma unroll
    for (int j = 0; j < 4; ++j) { const int n = (lane >> 3) + 8 * j; const LAS float* s = scr + (8 * c) * 33 + n;
        u32x4 o; o.x = pk2(s[0 * 33], s[1 * 33]); o.y = pk2(s[2 * 33], s[3 * 33]); o.z = pk2(s[4 * 33], s[5 * 33]); o.w = pk2(s[6 * 33], s[7 * 33]);
        *(u32x4*)(d.WT + (size_t)(d.drow0 + n) * D + d.k0 + 8 * c) = o; }
    asm volatile("s_waitcnt lgkmcnt(0)" ::: "memory");
}
}

namespace attn {
typedef float f32x16 __attribute__((ext_vector_type(16)));
typedef float f32x2_t __attribute__((ext_vector_type(2))); typedef __bf16 bf16x2_t __attribute__((ext_vector_type(2)));
__device__ __forceinline__ unsigned cvtpk(float lo, float hi) { f32x2_t v = {lo, hi}; bf16x2_t b = __builtin_convertvector(v, bf16x2_t); return __builtin_bit_cast(unsigned, b); }
constexpr int KP = 104, VP = 68;
constexpr int KT_BYTES = 64 * KP * 2, VT_BYTES = 64 * VP * 2, BUF_BYTES = KT_BYTES + VT_BYTES;
constexpr float THR = 8.f; constexpr int NWAVES_ATT = 8;
__device__ __forceinline__ void attn_phase(LAS unsigned char* lds, const bf16_t* QL, const bf16_t* QC, const bf16_t* KB, const bf16_t* VTG, bf16_t* MIX, int with_ctx, int G, int vcu, const cv::Job& J, bool cv_on) {
    const int nunits = 256 + (with_ctx ? 16 : 0);
    for (int unit = vcu; unit < nunits; unit += G) {
        int tid_l = threadIdx.x; asm volatile("" : "+v"(tid_l));
        const int tid = tid_l, lane = tid & 63, wid = __builtin_amdgcn_readfirstlane(tid >> 6), r32 = lane & 31, hi = lane >> 5;
        int bh, nk, orow0; const bf16_t* Qp;
        if (unit < 256) { bh = unit >> 4; const int qb = unit & 15; Qp = QL + ((size_t)bh * SEQ + qb * 256) * 96; nk = NPOS; orow0 = (bh >> 2) * NPOS + CTX + qb * 256; }
        else { bh = unit - 256; Qp = QC + (size_t)bh * CTX * 96; nk = CTX; orow0 = (bh >> 2) * NPOS; }
        const int hh = bh & 3, NT = nk / 64;
        const bf16_t* Kg = KB + (size_t)bh * NPOS * 96; const bf16_t* Vg = VTG + (size_t)bh * 64 * NPOS;
        bf16x8 qf[6];
        { const bf16_t* qp = Qp + (size_t)(wid * 32 + r32) * 96 + 8 * hi;
#pragma unroll
          for (int ds = 0; ds < 6; ++ds) qf[ds] = *(const bf16x8*)(qp + 16 * ds); }
        f32x16 o0 = {}, o1 = {}, negm = {}; float mhat = 0.f, l = 0.f;
        const int kr0 = tid / 12, kc0 = tid % 12, kr1 = (tid + 512) / 12, kc1 = (tid + 512) % 12; const bool k1ok = tid < 256;
        const int vd = tid >> 3, vc = tid & 7;
        u32x4 sk0, sk1 = {}, sv;
#define AT_LOAD(t_) do { const size_t k0_ = (size_t)(t_) * 64; sk0 = *(const u32x4*)(Kg + (k0_ + kr0) * 96 + kc0 * 8); if (k1ok) sk1 = *(const u32x4*)(Kg + (k0_ + kr1) * 96 + kc1 * 8); sv = *(const u32x4*)(Vg + (size_t)vd * NPOS + k0_ + vc * 8); } while (0)
#define AT_STORE(slot_) do { LAS unsigned char* bp_ = lds + (slot_) * BUF_BYTES; *(LAS u32x4*)(bp_ + kr0 * (KP * 2) + kc0 * 16) = sk0; if (k1ok) *(LAS u32x4*)(bp_ + kr1 * (KP * 2) + kc1 * 16) = sk1; *(LAS u32x4*)(bp_ + KT_BYTES + vd * (VP * 2) + vc * 16) = sv; } while (0)
#define AT_QK(P0, P1, slot_) do { const LAS bf16_t* Kt_ = (const LAS bf16_t*)(lds + (slot_) * BUF_BYTES); \
        _Pragma("unroll") for (int ds = 0; ds < 6; ++ds) { const bf16x8 k0f = *(const LAS bf16x8*)(Kt_ + r32 * KP + 16 * ds + 8 * hi), k1f = *(const LAS bf16x8*)(Kt_ + (32 + r32) * KP + 16 * ds + 8 * hi); \
            if (ds == 0) { P0 = __builtin_amdgcn_mfma_f32_32x32x16_bf16(k0f, qf[0], negm, 0, 0, 0); P1 = __builtin_amdgcn_mfma_f32_32x32x16_bf16(k1f, qf[0], negm, 0, 0, 0); } \
            else { P0 = __builtin_amdgcn_mfma_f32_32x32x16_bf16(k0f, qf[ds], P0, 0, 0, 0); P1 = __builtin_amdgcn_mfma_f32_32x32x16_bf16(k1f, qf[ds], P1, 0, 0, 0); } } } while (0)
#define MX3(a_, b_, c_) __builtin_fmaxf(__builtin_fmaxf((a_), (b_)), (c_))
#define AT_STEP(C0, C1, N0, N1, t_) do { \
            if ((t_) + 1 < NT) AT_QK(N0, N1, s_nxt); \
            float mx_ = MX3(C0[0], C0[1], C1[0]), my_ = MX3(C0[2], C0[3], C1[1]); mx_ = MX3(mx_, C1[2], C1[3]); \
            _Pragma("unroll") for (int r = 4; r < 16; r += 4) { mx_ = MX3(mx_, C0[r], C0[r + 1]); my_ = MX3(my_, C0[r + 2], C0[r + 3]); mx_ = MX3(mx_, C1[r], C1[r + 1]); my_ = MX3(my_, C1[r + 2], C1[r + 3]); } \
            mx_ = fmaxf(mx_, my_); mx_ = fmaxf(mx_, __shfl_xor(mx_, 32)); \
            if (__builtin_expect((t_) == 0 || __any(mx_ > THR), 0)) { const float dl = (t_) == 0 ? mx_ : fmaxf(mx_, 0.f), f = __builtin_amdgcn_exp2f(-dl); mhat += dl; l *= f; \
                _Pragma("unroll") for (int r = 0; r < 16; ++r) { C0[r] -= dl; C1[r] -= dl; o0[r] *= f; o1[r] *= f; negm[r] = -mhat; } \
                if ((t_) + 1 < NT) { _Pragma("unroll") for (int r = 0; r < 16; ++r) { N0[r] -= dl; N1[r] -= dl; } } } \
            float ls_ = 0.f; \
            _Pragma("unroll") for (int r = 0; r < 16; ++r) { C0[r] = __builtin_amdgcn_exp2f(C0[r]); C1[r] = __builtin_amdgcn_exp2f(C1[r]); ls_ += C0[r] + C1[r]; } \
            l += ls_; \
            const LAS bf16_t* Vt_ = (const LAS bf16_t*)(lds + s_cur * BUF_BYTES + KT_BYTES); \
            _Pragma("unroll") for (int q = 0; q < 4; ++q) { u32x4 pw_; \
                _Pragma("unroll") for (int j = 0; j < 4; ++j) { const int r = 8 * (q & 1) + 2 * j; pw_[j] = (q < 2) ? cvtpk(C0[r], C0[r + 1]) : cvtpk(C1[r], C1[r + 1]); } \
                const bf16x8 pf_ = __builtin_bit_cast(bf16x8, pw_); const int kvb = 32 * (q >> 1) + 16 * (q & 1) + 4 * hi; \
                _Pragma("unroll") for (int db = 0; db < 2; ++db) { const u32x2 va = *(const LAS u32x2*)(Vt_ + (32 * db + r32) * VP + kvb), vb = *(const LAS u32x2*)(Vt_ + (32 * db + r32) * VP + kvb + 8); \
                    const u32x4 vw = {va.x, va.y, vb.x, vb.y}; const bf16x8 vf = __builtin_bit_cast(bf16x8, vw); \
                    if (db == 0) o0 = __builtin_amdgcn_mfma_f32_32x32x16_bf16(vf, pf_, o0, 0, 0, 0); else o1 = __builtin_amdgcn_mfma_f32_32x32x16_bf16(vf, pf_, o1, 0, 0, 0); } } \
            if ((t_) + 2 < NT) AT_STORE(s_ld); \
            __syncthreads(); \
            { const int tmp_ = s_cur; s_cur = s_nxt; s_nxt = s_ld; s_ld = tmp_; } } while (0)
        AT_LOAD(0); AT_STORE(0);
        if (NT > 1) { AT_LOAD(1); AT_STORE(1); }
        __syncthreads();
        f32x16 pA0, pA1, pB0, pB1;
        AT_QK(pA0, pA1, 0);
        int s_cur = 0, s_nxt = 1, s_ld = 2;
        int cvv = (cv_on && unit < 256) ? vcu * NWAVES_ATT + wid : J.nv;
        int cvh = 0; bool cv_pend = false;
        f32x4 cvr[4];
#pragma unroll
        for (int i = 0; i < 4; ++i) cvr[i] = (f32x4){0.f, 0.f, 0.f, 0.f};
        LAS float* cscr = (LAS float*)(lds + 3 * BUF_BYTES + wid * cv::SCR_BYTES);
        for (int t = 0; t < NT; t += 2) {
            if (cv_pend) { cv::park_half(cscr, cvh, lane, cvr); if (cvh) { cv::finish(cv::decode(J, cvv), cscr, lane); cvv += 256 * NWAVES_ATT; } cvh ^= 1; }
            if (t + 2 < NT) AT_LOAD(t + 2);
            cv_pend = cvv < J.nv && (cvh == 1 || t + 2 < NT);
            cv::issue_half(cv::decode(J, cv_pend ? cvv : 0), cvh, lane, cvr);
            AT_STEP(pA0, pA1, pB0, pB1, t);
            if (t + 3 < NT) AT_LOAD(t + 3);
            AT_STEP(pB0, pB1, pA0, pA1, t + 1);
        }
        if (cv_pend) { cv::park_half(cscr, cvh, lane, cvr); if (cvh) cv::finish(cv::decode(J, cvv), cscr, lane); }
#undef AT_LOAD
#undef AT_STORE
#undef AT_QK
#undef AT_STEP
#undef MX3
        l += __shfl_xor(l, 32);
        const float il = 1.f / l;
        bf16_t* op = MIX + (size_t)(orow0 + wid * 32 + r32) * D + 512 + hh * 64 + 4 * hi;
#pragma unroll
        for (int g4 = 0; g4 < 4; ++g4) { u32x2 w0, w1; w0.x = cvtpk(o0[4 * g4] * il, o0[4 * g4 + 1] * il); w0.y = cvtpk(o0[4 * g4 + 2] * il, o0[4 * g4 + 3] * il);
            w1.x = cvtpk(o1[4 * g4] * il, o1[4 * g4 + 1] * il); w1.y = cvtpk(o1[4 * g4 + 2] * il, o1[4 * g4 + 3] * il);
            *(u32x2*)(op + 8 * g4) = w0; *(u32x2*)(op + 32 + 8 * g4) = w1; }
    }
}
}

namespace sm {
__device__ __forceinline__ float silu(float x) { return x / (1.f + __expf(-x)); }
__device__ __forceinline__ void mod_phase(LAS unsigned char* lds, const float* c, const float* c_ctx, const float* mod_w, const float* mod_b, float* MOD, int G, int bx, int tid) {
    LAS float* s = (LAS float*)lds;
    for (int i = tid; i < 5120; i += 512) { const int v = i >> 10, k = i & 1023; s[i] = silu(v < 4 ? c[v * 1024 + k] : c_ctx[k]); }
    __syncthreads();
    LAS float* red = s + 5120;
    for (int unit = bx; unit < 96; unit += G) {
        const int l = unit / 48, cb = unit % 48, cl = tid & 127, col = cb * 128 + cl, kq = tid >> 7, k0 = kq * 256;
        const float* W = mod_w + ((size_t)l * 1024 + k0) * 6144 + col;
        float a0 = 0.f, a1 = 0.f, a2 = 0.f, a3 = 0.f, a4 = 0.f;
#pragma unroll 16
        for (int k = 0; k < 256; ++k) { const float w = W[(size_t)k * 6144]; a0 += s[k0 + k] * w; a1 += s[1024 + k0 + k] * w; a2 += s[2048 + k0 + k] * w; a3 += s[3072 + k0 + k] * w; a4 += s[4096 + k0 + k] * w; }
        LAS float* rq = red + kq * 640 + cl; rq[0] = a0; rq[128] = a1; rq[256] = a2; rq[384] = a3; rq[512] = a4;
        __syncthreads();
        for (int i = tid; i < 640; i += 512) { const int v = i >> 7, cc = i & 127; const float r = ((red[i] + red[640 + i]) + (red[1280 + i] + red[1920 + i])) + mod_b[l * 6144 + cb * 128 + cc];
            MOD[((size_t)l * 5 + v) * 6144 + cb * 128 + cc] = r; }
        __syncthreads();
    }
}
__device__ __forceinline__ void norm_store(const float4 (&x)[4], float ss, const float* g, const float* mv, int sh_off, int sc_off, bf16_t* xn_row, int lane) {
    const float rs = rsqrtf(wave_sum(ss) * (1.f / D) + 1e-6f);
#pragma unroll
    for (int j = 0; j < 4; ++j) { const int c = (j * 64 + lane) * 4; const float4 gg = *(const float4*)(g + c), sh = *(const float4*)(mv + sh_off + c), sc = *(const float4*)(mv + sc_off + c);
        u32x2 o; o.x = pk2(x[j].x * rs * gg.x * (1.f + sc.x) + sh.x, x[j].y * rs * gg.y * (1.f + sc.y) + sh.y); o.y = pk2(x[j].z * rs * gg.z * (1.f + sc.z) + sh.z, x[j].w * rs * gg.w * (1.f + sc.w) + sh.w);
        *(u32x2*)(xn_row + c) = o; }
}
__device__ __forceinline__ void pro1_phase(const float* x, const float* ctx, const float* g, const float* MODl, float* H, bf16_t* XN, int r_first, int r_end, int r_step, int lane) {
    for (int r = r_first; r < r_end; r += r_step) { const int b = r / NPOS, pos = r % NPOS, v = pos < CTX ? 4 : b;
        const float* src = pos < CTX ? ctx + ((size_t)b * CTX + pos) * D : x + ((size_t)b * SEQ + (pos - CTX)) * D;
        float4 xv[4]; float ss = 0.f;
#pragma unroll
        for (int j = 0; j < 4; ++j) { const int c = (j * 64 + lane) * 4; xv[j] = *(const float4*)(src + c); ss += xv[j].x * xv[j].x + xv[j].y * xv[j].y + xv[j].z * xv[j].z + xv[j].w * xv[j].w; }
#pragma unroll
        for (int j = 0; j < 4; ++j) *(float4*)(H + (size_t)r * D + (j * 64 + lane) * 4) = xv[j];
        norm_store(xv, ss, g, MODl + (size_t)v * 6144, 0, 1024, XN + (size_t)r * D, lane); }
}
__device__ __forceinline__ void comb_phase(int l, float* H, const bf16_t* Y, const float* MODl, const float* g_next, const float* MODn, bf16_t* XN, const float* final_g, float* out, int gw, int NGW, int lane) {
    for (int r = gw; r < MROWS; r += NGW) { const int b = r / NPOS, pos = r % NPOS, v = pos < CTX ? 4 : b;
        if (l == 1 && pos < CTX) continue;
        const float* g2 = MODl + (size_t)v * 6144 + 5120;
        float4 xv[4]; float ss = 0.f;
#pragma unroll
        for (int j = 0; j < 4; ++j) { const int c = (j * 64 + lane) * 4; xv[j] = *(const float4*)(H + (size_t)r * D + c); float4 s = make_float4(0.f, 0.f, 0.f, 0.f);
#pragma unroll
            for (int k = 0; k < 4; ++k) { const u32x2 y = *(const u32x2*)(Y + ((size_t)r * 4 + k) * D + c); s.x += __uint_as_float(y.x << 16); s.y += __uint_as_float(y.x & 0xffff0000u); s.z += __uint_as_float(y.y << 16); s.w += __uint_as_float(y.y & 0xffff0000u); }
            const float4 gg = *(const float4*)(g2 + c); xv[j].x += gg.x * s.x; xv[j].y += gg.y * s.y; xv[j].z += gg.z * s.z; xv[j].w += gg.w * s.w;
            ss += xv[j].x * xv[j].x + xv[j].y * xv[j].y + xv[j].z * xv[j].z + xv[j].w * xv[j].w; }
        if (l == 0) {
#pragma unroll
            for (int j = 0; j < 4; ++j) *(float4*)(H + (size_t)r * D + (j * 64 + lane) * 4) = xv[j];
            norm_store(xv, ss, g_next, MODn + (size_t)v * 6144, 0, 1024, XN + (size_t)r * D, lane);
        } else { const float rs = rsqrtf(wave_sum(ss) * (1.f / D) + 1e-6f); float* op = out + ((size_t)b * SEQ + (pos - CTX)) * D;
#pragma unroll
            for (int j = 0; j < 4; ++j) { const int c = (j * 64 + lane) * 4; const float4 fg = *(const float4*)(final_g + c); float4 o; o.x = xv[j].x * rs * fg.x; o.y = xv[j].y * rs * fg.y; o.z = xv[j].z * rs * fg.z; o.w = xv[j].w * rs * fg.w; *(float4*)(op + c) = o; } }
    }
}
__device__ __forceinline__ void route_phase(LAS unsigned char* lds, int l, const float* H, const float* g, const float* MODl, const bf16_t* RWH, const bf16_t* RWL, const float* rb, bf16_t* XN, int* CNT, int* LIST, float* GATE,
                                            int G, int bx, int tid) {
    const int lane = tid & 63, wave = __builtin_amdgcn_readfirstlane(tid >> 6), fr = lane & 15, fq = lane >> 4;
    constexpr int FP = 1032;
    LAS bf16_t* FH = (LAS bf16_t*)lds; LAS bf16_t* FL = FH + 16 * FP;
    LAS float* PART = (LAS float*)(lds + 66048);
    LAS int* LCNT = (LAS int*)(lds + 66048 + 16384);
    LAS int* LBASE = LCNT + 64; LAS int* LENT = LCNT + 128;
    if (tid < 64) LCNT[tid] = 0;
    bf16x8 wh[2][4], wl[2][4];
#pragma unroll
    for (int nt = 0; nt < 2; ++nt)
#pragma unroll
        for (int ks = 0; ks < 4; ++ks) { const size_t o = ((size_t)l * NE + 16 * nt + fr) * D + 128 * wave + 32 * ks + 8 * fq; wh[nt][ks] = *(const bf16x8*)(RWH + o); wl[nt][ks] = *(const bf16x8*)(RWL + o); }
    const float bias = rb[lane & 31];
    __syncthreads();
    const int nb = l == 1 ? (MROWS - NB_ * CTX) / 16 : MROWS / 16;
    LAS float* LG = (LAS float*)(lds + 90112);
    LAS float* TOP = (LAS float*)(lds + 92160);
    float4 xv[2][4];
#define RT_ROW(q_) ((l == 1) ? ((q_) / SEQ) * NPOS + CTX + ((q_) % SEQ) : (q_))
#define RT_LOAD(bi_) do { _Pragma("unroll") for (int rr = 0; rr < 2; ++rr) { const int r_ = RT_ROW((bi_) * 16 + 2 * wave + rr); _Pragma("unroll") for (int j = 0; j < 4; ++j) xv[rr][j] = *(const float4*)(H + (size_t)r_ * D + (j * 64 + lane) * 4); } } while (0)
    if (bx < nb) RT_LOAD(bx);
    for (int bi = bx; bi < nb; bi += G) {
#pragma unroll
        for (int rr = 0; rr < 2; ++rr) { const int r = RT_ROW(bi * 16 + 2 * wave + rr);
            const int b = r / NPOS, pos = r % NPOS, v = pos < CTX ? 4 : b; const float* mv = MODl + (size_t)v * 6144;
            float ss = 0.f;
#pragma unroll
            for (int j = 0; j < 4; ++j) ss += xv[rr][j].x * xv[rr][j].x + xv[rr][j].y * xv[rr][j].y + xv[rr][j].z * xv[rr][j].z + xv[rr][j].w * xv[rr][j].w;
            const float rs = rsqrtf(wave_sum(ss) * (1.f / D) + 1e-6f);
#pragma unroll
            for (int j = 0; j < 4; ++j) { const int c = (j * 64 + lane) * 4; const float4 gg = *(const float4*)(g + c), sh = *(const float4*)(mv + 3072 + c), sc = *(const float4*)(mv + 4096 + c);
                float f[4]; f[0] = xv[rr][j].x * rs * gg.x * (1.f + sc.x) + sh.x; f[1] = xv[rr][j].y * rs * gg.y * (1.f + sc.y) + sh.y; f[2] = xv[rr][j].z * rs * gg.z * (1.f + sc.z) + sh.z; f[3] = xv[rr][j].w * rs * gg.w * (1.f + sc.w) + sh.w;
                u32x2 oh, ol; oh.x = pk2(f[0], f[1]); oh.y = pk2(f[2], f[3]);
                ol.x = pk2(f[0] - __uint_as_float(oh.x << 16), f[1] - __uint_as_float(oh.x & 0xffff0000u)); ol.y = pk2(f[2] - __uint_as_float(oh.y << 16), f[3] - __uint_as_float(oh.y & 0xffff0000u));
                *(u32x2*)(XN + (size_t)r * D + c) = oh; *(LAS u32x2*)(FH + (2 * wave + rr) * FP + c) = oh; *(LAS u32x2*)(FL + (2 * wave + rr) * FP + c) = ol; } }
        if (bi + G < nb) RT_LOAD(bi + G);
        __syncthreads();
        { f32x4 acc[2] = {(f32x4){0.f, 0.f, 0.f, 0.f}, (f32x4){0.f, 0.f, 0.f, 0.f}};
#pragma unroll
          for (int ks = 0; ks < 4; ++ks) { const bf16x8 ah = *(const LAS bf16x8*)(FH + fr * FP + 128 * wave + 32 * ks + 8 * fq), al = *(const LAS bf16x8*)(FL + fr * FP + 128 * wave + 32 * ks + 8 * fq);
#pragma unroll
              for (int nt = 0; nt < 2; ++nt) { acc[nt] = __builtin_amdgcn_mfma_f32_16x16x32_bf16(ah, wh[nt][ks], acc[nt], 0, 0, 0); acc[nt] = __builtin_amdgcn_mfma_f32_16x16x32_bf16(ah, wl[nt][ks], acc[nt], 0, 0, 0);
                  acc[nt] = __builtin_amdgcn_mfma_f32_16x16x32_bf16(al, wh[nt][ks], acc[nt], 0, 0, 0); } }
#pragma unroll
          for (int nt = 0; nt < 2; ++nt)
#pragma unroll
              for (int i = 0; i < 4; ++i) PART[(wave * 16 + 4 * fq + i) * 32 + 16 * nt + fr] = acc[nt][i]; }
        __syncthreads();
        { const int row = 2 * wave + (lane >> 5), e = lane & 31; const int r = RT_ROW(bi * 16 + row);
          float lg = bias;
#pragma unroll
          for (int kw = 0; kw < 8; ++kw) lg += PART[(kw * 16 + row) * 32 + e];
          LG[row * 32 + e] = lg;
          int rank = 0;
#pragma unroll
          for (int j4 = 0; j4 < 8; ++j4) { const f32x4 o = *(const LAS f32x4*)(LG + row * 32 + 4 * j4);
#pragma unroll
              for (int i = 0; i < 4; ++i) { const int j = 4 * j4 + i; rank += (o[i] > lg || (o[i] == lg && j < e)) ? 1 : 0; } }
          if (rank < 4) { TOP[(row * 4 + rank) * 2] = lg; TOP[(row * 4 + rank) * 2 + 1] = __int_as_float(e); }
          if (e == 0) { float tv[4]; int ti[4];
#pragma unroll
              for (int k = 0; k < 4; ++k) { tv[k] = TOP[(row * 4 + k) * 2]; ti[k] = __float_as_int(TOP[(row * 4 + k) * 2 + 1]); }
              float ex[4], sum = 0.f;
#pragma unroll
              for (int k = 0; k < 4; ++k) { ex[k] = __expf(tv[k] - tv[0]); sum += ex[k]; }
              const float isum = 1.f / sum;
#pragma unroll
              for (int k = 0; k < 4; ++k) { const int asg = r * 4 + k; GATE[asg] = ex[k] * isum; const int rk = __hip_atomic_fetch_add(&LCNT[ti[k]], 1, __ATOMIC_RELAXED, __HIP_MEMORY_SCOPE_WORKGROUP); const int slot = __hip_atomic_fetch_add(&LCNT[32], 1, __ATOMIC_RELAXED, __HIP_MEMORY_SCOPE_WORKGROUP);
                  LENT[slot * 2] = asg; LENT[slot * 2 + 1] = (ti[k] << 16) | rk; } } }
        __syncthreads();
    }
#undef RT_ROW
#undef RT_LOAD
    if (tid < 32) LBASE[tid] = LCNT[tid] > 0 ? atomicAdd(&CNT[tid * L::CNT_STRIDE], LCNT[tid]) : 0;
    __syncthreads();
    for (int i = tid; i < LCNT[32]; i += 512) { const int asg = LENT[i * 2], er = LENT[i * 2 + 1], ee = er >> 16, rank = er & 0xffff; LIST[(size_t)ee * LCAP + LBASE[ee] + rank] = asg; }
    __syncthreads();
}
__device__ __forceinline__ void smallw_phase(const float* w_uq, const float* qg, const float* w_ukv, const float* kvg, const float* w_a, const float* w_i, bf16_t* WUQT, bf16_t* WUKVT, bf16_t* WAT, bf16_t* WIT,
                                             float* TABC, float* TABS, const float* lam, float* SPT, const float* rw, bf16_t* RWHp, bf16_t* RWLp, int gt, int NGT) {
    for (int i = gt; i < 2 * 384 * 256; i += NGT) { const int l = i / (384 * 256), q = i % (384 * 256), n = q >> 8, k = q & 255; WUQT[i] = f2bf(qg[l * 256 + k] * w_uq[((size_t)l * 256 + k) * 384 + n]); }
    for (int i = gt; i < 2 * 512 * 128; i += NGT) { const int l = i / (512 * 128), q = i % (512 * 128), n = q >> 7, k = q & 127; WUKVT[i] = f2bf(kvg[l * 128 + k] * w_ukv[((size_t)l * 128 + k) * 512 + n]); }
    for (int i = gt; i < 16 * 4096; i += NGT) { const int m = i >> 12, q = i & 4095, e = q >> 6, d = q & 63; WAT[i] = f2bf(w_a[(size_t)m * 4096 + d * 64 + e]); WIT[i] = f2bf(w_i[(size_t)m * 4096 + d * 64 + e]); }
    for (int i = gt; i < 4096; i += NGT) { float s, c; sincospif((float)i / 2048.f, &s, &c); TABC[i] = c; TABS[i] = s; }
    for (int i = gt; i < 1024; i += NGT) SPT[i] = log1pf(__expf(-lam[i]));
    for (int i = gt; i < 2 * NE * D; i += NGT) { const int l = i / (NE * D), q = i % (NE * D), e = q >> 10, k = q & 1023; const float w = rw[((size_t)l * D + k) * NE + e]; const bf16_t h = f2bf(w); RWHp[i] = h; RWLp[i] = f2bf(w - bf2f(h)); }
}
}

namespace prep {
constexpr int O_KR = 0, O_CS = 8192, O_RS = 16384, O_CQ = 16896  , O_KS = 67072, O_CKV = 100864;
constexpr int CQP = 264, CKP = 136, QSP = 392, KSP = 264;
constexpr float C2 = 0.10206207261596577f * 1.4426950408889634f;
__device__ __forceinline__ void qkv_units(LAS unsigned char* lds, int l, const bf16_t* P, const bf16_t* WUQT, const bf16_t* WUKVT, const float* scw, const float* scb,
                                          bf16_t* QL, bf16_t* QC, bf16_t* KB, bf16_t* VTG, bf16_t* MIX, int u0, int u1, int ustep) {
    LAS float* KRo = (LAS float*)(lds + O_KR); LAS float* CS = (LAS float*)(lds + O_CS); LAS float* RS = (LAS float*)(lds + O_RS);
    LAS bf16_t* CQ = (LAS bf16_t*)(lds + O_CQ); LAS bf16_t* CK = (LAS bf16_t*)(lds + O_CKV); LAS bf16_t* KS = (LAS bf16_t*)(lds + O_KS); LAS bf16_t* QS = (LAS bf16_t*)(lds + O_CQ);
    for (int unit = u0; unit < u1; unit += ustep) {
        int tid_l = threadIdx.x; asm volatile("" : "+v"(tid_l));
        const int tid = tid_l, lane = tid & 63, w = __builtin_amdgcn_readfirstlane(tid >> 6), fr = lane & 15, fq = lane >> 4;
        const int b = unit / 68, chunk = unit % 68, pos0 = 64 * chunk; const bool ctxt = chunk < 4; const size_t r0 = (size_t)b * NPOS + pos0;
#pragma unroll
        for (int i = 0; i < 4; ++i) { const int q = tid + 512 * i, row = q >> 5, ch = q & 31; *(LAS u32x4*)((LAS unsigned char*)CQ + row * (CQP * 2) + ch * 16) = *(const u32x4*)(P + (r0 + row) * PP + C_CQ + ch * 8); }
#pragma unroll
        for (int i = 0; i < 2; ++i) { const int q = tid + 512 * i, row = q >> 4, ch = q & 15; *(LAS u32x4*)((LAS unsigned char*)CK + row * (CKP * 2) + ch * 16) = *(const u32x4*)(P + (r0 + row) * PP + C_CKV + ch * 8); }
        __syncthreads();
        { const int row = tid >> 3, j = tid & 7; float sq = 0.f, sk = 0.f;
#pragma unroll
          for (int i = 0; i < 4; ++i) { const u32x4 v = *(const LAS u32x4*)((const LAS unsigned char*)CQ + row * (CQP * 2) + j * 64 + i * 16);
#pragma unroll
              for (int e = 0; e < 4; ++e) { const float a = __uint_as_float(v[e] << 16), c = __uint_as_float(v[e] & 0xffff0000u); sq += a * a + c * c; } }
#pragma unroll
          for (int i = 0; i < 2; ++i) { const u32x4 v = *(const LAS u32x4*)((const LAS unsigned char*)CK + row * (CKP * 2) + j * 32 + i * 16);
#pragma unroll
              for (int e = 0; e < 4; ++e) { const float a = __uint_as_float(v[e] << 16), c = __uint_as_float(v[e] & 0xffff0000u); sk += a * a + c * c; } }
          sq += __shfl_xor(sq, 1); sq += __shfl_xor(sq, 2); sq += __shfl_xor(sq, 4); sk += __shfl_xor(sk, 1); sk += __shfl_xor(sk, 2); sk += __shfl_xor(sk, 4);
          if (j == 0) { RS[row * 2] = rsqrtf(sq * (1.f / 256.f) + 1e-6f); RS[row * 2 + 1] = rsqrtf(sk * (1.f / 128.f) + 1e-6f); }
          float cr = 1.f, sr = 0.f, cc = 1.f, sc = 0.f;
          if (!ctxt) { const int t = pos0 - CTX + row; const float inv = __expf(-9.210340371976184f * (float)j * 0.125f); float xa = (float)(t >> 6) * inv * 0.15915494309189535f; xa -= rintf(xa); sr = __sinf(xa * 6.283185307179586f); cr = __cosf(xa * 6.283185307179586f); float xb = (float)(t & 63) * inv * 0.15915494309189535f; xb -= rintf(xb); sc = __sinf(xb * 6.283185307179586f); cc = __cosf(xb * 6.283185307179586f); }
          CS[(row * 16 + j) * 2] = cr; CS[(row * 16 + j) * 2 + 1] = sr; CS[(row * 16 + 8 + j) * 2] = cc; CS[(row * 16 + 8 + j) * 2 + 1] = sc;
          const bf16_t* kp = P + (r0 + row) * PP + C_KR; const float z0 = bf2f(kp[j]), z1 = bf2f(kp[8 + j]), z2 = bf2f(kp[16 + j]), z3 = bf2f(kp[24 + j]);
          KRo[row * 32 + j] = z0 * cr - z1 * sr; KRo[row * 32 + 8 + j] = z0 * sr + z1 * cr; KRo[row * 32 + 16 + j] = z2 * cc - z3 * sc; KRo[row * 32 + 24 + j] = z2 * sc + z3 * cc; }
        __builtin_amdgcn_sched_barrier(0);
        { f32x4 qa[4][3];
#pragma unroll
          for (int mt = 0; mt < 4; ++mt)
#pragma unroll
              for (int n = 0; n < 3; ++n) qa[mt][n] = (f32x4){0.f, 0.f, 0.f, 0.f};
          const bf16_t* wq = WUQT + ((size_t)l * 384 + 48 * w + fr) * 256 + 8 * fq;
#pragma unroll
          for (int ks = 0; ks < 8; ++ks) { bf16x8 a[4], bb[3];
#pragma unroll
              for (int mt = 0; mt < 4; ++mt) a[mt] = *(const LAS bf16x8*)(CQ + (16 * mt + fr) * CQP + 32 * ks + 8 * fq);
#pragma unroll
              for (int n = 0; n < 3; ++n) bb[n] = *(const bf16x8*)(wq + (size_t)(16 * n) * 256 + 32 * ks);
#pragma unroll
              for (int mt = 0; mt < 4; ++mt)
#pragma unroll
                  for (int n = 0; n < 3; ++n) qa[mt][n] = __builtin_amdgcn_mfma_f32_16x16x32_bf16(a[mt], bb[n], qa[mt][n], 0, 0, 0); }
          __syncthreads();
#pragma unroll
          for (int n = 0; n < 3; ++n) { const int nt = 3 * w + n, m6 = nt % 6, col = 16 * nt + fr;
#pragma unroll
              for (int mt = 0; mt < 4; ++mt)
#pragma unroll
                  for (int i = 0; i < 4; ++i) { const int row = 16 * mt + 4 * fq + i; float v = qa[mt][n][i] * RS[row * 2];
                      if (m6 >= 4) { const float pv = __shfl_xor(v, 8); const int ci = (row * 16 + (m6 == 5 ? 8 : 0) + (fr & 7)) * 2; const float c = CS[ci], s = CS[ci + 1]; v = (fr < 8) ? v * c - pv * s : pv * s + v * c; }
                      QS[row * QSP + col] = f2bf(v * C2); } } }
        __builtin_amdgcn_sched_barrier(0);
        { f32x4 ka[4][4];
#pragma unroll
          for (int mt = 0; mt < 4; ++mt)
#pragma unroll
              for (int n = 0; n < 4; ++n) ka[mt][n] = (f32x4){0.f, 0.f, 0.f, 0.f};
          const bf16_t* wk = WUKVT + ((size_t)l * 512 + 64 * w + fr) * 128 + 8 * fq;
#pragma unroll
          for (int ks = 0; ks < 4; ++ks) { bf16x8 a[4], bb[4];
#pragma unroll
              for (int mt = 0; mt < 4; ++mt) a[mt] = *(const LAS bf16x8*)(CK + (16 * mt + fr) * CKP + 32 * ks + 8 * fq);
#pragma unroll
              for (int n = 0; n < 4; ++n) bb[n] = *(const bf16x8*)(wk + (size_t)(16 * n) * 128 + 32 * ks);
#pragma unroll
              for (int mt = 0; mt < 4; ++mt)
#pragma unroll
                  for (int n = 0; n < 4; ++n) ka[mt][n] = __builtin_amdgcn_mfma_f32_16x16x32_bf16(a[mt], bb[n], ka[mt][n], 0, 0, 0); }
          const int head = w >> 1;
          if ((w & 1) == 0) {
#pragma unroll
              for (int n = 0; n < 4; ++n)
#pragma unroll
                  for (int mt = 0; mt < 4; ++mt)
#pragma unroll
                      for (int i = 0; i < 4; ++i) { const int row = 16 * mt + 4 * fq + i; KS[row * KSP + head * 64 + 16 * n + fr] = f2bf(ka[mt][n][i] * RS[row * 2 + 1]); }
          } else {
#pragma unroll
              for (int n = 0; n < 4; ++n)
#pragma unroll
                  for (int mt = 0; mt < 4; ++mt) { const int rb = 16 * mt + 4 * fq; u32x2 o; o.x = pk2(ka[mt][n][0] * RS[rb * 2 + 1], ka[mt][n][1] * RS[rb * 2 + 3]); o.y = pk2(ka[mt][n][2] * RS[rb * 2 + 5], ka[mt][n][3] * RS[rb * 2 + 7]);
                      *(u32x2*)(VTG + ((size_t)(b * 4 + head) * 64 + 16 * n + fr) * NPOS + pos0 + rb) = o; } } }
        __syncthreads();
#pragma unroll
        for (int i = 0; i < 6; ++i) { const int q = tid + 512 * i, row = q / 48, rem = q % 48, head = rem / 12, ch = rem % 12, pos = pos0 + row;
            const u32x4 qv = *(const LAS u32x4*)((const LAS unsigned char*)QS + row * (QSP * 2) + (head * 96 + ch * 8) * 2);
            if (!ctxt) *(u32x4*)(QL + ((size_t)(b * 4 + head) * SEQ + (pos - CTX)) * 96 + ch * 8) = qv; else if (l == 0) *(u32x4*)(QC + ((size_t)(b * 4 + head) * CTX + pos) * 96 + ch * 8) = qv;
            u32x4 kv;
            if (ch < 8) kv = *(const LAS u32x4*)((const LAS unsigned char*)KS + row * (KSP * 2) + (head * 64 + ch * 8) * 2);
            else { const LAS float* kr = KRo + row * 32 + (ch - 8) * 8; kv.x = pk2(kr[0], kr[1]); kv.y = pk2(kr[2], kr[3]); kv.z = pk2(kr[4], kr[5]); kv.w = pk2(kr[6], kr[7]); }
            *(u32x4*)(KB + ((size_t)(b * 4 + head) * NPOS + pos) * 96 + ch * 8) = kv; }
        if (!(ctxt && l == 1)) { const int lo = ctxt ? 0 : CTX, hi = ctxt ? CTX : NPOS;
#pragma unroll
            for (int i = 0; i < 4; ++i) { const int q = tid + 512 * i, row = q >> 5, ch = q & 31, pos = pos0 + row; float acc[8];
#pragma unroll
                for (int e = 0; e < 8; ++e) acc[e] = scb[ch * 8 + e];
#pragma unroll
                for (int k = 0; k < 3; ++k) { const int p = pos - 1 + k; if (p >= lo && p < hi) { const bf16_t* pr = P + ((size_t)b * NPOS + p) * PP; const u32x4 sx = *(const u32x4*)(pr + C_SX + ch * 8), sc = *(const u32x4*)(pr + C_SC + ch * 8);
#pragma unroll
                        for (int e = 0; e < 4; ++e) { const float w0 = scw[k * 256 + ch * 8 + 2 * e], w1 = scw[k * 256 + ch * 8 + 2 * e + 1];
                            acc[2 * e] += w0 * (__uint_as_float(sx[e] << 16) * __uint_as_float(sc[e] << 16)); acc[2 * e + 1] += w1 * (__uint_as_float(sx[e] & 0xffff0000u) * __uint_as_float(sc[e] & 0xffff0000u)); } } }
                const u32x4 sb = *(const u32x4*)(P + (r0 + row) * PP + C_SB + ch * 8); u32x4 o;
#pragma unroll
                for (int e = 0; e < 4; ++e) o[e] = pk2(__uint_as_float(sb[e] << 16) * acc[2 * e], __uint_as_float(sb[e] & 0xffff0000u) * acc[2 * e + 1]);
                *(u32x4*)(MIX + (r0 + row) * D + 768 + ch * 8) = o; } }
        __syncthreads();
    }
}
}

namespace lru {
constexpr int XP = 264, O_X = 0, O_NA = 33792, O_BB = 66560;
__device__ __forceinline__ float sigm(float x) { return __builtin_amdgcn_rcpf(1.f + __expf(-x)); }
__device__ __forceinline__ void chunk_units(LAS unsigned char* lds, int l, const bf16_t* P, const float* conv_w, const float* conv_b, const bf16_t* WAT, const bf16_t* WIT, const float* b_a, const float* b_i, const float* SPT,
                                            bf16_t* HL, bf16_t* AC, float* SUM, int u0, int u1, int ustep, int knob) {
    LAS bf16_t* X = (LAS bf16_t*)(lds + O_X); LAS bf16_t* NA = (LAS bf16_t*)(lds + O_NA); LAS bf16_t* BB = (LAS bf16_t*)(lds + O_BB);
    for (int unit = u0; unit < u1; unit += ustep) {
        int tid_l = threadIdx.x; asm volatile("" : "+v"(tid_l));
        const int tid = tid_l, lane = tid & 63, w = __builtin_amdgcn_readfirstlane(tid >> 6), fr = lane & 15, fq = lane >> 4;
        const int dir = unit & 1, bc = unit >> 1, b = bc / 68, chunk = bc % 68, pos0 = 64 * chunk; const int lo = chunk < 4 ? 0 : CTX, hi = chunk < 4 ? CTX : NPOS, left = dir ? 1 : 2;
        const size_t r0 = (size_t)b * NPOS + pos0; const int pd = (l * 2 + dir) * 256;
        if (!(knob & 1)) { const int cg = tid & 31, ts = tid >> 5, c0 = cg * 8; float wv[4][8], cbv[8];
#pragma unroll
          for (int e = 0; e < 8; ++e) { cbv[e] = conv_b[pd + c0 + e];
#pragma unroll
              for (int k = 0; k < 4; ++k) wv[k][e] = conv_w[(size_t)pd * 4 + k * 256 + c0 + e]; }
          const bf16_t* pc = P + (size_t)b * NPOS * PP + C_LX + c0; const int pb = pos0 + 4 * ts - left;
          u32x4 u[7];
#pragma unroll
          for (int i = 0; i < 7; ++i) { const int p = pb + i; const int pcl = p < lo ? lo : (p >= hi ? hi - 1 : p); u[i] = *(const u32x4*)(pc + (size_t)pcl * PP); if (p < lo || p >= hi) u[i] = (u32x4){0u, 0u, 0u, 0u}; }
#pragma unroll
          for (int i = 0; i < 4; ++i) { u32x4 o;
#pragma unroll
              for (int e2 = 0; e2 < 4; ++e2) { float lo_ = cbv[2 * e2], hi_ = cbv[2 * e2 + 1];
#pragma unroll
                  for (int k = 0; k < 4; ++k) { const unsigned d = u[i + k][e2]; lo_ += wv[k][2 * e2] * __uint_as_float(d << 16); hi_ += wv[k][2 * e2 + 1] * __uint_as_float(d & 0xffff0000u); }
                  o[e2] = pk2(lo_, hi_); }
              *(LAS u32x4*)(X + (4 * ts + i) * XP + c0) = o; } }
        __syncthreads();
        if (!(knob & 2)) { const int h = w >> 1, mh = w & 1;
          f32x4 ra[2][4], ri[2][4];
#pragma unroll
          for (int m = 0; m < 2; ++m)
#pragma unroll
              for (int n = 0; n < 4; ++n) { ra[m][n] = (f32x4){0.f, 0.f, 0.f, 0.f}; ri[m][n] = (f32x4){0.f, 0.f, 0.f, 0.f}; }
          const bf16_t* wa = WAT + ((size_t)((l * 2 + dir) * 4 + h) * 64 + fr) * 64 + 8 * fq; const bf16_t* wi = WIT + ((size_t)((l * 2 + dir) * 4 + h) * 64 + fr) * 64 + 8 * fq;
#pragma unroll
          for (int ks = 0; ks < 2; ++ks) { bf16x8 a[2], ba[4], bi[4];
#pragma unroll
              for (int m = 0; m < 2; ++m) a[m] = *(const LAS bf16x8*)(X + (16 * (2 * mh + m) + fr) * XP + 64 * h + 32 * ks + 8 * fq);
#pragma unroll
              for (int n = 0; n < 4; ++n) { ba[n] = *(const bf16x8*)(wa + (size_t)(16 * n) * 64 + 32 * ks); bi[n] = *(const bf16x8*)(wi + (size_t)(16 * n) * 64 + 32 * ks); }
#pragma unroll
              for (int m = 0; m < 2; ++m)
#pragma unroll
                  for (int n = 0; n < 4; ++n) { ra[m][n] = __builtin_amdgcn_mfma_f32_16x16x32_bf16(a[m], ba[n], ra[m][n], 0, 0, 0); ri[m][n] = __builtin_amdgcn_mfma_f32_16x16x32_bf16(a[m], bi[n], ri[m][n], 0, 0, 0); } }
#pragma unroll
          for (int n = 0; n < 4; ++n) { const int c = 64 * h + 16 * n + fr; const float bav = b_a[pd + c], biv = b_i[pd + c], sp8 = 8.f * SPT[pd + c];
#pragma unroll
              for (int m = 0; m < 2; ++m)
#pragma unroll
                  for (int i = 0; i < 4; ++i) { const int t = 16 * (2 * mh + m) + 4 * fq + i; const float r = sigm(ra[m][n][i] + bav), ig = sigm(ri[m][n][i] + biv);
                      const float x = r * sp8; const float na = x < 0.03125f ? x * (1.f - 0.5f * x * (1.f - 0.33333334f * x * (1.f - 0.25f * x))) : 1.f - __expf(-x); const float xv = bf2f(X[t * XP + c]);
                      NA[t * 256 + c] = f2bf(na); BB[t * 256 + c] = f2bf(__builtin_amdgcn_sqrtf(fmaxf(na * (2.f - na), 0.f)) * (ig * xv)); } } }
        __syncthreads();
        if (tid < 256 && !(knob & 4)) { const int c = tid; float hst = 0.f, A = 1.f;
            if (dir == 0) {
#pragma unroll 8
                for (int t = 0; t < 64; ++t) { const float a = 1.f - bf2f(NA[t * 256 + c]); hst = a * hst + bf2f(BB[t * 256 + c]); A *= a; BB[t * 256 + c] = f2bf(hst); NA[t * 256 + c] = f2bf(A); }
            } else {
#pragma unroll 8
                for (int t = 63; t >= 0; --t) { const float a = 1.f - bf2f(NA[t * 256 + c]); hst = a * hst + bf2f(BB[t * 256 + c]); A *= a; BB[t * 256 + c] = f2bf(hst); NA[t * 256 + c] = f2bf(A); }
            }
            float* sm = SUM + ((size_t)(dir * 4 + b) * 68 + chunk) * 512; sm[c] = A; sm[256 + c] = hst; }
        __syncthreads();
        if (!(knob & 4)) {
#pragma unroll
            for (int i = 0; i < 4; ++i) { const int q = tid + 512 * i, t = q >> 5, ch = q & 31; const size_t go = ((size_t)dir * MROWS + r0 + t) * 256 + ch * 8;
                *(u32x4*)(AC + go) = *(const LAS u32x4*)(NA + t * 256 + ch * 8); *(u32x4*)(HL + go) = *(const LAS u32x4*)(BB + t * 256 + ch * 8); } }
        __syncthreads();
    }
}
__device__ __forceinline__ void fixup_units(LAS unsigned char* lds, int l, const bf16_t* P, const bf16_t* HL, const bf16_t* AC, const float* SUM, bf16_t* MIX, int G, int bx) {
    LAS float* CAR = (LAS float*)lds;
    for (int unit = bx; unit < 272; unit += G) {
        int tid_l = threadIdx.x; asm volatile("" : "+v"(tid_l));
        const int tid = tid_l;
        const int b = unit / 68, chunk = unit % 68; if (l == 1 && chunk < 4) continue;
        { const int dir = tid >> 8, c = tid & 255; const float* sp = SUM + ((size_t)(dir * 4 + b) * 68) * 512 + c;
          const int n_pre = dir == 0 ? chunk : (chunk < 4 ? 3 - chunk : 4 + (67 - chunk));
          float cy = 0.f;
          for (int j0 = 0; j0 < n_pre; j0 += 16) { float av[16], hv[16];
#pragma unroll
              for (int u = 0; u < 16; ++u) { const int n = j0 + u < n_pre ? j0 + u : n_pre - 1; const int j = dir == 0 ? n : (n < 4 ? 3 - n : 71 - n); av[u] = sp[(size_t)j * 512]; hv[u] = sp[(size_t)j * 512 + 256]; }
#pragma unroll
              for (int u = 0; u < 16; ++u) cy = (j0 + u < n_pre) ? hv[u] + av[u] * cy : cy; }
          CAR[tid] = cy; }
        __syncthreads();
        { const int cg = tid & 31, ts = tid >> 5, c0 = cg * 8; float cf[8], cb[8];
#pragma unroll
          for (int e = 0; e < 8; ++e) { cf[e] = CAR[c0 + e]; cb[e] = CAR[256 + c0 + e]; }
          const size_t r0 = (size_t)b * NPOS + 64 * chunk + 4 * ts;
          u32x4 hf[4], af[4], hb[4], ab[4], gt[4];
#pragma unroll
          for (int i = 0; i < 4; ++i) { const size_t r = r0 + i; hf[i] = *(const u32x4*)(HL + r * 256 + c0); af[i] = *(const u32x4*)(AC + r * 256 + c0); hb[i] = *(const u32x4*)(HL + ((size_t)MROWS + r) * 256 + c0); ab[i] = *(const u32x4*)(AC + ((size_t)MROWS + r) * 256 + c0);
              gt[i] = *(const u32x4*)(P + r * PP + C_LG + c0); }
#pragma unroll
          for (int i = 0; i < 4; ++i) { u32x4 o;
#pragma unroll
              for (int e2 = 0; e2 < 4; ++e2) { float res[2];
#pragma unroll
                  for (int hh = 0; hh < 2; ++hh) { const int e = 2 * e2 + hh;
                      const float vhf = hh ? __uint_as_float(hf[i][e2] & 0xffff0000u) : __uint_as_float(hf[i][e2] << 16), vaf = hh ? __uint_as_float(af[i][e2] & 0xffff0000u) : __uint_as_float(af[i][e2] << 16);
                      const float vhb = hh ? __uint_as_float(hb[i][e2] & 0xffff0000u) : __uint_as_float(hb[i][e2] << 16), vab = hh ? __uint_as_float(ab[i][e2] & 0xffff0000u) : __uint_as_float(ab[i][e2] << 16);
                      const float x = hh ? __uint_as_float(gt[i][e2] & 0xffff0000u) : __uint_as_float(gt[i][e2] << 16);
                      const float hsum = (vhf + vaf * cf[e]) + (vhb + vab * cb[e]);
                      const float u = 0.7978845608028654f * (x + 0.044715f * x * x * x); const float th_ = 1.f - 2.f * __builtin_amdgcn_rcpf(1.f + __expf(2.f * u));
                      res[hh] = 0.5f * x * (1.f + th_) * hsum; }
                  o[e2] = pk2(res[0], res[1]); }
              *(u32x4*)(MIX + (r0 + i) * D + 256 + c0) = o; } }
        __syncthreads();
    }
}
}

namespace fft {
__device__ __forceinline__ void ctx_a(LAS unsigned char* lds, const bf16_t* P, const float* TABC, const float* TABS, bf16_t* XCT, int G, int bx) {
    LAS bf16_t* U = (LAS bf16_t*)(lds + O_U); LAS bf16_t* X = (LAS bf16_t*)(lds + O_X);
    for (int unit = bx; unit < 16; unit += G) {
        int tid_l = threadIdx.x; asm volatile("" : "+v"(tid_l));
        const int tid = tid_l, lane = tid & 63, w = __builtin_amdgcn_readfirstlane(tid >> 6), fr = lane & 15, fq = lane >> 4;
        build_tables(lds, TABC, TABS, tid);
        const LAS bf16_t* Tc = (const LAS bf16_t*)(lds + O_TC); const LAS bf16_t* Ts = (const LAS bf16_t*)(lds + O_TS);
        const int b = unit >> 2, q = unit & 3;
#pragma unroll
        for (int i = 0; i < 4; ++i) { const int qq = tid + 512 * i, t1 = qq >> 5, ch = qq & 31;
            *(LAS u32x4*)((LAS unsigned char*)U + t1 * (UP * 2) + ch * 16) = *(const u32x4*)(P + ((size_t)b * NPOS + 64 * q + t1) * PP + ch * 8); }
        __syncthreads();
        { const int g = w >> 1, part = w & 1; const LAS bf16_t* T = part ? Ts : Tc;
          f32x4 acc[4][4];
#pragma unroll
          for (int mt = 0; mt < 4; ++mt)
#pragma unroll
              for (int nt = 0; nt < 4; ++nt) acc[mt][nt] = (f32x4){0.f, 0.f, 0.f, 0.f};
#pragma unroll
          for (int ks = 0; ks < 2; ++ks) { bf16x8 a[4], bb[4];
#pragma unroll
              for (int mt = 0; mt < 4; ++mt) a[mt] = *(const LAS bf16x8*)(U + (16 * mt + fr) * UP + g * 64 + 32 * ks + 8 * fq);
#pragma unroll
              for (int nt = 0; nt < 4; ++nt) bb[nt] = *(const LAS bf16x8*)(T + (16 * nt + fr) * TP + 32 * ks + 8 * fq);
#pragma unroll
              for (int mt = 0; mt < 4; ++mt)
#pragma unroll
                  for (int nt = 0; nt < 4; ++nt) acc[mt][nt] = __builtin_amdgcn_mfma_f32_16x16x32_bf16(a[mt], bb[nt], acc[mt][nt], 0, 0, 0); }
          const float sg = part ? -1.f : 1.f;
#pragma unroll
          for (int mt = 0; mt < 4; ++mt)
#pragma unroll
              for (int nt = 0; nt < 4; ++nt) { const f32x4 v = acc[mt][nt] * sg; u32x2 o; o.x = pk2(v[0], v[1]); o.y = pk2(v[2], v[3]);
                  *(LAS u32x2*)(X + (part * 256 + g * 64 + 16 * nt + fr) * TP + 16 * mt + 4 * fq) = o; } }
        __syncthreads();
#pragma unroll
        for (int i = 0; i < 8; ++i) { const int qq = tid + 512 * i, row = qq >> 3, c8 = qq & 7;
            *(u32x4*)(XCT + (((size_t)b * 4 + q) * 512 + row) * 64 + c8 * 8) = *(const LAS u32x4*)((const LAS unsigned char*)X + row * (TP * 2) + c8 * 16); }
        __syncthreads();
    }
}
__device__ __forceinline__ void ctx_b(LAS unsigned char* lds, const bf16_t* XCT, const float* TABC, const float* TABS, bf16_t* MIX, int G, int bx) {
    LAS bf16_t* Tc = (LAS bf16_t*)(lds + O_TC); LAS bf16_t* Ts = (LAS bf16_t*)(lds + O_TS);
    LAS bf16_t* Ys = (LAS bf16_t*)(lds + O_U); LAS bf16_t* ZT = (LAS bf16_t*)(lds + O_X);
    for (int unit = bx; unit < 16; unit += G) {
        int tid_l = threadIdx.x; asm volatile("" : "+v"(tid_l));
        const int tid = tid_l, lane = tid & 63, w = __builtin_amdgcn_readfirstlane(tid >> 6), fr = lane & 15, fq = lane >> 4;
        const int b = unit >> 2, ft = unit & 3;
        f32x4 y[4][2];
#pragma unroll
        for (int mt = 0; mt < 4; ++mt)
#pragma unroll
            for (int n = 0; n < 2; ++n) y[mt][n] = (f32x4){0.f, 0.f, 0.f, 0.f};
        for (int q = 0; q < 4; ++q) {
            for (int i = tid; i < 4096; i += 512) { const int fl = i >> 6, tl = i & 63, ix = (((64 * ft + fl) * (64 * q + tl)) & 255) * 16; Tc[fl * TP + tl] = f2bf(TABC[ix]); Ts[fl * TP + tl] = f2bf(TABS[ix]); }
#pragma unroll
            for (int i = 0; i < 8; ++i) { const int qq = tid + 512 * i, row = qq >> 3, c8 = qq & 7;
                *(LAS u32x4*)((LAS unsigned char*)ZT + row * (TP * 2) + c8 * 16) = *(const u32x4*)(XCT + (((size_t)b * 4 + q) * 512 + row) * 64 + c8 * 8); }
            __syncthreads();
#pragma unroll
            for (int ks = 0; ks < 2; ++ks) { bf16x8 xr[2], xi[2];
#pragma unroll
                for (int n = 0; n < 2; ++n) { xr[n] = *(const LAS bf16x8*)(ZT + (32 * w + 16 * n + fr) * TP + 32 * ks + 8 * fq); xi[n] = *(const LAS bf16x8*)(ZT + (256 + 32 * w + 16 * n + fr) * TP + 32 * ks + 8 * fq); }
#pragma unroll
                for (int mt = 0; mt < 4; ++mt) { const bf16x8 c = *(const LAS bf16x8*)(Tc + (16 * mt + fr) * TP + 32 * ks + 8 * fq), s = *(const LAS bf16x8*)(Ts + (16 * mt + fr) * TP + 32 * ks + 8 * fq);
#pragma unroll
                    for (int n = 0; n < 2; ++n) { y[mt][n] = __builtin_amdgcn_mfma_f32_16x16x32_bf16(c, xr[n], y[mt][n], 0, 0, 0); y[mt][n] = __builtin_amdgcn_mfma_f32_16x16x32_bf16(s, xi[n], y[mt][n], 0, 0, 0); } } }
            __syncthreads();
        }
#pragma unroll
        for (int mt = 0; mt < 4; ++mt)
#pragma unroll
            for (int i = 0; i < 4; ++i)
#pragma unroll
                for (int n = 0; n < 2; ++n) Ys[(16 * mt + 4 * fq + i) * UP + 32 * w + 16 * n + fr] = f2bf(y[mt][n][i] * (1.f / 128.f));
        __syncthreads();
#pragma unroll
        for (int i = 0; i < 4; ++i) { const int qq = tid + 512 * i, fl = qq >> 5, ch = qq & 31;
            *(u32x4*)(MIX + ((size_t)b * NPOS + 64 * ft + fl) * D + ch * 8) = *(const LAS u32x4*)((const LAS unsigned char*)Ys + fl * (UP * 2) + ch * 16); }
        __syncthreads();
    }
}
}

constexpr int NWAVES = 8, RING_BYTES = 131072 + 3072, LDSCTL_OFF = RING_BYTES, MISC_OFF = LDSCTL_OFF + 64, META_OFF = MISC_OFF + 64, LDS_BYTES = 147456;
enum { PH_PRO0 = 0, PH_PRO1 = 1, PH_L0 = 2, PH_PER_LAYER = 8, PH_N = 18 };
enum { PL_WIN = 0, PL_PREP = 1, PL_MIX = 2, PL_WOUT = 3, PL_ROUTE = 4, PL_MOE1 = 5, PL_MOE2 = 6, PL_COMB = 7 };
struct MArgs { const float* in[30]; float* out; unsigned char* ws; int npass, skip_mask, dup_ph, dup_n, dup_sub, knob; };

__device__ __forceinline__ void transpose_item(const float* W, int K, int N, bf16_t* WT, int drow0, LAS float* scr, int k0, int n0, int lane) {
    const int kr = lane >> 3, nc = (lane & 7) * 4;
    f32x4 v[8];
#pragma unroll
    for (int i = 0; i < 8; ++i) v[i] = __builtin_nontemporal_load((const f32x4*)(W + (size_t)(k0 + kr + 8 * i) * N + n0 + nc));
#pragma unroll
    for (int i = 0; i < 8; ++i) { LAS float* d = scr + (kr + 8 * i) * 33 + nc; d[0] = v[i][0]; d[1] = v[i][1]; d[2] = v[i][2]; d[3] = v[i][3]; }
    asm volatile("s_waitcnt lgkmcnt(0)" ::: "memory");
    const int c = lane & 7;
#pragma unroll
    for (int j = 0; j < 4; ++j) { const int n = (lane >> 3) + 8 * j; const LAS float* s = scr + (8 * c) * 33 + n;
        u32x4 o; o.x = pk2(s[0 * 33], s[1 * 33]); o.y = pk2(s[2 * 33], s[3 * 33]); o.z = pk2(s[4 * 33], s[5 * 33]); o.w = pk2(s[6 * 33], s[7 * 33]);
        *(u32x4*)(WT + (size_t)(drow0 + n) * K + k0 + 8 * c) = o; }
    asm volatile("s_waitcnt lgkmcnt(0)" ::: "memory");
}

constexpr int I_GU = NE * 16 * 64, I_DN = NE * 16 * 32, I_EXP = I_GU + I_DN;
__device__ __forceinline__ void expert_item(int l, int j, const float* wgu, const float* wdn, unsigned char* ws, LAS float* scr, int lane) {
    if (j < I_GU) { const int e = j / (16 * 64), q = j % (16 * 64), kb = q / 64, nb = q % 64; const int n0 = 32 * nb; const int c2 = n0 & 1023; const int drow = (c2 >> 7) * 256 + (n0 >> 10) * 128 + (c2 & 127);
        transpose_item(wgu + ((size_t)l * NE + e) * D * 2048, D, 2048, (bf16_t*)(ws + L::WGUT) + ((size_t)l * NE + e) * 2048 * D, drow, scr, 64 * kb, n0, lane); }
    else { const int r = j - I_GU; const int e = r / (16 * 32), q = r % (16 * 32), kb = q / 32, nb = q % 32;
        transpose_item(wdn + ((size_t)l * NE + e) * D * D, D, D, (bf16_t*)(ws + L::WDT) + ((size_t)l * NE + e) * D * D, 32 * nb, scr, 64 * kb, 32 * nb, lane); }
}
constexpr int Q_WIN = 48, Q_WOUT = 96, Q_MOE2 = 0;
constexpr int DEF_WIN = 224 * Q_WIN, DEF0 = DEF_WIN + 240 * Q_WOUT, DEF_MOE2 = 128 * Q_MOE2, DEF1 = DEF_MOE2 + 224 * Q_WIN;
constexpr int MIX_X = 11520;
static_assert(I_EXP - DEF0 + MIX_X <= 17 * 2048 && I_EXP - DEF1 - MIX_X <= 17 * 2048, "one attention unit takes at most 17 items per wave");
__device__ __forceinline__ void deferred_items(int l, int first, int count, const float* wgu, const float* wdn, unsigned char* ws, LAS unsigned char* lds, int wave, int lane) {
    LAS float* scr = (LAS float*)(lds + wave * 16384);
    for (int j = first + wave; j < first + count; j += NWAVES) expert_item(l, j, wgu, wdn, ws, scr, lane);
}

#define GASP __attribute__((address_space(1)))
#define ARG_IN(i) ({ const GASP float* _p; asm volatile("s_load_dwordx2 %0, %1, %2\n\ts_waitcnt lgkmcnt(0)" : "=s"(_p) : "s"(__builtin_amdgcn_kernarg_segment_ptr()), "n"((i) * 8)); (const float*)_p; })
__global__ void __launch_bounds__(NWAVES * 64, 2) mega(MArgs args) {
    extern __shared__ __attribute__((aligned(16))) unsigned char lds_raw[];
    const int G0 = gridDim.x, bx0 = blockIdx.x;
    unsigned char* ws0 = args.ws;
    unsigned* ctl0 = (unsigned*)(ws0 + L::CTL);
    for (int u = threadIdx.x; u < (LDS_BYTES - LDSCTL_OFF) / 4; u += NWAVES * 64) ((LAS unsigned*)(lds_raw + LDSCTL_OFF))[u] = 0u;
    __syncthreads();
    volatile LAS unsigned* MISC = (volatile LAS unsigned*)((LAS unsigned char*)lds_raw + MISC_OFF);
    XcdBarrier bar = xcd_barrier_post(ctl0 + L::CW_BAR, MISC);
    const int lo = 0, hi = PH_N;

    bool first = true;
    for (int pass = 0; pass < args.npass; ++pass)
    for (int ph = lo; ph < hi; ++ph) {
      const int reps = (ph == args.dup_ph) ? 1 + args.dup_n : 1;
      if (ph == PH_PRO1) continue;
      for (int rep = 0; rep < reps; ++rep) {
        if (!first) xcd_barrier(bar);
        first = false;
        if (pass + 1 < args.npass && ((args.skip_mask >> ph) & 1)) continue;
        const int sub = rep + 1 < reps ? args.dup_sub : 15; const int knob = rep + 1 < reps ? args.knob : 0; (void)knob;
        GASP unsigned char* wsg = (GASP unsigned char*)args.ws; asm volatile("" : "+s"(wsg)); unsigned char* ws = (unsigned char*)wsg;
        unsigned* ctl = (unsigned*)(ws + L::CTL);
        int tid_p = threadIdx.x; asm volatile("" : "+v"(tid_p));
        int G = G0, bx = bx0; asm volatile("" : "+s"(G), "+s"(bx));
        const int vcu = (G % 8 == 0) ? (bx % 8) * (G / 8) + bx / 8 : bx; (void)vcu;
        unsigned ldsb = 0; asm volatile("" : "+s"(ldsb)); LAS unsigned char* lds = (LAS unsigned char*)lds_raw + ldsb;
        LAS int* META = (LAS int*)(lds + META_OFF);
        const int tid = tid_p, lane = tid & 63, wave = __builtin_amdgcn_readfirstlane(tid >> 6); (void)lane; (void)wave;
        if (ph == PH_PRO0) {
            if (bx == 0 && tid < 2 * NE) ((int*)(ctl + L::CW_CNT))[tid * L::CNT_STRIDE] = 0;
            sm::smallw_phase(ARG_IN(17), ARG_IN(16), ARG_IN(19), ARG_IN(18), ARG_IN(11), ARG_IN(13), (bf16_t*)(ws + L::WUQT), (bf16_t*)(ws + L::WUKVT), (bf16_t*)(ws + L::WAT), (bf16_t*)(ws + L::WIT),
                             (float*)(ws + L::TABC), (float*)(ws + L::TABS), ARG_IN(15), (float*)(ws + L::SPT), ARG_IN(23), (bf16_t*)(ws + L::RWH), (bf16_t*)(ws + L::RWL), bx * 512 + tid, G * 512);
            __syncthreads();
            sm::mod_phase(lds, ARG_IN(1), ARG_IN(3), ARG_IN(4), ARG_IN(5), (float*)(ws + L::MOD), G, bx, tid);
            { int nmine = 0; for (int u = bx; u < 96; u += G) ++nmine;
              if (nmine) { asm volatile("s_waitcnt vmcnt(0)" ::: "memory"); __syncthreads();
                  if (tid == 0) { __builtin_amdgcn_fence(__ATOMIC_RELEASE, "agent"); asm volatile("s_waitcnt vmcnt(0)" ::: "memory"); __hip_atomic_fetch_add(ctl + L::CW_MODCNT, (unsigned)nmine, __ATOMIC_RELAXED, __HIP_MEMORY_SCOPE_AGENT); } } }
            __syncthreads();
            LAS float* scr = (LAS float*)(lds + wave * 16384);
            const int gw = vcu * NWAVES + wave, NGW = G * NWAVES;
            constexpr int I_IN = 16 * 61, I_OUT = 16 * 32, I_D = I_IN + I_OUT; const int d0 = G == 256 ? I_EXP : 0, d1 = G == 256 ? I_EXP : 0, R0 = I_EXP - d0, R1 = I_EXP - d1;
            for (int it = gw; it < 2 * I_D + R0 + R1; it += NGW) {
                if (it < 2 * I_D) { const int l = it / I_D; int r = it % I_D;
                    if (r < I_IN) { const int kb = r / 61, nb = r % 61; transpose_item(ARG_IN(8) + (size_t)l * D * PT, D, PT, (bf16_t*)(ws + L::WINT) + (size_t)l * 2048 * D, 32 * nb, scr, 64 * kb, 32 * nb, lane); }
                    else { r -= I_IN; const int kb = r / 32, nb = r % 32; transpose_item(ARG_IN(22) + (size_t)l * D * D, D, D, (bf16_t*)(ws + L::WOUTT) + (size_t)l * D * D, 32 * nb, scr, 64 * kb, 32 * nb, lane); }
                } else { const int r = it - 2 * I_D; if (r < R0) expert_item(0, d0 + r, ARG_IN(25), ARG_IN(27), ws, scr, lane); else expert_item(1, d1 + (r - R0), ARG_IN(25), ARG_IN(27), ws, scr, lane); }
            }
            for (int i = bx * 512 + tid; i < 2 * 96 * D / 8; i += G * 512) { const int l = i / (96 * D / 8), q = i % (96 * D / 8); *(u32x4*)((bf16_t*)(ws + L::WINT) + ((size_t)l * 2048 + PT) * D + (size_t)q * 8) = (u32x4){0u, 0u, 0u, 0u}; }
            if (tid == 0) { unsigned sp = 0; while (__hip_atomic_load(ctl + L::CW_MODCNT, __ATOMIC_RELAXED, __HIP_MEMORY_SCOPE_AGENT) < 96u && ++sp < (1u << 22)) __builtin_amdgcn_s_sleep(2);
                __builtin_amdgcn_fence(__ATOMIC_ACQUIRE, "agent"); asm volatile("s_waitcnt vmcnt(0)" ::: "memory"); }
            __syncthreads();
            { const int nmod = G < 96 ? G : 96; const int small = 45, rs0 = bx < nmod ? bx * small : nmod * small + (int)(((long)(bx - nmod) * (MROWS - nmod * small)) / (G - nmod)),
                  rs1 = bx + 1 < nmod ? (bx + 1) * small : (bx + 1 >= G ? MROWS : nmod * small + (int)(((long)(bx + 1 - nmod) * (MROWS - nmod * small)) / (G - nmod)));
              sm::pro1_phase(ARG_IN(0), ARG_IN(2), ARG_IN(6), (const float*)(ws + L::MOD), (float*)(ws + L::H), (bf16_t*)(ws + L::XN), rs0 + wave, rs1, NWAVES, lane); }
            continue;
        }
        if (ph < PH_L0) continue;
        const int l = (ph - PH_L0) / PH_PER_LAYER, pl = (ph - PH_L0) % PH_PER_LAYER;
        const float* MODl = (const float*)(ws + L::MOD) + (size_t)l * 5 * 6144;
        if (pl == PL_WIN) {
            g8::DenseSched S; S.init(MROWS / 256, PP / 256, G, bx, 0, (const bf16_t*)(ws + L::WINT) + (size_t)l * 2048 * D, D);
            g8::EpiP E{(bf16_t*)(ws + L::P)};
            g8::gemm_phase<g8::EpiP, g8::DenseSched, false, false>(lds, (const char*)(ws + L::XN), S, E);
            if (G == 256 && bx >= 32) deferred_items(l, (l == 0 ? 0 : DEF_MOE2) + (bx - 32) * Q_WIN, Q_WIN, ARG_IN(25), ARG_IN(27), ws, lds, wave, lane);
        } else if (pl == PL_PREP) {
            if (l == 0 && (sub & 2)) { fft::ctx_a(lds, (const bf16_t*)(ws + L::P), (const float*)(ws + L::TABC), (const float*)(ws + L::TABS), (bf16_t*)(ws + L::XCT), G, G - 1 - bx); __syncthreads(); }
            for (int p = 0; p * G < 1072; ++p) {
                const int k = p * G + ((p & 1) ? G - 1 - bx : bx);
                if (k >= 1072) continue;
                if (k < 272) { if (sub & 4) prep::qkv_units(lds, l, (const bf16_t*)(ws + L::P), (const bf16_t*)(ws + L::WUQT), (const bf16_t*)(ws + L::WUKVT), ARG_IN(20) + l * 768, ARG_IN(21) + l * 256,
                            (bf16_t*)(ws + L::QL), (bf16_t*)(ws + L::QC), (bf16_t*)(ws + L::KB), (bf16_t*)(ws + L::VTG), (bf16_t*)(ws + L::MIX), k, k + 1, 1); }
                else if (k < 816) { if (sub & 8) lru::chunk_units(lds, l, (const bf16_t*)(ws + L::P), ARG_IN(9), ARG_IN(10), (const bf16_t*)(ws + L::WAT), (const bf16_t*)(ws + L::WIT), ARG_IN(12), ARG_IN(14), (const float*)(ws + L::SPT),
                             (bf16_t*)(ws + L::HL), (bf16_t*)(ws + L::AC), (float*)(ws + L::SUM), k - 272, k - 271, 1, knob); }
                else { if (sub & 1) fft::stage_a(lds, (const bf16_t*)(ws + L::P), (const float*)(ws + L::TABC), (const float*)(ws + L::TABS), (bf16_t*)(ws + L::ZBUF), k - 816, k - 815, 1); }
                __syncthreads();
            }
        } else if (pl == PL_MIX) {
            if (sub & 1) lru::fixup_units(lds, l, (const bf16_t*)(ws + L::P), (const bf16_t*)(ws + L::HL), (const bf16_t*)(ws + L::AC), (const float*)(ws + L::SUM), (bf16_t*)(ws + L::MIX), G, bx);
            if (sub & 2) fft::stage_b(lds, (const bf16_t*)(ws + L::ZBUF), (const float*)(ws + L::TABC), (const float*)(ws + L::TABS), (bf16_t*)(ws + L::MIX), G, bx);
            __syncthreads();
            if (l == 0 && (sub & 4)) { fft::ctx_b(lds, (const bf16_t*)(ws + L::XCT), (const float*)(ws + L::TABC), (const float*)(ws + L::TABS), (bf16_t*)(ws + L::MIX), G, G - 1 - bx); __syncthreads(); }
            cv::Job cvj; cvj.wgu = ARG_IN(25); cvj.wdn = ARG_IN(27); cvj.ws = ws;
            if (l == 0) { cvj.n0 = I_EXP - DEF0; cvj.first0 = DEF0; cvj.first1 = DEF1; cvj.nv = cvj.n0 + MIX_X; } else { cvj.n0 = 0; cvj.first0 = 0; cvj.first1 = DEF1 + MIX_X; cvj.nv = I_EXP - DEF1 - MIX_X; }
            if (sub & 8) attn::attn_phase(lds, (const bf16_t*)(ws + L::QL), (const bf16_t*)(ws + L::QC), (const bf16_t*)(ws + L::KB), (const bf16_t*)(ws + L::VTG), (bf16_t*)(ws + L::MIX), l == 0 ? 1 : 0, G, vcu, cvj, G == 256);
        } else if (pl == PL_WOUT) {
            g8::DenseSched S; S.init(l == 0 ? MROWS / 256 : 64, D / 256, G, bx, l == 0 ? 0 : 1, (const bf16_t*)(ws + L::WOUTT) + (size_t)l * D * D, D);
            g8::EpiH E{(float*)(ws + L::H), MODl, 2048};
            g8::gemm_phase<g8::EpiH, g8::DenseSched, false, false>(lds, (const char*)(ws + L::MIX), S, E);
            if (G == 256 && l == 0 && bx >= 16) deferred_items(0, DEF_WIN + (bx - 16) * Q_WOUT, Q_WOUT, ARG_IN(25), ARG_IN(27), ws, lds, wave, lane);
        } else if (pl == PL_ROUTE) {
            sm::route_phase(lds, l, (const float*)(ws + L::H), ARG_IN(7) + l * D, MODl, (const bf16_t*)(ws + L::RWH), (const bf16_t*)(ws + L::RWL), ARG_IN(24) + l * NE, (bf16_t*)(ws + L::XN), (int*)(ctl + L::CW_CNT) + l * NE * L::CNT_STRIDE,
                            (int*)(ws + L::LIST) + (size_t)l * NE * LCAP, (float*)(ws + L::GATE), G, bx, tid);
        } else if (pl == PL_COMB) {
            sm::comb_phase(l, (float*)(ws + L::H), (const bf16_t*)(ws + L::Y), MODl, ARG_IN(6) + D, (const float*)(ws + L::MOD) + (size_t)5 * 6144, (bf16_t*)(ws + L::XN), ARG_IN(29), args.out, bx * NWAVES + wave, G * NWAVES, lane);
        } else if (pl == PL_MOE1 || pl == PL_MOE2) {
            const int* CNTg = (const int*)(ctl + L::CW_CNT) + l * NE * L::CNT_STRIDE;
            if (tid == 0) { int o = 0; for (int e = 0; e < NE; ++e) { const int cn = CNTg[e * L::CNT_STRIDE]; META[e] = o; META[64 + e] = cn; o += (cn + 255) >> 8; } META[NE] = o; }
            __syncthreads();
            g8::MoeSched S; S.tpre = META; S.cnt = META + 64; S.G = G; S.c = bx; S.K = D; S.list = (const int*)(ws + L::LIST) + (size_t)l * NE * LCAP;
            if (pl == PL_MOE1) {
                S.NT = 8; S.COLW = 128; S.total = __builtin_amdgcn_readfirstlane(META[NE]) * 8; S.Bt = (const char*)((const bf16_t*)(ws + L::WGUT) + (size_t)l * NE * 2048 * D);
                g8::EpiMoe1 E{(bf16_t*)(ws + L::ACT), ARG_IN(26) + (size_t)l * NE * 2048};
                g8::gemm_phase<g8::EpiMoe1, g8::MoeSched, true, true>(lds, (const char*)(ws + L::XN), S, E);
            } else {
                S.NT = 4; S.COLW = 256; S.total = __builtin_amdgcn_readfirstlane(META[NE]) * 4; S.Bt = (const char*)((const bf16_t*)(ws + L::WDT) + (size_t)l * NE * D * D);
                g8::EpiMoe2 E{(bf16_t*)(ws + L::Y), ARG_IN(28) + (size_t)l * NE * D, (const float*)(ws + L::GATE)};
                g8::gemm_phase<g8::EpiMoe2, g8::MoeSched, false, true>(lds, (const char*)(ws + L::ACT), S, E);
                if (G == 256 && l == 0 && bx >= 128) deferred_items(1, (bx - 128) * Q_MOE2, Q_MOE2, ARG_IN(25), ARG_IN(27), ws, lds, wave, lane);
            }
            __syncthreads();
        }
      }
    }
}
constexpr int PROBE_DUP_PH = -1, PROBE_DUP_N = 0, PROBE_DUP_SUB = 15, PROBE_KNOB = 0;
constexpr int PROBE_NPASS = 1, PROBE_SKIP = 0;
extern "C" void kernel_launch(void* const* d_in, const int* in_sizes, int n_in, void* d_out, int out_size, void* d_ws, size_t ws_size, hipStream_t stream) {
    static int grid = 0;
    if (grid == 0) {
        if (n_in != 30 || out_size != NB_ * SEQ * D || (size_t)L::END > ws_size) { fprintf(stderr, "kernel_launch: unexpected problem shape (n_in %d, out %d) or workspace too small (need %zu, have %zu); nothing launched\n", n_in, out_size, (size_t)L::END, ws_size); grid = -1; return; }
        int dev = 0, cus = 0;
        if (hipGetDevice(&dev) != hipSuccess || hipDeviceGetAttribute(&cus, hipDeviceAttributeMultiprocessorCount, dev) != hipSuccess) { fprintf(stderr, "kernel_launch: device query failed\n"); grid = -1; return; }
        if (hipFuncSetAttribute((const void*)mega, hipFuncAttributeMaxDynamicSharedMemorySize, LDS_BYTES) != hipSuccess) { fprintf(stderr, "kernel_launch: hipFuncSetAttribute failed\n"); grid = -1; return; }
        int per_cu = 0;
        if (hipOccupancyMaxActiveBlocksPerMultiprocessor(&per_cu, (const void*)mega, NWAVES * 64, LDS_BYTES) != hipSuccess || per_cu < 1) fprintf(stderr, "kernel_launch: note: the occupancy query reports %d workgroups per CU; launching one per CU anyway\n", per_cu);
        (void)hipGetLastError();
        grid = cus < 256 ? cus : 256;
    }
    if (grid < 0) return;
    unsigned char* p = (unsigned char*)d_ws;
    (void)hipMemsetAsync(p + L::CTL, 0, L::CTL_BYTES, stream);
    MArgs a{};
    for (int i = 0; i < 30; ++i) a.in[i] = (const float*)d_in[i];
    a.out = (float*)d_out; a.ws = p; a.npass = PROBE_NPASS; a.skip_mask = PROBE_SKIP; a.dup_ph = PROBE_DUP_PH; a.dup_n = PROBE_DUP_N; a.dup_sub = PROBE_DUP_SUB; a.knob = PROBE_KNOB;
    hipLaunchKernelGGL(mega, dim3(grid), dim3(NWAVES * 64), LDS_BYTES, stream, a);
}
```

```cpp
#include <hip/hip_runtime.h>
#include <cstdint>
#include <cstdio>

typedef unsigned short bf16_t;
constexpr int NB_ = 4, SEQ = 4096, CTX = 256, D = 1024, NPOS = SEQ + CTX, MROWS = NB_ * NPOS;
constexpr int PT = 1952, PP = 2048;
constexpr int NE = 32, TOPK = 4, LCAP = MROWS;
constexpr int NASG = MROWS * TOPK;
constexpr int ACT_ROWS = NASG + NE * 256;
constexpr int C_FN = 0, C_LX = 256, C_LG = 512, C_CQ = 768, C_CKV = 1024, C_KR = 1152, C_SX = 1184, C_SB = 1440, C_SC = 1696;

__device__ __forceinline__ float bf2f(bf16_t v) { return __uint_as_float((unsigned)v << 16); }
typedef float cv_f2 __attribute__((ext_vector_type(2))); typedef __bf16 cv_b2 __attribute__((ext_vector_type(2)));
__device__ __forceinline__ unsigned pk2(float lo, float hi) { cv_f2 v = {lo, hi}; return __builtin_bit_cast(unsigned, __builtin_convertvector(v, cv_b2)); }
__device__ __forceinline__ bf16_t f2bf(float f) { return (bf16_t)pk2(f, 0.f); }
__device__ __forceinline__ float wave_sum(float v) {
#pragma unroll
    for (int o = 1; o < 64; o <<= 1) v += __shfl_xor(v, o);
    return v;
}
__device__ __forceinline__ float sigmoidf_(float x) { return 1.f / (1.f + __expf(-x)); }
__device__ __forceinline__ float gelu_tanh(float x) { const float u = 0.7978845608028654f * (x + 0.044715f * x * x * x); return 0.5f * x * (1.f + tanhf(u)); }

#define LAS __attribute__((address_space(3)))
typedef short bf16x8 __attribute__((ext_vector_type(8)));
typedef float f32x4 __attribute__((ext_vector_type(4)));
typedef unsigned u32x4 __attribute__((ext_vector_type(4)));
typedef unsigned u32x2 __attribute__((ext_vector_type(2)));

namespace L {
constexpr size_t A256(size_t x) { return (x + 255) & ~(size_t)255; }
constexpr size_t CTL = 0, CTL_BYTES = 1u << 20;
constexpr size_t H = CTL + CTL_BYTES;
constexpr size_t MOD = CTL + 512 * 1024;
constexpr size_t TABC = A256(H + (size_t)MROWS * D * 4);
constexpr size_t TABS = A256(TABC + 4096 * 4);
constexpr size_t XN = A256(TABS + 4096 * 4);
constexpr size_t P = A256(XN + (size_t)MROWS * D * 2);
constexpr size_t MIX = A256(P + (size_t)MROWS * PP * 2);
constexpr size_t CQN = A256(MIX + (size_t)MROWS * D * 2);
constexpr size_t CKVN = A256(CQN + (size_t)MROWS * 256 * 2);
constexpr size_t QRAW = A256(CKVN + (size_t)MROWS * 128 * 2);
constexpr size_t KVRAW = A256(QRAW + (size_t)MROWS * 384 * 4);
constexpr size_t QL = A256(KVRAW + (size_t)MROWS * 512 * 4);
constexpr size_t QC = A256(QL + (size_t)16 * SEQ * 96 * 2);
constexpr size_t KB = A256(QC + (size_t)16 * CTX * 96 * 2);
constexpr size_t VB = A256(KB + (size_t)16 * NPOS * 96 * 2);
constexpr size_t LA = A256(VB + (size_t)16 * NPOS * 64 * 2);
constexpr size_t LB = A256(LA + (size_t)2 * MROWS * 256 * 4);
constexpr size_t HS = A256(LB + (size_t)2 * MROWS * 256 * 4);
constexpr size_t XCS = A256(HS + (size_t)2 * MROWS * 256 * 4);
constexpr size_t XCSC = A256(XCS + (size_t)4 * 8192 * 256 * 4);
constexpr size_t LIST = A256(XCSC + (size_t)4 * 512 * 256 * 4);
constexpr size_t GATE = A256(LIST + (size_t)2 * NE * LCAP * 4);
constexpr size_t ACT = A256(GATE + (size_t)NASG * 4);
constexpr size_t Y = A256(ACT + (size_t)ACT_ROWS * D * 2);
constexpr size_t WINT = A256(Y + (size_t)(NASG + 1) * D * 2);
constexpr size_t WOUTT = A256(WINT + (size_t)2 * 2048 * 1024 * 2);
constexpr size_t WGUT = A256(WOUTT + (size_t)2 * 1024 * 1024 * 2);
constexpr size_t WDT = A256(WGUT + (size_t)2 * NE * 2048 * 1024 * 2);
constexpr size_t ZBUF = A256(WDT + (size_t)2 * NE * 1024 * 1024 * 2);
constexpr size_t VTG = A256(ZBUF + (size_t)4 * 64 * 64 * 512 * 2);
constexpr size_t WUQT = A256(VTG + (size_t)16 * 64 * NPOS * 2);
constexpr size_t WUKVT = A256(WUQT + (size_t)2 * 384 * 256 * 2);
constexpr size_t WAT = A256(WUKVT + (size_t)2 * 512 * 128 * 2);
constexpr size_t WIT = A256(WAT + (size_t)16 * 4096 * 2);
constexpr size_t SPT = A256(WIT + (size_t)16 * 4096 * 2);
constexpr size_t RWH = A256(SPT + (size_t)1024 * 4);
constexpr size_t RWL = A256(RWH + (size_t)2 * NE * D * 2);
constexpr size_t HL = A256(RWL + (size_t)2 * NE * D * 2);
constexpr size_t AC = A256(HL + (size_t)2 * MROWS * 256 * 2);
constexpr size_t SUM = A256(AC + (size_t)2 * MROWS * 256 * 2);
constexpr size_t XCT = A256(SUM + (size_t)2 * 4 * 68 * 512 * 4);
constexpr size_t END = A256(XCT + (size_t)16 * 512 * 64 * 2);
constexpr int CW_BAR = 4096;
constexpr int CW_MODCNT = 2048;
constexpr int CW_CNT = 32768, CNT_STRIDE = 64;
}

#define XB_TMO      128
#define XB_XCNT(j)  (256  + 64 * (j))
#define XB_XSUB(j)  (1280 + 64 * (j))
#define XB_XGEN(j)  (2304 + 64 * (j))
#define XB_TOP      3328
#define XB_TOPGEN   3392
#define XCD_BAR_WORDS 3456
#define XB_SPIN_CAP (1u << 18)
__device__ __forceinline__ unsigned xb_ld(unsigned* p)              { return __hip_atomic_load(p, __ATOMIC_RELAXED, __HIP_MEMORY_SCOPE_AGENT); }
__device__ __forceinline__ unsigned xb_add(unsigned* p, unsigned v) { return __hip_atomic_fetch_add(p, v, __ATOMIC_RELAXED, __HIP_MEMORY_SCOPE_AGENT); }
__device__ __forceinline__ unsigned xb_xcc_id() { return (unsigned)__builtin_amdgcn_s_getreg((3 << 11) | 20) & 0xFu; }
#define XB_SPIN(cond, bar) do { unsigned _sp = 0; while (cond) { __builtin_amdgcn_s_sleep(1); \
    if ((++_sp & 255u) == 0u) { if (xb_ld(&(bar)[XB_TMO])) break; if (_sp > XB_SPIN_CAP) { atomicAdd(&(bar)[XB_TMO], 1u); break; } } } } while (0)
struct XcdBarrier { unsigned* bar; unsigned x; volatile LAS unsigned* st; };
__device__ __forceinline__ XcdBarrier xcd_barrier_post(unsigned* bar, volatile LAS unsigned* st) {
    XcdBarrier b; b.bar = bar; b.x = xb_xcc_id(); b.st = st;
    if (threadIdx.x == 0) (void)xb_add(&bar[XB_XCNT(b.x)], 1u);
    return b;
}
__device__ __forceinline__ void xcd_barrier_complete(unsigned* bar, unsigned x, unsigned& nloc, unsigned& nx) {
    const unsigned G = gridDim.x * gridDim.y * gridDim.z;
    unsigned sum, cnt, mine, sp = 0u;
    for (;;) {
        sum = 0u; cnt = 0u; mine = 0u;
#pragma unroll
        for (unsigned j = 0; j < 16; ++j) { const unsigned c = xb_ld(&bar[XB_XCNT(j)]); sum += c; cnt += (c > 0u) ? 1u : 0u; mine = (j == x) ? c : mine; }
        if (sum == G) break;
        __builtin_amdgcn_s_sleep(1);
        if ((++sp & 255u) == 0u) { if (xb_ld(&bar[XB_TMO])) break; if (sp > XB_SPIN_CAP) { atomicAdd(&bar[XB_TMO], 1u); break; } }
    }
    nloc = mine > 0u ? mine : 1u; nx = cnt > 0u ? cnt : 1u;
}
__device__ __forceinline__ void xcd_barrier(const XcdBarrier& b) {
    asm volatile("s_waitcnt vmcnt(0)" ::: "memory");
    __syncthreads();
    if (threadIdx.x == 0) {
        unsigned* bar = b.bar;
        __builtin_amdgcn_s_waitcnt(0);
        unsigned nloc = b.st[0], nx = b.st[1];
        if (nloc == 0u) { xcd_barrier_complete(bar, b.x, nloc, nx); b.st[0] = nloc; b.st[1] = nx; }
        const unsigned old = xb_add(&bar[XB_XSUB(b.x)], 1u);
        const unsigned gen = old / nloc;
        if (old + 1u == (gen + 1u) * nloc) {
            __builtin_amdgcn_fence(__ATOMIC_RELEASE, "agent");
            asm volatile("s_waitcnt vmcnt(0)" ::: "memory");
            const unsigned og = xb_add(&bar[XB_TOP], 1u);
            const unsigned tg = og / nx;
            if (og + 1u == (tg + 1u) * nx) xb_add(&bar[XB_TOPGEN], 1u);
            else XB_SPIN(xb_ld(&bar[XB_TOPGEN]) == tg, bar);
            __builtin_amdgcn_fence(__ATOMIC_ACQUIRE, "agent");
            xb_add(&bar[XB_XGEN(b.x)], 1u);
            asm volatile("s_waitcnt vmcnt(0)" ::: "memory");
        } else {
            XB_SPIN(xb_ld(&bar[XB_XGEN(b.x)]) == gen, bar);
            __builtin_amdgcn_fence(__ATOMIC_ACQUIRE, "agent");
            asm volatile("s_waitcnt vmcnt(0)" ::: "memory");
        }
    }
    __syncthreads();
}

namespace g8 {
constexpr int BM = 256, BK = 64, HALF = 128, HTB = HALF * BK * 2, STAGE_BYTES = 8 * HTB, NXCD = 8, WGM = 8;
__device__ __forceinline__ int lds_byte(int r, int c) { const int st = (r >> 4) * 2 + (c >> 5), rr = r & 15, cc = c & 31, ob = rr * 64 + cc * 2; return st * 1024 + (ob ^ (((ob >> 9) & 1) << 5)); }
__device__ __forceinline__ void stage_rc(int b, int& R, int& C) { const int st = b / 1024, sb = b % 1024, swz = sb ^ (((sb >> 9) & 1) << 5); R = (st >> 1) * 16 + swz / 64; C = (st & 1) * 32 + (swz % 64) / 2; }
__device__ __forceinline__ int perm32(int rho) { const int n = rho >> 4, i = rho & 15; return 8 * (i >> 2) + 4 * n + (i & 3); }
__device__ __forceinline__ unsigned cvt_pk_bf16(float lo, float hi) { return pk2(lo, hi); }
__device__ __forceinline__ int xcd_remap(int wgid, int nwg) { const int q = nwg / NXCD, r = nwg % NXCD, xcd = wgid % NXCD, off = wgid / NXCD; return (xcd < r ? xcd * (q + 1) : r * (q + 1) + (xcd - r) * q) + off; }

struct Unit { int row0, col0, ex, bt, nvalid, lrow; };

struct DenseSched {
    int nM, nN, nwg, G, c, lat_only; const char* Bt; int K; const int* list;
    __device__ __forceinline__ void init(int nM_, int nN_, int G_, int c_, int lat_only_, const void* Bt_, int K_) { nM = nM_; nN = nN_; nwg = nM * nN; G = G_; c = c_; lat_only = lat_only_; Bt = (const char*)Bt_; K = K_; list = nullptr; }
    __device__ __forceinline__ bool next(int i, Unit& u) const {
        const long Lx = (long)i * G + c; if (Lx >= nwg) return false;
        const int wgid = xcd_remap((int)Lx, nwg);
        const int nig = WGM * nN, gid = wgid / nig, fm = gid * WGM, gsz = (nM - fm) < WGM ? (nM - fm) : WGM;
        const int pm = fm + ((wgid % nig) % gsz), pn = (wgid % nig) / gsz;
        const int tile = lat_only ? (pm / 16) * 17 + 1 + (pm % 16) : pm;
        u.row0 = tile * 256; u.col0 = pn * 256; u.ex = 0; u.bt = pn; u.nvalid = 256; u.lrow = 0; return true;
    }
    __device__ __forceinline__ const char* bptr(const Unit& u) const { return Bt + (size_t)u.bt * (256 * 1024 * 2); }
};
struct MoeSched {
    const LAS int* tpre; const LAS int* cnt; int NT, COLW, G, c, total; const char* Bt; int K; const int* list;
    __device__ __forceinline__ bool next(int i, Unit& u) const {
        const long Lx = (long)i * G + c; if (Lx >= total) return false;
        const int wgid = xcd_remap((int)Lx, total);
        int e = 0;
        for (int j = 1; j < NE; ++j) if (tpre[j] * NT <= wgid) e = j;
        const int t0 = tpre[e], mte = tpre[e + 1] - t0, loc = wgid - t0 * NT, nt = loc / mte, mt = loc % mte;
        u.ex = __builtin_amdgcn_readfirstlane(e); u.row0 = __builtin_amdgcn_readfirstlane((t0 + mt) * 256); u.col0 = __builtin_amdgcn_readfirstlane(nt * COLW);
        u.bt = __builtin_amdgcn_readfirstlane(e * NT + nt); const int nv = cnt[e] - mt * 256; u.nvalid = __builtin_amdgcn_readfirstlane(nv < 256 ? nv : 256); u.lrow = __builtin_amdgcn_readfirstlane(mt * 256);
        return true;
    }
    __device__ __forceinline__ const char* bptr(const Unit& u) const { return Bt + (size_t)u.bt * (256 * 1024 * 2); }
};

struct EpiP {
    static constexpr bool PERM = true; bf16_t* O;
    __device__ __forceinline__ void operator()(const f32x4 (&acc)[2][2][4][2], const Unit& u, int wr, int wc, int fr, int fq, const LAS int*) const {
#pragma unroll
        for (int ai = 0; ai < 2; ++ai)
#pragma unroll
            for (int m = 0; m < 4; ++m) { bf16_t* rowp = O + (size_t)(u.row0 + ai * HALF + wr * 64 + m * 16 + fr) * PP + u.col0 + wc * 32 + 8 * fq;
#pragma unroll
                for (int bj = 0; bj < 2; ++bj) { const f32x4 v0 = acc[ai][bj][m][0], v1 = acc[ai][bj][m][1]; u32x4 w; w.x = cvt_pk_bf16(v0[0], v0[1]); w.y = cvt_pk_bf16(v0[2], v0[3]); w.z = cvt_pk_bf16(v1[0], v1[1]); w.w = cvt_pk_bf16(v1[2], v1[3]);
                    *(u32x4*)(rowp + bj * HALF) = w; } }
    }
};
struct EpiH {
    static constexpr bool PERM = false; float* Hh; const float* MODl; int g_off;
    __device__ __forceinline__ void operator()(const f32x4 (&acc)[2][2][4][2], const Unit& u, int wr, int wc, int fr, int fq, const LAS int*) const {
        const int tile = u.row0 >> 8, v = (tile % 17 == 0) ? 4 : tile / 17; const float* gp = MODl + (size_t)v * 6144 + g_off + u.col0 + wc * 32 + 4 * fq;
        f32x4 gv[2][2];
#pragma unroll
        for (int bj = 0; bj < 2; ++bj)
#pragma unroll
            for (int n = 0; n < 2; ++n) gv[bj][n] = *(const f32x4*)(gp + bj * HALF + n * 16);
#pragma unroll
        for (int ai = 0; ai < 2; ++ai)
#pragma unroll
          for (int mp = 0; mp < 2; ++mp) {
            f32x4 hv[2][2][2];
#pragma unroll
            for (int m2 = 0; m2 < 2; ++m2) { const float* rowp = Hh + (size_t)(u.row0 + ai * HALF + wr * 64 + (2 * mp + m2) * 16 + fr) * D + u.col0 + wc * 32 + 4 * fq;
#pragma unroll
                for (int bj = 0; bj < 2; ++bj)
#pragma unroll
                    for (int n = 0; n < 2; ++n) hv[m2][bj][n] = *(const f32x4*)(rowp + bj * HALF + n * 16); }
#pragma unroll
            for (int m2 = 0; m2 < 2; ++m2) { float* rowp = Hh + (size_t)(u.row0 + ai * HALF + wr * 64 + (2 * mp + m2) * 16 + fr) * D + u.col0 + wc * 32 + 4 * fq;
#pragma unroll
                for (int bj = 0; bj < 2; ++bj)
#pragma unroll
                    for (int n = 0; n < 2; ++n) *(f32x4*)(rowp + bj * HALF + n * 16) = hv[m2][bj][n] + gv[bj][n] * acc[ai][bj][2 * mp + m2][n]; }
          }
    }
};
struct EpiMoe1 {
    static constexpr bool PERM = true; bf16_t* ACTp; const float* bgu;
    __device__ __forceinline__ void operator()(const f32x4 (&acc)[2][2][4][2], const Unit& u, int wr, int wc, int fr, int fq, const LAS int*) const {
        const int cc = u.col0 + wc * 32 + 8 * fq; const float* bp = bgu + (size_t)u.ex * 2048 + cc;
        f32x4 bg[2], bu[2];
#pragma unroll
        for (int n = 0; n < 2; ++n) { bg[n] = *(const f32x4*)(bp + 4 * n); bu[n] = *(const f32x4*)(bp + 1024 + 4 * n); }
#pragma unroll
        for (int ai = 0; ai < 2; ++ai)
#pragma unroll
            for (int m = 0; m < 4; ++m) { const int r = ai * HALF + wr * 64 + m * 16 + fr;
                float o[8];
#pragma unroll
                for (int n = 0; n < 2; ++n)
#pragma unroll
                    for (int i = 0; i < 4; ++i) { const float g = fminf(acc[ai][0][m][n][i] + bg[n][i], 7.f); const float uu = fminf(fmaxf(acc[ai][1][m][n][i] + bu[n][i], -7.f), 7.f);
                        o[n * 4 + i] = (uu + 1.f) * g * __builtin_amdgcn_rcpf(1.f + __expf(-1.702f * g)); }
                { u32x4 w; w.x = cvt_pk_bf16(o[0], o[1]); w.y = cvt_pk_bf16(o[2], o[3]); w.z = cvt_pk_bf16(o[4], o[5]); w.w = cvt_pk_bf16(o[6], o[7]);
                    *(u32x4*)(ACTp + (size_t)(u.row0 + r) * D + cc) = w; } }
    }
};
struct EpiMoe2 {
    static constexpr bool PERM = true; bf16_t* Yp; const float* bd; const float* GATEp;
    __device__ __forceinline__ void operator()(const f32x4 (&acc)[2][2][4][2], const Unit& u, int wr, int wc, int fr, int fq, const LAS int* rows) const {
        const int cc = u.col0 + wc * 32 + 8 * fq; const float* bp = bd + (size_t)u.ex * 1024 + cc;
        f32x4 bv[2][2];
#pragma unroll
        for (int bj = 0; bj < 2; ++bj)
#pragma unroll
            for (int n = 0; n < 2; ++n) bv[bj][n] = *(const f32x4*)(bp + bj * HALF + 4 * n);
        int asgv[2][4]; float gtv[2][4];
#pragma unroll
        for (int ai = 0; ai < 2; ++ai)
#pragma unroll
            for (int m = 0; m < 4; ++m) { const int r = ai * HALF + wr * 64 + m * 16 + fr; const bool ok = r < u.nvalid; const int a = rows[ok ? r : 0]; asgv[ai][m] = ok ? a : NASG; gtv[ai][m] = GATEp[a]; }
#pragma unroll
        for (int ai = 0; ai < 2; ++ai)
#pragma unroll
            for (int m = 0; m < 4; ++m) { const float gt = gtv[ai][m]; bf16_t* rowp = Yp + (size_t)asgv[ai][m] * D + cc;
#pragma unroll
                for (int bj = 0; bj < 2; ++bj) { const f32x4 v0 = (acc[ai][bj][m][0] + bv[bj][0]) * gt, v1 = (acc[ai][bj][m][1] + bv[bj][1]) * gt;
                    u32x4 w; w.x = cvt_pk_bf16(v0[0], v0[1]); w.y = cvt_pk_bf16(v0[2], v0[3]); w.z = cvt_pk_bf16(v1[0], v1[1]); w.w = cvt_pk_bf16(v1[2], v1[3]); *(u32x4*)(rowp + bj * HALF) = w; } }
    }
};

template <class Epi, class Sched, bool GATHER, bool ROWLIST>
__device__ __forceinline__ void gemm_phase(LAS unsigned char* lds, const char* Abase, const Sched& S, const Epi& E) {
    constexpr int K = 1024;
    int tid_l = threadIdx.x; asm volatile("" : "+v"(tid_l));
    const int tid = tid_l, wid = __builtin_amdgcn_readfirstlane(tid >> 6), lane = tid & 63, wr = wid >> 2, wc = wid & 3, fr = lane & 15, fq = lane >> 4;
    constexpr int nt = K / BK; constexpr unsigned Kb = (unsigned)K * 2u;
    unsigned voffB[2];
#pragma unroll
    for (int i = 0; i < 2; ++i) { int R, C; stage_rc(tid * 16 + i * 8192, R, C); const int Rb = Epi::PERM ? ((R & ~31) + perm32(R & 31)) : R; voffB[i] = (unsigned)(Rb * K + C) * 2u; }
    constexpr size_t kstep = (size_t)(BK * 2), hstep = (size_t)HALF * K * 2;
    const unsigned ldsw = (unsigned)wid * 1024u;
    const int aoff = lds_byte(wr * 64 + fr, fq * 8), boff = lds_byte(wc * 32 + fr, fq * 8);
    LAS int* rowbuf = (LAS int*)(lds + STAGE_BYTES);
#define G8_SA(b, h) (((b) * 2 + (h)) * HTB)
#define G8_SB(b, h) ((4 + (b) * 2 + (h)) * HTB)
#define G8_STAGE_A(bufoff, kb, v) do { _Pragma("unroll") for (int _i = 0; _i < 2; ++_i) \
        __builtin_amdgcn_global_load_lds((const unsigned*)((kb) + (size_t)(v)[_i]), (LAS unsigned*)(lds + (bufoff) + ldsw + _i * 8192), 16, 0, 0); } while (0)
#define G8_STAGE_B(bufoff, gbase) do { _Pragma("unroll") for (int _i = 0; _i < 2; ++_i) \
        __builtin_amdgcn_global_load_lds((const unsigned*)((gbase) + voffB[_i]), (LAS unsigned*)(lds + (bufoff) + ldsw + _i * 8192), 16, 0, 0); } while (0)
#define G8_LDA(dst, b, h) do { _Pragma("unroll") for (int m = 0; m < 4; ++m) _Pragma("unroll") for (int k = 0; k < 2; ++k) dst[m][k] = *(const LAS bf16x8*)(lds + G8_SA(b, h) + aoff + m * 2048 + k * 1024); } while (0)
#define G8_LDB(dst, b, h) do { _Pragma("unroll") for (int n = 0; n < 2; ++n) _Pragma("unroll") for (int k = 0; k < 2; ++k) dst[n][k] = *(const LAS bf16x8*)(lds + G8_SB(b, h) + boff + n * 2048 + k * 1024); } while (0)
#define G8_MMA(ai, bj, At, Bt) do { __builtin_amdgcn_s_setprio(1); _Pragma("unroll") for (int m = 0; m < 4; ++m) _Pragma("unroll") for (int n = 0; n < 2; ++n) _Pragma("unroll") for (int k = 0; k < 2; ++k) \
        acc[ai][bj][m][n] = __builtin_amdgcn_mfma_f32_16x16x32_bf16(Bt[n][k], At[m][k], acc[ai][bj][m][n], 0, 0, 0); __builtin_amdgcn_s_setprio(0); } while (0)
#define G8_WAIT_V(n) asm volatile("s_waitcnt vmcnt(" #n ")" ::: "memory")
#define G8_WAIT_L(n) asm volatile("s_waitcnt lgkmcnt(" #n ")" ::: "memory")
#define G8_BAR __builtin_amdgcn_s_barrier()
#define G8_SCHED __builtin_amdgcn_sched_barrier(0)
#define G8_LISTDMA(u, s) do { if (wid < 4) __builtin_amdgcn_global_load_lds((const unsigned*)(S.list + (size_t)(u).ex * LCAP + (u).lrow + wid * 64 + lane), (LAS unsigned*)(rowbuf + (s) * 256 + wid * 64), 4, 0, 0); } while (0)
#define G8_ROWS_DENSE(v) do { _Pragma("unroll") for (int _i = 0; _i < 2; ++_i) { int _R, _C; stage_rc(tid * 16 + _i * 8192, _R, _C); _Pragma("unroll") for (int _h = 0; _h < 2; ++_h) (v)[_h][_i] = (unsigned)(_h * HALF + _R) * Kb + (unsigned)_C * 2u; } } while (0)
#define G8_ROWS_LIST(v, u, s) do { _Pragma("unroll") for (int _i = 0; _i < 2; ++_i) { int _R, _C; stage_rc(tid * 16 + _i * 8192, _R, _C); _Pragma("unroll") for (int _h = 0; _h < 2; ++_h) { const int _r = _h * HALF + _R; const int _a = rowbuf[(s) * 256 + _r]; \
        (v)[_h][_i] = (unsigned)(_r < (u).nvalid ? (_a >> 2) : 0) * Kb + (unsigned)_C * 2u; } } } while (0)
    Unit cur, nxt; int ui = 0, slot = 0;
    if (!S.next(0, cur)) return;
    unsigned vA[2][2];
    if constexpr (ROWLIST) { G8_LISTDMA(cur, 0); G8_WAIT_V(0); G8_BAR; }
    if constexpr (GATHER) { G8_ROWS_LIST(vA, cur, 0); } else { G8_ROWS_DENSE(vA); }
    f32x4 acc[2][2][4][2];
#pragma unroll
    for (int a = 0; a < 2; ++a)
#pragma unroll
        for (int b = 0; b < 2; ++b)
#pragma unroll
            for (int m = 0; m < 4; ++m)
#pragma unroll
                for (int n = 0; n < 2; ++n) acc[a][b][m][n] = (f32x4){0.f, 0.f, 0.f, 0.f};
    bf16x8 At[4][2], B0[2][2], B1[2][2];
    const char* cB = S.bptr(cur);
    const char* cA = GATHER ? Abase : Abase + (size_t)cur.row0 * Kb;
    G8_STAGE_B(G8_SB(0, 0), cB); G8_STAGE_B(G8_SB(0, 1), cB + hstep); G8_STAGE_A(G8_SA(0, 0), cA, vA[0]); G8_STAGE_A(G8_SA(0, 1), cA, vA[1]);
    if (wr == 1) G8_BAR;
    G8_WAIT_V(2); G8_BAR;
    G8_STAGE_B(G8_SB(1, 0), cB + kstep); G8_STAGE_A(G8_SA(1, 0), cA + kstep, vA[0]); G8_STAGE_B(G8_SB(1, 1), cB + hstep + kstep);
    G8_WAIT_V(6); G8_BAR;
    for (;;) {
        const bool has_next = S.next(ui + 1, nxt);
        const char* nB = has_next ? S.bptr(nxt) : cB;
        const char* nA = (GATHER || !has_next) ? cA : Abase + (size_t)nxt.row0 * Kb;
        const int nslot = slot == 2 ? 0 : slot + 1;
        if constexpr (ROWLIST) { if (has_next) G8_LISTDMA(nxt, nslot); }
        for (int t = 0; t < nt; t += 2) {
            const bool last = (t == nt - 2);
            const char* a1 = cA + (size_t)(t + 1) * kstep;
            const char* a2 = last ? nA : cA + (size_t)(t + 2) * kstep; const char* b2 = last ? nB : cB + (size_t)(t + 2) * kstep;
            const char* a3 = a2 + kstep; const char* b3 = b2 + kstep;
            G8_LDB(B0, 0, 0); G8_LDB(B1, 0, 1); G8_SCHED; G8_LDA(At, 0, 0); G8_STAGE_A(G8_SA(1, 1), a1, vA[1]);
            if constexpr (GATHER) { if (last && has_next) { G8_ROWS_LIST(vA, nxt, nslot); } }
            G8_WAIT_V(8); G8_WAIT_L(0); G8_BAR; G8_MMA(0, 0, At, B0); G8_MMA(0, 1, At, B1); G8_BAR; G8_SCHED;
            G8_LDA(At, 0, 1); G8_STAGE_B(G8_SB(0, 0), b2); G8_STAGE_B(G8_SB(0, 1), b2 + hstep); G8_STAGE_A(G8_SA(0, 0), a2, vA[0]);
            G8_WAIT_V(8); G8_WAIT_L(0); G8_BAR; G8_MMA(1, 0, At, B0); G8_MMA(1, 1, At, B1); G8_BAR; G8_SCHED;
            G8_LDB(B0, 1, 0); G8_LDB(B1, 1, 1); G8_SCHED; G8_LDA(At, 1, 0); G8_STAGE_A(G8_SA(0, 1), a2, vA[1]);
            G8_WAIT_V(8); G8_WAIT_L(0); G8_BAR; G8_MMA(0, 0, At, B0); G8_MMA(0, 1, At, B1); G8_BAR; G8_SCHED;
            G8_LDA(At, 1, 1); G8_STAGE_B(G8_SB(1, 0), b3); G8_STAGE_B(G8_SB(1, 1), b3 + hstep); G8_STAGE_A(G8_SA(1, 0), a3, vA[0]);
            G8_WAIT_V(8); G8_WAIT_L(0); G8_BAR; G8_MMA(1, 0, At, B0); G8_MMA(1, 1, At, B1); G8_BAR; G8_SCHED;
        }
        if (wr == 0) G8_BAR;
        { int t2 = threadIdx.x; asm volatile("" : "+v"(t2));
          const int w2 = __builtin_amdgcn_readfirstlane(t2 >> 6); E(acc, cur, w2 >> 2, w2 & 3, t2 & 15, (t2 & 63) >> 4, rowbuf + slot * 256); }
        if (!has_next) break;
#pragma unroll
        for (int a = 0; a < 2; ++a)
#pragma unroll
            for (int b = 0; b < 2; ++b)
#pragma unroll
                for (int m = 0; m < 4; ++m)
#pragma unroll
                    for (int n = 0; n < 2; ++n) acc[a][b][m][n] = (f32x4){0.f, 0.f, 0.f, 0.f};
        cur = nxt; cB = nB; cA = nA; ++ui; slot = nslot;
        if (wr == 1) G8_BAR;
    }
    G8_WAIT_V(0);
    G8_BAR;
#undef G8_SA
#undef G8_SB
#undef G8_STAGE_A
#undef G8_STAGE_B
#undef G8_LDA
#undef G8_LDB
#undef G8_MMA
#undef G8_WAIT_V
#undef G8_WAIT_L
#undef G8_BAR
#undef G8_SCHED
#undef G8_LISTDMA
#undef G8_ROWS_DENSE
#undef G8_ROWS_LIST
}
}

namespace fft {
constexpr int TP = 72;
constexpr int UP = 264;
constexpr int ZP = 520;
constexpr int O_TC = 0, O_TS = 9216, O_U = 18432, O_X = 52224, O_TW = 125952;
__device__ __forceinline__ bf16x8 neg8(bf16x8 v) { u32x4 w = __builtin_bit_cast(u32x4, v); w = w ^ 0x80008000u; return __builtin_bit_cast(bf16x8, w); }
__device__ __forceinline__ void build_tables(LAS unsigned char* lds, const float* TABC, const float* TABS, int tid) {
    for (int i = tid; i < 4096; i += 512) { const int a = i >> 6, b = i & 63, ix = ((a * b) & 63) * 64;
        ((LAS bf16_t*)(lds + O_TC))[a * TP + b] = f2bf(TABC[ix]); ((LAS bf16_t*)(lds + O_TS))[a * TP + b] = f2bf(TABS[ix]); }
}
__device__ __forceinline__ void stage_a(LAS unsigned char* lds, const bf16_t* P, const float* TABC, const float* TABS, bf16_t* ZBUF, int u0, int u1, int ustep) {
    int tid_l = threadIdx.x; asm volatile("" : "+v"(tid_l));
    const int tid = tid_l, lane = tid & 63, w = __builtin_amdgcn_readfirstlane(tid >> 6), fr = lane & 15, fq = lane >> 4;
    build_tables(lds, TABC, TABS, tid);
    const LAS bf16_t* Tc = (const LAS bf16_t*)(lds + O_TC); const LAS bf16_t* Ts = (const LAS bf16_t*)(lds + O_TS);
    LAS bf16_t* U = (LAS bf16_t*)(lds + O_U); LAS bf16_t* X = (LAS bf16_t*)(lds + O_X); LAS float* TW = (LAS float*)(lds + O_TW);
    for (int unit = u0; unit < u1; unit += ustep) {
        const int b = unit >> 6, t2 = unit & 63;
#pragma unroll
        for (int i = 0; i < 4; ++i) { const int q = tid + 512 * i, t1 = q >> 5, ch = q & 31;
            *(LAS u32x4*)((LAS unsigned char*)U + t1 * (UP * 2) + ch * 16) = *(const u32x4*)(P + ((size_t)b * NPOS + CTX + 64 * t1 + t2) * PP + ch * 8); }
        if (tid < 64) { const int ix = tid * t2; TW[2 * tid] = TABC[ix]; TW[2 * tid + 1] = TABS[ix]; }
        __syncthreads();
        { const int g = w >> 1, part = w & 1; const LAS bf16_t* T = part ? Ts : Tc;
          f32x4 acc[4][4];
#pragma unroll
          for (int mt = 0; mt < 4; ++mt)
#pragma unroll
              for (int nt = 0; nt < 4; ++nt) acc[mt][nt] = (f32x4){0.f, 0.f, 0.f, 0.f};
#pragma unroll
          for (int ks = 0; ks < 2; ++ks) { bf16x8 a[4], bb[4];
#pragma unroll
              for (int mt = 0; mt < 4; ++mt) a[mt] = *(const LAS bf16x8*)(U + (16 * mt + fr) * UP + g * 64 + 32 * ks + 8 * fq);
#pragma unroll
              for (int nt = 0; nt < 4; ++nt) bb[nt] = *(const LAS bf16x8*)(T + (16 * nt + fr) * TP + 32 * ks + 8 * fq);
#pragma unroll
              for (int mt = 0; mt < 4; ++mt)
#pragma unroll
                  for (int nt = 0; nt < 4; ++nt) acc[mt][nt] = __builtin_amdgcn_mfma_f32_16x16x32_bf16(a[mt], bb[nt], acc[mt][nt], 0, 0, 0); }
          const float sg = part ? -1.f : 1.f;
#pragma unroll
          for (int mt = 0; mt < 4; ++mt)
#pragma unroll
              for (int nt = 0; nt < 4; ++nt) { const f32x4 v = acc[mt][nt] * sg; u32x2 o; o.x = pk2(v[0], v[1]); o.y = pk2(v[2], v[3]);
                  *(LAS u32x2*)(X + (part * 256 + g * 64 + 16 * nt + fr) * TP + 16 * mt + 4 * fq) = o; } }
        __syncthreads();
        f32x4 zr[4][2], zi[4][2];
#pragma unroll
        for (int mt = 0; mt < 4; ++mt)
#pragma unroll
            for (int n = 0; n < 2; ++n) { zr[mt][n] = (f32x4){0.f, 0.f, 0.f, 0.f}; zi[mt][n] = (f32x4){0.f, 0.f, 0.f, 0.f}; }
#pragma unroll
        for (int ks = 0; ks < 2; ++ks) { bf16x8 xr[2], xi[2];
#pragma unroll
            for (int n = 0; n < 2; ++n) { xr[n] = *(const LAS bf16x8*)(X + (32 * w + 16 * n + fr) * TP + 32 * ks + 8 * fq); xi[n] = *(const LAS bf16x8*)(X + (256 + 32 * w + 16 * n + fr) * TP + 32 * ks + 8 * fq); }
#pragma unroll
            for (int mt = 0; mt < 4; ++mt) { const bf16x8 c = *(const LAS bf16x8*)(Tc + (16 * mt + fr) * TP + 32 * ks + 8 * fq), s = *(const LAS bf16x8*)(Ts + (16 * mt + fr) * TP + 32 * ks + 8 * fq), ns = neg8(s);
#pragma unroll
                for (int n = 0; n < 2; ++n) { zr[mt][n] = __builtin_amdgcn_mfma_f32_16x16x32_bf16(c, xr[n], zr[mt][n], 0, 0, 0); zr[mt][n] = __builtin_amdgcn_mfma_f32_16x16x32_bf16(s, xi[n], zr[mt][n], 0, 0, 0);
                    zi[mt][n] = __builtin_amdgcn_mfma_f32_16x16x32_bf16(c, xi[n], zi[mt][n], 0, 0, 0); zi[mt][n] = __builtin_amdgcn_mfma_f32_16x16x32_bf16(ns, xr[n], zi[mt][n], 0, 0, 0); } } }
        __syncthreads();
        { LAS bf16_t* Zs = X;
#pragma unroll
          for (int mt = 0; mt < 4; ++mt)
#pragma unroll
              for (int i = 0; i < 4; ++i) { const int f1 = 16 * mt + 4 * fq + i; const float ct = TW[2 * f1], st = TW[2 * f1 + 1];
#pragma unroll
                  for (int n = 0; n < 2; ++n) { const float a = zr[mt][n][i], bq = zi[mt][n][i]; const int col = 32 * w + 16 * n + fr;
                      Zs[f1 * ZP + col] = f2bf(a * ct + bq * st); Zs[f1 * ZP + 256 + col] = f2bf(bq * ct - a * st); } } }
        __syncthreads();
#pragma unroll
        for (int i = 0; i < 8; ++i) { const int q = tid + 512 * i, f1 = q >> 6, ch = q & 63;
            *(u32x4*)(ZBUF + (((size_t)b * 64 + f1) * 64 + t2) * 512 + ch * 8) = *(const LAS u32x4*)((const LAS unsigned char*)X + f1 * (ZP * 2) + ch * 16); }
        __syncthreads();
    }
}
__device__ __forceinline__ void stage_b(LAS unsigned char* lds, const bf16_t* ZBUF, const float* TABC, const float* TABS, bf16_t* MIX, int G, int bx) {
    int tid_l = threadIdx.x; asm volatile("" : "+v"(tid_l));
    const int tid = tid_l, lane = tid & 63, w = __builtin_amdgcn_readfirstlane(tid >> 6), fr = lane & 15, fq = lane >> 4;
    build_tables(lds, TABC, TABS, tid);
    const LAS bf16_t* Tc = (const LAS bf16_t*)(lds + O_TC); const LAS bf16_t* Ts = (const LAS bf16_t*)(lds + O_TS);
    LAS bf16_t* Ys = (LAS bf16_t*)(lds + O_U); LAS bf16_t* ZT = (LAS bf16_t*)(lds + O_X);
    for (int unit = bx; unit < 256; unit += G) {
        const int b = unit >> 6, f1 = unit & 63;
        const bf16_t* Zg = ZBUF + ((size_t)b * 64 + f1) * 64 * 512;
#pragma unroll
        for (int i = 0; i < 4; ++i) { const int q = tid + 512 * i, p = q & 31, ch = q >> 5;
            const u32x4 r0 = *(const u32x4*)(Zg + (size_t)(2 * p) * 512 + ch * 8), r1 = *(const u32x4*)(Zg + (size_t)(2 * p + 1) * 512 + ch * 8);
#pragma unroll
            for (int j = 0; j < 4; ++j) { const unsigned a = r0[j], c = r1[j];
                *(LAS unsigned*)(ZT + (ch * 8 + 2 * j) * TP + 2 * p) = (a & 0xffffu) | (c << 16);
                *(LAS unsigned*)(ZT + (ch * 8 + 2 * j + 1) * TP + 2 * p) = (a >> 16) | (c & 0xffff0000u); } }
        __syncthreads();
        f32x4 y[4][2];
#pragma unroll
        for (int mt = 0; mt < 4; ++mt)
#pragma unroll
            for (int n = 0; n < 2; ++n) y[mt][n] = (f32x4){0.f, 0.f, 0.f, 0.f};
#pragma unroll
        for (int ks = 0; ks < 2; ++ks) { bf16x8 xr[2], xi[2];
#pragma unroll
            for (int n = 0; n < 2; ++n) { xr[n] = *(const LAS bf16x8*)(ZT + (32 * w + 16 * n + fr) * TP + 32 * ks + 8 * fq); xi[n] = *(const LAS bf16x8*)(ZT + (256 + 32 * w + 16 * n + fr) * TP + 32 * ks + 8 * fq); }
#pragma unroll
            for (int mt = 0; mt < 4; ++mt) { const bf16x8 c = *(const LAS bf16x8*)(Tc + (16 * mt + fr) * TP + 32 * ks + 8 * fq), s = *(const LAS bf16x8*)(Ts + (16 * mt + fr) * TP + 32 * ks + 8 * fq);
#pragma unroll
                for (int n = 0; n < 2; ++n) { y[mt][n] = __builtin_amdgcn_mfma_f32_16x16x32_bf16(c, xr[n], y[mt][n], 0, 0, 0); y[mt][n] = __builtin_amdgcn_mfma_f32_16x16x32_bf16(s, xi[n], y[mt][n], 0, 0, 0); } } }
#pragma unroll
        for (int mt = 0; mt < 4; ++mt)
#pragma unroll
            for (int i = 0; i < 4; ++i)
#pragma unroll
                for (int n = 0; n < 2; ++n) Ys[(16 * mt + 4 * fq + i) * UP + 32 * w + 16 * n + fr] = f2bf(y[mt][n][i] * (1.f / 512.f));
        __syncthreads();
#pragma unroll
        for (int i = 0; i < 4; ++i) { const int q = tid + 512 * i, f2 = q >> 5, ch = q & 31;
            *(u32x4*)(MIX + ((size_t)b * NPOS + CTX + f1 + 64 * f2) * D + ch * 8) = *(const LAS u32x4*)((const LAS unsigned char*)Ys + f2 * (UP * 2) + ch * 16); }
        __syncthreads();
    }
}
}

namespace cv {
constexpr int SCR_BYTES = 64 * 33 * 4;
struct Job { const float* wgu; const float* wdn; unsigned char* ws; unsigned n0, first0, first1, nv; };
__device__ __forceinline__ void decode(const Job& J, unsigned v, const float*& src, unsigned& N, bf16_t*& dst) {
    const unsigned l = v < J.n0 ? 0u : 1u, j = v < J.n0 ? J.first0 + v : J.first1 + (v - J.n0);
    if (j < 32768u) { const unsigned e = j >> 10, kb = (j >> 6) & 15u, n0 = 32u * (j & 63u), c2 = n0 & 1023u, drow = (c2 >> 7) * 256u + (n0 >> 10) * 128u + (c2 & 127u);
        src = J.wgu + ((size_t)(l * NE + e) << 21) + ((size_t)kb << 17) + n0; N = 2048u; dst = (bf16_t*)(J.ws + L::WGUT) + ((size_t)(l * NE + e) << 21) + ((size_t)drow << 10) + 64u * kb; }
    else { const unsigned r = j - 32768u, e = r >> 9, kb = (r >> 5) & 15u, nb = r & 31u;
        src = J.wdn + ((size_t)(l * NE + e) << 20) + ((size_t)kb << 16) + 32u * nb; N = 1024u; dst = (bf16_t*)(J.ws + L::WDT) + ((size_t)(l * NE + e) << 20) + ((size_t)nb << 15) + 64u * kb; }
}
__device__ __forceinline__ void issue_half(const float* src, unsigned N, int h, int lane, f32x4 (&v)[4]) {
    const unsigned kr = lane >> 3, nc = (lane & 7) * 4; const unsigned off = ((32u * h + kr) * N + nc) * 4u, step = 32u * N;
#pragma unroll
    for (int i = 0; i < 4; ++i) v[i] = __builtin_nontemporal_load((const f32x4*)((const char*)src + (off + i * step)));
}
__device__ __forceinline__ void park_half(LAS float* scr, int h, int lane, const f32x4 (&v)[4]) {
    const int kr = lane >> 3, nc = (lane & 7) * 4;
#pragma unroll
    for (int i = 0; i < 4; ++i) { LAS float* p = scr + (32 * h + kr + 8 * i) * 33 + nc; p[0] = v[i][0]; p[1] = v[i][1]; p[2] = v[i][2]; p[3] = v[i][3]; }
}
__device__ __forceinline__ void finish(bf16_t* dst, const LAS float* scr, int lane) {
    asm volatile("s_waitcnt lgkmcnt(0)" ::: "memory");
    const int c = lane & 7; const unsigned off = ((unsigned)(lane >> 3) * D + 8u * c) * 2u;
#pragma unroll
    for (int j = 0; j < 4; ++j) { const LAS float* s = scr + (8 * c) * 33 + (lane >> 3) + 8 * j;
        u32x4 o; o.x = pk2(s[0 * 33], s[1 * 33]); o.y = pk2(s[2 * 33], s[3 * 33]); o.z = pk2(s[4 * 33], s[5 * 33]); o.w = pk2(s[6 * 33], s[7 * 33]);
        __builtin_nontemporal_store(o, (u32x4*)((char*)dst + (off + j * (8u * D * 2u)))); }
    asm volatile("s_waitcnt lgkmcnt(0)" ::: "memory");
}
}

namespace attn {
typedef float f32x16 __attribute__((ext_vector_type(16)));
typedef float f32x2_t __attribute__((ext_vector_type(2))); typedef __bf16 bf16x2_t __attribute__((ext_vector_type(2)));
__device__ __forceinline__ unsigned cvtpk(float lo, float hi) { f32x2_t v = {lo, hi}; bf16x2_t b = __builtin_convertvector(v, bf16x2_t); return __builtin_bit_cast(unsigned, b); }
constexpr int KP = 104, VP = 68;
constexpr int KT_BYTES = 64 * KP * 2, VT_BYTES = 64 * VP * 2, BUF_BYTES = KT_BYTES + VT_BYTES;
constexpr float THR = 8.f; constexpr int NWAVES_ATT = 8;
__device__ __forceinline__ void attn_phase(LAS unsigned char* lds, const bf16_t* QL, const bf16_t* QC, const bf16_t* KB, const bf16_t* VTG, bf16_t* MIX, int with_ctx, int G, int vcu, const cv::Job& J, bool cv_on) {
    const int nunits = 256 + (with_ctx ? 16 : 0);
    for (int unit = vcu; unit < nunits; unit += G) {
        int tid_l = threadIdx.x; asm volatile("" : "+v"(tid_l));
        const int tid = tid_l, lane = tid & 63, wid = __builtin_amdgcn_readfirstlane(tid >> 6), r32 = lane & 31, hi = lane >> 5;
        int bh, nk, orow0; const bf16_t* Qp;
        if (unit < 256) { bh = unit >> 4; const int qb = unit & 15; Qp = QL + ((size_t)bh * SEQ + qb * 256) * 96; nk = NPOS; orow0 = (bh >> 2) * NPOS + CTX + qb * 256; }
        else { bh = unit - 256; Qp = QC + (size_t)bh * CTX * 96; nk = CTX; orow0 = (bh >> 2) * NPOS; }
        const int hh = bh & 3, NT = nk / 64;
        const bf16_t* Kg = KB + (size_t)bh * NPOS * 96; const bf16_t* Vg = VTG + (size_t)bh * 64 * NPOS;
        bf16x8 qf[6];
        { const bf16_t* qp = Qp + (size_t)(wid * 32 + r32) * 96 + 8 * hi;
#pragma unroll
          for (int ds = 0; ds < 6; ++ds) qf[ds] = *(const bf16x8*)(qp + 16 * ds); }
        f32x16 o0 = {}, o1 = {}, negm = {}; float mhat = 0.f, l = 0.f;
        const int kr0 = tid / 12, kc0 = tid % 12, kr1 = (tid + 512) / 12, kc1 = (tid + 512) % 12; const bool k1ok = tid < 256;
        const int vd = tid >> 3, vc = tid & 7;
        u32x4 sk0, sk1 = {}, sv;
#define AT_LOAD(t_) do { const size_t k0_ = (size_t)(t_) * 64; sk0 = *(const u32x4*)(Kg + (k0_ + kr0) * 96 + kc0 * 8); if (k1ok) sk1 = *(const u32x4*)(Kg + (k0_ + kr1) * 96 + kc1 * 8); sv = *(const u32x4*)(Vg + (size_t)vd * NPOS + k0_ + vc * 8); } while (0)
#define AT_STORE(slot_) do { LAS unsigned char* bp_ = lds + (slot_) * BUF_BYTES; *(LAS u32x4*)(bp_ + kr0 * (KP * 2) + kc0 * 16) = sk0; if (k1ok) *(LAS u32x4*)(bp_ + kr1 * (KP * 2) + kc1 * 16) = sk1; *(LAS u32x4*)(bp_ + KT_BYTES + vd * (VP * 2) + vc * 16) = sv; } while (0)
#define AT_QK(P0, P1, slot_) do { const LAS bf16_t* Kt_ = (const LAS bf16_t*)(lds + (slot_) * BUF_BYTES); \
        _Pragma("unroll") for (int ds = 0; ds < 6; ++ds) { const bf16x8 k0f = *(const LAS bf16x8*)(Kt_ + r32 * KP + 16 * ds + 8 * hi), k1f = *(const LAS bf16x8*)(Kt_ + (32 + r32) * KP + 16 * ds + 8 * hi); \
            if (ds == 0) { P0 = __builtin_amdgcn_mfma_f32_32x32x16_bf16(k0f, qf[0], negm, 0, 0, 0); P1 = __builtin_amdgcn_mfma_f32_32x32x16_bf16(k1f, qf[0], negm, 0, 0, 0); } \
            else { P0 = __builtin_amdgcn_mfma_f32_32x32x16_bf16(k0f, qf[ds], P0, 0, 0, 0); P1 = __builtin_amdgcn_mfma_f32_32x32x16_bf16(k1f, qf[ds], P1, 0, 0, 0); } } } while (0)
#define MX3(a_, b_, c_) __builtin_fmaxf(__builtin_fmaxf((a_), (b_)), (c_))
#define AT_STEP(C0, C1, N0, N1, t_) do { \
            if ((t_) + 1 < NT) AT_QK(N0, N1, s_nxt); \
            float mx_ = MX3(C0[0], C0[1], C1[0]), my_ = MX3(C0[2], C0[3], C1[1]); mx_ = MX3(mx_, C1[2], C1[3]); \
            _Pragma("unroll") for (int r = 4; r < 16; r += 4) { mx_ = MX3(mx_, C0[r], C0[r + 1]); my_ = MX3(my_, C0[r + 2], C0[r + 3]); mx_ = MX3(mx_, C1[r], C1[r + 1]); my_ = MX3(my_, C1[r + 2], C1[r + 3]); } \
            mx_ = fmaxf(mx_, my_); mx_ = fmaxf(mx_, __shfl_xor(mx_, 32)); \
            if (__builtin_expect((t_) == 0 || __any(mx_ > THR), 0)) { const float dl = (t_) == 0 ? mx_ : fmaxf(mx_, 0.f), f = __builtin_amdgcn_exp2f(-dl); mhat += dl; l *= f; \
                _Pragma("unroll") for (int r = 0; r < 16; ++r) { C0[r] -= dl; C1[r] -= dl; o0[r] *= f; o1[r] *= f; negm[r] = -mhat; } \
                if ((t_) + 1 < NT) { _Pragma("unroll") for (int r = 0; r < 16; ++r) { N0[r] -= dl; N1[r] -= dl; } } } \
            float ls_ = 0.f; \
            _Pragma("unroll") for (int r = 0; r < 16; ++r) { C0[r] = __builtin_amdgcn_exp2f(C0[r]); C1[r] = __builtin_amdgcn_exp2f(C1[r]); ls_ += C0[r] + C1[r]; } \
            l += ls_; \
            const LAS bf16_t* Vt_ = (const LAS bf16_t*)(lds + s_cur * BUF_BYTES + KT_BYTES); \
            _Pragma("unroll") for (int q = 0; q < 4; ++q) { u32x4 pw_; \
                _Pragma("unroll") for (int j = 0; j < 4; ++j) { const int r = 8 * (q & 1) + 2 * j; pw_[j] = (q < 2) ? cvtpk(C0[r], C0[r + 1]) : cvtpk(C1[r], C1[r + 1]); } \
                const bf16x8 pf_ = __builtin_bit_cast(bf16x8, pw_); const int kvb = 32 * (q >> 1) + 16 * (q & 1) + 4 * hi; \
                _Pragma("unroll") for (int db = 0; db < 2; ++db) { const u32x2 va = *(const LAS u32x2*)(Vt_ + (32 * db + r32) * VP + kvb), vb = *(const LAS u32x2*)(Vt_ + (32 * db + r32) * VP + kvb + 8); \
                    const u32x4 vw = {va.x, va.y, vb.x, vb.y}; const bf16x8 vf = __builtin_bit_cast(bf16x8, vw); \
                    if (db == 0) o0 = __builtin_amdgcn_mfma_f32_32x32x16_bf16(vf, pf_, o0, 0, 0, 0); else o1 = __builtin_amdgcn_mfma_f32_32x32x16_bf16(vf, pf_, o1, 0, 0, 0); } } \
            if ((t_) + 2 < NT) AT_STORE(s_ld); \
            __syncthreads(); \
            { const int tmp_ = s_cur; s_cur = s_nxt; s_nxt = s_ld; s_ld = tmp_; } } while (0)
        AT_LOAD(0); AT_STORE(0);
        if (NT > 1) { AT_LOAD(1); AT_STORE(1); }
        __syncthreads();
        f32x16 pA0, pA1, pB0, pB1;
        AT_QK(pA0, pA1, 0);
        int s_cur = 0, s_nxt = 1, s_ld = 2;
        unsigned cvv = (cv_on && unit < 256) ? (unsigned)(vcu * NWAVES_ATT + wid) : J.nv;
        int cvh = 0; bool cv_pend = false;
        const float* csrc = J.wgu; unsigned cN = 2048u; bf16_t* cdst = (bf16_t*)(J.ws + L::WGUT);
        f32x4 cvr[4];
#pragma unroll
        for (int i = 0; i < 4; ++i) cvr[i] = (f32x4){0.f, 0.f, 0.f, 0.f};
        LAS float* cscr = (LAS float*)(lds + 3 * BUF_BYTES + wid * cv::SCR_BYTES);
        for (int t = 0; t < NT; t += 2) {
            if (cv_pend) { cv::park_half(cscr, cvh, lane, cvr); if (cvh) { cv::finish(cdst, cscr, lane); cvv += 256 * NWAVES_ATT; } cvh ^= 1; }
            if (t + 2 < NT) AT_LOAD(t + 2);
            cv_pend = cvv < J.nv && (cvh == 1 || t + 2 < NT);
            if (cv_pend && cvh == 0) cv::decode(J, cvv, csrc, cN, cdst);
            cv::issue_half(csrc, cN, cvh, lane, cvr);
            AT_STEP(pA0, pA1, pB0, pB1, t);
            if (t + 3 < NT) AT_LOAD(t + 3);
            AT_STEP(pB0, pB1, pA0, pA1, t + 1);
        }
        if (cv_pend) { cv::park_half(cscr, cvh, lane, cvr); if (cvh) cv::finish(cdst, cscr, lane); }
#undef AT_LOAD
#undef AT_STORE
#undef AT_QK
#undef AT_STEP
#undef MX3
        l += __shfl_xor(l, 32);
        const float il = 1.f / l;
        bf16_t* op = MIX + (size_t)(orow0 + wid * 32 + r32) * D + 512 + hh * 64 + 4 * hi;
#pragma unroll
        for (int g4 = 0; g4 < 4; ++g4) { u32x2 w0, w1; w0.x = cvtpk(o0[4 * g4] * il, o0[4 * g4 + 1] * il); w0.y = cvtpk(o0[4 * g4 + 2] * il, o0[4 * g4 + 3] * il);
            w1.x = cvtpk(o1[4 * g4] * il, o1[4 * g4 + 1] * il); w1.y = cvtpk(o1[4 * g4 + 2] * il, o1[4 * g4 + 3] * il);
            *(u32x2*)(op + 8 * g4) = w0; *(u32x2*)(op + 32 + 8 * g4) = w1; }
    }
}
}

namespace sm {
__device__ __forceinline__ float silu(float x) { return x / (1.f + __expf(-x)); }
__device__ __forceinline__ void mod_phase(LAS unsigned char* lds, const float* c, const float* c_ctx, const float* mod_w, const float* mod_b, float* MOD, int G, int bx, int tid) {
    LAS float* s = (LAS float*)lds;
    for (int i = tid; i < 5120; i += 512) { const int v = i >> 10, k = i & 1023; s[i] = silu(v < 4 ? c[v * 1024 + k] : c_ctx[k]); }
    __syncthreads();
    LAS float* red = s + 5120;
    for (int unit = bx; unit < 96; unit += G) {
        const int l = unit / 48, cb = unit % 48, cl = tid & 127, col = cb * 128 + cl, kq = tid >> 7, k0 = kq * 256;
        const float* W = mod_w + ((size_t)l * 1024 + k0) * 6144 + col;
        float a0 = 0.f, a1 = 0.f, a2 = 0.f, a3 = 0.f, a4 = 0.f;
#pragma unroll 16
        for (int k = 0; k < 256; ++k) { const float w = W[(size_t)k * 6144]; a0 += s[k0 + k] * w; a1 += s[1024 + k0 + k] * w; a2 += s[2048 + k0 + k] * w; a3 += s[3072 + k0 + k] * w; a4 += s[4096 + k0 + k] * w; }
        LAS float* rq = red + kq * 640 + cl; rq[0] = a0; rq[128] = a1; rq[256] = a2; rq[384] = a3; rq[512] = a4;
        __syncthreads();
        for (int i = tid; i < 640; i += 512) { const int v = i >> 7, cc = i & 127; const float r = ((red[i] + red[640 + i]) + (red[1280 + i] + red[1920 + i])) + mod_b[l * 6144 + cb * 128 + cc];
            MOD[((size_t)l * 5 + v) * 6144 + cb * 128 + cc] = r; }
        __syncthreads();
    }
}
__device__ __forceinline__ void norm_store(const float4 (&x)[4], float ss, const float* g, const float* mv, int sh_off, int sc_off, bf16_t* xn_row, int lane) {
    const float rs = rsqrtf(wave_sum(ss) * (1.f / D) + 1e-6f);
#pragma unroll
    for (int j = 0; j < 4; ++j) { const int c = (j * 64 + lane) * 4; const float4 gg = *(const float4*)(g + c), sh = *(const float4*)(mv + sh_off + c), sc = *(const float4*)(mv + sc_off + c);
        u32x2 o; o.x = pk2(x[j].x * rs * gg.x * (1.f + sc.x) + sh.x, x[j].y * rs * gg.y * (1.f + sc.y) + sh.y); o.y = pk2(x[j].z * rs * gg.z * (1.f + sc.z) + sh.z, x[j].w * rs * gg.w * (1.f + sc.w) + sh.w);
        *(u32x2*)(xn_row + c) = o; }
}
__device__ __forceinline__ void pro1_phase(const float* x, const float* ctx, const float* g, const float* MODl, float* H, bf16_t* XN, int r_first, int r_end, int r_step, int lane) {
    for (int r = r_first; r < r_end; r += r_step) { const int b = r / NPOS, pos = r % NPOS, v = pos < CTX ? 4 : b;
        const float* src = pos < CTX ? ctx + ((size_t)b * CTX + pos) * D : x + ((size_t)b * SEQ + (pos - CTX)) * D;
        float4 xv[4]; float ss = 0.f;
#pragma unroll
        for (int j = 0; j < 4; ++j) { const int c = (j * 64 + lane) * 4; xv[j] = *(const float4*)(src + c); ss += xv[j].x * xv[j].x + xv[j].y * xv[j].y + xv[j].z * xv[j].z + xv[j].w * xv[j].w; }
#pragma unroll
        for (int j = 0; j < 4; ++j) *(float4*)(H + (size_t)r * D + (j * 64 + lane) * 4) = xv[j];
        norm_store(xv, ss, g, MODl + (size_t)v * 6144, 0, 1024, XN + (size_t)r * D, lane); }
}
__device__ __forceinline__ void comb_phase(int l, float* H, const bf16_t* Y, const float* MODl, const float* g_next, const float* MODn, bf16_t* XN, const float* final_g, float* out, int gw, int NGW, int lane) {
    for (int r = gw; r < MROWS; r += NGW) { const int b = r / NPOS, pos = r % NPOS, v = pos < CTX ? 4 : b;
        if (l == 1 && pos < CTX) continue;
        const float* g2 = MODl + (size_t)v * 6144 + 5120;
        float4 xv[4]; float ss = 0.f;
#pragma unroll
        for (int j = 0; j < 4; ++j) { const int c = (j * 64 + lane) * 4; xv[j] = *(const float4*)(H + (size_t)r * D + c); float4 s = make_float4(0.f, 0.f, 0.f, 0.f);
#pragma unroll
            for (int k = 0; k < 4; ++k) { const u32x2 y = *(const u32x2*)(Y + ((size_t)r * 4 + k) * D + c); s.x += __uint_as_float(y.x << 16); s.y += __uint_as_float(y.x & 0xffff0000u); s.z += __uint_as_float(y.y << 16); s.w += __uint_as_float(y.y & 0xffff0000u); }
            const float4 gg = *(const float4*)(g2 + c); xv[j].x += gg.x * s.x; xv[j].y += gg.y * s.y; xv[j].z += gg.z * s.z; xv[j].w += gg.w * s.w;
            ss += xv[j].x * xv[j].x + xv[j].y * xv[j].y + xv[j].z * xv[j].z + xv[j].w * xv[j].w; }
        if (l == 0) {
#pragma unroll
            for (int j = 0; j < 4; ++j) *(float4*)(H + (size_t)r * D + (j * 64 + lane) * 4) = xv[j];
            norm_store(xv, ss, g_next, MODn + (size_t)v * 6144, 0, 1024, XN + (size_t)r * D, lane);
        } else { const float rs = rsqrtf(wave_sum(ss) * (1.f / D) + 1e-6f); float* op = out + ((size_t)b * SEQ + (pos - CTX)) * D;
#pragma unroll
            for (int j = 0; j < 4; ++j) { const int c = (j * 64 + lane) * 4; const float4 fg = *(const float4*)(final_g + c); float4 o; o.x = xv[j].x * rs * fg.x; o.y = xv[j].y * rs * fg.y; o.z = xv[j].z * rs * fg.z; o.w = xv[j].w * rs * fg.w; *(float4*)(op + c) = o; } }
    }
}
__device__ __forceinline__ void route_phase(LAS unsigned char* lds, int l, const float* H, const float* g, const float* MODl, const bf16_t* RWH, const bf16_t* RWL, const float* rb, bf16_t* XN, int* CNT, int* LIST, float* GATE,
                                            int G, int bx, int tid) {
    const int lane = tid & 63, wave = __builtin_amdgcn_readfirstlane(tid >> 6), fr = lane & 15, fq = lane >> 4;
    constexpr int FP = 1032;
    LAS bf16_t* FH = (LAS bf16_t*)lds; LAS bf16_t* FL = FH + 16 * FP;
    LAS float* PART = (LAS float*)(lds + 66048);
    LAS int* LCNT = (LAS int*)(lds + 66048 + 16384);
    LAS int* LBASE = LCNT + 64; LAS int* LENT = LCNT + 128;
    if (tid < 64) LCNT[tid] = 0;
    bf16x8 wh[2][4], wl[2][4];
#pragma unroll
    for (int nt = 0; nt < 2; ++nt)
#pragma unroll
        for (int ks = 0; ks < 4; ++ks) { const size_t o = ((size_t)l * NE + 16 * nt + fr) * D + 128 * wave + 32 * ks + 8 * fq; wh[nt][ks] = *(const bf16x8*)(RWH + o); wl[nt][ks] = *(const bf16x8*)(RWL + o); }
    const float bias = rb[lane & 31];
    __syncthreads();
    const int nb = l == 1 ? (MROWS - NB_ * CTX) / 16 : MROWS / 16;
    LAS float* LG = (LAS float*)(lds + 90112);
    LAS float* TOP = (LAS float*)(lds + 92160);
    float4 xv[2][4];
#define RT_ROW(q_) ((l == 1) ? ((q_) / SEQ) * NPOS + CTX + ((q_) % SEQ) : (q_))
#define RT_LOAD(bi_) do { _Pragma("unroll") for (int rr = 0; rr < 2; ++rr) { const int r_ = RT_ROW((bi_) * 16 + 2 * wave + rr); _Pragma("unroll") for (int j = 0; j < 4; ++j) xv[rr][j] = *(const float4*)(H + (size_t)r_ * D + (j * 64 + lane) * 4); } } while (0)
    if (bx < nb) RT_LOAD(bx);
    for (int bi = bx; bi < nb; bi += G) {
#pragma unroll
        for (int rr = 0; rr < 2; ++rr) { const int r = RT_ROW(bi * 16 + 2 * wave + rr);
            const int b = r / NPOS, pos = r % NPOS, v = pos < CTX ? 4 : b; const float* mv = MODl + (size_t)v * 6144;
            float ss = 0.f;
#pragma unroll
            for (int j = 0; j < 4; ++j) ss += xv[rr][j].x * xv[rr][j].x + xv[rr][j].y * xv[rr][j].y + xv[rr][j].z * xv[rr][j].z + xv[rr][j].w * xv[rr][j].w;
            const float rs = rsqrtf(wave_sum(ss) * (1.f / D) + 1e-6f);
#pragma unroll
            for (int j = 0; j < 4; ++j) { const int c = (j * 64 + lane) * 4; const float4 gg = *(const float4*)(g + c), sh = *(const float4*)(mv + 3072 + c), sc = *(const float4*)(mv + 4096 + c);
                float f[4]; f[0] = xv[rr][j].x * rs * gg.x * (1.f + sc.x) + sh.x; f[1] = xv[rr][j].y * rs * gg.y * (1.f + sc.y) + sh.y; f[2] = xv[rr][j].z * rs * gg.z * (1.f + sc.z) + sh.z; f[3] = xv[rr][j].w * rs * gg.w * (1.f + sc.w) + sh.w;
                u32x2 oh, ol; oh.x = pk2(f[0], f[1]); oh.y = pk2(f[2], f[3]);
                ol.x = pk2(f[0] - __uint_as_float(oh.x << 16), f[1] - __uint_as_float(oh.x & 0xffff0000u)); ol.y = pk2(f[2] - __uint_as_float(oh.y << 16), f[3] - __uint_as_float(oh.y & 0xffff0000u));
                *(u32x2*)(XN + (size_t)r * D + c) = oh; *(LAS u32x2*)(FH + (2 * wave + rr) * FP + c) = oh; *(LAS u32x2*)(FL + (2 * wave + rr) * FP + c) = ol; } }
        if (bi + G < nb) RT_LOAD(bi + G);
        __syncthreads();
        { f32x4 acc[2] = {(f32x4){0.f, 0.f, 0.f, 0.f}, (f32x4){0.f, 0.f, 0.f, 0.f}};
#pragma unroll
          for (int ks = 0; ks < 4; ++ks) { const bf16x8 ah = *(const LAS bf16x8*)(FH + fr * FP + 128 * wave + 32 * ks + 8 * fq), al = *(const LAS bf16x8*)(FL + fr * FP + 128 * wave + 32 * ks + 8 * fq);
#pragma unroll
              for (int nt = 0; nt < 2; ++nt) { acc[nt] = __builtin_amdgcn_mfma_f32_16x16x32_bf16(ah, wh[nt][ks], acc[nt], 0, 0, 0); acc[nt] = __builtin_amdgcn_mfma_f32_16x16x32_bf16(ah, wl[nt][ks], acc[nt], 0, 0, 0);
                  acc[nt] = __builtin_amdgcn_mfma_f32_16x16x32_bf16(al, wh[nt][ks], acc[nt], 0, 0, 0); } }
#pragma unroll
          for (int nt = 0; nt < 2; ++nt)
#pragma unroll
              for (int i = 0; i < 4; ++i) PART[(wave * 16 + 4 * fq + i) * 32 + 16 * nt + fr] = acc[nt][i]; }
        __syncthreads();
        { const int row = 2 * wave + (lane >> 5), e = lane & 31; const int r = RT_ROW(bi * 16 + row);
          float lg = bias;
#pragma unroll
          for (int kw = 0; kw < 8; ++kw) lg += PART[(kw * 16 + row) * 32 + e];
          LG[row * 32 + e] = lg;
          int rank = 0;
#pragma unroll
          for (int j4 = 0; j4 < 8; ++j4) { const f32x4 o = *(const LAS f32x4*)(LG + row * 32 + 4 * j4);
#pragma unroll
              for (int i = 0; i < 4; ++i) { const int j = 4 * j4 + i; rank += (o[i] > lg || (o[i] == lg && j < e)) ? 1 : 0; } }
          if (rank < 4) { TOP[(row * 4 + rank) * 2] = lg; TOP[(row * 4 + rank) * 2 + 1] = __int_as_float(e); }
          if (e == 0) { float tv[4]; int ti[4];
#pragma unroll
              for (int k = 0; k < 4; ++k) { tv[k] = TOP[(row * 4 + k) * 2]; ti[k] = __float_as_int(TOP[(row * 4 + k) * 2 + 1]); }
              float ex[4], sum = 0.f;
#pragma unroll
              for (int k = 0; k < 4; ++k) { ex[k] = __expf(tv[k] - tv[0]); sum += ex[k]; }
              const float isum = 1.f / sum;
#pragma unroll
              for (int k = 0; k < 4; ++k) { const int asg = r * 4 + k; GATE[asg] = ex[k] * isum; const int rk = __hip_atomic_fetch_add(&LCNT[ti[k]], 1, __ATOMIC_RELAXED, __HIP_MEMORY_SCOPE_WORKGROUP); const int slot = __hip_atomic_fetch_add(&LCNT[32], 1, __ATOMIC_RELAXED, __HIP_MEMORY_SCOPE_WORKGROUP);
                  LENT[slot * 2] = asg; LENT[slot * 2 + 1] = (ti[k] << 16) | rk; } } }
        __syncthreads();
    }
#undef RT_ROW
#undef RT_LOAD
    if (tid < 32) LBASE[tid] = LCNT[tid] > 0 ? atomicAdd(&CNT[tid * L::CNT_STRIDE], LCNT[tid]) : 0;
    __syncthreads();
    for (int i = tid; i < LCNT[32]; i += 512) { const int asg = LENT[i * 2], er = LENT[i * 2 + 1], ee = er >> 16, rank = er & 0xffff; LIST[(size_t)ee * LCAP + LBASE[ee] + rank] = asg; }
    __syncthreads();
}
__device__ __forceinline__ void smallw_phase(const float* w_uq, const float* qg, const float* w_ukv, const float* kvg, const float* w_a, const float* w_i, bf16_t* WUQT, bf16_t* WUKVT, bf16_t* WAT, bf16_t* WIT,
                                             float* TABC, float* TABS, const float* lam, float* SPT, const float* rw, bf16_t* RWHp, bf16_t* RWLp, int gt, int NGT) {
    for (int i = gt; i < 2 * 384 * 256; i += NGT) { const int l = i / (384 * 256), q = i % (384 * 256), n = q >> 8, k = q & 255; WUQT[i] = f2bf(qg[l * 256 + k] * w_uq[((size_t)l * 256 + k) * 384 + n]); }
    for (int i = gt; i < 2 * 512 * 128; i += NGT) { const int l = i / (512 * 128), q = i % (512 * 128), n = q >> 7, k = q & 127; WUKVT[i] = f2bf(kvg[l * 128 + k] * w_ukv[((size_t)l * 128 + k) * 512 + n]); }
    for (int i = gt; i < 16 * 4096; i += NGT) { const int m = i >> 12, q = i & 4095, e = q >> 6, d = q & 63; WAT[i] = f2bf(w_a[(size_t)m * 4096 + d * 64 + e]); WIT[i] = f2bf(w_i[(size_t)m * 4096 + d * 64 + e]); }
    for (int i = gt; i < 4096; i += NGT) { float s, c; sincospif((float)i / 2048.f, &s, &c); TABC[i] = c; TABS[i] = s; }
    for (int i = gt; i < 1024; i += NGT) SPT[i] = log1pf(__expf(-lam[i]));
    for (int i = gt; i < 2 * NE * D; i += NGT) { const int l = i / (NE * D), q = i % (NE * D), e = q >> 10, k = q & 1023; const float w = rw[((size_t)l * D + k) * NE + e]; const bf16_t h = f2bf(w); RWHp[i] = h; RWLp[i] = f2bf(w - bf2f(h)); }
}
}

namespace prep {
constexpr int O_KR = 0, O_CS = 8192, O_RS = 16384, O_CQ = 16896  , O_KS = 67072, O_CKV = 100864;
constexpr int CQP = 264, CKP = 136, QSP = 392, KSP = 264;
constexpr float C2 = 0.10206207261596577f * 1.4426950408889634f;
__device__ __forceinline__ void qkv_units(LAS unsigned char* lds, int l, const bf16_t* P, const bf16_t* WUQT, const bf16_t* WUKVT, const float* scw, const float* scb,
                                          bf16_t* QL, bf16_t* QC, bf16_t* KB, bf16_t* VTG, bf16_t* MIX, int u0, int u1, int ustep) {
    LAS float* KRo = (LAS float*)(lds + O_KR); LAS float* CS = (LAS float*)(lds + O_CS); LAS float* RS = (LAS float*)(lds + O_RS);
    LAS bf16_t* CQ = (LAS bf16_t*)(lds + O_CQ); LAS bf16_t* CK = (LAS bf16_t*)(lds + O_CKV); LAS bf16_t* KS = (LAS bf16_t*)(lds + O_KS); LAS bf16_t* QS = (LAS bf16_t*)(lds + O_CQ);
    for (int unit = u0; unit < u1; unit += ustep) {
        int tid_l = threadIdx.x; asm volatile("" : "+v"(tid_l));
        const int tid = tid_l, lane = tid & 63, w = __builtin_amdgcn_readfirstlane(tid >> 6), fr = lane & 15, fq = lane >> 4;
        const int b = unit / 68, chunk = unit % 68, pos0 = 64 * chunk; const bool ctxt = chunk < 4; const size_t r0 = (size_t)b * NPOS + pos0;
#pragma unroll
        for (int i = 0; i < 4; ++i) { const int q = tid + 512 * i, row = q >> 5, ch = q & 31; *(LAS u32x4*)((LAS unsigned char*)CQ + row * (CQP * 2) + ch * 16) = *(const u32x4*)(P + (r0 + row) * PP + C_CQ + ch * 8); }
#pragma unroll
        for (int i = 0; i < 2; ++i) { const int q = tid + 512 * i, row = q >> 4, ch = q & 15; *(LAS u32x4*)((LAS unsigned char*)CK + row * (CKP * 2) + ch * 16) = *(const u32x4*)(P + (r0 + row) * PP + C_CKV + ch * 8); }
        __syncthreads();
        { const int row = tid >> 3, j = tid & 7; float sq = 0.f, sk = 0.f;
#pragma unroll
          for (int i = 0; i < 4; ++i) { const u32x4 v = *(const LAS u32x4*)((const LAS unsigned char*)CQ + row * (CQP * 2) + j * 64 + i * 16);
#pragma unroll
              for (int e = 0; e < 4; ++e) { const float a = __uint_as_float(v[e] << 16), c = __uint_as_float(v[e] & 0xffff0000u); sq += a * a + c * c; } }
#pragma unroll
          for (int i = 0; i < 2; ++i) { const u32x4 v = *(const LAS u32x4*)((const LAS unsigned char*)CK + row * (CKP * 2) + j * 32 + i * 16);
#pragma unroll
              for (int e = 0; e < 4; ++e) { const float a = __uint_as_float(v[e] << 16), c = __uint_as_float(v[e] & 0xffff0000u); sk += a * a + c * c; } }
          sq += __shfl_xor(sq, 1); sq += __shfl_xor(sq, 2); sq += __shfl_xor(sq, 4); sk += __shfl_xor(sk, 1); sk += __shfl_xor(sk, 2); sk += __shfl_xor(sk, 4);
          if (j == 0) { RS[row * 2] = rsqrtf(sq * (1.f / 256.f) + 1e-6f); RS[row * 2 + 1] = rsqrtf(sk * (1.f / 128.f) + 1e-6f); }
          float cr = 1.f, sr = 0.f, cc = 1.f, sc = 0.f;
          if (!ctxt) { const int t = pos0 - CTX + row; const float inv = __expf(-9.210340371976184f * (float)j * 0.125f); float xa = (float)(t >> 6) * inv * 0.15915494309189535f; xa -= rintf(xa); sr = __sinf(xa * 6.283185307179586f); cr = __cosf(xa * 6.283185307179586f); float xb = (float)(t & 63) * inv * 0.15915494309189535f; xb -= rintf(xb); sc = __sinf(xb * 6.283185307179586f); cc = __cosf(xb * 6.283185307179586f); }
          CS[(row * 16 + j) * 2] = cr; CS[(row * 16 + j) * 2 + 1] = sr; CS[(row * 16 + 8 + j) * 2] = cc; CS[(row * 16 + 8 + j) * 2 + 1] = sc;
          const bf16_t* kp = P + (r0 + row) * PP + C_KR; const float z0 = bf2f(kp[j]), z1 = bf2f(kp[8 + j]), z2 = bf2f(kp[16 + j]), z3 = bf2f(kp[24 + j]);
          KRo[row * 32 + j] = z0 * cr - z1 * sr; KRo[row * 32 + 8 + j] = z0 * sr + z1 * cr; KRo[row * 32 + 16 + j] = z2 * cc - z3 * sc; KRo[row * 32 + 24 + j] = z2 * sc + z3 * cc; }
        __builtin_amdgcn_sched_barrier(0);
        { f32x4 qa[4][3];
#pragma unroll
          for (int mt = 0; mt < 4; ++mt)
#pragma unroll
              for (int n = 0; n < 3; ++n) qa[mt][n] = (f32x4){0.f, 0.f, 0.f, 0.f};
          const bf16_t* wq = WUQT + ((size_t)l * 384 + 48 * w + fr) * 256 + 8 * fq;
#pragma unroll
          for (int ks = 0; ks < 8; ++ks) { bf16x8 a[4], bb[3];
#pragma unroll
              for (int mt = 0; mt < 4; ++mt) a[mt] = *(const LAS bf16x8*)(CQ + (16 * mt + fr) * CQP + 32 * ks + 8 * fq);
#pragma unroll
              for (int n = 0; n < 3; ++n) bb[n] = *(const bf16x8*)(wq + (size_t)(16 * n) * 256 + 32 * ks);
#pragma unroll
              for (int mt = 0; mt < 4; ++mt)
#pragma unroll
                  for (int n = 0; n < 3; ++n) qa[mt][n] = __builtin_amdgcn_mfma_f32_16x16x32_bf16(a[mt], bb[n], qa[mt][n], 0, 0, 0); }
          __syncthreads();
#pragma unroll
          for (int n = 0; n < 3; ++n) { const int nt = 3 * w + n, m6 = nt % 6, col = 16 * nt + fr;
#pragma unroll
              for (int mt = 0; mt < 4; ++mt)
#pragma unroll
                  for (int i = 0; i < 4; ++i) { const int row = 16 * mt + 4 * fq + i; float v = qa[mt][n][i] * RS[row * 2];
                      if (m6 >= 4) { const float pv = __shfl_xor(v, 8); const int ci = (row * 16 + (m6 == 5 ? 8 : 0) + (fr & 7)) * 2; const float c = CS[ci], s = CS[ci + 1]; v = (fr < 8) ? v * c - pv * s : pv * s + v * c; }
                      QS[row * QSP + col] = f2bf(v * C2); } } }
        __builtin_amdgcn_sched_barrier(0);
        { f32x4 ka[4][4];
#pragma unroll
          for (int mt = 0; mt < 4; ++mt)
#pragma unroll
              for (int n = 0; n < 4; ++n) ka[mt][n] = (f32x4){0.f, 0.f, 0.f, 0.f};
          const bf16_t* wk = WUKVT + ((size_t)l * 512 + 64 * w + fr) * 128 + 8 * fq;
#pragma unroll
          for (int ks = 0; ks < 4; ++ks) { bf16x8 a[4], bb[4];
#pragma unroll
              for (int mt = 0; mt < 4; ++mt) a[mt] = *(const LAS bf16x8*)(CK + (16 * mt + fr) * CKP + 32 * ks + 8 * fq);
#pragma unroll
              for (int n = 0; n < 4; ++n) bb[n] = *(const bf16x8*)(wk + (size_t)(16 * n) * 128 + 32 * ks);
#pragma unroll
              for (int mt = 0; mt < 4; ++mt)
#pragma unroll
                  for (int n = 0; n < 4; ++n) ka[mt][n] = __builtin_amdgcn_mfma_f32_16x16x32_bf16(a[mt], bb[n], ka[mt][n], 0, 0, 0); }
          const int head = w >> 1;
          if ((w & 1) == 0) {
#pragma unroll
              for (int n = 0; n < 4; ++n)
#pragma unroll
                  for (int mt = 0; mt < 4; ++mt)
#pragma unroll
                      for (int i = 0; i < 4; ++i) { const int row = 16 * mt + 4 * fq + i; KS[row * KSP + head * 64 + 16 * n + fr] = f2bf(ka[mt][n][i] * RS[row * 2 + 1]); }
          } else {
#pragma unroll
              for (int n = 0; n < 4; ++n)
#pragma unroll
                  for (int mt = 0; mt < 4; ++mt) { const int rb = 16 * mt + 4 * fq; u32x2 o; o.x = pk2(ka[mt][n][0] * RS[rb * 2 + 1], ka[mt][n][1] * RS[rb * 2 + 3]); o.y = pk2(ka[mt][n][2] * RS[rb * 2 + 5], ka[mt][n][3] * RS[rb * 2 + 7]);
                      *(u32x2*)(VTG + ((size_t)(b * 4 + head) * 64 + 16 * n + fr) * NPOS + pos0 + rb) = o; } } }
        __syncthreads();
#pragma unroll
        for (int i = 0; i < 6; ++i) { const int q = tid + 512 * i, row = q / 48, rem = q % 48, head = rem / 12, ch = rem % 12, pos = pos0 + row;
            const u32x4 qv = *(const LAS u32x4*)((const LAS unsigned char*)QS + row * (QSP * 2) + (head * 96 + ch * 8) * 2);
            if (!ctxt) *(u32x4*)(QL + ((size_t)(b * 4 + head) * SEQ + (pos - CTX)) * 96 + ch * 8) = qv; else if (l == 0) *(u32x4*)(QC + ((size_t)(b * 4 + head) * CTX + pos) * 96 + ch * 8) = qv;
            u32x4 kv;
            if (ch < 8) kv = *(const LAS u32x4*)((const LAS unsigned char*)KS + row * (KSP * 2) + (head * 64 + ch * 8) * 2);
            else { const LAS float* kr = KRo + row * 32 + (ch - 8) * 8; kv.x = pk2(kr[0], kr[1]); kv.y = pk2(kr[2], kr[3]); kv.z = pk2(kr[4], kr[5]); kv.w = pk2(kr[6], kr[7]); }
            *(u32x4*)(KB + ((size_t)(b * 4 + head) * NPOS + pos) * 96 + ch * 8) = kv; }
        if (!(ctxt && l == 1)) { const int lo = ctxt ? 0 : CTX, hi = ctxt ? CTX : NPOS;
#pragma unroll
            for (int i = 0; i < 4; ++i) { const int q = tid + 512 * i, row = q >> 5, ch = q & 31, pos = pos0 + row; float acc[8];
#pragma unroll
                for (int e = 0; e < 8; ++e) acc[e] = scb[ch * 8 + e];
#pragma unroll
                for (int k = 0; k < 3; ++k) { const int p = pos - 1 + k; if (p >= lo && p < hi) { const bf16_t* pr = P + ((size_t)b * NPOS + p) * PP; const u32x4 sx = *(const u32x4*)(pr + C_SX + ch * 8), sc = *(const u32x4*)(pr + C_SC + ch * 8);
#pragma unroll
                        for (int e = 0; e < 4; ++e) { const float w0 = scw[k * 256 + ch * 8 + 2 * e], w1 = scw[k * 256 + ch * 8 + 2 * e + 1];
                            acc[2 * e] += w0 * (__uint_as_float(sx[e] << 16) * __uint_as_float(sc[e] << 16)); acc[2 * e + 1] += w1 * (__uint_as_float(sx[e] & 0xffff0000u) * __uint_as_float(sc[e] & 0xffff0000u)); } } }
                const u32x4 sb = *(const u32x4*)(P + (r0 + row) * PP + C_SB + ch * 8); u32x4 o;
#pragma unroll
                for (int e = 0; e < 4; ++e) o[e] = pk2(__uint_as_float(sb[e] << 16) * acc[2 * e], __uint_as_float(sb[e] & 0xffff0000u) * acc[2 * e + 1]);
                *(u32x4*)(MIX + (r0 + row) * D + 768 + ch * 8) = o; } }
        __syncthreads();
    }
}
}

namespace lru {
constexpr int XP = 264, O_X = 0, O_NA = 33792, O_BB = 66560;
__device__ __forceinline__ float sigm(float x) { return __builtin_amdgcn_rcpf(1.f + __expf(-x)); }
__device__ __forceinline__ void chunk_units(LAS unsigned char* lds, int l, const bf16_t* P, const float* conv_w, const float* conv_b, const bf16_t* WAT, const bf16_t* WIT, const float* b_a, const float* b_i, const float* SPT,
                                            bf16_t* HL, bf16_t* AC, float* SUM, int u0, int u1, int ustep, int knob) {
    LAS bf16_t* X = (LAS bf16_t*)(lds + O_X); LAS bf16_t* NA = (LAS bf16_t*)(lds + O_NA); LAS bf16_t* BB = (LAS bf16_t*)(lds + O_BB);
    for (int unit = u0; unit < u1; unit += ustep) {
        int tid_l = threadIdx.x; asm volatile("" : "+v"(tid_l));
        const int tid = tid_l, lane = tid & 63, w = __builtin_amdgcn_readfirstlane(tid >> 6), fr = lane & 15, fq = lane >> 4;
        const int dir = unit & 1, bc = unit >> 1, b = bc / 68, chunk = bc % 68, pos0 = 64 * chunk; const int lo = chunk < 4 ? 0 : CTX, hi = chunk < 4 ? CTX : NPOS, left = dir ? 1 : 2;
        const size_t r0 = (size_t)b * NPOS + pos0; const int pd = (l * 2 + dir) * 256;
        if (!(knob & 1)) { const int cg = tid & 31, ts = tid >> 5, c0 = cg * 8; float wv[4][8], cbv[8];
#pragma unroll
          for (int e = 0; e < 8; ++e) { cbv[e] = conv_b[pd + c0 + e];
#pragma unroll
              for (int k = 0; k < 4; ++k) wv[k][e] = conv_w[(size_t)pd * 4 + k * 256 + c0 + e]; }
          const bf16_t* pc = P + (size_t)b * NPOS * PP + C_LX + c0; const int pb = pos0 + 4 * ts - left;
          u32x4 u[7];
#pragma unroll
          for (int i = 0; i < 7; ++i) { const int p = pb + i; const int pcl = p < lo ? lo : (p >= hi ? hi - 1 : p); u[i] = *(const u32x4*)(pc + (size_t)pcl * PP); if (p < lo || p >= hi) u[i] = (u32x4){0u, 0u, 0u, 0u}; }
#pragma unroll
          for (int i = 0; i < 4; ++i) { u32x4 o;
#pragma unroll
              for (int e2 = 0; e2 < 4; ++e2) { float lo_ = cbv[2 * e2], hi_ = cbv[2 * e2 + 1];
#pragma unroll
                  for (int k = 0; k < 4; ++k) { const unsigned d = u[i + k][e2]; lo_ += wv[k][2 * e2] * __uint_as_float(d << 16); hi_ += wv[k][2 * e2 + 1] * __uint_as_float(d & 0xffff0000u); }
                  o[e2] = pk2(lo_, hi_); }
              *(LAS u32x4*)(X + (4 * ts + i) * XP + c0) = o; } }
        __syncthreads();
        if (!(knob & 2)) { const int h = w >> 1, mh = w & 1;
          f32x4 ra[2][4], ri[2][4];
#pragma unroll
          for (int m = 0; m < 2; ++m)
#pragma unroll
              for (int n = 0; n < 4; ++n) { ra[m][n] = (f32x4){0.f, 0.f, 0.f, 0.f}; ri[m][n] = (f32x4){0.f, 0.f, 0.f, 0.f}; }
          const bf16_t* wa = WAT + ((size_t)((l * 2 + dir) * 4 + h) * 64 + fr) * 64 + 8 * fq; const bf16_t* wi = WIT + ((size_t)((l * 2 + dir) * 4 + h) * 64 + fr) * 64 + 8 * fq;
#pragma unroll
          for (int ks = 0; ks < 2; ++ks) { bf16x8 a[2], ba[4], bi[4];
#pragma unroll
              for (int m = 0; m < 2; ++m) a[m] = *(const LAS bf16x8*)(X + (16 * (2 * mh + m) + fr) * XP + 64 * h + 32 * ks + 8 * fq);
#pragma unroll
              for (int n = 0; n < 4; ++n) { ba[n] = *(const bf16x8*)(wa + (size_t)(16 * n) * 64 + 32 * ks); bi[n] = *(const bf16x8*)(wi + (size_t)(16 * n) * 64 + 32 * ks); }
#pragma unroll
              for (int m = 0; m < 2; ++m)
#pragma unroll
                  for (int n = 0; n < 4; ++n) { ra[m][n] = __builtin_amdgcn_mfma_f32_16x16x32_bf16(a[m], ba[n], ra[m][n], 0, 0, 0); ri[m][n] = __builtin_amdgcn_mfma_f32_16x16x32_bf16(a[m], bi[n], ri[m][n], 0, 0, 0); } }
#pragma unroll
          for (int n = 0; n < 4; ++n) { const int c = 64 * h + 16 * n + fr; const float bav = b_a[pd + c], biv = b_i[pd + c], sp8 = 8.f * SPT[pd + c];
#pragma unroll
              for (int m = 0; m < 2; ++m)
#pragma unroll
                  for (int i = 0; i < 4; ++i) { const int t = 16 * (2 * mh + m) + 4 * fq + i; const float r = sigm(ra[m][n][i] + bav), ig = sigm(ri[m][n][i] + biv);
                      const float x = r * sp8; const float na = x < 0.03125f ? x * (1.f - 0.5f * x * (1.f - 0.33333334f * x * (1.f - 0.25f * x))) : 1.f - __expf(-x); const float xv = bf2f(X[t * XP + c]);
                      NA[t * 256 + c] = f2bf(na); BB[t * 256 + c] = f2bf(__builtin_amdgcn_sqrtf(fmaxf(na * (2.f - na), 0.f)) * (ig * xv)); } } }
        __syncthreads();
        if (tid < 256 && !(knob & 4)) { const int c = tid; float hst = 0.f, A = 1.f;
            if (dir == 0) {
#pragma unroll 8
                for (int t = 0; t < 64; ++t) { const float a = 1.f - bf2f(NA[t * 256 + c]); hst = a * hst + bf2f(BB[t * 256 + c]); A *= a; BB[t * 256 + c] = f2bf(hst); NA[t * 256 + c] = f2bf(A); }
            } else {
#pragma unroll 8
                for (int t = 63; t >= 0; --t) { const float a = 1.f - bf2f(NA[t * 256 + c]); hst = a * hst + bf2f(BB[t * 256 + c]); A *= a; BB[t * 256 + c] = f2bf(hst); NA[t * 256 + c] = f2bf(A); }
            }
            float* sm = SUM + ((size_t)(dir * 4 + b) * 68 + chunk) * 512; sm[c] = A; sm[256 + c] = hst; }
        __syncthreads();
        if (!(knob & 4)) {
#pragma unroll
            for (int i = 0; i < 4; ++i) { const int q = tid + 512 * i, t = q >> 5, ch = q & 31; const size_t go = ((size_t)dir * MROWS + r0 + t) * 256 + ch * 8;
                *(u32x4*)(AC + go) = *(const LAS u32x4*)(NA + t * 256 + ch * 8); *(u32x4*)(HL + go) = *(const LAS u32x4*)(BB + t * 256 + ch * 8); } }
        __syncthreads();
    }
}
__device__ __forceinline__ void fixup_units(LAS unsigned char* lds, int l, const bf16_t* P, const bf16_t* HL, const bf16_t* AC, const float* SUM, bf16_t* MIX, int G, int bx) {
    LAS float* CAR = (LAS float*)lds;
    for (int unit = bx; unit < 272; unit += G) {
        int tid_l = threadIdx.x; asm volatile("" : "+v"(tid_l));
        const int tid = tid_l;
        const int b = unit / 68, chunk = unit % 68; if (l == 1 && chunk < 4) continue;
        { const int dir = tid >> 8, c = tid & 255; const float* sp = SUM + ((size_t)(dir * 4 + b) * 68) * 512 + c;
          const int n_pre = dir == 0 ? chunk : (chunk < 4 ? 3 - chunk : 4 + (67 - chunk));
          float cy = 0.f;
          for (int j0 = 0; j0 < n_pre; j0 += 16) { float av[16], hv[16];
#pragma unroll
              for (int u = 0; u < 16; ++u) { const int n = j0 + u < n_pre ? j0 + u : n_pre - 1; const int j = dir == 0 ? n : (n < 4 ? 3 - n : 71 - n); av[u] = sp[(size_t)j * 512]; hv[u] = sp[(size_t)j * 512 + 256]; }
#pragma unroll
              for (int u = 0; u < 16; ++u) cy = (j0 + u < n_pre) ? hv[u] + av[u] * cy : cy; }
          CAR[tid] = cy; }
        __syncthreads();
        { const int cg = tid & 31, ts = tid >> 5, c0 = cg * 8; float cf[8], cb[8];
#pragma unroll
          for (int e = 0; e < 8; ++e) { cf[e] = CAR[c0 + e]; cb[e] = CAR[256 + c0 + e]; }
          const size_t r0 = (size_t)b * NPOS + 64 * chunk + 4 * ts;
          u32x4 hf[4], af[4], hb[4], ab[4], gt[4];
#pragma unroll
          for (int i = 0; i < 4; ++i) { const size_t r = r0 + i; hf[i] = *(const u32x4*)(HL + r * 256 + c0); af[i] = *(const u32x4*)(AC + r * 256 + c0); hb[i] = *(const u32x4*)(HL + ((size_t)MROWS + r) * 256 + c0); ab[i] = *(const u32x4*)(AC + ((size_t)MROWS + r) * 256 + c0);
              gt[i] = *(const u32x4*)(P + r * PP + C_LG + c0); }
#pragma unroll
          for (int i = 0; i < 4; ++i) { u32x4 o;
#pragma unroll
              for (int e2 = 0; e2 < 4; ++e2) { float res[2];
#pragma unroll
                  for (int hh = 0; hh < 2; ++hh) { const int e = 2 * e2 + hh;
                      const float vhf = hh ? __uint_as_float(hf[i][e2] & 0xffff0000u) : __uint_as_float(hf[i][e2] << 16), vaf = hh ? __uint_as_float(af[i][e2] & 0xffff0000u) : __uint_as_float(af[i][e2] << 16);
                      const float vhb = hh ? __uint_as_float(hb[i][e2] & 0xffff0000u) : __uint_as_float(hb[i][e2] << 16), vab = hh ? __uint_as_float(ab[i][e2] & 0xffff0000u) : __uint_as_float(ab[i][e2] << 16);
                      const float x = hh ? __uint_as_float(gt[i][e2] & 0xffff0000u) : __uint_as_float(gt[i][e2] << 16);
                      const float hsum = (vhf + vaf * cf[e]) + (vhb + vab * cb[e]);
                      const float u = 0.7978845608028654f * (x + 0.044715f * x * x * x); const float th_ = 1.f - 2.f * __builtin_amdgcn_rcpf(1.f + __expf(2.f * u));
                      res[hh] = 0.5f * x * (1.f + th_) * hsum; }
                  o[e2] = pk2(res[0], res[1]); }
              *(u32x4*)(MIX + (r0 + i) * D + 256 + c0) = o; } }
        __syncthreads();
    }
}
}

namespace fft {
__device__ __forceinline__ void ctx_a(LAS unsigned char* lds, const bf16_t* P, const float* TABC, const float* TABS, bf16_t* XCT, int G, int bx) {
    LAS bf16_t* U = (LAS bf16_t*)(lds + O_U); LAS bf16_t* X = (LAS bf16_t*)(lds + O_X);
    for (int unit = bx; unit < 16; unit += G) {
        int tid_l = threadIdx.x; asm volatile("" : "+v"(tid_l));
        const int tid = tid_l, lane = tid & 63, w = __builtin_amdgcn_readfirstlane(tid >> 6), fr = lane & 15, fq = lane >> 4;
        build_tables(lds, TABC, TABS, tid);
        const LAS bf16_t* Tc = (const LAS bf16_t*)(lds + O_TC); const LAS bf16_t* Ts = (const LAS bf16_t*)(lds + O_TS);
        const int b = unit >> 2, q = unit & 3;
#pragma unroll
        for (int i = 0; i < 4; ++i) { const int qq = tid + 512 * i, t1 = qq >> 5, ch = qq & 31;
            *(LAS u32x4*)((LAS unsigned char*)U + t1 * (UP * 2) + ch * 16) = *(const u32x4*)(P + ((size_t)b * NPOS + 64 * q + t1) * PP + ch * 8); }
        __syncthreads();
        { const int g = w >> 1, part = w & 1; const LAS bf16_t* T = part ? Ts : Tc;
          f32x4 acc[4][4];
#pragma unroll
          for (int mt = 0; mt < 4; ++mt)
#pragma unroll
              for (int nt = 0; nt < 4; ++nt) acc[mt][nt] = (f32x4){0.f, 0.f, 0.f, 0.f};
#pragma unroll
          for (int ks = 0; ks < 2; ++ks) { bf16x8 a[4], bb[4];
#pragma unroll
              for (int mt = 0; mt < 4; ++mt) a[mt] = *(const LAS bf16x8*)(U + (16 * mt + fr) * UP + g * 64 + 32 * ks + 8 * fq);
#pragma unroll
              for (int nt = 0; nt < 4; ++nt) bb[nt] = *(const LAS bf16x8*)(T + (16 * nt + fr) * TP + 32 * ks + 8 * fq);
#pragma unroll
              for (int mt = 0; mt < 4; ++mt)
#pragma unroll
                  for (int nt = 0; nt < 4; ++nt) acc[mt][nt] = __builtin_amdgcn_mfma_f32_16x16x32_bf16(a[mt], bb[nt], acc[mt][nt], 0, 0, 0); }
          const float sg = part ? -1.f : 1.f;
#pragma unroll
          for (int mt = 0; mt < 4; ++mt)
#pragma unroll
              for (int nt = 0; nt < 4; ++nt) { const f32x4 v = acc[mt][nt] * sg; u32x2 o; o.x = pk2(v[0], v[1]); o.y = pk2(v[2], v[3]);
                  *(LAS u32x2*)(X + (part * 256 + g * 64 + 16 * nt + fr) * TP + 16 * mt + 4 * fq) = o; } }
        __syncthreads();
#pragma unroll
        for (int i = 0; i < 8; ++i) { const int qq = tid + 512 * i, row = qq >> 3, c8 = qq & 7;
            *(u32x4*)(XCT + (((size_t)b * 4 + q) * 512 + row) * 64 + c8 * 8) = *(const LAS u32x4*)((const LAS unsigned char*)X + row * (TP * 2) + c8 * 16); }
        __syncthreads();
    }
}
__device__ __forceinline__ void ctx_b(LAS unsigned char* lds, const bf16_t* XCT, const float* TABC, const float* TABS, bf16_t* MIX, int G, int bx) {
    LAS bf16_t* Tc = (LAS bf16_t*)(lds + O_TC); LAS bf16_t* Ts = (LAS bf16_t*)(lds + O_TS);
    LAS bf16_t* Ys = (LAS bf16_t*)(lds + O_U); LAS bf16_t* ZT = (LAS bf16_t*)(lds + O_X);
    for (int unit = bx; unit < 16; unit += G) {
        int tid_l = threadIdx.x; asm volatile("" : "+v"(tid_l));
        const int tid = tid_l, lane = tid & 63, w = __builtin_amdgcn_readfirstlane(tid >> 6), fr = lane & 15, fq = lane >> 4;
        const int b = unit >> 2, ft = unit & 3;
        f32x4 y[4][2];
#pragma unroll
        for (int mt = 0; mt < 4; ++mt)
#pragma unroll
            for (int n = 0; n < 2; ++n) y[mt][n] = (f32x4){0.f, 0.f, 0.f, 0.f};
        for (int q = 0; q < 4; ++q) {
            for (int i = tid; i < 4096; i += 512) { const int fl = i >> 6, tl = i & 63, ix = (((64 * ft + fl) * (64 * q + tl)) & 255) * 16; Tc[fl * TP + tl] = f2bf(TABC[ix]); Ts[fl * TP + tl] = f2bf(TABS[ix]); }
#pragma unroll
            for (int i = 0; i < 8; ++i) { const int qq = tid + 512 * i, row = qq >> 3, c8 = qq & 7;
                *(LAS u32x4*)((LAS unsigned char*)ZT + row * (TP * 2) + c8 * 16) = *(const u32x4*)(XCT + (((size_t)b * 4 + q) * 512 + row) * 64 + c8 * 8); }
            __syncthreads();
#pragma unroll
            for (int ks = 0; ks < 2; ++ks) { bf16x8 xr[2], xi[2];
#pragma unroll
                for (int n = 0; n < 2; ++n) { xr[n] = *(const LAS bf16x8*)(ZT + (32 * w + 16 * n + fr) * TP + 32 * ks + 8 * fq); xi[n] = *(const LAS bf16x8*)(ZT + (256 + 32 * w + 16 * n + fr) * TP + 32 * ks + 8 * fq); }
#pragma unroll
                for (int mt = 0; mt < 4; ++mt) { const bf16x8 c = *(const LAS bf16x8*)(Tc + (16 * mt + fr) * TP + 32 * ks + 8 * fq), s = *(const LAS bf16x8*)(Ts + (16 * mt + fr) * TP + 32 * ks + 8 * fq);
#pragma unroll
                    for (int n = 0; n < 2; ++n) { y[mt][n] = __builtin_amdgcn_mfma_f32_16x16x32_bf16(c, xr[n], y[mt][n], 0, 0, 0); y[mt][n] = __builtin_amdgcn_mfma_f32_16x16x32_bf16(s, xi[n], y[mt][n], 0, 0, 0); } } }
            __syncthreads();
        }
#pragma unroll
        for (int mt = 0; mt < 4; ++mt)
#pragma unroll
            for (int i = 0; i < 4; ++i)
#pragma unroll
                for (int n = 0; n < 2; ++n) Ys[(16 * mt + 4 * fq + i) * UP + 32 * w + 16 * n + fr] = f2bf(y[mt][n][i] * (1.f / 128.f));
        __syncthreads();
#pragma unroll
        for (int i = 0; i < 4; ++i) { const int qq = tid + 512 * i, fl = qq >> 5, ch = qq & 31;
            *(u32x4*)(MIX + ((size_t)b * NPOS + 64 * ft + fl) * D + ch * 8) = *(const LAS u32x4*)((const LAS unsigned char*)Ys + fl * (UP * 2) + ch * 16); }
        __syncthreads();
    }
}
}

constexpr int NWAVES = 8, RING_BYTES = 131072 + 3072, LDSCTL_OFF = RING_BYTES, MISC_OFF = LDSCTL_OFF + 64, META_OFF = MISC_OFF + 64, LDS_BYTES = 147456;
enum { PH_PRO0 = 0, PH_PRO1 = 1, PH_L0 = 2, PH_PER_LAYER = 8, PH_N = 18 };
enum { PL_WIN = 0, PL_PREP = 1, PL_MIX = 2, PL_WOUT = 3, PL_ROUTE = 4, PL_MOE1 = 5, PL_MOE2 = 6, PL_COMB = 7 };
struct MArgs { const float* in[30]; float* out; unsigned char* ws; int npass, skip_mask, dup_ph, dup_n, dup_sub, knob; };

__device__ __forceinline__ void transpose_item(const float* W, int K, int N, bf16_t* WT, int drow0, LAS float* scr, int k0, int n0, int lane) {
    const int kr = lane >> 3, nc = (lane & 7) * 4;
    f32x4 v[8];
#pragma unroll
    for (int i = 0; i < 8; ++i) v[i] = __builtin_nontemporal_load((const f32x4*)(W + (size_t)(k0 + kr + 8 * i) * N + n0 + nc));
#pragma unroll
    for (int i = 0; i < 8; ++i) { LAS float* d = scr + (kr + 8 * i) * 33 + nc; d[0] = v[i][0]; d[1] = v[i][1]; d[2] = v[i][2]; d[3] = v[i][3]; }
    asm volatile("s_waitcnt lgkmcnt(0)" ::: "memory");
    const int c = lane & 7;
#pragma unroll
    for (int j = 0; j < 4; ++j) { const int n = (lane >> 3) + 8 * j; const LAS float* s = scr + (8 * c) * 33 + n;
        u32x4 o; o.x = pk2(s[0 * 33], s[1 * 33]); o.y = pk2(s[2 * 33], s[3 * 33]); o.z = pk2(s[4 * 33], s[5 * 33]); o.w = pk2(s[6 * 33], s[7 * 33]);
        *(u32x4*)(WT + (size_t)(drow0 + n) * K + k0 + 8 * c) = o; }
    asm volatile("s_waitcnt lgkmcnt(0)" ::: "memory");
}

constexpr int I_GU = NE * 16 * 64, I_DN = NE * 16 * 32, I_EXP = I_GU + I_DN;
__device__ __forceinline__ void expert_item(int l, int j, const float* wgu, const float* wdn, unsigned char* ws, LAS float* scr, int lane) {
    if (j < I_GU) { const int e = j / (16 * 64), q = j % (16 * 64), kb = q / 64, nb = q % 64; const int n0 = 32 * nb; const int c2 = n0 & 1023; const int drow = (c2 >> 7) * 256 + (n0 >> 10) * 128 + (c2 & 127);
        transpose_item(wgu + ((size_t)l * NE + e) * D * 2048, D, 2048, (bf16_t*)(ws + L::WGUT) + ((size_t)l * NE + e) * 2048 * D, drow, scr, 64 * kb, n0, lane); }
    else { const int r = j - I_GU; const int e = r / (16 * 32), q = r % (16 * 32), kb = q / 32, nb = q % 32;
        transpose_item(wdn + ((size_t)l * NE + e) * D * D, D, D, (bf16_t*)(ws + L::WDT) + ((size_t)l * NE + e) * D * D, 32 * nb, scr, 64 * kb, 32 * nb, lane); }
}
constexpr int Q_WIN = 48, Q_WOUT = 96, Q_MOE2 = 0;
constexpr int DEF_WIN = 224 * Q_WIN, DEF0 = DEF_WIN + 240 * Q_WOUT, DEF_MOE2 = 128 * Q_MOE2, DEF1 = DEF_MOE2 + 224 * Q_WIN;
constexpr int MIX_X = 11520;
static_assert(I_EXP - DEF0 + MIX_X <= 17 * 2048 && I_EXP - DEF1 - MIX_X <= 17 * 2048, "one attention unit takes at most 17 items per wave");
__device__ __forceinline__ void deferred_items(int l, int first, int count, const float* wgu, const float* wdn, unsigned char* ws, LAS unsigned char* lds, int wave, int lane) {
    LAS float* scr = (LAS float*)(lds + wave * 16384);
    for (int j = first + wave; j < first + count; j += NWAVES) expert_item(l, j, wgu, wdn, ws, scr, lane);
}

#define GASP __attribute__((address_space(1)))
#define ARG_IN(i) ({ const GASP float* _p; asm volatile("s_load_dwordx2 %0, %1, %2\n\ts_waitcnt lgkmcnt(0)" : "=s"(_p) : "s"(__builtin_amdgcn_kernarg_segment_ptr()), "n"((i) * 8)); (const float*)_p; })
__global__ void __launch_bounds__(NWAVES * 64, 2) mega(MArgs args) {
    extern __shared__ __attribute__((aligned(16))) unsigned char lds_raw[];
    const int G0 = gridDim.x, bx0 = blockIdx.x;
    unsigned char* ws0 = args.ws;
    unsigned* ctl0 = (unsigned*)(ws0 + L::CTL);
    for (int u = threadIdx.x; u < (LDS_BYTES - LDSCTL_OFF) / 4; u += NWAVES * 64) ((LAS unsigned*)(lds_raw + LDSCTL_OFF))[u] = 0u;
    __syncthreads();
    volatile LAS unsigned* MISC = (volatile LAS unsigned*)((LAS unsigned char*)lds_raw + MISC_OFF);
    XcdBarrier bar = xcd_barrier_post(ctl0 + L::CW_BAR, MISC);
    const int lo = 0, hi = PH_N;

    bool first = true;
    for (int pass = 0; pass < args.npass; ++pass)
    for (int ph = lo; ph < hi; ++ph) {
      const int reps = (ph == args.dup_ph) ? 1 + args.dup_n : 1;
      if (ph == PH_PRO1) continue;
      for (int rep = 0; rep < reps; ++rep) {
        if (!first) xcd_barrier(bar);
        first = false;
        if (pass + 1 < args.npass && ((args.skip_mask >> ph) & 1)) continue;
        const int sub = rep + 1 < reps ? args.dup_sub : 15; const int knob = rep + 1 < reps ? args.knob : 0; (void)knob;
        GASP unsigned char* wsg = (GASP unsigned char*)args.ws; asm volatile("" : "+s"(wsg)); unsigned char* ws = (unsigned char*)wsg;
        unsigned* ctl = (unsigned*)(ws + L::CTL);
        int tid_p = threadIdx.x; asm volatile("" : "+v"(tid_p));
        int G = G0, bx = bx0; asm volatile("" : "+s"(G), "+s"(bx));
        const int vcu = (G % 8 == 0) ? (bx % 8) * (G / 8) + bx / 8 : bx; (void)vcu;
        unsigned ldsb = 0; asm volatile("" : "+s"(ldsb)); LAS unsigned char* lds = (LAS unsigned char*)lds_raw + ldsb;
        LAS int* META = (LAS int*)(lds + META_OFF);
        const int tid = tid_p, lane = tid & 63, wave = __builtin_amdgcn_readfirstlane(tid >> 6); (void)lane; (void)wave;
        if (ph == PH_PRO0) {
            if (bx == 0 && tid < 2 * NE) ((int*)(ctl + L::CW_CNT))[tid * L::CNT_STRIDE] = 0;
            sm::smallw_phase(ARG_IN(17), ARG_IN(16), ARG_IN(19), ARG_IN(18), ARG_IN(11), ARG_IN(13), (bf16_t*)(ws + L::WUQT), (bf16_t*)(ws + L::WUKVT), (bf16_t*)(ws + L::WAT), (bf16_t*)(ws + L::WIT),
                             (float*)(ws + L::TABC), (float*)(ws + L::TABS), ARG_IN(15), (float*)(ws + L::SPT), ARG_IN(23), (bf16_t*)(ws + L::RWH), (bf16_t*)(ws + L::RWL), bx * 512 + tid, G * 512);
            __syncthreads();
            sm::mod_phase(lds, ARG_IN(1), ARG_IN(3), ARG_IN(4), ARG_IN(5), (float*)(ws + L::MOD), G, bx, tid);
            { int nmine = 0; for (int u = bx; u < 96; u += G) ++nmine;
              if (nmine) { asm volatile("s_waitcnt vmcnt(0)" ::: "memory"); __syncthreads();
                  if (tid == 0) { __builtin_amdgcn_fence(__ATOMIC_RELEASE, "agent"); asm volatile("s_waitcnt vmcnt(0)" ::: "memory"); __hip_atomic_fetch_add(ctl + L::CW_MODCNT, (unsigned)nmine, __ATOMIC_RELAXED, __HIP_MEMORY_SCOPE_AGENT); } } }
            __syncthreads();
            LAS float* scr = (LAS float*)(lds + wave * 16384);
            const int gw = vcu * NWAVES + wave, NGW = G * NWAVES;
            constexpr int I_IN = 16 * 61, I_OUT = 16 * 32, I_D = I_IN + I_OUT; const int d0 = G == 256 ? I_EXP : 0, d1 = G == 256 ? I_EXP : 0, R0 = I_EXP - d0, R1 = I_EXP - d1;
            for (int it = gw; it < 2 * I_D + R0 + R1; it += NGW) {
                if (it < 2 * I_D) { const int l = it / I_D; int r = it % I_D;
                    if (r < I_IN) { const int kb = r / 61, nb = r % 61; transpose_item(ARG_IN(8) + (size_t)l * D * PT, D, PT, (bf16_t*)(ws + L::WINT) + (size_t)l * 2048 * D, 32 * nb, scr, 64 * kb, 32 * nb, lane); }
                    else { r -= I_IN; const int kb = r / 32, nb = r % 32; transpose_item(ARG_IN(22) + (size_t)l * D * D, D, D, (bf16_t*)(ws + L::WOUTT) + (size_t)l * D * D, 32 * nb, scr, 64 * kb, 32 * nb, lane); }
                } else { const int r = it - 2 * I_D; if (r < R0) expert_item(0, d0 + r, ARG_IN(25), ARG_IN(27), ws, scr, lane); else expert_item(1, d1 + (r - R0), ARG_IN(25), ARG_IN(27), ws, scr, lane); }
            }
            for (int i = bx * 512 + tid; i < 2 * 96 * D / 8; i += G * 512) { const int l = i / (96 * D / 8), q = i % (96 * D / 8); *(u32x4*)((bf16_t*)(ws + L::WINT) + ((size_t)l * 2048 + PT) * D + (size_t)q * 8) = (u32x4){0u, 0u, 0u, 0u}; }
            if (tid == 0) { unsigned sp = 0; while (__hip_atomic_load(ctl + L::CW_MODCNT, __ATOMIC_RELAXED, __HIP_MEMORY_SCOPE_AGENT) < 96u && ++sp < (1u << 22)) __builtin_amdgcn_s_sleep(2);
                __builtin_amdgcn_fence(__ATOMIC_ACQUIRE, "agent"); asm volatile("s_waitcnt vmcnt(0)" ::: "memory"); }
            __syncthreads();
            { const int nmod = G < 96 ? G : 96; const int small = 45, rs0 = bx < nmod ? bx * small : nmod * small + (int)(((long)(bx - nmod) * (MROWS - nmod * small)) / (G - nmod)),
                  rs1 = bx + 1 < nmod ? (bx + 1) * small : (bx + 1 >= G ? MROWS : nmod * small + (int)(((long)(bx + 1 - nmod) * (MROWS - nmod * small)) / (G - nmod)));
              sm::pro1_phase(ARG_IN(0), ARG_IN(2), ARG_IN(6), (const float*)(ws + L::MOD), (float*)(ws + L::H), (bf16_t*)(ws + L::XN), rs0 + wave, rs1, NWAVES, lane); }
            continue;
        }
        if (ph < PH_L0) continue;
        const int l = (ph - PH_L0) / PH_PER_LAYER, pl = (ph - PH_L0) % PH_PER_LAYER;
        const float* MODl = (const float*)(ws + L::MOD) + (size_t)l * 5 * 6144;
        if (pl == PL_WIN) {
            g8::DenseSched S; S.init(MROWS / 256, PP / 256, G, bx, 0, (const bf16_t*)(ws + L::WINT) + (size_t)l * 2048 * D, D);
            g8::EpiP E{(bf16_t*)(ws + L::P)};
            g8::gemm_phase<g8::EpiP, g8::DenseSched, false, false>(lds, (const char*)(ws + L::XN), S, E);
            if (G == 256 && bx >= 32) deferred_items(l, (l == 0 ? 0 : DEF_MOE2) + (bx - 32) * Q_WIN, Q_WIN, ARG_IN(25), ARG_IN(27), ws, lds, wave, lane);
        } else if (pl == PL_PREP) {
            if (l == 0 && (sub & 2)) { fft::ctx_a(lds, (const bf16_t*)(ws + L::P), (const float*)(ws + L::TABC), (const float*)(ws + L::TABS), (bf16_t*)(ws + L::XCT), G, G - 1 - bx); __syncthreads(); }
            for (int p = 0; p * G < 1072; ++p) {
                const int k = p * G + ((p & 1) ? G - 1 - bx : bx);
                if (k >= 1072) continue;
                if (k < 272) { if (sub & 4) prep::qkv_units(lds, l, (const bf16_t*)(ws + L::P), (const bf16_t*)(ws + L::WUQT), (const bf16_t*)(ws + L::WUKVT), ARG_IN(20) + l * 768, ARG_IN(21) + l * 256,
                            (bf16_t*)(ws + L::QL), (bf16_t*)(ws + L::QC), (bf16_t*)(ws + L::KB), (bf16_t*)(ws + L::VTG), (bf16_t*)(ws + L::MIX), k, k + 1, 1); }
                else if (k < 816) { if (sub & 8) lru::chunk_units(lds, l, (const bf16_t*)(ws + L::P), ARG_IN(9), ARG_IN(10), (const bf16_t*)(ws + L::WAT), (const bf16_t*)(ws + L::WIT), ARG_IN(12), ARG_IN(14), (const float*)(ws + L::SPT),
                             (bf16_t*)(ws + L::HL), (bf16_t*)(ws + L::AC), (float*)(ws + L::SUM), k - 272, k - 271, 1, knob); }
                else { if (sub & 1) fft::stage_a(lds, (const bf16_t*)(ws + L::P), (const float*)(ws + L::TABC), (const float*)(ws + L::TABS), (bf16_t*)(ws + L::ZBUF), k - 816, k - 815, 1); }
                __syncthreads();
            }
        } else if (pl == PL_MIX) {
            if (sub & 1) lru::fixup_units(lds, l, (const bf16_t*)(ws + L::P), (const bf16_t*)(ws + L::HL), (const bf16_t*)(ws + L::AC), (const float*)(ws + L::SUM), (bf16_t*)(ws + L::MIX), G, bx);
            if (sub & 2) fft::stage_b(lds, (const bf16_t*)(ws + L::ZBUF), (const float*)(ws + L::TABC), (const float*)(ws + L::TABS), (bf16_t*)(ws + L::MIX), G, bx);
            __syncthreads();
            if (l == 0 && (sub & 4)) { fft::ctx_b(lds, (const bf16_t*)(ws + L::XCT), (const float*)(ws + L::TABC), (const float*)(ws + L::TABS), (bf16_t*)(ws + L::MIX), G, G - 1 - bx); __syncthreads(); }
            cv::Job cvj; cvj.wgu = ARG_IN(25); cvj.wdn = ARG_IN(27); cvj.ws = ws;
            if (l == 0) { cvj.n0 = I_EXP - DEF0; cvj.first0 = DEF0; cvj.first1 = DEF1; cvj.nv = cvj.n0 + MIX_X; } else { cvj.n0 = 0; cvj.first0 = 0; cvj.first1 = DEF1 + MIX_X; cvj.nv = I_EXP - DEF1 - MIX_X; }
            if (sub & 8) attn::attn_phase(lds, (const bf16_t*)(ws + L::QL), (const bf16_t*)(ws + L::QC), (const bf16_t*)(ws + L::KB), (const bf16_t*)(ws + L::VTG), (bf16_t*)(ws + L::MIX), l == 0 ? 1 : 0, G, vcu, cvj, G == 256);
        } else if (pl == PL_WOUT) {
            g8::DenseSched S; S.init(l == 0 ? MROWS / 256 : 64, D / 256, G, bx, l == 0 ? 0 : 1, (const bf16_t*)(ws + L::WOUTT) + (size_t)l * D * D, D);
            g8::EpiH E{(float*)(ws + L::H), MODl, 2048};
            g8::gemm_phase<g8::EpiH, g8::DenseSched, false, false>(lds, (const char*)(ws + L::MIX), S, E);
            if (G == 256 && l == 0 && bx >= 16) deferred_items(0, DEF_WIN + (bx - 16) * Q_WOUT, Q_WOUT, ARG_IN(25), ARG_IN(27), ws, lds, wave, lane);
        } else if (pl == PL_ROUTE) {
            sm::route_phase(lds, l, (const float*)(ws + L::H), ARG_IN(7) + l * D, MODl, (const bf16_t*)(ws + L::RWH), (const bf16_t*)(ws + L::RWL), ARG_IN(24) + l * NE, (bf16_t*)(ws + L::XN), (int*)(ctl + L::CW_CNT) + l * NE * L::CNT_STRIDE,
                            (int*)(ws + L::LIST) + (size_t)l * NE * LCAP, (float*)(ws + L::GATE), G, bx, tid);
        } else if (pl == PL_COMB) {
            sm::comb_phase(l, (float*)(ws + L::H), (const bf16_t*)(ws + L::Y), MODl, ARG_IN(6) + D, (const float*)(ws + L::MOD) + (size_t)5 * 6144, (bf16_t*)(ws + L::XN), ARG_IN(29), args.out, bx * NWAVES + wave, G * NWAVES, lane);
        } else if (pl == PL_MOE1 || pl == PL_MOE2) {
            const int* CNTg = (const int*)(ctl + L::CW_CNT) + l * NE * L::CNT_STRIDE;
            if (tid == 0) { int o = 0; for (int e = 0; e < NE; ++e) { const int cn = CNTg[e * L::CNT_STRIDE]; META[e] = o; META[64 + e] = cn; o += (cn + 255) >> 8; } META[NE] = o; }
            __syncthreads();
            g8::MoeSched S; S.tpre = META; S.cnt = META + 64; S.G = G; S.c = bx; S.K = D; S.list = (const int*)(ws + L::LIST) + (size_t)l * NE * LCAP;
            if (pl == PL_MOE1) {
                S.NT = 8; S.COLW = 128; S.total = __builtin_amdgcn_readfirstlane(META[NE]) * 8; S.Bt = (const char*)((const bf16_t*)(ws + L::WGUT) + (size_t)l * NE * 2048 * D);
                g8::EpiMoe1 E{(bf16_t*)(ws + L::ACT), ARG_IN(26) + (size_t)l * NE * 2048};
                g8::gemm_phase<g8::EpiMoe1, g8::MoeSched, true, true>(lds, (const char*)(ws + L::XN), S, E);
            } else {
                S.NT = 4; S.COLW = 256; S.total = __builtin_amdgcn_readfirstlane(META[NE]) * 4; S.Bt = (const char*)((const bf16_t*)(ws + L::WDT) + (size_t)l * NE * D * D);
                g8::EpiMoe2 E{(bf16_t*)(ws + L::Y), ARG_IN(28) + (size_t)l * NE * D, (const float*)(ws + L::GATE)};
                g8::gemm_phase<g8::EpiMoe2, g8::MoeSched, false, true>(lds, (const char*)(ws + L::ACT), S, E);
                if (G == 256 && l == 0 && bx >= 128) deferred_items(1, (bx - 128) * Q_MOE2, Q_MOE2, ARG_IN(25), ARG_IN(27), ws, lds, wave, lane);
            }
            __syncthreads();
        }
      }
    }
}
constexpr int PROBE_DUP_PH = -1, PROBE_DUP_N = 0, PROBE_DUP_SUB = 15, PROBE_KNOB = 0;
constexpr int PROBE_NPASS = 1, PROBE_SKIP = 0;
extern "C" void kernel_launch(void* const* d_in, const int* in_sizes, int n_in, void* d_out, int out_size, void* d_ws, size_t ws_size, hipStream_t stream) {
    static int grid = 0;
    if (grid == 0) {
        if (n_in != 30 || out_size != NB_ * SEQ * D || (size_t)L::END > ws_size) { fprintf(stderr, "kernel_launch: unexpected problem shape (n_in %d, out %d) or workspace too small (need %zu, have %zu); nothing launched\n", n_in, out_size, (size_t)L::END, ws_size); grid = -1; return; }
        int dev = 0, cus = 0;
        if (hipGetDevice(&dev) != hipSuccess || hipDeviceGetAttribute(&cus, hipDeviceAttributeMultiprocessorCount, dev) != hipSuccess) { fprintf(stderr, "kernel_launch: device query failed\n"); grid = -1; return; }
        if (hipFuncSetAttribute((const void*)mega, hipFuncAttributeMaxDynamicSharedMemorySize, LDS_BYTES) != hipSuccess) { fprintf(stderr, "kernel_launch: hipFuncSetAttribute failed\n"); grid = -1; return; }
        int per_cu = 0;
        if (hipOccupancyMaxActiveBlocksPerMultiprocessor(&per_cu, (const void*)mega, NWAVES * 64, LDS_BYTES) != hipSuccess || per_cu < 1) fprintf(stderr, "kernel_launch: note: the occupancy query reports %d workgroups per CU; launching one per CU anyway\n", per_cu);
        (void)hipGetLastError();
        grid = cus < 256 ? cus : 256;
    }
    if (grid < 0) return;
    unsigned char* p = (unsigned char*)d_ws;
    (void)hipMemsetAsync(p + L::CTL, 0, L::CTL_BYTES, stream);
    MArgs a{};
    for (int i = 0; i < 30; ++i) a.in[i] = (const float*)d_in[i];
    a.out = (float*)d_out; a.ws = p; a.npass = PROBE_NPASS; a.skip_mask = PROBE_SKIP; a.dup_ph = PROBE_DUP_PH; a.dup_n = PROBE_DUP_N; a.dup_sub = PROBE_DUP_SUB; a.knob = PROBE_KNOB;
    hipLaunchKernelGGL(mega, dim3(grid), dim3(NWAVES * 64), LDS_BYTES, stream, a);
}
```

```cpp
#include <hip/hip_runtime.h>
#include <cstdint>
#include <cstdio>

typedef unsigned short bf16_t;
constexpr int NB_ = 4, SEQ = 4096, CTX = 256, D = 1024, NPOS = SEQ + CTX, MROWS = NB_ * NPOS;
constexpr int PT = 1952, PP = 2048;
constexpr int NE = 32, TOPK = 4, LCAP = MROWS;
constexpr int NASG = MROWS * TOPK;
constexpr int ACT_ROWS = NASG + NE * 256;
constexpr int C_FN = 0, C_LX = 256, C_LG = 512, C_CQ = 768, C_CKV = 1024, C_KR = 1152, C_SX = 1184, C_SB = 1440, C_SC = 1696;

__device__ __forceinline__ float bf2f(bf16_t v) { return __uint_as_float((unsigned)v << 16); }
typedef float cv_f2 __attribute__((ext_vector_type(2))); typedef __bf16 cv_b2 __attribute__((ext_vector_type(2)));
__device__ __forceinline__ unsigned pk2(float lo, float hi) { cv_f2 v = {lo, hi}; return __builtin_bit_cast(unsigned, __builtin_convertvector(v, cv_b2)); }
__device__ __forceinline__ bf16_t f2bf(float f) { return (bf16_t)pk2(f, 0.f); }
__device__ __forceinline__ float wave_sum(float v) {
#pragma unroll
    for (int o = 1; o < 64; o <<= 1) v += __shfl_xor(v, o);
    return v;
}
__device__ __forceinline__ float sigmoidf_(float x) { return 1.f / (1.f + __expf(-x)); }
__device__ __forceinline__ float gelu_tanh(float x) { const float u = 0.7978845608028654f * (x + 0.044715f * x * x * x); return 0.5f * x * (1.f + tanhf(u)); }

#define LAS __attribute__((address_space(3)))
typedef short bf16x8 __attribute__((ext_vector_type(8)));
typedef float f32x4 __attribute__((ext_vector_type(4)));
typedef unsigned u32x4 __attribute__((ext_vector_type(4)));
typedef unsigned u32x2 __attribute__((ext_vector_type(2)));

namespace L {
constexpr size_t A256(size_t x) { return (x + 255) & ~(size_t)255; }
constexpr size_t CTL = 0, CTL_BYTES = 1u << 20;
constexpr size_t H = CTL + CTL_BYTES;
constexpr size_t MOD = CTL + 512 * 1024;
constexpr size_t TABC = A256(H + (size_t)MROWS * D * 4);
constexpr size_t TABS = A256(TABC + 4096 * 4);
constexpr size_t XN = A256(TABS + 4096 * 4);
constexpr size_t P = A256(XN + (size_t)MROWS * D * 2);
constexpr size_t MIX = A256(P + (size_t)MROWS * PP * 2);
constexpr size_t CQN = A256(MIX + (size_t)MROWS * D * 2);
constexpr size_t CKVN = A256(CQN + (size_t)MROWS * 256 * 2);
constexpr size_t QRAW = A256(CKVN + (size_t)MROWS * 128 * 2);
constexpr size_t KVRAW = A256(QRAW + (size_t)MROWS * 384 * 4);
constexpr size_t QL = A256(KVRAW + (size_t)MROWS * 512 * 4);
constexpr size_t QC = A256(QL + (size_t)16 * SEQ * 96 * 2);
constexpr size_t KB = A256(QC + (size_t)16 * CTX * 96 * 2);
constexpr size_t VB = A256(KB + (size_t)16 * NPOS * 96 * 2);
constexpr size_t LA = A256(VB + (size_t)16 * NPOS * 64 * 2);
constexpr size_t LB = A256(LA + (size_t)2 * MROWS * 256 * 4);
constexpr size_t HS = A256(LB + (size_t)2 * MROWS * 256 * 4);
constexpr size_t XCS = A256(HS + (size_t)2 * MROWS * 256 * 4);
constexpr size_t XCSC = A256(XCS + (size_t)4 * 8192 * 256 * 4);
constexpr size_t LIST = A256(XCSC + (size_t)4 * 512 * 256 * 4);
constexpr size_t GATE = A256(LIST + (size_t)2 * NE * LCAP * 4);
constexpr size_t ACT = A256(GATE + (size_t)NASG * 4);
constexpr size_t Y = A256(ACT + (size_t)ACT_ROWS * D * 2);
constexpr size_t WINT = A256(Y + (size_t)(NASG + 1) * D * 2);
constexpr size_t WOUTT = A256(WINT + (size_t)2 * 2048 * 1024 * 2);
constexpr size_t WGUT = A256(WOUTT + (size_t)2 * 1024 * 1024 * 2);
constexpr size_t WDT = A256(WGUT + (size_t)2 * NE * 2048 * 1024 * 2);
constexpr size_t ZBUF = A256(WDT + (size_t)2 * NE * 1024 * 1024 * 2);
constexpr size_t VTG = A256(ZBUF + (size_t)4 * 64 * 64 * 512 * 2);
constexpr size_t WUQT = A256(VTG + (size_t)16 * 64 * NPOS * 2);
constexpr size_t WUKVT = A256(WUQT + (size_t)2 * 384 * 256 * 2);
constexpr size_t WAT = A256(WUKVT + (size_t)2 * 512 * 128 * 2);
constexpr size_t WIT = A256(WAT + (size_t)16 * 4096 * 2);
constexpr size_t SPT = A256(WIT + (size_t)16 * 4096 * 2);
constexpr size_t RWH = A256(SPT + (size_t)1024 * 4);
constexpr size_t RWL = A256(RWH + (size_t)2 * NE * D * 2);
constexpr size_t HL = A256(RWL + (size_t)2 * NE * D * 2);
constexpr size_t AC = A256(HL + (size_t)2 * MROWS * 256 * 2);
constexpr size_t SUM = A256(AC + (size_t)2 * MROWS * 256 * 2);
constexpr size_t XCT = A256(SUM + (size_t)2 * 4 * 68 * 512 * 4);
constexpr size_t END = A256(XCT + (size_t)16 * 512 * 64 * 2);
constexpr int CW_BAR = 4096;
constexpr int CW_MODCNT = 2048;
constexpr int CW_CNT = 32768, CNT_STRIDE = 64;
}

#define XB_TMO      128
#define XB_XCNT(j)  (256  + 64 * (j))
#define XB_XSUB(j)  (1280 + 64 * (j))
#define XB_XGEN(j)  (2304 + 64 * (j))
#define XB_TOP      3328
#define XB_TOPGEN   3392
#define XCD_BAR_WORDS 3456
#define XB_SPIN_CAP (1u << 18)
__device__ __forceinline__ unsigned xb_ld(unsigned* p)              { return __hip_atomic_load(p, __ATOMIC_RELAXED, __HIP_MEMORY_SCOPE_AGENT); }
__device__ __forceinline__ unsigned xb_add(unsigned* p, unsigned v) { return __hip_atomic_fetch_add(p, v, __ATOMIC_RELAXED, __HIP_MEMORY_SCOPE_AGENT); }
__device__ __forceinline__ unsigned xb_xcc_id() { return (unsigned)__builtin_amdgcn_s_getreg((3 << 11) | 20) & 0xFu; }
#define XB_SPIN(cond, bar) do { unsigned _sp = 0; while (cond) { __builtin_amdgcn_s_sleep(1); \
    if ((++_sp & 255u) == 0u) { if (xb_ld(&(bar)[XB_TMO])) break; if (_sp > XB_SPIN_CAP) { atomicAdd(&(bar)[XB_TMO], 1u); break; } } } } while (0)
struct XcdBarrier { unsigned* bar; unsigned x; volatile LAS unsigned* st; };
__device__ __forceinline__ XcdBarrier xcd_barrier_post(unsigned* bar, volatile LAS unsigned* st) {
    XcdBarrier b; b.bar = bar; b.x = xb_xcc_id(); b.st = st;
    if (threadIdx.x == 0) (void)xb_add(&bar[XB_XCNT(b.x)], 1u);
    return b;
}
__device__ __forceinline__ void xcd_barrier_complete(unsigned* bar, unsigned x, unsigned& nloc, unsigned& nx) {
    const unsigned G = gridDim.x * gridDim.y * gridDim.z;
    unsigned sum, cnt, mine, sp = 0u;
    for (;;) {
        sum = 0u; cnt = 0u; mine = 0u;
#pragma unroll
        for (unsigned j = 0; j < 16; ++j) { const unsigned c = xb_ld(&bar[XB_XCNT(j)]); sum += c; cnt += (c > 0u) ? 1u : 0u; mine = (j == x) ? c : mine; }
        if (sum == G) break;
        __builtin_amdgcn_s_sleep(1);
        if ((++sp & 255u) == 0u) { if (xb_ld(&bar[XB_TMO])) break; if (sp > XB_SPIN_CAP) { atomicAdd(&bar[XB_TMO], 1u); break; } }
    }
    nloc = mine > 0u ? mine : 1u; nx = cnt > 0u ? cnt : 1u;
}
__device__ __forceinline__ void xcd_barrier(const XcdBarrier& b) {
    asm volatile("s_waitcnt vmcnt(0)" ::: "memory");
    __syncthreads();
    if (threadIdx.x == 0) {
        unsigned* bar = b.bar;
        __builtin_amdgcn_s_waitcnt(0);
        unsigned nloc = b.st[0], nx = b.st[1];
        if (nloc == 0u) { xcd_barrier_complete(bar, b.x, nloc, nx); b.st[0] = nloc; b.st[1] = nx; }
        const unsigned old = xb_add(&bar[XB_XSUB(b.x)], 1u);
        const unsigned gen = old / nloc;
        if (old + 1u == (gen + 1u) * nloc) {
            __builtin_amdgcn_fence(__ATOMIC_RELEASE, "agent");
            asm volatile("s_waitcnt vmcnt(0)" ::: "memory");
            const unsigned og = xb_add(&bar[XB_TOP], 1u);
            const unsigned tg = og / nx;
            if (og + 1u == (tg + 1u) * nx) xb_add(&bar[XB_TOPGEN], 1u);
            else XB_SPIN(xb_ld(&bar[XB_TOPGEN]) == tg, bar);
            __builtin_amdgcn_fence(__ATOMIC_ACQUIRE, "agent");
            xb_add(&bar[XB_XGEN(b.x)], 1u);
            asm volatile("s_waitcnt vmcnt(0)" ::: "memory");
        } else {
            XB_SPIN(xb_ld(&bar[XB_XGEN(b.x)]) == gen, bar);
            __builtin_amdgcn_fence(__ATOMIC_ACQUIRE, "agent");
            asm volatile("s_waitcnt vmcnt(0)" ::: "memory");
        }
    }
    __syncthreads();
}

namespace g8 {
constexpr int BM = 256, BK = 64, HALF = 128, HTB = HALF * BK * 2, STAGE_BYTES = 8 * HTB, NXCD = 8, WGM = 8;
__device__ __forceinline__ int lds_byte(int r, int c) { const int st = (r >> 4) * 2 + (c >> 5), rr = r & 15, cc = c & 31, ob = rr * 64 + cc * 2; return st * 1024 + (ob ^ (((ob >> 9) & 1) << 5)); }
__device__ __forceinline__ void stage_rc(int b, int& R, int& C) { const int st = b / 1024, sb = b % 1024, swz = sb ^ (((sb >> 9) & 1) << 5); R = (st >> 1) * 16 + swz / 64; C = (st & 1) * 32 + (swz % 64) / 2; }
__device__ __forceinline__ int perm32(int rho) { const int n = rho >> 4, i = rho & 15; return 8 * (i >> 2) + 4 * n + (i & 3); }
__device__ __forceinline__ unsigned cvt_pk_bf16(float lo, float hi) { return pk2(lo, hi); }
__device__ __forceinline__ int xcd_remap(int wgid, int nwg) { const int q = nwg / NXCD, r = nwg % NXCD, xcd = wgid % NXCD, off = wgid / NXCD; return (xcd < r ? xcd * (q + 1) : r * (q + 1) + (xcd - r) * q) + off; }

struct Unit { int row0, col0, ex, bt, nvalid, lrow; };

struct DenseSched {
    int nM, nN, nwg, G, c, lat_only; const char* Bt; int K; const int* list;
    __device__ __forceinline__ void init(int nM_, int nN_, int G_, int c_, int lat_only_, const void* Bt_, int K_) { nM = nM_; nN = nN_; nwg = nM * nN; G = G_; c = c_; lat_only = lat_only_; Bt = (const char*)Bt_; K = K_; list = nullptr; }
    __device__ __forceinline__ bool next(int i, Unit& u) const {
        const long Lx = (long)i * G + c; if (Lx >= nwg) return false;
        const int wgid = xcd_remap((int)Lx, nwg);
        const int nig = WGM * nN, gid = wgid / nig, fm = gid * WGM, gsz = (nM - fm) < WGM ? (nM - fm) : WGM;
        const int pm = fm + ((wgid % nig) % gsz), pn = (wgid % nig) / gsz;
        const int tile = lat_only ? (pm / 16) * 17 + 1 + (pm % 16) : pm;
        u.row0 = tile * 256; u.col0 = pn * 256; u.ex = 0; u.bt = pn; u.nvalid = 256; u.lrow = 0; return true;
    }
    __device__ __forceinline__ const char* bptr(const Unit& u) const { return Bt + (size_t)u.bt * (256 * 1024 * 2); }
};
struct MoeSched {
    const LAS int* tpre; const LAS int* cnt; int NT, COLW, G, c, total; const char* Bt; int K; const int* list;
    __device__ __forceinline__ bool next(int i, Unit& u) const {
        const long Lx = (long)i * G + c; if (Lx >= total) return false;
        const int wgid = xcd_remap((int)Lx, total);
        int e = 0;
        for (int j = 1; j < NE; ++j) if (tpre[j] * NT <= wgid) e = j;
        const int t0 = tpre[e], mte = tpre[e + 1] - t0, loc = wgid - t0 * NT, nt = loc / mte, mt = loc % mte;
        u.ex = __builtin_amdgcn_readfirstlane(e); u.row0 = __builtin_amdgcn_readfirstlane((t0 + mt) * 256); u.col0 = __builtin_amdgcn_readfirstlane(nt * COLW);
        u.bt = __builtin_amdgcn_readfirstlane(e * NT + nt); const int nv = cnt[e] - mt * 256; u.nvalid = __builtin_amdgcn_readfirstlane(nv < 256 ? nv : 256); u.lrow = __builtin_amdgcn_readfirstlane(mt * 256);
        return true;
    }
    __device__ __forceinline__ const char* bptr(const Unit& u) const { return Bt + (size_t)u.bt * (256 * 1024 * 2); }
};

struct EpiP {
    static constexpr bool PERM = true; bf16_t* O;
    __device__ __forceinline__ void operator()(const f32x4 (&acc)[2][2][4][2], const Unit& u, int wr, int wc, int fr, int fq, const LAS int*) const {
#pragma unroll
        for (int ai = 0; ai < 2; ++ai)
#pragma unroll
            for (int m = 0; m < 4; ++m) { bf16_t* rowp = O + (size_t)(u.row0 + ai * HALF + wr * 64 + m * 16 + fr) * PP + u.col0 + wc * 32 + 8 * fq;
#pragma unroll
                for (int bj = 0; bj < 2; ++bj) { const f32x4 v0 = acc[ai][bj][m][0], v1 = acc[ai][bj][m][1]; u32x4 w; w.x = cvt_pk_bf16(v0[0], v0[1]); w.y = cvt_pk_bf16(v0[2], v0[3]); w.z = cvt_pk_bf16(v1[0], v1[1]); w.w = cvt_pk_bf16(v1[2], v1[3]);
                    *(u32x4*)(rowp + bj * HALF) = w; } }
    }
};
struct EpiH {
    static constexpr bool PERM = false; float* Hh; const float* MODl; int g_off;
    __device__ __forceinline__ void operator()(const f32x4 (&acc)[2][2][4][2], const Unit& u, int wr, int wc, int fr, int fq, const LAS int*) const {
        const int tile = u.row0 >> 8, v = (tile % 17 == 0) ? 4 : tile / 17; const float* gp = MODl + (size_t)v * 6144 + g_off + u.col0 + wc * 32 + 4 * fq;
        f32x4 gv[2][2];
#pragma unroll
        for (int bj = 0; bj < 2; ++bj)
#pragma unroll
            for (int n = 0; n < 2; ++n) gv[bj][n] = *(const f32x4*)(gp + bj * HALF + n * 16);
#pragma unroll
        for (int ai = 0; ai < 2; ++ai)
#pragma unroll
          for (int mp = 0; mp < 2; ++mp) {
            f32x4 hv[2][2][2];
#pragma unroll
            for (int m2 = 0; m2 < 2; ++m2) { const float* rowp = Hh + (size_t)(u.row0 + ai * HALF + wr * 64 + (2 * mp + m2) * 16 + fr) * D + u.col0 + wc * 32 + 4 * fq;
#pragma unroll
                for (int bj = 0; bj < 2; ++bj)
#pragma unroll
                    for (int n = 0; n < 2; ++n) hv[m2][bj][n] = *(const f32x4*)(rowp + bj * HALF + n * 16); }
#pragma unroll
            for (int m2 = 0; m2 < 2; ++m2) { float* rowp = Hh + (size_t)(u.row0 + ai * HALF + wr * 64 + (2 * mp + m2) * 16 + fr) * D + u.col0 + wc * 32 + 4 * fq;
#pragma unroll
                for (int bj = 0; bj < 2; ++bj)
#pragma unroll
                    for (int n = 0; n < 2; ++n) *(f32x4*)(rowp + bj * HALF + n * 16) = hv[m2][bj][n] + gv[bj][n] * acc[ai][bj][2 * mp + m2][n]; }
          }
    }
};
struct EpiMoe1 {
    static constexpr bool PERM = true; bf16_t* ACTp; const float* bgu;
    __device__ __forceinline__ void operator()(const f32x4 (&acc)[2][2][4][2], const Unit& u, int wr, int wc, int fr, int fq, const LAS int*) const {
        const int cc = u.col0 + wc * 32 + 8 * fq; const float* bp = bgu + (size_t)u.ex * 2048 + cc;
        f32x4 bg[2], bu[2];
#pragma unroll
        for (int n = 0; n < 2; ++n) { bg[n] = *(const f32x4*)(bp + 4 * n); bu[n] = *(const f32x4*)(bp + 1024 + 4 * n); }
#pragma unroll
        for (int ai = 0; ai < 2; ++ai)
#pragma unroll
            for (int m = 0; m < 4; ++m) { const int r = ai * HALF + wr * 64 + m * 16 + fr;
                float o[8];
#pragma unroll
                for (int n = 0; n < 2; ++n)
#pragma unroll
                    for (int i = 0; i < 4; ++i) { const float g = fminf(acc[ai][0][m][n][i] + bg[n][i], 7.f); const float uu = fminf(fmaxf(acc[ai][1][m][n][i] + bu[n][i], -7.f), 7.f);
                        o[n * 4 + i] = (uu + 1.f) * g * __builtin_amdgcn_rcpf(1.f + __expf(-1.702f * g)); }
                { u32x4 w; w.x = cvt_pk_bf16(o[0], o[1]); w.y = cvt_pk_bf16(o[2], o[3]); w.z = cvt_pk_bf16(o[4], o[5]); w.w = cvt_pk_bf16(o[6], o[7]);
                    *(u32x4*)(ACTp + (size_t)(u.row0 + r) * D + cc) = w; } }
    }
};
struct EpiMoe2 {
    static constexpr bool PERM = true; bf16_t* Yp; const float* bd; const float* GATEp;
    __device__ __forceinline__ void operator()(const f32x4 (&acc)[2][2][4][2], const Unit& u, int wr, int wc, int fr, int fq, const LAS int* rows) const {
        const int cc = u.col0 + wc * 32 + 8 * fq; const float* bp = bd + (size_t)u.ex * 1024 + cc;
        f32x4 bv[2][2];
#pragma unroll
        for (int bj = 0; bj < 2; ++bj)
#pragma unroll
            for (int n = 0; n < 2; ++n) bv[bj][n] = *(const f32x4*)(bp + bj * HALF + 4 * n);
        int asgv[2][4]; float gtv[2][4];
#pragma unroll
        for (int ai = 0; ai < 2; ++ai)
#pragma unroll
            for (int m = 0; m < 4; ++m) { const int r = ai * HALF + wr * 64 + m * 16 + fr; const bool ok = r < u.nvalid; const int a = rows[ok ? r : 0]; asgv[ai][m] = ok ? a : NASG; gtv[ai][m] = GATEp[a]; }
#pragma unroll
        for (int ai = 0; ai < 2; ++ai)
#pragma unroll
            for (int m = 0; m < 4; ++m) { const float gt = gtv[ai][m]; bf16_t* rowp = Yp + (size_t)asgv[ai][m] * D + cc;
#pragma unroll
                for (int bj = 0; bj < 2; ++bj) { const f32x4 v0 = (acc[ai][bj][m][0] + bv[bj][0]) * gt, v1 = (acc[ai][bj][m][1] + bv[bj][1]) * gt;
                    u32x4 w; w.x = cvt_pk_bf16(v0[0], v0[1]); w.y = cvt_pk_bf16(v0[2], v0[3]); w.z = cvt_pk_bf16(v1[0], v1[1]); w.w = cvt_pk_bf16(v1[2], v1[3]); *(u32x4*)(rowp + bj * HALF) = w; } }
    }
};

template <class Epi, class Sched, bool GATHER, bool ROWLIST>
__device__ __forceinline__ void gemm_phase(LAS unsigned char* lds, const char* Abase, const Sched& S, const Epi& E) {
    constexpr int K = 1024;
    int tid_l = threadIdx.x; asm volatile("" : "+v"(tid_l));
    const int tid = tid_l, wid = __builtin_amdgcn_readfirstlane(tid >> 6), lane = tid & 63, wr = wid >> 2, wc = wid & 3, fr = lane & 15, fq = lane >> 4;
    constexpr int nt = K / BK; constexpr unsigned Kb = (unsigned)K * 2u;
    unsigned voffB[2];
#pragma unroll
    for (int i = 0; i < 2; ++i) { int R, C; stage_rc(tid * 16 + i * 8192, R, C); const int Rb = Epi::PERM ? ((R & ~31) + perm32(R & 31)) : R; voffB[i] = (unsigned)(Rb * K + C) * 2u; }
    constexpr size_t kstep = (size_t)(BK * 2), hstep = (size_t)HALF * K * 2;
    const unsigned ldsw = (unsigned)wid * 1024u;
    const int aoff = lds_byte(wr * 64 + fr, fq * 8), boff = lds_byte(wc * 32 + fr, fq * 8);
    LAS int* rowbuf = (LAS int*)(lds + STAGE_BYTES);
#define G8_SA(b, h) (((b) * 2 + (h)) * HTB)
#define G8_SB(b, h) ((4 + (b) * 2 + (h)) * HTB)
#define G8_STAGE_A(bufoff, kb, v) do { _Pragma("unroll") for (int _i = 0; _i < 2; ++_i) \
        __builtin_amdgcn_global_load_lds((const unsigned*)((kb) + (size_t)(v)[_i]), (LAS unsigned*)(lds + (bufoff) + ldsw + _i * 8192), 16, 0, 0); } while (0)
#define G8_STAGE_B(bufoff, gbase) do { _Pragma("unroll") for (int _i = 0; _i < 2; ++_i) \
        __builtin_amdgcn_global_load_lds((const unsigned*)((gbase) + voffB[_i]), (LAS unsigned*)(lds + (bufoff) + ldsw + _i * 8192), 16, 0, 0); } while (0)
#define G8_LDA(dst, b, h) do { _Pragma("unroll") for (int m = 0; m < 4; ++m) _Pragma("unroll") for (int k = 0; k < 2; ++k) dst[m][k] = *(const LAS bf16x8*)(lds + G8_SA(b, h) + aoff + m * 2048 + k * 1024); } while (0)
#define G8_LDB(dst, b, h) do { _Pragma("unroll") for (int n = 0; n < 2; ++n) _Pragma("unroll") for (int k = 0; k < 2; ++k) dst[n][k] = *(const LAS bf16x8*)(lds + G8_SB(b, h) + boff + n * 2048 + k * 1024); } while (0)
#define G8_MMA(ai, bj, At, Bt) do { __builtin_amdgcn_s_setprio(1); _Pragma("unroll") for (int m = 0; m < 4; ++m) _Pragma("unroll") for (int n = 0; n < 2; ++n) _Pragma("unroll") for (int k = 0; k < 2; ++k) \
        acc[ai][bj][m][n] = __builtin_amdgcn_mfma_f32_16x16x32_bf16(Bt[n][k], At[m][k], acc[ai][bj][m][n], 0, 0, 0); __builtin_amdgcn_s_setprio(0); } while (0)
#define G8_WAIT_V(n) asm volatile("s_waitcnt vmcnt(" #n ")" ::: "memory")
#define G8_WAIT_L(n) asm volatile("s_waitcnt lgkmcnt(" #n ")" ::: "memory")
#define G8_BAR __builtin_amdgcn_s_barrier()
#define G8_SCHED __builtin_amdgcn_sched_barrier(0)
#define G8_LISTDMA(u, s) do { if (wid < 4) __builtin_amdgcn_global_load_lds((const unsigned*)(S.list + (size_t)(u).ex * LCAP + (u).lrow + wid * 64 + lane), (LAS unsigned*)(rowbuf + (s) * 256 + wid * 64), 4, 0, 0); } while (0)
#define G8_ROWS_DENSE(v) do { _Pragma("unroll") for (int _i = 0; _i < 2; ++_i) { int _R, _C; stage_rc(tid * 16 + _i * 8192, _R, _C); _Pragma("unroll") for (int _h = 0; _h < 2; ++_h) (v)[_h][_i] = (unsigned)(_h * HALF + _R) * Kb + (unsigned)_C * 2u; } } while (0)
#define G8_ROWS_LIST(v, u, s) do { _Pragma("unroll") for (int _i = 0; _i < 2; ++_i) { int _R, _C; stage_rc(tid * 16 + _i * 8192, _R, _C); _Pragma("unroll") for (int _h = 0; _h < 2; ++_h) { const int _r = _h * HALF + _R; const int _a = rowbuf[(s) * 256 + _r]; \
        (v)[_h][_i] = (unsigned)(_r < (u).nvalid ? (_a >> 2) : 0) * Kb + (unsigned)_C * 2u; } } } while (0)
    Unit cur, nxt; int ui = 0, slot = 0;
    if (!S.next(0, cur)) return;
    unsigned vA[2][2];
    if constexpr (ROWLIST) { G8_LISTDMA(cur, 0); G8_WAIT_V(0); G8_BAR; }
    if constexpr (GATHER) { G8_ROWS_LIST(vA, cur, 0); } else { G8_ROWS_DENSE(vA); }
    f32x4 acc[2][2][4][2];
#pragma unroll
    for (int a = 0; a < 2; ++a)
#pragma unroll
        for (int b = 0; b < 2; ++b)
#pragma unroll
            for (int m = 0; m < 4; ++m)
#pragma unroll
                for (int n = 0; n < 2; ++n) acc[a][b][m][n] = (f32x4){0.f, 0.f, 0.f, 0.f};
    bf16x8 At[4][2], B0[2][2], B1[2][2];
    const char* cB = S.bptr(cur);
    const char* cA = GATHER ? Abase : Abase + (size_t)cur.row0 * Kb;
    G8_STAGE_B(G8_SB(0, 0), cB); G8_STAGE_B(G8_SB(0, 1), cB + hstep); G8_STAGE_A(G8_SA(0, 0), cA, vA[0]); G8_STAGE_A(G8_SA(0, 1), cA, vA[1]);
    if (wr == 1) G8_BAR;
    G8_WAIT_V(2); G8_BAR;
    G8_STAGE_B(G8_SB(1, 0), cB + kstep); G8_STAGE_A(G8_SA(1, 0), cA + kstep, vA[0]); G8_STAGE_B(G8_SB(1, 1), cB + hstep + kstep);
    G8_WAIT_V(6); G8_BAR;
    for (;;) {
        const bool has_next = S.next(ui + 1, nxt);
        const char* nB = has_next ? S.bptr(nxt) : cB;
        const char* nA = (GATHER || !has_next) ? cA : Abase + (size_t)nxt.row0 * Kb;
        const int nslot = slot == 2 ? 0 : slot + 1;
        if constexpr (ROWLIST) { if (has_next) G8_LISTDMA(nxt, nslot); }
        for (int t = 0; t < nt; t += 2) {
            const bool last = (t == nt - 2);
            const char* a1 = cA + (size_t)(t + 1) * kstep;
            const char* a2 = last ? nA : cA + (size_t)(t + 2) * kstep; const char* b2 = last ? nB : cB + (size_t)(t + 2) * kstep;
            const char* a3 = a2 + kstep; const char* b3 = b2 + kstep;
            G8_LDB(B0, 0, 0); G8_LDB(B1, 0, 1); G8_SCHED; G8_LDA(At, 0, 0); G8_STAGE_A(G8_SA(1, 1), a1, vA[1]);
            if constexpr (GATHER) { if (last && has_next) { G8_ROWS_LIST(vA, nxt, nslot); } }
            G8_WAIT_V(8); G8_WAIT_L(0); G8_BAR; G8_MMA(0, 0, At, B0); G8_MMA(0, 1, At, B1); G8_BAR; G8_SCHED;
            G8_LDA(At, 0, 1); G8_STAGE_B(G8_SB(0, 0), b2); G8_STAGE_B(G8_SB(0, 1), b2 + hstep); G8_STAGE_A(G8_SA(0, 0), a2, vA[0]);
            G8_WAIT_V(8); G8_WAIT_L(0); G8_BAR; G8_MMA(1, 0, At, B0); G8_MMA(1, 1, At, B1); G8_BAR; G8_SCHED;
            G8_LDB(B0, 1, 0); G8_LDB(B1, 1, 1); G8_SCHED; G8_LDA(At, 1, 0); G8_STAGE_A(G8_SA(0, 1), a2, vA[1]);
            G8_WAIT_V(8); G8_WAIT_L(0); G8_BAR; G8_MMA(0, 0, At, B0); G8_MMA(0, 1, At, B1); G8_BAR; G8_SCHED;
            G8_LDA(At, 1, 1); G8_STAGE_B(G8_SB(1, 0), b3); G8_STAGE_B(G8_SB(1, 1), b3 + hstep); G8_STAGE_A(G8_SA(1, 0), a3, vA[0]);
            G8_WAIT_V(8); G8_WAIT_L(0); G8_BAR; G8_MMA(1, 0, At, B0); G8_MMA(1, 1, At, B1); G8_BAR; G8_SCHED;
        }
        if (wr == 0) G8_BAR;
        { int t2 = threadIdx.x; asm volatile("" : "+v"(t2));
          const int w2 = __builtin_amdgcn_readfirstlane(t2 >> 6); E(acc, cur, w2 >> 2, w2 & 3, t2 & 15, (t2 & 63) >> 4, rowbuf + slot * 256); }
        if (!has_next) break;
#pragma unroll
        for (int a = 0; a < 2; ++a)
#pragma unroll
            for (int b = 0; b < 2; ++b)
#pragma unroll
                for (int m = 0; m < 4; ++m)
#pragma unroll
                    for (int n = 0; n < 2; ++n) acc[a][b][m][n] = (f32x4){0.f, 0.f, 0.f, 0.f};
        cur = nxt; cB = nB; cA = nA; ++ui; slot = nslot;
        if (wr == 1) G8_BAR;
    }
    G8_WAIT_V(0);
    G8_BAR;
#undef G8_SA
#undef G8_SB
#undef G8_STAGE_A
#undef G8_STAGE_B
#undef G8_LDA
#undef G8_LDB
#undef G8_MMA
#undef G8_WAIT_V
#undef G8_WAIT_L
#undef G8_BAR
#undef G8_SCHED
#undef G8_LISTDMA
#undef G8_ROWS_DENSE
#undef G8_ROWS_LIST
}
}

namespace fft {
constexpr int TP = 72;
constexpr int UP = 264;
constexpr int ZP = 520;
constexpr int O_TC = 0, O_TS = 9216, O_U = 18432, O_X = 52224, O_TW = 125952;
__device__ __forceinline__ bf16x8 neg8(bf16x8 v) { u32x4 w = __builtin_bit_cast(u32x4, v); w = w ^ 0x80008000u; return __builtin_bit_cast(bf16x8, w); }
__device__ __forceinline__ void build_tables(LAS unsigned char* lds, const float* TABC, const float* TABS, int tid) {
    for (int i = tid; i < 4096; i += 512) { const int a = i >> 6, b = i & 63, ix = ((a * b) & 63) * 64;
        ((LAS bf16_t*)(lds + O_TC))[a * TP + b] = f2bf(TABC[ix]); ((LAS bf16_t*)(lds + O_TS))[a * TP + b] = f2bf(TABS[ix]); }
}
__device__ __forceinline__ void stage_a(LAS unsigned char* lds, const bf16_t* P, const float* TABC, const float* TABS, bf16_t* ZBUF, int u0, int u1, int ustep) {
    int tid_l = threadIdx.x; asm volatile("" : "+v"(tid_l));
    const int tid = tid_l, lane = tid & 63, w = __builtin_amdgcn_readfirstlane(tid >> 6), fr = lane & 15, fq = lane >> 4;
    build_tables(lds, TABC, TABS, tid);
    const LAS bf16_t* Tc = (const LAS bf16_t*)(lds + O_TC); const LAS bf16_t* Ts = (const LAS bf16_t*)(lds + O_TS);
    LAS bf16_t* U = (LAS bf16_t*)(lds + O_U); LAS bf16_t* X = (LAS bf16_t*)(lds + O_X); LAS float* TW = (LAS float*)(lds + O_TW);
    for (int unit = u0; unit < u1; unit += ustep) {
        const int b = unit >> 6, t2 = unit & 63;
#pragma unroll
        for (int i = 0; i < 4; ++i) { const int q = tid + 512 * i, t1 = q >> 5, ch = q & 31;
            *(LAS u32x4*)((LAS unsigned char*)U + t1 * (UP * 2) + ch * 16) = *(const u32x4*)(P + ((size_t)b * NPOS + CTX + 64 * t1 + t2) * PP + ch * 8); }
        if (tid < 64) { const int ix = tid * t2; TW[2 * tid] = TABC[ix]; TW[2 * tid + 1] = TABS[ix]; }
        __syncthreads();
        { const int g = w >> 1, part = w & 1; const LAS bf16_t* T = part ? Ts : Tc;
          f32x4 acc[4][4];
#pragma unroll
          for (int mt = 0; mt < 4; ++mt)
#pragma unroll
              for (int nt = 0; nt < 4; ++nt) acc[mt][nt] = (f32x4){0.f, 0.f, 0.f, 0.f};
#pragma unroll
          for (int ks = 0; ks < 2; ++ks) { bf16x8 a[4], bb[4];
#pragma unroll
              for (int mt = 0; mt < 4; ++mt) a[mt] = *(const LAS bf16x8*)(U + (16 * mt + fr) * UP + g * 64 + 32 * ks + 8 * fq);
#pragma unroll
              for (int nt = 0; nt < 4; ++nt) bb[nt] = *(const LAS bf16x8*)(T + (16 * nt + fr) * TP + 32 * ks + 8 * fq);
#pragma unroll
              for (int mt = 0; mt < 4; ++mt)
#pragma unroll
                  for (int nt = 0; nt < 4; ++nt) acc[mt][nt] = __builtin_amdgcn_mfma_f32_16x16x32_bf16(a[mt], bb[nt], acc[mt][nt], 0, 0, 0); }
          const float sg = part ? -1.f : 1.f;
#pragma unroll
          for (int mt = 0; mt < 4; ++mt)
#pragma unroll
              for (int nt = 0; nt < 4; ++nt) { const f32x4 v = acc[mt][nt] * sg; u32x2 o; o.x = pk2(v[0], v[1]); o.y = pk2(v[2], v[3]);
                  *(LAS u32x2*)(X + (part * 256 + g * 64 + 16 * nt + fr) * TP + 16 * mt + 4 * fq) = o; } }
        __syncthreads();
        f32x4 zr[4][2], zi[4][2];
#pragma unroll
        for (int mt = 0; mt < 4; ++mt)
#pragma unroll
            for (int n = 0; n < 2; ++n) { zr[mt][n] = (f32x4){0.f, 0.f, 0.f, 0.f}; zi[mt][n] = (f32x4){0.f, 0.f, 0.f, 0.f}; }
#pragma unroll
        for (int ks = 0; ks < 2; ++ks) { bf16x8 xr[2], xi[2];
#pragma unroll
            for (int n = 0; n < 2; ++n) { xr[n] = *(const LAS bf16x8*)(X + (32 * w + 16 * n + fr) * TP + 32 * ks + 8 * fq); xi[n] = *(const LAS bf16x8*)(X + (256 + 32 * w + 16 * n + fr) * TP + 32 * ks + 8 * fq); }
#pragma unroll
            for (int mt = 0; mt < 4; ++mt) { const bf16x8 c = *(const LAS bf16x8*)(Tc + (16 * mt + fr) * TP + 32 * ks + 8 * fq), s = *(const LAS bf16x8*)(Ts + (16 * mt + fr) * TP + 32 * ks + 8 * fq), ns = neg8(s);
#pragma unroll
                for (int n = 0; n < 2; ++n) { zr[mt][n] = __builtin_amdgcn_mfma_f32_16x16x32_bf16(c, xr[n], zr[mt][n], 0, 0, 0); zr[mt][n] = __builtin_amdgcn_mfma_f32_16x16x32_bf16(s, xi[n], zr[mt][n], 0, 0, 0);
                    zi[mt][n] = __builtin_amdgcn_mfma_f32_16x16x32_bf16(c, xi[n], zi[mt][n], 0, 0, 0); zi[mt][n] = __builtin_amdgcn_mfma_f32_16x16x32_bf16(ns, xr[n], zi[mt][n], 0, 0, 0); } } }
        __syncthreads();
        { LAS bf16_t* Zs = X;
#pragma unroll
          for (int mt = 0; mt < 4; ++mt)
#pragma unroll
              for (int i = 0; i < 4; ++i) { const int f1 = 16 * mt + 4 * fq + i; const float ct = TW[2 * f1], st = TW[2 * f1 + 1];
#pragma unroll
                  for (int n = 0; n < 2; ++n) { const float a = zr[mt][n][i], bq = zi[mt][n][i]; const int col = 32 * w + 16 * n + fr;
                      Zs[f1 * ZP + col] = f2bf(a * ct + bq * st); Zs[f1 * ZP + 256 + col] = f2bf(bq * ct - a * st); } } }
        __syncthreads();
#pragma unroll
        for (int i = 0; i < 8; ++i) { const int q = tid + 512 * i, f1 = q >> 6, ch = q & 63;
            *(u32x4*)(ZBUF + (((size_t)b * 64 + f1) * 64 + t2) * 512 + ch * 8) = *(const LAS u32x4*)((const LAS unsigned char*)X + f1 * (ZP * 2) + ch * 16); }
        __syncthreads();
    }
}
__device__ __forceinline__ void stage_b(LAS unsigned char* lds, const bf16_t* ZBUF, const float* TABC, const float* TABS, bf16_t* MIX, int G, int bx) {
    int tid_l = threadIdx.x; asm volatile("" : "+v"(tid_l));
    const int tid = tid_l, lane = tid & 63, w = __builtin_amdgcn_readfirstlane(tid >> 6), fr = lane & 15, fq = lane >> 4;
    build_tables(lds, TABC, TABS, tid);
    const LAS bf16_t* Tc = (const LAS bf16_t*)(lds + O_TC); const LAS bf16_t* Ts = (const LAS bf16_t*)(lds + O_TS);
    LAS bf16_t* Ys = (LAS bf16_t*)(lds + O_U); LAS bf16_t* ZT = (LAS bf16_t*)(lds + O_X);
    for (int unit = bx; unit < 256; unit += G) {
        const int b = unit >> 6, f1 = unit & 63;
        const bf16_t* Zg = ZBUF + ((size_t)b * 64 + f1) * 64 * 512;
#pragma unroll
        for (int i = 0; i < 4; ++i) { const int q = tid + 512 * i, p = q & 31, ch = q >> 5;
            const u32x4 r0 = *(const u32x4*)(Zg + (size_t)(2 * p) * 512 + ch * 8), r1 = *(const u32x4*)(Zg + (size_t)(2 * p + 1) * 512 + ch * 8);
#pragma unroll
            for (int j = 0; j < 4; ++j) { const unsigned a = r0[j], c = r1[j];
                *(LAS unsigned*)(ZT + (ch * 8 + 2 * j) * TP + 2 * p) = (a & 0xffffu) | (c << 16);
                *(LAS unsigned*)(ZT + (ch * 8 + 2 * j + 1) * TP + 2 * p) = (a >> 16) | (c & 0xffff0000u); } }
        __syncthreads();
        f32x4 y[4][2];
#pragma unroll
        for (int mt = 0; mt < 4; ++mt)
#pragma unroll
            for (int n = 0; n < 2; ++n) y[mt][n] = (f32x4){0.f, 0.f, 0.f, 0.f};
#pragma unroll
        for (int ks = 0; ks < 2; ++ks) { bf16x8 xr[2], xi[2];
#pragma unroll
            for (int n = 0; n < 2; ++n) { xr[n] = *(const LAS bf16x8*)(ZT + (32 * w + 16 * n + fr) * TP + 32 * ks + 8 * fq); xi[n] = *(const LAS bf16x8*)(ZT + (256 + 32 * w + 16 * n + fr) * TP + 32 * ks + 8 * fq); }
#pragma unroll
            for (int mt = 0; mt < 4; ++mt) { const bf16x8 c = *(const LAS bf16x8*)(Tc + (16 * mt + fr) * TP + 32 * ks + 8 * fq), s = *(const LAS bf16x8*)(Ts + (16 * mt + fr) * TP + 32 * ks + 8 * fq);
#pragma unroll
                for (int n = 0; n < 2; ++n) { y[mt][n] = __builtin_amdgcn_mfma_f32_16x16x32_bf16(c, xr[n], y[mt][n], 0, 0, 0); y[mt][n] = __builtin_amdgcn_mfma_f32_16x16x32_bf16(s, xi[n], y[mt][n], 0, 0, 0); } } }
#pragma unroll
        for (int mt = 0; mt < 4; ++mt)
#pragma unroll
            for (int i = 0; i < 4; ++i)
#pragma unroll
                for (int n = 0; n < 2; ++n) Ys[(16 * mt + 4 * fq + i) * UP + 32 * w + 16 * n + fr] = f2bf(y[mt][n][i] * (1.f / 512.f));
        __syncthreads();
#pragma unroll
        for (int i = 0; i < 4; ++i) { const int q = tid + 512 * i, f2 = q >> 5, ch = q & 31;
            *(u32x4*)(MIX + ((size_t)b * NPOS + CTX + f1 + 64 * f2) * D + ch * 8) = *(const LAS u32x4*)((const LAS unsigned char*)Ys + f2 * (UP * 2) + ch * 16); }
        __syncthreads();
    }
}
}

namespace cv {
constexpr int SCR_BYTES = 64 * 33 * 4;
struct Job { const float* wgu; const float* wdn; unsigned char* ws; unsigned n0, first0, first1, nv; };
__device__ __forceinline__ void decode(const Job& J, unsigned v, const float*& src, unsigned& N, bf16_t*& dst) {
    const unsigned l = v < J.n0 ? 0u : 1u, j = v < J.n0 ? J.first0 + v : J.first1 + (v - J.n0);
    if (j < 32768u) { const unsigned e = j >> 10, kb = (j >> 6) & 15u, n0 = 32u * (j & 63u), c2 = n0 & 1023u, drow = (c2 >> 7) * 256u + (n0 >> 10) * 128u + (c2 & 127u);
        src = J.wgu + ((size_t)(l * NE + e) << 21) + ((size_t)kb << 17) + n0; N = 2048u; dst = (bf16_t*)(J.ws + L::WGUT) + ((size_t)(l * NE + e) << 21) + ((size_t)drow << 10) + 64u * kb; }
    else { const unsigned r = j - 32768u, e = r >> 9, kb = (r >> 5) & 15u, nb = r & 31u;
        src = J.wdn + ((size_t)(l * NE + e) << 20) + ((size_t)kb << 16) + 32u * nb; N = 1024u; dst = (bf16_t*)(J.ws + L::WDT) + ((size_t)(l * NE + e) << 20) + ((size_t)nb << 15) + 64u * kb; }
}
__device__ __forceinline__ void glds16(const void* gsrc, unsigned lds_dst) {
    unsigned keep;
    asm volatile("s_mov_b32 %0, m0\n\ts_mov_b32 m0, %2\n\ts_nop 0\n\tglobal_load_lds_dwordx4 %1, off nt\n\ts_mov_b32 m0, %0" : "=&s"(keep) : "v"(gsrc), "s"(lds_dst) : "memory");
}
__device__ __forceinline__ void issue(const float* src, unsigned N, unsigned scr_addr, int lane) {
    const unsigned kr = lane >> 3, nc = (lane & 7) * 4; const char* gp = (const char*)src + (size_t)((kr * N + nc) * 4u); const unsigned step = 32u * N;
#pragma unroll
    for (int i = 0; i < 8; ++i) glds16(gp + (size_t)(i * step), scr_addr + 1056u * i);
}
__device__ __forceinline__ void finish(bf16_t* dst, const LAS float* scr, int lane) {
    const int c = lane & 7; const unsigned off = ((unsigned)(lane >> 3) * D + 8u * c) * 2u;
#pragma unroll
    for (int j = 0; j < 4; ++j) { const LAS float* s = scr + 264 * c + (lane >> 3) + 8 * j;
        u32x4 o; o.x = pk2(s[0 * 32], s[1 * 32]); o.y = pk2(s[2 * 32], s[3 * 32]); o.z = pk2(s[4 * 32], s[5 * 32]); o.w = pk2(s[6 * 32], s[7 * 32]);
        __builtin_nontemporal_store(o, (u32x4*)((char*)dst + (off + j * (8u * D * 2u)))); }
    asm volatile("s_waitcnt lgkmcnt(0)" ::: "memory");
}
}

namespace attn {
typedef float f32x16 __attribute__((ext_vector_type(16)));
typedef float f32x2_t __attribute__((ext_vector_type(2))); typedef __bf16 bf16x2_t __attribute__((ext_vector_type(2)));
__device__ __forceinline__ unsigned cvtpk(float lo, float hi) { f32x2_t v = {lo, hi}; bf16x2_t b = __builtin_convertvector(v, bf16x2_t); return __builtin_bit_cast(unsigned, b); }
constexpr int KP = 104, VP = 68;
constexpr int KT_BYTES = 64 * KP * 2, VT_BYTES = 64 * VP * 2, BUF_BYTES = KT_BYTES + VT_BYTES;
constexpr float THR = 8.f; constexpr int NWAVES_ATT = 8;
__device__ __forceinline__ void attn_phase(LAS unsigned char* lds, const bf16_t* QL, const bf16_t* QC, const bf16_t* KB, const bf16_t* VTG, bf16_t* MIX, int with_ctx, int G, int vcu, const cv::Job& J, bool cv_on) {
    const int nunits = 256 + (with_ctx ? 16 : 0);
    for (int unit = vcu; unit < nunits; unit += G) {
        int tid_l = threadIdx.x; asm volatile("" : "+v"(tid_l));
        const int tid = tid_l, lane = tid & 63, wid = __builtin_amdgcn_readfirstlane(tid >> 6), r32 = lane & 31, hi = lane >> 5;
        int bh, nk, orow0; const bf16_t* Qp;
        if (unit < 256) { bh = unit >> 4; const int qb = unit & 15; Qp = QL + ((size_t)bh * SEQ + qb * 256) * 96; nk = NPOS; orow0 = (bh >> 2) * NPOS + CTX + qb * 256; }
        else { bh = unit - 256; Qp = QC + (size_t)bh * CTX * 96; nk = CTX; orow0 = (bh >> 2) * NPOS; }
        const int hh = bh & 3, NT = nk / 64;
        const bf16_t* Kg = KB + (size_t)bh * NPOS * 96; const bf16_t* Vg = VTG + (size_t)bh * 64 * NPOS;
        bf16x8 qf[6];
        { const bf16_t* qp = Qp + (size_t)(wid * 32 + r32) * 96 + 8 * hi;
#pragma unroll
          for (int ds = 0; ds < 6; ++ds) qf[ds] = *(const bf16x8*)(qp + 16 * ds); }
        f32x16 o0 = {}, o1 = {}, negm = {}; float mhat = 0.f, l = 0.f;
        const int kr0 = tid / 12, kc0 = tid % 12, kr1 = (tid + 256) / 12, kc1 = (tid + 256) % 12, kr2 = (tid + 512) / 12, kc2 = (tid + 512) % 12;
        const int vd = tid >> 3, vc = tid & 7;
        u32x4 sk0, sk1, sk2, sv0, sv1;
#define AT_LOAD(t_) do { const size_t k0_ = (size_t)(t_) * 64; sk0 = *(const u32x4*)(Kg + (k0_ + kr0) * 96 + kc0 * 8); sk1 = *(const u32x4*)(Kg + (k0_ + kr1) * 96 + kc1 * 8); sk2 = *(const u32x4*)(Kg + (k0_ + kr2) * 96 + kc2 * 8); \
            sv0 = *(const u32x4*)(Vg + (size_t)vd * NPOS + k0_ + vc * 8); sv1 = *(const u32x4*)(Vg + (size_t)(vd + 32) * NPOS + k0_ + vc * 8); } while (0)
#define AT_STORE(slot_) do { LAS unsigned char* bp_ = lds + (slot_) * BUF_BYTES; *(LAS u32x4*)(bp_ + kr0 * (KP * 2) + kc0 * 16) = sk0; *(LAS u32x4*)(bp_ + kr1 * (KP * 2) + kc1 * 16) = sk1; *(LAS u32x4*)(bp_ + kr2 * (KP * 2) + kc2 * 16) = sk2; \
            *(LAS u32x4*)(bp_ + KT_BYTES + vd * (VP * 2) + vc * 16) = sv0; *(LAS u32x4*)(bp_ + KT_BYTES + (vd + 32) * (VP * 2) + vc * 16) = sv1; } while (0)
#define AT_QK(P0, P1, slot_) do { const LAS bf16_t* Kt_ = (const LAS bf16_t*)(lds + (slot_) * BUF_BYTES); \
        _Pragma("unroll") for (int ds = 0; ds < 6; ++ds) { const bf16x8 k0f = *(const LAS bf16x8*)(Kt_ + r32 * KP + 16 * ds + 8 * hi), k1f = *(const LAS bf16x8*)(Kt_ + (32 + r32) * KP + 16 * ds + 8 * hi); \
            if (ds == 0) { P0 = __builtin_amdgcn_mfma_f32_32x32x16_bf16(k0f, qf[0], negm, 0, 0, 0); P1 = __builtin_amdgcn_mfma_f32_32x32x16_bf16(k1f, qf[0], negm, 0, 0, 0); } \
            else { P0 = __builtin_amdgcn_mfma_f32_32x32x16_bf16(k0f, qf[ds], P0, 0, 0, 0); P1 = __builtin_amdgcn_mfma_f32_32x32x16_bf16(k1f, qf[ds], P1, 0, 0, 0); } } } while (0)
#define MX3(a_, b_, c_) __builtin_fmaxf(__builtin_fmaxf((a_), (b_)), (c_))
#define AT_STEP(C0, C1, N0, N1, t_, STO_, PRE_) do { \
            if ((t_) + 1 < NT) AT_QK(N0, N1, s_nxt); \
            float mx_ = MX3(C0[0], C0[1], C1[0]), my_ = MX3(C0[2], C0[3], C1[1]); mx_ = MX3(mx_, C1[2], C1[3]); \
            _Pragma("unroll") for (int r = 4; r < 16; r += 4) { mx_ = MX3(mx_, C0[r], C0[r + 1]); my_ = MX3(my_, C0[r + 2], C0[r + 3]); mx_ = MX3(mx_, C1[r], C1[r + 1]); my_ = MX3(my_, C1[r + 2], C1[r + 3]); } \
            mx_ = fmaxf(mx_, my_); mx_ = fmaxf(mx_, __shfl_xor(mx_, 32)); \
            if (__builtin_expect((t_) == 0 || __any(mx_ > THR), 0)) { const float dl = (t_) == 0 ? mx_ : fmaxf(mx_, 0.f), f = __builtin_amdgcn_exp2f(-dl); mhat += dl; l *= f; \
                _Pragma("unroll") for (int r = 0; r < 16; ++r) { C0[r] -= dl; C1[r] -= dl; o0[r] *= f; o1[r] *= f; negm[r] = -mhat; } \
                if ((t_) + 1 < NT) { _Pragma("unroll") for (int r = 0; r < 16; ++r) { N0[r] -= dl; N1[r] -= dl; } } } \
            float ls_ = 0.f; \
            _Pragma("unroll") for (int r = 0; r < 16; ++r) { C0[r] = __builtin_amdgcn_exp2f(C0[r]); C1[r] = __builtin_amdgcn_exp2f(C1[r]); ls_ += C0[r] + C1[r]; } \
            l += ls_; \
            const LAS bf16_t* Vt_ = (const LAS bf16_t*)(lds + s_cur * BUF_BYTES + KT_BYTES); \
            _Pragma("unroll") for (int q = 0; q < 4; ++q) { u32x4 pw_; \
                _Pragma("unroll") for (int j = 0; j < 4; ++j) { const int r = 8 * (q & 1) + 2 * j; pw_[j] = (q < 2) ? cvtpk(C0[r], C0[r + 1]) : cvtpk(C1[r], C1[r + 1]); } \
                const bf16x8 pf_ = __builtin_bit_cast(bf16x8, pw_); const int kvb = 32 * (q >> 1) + 16 * (q & 1) + 4 * hi; \
                _Pragma("unroll") for (int db = 0; db < 2; ++db) { const u32x2 va = *(const LAS u32x2*)(Vt_ + (32 * db + r32) * VP + kvb), vb = *(const LAS u32x2*)(Vt_ + (32 * db + r32) * VP + kvb + 8); \
                    const u32x4 vw = {va.x, va.y, vb.x, vb.y}; const bf16x8 vf = __builtin_bit_cast(bf16x8, vw); \
                    if (db == 0) o0 = __builtin_amdgcn_mfma_f32_32x32x16_bf16(vf, pf_, o0, 0, 0, 0); else o1 = __builtin_amdgcn_mfma_f32_32x32x16_bf16(vf, pf_, o1, 0, 0, 0); } } \
            if ((t_) + 2 < NT) { STO_; } \
            PRE_; \
            __syncthreads(); \
            { const int tmp_ = s_cur; s_cur = s_nxt; s_nxt = s_ld; s_ld = tmp_; } } while (0)
        if (wid < 4) { AT_LOAD(0); AT_STORE(0); if (NT > 1) { AT_LOAD(1); AT_STORE(1); } }
        __syncthreads();
        f32x16 pA0, pA1, pB0, pB1;
        AT_QK(pA0, pA1, 0);
        int s_cur = 0, s_nxt = 1, s_ld = 2;
        const unsigned cvb = (cv_on && unit < 256 && wid >= 4) ? (unsigned)(vcu * 4 + (wid - 4)) : J.nv;
#define CV_HAS(q_) ((q_) >= 0 && cvb + 1024u * (unsigned)(q_) < J.nv)
#define CV_WAIT(q_) do { if (CV_HAS((q_) - 1)) { const bool f_ = (q_) >= 2; const bool i_ = CV_HAS(q_); if (f_ && i_) asm volatile("s_waitcnt vmcnt(12)" ::: "memory"); else if (i_) asm volatile("s_waitcnt vmcnt(8)" ::: "memory"); \
            else if (f_) asm volatile("s_waitcnt vmcnt(4)" ::: "memory"); else asm volatile("s_waitcnt vmcnt(0)" ::: "memory"); } } while (0)
        LAS float* cscr = (LAS float*)(lds + 3 * BUF_BYTES + ((wid & 3) * 2) * cv::SCR_BYTES);
        const unsigned cscr_addr = __builtin_amdgcn_readfirstlane((unsigned)(unsigned long)cscr);
        const float* csrc = J.wgu; unsigned cN = 2048u; bf16_t* cdst = (bf16_t*)(J.ws + L::WGUT);
        if (wid < 4) {
            for (int t = 0; t < NT; t += 2) {
                if (t + 2 < NT) AT_LOAD(t + 2);
                AT_STEP(pA0, pA1, pB0, pB1, t, AT_STORE(s_ld), (void)0);
                if (t + 3 < NT) AT_LOAD(t + 3);
                AT_STEP(pB0, pB1, pA0, pA1, t + 1, AT_STORE(s_ld), (void)0);
            }
        } else {
            for (int t = 0; t < NT; t += 2) {
                const int q = t >> 1;
                if (CV_HAS(q - 2)) { cv::decode(J, cvb + 1024u * (unsigned)(q - 2), csrc, cN, cdst); cv::finish(cdst, cscr + (q & 1) * (cv::SCR_BYTES / 4), lane); }
                if (CV_HAS(q)) { cv::decode(J, cvb + 1024u * (unsigned)q, csrc, cN, cdst); cv::issue(csrc, cN, cscr_addr + (unsigned)(q & 1) * cv::SCR_BYTES, lane); }
                AT_STEP(pA0, pA1, pB0, pB1, t, (void)0, (void)0);
                AT_STEP(pB0, pB1, pA0, pA1, t + 1, (void)0, CV_WAIT(q));
            }
        }
        if (cvb < J.nv) {
            asm volatile("s_waitcnt vmcnt(0)" ::: "memory");
        }
        if (cv_on && unit < 256) __syncthreads();
        if (cvb < J.nv) { const int q = NT >> 1;
            if (CV_HAS(q - 2)) { cv::decode(J, cvb + 1024u * (unsigned)(q - 2), csrc, cN, cdst); cv::finish(cdst, cscr + (q & 1) * (cv::SCR_BYTES / 4), lane); }
            if (CV_HAS(q - 1)) { cv::decode(J, cvb + 1024u * (unsigned)(q - 1), csrc, cN, cdst); cv::finish(cdst, cscr + ((q + 1) & 1) * (cv::SCR_BYTES / 4), lane); } }
#undef CV_HAS
#undef CV_WAIT
#undef AT_LOAD
#undef AT_STORE
#undef AT_QK
#undef AT_STEP
#undef MX3
        l += __shfl_xor(l, 32);
        const float il = 1.f / l;
        bf16_t* op = MIX + (size_t)(orow0 + wid * 32 + r32) * D + 512 + hh * 64 + 4 * hi;
#pragma unroll
        for (int g4 = 0; g4 < 4; ++g4) { u32x2 w0, w1; w0.x = cvtpk(o0[4 * g4] * il, o0[4 * g4 + 1] * il); w0.y = cvtpk(o0[4 * g4 + 2] * il, o0[4 * g4 + 3] * il);
            w1.x = cvtpk(o1[4 * g4] * il, o1[4 * g4 + 1] * il); w1.y = cvtpk(o1[4 * g4 + 2] * il, o1[4 * g4 + 3] * il);
            *(u32x2*)(op + 8 * g4) = w0; *(u32x2*)(op + 32 + 8 * g4) = w1; }
    }
}
}

namespace sm {
__device__ __forceinline__ float silu(float x) { return x / (1.f + __expf(-x)); }
__device__ __forceinline__ void mod_phase(LAS unsigned char* lds, const float* c, const float* c_ctx, const float* mod_w, const float* mod_b, float* MOD, int G, int bx, int tid) {
    LAS float* s = (LAS float*)lds;
    for (int i = tid; i < 5120; i += 512) { const int v = i >> 10, k = i & 1023; s[i] = silu(v < 4 ? c[v * 1024 + k] : c_ctx[k]); }
    __syncthreads();
    LAS float* red = s + 5120;
    for (int unit = bx; unit < 96; unit += G) {
        const int l = unit / 48, cb = unit % 48, cl = tid & 127, col = cb * 128 + cl, kq = tid >> 7, k0 = kq * 256;
        const float* W = mod_w + ((size_t)l * 1024 + k0) * 6144 + col;
        float a0 = 0.f, a1 = 0.f, a2 = 0.f, a3 = 0.f, a4 = 0.f;
#pragma unroll 16
        for (int k = 0; k < 256; ++k) { const float w = W[(size_t)k * 6144]; a0 += s[k0 + k] * w; a1 += s[1024 + k0 + k] * w; a2 += s[2048 + k0 + k] * w; a3 += s[3072 + k0 + k] * w; a4 += s[4096 + k0 + k] * w; }
        LAS float* rq = red + kq * 640 + cl; rq[0] = a0; rq[128] = a1; rq[256] = a2; rq[384] = a3; rq[512] = a4;
        __syncthreads();
        for (int i = tid; i < 640; i += 512) { const int v = i >> 7, cc = i & 127; const float r = ((red[i] + red[640 + i]) + (red[1280 + i] + red[1920 + i])) + mod_b[l * 6144 + cb * 128 + cc];
            MOD[((size_t)l * 5 + v) * 6144 + cb * 128 + cc] = r; }
        __syncthreads();
    }
}
__device__ __forceinline__ void norm_store(const float4 (&x)[4], float ss, const float* g, const float* mv, int sh_off, int sc_off, bf16_t* xn_row, int lane) {
    const float rs = rsqrtf(wave_sum(ss) * (1.f / D) + 1e-6f);
#pragma unroll
    for (int j = 0; j < 4; ++j) { const int c = (j * 64 + lane) * 4; const float4 gg = *(const float4*)(g + c), sh = *(const float4*)(mv + sh_off + c), sc = *(const float4*)(mv + sc_off + c);
        u32x2 o; o.x = pk2(x[j].x * rs * gg.x * (1.f + sc.x) + sh.x, x[j].y * rs * gg.y * (1.f + sc.y) + sh.y); o.y = pk2(x[j].z * rs * gg.z * (1.f + sc.z) + sh.z, x[j].w * rs * gg.w * (1.f + sc.w) + sh.w);
        *(u32x2*)(xn_row + c) = o; }
}
__device__ __forceinline__ void pro1_phase(const float* x, const float* ctx, const float* g, const float* MODl, float* H, bf16_t* XN, int r_first, int r_end, int r_step, int lane) {
    for (int r = r_first; r < r_end; r += r_step) { const int b = r / NPOS, pos = r % NPOS, v = pos < CTX ? 4 : b;
        const float* src = pos < CTX ? ctx + ((size_t)b * CTX + pos) * D : x + ((size_t)b * SEQ + (pos - CTX)) * D;
        float4 xv[4]; float ss = 0.f;
#pragma unroll
        for (int j = 0; j < 4; ++j) { const int c = (j * 64 + lane) * 4; xv[j] = *(const float4*)(src + c); ss += xv[j].x * xv[j].x + xv[j].y * xv[j].y + xv[j].z * xv[j].z + xv[j].w * xv[j].w; }
#pragma unroll
        for (int j = 0; j < 4; ++j) *(float4*)(H + (size_t)r * D + (j * 64 + lane) * 4) = xv[j];
        norm_store(xv, ss, g, MODl + (size_t)v * 6144, 0, 1024, XN + (size_t)r * D, lane); }
}
__device__ __forceinline__ void comb_phase(int l, float* H, const bf16_t* Y, const float* MODl, const float* g_next, const float* MODn, bf16_t* XN, const float* final_g, float* out, int gw, int NGW, int lane) {
    for (int r = gw; r < MROWS; r += NGW) { const int b = r / NPOS, pos = r % NPOS, v = pos < CTX ? 4 : b;
        if (l == 1 && pos < CTX) continue;
        const float* g2 = MODl + (size_t)v * 6144 + 5120;
        float4 xv[4]; float ss = 0.f;
#pragma unroll
        for (int j = 0; j < 4; ++j) { const int c = (j * 64 + lane) * 4; xv[j] = *(const float4*)(H + (size_t)r * D + c); float4 s = make_float4(0.f, 0.f, 0.f, 0.f);
#pragma unroll
            for (int k = 0; k < 4; ++k) { const u32x2 y = *(const u32x2*)(Y + ((size_t)r * 4 + k) * D + c); s.x += __uint_as_float(y.x << 16); s.y += __uint_as_float(y.x & 0xffff0000u); s.z += __uint_as_float(y.y << 16); s.w += __uint_as_float(y.y & 0xffff0000u); }
            const float4 gg = *(const float4*)(g2 + c); xv[j].x += gg.x * s.x; xv[j].y += gg.y * s.y; xv[j].z += gg.z * s.z; xv[j].w += gg.w * s.w;
            ss += xv[j].x * xv[j].x + xv[j].y * xv[j].y + xv[j].z * xv[j].z + xv[j].w * xv[j].w; }
        if (l == 0) {
#pragma unroll
            for (int j = 0; j < 4; ++j) *(float4*)(H + (size_t)r * D + (j * 64 + lane) * 4) = xv[j];
            norm_store(xv, ss, g_next, MODn + (size_t)v * 6144, 0, 1024, XN + (size_t)r * D, lane);
        } else { const float rs = rsqrtf(wave_sum(ss) * (1.f / D) + 1e-6f); float* op = out + ((size_t)b * SEQ + (pos - CTX)) * D;
#pragma unroll
            for (int j = 0; j < 4; ++j) { const int c = (j * 64 + lane) * 4; const float4 fg = *(const float4*)(final_g + c); float4 o; o.x = xv[j].x * rs * fg.x; o.y = xv[j].y * rs * fg.y; o.z = xv[j].z * rs * fg.z; o.w = xv[j].w * rs * fg.w; *(float4*)(op + c) = o; } }
    }
}
__device__ __forceinline__ void route_phase(LAS unsigned char* lds, int l, const float* H, const float* g, const float* MODl, const bf16_t* RWH, const bf16_t* RWL, const float* rb, bf16_t* XN, int* CNT, int* LIST, float* GATE,
                                            int G, int bx, int tid) {
    const int lane = tid & 63, wave = __builtin_amdgcn_readfirstlane(tid >> 6), fr = lane & 15, fq = lane >> 4;
    constexpr int FP = 1032;
    LAS bf16_t* FH = (LAS bf16_t*)lds; LAS bf16_t* FL = FH + 16 * FP;
    LAS float* PART = (LAS float*)(lds + 66048);
    LAS int* LCNT = (LAS int*)(lds + 66048 + 16384);
    LAS int* LBASE = LCNT + 64; LAS int* LENT = LCNT + 128;
    if (tid < 64) LCNT[tid] = 0;
    bf16x8 wh[2][4], wl[2][4];
#pragma unroll
    for (int nt = 0; nt < 2; ++nt)
#pragma unroll
        for (int ks = 0; ks < 4; ++ks) { const size_t o = ((size_t)l * NE + 16 * nt + fr) * D + 128 * wave + 32 * ks + 8 * fq; wh[nt][ks] = *(const bf16x8*)(RWH + o); wl[nt][ks] = *(const bf16x8*)(RWL + o); }
    const float bias = rb[lane & 31];
    __syncthreads();
    const int nb = l == 1 ? (MROWS - NB_ * CTX) / 16 : MROWS / 16;
    LAS float* LG = (LAS float*)(lds + 90112);
    LAS float* TOP = (LAS float*)(lds + 92160);
    float4 xv[2][4];
#define RT_ROW(q_) ((l == 1) ? ((q_) / SEQ) * NPOS + CTX + ((q_) % SEQ) : (q_))
#define RT_LOAD(bi_) do { _Pragma("unroll") for (int rr = 0; rr < 2; ++rr) { const int r_ = RT_ROW((bi_) * 16 + 2 * wave + rr); _Pragma("unroll") for (int j = 0; j < 4; ++j) xv[rr][j] = *(const float4*)(H + (size_t)r_ * D + (j * 64 + lane) * 4); } } while (0)
    if (bx < nb) RT_LOAD(bx);
    for (int bi = bx; bi < nb; bi += G) {
#pragma unroll
        for (int rr = 0; rr < 2; ++rr) { const int r = RT_ROW(bi * 16 + 2 * wave + rr);
            const int b = r / NPOS, pos = r % NPOS, v = pos < CTX ? 4 : b; const float* mv = MODl + (size_t)v * 6144;
            float ss = 0.f;
#pragma unroll
            for (int j = 0; j < 4; ++j) ss += xv[rr][j].x * xv[rr][j].x + xv[rr][j].y * xv[rr][j].y + xv[rr][j].z * xv[rr][j].z + xv[rr][j].w * xv[rr][j].w;
            const float rs = rsqrtf(wave_sum(ss) * (1.f / D) + 1e-6f);
#pragma unroll
            for (int j = 0; j < 4; ++j) { const int c = (j * 64 + lane) * 4; const float4 gg = *(const float4*)(g + c), sh = *(const float4*)(mv + 3072 + c), sc = *(const float4*)(mv + 4096 + c);
                float f[4]; f[0] = xv[rr][j].x * rs * gg.x * (1.f + sc.x) + sh.x; f[1] = xv[rr][j].y * rs * gg.y * (1.f + sc.y) + sh.y; f[2] = xv[rr][j].z * rs * gg.z * (1.f + sc.z) + sh.z; f[3] = xv[rr][j].w * rs * gg.w * (1.f + sc.w) + sh.w;
                u32x2 oh, ol; oh.x = pk2(f[0], f[1]); oh.y = pk2(f[2], f[3]);
                ol.x = pk2(f[0] - __uint_as_float(oh.x << 16), f[1] - __uint_as_float(oh.x & 0xffff0000u)); ol.y = pk2(f[2] - __uint_as_float(oh.y << 16), f[3] - __uint_as_float(oh.y & 0xffff0000u));
                *(u32x2*)(XN + (size_t)r * D + c) = oh; *(LAS u32x2*)(FH + (2 * wave + rr) * FP + c) = oh; *(LAS u32x2*)(FL + (2 * wave + rr) * FP + c) = ol; } }
        if (bi + G < nb) RT_LOAD(bi + G);
        __syncthreads();
        { f32x4 acc[2] = {(f32x4){0.f, 0.f, 0.f, 0.f}, (f32x4){0.f, 0.f, 0.f, 0.f}};
#pragma unroll
          for (int ks = 0; ks < 4; ++ks) { const bf16x8 ah = *(const LAS bf16x8*)(FH + fr * FP + 128 * wave + 32 * ks + 8 * fq), al = *(const LAS bf16x8*)(FL + fr * FP + 128 * wave + 32 * ks + 8 * fq);
#pragma unroll
              for (int nt = 0; nt < 2; ++nt) { acc[nt] = __builtin_amdgcn_mfma_f32_16x16x32_bf16(ah, wh[nt][ks], acc[nt], 0, 0, 0); acc[nt] = __builtin_amdgcn_mfma_f32_16x16x32_bf16(ah, wl[nt][ks], acc[nt], 0, 0, 0);
                  acc[nt] = __builtin_amdgcn_mfma_f32_16x16x32_bf16(al, wh[nt][ks], acc[nt], 0, 0, 0); } }
#pragma unroll
          for (int nt = 0; nt < 2; ++nt)
#pragma unroll
              for (int i = 0; i < 4; ++i) PART[(wave * 16 + 4 * fq + i) * 32 + 16 * nt + fr] = acc[nt][i]; }
        __syncthreads();
        { const int row = 2 * wave + (lane >> 5), e = lane & 31; const int r = RT_ROW(bi * 16 + row);
          float lg = bias;
#pragma unroll
          for (int kw = 0; kw < 8; ++kw) lg += PART[(kw * 16 + row) * 32 + e];
          LG[row * 32 + e] = lg;
          int rank = 0;
#pragma unroll
          for (int j4 = 0; j4 < 8; ++j4) { const f32x4 o = *(const LAS f32x4*)(LG + row * 32 + 4 * j4);
#pragma unroll
              for (int i = 0; i < 4; ++i) { const int j = 4 * j4 + i; rank += (o[i] > lg || (o[i] == lg && j < e)) ? 1 : 0; } }
          if (rank < 4) { TOP[(row * 4 + rank) * 2] = lg; TOP[(row * 4 + rank) * 2 + 1] = __int_as_float(e); }
          if (e == 0) { float tv[4]; int ti[4];
#pragma unroll
              for (int k = 0; k < 4; ++k) { tv[k] = TOP[(row * 4 + k) * 2]; ti[k] = __float_as_int(TOP[(row * 4 + k) * 2 + 1]); }
              float ex[4], sum = 0.f;
#pragma unroll
              for (int k = 0; k < 4; ++k) { ex[k] = __expf(tv[k] - tv[0]); sum += ex[k]; }
              const float isum = 1.f / sum;
#pragma unroll
              for (int k = 0; k < 4; ++k) { const int asg = r * 4 + k; GATE[asg] = ex[k] * isum; const int rk = __hip_atomic_fetch_add(&LCNT[ti[k]], 1, __ATOMIC_RELAXED, __HIP_MEMORY_SCOPE_WORKGROUP); const int slot = __hip_atomic_fetch_add(&LCNT[32], 1, __ATOMIC_RELAXED, __HIP_MEMORY_SCOPE_WORKGROUP);
                  LENT[slot * 2] = asg; LENT[slot * 2 + 1] = (ti[k] << 16) | rk; } } }
        __syncthreads();
    }
#undef RT_ROW
#undef RT_LOAD
    if (tid < 32) LBASE[tid] = LCNT[tid] > 0 ? atomicAdd(&CNT[tid * L::CNT_STRIDE], LCNT[tid]) : 0;
    __syncthreads();
    for (int i = tid; i < LCNT[32]; i += 512) { const int asg = LENT[i * 2], er = LENT[i * 2 + 1], ee = er >> 16, rank = er & 0xffff; LIST[(size_t)ee * LCAP + LBASE[ee] + rank] = asg; }
    __syncthreads();
}
__device__ __forceinline__ void smallw_phase(const float* w_uq, const float* qg, const float* w_ukv, const float* kvg, const float* w_a, const float* w_i, bf16_t* WUQT, bf16_t* WUKVT, bf16_t* WAT, bf16_t* WIT,
                                             float* TABC, float* TABS, const float* lam, float* SPT, const float* rw, bf16_t* RWHp, bf16_t* RWLp, int gt, int NGT) {
    for (int i = gt; i < 2 * 384 * 256; i += NGT) { const int l = i / (384 * 256), q = i % (384 * 256), n = q >> 8, k = q & 255; WUQT[i] = f2bf(qg[l * 256 + k] * w_uq[((size_t)l * 256 + k) * 384 + n]); }
    for (int i = gt; i < 2 * 512 * 128; i += NGT) { const int l = i / (512 * 128), q = i % (512 * 128), n = q >> 7, k = q & 127; WUKVT[i] = f2bf(kvg[l * 128 + k] * w_ukv[((size_t)l * 128 + k) * 512 + n]); }
    for (int i = gt; i < 16 * 4096; i += NGT) { const int m = i >> 12, q = i & 4095, e = q >> 6, d = q & 63; WAT[i] = f2bf(w_a[(size_t)m * 4096 + d * 64 + e]); WIT[i] = f2bf(w_i[(size_t)m * 4096 + d * 64 + e]); }
    for (int i = gt; i < 4096; i += NGT) { float s, c; sincospif((float)i / 2048.f, &s, &c); TABC[i] = c; TABS[i] = s; }
    for (int i = gt; i < 1024; i += NGT) SPT[i] = log1pf(__expf(-lam[i]));
    for (int i = gt; i < 2 * NE * D; i += NGT) { const int l = i / (NE * D), q = i % (NE * D), e = q >> 10, k = q & 1023; const float w = rw[((size_t)l * D + k) * NE + e]; const bf16_t h = f2bf(w); RWHp[i] = h; RWLp[i] = f2bf(w - bf2f(h)); }
}
}

namespace prep {
constexpr int O_KR = 0, O_CS = 8192, O_RS = 16384, O_CQ = 16896  , O_KS = 67072, O_CKV = 100864;
constexpr int CQP = 264, CKP = 136, QSP = 392, KSP = 264;
constexpr float C2 = 0.10206207261596577f * 1.4426950408889634f;
__device__ __forceinline__ void qkv_units(LAS unsigned char* lds, int l, const bf16_t* P, const bf16_t* WUQT, const bf16_t* WUKVT, const float* scw, const float* scb,
                                          bf16_t* QL, bf16_t* QC, bf16_t* KB, bf16_t* VTG, bf16_t* MIX, int u0, int u1, int ustep) {
    LAS float* KRo = (LAS float*)(lds + O_KR); LAS float* CS = (LAS float*)(lds + O_CS); LAS float* RS = (LAS float*)(lds + O_RS);
    LAS bf16_t* CQ = (LAS bf16_t*)(lds + O_CQ); LAS bf16_t* CK = (LAS bf16_t*)(lds + O_CKV); LAS bf16_t* KS = (LAS bf16_t*)(lds + O_KS); LAS bf16_t* QS = (LAS bf16_t*)(lds + O_CQ);
    for (int unit = u0; unit < u1; unit += ustep) {
        int tid_l = threadIdx.x; asm volatile("" : "+v"(tid_l));
        const int tid = tid_l, lane = tid & 63, w = __builtin_amdgcn_readfirstlane(tid >> 6), fr = lane & 15, fq = lane >> 4;
        const int b = unit / 68, chunk = unit % 68, pos0 = 64 * chunk; const bool ctxt = chunk < 4; const size_t r0 = (size_t)b * NPOS + pos0;
#pragma unroll
        for (int i = 0; i < 4; ++i) { const int q = tid + 512 * i, row = q >> 5, ch = q & 31; *(LAS u32x4*)((LAS unsigned char*)CQ + row * (CQP * 2) + ch * 16) = *(const u32x4*)(P + (r0 + row) * PP + C_CQ + ch * 8); }
#pragma unroll
        for (int i = 0; i < 2; ++i) { const int q = tid + 512 * i, row = q >> 4, ch = q & 15; *(LAS u32x4*)((LAS unsigned char*)CK + row * (CKP * 2) + ch * 16) = *(const u32x4*)(P + (r0 + row) * PP + C_CKV + ch * 8); }
        __syncthreads();
        { const int row = tid >> 3, j = tid & 7; float sq = 0.f, sk = 0.f;
#pragma unroll
          for (int i = 0; i < 4; ++i) { const u32x4 v = *(const LAS u32x4*)((const LAS unsigned char*)CQ + row * (CQP * 2) + j * 64 + i * 16);
#pragma unroll
              for (int e = 0; e < 4; ++e) { const float a = __uint_as_float(v[e] << 16), c = __uint_as_float(v[e] & 0xffff0000u); sq += a * a + c * c; } }
#pragma unroll
          for (int i = 0; i < 2; ++i) { const u32x4 v = *(const LAS u32x4*)((const LAS unsigned char*)CK + row * (CKP * 2) + j * 32 + i * 16);
#pragma unroll
              for (int e = 0; e < 4; ++e) { const float a = __uint_as_float(v[e] << 16), c = __uint_as_float(v[e] & 0xffff0000u); sk += a * a + c * c; } }
          sq += __shfl_xor(sq, 1); sq += __shfl_xor(sq, 2); sq += __shfl_xor(sq, 4); sk += __shfl_xor(sk, 1); sk += __shfl_xor(sk, 2); sk += __shfl_xor(sk, 4);
          if (j == 0) { RS[row * 2] = rsqrtf(sq * (1.f / 256.f) + 1e-6f); RS[row * 2 + 1] = rsqrtf(sk * (1.f / 128.f) + 1e-6f); }
          float cr = 1.f, sr = 0.f, cc = 1.f, sc = 0.f;
          if (!ctxt) { const int t = pos0 - CTX + row; const float inv = __expf(-9.210340371976184f * (float)j * 0.125f); float xa = (float)(t >> 6) * inv * 0.15915494309189535f; xa -= rintf(xa); sr = __sinf(xa * 6.283185307179586f); cr = __cosf(xa * 6.283185307179586f); float xb = (float)(t & 63) * inv * 0.15915494309189535f; xb -= rintf(xb); sc = __sinf(xb * 6.283185307179586f); cc = __cosf(xb * 6.283185307179586f); }
          CS[(row * 16 + j) * 2] = cr; CS[(row * 16 + j) * 2 + 1] = sr; CS[(row * 16 + 8 + j) * 2] = cc; CS[(row * 16 + 8 + j) * 2 + 1] = sc;
          const bf16_t* kp = P + (r0 + row) * PP + C_KR; const float z0 = bf2f(kp[j]), z1 = bf2f(kp[8 + j]), z2 = bf2f(kp[16 + j]), z3 = bf2f(kp[24 + j]);
          KRo[row * 32 + j] = z0 * cr - z1 * sr; KRo[row * 32 + 8 + j] = z0 * sr + z1 * cr; KRo[row * 32 + 16 + j] = z2 * cc - z3 * sc; KRo[row * 32 + 24 + j] = z2 * sc + z3 * cc; }
        __builtin_amdgcn_sched_barrier(0);
        { f32x4 qa[4][3];
#pragma unroll
          for (int mt = 0; mt < 4; ++mt)
#pragma unroll
              for (int n = 0; n < 3; ++n) qa[mt][n] = (f32x4){0.f, 0.f, 0.f, 0.f};
          const bf16_t* wq = WUQT + ((size_t)l * 384 + 48 * w + fr) * 256 + 8 * fq;
#pragma unroll
          for (int ks = 0; ks < 8; ++ks) { bf16x8 a[4], bb[3];
#pragma unroll
              for (int mt = 0; mt < 4; ++mt) a[mt] = *(const LAS bf16x8*)(CQ + (16 * mt + fr) * CQP + 32 * ks + 8 * fq);
#pragma unroll
              for (int n = 0; n < 3; ++n) bb[n] = *(const bf16x8*)(wq + (size_t)(16 * n) * 256 + 32 * ks);
#pragma unroll
              for (int mt = 0; mt < 4; ++mt)
#pragma unroll
                  for (int n = 0; n < 3; ++n) qa[mt][n] = __builtin_amdgcn_mfma_f32_16x16x32_bf16(a[mt], bb[n], qa[mt][n], 0, 0, 0); }
          __syncthreads();
#pragma unroll
          for (int n = 0; n < 3; ++n) { const int nt = 3 * w + n, m6 = nt % 6, col = 16 * nt + fr;
#pragma unroll
              for (int mt = 0; mt < 4; ++mt)
#pragma unroll
                  for (int i = 0; i < 4; ++i) { const int row = 16 * mt + 4 * fq + i; float v = qa[mt][n][i] * RS[row * 2];
                      if (m6 >= 4) { const float pv = __shfl_xor(v, 8); const int ci = (row * 16 + (m6 == 5 ? 8 : 0) + (fr & 7)) * 2; const float c = CS[ci], s = CS[ci + 1]; v = (fr < 8) ? v * c - pv * s : pv * s + v * c; }
                      QS[row * QSP + col] = f2bf(v * C2); } } }
        __builtin_amdgcn_sched_barrier(0);
        { f32x4 ka[4][4];
#pragma unroll
          for (int mt = 0; mt < 4; ++mt)
#pragma unroll
              for (int n = 0; n < 4; ++n) ka[mt][n] = (f32x4){0.f, 0.f, 0.f, 0.f};
          const bf16_t* wk = WUKVT + ((size_t)l * 512 + 64 * w + fr) * 128 + 8 * fq;
#pragma unroll
          for (int ks = 0; ks < 4; ++ks) { bf16x8 a[4], bb[4];
#pragma unroll
              for (int mt = 0; mt < 4; ++mt) a[mt] = *(const LAS bf16x8*)(CK + (16 * mt + fr) * CKP + 32 * ks + 8 * fq);
#pragma unroll
              for (int n = 0; n < 4; ++n) bb[n] = *(const bf16x8*)(wk + (size_t)(16 * n) * 128 + 32 * ks);
#pragma unroll
              for (int mt = 0; mt < 4; ++mt)
#pragma unroll
                  for (int n = 0; n < 4; ++n) ka[mt][n] = __builtin_amdgcn_mfma_f32_16x16x32_bf16(a[mt], bb[n], ka[mt][n], 0, 0, 0); }
          const int head = w >> 1;
          if ((w & 1) == 0) {
#pragma unroll
              for (int n = 0; n < 4; ++n)
#pragma unroll
                  for (int mt = 0; mt < 4; ++mt)
#pragma unroll
                      for (int i = 0; i < 4; ++i) { const int row = 16 * mt + 4 * fq + i; KS[row * KSP + head * 64 + 16 * n + fr] = f2bf(ka[mt][n][i] * RS[row * 2 + 1]); }
          } else {
#pragma unroll
              for (int n = 0; n < 4; ++n)
#pragma unroll
                  for (int mt = 0; mt < 4; ++mt) { const int rb = 16 * mt + 4 * fq; u32x2 o; o.x = pk2(ka[mt][n][0] * RS[rb * 2 + 1], ka[mt][n][1] * RS[rb * 2 + 3]); o.y = pk2(ka[mt][n][2] * RS[rb * 2 + 5], ka[mt][n][3] * RS[rb * 2 + 7]);
                      *(u32x2*)(VTG + ((size_t)(b * 4 + head) * 64 + 16 * n + fr) * NPOS + pos0 + rb) = o; } } }
        __syncthreads();
#pragma unroll
        for (int i = 0; i < 6; ++i) { const int q = tid + 512 * i, row = q / 48, rem = q % 48, head = rem / 12, ch = rem % 12, pos = pos0 + row;
            const u32x4 qv = *(const LAS u32x4*)((const LAS unsigned char*)QS + row * (QSP * 2) + (head * 96 + ch * 8) * 2);
            if (!ctxt) *(u32x4*)(QL + ((size_t)(b * 4 + head) * SEQ + (pos - CTX)) * 96 + ch * 8) = qv; else if (l == 0) *(u32x4*)(QC + ((size_t)(b * 4 + head) * CTX + pos) * 96 + ch * 8) = qv;
            u32x4 kv;
            if (ch < 8) kv = *(const LAS u32x4*)((const LAS unsigned char*)KS + row * (KSP * 2) + (head * 64 + ch * 8) * 2);
            else { const LAS float* kr = KRo + row * 32 + (ch - 8) * 8; kv.x = pk2(kr[0], kr[1]); kv.y = pk2(kr[2], kr[3]); kv.z = pk2(kr[4], kr[5]); kv.w = pk2(kr[6], kr[7]); }
            *(u32x4*)(KB + ((size_t)(b * 4 + head) * NPOS + pos) * 96 + ch * 8) = kv; }
        if (!(ctxt && l == 1)) { const int lo = ctxt ? 0 : CTX, hi = ctxt ? CTX : NPOS;
#pragma unroll
            for (int i = 0; i < 4; ++i) { const int q = tid + 512 * i, row = q >> 5, ch = q & 31, pos = pos0 + row; float acc[8];
#pragma unroll
                for (int e = 0; e < 8; ++e) acc[e] = scb[ch * 8 + e];
#pragma unroll
                for (int k = 0; k < 3; ++k) { const int p = pos - 1 + k; if (p >= lo && p < hi) { const bf16_t* pr = P + ((size_t)b * NPOS + p) * PP; const u32x4 sx = *(const u32x4*)(pr + C_SX + ch * 8), sc = *(const u32x4*)(pr + C_SC + ch * 8);
#pragma unroll
                        for (int e = 0; e < 4; ++e) { const float w0 = scw[k * 256 + ch * 8 + 2 * e], w1 = scw[k * 256 + ch * 8 + 2 * e + 1];
                            acc[2 * e] += w0 * (__uint_as_float(sx[e] << 16) * __uint_as_float(sc[e] << 16)); acc[2 * e + 1] += w1 * (__uint_as_float(sx[e] & 0xffff0000u) * __uint_as_float(sc[e] & 0xffff0000u)); } } }
                const u32x4 sb = *(const u32x4*)(P + (r0 + row) * PP + C_SB + ch * 8); u32x4 o;
#pragma unroll
                for (int e = 0; e < 4; ++e) o[e] = pk2(__uint_as_float(sb[e] << 16) * acc[2 * e], __uint_as_float(sb[e] & 0xffff0000u) * acc[2 * e + 1]);
                *(u32x4*)(MIX + (r0 + row) * D + 768 + ch * 8) = o; } }
        __syncthreads();
    }
}
}

namespace lru {
constexpr int XP = 264, O_X = 0, O_NA = 33792, O_BB = 66560;
__device__ __forceinline__ float sigm(float x) { return __builtin_amdgcn_rcpf(1.f + __expf(-x)); }
__device__ __forceinline__ void chunk_units(LAS unsigned char* lds, int l, const bf16_t* P, const float* conv_w, const float* conv_b, const bf16_t* WAT, const bf16_t* WIT, const float* b_a, const float* b_i, const float* SPT,
                                            bf16_t* HL, bf16_t* AC, float* SUM, int u0, int u1, int ustep, int knob) {
    LAS bf16_t* X = (LAS bf16_t*)(lds + O_X); LAS bf16_t* NA = (LAS bf16_t*)(lds + O_NA); LAS bf16_t* BB = (LAS bf16_t*)(lds + O_BB);
    for (int unit = u0; unit < u1; unit += ustep) {
        int tid_l = threadIdx.x; asm volatile("" : "+v"(tid_l));
        const int tid = tid_l, lane = tid & 63, w = __builtin_amdgcn_readfirstlane(tid >> 6), fr = lane & 15, fq = lane >> 4;
        const int dir = unit & 1, bc = unit >> 1, b = bc / 68, chunk = bc % 68, pos0 = 64 * chunk; const int lo = chunk < 4 ? 0 : CTX, hi = chunk < 4 ? CTX : NPOS, left = dir ? 1 : 2;
        const size_t r0 = (size_t)b * NPOS + pos0; const int pd = (l * 2 + dir) * 256;
        if (!(knob & 1)) { const int cg = tid & 31, ts = tid >> 5, c0 = cg * 8; float wv[4][8], cbv[8];
#pragma unroll
          for (int e = 0; e < 8; ++e) { cbv[e] = conv_b[pd + c0 + e];
#pragma unroll
              for (int k = 0; k < 4; ++k) wv[k][e] = conv_w[(size_t)pd * 4 + k * 256 + c0 + e]; }
          const bf16_t* pc = P + (size_t)b * NPOS * PP + C_LX + c0; const int pb = pos0 + 4 * ts - left;
          u32x4 u[7];
#pragma unroll
          for (int i = 0; i < 7; ++i) { const int p = pb + i; const int pcl = p < lo ? lo : (p >= hi ? hi - 1 : p); u[i] = *(const u32x4*)(pc + (size_t)pcl * PP); if (p < lo || p >= hi) u[i] = (u32x4){0u, 0u, 0u, 0u}; }
#pragma unroll
          for (int i = 0; i < 4; ++i) { u32x4 o;
#pragma unroll
              for (int e2 = 0; e2 < 4; ++e2) { float lo_ = cbv[2 * e2], hi_ = cbv[2 * e2 + 1];
#pragma unroll
                  for (int k = 0; k < 4; ++k) { const unsigned d = u[i + k][e2]; lo_ += wv[k][2 * e2] * __uint_as_float(d << 16); hi_ += wv[k][2 * e2 + 1] * __uint_as_float(d & 0xffff0000u); }
                  o[e2] = pk2(lo_, hi_); }
              *(LAS u32x4*)(X + (4 * ts + i) * XP + c0) = o; } }
        __syncthreads();
        if (!(knob & 2)) { const int h = w >> 1, mh = w & 1;
          f32x4 ra[2][4], ri[2][4];
#pragma unroll
          for (int m = 0; m < 2; ++m)
#pragma unroll
              for (int n = 0; n < 4; ++n) { ra[m][n] = (f32x4){0.f, 0.f, 0.f, 0.f}; ri[m][n] = (f32x4){0.f, 0.f, 0.f, 0.f}; }
          const bf16_t* wa = WAT + ((size_t)((l * 2 + dir) * 4 + h) * 64 + fr) * 64 + 8 * fq; const bf16_t* wi = WIT + ((size_t)((l * 2 + dir) * 4 + h) * 64 + fr) * 64 + 8 * fq;
#pragma unroll
          for (int ks = 0; ks < 2; ++ks) { bf16x8 a[2], ba[4], bi[4];
#pragma unroll
              for (int m = 0; m < 2; ++m) a[m] = *(const LAS bf16x8*)(X + (16 * (2 * mh + m) + fr) * XP + 64 * h + 32 * ks + 8 * fq);
#pragma unroll
              for (int n = 0; n < 4; ++n) { ba[n] = *(const bf16x8*)(wa + (size_t)(16 * n) * 64 + 32 * ks); bi[n] = *(const bf16x8*)(wi + (size_t)(16 * n) * 64 + 32 * ks); }
#pragma unroll
              for (int m = 0; m < 2; ++m)
#pragma unroll
                  for (int n = 0; n < 4; ++n) { ra[m][n] = __builtin_amdgcn_mfma_f32_16x16x32_bf16(a[m], ba[n], ra[m][n], 0, 0, 0); ri[m][n] = __builtin_amdgcn_mfma_f32_16x16x32_bf16(a[m], bi[n], ri[m][n], 0, 0, 0); } }
#pragma unroll
          for (int n = 0; n < 4; ++n) { const int c = 64 * h + 16 * n + fr; const float bav = b_a[pd + c], biv = b_i[pd + c], sp8 = 8.f * SPT[pd + c];
#pragma unroll
              for (int m = 0; m < 2; ++m)
#pragma unroll
                  for (int i = 0; i < 4; ++i) { const int t = 16 * (2 * mh + m) + 4 * fq + i; const float r = sigm(ra[m][n][i] + bav), ig = sigm(ri[m][n][i] + biv);
                      const float x = r * sp8; const float na = x < 0.03125f ? x * (1.f - 0.5f * x * (1.f - 0.33333334f * x * (1.f - 0.25f * x))) : 1.f - __expf(-x); const float xv = bf2f(X[t * XP + c]);
                      NA[t * 256 + c] = f2bf(na); BB[t * 256 + c] = f2bf(__builtin_amdgcn_sqrtf(fmaxf(na * (2.f - na), 0.f)) * (ig * xv)); } } }
        __syncthreads();
        if (tid < 256 && !(knob & 4)) { const int c = tid; float hst = 0.f, A = 1.f;
            if (dir == 0) {
#pragma unroll 8
                for (int t = 0; t < 64; ++t) { const float a = 1.f - bf2f(NA[t * 256 + c]); hst = a * hst + bf2f(BB[t * 256 + c]); A *= a; BB[t * 256 + c] = f2bf(hst); NA[t * 256 + c] = f2bf(A); }
            } else {
#pragma unroll 8
                for (int t = 63; t >= 0; --t) { const float a = 1.f - bf2f(NA[t * 256 + c]); hst = a * hst + bf2f(BB[t * 256 + c]); A *= a; BB[t * 256 + c] = f2bf(hst); NA[t * 256 + c] = f2bf(A); }
            }
            float* sm = SUM + ((size_t)(dir * 4 + b) * 68 + chunk) * 512; sm[c] = A; sm[256 + c] = hst; }
        __syncthreads();
        if (!(knob & 4)) {
#pragma unroll
            for (int i = 0; i < 4; ++i) { const int q = tid + 512 * i, t = q >> 5, ch = q & 31; const size_t go = ((size_t)dir * MROWS + r0 + t) * 256 + ch * 8;
                *(u32x4*)(AC + go) = *(const LAS u32x4*)(NA + t * 256 + ch * 8); *(u32x4*)(HL + go) = *(const LAS u32x4*)(BB + t * 256 + ch * 8); } }
        __syncthreads();
    }
}
__device__ __forceinline__ void fixup_units(LAS unsigned char* lds, int l, const bf16_t* P, const bf16_t* HL, const bf16_t* AC, const float* SUM, bf16_t* MIX, int G, int bx) {
    LAS float* CAR = (LAS float*)lds;
    for (int unit = bx; unit < 272; unit += G) {
        int tid_l = threadIdx.x; asm volatile("" : "+v"(tid_l));
        const int tid = tid_l;
        const int b = unit / 68, chunk = unit % 68; if (l == 1 && chunk < 4) continue;
        { const int dir = tid >> 8, c = tid & 255; const float* sp = SUM + ((size_t)(dir * 4 + b) * 68) * 512 + c;
          const int n_pre = dir == 0 ? chunk : (chunk < 4 ? 3 - chunk : 4 + (67 - chunk));
          float cy = 0.f;
          for (int j0 = 0; j0 < n_pre; j0 += 16) { float av[16], hv[16];
#pragma unroll
              for (int u = 0; u < 16; ++u) { const int n = j0 + u < n_pre ? j0 + u : n_pre - 1; const int j = dir == 0 ? n : (n < 4 ? 3 - n : 71 - n); av[u] = sp[(size_t)j * 512]; hv[u] = sp[(size_t)j * 512 + 256]; }
#pragma unroll
              for (int u = 0; u < 16; ++u) cy = (j0 + u < n_pre) ? hv[u] + av[u] * cy : cy; }
          CAR[tid] = cy; }
        __syncthreads();
        { const int cg = tid & 31, ts = tid >> 5, c0 = cg * 8; float cf[8], cb[8];
#pragma unroll
          for (int e = 0; e < 8; ++e) { cf[e] = CAR[c0 + e]; cb[e] = CAR[256 + c0 + e]; }
          const size_t r0 = (size_t)b * NPOS + 64 * chunk + 4 * ts;
          u32x4 hf[4], af[4], hb[4], ab[4], gt[4];
#pragma unroll
          for (int i = 0; i < 4; ++i) { const size_t r = r0 + i; hf[i] = *(const u32x4*)(HL + r * 256 + c0); af[i] = *(const u32x4*)(AC + r * 256 + c0); hb[i] = *(const u32x4*)(HL + ((size_t)MROWS + r) * 256 + c0); ab[i] = *(const u32x4*)(AC + ((size_t)MROWS + r) * 256 + c0);
              gt[i] = *(const u32x4*)(P + r * PP + C_LG + c0); }
#pragma unroll
          for (int i = 0; i < 4; ++i) { u32x4 o;
#pragma unroll
              for (int e2 = 0; e2 < 4; ++e2) { float res[2];
#pragma unroll
                  for (int hh = 0; hh < 2; ++hh) { const int e = 2 * e2 + hh;
                      const float vhf = hh ? __uint_as_float(hf[i][e2] & 0xffff0000u) : __uint_as_float(hf[i][e2] << 16), vaf = hh ? __uint_as_float(af[i][e2] & 0xffff0000u) : __uint_as_float(af[i][e2] << 16);
                      const float vhb = hh ? __uint_as_float(hb[i][e2] & 0xffff0000u) : __uint_as_float(hb[i][e2] << 16), vab = hh ? __uint_as_float(ab[i][e2] & 0xffff0000u) : __uint_as_float(ab[i][e2] << 16);
                      const float x = hh ? __uint_as_float(gt[i][e2] & 0xffff0000u) : __uint_as_float(gt[i][e2] << 16);
                      const float hsum = (vhf + vaf * cf[e]) + (vhb + vab * cb[e]);
                      const float u = 0.7978845608028654f * (x + 0.044715f * x * x * x); const float th_ = 1.f - 2.f * __builtin_amdgcn_rcpf(1.f + __expf(2.f * u));
                      res[hh] = 0.5f * x * (1.f + th_) * hsum; }
                  o[e2] = pk2(res[0], res[1]); }
              *(u32x4*)(MIX + (r0 + i) * D + 256 + c0) = o; } }
        __syncthreads();
    }
}
}

namespace fft {
__device__ __forceinline__ void ctx_a(LAS unsigned char* lds, const bf16_t* P, const float* TABC, const float* TABS, bf16_t* XCT, int G, int bx) {
    LAS bf16_t* U = (LAS bf16_t*)(lds + O_U); LAS bf16_t* X = (LAS bf16_t*)(lds + O_X);
    for (int unit = bx; unit < 16; unit += G) {
        int tid_l = threadIdx.x; asm volatile("" : "+v"(tid_l));
        const int tid = tid_l, lane = tid & 63, w = __builtin_amdgcn_readfirstlane(tid >> 6), fr = lane & 15, fq = lane >> 4;
        build_tables(lds, TABC, TABS, tid);
        const LAS bf16_t* Tc = (const LAS bf16_t*)(lds + O_TC); const LAS bf16_t* Ts = (const LAS bf16_t*)(lds + O_TS);
        const int b = unit >> 2, q = unit & 3;
#pragma unroll
        for (int i = 0; i < 4; ++i) { const int qq = tid + 512 * i, t1 = qq >> 5, ch = qq & 31;
            *(LAS u32x4*)((LAS unsigned char*)U + t1 * (UP * 2) + ch * 16) = *(const u32x4*)(P + ((size_t)b * NPOS + 64 * q + t1) * PP + ch * 8); }
        __syncthreads();
        { const int g = w >> 1, part = w & 1; const LAS bf16_t* T = part ? Ts : Tc;
          f32x4 acc[4][4];
#pragma unroll
          for (int mt = 0; mt < 4; ++mt)
#pragma unroll
              for (int nt = 0; nt < 4; ++nt) acc[mt][nt] = (f32x4){0.f, 0.f, 0.f, 0.f};
#pragma unroll
          for (int ks = 0; ks < 2; ++ks) { bf16x8 a[4], bb[4];
#pragma unroll
              for (int mt = 0; mt < 4; ++mt) a[mt] = *(const LAS bf16x8*)(U + (16 * mt + fr) * UP + g * 64 + 32 * ks + 8 * fq);
#pragma unroll
              for (int nt = 0; nt < 4; ++nt) bb[nt] = *(const LAS bf16x8*)(T + (16 * nt + fr) * TP + 32 * ks + 8 * fq);
#pragma unroll
              for (int mt = 0; mt < 4; ++mt)
#pragma unroll
                  for (int nt = 0; nt < 4; ++nt) acc[mt][nt] = __builtin_amdgcn_mfma_f32_16x16x32_bf16(a[mt], bb[nt], acc[mt][nt], 0, 0, 0); }
          const float sg = part ? -1.f : 1.f;
#pragma unroll
          for (int mt = 0; mt < 4; ++mt)
#pragma unroll
              for (int nt = 0; nt < 4; ++nt) { const f32x4 v = acc[mt][nt] * sg; u32x2 o; o.x = pk2(v[0], v[1]); o.y = pk2(v[2], v[3]);
                  *(LAS u32x2*)(X + (part * 256 + g * 64 + 16 * nt + fr) * TP + 16 * mt + 4 * fq) = o; } }
        __syncthreads();
#pragma unroll
        for (int i = 0; i < 8; ++i) { const int qq = tid + 512 * i, row = qq >> 3, c8 = qq & 7;
            *(u32x4*)(XCT + (((size_t)b * 4 + q) * 512 + row) * 64 + c8 * 8) = *(const LAS u32x4*)((const LAS unsigned char*)X + row * (TP * 2) + c8 * 16); }
        __syncthreads();
    }
}
__device__ __forceinline__ void ctx_b(LAS unsigned char* lds, const bf16_t* XCT, const float* TABC, const float* TABS, bf16_t* MIX, int G, int bx) {
    LAS bf16_t* Tc = (LAS bf16_t*)(lds + O_TC); LAS bf16_t* Ts = (LAS bf16_t*)(lds + O_TS);
    LAS bf16_t* Ys = (LAS bf16_t*)(lds + O_U); LAS bf16_t* ZT = (LAS bf16_t*)(lds + O_X);
    for (int unit = bx; unit < 16; unit += G) {
        int tid_l = threadIdx.x; asm volatile("" : "+v"(tid_l));
        const int tid = tid_l, lane = tid & 63, w = __builtin_amdgcn_readfirstlane(tid >> 6), fr = lane & 15, fq = lane >> 4;
        const int b = unit >> 2, ft = unit & 3;
        f32x4 y[4][2];
#pragma unroll
        for (int mt = 0; mt < 4; ++mt)
#pragma unroll
            for (int n = 0; n < 2; ++n) y[mt][n] = (f32x4){0.f, 0.f, 0.f, 0.f};
        for (int q = 0; q < 4; ++q) {
            for (int i = tid; i < 4096; i += 512) { const int fl = i >> 6, tl = i & 63, ix = (((64 * ft + fl) * (64 * q + tl)) & 255) * 16; Tc[fl * TP + tl] = f2bf(TABC[ix]); Ts[fl * TP + tl] = f2bf(TABS[ix]); }
#pragma unroll
            for (int i = 0; i < 8; ++i) { const int qq = tid + 512 * i, row = qq >> 3, c8 = qq & 7;
                *(LAS u32x4*)((LAS unsigned char*)ZT + row * (TP * 2) + c8 * 16) = *(const u32x4*)(XCT + (((size_t)b * 4 + q) * 512 + row) * 64 + c8 * 8); }
            __syncthreads();
#pragma unroll
            for (int ks = 0; ks < 2; ++ks) { bf16x8 xr[2], xi[2];
#pragma unroll
                for (int n = 0; n < 2; ++n) { xr[n] = *(const LAS bf16x8*)(ZT + (32 * w + 16 * n + fr) * TP + 32 * ks + 8 * fq); xi[n] = *(const LAS bf16x8*)(ZT + (256 + 32 * w + 16 * n + fr) * TP + 32 * ks + 8 * fq); }
#pragma unroll
                for (int mt = 0; mt < 4; ++mt) { const bf16x8 c = *(const LAS bf16x8*)(Tc + (16 * mt + fr) * TP + 32 * ks + 8 * fq), s = *(const LAS bf16x8*)(Ts + (16 * mt + fr) * TP + 32 * ks + 8 * fq);
#pragma unroll
                    for (int n = 0; n < 2; ++n) { y[mt][n] = __builtin_amdgcn_mfma_f32_16x16x32_bf16(c, xr[n], y[mt][n], 0, 0, 0); y[mt][n] = __builtin_amdgcn_mfma_f32_16x16x32_bf16(s, xi[n], y[mt][n], 0, 0, 0); } } }
            __syncthreads();
        }
#pragma unroll
        for (int mt = 0; mt < 4; ++mt)
#pragma unroll
            for (int i = 0; i < 4; ++i)
#pragma unroll
                for (int n = 0; n < 2; ++n) Ys[(16 * mt + 4 * fq + i) * UP + 32 * w + 16 * n + fr] = f2bf(y[mt][n][i] * (1.f / 128.f));
        __syncthreads();
#pragma unroll
        for (int i = 0; i < 4; ++i) { const int qq = tid + 512 * i, fl = qq >> 5, ch = qq & 31;
            *(u32x4*)(MIX + ((size_t)b * NPOS + 64 * ft + fl) * D + ch * 8) = *(const LAS u32x4*)((const LAS unsigned char*)Ys + fl * (UP * 2) + ch * 16); }
        __syncthreads();
    }
}
}

constexpr int NWAVES = 8, RING_BYTES = 131072 + 3072, LDSCTL_OFF = RING_BYTES, MISC_OFF = LDSCTL_OFF + 64, META_OFF = MISC_OFF + 64, LDS_BYTES = 147456;
enum { PH_PRO0 = 0, PH_PRO1 = 1, PH_L0 = 2, PH_PER_LAYER = 8, PH_N = 18 };
enum { PL_WIN = 0, PL_PREP = 1, PL_MIX = 2, PL_WOUT = 3, PL_ROUTE = 4, PL_MOE1 = 5, PL_MOE2 = 6, PL_COMB = 7 };
struct MArgs { const float* in[30]; float* out; unsigned char* ws; int npass, skip_mask, dup_ph, dup_n, dup_sub, knob; };

__device__ __forceinline__ void transpose_item(const float* W, int K, int N, bf16_t* WT, int drow0, LAS float* scr, int k0, int n0, int lane) {
    const int kr = lane >> 3, nc = (lane & 7) * 4;
    f32x4 v[8];
#pragma unroll
    for (int i = 0; i < 8; ++i) v[i] = __builtin_nontemporal_load((const f32x4*)(W + (size_t)(k0 + kr + 8 * i) * N + n0 + nc));
#pragma unroll
    for (int i = 0; i < 8; ++i) { LAS float* d = scr + (kr + 8 * i) * 33 + nc; d[0] = v[i][0]; d[1] = v[i][1]; d[2] = v[i][2]; d[3] = v[i][3]; }
    asm volatile("s_waitcnt lgkmcnt(0)" ::: "memory");
    const int c = lane & 7;
#pragma unroll
    for (int j = 0; j < 4; ++j) { const int n = (lane >> 3) + 8 * j; const LAS float* s = scr + (8 * c) * 33 + n;
        u32x4 o; o.x = pk2(s[0 * 33], s[1 * 33]); o.y = pk2(s[2 * 33], s[3 * 33]); o.z = pk2(s[4 * 33], s[5 * 33]); o.w = pk2(s[6 * 33], s[7 * 33]);
        *(u32x4*)(WT + (size_t)(drow0 + n) * K + k0 + 8 * c) = o; }
    asm volatile("s_waitcnt lgkmcnt(0)" ::: "memory");
}

constexpr int I_GU = NE * 16 * 64, I_DN = NE * 16 * 32, I_EXP = I_GU + I_DN;
__device__ __forceinline__ void expert_item(int l, int j, const float* wgu, const float* wdn, unsigned char* ws, LAS float* scr, int lane) {
    if (j < I_GU) { const int e = j / (16 * 64), q = j % (16 * 64), kb = q / 64, nb = q % 64; const int n0 = 32 * nb; const int c2 = n0 & 1023; const int drow = (c2 >> 7) * 256 + (n0 >> 10) * 128 + (c2 & 127);
        transpose_item(wgu + ((size_t)l * NE + e) * D * 2048, D, 2048, (bf16_t*)(ws + L::WGUT) + ((size_t)l * NE + e) * 2048 * D, drow, scr, 64 * kb, n0, lane); }
    else { const int r = j - I_GU; const int e = r / (16 * 32), q = r % (16 * 32), kb = q / 32, nb = q % 32;
        transpose_item(wdn + ((size_t)l * NE + e) * D * D, D, D, (bf16_t*)(ws + L::WDT) + ((size_t)l * NE + e) * D * D, 32 * nb, scr, 64 * kb, 32 * nb, lane); }
}
constexpr int Q_WIN = 48, Q_WOUT = 96, Q_MOE2 = 0;
constexpr int DEF_WIN = 224 * Q_WIN, DEF0 = DEF_WIN + 240 * Q_WOUT, DEF_MOE2 = 128 * Q_MOE2, DEF1 = DEF_MOE2 + 224 * Q_WIN;
constexpr int MIX_X = 11520;
static_assert(I_EXP - DEF0 + MIX_X <= 34 * 1024 && I_EXP - DEF1 - MIX_X <= 34 * 1024, "one attention unit takes at most 34 items per converting wave");
__device__ __forceinline__ void deferred_items(int l, int first, int count, const float* wgu, const float* wdn, unsigned char* ws, LAS unsigned char* lds, int wave, int lane) {
    LAS float* scr = (LAS float*)(lds + wave * 16384);
    for (int j = first + wave; j < first + count; j += NWAVES) expert_item(l, j, wgu, wdn, ws, scr, lane);
}

#define GASP __attribute__((address_space(1)))
#define ARG_IN(i) ({ const GASP float* _p; asm volatile("s_load_dwordx2 %0, %1, %2\n\ts_waitcnt lgkmcnt(0)" : "=s"(_p) : "s"(__builtin_amdgcn_kernarg_segment_ptr()), "n"((i) * 8)); (const float*)_p; })
__global__ void __launch_bounds__(NWAVES * 64, 2) mega(MArgs args) {
    extern __shared__ __attribute__((aligned(16))) unsigned char lds_raw[];
    const int G0 = gridDim.x, bx0 = blockIdx.x;
    unsigned char* ws0 = args.ws;
    unsigned* ctl0 = (unsigned*)(ws0 + L::CTL);
    for (int u = threadIdx.x; u < (LDS_BYTES - LDSCTL_OFF) / 4; u += NWAVES * 64) ((LAS unsigned*)(lds_raw + LDSCTL_OFF))[u] = 0u;
    __syncthreads();
    volatile LAS unsigned* MISC = (volatile LAS unsigned*)((LAS unsigned char*)lds_raw + MISC_OFF);
    XcdBarrier bar = xcd_barrier_post(ctl0 + L::CW_BAR, MISC);
    const int lo = 0, hi = PH_N;

    bool first = true;
    for (int pass = 0; pass < args.npass; ++pass)
    for (int ph = lo; ph < hi; ++ph) {
      const int reps = (ph == args.dup_ph) ? 1 + args.dup_n : 1;
      if (ph == PH_PRO1) continue;
      for (int rep = 0; rep < reps; ++rep) {
        if (!first) xcd_barrier(bar);
        first = false;
        if (pass + 1 < args.npass && ((args.skip_mask >> ph) & 1)) continue;
        const int sub = rep + 1 < reps ? args.dup_sub : 15; const int knob = rep + 1 < reps ? args.knob : 0; (void)knob;
        GASP unsigned char* wsg = (GASP unsigned char*)args.ws; asm volatile("" : "+s"(wsg)); unsigned char* ws = (unsigned char*)wsg;
        unsigned* ctl = (unsigned*)(ws + L::CTL);
        int tid_p = threadIdx.x; asm volatile("" : "+v"(tid_p));
        int G = G0, bx = bx0; asm volatile("" : "+s"(G), "+s"(bx));
        const int vcu = (G % 8 == 0) ? (bx % 8) * (G / 8) + bx / 8 : bx; (void)vcu;
        unsigned ldsb = 0; asm volatile("" : "+s"(ldsb)); LAS unsigned char* lds = (LAS unsigned char*)lds_raw + ldsb;
        LAS int* META = (LAS int*)(lds + META_OFF);
        const int tid = tid_p, lane = tid & 63, wave = __builtin_amdgcn_readfirstlane(tid >> 6); (void)lane; (void)wave;
        if (ph == PH_PRO0) {
            if (bx == 0 && tid < 2 * NE) ((int*)(ctl + L::CW_CNT))[tid * L::CNT_STRIDE] = 0;
            sm::smallw_phase(ARG_IN(17), ARG_IN(16), ARG_IN(19), ARG_IN(18), ARG_IN(11), ARG_IN(13), (bf16_t*)(ws + L::WUQT), (bf16_t*)(ws + L::WUKVT), (bf16_t*)(ws + L::WAT), (bf16_t*)(ws + L::WIT),
                             (float*)(ws + L::TABC), (float*)(ws + L::TABS), ARG_IN(15), (float*)(ws + L::SPT), ARG_IN(23), (bf16_t*)(ws + L::RWH), (bf16_t*)(ws + L::RWL), bx * 512 + tid, G * 512);
            __syncthreads();
            sm::mod_phase(lds, ARG_IN(1), ARG_IN(3), ARG_IN(4), ARG_IN(5), (float*)(ws + L::MOD), G, bx, tid);
            { int nmine = 0; for (int u = bx; u < 96; u += G) ++nmine;
              if (nmine) { asm volatile("s_waitcnt vmcnt(0)" ::: "memory"); __syncthreads();
                  if (tid == 0) { __builtin_amdgcn_fence(__ATOMIC_RELEASE, "agent"); asm volatile("s_waitcnt vmcnt(0)" ::: "memory"); __hip_atomic_fetch_add(ctl + L::CW_MODCNT, (unsigned)nmine, __ATOMIC_RELAXED, __HIP_MEMORY_SCOPE_AGENT); } } }
            __syncthreads();
            LAS float* scr = (LAS float*)(lds + wave * 16384);
            const int gw = vcu * NWAVES + wave, NGW = G * NWAVES;
            constexpr int I_IN = 16 * 61, I_OUT = 16 * 32, I_D = I_IN + I_OUT; const int d0 = G == 256 ? I_EXP : 0, d1 = G == 256 ? I_EXP : 0, R0 = I_EXP - d0, R1 = I_EXP - d1;
            for (int it = gw; it < 2 * I_D + R0 + R1; it += NGW) {
                if (it < 2 * I_D) { const int l = it / I_D; int r = it % I_D;
                    if (r < I_IN) { const int kb = r / 61, nb = r % 61; transpose_item(ARG_IN(8) + (size_t)l * D * PT, D, PT, (bf16_t*)(ws + L::WINT) + (size_t)l * 2048 * D, 32 * nb, scr, 64 * kb, 32 * nb, lane); }
                    else { r -= I_IN; const int kb = r / 32, nb = r % 32; transpose_item(ARG_IN(22) + (size_t)l * D * D, D, D, (bf16_t*)(ws + L::WOUTT) + (size_t)l * D * D, 32 * nb, scr, 64 * kb, 32 * nb, lane); }
                } else { const int r = it - 2 * I_D; if (r < R0) expert_item(0, d0 + r, ARG_IN(25), ARG_IN(27), ws, scr, lane); else expert_item(1, d1 + (r - R0), ARG_IN(25), ARG_IN(27), ws, scr, lane); }
            }
            { u32x4 zv = {0u, 0u, 0u, 0u}; asm volatile("" : "+v"(zv));
              for (int i = bx * 512 + tid; i < 2 * 96 * D / 8; i += G * 512) { const int l = i / (96 * D / 8), q = i % (96 * D / 8); *(u32x4*)((bf16_t*)(ws + L::WINT) + ((size_t)l * 2048 + PT) * D + (size_t)q * 8) = zv; } }
            if (tid == 0) { unsigned sp = 0; while (__hip_atomic_load(ctl + L::CW_MODCNT, __ATOMIC_RELAXED, __HIP_MEMORY_SCOPE_AGENT) < 96u && ++sp < (1u << 22)) __builtin_amdgcn_s_sleep(2);
                __builtin_amdgcn_fence(__ATOMIC_ACQUIRE, "agent"); asm volatile("s_waitcnt vmcnt(0)" ::: "memory"); }
            __syncthreads();
            { const int nmod = G < 96 ? G : 96; const int small = 45, rs0 = bx < nmod ? bx * small : nmod * small + (int)(((long)(bx - nmod) * (MROWS - nmod * small)) / (G - nmod)),
                  rs1 = bx + 1 < nmod ? (bx + 1) * small : (bx + 1 >= G ? MROWS : nmod * small + (int)(((long)(bx + 1 - nmod) * (MROWS - nmod * small)) / (G - nmod)));
              sm::pro1_phase(ARG_IN(0), ARG_IN(2), ARG_IN(6), (const float*)(ws + L::MOD), (float*)(ws + L::H), (bf16_t*)(ws + L::XN), rs0 + wave, rs1, NWAVES, lane); }
            continue;
        }
        if (ph < PH_L0) continue;
        const int l = (ph - PH_L0) / PH_PER_LAYER, pl = (ph - PH_L0) % PH_PER_LAYER;
        const float* MODl = (const float*)(ws + L::MOD) + (size_t)l * 5 * 6144;
        if (pl == PL_WIN) {
            g8::DenseSched S; S.init(MROWS / 256, PP / 256, G, bx, 0, (const bf16_t*)(ws + L::WINT) + (size_t)l * 2048 * D, D);
            g8::EpiP E{(bf16_t*)(ws + L::P)};
            g8::gemm_phase<g8::EpiP, g8::DenseSched, false, false>(lds, (const char*)(ws + L::XN), S, E);
            if (G == 256 && bx >= 32) deferred_items(l, (l == 0 ? 0 : DEF_MOE2) + (bx - 32) * Q_WIN, Q_WIN, ARG_IN(25), ARG_IN(27), ws, lds, wave, lane);
        } else if (pl == PL_PREP) {
            if (l == 0 && (sub & 2)) { fft::ctx_a(lds, (const bf16_t*)(ws + L::P), (const float*)(ws + L::TABC), (const float*)(ws + L::TABS), (bf16_t*)(ws + L::XCT), G, G - 1 - bx); __syncthreads(); }
            for (int p = 0; p * G < 1072; ++p) {
                const int k = p * G + ((p & 1) ? G - 1 - bx : bx);
                if (k >= 1072) continue;
                if (k < 272) { if (sub & 4) prep::qkv_units(lds, l, (const bf16_t*)(ws + L::P), (const bf16_t*)(ws + L::WUQT), (const bf16_t*)(ws + L::WUKVT), ARG_IN(20) + l * 768, ARG_IN(21) + l * 256,
                            (bf16_t*)(ws + L::QL), (bf16_t*)(ws + L::QC), (bf16_t*)(ws + L::KB), (bf16_t*)(ws + L::VTG), (bf16_t*)(ws + L::MIX), k, k + 1, 1); }
                else if (k < 816) { if (sub & 8) lru::chunk_units(lds, l, (const bf16_t*)(ws + L::P), ARG_IN(9), ARG_IN(10), (const bf16_t*)(ws + L::WAT), (const bf16_t*)(ws + L::WIT), ARG_IN(12), ARG_IN(14), (const float*)(ws + L::SPT),
                             (bf16_t*)(ws + L::HL), (bf16_t*)(ws + L::AC), (float*)(ws + L::SUM), k - 272, k - 271, 1, knob); }
                else { if (sub & 1) fft::stage_a(lds, (const bf16_t*)(ws + L::P), (const float*)(ws + L::TABC), (const float*)(ws + L::TABS), (bf16_t*)(ws + L::ZBUF), k - 816, k - 815, 1); }
                __syncthreads();
            }
        } else if (pl == PL_MIX) {
            if (sub & 1) lru::fixup_units(lds, l, (const bf16_t*)(ws + L::P), (const bf16_t*)(ws + L::HL), (const bf16_t*)(ws + L::AC), (const float*)(ws + L::SUM), (bf16_t*)(ws + L::MIX), G, bx);
            if (sub & 2) fft::stage_b(lds, (const bf16_t*)(ws + L::ZBUF), (const float*)(ws + L::TABC), (const float*)(ws + L::TABS), (bf16_t*)(ws + L::MIX), G, bx);
            __syncthreads();
            if (l == 0 && (sub & 4)) { fft::ctx_b(lds, (const bf16_t*)(ws + L::XCT), (const float*)(ws + L::TABC), (const float*)(ws + L::TABS), (bf16_t*)(ws + L::MIX), G, G - 1 - bx); __syncthreads(); }
            cv::Job cvj; cvj.wgu = ARG_IN(25); cvj.wdn = ARG_IN(27); cvj.ws = ws;
            if (l == 0) { cvj.n0 = I_EXP - DEF0; cvj.first0 = DEF0; cvj.first1 = DEF1; cvj.nv = cvj.n0 + MIX_X; } else { cvj.n0 = 0; cvj.first0 = 0; cvj.first1 = DEF1 + MIX_X; cvj.nv = I_EXP - DEF1 - MIX_X; }
            if (sub & 8) attn::attn_phase(lds, (const bf16_t*)(ws + L::QL), (const bf16_t*)(ws + L::QC), (const bf16_t*)(ws + L::KB), (const bf16_t*)(ws + L::VTG), (bf16_t*)(ws + L::MIX), l == 0 ? 1 : 0, G, vcu, cvj, G == 256);
        } else if (pl == PL_WOUT) {
            g8::DenseSched S; S.init(l == 0 ? MROWS / 256 : 64, D / 256, G, bx, l == 0 ? 0 : 1, (const bf16_t*)(ws + L::WOUTT) + (size_t)l * D * D, D);
            g8::EpiH E{(float*)(ws + L::H), MODl, 2048};
            g8::gemm_phase<g8::EpiH, g8::DenseSched, false, false>(lds, (const char*)(ws + L::MIX), S, E);
            if (G == 256 && l == 0 && bx >= 16) deferred_items(0, DEF_WIN + (bx - 16) * Q_WOUT, Q_WOUT, ARG_IN(25), ARG_IN(27), ws, lds, wave, lane);
        } else if (pl == PL_ROUTE) {
            sm::route_phase(lds, l, (const float*)(ws + L::H), ARG_IN(7) + l * D, MODl, (const bf16_t*)(ws + L::RWH), (const bf16_t*)(ws + L::RWL), ARG_IN(24) + l * NE, (bf16_t*)(ws + L::XN), (int*)(ctl + L::CW_CNT) + l * NE * L::CNT_STRIDE,
                            (int*)(ws + L::LIST) + (size_t)l * NE * LCAP, (float*)(ws + L::GATE), G, bx, tid);
        } else if (pl == PL_COMB) {
            sm::comb_phase(l, (float*)(ws + L::H), (const bf16_t*)(ws + L::Y), MODl, ARG_IN(6) + D, (const float*)(ws + L::MOD) + (size_t)5 * 6144, (bf16_t*)(ws + L::XN), ARG_IN(29), args.out, bx * NWAVES + wave, G * NWAVES, lane);
        } else if (pl == PL_MOE1 || pl == PL_MOE2) {
            const int* CNTg = (const int*)(ctl + L::CW_CNT) + l * NE * L::CNT_STRIDE;
            if (tid == 0) { int o = 0; for (int e = 0; e < NE; ++e) { const int cn = CNTg[e * L::CNT_STRIDE]; META[e] = o; META[64 + e] = cn; o += (cn + 255) >> 8; } META[NE] = o; }
            __syncthreads();
            g8::MoeSched S; S.tpre = META; S.cnt = META + 64; S.G = G; S.c = bx; S.K = D; S.list = (const int*)(ws + L::LIST) + (size_t)l * NE * LCAP;
            if (pl == PL_MOE1) {
                S.NT = 8; S.COLW = 128; S.total = __builtin_amdgcn_readfirstlane(META[NE]) * 8; S.Bt = (const char*)((const bf16_t*)(ws + L::WGUT) + (size_t)l * NE * 2048 * D);
                g8::EpiMoe1 E{(bf16_t*)(ws + L::ACT), ARG_IN(26) + (size_t)l * NE * 2048};
                g8::gemm_phase<g8::EpiMoe1, g8::MoeSched, true, true>(lds, (const char*)(ws + L::XN), S, E);
            } else {
                S.NT = 4; S.COLW = 256; S.total = __builtin_amdgcn_readfirstlane(META[NE]) * 4; S.Bt = (const char*)((const bf16_t*)(ws + L::WDT) + (size_t)l * NE * D * D);
                g8::EpiMoe2 E{(bf16_t*)(ws + L::Y), ARG_IN(28) + (size_t)l * NE * D, (const float*)(ws + L::GATE)};
                g8::gemm_phase<g8::EpiMoe2, g8::MoeSched, false, true>(lds, (const char*)(ws + L::ACT), S, E);
                if (G == 256 && l == 0 && bx >= 128) deferred_items(1, (bx - 128) * Q_MOE2, Q_MOE2, ARG_IN(25), ARG_IN(27), ws, lds, wave, lane);
            }
            __syncthreads();
        }
      }
    }
}
constexpr int PROBE_DUP_PH = -1, PROBE_DUP_N = 0, PROBE_DUP_SUB = 15, PROBE_KNOB = 0;
constexpr int PROBE_NPASS = 1, PROBE_SKIP = 0;
extern "C" void kernel_launch(void* const* d_in, const int* in_sizes, int n_in, void* d_out, int out_size, void* d_ws, size_t ws_size, hipStream_t stream) {
    static int grid = 0;
    if (grid == 0) {
        if (n_in != 30 || out_size != NB_ * SEQ * D || (size_t)L::END > ws_size) { fprintf(stderr, "kernel_launch: unexpected problem shape (n_in %d, out %d) or workspace too small (need %zu, have %zu); nothing launched\n", n_in, out_size, (size_t)L::END, ws_size); grid = -1; return; }
        int dev = 0, cus = 0;
        if (hipGetDevice(&dev) != hipSuccess || hipDeviceGetAttribute(&cus, hipDeviceAttributeMultiprocessorCount, dev) != hipSuccess) { fprintf(stderr, "kernel_launch: device query failed\n"); grid = -1; return; }
        if (hipFuncSetAttribute((const void*)mega, hipFuncAttributeMaxDynamicSharedMemorySize, LDS_BYTES) != hipSuccess) { fprintf(stderr, "kernel_launch: hipFuncSetAttribute failed\n"); grid = -1; return; }
        int per_cu = 0;
        if (hipOccupancyMaxActiveBlocksPerMultiprocessor(&per_cu, (const void*)mega, NWAVES * 64, LDS_BYTES) != hipSuccess || per_cu < 1) fprintf(stderr, "kernel_launch: note: the occupancy query reports %d workgroups per CU; launching one per CU anyway\n", per_cu);
        (void)hipGetLastError();
        grid = cus < 256 ? cus : 256;
    }
    if (grid < 0) return;
    unsigned char* p = (unsigned char*)d_ws;
    (void)hipMemsetAsync(p + L::CTL, 0, L::CTL_BYTES, stream);
    MArgs a{};
    for (int i = 0; i < 30; ++i) a.in[i] = (const float*)d_in[i];
    a.out = (float*)d_out; a.ws = p; a.npass = PROBE_NPASS; a.skip_mask = PROBE_SKIP; a.dup_ph = PROBE_DUP_PH; a.dup_n = PROBE_DUP_N; a.dup_sub = PROBE_DUP_SUB; a.knob = PROBE_KNOB;
    hipLaunchKernelGGL(mega, dim3(grid), dim3(NWAVES * 64), LDS_BYTES, stream, a);
}
```

```cpp
#include <hip/hip_runtime.h>
#include <cstdint>
#include <cstdio>

typedef unsigned short bf16_t;
constexpr int NB_ = 4, SEQ = 4096, CTX = 256, D = 1024, NPOS = SEQ + CTX, MROWS = NB_ * NPOS;
constexpr int PT = 1952, PP = 2048;
constexpr int NE = 32, TOPK = 4, LCAP = MROWS;
constexpr int NASG = MROWS * TOPK;
constexpr int ACT_ROWS = NASG + NE * 256;
constexpr int C_FN = 0, C_LX = 256, C_LG = 512, C_CQ = 768, C_CKV = 1024, C_KR = 1152, C_SX = 1184, C_SB = 1440, C_SC = 1696;

__device__ __forceinline__ float bf2f(bf16_t v) { return __uint_as_float((unsigned)v << 16); }
typedef float cv_f2 __attribute__((ext_vector_type(2))); typedef __bf16 cv_b2 __attribute__((ext_vector_type(2)));
__device__ __forceinline__ unsigned pk2(float lo, float hi) { cv_f2 v = {lo, hi}; return __builtin_bit_cast(unsigned, __builtin_convertvector(v, cv_b2)); }
__device__ __forceinline__ bf16_t f2bf(float f) { return (bf16_t)pk2(f, 0.f); }
__device__ __forceinline__ float wave_sum(float v) {
#pragma unroll
    for (int o = 1; o < 64; o <<= 1) v += __shfl_xor(v, o);
    return v;
}
__device__ __forceinline__ float sigmoidf_(float x) { return 1.f / (1.f + __expf(-x)); }
__device__ __forceinline__ float gelu_tanh(float x) { const float u = 0.7978845608028654f * (x + 0.044715f * x * x * x); return 0.5f * x * (1.f + tanhf(u)); }

#define LAS __attribute__((address_space(3)))
typedef short bf16x8 __attribute__((ext_vector_type(8)));
typedef float f32x4 __attribute__((ext_vector_type(4)));
typedef unsigned u32x4 __attribute__((ext_vector_type(4)));
typedef unsigned u32x2 __attribute__((ext_vector_type(2)));

namespace L {
constexpr size_t A256(size_t x) { return (x + 255) & ~(size_t)255; }
constexpr size_t CTL = 0, CTL_BYTES = 1u << 20;
constexpr size_t H = CTL + CTL_BYTES;
constexpr size_t MOD = CTL + 512 * 1024;
constexpr size_t TABC = A256(H + (size_t)MROWS * D * 4);
constexpr size_t TABS = A256(TABC + 4096 * 4);
constexpr size_t XN = A256(TABS + 4096 * 4);
constexpr size_t P = A256(XN + (size_t)MROWS * D * 2);
constexpr size_t MIX = A256(P + (size_t)MROWS * PP * 2);
constexpr size_t CQN = A256(MIX + (size_t)MROWS * D * 2);
constexpr size_t CKVN = A256(CQN + (size_t)MROWS * 256 * 2);
constexpr size_t QRAW = A256(CKVN + (size_t)MROWS * 128 * 2);
constexpr size_t KVRAW = A256(QRAW + (size_t)MROWS * 384 * 4);
constexpr size_t QL = A256(KVRAW + (size_t)MROWS * 512 * 4);
constexpr size_t QC = A256(QL + (size_t)16 * SEQ * 96 * 2);
constexpr size_t KB = A256(QC + (size_t)16 * CTX * 96 * 2);
constexpr size_t VB = A256(KB + (size_t)16 * NPOS * 96 * 2);
constexpr size_t LA = A256(VB + (size_t)16 * NPOS * 64 * 2);
constexpr size_t LB = A256(LA + (size_t)2 * MROWS * 256 * 4);
constexpr size_t HS = A256(LB + (size_t)2 * MROWS * 256 * 4);
constexpr size_t XCS = A256(HS + (size_t)2 * MROWS * 256 * 4);
constexpr size_t XCSC = A256(XCS + (size_t)4 * 8192 * 256 * 4);
constexpr size_t LIST = A256(XCSC + (size_t)4 * 512 * 256 * 4);
constexpr size_t GATE = A256(LIST + (size_t)2 * NE * LCAP * 4);
constexpr size_t ACT = A256(GATE + (size_t)NASG * 4);
constexpr size_t Y = A256(ACT + (size_t)ACT_ROWS * D * 2);
constexpr size_t WINT = A256(Y + (size_t)(NASG + 1) * D * 2);
constexpr size_t WOUTT = A256(WINT + (size_t)2 * 2048 * 1024 * 2);
constexpr size_t WGUT = A256(WOUTT + (size_t)2 * 1024 * 1024 * 2);
constexpr size_t WDT = A256(WGUT + (size_t)2 * NE * 2048 * 1024 * 2);
constexpr size_t ZBUF = A256(WDT + (size_t)2 * NE * 1024 * 1024 * 2);
constexpr size_t VTG = A256(ZBUF + (size_t)4 * 64 * 64 * 512 * 2);
constexpr size_t WUQT = A256(VTG + (size_t)16 * 64 * NPOS * 2);
constexpr size_t WUKVT = A256(WUQT + (size_t)2 * 384 * 256 * 2);
constexpr size_t WAT = A256(WUKVT + (size_t)2 * 512 * 128 * 2);
constexpr size_t WIT = A256(WAT + (size_t)16 * 4096 * 2);
constexpr size_t SPT = A256(WIT + (size_t)16 * 4096 * 2);
constexpr size_t RWH = A256(SPT + (size_t)1024 * 4);
constexpr size_t RWL = A256(RWH + (size_t)2 * NE * D * 2);
constexpr size_t HL = A256(RWL + (size_t)2 * NE * D * 2);
constexpr size_t AC = A256(HL + (size_t)2 * MROWS * 256 * 2);
constexpr size_t SUM = A256(AC + (size_t)2 * MROWS * 256 * 2);
constexpr size_t XCT = A256(SUM + (size_t)2 * 4 * 68 * 512 * 4);
constexpr size_t END = A256(XCT + (size_t)16 * 512 * 64 * 2);
constexpr int CW_BAR = 4096;
constexpr int CW_MODCNT = 2048;
constexpr int CW_CNT = 32768, CNT_STRIDE = 64;
}

#define XB_TMO      128
#define XB_XCNT(j)  (256  + 64 * (j))
#define XB_XSUB(j)  (1280 + 64 * (j))
#define XB_XGEN(j)  (2304 + 64 * (j))
#define XB_TOP      3328
#define XB_TOPGEN   3392
#define XCD_BAR_WORDS 3456
#define XB_SPIN_CAP (1u << 18)
__device__ __forceinline__ unsigned xb_ld(unsigned* p)              { return __hip_atomic_load(p, __ATOMIC_RELAXED, __HIP_MEMORY_SCOPE_AGENT); }
__device__ __forceinline__ unsigned xb_add(unsigned* p, unsigned v) { return __hip_atomic_fetch_add(p, v, __ATOMIC_RELAXED, __HIP_MEMORY_SCOPE_AGENT); }
__device__ __forceinline__ unsigned xb_xcc_id() { return (unsigned)__builtin_amdgcn_s_getreg((3 << 11) | 20) & 0xFu; }
#define XB_SPIN(cond, bar) do { unsigned _sp = 0; while (cond) { __builtin_amdgcn_s_sleep(1); \
    if ((++_sp & 255u) == 0u) { if (xb_ld(&(bar)[XB_TMO])) break; if (_sp > XB_SPIN_CAP) { atomicAdd(&(bar)[XB_TMO], 1u); break; } } } } while (0)
struct XcdBarrier { unsigned* bar; unsigned x; volatile LAS unsigned* st; };
__device__ __forceinline__ XcdBarrier xcd_barrier_post(unsigned* bar, volatile LAS unsigned* st) {
    XcdBarrier b; b.bar = bar; b.x = xb_xcc_id(); b.st = st;
    if (threadIdx.x == 0) (void)xb_add(&bar[XB_XCNT(b.x)], 1u);
    return b;
}
__device__ __forceinline__ void xcd_barrier_complete(unsigned* bar, unsigned x, unsigned& nloc, unsigned& nx) {
    const unsigned G = gridDim.x * gridDim.y * gridDim.z;
    unsigned sum, cnt, mine, sp = 0u;
    for (;;) {
        sum = 0u; cnt = 0u; mine = 0u;
#pragma unroll
        for (unsigned j = 0; j < 16; ++j) { const unsigned c = xb_ld(&bar[XB_XCNT(j)]); sum += c; cnt += (c > 0u) ? 1u : 0u; mine = (j == x) ? c : mine; }
        if (sum == G) break;
        __builtin_amdgcn_s_sleep(1);
        if ((++sp & 255u) == 0u) { if (xb_ld(&bar[XB_TMO])) break; if (sp > XB_SPIN_CAP) { atomicAdd(&bar[XB_TMO], 1u); break; } }
    }
    nloc = mine > 0u ? mine : 1u; nx = cnt > 0u ? cnt : 1u;
}
__device__ __forceinline__ void xcd_barrier(const XcdBarrier& b) {
    asm volatile("s_waitcnt vmcnt(0)" ::: "memory");
    __syncthreads();
    if (threadIdx.x == 0) {
        unsigned* bar = b.bar;
        __builtin_amdgcn_s_waitcnt(0);
        unsigned nloc = b.st[0], nx = b.st[1];
        if (nloc == 0u) { xcd_barrier_complete(bar, b.x, nloc, nx); b.st[0] = nloc; b.st[1] = nx; }
        const unsigned old = xb_add(&bar[XB_XSUB(b.x)], 1u);
        const unsigned gen = old / nloc;
        if (old + 1u == (gen + 1u) * nloc) {
            __builtin_amdgcn_fence(__ATOMIC_RELEASE, "agent");
            asm volatile("s_waitcnt vmcnt(0)" ::: "memory");
            const unsigned og = xb_add(&bar[XB_TOP], 1u);
            const unsigned tg = og / nx;
            if (og + 1u == (tg + 1u) * nx) xb_add(&bar[XB_TOPGEN], 1u);
            else XB_SPIN(xb_ld(&bar[XB_TOPGEN]) == tg, bar);
            __builtin_amdgcn_fence(__ATOMIC_ACQUIRE, "agent");
            xb_add(&bar[XB_XGEN(b.x)], 1u);
            asm volatile("s_waitcnt vmcnt(0)" ::: "memory");
        } else {
            XB_SPIN(xb_ld(&bar[XB_XGEN(b.x)]) == gen, bar);
            __builtin_amdgcn_fence(__ATOMIC_ACQUIRE, "agent");
            asm volatile("s_waitcnt vmcnt(0)" ::: "memory");
        }
    }
    __syncthreads();
}

namespace g8 {
constexpr int BM = 256, BK = 64, HALF = 128, HTB = HALF * BK * 2, STAGE_BYTES = 8 * HTB, NXCD = 8, WGM = 8;
__device__ __forceinline__ int lds_byte(int r, int c) { const int st = (r >> 4) * 2 + (c >> 5), rr = r & 15, cc = c & 31, ob = rr * 64 + cc * 2; return st * 1024 + (ob ^ (((ob >> 9) & 1) << 5)); }
__device__ __forceinline__ void stage_rc(int b, int& R, int& C) { const int st = b / 1024, sb = b % 1024, swz = sb ^ (((sb >> 9) & 1) << 5); R = (st >> 1) * 16 + swz / 64; C = (st & 1) * 32 + (swz % 64) / 2; }
__device__ __forceinline__ int perm32(int rho) { const int n = rho >> 4, i = rho & 15; return 8 * (i >> 2) + 4 * n + (i & 3); }
__device__ __forceinline__ unsigned cvt_pk_bf16(float lo, float hi) { return pk2(lo, hi); }
__device__ __forceinline__ int xcd_remap(int wgid, int nwg) { const int q = nwg / NXCD, r = nwg % NXCD, xcd = wgid % NXCD, off = wgid / NXCD; return (xcd < r ? xcd * (q + 1) : r * (q + 1) + (xcd - r) * q) + off; }

struct Unit { int row0, col0, ex, bt, nvalid, lrow; };

struct DenseSched {
    int nM, nN, nwg, G, c, lat_only; const char* Bt; int K; const int* list;
    __device__ __forceinline__ void init(int nM_, int nN_, int G_, int c_, int lat_only_, const void* Bt_, int K_) { nM = nM_; nN = nN_; nwg = nM * nN; G = G_; c = c_; lat_only = lat_only_; Bt = (const char*)Bt_; K = K_; list = nullptr; }
    __device__ __forceinline__ bool next(int i, Unit& u) const {
        const long Lx = (long)i * G + c; if (Lx >= nwg) return false;
        const int wgid = xcd_remap((int)Lx, nwg);
        const int nig = WGM * nN, gid = wgid / nig, fm = gid * WGM, gsz = (nM - fm) < WGM ? (nM - fm) : WGM;
        const int pm = fm + ((wgid % nig) % gsz), pn = (wgid % nig) / gsz;
        const int tile = lat_only ? (pm / 16) * 17 + 1 + (pm % 16) : pm;
        u.row0 = tile * 256; u.col0 = pn * 256; u.ex = 0; u.bt = pn; u.nvalid = 256; u.lrow = 0; return true;
    }
    __device__ __forceinline__ const char* bptr(const Unit& u) const { return Bt + (size_t)u.bt * (256 * 1024 * 2); }
};
struct MoeSched {
    const LAS int* tpre; const LAS int* cnt; int NT, COLW, G, c, total; const char* Bt; int K; const int* list;
    __device__ __forceinline__ bool next(int i, Unit& u) const {
        const long Lx = (long)i * G + c; if (Lx >= total) return false;
        const int wgid = xcd_remap((int)Lx, total);
        int e = 0;
        for (int j = 1; j < NE; ++j) if (tpre[j] * NT <= wgid) e = j;
        const int t0 = tpre[e], mte = tpre[e + 1] - t0, loc = wgid - t0 * NT, nt = loc / mte, mt = loc % mte;
        u.ex = __builtin_amdgcn_readfirstlane(e); u.row0 = __builtin_amdgcn_readfirstlane((t0 + mt) * 256); u.col0 = __builtin_amdgcn_readfirstlane(nt * COLW);
        u.bt = __builtin_amdgcn_readfirstlane(e * NT + nt); const int nv = cnt[e] - mt * 256; u.nvalid = __builtin_amdgcn_readfirstlane(nv < 256 ? nv : 256); u.lrow = __builtin_amdgcn_readfirstlane(mt * 256);
        return true;
    }
    __device__ __forceinline__ const char* bptr(const Unit& u) const { return Bt + (size_t)u.bt * (256 * 1024 * 2); }
};

struct EpiP {
    static constexpr bool PERM = true; bf16_t* O;
    __device__ __forceinline__ void operator()(const f32x4 (&acc)[2][2][4][2], const Unit& u, int wr, int wc, int fr, int fq, const LAS int*) const {
#pragma unroll
        for (int ai = 0; ai < 2; ++ai)
#pragma unroll
            for (int m = 0; m < 4; ++m) { bf16_t* rowp = O + (size_t)(u.row0 + ai * HALF + wr * 64 + m * 16 + fr) * PP + u.col0 + wc * 32 + 8 * fq;
#pragma unroll
                for (int bj = 0; bj < 2; ++bj) { const f32x4 v0 = acc[ai][bj][m][0], v1 = acc[ai][bj][m][1]; u32x4 w; w.x = cvt_pk_bf16(v0[0], v0[1]); w.y = cvt_pk_bf16(v0[2], v0[3]); w.z = cvt_pk_bf16(v1[0], v1[1]); w.w = cvt_pk_bf16(v1[2], v1[3]);
                    *(u32x4*)(rowp + bj * HALF) = w; } }
    }
};
struct EpiH {
    static constexpr bool PERM = false; float* Hh; const float* MODl; int g_off;
    __device__ __forceinline__ void operator()(const f32x4 (&acc)[2][2][4][2], const Unit& u, int wr, int wc, int fr, int fq, const LAS int*) const {
        const int tile = u.row0 >> 8, v = (tile % 17 == 0) ? 4 : tile / 17; const float* gp = MODl + (size_t)v * 6144 + g_off + u.col0 + wc * 32 + 4 * fq;
        f32x4 gv[2][2];
#pragma unroll
        for (int bj = 0; bj < 2; ++bj)
#pragma unroll
            for (int n = 0; n < 2; ++n) gv[bj][n] = *(const f32x4*)(gp + bj * HALF + n * 16);
#pragma unroll
        for (int ai = 0; ai < 2; ++ai)
#pragma unroll
          for (int mp = 0; mp < 2; ++mp) {
            f32x4 hv[2][2][2];
#pragma unroll
            for (int m2 = 0; m2 < 2; ++m2) { const float* rowp = Hh + (size_t)(u.row0 + ai * HALF + wr * 64 + (2 * mp + m2) * 16 + fr) * D + u.col0 + wc * 32 + 4 * fq;
#pragma unroll
                for (int bj = 0; bj < 2; ++bj)
#pragma unroll
                    for (int n = 0; n < 2; ++n) hv[m2][bj][n] = *(const f32x4*)(rowp + bj * HALF + n * 16); }
#pragma unroll
            for (int m2 = 0; m2 < 2; ++m2) { float* rowp = Hh + (size_t)(u.row0 + ai * HALF + wr * 64 + (2 * mp + m2) * 16 + fr) * D + u.col0 + wc * 32 + 4 * fq;
#pragma unroll
                for (int bj = 0; bj < 2; ++bj)
#pragma unroll
                    for (int n = 0; n < 2; ++n) *(f32x4*)(rowp + bj * HALF + n * 16) = hv[m2][bj][n] + gv[bj][n] * acc[ai][bj][2 * mp + m2][n]; }
          }
    }
};
struct EpiMoe1 {
    static constexpr bool PERM = true; bf16_t* ACTp; const float* bgu;
    __device__ __forceinline__ void operator()(const f32x4 (&acc)[2][2][4][2], const Unit& u, int wr, int wc, int fr, int fq, const LAS int*) const {
        const int cc = u.col0 + wc * 32 + 8 * fq; const float* bp = bgu + (size_t)u.ex * 2048 + cc;
        f32x4 bg[2], bu[2];
#pragma unroll
        for (int n = 0; n < 2; ++n) { bg[n] = *(const f32x4*)(bp + 4 * n); bu[n] = *(const f32x4*)(bp + 1024 + 4 * n); }
#pragma unroll
        for (int ai = 0; ai < 2; ++ai)
#pragma unroll
            for (int m = 0; m < 4; ++m) { const int r = ai * HALF + wr * 64 + m * 16 + fr;
                float o[8];
#pragma unroll
                for (int n = 0; n < 2; ++n)
#pragma unroll
                    for (int i = 0; i < 4; ++i) { const float g = fminf(acc[ai][0][m][n][i] + bg[n][i], 7.f); const float uu = fminf(fmaxf(acc[ai][1][m][n][i] + bu[n][i], -7.f), 7.f);
                        o[n * 4 + i] = (uu + 1.f) * g * __builtin_amdgcn_rcpf(1.f + __expf(-1.702f * g)); }
                { u32x4 w; w.x = cvt_pk_bf16(o[0], o[1]); w.y = cvt_pk_bf16(o[2], o[3]); w.z = cvt_pk_bf16(o[4], o[5]); w.w = cvt_pk_bf16(o[6], o[7]);
                    *(u32x4*)(ACTp + (size_t)(u.row0 + r) * D + cc) = w; } }
    }
};
struct EpiMoe2 {
    static constexpr bool PERM = true; bf16_t* Yp; const float* bd; const float* GATEp;
    __device__ __forceinline__ void operator()(const f32x4 (&acc)[2][2][4][2], const Unit& u, int wr, int wc, int fr, int fq, const LAS int* rows) const {
        const int cc = u.col0 + wc * 32 + 8 * fq; const float* bp = bd + (size_t)u.ex * 1024 + cc;
        f32x4 bv[2][2];
#pragma unroll
        for (int bj = 0; bj < 2; ++bj)
#pragma unroll
            for (int n = 0; n < 2; ++n) bv[bj][n] = *(const f32x4*)(bp + bj * HALF + 4 * n);
        int asgv[2][4]; float gtv[2][4];
#pragma unroll
        for (int ai = 0; ai < 2; ++ai)
#pragma unroll
            for (int m = 0; m < 4; ++m) { const int r = ai * HALF + wr * 64 + m * 16 + fr; const bool ok = r < u.nvalid; const int a = rows[ok ? r : 0]; asgv[ai][m] = ok ? a : NASG; gtv[ai][m] = GATEp[a]; }
#pragma unroll
        for (int ai = 0; ai < 2; ++ai)
#pragma unroll
            for (int m = 0; m < 4; ++m) { const float gt = gtv[ai][m]; bf16_t* rowp = Yp + (size_t)asgv[ai][m] * D + cc;
#pragma unroll
                for (int bj = 0; bj < 2; ++bj) { const f32x4 v0 = (acc[ai][bj][m][0] + bv[bj][0]) * gt, v1 = (acc[ai][bj][m][1] + bv[bj][1]) * gt;
                    u32x4 w; w.x = cvt_pk_bf16(v0[0], v0[1]); w.y = cvt_pk_bf16(v0[2], v0[3]); w.z = cvt_pk_bf16(v1[0], v1[1]); w.w = cvt_pk_bf16(v1[2], v1[3]); *(u32x4*)(rowp + bj * HALF) = w; } }
    }
};

template <class Epi, class Sched, bool GATHER, bool ROWLIST>
__device__ __forceinline__ void gemm_phase(LAS unsigned char* lds, const char* Abase, const Sched& S, const Epi& E) {
    constexpr int K = 1024;
    int tid_l = threadIdx.x; asm volatile("" : "+v"(tid_l));
    const int tid = tid_l, wid = __builtin_amdgcn_readfirstlane(tid >> 6), lane = tid & 63, wr = wid >> 2, wc = wid & 3, fr = lane & 15, fq = lane >> 4;
    constexpr int nt = K / BK; constexpr unsigned Kb = (unsigned)K * 2u;
    unsigned voffB[2];
#pragma unroll
    for (int i = 0; i < 2; ++i) { int R, C; stage_rc(tid * 16 + i * 8192, R, C); const int Rb = Epi::PERM ? ((R & ~31) + perm32(R & 31)) : R; voffB[i] = (unsigned)(Rb * K + C) * 2u; }
    constexpr size_t kstep = (size_t)(BK * 2), hstep = (size_t)HALF * K * 2;
    const unsigned ldsw = (unsigned)wid * 1024u;
    const int aoff = lds_byte(wr * 64 + fr, fq * 8), boff = lds_byte(wc * 32 + fr, fq * 8);
    LAS int* rowbuf = (LAS int*)(lds + STAGE_BYTES);
#define G8_SA(b, h) (((b) * 2 + (h)) * HTB)
#define G8_SB(b, h) ((4 + (b) * 2 + (h)) * HTB)
#define G8_STAGE_A(bufoff, kb, v) do { _Pragma("unroll") for (int _i = 0; _i < 2; ++_i) \
        __builtin_amdgcn_global_load_lds((const unsigned*)((kb) + (size_t)(v)[_i]), (LAS unsigned*)(lds + (bufoff) + ldsw + _i * 8192), 16, 0, 0); } while (0)
#define G8_STAGE_B(bufoff, gbase) do { _Pragma("unroll") for (int _i = 0; _i < 2; ++_i) \
        __builtin_amdgcn_global_load_lds((const unsigned*)((gbase) + voffB[_i]), (LAS unsigned*)(lds + (bufoff) + ldsw + _i * 8192), 16, 0, 0); } while (0)
#define G8_LDA(dst, b, h) do { _Pragma("unroll") for (int m = 0; m < 4; ++m) _Pragma("unroll") for (int k = 0; k < 2; ++k) dst[m][k] = *(const LAS bf16x8*)(lds + G8_SA(b, h) + aoff + m * 2048 + k * 1024); } while (0)
#define G8_LDB(dst, b, h) do { _Pragma("unroll") for (int n = 0; n < 2; ++n) _Pragma("unroll") for (int k = 0; k < 2; ++k) dst[n][k] = *(const LAS bf16x8*)(lds + G8_SB(b, h) + boff + n * 2048 + k * 1024); } while (0)
#define G8_MMA(ai, bj, At, Bt) do { __builtin_amdgcn_s_setprio(1); _Pragma("unroll") for (int m = 0; m < 4; ++m) _Pragma("unroll") for (int n = 0; n < 2; ++n) _Pragma("unroll") for (int k = 0; k < 2; ++k) \
        acc[ai][bj][m][n] = __builtin_amdgcn_mfma_f32_16x16x32_bf16(Bt[n][k], At[m][k], acc[ai][bj][m][n], 0, 0, 0); __builtin_amdgcn_s_setprio(0); } while (0)
#define G8_WAIT_V(n) asm volatile("s_waitcnt vmcnt(" #n ")" ::: "memory")
#define G8_WAIT_L(n) asm volatile("s_waitcnt lgkmcnt(" #n ")" ::: "memory")
#define G8_BAR __builtin_amdgcn_s_barrier()
#define G8_SCHED __builtin_amdgcn_sched_barrier(0)
#define G8_LISTDMA(u, s) do { if (wid < 4) __builtin_amdgcn_global_load_lds((const unsigned*)(S.list + (size_t)(u).ex * LCAP + (u).lrow + wid * 64 + lane), (LAS unsigned*)(rowbuf + (s) * 256 + wid * 64), 4, 0, 0); } while (0)
#define G8_ROWS_DENSE(v) do { _Pragma("unroll") for (int _i = 0; _i < 2; ++_i) { int _R, _C; stage_rc(tid * 16 + _i * 8192, _R, _C); _Pragma("unroll") for (int _h = 0; _h < 2; ++_h) (v)[_h][_i] = (unsigned)(_h * HALF + _R) * Kb + (unsigned)_C * 2u; } } while (0)
#define G8_ROWS_LIST(v, u, s) do { _Pragma("unroll") for (int _i = 0; _i < 2; ++_i) { int _R, _C; stage_rc(tid * 16 + _i * 8192, _R, _C); _Pragma("unroll") for (int _h = 0; _h < 2; ++_h) { const int _r = _h * HALF + _R; const int _a = rowbuf[(s) * 256 + _r]; \
        (v)[_h][_i] = (unsigned)(_r < (u).nvalid ? (_a >> 2) : 0) * Kb + (unsigned)_C * 2u; } } } while (0)
    Unit cur, nxt; int ui = 0, slot = 0;
    if (!S.next(0, cur)) return;
    unsigned vA[2][2];
    if constexpr (ROWLIST) { G8_LISTDMA(cur, 0); G8_WAIT_V(0); G8_BAR; }
    if constexpr (GATHER) { G8_ROWS_LIST(vA, cur, 0); } else { G8_ROWS_DENSE(vA); }
    f32x4 acc[2][2][4][2];
#pragma unroll
    for (int a = 0; a < 2; ++a)
#pragma unroll
        for (int b = 0; b < 2; ++b)
#pragma unroll
            for (int m = 0; m < 4; ++m)
#pragma unroll
                for (int n = 0; n < 2; ++n) acc[a][b][m][n] = (f32x4){0.f, 0.f, 0.f, 0.f};
    bf16x8 At[4][2], B0[2][2], B1[2][2];
    const char* cB = S.bptr(cur);
    const char* cA = GATHER ? Abase : Abase + (size_t)cur.row0 * Kb;
    G8_STAGE_B(G8_SB(0, 0), cB); G8_STAGE_B(G8_SB(0, 1), cB + hstep); G8_STAGE_A(G8_SA(0, 0), cA, vA[0]); G8_STAGE_A(G8_SA(0, 1), cA, vA[1]);
    if (wr == 1) G8_BAR;
    G8_WAIT_V(2); G8_BAR;
    G8_STAGE_B(G8_SB(1, 0), cB + kstep); G8_STAGE_A(G8_SA(1, 0), cA + kstep, vA[0]); G8_STAGE_B(G8_SB(1, 1), cB + hstep + kstep);
    G8_WAIT_V(6); G8_BAR;
    for (;;) {
        const bool has_next = S.next(ui + 1, nxt);
        const char* nB = has_next ? S.bptr(nxt) : cB;
        const char* nA = (GATHER || !has_next) ? cA : Abase + (size_t)nxt.row0 * Kb;
        const int nslot = slot == 2 ? 0 : slot + 1;
        if constexpr (ROWLIST) { if (has_next) G8_LISTDMA(nxt, nslot); }
        for (int t = 0; t < nt; t += 2) {
            const bool last = (t == nt - 2);
            const char* a1 = cA + (size_t)(t + 1) * kstep;
            const char* a2 = last ? nA : cA + (size_t)(t + 2) * kstep; const char* b2 = last ? nB : cB + (size_t)(t + 2) * kstep;
            const char* a3 = a2 + kstep; const char* b3 = b2 + kstep;
            G8_LDB(B0, 0, 0); G8_LDB(B1, 0, 1); G8_SCHED; G8_LDA(At, 0, 0); G8_STAGE_A(G8_SA(1, 1), a1, vA[1]);
            if constexpr (GATHER) { if (last && has_next) { G8_ROWS_LIST(vA, nxt, nslot); } }
            G8_WAIT_V(8); G8_WAIT_L(0); G8_BAR; G8_MMA(0, 0, At, B0); G8_MMA(0, 1, At, B1); G8_BAR; G8_SCHED;
            G8_LDA(At, 0, 1); G8_STAGE_B(G8_SB(0, 0), b2); G8_STAGE_B(G8_SB(0, 1), b2 + hstep); G8_STAGE_A(G8_SA(0, 0), a2, vA[0]);
            G8_WAIT_V(8); G8_WAIT_L(0); G8_BAR; G8_MMA(1, 0, At, B0); G8_MMA(1, 1, At, B1); G8_BAR; G8_SCHED;
            G8_LDB(B0, 1, 0); G8_LDB(B1, 1, 1); G8_SCHED; G8_LDA(At, 1, 0); G8_STAGE_A(G8_SA(0, 1), a2, vA[1]);
            G8_WAIT_V(8); G8_WAIT_L(0); G8_BAR; G8_MMA(0, 0, At, B0); G8_MMA(0, 1, At, B1); G8_BAR; G8_SCHED;
            G8_LDA(At, 1, 1); G8_STAGE_B(G8_SB(1, 0), b3); G8_STAGE_B(G8_SB(1, 1), b3 + hstep); G8_STAGE_A(G8_SA(1, 0), a3, vA[0]);
            G8_WAIT_V(8); G8_WAIT_L(0); G8_BAR; G8_MMA(1, 0, At, B0); G8_MMA(1, 1, At, B1); G8_BAR; G8_SCHED;
        }
        if (wr == 0) G8_BAR;
        { int t2 = threadIdx.x; asm volatile("" : "+v"(t2));
          const int w2 = __builtin_amdgcn_readfirstlane(t2 >> 6); E(acc, cur, w2 >> 2, w2 & 3, t2 & 15, (t2 & 63) >> 4, rowbuf + slot * 256); }
        if (!has_next) break;
#pragma unroll
        for (int a = 0; a < 2; ++a)
#pragma unroll
            for (int b = 0; b < 2; ++b)
#pragma unroll
                for (int m = 0; m < 4; ++m)
#pragma unroll
                    for (int n = 0; n < 2; ++n) acc[a][b][m][n] = (f32x4){0.f, 0.f, 0.f, 0.f};
        cur = nxt; cB = nB; cA = nA; ++ui; slot = nslot;
        if (wr == 1) G8_BAR;
    }
    G8_WAIT_V(0);
    G8_BAR;
#undef G8_SA
#undef G8_SB
#undef G8_STAGE_A
#undef G8_STAGE_B
#undef G8_LDA
#undef G8_LDB
#undef G8_MMA
#undef G8_WAIT_V
#undef G8_WAIT_L
#undef G8_BAR
#undef G8_SCHED
#undef G8_LISTDMA
#undef G8_ROWS_DENSE
#undef G8_ROWS_LIST
}
}

namespace fft {
constexpr int TP = 72;
constexpr int UP = 264;
constexpr int ZP = 520;
constexpr int O_TC = 0, O_TS = 9216, O_U = 18432, O_X = 52224, O_TW = 125952;
__device__ __forceinline__ bf16x8 neg8(bf16x8 v) { u32x4 w = __builtin_bit_cast(u32x4, v); w = w ^ 0x80008000u; return __builtin_bit_cast(bf16x8, w); }
__device__ __forceinline__ void build_tables(LAS unsigned char* lds, const float* TABC, const float* TABS, int tid) {
    for (int i = tid; i < 4096; i += 512) { const int a = i >> 6, b = i & 63, ix = ((a * b) & 63) * 64;
        ((LAS bf16_t*)(lds + O_TC))[a * TP + b] = f2bf(TABC[ix]); ((LAS bf16_t*)(lds + O_TS))[a * TP + b] = f2bf(TABS[ix]); }
}
__device__ __forceinline__ void stage_a(LAS unsigned char* lds, const bf16_t* P, const float* TABC, const float* TABS, bf16_t* ZBUF, int u0, int u1, int ustep) {
    int tid_l = threadIdx.x; asm volatile("" : "+v"(tid_l));
    const int tid = tid_l, lane = tid & 63, w = __builtin_amdgcn_readfirstlane(tid >> 6), fr = lane & 15, fq = lane >> 4;
    build_tables(lds, TABC, TABS, tid);
    const LAS bf16_t* Tc = (const LAS bf16_t*)(lds + O_TC); const LAS bf16_t* Ts = (const LAS bf16_t*)(lds + O_TS);
    LAS bf16_t* U = (LAS bf16_t*)(lds + O_U); LAS bf16_t* X = (LAS bf16_t*)(lds + O_X); LAS float* TW = (LAS float*)(lds + O_TW);
    for (int unit = u0; unit < u1; unit += ustep) {
        const int b = unit >> 6, t2 = unit & 63;
#pragma unroll
        for (int i = 0; i < 4; ++i) { const int q = tid + 512 * i, t1 = q >> 5, ch = q & 31;
            *(LAS u32x4*)((LAS unsigned char*)U + t1 * (UP * 2) + ch * 16) = *(const u32x4*)(P + ((size_t)b * NPOS + CTX + 64 * t1 + t2) * PP + ch * 8); }
        if (tid < 64) { const int ix = tid * t2; TW[2 * tid] = TABC[ix]; TW[2 * tid + 1] = TABS[ix]; }
        __syncthreads();
        { const int g = w >> 1, part = w & 1; const LAS bf16_t* T = part ? Ts : Tc;
          f32x4 acc[4][4];
#pragma unroll
          for (int mt = 0; mt < 4; ++mt)
#pragma unroll
              for (int nt = 0; nt < 4; ++nt) acc[mt][nt] = (f32x4){0.f, 0.f, 0.f, 0.f};
#pragma unroll
          for (int ks = 0; ks < 2; ++ks) { bf16x8 a[4], bb[4];
#pragma unroll
              for (int mt = 0; mt < 4; ++mt) a[mt] = *(const LAS bf16x8*)(U + (16 * mt + fr) * UP + g * 64 + 32 * ks + 8 * fq);
#pragma unroll
              for (int nt = 0; nt < 4; ++nt) bb[nt] = *(const LAS bf16x8*)(T + (16 * nt + fr) * TP + 32 * ks + 8 * fq);
#pragma unroll
              for (int mt = 0; mt < 4; ++mt)
#pragma unroll
                  for (int nt = 0; nt < 4; ++nt) acc[mt][nt] = __builtin_amdgcn_mfma_f32_16x16x32_bf16(a[mt], bb[nt], acc[mt][nt], 0, 0, 0); }
          const float sg = part ? -1.f : 1.f;
#pragma unroll
          for (int mt = 0; mt < 4; ++mt)
#pragma unroll
              for (int nt = 0; nt < 4; ++nt) { const f32x4 v = acc[mt][nt] * sg; u32x2 o; o.x = pk2(v[0], v[1]); o.y = pk2(v[2], v[3]);
                  *(LAS u32x2*)(X + (part * 256 + g * 64 + 16 * nt + fr) * TP + 16 * mt + 4 * fq) = o; } }
        __syncthreads();
        f32x4 zr[4][2], zi[4][2];
#pragma unroll
        for (int mt = 0; mt < 4; ++mt)
#pragma unroll
            for (int n = 0; n < 2; ++n) { zr[mt][n] = (f32x4){0.f, 0.f, 0.f, 0.f}; zi[mt][n] = (f32x4){0.f, 0.f, 0.f, 0.f}; }
#pragma unroll
        for (int ks = 0; ks < 2; ++ks) { bf16x8 xr[2], xi[2];
#pragma unroll
            for (int n = 0; n < 2; ++n) { xr[n] = *(const LAS bf16x8*)(X + (32 * w + 16 * n + fr) * TP + 32 * ks + 8 * fq); xi[n] = *(const LAS bf16x8*)(X + (256 + 32 * w + 16 * n + fr) * TP + 32 * ks + 8 * fq); }
#pragma unroll
            for (int mt = 0; mt < 4; ++mt) { const bf16x8 c = *(const LAS bf16x8*)(Tc + (16 * mt + fr) * TP + 32 * ks + 8 * fq), s = *(const LAS bf16x8*)(Ts + (16 * mt + fr) * TP + 32 * ks + 8 * fq), ns = neg8(s);
#pragma unroll
                for (int n = 0; n < 2; ++n) { zr[mt][n] = __builtin_amdgcn_mfma_f32_16x16x32_bf16(c, xr[n], zr[mt][n], 0, 0, 0); zr[mt][n] = __builtin_amdgcn_mfma_f32_16x16x32_bf16(s, xi[n], zr[mt][n], 0, 0, 0);
                    zi[mt][n] = __builtin_amdgcn_mfma_f32_16x16x32_bf16(c, xi[n], zi[mt][n], 0, 0, 0); zi[mt][n] = __builtin_amdgcn_mfma_f32_16x16x32_bf16(ns, xr[n], zi[mt][n], 0, 0, 0); } } }
        __syncthreads();
        { LAS bf16_t* Zs = X;
#pragma unroll
          for (int mt = 0; mt < 4; ++mt)
#pragma unroll
              for (int i = 0; i < 4; ++i) { const int f1 = 16 * mt + 4 * fq + i; const float ct = TW[2 * f1], st = TW[2 * f1 + 1];
#pragma unroll
                  for (int n = 0; n < 2; ++n) { const float a = zr[mt][n][i], bq = zi[mt][n][i]; const int col = 32 * w + 16 * n + fr;
                      Zs[f1 * ZP + col] = f2bf(a * ct + bq * st); Zs[f1 * ZP + 256 + col] = f2bf(bq * ct - a * st); } } }
        __syncthreads();
#pragma unroll
        for (int i = 0; i < 8; ++i) { const int q = tid + 512 * i, f1 = q >> 6, ch = q & 63;
            *(u32x4*)(ZBUF + (((size_t)b * 64 + f1) * 64 + t2) * 512 + ch * 8) = *(const LAS u32x4*)((const LAS unsigned char*)X + f1 * (ZP * 2) + ch * 16); }
        __syncthreads();
    }
}
__device__ __forceinline__ void stage_b(LAS unsigned char* lds, const bf16_t* ZBUF, const float* TABC, const float* TABS, bf16_t* MIX, int G, int bx) {
    int tid_l = threadIdx.x; asm volatile("" : "+v"(tid_l));
    const int tid = tid_l, lane = tid & 63, w = __builtin_amdgcn_readfirstlane(tid >> 6), fr = lane & 15, fq = lane >> 4;
    build_tables(lds, TABC, TABS, tid);
    const LAS bf16_t* Tc = (const LAS bf16_t*)(lds + O_TC); const LAS bf16_t* Ts = (const LAS bf16_t*)(lds + O_TS);
    LAS bf16_t* Ys = (LAS bf16_t*)(lds + O_U); LAS bf16_t* ZT = (LAS bf16_t*)(lds + O_X);
    for (int unit = bx; unit < 256; unit += G) {
        const int b = unit >> 6, f1 = unit & 63;
        const bf16_t* Zg = ZBUF + ((size_t)b * 64 + f1) * 64 * 512;
#pragma unroll
        for (int i = 0; i < 4; ++i) { const int q = tid + 512 * i, p = q & 31, ch = q >> 5;
            const u32x4 r0 = *(const u32x4*)(Zg + (size_t)(2 * p) * 512 + ch * 8), r1 = *(const u32x4*)(Zg + (size_t)(2 * p + 1) * 512 + ch * 8);
#pragma unroll
            for (int j = 0; j < 4; ++j) { const unsigned a = r0[j], c = r1[j];
                *(LAS unsigned*)(ZT + (ch * 8 + 2 * j) * TP + 2 * p) = (a & 0xffffu) | (c << 16);
                *(LAS unsigned*)(ZT + (ch * 8 + 2 * j + 1) * TP + 2 * p) = (a >> 16) | (c & 0xffff0000u); } }
        __syncthreads();
        f32x4 y[4][2];
#pragma unroll
        for (int mt = 0; mt < 4; ++mt)
#pragma unroll
            for (int n = 0; n < 2; ++n) y[mt][n] = (f32x4){0.f, 0.f, 0.f, 0.f};
#pragma unroll
        for (int ks = 0; ks < 2; ++ks) { bf16x8 xr[2], xi[2];
#pragma unroll
            for (int n = 0; n < 2; ++n) { xr[n] = *(const LAS bf16x8*)(ZT + (32 * w + 16 * n + fr) * TP + 32 * ks + 8 * fq); xi[n] = *(const LAS bf16x8*)(ZT + (256 + 32 * w + 16 * n + fr) * TP + 32 * ks + 8 * fq); }
#pragma unroll
            for (int mt = 0; mt < 4; ++mt) { const bf16x8 c = *(const LAS bf16x8*)(Tc + (16 * mt + fr) * TP + 32 * ks + 8 * fq), s = *(const LAS bf16x8*)(Ts + (16 * mt + fr) * TP + 32 * ks + 8 * fq);
#pragma unroll
                for (int n = 0; n < 2; ++n) { y[mt][n] = __builtin_amdgcn_mfma_f32_16x16x32_bf16(c, xr[n], y[mt][n], 0, 0, 0); y[mt][n] = __builtin_amdgcn_mfma_f32_16x16x32_bf16(s, xi[n], y[mt][n], 0, 0, 0); } } }
#pragma unroll
        for (int mt = 0; mt < 4; ++mt)
#pragma unroll
            for (int i = 0; i < 4; ++i)
#pragma unroll
                for (int n = 0; n < 2; ++n) Ys[(16 * mt + 4 * fq + i) * UP + 32 * w + 16 * n + fr] = f2bf(y[mt][n][i] * (1.f / 512.f));
        __syncthreads();
#pragma unroll
        for (int i = 0; i < 4; ++i) { const int q = tid + 512 * i, f2 = q >> 5, ch = q & 31;
            *(u32x4*)(MIX + ((size_t)b * NPOS + CTX + f1 + 64 * f2) * D + ch * 8) = *(const LAS u32x4*)((const LAS unsigned char*)Ys + f2 * (UP * 2) + ch * 16); }
        __syncthreads();
    }
}
}

namespace cv {
constexpr int SCR_BYTES = 64 * 33 * 4;
struct Job { const float* wgu; const float* wdn; unsigned char* ws; unsigned n0, first0, first1, nv; };
__device__ __forceinline__ void decode(const Job& J, unsigned v, const float*& src, unsigned& N, bf16_t*& dst) {
    const unsigned l = v < J.n0 ? 0u : 1u, j = v < J.n0 ? J.first0 + v : J.first1 + (v - J.n0);
    if (j < 32768u) { const unsigned e = j >> 10, kb = (j >> 6) & 15u, n0 = 32u * (j & 63u), c2 = n0 & 1023u, drow = (c2 >> 7) * 256u + (n0 >> 10) * 128u + (c2 & 127u);
        src = J.wgu + ((size_t)(l * NE + e) << 21) + ((size_t)kb << 17) + n0; N = 2048u; dst = (bf16_t*)(J.ws + L::WGUT) + ((size_t)(l * NE + e) << 21) + ((size_t)drow << 10) + 64u * kb; }
    else { const unsigned r = j - 32768u, e = r >> 9, kb = (r >> 5) & 15u, nb = r & 31u;
        src = J.wdn + ((size_t)(l * NE + e) << 20) + ((size_t)kb << 16) + 32u * nb; N = 1024u; dst = (bf16_t*)(J.ws + L::WDT) + ((size_t)(l * NE + e) << 20) + ((size_t)nb << 15) + 64u * kb; }
}
__device__ __forceinline__ void issue(const float* src, unsigned N, unsigned scr_addr, int lane) {
    const unsigned kr = lane >> 3, nc = (lane & 7) * 4; unsigned voff = (kr * N + nc) * 4u; const unsigned dstep = 32u * N - 1056u, dstep4 = dstep + 4224u, scr_hi = scr_addr + 4224u; unsigned keep;
    asm volatile("s_mov_b32 %0, m0\n\ts_mov_b32 m0, %3\n\ts_nop 0\n\t"
                 "global_load_lds_dwordx4 %1, %2 nt\n\tv_add_u32 %1, %4, %1\n\t"
                 "global_load_lds_dwordx4 %1, %2 offset:1056 nt\n\tv_add_u32 %1, %4, %1\n\t"
                 "global_load_lds_dwordx4 %1, %2 offset:2112 nt\n\tv_add_u32 %1, %4, %1\n\t"
                 "global_load_lds_dwordx4 %1, %2 offset:3168 nt\n\tv_add_u32 %1, %5, %1\n\t"
                 "s_mov_b32 m0, %6\n\ts_nop 0\n\t"
                 "global_load_lds_dwordx4 %1, %2 nt\n\tv_add_u32 %1, %4, %1\n\t"
                 "global_load_lds_dwordx4 %1, %2 offset:1056 nt\n\tv_add_u32 %1, %4, %1\n\t"
                 "global_load_lds_dwordx4 %1, %2 offset:2112 nt\n\tv_add_u32 %1, %4, %1\n\t"
                 "global_load_lds_dwordx4 %1, %2 offset:3168 nt\n\t"
                 "s_mov_b32 m0, %0"
                 : "=&s"(keep), "+v"(voff) : "s"(src), "s"(scr_addr), "s"(dstep), "s"(dstep4), "s"(scr_hi) : "memory");
}
__device__ __forceinline__ void finish(bf16_t* dst, const LAS float* scr, int lane) {
    const int c = lane & 7; const unsigned off = ((unsigned)(lane >> 3) * D + 8u * c) * 2u;
#pragma unroll
    for (int j = 0; j < 4; ++j) { const LAS float* s = scr + 264 * c + (lane >> 3) + 8 * j;
        u32x4 o; o.x = pk2(s[0 * 32], s[1 * 32]); o.y = pk2(s[2 * 32], s[3 * 32]); o.z = pk2(s[4 * 32], s[5 * 32]); o.w = pk2(s[6 * 32], s[7 * 32]);
        __builtin_nontemporal_store(o, (u32x4*)((char*)dst + (off + j * (8u * D * 2u)))); }
    asm volatile("s_waitcnt lgkmcnt(0)" ::: "memory");
}
}

namespace attn {
typedef float f32x16 __attribute__((ext_vector_type(16)));
typedef float f32x2_t __attribute__((ext_vector_type(2))); typedef __bf16 bf16x2_t __attribute__((ext_vector_type(2)));
__device__ __forceinline__ unsigned cvtpk(float lo, float hi) { f32x2_t v = {lo, hi}; bf16x2_t b = __builtin_convertvector(v, bf16x2_t); return __builtin_bit_cast(unsigned, b); }
constexpr int KP = 104, VP = 68;
constexpr int KT_BYTES = 64 * KP * 2, VT_BYTES = 64 * VP * 2, BUF_BYTES = KT_BYTES + VT_BYTES;
constexpr float THR = 8.f; constexpr int NWAVES_ATT = 8;
__device__ __forceinline__ void attn_phase(LAS unsigned char* lds, const bf16_t* QL, const bf16_t* QC, const bf16_t* KB, const bf16_t* VTG, bf16_t* MIX, int with_ctx, int G, int vcu, const cv::Job& J, bool cv_on) {
    const int nunits = 256 + (with_ctx ? 16 : 0);
    for (int unit = vcu; unit < nunits; unit += G) {
        int tid_l = threadIdx.x; asm volatile("" : "+v"(tid_l));
        const int tid = tid_l, lane = tid & 63, wid = __builtin_amdgcn_readfirstlane(tid >> 6), r32 = lane & 31, hi = lane >> 5;
        int bh, nk, orow0; const bf16_t* Qp;
        if (unit < 256) { bh = unit >> 4; const int qb = unit & 15; Qp = QL + ((size_t)bh * SEQ + qb * 256) * 96; nk = NPOS; orow0 = (bh >> 2) * NPOS + CTX + qb * 256; }
        else { bh = unit - 256; Qp = QC + (size_t)bh * CTX * 96; nk = CTX; orow0 = (bh >> 2) * NPOS; }
        const int hh = bh & 3, NT = nk / 64;
        const bf16_t* Kg = KB + (size_t)bh * NPOS * 96; const bf16_t* Vg = VTG + (size_t)bh * 64 * NPOS;
        bf16x8 qf[6];
        { const bf16_t* qp = Qp + (size_t)(wid * 32 + r32) * 96 + 8 * hi;
#pragma unroll
          for (int ds = 0; ds < 6; ++ds) qf[ds] = *(const bf16x8*)(qp + 16 * ds); }
        f32x16 o0 = {}, o1 = {}, negm = {}; float mhat = 0.f, l = 0.f;
        const int kr0 = tid / 12, kc0 = tid % 12, kr1 = (tid + 256) / 12, kc1 = (tid + 256) % 12, kr2 = (tid + 512) / 12, kc2 = (tid + 512) % 12;
        const int vd = tid >> 3, vc = tid & 7;
        u32x4 sk0, sk1, sk2, sv0, sv1;
#define AT_LOAD(t_) do { const size_t k0_ = (size_t)(t_) * 64; sk0 = *(const u32x4*)(Kg + (k0_ + kr0) * 96 + kc0 * 8); sk1 = *(const u32x4*)(Kg + (k0_ + kr1) * 96 + kc1 * 8); sk2 = *(const u32x4*)(Kg + (k0_ + kr2) * 96 + kc2 * 8); \
            sv0 = *(const u32x4*)(Vg + (size_t)vd * NPOS + k0_ + vc * 8); sv1 = *(const u32x4*)(Vg + (size_t)(vd + 32) * NPOS + k0_ + vc * 8); } while (0)
#define AT_STORE(slot_) do { LAS unsigned char* bp_ = lds + (slot_) * BUF_BYTES; *(LAS u32x4*)(bp_ + kr0 * (KP * 2) + kc0 * 16) = sk0; *(LAS u32x4*)(bp_ + kr1 * (KP * 2) + kc1 * 16) = sk1; *(LAS u32x4*)(bp_ + kr2 * (KP * 2) + kc2 * 16) = sk2; \
            *(LAS u32x4*)(bp_ + KT_BYTES + vd * (VP * 2) + vc * 16) = sv0; *(LAS u32x4*)(bp_ + KT_BYTES + (vd + 32) * (VP * 2) + vc * 16) = sv1; } while (0)
#define AT_QK(P0, P1, slot_) do { const LAS bf16_t* Kt_ = (const LAS bf16_t*)(lds + (slot_) * BUF_BYTES); \
        _Pragma("unroll") for (int ds = 0; ds < 6; ++ds) { const bf16x8 k0f = *(const LAS bf16x8*)(Kt_ + r32 * KP + 16 * ds + 8 * hi), k1f = *(const LAS bf16x8*)(Kt_ + (32 + r32) * KP + 16 * ds + 8 * hi); \
            if (ds == 0) { P0 = __builtin_amdgcn_mfma_f32_32x32x16_bf16(k0f, qf[0], negm, 0, 0, 0); P1 = __builtin_amdgcn_mfma_f32_32x32x16_bf16(k1f, qf[0], negm, 0, 0, 0); } \
            else { P0 = __builtin_amdgcn_mfma_f32_32x32x16_bf16(k0f, qf[ds], P0, 0, 0, 0); P1 = __builtin_amdgcn_mfma_f32_32x32x16_bf16(k1f, qf[ds], P1, 0, 0, 0); } } } while (0)
#define MX3(a_, b_, c_) __builtin_fmaxf(__builtin_fmaxf((a_), (b_)), (c_))
#define AT_STEP(C0, C1, N0, N1, t_, STO_, PRE_) do { \
            if ((t_) + 1 < NT) AT_QK(N0, N1, s_nxt); \
            float mx_ = MX3(C0[0], C0[1], C1[0]), my_ = MX3(C0[2], C0[3], C1[1]); mx_ = MX3(mx_, C1[2], C1[3]); \
            _Pragma("unroll") for (int r = 4; r < 16; r += 4) { mx_ = MX3(mx_, C0[r], C0[r + 1]); my_ = MX3(my_, C0[r + 2], C0[r + 3]); mx_ = MX3(mx_, C1[r], C1[r + 1]); my_ = MX3(my_, C1[r + 2], C1[r + 3]); } \
            mx_ = fmaxf(mx_, my_); mx_ = fmaxf(mx_, __shfl_xor(mx_, 32)); \
            if (__builtin_expect((t_) == 0 || __any(mx_ > THR), 0)) { const float dl = (t_) == 0 ? mx_ : fmaxf(mx_, 0.f), f = __builtin_amdgcn_exp2f(-dl); mhat += dl; l *= f; \
                _Pragma("unroll") for (int r = 0; r < 16; ++r) { C0[r] -= dl; C1[r] -= dl; o0[r] *= f; o1[r] *= f; negm[r] = -mhat; } \
                if ((t_) + 1 < NT) { _Pragma("unroll") for (int r = 0; r < 16; ++r) { N0[r] -= dl; N1[r] -= dl; } } } \
            float ls_ = 0.f; \
            _Pragma("unroll") for (int r = 0; r < 16; ++r) { C0[r] = __builtin_amdgcn_exp2f(C0[r]); C1[r] = __builtin_amdgcn_exp2f(C1[r]); ls_ += C0[r] + C1[r]; } \
            l += ls_; \
            const LAS bf16_t* Vt_ = (const LAS bf16_t*)(lds + s_cur * BUF_BYTES + KT_BYTES); \
            _Pragma("unroll") for (int q = 0; q < 4; ++q) { u32x4 pw_; \
                _Pragma("unroll") for (int j = 0; j < 4; ++j) { const int r = 8 * (q & 1) + 2 * j; pw_[j] = (q < 2) ? cvtpk(C0[r], C0[r + 1]) : cvtpk(C1[r], C1[r + 1]); } \
                const bf16x8 pf_ = __builtin_bit_cast(bf16x8, pw_); const int kvb = 32 * (q >> 1) + 16 * (q & 1) + 4 * hi; \
                _Pragma("unroll") for (int db = 0; db < 2; ++db) { const u32x2 va = *(const LAS u32x2*)(Vt_ + (32 * db + r32) * VP + kvb), vb = *(const LAS u32x2*)(Vt_ + (32 * db + r32) * VP + kvb + 8); \
                    const u32x4 vw = {va.x, va.y, vb.x, vb.y}; const bf16x8 vf = __builtin_bit_cast(bf16x8, vw); \
                    if (db == 0) o0 = __builtin_amdgcn_mfma_f32_32x32x16_bf16(vf, pf_, o0, 0, 0, 0); else o1 = __builtin_amdgcn_mfma_f32_32x32x16_bf16(vf, pf_, o1, 0, 0, 0); } } \
            if ((t_) + 2 < NT) { STO_; } \
            PRE_; \
            __syncthreads(); \
            { const int tmp_ = s_cur; s_cur = s_nxt; s_nxt = s_ld; s_ld = tmp_; } } while (0)
        if (wid < 4) { AT_LOAD(0); AT_STORE(0); if (NT > 1) { AT_LOAD(1); AT_STORE(1); } }
        __syncthreads();
        f32x16 pA0, pA1, pB0, pB1;
        AT_QK(pA0, pA1, 0);
        int s_cur = 0, s_nxt = 1, s_ld = 2;
        const unsigned cvb = (cv_on && unit < 256 && wid >= 4) ? (unsigned)(vcu * 4 + (wid - 4)) : J.nv;
#define CV_HAS(q_) ((q_) >= 0 && cvb + 1024u * (unsigned)(q_) < J.nv)
#define CV_WAIT(q_) do { if (CV_HAS((q_) - 1)) { const bool f_ = (q_) >= 2; const bool i_ = CV_HAS(q_); if (f_ && i_) asm volatile("s_waitcnt vmcnt(12)" ::: "memory"); else if (i_) asm volatile("s_waitcnt vmcnt(8)" ::: "memory"); \
            else if (f_) asm volatile("s_waitcnt vmcnt(4)" ::: "memory"); else asm volatile("s_waitcnt vmcnt(0)" ::: "memory"); } } while (0)
        LAS float* cscr = (LAS float*)(lds + 3 * BUF_BYTES + ((wid & 3) * 2) * cv::SCR_BYTES);
        const unsigned cscr_addr = __builtin_amdgcn_readfirstlane((unsigned)(unsigned long)cscr);
        const float* csrc = J.wgu; unsigned cN = 2048u; bf16_t* cdst0 = (bf16_t*)(J.ws + L::WGUT); bf16_t* cdst1 = cdst0;
        if (wid < 4) {
            for (int t = 0; t < NT; t += 2) {
                if (t + 2 < NT) AT_LOAD(t + 2);
                AT_STEP(pA0, pA1, pB0, pB1, t, AT_STORE(s_ld), (void)0);
                if (t + 3 < NT) AT_LOAD(t + 3);
                AT_STEP(pB0, pB1, pA0, pA1, t + 1, AT_STORE(s_ld), (void)0);
            }
        } else {
            for (int t = 0; t < NT; t += 2) {
                const int q = t >> 1;
                if (CV_HAS(q - 2)) cv::finish((q & 1) ? cdst1 : cdst0, cscr + (q & 1) * (cv::SCR_BYTES / 4), lane);
                if (CV_HAS(q)) { bf16_t* nd; cv::decode(J, cvb + 1024u * (unsigned)q, csrc, cN, nd); if (q & 1) cdst1 = nd; else cdst0 = nd; cv::issue(csrc, cN, cscr_addr + (unsigned)(q & 1) * cv::SCR_BYTES, lane); }
                AT_STEP(pA0, pA1, pB0, pB1, t, (void)0, (void)0);
                AT_STEP(pB0, pB1, pA0, pA1, t + 1, (void)0, CV_WAIT(q));
            }
        }
        if (cvb < J.nv) {
            asm volatile("s_waitcnt vmcnt(0)" ::: "memory");
        }
        if (cv_on && unit < 256) __syncthreads();
        if (cvb < J.nv) { const int q = NT >> 1;
            if (CV_HAS(q - 2)) cv::finish((q & 1) ? cdst1 : cdst0, cscr + (q & 1) * (cv::SCR_BYTES / 4), lane);
            if (CV_HAS(q - 1)) cv::finish((q & 1) ? cdst0 : cdst1, cscr + ((q + 1) & 1) * (cv::SCR_BYTES / 4), lane); }
#undef CV_HAS
#undef CV_WAIT
#undef AT_LOAD
#undef AT_STORE
#undef AT_QK
#undef AT_STEP
#undef MX3
        l += __shfl_xor(l, 32);
        const float il = 1.f / l;
        bf16_t* op = MIX + (size_t)(orow0 + wid * 32 + r32) * D + 512 + hh * 64 + 4 * hi;
#pragma unroll
        for (int g4 = 0; g4 < 4; ++g4) { u32x2 w0, w1; w0.x = cvtpk(o0[4 * g4] * il, o0[4 * g4 + 1] * il); w0.y = cvtpk(o0[4 * g4 + 2] * il, o0[4 * g4 + 3] * il);
            w1.x = cvtpk(o1[4 * g4] * il, o1[4 * g4 + 1] * il); w1.y = cvtpk(o1[4 * g4 + 2] * il, o1[4 * g4 + 3] * il);
            *(u32x2*)(op + 8 * g4) = w0; *(u32x2*)(op + 32 + 8 * g4) = w1; }
    }
}
}

namespace sm {
__device__ __forceinline__ float silu(float x) { return x / (1.f + __expf(-x)); }
__device__ __forceinline__ void mod_phase(LAS unsigned char* lds, const float* c, const float* c_ctx, const float* mod_w, const float* mod_b, float* MOD, int G, int bx, int tid) {
    LAS float* s = (LAS float*)lds;
    for (int i = tid; i < 5120; i += 512) { const int v = i >> 10, k = i & 1023; s[i] = silu(v < 4 ? c[v * 1024 + k] : c_ctx[k]); }
    __syncthreads();
    LAS float* red = s + 5120;
    for (int unit = bx; unit < 96; unit += G) {
        const int l = unit / 48, cb = unit % 48, cl = tid & 127, col = cb * 128 + cl, kq = tid >> 7, k0 = kq * 256;
        const float* W = mod_w + ((size_t)l * 1024 + k0) * 6144 + col;
        float a0 = 0.f, a1 = 0.f, a2 = 0.f, a3 = 0.f, a4 = 0.f;
#pragma unroll 16
        for (int k = 0; k < 256; ++k) { const float w = W[(size_t)k * 6144]; a0 += s[k0 + k] * w; a1 += s[1024 + k0 + k] * w; a2 += s[2048 + k0 + k] * w; a3 += s[3072 + k0 + k] * w; a4 += s[4096 + k0 + k] * w; }
        LAS float* rq = red + kq * 640 + cl; rq[0] = a0; rq[128] = a1; rq[256] = a2; rq[384] = a3; rq[512] = a4;
        __syncthreads();
        for (int i = tid; i < 640; i += 512) { const int v = i >> 7, cc = i & 127; const float r = ((red[i] + red[640 + i]) + (red[1280 + i] + red[1920 + i])) + mod_b[l * 6144 + cb * 128 + cc];
            MOD[((size_t)l * 5 + v) * 6144 + cb * 128 + cc] = r; }
        __syncthreads();
    }
}
__device__ __forceinline__ void norm_store(const float4 (&x)[4], float ss, const float* g, const float* mv, int sh_off, int sc_off, bf16_t* xn_row, int lane) {
    const float rs = rsqrtf(wave_sum(ss) * (1.f / D) + 1e-6f);
#pragma unroll
    for (int j = 0; j < 4; ++j) { const int c = (j * 64 + lane) * 4; const float4 gg = *(const float4*)(g + c), sh = *(const float4*)(mv + sh_off + c), sc = *(const float4*)(mv + sc_off + c);
        u32x2 o; o.x = pk2(x[j].x * rs * gg.x * (1.f + sc.x) + sh.x, x[j].y * rs * gg.y * (1.f + sc.y) + sh.y); o.y = pk2(x[j].z * rs * gg.z * (1.f + sc.z) + sh.z, x[j].w * rs * gg.w * (1.f + sc.w) + sh.w);
        *(u32x2*)(xn_row + c) = o; }
}
__device__ __forceinline__ void pro1_phase(const float* x, const float* ctx, const float* g, const float* MODl, float* H, bf16_t* XN, int r_first, int r_end, int r_step, int lane) {
    for (int r = r_first; r < r_end; r += r_step) { const int b = r / NPOS, pos = r % NPOS, v = pos < CTX ? 4 : b;
        const float* src = pos < CTX ? ctx + ((size_t)b * CTX + pos) * D : x + ((size_t)b * SEQ + (pos - CTX)) * D;
        float4 xv[4]; float ss = 0.f;
#pragma unroll
        for (int j = 0; j < 4; ++j) { const int c = (j * 64 + lane) * 4; xv[j] = *(const float4*)(src + c); ss += xv[j].x * xv[j].x + xv[j].y * xv[j].y + xv[j].z * xv[j].z + xv[j].w * xv[j].w; }
#pragma unroll
        for (int j = 0; j < 4; ++j) *(float4*)(H + (size_t)r * D + (j * 64 + lane) * 4) = xv[j];
        norm_store(xv, ss, g, MODl + (size_t)v * 6144, 0, 1024, XN + (size_t)r * D, lane); }
}
__device__ __forceinline__ void comb_phase(int l, float* H, const bf16_t* Y, const float* MODl, const float* g_next, const float* MODn, bf16_t* XN, const float* final_g, float* out, int gw, int NGW, int lane) {
    for (int r = gw; r < MROWS; r += NGW) { const int b = r / NPOS, pos = r % NPOS, v = pos < CTX ? 4 : b;
        if (l == 1 && pos < CTX) continue;
        const float* g2 = MODl + (size_t)v * 6144 + 5120;
        float4 xv[4]; float ss = 0.f;
#pragma unroll
        for (int j = 0; j < 4; ++j) { const int c = (j * 64 + lane) * 4; xv[j] = *(const float4*)(H + (size_t)r * D + c); float4 s = make_float4(0.f, 0.f, 0.f, 0.f);
#pragma unroll
            for (int k = 0; k < 4; ++k) { const u32x2 y = *(const u32x2*)(Y + ((size_t)r * 4 + k) * D + c); s.x += __uint_as_float(y.x << 16); s.y += __uint_as_float(y.x & 0xffff0000u); s.z += __uint_as_float(y.y << 16); s.w += __uint_as_float(y.y & 0xffff0000u); }
            const float4 gg = *(const float4*)(g2 + c); xv[j].x += gg.x * s.x; xv[j].y += gg.y * s.y; xv[j].z += gg.z * s.z; xv[j].w += gg.w * s.w;
            ss += xv[j].x * xv[j].x + xv[j].y * xv[j].y + xv[j].z * xv[j].z + xv[j].w * xv[j].w; }
        if (l == 0) {
#pragma unroll
            for (int j = 0; j < 4; ++j) *(float4*)(H + (size_t)r * D + (j * 64 + lane) * 4) = xv[j];
            norm_store(xv, ss, g_next, MODn + (size_t)v * 6144, 0, 1024, XN + (size_t)r * D, lane);
        } else { const float rs = rsqrtf(wave_sum(ss) * (1.f / D) + 1e-6f); float* op = out + ((size_t)b * SEQ + (pos - CTX)) * D;
#pragma unroll
            for (int j = 0; j < 4; ++j) { const int c = (j * 64 + lane) * 4; const float4 fg = *(const float4*)(final_g + c); float4 o; o.x = xv[j].x * rs * fg.x; o.y = xv[j].y * rs * fg.y; o.z = xv[j].z * rs * fg.z; o.w = xv[j].w * rs * fg.w; *(float4*)(op + c) = o; } }
    }
}
__device__ __forceinline__ void route_phase(LAS unsigned char* lds, int l, const float* H, const float* g, const float* MODl, const bf16_t* RWH, const bf16_t* RWL, const float* rb, bf16_t* XN, int* CNT, int* LIST, float* GATE,
                                            int G, int bx, int tid) {
    const int lane = tid & 63, wave = __builtin_amdgcn_readfirstlane(tid >> 6), fr = lane & 15, fq = lane >> 4;
    constexpr int FP = 1032;
    LAS bf16_t* FH = (LAS bf16_t*)lds; LAS bf16_t* FL = FH + 16 * FP;
    LAS float* PART = (LAS float*)(lds + 66048);
    LAS int* LCNT = (LAS int*)(lds + 66048 + 16384);
    LAS int* LBASE = LCNT + 64; LAS int* LENT = LCNT + 128;
    if (tid < 64) LCNT[tid] = 0;
    bf16x8 wh[2][4], wl[2][4];
#pragma unroll
    for (int nt = 0; nt < 2; ++nt)
#pragma unroll
        for (int ks = 0; ks < 4; ++ks) { const size_t o = ((size_t)l * NE + 16 * nt + fr) * D + 128 * wave + 32 * ks + 8 * fq; wh[nt][ks] = *(const bf16x8*)(RWH + o); wl[nt][ks] = *(const bf16x8*)(RWL + o); }
    const float bias = rb[lane & 31];
    __syncthreads();
    const int nb = l == 1 ? (MROWS - NB_ * CTX) / 16 : MROWS / 16;
    LAS float* LG = (LAS float*)(lds + 90112);
    LAS float* TOP = (LAS float*)(lds + 92160);
    float4 xv[2][4];
#define RT_ROW(q_) ((l == 1) ? ((q_) / SEQ) * NPOS + CTX + ((q_) % SEQ) : (q_))
#define RT_LOAD(bi_) do { _Pragma("unroll") for (int rr = 0; rr < 2; ++rr) { const int r_ = RT_ROW((bi_) * 16 + 2 * wave + rr); _Pragma("unroll") for (int j = 0; j < 4; ++j) xv[rr][j] = *(const float4*)(H + (size_t)r_ * D + (j * 64 + lane) * 4); } } while (0)
    if (bx < nb) RT_LOAD(bx);
    for (int bi = bx; bi < nb; bi += G) {
#pragma unroll
        for (int rr = 0; rr < 2; ++rr) { const int r = RT_ROW(bi * 16 + 2 * wave + rr);
            const int b = r / NPOS, pos = r % NPOS, v = pos < CTX ? 4 : b; const float* mv = MODl + (size_t)v * 6144;
            float ss = 0.f;
#pragma unroll
            for (int j = 0; j < 4; ++j) ss += xv[rr][j].x * xv[rr][j].x + xv[rr][j].y * xv[rr][j].y + xv[rr][j].z * xv[rr][j].z + xv[rr][j].w * xv[rr][j].w;
            const float rs = rsqrtf(wave_sum(ss) * (1.f / D) + 1e-6f);
#pragma unroll
            for (int j = 0; j < 4; ++j) { const int c = (j * 64 + lane) * 4; const float4 gg = *(const float4*)(g + c), sh = *(const float4*)(mv + 3072 + c), sc = *(const float4*)(mv + 4096 + c);
                float f[4]; f[0] = xv[rr][j].x * rs * gg.x * (1.f + sc.x) + sh.x; f[1] = xv[rr][j].y * rs * gg.y * (1.f + sc.y) + sh.y; f[2] = xv[rr][j].z * rs * gg.z * (1.f + sc.z) + sh.z; f[3] = xv[rr][j].w * rs * gg.w * (1.f + sc.w) + sh.w;
                u32x2 oh, ol; oh.x = pk2(f[0], f[1]); oh.y = pk2(f[2], f[3]);
                ol.x = pk2(f[0] - __uint_as_float(oh.x << 16), f[1] - __uint_as_float(oh.x & 0xffff0000u)); ol.y = pk2(f[2] - __uint_as_float(oh.y << 16), f[3] - __uint_as_float(oh.y & 0xffff0000u));
                *(u32x2*)(XN + (size_t)r * D + c) = oh; *(LAS u32x2*)(FH + (2 * wave + rr) * FP + c) = oh; *(LAS u32x2*)(FL + (2 * wave + rr) * FP + c) = ol; } }
        if (bi + G < nb) RT_LOAD(bi + G);
        __syncthreads();
        { f32x4 acc[2] = {(f32x4){0.f, 0.f, 0.f, 0.f}, (f32x4){0.f, 0.f, 0.f, 0.f}};
#pragma unroll
          for (int ks = 0; ks < 4; ++ks) { const bf16x8 ah = *(const LAS bf16x8*)(FH + fr * FP + 128 * wave + 32 * ks + 8 * fq), al = *(const LAS bf16x8*)(FL + fr * FP + 128 * wave + 32 * ks + 8 * fq);
#pragma unroll
              for (int nt = 0; nt < 2; ++nt) { acc[nt] = __builtin_amdgcn_mfma_f32_16x16x32_bf16(ah, wh[nt][ks], acc[nt], 0, 0, 0); acc[nt] = __builtin_amdgcn_mfma_f32_16x16x32_bf16(ah, wl[nt][ks], acc[nt], 0, 0, 0);
                  acc[nt] = __builtin_amdgcn_mfma_f32_16x16x32_bf16(al, wh[nt][ks], acc[nt], 0, 0, 0); } }
#pragma unroll
          for (int nt = 0; nt < 2; ++nt)
#pragma unroll
              for (int i = 0; i < 4; ++i) PART[(wave * 16 + 4 * fq + i) * 32 + 16 * nt + fr] = acc[nt][i]; }
        __syncthreads();
        { const int row = 2 * wave + (lane >> 5), e = lane & 31; const int r = RT_ROW(bi * 16 + row);
          float lg = bias;
#pragma unroll
          for (int kw = 0; kw < 8; ++kw) lg += PART[(kw * 16 + row) * 32 + e];
          LG[row * 32 + e] = lg;
          int rank = 0;
#pragma unroll
          for (int j4 = 0; j4 < 8; ++j4) { const f32x4 o = *(const LAS f32x4*)(LG + row * 32 + 4 * j4);
#pragma unroll
              for (int i = 0; i < 4; ++i) { const int j = 4 * j4 + i; rank += (o[i] > lg || (o[i] == lg && j < e)) ? 1 : 0; } }
          if (rank < 4) { TOP[(row * 4 + rank) * 2] = lg; TOP[(row * 4 + rank) * 2 + 1] = __int_as_float(e); }
          if (e == 0) { float tv[4]; int ti[4];
#pragma unroll
              for (int k = 0; k < 4; ++k) { tv[k] = TOP[(row * 4 + k) * 2]; ti[k] = __float_as_int(TOP[(row * 4 + k) * 2 + 1]); }
              float ex[4], sum = 0.f;
#pragma unroll
              for (int k = 0; k < 4; ++k) { ex[k] = __expf(tv[k] - tv[0]); sum += ex[k]; }
              const float isum = 1.f / sum;
#pragma unroll
              for (int k = 0; k < 4; ++k) { const int asg = r * 4 + k; GATE[asg] = ex[k] * isum; const int rk = __hip_atomic_fetch_add(&LCNT[ti[k]], 1, __ATOMIC_RELAXED, __HIP_MEMORY_SCOPE_WORKGROUP); const int slot = __hip_atomic_fetch_add(&LCNT[32], 1, __ATOMIC_RELAXED, __HIP_MEMORY_SCOPE_WORKGROUP);
                  LENT[slot * 2] = asg; LENT[slot * 2 + 1] = (ti[k] << 16) | rk; } } }
        __syncthreads();
    }
#undef RT_ROW
#undef RT_LOAD
    if (tid < 32) LBASE[tid] = LCNT[tid] > 0 ? atomicAdd(&CNT[tid * L::CNT_STRIDE], LCNT[tid]) : 0;
    __syncthreads();
    for (int i = tid; i < LCNT[32]; i += 512) { const int asg = LENT[i * 2], er = LENT[i * 2 + 1], ee = er >> 16, rank = er & 0xffff; LIST[(size_t)ee * LCAP + LBASE[ee] + rank] = asg; }
    __syncthreads();
}
__device__ __forceinline__ void smallw_phase(const float* w_uq, const float* qg, const float* w_ukv, const float* kvg, const float* w_a, const float* w_i, bf16_t* WUQT, bf16_t* WUKVT, bf16_t* WAT, bf16_t* WIT,
                                             float* TABC, float* TABS, const float* lam, float* SPT, const float* rw, bf16_t* RWHp, bf16_t* RWLp, int gt, int NGT) {
    for (int i = gt; i < 2 * 384 * 256; i += NGT) { const int l = i / (384 * 256), q = i % (384 * 256), n = q >> 8, k = q & 255; WUQT[i] = f2bf(qg[l * 256 + k] * w_uq[((size_t)l * 256 + k) * 384 + n]); }
    for (int i = gt; i < 2 * 512 * 128; i += NGT) { const int l = i / (512 * 128), q = i % (512 * 128), n = q >> 7, k = q & 127; WUKVT[i] = f2bf(kvg[l * 128 + k] * w_ukv[((size_t)l * 128 + k) * 512 + n]); }
    for (int i = gt; i < 16 * 4096; i += NGT) { const int m = i >> 12, q = i & 4095, e = q >> 6, d = q & 63; WAT[i] = f2bf(w_a[(size_t)m * 4096 + d * 64 + e]); WIT[i] = f2bf(w_i[(size_t)m * 4096 + d * 64 + e]); }
    for (int i = gt; i < 4096; i += NGT) { float s, c; sincospif((float)i / 2048.f, &s, &c); TABC[i] = c; TABS[i] = s; }
    for (int i = gt; i < 1024; i += NGT) SPT[i] = log1pf(__expf(-lam[i]));
    for (int i = gt; i < 2 * NE * D; i += NGT) { const int l = i / (NE * D), q = i % (NE * D), e = q >> 10, k = q & 1023; const float w = rw[((size_t)l * D + k) * NE + e]; const bf16_t h = f2bf(w); RWHp[i] = h; RWLp[i] = f2bf(w - bf2f(h)); }
}
}

namespace prep {
constexpr int O_KR = 0, O_CS = 8192, O_RS = 16384, O_CQ = 16896  , O_KS = 67072, O_CKV = 100864;
constexpr int CQP = 264, CKP = 136, QSP = 392, KSP = 264;
constexpr float C2 = 0.10206207261596577f * 1.4426950408889634f;
__device__ __forceinline__ void qkv_units(LAS unsigned char* lds, int l, const bf16_t* P, const bf16_t* WUQT, const bf16_t* WUKVT, const float* scw, const float* scb,
                                          bf16_t* QL, bf16_t* QC, bf16_t* KB, bf16_t* VTG, bf16_t* MIX, int u0, int u1, int ustep) {
    LAS float* KRo = (LAS float*)(lds + O_KR); LAS float* CS = (LAS float*)(lds + O_CS); LAS float* RS = (LAS float*)(lds + O_RS);
    LAS bf16_t* CQ = (LAS bf16_t*)(lds + O_CQ); LAS bf16_t* CK = (LAS bf16_t*)(lds + O_CKV); LAS bf16_t* KS = (LAS bf16_t*)(lds + O_KS); LAS bf16_t* QS = (LAS bf16_t*)(lds + O_CQ);
    for (int unit = u0; unit < u1; unit += ustep) {
        int tid_l = threadIdx.x; asm volatile("" : "+v"(tid_l));
        const int tid = tid_l, lane = tid & 63, w = __builtin_amdgcn_readfirstlane(tid >> 6), fr = lane & 15, fq = lane >> 4;
        const int b = unit / 68, chunk = unit % 68, pos0 = 64 * chunk; const bool ctxt = chunk < 4; const size_t r0 = (size_t)b * NPOS + pos0;
#pragma unroll
        for (int i = 0; i < 4; ++i) { const int q = tid + 512 * i, row = q >> 5, ch = q & 31; *(LAS u32x4*)((LAS unsigned char*)CQ + row * (CQP * 2) + ch * 16) = *(const u32x4*)(P + (r0 + row) * PP + C_CQ + ch * 8); }
#pragma unroll
        for (int i = 0; i < 2; ++i) { const int q = tid + 512 * i, row = q >> 4, ch = q & 15; *(LAS u32x4*)((LAS unsigned char*)CK + row * (CKP * 2) + ch * 16) = *(const u32x4*)(P + (r0 + row) * PP + C_CKV + ch * 8); }
        __syncthreads();
        { const int row = tid >> 3, j = tid & 7; float sq = 0.f, sk = 0.f;
#pragma unroll
          for (int i = 0; i < 4; ++i) { const u32x4 v = *(const LAS u32x4*)((const LAS unsigned char*)CQ + row * (CQP * 2) + j * 64 + i * 16);
#pragma unroll
              for (int e = 0; e < 4; ++e) { const float a = __uint_as_float(v[e] << 16), c = __uint_as_float(v[e] & 0xffff0000u); sq += a * a + c * c; } }
#pragma unroll
          for (int i = 0; i < 2; ++i) { const u32x4 v = *(const LAS u32x4*)((const LAS unsigned char*)CK + row * (CKP * 2) + j * 32 + i * 16);
#pragma unroll
              for (int e = 0; e < 4; ++e) { const float a = __uint_as_float(v[e] << 16), c = __uint_as_float(v[e] & 0xffff0000u); sk += a * a + c * c; } }
          sq += __shfl_xor(sq, 1); sq += __shfl_xor(sq, 2); sq += __shfl_xor(sq, 4); sk += __shfl_xor(sk, 1); sk += __shfl_xor(sk, 2); sk += __shfl_xor(sk, 4);
          if (j == 0) { RS[row * 2] = rsqrtf(sq * (1.f / 256.f) + 1e-6f); RS[row * 2 + 1] = rsqrtf(sk * (1.f / 128.f) + 1e-6f); }
          float cr = 1.f, sr = 0.f, cc = 1.f, sc = 0.f;
          if (!ctxt) { const int t = pos0 - CTX + row; const float inv = __expf(-9.210340371976184f * (float)j * 0.125f); float xa = (float)(t >> 6) * inv * 0.15915494309189535f; xa -= rintf(xa); sr = __sinf(xa * 6.283185307179586f); cr = __cosf(xa * 6.283185307179586f); float xb = (float)(t & 63) * inv * 0.15915494309189535f; xb -= rintf(xb); sc = __sinf(xb * 6.283185307179586f); cc = __cosf(xb * 6.283185307179586f); }
          CS[(row * 16 + j) * 2] = cr; CS[(row * 16 + j) * 2 + 1] = sr; CS[(row * 16 + 8 + j) * 2] = cc; CS[(row * 16 + 8 + j) * 2 + 1] = sc;
          const bf16_t* kp = P + (r0 + row) * PP + C_KR; const float z0 = bf2f(kp[j]), z1 = bf2f(kp[8 + j]), z2 = bf2f(kp[16 + j]), z3 = bf2f(kp[24 + j]);
          KRo[row * 32 + j] = z0 * cr - z1 * sr; KRo[row * 32 + 8 + j] = z0 * sr + z1 * cr; KRo[row * 32 + 16 + j] = z2 * cc - z3 * sc; KRo[row * 32 + 24 + j] = z2 * sc + z3 * cc; }
        __builtin_amdgcn_sched_barrier(0);
        { f32x4 qa[4][3];
#pragma unroll
          for (int mt = 0; mt < 4; ++mt)
#pragma unroll
              for (int n = 0; n < 3; ++n) qa[mt][n] = (f32x4){0.f, 0.f, 0.f, 0.f};
          const bf16_t* wq = WUQT + ((size_t)l * 384 + 48 * w + fr) * 256 + 8 * fq;
#pragma unroll
          for (int ks = 0; ks < 8; ++ks) { bf16x8 a[4], bb[3];
#pragma unroll
              for (int mt = 0; mt < 4; ++mt) a[mt] = *(const LAS bf16x8*)(CQ + (16 * mt + fr) * CQP + 32 * ks + 8 * fq);
#pragma unroll
              for (int n = 0; n < 3; ++n) bb[n] = *(const bf16x8*)(wq + (size_t)(16 * n) * 256 + 32 * ks);
#pragma unroll
              for (int mt = 0; mt < 4; ++mt)
#pragma unroll
                  for (int n = 0; n < 3; ++n) qa[mt][n] = __builtin_amdgcn_mfma_f32_16x16x32_bf16(a[mt], bb[n], qa[mt][n], 0, 0, 0); }
          __syncthreads();
#pragma unroll
          for (int n = 0; n < 3; ++n) { const int nt = 3 * w + n, m6 = nt % 6, col = 16 * nt + fr;
#pragma unroll
              for (int mt = 0; mt < 4; ++mt)
#pragma unroll
                  for (int i = 0; i < 4; ++i) { const int row = 16 * mt + 4 * fq + i; float v = qa[mt][n][i] * RS[row * 2];
                      if (m6 >= 4) { const float pv = __shfl_xor(v, 8); const int ci = (row * 16 + (m6 == 5 ? 8 : 0) + (fr & 7)) * 2; const float c = CS[ci], s = CS[ci + 1]; v = (fr < 8) ? v * c - pv * s : pv * s + v * c; }
                      QS[row * QSP + col] = f2bf(v * C2); } } }
        __builtin_amdgcn_sched_barrier(0);
        { f32x4 ka[4][4];
#pragma unroll
          for (int mt = 0; mt < 4; ++mt)
#pragma unroll
              for (int n = 0; n < 4; ++n) ka[mt][n] = (f32x4){0.f, 0.f, 0.f, 0.f};
          const bf16_t* wk = WUKVT + ((size_t)l * 512 + 64 * w + fr) * 128 + 8 * fq;
#pragma unroll
          for (int ks = 0; ks < 4; ++ks) { bf16x8 a[4], bb[4];
#pragma unroll
              for (int mt = 0; mt < 4; ++mt) a[mt] = *(const LAS bf16x8*)(CK + (16 * mt + fr) * CKP + 32 * ks + 8 * fq);
#pragma unroll
              for (int n = 0; n < 4; ++n) bb[n] = *(const bf16x8*)(wk + (size_t)(16 * n) * 128 + 32 * ks);
#pragma unroll
              for (int mt = 0; mt < 4; ++mt)
#pragma unroll
                  for (int n = 0; n < 4; ++n) ka[mt][n] = __builtin_amdgcn_mfma_f32_16x16x32_bf16(a[mt], bb[n], ka[mt][n], 0, 0, 0); }
          const int head = w >> 1;
          if ((w & 1) == 0) {
#pragma unroll
              for (int n = 0; n < 4; ++n)
#pragma unroll
                  for (int mt = 0; mt < 4; ++mt)
#pragma unroll
                      for (int i = 0; i < 4; ++i) { const int row = 16 * mt + 4 * fq + i; KS[row * KSP + head * 64 + 16 * n + fr] = f2bf(ka[mt][n][i] * RS[row * 2 + 1]); }
          } else {
#pragma unroll
              for (int n = 0; n < 4; ++n)
#pragma unroll
                  for (int mt = 0; mt < 4; ++mt) { const int rb = 16 * mt + 4 * fq; u32x2 o; o.x = pk2(ka[mt][n][0] * RS[rb * 2 + 1], ka[mt][n][1] * RS[rb * 2 + 3]); o.y = pk2(ka[mt][n][2] * RS[rb * 2 + 5], ka[mt][n][3] * RS[rb * 2 + 7]);
                      *(u32x2*)(VTG + ((size_t)(b * 4 + head) * 64 + 16 * n + fr) * NPOS + pos0 + rb) = o; } } }
        __syncthreads();
#pragma unroll
        for (int i = 0; i < 6; ++i) { const int q = tid + 512 * i, row = q / 48, rem = q % 48, head = rem / 12, ch = rem % 12, pos = pos0 + row;
            const u32x4 qv = *(const LAS u32x4*)((const LAS unsigned char*)QS + row * (QSP * 2) + (head * 96 + ch * 8) * 2);
            if (!ctxt) *(u32x4*)(QL + ((size_t)(b * 4 + head) * SEQ + (pos - CTX)) * 96 + ch * 8) = qv; else if (l == 0) *(u32x4*)(QC + ((size_t)(b * 4 + head) * CTX + pos) * 96 + ch * 8) = qv;
            u32x4 kv;
            if (ch < 8) kv = *(const LAS u32x4*)((const LAS unsigned char*)KS + row * (KSP * 2) + (head * 64 + ch * 8) * 2);
            else { const LAS float* kr = KRo + row * 32 + (ch - 8) * 8; kv.x = pk2(kr[0], kr[1]); kv.y = pk2(kr[2], kr[3]); kv.z = pk2(kr[4], kr[5]); kv.w = pk2(kr[6], kr[7]); }
            *(u32x4*)(KB + ((size_t)(b * 4 + head) * NPOS + pos) * 96 + ch * 8) = kv; }
        if (!(ctxt && l == 1)) { const int lo = ctxt ? 0 : CTX, hi = ctxt ? CTX : NPOS;
#pragma unroll
            for (int i = 0; i < 4; ++i) { const int q = tid + 512 * i, row = q >> 5, ch = q & 31, pos = pos0 + row; float acc[8];
#pragma unroll
                for (int e = 0; e < 8; ++e) acc[e] = scb[ch * 8 + e];
#pragma unroll
                for (int k = 0; k < 3; ++k) { const int p = pos - 1 + k; if (p >= lo && p < hi) { const bf16_t* pr = P + ((size_t)b * NPOS + p) * PP; const u32x4 sx = *(const u32x4*)(pr + C_SX + ch * 8), sc = *(const u32x4*)(pr + C_SC + ch * 8);
#pragma unroll
                        for (int e = 0; e < 4; ++e) { const float w0 = scw[k * 256 + ch * 8 + 2 * e], w1 = scw[k * 256 + ch * 8 + 2 * e + 1];
                            acc[2 * e] += w0 * (__uint_as_float(sx[e] << 16) * __uint_as_float(sc[e] << 16)); acc[2 * e + 1] += w1 * (__uint_as_float(sx[e] & 0xffff0000u) * __uint_as_float(sc[e] & 0xffff0000u)); } } }
                const u32x4 sb = *(const u32x4*)(P + (r0 + row) * PP + C_SB + ch * 8); u32x4 o;
#pragma unroll
                for (int e = 0; e < 4; ++e) o[e] = pk2(__uint_as_float(sb[e] << 16) * acc[2 * e], __uint_as_float(sb[e] & 0xffff0000u) * acc[2 * e + 1]);
                *(u32x4*)(MIX + (r0 + row) * D + 768 + ch * 8) = o; } }
        __syncthreads();
    }
}
}

namespace lru {
constexpr int XP = 264, O_X = 0, O_NA = 33792, O_BB = 66560;
__device__ __forceinline__ float sigm(float x) { return __builtin_amdgcn_rcpf(1.f + __expf(-x)); }
__device__ __forceinline__ void chunk_units(LAS unsigned char* lds, int l, const bf16_t* P, const float* conv_w, const float* conv_b, const bf16_t* WAT, const bf16_t* WIT, const float* b_a, const float* b_i, const float* SPT,
                                            bf16_t* HL, bf16_t* AC, float* SUM, int u0, int u1, int ustep, int knob) {
    LAS bf16_t* X = (LAS bf16_t*)(lds + O_X); LAS bf16_t* NA = (LAS bf16_t*)(lds + O_NA); LAS bf16_t* BB = (LAS bf16_t*)(lds + O_BB);
    for (int unit = u0; unit < u1; unit += ustep) {
        int tid_l = threadIdx.x; asm volatile("" : "+v"(tid_l));
        const int tid = tid_l, lane = tid & 63, w = __builtin_amdgcn_readfirstlane(tid >> 6), fr = lane & 15, fq = lane >> 4;
        const int dir = unit & 1, bc = unit >> 1, b = bc / 68, chunk = bc % 68, pos0 = 64 * chunk; const int lo = chunk < 4 ? 0 : CTX, hi = chunk < 4 ? CTX : NPOS, left = dir ? 1 : 2;
        const size_t r0 = (size_t)b * NPOS + pos0; const int pd = (l * 2 + dir) * 256;
        if (!(knob & 1)) { const int cg = tid & 31, ts = tid >> 5, c0 = cg * 8; float wv[4][8], cbv[8];
#pragma unroll
          for (int e = 0; e < 8; ++e) { cbv[e] = conv_b[pd + c0 + e];
#pragma unroll
              for (int k = 0; k < 4; ++k) wv[k][e] = conv_w[(size_t)pd * 4 + k * 256 + c0 + e]; }
          const bf16_t* pc = P + (size_t)b * NPOS * PP + C_LX + c0; const int pb = pos0 + 4 * ts - left;
          u32x4 u[7];
#pragma unroll
          for (int i = 0; i < 7; ++i) { const int p = pb + i; const int pcl = p < lo ? lo : (p >= hi ? hi - 1 : p); u[i] = *(const u32x4*)(pc + (size_t)pcl * PP); if (p < lo || p >= hi) u[i] = (u32x4){0u, 0u, 0u, 0u}; }
#pragma unroll
          for (int i = 0; i < 4; ++i) { u32x4 o;
#pragma unroll
              for (int e2 = 0; e2 < 4; ++e2) { float lo_ = cbv[2 * e2], hi_ = cbv[2 * e2 + 1];
#pragma unroll
                  for (int k = 0; k < 4; ++k) { const unsigned d = u[i + k][e2]; lo_ += wv[k][2 * e2] * __uint_as_float(d << 16); hi_ += wv[k][2 * e2 + 1] * __uint_as_float(d & 0xffff0000u); }
                  o[e2] = pk2(lo_, hi_); }
              *(LAS u32x4*)(X + (4 * ts + i) * XP + c0) = o; } }
        __syncthreads();
        if (!(knob & 2)) { const int h = w >> 1, mh = w & 1;
          f32x4 ra[2][4], ri[2][4];
#pragma unroll
          for (int m = 0; m < 2; ++m)
#pragma unroll
              for (int n = 0; n < 4; ++n) { ra[m][n] = (f32x4){0.f, 0.f, 0.f, 0.f}; ri[m][n] = (f32x4){0.f, 0.f, 0.f, 0.f}; }
          const bf16_t* wa = WAT + ((size_t)((l * 2 + dir) * 4 + h) * 64 + fr) * 64 + 8 * fq; const bf16_t* wi = WIT + ((size_t)((l * 2 + dir) * 4 + h) * 64 + fr) * 64 + 8 * fq;
#pragma unroll
          for (int ks = 0; ks < 2; ++ks) { bf16x8 a[2], ba[4], bi[4];
#pragma unroll
              for (int m = 0; m < 2; ++m) a[m] = *(const LAS bf16x8*)(X + (16 * (2 * mh + m) + fr) * XP + 64 * h + 32 * ks + 8 * fq);
#pragma unroll
              for (int n = 0; n < 4; ++n) { ba[n] = *(const bf16x8*)(wa + (size_t)(16 * n) * 64 + 32 * ks); bi[n] = *(const bf16x8*)(wi + (size_t)(16 * n) * 64 + 32 * ks); }
#pragma unroll
              for (int m = 0; m < 2; ++m)
#pragma unroll
                  for (int n = 0; n < 4; ++n) { ra[m][n] = __builtin_amdgcn_mfma_f32_16x16x32_bf16(a[m], ba[n], ra[m][n], 0, 0, 0); ri[m][n] = __builtin_amdgcn_mfma_f32_16x16x32_bf16(a[m], bi[n], ri[m][n], 0, 0, 0); } }
#pragma unroll
          for (int n = 0; n < 4; ++n) { const int c = 64 * h + 16 * n + fr; const float bav = b_a[pd + c], biv = b_i[pd + c], sp8 = 8.f * SPT[pd + c];
#pragma unroll
              for (int m = 0; m < 2; ++m)
#pragma unroll
                  for (int i = 0; i < 4; ++i) { const int t = 16 * (2 * mh + m) + 4 * fq + i; const float r = sigm(ra[m][n][i] + bav), ig = sigm(ri[m][n][i] + biv);
                      const float x = r * sp8; const float na = x < 0.03125f ? x * (1.f - 0.5f * x * (1.f - 0.33333334f * x * (1.f - 0.25f * x))) : 1.f - __expf(-x); const float xv = bf2f(X[t * XP + c]);
                      NA[t * 256 + c] = f2bf(na); BB[t * 256 + c] = f2bf(__builtin_amdgcn_sqrtf(fmaxf(na * (2.f - na), 0.f)) * (ig * xv)); } } }
        __syncthreads();
        if (tid < 256 && !(knob & 4)) { const int c = tid; float hst = 0.f, A = 1.f;
            if (dir == 0) {
#pragma unroll 8
                for (int t = 0; t < 64; ++t) { const float a = 1.f - bf2f(NA[t * 256 + c]); hst = a * hst + bf2f(BB[t * 256 + c]); A *= a; BB[t * 256 + c] = f2bf(hst); NA[t * 256 + c] = f2bf(A); }
            } else {
#pragma unroll 8
                for (int t = 63; t >= 0; --t) { const float a = 1.f - bf2f(NA[t * 256 + c]); hst = a * hst + bf2f(BB[t * 256 + c]); A *= a; BB[t * 256 + c] = f2bf(hst); NA[t * 256 + c] = f2bf(A); }
            }
            float* sm = SUM + ((size_t)(dir * 4 + b) * 68 + chunk) * 512; sm[c] = A; sm[256 + c] = hst; }
        __syncthreads();
        if (!(knob & 4)) {
#pragma unroll
            for (int i = 0; i < 4; ++i) { const int q = tid + 512 * i, t = q >> 5, ch = q & 31; const size_t go = ((size_t)dir * MROWS + r0 + t) * 256 + ch * 8;
                *(u32x4*)(AC + go) = *(const LAS u32x4*)(NA + t * 256 + ch * 8); *(u32x4*)(HL + go) = *(const LAS u32x4*)(BB + t * 256 + ch * 8); } }
        __syncthreads();
    }
}
__device__ __forceinline__ void fixup_units(LAS unsigned char* lds, int l, const bf16_t* P, const bf16_t* HL, const bf16_t* AC, const float* SUM, bf16_t* MIX, int G, int bx) {
    LAS float* CAR = (LAS float*)lds;
    for (int unit = bx; unit < 272; unit += G) {
        int tid_l = threadIdx.x; asm volatile("" : "+v"(tid_l));
        const int tid = tid_l;
        const int b = unit / 68, chunk = unit % 68; if (l == 1 && chunk < 4) continue;
        { const int dir = tid >> 8, c = tid & 255; const float* sp = SUM + ((size_t)(dir * 4 + b) * 68) * 512 + c;
          const int n_pre = dir == 0 ? chunk : (chunk < 4 ? 3 - chunk : 4 + (67 - chunk));
          float cy = 0.f;
          for (int j0 = 0; j0 < n_pre; j0 += 16) { float av[16], hv[16];
#pragma unroll
              for (int u = 0; u < 16; ++u) { const int n = j0 + u < n_pre ? j0 + u : n_pre - 1; const int j = dir == 0 ? n : (n < 4 ? 3 - n : 71 - n); av[u] = sp[(size_t)j * 512]; hv[u] = sp[(size_t)j * 512 + 256]; }
#pragma unroll
              for (int u = 0; u < 16; ++u) cy = (j0 + u < n_pre) ? hv[u] + av[u] * cy : cy; }
          CAR[tid] = cy; }
        __syncthreads();
        { const int cg = tid & 31, ts = tid >> 5, c0 = cg * 8; float cf[8], cb[8];
#pragma unroll
          for (int e = 0; e < 8; ++e) { cf[e] = CAR[c0 + e]; cb[e] = CAR[256 + c0 + e]; }
          const size_t r0 = (size_t)b * NPOS + 64 * chunk + 4 * ts;
          u32x4 hf[4], af[4], hb[4], ab[4], gt[4];
#pragma unroll
          for (int i = 0; i < 4; ++i) { const size_t r = r0 + i; hf[i] = *(const u32x4*)(HL + r * 256 + c0); af[i] = *(const u32x4*)(AC + r * 256 + c0); hb[i] = *(const u32x4*)(HL + ((size_t)MROWS + r) * 256 + c0); ab[i] = *(const u32x4*)(AC + ((size_t)MROWS + r) * 256 + c0);
              gt[i] = *(const u32x4*)(P + r * PP + C_LG + c0); }
#pragma unroll
          for (int i = 0; i < 4; ++i) { u32x4 o;
#pragma unroll
              for (int e2 = 0; e2 < 4; ++e2) { float res[2];
#pragma unroll
                  for (int hh = 0; hh < 2; ++hh) { const int e = 2 * e2 + hh;
                      const float vhf = hh ? __uint_as_float(hf[i][e2] & 0xffff0000u) : __uint_as_float(hf[i][e2] << 16), vaf = hh ? __uint_as_float(af[i][e2] & 0xffff0000u) : __uint_as_float(af[i][e2] << 16);
                      const float vhb = hh ? __uint_as_float(hb[i][e2] & 0xffff0000u) : __uint_as_float(hb[i][e2] << 16), vab = hh ? __uint_as_float(ab[i][e2] & 0xffff0000u) : __uint_as_float(ab[i][e2] << 16);
                      const float x = hh ? __uint_as_float(gt[i][e2] & 0xffff0000u) : __uint_as_float(gt[i][e2] << 16);
                      const float hsum = (vhf + vaf * cf[e]) + (vhb + vab * cb[e]);
                      const float u = 0.7978845608028654f * (x + 0.044715f * x * x * x); const float th_ = 1.f - 2.f * __builtin_amdgcn_rcpf(1.f + __expf(2.f * u));
                      res[hh] = 0.5f * x * (1.f + th_) * hsum; }
                  o[e2] = pk2(res[0], res[1]); }
              *(u32x4*)(MIX + (r0 + i) * D + 256 + c0) = o; } }
        __syncthreads();
    }
}
}

namespace fft {
__device__ __forceinline__ void ctx_a(LAS unsigned char* lds, const bf16_t* P, const float* TABC, const float* TABS, bf16_t* XCT, int G, int bx) {
    LAS bf16_t* U = (LAS bf16_t*)(lds + O_U); LAS bf16_t* X = (LAS bf16_t*)(lds + O_X);
    for (int unit = bx; unit < 16; unit += G) {
        int tid_l = threadIdx.x; asm volatile("" : "+v"(tid_l));
        const int tid = tid_l, lane = tid & 63, w = __builtin_amdgcn_readfirstlane(tid >> 6), fr = lane & 15, fq = lane >> 4;
        build_tables(lds, TABC, TABS, tid);
        const LAS bf16_t* Tc = (const LAS bf16_t*)(lds + O_TC); const LAS bf16_t* Ts = (const LAS bf16_t*)(lds + O_TS);
        const int b = unit >> 2, q = unit & 3;
#pragma unroll
        for (int i = 0; i < 4; ++i) { const int qq = tid + 512 * i, t1 = qq >> 5, ch = qq & 31;
            *(LAS u32x4*)((LAS unsigned char*)U + t1 * (UP * 2) + ch * 16) = *(const u32x4*)(P + ((size_t)b * NPOS + 64 * q + t1) * PP + ch * 8); }
        __syncthreads();
        { const int g = w >> 1, part = w & 1; const LAS bf16_t* T = part ? Ts : Tc;
          f32x4 acc[4][4];
#pragma unroll
          for (int mt = 0; mt < 4; ++mt)
#pragma unroll
              for (int nt = 0; nt < 4; ++nt) acc[mt][nt] = (f32x4){0.f, 0.f, 0.f, 0.f};
#pragma unroll
          for (int ks = 0; ks < 2; ++ks) { bf16x8 a[4], bb[4];
#pragma unroll
              for (int mt = 0; mt < 4; ++mt) a[mt] = *(const LAS bf16x8*)(U + (16 * mt + fr) * UP + g * 64 + 32 * ks + 8 * fq);
#pragma unroll
              for (int nt = 0; nt < 4; ++nt) bb[nt] = *(const LAS bf16x8*)(T + (16 * nt + fr) * TP + 32 * ks + 8 * fq);
#pragma unroll
              for (int mt = 0; mt < 4; ++mt)
#pragma unroll
                  for (int nt = 0; nt < 4; ++nt) acc[mt][nt] = __builtin_amdgcn_mfma_f32_16x16x32_bf16(a[mt], bb[nt], acc[mt][nt], 0, 0, 0); }
          const float sg = part ? -1.f : 1.f;
#pragma unroll
          for (int mt = 0; mt < 4; ++mt)
#pragma unroll
              for (int nt = 0; nt < 4; ++nt) { const f32x4 v = acc[mt][nt] * sg; u32x2 o; o.x = pk2(v[0], v[1]); o.y = pk2(v[2], v[3]);
                  *(LAS u32x2*)(X + (part * 256 + g * 64 + 16 * nt + fr) * TP + 16 * mt + 4 * fq) = o; } }
        __syncthreads();
#pragma unroll
        for (int i = 0; i < 8; ++i) { const int qq = tid + 512 * i, row = qq >> 3, c8 = qq & 7;
            *(u32x4*)(XCT + (((size_t)b * 4 + q) * 512 + row) * 64 + c8 * 8) = *(const LAS u32x4*)((const LAS unsigned char*)X + row * (TP * 2) + c8 * 16); }
        __syncthreads();
    }
}
__device__ __forceinline__ void ctx_b(LAS unsigned char* lds, const bf16_t* XCT, const float* TABC, const float* TABS, bf16_t* MIX, int G, int bx) {
    LAS bf16_t* Tc = (LAS bf16_t*)(lds + O_TC); LAS bf16_t* Ts = (LAS bf16_t*)(lds + O_TS);
    LAS bf16_t* Ys = (LAS bf16_t*)(lds + O_U); LAS bf16_t* ZT = (LAS bf16_t*)(lds + O_X);
    for (int unit = bx; unit < 16; unit += G) {
        int tid_l = threadIdx.x; asm volatile("" : "+v"(tid_l));
        const int tid = tid_l, lane = tid & 63, w = __builtin_amdgcn_readfirstlane(tid >> 6), fr = lane & 15, fq = lane >> 4;
        const int b = unit >> 2, ft = unit & 3;
        f32x4 y[4][2];
#pragma unroll
        for (int mt = 0; mt < 4; ++mt)
#pragma unroll
            for (int n = 0; n < 2; ++n) y[mt][n] = (f32x4){0.f, 0.f, 0.f, 0.f};
        for (int q = 0; q < 4; ++q) {
            for (int i = tid; i < 4096; i += 512) { const int fl = i >> 6, tl = i & 63, ix = (((64 * ft + fl) * (64 * q + tl)) & 255) * 16; Tc[fl * TP + tl] = f2bf(TABC[ix]); Ts[fl * TP + tl] = f2bf(TABS[ix]); }
#pragma unroll
            for (int i = 0; i < 8; ++i) { const int qq = tid + 512 * i, row = qq >> 3, c8 = qq & 7;
                *(LAS u32x4*)((LAS unsigned char*)ZT + row * (TP * 2) + c8 * 16) = *(const u32x4*)(XCT + (((size_t)b * 4 + q) * 512 + row) * 64 + c8 * 8); }
            __syncthreads();
#pragma unroll
            for (int ks = 0; ks < 2; ++ks) { bf16x8 xr[2], xi[2];
#pragma unroll
                for (int n = 0; n < 2; ++n) { xr[n] = *(const LAS bf16x8*)(ZT + (32 * w + 16 * n + fr) * TP + 32 * ks + 8 * fq); xi[n] = *(const LAS bf16x8*)(ZT + (256 + 32 * w + 16 * n + fr) * TP + 32 * ks + 8 * fq); }
#pragma unroll
                for (int mt = 0; mt < 4; ++mt) { const bf16x8 c = *(const LAS bf16x8*)(Tc + (16 * mt + fr) * TP + 32 * ks + 8 * fq), s = *(const LAS bf16x8*)(Ts + (16 * mt + fr) * TP + 32 * ks + 8 * fq);
#pragma unroll
                    for (int n = 0; n < 2; ++n) { y[mt][n] = __builtin_amdgcn_mfma_f32_16x16x32_bf16(c, xr[n], y[mt][n], 0, 0, 0); y[mt][n] = __builtin_amdgcn_mfma_f32_16x16x32_bf16(s, xi[n], y[mt][n], 0, 0, 0); } } }
            __syncthreads();
        }
#pragma unroll
        for (int mt = 0; mt < 4; ++mt)
#pragma unroll
            for (int i = 0; i < 4; ++i)
#pragma unroll
                for (int n = 0; n < 2; ++n) Ys[(16 * mt + 4 * fq + i) * UP + 32 * w + 16 * n + fr] = f2bf(y[mt][n][i] * (1.f / 128.f));
        __syncthreads();
#pragma unroll
        for (int i = 0; i < 4; ++i) { const int qq = tid + 512 * i, fl = qq >> 5, ch = qq & 31;
            *(u32x4*)(MIX + ((size_t)b * NPOS + 64 * ft + fl) * D + ch * 8) = *(const LAS u32x4*)((const LAS unsigned char*)Ys + fl * (UP * 2) + ch * 16); }
        __syncthreads();
    }
}
}

constexpr int NWAVES = 8, RING_BYTES = 131072 + 3072, LDSCTL_OFF = RING_BYTES, MISC_OFF = LDSCTL_OFF + 64, META_OFF = MISC_OFF + 64, LDS_BYTES = 147456;
enum { PH_PRO0 = 0, PH_PRO1 = 1, PH_L0 = 2, PH_PER_LAYER = 8, PH_N = 18 };
enum { PL_WIN = 0, PL_PREP = 1, PL_MIX = 2, PL_WOUT = 3, PL_ROUTE = 4, PL_MOE1 = 5, PL_MOE2 = 6, PL_COMB = 7 };
struct MArgs { const float* in[30]; float* out; unsigned char* ws; int npass, skip_mask, dup_ph, dup_n, dup_sub, knob; };

__device__ __forceinline__ void transpose_item(const float* W, int K, int N, bf16_t* WT, int drow0, LAS float* scr, int k0, int n0, int lane) {
    const int kr = lane >> 3, nc = (lane & 7) * 4;
    f32x4 v[8];
#pragma unroll
    for (int i = 0; i < 8; ++i) v[i] = __builtin_nontemporal_load((const f32x4*)(W + (size_t)(k0 + kr + 8 * i) * N + n0 + nc));
#pragma unroll
    for (int i = 0; i < 8; ++i) { LAS float* d = scr + (kr + 8 * i) * 33 + nc; d[0] = v[i][0]; d[1] = v[i][1]; d[2] = v[i][2]; d[3] = v[i][3]; }
    asm volatile("s_waitcnt lgkmcnt(0)" ::: "memory");
    const int c = lane & 7;
#pragma unroll
    for (int j = 0; j < 4; ++j) { const int n = (lane >> 3) + 8 * j; const LAS float* s = scr + (8 * c) * 33 + n;
        u32x4 o; o.x = pk2(s[0 * 33], s[1 * 33]); o.y = pk2(s[2 * 33], s[3 * 33]); o.z = pk2(s[4 * 33], s[5 * 33]); o.w = pk2(s[6 * 33], s[7 * 33]);
        *(u32x4*)(WT + (size_t)(drow0 + n) * K + k0 + 8 * c) = o; }
    asm volatile("s_waitcnt lgkmcnt(0)" ::: "memory");
}

constexpr int I_GU = NE * 16 * 64, I_DN = NE * 16 * 32, I_EXP = I_GU + I_DN;
__device__ __forceinline__ void expert_item(int l, int j, const float* wgu, const float* wdn, unsigned char* ws, LAS float* scr, int lane) {
    if (j < I_GU) { const int e = j / (16 * 64), q = j % (16 * 64), kb = q / 64, nb = q % 64; const int n0 = 32 * nb; const int c2 = n0 & 1023; const int drow = (c2 >> 7) * 256 + (n0 >> 10) * 128 + (c2 & 127);
        transpose_item(wgu + ((size_t)l * NE + e) * D * 2048, D, 2048, (bf16_t*)(ws + L::WGUT) + ((size_t)l * NE + e) * 2048 * D, drow, scr, 64 * kb, n0, lane); }
    else { const int r = j - I_GU; const int e = r / (16 * 32), q = r % (16 * 32), kb = q / 32, nb = q % 32;
        transpose_item(wdn + ((size_t)l * NE + e) * D * D, D, D, (bf16_t*)(ws + L::WDT) + ((size_t)l * NE + e) * D * D, 32 * nb, scr, 64 * kb, 32 * nb, lane); }
}
constexpr int Q_WIN = 48, Q_WOUT = 96, Q_MOE2 = 0;
constexpr int DEF_WIN = 224 * Q_WIN, DEF0 = DEF_WIN + 240 * Q_WOUT, DEF_MOE2 = 128 * Q_MOE2, DEF1 = DEF_MOE2 + 224 * Q_WIN;
constexpr int MIX_X = 11520;
static_assert(I_EXP - DEF0 + MIX_X <= 34 * 1024 && I_EXP - DEF1 - MIX_X <= 34 * 1024, "one attention unit takes at most 34 items per converting wave");
__device__ __forceinline__ void deferred_items(int l, int first, int count, const float* wgu, const float* wdn, unsigned char* ws, LAS unsigned char* lds, int wave, int lane) {
    LAS float* scr = (LAS float*)(lds + wave * 16384);
    for (int j = first + wave; j < first + count; j += NWAVES) expert_item(l, j, wgu, wdn, ws, scr, lane);
}

#define GASP __attribute__((address_space(1)))
#define ARG_IN(i) ({ const GASP float* _p; asm volatile("s_load_dwordx2 %0, %1, %2\n\ts_waitcnt lgkmcnt(0)" : "=s"(_p) : "s"(__builtin_amdgcn_kernarg_segment_ptr()), "n"((i) * 8)); (const float*)_p; })
__global__ void __launch_bounds__(NWAVES * 64, 2) mega(MArgs args) {
    extern __shared__ __attribute__((aligned(16))) unsigned char lds_raw[];
    const int G0 = gridDim.x, bx0 = blockIdx.x;
    unsigned char* ws0 = args.ws;
    unsigned* ctl0 = (unsigned*)(ws0 + L::CTL);
    for (int u = threadIdx.x; u < (LDS_BYTES - LDSCTL_OFF) / 4; u += NWAVES * 64) ((LAS unsigned*)(lds_raw + LDSCTL_OFF))[u] = 0u;
    __syncthreads();
    volatile LAS unsigned* MISC = (volatile LAS unsigned*)((LAS unsigned char*)lds_raw + MISC_OFF);
    XcdBarrier bar = xcd_barrier_post(ctl0 + L::CW_BAR, MISC);
    const int lo = 0, hi = PH_N;

    bool first = true;
    for (int pass = 0; pass < args.npass; ++pass)
    for (int ph = lo; ph < hi; ++ph) {
      const int reps = (ph == args.dup_ph) ? 1 + args.dup_n : 1;
      if (ph == PH_PRO1) continue;
      for (int rep = 0; rep < reps; ++rep) {
        if (!first) xcd_barrier(bar);
        first = false;
        if (pass + 1 < args.npass && ((args.skip_mask >> ph) & 1)) continue;
        const int sub = rep + 1 < reps ? args.dup_sub : 15; const int knob = rep + 1 < reps ? args.knob : 0; (void)knob;
        GASP unsigned char* wsg = (GASP unsigned char*)args.ws; asm volatile("" : "+s"(wsg)); unsigned char* ws = (unsigned char*)wsg;
        unsigned* ctl = (unsigned*)(ws + L::CTL);
        int tid_p = threadIdx.x; asm volatile("" : "+v"(tid_p));
        int G = G0, bx = bx0; asm volatile("" : "+s"(G), "+s"(bx));
        const int vcu = (G % 8 == 0) ? (bx % 8) * (G / 8) + bx / 8 : bx; (void)vcu;
        unsigned ldsb = 0; asm volatile("" : "+s"(ldsb)); LAS unsigned char* lds = (LAS unsigned char*)lds_raw + ldsb;
        LAS int* META = (LAS int*)(lds + META_OFF);
        const int tid = tid_p, lane = tid & 63, wave = __builtin_amdgcn_readfirstlane(tid >> 6); (void)lane; (void)wave;
        if (ph == PH_PRO0) {
            if (bx == 0 && tid < 2 * NE) ((int*)(ctl + L::CW_CNT))[tid * L::CNT_STRIDE] = 0;
            sm::smallw_phase(ARG_IN(17), ARG_IN(16), ARG_IN(19), ARG_IN(18), ARG_IN(11), ARG_IN(13), (bf16_t*)(ws + L::WUQT), (bf16_t*)(ws + L::WUKVT), (bf16_t*)(ws + L::WAT), (bf16_t*)(ws + L::WIT),
                             (float*)(ws + L::TABC), (float*)(ws + L::TABS), ARG_IN(15), (float*)(ws + L::SPT), ARG_IN(23), (bf16_t*)(ws + L::RWH), (bf16_t*)(ws + L::RWL), bx * 512 + tid, G * 512);
            __syncthreads();
            sm::mod_phase(lds, ARG_IN(1), ARG_IN(3), ARG_IN(4), ARG_IN(5), (float*)(ws + L::MOD), G, bx, tid);
            { int nmine = 0; for (int u = bx; u < 96; u += G) ++nmine;
              if (nmine) { asm volatile("s_waitcnt vmcnt(0)" ::: "memory"); __syncthreads();
                  if (tid == 0) { __builtin_amdgcn_fence(__ATOMIC_RELEASE, "agent"); asm volatile("s_waitcnt vmcnt(0)" ::: "memory"); __hip_atomic_fetch_add(ctl + L::CW_MODCNT, (unsigned)nmine, __ATOMIC_RELAXED, __HIP_MEMORY_SCOPE_AGENT); } } }
            __syncthreads();
            LAS float* scr = (LAS float*)(lds + wave * 16384);
            const int gw = vcu * NWAVES + wave, NGW = G * NWAVES;
            constexpr int I_IN = 16 * 61, I_OUT = 16 * 32, I_D = I_IN + I_OUT; const int d0 = G == 256 ? I_EXP : 0, d1 = G == 256 ? I_EXP : 0, R0 = I_EXP - d0, R1 = I_EXP - d1;
            for (int it = gw; it < 2 * I_D + R0 + R1; it += NGW) {
                if (it < 2 * I_D) { const int l = it / I_D; int r = it % I_D;
                    if (r < I_IN) { const int kb = r / 61, nb = r % 61; transpose_item(ARG_IN(8) + (size_t)l * D * PT, D, PT, (bf16_t*)(ws + L::WINT) + (size_t)l * 2048 * D, 32 * nb, scr, 64 * kb, 32 * nb, lane); }
                    else { r -= I_IN; const int kb = r / 32, nb = r % 32; transpose_item(ARG_IN(22) + (size_t)l * D * D, D, D, (bf16_t*)(ws + L::WOUTT) + (size_t)l * D * D, 32 * nb, scr, 64 * kb, 32 * nb, lane); }
                } else { const int r = it - 2 * I_D; if (r < R0) expert_item(0, d0 + r, ARG_IN(25), ARG_IN(27), ws, scr, lane); else expert_item(1, d1 + (r - R0), ARG_IN(25), ARG_IN(27), ws, scr, lane); }
            }
            { u32x4 zv = {0u, 0u, 0u, 0u}; asm volatile("" : "+v"(zv));
              for (int i = bx * 512 + tid; i < 2 * 96 * D / 8; i += G * 512) { const int l = i / (96 * D / 8), q = i % (96 * D / 8); *(u32x4*)((bf16_t*)(ws + L::WINT) + ((size_t)l * 2048 + PT) * D + (size_t)q * 8) = zv; } }
            if (tid == 0) { unsigned sp = 0; while (__hip_atomic_load(ctl + L::CW_MODCNT, __ATOMIC_RELAXED, __HIP_MEMORY_SCOPE_AGENT) < 96u && ++sp < (1u << 22)) __builtin_amdgcn_s_sleep(2);
                __builtin_amdgcn_fence(__ATOMIC_ACQUIRE, "agent"); asm volatile("s_waitcnt vmcnt(0)" ::: "memory"); }
            __syncthreads();
            { const int nmod = G < 96 ? G : 96; const int small = 45, rs0 = bx < nmod ? bx * small : nmod * small + (int)(((long)(bx - nmod) * (MROWS - nmod * small)) / (G - nmod)),
                  rs1 = bx + 1 < nmod ? (bx + 1) * small : (bx + 1 >= G ? MROWS : nmod * small + (int)(((long)(bx + 1 - nmod) * (MROWS - nmod * small)) / (G - nmod)));
              sm::pro1_phase(ARG_IN(0), ARG_IN(2), ARG_IN(6), (const float*)(ws + L::MOD), (float*)(ws + L::H), (bf16_t*)(ws + L::XN), rs0 + wave, rs1, NWAVES, lane); }
            continue;
        }
        if (ph < PH_L0) continue;
        const int l = (ph - PH_L0) / PH_PER_LAYER, pl = (ph - PH_L0) % PH_PER_LAYER;
        const float* MODl = (const float*)(ws + L::MOD) + (size_t)l * 5 * 6144;
        if (pl == PL_WIN) {
            g8::DenseSched S; S.init(MROWS / 256, PP / 256, G, bx, 0, (const bf16_t*)(ws + L::WINT) + (size_t)l * 2048 * D, D);
            g8::EpiP E{(bf16_t*)(ws + L::P)};
            g8::gemm_phase<g8::EpiP, g8::DenseSched, false, false>(lds, (const char*)(ws + L::XN), S, E);
            if (G == 256 && bx >= 32) deferred_items(l, (l == 0 ? 0 : DEF_MOE2) + (bx - 32) * Q_WIN, Q_WIN, ARG_IN(25), ARG_IN(27), ws, lds, wave, lane);
        } else if (pl == PL_PREP) {
            if (l == 0 && (sub & 2)) { fft::ctx_a(lds, (const bf16_t*)(ws + L::P), (const float*)(ws + L::TABC), (const float*)(ws + L::TABS), (bf16_t*)(ws + L::XCT), G, G - 1 - bx); __syncthreads(); }
            for (int p = 0; p * G < 1072; ++p) {
                const int k = p * G + ((p & 1) ? G - 1 - bx : bx);
                if (k >= 1072) continue;
                if (k < 272) { if (sub & 4) prep::qkv_units(lds, l, (const bf16_t*)(ws + L::P), (const bf16_t*)(ws + L::WUQT), (const bf16_t*)(ws + L::WUKVT), ARG_IN(20) + l * 768, ARG_IN(21) + l * 256,
                            (bf16_t*)(ws + L::QL), (bf16_t*)(ws + L::QC), (bf16_t*)(ws + L::KB), (bf16_t*)(ws + L::VTG), (bf16_t*)(ws + L::MIX), k, k + 1, 1); }
                else if (k < 816) { if (sub & 8) lru::chunk_units(lds, l, (const bf16_t*)(ws + L::P), ARG_IN(9), ARG_IN(10), (const bf16_t*)(ws + L::WAT), (const bf16_t*)(ws + L::WIT), ARG_IN(12), ARG_IN(14), (const float*)(ws + L::SPT),
                             (bf16_t*)(ws + L::HL), (bf16_t*)(ws + L::AC), (float*)(ws + L::SUM), k - 272, k - 271, 1, knob); }
                else { if (sub & 1) fft::stage_a(lds, (const bf16_t*)(ws + L::P), (const float*)(ws + L::TABC), (const float*)(ws + L::TABS), (bf16_t*)(ws + L::ZBUF), k - 816, k - 815, 1); }
                __syncthreads();
            }
        } else if (pl == PL_MIX) {
            if (sub & 1) lru::fixup_units(lds, l, (const bf16_t*)(ws + L::P), (const bf16_t*)(ws + L::HL), (const bf16_t*)(ws + L::AC), (const float*)(ws + L::SUM), (bf16_t*)(ws + L::MIX), G, bx);
            if (sub & 2) fft::stage_b(lds, (const bf16_t*)(ws + L::ZBUF), (const float*)(ws + L::TABC), (const float*)(ws + L::TABS), (bf16_t*)(ws + L::MIX), G, bx);
            __syncthreads();
            if (l == 0 && (sub & 4)) { fft::ctx_b(lds, (const bf16_t*)(ws + L::XCT), (const float*)(ws + L::TABC), (const float*)(ws + L::TABS), (bf16_t*)(ws + L::MIX), G, G - 1 - bx); __syncthreads(); }
            cv::Job cvj; cvj.wgu = ARG_IN(25); cvj.wdn = ARG_IN(27); cvj.ws = ws;
            if (l == 0) { cvj.n0 = I_EXP - DEF0; cvj.first0 = DEF0; cvj.first1 = DEF1; cvj.nv = cvj.n0 + MIX_X; } else { cvj.n0 = 0; cvj.first0 = 0; cvj.first1 = DEF1 + MIX_X; cvj.nv = I_EXP - DEF1 - MIX_X; }
            if (sub & 8) attn::attn_phase(lds, (const bf16_t*)(ws + L::QL), (const bf16_t*)(ws + L::QC), (const bf16_t*)(ws + L::KB), (const bf16_t*)(ws + L::VTG), (bf16_t*)(ws + L::MIX), l == 0 ? 1 : 0, G, vcu, cvj, G == 256);
        } else if (pl == PL_WOUT) {
            g8::DenseSched S; S.init(l == 0 ? MROWS / 256 : 64, D / 256, G, bx, l == 0 ? 0 : 1, (const bf16_t*)(ws + L::WOUTT) + (size_t)l * D * D, D);
            g8::EpiH E{(float*)(ws + L::H), MODl, 2048};
            g8::gemm_phase<g8::EpiH, g8::DenseSched, false, false>(lds, (const char*)(ws + L::MIX), S, E);
            if (G == 256 && l == 0 && bx >= 16) deferred_items(0, DEF_WIN + (bx - 16) * Q_WOUT, Q_WOUT, ARG_IN(25), ARG_IN(27), ws, lds, wave, lane);
        } else if (pl == PL_ROUTE) {
            sm::route_phase(lds, l, (const float*)(ws + L::H), ARG_IN(7) + l * D, MODl, (const bf16_t*)(ws + L::RWH), (const bf16_t*)(ws + L::RWL), ARG_IN(24) + l * NE, (bf16_t*)(ws + L::XN), (int*)(ctl + L::CW_CNT) + l * NE * L::CNT_STRIDE,
                            (int*)(ws + L::LIST) + (size_t)l * NE * LCAP, (float*)(ws + L::GATE), G, bx, tid);
        } else if (pl == PL_COMB) {
            sm::comb_phase(l, (float*)(ws + L::H), (const bf16_t*)(ws + L::Y), MODl, ARG_IN(6) + D, (const float*)(ws + L::MOD) + (size_t)5 * 6144, (bf16_t*)(ws + L::XN), ARG_IN(29), args.out, bx * NWAVES + wave, G * NWAVES, lane);
        } else if (pl == PL_MOE1 || pl == PL_MOE2) {
            const int* CNTg = (const int*)(ctl + L::CW_CNT) + l * NE * L::CNT_STRIDE;
            if (tid == 0) { int o = 0; for (int e = 0; e < NE; ++e) { const int cn = CNTg[e * L::CNT_STRIDE]; META[e] = o; META[64 + e] = cn; o += (cn + 255) >> 8; } META[NE] = o; }
            __syncthreads();
            g8::MoeSched S; S.tpre = META; S.cnt = META + 64; S.G = G; S.c = bx; S.K = D; S.list = (const int*)(ws + L::LIST) + (size_t)l * NE * LCAP;
            if (pl == PL_MOE1) {
                S.NT = 8; S.COLW = 128; S.total = __builtin_amdgcn_readfirstlane(META[NE]) * 8; S.Bt = (const char*)((const bf16_t*)(ws + L::WGUT) + (size_t)l * NE * 2048 * D);
                g8::EpiMoe1 E{(bf16_t*)(ws + L::ACT), ARG_IN(26) + (size_t)l * NE * 2048};
                g8::gemm_phase<g8::EpiMoe1, g8::MoeSched, true, true>(lds, (const char*)(ws + L::XN), S, E);
            } else {
                S.NT = 4; S.COLW = 256; S.total = __builtin_amdgcn_readfirstlane(META[NE]) * 4; S.Bt = (const char*)((const bf16_t*)(ws + L::WDT) + (size_t)l * NE * D * D);
                g8::EpiMoe2 E{(bf16_t*)(ws + L::Y), ARG_IN(28) + (size_t)l * NE * D, (const float*)(ws + L::GATE)};
                g8::gemm_phase<g8::EpiMoe2, g8::MoeSched, false, true>(lds, (const char*)(ws + L::ACT), S, E);
                if (G == 256 && l == 0 && bx >= 128) deferred_items(1, (bx - 128) * Q_MOE2, Q_MOE2, ARG_IN(25), ARG_IN(27), ws, lds, wave, lane);
            }
            __syncthreads();
        }
      }
    }
}
constexpr int PROBE_DUP_PH = -1, PROBE_DUP_N = 0, PROBE_DUP_SUB = 15, PROBE_KNOB = 0;
constexpr int PROBE_NPASS = 1, PROBE_SKIP = 0;
extern "C" void kernel_launch(void* const* d_in, const int* in_sizes, int n_in, void* d_out, int out_size, void* d_ws, size_t ws_size, hipStream_t stream) {
    static int grid = 0;
    if (grid == 0) {
        if (n_in != 30 || out_size != NB_ * SEQ * D || (size_t)L::END > ws_size) { fprintf(stderr, "kernel_launch: unexpected problem shape (n_in %d, out %d) or workspace too small (need %zu, have %zu); nothing launched\n", n_in, out_size, (size_t)L::END, ws_size); grid = -1; return; }
        int dev = 0, cus = 0;
        if (hipGetDevice(&dev) != hipSuccess || hipDeviceGetAttribute(&cus, hipDeviceAttributeMultiprocessorCount, dev) != hipSuccess) { fprintf(stderr, "kernel_launch: device query failed\n"); grid = -1; return; }
        if (hipFuncSetAttribute((const void*)mega, hipFuncAttributeMaxDynamicSharedMemorySize, LDS_BYTES) != hipSuccess) { fprintf(stderr, "kernel_launch: hipFuncSetAttribute failed\n"); grid = -1; return; }
        int per_cu = 0;
        if (hipOccupancyMaxActiveBlocksPerMultiprocessor(&per_cu, (const void*)mega, NWAVES * 64, LDS_BYTES) != hipSuccess || per_cu < 1) fprintf(stderr, "kernel_launch: note: the occupancy query reports %d workgroups per CU; launching one per CU anyway\n", per_cu);
        (void)hipGetLastError();
        grid = cus < 256 ? cus : 256;
    }
    if (grid < 0) return;
    unsigned char* p = (unsigned char*)d_ws;
    (void)hipMemsetAsync(p + L::CTL, 0, L::CTL_BYTES, stream);
    MArgs a{};
    for (int i = 0; i < 30; ++i) a.in[i] = (const float*)d_in[i];
    a.out = (float*)d_out; a.ws = p; a.npass = PROBE_NPASS; a.skip_mask = PROBE_SKIP; a.dup_ph = PROBE_DUP_PH; a.dup_n = PROBE_DUP_N; a.dup_sub = PROBE_DUP_SUB; a.knob = PROBE_KNOB;
    hipLaunchKernelGGL(mega, dim3(grid), dim3(NWAVES * 64), LDS_BYTES, stream, a);
}
```
